# Optimizing an MI355X kernel written in HIP

```python
import jax, jax.numpy as jnp
from jax import lax
import numpy as np

D_MODEL = 1024
BATCH = 32
SEQ = 2048
DEPTH = 2

CHUNK = 64
Q_BLOCK = 128
N_A_LAYERS = max(1, DEPTH // 2)
N_B_LAYERS = DEPTH - N_A_LAYERS
N_DENSE = (DEPTH + 1) // 2
N_MOE = DEPTH // 2

MLA_HEADS = 16
MLA_NOPE = 64
MLA_ROPE = 32
MLA_QK = MLA_NOPE + MLA_ROPE
MLA_V = 64
Q_LORA = 384
KV_LORA = 256
ROPE_THETA = 10000.0

CA_HEADS = 16
CA_HEAD_DIM = D_MODEL // CA_HEADS
LEFT_CHUNKS = 8
BAND = (LEFT_CHUNKS + 1) * CHUNK
REL_CLIP = 128

DENSE_FF = 2816
N_EXPERTS = 8
TOP_K = 2
EXPERT_FF = 3584

EPS = 1e-6

kernel_name = "yoco_mla_chunkband_moe_trunk"


def rms_norm(x, g):
    xf = x.astype(jnp.float32)
    y = xf * lax.rsqrt(jnp.mean(xf * xf, axis=-1, keepdims=True) + EPS)
    return (y * g.astype(jnp.float32)).astype(x.dtype)


def rope(x, pos):
    half = x.shape[-1] // 2
    inv = ROPE_THETA ** (-jnp.arange(half, dtype=jnp.float32) / half)
    ang = pos.astype(jnp.float32)[:, None] * inv[None, :]
    cos = jnp.cos(ang)[:, None, :]
    sin = jnp.sin(ang)[:, None, :]
    xf = x.astype(jnp.float32)
    x1, x2 = xf[..., :half], xf[..., half:]
    return jnp.concatenate([x1 * cos - x2 * sin, x2 * cos + x1 * sin], axis=-1).astype(x.dtype)


def swiglu(h, w1, w3, w2):
    return (jax.nn.silu(h @ w1) * (h @ w3)) @ w2


def block_causal_attention(q, k, v, scale):
    B, S, H, Dq = q.shape
    Dv = v.shape[-1]
    nb = S // Q_BLOCK
    qb = q.reshape(B, nb, Q_BLOCK, H, Dq).transpose(1, 0, 2, 3, 4)
    kchunk = jnp.arange(S) // CHUNK
    neg = jnp.finfo(jnp.float32).min

    def one(args):
        qblk, ib = args
        s = jnp.einsum('bqhd,bkhd->bhqk', qblk, k).astype(jnp.float32) * scale
        qchunk = (ib * Q_BLOCK + jnp.arange(Q_BLOCK)) // CHUNK
        mask = kchunk[None, :] <= qchunk[:, None]
        s = jnp.where(mask[None, None], s, neg)
        p = jax.nn.softmax(s, axis=-1).astype(v.dtype)
        return jnp.einsum('bhqk,bkhd->bqhd', p, v)

    o = lax.map(one, (qb, jnp.arange(nb)))
    return o.transpose(1, 0, 2, 3, 4).reshape(B, S, H, Dv)


def mla_attention(h, w_dq, g_cq, w_uq, w_dkv, g_ckv, w_ukv, g_qn, g_kn, w_o):
    B, S, _ = h.shape
    pos = jnp.arange(S)
    c_q = rms_norm(h @ w_dq, g_cq)
    q = (c_q @ w_uq).reshape(B, S, MLA_HEADS, MLA_QK)
    kv_a = h @ w_dkv
    c_kv = rms_norm(kv_a[..., :KV_LORA], g_ckv)
    k_pe = jnp.broadcast_to(kv_a[:, :, None, KV_LORA:], (B, S, MLA_HEADS, MLA_ROPE))
    kv = (c_kv @ w_ukv).reshape(B, S, MLA_HEADS, MLA_NOPE + MLA_V)
    k_nope, v = kv[..., :MLA_NOPE], kv[..., MLA_NOPE:]
    k = jnp.concatenate([k_nope, k_pe], axis=-1)
    q = rms_norm(q, g_qn)
    k = rms_norm(k, g_kn)
    q = jnp.concatenate([q[..., :MLA_NOPE], rope(q[..., MLA_NOPE:], pos)], axis=-1)
    k = jnp.concatenate([k[..., :MLA_NOPE], rope(k[..., MLA_NOPE:], pos)], axis=-1)
    o = block_causal_attention(q, k, v, MLA_QK ** -0.5)
    return o.reshape(B, S, MLA_HEADS * MLA_V) @ w_o


def shared_band_kv(x, g_kv, w_k, w_v, g_kn):
    B, S, _ = x.shape
    h = rms_norm(x, g_kv)
    k = rms_norm((h @ w_k).reshape(B, S, CA_HEADS, CA_HEAD_DIM), g_kn)
    v = (h @ w_v).reshape(B, S, CA_HEADS, CA_HEAD_DIM)
    pad = ((0, 0), (LEFT_CHUNKS * CHUNK, 0), (0, 0), (0, 0))
    return jnp.pad(k, pad), jnp.pad(v, pad)


def chunked_band_attention(h, w_q, g_qn, rel_bias, w_o, k_pad, v_pad):
    B, S, _ = h.shape
    nc = S // CHUNK
    q = rms_norm((h @ w_q).reshape(B, S, CA_HEADS, CA_HEAD_DIM), g_qn)
    i = jnp.arange(CHUNK)
    j = jnp.arange(BAND)
    rel = i[:, None] + LEFT_CHUNKS * CHUNK - j[None, :]
    idx = jnp.clip(rel, -REL_CLIP, REL_CLIP) + REL_CLIP
    bias = rel_bias[:, idx].astype(jnp.float32)
    qc = q.reshape(B, nc, CHUNK, CA_HEADS, CA_HEAD_DIM).transpose(1, 0, 2, 3, 4)
    neg = jnp.finfo(jnp.float32).min
    scale = CA_HEAD_DIM ** -0.5

    def one(args):
        qch, c = args
        kb = lax.dynamic_slice_in_dim(k_pad, c * CHUNK, BAND, axis=1)
        vb = lax.dynamic_slice_in_dim(v_pad, c * CHUNK, BAND, axis=1)
        s = jnp.einsum('bqhd,bkhd->bhqk', qch, kb).astype(jnp.float32) * scale + bias[None]
        valid = (c - LEFT_CHUNKS) * CHUNK + j >= 0
        s = jnp.where(valid[None, None, None, :], s, neg)
        p = jax.nn.softmax(s, axis=-1).astype(vb.dtype)
        return jnp.einsum('bhqk,bkhd->bqhd', p, vb)

    o = lax.map(one, (qc, jnp.arange(nc)))
    o = o.transpose(1, 0, 2, 3, 4).reshape(B, S, CA_HEADS * CA_HEAD_DIM)
    return o @ w_o


def moe_swiglu(h, w_router, w1, w3, w2):
    B, S, D = h.shape
    t = h.reshape(B * S, D)
    logits = (t @ w_router).astype(jnp.float32)
    top_vals, top_idx = lax.top_k(logits, TOP_K)
    gates = jax.nn.softmax(top_vals, axis=-1)
    combine = jnp.sum(jax.nn.one_hot(top_idx, N_EXPERTS, dtype=jnp.float32) * gates[..., None], axis=1)
    y = jnp.zeros_like(t)
    for e in range(N_EXPERTS):
        y = y + combine[:, e:e + 1].astype(t.dtype) * swiglu(t, w1[e], w3[e], w2[e])
    return y.reshape(B, S, D)


def setup_inputs(seed: int = 0) -> dict:
    key = jax.random.key(seed)
    ks = list(jax.random.split(key, 32))
    f32 = jnp.float32

    def w(k, shape, fan_in):
        return jax.random.normal(k, shape, f32) * (fan_in ** -0.5)

    def gain(k, shape):
        return 1.0 + 0.02 * jax.random.normal(k, shape, f32)

    D = D_MODEL
    return {
        "x": jax.random.normal(ks[0], (BATCH, SEQ, D), f32),
        "attn_norm": gain(ks[1], (DEPTH, D)),
        "ffn_norm": gain(ks[2], (DEPTH, D)),
        "a_w_dq": w(ks[3], (N_A_LAYERS, D, Q_LORA), D),
        "a_g_cq": gain(ks[4], (N_A_LAYERS, Q_LORA)),
        "a_w_uq": w(ks[5], (N_A_LAYERS, Q_LORA, MLA_HEADS * MLA_QK), Q_LORA),
        "a_w_dkv": w(ks[6], (N_A_LAYERS, D, KV_LORA + MLA_ROPE), D),
        "a_g_ckv": gain(ks[7], (N_A_LAYERS, KV_LORA)),
        "a_w_ukv": w(ks[8], (N_A_LAYERS, KV_LORA, MLA_HEADS * (MLA_NOPE + MLA_V)), KV_LORA),
        "a_g_qn": gain(ks[9], (N_A_LAYERS, MLA_QK)),
        "a_g_kn": gain(ks[10], (N_A_LAYERS, MLA_QK)),
        "a_w_o": w(ks[11], (N_A_LAYERS, MLA_HEADS * MLA_V, D), MLA_HEADS * MLA_V),
        "kv_norm": gain(ks[12], (D,)),
        "kv_w_k": w(ks[13], (D, CA_HEADS * CA_HEAD_DIM), D),
        "kv_w_v": w(ks[14], (D, CA_HEADS * CA_HEAD_DIM), D),
        "kv_g_kn": gain(ks[15], (CA_HEAD_DIM,)),
        "b_w_q": w(ks[16], (N_B_LAYERS, D, CA_HEADS * CA_HEAD_DIM), D),
        "b_g_qn": gain(ks[17], (N_B_LAYERS, CA_HEAD_DIM)),
        "b_rel_bias": 0.1 * jax.random.normal(ks[18], (N_B_LAYERS, CA_HEADS, 2 * REL_CLIP + 1), f32),
        "b_w_o": w(ks[19], (N_B_LAYERS, CA_HEADS * CA_HEAD_DIM, D), CA_HEADS * CA_HEAD_DIM),
        "ffn_w1": w(ks[20], (N_DENSE, D, DENSE_FF), D),
        "ffn_w3": w(ks[21], (N_DENSE, D, DENSE_FF), D),
        "ffn_w2": w(ks[22], (N_DENSE, DENSE_FF, D), DENSE_FF),
        "moe_router": w(ks[23], (N_MOE, D, N_EXPERTS), D),
        "moe_w1": w(ks[24], (N_MOE, N_EXPERTS, D, EXPERT_FF), D),
        "moe_w3": w(ks[25], (N_MOE, N_EXPERTS, D, EXPERT_FF), D),
        "moe_w2": w(ks[26], (N_MOE, N_EXPERTS, EXPERT_FF, D), EXPERT_FF),
    }


def reference(x, attn_norm, ffn_norm, a_w_dq, a_g_cq, a_w_uq, a_w_dkv, a_g_ckv, a_w_ukv,
              a_g_qn, a_g_kn, a_w_o, kv_norm, kv_w_k, kv_w_v, kv_g_kn, b_w_q, b_g_qn,
              b_rel_bias, b_w_o, ffn_w1, ffn_w3, ffn_w2, moe_router, moe_w1, moe_w3, moe_w2):
    k_pad = None
    v_pad = None
    for layer in range(DEPTH):
        h = rms_norm(x, attn_norm[layer])
        if layer < N_A_LAYERS:
            la = layer
            x = x + mla_attention(h, a_w_dq[la], a_g_cq[la], a_w_uq[la], a_w_dkv[la], a_g_ckv[la],
                                  a_w_ukv[la], a_g_qn[la], a_g_kn[la], a_w_o[la])
        else:
            lb = layer - N_A_LAYERS
            x = x + chunked_band_attention(h, b_w_q[lb], b_g_qn[lb], b_rel_bias[lb], b_w_o[lb],
                                           k_pad, v_pad)
        h = rms_norm(x, ffn_norm[layer])
        if layer % 2 == 0:
            ld = layer // 2
            x = x + swiglu(h, ffn_w1[ld], ffn_w3[ld], ffn_w2[ld])
        else:
            lm = layer // 2
            x = x + moe_swiglu(h, moe_router[lm], moe_w1[lm], moe_w3[lm], moe_w2[lm])
        if layer == N_A_LAYERS - 1:
            k_pad, v_pad = shared_band_kv(x, kv_norm, kv_w_k, kv_w_v, kv_g_kn)
    return x
```

```cpp
#include <hip/hip_runtime.h>
#include <cstdio>
#include <cstdint>
namespace pg8 {
#define PG8_LAS __attribute__((address_space(3)))
typedef unsigned short bf16_t;
typedef short bf16x8 __attribute__((ext_vector_type(8)));
typedef float f32x4 __attribute__((ext_vector_type(4)));
typedef unsigned u32x4 __attribute__((ext_vector_type(4)));
constexpr int BM = 256, BK = 64, HALF = 128, HTB = HALF * BK * 2  , STAGE_BYTES = 8 * HTB, NXCD = 8, WGM = 8;

__host__ __device__ __forceinline__ int lds_byte(int r, int c) { const int st = (r >> 4) * 2 + (c >> 5), rr = r & 15, cc = c & 31, ob = rr * 64 + cc * 2; return st * 1024 + (ob ^ (((ob >> 9) & 1) << 5)); }
__host__ __device__ __forceinline__ void stage_rc(int b, int& R, int& C) { const int st = b / 1024, sb = b % 1024, swz = sb ^ (((sb >> 9) & 1) << 5); R = (st >> 1) * 16 + swz / 64; C = (st & 1) * 32 + (swz % 64) / 2; }
__host__ __device__ __forceinline__ int perm32(int rho) { const int n = rho >> 4, i = rho & 15; return 8 * (i >> 2) + 4 * n + (i & 3); }

struct Unit { int pm, pn; };
struct Gemm { const bf16_t* A; const bf16_t* Bt; int M, N, K; };

struct StaticOrder {
    int nM, nN, nwg, G, c;
    __host__ __device__ void init(int M, int N, int G_, int c_) { nM = M / BM; nN = N / BM; nwg = nM * nN; G = G_; c = c_; }
    __host__ __device__ bool next(int i, Unit& u) const {
        const long L = (long)i * G + c; if (L >= nwg) return false;
        int wgid = (int)L; { const int q = nwg / NXCD, r = nwg % NXCD, xcd = wgid % NXCD, off = wgid / NXCD; wgid = (xcd < r ? xcd * (q + 1) : r * (q + 1) + (xcd - r) * q) + off; }
        const int nig = WGM * nN, gid = wgid / nig, fm = gid * WGM, gsz = (nM - fm) < WGM ? (nM - fm) : WGM;
        u.pm = fm + ((wgid % nig) % gsz); u.pn = (wgid % nig) / gsz; return true;
    }
    __device__ __forceinline__ void a_ready(const Unit&) const {}
    __device__ __forceinline__ void done(const Unit&) const {}
};
__device__ __forceinline__ unsigned cvt_pk_bf16(float lo, float hi) { unsigned r; asm volatile("v_cvt_pk_bf16_f32 %0, %1, %2" : "=v"(r) : "v"(lo), "v"(hi)); return r; }
__device__ __forceinline__ float silu_f(float x) { const float e = __builtin_amdgcn_exp2f(x * -1.4426950408889634f); return x * __builtin_amdgcn_rcpf(1.f + e); }

struct EpiStoreBf16 {
    static constexpr bool PERM = true, AFTER_DRAIN = false;
    bf16_t* O; int ldc; int ntile;
    __device__ __forceinline__ void operator()(const f32x4 (&acc)[2][2][4][2], const Unit& u, int wr, int wc, int fr, int fq) const {
        const int pnl = ntile ? (u.pn % ntile) : u.pn;
        const int row0 = u.pm * BM + wr * 64 + fr, col0 = pnl * BM + wc * 32 + 8 * fq;
#pragma unroll
        for (int ai = 0; ai < 2; ++ai)
#pragma unroll
            for (int m = 0; m < 4; ++m) { bf16_t* rowp = O + (size_t)(row0 + ai * HALF + m * 16) * ldc + col0;
#pragma unroll
                for (int bj = 0; bj < 2; ++bj) { const f32x4 v0 = acc[ai][bj][m][0], v1 = acc[ai][bj][m][1];
                    u32x4 w; w.x = cvt_pk_bf16(v0[0], v0[1]); w.y = cvt_pk_bf16(v0[2], v0[3]); w.z = cvt_pk_bf16(v1[0], v1[1]); w.w = cvt_pk_bf16(v1[2], v1[3]);
                    *(u32x4*)(rowp + bj * HALF) = w; } }
    }
};

struct EpiGated {
    static constexpr bool PERM = true, AFTER_DRAIN = false;
    bf16_t* Hd; int ldc; int ntile;
    __device__ __forceinline__ void operator()(const f32x4 (&acc)[2][2][4][2], const Unit& u, int wr, int wc, int fr, int fq) const {
        const int pnl = ntile ? (u.pn % ntile) : u.pn;
        const int row0 = u.pm * BM + wr * 64 + fr, col0 = pnl * HALF + wc * 32 + 8 * fq;
#pragma unroll
        for (int ai = 0; ai < 2; ++ai)
#pragma unroll
            for (int m = 0; m < 4; ++m) { bf16_t* rowp = Hd + (size_t)(row0 + ai * HALF + m * 16) * ldc + col0;
                const f32x4 g0 = acc[ai][0][m][0], g1 = acc[ai][0][m][1], u0 = acc[ai][1][m][0], u1 = acc[ai][1][m][1];
                u32x4 w;
                w.x = cvt_pk_bf16(silu_f(g0[0]) * u0[0], silu_f(g0[1]) * u0[1]); w.y = cvt_pk_bf16(silu_f(g0[2]) * u0[2], silu_f(g0[3]) * u0[3]);
                w.z = cvt_pk_bf16(silu_f(g1[0]) * u1[0], silu_f(g1[1]) * u1[1]); w.w = cvt_pk_bf16(silu_f(g1[2]) * u1[2], silu_f(g1[3]) * u1[3]);
                *(u32x4*)rowp = w; }
    }
};

struct EpiResF32 {
    static constexpr bool PERM = false, AFTER_DRAIN = false;
    const float* res; float* out; int ldc;
    __device__ __forceinline__ void operator()(const f32x4 (&acc)[2][2][4][2], const Unit& u, int wr, int wc, int fr, int fq) const {
        const int row0 = u.pm * BM + wr * 64 + fr, col0 = u.pn * BM + wc * 32 + 4 * fq;
#pragma unroll
        for (int ai = 0; ai < 2; ++ai)
#pragma unroll
            for (int m = 0; m < 4; ++m) { const size_t ro = (size_t)(row0 + ai * HALF + m * 16) * ldc + col0;
                f32x4 r[2][2];
#pragma unroll
                for (int bj = 0; bj < 2; ++bj)
#pragma unroll
                    for (int n = 0; n < 2; ++n) r[bj][n] = *(const f32x4*)(res + ro + bj * HALF + n * 16);
#pragma unroll
                for (int bj = 0; bj < 2; ++bj)
#pragma unroll
                    for (int n = 0; n < 2; ++n) *(f32x4*)(out + ro + bj * HALF + n * 16) = r[bj][n] + acc[ai][bj][m][n]; }
    }
};

struct EpiMoeDown {
    static constexpr bool PERM = false, AFTER_DRAIN = false;
    float* out; const int* slot_tok; const float* slot_gate; int slot_base; int ldc;
    __device__ __forceinline__ void operator()(const f32x4 (&acc)[2][2][4][2], const Unit& u, int wr, int wc, int fr, int fq) const {
        const int pnl = u.pn & 3;
        const int row0 = slot_base + u.pm * BM + wr * 64 + fr, col0 = pnl * BM + wc * 32 + 4 * fq;
#pragma unroll
        for (int ai = 0; ai < 2; ++ai)
#pragma unroll
            for (int m = 0; m < 4; ++m) { const int slot = row0 + ai * HALF + m * 16; const int tok = slot_tok[slot]; const float gt = slot_gate[slot];
                if (tok >= 0) { float* rowp = out + (size_t)tok * ldc + col0;
                    f32x4 r[2][2];
#pragma unroll
                    for (int bj = 0; bj < 2; ++bj)
#pragma unroll
                        for (int n = 0; n < 2; ++n) r[bj][n] = *(const f32x4*)(rowp + bj * HALF + n * 16);
#pragma unroll
                    for (int bj = 0; bj < 2; ++bj)
#pragma unroll
                        for (int n = 0; n < 2; ++n) *(f32x4*)(rowp + bj * HALF + n * 16) = r[bj][n] + acc[ai][bj][m][n] * gt; } }
    }
};

struct MoeOrder {
    int nM, nN, nwg, G, c; const int* panel_e;
    __device__ void init(int nPanels, int nN_, int G_, int c_, const int* pe) { nM = nPanels; nN = nN_; nwg = nM * nN; G = G_; c = c_; panel_e = pe; }
    __device__ bool next(int i, Unit& u) const {
        const long L = (long)i * G + c; if (L >= nwg) return false;
        int wgid = (int)L; { const int q = nwg / NXCD, r = nwg % NXCD, xcd = wgid % NXCD, off = wgid / NXCD; wgid = (xcd < r ? xcd * (q + 1) : r * (q + 1) + (xcd - r) * q) + off; }
        const int nig = WGM * nN, gid = wgid / nig, fm = gid * WGM, gsz = (nM - fm) < WGM ? (nM - fm) : WGM;
        u.pm = fm + ((wgid % nig) % gsz); const int pnl = (wgid % nig) / gsz;
        const int e = __builtin_amdgcn_readfirstlane(panel_e[u.pm]);
        u.pn = e * nN + pnl; return true;
    }
    __device__ __forceinline__ void a_ready(const Unit&) const {}
    __device__ __forceinline__ void done(const Unit&) const {}
};
template <class Epi, class Sched, bool ALIGN_EPI = false, bool SP2 = false>
__device__ __forceinline__ void gemm_phase(PG8_LAS unsigned char* lds, const Gemm g, const Sched& S, const Epi& E) {
    const int tid = threadIdx.x, wid = __builtin_amdgcn_readfirstlane(tid >> 6), lane = tid & 63, wr = wid >> 2, wc = wid & 3, fr = lane & 15, fq = lane >> 4;
    const int K = g.K, nt = K / BK;
    unsigned voffA[2], voffB[2];
#pragma unroll
    for (int i = 0; i < 2; ++i) { int R, C; stage_rc(tid * 16 + i * 8192, R, C); const int Rb = Epi::PERM ? ((R & ~31) + perm32(R & 31)) : R;
        voffA[i] = (unsigned)(R * K + C) * 2u; voffB[i] = (unsigned)(Rb * K + C) * 2u; }
    const size_t kstep = (size_t)(BK * 2);
    const size_t hstep = (size_t)HALF * K * 2;
    const size_t tstep = 2 * hstep;
    const unsigned ldsw = (unsigned)wid * 1024u;
    const int aoff = lds_byte(wr * 64 + fr, fq * 8), boff = lds_byte(wc * 32 + fr, fq * 8);
#define PG8_SA(b, h) (((b) * 2 + (h)) * HTB)
#define PG8_SB(b, h) ((4 + (b) * 2 + (h)) * HTB)
#define PG8_STAGE(bufoff, gbase, voff) do { _Pragma("unroll") for (int _i = 0; _i < 2; ++_i) \
        __builtin_amdgcn_global_load_lds((const unsigned*)((const char*)(gbase) + (voff)[_i]), (PG8_LAS unsigned*)(lds + (bufoff) + ldsw + _i * 8192), 16, 0, 0); } while (0)
#define PG8_LDA(dst, b, h) do { _Pragma("unroll") for (int m = 0; m < 4; ++m) _Pragma("unroll") for (int k = 0; k < 2; ++k) dst[m][k] = *(const PG8_LAS bf16x8*)(lds + PG8_SA(b, h) + aoff + m * 2048 + k * 1024); } while (0)
#define PG8_LDB(dst, b, h) do { _Pragma("unroll") for (int n = 0; n < 2; ++n) _Pragma("unroll") for (int k = 0; k < 2; ++k) dst[n][k] = *(const PG8_LAS bf16x8*)(lds + PG8_SB(b, h) + boff + n * 2048 + k * 1024); } while (0)
#define PG8_MMA(ai, bj, At, Bt) do { __builtin_amdgcn_s_setprio(1); _Pragma("unroll") for (int m = 0; m < 4; ++m) _Pragma("unroll") for (int n = 0; n < 2; ++n) _Pragma("unroll") for (int k = 0; k < 2; ++k) \
        acc[ai][bj][m][n] = __builtin_amdgcn_mfma_f32_16x16x32_bf16(Bt[n][k], At[m][k], acc[ai][bj][m][n], 0, 0, 0); __builtin_amdgcn_s_setprio(0); } while (0)
#define PG8_WAIT_V(n) asm volatile("s_waitcnt vmcnt(" #n ")" ::: "memory")
#define PG8_WAIT_L(n) asm volatile("s_waitcnt lgkmcnt(" #n ")" ::: "memory")
#define PG8_BAR __builtin_amdgcn_s_barrier()
#define PG8_SCHED __builtin_amdgcn_sched_barrier(0)
    Unit cur, nxt; int ui = 0;
    if (!S.next(0, cur)) return;
    f32x4 acc[2][2][4][2];
#pragma unroll
    for (int a = 0; a < 2; ++a)
#pragma unroll
        for (int b = 0; b < 2; ++b)
#pragma unroll
            for (int m = 0; m < 4; ++m)
#pragma unroll
                for (int n = 0; n < 2; ++n) acc[a][b][m][n] = (f32x4){0.f, 0.f, 0.f, 0.f};
    bf16x8 At[4][2], B0[2][2], B1[2][2];
    const char* cA = (const char*)g.A + (size_t)cur.pm * tstep; const char* cB = (const char*)g.Bt + (size_t)cur.pn * tstep;
    S.a_ready(cur);
    if constexpr (SP2) {
        PG8_STAGE(PG8_SB(0, 0), cB, voffB); PG8_STAGE(PG8_SB(0, 1), cB + hstep, voffB); PG8_STAGE(PG8_SA(0, 0), cA, voffA); PG8_STAGE(PG8_SA(0, 1), cA + hstep, voffA);
        if (wr == 1) PG8_BAR;
        PG8_WAIT_V(2); PG8_BAR;
        PG8_STAGE(PG8_SB(1, 0), cB + kstep, voffB); PG8_STAGE(PG8_SA(1, 0), cA + kstep, voffA); PG8_STAGE(PG8_SB(1, 1), cB + hstep + kstep, voffB);
        PG8_WAIT_V(6); PG8_BAR;
    } else {
        PG8_STAGE(PG8_SB(0, 0), cB, voffB); PG8_STAGE(PG8_SA(0, 0), cA, voffA); PG8_STAGE(PG8_SB(0, 1), cB + hstep, voffB); PG8_STAGE(PG8_SA(0, 1), cA + hstep, voffA);
        if (wr == 1) PG8_BAR;
        PG8_WAIT_V(4); PG8_BAR;
        PG8_STAGE(PG8_SB(1, 0), cB + kstep, voffB); PG8_STAGE(PG8_SA(1, 0), cA + kstep, voffA); PG8_STAGE(PG8_SB(1, 1), cB + hstep + kstep, voffB);
        PG8_WAIT_V(6); PG8_BAR;
    }
    for (;;) {
        const bool has_next = S.next(ui + 1, nxt);
        const char* nA = has_next ? (const char*)g.A + (size_t)nxt.pm * tstep : cA; const char* nB = has_next ? (const char*)g.Bt + (size_t)nxt.pn * tstep : cB;
        for (int t = 0; t < nt; t += 2) {
            const bool last = (t == nt - 2);
            const char* a1 = cA + (size_t)(t + 1) * kstep;
            const char* a2 = last ? nA : cA + (size_t)(t + 2) * kstep; const char* b2 = last ? nB : cB + (size_t)(t + 2) * kstep;
            const char* a3 = a2 + kstep; const char* b3 = b2 + kstep;
            if (last && has_next) S.a_ready(nxt);
            if constexpr (SP2) {
            PG8_LDB(B0, 0, 0); PG8_LDB(B1, 0, 1); PG8_SCHED; PG8_LDA(At, 0, 0); PG8_STAGE(PG8_SA(1, 1), a1 + hstep, voffA);
            PG8_WAIT_V(8); PG8_WAIT_L(0); PG8_BAR; PG8_MMA(0, 0, At, B0); PG8_MMA(0, 1, At, B1); PG8_BAR; PG8_SCHED;
            PG8_LDA(At, 0, 1); PG8_STAGE(PG8_SB(0, 0), b2, voffB); PG8_STAGE(PG8_SB(0, 1), b2 + hstep, voffB); PG8_STAGE(PG8_SA(0, 0), a2, voffA);
            PG8_WAIT_V(8); PG8_WAIT_L(0); PG8_BAR; PG8_MMA(1, 0, At, B0); PG8_MMA(1, 1, At, B1); PG8_BAR; PG8_SCHED;
            PG8_LDB(B0, 1, 0); PG8_LDB(B1, 1, 1); PG8_SCHED; PG8_LDA(At, 1, 0); PG8_STAGE(PG8_SA(0, 1), a2 + hstep, voffA);
            PG8_WAIT_V(8); PG8_WAIT_L(0); PG8_BAR; PG8_MMA(0, 0, At, B0); PG8_MMA(0, 1, At, B1); PG8_BAR; PG8_SCHED;
            PG8_LDA(At, 1, 1); PG8_STAGE(PG8_SB(1, 0), b3, voffB); PG8_STAGE(PG8_SB(1, 1), b3 + hstep, voffB); PG8_STAGE(PG8_SA(1, 0), a3, voffA);
            PG8_WAIT_V(8); PG8_WAIT_L(0); PG8_BAR; PG8_MMA(1, 0, At, B0); PG8_MMA(1, 1, At, B1); PG8_BAR; PG8_SCHED;
            } else {
            PG8_LDB(B0, 0, 0); PG8_SCHED; PG8_LDA(At, 0, 0); PG8_STAGE(PG8_SA(1, 1), a1 + hstep, voffA);
            PG8_WAIT_L(8); PG8_BAR; PG8_WAIT_L(0); PG8_MMA(0, 0, At, B0); PG8_BAR; PG8_SCHED;
            PG8_LDB(B1, 0, 1); PG8_STAGE(PG8_SB(0, 0), b2, voffB);
            PG8_BAR; PG8_WAIT_L(0); PG8_MMA(0, 1, At, B1); PG8_BAR;
            PG8_LDA(At, 0, 1); PG8_STAGE(PG8_SA(0, 0), a2, voffA);
            PG8_BAR; PG8_WAIT_L(0); PG8_MMA(1, 0, At, B0); PG8_BAR; PG8_SCHED;
            PG8_STAGE(PG8_SB(0, 1), b2 + hstep, voffB);
            PG8_WAIT_V(6); PG8_BAR; PG8_MMA(1, 1, At, B1); PG8_BAR;
            PG8_LDB(B0, 1, 0); PG8_SCHED; PG8_LDA(At, 1, 0); PG8_STAGE(PG8_SA(0, 1), a2 + hstep, voffA);
            PG8_WAIT_L(8); PG8_BAR; PG8_WAIT_L(0); PG8_MMA(0, 0, At, B0); PG8_BAR; PG8_SCHED;
            PG8_LDB(B1, 1, 1); PG8_STAGE(PG8_SB(1, 0), b3, voffB);
            PG8_BAR; PG8_WAIT_L(0); PG8_MMA(0, 1, At, B1); PG8_BAR;
            PG8_LDA(At, 1, 1); PG8_STAGE(PG8_SA(1, 0), a3, voffA);
            PG8_BAR; PG8_WAIT_L(0); PG8_MMA(1, 0, At, B0); PG8_BAR; PG8_SCHED;
            PG8_STAGE(PG8_SB(1, 1), b3 + hstep, voffB);
            PG8_WAIT_V(6); PG8_BAR; PG8_MMA(1, 1, At, B1); PG8_BAR;
            }
        }
        if constexpr (ALIGN_EPI) { if (wr == 0) PG8_BAR; }
        if constexpr (!Epi::AFTER_DRAIN) { E(acc, cur, wr, wc, fr, fq); S.done(cur); }
        if (!has_next) break;
#pragma unroll
        for (int a = 0; a < 2; ++a)
#pragma unroll
            for (int b = 0; b < 2; ++b)
#pragma unroll
                for (int m = 0; m < 4; ++m)
#pragma unroll
                    for (int n = 0; n < 2; ++n) acc[a][b][m][n] = (f32x4){0.f, 0.f, 0.f, 0.f};
        cur = nxt; cA = nA; cB = nB; ++ui;
        if constexpr (ALIGN_EPI) { if (wr == 1) PG8_BAR; }
    }
    PG8_WAIT_V(0);
    if constexpr (!ALIGN_EPI) { if (wr == 0) PG8_BAR; }
    PG8_BAR;
    if constexpr (Epi::AFTER_DRAIN) { E.fused(acc, cur, wr, wc, fr, fq, lds, wid, lane); S.done(cur); }
#undef PG8_SA
#undef PG8_SB
#undef PG8_STAGE
#undef PG8_LDA
#undef PG8_LDB
#undef PG8_MMA
#undef PG8_WAIT_V
#undef PG8_WAIT_L
#undef PG8_BAR
#undef PG8_SCHED
}
}
namespace att {
#define ATT_LAS __attribute__((address_space(3)))
typedef unsigned short bf16;
typedef short bf16x8 __attribute__((ext_vector_type(8)));
typedef short s16x4 __attribute__((ext_vector_type(4)));
typedef float f32x16 __attribute__((ext_vector_type(16)));
typedef unsigned u32x4 __attribute__((ext_vector_type(4)));
typedef unsigned u32x2 __attribute__((ext_vector_type(2)));
typedef float f32x2_t __attribute__((ext_vector_type(2))); typedef __bf16 bf16x2_t __attribute__((ext_vector_type(2)));
__device__ __forceinline__ unsigned cvtpk(float lo, float hi) { f32x2_t v = {lo, hi}; bf16x2_t b = __builtin_convertvector(v, bf16x2_t); return __builtin_bit_cast(unsigned, b); }
__device__ __forceinline__ s16x4 vtr(const ATT_LAS unsigned char* p) { return __builtin_bit_cast(s16x4, __builtin_amdgcn_ds_read_tr16_b64_v4i16((ATT_LAS s16x4*)p)); }
constexpr int VSTR = 192;
template <int DQK> struct Geo { static constexpr int KSTR = DQK * 2 + 16, KBUF = 64 * KSTR, VBUF = 64 * VSTR, CPR = DQK / 8, NKC = 64 * CPR, KIT = (NKC + 511) / 512; };
template <int DQK> constexpr int lds_bytes() { return 2 * Geo<DQK>::KBUF + 2 * Geo<DQK>::VBUF + 2048; }

__device__ __forceinline__ float rowmax32(const f32x16& p0, const f32x16& p1) {
    float a = fmaxf(p0[0], p1[0]), b = fmaxf(p0[1], p1[1]);
#pragma unroll
    for (int r = 2; r < 16; r += 2) { a = fmaxf(a, fmaxf(p0[r], p1[r])); b = fmaxf(b, fmaxf(p0[r + 1], p1[r + 1])); }
    const float m = fmaxf(a, b);
    return fmaxf(m, __shfl_xor(m, 32));
}

template <int DQK, bool BAND>
__device__ __forceinline__ void attn_unit(ATT_LAS unsigned char* lds, const bf16* Qb, int qpitch, const bf16* Kb, int kpitch, const bf16* Vb, int vpitch, bf16* Ob, int opitch,
                                          int q0, int t_lo, int t_hi, int my_lo, int my_hi, int cc, const float* bias_g) {
    typedef Geo<DQK> G;
    int tid_ = threadIdx.x; asm volatile("" : "+v"(tid_));
    const int tid = tid_, lane = tid & 63, r32 = lane & 31, hi = lane >> 5, wid = __builtin_amdgcn_readfirstlane(tid >> 6);
    ATT_LAS float* biasL = (ATT_LAS float*)(lds + 2 * G::KBUF + 2 * G::VBUF);
    bf16x8 qf[DQK / 16];
    { const bf16* qp = Qb + (size_t)(q0 + wid * 32 + r32) * qpitch + 8 * hi;
#pragma unroll
      for (int kk = 0; kk < DQK / 16; ++kk) qf[kk] = *(const bf16x8*)(qp + 16 * kk); }
    if (BAND) { if (tid < 257) biasL[tid] = bias_g[tid] * 1.4426950408889634f; }
    u32x4 kreg[G::KIT], vreg;
    const int vrow = tid >> 3, vch = tid & 7;
#define ATT_GLOAD(t) do { const size_t kr0 = (size_t)(t) * 64; \
        _Pragma("unroll") for (int i = 0; i < G::KIT; ++i) { const int c = tid + 512 * i; if (c < G::NKC) { const int row = c / G::CPR, ch = c % G::CPR; \
            kreg[i] = *(const u32x4*)(Kb + (kr0 + row) * kpitch + ch * 8); } } \
        vreg = *(const u32x4*)(Vb + (kr0 + vrow) * vpitch + vch * 8); } while (0)
#define ATT_LSTORE(b) do { \
        _Pragma("unroll") for (int i = 0; i < G::KIT; ++i) { const int c = tid + 512 * i; if (c < G::NKC) { const int row = c / G::CPR, ch = c % G::CPR; \
            *(ATT_LAS u32x4*)(lds + (b) * G::KBUF + row * G::KSTR + ch * 16) = kreg[i]; } } \
        *(ATT_LAS u32x4*)(lds + 2 * G::KBUF + (b) * G::VBUF + vrow * VSTR + vch * 16) = vreg; } while (0)
    f32x16 o0, o1;
#pragma unroll
    for (int i = 0; i < 16; ++i) { o0[i] = 0.f; o1[i] = 0.f; }
    float mrun = -INFINITY, lsum = 0.f;
    ATT_GLOAD(t_lo);
    ATT_LSTORE(0);
    __syncthreads();
    const int koff = r32 * G::KSTR + hi * 16;
    const int voff = ((lane >> 5) * 4 + ((lane & 15) >> 2)) * VSTR + (((lane >> 4) & 1) * 16 + (lane & 3) * 4) * 2;
    for (int t = t_lo; t <= t_hi; ++t) {
        const int buf = (t - t_lo) & 1;
        if (t < t_hi) ATT_GLOAD(t + 1);
        if (t >= my_lo && t <= my_hi) {
            const ATT_LAS unsigned char* Kt = lds + buf * G::KBUF + koff;
            const ATT_LAS unsigned char* Vt = lds + 2 * G::KBUF + buf * G::VBUF + voff;
            f32x16 s0, s1;
#pragma unroll
            for (int i = 0; i < 16; ++i) { s0[i] = 0.f; s1[i] = 0.f; }
#pragma unroll
            for (int kk = 0; kk < DQK / 16; ++kk) {
                const bf16x8 a0 = *(const ATT_LAS bf16x8*)(Kt + kk * 32);
                const bf16x8 a1 = *(const ATT_LAS bf16x8*)(Kt + 32 * G::KSTR + kk * 32);
                s0 = __builtin_amdgcn_mfma_f32_32x32x16_bf16(a0, qf[kk], s0, 0, 0, 0);
                s1 = __builtin_amdgcn_mfma_f32_32x32x16_bf16(a1, qf[kk], s1, 0, 0, 0);
            }
            if (BAND) {
                const int delta = cc - t;
                if (delta >= 3) { const float bf = biasL[256];
#pragma unroll
                    for (int i = 0; i < 16; ++i) { s0[i] += bf; s1[i] += bf; } }
                else { const int relb = 64 * delta + (32 * (wid & 1) + r32) - 4 * hi + 128;
#pragma unroll
                    for (int i = 0; i < 16; ++i) { const int kj = (i & 3) + 8 * (i >> 2);
                        int i0 = relb - kj, i1 = relb - kj - 32; i0 = i0 < 0 ? 0 : (i0 > 256 ? 256 : i0); i1 = i1 < 0 ? 0 : (i1 > 256 ? 256 : i1);
                        s0[i] += biasL[i0]; s1[i] += biasL[i1]; } }
            }
            const float mt = rowmax32(s0, s1);
            const float mnew = fmaxf(mrun, mt);
            const float alpha = __builtin_amdgcn_exp2f(mrun - mnew);
            mrun = mnew;
            float ps = 0.f;
#pragma unroll
            for (int i = 0; i < 16; ++i) { s0[i] = __builtin_amdgcn_exp2f(s0[i] - mnew); s1[i] = __builtin_amdgcn_exp2f(s1[i] - mnew); ps += s0[i] + s1[i]; }
            lsum = lsum * alpha + ps;
#pragma unroll
            for (int i = 0; i < 16; ++i) { o0[i] *= alpha; o1[i] *= alpha; }
            bf16x8 pf[2][2];
#pragma unroll
            for (int s = 0; s < 2; ++s) {
                u32x4 w0, w1;
                w0.x = cvtpk(s0[8 * s + 0], s0[8 * s + 1]); w0.y = cvtpk(s0[8 * s + 2], s0[8 * s + 3]); w0.z = cvtpk(s0[8 * s + 4], s0[8 * s + 5]); w0.w = cvtpk(s0[8 * s + 6], s0[8 * s + 7]);
                w1.x = cvtpk(s1[8 * s + 0], s1[8 * s + 1]); w1.y = cvtpk(s1[8 * s + 2], s1[8 * s + 3]); w1.z = cvtpk(s1[8 * s + 4], s1[8 * s + 5]); w1.w = cvtpk(s1[8 * s + 6], s1[8 * s + 7]);
                pf[0][s] = __builtin_bit_cast(bf16x8, w0); pf[1][s] = __builtin_bit_cast(bf16x8, w1);
            }
#pragma unroll
            for (int kb = 0; kb < 2; ++kb)
#pragma unroll
                for (int s = 0; s < 2; ++s) {
                    const ATT_LAS unsigned char* vp = Vt + (32 * kb + 16 * s) * VSTR;
                    const s16x4 l0 = vtr(vp), h0 = vtr(vp + 8 * VSTR), l1 = vtr(vp + 64), h1 = vtr(vp + 8 * VSTR + 64);
                    const bf16x8 a0 = (bf16x8){l0[0], l0[1], l0[2], l0[3], h0[0], h0[1], h0[2], h0[3]};
                    const bf16x8 a1 = (bf16x8){l1[0], l1[1], l1[2], l1[3], h1[0], h1[1], h1[2], h1[3]};
                    o0 = __builtin_amdgcn_mfma_f32_32x32x16_bf16(a0, pf[kb][s], o0, 0, 0, 0);
                    o1 = __builtin_amdgcn_mfma_f32_32x32x16_bf16(a1, pf[kb][s], o1, 0, 0, 0);
                }
        }
        if (t < t_hi) ATT_LSTORE(buf ^ 1);
        __syncthreads();
    }
    const float ltot = lsum + __shfl_xor(lsum, 32);
    const float inv = 1.f / ltot;
    bf16* op = Ob + (size_t)(q0 + wid * 32 + r32) * opitch + 4 * hi;
#pragma unroll
    for (int g4 = 0; g4 < 4; ++g4) {
        u32x2 w0, w1;
        w0.x = cvtpk(o0[4 * g4 + 0] * inv, o0[4 * g4 + 1] * inv); w0.y = cvtpk(o0[4 * g4 + 2] * inv, o0[4 * g4 + 3] * inv);
        w1.x = cvtpk(o1[4 * g4 + 0] * inv, o1[4 * g4 + 1] * inv); w1.y = cvtpk(o1[4 * g4 + 2] * inv, o1[4 * g4 + 3] * inv);
        *(u32x2*)(op + 8 * g4) = w0; *(u32x2*)(op + 32 + 8 * g4) = w1;
    }
#undef ATT_GLOAD
#undef ATT_LSTORE
}
}
constexpr int NWAVES = 8;
constexpr int D = 1024, BATCH = 32, SEQ = 2048, M = BATCH * SEQ;
constexpr int NH = 16, QLORA = 384, KVLORA = 256, ROPE_D = 32, NOPE = 64, QKD = 96;
constexpr int NA = 768;
constexpr int FF = 2816, EFF = 3584, NE = 8;
constexpr float EPS = 1e-6f, LOG2E = 1.4426950408889634f;
constexpr int MAXP_HALF = 264, MAXP = 528;
constexpr size_t MiB = 1u << 20;
constexpr size_t WS_CTL = 0, CTL_ZERO_BYTES = 1 * MiB;
constexpr size_t WS_ROPE = 1 * MiB;
constexpr size_t WS_CNT = WS_ROPE + 256 * 1024;
constexpr size_t WS_PANELE = WS_CNT + 16 * 1024;
constexpr size_t WS_META = WS_PANELE + 4096;
constexpr size_t WS_TOKE = 2 * MiB;
constexpr size_t WS_TOKG = WS_TOKE + (size_t)M * 4;
constexpr size_t WS_SLOTTOK = WS_TOKG + (size_t)M * 8;
constexpr size_t WS_SLOTGATE = WS_SLOTTOK + (size_t)MAXP * 256 * 4;
constexpr size_t WS_KPE = 4 * MiB;
static_assert(WS_SLOTGATE + (size_t)MAXP * 256 * 4 <= WS_KPE, "tok arrays");
constexpr size_t WS_W = 8 * MiB;
constexpr size_t WS_WA = WS_W, WS_WUQ = WS_WA + (size_t)NA * D * 2, WS_WUKV = WS_WUQ + (size_t)1536 * QLORA * 2, WS_WO = WS_WUKV + (size_t)2048 * KVLORA * 2;
constexpr size_t WS_WF1 = WS_WO + (size_t)D * D * 2, WS_WF2 = WS_WF1 + (size_t)2 * FF * D * 2, WS_WKVQ = WS_WF2 + (size_t)D * FF * 2, WS_WBO = WS_WKVQ + (size_t)3 * D * D * 2;
constexpr size_t WS_WM1 = WS_WBO + (size_t)D * D * 2, WS_WM2 = WS_WM1 + (size_t)NE * 2 * EFF * D * 2, WS_WEND = WS_WM2 + (size_t)NE * D * EFF * 2;
constexpr size_t ARENA = 208 * MiB;
static_assert(WS_WEND <= ARENA, "weights fit under the arena");
constexpr size_t WS_XN = ARENA;
constexpr size_t WS_QA = ARENA + 128 * MiB;
constexpr size_t WS_CQ = ARENA + 224 * MiB;
constexpr size_t WS_CKV = ARENA + 272 * MiB;
constexpr size_t WS_Q = ARENA + 320 * MiB;
constexpr size_t WS_KV = ARENA + 512 * MiB;
constexpr size_t WS_K = ARENA;
constexpr size_t WS_O = ARENA + 192 * MiB;
static_assert(WS_K + (size_t)M * 1536 * 2 <= WS_O && WS_O + (size_t)M * D * 2 <= WS_Q && WS_KV + (size_t)M * 2048 * 2 <= 1024 * MiB, "MLA arena");
constexpr size_t WS_H = ARENA + 128 * MiB;
constexpr size_t WS_KVQ2 = ARENA + 128 * MiB;
constexpr size_t WS_O2 = ARENA + 512 * MiB;
constexpr size_t WS_XG = ARENA;
constexpr size_t WS_HM = ARENA + 264 * MiB;
constexpr size_t WS_XN5 = WS_HM;
constexpr size_t WS_END = WS_HM + (size_t)MAXP_HALF * 256 * EFF * 2;
static_assert(WS_XG + (size_t)MAXP * 256 * D * 2 <= WS_HM && WS_END <= 1024 * MiB, "MoE arena");
constexpr int CW_BAR = 4096;
constexpr int RING_OFF = 0, RING_BYTES = 131072;
constexpr int LDSCTL_OFF = RING_BYTES, MISC_OFF = LDSCTL_OFF + 320;
constexpr int LDS_BYTES = 147456;
static_assert(MISC_OFF + 128 <= LDS_BYTES, "LDS map");
static_assert(att::lds_bytes<96>() <= RING_BYTES, "attention scratch fits the ring region");

#define GAS __attribute__((address_space(1)))
#define LAS __attribute__((address_space(3)))
typedef unsigned short bf16;
typedef unsigned v4u __attribute__((ext_vector_type(4)));
typedef unsigned v2u __attribute__((ext_vector_type(2)));
typedef float f32x4 __attribute__((ext_vector_type(4)));
typedef GAS unsigned gu32;
#define RLX_AGENT __ATOMIC_RELAXED, __HIP_MEMORY_SCOPE_AGENT
#define LDS_WAIT() asm volatile("s_waitcnt lgkmcnt(0)" ::: "memory")
__device__ __forceinline__ unsigned f2bf(float f) { unsigned u = __builtin_bit_cast(unsigned, f); return (u + 0x7fffu + ((u >> 16) & 1u)) >> 16; }
__device__ __forceinline__ unsigned pk2(float lo, float hi) { return f2bf(lo) | (f2bf(hi) << 16); }
__device__ __forceinline__ float bflo(unsigned u) { return __builtin_bit_cast(float, u << 16); }
__device__ __forceinline__ float bfhi(unsigned u) { return __builtin_bit_cast(float, u & 0xffff0000u); }
__device__ __forceinline__ float wave_sum(float v) {
#pragma unroll
    for (int o = 1; o < 64; o <<= 1) v += __shfl_xor(v, o);
    return v;
}

#define XB_TMO      128
#define XB_XCNT(j)  (256  + 64 * (j))
#define XB_XSUB(j)  (1280 + 64 * (j))
#define XB_XGEN(j)  (2304 + 64 * (j))
#define XB_TOP      3328
#define XB_TOPGEN   3392
#define XCD_BAR_WORDS 3456
#define XB_SPIN_CAP (1u << 18)

__device__ __forceinline__ unsigned xb_ld(unsigned* p)              { return __hip_atomic_load(p, __ATOMIC_RELAXED, __HIP_MEMORY_SCOPE_AGENT); }
__device__ __forceinline__ unsigned xb_add(unsigned* p, unsigned v) { return __hip_atomic_fetch_add(p, v, __ATOMIC_RELAXED, __HIP_MEMORY_SCOPE_AGENT); }
__device__ __forceinline__ unsigned xb_xcc_id() { return (unsigned)__builtin_amdgcn_s_getreg((3 << 11) | 20) & 0xFu; }
#define XB_SPIN(cond, bar) do { unsigned _sp = 0; while (cond) { __builtin_amdgcn_s_sleep(1); \
    if ((++_sp & 255u) == 0u) { if (xb_ld(&(bar)[XB_TMO])) break; if (_sp > XB_SPIN_CAP) { atomicAdd(&(bar)[XB_TMO], 1u); break; } } } } while (0)

struct XcdBarrier {
    unsigned* bar; unsigned x;
    volatile LAS unsigned* st;
};

__device__ __forceinline__ XcdBarrier xcd_barrier_post(unsigned* bar, volatile LAS unsigned* st) {
    XcdBarrier b; b.bar = bar; b.x = xb_xcc_id(); b.st = st;
    if (threadIdx.x == 0) (void)xb_add(&bar[XB_XCNT(b.x)], 1u);
    return b;
}
__device__ __forceinline__ void xcd_barrier_complete(unsigned* bar, unsigned x, unsigned& nloc, unsigned& nx) {
    const unsigned G = gridDim.x * gridDim.y * gridDim.z;
    unsigned sum, cnt, mine, sp = 0u;
    for (;;) {
        sum = 0u; cnt = 0u; mine = 0u;
#pragma unroll
        for (unsigned j = 0; j < 16; ++j) { const unsigned c = xb_ld(&bar[XB_XCNT(j)]); sum += c; cnt += (c > 0u) ? 1u : 0u; mine = (j == x) ? c : mine; }
        if (sum == G) break;
        __builtin_amdgcn_s_sleep(1);
        if ((++sp & 255u) == 0u) { if (xb_ld(&bar[XB_TMO])) break; if (sp > XB_SPIN_CAP) { atomicAdd(&bar[XB_TMO], 1u); break; } }
    }
    nloc = mine > 0u ? mine : 1u; nx = cnt > 0u ? cnt : 1u;
}

__device__ __forceinline__ void xcd_barrier(const XcdBarrier& b) {
    asm volatile("s_waitcnt vmcnt(0)" ::: "memory");
    __syncthreads();
    if (threadIdx.x == 0) {
        unsigned* bar = b.bar;
        __builtin_amdgcn_s_waitcnt(0);
        unsigned nloc = b.st[0], nx = b.st[1];
        if (nloc == 0u) { xcd_barrier_complete(bar, b.x, nloc, nx); b.st[0] = nloc; b.st[1] = nx; }
        const unsigned old = xb_add(&bar[XB_XSUB(b.x)], 1u);
        const unsigned gen = old / nloc;
        if (old + 1u == (gen + 1u) * nloc) {
            __builtin_amdgcn_fence(__ATOMIC_RELEASE, "agent");
            asm volatile("s_waitcnt vmcnt(0)" ::: "memory");
            const unsigned og = xb_add(&bar[XB_TOP], 1u);
            const unsigned tg = og / nx;
            if (og + 1u == (tg + 1u) * nx) xb_add(&bar[XB_TOPGEN], 1u);
            else XB_SPIN(xb_ld(&bar[XB_TOPGEN]) == tg, bar);
            __builtin_amdgcn_fence(__ATOMIC_ACQUIRE, "agent");
            xb_add(&bar[XB_XGEN(b.x)], 1u);
            asm volatile("s_waitcnt vmcnt(0)" ::: "memory");
        } else {
            XB_SPIN(xb_ld(&bar[XB_XGEN(b.x)]) == gen, bar);
            __builtin_amdgcn_fence(__ATOMIC_ACQUIRE, "agent");
            asm volatile("s_waitcnt vmcnt(0)" ::: "memory");
        }
    }
    __syncthreads();
}

struct Args { const float* in[27]; float* out; unsigned char* ws; };
enum { I_X = 0, I_ATTN_NORM, I_FFN_NORM, I_A_WDQ, I_A_GCQ, I_A_WUQ, I_A_WDKV, I_A_GCKV, I_A_WUKV, I_A_GQN, I_A_GKN, I_A_WO, I_KV_NORM, I_KV_WK, I_KV_WV, I_KV_GKN,
       I_B_WQ, I_B_GQN, I_B_RELB, I_B_WO, I_FFN_W1, I_FFN_W3, I_FFN_W2, I_MOE_ROUTER, I_MOE_W1, I_MOE_W3, I_MOE_W2 };

struct Frame {
    LAS unsigned char* lds;
    int tid, lane, wave, vcu, G;
};
typedef const __attribute__((address_space(4))) Args* KArgs;
__device__ __forceinline__ KArgs kargs() { KArgs p = (KArgs)__builtin_amdgcn_kernarg_segment_ptr(); asm volatile("" : "+s"(p)); return p; }
#define INP(i) (kargs()->in[i])
#define OUTP (kargs()->out)
#define WSP (kargs()->ws)
__device__ __forceinline__ int fresh(int v) { asm volatile("" : "+v"(v)); return v; }

__device__ __forceinline__ void tr_item(const float* W, int ldw, int K, int k0, int nsrc0, const float* gain, bf16* WT, int drow0, LAS float* scr, int lane) {
#pragma unroll 8
    for (int i = 0; i < 32; ++i) { const int kk = 2 * i + (lane >> 5); float v = W[(size_t)(k0 + kk) * ldw + nsrc0 + (lane & 31)]; if (gain) v *= gain[k0 + kk]; scr[kk * 33 + (lane & 31)] = v; }
    LDS_WAIT(); asm volatile("" ::: "memory");
    const int c = lane & 7;
#pragma unroll
    for (int j = 0; j < 4; ++j) { const int n = (lane >> 3) + 8 * j; const LAS float* s = scr + (8 * c) * 33 + n;
        v4u o; o.x = pk2(s[0 * 33], s[1 * 33]); o.y = pk2(s[2 * 33], s[3 * 33]); o.z = pk2(s[4 * 33], s[5 * 33]); o.w = pk2(s[6 * 33], s[7 * 33]);
        *(GAS v4u*)(WT + (size_t)(drow0 + n) * K + k0 + 8 * c) = o; }
    LDS_WAIT(); asm volatile("" ::: "memory");
}
__device__ __forceinline__ void tr_plain(const float* W, int K, int N, const float* gain, bf16* WT, int drow_off, LAS float* scr, int item, int lane) {
    const int nblk = N / 32, kb = item / nblk, nb = item % nblk;
    tr_item(W, N, K, 64 * kb, 32 * nb, gain, WT, drow_off + 32 * nb, scr, lane);
}
__device__ __forceinline__ void tr_gated(const float* W, int K, int N, const float* gain, bf16* WT, int half, LAS float* scr, int item, int lane) {
    const int nblk = N / 32, kb = item / nblk, nb = item % nblk, n0 = 32 * nb;
    tr_item(W, N, K, 64 * kb, n0, gain, WT, (n0 >> 7) * 256 + half * 128 + (n0 & 127), scr, lane);
}
__device__ __forceinline__ float rms_row_to_bf16(const float* xrow, bf16* orow, int lane, f32x4 (&v)[4]) {
    const GAS f32x4* xr = (const GAS f32x4*)xrow + lane;
    float s = 0.f;
#pragma unroll
    for (int j = 0; j < 4; ++j) { v[j] = xr[64 * j]; s += (v[j].x * v[j].x + v[j].y * v[j].y) + (v[j].z * v[j].z + v[j].w * v[j].w); }
    const float rstd = 1.f / sqrtf(wave_sum(s) * (1.f / D) + EPS);
    GAS unsigned long long* o8 = (GAS unsigned long long*)orow + lane;
#pragma unroll
    for (int j = 0; j < 4; ++j) o8[64 * j] = (unsigned long long)pk2(v[j].x * rstd, v[j].y * rstd) | ((unsigned long long)pk2(v[j].z * rstd, v[j].w * rstd) << 32);
    return rstd;
}
__device__ __forceinline__ void norm_phase(const Frame& F, const float* x, bf16* xn) {
    const int gw = F.vcu * NWAVES + F.wave, NGW = F.G * NWAVES;
    for (int m = gw; m < M; m += NGW) { f32x4 v[4]; (void)rms_row_to_bf16(x + (size_t)m * D, xn + (size_t)m * D, F.lane, v); }
}

__device__ __forceinline__ void p0_prologue(const Frame& F) {
    LAS float* scr = (LAS float*)(F.lds + RING_OFF + F.wave * 16384);
    unsigned char* ws = WSP;
    const int gw = F.vcu * NWAVES + F.wave, NGW = F.G * NWAVES;
    constexpr int I_DQ = 16 * 12, I_DKV = 16 * 9, I_UQ = 6 * 48, I_UKV = 4 * 64, I_SQ = 16 * 32, I_F13 = 16 * 88, I_F2 = 44 * 32, I_M13 = 16 * 112, I_M2 = 56 * 32;
    constexpr int NSMALL = I_DQ + I_DKV + I_UQ + I_UKV + I_SQ + 2 * I_F13 + I_F2 + 4 * I_SQ;
    constexpr int NITEMS = NSMALL + NE * (2 * I_M13 + I_M2);
    for (int it = gw; it < NITEMS; it += NGW) {
        int r = it;
        if (r < I_DQ)  { tr_plain(INP(I_A_WDQ), D, QLORA, INP(I_ATTN_NORM), (bf16*)(ws + WS_WA), 0, scr, r, F.lane); continue; } r -= I_DQ;
        if (r < I_DKV) { tr_plain(INP(I_A_WDKV), D, KVLORA + ROPE_D, INP(I_ATTN_NORM), (bf16*)(ws + WS_WA), QLORA, scr, r, F.lane); continue; } r -= I_DKV;
        if (r < I_UQ)  { tr_plain(INP(I_A_WUQ), QLORA, NH * QKD, INP(I_A_GCQ), (bf16*)(ws + WS_WUQ), 0, scr, r, F.lane); continue; } r -= I_UQ;
        if (r < I_UKV) { tr_plain(INP(I_A_WUKV), KVLORA, NH * 128, INP(I_A_GCKV), (bf16*)(ws + WS_WUKV), 0, scr, r, F.lane); continue; } r -= I_UKV;
        if (r < I_SQ)  { tr_plain(INP(I_A_WO), D, D, nullptr, (bf16*)(ws + WS_WO), 0, scr, r, F.lane); continue; } r -= I_SQ;
        if (r < I_F13) { tr_gated(INP(I_FFN_W1), D, FF, INP(I_FFN_NORM), (bf16*)(ws + WS_WF1), 0, scr, r, F.lane); continue; } r -= I_F13;
        if (r < I_F13) { tr_gated(INP(I_FFN_W3), D, FF, INP(I_FFN_NORM), (bf16*)(ws + WS_WF1), 1, scr, r, F.lane); continue; } r -= I_F13;
        if (r < I_F2)  { tr_plain(INP(I_FFN_W2), FF, D, nullptr, (bf16*)(ws + WS_WF2), 0, scr, r, F.lane); continue; } r -= I_F2;
        if (r < I_SQ)  { tr_plain(INP(I_KV_WK), D, D, INP(I_KV_NORM), (bf16*)(ws + WS_WKVQ), 0, scr, r, F.lane); continue; } r -= I_SQ;
        if (r < I_SQ)  { tr_plain(INP(I_KV_WV), D, D, INP(I_KV_NORM), (bf16*)(ws + WS_WKVQ), D, scr, r, F.lane); continue; } r -= I_SQ;
        if (r < I_SQ)  { tr_plain(INP(I_B_WQ), D, D, INP(I_ATTN_NORM) + D, (bf16*)(ws + WS_WKVQ), 2 * D, scr, r, F.lane); continue; } r -= I_SQ;
        if (r < I_SQ)  { tr_plain(INP(I_B_WO), D, D, nullptr, (bf16*)(ws + WS_WBO), 0, scr, r, F.lane); continue; } r -= I_SQ;
        const int e = r / (2 * I_M13 + I_M2); r -= e * (2 * I_M13 + I_M2);
        if (r < I_M13) { tr_gated(INP(I_MOE_W1) + (size_t)e * D * EFF, D, EFF, INP(I_FFN_NORM) + D, (bf16*)(ws + WS_WM1) + (size_t)e * 2 * EFF * D, 0, scr, r, F.lane); continue; } r -= I_M13;
        if (r < I_M13) { tr_gated(INP(I_MOE_W3) + (size_t)e * D * EFF, D, EFF, INP(I_FFN_NORM) + D, (bf16*)(ws + WS_WM1) + (size_t)e * 2 * EFF * D, 1, scr, r, F.lane); continue; } r -= I_M13;
        tr_plain(INP(I_MOE_W2) + (size_t)e * EFF * D, EFF, D, nullptr, (bf16*)(ws + WS_WM2) + (size_t)e * D * EFF, 0, scr, r, F.lane);
    }
    const int gt = F.vcu * (NWAVES * 64) + F.tid, NGT = F.G * NWAVES * 64;
    for (int c = gt; c < 96 * D * 2 / 16; c += NGT) *((GAS v4u*)(ws + WS_WA + (size_t)(QLORA + KVLORA + ROPE_D) * D * 2) + c) = (v4u){0u, 0u, 0u, 0u};
    for (int c = gt; c < SEQ * 16; c += NGT) { const int pos = c >> 4, i = c & 15;
        const float inv = __builtin_amdgcn_exp2f(-(float)i * (13.287712379549449f / 16.f));
        const float rev = (float)pos * inv * 0.15915494309189535f; const float fr = rev - floorf(rev);
        ((GAS float*)(ws + WS_ROPE))[2 * c] = __builtin_amdgcn_cosf(fr); ((GAS float*)(ws + WS_ROPE))[2 * c + 1] = __builtin_amdgcn_sinf(fr); }
    norm_phase(F, INP(I_X), (bf16*)(ws + WS_XN));
}

__device__ __forceinline__ void latent_norm_phase(const Frame& F, unsigned char* ws) {
    const int gw = F.vcu * NWAVES + F.wave, NGW = F.G * NWAVES, l = F.lane;
    for (int m = gw; m < M; m += NGW) {
        const GAS v2u* src = (const GAS v2u*)(ws + WS_QA + (size_t)m * NA * 2);
        const v2u g0 = src[l], g1 = src[l + 64], g2 = src[l + 128];
        const float a0 = bflo(g0.x), a1 = bfhi(g0.x), a2 = bflo(g0.y), a3 = bfhi(g0.y);
        const float b0 = bflo(g1.x), b1 = bfhi(g1.x), b2 = bflo(g1.y), b3 = bfhi(g1.y);
        const float c0 = bflo(g2.x), c1 = bfhi(g2.x), c2 = bflo(g2.y), c3 = bfhi(g2.y);
        const float sa = (a0 * a0 + a1 * a1) + (a2 * a2 + a3 * a3), sb = (b0 * b0 + b1 * b1) + (b2 * b2 + b3 * b3), sc = (c0 * c0 + c1 * c1) + (c2 * c2 + c3 * c3);
        const bool bq = (l < 32);
        const float ssq_q = wave_sum(sa + (bq ? sb : 0.f));
        const float ssq_kv = wave_sum((bq ? 0.f : sb) + (l < 32 ? sc : 0.f));
        const float rq = 1.f / sqrtf(ssq_q * (1.f / QLORA) + EPS), rkv = 1.f / sqrtf(ssq_kv * (1.f / KVLORA) + EPS);
        GAS v2u* cq = (GAS v2u*)(ws + WS_CQ + (size_t)m * QLORA * 2); GAS v2u* ckv = (GAS v2u*)(ws + WS_CKV + (size_t)m * KVLORA * 2);
        cq[l] = (v2u){pk2(a0 * rq, a1 * rq), pk2(a2 * rq, a3 * rq)};
        if (bq) cq[64 + l] = (v2u){pk2(b0 * rq, b1 * rq), pk2(b2 * rq, b3 * rq)};
        else ckv[l - 32] = (v2u){pk2(b0 * rkv, b1 * rkv), pk2(b2 * rkv, b3 * rkv)};
        if (l < 32) ckv[32 + l] = (v2u){pk2(c0 * rkv, c1 * rkv), pk2(c2 * rkv, c3 * rkv)};
        else if (l < 40) ((GAS v2u*)(ws + WS_KPE + (size_t)m * ROPE_D * 2))[l - 32] = g2;
    }
}

__device__ __forceinline__ void qk_post_phase(const Frame& F, unsigned char* ws, const float* g_qn, const float* g_kn) {
    const int gw = F.vcu * NWAVES + F.wave, NGW = F.G * NWAVES, l = F.lane, h = l >> 2, s = l & 3;
    float gq[24], gk[24];
#pragma unroll
    for (int i = 0; i < 16; ++i) { gq[i] = g_qn[16 * s + i]; gk[i] = g_kn[16 * s + i]; }
#pragma unroll
    for (int i = 0; i < 4; ++i) { gq[16 + i] = g_qn[64 + 4 * s + i]; gq[20 + i] = g_qn[80 + 4 * s + i]; gk[16 + i] = g_kn[64 + 4 * s + i]; gk[20 + i] = g_kn[80 + 4 * s + i]; }
    const float qscale = 0.10206207261596577f * LOG2E;
    for (int m = gw; m < M; m += NGW) {
        const int pos = m & (SEQ - 1);
        const GAS f32x4* rp = (const GAS f32x4*)(ws + WS_ROPE + ((size_t)pos * 16 + 4 * s) * 8);
        const f32x4 cs0 = rp[0], cs1 = rp[1];
        const float cs[8] = {cs0.x, cs0.y, cs0.z, cs0.w, cs1.x, cs1.y, cs1.z, cs1.w};
#pragma unroll
        for (int which = 0; which < 2; ++which) {
            float v[24];
            if (which == 0) {
                const GAS unsigned char* qr = (const GAS unsigned char*)(ws + WS_Q + ((size_t)m * 1536 + h * QKD) * 2);
                const v4u n0 = *(const GAS v4u*)(qr + 32 * s), n1 = *(const GAS v4u*)(qr + 32 * s + 16);
                const v2u r0 = *(const GAS v2u*)(qr + 128 + 8 * s), r1 = *(const GAS v2u*)(qr + 160 + 8 * s);
                const unsigned w[12] = {n0.x, n0.y, n0.z, n0.w, n1.x, n1.y, n1.z, n1.w, r0.x, r0.y, r1.x, r1.y};
#pragma unroll
                for (int i = 0; i < 12; ++i) { v[2 * i] = bflo(w[i]); v[2 * i + 1] = bfhi(w[i]); }
            } else {
                const GAS unsigned char* kr = (const GAS unsigned char*)(ws + WS_KV + ((size_t)m * 2048 + h * 128) * 2);
                const GAS unsigned char* pr = (const GAS unsigned char*)(ws + WS_KPE + (size_t)m * ROPE_D * 2);
                const v4u n0 = *(const GAS v4u*)(kr + 32 * s), n1 = *(const GAS v4u*)(kr + 32 * s + 16);
                const v2u r0 = *(const GAS v2u*)(pr + 8 * s), r1 = *(const GAS v2u*)(pr + 32 + 8 * s);
                const unsigned w[12] = {n0.x, n0.y, n0.z, n0.w, n1.x, n1.y, n1.z, n1.w, r0.x, r0.y, r1.x, r1.y};
#pragma unroll
                for (int i = 0; i < 12; ++i) { v[2 * i] = bflo(w[i]); v[2 * i + 1] = bfhi(w[i]); }
            }
            float ss = 0.f;
#pragma unroll
            for (int i = 0; i < 24; ++i) ss += v[i] * v[i];
            ss += __shfl_xor(ss, 1); ss += __shfl_xor(ss, 2);
            float rstd = 1.f / sqrtf(ss * (1.f / QKD) + EPS);
            if (which == 0) rstd *= qscale;
#pragma unroll
            for (int i = 0; i < 24; ++i) v[i] *= rstd * (which == 0 ? gq[i] : gk[i]);
#pragma unroll
            for (int i = 0; i < 4; ++i) { const float x1 = v[16 + i], x2 = v[20 + i], c = cs[2 * i], sn = cs[2 * i + 1]; v[16 + i] = x1 * c - x2 * sn; v[20 + i] = x2 * c + x1 * sn; }
            GAS unsigned char* dst = (GAS unsigned char*)(ws + (which == 0 ? WS_Q : WS_K) + ((size_t)m * 1536 + h * QKD) * 2);
            *(GAS v4u*)(dst + 32 * s) = (v4u){pk2(v[0], v[1]), pk2(v[2], v[3]), pk2(v[4], v[5]), pk2(v[6], v[7])};
            *(GAS v4u*)(dst + 32 * s + 16) = (v4u){pk2(v[8], v[9]), pk2(v[10], v[11]), pk2(v[12], v[13]), pk2(v[14], v[15])};
            *(GAS v2u*)(dst + 128 + 8 * s) = (v2u){pk2(v[16], v[17]), pk2(v[18], v[19])};
            *(GAS v2u*)(dst + 160 + 8 * s) = (v2u){pk2(v[20], v[21]), pk2(v[22], v[23])};
        }
    }
}

__device__ __forceinline__ void head_norm_phase(const Frame& F, unsigned char* ws, const float* g_k, const float* g_q) {
    const int gw = F.vcu * NWAVES + F.wave, NGW = F.G * NWAVES, l = F.lane, s = l & 3;
    float gk[16], gq[16];
#pragma unroll
    for (int i = 0; i < 16; ++i) { gk[i] = g_k[16 * s + i]; gq[i] = g_q[16 * s + i] * (0.125f * LOG2E); }
    for (int m = gw; m < M; m += NGW) {
#pragma unroll
        for (int which = 0; which < 2; ++which) {
            GAS v4u* p = (GAS v4u*)(ws + WS_KVQ2 + ((size_t)m * 3072 + (which ? 2048 : 0)) * 2) + 2 * l;
            const v4u n0 = p[0], n1 = p[1];
            const unsigned w[8] = {n0.x, n0.y, n0.z, n0.w, n1.x, n1.y, n1.z, n1.w};
            float v[16];
#pragma unroll
            for (int i = 0; i < 8; ++i) { v[2 * i] = bflo(w[i]); v[2 * i + 1] = bfhi(w[i]); }
            float ss = 0.f;
#pragma unroll
            for (int i = 0; i < 16; ++i) ss += v[i] * v[i];
            ss += __shfl_xor(ss, 1); ss += __shfl_xor(ss, 2);
            const float rstd = 1.f / sqrtf(ss * (1.f / 64) + EPS);
#pragma unroll
            for (int i = 0; i < 16; ++i) v[i] *= rstd * (which ? gq[i] : gk[i]);
            p[0] = (v4u){pk2(v[0], v[1]), pk2(v[2], v[3]), pk2(v[4], v[5]), pk2(v[6], v[7])};
            p[1] = (v4u){pk2(v[8], v[9]), pk2(v[10], v[11]), pk2(v[12], v[13]), pk2(v[14], v[15])};
        }
    }
}

__device__ __forceinline__ void route_phase(const Frame& F) {
    unsigned char* ws = WSP;
    LAS float* wrg = (LAS float*)(F.lds + RING_OFF);
    LAS int* cnt = (LAS int*)(F.lds + RING_OFF + 32768);
    const float* wr = INP(I_MOE_ROUTER); const float* g = INP(I_FFN_NORM) + D;
    for (int idx = F.tid; idx < D * NE; idx += NWAVES * 64) wrg[idx] = wr[idx] * g[idx >> 3];
    __syncthreads();
    for (int c = F.vcu; c < M / 256; c += F.G) {
        if (F.tid < 16) cnt[F.tid] = 0;
        __syncthreads();
        for (int i = 0; i < 32; ++i) {
            const int m = c * 256 + F.wave * 32 + i;
            f32x4 v[4];
            const float rstd = rms_row_to_bf16(OUTP + (size_t)m * D, (bf16*)(ws + WS_XN5) + (size_t)m * D, F.lane, v);
            float lg[8];
#pragma unroll
            for (int e = 0; e < 8; ++e) lg[e] = 0.f;
#pragma unroll
            for (int j = 0; j < 4; ++j)
#pragma unroll
                for (int q = 0; q < 4; ++q) { const int k = 256 * j + 4 * F.lane + q; const float xv = v[j][q];
                    const f32x4 w0 = *(const LAS f32x4*)(wrg + k * 8), w1 = *(const LAS f32x4*)(wrg + k * 8 + 4);
                    lg[0] += xv * w0.x; lg[1] += xv * w0.y; lg[2] += xv * w0.z; lg[3] += xv * w0.w; lg[4] += xv * w1.x; lg[5] += xv * w1.y; lg[6] += xv * w1.z; lg[7] += xv * w1.w; }
#pragma unroll
            for (int e = 0; e < 8; ++e) lg[e] = wave_sum(lg[e]) * rstd;
            int e1 = 0; float l1 = lg[0];
#pragma unroll
            for (int e = 1; e < 8; ++e) if (lg[e] > l1) { l1 = lg[e]; e1 = e; }
            int e2 = -1; float l2 = -INFINITY;
#pragma unroll
            for (int e = 0; e < 8; ++e) if (e != e1 && lg[e] > l2) { l2 = lg[e]; e2 = e; }
            const float g1 = 1.f / (1.f + __expf(l2 - l1)), g2 = 1.f - g1;
            const int elo = e1 < e2 ? e1 : e2, ehi = e1 < e2 ? e2 : e1;
            const float glo = e1 < e2 ? g1 : g2, ghi = e1 < e2 ? g2 : g1;
            if (F.lane == 0) { ((GAS int*)(ws + WS_TOKE))[m] = elo | (ehi << 8); ((GAS float*)(ws + WS_TOKG))[2 * m] = glo; ((GAS float*)(ws + WS_TOKG))[2 * m + 1] = ghi;
                atomicAdd((int*)&cnt[elo], 1); atomicAdd((int*)&cnt[8 + ehi], 1); }
        }
        __syncthreads();
        if (F.tid < 16) ((GAS int*)(ws + WS_CNT))[c * 16 + F.tid] = cnt[F.tid];
        __syncthreads();
    }
}

__device__ __forceinline__ void slot_phase(const Frame& F, unsigned char* ws) {
    LAS int* call = (LAS int*)(F.lds + RING_OFF);
    LAS int* tot = call + 4096; LAS int* base = tot + 16; LAS int* pre = base + 16; LAS int* meta = pre + 16;
    LAS int* grp = meta + 16;
    LAS int* slot_of = grp + 512;
    for (int idx = F.tid; idx < 4096; idx += NWAVES * 64) call[idx] = ((const GAS int*)(ws + WS_CNT))[idx];
    __syncthreads();
    if (F.tid < 16) { int t = 0; for (int cc = 0; cc < 256; ++cc) t += call[cc * 16 + F.tid]; tot[F.tid] = t; }
    __syncthreads();
    if (F.tid == 0) { int off = 0; for (int g = 0; g < 16; ++g) { base[g] = off; off += (tot[g] + 255) & ~255; if (g == 7) meta[0] = off >> 8; } meta[1] = (off >> 8) - meta[0]; }
    __syncthreads();
    for (int c = F.vcu; c < M / 256; c += F.G) {
        if (F.tid < 16) { int p = 0; for (int cc = 0; cc < c; ++cc) p += call[cc * 16 + F.tid]; pre[F.tid] = p; }
        const int hf = F.tid >> 8, i = F.tid & 255, m = c * 256 + i;
        const int te = ((const GAS int*)(ws + WS_TOKE))[m];
        const int g = hf * 8 + (hf ? ((te >> 8) & 0xff) : (te & 0xff));
        grp[F.tid] = g;
        __syncthreads();
        int rank = 0;
        for (int j = 0; j < i; ++j) rank += (grp[hf * 256 + j] == g) ? 1 : 0;
        const int slot = base[g] + pre[g] + rank;
        ((GAS int*)(ws + WS_SLOTTOK))[slot] = m; ((GAS float*)(ws + WS_SLOTGATE))[slot] = ((const GAS float*)(ws + WS_TOKG))[2 * m + hf];
        slot_of[F.tid] = slot;
        __syncthreads();
        for (int p = F.wave; p < 512; p += NWAVES) { const int mm = c * 256 + (p & 255), sl = slot_of[p];
            const GAS v4u* src = (const GAS v4u*)(ws + WS_XN5 + (size_t)mm * D * 2); GAS v4u* dst = (GAS v4u*)(ws + WS_XG + (size_t)sl * D * 2);
            const v4u x0 = src[F.lane], x1 = src[F.lane + 64]; dst[F.lane] = x0; dst[F.lane + 64] = x1; }
        __syncthreads();
    }
    for (int g = F.vcu; g < 16; g += F.G) {
        const int s0 = base[g] + tot[g], s1 = base[g] + ((tot[g] + 255) & ~255);
        for (int s = s0 + F.wave; s < s1; s += NWAVES) { GAS v4u* dst = (GAS v4u*)(ws + WS_XG + (size_t)s * D * 2);
            dst[F.lane] = (v4u){0u, 0u, 0u, 0u}; dst[F.lane + 64] = (v4u){0u, 0u, 0u, 0u};
            if (F.lane == 0) { ((GAS int*)(ws + WS_SLOTTOK))[s] = -1; ((GAS float*)(ws + WS_SLOTGATE))[s] = 0.f; } }
    }
    if (F.vcu == 0) {
        if (F.tid < 16) { const int p0 = base[F.tid] >> 8, p1 = (base[F.tid] + ((tot[F.tid] + 255) & ~255)) >> 8; for (int p = p0; p < p1; ++p) ((GAS int*)(ws + WS_PANELE))[p] = F.tid & 7; }
        if (F.tid == 0) { ((GAS int*)(ws + WS_META))[0] = meta[0]; ((GAS int*)(ws + WS_META))[1] = meta[1]; }
    }
    __syncthreads();
}

__global__ void __launch_bounds__(NWAVES * 64, 2) yoco_fwd(Args args) {
    extern __shared__ __attribute__((aligned(16))) unsigned char lds_raw[];
    Frame F;
    F.lds = (LAS unsigned char*)lds_raw;
    F.tid = threadIdx.x; F.lane = F.tid & 63; F.wave = __builtin_amdgcn_readfirstlane(F.tid >> 6);
    F.G = gridDim.x; { const int bx = blockIdx.x; F.vcu = (F.G % 8 == 0) ? (bx % 8) * (F.G / 8) + bx / 8 : bx; }
    unsigned char* ws = WSP;
    volatile LAS unsigned* MISC = (volatile LAS unsigned*)(F.lds + MISC_OFF);
    for (int u = fresh(F.tid); u < (LDS_BYTES - LDSCTL_OFF) / 4; u += NWAVES * 64) ((LAS unsigned*)(F.lds + LDSCTL_OFF))[u] = 0u;
    __syncthreads();
    XcdBarrier bar = xcd_barrier_post((unsigned*)(ws + WS_CTL) + CW_BAR, MISC + 8);
    LAS unsigned char* ring = F.lds + RING_OFF;
    const int bid = (int)blockIdx.x;
#define GRID_BAR() xcd_barrier(bar)
#define GEMM(EpiT, SchedT) pg8::gemm_phase<EpiT, SchedT, true, true>

    p0_prologue(F);
    GRID_BAR();
    { pg8::Gemm g{(const bf16*)(ws + WS_XN), (const bf16*)(ws + WS_WA), M, NA, D}; pg8::StaticOrder S; S.init(M, NA, F.G, bid);
      pg8::EpiStoreBf16 E{(bf16*)(ws + WS_QA), NA, 0};
      GEMM(pg8::EpiStoreBf16, pg8::StaticOrder)(ring, g, S, E); }
    GRID_BAR();
    latent_norm_phase(F, ws);
    GRID_BAR();
    { pg8::Gemm g{(const bf16*)(ws + WS_CQ), (const bf16*)(ws + WS_WUQ), M, NH * QKD, QLORA}; pg8::StaticOrder S; S.init(M, NH * QKD, F.G, bid);
      pg8::EpiStoreBf16 E{(bf16*)(ws + WS_Q), NH * QKD, 0};
      GEMM(pg8::EpiStoreBf16, pg8::StaticOrder)(ring, g, S, E); }
    { pg8::Gemm g{(const bf16*)(ws + WS_CKV), (const bf16*)(ws + WS_WUKV), M, NH * 128, KVLORA}; pg8::StaticOrder S; S.init(M, NH * 128, F.G, bid);
      pg8::EpiStoreBf16 E{(bf16*)(ws + WS_KV), NH * 128, 0};
      GEMM(pg8::EpiStoreBf16, pg8::StaticOrder)(ring, g, S, E); }
    GRID_BAR();
    qk_post_phase(F, ws, INP(I_A_GQN), INP(I_A_GKN));
    GRID_BAR();
    for (int p = F.vcu; p < BATCH * NH * 4; p += F.G) {
        const int bh = p >> 2, pid = p & 3, b = bh >> 4, h = bh & 15;
        for (int u2 = 0; u2 < 2; ++u2) {
            const int qb = u2 ? 7 - pid : pid;
            att::attn_unit<96, false>(ring, (const bf16*)(ws + WS_Q) + (size_t)b * SEQ * 1536 + h * QKD, 1536, (const bf16*)(ws + WS_K) + (size_t)b * SEQ * 1536 + h * QKD, 1536,
                                      (const bf16*)(ws + WS_KV) + (size_t)b * SEQ * 2048 + h * 128 + 64, 2048, (bf16*)(ws + WS_O) + (size_t)b * SEQ * D + h * 64, D,
                                      256 * qb, 0, 4 * qb + 3, 0, 4 * qb + (F.wave >> 1), 0, nullptr);
        }
    }
    GRID_BAR();
    { pg8::Gemm g{(const bf16*)(ws + WS_O), (const bf16*)(ws + WS_WO), M, D, D}; pg8::StaticOrder S; S.init(M, D, F.G, bid);
      pg8::EpiResF32 E{INP(I_X), OUTP, D};
      GEMM(pg8::EpiResF32, pg8::StaticOrder)(ring, g, S, E); }
    GRID_BAR();
    norm_phase(F, OUTP, (bf16*)(ws + WS_XN));
    GRID_BAR();
    { pg8::Gemm g{(const bf16*)(ws + WS_XN), (const bf16*)(ws + WS_WF1), M, 2 * FF, D}; pg8::StaticOrder S; S.init(M, 2 * FF, F.G, bid);
      pg8::EpiGated E{(bf16*)(ws + WS_H), FF, 0};
      GEMM(pg8::EpiGated, pg8::StaticOrder)(ring, g, S, E); }
    GRID_BAR();
    { pg8::Gemm g{(const bf16*)(ws + WS_H), (const bf16*)(ws + WS_WF2), M, D, FF}; pg8::StaticOrder S; S.init(M, D, F.G, bid);
      pg8::EpiResF32 E{OUTP, OUTP, D};
      GEMM(pg8::EpiResF32, pg8::StaticOrder)(ring, g, S, E); }
    GRID_BAR();
    norm_phase(F, OUTP, (bf16*)(ws + WS_XN));
    GRID_BAR();
    { pg8::Gemm g{(const bf16*)(ws + WS_XN), (const bf16*)(ws + WS_WKVQ), M, 3 * D, D}; pg8::StaticOrder S; S.init(M, 3 * D, F.G, bid);
      pg8::EpiStoreBf16 E{(bf16*)(ws + WS_KVQ2), 3 * D, 0};
      GEMM(pg8::EpiStoreBf16, pg8::StaticOrder)(ring, g, S, E); }
    GRID_BAR();
    head_norm_phase(F, ws, INP(I_KV_GKN), INP(I_B_GQN));
    GRID_BAR();
    for (int p = F.vcu; p < BATCH * NH * 8; p += F.G) {
        const int bh = p >> 3, cb = ((p & 7) + (p >> 8)) & 7, b = bh >> 4, h = bh & 15;
        const int c0 = 4 * cb, cc = c0 + (F.wave >> 1);
        const bf16* base = (const bf16*)(ws + WS_KVQ2) + (size_t)b * SEQ * 3072 + h * 64;
        att::attn_unit<64, true>(ring, base + 2048, 3072, base, 3072, base + 1024, 3072, (bf16*)(ws + WS_O2) + (size_t)b * SEQ * D + h * 64, D,
                                 256 * cb, c0 - 8 < 0 ? 0 : c0 - 8, c0 + 3, cc - 8 < 0 ? 0 : cc - 8, cc, cc, INP(I_B_RELB) + h * 257);
    }
    GRID_BAR();
    { pg8::Gemm g{(const bf16*)(ws + WS_O2), (const bf16*)(ws + WS_WBO), M, D, D}; pg8::StaticOrder S; S.init(M, D, F.G, bid);
      pg8::EpiResF32 E{OUTP, OUTP, D};
      GEMM(pg8::EpiResF32, pg8::StaticOrder)(ring, g, S, E); }
    GRID_BAR();
    route_phase(F);
    GRID_BAR();
    slot_phase(F, ws);
    GRID_BAR();
    {
        const int nPA = __builtin_amdgcn_readfirstlane(((const GAS int*)(ws + WS_META))[0]), nPB = __builtin_amdgcn_readfirstlane(((const GAS int*)(ws + WS_META))[1]);
        for (int hf = 0; hf < 2; ++hf) {
            const int nP = hf ? nPB : nPA, p0 = hf ? nPA : 0;
            { pg8::Gemm g{(const bf16*)(ws + WS_XG) + (size_t)p0 * 256 * D, (const bf16*)(ws + WS_WM1), nP * 256, 2 * EFF, D};
              pg8::MoeOrder S; S.init(nP, 2 * EFF / 256, F.G, bid, (const int*)(ws + WS_PANELE) + p0);
              pg8::EpiGated E{(bf16*)(ws + WS_HM), EFF, 2 * EFF / 256};
              GEMM(pg8::EpiGated, pg8::MoeOrder)(ring, g, S, E); }
            GRID_BAR();
            { pg8::Gemm g{(const bf16*)(ws + WS_HM), (const bf16*)(ws + WS_WM2), nP * 256, D, EFF};
              pg8::MoeOrder S; S.init(nP, D / 256, F.G, bid, (const int*)(ws + WS_PANELE) + p0);
              pg8::EpiMoeDown E{OUTP, (const int*)(ws + WS_SLOTTOK), (const float*)(ws + WS_SLOTGATE), p0 * 256, D};
              GEMM(pg8::EpiMoeDown, pg8::MoeOrder)(ring, g, S, E); }
            if (hf == 0) GRID_BAR();
        }
    }
#undef GRID_BAR
#undef GEMM
}

extern "C" void kernel_launch(void* const* d_in, const int* in_sizes, int n_in, void* d_out, int out_size, void* d_ws, size_t ws_size, hipStream_t stream) {
    static int grid = 0;
    if (grid == 0) {
        if (n_in != 27 || in_sizes[0] != M * D || out_size != M * D || ws_size < WS_END) { fprintf(stderr, "kernel_launch: unexpected shapes (n_in %d, in0 %d, out %d, ws %zu < %zu); nothing launched\n", n_in, n_in > 0 ? in_sizes[0] : -1, out_size, ws_size, (size_t)WS_END); grid = -1; return; }
        int dev = 0, cus = 0, per_cu = 0;
        if (hipGetDevice(&dev) != hipSuccess || hipDeviceGetAttribute(&cus, hipDeviceAttributeMultiprocessorCount, dev) != hipSuccess) { grid = -1; return; }
        if (hipFuncSetAttribute((const void*)yoco_fwd, hipFuncAttributeMaxDynamicSharedMemorySize, LDS_BYTES) != hipSuccess) { fprintf(stderr, "kernel_launch: hipFuncSetAttribute failed\n"); grid = -1; return; }
        if (hipOccupancyMaxActiveBlocksPerMultiprocessor(&per_cu, (const void*)yoco_fwd, NWAVES * 64, LDS_BYTES) != hipSuccess || per_cu < 1) { fprintf(stderr, "kernel_launch: occupancy query says %d\n", per_cu); }
        (void)hipGetLastError();
        grid = cus;
    }
    if (grid < 0) return;
    if (hipMemsetAsync((char*)d_ws + WS_CTL, 0, CTL_ZERO_BYTES, stream) != hipSuccess) return;
    Args a{};
    for (int i = 0; i < 27; ++i) a.in[i] = (const float*)d_in[i];
    a.out = (float*)d_out; a.ws = (unsigned char*)d_ws;
    hipLaunchKernelGGL(yoco_fwd, dim3(grid), dim3(NWAVES * 64), LDS_BYTES, stream, a);
}
```

```cpp
#include <hip/hip_runtime.h>
#include <cstdio>
#include <cstdint>
namespace pg8 {
#define PG8_LAS __attribute__((address_space(3)))
typedef unsigned short bf16_t;
typedef short bf16x8 __attribute__((ext_vector_type(8)));
typedef float f32x4 __attribute__((ext_vector_type(4)));
typedef unsigned u32x4 __attribute__((ext_vector_type(4)));
constexpr int BM = 256, BK = 64, HALF = 128, HTB = HALF * BK * 2  , STAGE_BYTES = 8 * HTB, NXCD = 8, WGM = 8;

__host__ __device__ __forceinline__ int lds_byte(int r, int c) { const int st = (r >> 4) * 2 + (c >> 5), rr = r & 15, cc = c & 31, ob = rr * 64 + cc * 2; return st * 1024 + (ob ^ (((ob >> 9) & 1) << 5)); }
__host__ __device__ __forceinline__ void stage_rc(int b, int& R, int& C) { const int st = b / 1024, sb = b % 1024, swz = sb ^ (((sb >> 9) & 1) << 5); R = (st >> 1) * 16 + swz / 64; C = (st & 1) * 32 + (swz % 64) / 2; }
__host__ __device__ __forceinline__ int perm32(int rho) { const int n = rho >> 4, i = rho & 15; return 8 * (i >> 2) + 4 * n + (i & 3); }

struct Unit { int pm, pn; };
struct Gemm { const bf16_t* A; const bf16_t* Bt; int M, N, K, lda; };

struct StaticOrder {
    int nM, nN, nwg, G, c;
    __host__ __device__ void init(int M, int N, int G_, int c_) { nM = M / BM; nN = N / BM; nwg = nM * nN; G = G_; c = c_; }
    __host__ __device__ bool next(int i, Unit& u) const {
        const long L = (long)i * G + c; if (L >= nwg) return false;
        int wgid = (int)L; { const int q = nwg / NXCD, r = nwg % NXCD, xcd = wgid % NXCD, off = wgid / NXCD; wgid = (xcd < r ? xcd * (q + 1) : r * (q + 1) + (xcd - r) * q) + off; }
        const int nig = WGM * nN, gid = wgid / nig, fm = gid * WGM, gsz = (nM - fm) < WGM ? (nM - fm) : WGM;
        u.pm = fm + ((wgid % nig) % gsz); u.pn = (wgid % nig) / gsz; return true;
    }
    __device__ __forceinline__ void a_ready(const Unit&) const {}
    __device__ __forceinline__ void done(const Unit&) const {}
};
__device__ __forceinline__ unsigned cvt_pk_bf16(float lo, float hi) { unsigned r; asm volatile("v_cvt_pk_bf16_f32 %0, %1, %2" : "=v"(r) : "v"(lo), "v"(hi)); return r; }
__device__ __forceinline__ float silu_f(float x) { const float e = __builtin_amdgcn_exp2f(x * -1.4426950408889634f); return x * __builtin_amdgcn_rcpf(1.f + e); }

__device__ __forceinline__ float sum4(const f32x4& a) { return (a[0] + a[1]) + (a[2] + a[3]); }
__device__ __forceinline__ float part_sum8(const float* p) { return sum4(*(const f32x4*)p) + sum4(*(const f32x4*)(p + 4)); }
__device__ __forceinline__ float part_sum16(const float* p) { return (sum4(*(const f32x4*)p) + sum4(*(const f32x4*)(p + 4))) + (sum4(*(const f32x4*)(p + 8)) + sum4(*(const f32x4*)(p + 12))); }
__device__ __forceinline__ float fq_sum(float v) { v += __shfl_xor(v, 16); v += __shfl_xor(v, 32); return v; }
__device__ __forceinline__ float sq8(const f32x4& a, const f32x4& b) { return ((a[0] * a[0] + a[1] * a[1]) + (a[2] * a[2] + a[3] * a[3])) + ((b[0] * b[0] + b[1] * b[1]) + (b[2] * b[2] + b[3] * b[3])); }
__device__ __forceinline__ u32x4 pack8(const f32x4& a, const f32x4& b) { u32x4 w; w.x = cvt_pk_bf16(a[0], a[1]); w.y = cvt_pk_bf16(a[2], a[3]); w.z = cvt_pk_bf16(b[0], b[1]); w.w = cvt_pk_bf16(b[2], b[3]); return w; }
constexpr float EPS_ = 1e-6f;

struct EpiQA {
    static constexpr bool PERM = true, AFTER_DRAIN = false;
    bf16_t* O; float* part;
    __device__ __forceinline__ void operator()(const f32x4 (&acc)[2][2][4][2], const Unit& u, int wr, int wc, int fr, int fq) const {
        { int t_ = threadIdx.x; asm volatile("" : "+v"(t_)); fr = t_ & 15; fq = (t_ >> 4) & 3; }
        const int row0 = u.pm * BM + wr * 64 + fr, col0 = u.pn * BM + wc * 32 + 8 * fq;
#pragma unroll
        for (int ai = 0; ai < 2; ++ai)
#pragma unroll
            for (int m = 0; m < 4; ++m) { const int row = row0 + ai * HALF + m * 16; bf16_t* rowp = O + (size_t)row * 768 + col0;
                *(u32x4*)(rowp) = pack8(acc[ai][0][m][0], acc[ai][0][m][1]); *(u32x4*)(rowp + HALF) = pack8(acc[ai][1][m][0], acc[ai][1][m][1]);
                const float s0 = sq8(acc[ai][0][m][0], acc[ai][0][m][1]), s1 = sq8(acc[ai][1][m][0], acc[ai][1][m][1]);
                float* pr = part + (size_t)row * 16;
                if (u.pn == 0) { const float t = fq_sum(s0 + s1); if (fq == 0) pr[wc] = t; }
                else if (u.pn == 1) { const float t0 = fq_sum(s0), t1 = fq_sum(s1); if (fq == 0) { pr[4 + wc] = t0; pr[8 + wc] = t1; } }
                else { const float t = fq_sum(s0); if (fq == 0) pr[12 + wc] = t; } }
    }
};

struct EpiRowScaleBf16 {
    static constexpr bool PERM = true, AFTER_DRAIN = false;
    bf16_t* O; int ldc; const float* part; float inv_n;
    __device__ __forceinline__ void operator()(const f32x4 (&acc)[2][2][4][2], const Unit& u, int wr, int wc, int fr, int fq) const {
        { int t_ = threadIdx.x; asm volatile("" : "+v"(t_)); fr = t_ & 15; fq = (t_ >> 4) & 3; }
        const int row0 = u.pm * BM + wr * 64 + fr, col0 = u.pn * BM + wc * 32 + 8 * fq;
#pragma unroll
        for (int ai = 0; ai < 2; ++ai)
#pragma unroll
            for (int m = 0; m < 4; ++m) { const int row = row0 + ai * HALF + m * 16; bf16_t* rowp = O + (size_t)row * ldc + col0;
                const float rs = __builtin_amdgcn_rsqf(part_sum8(part + (size_t)row * 16) * inv_n + EPS_);
                *(u32x4*)(rowp) = pack8(acc[ai][0][m][0] * rs, acc[ai][0][m][1] * rs); *(u32x4*)(rowp + HALF) = pack8(acc[ai][1][m][0] * rs, acc[ai][1][m][1] * rs); }
    }
};

struct EpiKVup {
    static constexpr bool PERM = true, AFTER_DRAIN = false;
    bf16_t* Kd; bf16_t* Vd; const float* part; const bf16_t* QA; const float* g_kn; const float* rope;
    __device__ __forceinline__ void operator()(const f32x4 (&acc)[2][2][4][2], const Unit& u, int wr, int wc, int fr, int fq) const {
        { int t_ = threadIdx.x; asm volatile("" : "+v"(t_)); fr = t_ & 15; fq = (t_ >> 4) & 3; }
        const int row0 = u.pm * BM + wr * 64 + fr;
        if (u.pn >= 4) {
            const int col0 = (u.pn - 4) * BM + wc * 32 + 8 * fq;
#pragma unroll
            for (int ai = 0; ai < 2; ++ai)
#pragma unroll
                for (int m = 0; m < 4; ++m) { const int row = row0 + ai * HALF + m * 16; bf16_t* rowp = Vd + (size_t)row * 1024 + col0;
                    const float rs = __builtin_amdgcn_rsqf(part_sum8(part + (size_t)row * 16 + 8) * (1.f / 256) + EPS_);
                    *(u32x4*)(rowp) = pack8(acc[ai][0][m][0] * rs, acc[ai][0][m][1] * rs); *(u32x4*)(rowp + HALF) = pack8(acc[ai][1][m][0] * rs, acc[ai][1][m][1] * rs); }
            return;
        }
        const int head = 4 * u.pn + wc;
        f32x4 gA0 = *(const f32x4*)(g_kn + 8 * fq), gA1 = *(const f32x4*)(g_kn + 8 * fq + 4), gB0 = *(const f32x4*)(g_kn + 32 + 8 * fq), gB1 = *(const f32x4*)(g_kn + 32 + 8 * fq + 4);
        const f32x4 gR1 = *(const f32x4*)(g_kn + 64 + 4 * fq), gR2 = *(const f32x4*)(g_kn + 80 + 4 * fq);
#pragma unroll
        for (int ai = 0; ai < 2; ++ai)
#pragma unroll
            for (int m = 0; m < 4; ++m) { const int row = row0 + ai * HALF + m * 16;
                const float rs = __builtin_amdgcn_rsqf(part_sum8(part + (size_t)row * 16 + 8) * (1.f / 256) + EPS_);
                f32x4 a0 = acc[ai][0][m][0] * rs, a1 = acc[ai][0][m][1] * rs, b0 = acc[ai][1][m][0] * rs, b1 = acc[ai][1][m][1] * rs;
                const unsigned long long p1 = *(const unsigned long long*)(QA + (size_t)row * 768 + 640 + 4 * fq), p2 = *(const unsigned long long*)(QA + (size_t)row * 768 + 656 + 4 * fq);
                f32x4 x1, x2;
                x1[0] = __builtin_bit_cast(float, (unsigned)(p1 << 16)); x1[1] = __builtin_bit_cast(float, (unsigned)p1 & 0xffff0000u);
                x1[2] = __builtin_bit_cast(float, (unsigned)(p1 >> 32) << 16); x1[3] = __builtin_bit_cast(float, (unsigned)(p1 >> 32) & 0xffff0000u);
                x2[0] = __builtin_bit_cast(float, (unsigned)(p2 << 16)); x2[1] = __builtin_bit_cast(float, (unsigned)p2 & 0xffff0000u);
                x2[2] = __builtin_bit_cast(float, (unsigned)(p2 >> 32) << 16); x2[3] = __builtin_bit_cast(float, (unsigned)(p2 >> 32) & 0xffff0000u);
                const float ss = fq_sum(sq8(a0, a1) + sq8(b0, b1) + sq8(x1, x2));
                const float sh = __builtin_amdgcn_rsqf(ss * (1.f / 96) + EPS_);
                bf16_t* kp = Kd + (size_t)row * 1536 + head * 96;
                *(u32x4*)(kp + 8 * fq) = pack8(a0 * gA0 * sh, a1 * gA1 * sh); *(u32x4*)(kp + 32 + 8 * fq) = pack8(b0 * gB0 * sh, b1 * gB1 * sh);
                const f32x4* rp = (const f32x4*)(rope + ((size_t)(row & 2047) * 16 + 4 * fq) * 2);
                const f32x4 c01 = rp[0], c23 = rp[1];
                const f32x4 y1 = x1 * gR1 * sh, y2 = x2 * gR2 * sh;
                f32x4 o1, o2;
                o1[0] = y1[0] * c01[0] - y2[0] * c01[1]; o2[0] = y2[0] * c01[0] + y1[0] * c01[1];
                o1[1] = y1[1] * c01[2] - y2[1] * c01[3]; o2[1] = y2[1] * c01[2] + y1[1] * c01[3];
                o1[2] = y1[2] * c23[0] - y2[2] * c23[1]; o2[2] = y2[2] * c23[0] + y1[2] * c23[1];
                o1[3] = y1[3] * c23[2] - y2[3] * c23[3]; o2[3] = y2[3] * c23[2] + y1[3] * c23[3];
                unsigned long long w1 = (unsigned long long)cvt_pk_bf16(o1[0], o1[1]) | ((unsigned long long)cvt_pk_bf16(o1[2], o1[3]) << 32);
                unsigned long long w2 = (unsigned long long)cvt_pk_bf16(o2[0], o2[1]) | ((unsigned long long)cvt_pk_bf16(o2[2], o2[3]) << 32);
                *(unsigned long long*)(kp + 64 + 4 * fq) = w1; *(unsigned long long*)(kp + 80 + 4 * fq) = w2; }
    }
};

struct EpiKVQ2 {
    static constexpr bool PERM = true, AFTER_DRAIN = false;
    bf16_t* O; const float* pss; const float* gk; const float* gq;
    __device__ __forceinline__ void operator()(const f32x4 (&acc)[2][2][4][2], const Unit& u, int wr, int wc, int fr, int fq) const {
        { int t_ = threadIdx.x; asm volatile("" : "+v"(t_)); fr = t_ & 15; fq = (t_ >> 4) & 3; }
        const int row0 = u.pm * BM + wr * 64 + fr, part = u.pn >> 2, tl = u.pn & 3;
        if (part == 1) {
            const int col0 = u.pn * BM + wc * 32 + 8 * fq;
#pragma unroll
            for (int ai = 0; ai < 2; ++ai)
#pragma unroll
                for (int m = 0; m < 4; ++m) { const int row = row0 + ai * HALF + m * 16; bf16_t* rowp = O + (size_t)row * 3072 + col0;
                    const float rs = __builtin_amdgcn_rsqf(part_sum16(pss + (size_t)row * 16) * (1.f / 1024) + EPS_);
                    *(u32x4*)(rowp) = pack8(acc[ai][0][m][0] * rs, acc[ai][0][m][1] * rs); *(u32x4*)(rowp + HALF) = pack8(acc[ai][1][m][0] * rs, acc[ai][1][m][1] * rs); }
            return;
        }
        const float* g = part ? gq : gk; const float post = part ? 0.125f * 1.4426950408889634f : 1.f;
        const f32x4 gA0 = *(const f32x4*)(g + 8 * fq) * post, gA1 = *(const f32x4*)(g + 8 * fq + 4) * post, gB0 = *(const f32x4*)(g + 32 + 8 * fq) * post, gB1 = *(const f32x4*)(g + 32 + 8 * fq + 4) * post;
        const int colh = part * 1024 + (4 * tl + wc) * 64;
#pragma unroll
        for (int ai = 0; ai < 2; ++ai)
#pragma unroll
            for (int m = 0; m < 4; ++m) { const int row = row0 + ai * HALF + m * 16; bf16_t* rowp = O + (size_t)row * 3072 + colh;
                const float rs = __builtin_amdgcn_rsqf(part_sum16(pss + (size_t)row * 16) * (1.f / 1024) + EPS_);
                const f32x4 a0 = acc[ai][0][m][0] * rs, a1 = acc[ai][0][m][1] * rs, b0 = acc[ai][1][m][0] * rs, b1 = acc[ai][1][m][1] * rs;
                const float ss = fq_sum(sq8(a0, a1) + sq8(b0, b1));
                const float sh = __builtin_amdgcn_rsqf(ss * (1.f / 64) + EPS_);
                *(u32x4*)(rowp + 8 * fq) = pack8(a0 * gA0 * sh, a1 * gA1 * sh); *(u32x4*)(rowp + 32 + 8 * fq) = pack8(b0 * gB0 * sh, b1 * gB1 * sh); }
    }
};

template <bool SSQ> struct EpiGated {
    static constexpr bool PERM = true, AFTER_DRAIN = false;
    bf16_t* Hd; int ldc; int ntile; const float* rs;
    __device__ __forceinline__ void operator()(const f32x4 (&acc)[2][2][4][2], const Unit& u, int wr, int wc, int fr, int fq) const {
        { int t_ = threadIdx.x; asm volatile("" : "+v"(t_)); fr = t_ & 15; fq = (t_ >> 4) & 3; }
        const int pnl = ntile ? (u.pn % ntile) : u.pn;
        const int row0 = u.pm * BM + wr * 64 + fr, col0 = pnl * HALF + wc * 32 + 8 * fq;
#pragma unroll
        for (int ai = 0; ai < 2; ++ai)
#pragma unroll
            for (int m = 0; m < 4; ++m) { const int row = row0 + ai * HALF + m * 16; bf16_t* rowp = Hd + (size_t)row * ldc + col0;
                const float r = SSQ ? __builtin_amdgcn_rsqf(part_sum16(rs + (size_t)row * 16) * (1.f / 1024) + EPS_) : rs[row];
                const f32x4 g0 = acc[ai][0][m][0] * r, g1 = acc[ai][0][m][1] * r, u0 = acc[ai][1][m][0] * r, u1 = acc[ai][1][m][1] * r;
                u32x4 w;
                w.x = cvt_pk_bf16(silu_f(g0[0]) * u0[0], silu_f(g0[1]) * u0[1]); w.y = cvt_pk_bf16(silu_f(g0[2]) * u0[2], silu_f(g0[3]) * u0[3]);
                w.z = cvt_pk_bf16(silu_f(g1[0]) * u1[0], silu_f(g1[1]) * u1[1]); w.w = cvt_pk_bf16(silu_f(g1[2]) * u1[2], silu_f(g1[3]) * u1[3]);
                *(u32x4*)rowp = w; }
    }
};

template <bool SSQ> struct EpiResNorm {
    static constexpr bool PERM = true, AFTER_DRAIN = false;
    const float* res; float* out; bf16_t* XR; float* ssq;
    __device__ __forceinline__ void operator()(const f32x4 (&acc)[2][2][4][2], const Unit& u, int wr, int wc, int fr, int fq) const {
        { int t_ = threadIdx.x; asm volatile("" : "+v"(t_)); fr = t_ & 15; fq = (t_ >> 4) & 3; }
        const int row0 = u.pm * BM + wr * 64 + fr, col0 = u.pn * BM + wc * 32 + 8 * fq;
#pragma unroll
        for (int ai = 0; ai < 2; ++ai)
#pragma unroll
            for (int m = 0; m < 4; ++m) { const int row = row0 + ai * HALF + m * 16; const size_t ro = (size_t)row * 1024 + col0;
                f32x4 r[2][2];
#pragma unroll
                for (int bj = 0; bj < 2; ++bj)
#pragma unroll
                    for (int n = 0; n < 2; ++n) r[bj][n] = *(const f32x4*)(res + ro + bj * HALF + n * 4);
#pragma unroll
                for (int bj = 0; bj < 2; ++bj)
#pragma unroll
                    for (int n = 0; n < 2; ++n) { r[bj][n] = r[bj][n] + acc[ai][bj][m][n]; *(f32x4*)(out + ro + bj * HALF + n * 4) = r[bj][n]; }
                *(u32x4*)(XR + ro) = pack8(r[0][0], r[0][1]); *(u32x4*)(XR + ro + HALF) = pack8(r[1][0], r[1][1]);
                if (SSQ) { const float t = fq_sum(sq8(r[0][0], r[0][1]) + sq8(r[1][0], r[1][1])); if (fq == 0) ssq[(size_t)row * 16 + u.pn * 4 + wc] = t; } }
    }
};

struct EpiMoeDown {
    static constexpr bool PERM = false, AFTER_DRAIN = false;
    float* out; const int* slot_tok; const float* slot_gate; int slot_base; int ldc;
    __device__ __forceinline__ void operator()(const f32x4 (&acc)[2][2][4][2], const Unit& u, int wr, int wc, int fr, int fq) const {
        { int t_ = threadIdx.x; asm volatile("" : "+v"(t_)); fr = t_ & 15; fq = (t_ >> 4) & 3; }
        const int pnl = u.pn & 3;
        const int row0 = slot_base + u.pm * BM + wr * 64 + fr, col0 = pnl * BM + wc * 32 + 4 * fq;
#pragma unroll
        for (int ai = 0; ai < 2; ++ai)
#pragma unroll
            for (int m = 0; m < 4; ++m) { const int slot = row0 + ai * HALF + m * 16; const int tok = slot_tok[slot]; const float gt = slot_gate[slot];
                if (tok >= 0) { float* rowp = out + (size_t)tok * ldc + col0;
                    f32x4 r[2][2];
#pragma unroll
                    for (int bj = 0; bj < 2; ++bj)
#pragma unroll
                        for (int n = 0; n < 2; ++n) r[bj][n] = *(const f32x4*)(rowp + bj * HALF + n * 16);
#pragma unroll
                    for (int bj = 0; bj < 2; ++bj)
#pragma unroll
                        for (int n = 0; n < 2; ++n) *(f32x4*)(rowp + bj * HALF + n * 16) = r[bj][n] + acc[ai][bj][m][n] * gt; } }
    }
};

struct MoeOrder {
    int nM, nN, nwg, G, c; const int* panel_e;
    __device__ void init(int nPanels, int nN_, int G_, int c_, const int* pe) { nM = nPanels; nN = nN_; nwg = nM * nN; G = G_; c = c_; panel_e = pe; }
    __device__ bool next(int i, Unit& u) const {
        const long L = (long)i * G + c; if (L >= nwg) return false;
        int wgid = (int)L; { const int q = nwg / NXCD, r = nwg % NXCD, xcd = wgid % NXCD, off = wgid / NXCD; wgid = (xcd < r ? xcd * (q + 1) : r * (q + 1) + (xcd - r) * q) + off; }
        const int nig = WGM * nN, gid = wgid / nig, fm = gid * WGM, gsz = (nM - fm) < WGM ? (nM - fm) : WGM;
        u.pm = fm + ((wgid % nig) % gsz); const int pnl = (wgid % nig) / gsz;
        const int e = __builtin_amdgcn_readfirstlane(panel_e[u.pm]);
        u.pn = e * nN + pnl; return true;
    }
    __device__ __forceinline__ void a_ready(const Unit&) const {}
    __device__ __forceinline__ void done(const Unit&) const {}
};
template <class Epi, class Sched, bool ALIGN_EPI = false, bool SP2 = false>
__device__ __forceinline__ void gemm_phase(PG8_LAS unsigned char* lds, const Gemm g, const Sched& S, const Epi& E) {
    int tid_ = threadIdx.x; asm volatile("" : "+v"(tid_));
    const int tid = tid_, wid = __builtin_amdgcn_readfirstlane(tid >> 6), lane = tid & 63, wr = wid >> 2, wc = wid & 3, fr = lane & 15, fq = lane >> 4;
    const int K = g.K, nt = K / BK;
    unsigned voffA[2], voffB[2];
#pragma unroll
    for (int i = 0; i < 2; ++i) { int R, C; stage_rc(tid * 16 + i * 8192, R, C); const int Rb = Epi::PERM ? ((R & ~31) + perm32(R & 31)) : R;
        voffA[i] = (unsigned)(R * g.lda + C) * 2u; voffB[i] = (unsigned)(Rb * K + C) * 2u; }
    const size_t kstep = (size_t)(BK * 2);
    const size_t hstepA = (size_t)HALF * g.lda * 2, hstepB = (size_t)HALF * K * 2;
    const size_t tstepA = 2 * hstepA, tstepB = 2 * hstepB;
    const unsigned ldsw = (unsigned)wid * 1024u;
    const int aoff = lds_byte(wr * 64 + fr, fq * 8), boff = lds_byte(wc * 32 + fr, fq * 8);
#define PG8_SA(b, h) (((b) * 2 + (h)) * HTB)
#define PG8_SB(b, h) ((4 + (b) * 2 + (h)) * HTB)
#define PG8_STAGE(bufoff, gbase, voff) do { _Pragma("unroll") for (int _i = 0; _i < 2; ++_i) \
        __builtin_amdgcn_global_load_lds((const unsigned*)((const char*)(gbase) + (voff)[_i]), (PG8_LAS unsigned*)(lds + (bufoff) + ldsw + _i * 8192), 16, 0, 0); } while (0)
#define PG8_LDA(dst, b, h) do { _Pragma("unroll") for (int m = 0; m < 4; ++m) _Pragma("unroll") for (int k = 0; k < 2; ++k) dst[m][k] = *(const PG8_LAS bf16x8*)(lds + PG8_SA(b, h) + aoff + m * 2048 + k * 1024); } while (0)
#define PG8_LDB(dst, b, h) do { _Pragma("unroll") for (int n = 0; n < 2; ++n) _Pragma("unroll") for (int k = 0; k < 2; ++k) dst[n][k] = *(const PG8_LAS bf16x8*)(lds + PG8_SB(b, h) + boff + n * 2048 + k * 1024); } while (0)
#define PG8_MMA(ai, bj, At, Bt) do { __builtin_amdgcn_s_setprio(1); _Pragma("unroll") for (int m = 0; m < 4; ++m) _Pragma("unroll") for (int n = 0; n < 2; ++n) _Pragma("unroll") for (int k = 0; k < 2; ++k) \
        acc[ai][bj][m][n] = __builtin_amdgcn_mfma_f32_16x16x32_bf16(Bt[n][k], At[m][k], acc[ai][bj][m][n], 0, 0, 0); __builtin_amdgcn_s_setprio(0); } while (0)
#define PG8_WAIT_V(n) asm volatile("s_waitcnt vmcnt(" #n ")" ::: "memory")
#define PG8_WAIT_L(n) asm volatile("s_waitcnt lgkmcnt(" #n ")" ::: "memory")
#define PG8_BAR __builtin_amdgcn_s_barrier()
#define PG8_SCHED __builtin_amdgcn_sched_barrier(0)
    Unit cur, nxt; int ui = 0;
    if (!S.next(0, cur)) return;
    f32x4 acc[2][2][4][2];
#pragma unroll
    for (int a = 0; a < 2; ++a)
#pragma unroll
        for (int b = 0; b < 2; ++b)
#pragma unroll
            for (int m = 0; m < 4; ++m)
#pragma unroll
                for (int n = 0; n < 2; ++n) acc[a][b][m][n] = (f32x4){0.f, 0.f, 0.f, 0.f};
    bf16x8 At[4][2], B0[2][2], B1[2][2];
    const char* cA = (const char*)g.A + (size_t)cur.pm * tstepA; const char* cB = (const char*)g.Bt + (size_t)cur.pn * tstepB;
    S.a_ready(cur);
    if constexpr (SP2) {
        PG8_STAGE(PG8_SB(0, 0), cB, voffB); PG8_STAGE(PG8_SB(0, 1), cB + hstepB, voffB); PG8_STAGE(PG8_SA(0, 0), cA, voffA); PG8_STAGE(PG8_SA(0, 1), cA + hstepA, voffA);
        if (wr == 1) PG8_BAR;
        PG8_WAIT_V(2); PG8_BAR;
        PG8_STAGE(PG8_SB(1, 0), cB + kstep, voffB); PG8_STAGE(PG8_SA(1, 0), cA + kstep, voffA); PG8_STAGE(PG8_SB(1, 1), cB + hstepB + kstep, voffB);
        PG8_WAIT_V(6); PG8_BAR;
    } else {
        PG8_STAGE(PG8_SB(0, 0), cB, voffB); PG8_STAGE(PG8_SA(0, 0), cA, voffA); PG8_STAGE(PG8_SB(0, 1), cB + hstepB, voffB); PG8_STAGE(PG8_SA(0, 1), cA + hstepA, voffA);
        if (wr == 1) PG8_BAR;
        PG8_WAIT_V(4); PG8_BAR;
        PG8_STAGE(PG8_SB(1, 0), cB + kstep, voffB); PG8_STAGE(PG8_SA(1, 0), cA + kstep, voffA); PG8_STAGE(PG8_SB(1, 1), cB + hstepB + kstep, voffB);
        PG8_WAIT_V(6); PG8_BAR;
    }
    for (;;) {
        const bool has_next = S.next(ui + 1, nxt);
        const char* nA = has_next ? (const char*)g.A + (size_t)nxt.pm * tstepA : cA; const char* nB = has_next ? (const char*)g.Bt + (size_t)nxt.pn * tstepB : cB;
        for (int t = 0; t < nt; t += 2) {
            const bool last = (t == nt - 2);
            const char* a1 = cA + (size_t)(t + 1) * kstep;
            const char* a2 = last ? nA : cA + (size_t)(t + 2) * kstep; const char* b2 = last ? nB : cB + (size_t)(t + 2) * kstep;
            const char* a3 = a2 + kstep; const char* b3 = b2 + kstep;
            if (last && has_next) S.a_ready(nxt);
            if constexpr (SP2) {
            PG8_LDB(B0, 0, 0); PG8_LDB(B1, 0, 1); PG8_SCHED; PG8_LDA(At, 0, 0); PG8_STAGE(PG8_SA(1, 1), a1 + hstepA, voffA);
            PG8_WAIT_V(8); PG8_WAIT_L(0); PG8_BAR; PG8_MMA(0, 0, At, B0); PG8_MMA(0, 1, At, B1); PG8_BAR; PG8_SCHED;
            PG8_LDA(At, 0, 1); PG8_STAGE(PG8_SB(0, 0), b2, voffB); PG8_STAGE(PG8_SB(0, 1), b2 + hstepB, voffB); PG8_STAGE(PG8_SA(0, 0), a2, voffA);
            PG8_WAIT_V(8); PG8_WAIT_L(0); PG8_BAR; PG8_MMA(1, 0, At, B0); PG8_MMA(1, 1, At, B1); PG8_BAR; PG8_SCHED;
            PG8_LDB(B0, 1, 0); PG8_LDB(B1, 1, 1); PG8_SCHED; PG8_LDA(At, 1, 0); PG8_STAGE(PG8_SA(0, 1), a2 + hstepA, voffA);
            PG8_WAIT_V(8); PG8_WAIT_L(0); PG8_BAR; PG8_MMA(0, 0, At, B0); PG8_MMA(0, 1, At, B1); PG8_BAR; PG8_SCHED;
            PG8_LDA(At, 1, 1); PG8_STAGE(PG8_SB(1, 0), b3, voffB); PG8_STAGE(PG8_SB(1, 1), b3 + hstepB, voffB); PG8_STAGE(PG8_SA(1, 0), a3, voffA);
            PG8_WAIT_V(8); PG8_WAIT_L(0); PG8_BAR; PG8_MMA(1, 0, At, B0); PG8_MMA(1, 1, At, B1); PG8_BAR; PG8_SCHED;
            } else {
            PG8_LDB(B0, 0, 0); PG8_SCHED; PG8_LDA(At, 0, 0); PG8_STAGE(PG8_SA(1, 1), a1 + hstepA, voffA);
            PG8_WAIT_L(8); PG8_BAR; PG8_WAIT_L(0); PG8_MMA(0, 0, At, B0); PG8_BAR; PG8_SCHED;
            PG8_LDB(B1, 0, 1); PG8_STAGE(PG8_SB(0, 0), b2, voffB);
            PG8_BAR; PG8_WAIT_L(0); PG8_MMA(0, 1, At, B1); PG8_BAR;
            PG8_LDA(At, 0, 1); PG8_STAGE(PG8_SA(0, 0), a2, voffA);
            PG8_BAR; PG8_WAIT_L(0); PG8_MMA(1, 0, At, B0); PG8_BAR; PG8_SCHED;
            PG8_STAGE(PG8_SB(0, 1), b2 + hstepB, voffB);
            PG8_WAIT_V(6); PG8_BAR; PG8_MMA(1, 1, At, B1); PG8_BAR;
            PG8_LDB(B0, 1, 0); PG8_SCHED; PG8_LDA(At, 1, 0); PG8_STAGE(PG8_SA(0, 1), a2 + hstepA, voffA);
            PG8_WAIT_L(8); PG8_BAR; PG8_WAIT_L(0); PG8_MMA(0, 0, At, B0); PG8_BAR; PG8_SCHED;
            PG8_LDB(B1, 1, 1); PG8_STAGE(PG8_SB(1, 0), b3, voffB);
            PG8_BAR; PG8_WAIT_L(0); PG8_MMA(0, 1, At, B1); PG8_BAR;
            PG8_LDA(At, 1, 1); PG8_STAGE(PG8_SA(1, 0), a3, voffA);
            PG8_BAR; PG8_WAIT_L(0); PG8_MMA(1, 0, At, B0); PG8_BAR; PG8_SCHED;
            PG8_STAGE(PG8_SB(1, 1), b3 + hstepB, voffB);
            PG8_WAIT_V(6); PG8_BAR; PG8_MMA(1, 1, At, B1); PG8_BAR;
            }
        }
        if constexpr (ALIGN_EPI) { if (wr == 0) PG8_BAR; }
        if constexpr (!Epi::AFTER_DRAIN) { E(acc, cur, wr, wc, fr, fq); S.done(cur); }
        if (!has_next) break;
#pragma unroll
        for (int a = 0; a < 2; ++a)
#pragma unroll
            for (int b = 0; b < 2; ++b)
#pragma unroll
                for (int m = 0; m < 4; ++m)
#pragma unroll
                    for (int n = 0; n < 2; ++n) acc[a][b][m][n] = (f32x4){0.f, 0.f, 0.f, 0.f};
        cur = nxt; cA = nA; cB = nB; ++ui;
        if constexpr (ALIGN_EPI) { if (wr == 1) PG8_BAR; }
    }
    PG8_WAIT_V(0);
    if constexpr (!ALIGN_EPI) { if (wr == 0) PG8_BAR; }
    PG8_BAR;
    if constexpr (Epi::AFTER_DRAIN) { E.fused(acc, cur, wr, wc, fr, fq, lds, wid, lane); S.done(cur); }
#undef PG8_SA
#undef PG8_SB
#undef PG8_STAGE
#undef PG8_LDA
#undef PG8_LDB
#undef PG8_MMA
#undef PG8_WAIT_V
#undef PG8_WAIT_L
#undef PG8_BAR
#undef PG8_SCHED
}
}
namespace att {
#define ATT_LAS __attribute__((address_space(3)))
typedef unsigned short bf16;
typedef short bf16x8 __attribute__((ext_vector_type(8)));
typedef short s16x4 __attribute__((ext_vector_type(4)));
typedef float f32x16 __attribute__((ext_vector_type(16)));
typedef float f32x4_t __attribute__((ext_vector_type(4)));
typedef unsigned u32x4 __attribute__((ext_vector_type(4)));
typedef unsigned u32x2 __attribute__((ext_vector_type(2)));
typedef float f32x2_t __attribute__((ext_vector_type(2))); typedef __bf16 bf16x2_t __attribute__((ext_vector_type(2)));
__device__ __forceinline__ unsigned cvtpk(float lo, float hi) { f32x2_t v = {lo, hi}; bf16x2_t b = __builtin_convertvector(v, bf16x2_t); return __builtin_bit_cast(unsigned, b); }
__device__ __forceinline__ s16x4 vtr(const ATT_LAS unsigned char* p) { return __builtin_bit_cast(s16x4, __builtin_amdgcn_ds_read_tr16_b64_v4i16((ATT_LAS s16x4*)p)); }
constexpr int VSTR = 192;
template <int DQK> struct Geo { static constexpr int KSTR = DQK * 2 + 16, KBUF = 64 * KSTR, VBUF = 64 * VSTR, CPR = DQK / 8, NKC = 64 * CPR, KIT = (NKC + 511) / 512; };
template <int DQK> constexpr int lds_bytes() { return 2 * Geo<DQK>::KBUF + 2 * Geo<DQK>::VBUF + 2048; }

__device__ __forceinline__ float rowmax32(const f32x16& p0, const f32x16& p1) {
    float a = fmaxf(p0[0], p1[0]), b = fmaxf(p0[1], p1[1]);
#pragma unroll
    for (int r = 2; r < 16; r += 2) { a = fmaxf(a, fmaxf(p0[r], p1[r])); b = fmaxf(b, fmaxf(p0[r + 1], p1[r + 1])); }
    const float m = fmaxf(a, b);
    return fmaxf(m, __shfl_xor(m, 32));
}

template <int DQK, bool BAND>
__device__ __forceinline__ void attn_unit(ATT_LAS unsigned char* lds, const bf16* Qb, int qpitch, const bf16* Kb, int kpitch, const bf16* Vb, int vpitch, bf16* Ob, int opitch,
                                          int q0, int t_lo, int t_hi, int my_lo, int my_hi, int cc, const float* bias_g, const float* g_qn, const float* rope) {
    typedef Geo<DQK> G;
    int tid_ = threadIdx.x; asm volatile("" : "+v"(tid_));
    const int tid = tid_, lane = tid & 63, r32 = lane & 31, hi = lane >> 5, wid = __builtin_amdgcn_readfirstlane(tid >> 6);
    ATT_LAS float* biasL = (ATT_LAS float*)(lds + 2 * G::KBUF + 2 * G::VBUF);
    bf16x8 qf[DQK / 16];
    { const bf16* qp = Qb + (size_t)(q0 + wid * 32 + r32) * qpitch + 8 * hi;
#pragma unroll
      for (int kk = 0; kk < DQK / 16; ++kk) qf[kk] = *(const bf16x8*)(qp + 16 * kk); }
    if constexpr (!BAND) {
        float qv[DQK / 16][8]; float ss = 0.f;
#pragma unroll
        for (int kk = 0; kk < DQK / 16; ++kk)
#pragma unroll
            for (int j = 0; j < 8; ++j) { qv[kk][j] = __builtin_bit_cast(float, (unsigned)(unsigned short)qf[kk][j] << 16); ss += qv[kk][j] * qv[kk][j]; }
        ss += __shfl_xor(ss, 32);
        const float rs = __builtin_amdgcn_rsqf(ss * (1.f / DQK) + 1e-6f) * (0.10206207261596577f * 1.4426950408889634f);
#pragma unroll
        for (int kk = 0; kk < DQK / 16; ++kk) { const f32x4_t g0 = *(const f32x4_t*)(g_qn + 16 * kk + 8 * hi), g1 = *(const f32x4_t*)(g_qn + 16 * kk + 8 * hi + 4);
#pragma unroll
            for (int j = 0; j < 4; ++j) { qv[kk][j] *= rs * g0[j]; qv[kk][4 + j] *= rs * g1[j]; } }
        const f32x4_t* rp = (const f32x4_t*)(rope + ((size_t)(q0 + wid * 32 + r32) * 16 + 8 * hi) * 2);
#pragma unroll
        for (int j2 = 0; j2 < 4; ++j2) { const f32x4_t cs = rp[j2];
            { const float x1 = qv[4][2 * j2], x2 = qv[5][2 * j2]; qv[4][2 * j2] = x1 * cs[0] - x2 * cs[1]; qv[5][2 * j2] = x2 * cs[0] + x1 * cs[1]; }
            { const float x1 = qv[4][2 * j2 + 1], x2 = qv[5][2 * j2 + 1]; qv[4][2 * j2 + 1] = x1 * cs[2] - x2 * cs[3]; qv[5][2 * j2 + 1] = x2 * cs[2] + x1 * cs[3]; } }
#pragma unroll
        for (int kk = 0; kk < DQK / 16; ++kk) { u32x4 w; w.x = cvtpk(qv[kk][0], qv[kk][1]); w.y = cvtpk(qv[kk][2], qv[kk][3]); w.z = cvtpk(qv[kk][4], qv[kk][5]); w.w = cvtpk(qv[kk][6], qv[kk][7]);
            qf[kk] = __builtin_bit_cast(bf16x8, w); }
    }
    if (BAND) { if (tid < 257) biasL[tid] = bias_g[tid] * 1.4426950408889634f; }
    u32x4 kreg[G::KIT], vreg;
    const int vrow = tid >> 3, vch = tid & 7;
#define ATT_GLOAD(t) do { const size_t kr0 = (size_t)(t) * 64; \
        _Pragma("unroll") for (int i = 0; i < G::KIT; ++i) { const int c = tid + 512 * i; if (c < G::NKC) { const int row = c / G::CPR, ch = c % G::CPR; \
            kreg[i] = *(const u32x4*)(Kb + (kr0 + row) * kpitch + ch * 8); } } \
        vreg = *(const u32x4*)(Vb + (kr0 + vrow) * vpitch + vch * 8); } while (0)
#define ATT_LSTORE(b) do { \
        _Pragma("unroll") for (int i = 0; i < G::KIT; ++i) { const int c = tid + 512 * i; if (c < G::NKC) { const int row = c / G::CPR, ch = c % G::CPR; \
            *(ATT_LAS u32x4*)(lds + (b) * G::KBUF + row * G::KSTR + ch * 16) = kreg[i]; } } \
        *(ATT_LAS u32x4*)(lds + 2 * G::KBUF + (b) * G::VBUF + vrow * VSTR + vch * 16) = vreg; } while (0)
    f32x16 o0, o1;
#pragma unroll
    for (int i = 0; i < 16; ++i) { o0[i] = 0.f; o1[i] = 0.f; }
    float mrun = -INFINITY, lsum = 0.f;
    ATT_GLOAD(t_lo);
    ATT_LSTORE(0);
    __syncthreads();
    const int koff = r32 * G::KSTR + hi * 16;
    const int voff = ((lane >> 5) * 4 + ((lane & 15) >> 2)) * VSTR + (((lane >> 4) & 1) * 16 + (lane & 3) * 4) * 2;
    for (int t = t_lo; t <= t_hi; ++t) {
        const int buf = (t - t_lo) & 1;
        if (t < t_hi) ATT_GLOAD(t + 1);
        if (t >= my_lo && t <= my_hi) {
            const ATT_LAS unsigned char* Kt = lds + buf * G::KBUF + koff;
            const ATT_LAS unsigned char* Vt = lds + 2 * G::KBUF + buf * G::VBUF + voff;
            f32x16 s0, s1;
#pragma unroll
            for (int i = 0; i < 16; ++i) { s0[i] = 0.f; s1[i] = 0.f; }
#pragma unroll
            for (int kk = 0; kk < DQK / 16; ++kk) {
                const bf16x8 a0 = *(const ATT_LAS bf16x8*)(Kt + kk * 32);
                const bf16x8 a1 = *(const ATT_LAS bf16x8*)(Kt + 32 * G::KSTR + kk * 32);
                s0 = __builtin_amdgcn_mfma_f32_32x32x16_bf16(a0, qf[kk], s0, 0, 0, 0);
                s1 = __builtin_amdgcn_mfma_f32_32x32x16_bf16(a1, qf[kk], s1, 0, 0, 0);
            }
            if (BAND) {
                const int delta = cc - t;
                if (delta >= 3) { const float bf = biasL[256];
#pragma unroll
                    for (int i = 0; i < 16; ++i) { s0[i] += bf; s1[i] += bf; } }
                else { const int relb = 64 * delta + (32 * (wid & 1) + r32) - 4 * hi + 128;
#pragma unroll
                    for (int i = 0; i < 16; ++i) { const int kj = (i & 3) + 8 * (i >> 2);
                        int i0 = relb - kj, i1 = relb - kj - 32; i0 = i0 < 0 ? 0 : (i0 > 256 ? 256 : i0); i1 = i1 < 0 ? 0 : (i1 > 256 ? 256 : i1);
                        s0[i] += biasL[i0]; s1[i] += biasL[i1]; } }
            }
            const float mt = rowmax32(s0, s1);
            const float mnew = fmaxf(mrun, mt);
            const float alpha = __builtin_amdgcn_exp2f(mrun - mnew);
            mrun = mnew;
            float ps = 0.f;
#pragma unroll
            for (int i = 0; i < 16; ++i) { s0[i] = __builtin_amdgcn_exp2f(s0[i] - mnew); s1[i] = __builtin_amdgcn_exp2f(s1[i] - mnew); ps += s0[i] + s1[i]; }
            lsum = lsum * alpha + ps;
#pragma unroll
            for (int i = 0; i < 16; ++i) { o0[i] *= alpha; o1[i] *= alpha; }
            bf16x8 pf[2][2];
#pragma unroll
            for (int s = 0; s < 2; ++s) {
                u32x4 w0, w1;
                w0.x = cvtpk(s0[8 * s + 0], s0[8 * s + 1]); w0.y = cvtpk(s0[8 * s + 2], s0[8 * s + 3]); w0.z = cvtpk(s0[8 * s + 4], s0[8 * s + 5]); w0.w = cvtpk(s0[8 * s + 6], s0[8 * s + 7]);
                w1.x = cvtpk(s1[8 * s + 0], s1[8 * s + 1]); w1.y = cvtpk(s1[8 * s + 2], s1[8 * s + 3]); w1.z = cvtpk(s1[8 * s + 4], s1[8 * s + 5]); w1.w = cvtpk(s1[8 * s + 6], s1[8 * s + 7]);
                pf[0][s] = __builtin_bit_cast(bf16x8, w0); pf[1][s] = __builtin_bit_cast(bf16x8, w1);
            }
#pragma unroll
            for (int kb = 0; kb < 2; ++kb)
#pragma unroll
                for (int s = 0; s < 2; ++s) {
                    const ATT_LAS unsigned char* vp = Vt + (32 * kb + 16 * s) * VSTR;
                    const s16x4 l0 = vtr(vp), h0 = vtr(vp + 8 * VSTR), l1 = vtr(vp + 64), h1 = vtr(vp + 8 * VSTR + 64);
                    const bf16x8 a0 = (bf16x8){l0[0], l0[1], l0[2], l0[3], h0[0], h0[1], h0[2], h0[3]};
                    const bf16x8 a1 = (bf16x8){l1[0], l1[1], l1[2], l1[3], h1[0], h1[1], h1[2], h1[3]};
                    o0 = __builtin_amdgcn_mfma_f32_32x32x16_bf16(a0, pf[kb][s], o0, 0, 0, 0);
                    o1 = __builtin_amdgcn_mfma_f32_32x32x16_bf16(a1, pf[kb][s], o1, 0, 0, 0);
                }
        }
        if (t < t_hi) ATT_LSTORE(buf ^ 1);
        __syncthreads();
    }
    const float ltot = lsum + __shfl_xor(lsum, 32);
    const float inv = 1.f / ltot;
    bf16* op = Ob + (size_t)(q0 + wid * 32 + r32) * opitch + 4 * hi;
#pragma unroll
    for (int g4 = 0; g4 < 4; ++g4) {
        u32x2 w0, w1;
        w0.x = cvtpk(o0[4 * g4 + 0] * inv, o0[4 * g4 + 1] * inv); w0.y = cvtpk(o0[4 * g4 + 2] * inv, o0[4 * g4 + 3] * inv);
        w1.x = cvtpk(o1[4 * g4 + 0] * inv, o1[4 * g4 + 1] * inv); w1.y = cvtpk(o1[4 * g4 + 2] * inv, o1[4 * g4 + 3] * inv);
        *(u32x2*)(op + 8 * g4) = w0; *(u32x2*)(op + 32 + 8 * g4) = w1;
    }
#undef ATT_GLOAD
#undef ATT_LSTORE
}
}
constexpr int NWAVES = 8;
constexpr int D = 1024, BATCH = 32, SEQ = 2048, M = BATCH * SEQ;
constexpr int NH = 16, QLORA = 384, KVLORA = 256, ROPE_D = 32, NOPE = 64, QKD = 96;
constexpr int NA = 768;
constexpr int FF = 2816, EFF = 3584, NE = 8;
constexpr float EPS = 1e-6f, LOG2E = 1.4426950408889634f;
constexpr int MAXP_HALF = 264, MAXP = 528;
constexpr size_t MiB = 1u << 20;
constexpr size_t WS_CTL = 0, CTL_ZERO_BYTES = 1 * MiB;
constexpr size_t WS_ROPE = 1 * MiB;
constexpr size_t WS_CNT = WS_ROPE + 256 * 1024;
constexpr size_t WS_PANELE = WS_CNT + 16 * 1024;
constexpr size_t WS_META = WS_PANELE + 4096;
constexpr size_t WS_TOKE = 2 * MiB;
constexpr size_t WS_TOKG = WS_TOKE + (size_t)M * 4;
constexpr size_t WS_SLOTTOK = WS_TOKG + (size_t)M * 8;
constexpr size_t WS_SLOTGATE = WS_SLOTTOK + (size_t)MAXP * 256 * 4;
constexpr size_t WS_PARTQA = 976 * MiB, WS_PART1 = 980 * MiB, WS_PART2 = 984 * MiB;
constexpr size_t WS_TOKRSTD = 4 * MiB;
constexpr size_t WS_SLOTRSTD = WS_TOKRSTD + (size_t)M * 4;
static_assert(WS_SLOTGATE + (size_t)MAXP * 256 * 4 <= WS_TOKRSTD && WS_SLOTRSTD + (size_t)MAXP * 256 * 4 <= 8 * MiB, "small arrays");
constexpr size_t WS_W = 8 * MiB;
constexpr size_t WS_WA = WS_W, WS_WUQ = WS_WA + (size_t)NA * D * 2, WS_WUKV = WS_WUQ + (size_t)1536 * QLORA * 2, WS_WO = WS_WUKV + (size_t)2048 * KVLORA * 2;
constexpr size_t WS_WF1 = WS_WO + (size_t)D * D * 2, WS_WF2 = WS_WF1 + (size_t)2 * FF * D * 2, WS_WKVQ = WS_WF2 + (size_t)D * FF * 2, WS_WBO = WS_WKVQ + (size_t)3 * D * D * 2;
constexpr size_t WS_WM1 = WS_WBO + (size_t)D * D * 2, WS_WM2 = WS_WM1 + (size_t)NE * 2 * EFF * D * 2, WS_WEND = WS_WM2 + (size_t)NE * D * EFF * 2;
constexpr size_t ARENA = 208 * MiB;
static_assert(WS_WEND <= ARENA, "weights fit under the arena");
constexpr size_t WS_XN = ARENA;
constexpr size_t WS_QA = ARENA + 128 * MiB;
constexpr size_t WS_Q = ARENA + 224 * MiB;
constexpr size_t WS_K = ARENA + 416 * MiB;
constexpr size_t WS_V = ARENA + 608 * MiB;
constexpr size_t WS_O = ARENA;
static_assert(WS_V + (size_t)M * D * 2 <= 1024 * MiB, "MLA arena");
constexpr size_t WS_XR1 = ARENA + 128 * MiB;
constexpr size_t WS_H = ARENA + 256 * MiB;
constexpr size_t WS_XR2 = ARENA;
constexpr size_t WS_KVQ2 = ARENA + 128 * MiB;
constexpr size_t WS_O2 = ARENA + 512 * MiB;
constexpr size_t WS_XR3 = ARENA + 640 * MiB;
constexpr size_t WS_XG = ARENA;
constexpr size_t WS_HM = ARENA + 264 * MiB;
constexpr size_t WS_END = WS_HM + (size_t)MAXP_HALF * 256 * EFF * 2;
static_assert(WS_XG + (size_t)MAXP * 256 * D * 2 <= WS_HM && WS_END <= 1024 * MiB && WS_XR3 + (size_t)M * D * 2 <= 1024 * MiB && WS_H + (size_t)M * FF * 2 <= 1024 * MiB, "arena");
constexpr int CW_BAR = 4096;
constexpr int RING_OFF = 0, RING_BYTES = 131072;
constexpr int LDSCTL_OFF = RING_BYTES, MISC_OFF = LDSCTL_OFF + 320;
constexpr int LDS_BYTES = 147456;
static_assert(MISC_OFF + 128 <= LDS_BYTES, "LDS map");
static_assert(att::lds_bytes<96>() <= RING_BYTES, "attention scratch fits the ring region");

#define GAS __attribute__((address_space(1)))
#define LAS __attribute__((address_space(3)))
typedef unsigned short bf16;
typedef unsigned v4u __attribute__((ext_vector_type(4)));
typedef unsigned v2u __attribute__((ext_vector_type(2)));
typedef float f32x4 __attribute__((ext_vector_type(4)));
typedef GAS unsigned gu32;
#define RLX_AGENT __ATOMIC_RELAXED, __HIP_MEMORY_SCOPE_AGENT
#define LDS_WAIT() asm volatile("s_waitcnt lgkmcnt(0)" ::: "memory")
__device__ __forceinline__ unsigned f2bf(float f) { unsigned u = __builtin_bit_cast(unsigned, f); return (u + 0x7fffu + ((u >> 16) & 1u)) >> 16; }
__device__ __forceinline__ unsigned pk2(float lo, float hi) { return f2bf(lo) | (f2bf(hi) << 16); }
__device__ __forceinline__ float bflo(unsigned u) { return __builtin_bit_cast(float, u << 16); }
__device__ __forceinline__ float bfhi(unsigned u) { return __builtin_bit_cast(float, u & 0xffff0000u); }
__device__ __forceinline__ float wave_sum(float v) {
#pragma unroll
    for (int o = 1; o < 64; o <<= 1) v += __shfl_xor(v, o);
    return v;
}

#define XB_TMO      128
#define XB_XCNT(j)  (256  + 64 * (j))
#define XB_XSUB(j)  (1280 + 64 * (j))
#define XB_XGEN(j)  (2304 + 64 * (j))
#define XB_TOP      3328
#define XB_TOPGEN   3392
#define XCD_BAR_WORDS 3456
#define XB_SPIN_CAP (1u << 18)

__device__ __forceinline__ unsigned xb_ld(unsigned* p)              { return __hip_atomic_load(p, __ATOMIC_RELAXED, __HIP_MEMORY_SCOPE_AGENT); }
__device__ __forceinline__ unsigned xb_add(unsigned* p, unsigned v) { return __hip_atomic_fetch_add(p, v, __ATOMIC_RELAXED, __HIP_MEMORY_SCOPE_AGENT); }
__device__ __forceinline__ unsigned xb_xcc_id() { return (unsigned)__builtin_amdgcn_s_getreg((3 << 11) | 20) & 0xFu; }
#define XB_SPIN(cond, bar) do { unsigned _sp = 0; while (cond) { __builtin_amdgcn_s_sleep(1); \
    if ((++_sp & 255u) == 0u) { if (xb_ld(&(bar)[XB_TMO])) break; if (_sp > XB_SPIN_CAP) { atomicAdd(&(bar)[XB_TMO], 1u); break; } } } } while (0)

struct XcdBarrier {
    unsigned* bar; unsigned x;
    volatile LAS unsigned* st;
};

__device__ __forceinline__ XcdBarrier xcd_barrier_post(unsigned* bar, volatile LAS unsigned* st) {
    XcdBarrier b; b.bar = bar; b.x = xb_xcc_id(); b.st = st;
    if (threadIdx.x == 0) (void)xb_add(&bar[XB_XCNT(b.x)], 1u);
    return b;
}
__device__ __forceinline__ void xcd_barrier_complete(unsigned* bar, unsigned x, unsigned& nloc, unsigned& nx) {
    const unsigned G = gridDim.x * gridDim.y * gridDim.z;
    unsigned sum, cnt, mine, sp = 0u;
    for (;;) {
        sum = 0u; cnt = 0u; mine = 0u;
#pragma unroll
        for (unsigned j = 0; j < 16; ++j) { const unsigned c = xb_ld(&bar[XB_XCNT(j)]); sum += c; cnt += (c > 0u) ? 1u : 0u; mine = (j == x) ? c : mine; }
        if (sum == G) break;
        __builtin_amdgcn_s_sleep(1);
        if ((++sp & 255u) == 0u) { if (xb_ld(&bar[XB_TMO])) break; if (sp > XB_SPIN_CAP) { atomicAdd(&bar[XB_TMO], 1u); break; } }
    }
    nloc = mine > 0u ? mine : 1u; nx = cnt > 0u ? cnt : 1u;
}

__device__ __forceinline__ void xcd_barrier(const XcdBarrier& b) {
    asm volatile("s_waitcnt vmcnt(0)" ::: "memory");
    __syncthreads();
    if (threadIdx.x == 0) {
        unsigned* bar = b.bar;
        __builtin_amdgcn_s_waitcnt(0);
        unsigned nloc = b.st[0], nx = b.st[1];
        if (nloc == 0u) { xcd_barrier_complete(bar, b.x, nloc, nx); b.st[0] = nloc; b.st[1] = nx; }
        const unsigned old = xb_add(&bar[XB_XSUB(b.x)], 1u);
        const unsigned gen = old / nloc;
        if (old + 1u == (gen + 1u) * nloc) {
            __builtin_amdgcn_fence(__ATOMIC_RELEASE, "agent");
            asm volatile("s_waitcnt vmcnt(0)" ::: "memory");
            const unsigned og = xb_add(&bar[XB_TOP], 1u);
            const unsigned tg = og / nx;
            if (og + 1u == (tg + 1u) * nx) xb_add(&bar[XB_TOPGEN], 1u);
            else XB_SPIN(xb_ld(&bar[XB_TOPGEN]) == tg, bar);
            __builtin_amdgcn_fence(__ATOMIC_ACQUIRE, "agent");
            xb_add(&bar[XB_XGEN(b.x)], 1u);
            asm volatile("s_waitcnt vmcnt(0)" ::: "memory");
        } else {
            XB_SPIN(xb_ld(&bar[XB_XGEN(b.x)]) == gen, bar);
            __builtin_amdgcn_fence(__ATOMIC_ACQUIRE, "agent");
            asm volatile("s_waitcnt vmcnt(0)" ::: "memory");
        }
    }
    __syncthreads();
}

struct Args { const float* in[27]; float* out; unsigned char* ws; };
enum { I_X = 0, I_ATTN_NORM, I_FFN_NORM, I_A_WDQ, I_A_GCQ, I_A_WUQ, I_A_WDKV, I_A_GCKV, I_A_WUKV, I_A_GQN, I_A_GKN, I_A_WO, I_KV_NORM, I_KV_WK, I_KV_WV, I_KV_GKN,
       I_B_WQ, I_B_GQN, I_B_RELB, I_B_WO, I_FFN_W1, I_FFN_W3, I_FFN_W2, I_MOE_ROUTER, I_MOE_W1, I_MOE_W3, I_MOE_W2 };

struct Frame {
    LAS unsigned char* lds;
    int wave, vcu, G;
};
typedef const __attribute__((address_space(4))) Args* KArgs;
__device__ __forceinline__ KArgs kargs() { KArgs p = (KArgs)__builtin_amdgcn_kernarg_segment_ptr(); asm volatile("" : "+s"(p)); return p; }
#define INP(i) (kargs()->in[i])
#define OUTP (kargs()->out)
#define WSP (kargs()->ws)
__device__ __forceinline__ int fresh(int v) { asm volatile("" : "+v"(v)); return v; }

__device__ __forceinline__ void tr_item(const float* W, int ldw, int K, int k0, int nsrc0, const float* gain, bf16* WT, int drow0, LAS float* scr, int lane) {
#pragma unroll 8
    for (int i = 0; i < 32; ++i) { const int kk = 2 * i + (lane >> 5); float v = W[(size_t)(k0 + kk) * ldw + nsrc0 + (lane & 31)]; if (gain) v *= gain[k0 + kk]; scr[kk * 33 + (lane & 31)] = v; }
    LDS_WAIT(); asm volatile("" ::: "memory");
    const int c = lane & 7;
#pragma unroll
    for (int j = 0; j < 4; ++j) { const int n = (lane >> 3) + 8 * j; const LAS float* s = scr + (8 * c) * 33 + n;
        v4u o; o.x = pk2(s[0 * 33], s[1 * 33]); o.y = pk2(s[2 * 33], s[3 * 33]); o.z = pk2(s[4 * 33], s[5 * 33]); o.w = pk2(s[6 * 33], s[7 * 33]);
        *(GAS v4u*)(WT + (size_t)(drow0 + n) * K + k0 + 8 * c) = o; }
    LDS_WAIT(); asm volatile("" ::: "memory");
}
__device__ __forceinline__ void tr_plain(const float* W, int K, int N, const float* gain, bf16* WT, int drow_off, LAS float* scr, int item, int lane) {
    const int nblk = N / 32, kb = item / nblk, nb = item % nblk;
    tr_item(W, N, K, 64 * kb, 32 * nb, gain, WT, drow_off + 32 * nb, scr, lane);
}
__device__ __forceinline__ void tr_gated(const float* W, int K, int N, const float* gain, bf16* WT, int half, LAS float* scr, int item, int lane) {
    const int nblk = N / 32, kb = item / nblk, nb = item % nblk, n0 = 32 * nb;
    tr_item(W, N, K, 64 * kb, n0, gain, WT, (n0 >> 7) * 256 + half * 128 + (n0 & 127), scr, lane);
}
__device__ __forceinline__ float rms_row_to_bf16(const float* xrow, bf16* orow, int lane, f32x4 (&v)[4]) {
    const GAS f32x4* xr = (const GAS f32x4*)xrow + lane;
    float s = 0.f;
#pragma unroll
    for (int j = 0; j < 4; ++j) { v[j] = xr[64 * j]; s += (v[j].x * v[j].x + v[j].y * v[j].y) + (v[j].z * v[j].z + v[j].w * v[j].w); }
    const float rstd = 1.f / sqrtf(wave_sum(s) * (1.f / D) + EPS);
    GAS unsigned long long* o8 = (GAS unsigned long long*)orow + lane;
#pragma unroll
    for (int j = 0; j < 4; ++j) o8[64 * j] = (unsigned long long)pk2(v[j].x * rstd, v[j].y * rstd) | ((unsigned long long)pk2(v[j].z * rstd, v[j].w * rstd) << 32);
    return rstd;
}
__device__ __forceinline__ void norm_phase(const Frame& F, const float* x, bf16* xn) {
    const int tid = fresh((int)threadIdx.x), lane = tid & 63; (void)lane;
    const int gw = F.vcu * NWAVES + F.wave, NGW = F.G * NWAVES;
    for (int m = gw; m < M; m += NGW) { f32x4 v[4]; (void)rms_row_to_bf16(x + (size_t)m * D, xn + (size_t)m * D, lane, v); }
}

__device__ __forceinline__ void p0_prologue(const Frame& F) {
    const int tid = fresh((int)threadIdx.x), lane = tid & 63; (void)lane;
    LAS float* scr = (LAS float*)(F.lds + RING_OFF + F.wave * 16384);
    unsigned char* ws = WSP;
    const int gw = F.vcu * NWAVES + F.wave, NGW = F.G * NWAVES;
    constexpr int I_DQ = 16 * 12, I_DKV = 16 * 9, I_UQ = 6 * 48, I_UKV = 4 * 64, I_SQ = 16 * 32, I_F13 = 16 * 88, I_F2 = 44 * 32, I_M13 = 16 * 112, I_M2 = 56 * 32;
    constexpr int NSMALL = I_DQ + I_DKV + I_UQ + I_UKV + I_SQ + 2 * I_F13 + I_F2 + 4 * I_SQ;
    constexpr int NITEMS = NSMALL + NE * (2 * I_M13 + I_M2);
    for (int it = gw; it < NITEMS; it += NGW) {
        int r = it;
        if (r < I_DQ)  { tr_plain(INP(I_A_WDQ), D, QLORA, INP(I_ATTN_NORM), (bf16*)(ws + WS_WA), 0, scr, r, lane); continue; } r -= I_DQ;
        if (r < I_DKV) { tr_plain(INP(I_A_WDKV), D, KVLORA + ROPE_D, INP(I_ATTN_NORM), (bf16*)(ws + WS_WA), QLORA, scr, r, lane); continue; } r -= I_DKV;
        if (r < I_UQ)  { tr_plain(INP(I_A_WUQ), QLORA, NH * QKD, INP(I_A_GCQ), (bf16*)(ws + WS_WUQ), 0, scr, r, lane); continue; } r -= I_UQ;
        if (r < I_UKV) { const int kb = r / 64, n0 = 32 * (r % 64), head = n0 >> 7, within = n0 & 127;
            const int drow = within < 64 ? 256 * (head >> 2) + 128 * (within >> 5) + 32 * (head & 3) : 1024 + head * 64 + (within - 64);
            tr_item(INP(I_A_WUKV), NH * 128, KVLORA, 64 * kb, n0, INP(I_A_GCKV), (bf16*)(ws + WS_WUKV), drow, scr, lane); continue; } r -= I_UKV;
        if (r < I_SQ)  { tr_plain(INP(I_A_WO), D, D, nullptr, (bf16*)(ws + WS_WO), 0, scr, r, lane); continue; } r -= I_SQ;
        if (r < I_F13) { tr_gated(INP(I_FFN_W1), D, FF, INP(I_FFN_NORM), (bf16*)(ws + WS_WF1), 0, scr, r, lane); continue; } r -= I_F13;
        if (r < I_F13) { tr_gated(INP(I_FFN_W3), D, FF, INP(I_FFN_NORM), (bf16*)(ws + WS_WF1), 1, scr, r, lane); continue; } r -= I_F13;
        if (r < I_F2)  { tr_plain(INP(I_FFN_W2), FF, D, nullptr, (bf16*)(ws + WS_WF2), 0, scr, r, lane); continue; } r -= I_F2;
        if (r < I_SQ)  { const int kb = r / 32, n0 = 32 * (r % 32), head = n0 >> 6;
            tr_item(INP(I_KV_WK), D, D, 64 * kb, n0, INP(I_KV_NORM), (bf16*)(ws + WS_WKVQ), 256 * (head >> 2) + 128 * ((n0 >> 5) & 1) + 32 * (head & 3), scr, lane); continue; } r -= I_SQ;
        if (r < I_SQ)  { tr_plain(INP(I_KV_WV), D, D, INP(I_KV_NORM), (bf16*)(ws + WS_WKVQ), D, scr, r, lane); continue; } r -= I_SQ;
        if (r < I_SQ)  { const int kb = r / 32, n0 = 32 * (r % 32), head = n0 >> 6;
            tr_item(INP(I_B_WQ), D, D, 64 * kb, n0, INP(I_ATTN_NORM) + D, (bf16*)(ws + WS_WKVQ), 2 * D + 256 * (head >> 2) + 128 * ((n0 >> 5) & 1) + 32 * (head & 3), scr, lane); continue; } r -= I_SQ;
        if (r < I_SQ)  { tr_plain(INP(I_B_WO), D, D, nullptr, (bf16*)(ws + WS_WBO), 0, scr, r, lane); continue; } r -= I_SQ;
        const int e = r / (2 * I_M13 + I_M2); r -= e * (2 * I_M13 + I_M2);
        if (r < I_M13) { tr_gated(INP(I_MOE_W1) + (size_t)e * D * EFF, D, EFF, INP(I_FFN_NORM) + D, (bf16*)(ws + WS_WM1) + (size_t)e * 2 * EFF * D, 0, scr, r, lane); continue; } r -= I_M13;
        if (r < I_M13) { tr_gated(INP(I_MOE_W3) + (size_t)e * D * EFF, D, EFF, INP(I_FFN_NORM) + D, (bf16*)(ws + WS_WM1) + (size_t)e * 2 * EFF * D, 1, scr, r, lane); continue; } r -= I_M13;
        tr_plain(INP(I_MOE_W2) + (size_t)e * EFF * D, EFF, D, nullptr, (bf16*)(ws + WS_WM2) + (size_t)e * D * EFF, 0, scr, r, lane);
    }
    const int gt = F.vcu * (NWAVES * 64) + tid, NGT = F.G * NWAVES * 64;
    for (int c = gt; c < 96 * D * 2 / 16; c += NGT) *((GAS v4u*)(ws + WS_WA + (size_t)(QLORA + KVLORA + ROPE_D) * D * 2) + c) = (v4u){0u, 0u, 0u, 0u};
    for (int c = gt; c < SEQ * 16; c += NGT) { const int pos = c >> 4, i = c & 15;
        const float inv = __builtin_amdgcn_exp2f(-(float)i * (13.287712379549449f / 16.f));
        const float rev = (float)pos * inv * 0.15915494309189535f; const float fr = rev - floorf(rev);
        ((GAS float*)(ws + WS_ROPE))[2 * c] = __builtin_amdgcn_cosf(fr); ((GAS float*)(ws + WS_ROPE))[2 * c + 1] = __builtin_amdgcn_sinf(fr); }
    norm_phase(F, INP(I_X), (bf16*)(ws + WS_XN));
}

__device__ __forceinline__ void route_phase(const Frame& F) {
    const int tid = fresh((int)threadIdx.x), lane = tid & 63; (void)lane;
    unsigned char* ws = WSP;
    LAS float* wrg = (LAS float*)(F.lds + RING_OFF);
    LAS int* cnt = (LAS int*)(F.lds + RING_OFF + 32768);
    const float* wr = INP(I_MOE_ROUTER); const float* g = INP(I_FFN_NORM) + D;
    for (int idx = tid; idx < D * NE; idx += NWAVES * 64) wrg[idx] = wr[idx] * g[idx >> 3];
    __syncthreads();
    for (int c = F.vcu; c < M / 256; c += F.G) {
        if (tid < 16) cnt[tid] = 0;
        __syncthreads();
        for (int i = 0; i < 32; ++i) {
            const int m = c * 256 + F.wave * 32 + i;
            f32x4 v[4]; float ssx = 0.f;
            { const GAS f32x4* xr = (const GAS f32x4*)(OUTP + (size_t)m * D) + lane;
#pragma unroll
              for (int j = 0; j < 4; ++j) { v[j] = xr[64 * j]; ssx += (v[j].x * v[j].x + v[j].y * v[j].y) + (v[j].z * v[j].z + v[j].w * v[j].w); } }
            const float rstd = 1.f / sqrtf(wave_sum(ssx) * (1.f / D) + EPS);
            float lg[8];
#pragma unroll
            for (int e = 0; e < 8; ++e) lg[e] = 0.f;
#pragma unroll
            for (int j = 0; j < 4; ++j)
#pragma unroll
                for (int q = 0; q < 4; ++q) { const int k = 256 * j + 4 * lane + q; const float xv = v[j][q];
                    const f32x4 w0 = *(const LAS f32x4*)(wrg + k * 8), w1 = *(const LAS f32x4*)(wrg + k * 8 + 4);
                    lg[0] += xv * w0.x; lg[1] += xv * w0.y; lg[2] += xv * w0.z; lg[3] += xv * w0.w; lg[4] += xv * w1.x; lg[5] += xv * w1.y; lg[6] += xv * w1.z; lg[7] += xv * w1.w; }
#pragma unroll
            for (int e = 0; e < 8; ++e) lg[e] = wave_sum(lg[e]) * rstd;
            int e1 = 0; float l1 = lg[0];
#pragma unroll
            for (int e = 1; e < 8; ++e) if (lg[e] > l1) { l1 = lg[e]; e1 = e; }
            int e2 = -1; float l2 = -INFINITY;
#pragma unroll
            for (int e = 0; e < 8; ++e) if (e != e1 && lg[e] > l2) { l2 = lg[e]; e2 = e; }
            const float g1 = 1.f / (1.f + __expf(l2 - l1)), g2 = 1.f - g1;
            const int elo = e1 < e2 ? e1 : e2, ehi = e1 < e2 ? e2 : e1;
            const float glo = e1 < e2 ? g1 : g2, ghi = e1 < e2 ? g2 : g1;
            if (lane == 0) { ((GAS float*)(ws + WS_TOKRSTD))[m] = rstd; ((GAS int*)(ws + WS_TOKE))[m] = elo | (ehi << 8); ((GAS float*)(ws + WS_TOKG))[2 * m] = glo; ((GAS float*)(ws + WS_TOKG))[2 * m + 1] = ghi;
                atomicAdd((int*)&cnt[elo], 1); atomicAdd((int*)&cnt[8 + ehi], 1); }
        }
        __syncthreads();
        if (tid < 16) ((GAS int*)(ws + WS_CNT))[c * 16 + tid] = cnt[tid];
        __syncthreads();
    }
}

__device__ __forceinline__ void slot_phase(const Frame& F, unsigned char* ws) {
    const int tid = fresh((int)threadIdx.x), lane = tid & 63; (void)lane;
    LAS int* call = (LAS int*)(F.lds + RING_OFF);
    LAS int* tot = call + 4096; LAS int* base = tot + 16; LAS int* pre = base + 16; LAS int* meta = pre + 16;
    LAS int* grp = meta + 16;
    LAS int* slot_of = grp + 512;
    for (int idx = tid; idx < 4096; idx += NWAVES * 64) call[idx] = ((const GAS int*)(ws + WS_CNT))[idx];
    __syncthreads();
    if (tid < 16) { int t = 0; for (int cc = 0; cc < 256; ++cc) t += call[cc * 16 + tid]; tot[tid] = t; }
    __syncthreads();
    if (tid == 0) { int off = 0; for (int g = 0; g < 16; ++g) { base[g] = off; off += (tot[g] + 255) & ~255; if (g == 7) meta[0] = off >> 8; } meta[1] = (off >> 8) - meta[0]; }
    __syncthreads();
    for (int c = F.vcu; c < M / 256; c += F.G) {
        if (tid < 16) { int p = 0; for (int cc = 0; cc < c; ++cc) p += call[cc * 16 + tid]; pre[tid] = p; }
        const int hf = tid >> 8, i = tid & 255, m = c * 256 + i;
        const int te = ((const GAS int*)(ws + WS_TOKE))[m];
        const int g = hf * 8 + (hf ? ((te >> 8) & 0xff) : (te & 0xff));
        grp[tid] = g;
        __syncthreads();
        int rank = 0;
        for (int j = 0; j < i; ++j) rank += (grp[hf * 256 + j] == g) ? 1 : 0;
        const int slot = base[g] + pre[g] + rank;
        ((GAS int*)(ws + WS_SLOTTOK))[slot] = m; ((GAS float*)(ws + WS_SLOTGATE))[slot] = ((const GAS float*)(ws + WS_TOKG))[2 * m + hf];
        ((GAS float*)(ws + WS_SLOTRSTD))[slot] = ((const GAS float*)(ws + WS_TOKRSTD))[m];
        slot_of[tid] = slot;
        __syncthreads();
        for (int p = F.wave; p < 512; p += NWAVES) { const int mm = c * 256 + (p & 255), sl = slot_of[p];
            const GAS v4u* src = (const GAS v4u*)(ws + WS_XR3 + (size_t)mm * D * 2); GAS v4u* dst = (GAS v4u*)(ws + WS_XG + (size_t)sl * D * 2);
            const v4u x0 = src[lane], x1 = src[lane + 64]; dst[lane] = x0; dst[lane + 64] = x1; }
        __syncthreads();
    }
    for (int g = F.vcu; g < 16; g += F.G) {
        const int s0 = base[g] + tot[g], s1 = base[g] + ((tot[g] + 255) & ~255);
        for (int s = s0 + F.wave; s < s1; s += NWAVES) { GAS v4u* dst = (GAS v4u*)(ws + WS_XG + (size_t)s * D * 2);
            dst[lane] = (v4u){0u, 0u, 0u, 0u}; dst[lane + 64] = (v4u){0u, 0u, 0u, 0u};
            if (lane == 0) { ((GAS int*)(ws + WS_SLOTTOK))[s] = -1; ((GAS float*)(ws + WS_SLOTGATE))[s] = 0.f; ((GAS float*)(ws + WS_SLOTRSTD))[s] = 0.f; } }
    }
    if (F.vcu == 0) {
        if (tid < 16) { const int p0 = base[tid] >> 8, p1 = (base[tid] + ((tot[tid] + 255) & ~255)) >> 8; for (int p = p0; p < p1; ++p) ((GAS int*)(ws + WS_PANELE))[p] = tid & 7; }
        if (tid == 0) { ((GAS int*)(ws + WS_META))[0] = meta[0]; ((GAS int*)(ws + WS_META))[1] = meta[1]; }
    }
    __syncthreads();
}

__global__ void __launch_bounds__(NWAVES * 64, 2) yoco_fwd(Args args) {
    extern __shared__ __attribute__((aligned(16))) unsigned char lds_raw[];
    Frame F;
    F.lds = (LAS unsigned char*)lds_raw;
    F.wave = __builtin_amdgcn_readfirstlane((int)threadIdx.x >> 6);
    F.G = gridDim.x; { const int bx = blockIdx.x; F.vcu = (F.G % 8 == 0) ? (bx % 8) * (F.G / 8) + bx / 8 : bx; }
    unsigned char* ws = WSP;
    volatile LAS unsigned* MISC = (volatile LAS unsigned*)(F.lds + MISC_OFF);
    for (int u = fresh((int)threadIdx.x); u < (LDS_BYTES - LDSCTL_OFF) / 4; u += NWAVES * 64) ((LAS unsigned*)(F.lds + LDSCTL_OFF))[u] = 0u;
    __syncthreads();
    XcdBarrier bar = xcd_barrier_post((unsigned*)(ws + WS_CTL) + CW_BAR, MISC + 8);
    LAS unsigned char* ring = F.lds + RING_OFF;
    const int bid = (int)blockIdx.x;
#define GRID_BAR() xcd_barrier(bar)
#define GEMM(EpiT, SchedT) pg8::gemm_phase<EpiT, SchedT, true, true>

    p0_prologue(F);
    GRID_BAR();
    { pg8::Gemm g{(const bf16*)(ws + WS_XN), (const bf16*)(ws + WS_WA), M, NA, D, D}; pg8::StaticOrder S; S.init(M, NA, F.G, bid);
      pg8::EpiQA E{(bf16*)(ws + WS_QA), (float*)(ws + WS_PARTQA)};
      GEMM(pg8::EpiQA, pg8::StaticOrder)(ring, g, S, E); }
    GRID_BAR();
    { pg8::Gemm g{(const bf16*)(ws + WS_QA), (const bf16*)(ws + WS_WUQ), M, NH * QKD, QLORA, NA}; pg8::StaticOrder S; S.init(M, NH * QKD, F.G, bid);
      pg8::EpiRowScaleBf16 E{(bf16*)(ws + WS_Q), NH * QKD, (const float*)(ws + WS_PARTQA), 1.f / QLORA};
      GEMM(pg8::EpiRowScaleBf16, pg8::StaticOrder)(ring, g, S, E); }
    { pg8::Gemm g{(const bf16*)(ws + WS_QA) + QLORA, (const bf16*)(ws + WS_WUKV), M, NH * 128, KVLORA, NA}; pg8::StaticOrder S; S.init(M, NH * 128, F.G, bid);
      pg8::EpiKVup E{(bf16*)(ws + WS_K), (bf16*)(ws + WS_V), (const float*)(ws + WS_PARTQA), (const bf16*)(ws + WS_QA), INP(I_A_GKN), (const float*)(ws + WS_ROPE)};
      GEMM(pg8::EpiKVup, pg8::StaticOrder)(ring, g, S, E); }
    GRID_BAR();
    for (int p = F.vcu; p < BATCH * NH * 4; p += F.G) {
        const int bh = p >> 2, pid = p & 3, b = bh >> 4, h = bh & 15;
        for (int u2 = 0; u2 < 2; ++u2) {
            const int qb = u2 ? 7 - pid : pid;
            att::attn_unit<96, false>(ring, (const bf16*)(ws + WS_Q) + (size_t)b * SEQ * 1536 + h * QKD, 1536, (const bf16*)(ws + WS_K) + (size_t)b * SEQ * 1536 + h * QKD, 1536,
                                      (const bf16*)(ws + WS_V) + (size_t)b * SEQ * D + h * 64, D, (bf16*)(ws + WS_O) + (size_t)b * SEQ * D + h * 64, D,
                                      256 * qb, 0, 4 * qb + 3, 0, 4 * qb + (F.wave >> 1), 0, nullptr, INP(I_A_GQN), (const float*)(ws + WS_ROPE));
        }
    }
    GRID_BAR();
    { pg8::Gemm g{(const bf16*)(ws + WS_O), (const bf16*)(ws + WS_WO), M, D, D, D}; pg8::StaticOrder S; S.init(M, D, F.G, bid);
      pg8::EpiResNorm<true> E{INP(I_X), OUTP, (bf16*)(ws + WS_XR1), (float*)(ws + WS_PART1)};
      GEMM(pg8::EpiResNorm<true>, pg8::StaticOrder)(ring, g, S, E); }
    GRID_BAR();
    { pg8::Gemm g{(const bf16*)(ws + WS_XR1), (const bf16*)(ws + WS_WF1), M, 2 * FF, D, D}; pg8::StaticOrder S; S.init(M, 2 * FF, F.G, bid);
      pg8::EpiGated<true> E{(bf16*)(ws + WS_H), FF, 0, (const float*)(ws + WS_PART1)};
      GEMM(pg8::EpiGated<true>, pg8::StaticOrder)(ring, g, S, E); }
    GRID_BAR();
    { pg8::Gemm g{(const bf16*)(ws + WS_H), (const bf16*)(ws + WS_WF2), M, D, FF, FF}; pg8::StaticOrder S; S.init(M, D, F.G, bid);
      pg8::EpiResNorm<true> E{OUTP, OUTP, (bf16*)(ws + WS_XR2), (float*)(ws + WS_PART2)};
      GEMM(pg8::EpiResNorm<true>, pg8::StaticOrder)(ring, g, S, E); }
    GRID_BAR();
    { pg8::Gemm g{(const bf16*)(ws + WS_XR2), (const bf16*)(ws + WS_WKVQ), M, 3 * D, D, D}; pg8::StaticOrder S; S.init(M, 3 * D, F.G, bid);
      pg8::EpiKVQ2 E{(bf16*)(ws + WS_KVQ2), (const float*)(ws + WS_PART2), INP(I_KV_GKN), INP(I_B_GQN)};
      GEMM(pg8::EpiKVQ2, pg8::StaticOrder)(ring, g, S, E); }
    GRID_BAR();
    for (int p = F.vcu; p < BATCH * NH * 8; p += F.G) {
        const int bh = p >> 3, cb = ((p & 7) + (p >> 8)) & 7, b = bh >> 4, h = bh & 15;
        const int c0 = 4 * cb, cc = c0 + (F.wave >> 1);
        const bf16* base = (const bf16*)(ws + WS_KVQ2) + (size_t)b * SEQ * 3072 + h * 64;
        att::attn_unit<64, true>(ring, base + 2048, 3072, base, 3072, base + 1024, 3072, (bf16*)(ws + WS_O2) + (size_t)b * SEQ * D + h * 64, D,
                                 256 * cb, c0 - 8 < 0 ? 0 : c0 - 8, c0 + 3, cc - 8 < 0 ? 0 : cc - 8, cc, cc, INP(I_B_RELB) + h * 257, nullptr, nullptr);
    }
    GRID_BAR();
    { pg8::Gemm g{(const bf16*)(ws + WS_O2), (const bf16*)(ws + WS_WBO), M, D, D, D}; pg8::StaticOrder S; S.init(M, D, F.G, bid);
      pg8::EpiResNorm<false> E{OUTP, OUTP, (bf16*)(ws + WS_XR3), nullptr};
      GEMM(pg8::EpiResNorm<false>, pg8::StaticOrder)(ring, g, S, E); }
    GRID_BAR();
    route_phase(F);
    GRID_BAR();
    slot_phase(F, ws);
    GRID_BAR();
    {
        const int nPA = __builtin_amdgcn_readfirstlane(((const GAS int*)(ws + WS_META))[0]), nPB = __builtin_amdgcn_readfirstlane(((const GAS int*)(ws + WS_META))[1]);
        for (int hf = 0; hf < 2; ++hf) {
            const int nP = hf ? nPB : nPA, p0 = hf ? nPA : 0;
            { pg8::Gemm g{(const bf16*)(ws + WS_XG) + (size_t)p0 * 256 * D, (const bf16*)(ws + WS_WM1), nP * 256, 2 * EFF, D, D};
              pg8::MoeOrder S; S.init(nP, 2 * EFF / 256, F.G, bid, (const int*)(ws + WS_PANELE) + p0);
              pg8::EpiGated<false> E{(bf16*)(ws + WS_HM), EFF, 2 * EFF / 256, (const float*)(ws + WS_SLOTRSTD) + (size_t)p0 * 256};
              GEMM(pg8::EpiGated<false>, pg8::MoeOrder)(ring, g, S, E); }
            GRID_BAR();
            { pg8::Gemm g{(const bf16*)(ws + WS_HM), (const bf16*)(ws + WS_WM2), nP * 256, D, EFF, EFF};
              pg8::MoeOrder S; S.init(nP, D / 256, F.G, bid, (const int*)(ws + WS_PANELE) + p0);
              pg8::EpiMoeDown E{OUTP, (const int*)(ws + WS_SLOTTOK), (const float*)(ws + WS_SLOTGATE), p0 * 256, D};
              GEMM(pg8::EpiMoeDown, pg8::MoeOrder)(ring, g, S, E); }
            if (hf == 0) GRID_BAR();
        }
    }
#undef GRID_BAR
#undef GEMM
}

extern "C" void kernel_launch(void* const* d_in, const int* in_sizes, int n_in, void* d_out, int out_size, void* d_ws, size_t ws_size, hipStream_t stream) {
    static int grid = 0;
    if (grid == 0) {
        if (n_in != 27 || in_sizes[0] != M * D || out_size != M * D || ws_size < WS_END) { fprintf(stderr, "kernel_launch: unexpected shapes (n_in %d, in0 %d, out %d, ws %zu < %zu); nothing launched\n", n_in, n_in > 0 ? in_sizes[0] : -1, out_size, ws_size, (size_t)WS_END); grid = -1; return; }
        int dev = 0, cus = 0, per_cu = 0;
        if (hipGetDevice(&dev) != hipSuccess || hipDeviceGetAttribute(&cus, hipDeviceAttributeMultiprocessorCount, dev) != hipSuccess) { grid = -1; return; }
        if (hipFuncSetAttribute((const void*)yoco_fwd, hipFuncAttributeMaxDynamicSharedMemorySize, LDS_BYTES) != hipSuccess) { fprintf(stderr, "kernel_launch: hipFuncSetAttribute failed\n"); grid = -1; return; }
        if (hipOccupancyMaxActiveBlocksPerMultiprocessor(&per_cu, (const void*)yoco_fwd, NWAVES * 64, LDS_BYTES) != hipSuccess || per_cu < 1) { fprintf(stderr, "kernel_launch: occupancy query says %d\n", per_cu); }
        (void)hipGetLastError();
        grid = cus;
    }
    if (grid < 0) return;
    if (hipMemsetAsync((char*)d_ws + WS_CTL, 0, CTL_ZERO_BYTES, stream) != hipSuccess) return;
    Args a{};
    for (int i = 0; i < 27; ++i) a.in[i] = (const float*)d_in[i];
    a.out = (float*)d_out; a.ws = (unsigned char*)d_ws;
    hipLaunchKernelGGL(yoco_fwd, dim3(grid), dim3(NWAVES * 64), LDS_BYTES, stream, a);
}
```

```cpp
#include <hip/hip_runtime.h>
#include <cstdio>
#include <cstdint>
namespace pg8 {
#define PG8_LAS __attribute__((address_space(3)))
typedef unsigned short bf16_t;
typedef short bf16x8 __attribute__((ext_vector_type(8)));
typedef float f32x4 __attribute__((ext_vector_type(4)));
typedef unsigned u32x4 __attribute__((ext_vector_type(4)));
constexpr int BM = 256, BK = 64, HALF = 128, HTB = HALF * BK * 2  , STAGE_BYTES = 8 * HTB, NXCD = 8, WGM = 8;

__host__ __device__ __forceinline__ int lds_byte(int r, int c) { const int st = (r >> 4) * 2 + (c >> 5), rr = r & 15, cc = c & 31, ob = rr * 64 + cc * 2; return st * 1024 + (ob ^ (((ob >> 9) & 1) << 5)); }
__host__ __device__ __forceinline__ void stage_rc(int b, int& R, int& C) { const int st = b / 1024, sb = b % 1024, swz = sb ^ (((sb >> 9) & 1) << 5); R = (st >> 1) * 16 + swz / 64; C = (st & 1) * 32 + (swz % 64) / 2; }
__host__ __device__ __forceinline__ int perm32(int rho) { const int n = rho >> 4, i = rho & 15; return 8 * (i >> 2) + 4 * n + (i & 3); }

struct Unit { int pm, pn; };
struct Gemm { const bf16_t* A; const bf16_t* Bt; int M, N, K, lda; };

struct StaticOrder {
    int nM, nN, nwg, G, c;
    __host__ __device__ void init(int M, int N, int G_, int c_) { nM = M / BM; nN = N / BM; nwg = nM * nN; G = G_; c = c_; }
    __host__ __device__ bool next(int i, Unit& u) const {
        const long L = (long)i * G + c; if (L >= nwg) return false;
        int wgid = (int)L; { const int q = nwg / NXCD, r = nwg % NXCD, xcd = wgid % NXCD, off = wgid / NXCD; wgid = (xcd < r ? xcd * (q + 1) : r * (q + 1) + (xcd - r) * q) + off; }
        const int nig = WGM * nN, gid = wgid / nig, fm = gid * WGM, gsz = (nM - fm) < WGM ? (nM - fm) : WGM;
        u.pm = fm + ((wgid % nig) % gsz); u.pn = (wgid % nig) / gsz; return true;
    }
    __device__ __forceinline__ void a_ready(const Unit&) const {}
    __device__ __forceinline__ void done(const Unit&) const {}
};
__device__ __forceinline__ unsigned cvt_pk_bf16(float lo, float hi) { unsigned r; asm volatile("v_cvt_pk_bf16_f32 %0, %1, %2" : "=v"(r) : "v"(lo), "v"(hi)); return r; }
__device__ __forceinline__ float silu_f(float x) { const float e = __builtin_amdgcn_exp2f(x * -1.4426950408889634f); return x * __builtin_amdgcn_rcpf(1.f + e); }

__device__ __forceinline__ float sum4(const f32x4& a) { return (a[0] + a[1]) + (a[2] + a[3]); }
__device__ __forceinline__ float part_sum8(const float* p) { return sum4(*(const f32x4*)p) + sum4(*(const f32x4*)(p + 4)); }
__device__ __forceinline__ float part_sum16(const float* p) { return (sum4(*(const f32x4*)p) + sum4(*(const f32x4*)(p + 4))) + (sum4(*(const f32x4*)(p + 8)) + sum4(*(const f32x4*)(p + 12))); }
__device__ __forceinline__ float fq_sum(float v) { v += __shfl_xor(v, 16); v += __shfl_xor(v, 32); return v; }
__device__ __forceinline__ float sq8(const f32x4& a, const f32x4& b) { return ((a[0] * a[0] + a[1] * a[1]) + (a[2] * a[2] + a[3] * a[3])) + ((b[0] * b[0] + b[1] * b[1]) + (b[2] * b[2] + b[3] * b[3])); }
__device__ __forceinline__ u32x4 pack8(const f32x4& a, const f32x4& b) { u32x4 w; w.x = cvt_pk_bf16(a[0], a[1]); w.y = cvt_pk_bf16(a[2], a[3]); w.z = cvt_pk_bf16(b[0], b[1]); w.w = cvt_pk_bf16(b[2], b[3]); return w; }
constexpr float EPS_ = 1e-6f;

struct EpiQA {
    static constexpr bool PERM = true, AFTER_DRAIN = false;
    bf16_t* O; float* part;
    __device__ __forceinline__ void operator()(const f32x4 (&acc)[2][2][4][2], const Unit& u, int wr, int wc, int fr, int fq) const {
        { int t_ = threadIdx.x; asm volatile("" : "+v"(t_)); fr = t_ & 15; fq = (t_ >> 4) & 3; }
        const int row0 = u.pm * BM + wr * 64 + fr, col0 = u.pn * BM + wc * 32 + 8 * fq;
#pragma unroll
        for (int ai = 0; ai < 2; ++ai)
#pragma unroll
            for (int m = 0; m < 4; ++m) { const int row = row0 + ai * HALF + m * 16; bf16_t* rowp = O + (size_t)row * 768 + col0;
                *(u32x4*)(rowp) = pack8(acc[ai][0][m][0], acc[ai][0][m][1]); *(u32x4*)(rowp + HALF) = pack8(acc[ai][1][m][0], acc[ai][1][m][1]);
                const float s0 = sq8(acc[ai][0][m][0], acc[ai][0][m][1]), s1 = sq8(acc[ai][1][m][0], acc[ai][1][m][1]);
                float* pr = part + (size_t)row * 16;
                if (u.pn == 0) { const float t = fq_sum(s0 + s1); if (fq == 0) pr[wc] = t; }
                else if (u.pn == 1) { const float t0 = fq_sum(s0), t1 = fq_sum(s1); if (fq == 0) { pr[4 + wc] = t0; pr[8 + wc] = t1; } }
                else { const float t = fq_sum(s0); if (fq == 0) pr[12 + wc] = t; } }
    }
};

struct EpiRowScaleBf16 {
    static constexpr bool PERM = true, AFTER_DRAIN = false;
    bf16_t* O; int ldc; const float* part; float inv_n;
    __device__ __forceinline__ void operator()(const f32x4 (&acc)[2][2][4][2], const Unit& u, int wr, int wc, int fr, int fq) const {
        { int t_ = threadIdx.x; asm volatile("" : "+v"(t_)); fr = t_ & 15; fq = (t_ >> 4) & 3; }
        const int row0 = u.pm * BM + wr * 64 + fr, col0 = u.pn * BM + wc * 32 + 8 * fq;
#pragma unroll
        for (int ai = 0; ai < 2; ++ai)
#pragma unroll
            for (int m = 0; m < 4; ++m) { const int row = row0 + ai * HALF + m * 16; bf16_t* rowp = O + (size_t)row * ldc + col0;
                const float rs = __builtin_amdgcn_rsqf(part_sum8(part + (size_t)row * 16) * inv_n + EPS_);
                *(u32x4*)(rowp) = pack8(acc[ai][0][m][0] * rs, acc[ai][0][m][1] * rs); *(u32x4*)(rowp + HALF) = pack8(acc[ai][1][m][0] * rs, acc[ai][1][m][1] * rs); }
    }
};

struct EpiKVup {
    static constexpr bool PERM = true, AFTER_DRAIN = false;
    bf16_t* Kd; bf16_t* Vd; const float* part; const bf16_t* QA; const float* g_kn; const float* rope;
    __device__ __forceinline__ void operator()(const f32x4 (&acc)[2][2][4][2], const Unit& u, int wr, int wc, int fr, int fq) const {
        { int t_ = threadIdx.x; asm volatile("" : "+v"(t_)); fr = t_ & 15; fq = (t_ >> 4) & 3; }
        const int row0 = u.pm * BM + wr * 64 + fr;
        if (u.pn >= 4) {
            const int col0 = (u.pn - 4) * BM + wc * 32 + 8 * fq;
#pragma unroll
            for (int ai = 0; ai < 2; ++ai)
#pragma unroll
                for (int m = 0; m < 4; ++m) { const int row = row0 + ai * HALF + m * 16; bf16_t* rowp = Vd + (size_t)row * 1024 + col0;
                    const float rs = __builtin_amdgcn_rsqf(part_sum8(part + (size_t)row * 16 + 8) * (1.f / 256) + EPS_);
                    *(u32x4*)(rowp) = pack8(acc[ai][0][m][0] * rs, acc[ai][0][m][1] * rs); *(u32x4*)(rowp + HALF) = pack8(acc[ai][1][m][0] * rs, acc[ai][1][m][1] * rs); }
            return;
        }
        const int head = 4 * u.pn + wc;
        f32x4 gA0 = *(const f32x4*)(g_kn + 8 * fq), gA1 = *(const f32x4*)(g_kn + 8 * fq + 4), gB0 = *(const f32x4*)(g_kn + 32 + 8 * fq), gB1 = *(const f32x4*)(g_kn + 32 + 8 * fq + 4);
        const f32x4 gR1 = *(const f32x4*)(g_kn + 64 + 4 * fq), gR2 = *(const f32x4*)(g_kn + 80 + 4 * fq);
#pragma unroll
        for (int ai = 0; ai < 2; ++ai)
#pragma unroll
            for (int m = 0; m < 4; ++m) { const int row = row0 + ai * HALF + m * 16;
                const float rs = __builtin_amdgcn_rsqf(part_sum8(part + (size_t)row * 16 + 8) * (1.f / 256) + EPS_);
                f32x4 a0 = acc[ai][0][m][0] * rs, a1 = acc[ai][0][m][1] * rs, b0 = acc[ai][1][m][0] * rs, b1 = acc[ai][1][m][1] * rs;
                const unsigned long long p1 = *(const unsigned long long*)(QA + (size_t)row * 768 + 640 + 4 * fq), p2 = *(const unsigned long long*)(QA + (size_t)row * 768 + 656 + 4 * fq);
                f32x4 x1, x2;
                x1[0] = __builtin_bit_cast(float, (unsigned)(p1 << 16)); x1[1] = __builtin_bit_cast(float, (unsigned)p1 & 0xffff0000u);
                x1[2] = __builtin_bit_cast(float, (unsigned)(p1 >> 32) << 16); x1[3] = __builtin_bit_cast(float, (unsigned)(p1 >> 32) & 0xffff0000u);
                x2[0] = __builtin_bit_cast(float, (unsigned)(p2 << 16)); x2[1] = __builtin_bit_cast(float, (unsigned)p2 & 0xffff0000u);
                x2[2] = __builtin_bit_cast(float, (unsigned)(p2 >> 32) << 16); x2[3] = __builtin_bit_cast(float, (unsigned)(p2 >> 32) & 0xffff0000u);
                const float ss = fq_sum(sq8(a0, a1) + sq8(b0, b1) + sq8(x1, x2));
                const float sh = __builtin_amdgcn_rsqf(ss * (1.f / 96) + EPS_);
                bf16_t* kp = Kd + (size_t)row * 1536 + head * 96;
                *(u32x4*)(kp + 8 * fq) = pack8(a0 * gA0 * sh, a1 * gA1 * sh); *(u32x4*)(kp + 32 + 8 * fq) = pack8(b0 * gB0 * sh, b1 * gB1 * sh);
                const f32x4* rp = (const f32x4*)(rope + ((size_t)(row & 2047) * 16 + 4 * fq) * 2);
                const f32x4 c01 = rp[0], c23 = rp[1];
                const f32x4 y1 = x1 * gR1 * sh, y2 = x2 * gR2 * sh;
                f32x4 o1, o2;
                o1[0] = y1[0] * c01[0] - y2[0] * c01[1]; o2[0] = y2[0] * c01[0] + y1[0] * c01[1];
                o1[1] = y1[1] * c01[2] - y2[1] * c01[3]; o2[1] = y2[1] * c01[2] + y1[1] * c01[3];
                o1[2] = y1[2] * c23[0] - y2[2] * c23[1]; o2[2] = y2[2] * c23[0] + y1[2] * c23[1];
                o1[3] = y1[3] * c23[2] - y2[3] * c23[3]; o2[3] = y2[3] * c23[2] + y1[3] * c23[3];
                unsigned long long w1 = (unsigned long long)cvt_pk_bf16(o1[0], o1[1]) | ((unsigned long long)cvt_pk_bf16(o1[2], o1[3]) << 32);
                unsigned long long w2 = (unsigned long long)cvt_pk_bf16(o2[0], o2[1]) | ((unsigned long long)cvt_pk_bf16(o2[2], o2[3]) << 32);
                *(unsigned long long*)(kp + 64 + 4 * fq) = w1; *(unsigned long long*)(kp + 80 + 4 * fq) = w2; }
    }
};

struct EpiKVQ2 {
    static constexpr bool PERM = true, AFTER_DRAIN = false;
    bf16_t* O; const float* pss; const float* gk; const float* gq;
    __device__ __forceinline__ void operator()(const f32x4 (&acc)[2][2][4][2], const Unit& u, int wr, int wc, int fr, int fq) const {
        { int t_ = threadIdx.x; asm volatile("" : "+v"(t_)); fr = t_ & 15; fq = (t_ >> 4) & 3; }
        const int row0 = u.pm * BM + wr * 64 + fr, part = u.pn >> 2, tl = u.pn & 3;
        if (part == 1) {
            const int col0 = u.pn * BM + wc * 32 + 8 * fq;
#pragma unroll
            for (int ai = 0; ai < 2; ++ai)
#pragma unroll
                for (int m = 0; m < 4; ++m) { const int row = row0 + ai * HALF + m * 16; bf16_t* rowp = O + (size_t)row * 3072 + col0;
                    const float rs = __builtin_amdgcn_rsqf(part_sum16(pss + (size_t)row * 16) * (1.f / 1024) + EPS_);
                    *(u32x4*)(rowp) = pack8(acc[ai][0][m][0] * rs, acc[ai][0][m][1] * rs); *(u32x4*)(rowp + HALF) = pack8(acc[ai][1][m][0] * rs, acc[ai][1][m][1] * rs); }
            return;
        }
        const float* g = part ? gq : gk; const float post = part ? 0.125f * 1.4426950408889634f : 1.f;
        const f32x4 gA0 = *(const f32x4*)(g + 8 * fq) * post, gA1 = *(const f32x4*)(g + 8 * fq + 4) * post, gB0 = *(const f32x4*)(g + 32 + 8 * fq) * post, gB1 = *(const f32x4*)(g + 32 + 8 * fq + 4) * post;
        const int colh = part * 1024 + (4 * tl + wc) * 64;
#pragma unroll
        for (int ai = 0; ai < 2; ++ai)
#pragma unroll
            for (int m = 0; m < 4; ++m) { const int row = row0 + ai * HALF + m * 16; bf16_t* rowp = O + (size_t)row * 3072 + colh;
                const float rs = __builtin_amdgcn_rsqf(part_sum16(pss + (size_t)row * 16) * (1.f / 1024) + EPS_);
                const f32x4 a0 = acc[ai][0][m][0] * rs, a1 = acc[ai][0][m][1] * rs, b0 = acc[ai][1][m][0] * rs, b1 = acc[ai][1][m][1] * rs;
                const float ss = fq_sum(sq8(a0, a1) + sq8(b0, b1));
                const float sh = __builtin_amdgcn_rsqf(ss * (1.f / 64) + EPS_);
                *(u32x4*)(rowp + 8 * fq) = pack8(a0 * gA0 * sh, a1 * gA1 * sh); *(u32x4*)(rowp + 32 + 8 * fq) = pack8(b0 * gB0 * sh, b1 * gB1 * sh); }
    }
};

template <bool SSQ> struct EpiGated {
    static constexpr bool PERM = true, AFTER_DRAIN = false;
    bf16_t* Hd; int ldc; int ntile; const float* rs;
    __device__ __forceinline__ void operator()(const f32x4 (&acc)[2][2][4][2], const Unit& u, int wr, int wc, int fr, int fq) const {
        { int t_ = threadIdx.x; asm volatile("" : "+v"(t_)); fr = t_ & 15; fq = (t_ >> 4) & 3; }
        const int pnl = ntile ? (u.pn % ntile) : u.pn;
        const int row0 = u.pm * BM + wr * 64 + fr, col0 = pnl * HALF + wc * 32 + 8 * fq;
#pragma unroll
        for (int ai = 0; ai < 2; ++ai)
#pragma unroll
            for (int m = 0; m < 4; ++m) { const int row = row0 + ai * HALF + m * 16; bf16_t* rowp = Hd + (size_t)row * ldc + col0;
                const float r = SSQ ? __builtin_amdgcn_rsqf(part_sum16(rs + (size_t)row * 16) * (1.f / 1024) + EPS_) : rs[row];
                const f32x4 g0 = acc[ai][0][m][0] * r, g1 = acc[ai][0][m][1] * r, u0 = acc[ai][1][m][0] * r, u1 = acc[ai][1][m][1] * r;
                u32x4 w;
                w.x = cvt_pk_bf16(silu_f(g0[0]) * u0[0], silu_f(g0[1]) * u0[1]); w.y = cvt_pk_bf16(silu_f(g0[2]) * u0[2], silu_f(g0[3]) * u0[3]);
                w.z = cvt_pk_bf16(silu_f(g1[0]) * u1[0], silu_f(g1[1]) * u1[1]); w.w = cvt_pk_bf16(silu_f(g1[2]) * u1[2], silu_f(g1[3]) * u1[3]);
                *(u32x4*)rowp = w; }
    }
};

template <bool SSQ> struct EpiResNorm {
    static constexpr bool PERM = true, AFTER_DRAIN = false;
    const float* res; float* out; bf16_t* XR; float* ssq;
    __device__ __forceinline__ void operator()(const f32x4 (&acc)[2][2][4][2], const Unit& u, int wr, int wc, int fr, int fq) const {
        { int t_ = threadIdx.x; asm volatile("" : "+v"(t_)); fr = t_ & 15; fq = (t_ >> 4) & 3; }
        const int row0 = u.pm * BM + wr * 64 + fr, col0 = u.pn * BM + wc * 32 + 8 * fq;
#pragma unroll
        for (int ai = 0; ai < 2; ++ai)
#pragma unroll
            for (int m = 0; m < 4; ++m) { const int row = row0 + ai * HALF + m * 16; const size_t ro = (size_t)row * 1024 + col0;
                f32x4 r[2][2];
#pragma unroll
                for (int bj = 0; bj < 2; ++bj)
#pragma unroll
                    for (int n = 0; n < 2; ++n) r[bj][n] = *(const f32x4*)(res + ro + bj * HALF + n * 4);
#pragma unroll
                for (int bj = 0; bj < 2; ++bj)
#pragma unroll
                    for (int n = 0; n < 2; ++n) { r[bj][n] = r[bj][n] + acc[ai][bj][m][n]; *(f32x4*)(out + ro + bj * HALF + n * 4) = r[bj][n]; }
                *(u32x4*)(XR + ro) = pack8(r[0][0], r[0][1]); *(u32x4*)(XR + ro + HALF) = pack8(r[1][0], r[1][1]);
                if (SSQ) { const float t = fq_sum(sq8(r[0][0], r[0][1]) + sq8(r[1][0], r[1][1])); if (fq == 0) ssq[(size_t)row * 16 + u.pn * 4 + wc] = t; } }
    }
};

struct EpiMoeDown {
    static constexpr bool PERM = false, AFTER_DRAIN = false;
    float* out; const int* slot_tok; const float* slot_gate; int slot_base; int ldc;
    __device__ __forceinline__ void operator()(const f32x4 (&acc)[2][2][4][2], const Unit& u, int wr, int wc, int fr, int fq) const {
        { int t_ = threadIdx.x; asm volatile("" : "+v"(t_)); fr = t_ & 15; fq = (t_ >> 4) & 3; }
        const int pnl = u.pn & 3;
        const int row0 = slot_base + u.pm * BM + wr * 64 + fr, col0 = pnl * BM + wc * 32 + 4 * fq;
#pragma unroll
        for (int ai = 0; ai < 2; ++ai)
#pragma unroll
            for (int m = 0; m < 4; ++m) { const int slot = row0 + ai * HALF + m * 16; const int tok = slot_tok[slot]; const float gt = slot_gate[slot];
                if (tok >= 0) { float* rowp = out + (size_t)tok * ldc + col0;
                    f32x4 r[2][2];
#pragma unroll
                    for (int bj = 0; bj < 2; ++bj)
#pragma unroll
                        for (int n = 0; n < 2; ++n) r[bj][n] = *(const f32x4*)(rowp + bj * HALF + n * 16);
#pragma unroll
                    for (int bj = 0; bj < 2; ++bj)
#pragma unroll
                        for (int n = 0; n < 2; ++n) *(f32x4*)(rowp + bj * HALF + n * 16) = r[bj][n] + acc[ai][bj][m][n] * gt; } }
    }
};

struct MoeOrder {
    int nM, nN, nwg, G, c; const int* panel_e;
    __device__ void init(int nPanels, int nN_, int G_, int c_, const int* pe) { nM = nPanels; nN = nN_; nwg = nM * nN; G = G_; c = c_; panel_e = pe; }
    __device__ bool next(int i, Unit& u) const {
        const long L = (long)i * G + c; if (L >= nwg) return false;
        int wgid = (int)L; { const int q = nwg / NXCD, r = nwg % NXCD, xcd = wgid % NXCD, off = wgid / NXCD; wgid = (xcd < r ? xcd * (q + 1) : r * (q + 1) + (xcd - r) * q) + off; }
        const int nig = WGM * nN, gid = wgid / nig, fm = gid * WGM, gsz = (nM - fm) < WGM ? (nM - fm) : WGM;
        u.pm = fm + ((wgid % nig) % gsz); const int pnl = (wgid % nig) / gsz;
        const int e = __builtin_amdgcn_readfirstlane(panel_e[u.pm]);
        u.pn = e * nN + pnl; return true;
    }
    __device__ __forceinline__ void a_ready(const Unit&) const {}
    __device__ __forceinline__ void done(const Unit&) const {}
};
template <class Epi, class Sched, bool ALIGN_EPI = false, bool SP2 = false>
__device__ __forceinline__ void gemm_phase(PG8_LAS unsigned char* lds, const Gemm g, const Sched& S, const Epi& E) {
    int tid_ = threadIdx.x; asm volatile("" : "+v"(tid_));
    const int tid = tid_, wid = __builtin_amdgcn_readfirstlane(tid >> 6), lane = tid & 63, wr = wid >> 2, wc = wid & 3, fr = lane & 15, fq = lane >> 4;
    const int K = g.K, nt = K / BK;
    unsigned voffA[2], voffB[2];
#pragma unroll
    for (int i = 0; i < 2; ++i) { int R, C; stage_rc(tid * 16 + i * 8192, R, C); const int Rb = Epi::PERM ? ((R & ~31) + perm32(R & 31)) : R;
        voffA[i] = (unsigned)(R * g.lda + C) * 2u; voffB[i] = (unsigned)(Rb * K + C) * 2u; }
    const size_t kstep = (size_t)(BK * 2);
    const size_t hstepA = (size_t)HALF * g.lda * 2, hstepB = (size_t)HALF * K * 2;
    const size_t tstepA = 2 * hstepA, tstepB = 2 * hstepB;
    const unsigned ldsw = (unsigned)wid * 1024u;
    const int aoff = lds_byte(wr * 64 + fr, fq * 8), boff = lds_byte(wc * 32 + fr, fq * 8);
#define PG8_SA(b, h) (((b) * 2 + (h)) * HTB)
#define PG8_SB(b, h) ((4 + (b) * 2 + (h)) * HTB)
#define PG8_STAGE(bufoff, gbase, voff) do { _Pragma("unroll") for (int _i = 0; _i < 2; ++_i) \
        __builtin_amdgcn_global_load_lds((const unsigned*)((const char*)(gbase) + (voff)[_i]), (PG8_LAS unsigned*)(lds + (bufoff) + ldsw + _i * 8192), 16, 0, 0); } while (0)
#define PG8_LDA(dst, b, h) do { _Pragma("unroll") for (int m = 0; m < 4; ++m) _Pragma("unroll") for (int k = 0; k < 2; ++k) dst[m][k] = *(const PG8_LAS bf16x8*)(lds + PG8_SA(b, h) + aoff + m * 2048 + k * 1024); } while (0)
#define PG8_LDB(dst, b, h) do { _Pragma("unroll") for (int n = 0; n < 2; ++n) _Pragma("unroll") for (int k = 0; k < 2; ++k) dst[n][k] = *(const PG8_LAS bf16x8*)(lds + PG8_SB(b, h) + boff + n * 2048 + k * 1024); } while (0)
#define PG8_MMA(ai, bj, At, Bt) do { __builtin_amdgcn_s_setprio(1); _Pragma("unroll") for (int m = 0; m < 4; ++m) _Pragma("unroll") for (int n = 0; n < 2; ++n) _Pragma("unroll") for (int k = 0; k < 2; ++k) \
        acc[ai][bj][m][n] = __builtin_amdgcn_mfma_f32_16x16x32_bf16(Bt[n][k], At[m][k], acc[ai][bj][m][n], 0, 0, 0); __builtin_amdgcn_s_setprio(0); } while (0)
#define PG8_WAIT_V(n) asm volatile("s_waitcnt vmcnt(" #n ")" ::: "memory")
#define PG8_WAIT_L(n) asm volatile("s_waitcnt lgkmcnt(" #n ")" ::: "memory")
#define PG8_BAR __builtin_amdgcn_s_barrier()
#define PG8_SCHED __builtin_amdgcn_sched_barrier(0)
    Unit cur, nxt; int ui = 0;
    if (!S.next(0, cur)) return;
    f32x4 acc[2][2][4][2];
#pragma unroll
    for (int a = 0; a < 2; ++a)
#pragma unroll
        for (int b = 0; b < 2; ++b)
#pragma unroll
            for (int m = 0; m < 4; ++m)
#pragma unroll
                for (int n = 0; n < 2; ++n) acc[a][b][m][n] = (f32x4){0.f, 0.f, 0.f, 0.f};
    bf16x8 At[4][2], B0[2][2], B1[2][2];
    const char* cA = (const char*)g.A + (size_t)cur.pm * tstepA; const char* cB = (const char*)g.Bt + (size_t)cur.pn * tstepB;
    S.a_ready(cur);
    if constexpr (SP2) {
        PG8_STAGE(PG8_SB(0, 0), cB, voffB); PG8_STAGE(PG8_SB(0, 1), cB + hstepB, voffB); PG8_STAGE(PG8_SA(0, 0), cA, voffA); PG8_STAGE(PG8_SA(0, 1), cA + hstepA, voffA);
        if (wr == 1) PG8_BAR;
        PG8_WAIT_V(2); PG8_BAR;
        PG8_STAGE(PG8_SB(1, 0), cB + kstep, voffB); PG8_STAGE(PG8_SA(1, 0), cA + kstep, voffA); PG8_STAGE(PG8_SB(1, 1), cB + hstepB + kstep, voffB);
        PG8_WAIT_V(6); PG8_BAR;
    } else {
        PG8_STAGE(PG8_SB(0, 0), cB, voffB); PG8_STAGE(PG8_SA(0, 0), cA, voffA); PG8_STAGE(PG8_SB(0, 1), cB + hstepB, voffB); PG8_STAGE(PG8_SA(0, 1), cA + hstepA, voffA);
        if (wr == 1) PG8_BAR;
        PG8_WAIT_V(4); PG8_BAR;
        PG8_STAGE(PG8_SB(1, 0), cB + kstep, voffB); PG8_STAGE(PG8_SA(1, 0), cA + kstep, voffA); PG8_STAGE(PG8_SB(1, 1), cB + hstepB + kstep, voffB);
        PG8_WAIT_V(6); PG8_BAR;
    }
    for (;;) {
        const bool has_next = S.next(ui + 1, nxt);
        const char* nA = has_next ? (const char*)g.A + (size_t)nxt.pm * tstepA : cA; const char* nB = has_next ? (const char*)g.Bt + (size_t)nxt.pn * tstepB : cB;
        for (int t = 0; t < nt; t += 2) {
            const bool last = (t == nt - 2);
            const char* a1 = cA + (size_t)(t + 1) * kstep;
            const char* a2 = last ? nA : cA + (size_t)(t + 2) * kstep; const char* b2 = last ? nB : cB + (size_t)(t + 2) * kstep;
            const char* a3 = a2 + kstep; const char* b3 = b2 + kstep;
            if (last && has_next) S.a_ready(nxt);
            if constexpr (SP2) {
            PG8_LDB(B0, 0, 0); PG8_LDB(B1, 0, 1); PG8_SCHED; PG8_LDA(At, 0, 0); PG8_STAGE(PG8_SA(1, 1), a1 + hstepA, voffA);
            PG8_WAIT_V(8); PG8_WAIT_L(0); PG8_BAR; PG8_MMA(0, 0, At, B0); PG8_MMA(0, 1, At, B1); PG8_BAR; PG8_SCHED;
            PG8_LDA(At, 0, 1); PG8_STAGE(PG8_SB(0, 0), b2, voffB); PG8_STAGE(PG8_SB(0, 1), b2 + hstepB, voffB); PG8_STAGE(PG8_SA(0, 0), a2, voffA);
            PG8_WAIT_V(8); PG8_WAIT_L(0); PG8_BAR; PG8_MMA(1, 0, At, B0); PG8_MMA(1, 1, At, B1); PG8_BAR; PG8_SCHED;
            PG8_LDB(B0, 1, 0); PG8_LDB(B1, 1, 1); PG8_SCHED; PG8_LDA(At, 1, 0); PG8_STAGE(PG8_SA(0, 1), a2 + hstepA, voffA);
            PG8_WAIT_V(8); PG8_WAIT_L(0); PG8_BAR; PG8_MMA(0, 0, At, B0); PG8_MMA(0, 1, At, B1); PG8_BAR; PG8_SCHED;
            PG8_LDA(At, 1, 1); PG8_STAGE(PG8_SB(1, 0), b3, voffB); PG8_STAGE(PG8_SB(1, 1), b3 + hstepB, voffB); PG8_STAGE(PG8_SA(1, 0), a3, voffA);
            PG8_WAIT_V(8); PG8_WAIT_L(0); PG8_BAR; PG8_MMA(1, 0, At, B0); PG8_MMA(1, 1, At, B1); PG8_BAR; PG8_SCHED;
            } else {
            PG8_LDB(B0, 0, 0); PG8_SCHED; PG8_LDA(At, 0, 0); PG8_STAGE(PG8_SA(1, 1), a1 + hstepA, voffA);
            PG8_WAIT_L(8); PG8_BAR; PG8_WAIT_L(0); PG8_MMA(0, 0, At, B0); PG8_BAR; PG8_SCHED;
            PG8_LDB(B1, 0, 1); PG8_STAGE(PG8_SB(0, 0), b2, voffB);
            PG8_BAR; PG8_WAIT_L(0); PG8_MMA(0, 1, At, B1); PG8_BAR;
            PG8_LDA(At, 0, 1); PG8_STAGE(PG8_SA(0, 0), a2, voffA);
            PG8_BAR; PG8_WAIT_L(0); PG8_MMA(1, 0, At, B0); PG8_BAR; PG8_SCHED;
            PG8_STAGE(PG8_SB(0, 1), b2 + hstepB, voffB);
            PG8_WAIT_V(6); PG8_BAR; PG8_MMA(1, 1, At, B1); PG8_BAR;
            PG8_LDB(B0, 1, 0); PG8_SCHED; PG8_LDA(At, 1, 0); PG8_STAGE(PG8_SA(0, 1), a2 + hstepA, voffA);
            PG8_WAIT_L(8); PG8_BAR; PG8_WAIT_L(0); PG8_MMA(0, 0, At, B0); PG8_BAR; PG8_SCHED;
            PG8_LDB(B1, 1, 1); PG8_STAGE(PG8_SB(1, 0), b3, voffB);
            PG8_BAR; PG8_WAIT_L(0); PG8_MMA(0, 1, At, B1); PG8_BAR;
            PG8_LDA(At, 1, 1); PG8_STAGE(PG8_SA(1, 0), a3, voffA);
            PG8_BAR; PG8_WAIT_L(0); PG8_MMA(1, 0, At, B0); PG8_BAR; PG8_SCHED;
            PG8_STAGE(PG8_SB(1, 1), b3 + hstepB, voffB);
            PG8_WAIT_V(6); PG8_BAR; PG8_MMA(1, 1, At, B1); PG8_BAR;
            }
        }
        if constexpr (ALIGN_EPI) { if (wr == 0) PG8_BAR; }
        if constexpr (!Epi::AFTER_DRAIN) { E(acc, cur, wr, wc, fr, fq); S.done(cur); }
        if (!has_next) break;
#pragma unroll
        for (int a = 0; a < 2; ++a)
#pragma unroll
            for (int b = 0; b < 2; ++b)
#pragma unroll
                for (int m = 0; m < 4; ++m)
#pragma unroll
                    for (int n = 0; n < 2; ++n) acc[a][b][m][n] = (f32x4){0.f, 0.f, 0.f, 0.f};
        cur = nxt; cA = nA; cB = nB; ++ui;
        if constexpr (ALIGN_EPI) { if (wr == 1) PG8_BAR; }
    }
    PG8_WAIT_V(0);
    if constexpr (!ALIGN_EPI) { if (wr == 0) PG8_BAR; }
    PG8_BAR;
    if constexpr (Epi::AFTER_DRAIN) { E.fused(acc, cur, wr, wc, fr, fq, lds, wid, lane); S.done(cur); }
#undef PG8_SA
#undef PG8_SB
#undef PG8_STAGE
#undef PG8_LDA
#undef PG8_LDB
#undef PG8_MMA
#undef PG8_WAIT_V
#undef PG8_WAIT_L
#undef PG8_BAR
#undef PG8_SCHED
}
}
namespace att {
#define ATT_LAS __attribute__((address_space(3)))
typedef unsigned short bf16;
typedef short bf16x8 __attribute__((ext_vector_type(8)));
typedef short s16x4 __attribute__((ext_vector_type(4)));
typedef float f32x16 __attribute__((ext_vector_type(16)));
typedef float f32x4_t __attribute__((ext_vector_type(4)));
typedef unsigned u32x4 __attribute__((ext_vector_type(4)));
typedef unsigned u32x2 __attribute__((ext_vector_type(2)));
typedef float f32x2_t __attribute__((ext_vector_type(2))); typedef __bf16 bf16x2_t __attribute__((ext_vector_type(2)));
__device__ __forceinline__ unsigned cvtpk(float lo, float hi) { f32x2_t v = {lo, hi}; bf16x2_t b = __builtin_convertvector(v, bf16x2_t); return __builtin_bit_cast(unsigned, b); }
__device__ __forceinline__ s16x4 vtr(const ATT_LAS unsigned char* p) { return __builtin_bit_cast(s16x4, __builtin_amdgcn_ds_read_tr16_b64_v4i16((ATT_LAS s16x4*)p)); }
constexpr int VSTR = 192;
template <int DQK> struct Geo { static constexpr int KSTR = DQK * 2 + 16, KBUF = 64 * KSTR, VBUF = 64 * VSTR, CPR = DQK / 8, NKC = 64 * CPR, KIT = (NKC + 511) / 512; };
template <int DQK> constexpr int lds_bytes() { return 2 * Geo<DQK>::KBUF + 2 * Geo<DQK>::VBUF + 2048 + 8192; }

__device__ __forceinline__ float xhalf_max(float m) { auto rr = __builtin_amdgcn_permlane32_swap(__float_as_uint(m), __float_as_uint(m), false, false); return fmaxf(__uint_as_float(rr[0]), __uint_as_float(rr[1])); }
__device__ __forceinline__ float xhalf_sum(float m) { auto rr = __builtin_amdgcn_permlane32_swap(__float_as_uint(m), __float_as_uint(m), false, false); return __uint_as_float(rr[0]) + __uint_as_float(rr[1]); }
__device__ __forceinline__ float max3f(float a, float b, float c) { float r; asm("v_max3_f32 %0, %1, %2, %3" : "=v"(r) : "v"(a), "v"(b), "v"(c)); return r; }
__device__ __forceinline__ float max2f(float a, float b) { float r; asm("v_max_f32_e32 %0, %1, %2" : "=v"(r) : "v"(a), "v"(b)); return r; }
__device__ __forceinline__ float rowmax32(const f32x16& p0, const f32x16& p1) {
    float a = max2f(p0[0], p1[0]), b = max2f(p0[1], p1[1]);
#pragma unroll
    for (int r = 2; r < 16; r += 2) { a = max3f(a, p0[r], p1[r]); b = max3f(b, p0[r + 1], p1[r + 1]); }
    const float m = max2f(a, b);
    auto rr = __builtin_amdgcn_permlane32_swap(__float_as_uint(m), __float_as_uint(m), false, false);
    return max2f(__uint_as_float(rr[0]), __uint_as_float(rr[1]));
}

template <int DQK, bool BAND, int qpitch, int kpitch, int vpitch, int opitch>
__device__ __forceinline__ void attn_unit(ATT_LAS unsigned char* lds, const bf16* Qb, const bf16* Kb, const bf16* Vb, bf16* Ob,
                                          int q0, int t_lo, int t_hi, int my_lo, int my_hi, int cc, const float* bias_g, const float* g_qn, const float* rope) {
    typedef Geo<DQK> G;
    int tid_ = threadIdx.x; asm volatile("" : "+v"(tid_));
    const int tid = tid_, lane = tid & 63, r32 = lane & 31, hi = lane >> 5, wid = __builtin_amdgcn_readfirstlane(tid >> 6);
    ATT_LAS float* biasL = (ATT_LAS float*)(lds + 2 * G::KBUF + 2 * G::VBUF);
    bf16x8 qf[DQK / 16];
    { const bf16* qp = Qb + (size_t)(q0 + wid * 32 + r32) * qpitch + 8 * hi;
#pragma unroll
      for (int kk = 0; kk < DQK / 16; ++kk) qf[kk] = *(const bf16x8*)(qp + 16 * kk); }
    if constexpr (!BAND) {
        float qv[DQK / 16][8]; float ss = 0.f;
#pragma unroll
        for (int kk = 0; kk < DQK / 16; ++kk)
#pragma unroll
            for (int j = 0; j < 8; ++j) { qv[kk][j] = __builtin_bit_cast(float, (unsigned)(unsigned short)qf[kk][j] << 16); ss += qv[kk][j] * qv[kk][j]; }
        ss = xhalf_sum(ss);
        const float rs = __builtin_amdgcn_rsqf(ss * (1.f / DQK) + 1e-6f) * (0.10206207261596577f * 1.4426950408889634f);
#pragma unroll
        for (int kk = 0; kk < DQK / 16; ++kk) { const f32x4_t g0 = *(const f32x4_t*)(g_qn + 16 * kk + 8 * hi), g1 = *(const f32x4_t*)(g_qn + 16 * kk + 8 * hi + 4);
#pragma unroll
            for (int j = 0; j < 4; ++j) { qv[kk][j] *= rs * g0[j]; qv[kk][4 + j] *= rs * g1[j]; } }
        const f32x4_t* rp = (const f32x4_t*)(rope + ((size_t)(q0 + wid * 32 + r32) * 16 + 8 * hi) * 2);
#pragma unroll
        for (int j2 = 0; j2 < 4; ++j2) { const f32x4_t cs = rp[j2];
            { const float x1 = qv[4][2 * j2], x2 = qv[5][2 * j2]; qv[4][2 * j2] = x1 * cs[0] - x2 * cs[1]; qv[5][2 * j2] = x2 * cs[0] + x1 * cs[1]; }
            { const float x1 = qv[4][2 * j2 + 1], x2 = qv[5][2 * j2 + 1]; qv[4][2 * j2 + 1] = x1 * cs[2] - x2 * cs[3]; qv[5][2 * j2 + 1] = x2 * cs[2] + x1 * cs[3]; } }
#pragma unroll
        for (int kk = 0; kk < DQK / 16; ++kk) { u32x4 w; w.x = cvtpk(qv[kk][0], qv[kk][1]); w.y = cvtpk(qv[kk][2], qv[kk][3]); w.z = cvtpk(qv[kk][4], qv[kk][5]); w.w = cvtpk(qv[kk][6], qv[kk][7]);
            qf[kk] = __builtin_bit_cast(bf16x8, w); }
    }
    if (BAND) { if (tid < 257) biasL[tid] = bias_g[tid] * 1.4426950408889634f; }
    constexpr int KCPL = G::KSTR / 16, KNP = (64 * KCPL + 63) / 64;
    constexpr int VCPL = VSTR / 16, VNP = 64 * VCPL / 64;
    constexpr int KPP = (KNP + 7) / 8, VPP = (VNP + 7) / 8;
    ATT_LAS unsigned* dmaL = (ATT_LAS unsigned*)(lds + 2 * G::KBUF + 2 * G::VBUF + 2048) + wid * 256 + lane;
#pragma unroll
    for (int pp = 0; pp < KPP; ++pp) { const int pc = wid + 8 * pp, c = pc * 64 + lane, row = (c / KCPL) & 63, ch = c % KCPL; dmaL[64 * pp] = (unsigned)(row * kpitch + (ch < G::CPR ? ch : 0) * 8) * 2u; }
#pragma unroll
    for (int pp = 0; pp < VPP; ++pp) { const int pc = wid + 8 * pp, c = pc * 64 + lane, row = (c / VCPL) & 63, ch = c % VCPL; dmaL[128 + 64 * pp] = (unsigned)(row * vpitch + (ch < 8 ? ch : 0) * 8) * 2u; }
#define ATT_DMA_K(t, b) do { const char* kt_ = (const char*)(Kb + (size_t)(t) * 64 * kpitch); _Pragma("unroll") for (int pp = 0; pp < KPP; ++pp) { if (wid + 8 * pp < KNP) \
            __builtin_amdgcn_global_load_lds((const unsigned*)(kt_ + dmaL[64 * pp]), (ATT_LAS unsigned*)(lds + (b) * G::KBUF + (wid + 8 * pp) * 1024), 16, 0, 0); } } while (0)
#define ATT_DMA_V(t, b) do { const char* vt_ = (const char*)(Vb + (size_t)(t) * 64 * vpitch); _Pragma("unroll") for (int pp = 0; pp < VPP; ++pp) { if (wid + 8 * pp < VNP) \
            __builtin_amdgcn_global_load_lds((const unsigned*)(vt_ + dmaL[128 + 64 * pp]), (ATT_LAS unsigned*)(lds + 2 * G::KBUF + (b) * G::VBUF + (wid + 8 * pp) * 1024), 16, 0, 0); } } while (0)
    f32x16 o0, o1;
#pragma unroll
    for (int i = 0; i < 16; ++i) { o0[i] = 0.f; o1[i] = 0.f; }
    float mrun = -INFINITY, lsum = 0.f;
    const int koff = r32 * G::KSTR + hi * 16;
    const int voff = ((lane >> 5) * 4 + ((lane & 15) >> 2)) * VSTR + (((lane >> 4) & 1) * 16 + (lane & 3) * 4) * 2;
    const f32x16 zero16 = {0.f, 0.f, 0.f, 0.f, 0.f, 0.f, 0.f, 0.f, 0.f, 0.f, 0.f, 0.f, 0.f, 0.f, 0.f, 0.f};
#define ATT_QK(X0, X1, t) do { const ATT_LAS unsigned char* Kt = lds + ((t) & 1) * G::KBUF + koff; \
        _Pragma("unroll") for (int kk = 0; kk < DQK / 16; ++kk) { \
            const bf16x8 a0 = *(const ATT_LAS bf16x8*)(Kt + kk * 32); const bf16x8 a1 = *(const ATT_LAS bf16x8*)(Kt + 32 * G::KSTR + kk * 32); \
            X0 = __builtin_amdgcn_mfma_f32_32x32x16_bf16(a0, qf[kk], kk ? X0 : zero16, 0, 0, 0); X1 = __builtin_amdgcn_mfma_f32_32x32x16_bf16(a1, qf[kk], kk ? X1 : zero16, 0, 0, 0); } } while (0)
#define ATT_SMPV(X0, X1, t) do { \
        float cadd = 0.f; \
        if (BAND) { const int delta = cc - (t); \
            if (delta >= 3) cadd = biasL[256]; \
            else { const ATT_LAS float* bp = biasL + (64 * delta + (32 * (wid & 1) + r32) - 4 * hi + 128 - 63); \
                if (delta < 2) { _Pragma("unroll") for (int i = 0; i < 16; ++i) { const int kj = (i & 3) + 8 * (i >> 2); X0[i] += bp[63 - kj]; X1[i] += bp[31 - kj]; } } \
                else { const int relb = 64 * delta + (32 * (wid & 1) + r32) - 4 * hi + 128; \
                    _Pragma("unroll") for (int i = 0; i < 16; ++i) { const int kj = (i & 3) + 8 * (i >> 2); int i0 = relb - kj, i1 = relb - kj - 32; i0 = i0 > 256 ? 256 : i0; i1 = i1 > 256 ? 256 : i1; \
                        X0[i] += biasL[i0]; X1[i] += biasL[i1]; } } } } \
        const float mt = rowmax32(X0, X1) + cadd; \
        const float mnew = max2f(mrun, mt); \
        const float alpha = __builtin_amdgcn_exp2f(mrun - mnew); \
        const float msub = mnew - cadd; \
        mrun = mnew; \
        float ps = 0.f; \
        _Pragma("unroll") for (int i = 0; i < 16; ++i) { X0[i] = __builtin_amdgcn_exp2f(X0[i] - msub); X1[i] = __builtin_amdgcn_exp2f(X1[i] - msub); ps += X0[i] + X1[i]; } \
        lsum = lsum * alpha + ps; \
        _Pragma("unroll") for (int i = 0; i < 16; ++i) { o0[i] *= alpha; o1[i] *= alpha; } \
        bf16x8 pf[2][2]; \
        _Pragma("unroll") for (int s = 0; s < 2; ++s) { u32x4 w0, w1; \
            w0.x = cvtpk(X0[8 * s + 0], X0[8 * s + 1]); w0.y = cvtpk(X0[8 * s + 2], X0[8 * s + 3]); w0.z = cvtpk(X0[8 * s + 4], X0[8 * s + 5]); w0.w = cvtpk(X0[8 * s + 6], X0[8 * s + 7]); \
            w1.x = cvtpk(X1[8 * s + 0], X1[8 * s + 1]); w1.y = cvtpk(X1[8 * s + 2], X1[8 * s + 3]); w1.z = cvtpk(X1[8 * s + 4], X1[8 * s + 5]); w1.w = cvtpk(X1[8 * s + 6], X1[8 * s + 7]); \
            pf[0][s] = __builtin_bit_cast(bf16x8, w0); pf[1][s] = __builtin_bit_cast(bf16x8, w1); } \
        const ATT_LAS unsigned char* Vt = lds + 2 * G::KBUF + ((t) & 1) * G::VBUF + voff; \
        _Pragma("unroll") for (int kb = 0; kb < 2; ++kb) _Pragma("unroll") for (int s = 0; s < 2; ++s) { \
            const ATT_LAS unsigned char* vp = Vt + (32 * kb + 16 * s) * VSTR; \
            const s16x4 l0 = vtr(vp), h0 = vtr(vp + 8 * VSTR), l1 = vtr(vp + 64), h1 = vtr(vp + 8 * VSTR + 64); \
            const bf16x8 a0 = (bf16x8){l0[0], l0[1], l0[2], l0[3], h0[0], h0[1], h0[2], h0[3]}; \
            const bf16x8 a1 = (bf16x8){l1[0], l1[1], l1[2], l1[3], h1[0], h1[1], h1[2], h1[3]}; \
            o0 = __builtin_amdgcn_mfma_f32_32x32x16_bf16(a0, pf[kb][s], o0, 0, 0, 0); o1 = __builtin_amdgcn_mfma_f32_32x32x16_bf16(a1, pf[kb][s], o1, 0, 0, 0); } } while (0)
#define ATT_FUSED(C0, C1, N0, N1, t, tn) do { \
        bf16x8 kfa[DQK / 16], kfb[DQK / 16]; \
        { const ATT_LAS unsigned char* Kt = lds + ((tn) & 1) * G::KBUF + koff; \
          _Pragma("unroll") for (int kk = 0; kk < DQK / 16; ++kk) { kfa[kk] = *(const ATT_LAS bf16x8*)(Kt + kk * 32); kfb[kk] = *(const ATT_LAS bf16x8*)(Kt + 32 * G::KSTR + kk * 32); } } \
        __builtin_amdgcn_sched_barrier(0); \
        float cadd = 0.f; \
        if (BAND) { const int delta = cc - (t); \
            if (delta >= 3) cadd = biasL[256]; \
            else { const ATT_LAS float* bp = biasL + (64 * delta + (32 * (wid & 1) + r32) - 4 * hi + 128 - 63); \
                if (delta < 2) { _Pragma("unroll") for (int i = 0; i < 16; ++i) { const int kj = (i & 3) + 8 * (i >> 2); C0[i] += bp[63 - kj]; C1[i] += bp[31 - kj]; } } \
                else { const int relb = 64 * delta + (32 * (wid & 1) + r32) - 4 * hi + 128; \
                    _Pragma("unroll") for (int i = 0; i < 16; ++i) { const int kj = (i & 3) + 8 * (i >> 2); int i0 = relb - kj, i1 = relb - kj - 32; i0 = i0 > 256 ? 256 : i0; i1 = i1 > 256 ? 256 : i1; \
                        C0[i] += biasL[i0]; C1[i] += biasL[i1]; } } } } \
        const float mt = rowmax32(C0, C1) + cadd; \
        const float mnew = max2f(mrun, mt); \
        const float alpha = __builtin_amdgcn_exp2f(mrun - mnew); \
        const float msub = mnew - cadd; \
        if (__builtin_amdgcn_ballot_w64(mnew > mrun)) { _Pragma("unroll") for (int i = 0; i < 16; ++i) { o0[i] *= alpha; o1[i] *= alpha; } } \
        mrun = mnew; \
        __builtin_amdgcn_sched_barrier(0); \
        _Pragma("unroll") for (int kk = 0; kk < DQK / 16; ++kk) { \
            N0 = __builtin_amdgcn_mfma_f32_32x32x16_bf16(kfa[kk], qf[kk], kk ? N0 : zero16, 0, 0, 0); N1 = __builtin_amdgcn_mfma_f32_32x32x16_bf16(kfb[kk], qf[kk], kk ? N1 : zero16, 0, 0, 0); } \
        s16x4 vl0[4], vh0[4], vl1[4], vh1[4]; \
        { const ATT_LAS unsigned char* Vt = lds + 2 * G::KBUF + ((t) & 1) * G::VBUF + voff; \
          _Pragma("unroll") for (int ks = 0; ks < 4; ++ks) { const ATT_LAS unsigned char* vp = Vt + 16 * ks * VSTR; vl0[ks] = vtr(vp); vh0[ks] = vtr(vp + 8 * VSTR); vl1[ks] = vtr(vp + 64); vh1[ks] = vtr(vp + 8 * VSTR + 64); } } \
        float ps = 0.f; \
        _Pragma("unroll") for (int i = 0; i < 16; ++i) { C0[i] = __builtin_amdgcn_exp2f(C0[i] - msub); C1[i] = __builtin_amdgcn_exp2f(C1[i] - msub); ps += C0[i] + C1[i]; } \
        lsum = lsum * alpha + ps; \
        bf16x8 pf[4]; \
        _Pragma("unroll") for (int s = 0; s < 2; ++s) { u32x4 w0, w1; \
            w0.x = cvtpk(C0[8 * s + 0], C0[8 * s + 1]); w0.y = cvtpk(C0[8 * s + 2], C0[8 * s + 3]); w0.z = cvtpk(C0[8 * s + 4], C0[8 * s + 5]); w0.w = cvtpk(C0[8 * s + 6], C0[8 * s + 7]); \
            w1.x = cvtpk(C1[8 * s + 0], C1[8 * s + 1]); w1.y = cvtpk(C1[8 * s + 2], C1[8 * s + 3]); w1.z = cvtpk(C1[8 * s + 4], C1[8 * s + 5]); w1.w = cvtpk(C1[8 * s + 6], C1[8 * s + 7]); \
            pf[s] = __builtin_bit_cast(bf16x8, w0); pf[2 + s] = __builtin_bit_cast(bf16x8, w1); } \
        __builtin_amdgcn_sched_barrier(0); \
        _Pragma("unroll") for (int ks = 0; ks < 4; ++ks) { \
            const bf16x8 a0 = (bf16x8){vl0[ks][0], vl0[ks][1], vl0[ks][2], vl0[ks][3], vh0[ks][0], vh0[ks][1], vh0[ks][2], vh0[ks][3]}; \
            const bf16x8 a1 = (bf16x8){vl1[ks][0], vl1[ks][1], vl1[ks][2], vl1[ks][3], vh1[ks][0], vh1[ks][1], vh1[ks][2], vh1[ks][3]}; \
            o0 = __builtin_amdgcn_mfma_f32_32x32x16_bf16(a0, pf[ks], o0, 0, 0, 0); o1 = __builtin_amdgcn_mfma_f32_32x32x16_bf16(a1, pf[ks], o1, 0, 0, 0); } } while (0)
#define ATT_STAGE(t) do { if ((t) + 2 <= t_hi) ATT_DMA_K((t) + 2, (t) & 1); if ((t) + 1 <= t_hi) ATT_DMA_V((t) + 1, ((t) + 1) & 1); } while (0)
    f32x16 sa0, sa1, sb0, sb1;
    ATT_DMA_K(t_lo, t_lo & 1);
    __syncthreads();
    if (t_lo + 1 <= t_hi) ATT_DMA_K(t_lo + 1, (t_lo + 1) & 1);
    ATT_DMA_V(t_lo, t_lo & 1);
    if (my_lo == t_lo) ATT_QK(sa0, sa1, t_lo);
    __syncthreads();
    {
        int t = t_lo;
        for (; t < my_lo - 1; ++t) { ATT_STAGE(t); __syncthreads(); }
        if (my_lo > t_lo) { ATT_STAGE(t); ATT_QK(sa0, sa1, t + 1); __syncthreads(); ++t; }
        int nf = my_hi - my_lo;
        for (; nf >= 2; nf -= 2, t += 2) {
            ATT_STAGE(t); ATT_FUSED(sa0, sa1, sb0, sb1, t, t + 1); __syncthreads();
            ATT_STAGE(t + 1); ATT_FUSED(sb0, sb1, sa0, sa1, t + 1, t + 2); __syncthreads();
        }
        if (nf == 1) {
            ATT_STAGE(t); ATT_FUSED(sa0, sa1, sb0, sb1, t, t + 1); __syncthreads(); ++t;
            ATT_STAGE(t); ATT_SMPV(sb0, sb1, t); __syncthreads(); ++t;
        } else {
            ATT_STAGE(t); ATT_SMPV(sa0, sa1, t); __syncthreads(); ++t;
        }
        for (; t <= t_hi; ++t) { ATT_STAGE(t); __syncthreads(); }
    }
    const float ltot = xhalf_sum(lsum);
    const float inv = 1.f / ltot;
    bf16* op = Ob + (size_t)(q0 + wid * 32 + r32) * opitch + 4 * hi;
#pragma unroll
    for (int g4 = 0; g4 < 4; ++g4) {
        u32x2 w0, w1;
        w0.x = cvtpk(o0[4 * g4 + 0] * inv, o0[4 * g4 + 1] * inv); w0.y = cvtpk(o0[4 * g4 + 2] * inv, o0[4 * g4 + 3] * inv);
        w1.x = cvtpk(o1[4 * g4 + 0] * inv, o1[4 * g4 + 1] * inv); w1.y = cvtpk(o1[4 * g4 + 2] * inv, o1[4 * g4 + 3] * inv);
        *(u32x2*)(op + 8 * g4) = w0; *(u32x2*)(op + 32 + 8 * g4) = w1;
    }
#undef ATT_DMA_K
#undef ATT_DMA_V
#undef ATT_QK
#undef ATT_SMPV
#undef ATT_STAGE
#undef ATT_FUSED
}
}
constexpr int NWAVES = 8;
constexpr int D = 1024, BATCH = 32, SEQ = 2048, M = BATCH * SEQ;
constexpr int NH = 16, QLORA = 384, KVLORA = 256, ROPE_D = 32, NOPE = 64, QKD = 96;
constexpr int NA = 768;
constexpr int FF = 2816, EFF = 3584, NE = 8;
constexpr float EPS = 1e-6f, LOG2E = 1.4426950408889634f;
constexpr int MAXP_HALF = 264, MAXP = 528;
constexpr size_t MiB = 1u << 20;
constexpr size_t WS_CTL = 0, CTL_ZERO_BYTES = 1 * MiB;
constexpr size_t WS_ROPE = 1 * MiB;
constexpr size_t WS_CNT = WS_ROPE + 256 * 1024;
constexpr size_t WS_PANELE = WS_CNT + 16 * 1024;
constexpr size_t WS_META = WS_PANELE + 4096;
constexpr size_t WS_TOKE = 2 * MiB;
constexpr size_t WS_TOKG = WS_TOKE + (size_t)M * 4;
constexpr size_t WS_SLOTTOK = WS_TOKG + (size_t)M * 8;
constexpr size_t WS_SLOTGATE = WS_SLOTTOK + (size_t)MAXP * 256 * 4;
constexpr size_t WS_PARTQA = 976 * MiB, WS_PART1 = 980 * MiB, WS_PART2 = 984 * MiB;
constexpr size_t WS_TOKRSTD = 4 * MiB;
constexpr size_t WS_SLOTRSTD = WS_TOKRSTD + (size_t)M * 4;
static_assert(WS_SLOTGATE + (size_t)MAXP * 256 * 4 <= WS_TOKRSTD && WS_SLOTRSTD + (size_t)MAXP * 256 * 4 <= 8 * MiB, "small arrays");
constexpr size_t WS_W = 8 * MiB;
constexpr size_t WS_WA = WS_W, WS_WUQ = WS_WA + (size_t)NA * D * 2, WS_WUKV = WS_WUQ + (size_t)1536 * QLORA * 2, WS_WO = WS_WUKV + (size_t)2048 * KVLORA * 2;
constexpr size_t WS_WF1 = WS_WO + (size_t)D * D * 2, WS_WF2 = WS_WF1 + (size_t)2 * FF * D * 2, WS_WKVQ = WS_WF2 + (size_t)D * FF * 2, WS_WBO = WS_WKVQ + (size_t)3 * D * D * 2;
constexpr size_t WS_WM1 = WS_WBO + (size_t)D * D * 2, WS_WM2 = WS_WM1 + (size_t)NE * 2 * EFF * D * 2, WS_WEND = WS_WM2 + (size_t)NE * D * EFF * 2;
constexpr size_t ARENA = 208 * MiB;
static_assert(WS_WEND <= ARENA, "weights fit under the arena");
constexpr size_t WS_XN = ARENA;
constexpr size_t WS_QA = ARENA + 128 * MiB;
constexpr size_t WS_Q = ARENA + 224 * MiB;
constexpr size_t WS_K = ARENA + 416 * MiB;
constexpr size_t WS_V = ARENA + 608 * MiB;
constexpr size_t WS_O = ARENA;
static_assert(WS_V + (size_t)M * D * 2 <= 1024 * MiB, "MLA arena");
constexpr size_t WS_XR1 = ARENA + 128 * MiB;
constexpr size_t WS_H = ARENA + 256 * MiB;
constexpr size_t WS_XR2 = ARENA;
constexpr size_t WS_KVQ2 = ARENA + 128 * MiB;
constexpr size_t WS_O2 = ARENA + 512 * MiB;
constexpr size_t WS_XR3 = ARENA + 640 * MiB;
constexpr size_t WS_XG = ARENA;
constexpr size_t WS_HM = ARENA + 264 * MiB;
constexpr size_t WS_END = WS_HM + (size_t)MAXP_HALF * 256 * EFF * 2;
static_assert(WS_XG + (size_t)MAXP * 256 * D * 2 <= WS_HM && WS_END <= 1024 * MiB && WS_XR3 + (size_t)M * D * 2 <= 1024 * MiB && WS_H + (size_t)M * FF * 2 <= 1024 * MiB, "arena");
constexpr int CW_BAR = 4096;
constexpr int RING_OFF = 0, RING_BYTES = 131072;
constexpr int P0_SCR = 128 * 33 * 4;
constexpr int LDSCTL_OFF = 8 * P0_SCR, MISC_OFF = LDSCTL_OFF + 320;
static_assert(LDSCTL_OFF >= RING_BYTES, "control words above every phase's scratch");
constexpr int LDS_BYTES = 147456;
static_assert(MISC_OFF + 128 <= LDS_BYTES, "LDS map");
static_assert(att::lds_bytes<96>() <= RING_BYTES, "attention scratch fits the ring region");

#define GAS __attribute__((address_space(1)))
#define LAS __attribute__((address_space(3)))
typedef unsigned short bf16;
typedef unsigned v4u __attribute__((ext_vector_type(4)));
typedef unsigned v2u __attribute__((ext_vector_type(2)));
typedef float f32x4 __attribute__((ext_vector_type(4)));
typedef GAS unsigned gu32;
#define RLX_AGENT __ATOMIC_RELAXED, __HIP_MEMORY_SCOPE_AGENT
#define LDS_WAIT() asm volatile("s_waitcnt lgkmcnt(0)" ::: "memory")
__device__ __forceinline__ unsigned f2bf(float f) { unsigned u = __builtin_bit_cast(unsigned, f); return (u + 0x7fffu + ((u >> 16) & 1u)) >> 16; }
__device__ __forceinline__ unsigned pk2(float lo, float hi) { return f2bf(lo) | (f2bf(hi) << 16); }
__device__ __forceinline__ float bflo(unsigned u) { return __builtin_bit_cast(float, u << 16); }
__device__ __forceinline__ float bfhi(unsigned u) { return __builtin_bit_cast(float, u & 0xffff0000u); }
__device__ __forceinline__ float wave_sum(float v) {
#pragma unroll
    for (int o = 1; o < 64; o <<= 1) v += __shfl_xor(v, o);
    return v;
}

#define XB_TMO      128
#define XB_XCNT(j)  (256  + 64 * (j))
#define XB_XSUB(j)  (1280 + 64 * (j))
#define XB_XGEN(j)  (2304 + 64 * (j))
#define XB_TOP      3328
#define XB_TOPGEN   3392
#define XCD_BAR_WORDS 3456
#define XB_SPIN_CAP (1u << 18)

__device__ __forceinline__ unsigned xb_ld(unsigned* p)              { return __hip_atomic_load(p, __ATOMIC_RELAXED, __HIP_MEMORY_SCOPE_AGENT); }
__device__ __forceinline__ unsigned xb_add(unsigned* p, unsigned v) { return __hip_atomic_fetch_add(p, v, __ATOMIC_RELAXED, __HIP_MEMORY_SCOPE_AGENT); }
__device__ __forceinline__ unsigned xb_xcc_id() { return (unsigned)__builtin_amdgcn_s_getreg((3 << 11) | 20) & 0xFu; }
#define XB_SPIN(cond, bar) do { unsigned _sp = 0; while (cond) { __builtin_amdgcn_s_sleep(1); \
    if ((++_sp & 255u) == 0u) { if (xb_ld(&(bar)[XB_TMO])) break; if (_sp > XB_SPIN_CAP) { atomicAdd(&(bar)[XB_TMO], 1u); break; } } } } while (0)

struct XcdBarrier {
    unsigned* bar; unsigned x;
    volatile LAS unsigned* st;
};

__device__ __forceinline__ XcdBarrier xcd_barrier_post(unsigned* bar, volatile LAS unsigned* st) {
    XcdBarrier b; b.bar = bar; b.x = xb_xcc_id(); b.st = st;
    if (threadIdx.x == 0) (void)xb_add(&bar[XB_XCNT(b.x)], 1u);
    return b;
}
__device__ __forceinline__ void xcd_barrier_complete(unsigned* bar, unsigned x, unsigned& nloc, unsigned& nx) {
    const unsigned G = gridDim.x * gridDim.y * gridDim.z;
    unsigned sum, cnt, mine, sp = 0u;
    for (;;) {
        sum = 0u; cnt = 0u; mine = 0u;
#pragma unroll
        for (unsigned j = 0; j < 16; ++j) { const unsigned c = xb_ld(&bar[XB_XCNT(j)]); sum += c; cnt += (c > 0u) ? 1u : 0u; mine = (j == x) ? c : mine; }
        if (sum == G) break;
        __builtin_amdgcn_s_sleep(1);
        if ((++sp & 255u) == 0u) { if (xb_ld(&bar[XB_TMO])) break; if (sp > XB_SPIN_CAP) { atomicAdd(&bar[XB_TMO], 1u); break; } }
    }
    nloc = mine > 0u ? mine : 1u; nx = cnt > 0u ? cnt : 1u;
}

__device__ __forceinline__ void xcd_barrier(const XcdBarrier& b) {
    asm volatile("s_waitcnt vmcnt(0)" ::: "memory");
    __syncthreads();
    if (threadIdx.x == 0) {
        unsigned* bar = b.bar;
        __builtin_amdgcn_s_waitcnt(0);
        unsigned nloc = b.st[0], nx = b.st[1];
        if (nloc == 0u) { xcd_barrier_complete(bar, b.x, nloc, nx); b.st[0] = nloc; b.st[1] = nx; }
        const unsigned old = xb_add(&bar[XB_XSUB(b.x)], 1u);
        const unsigned gen = old / nloc;
        if (old + 1u == (gen + 1u) * nloc) {
            __builtin_amdgcn_fence(__ATOMIC_RELEASE, "agent");
            asm volatile("s_waitcnt vmcnt(0)" ::: "memory");
            const unsigned og = xb_add(&bar[XB_TOP], 1u);
            const unsigned tg = og / nx;
            if (og + 1u == (tg + 1u) * nx) xb_add(&bar[XB_TOPGEN], 1u);
            else XB_SPIN(xb_ld(&bar[XB_TOPGEN]) == tg, bar);
            __builtin_amdgcn_fence(__ATOMIC_ACQUIRE, "agent");
            xb_add(&bar[XB_XGEN(b.x)], 1u);
            asm volatile("s_waitcnt vmcnt(0)" ::: "memory");
        } else {
            XB_SPIN(xb_ld(&bar[XB_XGEN(b.x)]) == gen, bar);
            __builtin_amdgcn_fence(__ATOMIC_ACQUIRE, "agent");
            asm volatile("s_waitcnt vmcnt(0)" ::: "memory");
        }
    }
    __syncthreads();
}

struct Args { const float* in[27]; float* out; unsigned char* ws; };
enum { I_X = 0, I_ATTN_NORM, I_FFN_NORM, I_A_WDQ, I_A_GCQ, I_A_WUQ, I_A_WDKV, I_A_GCKV, I_A_WUKV, I_A_GQN, I_A_GKN, I_A_WO, I_KV_NORM, I_KV_WK, I_KV_WV, I_KV_GKN,
       I_B_WQ, I_B_GQN, I_B_RELB, I_B_WO, I_FFN_W1, I_FFN_W3, I_FFN_W2, I_MOE_ROUTER, I_MOE_W1, I_MOE_W3, I_MOE_W2 };

struct Frame {
    LAS unsigned char* lds;
    int wave, vcu, G;
};
typedef const __attribute__((address_space(4))) Args* KArgs;
__device__ __forceinline__ KArgs kargs() { KArgs p = (KArgs)__builtin_amdgcn_kernarg_segment_ptr(); asm volatile("" : "+s"(p)); return p; }
#define INP(i) (kargs()->in[i])
#define OUTP (kargs()->out)
#define WSP (kargs()->ws)
__device__ __forceinline__ int fresh(int v) { asm volatile("" : "+v"(v)); return v; }

__device__ __forceinline__ void tr_item(const float* W, int ldw, int K, int k0, int nsrc0, const float* gain, bf16* WT, int drow0, LAS float* scr, int lane) {
    const int c4 = lane & 7, r = lane >> 3;
    const GAS float* src = (const GAS float*)W + (size_t)(k0 + r) * ldw + nsrc0 + 4 * c4;
    f32x4 v[16];
#pragma unroll
    for (int i = 0; i < 16; ++i) v[i] = *(const GAS f32x4*)(src + (size_t)(8 * i) * ldw);
    if (gain) {
#pragma unroll
        for (int i = 0; i < 16; ++i) v[i] = v[i] * gain[k0 + 8 * i + r];
    }
#pragma unroll
    for (int i = 0; i < 16; ++i) { LAS float* d = scr + (8 * i + r) * 33 + 4 * c4; d[0] = v[i].x; d[1] = v[i].y; d[2] = v[i].z; d[3] = v[i].w; }
    LDS_WAIT(); asm volatile("" ::: "memory");
    const int c16 = lane >> 2;
#pragma unroll
    for (int j = 0; j < 8; ++j) { const int n = (lane & 3) + 4 * j; const LAS float* sp = scr + (8 * c16) * 33 + n;
        v4u o; o.x = pk2(sp[0 * 33], sp[1 * 33]); o.y = pk2(sp[2 * 33], sp[3 * 33]); o.z = pk2(sp[4 * 33], sp[5 * 33]); o.w = pk2(sp[6 * 33], sp[7 * 33]);
        *(GAS v4u*)(WT + (size_t)(drow0 + n) * K + k0 + 8 * c16) = o; }
    LDS_WAIT(); asm volatile("" ::: "memory");
}
__device__ __forceinline__ void tr_plain(const float* W, int K, int N, const float* gain, bf16* WT, int drow_off, LAS float* scr, int item, int lane) {
    const int nblk = N / 32, kb = item / nblk, nb = item % nblk;
    tr_item(W, N, K, 128 * kb, 32 * nb, gain, WT, drow_off + 32 * nb, scr, lane);
}
__device__ __forceinline__ void tr_gated(const float* W, int K, int N, const float* gain, bf16* WT, int half, LAS float* scr, int item, int lane) {
    const int nblk = N / 32, kb = item / nblk, nb = item % nblk, n0 = 32 * nb;
    tr_item(W, N, K, 128 * kb, n0, gain, WT, (n0 >> 7) * 256 + half * 128 + (n0 & 127), scr, lane);
}
__device__ __forceinline__ float rms_row_to_bf16(const float* xrow, bf16* orow, int lane, f32x4 (&v)[4]) {
    const GAS f32x4* xr = (const GAS f32x4*)xrow + lane;
    float s = 0.f;
#pragma unroll
    for (int j = 0; j < 4; ++j) { v[j] = xr[64 * j]; s += (v[j].x * v[j].x + v[j].y * v[j].y) + (v[j].z * v[j].z + v[j].w * v[j].w); }
    const float rstd = 1.f / sqrtf(wave_sum(s) * (1.f / D) + EPS);
    GAS unsigned long long* o8 = (GAS unsigned long long*)orow + lane;
#pragma unroll
    for (int j = 0; j < 4; ++j) o8[64 * j] = (unsigned long long)pk2(v[j].x * rstd, v[j].y * rstd) | ((unsigned long long)pk2(v[j].z * rstd, v[j].w * rstd) << 32);
    return rstd;
}
__device__ __forceinline__ void norm_phase(const Frame& F, const float* x, bf16* xn) {
    const int tid = fresh((int)threadIdx.x), lane = tid & 63; (void)lane;
    const int gw = F.vcu * NWAVES + F.wave, NGW = F.G * NWAVES;
    for (int m = 2 * gw; m < M; m += 2 * NGW) {
        const GAS f32x4* xr = (const GAS f32x4*)(x + (size_t)m * D) + lane;
        f32x4 v[8]; float s0 = 0.f, s1 = 0.f;
#pragma unroll
        for (int j = 0; j < 8; ++j) v[j] = xr[64 * j];
#pragma unroll
        for (int j = 0; j < 4; ++j) { s0 += (v[j].x * v[j].x + v[j].y * v[j].y) + (v[j].z * v[j].z + v[j].w * v[j].w); s1 += (v[4 + j].x * v[4 + j].x + v[4 + j].y * v[4 + j].y) + (v[4 + j].z * v[4 + j].z + v[4 + j].w * v[4 + j].w); }
        const float r0 = 1.f / sqrtf(wave_sum(s0) * (1.f / D) + EPS), r1 = 1.f / sqrtf(wave_sum(s1) * (1.f / D) + EPS);
        GAS unsigned long long* o8 = (GAS unsigned long long*)(xn + (size_t)m * D) + lane;
#pragma unroll
        for (int j = 0; j < 8; ++j) { const float rr = j < 4 ? r0 : r1; o8[64 * j] = (unsigned long long)pk2(v[j].x * rr, v[j].y * rr) | ((unsigned long long)pk2(v[j].z * rr, v[j].w * rr) << 32); }
    }
}

__device__ __forceinline__ void p0_prologue(const Frame& F) {
    const int tid = fresh((int)threadIdx.x), lane = tid & 63; (void)lane;
    LAS float* scr = (LAS float*)(F.lds + RING_OFF + F.wave * P0_SCR);
    unsigned char* ws = WSP;
    const int gw = F.vcu * NWAVES + F.wave, NGW = F.G * NWAVES;
    constexpr int I_DQ = 8 * 12, I_DKV = 8 * 9, I_UQ = 3 * 48, I_UKV = 2 * 64, I_SQ = 8 * 32, I_F13 = 8 * 88, I_F2 = 22 * 32, I_M13 = 8 * 112, I_M2 = 28 * 32;
    constexpr int NSMALL = I_DQ + I_DKV + I_UQ + I_UKV + I_SQ + 2 * I_F13 + I_F2 + 4 * I_SQ;
    constexpr int NITEMS = NSMALL + NE * (2 * I_M13 + I_M2);
    for (int it = gw; it < NITEMS; it += NGW) {
        int r = it;
        if (r < I_DQ)  { tr_plain(INP(I_A_WDQ), D, QLORA, INP(I_ATTN_NORM), (bf16*)(ws + WS_WA), 0, scr, r, lane); continue; } r -= I_DQ;
        if (r < I_DKV) { tr_plain(INP(I_A_WDKV), D, KVLORA + ROPE_D, INP(I_ATTN_NORM), (bf16*)(ws + WS_WA), QLORA, scr, r, lane); continue; } r -= I_DKV;
        if (r < I_UQ)  { tr_plain(INP(I_A_WUQ), QLORA, NH * QKD, INP(I_A_GCQ), (bf16*)(ws + WS_WUQ), 0, scr, r, lane); continue; } r -= I_UQ;
        if (r < I_UKV) { const int kb = r / 64, n0 = 32 * (r % 64), head = n0 >> 7, within = n0 & 127;
            const int drow = within < 64 ? 256 * (head >> 2) + 128 * (within >> 5) + 32 * (head & 3) : 1024 + head * 64 + (within - 64);
            tr_item(INP(I_A_WUKV), NH * 128, KVLORA, 128 * kb, n0, INP(I_A_GCKV), (bf16*)(ws + WS_WUKV), drow, scr, lane); continue; } r -= I_UKV;
        if (r < I_SQ)  { tr_plain(INP(I_A_WO), D, D, nullptr, (bf16*)(ws + WS_WO), 0, scr, r, lane); continue; } r -= I_SQ;
        if (r < I_F13) { tr_gated(INP(I_FFN_W1), D, FF, INP(I_FFN_NORM), (bf16*)(ws + WS_WF1), 0, scr, r, lane); continue; } r -= I_F13;
        if (r < I_F13) { tr_gated(INP(I_FFN_W3), D, FF, INP(I_FFN_NORM), (bf16*)(ws + WS_WF1), 1, scr, r, lane); continue; } r -= I_F13;
        if (r < I_F2)  { tr_plain(INP(I_FFN_W2), FF, D, nullptr, (bf16*)(ws + WS_WF2), 0, scr, r, lane); continue; } r -= I_F2;
        if (r < I_SQ)  { const int kb = r / 32, n0 = 32 * (r % 32), head = n0 >> 6;
            tr_item(INP(I_KV_WK), D, D, 128 * kb, n0, INP(I_KV_NORM), (bf16*)(ws + WS_WKVQ), 256 * (head >> 2) + 128 * ((n0 >> 5) & 1) + 32 * (head & 3), scr, lane); continue; } r -= I_SQ;
        if (r < I_SQ)  { tr_plain(INP(I_KV_WV), D, D, INP(I_KV_NORM), (bf16*)(ws + WS_WKVQ), D, scr, r, lane); continue; } r -= I_SQ;
        if (r < I_SQ)  { const int kb = r / 32, n0 = 32 * (r % 32), head = n0 >> 6;
            tr_item(INP(I_B_WQ), D, D, 128 * kb, n0, INP(I_ATTN_NORM) + D, (bf16*)(ws + WS_WKVQ), 2 * D + 256 * (head >> 2) + 128 * ((n0 >> 5) & 1) + 32 * (head & 3), scr, lane); continue; } r -= I_SQ;
        if (r < I_SQ)  { tr_plain(INP(I_B_WO), D, D, nullptr, (bf16*)(ws + WS_WBO), 0, scr, r, lane); continue; } r -= I_SQ;
        const int e = r / (2 * I_M13 + I_M2); r -= e * (2 * I_M13 + I_M2);
        if (r < I_M13) { tr_gated(INP(I_MOE_W1) + (size_t)e * D * EFF, D, EFF, INP(I_FFN_NORM) + D, (bf16*)(ws + WS_WM1) + (size_t)e * 2 * EFF * D, 0, scr, r, lane); continue; } r -= I_M13;
        if (r < I_M13) { tr_gated(INP(I_MOE_W3) + (size_t)e * D * EFF, D, EFF, INP(I_FFN_NORM) + D, (bf16*)(ws + WS_WM1) + (size_t)e * 2 * EFF * D, 1, scr, r, lane); continue; } r -= I_M13;
        tr_plain(INP(I_MOE_W2) + (size_t)e * EFF * D, EFF, D, nullptr, (bf16*)(ws + WS_WM2) + (size_t)e * D * EFF, 0, scr, r, lane);
    }
    const int gt = F.vcu * (NWAVES * 64) + tid, NGT = F.G * NWAVES * 64;
    for (int c = gt; c < 96 * D * 2 / 16; c += NGT) *((GAS v4u*)(ws + WS_WA + (size_t)(QLORA + KVLORA + ROPE_D) * D * 2) + c) = (v4u){0u, 0u, 0u, 0u};
    for (int c = gt; c < SEQ * 16; c += NGT) { const int pos = c >> 4, i = c & 15;
        const float inv = __builtin_amdgcn_exp2f(-(float)i * (13.287712379549449f / 16.f));
        const float rev = (float)pos * inv * 0.15915494309189535f; const float fr = rev - floorf(rev);
        ((GAS float*)(ws + WS_ROPE))[2 * c] = __builtin_amdgcn_cosf(fr); ((GAS float*)(ws + WS_ROPE))[2 * c + 1] = __builtin_amdgcn_sinf(fr); }
    norm_phase(F, INP(I_X), (bf16*)(ws + WS_XN));
}

__device__ __forceinline__ void route_phase(const Frame& F) {
    const int tid = fresh((int)threadIdx.x), lane = tid & 63;
    unsigned char* ws = WSP;
    LAS float* wrg = (LAS float*)(F.lds + RING_OFF);
    LAS int* cnt = (LAS int*)(F.lds + RING_OFF + 32768);
    const float* wr = INP(I_MOE_ROUTER); const float* g = INP(I_FFN_NORM) + D;
    for (int idx = tid; idx < D * NE; idx += NWAVES * 64) { const int k = idx >> 3, e = idx & 7, j = k >> 8, l = (k & 255) >> 2, q = k & 3;
        wrg[((j * 4 + q) * 2 + (e >> 2)) * 256 + 4 * l + (e & 3)] = wr[idx] * g[k]; }
    __syncthreads();
    const int b5 = (lane >> 5) & 1, b4 = (lane >> 4) & 1, b3 = (lane >> 3) & 1;
    for (int c = F.vcu; c < M / 256; c += F.G) {
        if (tid < 16) cnt[tid] = 0;
        __syncthreads();
        for (int i = 0; i < 32; ++i) {
            const int m = c * 256 + F.wave * 32 + i;
            f32x4 v[4]; float ssx = 0.f;
            { const GAS f32x4* xr = (const GAS f32x4*)(OUTP + (size_t)m * D) + lane;
#pragma unroll
              for (int j = 0; j < 4; ++j) v[j] = xr[64 * j];
#pragma unroll
              for (int j = 0; j < 4; ++j) ssx += (v[j].x * v[j].x + v[j].y * v[j].y) + (v[j].z * v[j].z + v[j].w * v[j].w); }
            float lg[8];
#pragma unroll
            for (int e = 0; e < 8; ++e) lg[e] = 0.f;
#pragma unroll
            for (int j = 0; j < 4; ++j)
#pragma unroll
                for (int q = 0; q < 4; ++q) { const float xv = v[j][q];
                    const f32x4 w0 = *(const LAS f32x4*)(wrg + ((j * 4 + q) * 2) * 256 + 4 * lane), w1 = *(const LAS f32x4*)(wrg + ((j * 4 + q) * 2 + 1) * 256 + 4 * lane);
                    lg[0] += xv * w0.x; lg[1] += xv * w0.y; lg[2] += xv * w0.z; lg[3] += xv * w0.w; lg[4] += xv * w1.x; lg[5] += xv * w1.y; lg[6] += xv * w1.z; lg[7] += xv * w1.w; }
            float r4[4], r2[2], r1;
#pragma unroll
            for (int e = 0; e < 4; ++e) { const float mine = b5 ? lg[4 + e] : lg[e], other = b5 ? lg[e] : lg[4 + e]; r4[e] = mine + __shfl_xor(other, 32); }
#pragma unroll
            for (int e = 0; e < 2; ++e) { const float mine = b4 ? r4[2 + e] : r4[e], other = b4 ? r4[e] : r4[2 + e]; r2[e] = mine + __shfl_xor(other, 16); }
            { const float mine = b3 ? r2[1] : r2[0], other = b3 ? r2[0] : r2[1]; r1 = mine + __shfl_xor(other, 8); }
            r1 += __shfl_xor(r1, 4); r1 += __shfl_xor(r1, 2); r1 += __shfl_xor(r1, 1);
            const float rstd = 1.f / sqrtf(wave_sum(ssx) * (1.f / D) + EPS);
#pragma unroll
            for (int e = 0; e < 8; ++e) lg[e] = __builtin_bit_cast(float, __builtin_amdgcn_readlane(__builtin_bit_cast(int, r1), 8 * e)) * rstd;
            int e1 = 0; float l1 = lg[0];
#pragma unroll
            for (int e = 1; e < 8; ++e) if (lg[e] > l1) { l1 = lg[e]; e1 = e; }
            int e2 = -1; float l2 = -INFINITY;
#pragma unroll
            for (int e = 0; e < 8; ++e) if (e != e1 && lg[e] > l2) { l2 = lg[e]; e2 = e; }
            const float g1 = 1.f / (1.f + __expf(l2 - l1)), g2 = 1.f - g1;
            const int elo = e1 < e2 ? e1 : e2, ehi = e1 < e2 ? e2 : e1;
            const float glo = e1 < e2 ? g1 : g2, ghi = e1 < e2 ? g2 : g1;
            if (lane == 0) { ((GAS float*)(ws + WS_TOKRSTD))[m] = rstd; ((GAS int*)(ws + WS_TOKE))[m] = elo | (ehi << 8); ((GAS float*)(ws + WS_TOKG))[2 * m] = glo; ((GAS float*)(ws + WS_TOKG))[2 * m + 1] = ghi;
                atomicAdd((int*)&cnt[elo], 1); atomicAdd((int*)&cnt[8 + ehi], 1); }
        }
        __syncthreads();
        if (tid < 16) ((GAS int*)(ws + WS_CNT))[c * 16 + tid] = cnt[tid];
        __syncthreads();
    }
}

__device__ __forceinline__ void slot_phase(const Frame& F, unsigned char* ws) {
    const int tid = fresh((int)threadIdx.x), lane = tid & 63; (void)lane;
    LAS int* call = (LAS int*)(F.lds + RING_OFF);
    LAS int* tot = call + 4096; LAS int* base = tot + 16; LAS int* pre = base + 16; LAS int* meta = pre + 16;
    LAS int* grp = meta + 16;
    LAS int* slot_of = grp + 512;
    for (int idx = tid; idx < 4096; idx += NWAVES * 64) call[idx] = ((const GAS int*)(ws + WS_CNT))[idx];
    __syncthreads();
    if (tid < 16) { int t = 0; for (int cc = 0; cc < 256; ++cc) t += call[cc * 16 + tid]; tot[tid] = t; }
    __syncthreads();
    if (tid == 0) { int off = 0; for (int g = 0; g < 16; ++g) { base[g] = off; off += (tot[g] + 255) & ~255; if (g == 7) meta[0] = off >> 8; } meta[1] = (off >> 8) - meta[0]; }
    __syncthreads();
    for (int c = F.vcu; c < M / 256; c += F.G) {
        if (tid < 16) { int p = 0; for (int cc = 0; cc < c; ++cc) p += call[cc * 16 + tid]; pre[tid] = p; }
        const int hf = tid >> 8, i = tid & 255, m = c * 256 + i;
        const int te = ((const GAS int*)(ws + WS_TOKE))[m];
        const int g = hf * 8 + (hf ? ((te >> 8) & 0xff) : (te & 0xff));
        grp[tid] = g;
        __syncthreads();
        int rank = 0;
        for (int j = 0; j < i; ++j) rank += (grp[hf * 256 + j] == g) ? 1 : 0;
        const int slot = base[g] + pre[g] + rank;
        ((GAS int*)(ws + WS_SLOTTOK))[slot] = m; ((GAS float*)(ws + WS_SLOTGATE))[slot] = ((const GAS float*)(ws + WS_TOKG))[2 * m + hf];
        ((GAS float*)(ws + WS_SLOTRSTD))[slot] = ((const GAS float*)(ws + WS_TOKRSTD))[m];
        slot_of[tid] = slot;
        __syncthreads();
        for (int p = F.wave; p < 512; p += NWAVES) { const int mm = c * 256 + (p & 255), sl = slot_of[p];
            const GAS v4u* src = (const GAS v4u*)(ws + WS_XR3 + (size_t)mm * D * 2); GAS v4u* dst = (GAS v4u*)(ws + WS_XG + (size_t)sl * D * 2);
            const v4u x0 = src[lane], x1 = src[lane + 64]; dst[lane] = x0; dst[lane + 64] = x1; }
        __syncthreads();
    }
    for (int g = F.vcu; g < 16; g += F.G) {
        const int s0 = base[g] + tot[g], s1 = base[g] + ((tot[g] + 255) & ~255);
        for (int s = s0 + F.wave; s < s1; s += NWAVES) { GAS v4u* dst = (GAS v4u*)(ws + WS_XG + (size_t)s * D * 2);
            dst[lane] = (v4u){0u, 0u, 0u, 0u}; dst[lane + 64] = (v4u){0u, 0u, 0u, 0u};
            if (lane == 0) { ((GAS int*)(ws + WS_SLOTTOK))[s] = -1; ((GAS float*)(ws + WS_SLOTGATE))[s] = 0.f; ((GAS float*)(ws + WS_SLOTRSTD))[s] = 0.f; } }
    }
    if (F.vcu == 0) {
        if (tid < 16) { const int p0 = base[tid] >> 8, p1 = (base[tid] + ((tot[tid] + 255) & ~255)) >> 8; for (int p = p0; p < p1; ++p) ((GAS int*)(ws + WS_PANELE))[p] = tid & 7; }
        if (tid == 0) { ((GAS int*)(ws + WS_META))[0] = meta[0]; ((GAS int*)(ws + WS_META))[1] = meta[1]; }
    }
    __syncthreads();
}

__global__ void __launch_bounds__(NWAVES * 64, 2) yoco_fwd(Args args) {
    extern __shared__ __attribute__((aligned(16))) unsigned char lds_raw[];
    Frame F;
    F.lds = (LAS unsigned char*)lds_raw;
    F.wave = __builtin_amdgcn_readfirstlane((int)threadIdx.x >> 6);
    F.G = gridDim.x; { const int bx = blockIdx.x; F.vcu = (F.G % 8 == 0) ? (bx % 8) * (F.G / 8) + bx / 8 : bx; }
    unsigned char* ws = WSP;
    volatile LAS unsigned* MISC = (volatile LAS unsigned*)(F.lds + MISC_OFF);
    for (int u = fresh((int)threadIdx.x); u < (LDS_BYTES - LDSCTL_OFF) / 4; u += NWAVES * 64) ((LAS unsigned*)(F.lds + LDSCTL_OFF))[u] = 0u;
    __syncthreads();
    (void)xcd_barrier_post((unsigned*)(ws + WS_CTL) + CW_BAR, MISC + 8);
    LAS unsigned char* ring = F.lds + RING_OFF;
#define bid ((int)blockIdx.x)
#define GRID_BAR() do { XcdBarrier b_; b_.bar = (unsigned*)(WSP + WS_CTL) + CW_BAR; b_.x = xb_xcc_id(); b_.st = (volatile LAS unsigned*)(F.lds + MISC_OFF) + 8; xcd_barrier(b_); } while (0)
#define GEMM(EpiT, SchedT) pg8::gemm_phase<EpiT, SchedT, true, true>

    p0_prologue(F);
    GRID_BAR();
    { pg8::Gemm g{(const bf16*)(ws + WS_XN), (const bf16*)(ws + WS_WA), M, NA, D, D}; pg8::StaticOrder S; S.init(M, NA, F.G, bid);
      pg8::EpiQA E{(bf16*)(ws + WS_QA), (float*)(ws + WS_PARTQA)};
      GEMM(pg8::EpiQA, pg8::StaticOrder)(ring, g, S, E); }
    GRID_BAR();
    { pg8::Gemm g{(const bf16*)(ws + WS_QA), (const bf16*)(ws + WS_WUQ), M, NH * QKD, QLORA, NA}; pg8::StaticOrder S; S.init(M, NH * QKD, F.G, bid);
      pg8::EpiRowScaleBf16 E{(bf16*)(ws + WS_Q), NH * QKD, (const float*)(ws + WS_PARTQA), 1.f / QLORA};
      GEMM(pg8::EpiRowScaleBf16, pg8::StaticOrder)(ring, g, S, E); }
    { pg8::Gemm g{(const bf16*)(ws + WS_QA) + QLORA, (const bf16*)(ws + WS_WUKV), M, NH * 128, KVLORA, NA}; pg8::StaticOrder S; S.init(M, NH * 128, F.G, bid);
      pg8::EpiKVup E{(bf16*)(ws + WS_K), (bf16*)(ws + WS_V), (const float*)(ws + WS_PARTQA), (const bf16*)(ws + WS_QA), INP(I_A_GKN), (const float*)(ws + WS_ROPE)};
      GEMM(pg8::EpiKVup, pg8::StaticOrder)(ring, g, S, E); }
    GRID_BAR();
    for (int p = F.vcu; p < BATCH * NH * 4; p += F.G) {
        const int bh = p >> 2, pid = p & 3, b = bh >> 4, h = bh & 15;
        for (int u2 = 0; u2 < 2; ++u2) {
            const int qb = u2 ? 7 - pid : pid;
            att::attn_unit<96, false, 1536, 1536, D, D>(ring, (const bf16*)(ws + WS_Q) + (size_t)b * SEQ * 1536 + h * QKD, (const bf16*)(ws + WS_K) + (size_t)b * SEQ * 1536 + h * QKD,
                                      (const bf16*)(ws + WS_V) + (size_t)b * SEQ * D + h * 64, (bf16*)(ws + WS_O) + (size_t)b * SEQ * D + h * 64,
                                      256 * qb, 0, 4 * qb + 3, 0, 4 * qb + (F.wave >> 1), 0, nullptr, INP(I_A_GQN), (const float*)(ws + WS_ROPE));
        }
    }
    GRID_BAR();
    { pg8::Gemm g{(const bf16*)(ws + WS_O), (const bf16*)(ws + WS_WO), M, D, D, D}; pg8::StaticOrder S; S.init(M, D, F.G, bid);
      pg8::EpiResNorm<true> E{INP(I_X), OUTP, (bf16*)(ws + WS_XR1), (float*)(ws + WS_PART1)};
      GEMM(pg8::EpiResNorm<true>, pg8::StaticOrder)(ring, g, S, E); }
    GRID_BAR();
    { pg8::Gemm g{(const bf16*)(ws + WS_XR1), (const bf16*)(ws + WS_WF1), M, 2 * FF, D, D}; pg8::StaticOrder S; S.init(M, 2 * FF, F.G, bid);
      pg8::EpiGated<true> E{(bf16*)(ws + WS_H), FF, 0, (const float*)(ws + WS_PART1)};
      GEMM(pg8::EpiGated<true>, pg8::StaticOrder)(ring, g, S, E); }
    GRID_BAR();
    { pg8::Gemm g{(const bf16*)(ws + WS_H), (const bf16*)(ws + WS_WF2), M, D, FF, FF}; pg8::StaticOrder S; S.init(M, D, F.G, bid);
      pg8::EpiResNorm<true> E{OUTP, OUTP, (bf16*)(ws + WS_XR2), (float*)(ws + WS_PART2)};
      GEMM(pg8::EpiResNorm<true>, pg8::StaticOrder)(ring, g, S, E); }
    GRID_BAR();
    { pg8::Gemm g{(const bf16*)(ws + WS_XR2), (const bf16*)(ws + WS_WKVQ), M, 3 * D, D, D}; pg8::StaticOrder S; S.init(M, 3 * D, F.G, bid);
      pg8::EpiKVQ2 E{(bf16*)(ws + WS_KVQ2), (const float*)(ws + WS_PART2), INP(I_KV_GKN), INP(I_B_GQN)};
      GEMM(pg8::EpiKVQ2, pg8::StaticOrder)(ring, g, S, E); }
    GRID_BAR();
    for (int p = F.vcu; p < BATCH * NH * 8; p += F.G) {
        const int bh = p >> 3, cb = ((p & 7) + (p >> 8)) & 7, b = bh >> 4, h = bh & 15;
        const int c0 = 4 * cb, cc = c0 + (F.wave >> 1);
        const bf16* base = (const bf16*)(ws + WS_KVQ2) + (size_t)b * SEQ * 3072 + h * 64;
        att::attn_unit<64, true, 3072, 3072, 3072, D>(ring, base + 2048, base, base + 1024, (bf16*)(ws + WS_O2) + (size_t)b * SEQ * D + h * 64,
                                 256 * cb, c0 - 8 < 0 ? 0 : c0 - 8, c0 + 3, cc - 8 < 0 ? 0 : cc - 8, cc, cc, INP(I_B_RELB) + h * 257, nullptr, nullptr);
    }
    GRID_BAR();
    { pg8::Gemm g{(const bf16*)(ws + WS_O2), (const bf16*)(ws + WS_WBO), M, D, D, D}; pg8::StaticOrder S; S.init(M, D, F.G, bid);
      pg8::EpiResNorm<false> E{OUTP, OUTP, (bf16*)(ws + WS_XR3), nullptr};
      GEMM(pg8::EpiResNorm<false>, pg8::StaticOrder)(ring, g, S, E); }
    GRID_BAR();
    route_phase(F);
    GRID_BAR();
    slot_phase(F, ws);
    GRID_BAR();
    {
        const int nPA = __builtin_amdgcn_readfirstlane(((const GAS int*)(ws + WS_META))[0]), nPB = __builtin_amdgcn_readfirstlane(((const GAS int*)(ws + WS_META))[1]);
        for (int hf = 0; hf < 2; ++hf) {
            const int nP = hf ? nPB : nPA, p0 = hf ? nPA : 0;
            { pg8::Gemm g{(const bf16*)(ws + WS_XG) + (size_t)p0 * 256 * D, (const bf16*)(ws + WS_WM1), nP * 256, 2 * EFF, D, D};
              pg8::MoeOrder S; S.init(nP, 2 * EFF / 256, F.G, bid, (const int*)(ws + WS_PANELE) + p0);
              pg8::EpiGated<false> E{(bf16*)(ws + WS_HM), EFF, 2 * EFF / 256, (const float*)(ws + WS_SLOTRSTD) + (size_t)p0 * 256};
              GEMM(pg8::EpiGated<false>, pg8::MoeOrder)(ring, g, S, E); }
            GRID_BAR();
            { pg8::Gemm g{(const bf16*)(ws + WS_HM), (const bf16*)(ws + WS_WM2), nP * 256, D, EFF, EFF};
              pg8::MoeOrder S; S.init(nP, D / 256, F.G, bid, (const int*)(ws + WS_PANELE) + p0);
              pg8::EpiMoeDown E{OUTP, (const int*)(ws + WS_SLOTTOK), (const float*)(ws + WS_SLOTGATE), p0 * 256, D};
              GEMM(pg8::EpiMoeDown, pg8::MoeOrder)(ring, g, S, E); }
            if (hf == 0) GRID_BAR();
        }
    }
#undef GRID_BAR
#undef bid
#undef GEMM
}

extern "C" void kernel_launch(void* const* d_in, const int* in_sizes, int n_in, void* d_out, int out_size, void* d_ws, size_t ws_size, hipStream_t stream) {
    static int grid = 0;
    if (grid == 0) {
        if (n_in != 27 || in_sizes[0] != M * D || out_size != M * D || ws_size < WS_END) { fprintf(stderr, "kernel_launch: unexpected shapes (n_in %d, in0 %d, out %d, ws %zu < %zu); nothing launched\n", n_in, n_in > 0 ? in_sizes[0] : -1, out_size, ws_size, (size_t)WS_END); grid = -1; return; }
        int dev = 0, cus = 0, per_cu = 0;
        if (hipGetDevice(&dev) != hipSuccess || hipDeviceGetAttribute(&cus, hipDeviceAttributeMultiprocessorCount, dev) != hipSuccess) { grid = -1; return; }
        if (hipFuncSetAttribute((const void*)yoco_fwd, hipFuncAttributeMaxDynamicSharedMemorySize, LDS_BYTES) != hipSuccess) { fprintf(stderr, "kernel_launch: hipFuncSetAttribute failed\n"); grid = -1; return; }
        if (hipOccupancyMaxActiveBlocksPerMultiprocessor(&per_cu, (const void*)yoco_fwd, NWAVES * 64, LDS_BYTES) != hipSuccess || per_cu < 1) { fprintf(stderr, "kernel_launch: occupancy query says %d\n", per_cu); }
        (void)hipGetLastError();
        grid = cus;
    }
    if (grid < 0) return;
    if (hipMemsetAsync((char*)d_ws + WS_CTL, 0, CTL_ZERO_BYTES, stream) != hipSuccess) return;
    Args a{};
    for (int i = 0; i < 27; ++i) a.in[i] = (const float*)d_in[i];
    a.out = (float*)d_out; a.ws = (unsigned char*)d_ws;
    hipLaunchKernelGGL(yoco_fwd, dim3(grid), dim3(NWAVES * 64), LDS_BYTES, stream, a);
}
```

```cpp
#include <hip/hip_runtime.h>
#include <cstdio>
#include <cstdint>
namespace pg8 {
#define PG8_LAS __attribute__((address_space(3)))
typedef unsigned short bf16_t;
typedef short bf16x8 __attribute__((ext_vector_type(8)));
typedef float f32x4 __attribute__((ext_vector_type(4)));
typedef unsigned u32x4 __attribute__((ext_vector_type(4)));
constexpr int BM = 256, BK = 64, HALF = 128, HTB = HALF * BK * 2  , STAGE_BYTES = 8 * HTB, NXCD = 8, WGM = 8;

__host__ __device__ __forceinline__ int lds_byte(int r, int c) { const int st = (r >> 4) * 2 + (c >> 5), rr = r & 15, cc = c & 31, ob = rr * 64 + cc * 2; return st * 1024 + (ob ^ (((ob >> 9) & 1) << 5)); }
__host__ __device__ __forceinline__ void stage_rc(int b, int& R, int& C) { const int st = b / 1024, sb = b % 1024, swz = sb ^ (((sb >> 9) & 1) << 5); R = (st >> 1) * 16 + swz / 64; C = (st & 1) * 32 + (swz % 64) / 2; }
__host__ __device__ __forceinline__ int perm32(int rho) { const int n = rho >> 4, i = rho & 15; return 8 * (i >> 2) + 4 * n + (i & 3); }

struct Unit { int pm, pn; };
struct Gemm { const bf16_t* A; const bf16_t* Bt; int M, N, K, lda; };

struct StaticOrder {
    int nM, nN, nwg, G, c;
    __host__ __device__ void init(int M, int N, int G_, int c_) { nM = M / BM; nN = N / BM; nwg = nM * nN; G = G_; c = c_; }
    __host__ __device__ bool next(int i, Unit& u) const {
        const long L = (long)i * G + c; if (L >= nwg) return false;
        int wgid = (int)L; { const int q = nwg / NXCD, r = nwg % NXCD, xcd = wgid % NXCD, off = wgid / NXCD; wgid = (xcd < r ? xcd * (q + 1) : r * (q + 1) + (xcd - r) * q) + off; }
        const int nig = WGM * nN, gid = wgid / nig, fm = gid * WGM, gsz = (nM - fm) < WGM ? (nM - fm) : WGM;
        u.pm = fm + ((wgid % nig) % gsz); u.pn = (wgid % nig) / gsz; return true;
    }
    __device__ __forceinline__ void a_ready(const Unit&) const {}
    __device__ __forceinline__ void done(const Unit&) const {}
};
__device__ __forceinline__ unsigned cvt_pk_bf16(float lo, float hi) { unsigned r; asm volatile("v_cvt_pk_bf16_f32 %0, %1, %2" : "=v"(r) : "v"(lo), "v"(hi)); return r; }
__device__ __forceinline__ float silu_f(float x) { const float e = __builtin_amdgcn_exp2f(x * -1.4426950408889634f); return x * __builtin_amdgcn_rcpf(1.f + e); }

__device__ __forceinline__ float sum4(const f32x4& a) { return (a[0] + a[1]) + (a[2] + a[3]); }
__device__ __forceinline__ float part_sum8(const float* p) { return sum4(*(const f32x4*)p) + sum4(*(const f32x4*)(p + 4)); }
__device__ __forceinline__ float part_sum16(const float* p) { return (sum4(*(const f32x4*)p) + sum4(*(const f32x4*)(p + 4))) + (sum4(*(const f32x4*)(p + 8)) + sum4(*(const f32x4*)(p + 12))); }
__device__ __forceinline__ float fq_sum(float v) { v += __shfl_xor(v, 16); v += __shfl_xor(v, 32); return v; }
__device__ __forceinline__ float sq8(const f32x4& a, const f32x4& b) { return ((a[0] * a[0] + a[1] * a[1]) + (a[2] * a[2] + a[3] * a[3])) + ((b[0] * b[0] + b[1] * b[1]) + (b[2] * b[2] + b[3] * b[3])); }
__device__ __forceinline__ u32x4 pack8(const f32x4& a, const f32x4& b) { u32x4 w; w.x = cvt_pk_bf16(a[0], a[1]); w.y = cvt_pk_bf16(a[2], a[3]); w.z = cvt_pk_bf16(b[0], b[1]); w.w = cvt_pk_bf16(b[2], b[3]); return w; }
constexpr float EPS_ = 1e-6f;
__device__ __forceinline__ unsigned pk_fp8x4(float a, float b, float c, float d) { int w = 0; w = __builtin_amdgcn_cvt_pk_fp8_f32(a, b, w, false); w = __builtin_amdgcn_cvt_pk_fp8_f32(c, d, w, true); return (unsigned)w; }

struct EpiQA {
    static constexpr bool PERM = true, AFTER_DRAIN = false;
    bf16_t* O; float* part;
    __device__ __forceinline__ void operator()(const f32x4 (&acc)[2][2][4][2], const Unit& u, int wr, int wc, int fr, int fq) const {
        { int t_ = threadIdx.x; asm volatile("" : "+v"(t_)); fr = t_ & 15; fq = (t_ >> 4) & 3; }
        const int row0 = u.pm * BM + wr * 64 + fr, col0 = u.pn * BM + wc * 32 + 8 * fq;
#pragma unroll
        for (int ai = 0; ai < 2; ++ai)
#pragma unroll
            for (int m = 0; m < 4; ++m) { const int row = row0 + ai * HALF + m * 16; bf16_t* rowp = O + (size_t)row * 768 + col0;
                *(u32x4*)(rowp) = pack8(acc[ai][0][m][0], acc[ai][0][m][1]); *(u32x4*)(rowp + HALF) = pack8(acc[ai][1][m][0], acc[ai][1][m][1]);
                const float s0 = sq8(acc[ai][0][m][0], acc[ai][0][m][1]), s1 = sq8(acc[ai][1][m][0], acc[ai][1][m][1]);
                float* pr = part + (size_t)row * 16;
                if (u.pn == 0) { const float t = fq_sum(s0 + s1); if (fq == 0) pr[wc] = t; }
                else if (u.pn == 1) { const float t0 = fq_sum(s0), t1 = fq_sum(s1); if (fq == 0) { pr[4 + wc] = t0; pr[8 + wc] = t1; } }
                else { const float t = fq_sum(s0); if (fq == 0) pr[12 + wc] = t; } }
    }
};

struct EpiRowScaleBf16 {
    static constexpr bool PERM = true, AFTER_DRAIN = false;
    bf16_t* O; int ldc; const float* part; float inv_n;
    __device__ __forceinline__ void operator()(const f32x4 (&acc)[2][2][4][2], const Unit& u, int wr, int wc, int fr, int fq) const {
        { int t_ = threadIdx.x; asm volatile("" : "+v"(t_)); fr = t_ & 15; fq = (t_ >> 4) & 3; }
        const int row0 = u.pm * BM + wr * 64 + fr, col0 = u.pn * BM + wc * 32 + 8 * fq;
#pragma unroll
        for (int ai = 0; ai < 2; ++ai)
#pragma unroll
            for (int m = 0; m < 4; ++m) { const int row = row0 + ai * HALF + m * 16; bf16_t* rowp = O + (size_t)row * ldc + col0;
                const float rs = __builtin_amdgcn_rsqf(part_sum8(part + (size_t)row * 16) * inv_n + EPS_);
                *(u32x4*)(rowp) = pack8(acc[ai][0][m][0] * rs, acc[ai][0][m][1] * rs); *(u32x4*)(rowp + HALF) = pack8(acc[ai][1][m][0] * rs, acc[ai][1][m][1] * rs); }
    }
};

struct EpiKVup {
    static constexpr bool PERM = true, AFTER_DRAIN = false;
    bf16_t* Kd; bf16_t* Vd; const float* part; const bf16_t* QA; const float* g_kn; const float* rope;
    __device__ __forceinline__ void operator()(const f32x4 (&acc)[2][2][4][2], const Unit& u, int wr, int wc, int fr, int fq) const {
        { int t_ = threadIdx.x; asm volatile("" : "+v"(t_)); fr = t_ & 15; fq = (t_ >> 4) & 3; }
        const int row0 = u.pm * BM + wr * 64 + fr;
        if (u.pn >= 4) {
            const int col0 = (u.pn - 4) * BM + wc * 32 + 8 * fq;
#pragma unroll
            for (int ai = 0; ai < 2; ++ai)
#pragma unroll
                for (int m = 0; m < 4; ++m) { const int row = row0 + ai * HALF + m * 16; bf16_t* rowp = Vd + (size_t)row * 1024 + col0;
                    const float rs = __builtin_amdgcn_rsqf(part_sum8(part + (size_t)row * 16 + 8) * (1.f / 256) + EPS_);
                    *(u32x4*)(rowp) = pack8(acc[ai][0][m][0] * rs, acc[ai][0][m][1] * rs); *(u32x4*)(rowp + HALF) = pack8(acc[ai][1][m][0] * rs, acc[ai][1][m][1] * rs); }
            return;
        }
        const int head = 4 * u.pn + wc;
        f32x4 gA0 = *(const f32x4*)(g_kn + 8 * fq), gA1 = *(const f32x4*)(g_kn + 8 * fq + 4), gB0 = *(const f32x4*)(g_kn + 32 + 8 * fq), gB1 = *(const f32x4*)(g_kn + 32 + 8 * fq + 4);
        const f32x4 gR1 = *(const f32x4*)(g_kn + 64 + 4 * fq), gR2 = *(const f32x4*)(g_kn + 80 + 4 * fq);
#pragma unroll
        for (int ai = 0; ai < 2; ++ai)
#pragma unroll
            for (int m = 0; m < 4; ++m) { const int row = row0 + ai * HALF + m * 16;
                const float rs = __builtin_amdgcn_rsqf(part_sum8(part + (size_t)row * 16 + 8) * (1.f / 256) + EPS_);
                f32x4 a0 = acc[ai][0][m][0] * rs, a1 = acc[ai][0][m][1] * rs, b0 = acc[ai][1][m][0] * rs, b1 = acc[ai][1][m][1] * rs;
                const unsigned long long p1 = *(const unsigned long long*)(QA + (size_t)row * 768 + 640 + 4 * fq), p2 = *(const unsigned long long*)(QA + (size_t)row * 768 + 656 + 4 * fq);
                f32x4 x1, x2;
                x1[0] = __builtin_bit_cast(float, (unsigned)(p1 << 16)); x1[1] = __builtin_bit_cast(float, (unsigned)p1 & 0xffff0000u);
                x1[2] = __builtin_bit_cast(float, (unsigned)(p1 >> 32) << 16); x1[3] = __builtin_bit_cast(float, (unsigned)(p1 >> 32) & 0xffff0000u);
                x2[0] = __builtin_bit_cast(float, (unsigned)(p2 << 16)); x2[1] = __builtin_bit_cast(float, (unsigned)p2 & 0xffff0000u);
                x2[2] = __builtin_bit_cast(float, (unsigned)(p2 >> 32) << 16); x2[3] = __builtin_bit_cast(float, (unsigned)(p2 >> 32) & 0xffff0000u);
                const float ss = fq_sum(sq8(a0, a1) + sq8(b0, b1) + sq8(x1, x2));
                const float sh = __builtin_amdgcn_rsqf(ss * (1.f / 96) + EPS_);
                bf16_t* kp = Kd + (size_t)row * 1536 + head * 96;
                *(u32x4*)(kp + 8 * fq) = pack8(a0 * gA0 * sh, a1 * gA1 * sh); *(u32x4*)(kp + 32 + 8 * fq) = pack8(b0 * gB0 * sh, b1 * gB1 * sh);
                const f32x4* rp = (const f32x4*)(rope + ((size_t)(row & 2047) * 16 + 4 * fq) * 2);
                const f32x4 c01 = rp[0], c23 = rp[1];
                const f32x4 y1 = x1 * gR1 * sh, y2 = x2 * gR2 * sh;
                f32x4 o1, o2;
                o1[0] = y1[0] * c01[0] - y2[0] * c01[1]; o2[0] = y2[0] * c01[0] + y1[0] * c01[1];
                o1[1] = y1[1] * c01[2] - y2[1] * c01[3]; o2[1] = y2[1] * c01[2] + y1[1] * c01[3];
                o1[2] = y1[2] * c23[0] - y2[2] * c23[1]; o2[2] = y2[2] * c23[0] + y1[2] * c23[1];
                o1[3] = y1[3] * c23[2] - y2[3] * c23[3]; o2[3] = y2[3] * c23[2] + y1[3] * c23[3];
                unsigned long long w1 = (unsigned long long)cvt_pk_bf16(o1[0], o1[1]) | ((unsigned long long)cvt_pk_bf16(o1[2], o1[3]) << 32);
                unsigned long long w2 = (unsigned long long)cvt_pk_bf16(o2[0], o2[1]) | ((unsigned long long)cvt_pk_bf16(o2[2], o2[3]) << 32);
                *(unsigned long long*)(kp + 64 + 4 * fq) = w1; *(unsigned long long*)(kp + 80 + 4 * fq) = w2; }
    }
};

struct EpiKVQ2 {
    static constexpr bool PERM = true, AFTER_DRAIN = false;
    bf16_t* O; const float* pss; const float* gk; const float* gq;
    __device__ __forceinline__ void operator()(const f32x4 (&acc)[2][2][4][2], const Unit& u, int wr, int wc, int fr, int fq) const {
        { int t_ = threadIdx.x; asm volatile("" : "+v"(t_)); fr = t_ & 15; fq = (t_ >> 4) & 3; }
        const int row0 = u.pm * BM + wr * 64 + fr, part = u.pn >> 2, tl = u.pn & 3;
        if (part == 1) {
            const int col0 = u.pn * BM + wc * 32 + 8 * fq;
#pragma unroll
            for (int ai = 0; ai < 2; ++ai)
#pragma unroll
                for (int m = 0; m < 4; ++m) { const int row = row0 + ai * HALF + m * 16; bf16_t* rowp = O + (size_t)row * 3072 + col0;
                    const float rs = __builtin_amdgcn_rsqf(part_sum16(pss + (size_t)row * 16) * (1.f / 1024) + EPS_);
                    *(u32x4*)(rowp) = pack8(acc[ai][0][m][0] * rs, acc[ai][0][m][1] * rs); *(u32x4*)(rowp + HALF) = pack8(acc[ai][1][m][0] * rs, acc[ai][1][m][1] * rs); }
            return;
        }
        const float* g = part ? gq : gk; const float post = part ? 0.125f * 1.4426950408889634f : 1.f;
        const f32x4 gA0 = *(const f32x4*)(g + 8 * fq) * post, gA1 = *(const f32x4*)(g + 8 * fq + 4) * post, gB0 = *(const f32x4*)(g + 32 + 8 * fq) * post, gB1 = *(const f32x4*)(g + 32 + 8 * fq + 4) * post;
        const int colh = part * 1024 + (4 * tl + wc) * 64;
#pragma unroll
        for (int ai = 0; ai < 2; ++ai)
#pragma unroll
            for (int m = 0; m < 4; ++m) { const int row = row0 + ai * HALF + m * 16; bf16_t* rowp = O + (size_t)row * 3072 + colh;
                const float rs = __builtin_amdgcn_rsqf(part_sum16(pss + (size_t)row * 16) * (1.f / 1024) + EPS_);
                const f32x4 a0 = acc[ai][0][m][0] * rs, a1 = acc[ai][0][m][1] * rs, b0 = acc[ai][1][m][0] * rs, b1 = acc[ai][1][m][1] * rs;
                const float ss = fq_sum(sq8(a0, a1) + sq8(b0, b1));
                const float sh = __builtin_amdgcn_rsqf(ss * (1.f / 64) + EPS_);
                *(u32x4*)(rowp + 8 * fq) = pack8(a0 * gA0 * sh, a1 * gA1 * sh); *(u32x4*)(rowp + 32 + 8 * fq) = pack8(b0 * gB0 * sh, b1 * gB1 * sh); }
    }
};

template <bool SSQ> struct EpiGated {
    static constexpr bool PERM = true, AFTER_DRAIN = false;
    bf16_t* Hd; int ldc; int ntile; const float* rs;
    __device__ __forceinline__ void operator()(const f32x4 (&acc)[2][2][4][2], const Unit& u, int wr, int wc, int fr, int fq) const {
        { int t_ = threadIdx.x; asm volatile("" : "+v"(t_)); fr = t_ & 15; fq = (t_ >> 4) & 3; }
        const int pnl = ntile ? (u.pn % ntile) : u.pn;
        const int row0 = u.pm * BM + wr * 64 + fr, col0 = pnl * HALF + wc * 32 + 8 * fq;
#pragma unroll
        for (int ai = 0; ai < 2; ++ai)
#pragma unroll
            for (int m = 0; m < 4; ++m) { const int row = row0 + ai * HALF + m * 16; bf16_t* rowp = Hd + (size_t)row * ldc + col0;
                const float r = SSQ ? __builtin_amdgcn_rsqf(part_sum16(rs + (size_t)row * 16) * (1.f / 1024) + EPS_) : rs[row];
                const f32x4 g0 = acc[ai][0][m][0] * r, g1 = acc[ai][0][m][1] * r, u0 = acc[ai][1][m][0] * r, u1 = acc[ai][1][m][1] * r;
                u32x4 w;
                w.x = cvt_pk_bf16(silu_f(g0[0]) * u0[0], silu_f(g0[1]) * u0[1]); w.y = cvt_pk_bf16(silu_f(g0[2]) * u0[2], silu_f(g0[3]) * u0[3]);
                w.z = cvt_pk_bf16(silu_f(g1[0]) * u1[0], silu_f(g1[1]) * u1[1]); w.w = cvt_pk_bf16(silu_f(g1[2]) * u1[2], silu_f(g1[3]) * u1[3]);
                *(u32x4*)rowp = w; }
    }
};

struct EpiGatedF8 {
    static constexpr bool PERM = true, AFTER_DRAIN = false;
    unsigned char* Hd; int ldc; int ntile; const float* rs;
    __device__ __forceinline__ void operator()(const f32x4 (&acc)[2][2][4][2], const Unit& u, int wr, int wc, int fr, int fq) const {
        { int t_ = threadIdx.x; asm volatile("" : "+v"(t_)); fr = t_ & 15; fq = (t_ >> 4) & 3; }
        const int pnl = u.pn % ntile;
        const int row0 = u.pm * BM + wr * 64 + fr, col0 = pnl * HALF + wc * 32 + 8 * fq;
#pragma unroll
        for (int ai = 0; ai < 2; ++ai)
#pragma unroll
            for (int m = 0; m < 4; ++m) { const int row = row0 + ai * HALF + m * 16; unsigned char* rowp = Hd + (size_t)row * ldc + col0;
                const float r = rs[row] * (1.f / 64);
                const f32x4 g0 = acc[ai][0][m][0] * r, g1 = acc[ai][0][m][1] * r, u0 = acc[ai][1][m][0] * r, u1 = acc[ai][1][m][1] * r;
                unsigned long long w = (unsigned long long)pk_fp8x4(silu_f(g0[0]) * u0[0], silu_f(g0[1]) * u0[1], silu_f(g0[2]) * u0[2], silu_f(g0[3]) * u0[3])
                                     | ((unsigned long long)pk_fp8x4(silu_f(g1[0]) * u1[0], silu_f(g1[1]) * u1[1], silu_f(g1[2]) * u1[2], silu_f(g1[3]) * u1[3]) << 32);
                *(unsigned long long*)rowp = w; }
    }
};

template <bool SSQ> struct EpiResNorm {
    static constexpr bool PERM = true, AFTER_DRAIN = false;
    const float* res; float* out; bf16_t* XR; float* ssq;
    __device__ __forceinline__ void operator()(const f32x4 (&acc)[2][2][4][2], const Unit& u, int wr, int wc, int fr, int fq) const {
        { int t_ = threadIdx.x; asm volatile("" : "+v"(t_)); fr = t_ & 15; fq = (t_ >> 4) & 3; }
        const int row0 = u.pm * BM + wr * 64 + fr, col0 = u.pn * BM + wc * 32 + 8 * fq;
#pragma unroll
        for (int ai = 0; ai < 2; ++ai)
#pragma unroll
            for (int m = 0; m < 4; ++m) { const int row = row0 + ai * HALF + m * 16; const size_t ro = (size_t)row * 1024 + col0;
                f32x4 r[2][2];
#pragma unroll
                for (int bj = 0; bj < 2; ++bj)
#pragma unroll
                    for (int n = 0; n < 2; ++n) r[bj][n] = *(const f32x4*)(res + ro + bj * HALF + n * 4);
#pragma unroll
                for (int bj = 0; bj < 2; ++bj)
#pragma unroll
                    for (int n = 0; n < 2; ++n) { r[bj][n] = r[bj][n] + acc[ai][bj][m][n]; *(f32x4*)(out + ro + bj * HALF + n * 4) = r[bj][n]; }
                *(u32x4*)(XR + ro) = pack8(r[0][0], r[0][1]); *(u32x4*)(XR + ro + HALF) = pack8(r[1][0], r[1][1]);
                if (SSQ) { const float t = fq_sum(sq8(r[0][0], r[0][1]) + sq8(r[1][0], r[1][1])); if (fq == 0) ssq[(size_t)row * 16 + u.pn * 4 + wc] = t; } }
    }
};

struct EpiMoeDown {
    static constexpr bool PERM = false, AFTER_DRAIN = false;
    float* out; const int* slot_tok; const float* slot_gate; int slot_base; int ldc; float wscale;
    __device__ __forceinline__ void operator()(const f32x4 (&acc)[2][2][4][2], const Unit& u, int wr, int wc, int fr, int fq) const {
        { int t_ = threadIdx.x; asm volatile("" : "+v"(t_)); fr = t_ & 15; fq = (t_ >> 4) & 3; }
        const int pnl = u.pn & 3;
        const int row0 = slot_base + u.pm * BM + wr * 64 + fr, col0 = pnl * BM + wc * 32 + 4 * fq;
#pragma unroll
        for (int ai = 0; ai < 2; ++ai)
#pragma unroll
            for (int m = 0; m < 4; ++m) { const int slot = row0 + ai * HALF + m * 16; const int tok = slot_tok[slot]; const float gt = slot_gate[slot] * wscale;
                if (tok >= 0) { float* rowp = out + (size_t)tok * ldc + col0;
                    f32x4 r[2][2];
#pragma unroll
                    for (int bj = 0; bj < 2; ++bj)
#pragma unroll
                        for (int n = 0; n < 2; ++n) r[bj][n] = *(const f32x4*)(rowp + bj * HALF + n * 16);
#pragma unroll
                    for (int bj = 0; bj < 2; ++bj)
#pragma unroll
                        for (int n = 0; n < 2; ++n) *(f32x4*)(rowp + bj * HALF + n * 16) = r[bj][n] + acc[ai][bj][m][n] * gt; } }
    }
};

struct MoeOrder {
    int nM, nN, nwg, G, c; const int* panel_e;
    __device__ void init(int nPanels, int nN_, int G_, int c_, const int* pe) { nM = nPanels; nN = nN_; nwg = nM * nN; G = G_; c = c_; panel_e = pe; }
    __device__ bool next(int i, Unit& u) const {
        const long L = (long)i * G + c; if (L >= nwg) return false;
        int wgid = (int)L; { const int q = nwg / NXCD, r = nwg % NXCD, xcd = wgid % NXCD, off = wgid / NXCD; wgid = (xcd < r ? xcd * (q + 1) : r * (q + 1) + (xcd - r) * q) + off; }
        const int nig = WGM * nN, gid = wgid / nig, fm = gid * WGM, gsz = (nM - fm) < WGM ? (nM - fm) : WGM;
        u.pm = fm + ((wgid % nig) % gsz); const int pnl = (wgid % nig) / gsz;
        const int e = __builtin_amdgcn_readfirstlane(panel_e[u.pm]);
        u.pn = e * nN + pnl; return true;
    }
    __device__ __forceinline__ void a_ready(const Unit&) const {}
    __device__ __forceinline__ void done(const Unit&) const {}
};
template <class Epi, class Sched, bool ALIGN_EPI = false, bool SP2 = false, bool F8 = false>
__device__ __forceinline__ void gemm_phase(PG8_LAS unsigned char* lds, const Gemm g, const Sched& S, const Epi& E) {
    int tid_ = threadIdx.x; asm volatile("" : "+v"(tid_));
    const int tid = tid_, wid = __builtin_amdgcn_readfirstlane(tid >> 6), lane = tid & 63, wr = wid >> 2, wc = wid & 3, fr = lane & 15, fq = lane >> 4;
    const int K = g.K, nt = K / BK;
    unsigned voffA0, voffB0;
    { int R, C; stage_rc(tid * 16, R, C); const int Rb = Epi::PERM ? ((R & ~31) + perm32(R & 31)) : R;
      voffA0 = (unsigned)(R * g.lda + C) * 2u; voffB0 = (unsigned)(Rb * K + C) * 2u; }
    const size_t voffAR = (size_t)64 * g.lda * 2, voffBR = (size_t)64 * K * 2;
    const size_t kstep = (size_t)(BK * 2);
    const size_t hstepA = (size_t)HALF * g.lda * 2, hstepB = (size_t)HALF * K * 2;
    const size_t tstepA = 2 * hstepA, tstepB = 2 * hstepB;
    const unsigned ldsw = (unsigned)wid * 1024u;
    const int aoff = lds_byte(wr * 64 + fr, fq * 8), boff = lds_byte(wc * 32 + fr, fq * 8);
#define PG8_SA(b, h) (((b) * 2 + (h)) * HTB)
#define PG8_SB(b, h) ((4 + (b) * 2 + (h)) * HTB)
#define PG8_STAGE(bufoff, gbase, voff) do { _Pragma("unroll") for (int _i = 0; _i < 2; ++_i) \
        __builtin_amdgcn_global_load_lds((const unsigned*)((const char*)(gbase) + (size_t)_i * voff##R + voff##0), (PG8_LAS unsigned*)(lds + (bufoff) + ldsw + _i * 8192), 16, 0, 0); } while (0)
#define PG8_LDA(dst, b, h) do { _Pragma("unroll") for (int m = 0; m < 4; ++m) _Pragma("unroll") for (int k = 0; k < 2; ++k) dst[m][k] = *(const PG8_LAS bf16x8*)(lds + PG8_SA(b, h) + aoff + m * 2048 + k * 1024); } while (0)
#define PG8_LDB(dst, b, h) do { _Pragma("unroll") for (int n = 0; n < 2; ++n) _Pragma("unroll") for (int k = 0; k < 2; ++k) dst[n][k] = *(const PG8_LAS bf16x8*)(lds + PG8_SB(b, h) + boff + n * 2048 + k * 1024); } while (0)
#define PG8_MMA(ai, bj, At, Bt) do { __builtin_amdgcn_s_setprio(1); _Pragma("unroll") for (int m = 0; m < 4; ++m) _Pragma("unroll") for (int n = 0; n < 2; ++n) { \
        if constexpr (F8) { typedef int v8i_ __attribute__((ext_vector_type(8))); typedef int v4i_ __attribute__((ext_vector_type(4))); \
            const v4i_ b0_ = __builtin_bit_cast(v4i_, Bt[n][0]), b1_ = __builtin_bit_cast(v4i_, Bt[n][1]), a0_ = __builtin_bit_cast(v4i_, At[m][0]), a1_ = __builtin_bit_cast(v4i_, At[m][1]); \
            const v8i_ bb_ = __builtin_shufflevector(b0_, b1_, 0, 1, 2, 3, 4, 5, 6, 7), aa_ = __builtin_shufflevector(a0_, a1_, 0, 1, 2, 3, 4, 5, 6, 7); \
            acc[ai][bj][m][n] = __builtin_amdgcn_mfma_scale_f32_16x16x128_f8f6f4(bb_, aa_, acc[ai][bj][m][n], 0, 0, 0, 0, 0, 0); } \
        else { _Pragma("unroll") for (int k = 0; k < 2; ++k) acc[ai][bj][m][n] = __builtin_amdgcn_mfma_f32_16x16x32_bf16(Bt[n][k], At[m][k], acc[ai][bj][m][n], 0, 0, 0); } } \
        __builtin_amdgcn_s_setprio(0); } while (0)
#define PG8_WAIT_V(n) asm volatile("s_waitcnt vmcnt(" #n ")" ::: "memory")
#define PG8_WAIT_L(n) asm volatile("s_waitcnt lgkmcnt(" #n ")" ::: "memory")
#define PG8_BAR __builtin_amdgcn_s_barrier()
#define PG8_SCHED __builtin_amdgcn_sched_barrier(0)
    Unit cur, nxt; int ui = 0;
    if (!S.next(0, cur)) return;
    f32x4 acc[2][2][4][2];
#pragma unroll
    for (int a = 0; a < 2; ++a)
#pragma unroll
        for (int b = 0; b < 2; ++b)
#pragma unroll
            for (int m = 0; m < 4; ++m)
#pragma unroll
                for (int n = 0; n < 2; ++n) acc[a][b][m][n] = (f32x4){0.f, 0.f, 0.f, 0.f};
    bf16x8 At[4][2], B0[2][2], B1[2][2];
    const char* cA = (const char*)g.A + (size_t)cur.pm * tstepA; const char* cB = (const char*)g.Bt + (size_t)cur.pn * tstepB;
    S.a_ready(cur);
    if constexpr (SP2) {
        PG8_STAGE(PG8_SB(0, 0), cB, voffB); PG8_STAGE(PG8_SB(0, 1), cB + hstepB, voffB); PG8_STAGE(PG8_SA(0, 0), cA, voffA); PG8_STAGE(PG8_SA(0, 1), cA + hstepA, voffA);
        if (wr == 1) PG8_BAR;
        PG8_WAIT_V(2); PG8_BAR;
        PG8_STAGE(PG8_SB(1, 0), cB + kstep, voffB); PG8_STAGE(PG8_SA(1, 0), cA + kstep, voffA); PG8_STAGE(PG8_SB(1, 1), cB + hstepB + kstep, voffB);
        PG8_WAIT_V(6); PG8_BAR;
    } else {
        PG8_STAGE(PG8_SB(0, 0), cB, voffB); PG8_STAGE(PG8_SA(0, 0), cA, voffA); PG8_STAGE(PG8_SB(0, 1), cB + hstepB, voffB); PG8_STAGE(PG8_SA(0, 1), cA + hstepA, voffA);
        if (wr == 1) PG8_BAR;
        PG8_WAIT_V(4); PG8_BAR;
        PG8_STAGE(PG8_SB(1, 0), cB + kstep, voffB); PG8_STAGE(PG8_SA(1, 0), cA + kstep, voffA); PG8_STAGE(PG8_SB(1, 1), cB + hstepB + kstep, voffB);
        PG8_WAIT_V(6); PG8_BAR;
    }
    for (;;) {
        const bool has_next = S.next(ui + 1, nxt);
        const char* nA = has_next ? (const char*)g.A + (size_t)nxt.pm * tstepA : cA; const char* nB = has_next ? (const char*)g.Bt + (size_t)nxt.pn * tstepB : cB;
#pragma unroll 1
        for (int t = 0; t < nt; t += 2) {
            const bool last = (t == nt - 2);
            const char* a1 = cA + (size_t)(t + 1) * kstep;
            const char* a2 = last ? nA : cA + (size_t)(t + 2) * kstep; const char* b2 = last ? nB : cB + (size_t)(t + 2) * kstep;
            const char* a3 = a2 + kstep; const char* b3 = b2 + kstep;
            if (last && has_next) S.a_ready(nxt);
            if constexpr (SP2) {
            PG8_LDB(B0, 0, 0); PG8_LDB(B1, 0, 1); PG8_SCHED; PG8_LDA(At, 0, 0); PG8_STAGE(PG8_SA(1, 1), a1 + hstepA, voffA);
            PG8_WAIT_V(8); PG8_WAIT_L(0); PG8_BAR; PG8_MMA(0, 0, At, B0); PG8_MMA(0, 1, At, B1); PG8_BAR; PG8_SCHED;
            PG8_LDA(At, 0, 1); PG8_STAGE(PG8_SB(0, 0), b2, voffB); PG8_STAGE(PG8_SB(0, 1), b2 + hstepB, voffB); PG8_STAGE(PG8_SA(0, 0), a2, voffA);
            PG8_WAIT_V(8); PG8_WAIT_L(0); PG8_BAR; PG8_MMA(1, 0, At, B0); PG8_MMA(1, 1, At, B1); PG8_BAR; PG8_SCHED;
            PG8_LDB(B0, 1, 0); PG8_LDB(B1, 1, 1); PG8_SCHED; PG8_LDA(At, 1, 0); PG8_STAGE(PG8_SA(0, 1), a2 + hstepA, voffA);
            PG8_WAIT_V(8); PG8_WAIT_L(0); PG8_BAR; PG8_MMA(0, 0, At, B0); PG8_MMA(0, 1, At, B1); PG8_BAR; PG8_SCHED;
            PG8_LDA(At, 1, 1); PG8_STAGE(PG8_SB(1, 0), b3, voffB); PG8_STAGE(PG8_SB(1, 1), b3 + hstepB, voffB); PG8_STAGE(PG8_SA(1, 0), a3, voffA);
            PG8_WAIT_V(8); PG8_WAIT_L(0); PG8_BAR; PG8_MMA(1, 0, At, B0); PG8_MMA(1, 1, At, B1); PG8_BAR; PG8_SCHED;
            } else {
            PG8_LDB(B0, 0, 0); PG8_SCHED; PG8_LDA(At, 0, 0); PG8_STAGE(PG8_SA(1, 1), a1 + hstepA, voffA);
            PG8_WAIT_L(8); PG8_BAR; PG8_WAIT_L(0); PG8_MMA(0, 0, At, B0); PG8_BAR; PG8_SCHED;
            PG8_LDB(B1, 0, 1); PG8_STAGE(PG8_SB(0, 0), b2, voffB);
            PG8_BAR; PG8_WAIT_L(0); PG8_MMA(0, 1, At, B1); PG8_BAR;
            PG8_LDA(At, 0, 1); PG8_STAGE(PG8_SA(0, 0), a2, voffA);
            PG8_BAR; PG8_WAIT_L(0); PG8_MMA(1, 0, At, B0); PG8_BAR; PG8_SCHED;
            PG8_STAGE(PG8_SB(0, 1), b2 + hstepB, voffB);
            PG8_WAIT_V(6); PG8_BAR; PG8_MMA(1, 1, At, B1); PG8_BAR;
            PG8_LDB(B0, 1, 0); PG8_SCHED; PG8_LDA(At, 1, 0); PG8_STAGE(PG8_SA(0, 1), a2 + hstepA, voffA);
            PG8_WAIT_L(8); PG8_BAR; PG8_WAIT_L(0); PG8_MMA(0, 0, At, B0); PG8_BAR; PG8_SCHED;
            PG8_LDB(B1, 1, 1); PG8_STAGE(PG8_SB(1, 0), b3, voffB);
            PG8_BAR; PG8_WAIT_L(0); PG8_MMA(0, 1, At, B1); PG8_BAR;
            PG8_LDA(At, 1, 1); PG8_STAGE(PG8_SA(1, 0), a3, voffA);
            PG8_BAR; PG8_WAIT_L(0); PG8_MMA(1, 0, At, B0); PG8_BAR; PG8_SCHED;
            PG8_STAGE(PG8_SB(1, 1), b3 + hstepB, voffB);
            PG8_WAIT_V(6); PG8_BAR; PG8_MMA(1, 1, At, B1); PG8_BAR;
            }
        }
        if constexpr (ALIGN_EPI) { if (wr == 0) PG8_BAR; }
        if constexpr (!Epi::AFTER_DRAIN) { E(acc, cur, wr, wc, fr, fq); S.done(cur); }
        if (!has_next) break;
#pragma unroll
        for (int a = 0; a < 2; ++a)
#pragma unroll
            for (int b = 0; b < 2; ++b)
#pragma unroll
                for (int m = 0; m < 4; ++m)
#pragma unroll
                    for (int n = 0; n < 2; ++n) acc[a][b][m][n] = (f32x4){0.f, 0.f, 0.f, 0.f};
        cur = nxt; cA = nA; cB = nB; ++ui;
        if constexpr (ALIGN_EPI) { if (wr == 1) PG8_BAR; }
    }
    PG8_WAIT_V(0);
    if constexpr (!ALIGN_EPI) { if (wr == 0) PG8_BAR; }
    PG8_BAR;
    if constexpr (Epi::AFTER_DRAIN) { E.fused(acc, cur, wr, wc, fr, fq, lds, wid, lane); S.done(cur); }
#undef PG8_SA
#undef PG8_SB
#undef PG8_STAGE
#undef PG8_LDA
#undef PG8_LDB
#undef PG8_MMA
#undef PG8_WAIT_V
#undef PG8_WAIT_L
#undef PG8_BAR
#undef PG8_SCHED
}
}
namespace att {
#define ATT_LAS __attribute__((address_space(3)))
typedef unsigned short bf16;
typedef short bf16x8 __attribute__((ext_vector_type(8)));
typedef short s16x4 __attribute__((ext_vector_type(4)));
typedef float f32x16 __attribute__((ext_vector_type(16)));
typedef float f32x4_t __attribute__((ext_vector_type(4)));
typedef unsigned u32x4 __attribute__((ext_vector_type(4)));
typedef unsigned u32x2 __attribute__((ext_vector_type(2)));
typedef float f32x2_t __attribute__((ext_vector_type(2))); typedef __bf16 bf16x2_t __attribute__((ext_vector_type(2)));
__device__ __forceinline__ unsigned cvtpk(float lo, float hi) { f32x2_t v = {lo, hi}; bf16x2_t b = __builtin_convertvector(v, bf16x2_t); return __builtin_bit_cast(unsigned, b); }
__device__ __forceinline__ s16x4 vtr(const ATT_LAS unsigned char* p) { return __builtin_bit_cast(s16x4, __builtin_amdgcn_ds_read_tr16_b64_v4i16((ATT_LAS s16x4*)p)); }
constexpr int VSTR = 192;
template <int DQK> struct Geo { static constexpr int KSTR = DQK * 2 + 16, KBUF = 64 * KSTR, VBUF = 64 * VSTR, CPR = DQK / 8, NKC = 64 * CPR, KIT = (NKC + 511) / 512; };
template <int DQK> constexpr int lds_bytes() { return 2 * Geo<DQK>::KBUF + 2 * Geo<DQK>::VBUF + 2048 + 8192; }

__device__ __forceinline__ float xhalf_max(float m) { auto rr = __builtin_amdgcn_permlane32_swap(__float_as_uint(m), __float_as_uint(m), false, false); return fmaxf(__uint_as_float(rr[0]), __uint_as_float(rr[1])); }
__device__ __forceinline__ float xhalf_sum(float m) { auto rr = __builtin_amdgcn_permlane32_swap(__float_as_uint(m), __float_as_uint(m), false, false); return __uint_as_float(rr[0]) + __uint_as_float(rr[1]); }
__device__ __forceinline__ float max3f(float a, float b, float c) { float r; asm("v_max3_f32 %0, %1, %2, %3" : "=v"(r) : "v"(a), "v"(b), "v"(c)); return r; }
__device__ __forceinline__ float max2f(float a, float b) { float r; asm("v_max_f32_e32 %0, %1, %2" : "=v"(r) : "v"(a), "v"(b)); return r; }
__device__ __forceinline__ float rowmax32(const f32x16& p0, const f32x16& p1) {
    float a = max2f(p0[0], p1[0]), b = max2f(p0[1], p1[1]);
#pragma unroll
    for (int r = 2; r < 16; r += 2) { a = max3f(a, p0[r], p1[r]); b = max3f(b, p0[r + 1], p1[r + 1]); }
    const float m = max2f(a, b);
    auto rr = __builtin_amdgcn_permlane32_swap(__float_as_uint(m), __float_as_uint(m), false, false);
    return max2f(__uint_as_float(rr[0]), __uint_as_float(rr[1]));
}

template <int DQK, bool BAND, int qpitch, int kpitch, int vpitch, int opitch>
__device__ __forceinline__ void attn_unit(ATT_LAS unsigned char* lds, const bf16* Qb, const bf16* Kb, const bf16* Vb, bf16* Ob,
                                          int q0, int t_lo, int t_hi, int my_lo, int my_hi, int cc, const float* bias_g, const float* g_qn, const float* rope) {
    typedef Geo<DQK> G;
    int tid_ = threadIdx.x; asm volatile("" : "+v"(tid_));
    const int tid = tid_, lane = tid & 63, r32 = lane & 31, hi = lane >> 5, wid = __builtin_amdgcn_readfirstlane(tid >> 6);
    ATT_LAS float* biasL = (ATT_LAS float*)(lds + 2 * G::KBUF + 2 * G::VBUF);
    bf16x8 qf[DQK / 16];
    { const bf16* qp = Qb + (size_t)(q0 + wid * 32 + r32) * qpitch + 8 * hi;
#pragma unroll
      for (int kk = 0; kk < DQK / 16; ++kk) qf[kk] = *(const bf16x8*)(qp + 16 * kk); }
    if constexpr (!BAND) {
        float qv[DQK / 16][8]; float ss = 0.f;
#pragma unroll
        for (int kk = 0; kk < DQK / 16; ++kk)
#pragma unroll
            for (int j = 0; j < 8; ++j) { qv[kk][j] = __builtin_bit_cast(float, (unsigned)(unsigned short)qf[kk][j] << 16); ss += qv[kk][j] * qv[kk][j]; }
        ss = xhalf_sum(ss);
        const float rs = __builtin_amdgcn_rsqf(ss * (1.f / DQK) + 1e-6f) * (0.10206207261596577f * 1.4426950408889634f);
#pragma unroll
        for (int kk = 0; kk < DQK / 16; ++kk) { const f32x4_t g0 = *(const f32x4_t*)(g_qn + 16 * kk + 8 * hi), g1 = *(const f32x4_t*)(g_qn + 16 * kk + 8 * hi + 4);
#pragma unroll
            for (int j = 0; j < 4; ++j) { qv[kk][j] *= rs * g0[j]; qv[kk][4 + j] *= rs * g1[j]; } }
        const f32x4_t* rp = (const f32x4_t*)(rope + ((size_t)(q0 + wid * 32 + r32) * 16 + 8 * hi) * 2);
#pragma unroll
        for (int j2 = 0; j2 < 4; ++j2) { const f32x4_t cs = rp[j2];
            { const float x1 = qv[4][2 * j2], x2 = qv[5][2 * j2]; qv[4][2 * j2] = x1 * cs[0] - x2 * cs[1]; qv[5][2 * j2] = x2 * cs[0] + x1 * cs[1]; }
            { const float x1 = qv[4][2 * j2 + 1], x2 = qv[5][2 * j2 + 1]; qv[4][2 * j2 + 1] = x1 * cs[2] - x2 * cs[3]; qv[5][2 * j2 + 1] = x2 * cs[2] + x1 * cs[3]; } }
#pragma unroll
        for (int kk = 0; kk < DQK / 16; ++kk) { u32x4 w; w.x = cvtpk(qv[kk][0], qv[kk][1]); w.y = cvtpk(qv[kk][2], qv[kk][3]); w.z = cvtpk(qv[kk][4], qv[kk][5]); w.w = cvtpk(qv[kk][6], qv[kk][7]);
            qf[kk] = __builtin_bit_cast(bf16x8, w); }
    }
    if (BAND) { if (tid < 257) biasL[tid] = bias_g[tid] * 1.4426950408889634f; }
    constexpr int KCPL = G::KSTR / 16, KNP = (64 * KCPL + 63) / 64;
    constexpr int VCPL = VSTR / 16, VNP = 64 * VCPL / 64;
    constexpr int KPP = (KNP + 7) / 8, VPP = (VNP + 7) / 8;
    ATT_LAS unsigned* dmaL = (ATT_LAS unsigned*)(lds + 2 * G::KBUF + 2 * G::VBUF + 2048) + wid * 256 + lane;
#pragma unroll
    for (int pp = 0; pp < KPP; ++pp) { const int pc = wid + 8 * pp, c = pc * 64 + lane, row = (c / KCPL) & 63, ch = c % KCPL; dmaL[64 * pp] = (unsigned)(row * kpitch + (ch < G::CPR ? ch : 0) * 8) * 2u; }
#pragma unroll
    for (int pp = 0; pp < VPP; ++pp) { const int pc = wid + 8 * pp, c = pc * 64 + lane, row = (c / VCPL) & 63, ch = c % VCPL; dmaL[128 + 64 * pp] = (unsigned)(row * vpitch + (ch < 8 ? ch : 0) * 8) * 2u; }
#define ATT_DMA_K(t, b) do { const char* kt_ = (const char*)(Kb + (size_t)(t) * 64 * kpitch); _Pragma("unroll") for (int pp = 0; pp < KPP; ++pp) { if (wid + 8 * pp < KNP) \
            __builtin_amdgcn_global_load_lds((const unsigned*)(kt_ + dmaL[64 * pp]), (ATT_LAS unsigned*)(lds + (b) * G::KBUF + (wid + 8 * pp) * 1024), 16, 0, 0); } } while (0)
#define ATT_DMA_V(t, b) do { const char* vt_ = (const char*)(Vb + (size_t)(t) * 64 * vpitch); _Pragma("unroll") for (int pp = 0; pp < VPP; ++pp) { if (wid + 8 * pp < VNP) \
            __builtin_amdgcn_global_load_lds((const unsigned*)(vt_ + dmaL[128 + 64 * pp]), (ATT_LAS unsigned*)(lds + 2 * G::KBUF + (b) * G::VBUF + (wid + 8 * pp) * 1024), 16, 0, 0); } } while (0)
    f32x16 o0, o1;
#pragma unroll
    for (int i = 0; i < 16; ++i) { o0[i] = 0.f; o1[i] = 0.f; }
    float mrun = -INFINITY, lsum = 0.f;
    const int koff = r32 * G::KSTR + hi * 16;
    const int voff = ((lane >> 5) * 4 + ((lane & 15) >> 2)) * VSTR + (((lane >> 4) & 1) * 16 + (lane & 3) * 4) * 2;
    const f32x16 zero16 = {0.f, 0.f, 0.f, 0.f, 0.f, 0.f, 0.f, 0.f, 0.f, 0.f, 0.f, 0.f, 0.f, 0.f, 0.f, 0.f};
#define ATT_QK(X0, X1, t) do { const ATT_LAS unsigned char* Kt = lds + ((t) & 1) * G::KBUF + koff; \
        _Pragma("unroll") for (int kk = 0; kk < DQK / 16; ++kk) { \
            const bf16x8 a0 = *(const ATT_LAS bf16x8*)(Kt + kk * 32); const bf16x8 a1 = *(const ATT_LAS bf16x8*)(Kt + 32 * G::KSTR + kk * 32); \
            X0 = __builtin_amdgcn_mfma_f32_32x32x16_bf16(a0, qf[kk], kk ? X0 : zero16, 0, 0, 0); X1 = __builtin_amdgcn_mfma_f32_32x32x16_bf16(a1, qf[kk], kk ? X1 : zero16, 0, 0, 0); } } while (0)
#define ATT_SMPV(X0, X1, t) do { \
        float cadd = 0.f; \
        if (BAND) { const int delta = cc - (t); \
            if (delta >= 3) cadd = biasL[256]; \
            else { const ATT_LAS float* bp = biasL + (64 * delta + (32 * (wid & 1) + r32) - 4 * hi + 128 - 63); \
                if (delta < 2) { _Pragma("unroll") for (int i = 0; i < 16; ++i) { const int kj = (i & 3) + 8 * (i >> 2); X0[i] += bp[63 - kj]; X1[i] += bp[31 - kj]; } } \
                else { const int relb = 64 * delta + (32 * (wid & 1) + r32) - 4 * hi + 128; \
                    _Pragma("unroll") for (int i = 0; i < 16; ++i) { const int kj = (i & 3) + 8 * (i >> 2); int i0 = relb - kj, i1 = relb - kj - 32; i0 = i0 > 256 ? 256 : i0; i1 = i1 > 256 ? 256 : i1; \
                        X0[i] += biasL[i0]; X1[i] += biasL[i1]; } } } } \
        const float mt = rowmax32(X0, X1) + cadd; \
        const float mnew = max2f(mrun, mt); \
        const float alpha = __builtin_amdgcn_exp2f(mrun - mnew); \
        const float msub = mnew - cadd; \
        mrun = mnew; \
        float ps = 0.f; \
        _Pragma("unroll") for (int i = 0; i < 16; ++i) { X0[i] = __builtin_amdgcn_exp2f(X0[i] - msub); X1[i] = __builtin_amdgcn_exp2f(X1[i] - msub); ps += X0[i] + X1[i]; } \
        lsum = lsum * alpha + ps; \
        _Pragma("unroll") for (int i = 0; i < 16; ++i) { o0[i] *= alpha; o1[i] *= alpha; } \
        bf16x8 pf[2][2]; \
        _Pragma("unroll") for (int s = 0; s < 2; ++s) { u32x4 w0, w1; \
            w0.x = cvtpk(X0[8 * s + 0], X0[8 * s + 1]); w0.y = cvtpk(X0[8 * s + 2], X0[8 * s + 3]); w0.z = cvtpk(X0[8 * s + 4], X0[8 * s + 5]); w0.w = cvtpk(X0[8 * s + 6], X0[8 * s + 7]); \
            w1.x = cvtpk(X1[8 * s + 0], X1[8 * s + 1]); w1.y = cvtpk(X1[8 * s + 2], X1[8 * s + 3]); w1.z = cvtpk(X1[8 * s + 4], X1[8 * s + 5]); w1.w = cvtpk(X1[8 * s + 6], X1[8 * s + 7]); \
            pf[0][s] = __builtin_bit_cast(bf16x8, w0); pf[1][s] = __builtin_bit_cast(bf16x8, w1); } \
        const ATT_LAS unsigned char* Vt = lds + 2 * G::KBUF + ((t) & 1) * G::VBUF + voff; \
        _Pragma("unroll") for (int kb = 0; kb < 2; ++kb) _Pragma("unroll") for (int s = 0; s < 2; ++s) { \
            const ATT_LAS unsigned char* vp = Vt + (32 * kb + 16 * s) * VSTR; \
            const s16x4 l0 = vtr(vp), h0 = vtr(vp + 8 * VSTR), l1 = vtr(vp + 64), h1 = vtr(vp + 8 * VSTR + 64); \
            const bf16x8 a0 = (bf16x8){l0[0], l0[1], l0[2], l0[3], h0[0], h0[1], h0[2], h0[3]}; \
            const bf16x8 a1 = (bf16x8){l1[0], l1[1], l1[2], l1[3], h1[0], h1[1], h1[2], h1[3]}; \
            o0 = __builtin_amdgcn_mfma_f32_32x32x16_bf16(a0, pf[kb][s], o0, 0, 0, 0); o1 = __builtin_amdgcn_mfma_f32_32x32x16_bf16(a1, pf[kb][s], o1, 0, 0, 0); } } while (0)
#define ATT_FUSED(C0, C1, N0, N1, t, tn) do { \
        bf16x8 kfa[DQK / 16], kfb[DQK / 16]; \
        { const ATT_LAS unsigned char* Kt = lds + ((tn) & 1) * G::KBUF + koff; \
          _Pragma("unroll") for (int kk = 0; kk < DQK / 16; ++kk) { kfa[kk] = *(const ATT_LAS bf16x8*)(Kt + kk * 32); kfb[kk] = *(const ATT_LAS bf16x8*)(Kt + 32 * G::KSTR + kk * 32); } } \
        __builtin_amdgcn_sched_barrier(0); \
        float cadd = 0.f; \
        if (BAND) { const int delta = cc - (t); \
            if (delta >= 3) cadd = biasL[256]; \
            else { const ATT_LAS float* bp = biasL + (64 * delta + (32 * (wid & 1) + r32) - 4 * hi + 128 - 63); \
                if (delta < 2) { _Pragma("unroll") for (int i = 0; i < 16; ++i) { const int kj = (i & 3) + 8 * (i >> 2); C0[i] += bp[63 - kj]; C1[i] += bp[31 - kj]; } } \
                else { const int relb = 64 * delta + (32 * (wid & 1) + r32) - 4 * hi + 128; \
                    _Pragma("unroll") for (int i = 0; i < 16; ++i) { const int kj = (i & 3) + 8 * (i >> 2); int i0 = relb - kj, i1 = relb - kj - 32; i0 = i0 > 256 ? 256 : i0; i1 = i1 > 256 ? 256 : i1; \
                        C0[i] += biasL[i0]; C1[i] += biasL[i1]; } } } } \
        const float mt = rowmax32(C0, C1) + cadd; \
        const float mnew = max2f(mrun, mt); \
        const float alpha = __builtin_amdgcn_exp2f(mrun - mnew); \
        const float msub = mnew - cadd; \
        if (__builtin_amdgcn_ballot_w64(mnew > mrun)) { _Pragma("unroll") for (int i = 0; i < 16; ++i) { o0[i] *= alpha; o1[i] *= alpha; } } \
        mrun = mnew; \
        __builtin_amdgcn_sched_barrier(0); \
        _Pragma("unroll") for (int kk = 0; kk < DQK / 16; ++kk) { \
            N0 = __builtin_amdgcn_mfma_f32_32x32x16_bf16(kfa[kk], qf[kk], kk ? N0 : zero16, 0, 0, 0); N1 = __builtin_amdgcn_mfma_f32_32x32x16_bf16(kfb[kk], qf[kk], kk ? N1 : zero16, 0, 0, 0); } \
        s16x4 vl0[4], vh0[4], vl1[4], vh1[4]; \
        { const ATT_LAS unsigned char* Vt = lds + 2 * G::KBUF + ((t) & 1) * G::VBUF + voff; \
          _Pragma("unroll") for (int ks = 0; ks < 4; ++ks) { const ATT_LAS unsigned char* vp = Vt + 16 * ks * VSTR; vl0[ks] = vtr(vp); vh0[ks] = vtr(vp + 8 * VSTR); vl1[ks] = vtr(vp + 64); vh1[ks] = vtr(vp + 8 * VSTR + 64); } } \
        float ps = 0.f; \
        _Pragma("unroll") for (int i = 0; i < 16; ++i) { C0[i] = __builtin_amdgcn_exp2f(C0[i] - msub); C1[i] = __builtin_amdgcn_exp2f(C1[i] - msub); ps += C0[i] + C1[i]; } \
        lsum = lsum * alpha + ps; \
        bf16x8 pf[4]; \
        _Pragma("unroll") for (int s = 0; s < 2; ++s) { u32x4 w0, w1; \
            w0.x = cvtpk(C0[8 * s + 0], C0[8 * s + 1]); w0.y = cvtpk(C0[8 * s + 2], C0[8 * s + 3]); w0.z = cvtpk(C0[8 * s + 4], C0[8 * s + 5]); w0.w = cvtpk(C0[8 * s + 6], C0[8 * s + 7]); \
            w1.x = cvtpk(C1[8 * s + 0], C1[8 * s + 1]); w1.y = cvtpk(C1[8 * s + 2], C1[8 * s + 3]); w1.z = cvtpk(C1[8 * s + 4], C1[8 * s + 5]); w1.w = cvtpk(C1[8 * s + 6], C1[8 * s + 7]); \
            pf[s] = __builtin_bit_cast(bf16x8, w0); pf[2 + s] = __builtin_bit_cast(bf16x8, w1); } \
        __builtin_amdgcn_sched_barrier(0); \
        _Pragma("unroll") for (int ks = 0; ks < 4; ++ks) { \
            const bf16x8 a0 = (bf16x8){vl0[ks][0], vl0[ks][1], vl0[ks][2], vl0[ks][3], vh0[ks][0], vh0[ks][1], vh0[ks][2], vh0[ks][3]}; \
            const bf16x8 a1 = (bf16x8){vl1[ks][0], vl1[ks][1], vl1[ks][2], vl1[ks][3], vh1[ks][0], vh1[ks][1], vh1[ks][2], vh1[ks][3]}; \
            o0 = __builtin_amdgcn_mfma_f32_32x32x16_bf16(a0, pf[ks], o0, 0, 0, 0); o1 = __builtin_amdgcn_mfma_f32_32x32x16_bf16(a1, pf[ks], o1, 0, 0, 0); } } while (0)
#define ATT_STAGE(t) do { if ((t) + 2 <= t_hi) ATT_DMA_K((t) + 2, (t) & 1); if ((t) + 1 <= t_hi) ATT_DMA_V((t) + 1, ((t) + 1) & 1); } while (0)
    f32x16 sa0, sa1, sb0, sb1;
    ATT_DMA_K(t_lo, t_lo & 1);
    __syncthreads();
    if (t_lo + 1 <= t_hi) ATT_DMA_K(t_lo + 1, (t_lo + 1) & 1);
    ATT_DMA_V(t_lo, t_lo & 1);
    if (my_lo == t_lo) ATT_QK(sa0, sa1, t_lo);
    __syncthreads();
    {
        int t = t_lo;
        for (; t < my_lo - 1; ++t) { ATT_STAGE(t); __syncthreads(); }
        if (my_lo > t_lo) { ATT_STAGE(t); ATT_QK(sa0, sa1, t + 1); __syncthreads(); ++t; }
        int nf = my_hi - my_lo;
        for (; nf >= 2; nf -= 2, t += 2) {
            ATT_STAGE(t); ATT_FUSED(sa0, sa1, sb0, sb1, t, t + 1); __syncthreads();
            ATT_STAGE(t + 1); ATT_FUSED(sb0, sb1, sa0, sa1, t + 1, t + 2); __syncthreads();
        }
        if (nf == 1) {
            ATT_STAGE(t); ATT_FUSED(sa0, sa1, sb0, sb1, t, t + 1); __syncthreads(); ++t;
            ATT_STAGE(t); ATT_SMPV(sb0, sb1, t); __syncthreads(); ++t;
        } else {
            ATT_STAGE(t); ATT_SMPV(sa0, sa1, t); __syncthreads(); ++t;
        }
        for (; t <= t_hi; ++t) { ATT_STAGE(t); __syncthreads(); }
    }
    const float ltot = xhalf_sum(lsum);
    const float inv = 1.f / ltot;
    bf16* op = Ob + (size_t)(q0 + wid * 32 + r32) * opitch + 4 * hi;
#pragma unroll
    for (int g4 = 0; g4 < 4; ++g4) {
        u32x2 w0, w1;
        w0.x = cvtpk(o0[4 * g4 + 0] * inv, o0[4 * g4 + 1] * inv); w0.y = cvtpk(o0[4 * g4 + 2] * inv, o0[4 * g4 + 3] * inv);
        w1.x = cvtpk(o1[4 * g4 + 0] * inv, o1[4 * g4 + 1] * inv); w1.y = cvtpk(o1[4 * g4 + 2] * inv, o1[4 * g4 + 3] * inv);
        *(u32x2*)(op + 8 * g4) = w0; *(u32x2*)(op + 32 + 8 * g4) = w1;
    }
#undef ATT_DMA_K
#undef ATT_DMA_V
#undef ATT_QK
#undef ATT_SMPV
#undef ATT_STAGE
#undef ATT_FUSED
}
}
constexpr int NWAVES = 8;
constexpr int D = 1024, BATCH = 32, SEQ = 2048, M = BATCH * SEQ;
constexpr int NH = 16, QLORA = 384, KVLORA = 256, ROPE_D = 32, NOPE = 64, QKD = 96;
constexpr int NA = 768;
constexpr int FF = 2816, EFF = 3584, NE = 8;
constexpr float EPS = 1e-6f, LOG2E = 1.4426950408889634f;
constexpr int MAXP_HALF = 264, MAXP = 528;
constexpr size_t MiB = 1u << 20;
constexpr size_t WS_CTL = 0, CTL_ZERO_BYTES = 1 * MiB;
constexpr size_t WS_ROPE = 1 * MiB;
constexpr size_t WS_CNT = WS_ROPE + 256 * 1024;
constexpr size_t WS_PANELE = WS_CNT + 16 * 1024;
constexpr size_t WS_META = WS_PANELE + 4096;
constexpr size_t WS_TOKE = 2 * MiB;
constexpr size_t WS_TOKG = WS_TOKE + (size_t)M * 4;
constexpr size_t WS_SLOTTOK = WS_TOKG + (size_t)M * 8;
constexpr size_t WS_SLOTGATE = WS_SLOTTOK + (size_t)MAXP * 256 * 4;
constexpr size_t WS_PARTQA = 976 * MiB, WS_PART1 = 980 * MiB, WS_PART2 = 984 * MiB;
constexpr size_t WS_TOKRSTD = 4 * MiB;
constexpr size_t WS_SLOTRSTD = WS_TOKRSTD + (size_t)M * 4;
static_assert(WS_SLOTGATE + (size_t)MAXP * 256 * 4 <= WS_TOKRSTD && WS_SLOTRSTD + (size_t)MAXP * 256 * 4 <= 8 * MiB, "small arrays");
constexpr size_t WS_W = 8 * MiB;
constexpr size_t WS_WA = WS_W, WS_WUQ = WS_WA + (size_t)NA * D * 2, WS_WUKV = WS_WUQ + (size_t)1536 * QLORA * 2, WS_WO = WS_WUKV + (size_t)2048 * KVLORA * 2;
constexpr size_t WS_WF1 = WS_WO + (size_t)D * D * 2, WS_WF2 = WS_WF1 + (size_t)2 * FF * D * 2, WS_WKVQ = WS_WF2 + (size_t)D * FF * 2, WS_WBO = WS_WKVQ + (size_t)3 * D * D * 2;
constexpr size_t WS_WM1 = WS_WBO + (size_t)D * D * 2, WS_WM2 = WS_WM1 + (size_t)NE * 2 * EFF * D * 2, WS_WEND = WS_WM2 + (size_t)NE * D * EFF * 2;
constexpr size_t ARENA = 208 * MiB;
static_assert(WS_WEND <= ARENA, "weights fit under the arena");
constexpr size_t WS_XN = ARENA;
constexpr size_t WS_QA = ARENA + 128 * MiB;
constexpr size_t WS_Q = ARENA + 224 * MiB;
constexpr size_t WS_K = ARENA + 416 * MiB;
constexpr size_t WS_V = ARENA + 608 * MiB;
constexpr size_t WS_O = ARENA;
static_assert(WS_V + (size_t)M * D * 2 <= 1024 * MiB, "MLA arena");
constexpr size_t WS_XR1 = ARENA + 128 * MiB;
constexpr size_t WS_H = ARENA + 256 * MiB;
constexpr size_t WS_XR2 = ARENA;
constexpr size_t WS_KVQ2 = ARENA + 128 * MiB;
constexpr size_t WS_O2 = ARENA + 512 * MiB;
constexpr size_t WS_XR3 = ARENA + 640 * MiB;
constexpr size_t WS_XG = ARENA;
constexpr size_t WS_HM = ARENA + 264 * MiB;
constexpr size_t WS_END = WS_HM + (size_t)MAXP_HALF * 256 * EFF * 2;
static_assert(WS_XG + (size_t)MAXP * 256 * D * 2 <= WS_HM && WS_END <= 1024 * MiB && WS_XR3 + (size_t)M * D * 2 <= 1024 * MiB && WS_H + (size_t)M * FF * 2 <= 1024 * MiB, "arena");
constexpr int CW_BAR = 4096;
constexpr int RING_OFF = 0, RING_BYTES = 131072;
constexpr int P0_SCR = 128 * 33 * 4;
constexpr int LDSCTL_OFF = 8 * P0_SCR, MISC_OFF = LDSCTL_OFF + 320;
static_assert(LDSCTL_OFF >= RING_BYTES, "control words above every phase's scratch");
constexpr int LDS_BYTES = 147456;
static_assert(MISC_OFF + 128 <= LDS_BYTES, "LDS map");
static_assert(att::lds_bytes<96>() <= RING_BYTES, "attention scratch fits the ring region");

#define GAS __attribute__((address_space(1)))
#define LAS __attribute__((address_space(3)))
typedef unsigned short bf16;
typedef unsigned v4u __attribute__((ext_vector_type(4)));
typedef unsigned v2u __attribute__((ext_vector_type(2)));
typedef float f32x4 __attribute__((ext_vector_type(4)));
typedef GAS unsigned gu32;
#define RLX_AGENT __ATOMIC_RELAXED, __HIP_MEMORY_SCOPE_AGENT
#define LDS_WAIT() asm volatile("s_waitcnt lgkmcnt(0)" ::: "memory")
__device__ __forceinline__ unsigned f2bf(float f) { unsigned u = __builtin_bit_cast(unsigned, f); return (u + 0x7fffu + ((u >> 16) & 1u)) >> 16; }
__device__ __forceinline__ unsigned pk2(float lo, float hi) { return f2bf(lo) | (f2bf(hi) << 16); }
__device__ __forceinline__ float bflo(unsigned u) { return __builtin_bit_cast(float, u << 16); }
__device__ __forceinline__ float bfhi(unsigned u) { return __builtin_bit_cast(float, u & 0xffff0000u); }
__device__ __forceinline__ float wave_sum(float v) {
#pragma unroll
    for (int o = 1; o < 64; o <<= 1) v += __shfl_xor(v, o);
    return v;
}

#define XB_TMO      128
#define XB_XCNT(j)  (256  + 64 * (j))
#define XB_XSUB(j)  (1280 + 64 * (j))
#define XB_XGEN(j)  (2304 + 64 * (j))
#define XB_TOP      3328
#define XB_TOPGEN   3392
#define XCD_BAR_WORDS 3456
#define XB_SPIN_CAP (1u << 18)

__device__ __forceinline__ unsigned xb_ld(unsigned* p)              { return __hip_atomic_load(p, __ATOMIC_RELAXED, __HIP_MEMORY_SCOPE_AGENT); }
__device__ __forceinline__ unsigned xb_add(unsigned* p, unsigned v) { return __hip_atomic_fetch_add(p, v, __ATOMIC_RELAXED, __HIP_MEMORY_SCOPE_AGENT); }
__device__ __forceinline__ unsigned xb_xcc_id() { return (unsigned)__builtin_amdgcn_s_getreg((3 << 11) | 20) & 0xFu; }
#define XB_SPIN(cond, bar) do { unsigned _sp = 0; while (cond) { __builtin_amdgcn_s_sleep(1); \
    if ((++_sp & 255u) == 0u) { if (xb_ld(&(bar)[XB_TMO])) break; if (_sp > XB_SPIN_CAP) { atomicAdd(&(bar)[XB_TMO], 1u); break; } } } } while (0)

struct XcdBarrier {
    unsigned* bar; unsigned x;
    volatile LAS unsigned* st;
};

__device__ __forceinline__ XcdBarrier xcd_barrier_post(unsigned* bar, volatile LAS unsigned* st) {
    XcdBarrier b; b.bar = bar; b.x = xb_xcc_id(); b.st = st;
    if (threadIdx.x == 0) (void)xb_add(&bar[XB_XCNT(b.x)], 1u);
    return b;
}
__device__ __forceinline__ void xcd_barrier_complete(unsigned* bar, unsigned x, unsigned& nloc, unsigned& nx) {
    const unsigned G = gridDim.x * gridDim.y * gridDim.z;
    unsigned sum, cnt, mine, sp = 0u;
    for (;;) {
        sum = 0u; cnt = 0u; mine = 0u;
#pragma unroll
        for (unsigned j = 0; j < 16; ++j) { const unsigned c = xb_ld(&bar[XB_XCNT(j)]); sum += c; cnt += (c > 0u) ? 1u : 0u; mine = (j == x) ? c : mine; }
        if (sum == G) break;
        __builtin_amdgcn_s_sleep(1);
        if ((++sp & 255u) == 0u) { if (xb_ld(&bar[XB_TMO])) break; if (sp > XB_SPIN_CAP) { atomicAdd(&bar[XB_TMO], 1u); break; } }
    }
    nloc = mine > 0u ? mine : 1u; nx = cnt > 0u ? cnt : 1u;
}

__device__ __forceinline__ void xcd_barrier(const XcdBarrier& b) {
    asm volatile("s_waitcnt vmcnt(0)" ::: "memory");
    __syncthreads();
    if (threadIdx.x == 0) {
        unsigned* bar = b.bar;
        __builtin_amdgcn_s_waitcnt(0);
        unsigned nloc = b.st[0], nx = b.st[1];
        if (nloc == 0u) { xcd_barrier_complete(bar, b.x, nloc, nx); b.st[0] = nloc; b.st[1] = nx; }
        const unsigned old = xb_add(&bar[XB_XSUB(b.x)], 1u);
        const unsigned gen = old / nloc;
        if (old + 1u == (gen + 1u) * nloc) {
            __builtin_amdgcn_fence(__ATOMIC_RELEASE, "agent");
            asm volatile("s_waitcnt vmcnt(0)" ::: "memory");
            const unsigned og = xb_add(&bar[XB_TOP], 1u);
            const unsigned tg = og / nx;
            if (og + 1u == (tg + 1u) * nx) xb_add(&bar[XB_TOPGEN], 1u);
            else XB_SPIN(xb_ld(&bar[XB_TOPGEN]) == tg, bar);
            __builtin_amdgcn_fence(__ATOMIC_ACQUIRE, "agent");
            xb_add(&bar[XB_XGEN(b.x)], 1u);
            asm volatile("s_waitcnt vmcnt(0)" ::: "memory");
        } else {
            XB_SPIN(xb_ld(&bar[XB_XGEN(b.x)]) == gen, bar);
            __builtin_amdgcn_fence(__ATOMIC_ACQUIRE, "agent");
            asm volatile("s_waitcnt vmcnt(0)" ::: "memory");
        }
    }
    __syncthreads();
}

struct Args { const float* in[27]; float* out; unsigned char* ws; };
enum { I_X = 0, I_ATTN_NORM, I_FFN_NORM, I_A_WDQ, I_A_GCQ, I_A_WUQ, I_A_WDKV, I_A_GCKV, I_A_WUKV, I_A_GQN, I_A_GKN, I_A_WO, I_KV_NORM, I_KV_WK, I_KV_WV, I_KV_GKN,
       I_B_WQ, I_B_GQN, I_B_RELB, I_B_WO, I_FFN_W1, I_FFN_W3, I_FFN_W2, I_MOE_ROUTER, I_MOE_W1, I_MOE_W3, I_MOE_W2 };

struct Frame {
    LAS unsigned char* lds;
    int wave, vcu, G;
};
typedef const __attribute__((address_space(4))) Args* KArgs;
__device__ __forceinline__ KArgs kargs() { KArgs p = (KArgs)__builtin_amdgcn_kernarg_segment_ptr(); asm volatile("" : "+s"(p)); return p; }
#define INP(i) (kargs()->in[i])
#define OUTP (kargs()->out)
#define WSP (kargs()->ws)
__device__ __forceinline__ int fresh(int v) { asm volatile("" : "+v"(v)); return v; }

__device__ __forceinline__ void tr_item(const float* W, int ldw, int K, int k0, int nsrc0, const float* gain, bf16* WT, int drow0, LAS float* scr, int lane) {
    const int c4 = lane & 7, r = lane >> 3;
    const GAS float* src = (const GAS float*)W + (size_t)(k0 + r) * ldw + nsrc0 + 4 * c4;
    f32x4 v[16];
#pragma unroll
    for (int i = 0; i < 16; ++i) v[i] = *(const GAS f32x4*)(src + (size_t)(8 * i) * ldw);
    if (gain) {
#pragma unroll
        for (int i = 0; i < 16; ++i) v[i] = v[i] * gain[k0 + 8 * i + r];
    }
#pragma unroll
    for (int i = 0; i < 16; ++i) { LAS float* d = scr + (8 * i + r) * 33 + 4 * c4; d[0] = v[i].x; d[1] = v[i].y; d[2] = v[i].z; d[3] = v[i].w; }
    LDS_WAIT(); asm volatile("" ::: "memory");
    const int c16 = lane >> 2;
#pragma unroll
    for (int j = 0; j < 8; ++j) { const int n = (lane & 3) + 4 * j; const LAS float* sp = scr + (8 * c16) * 33 + n;
        v4u o; o.x = pk2(sp[0 * 33], sp[1 * 33]); o.y = pk2(sp[2 * 33], sp[3 * 33]); o.z = pk2(sp[4 * 33], sp[5 * 33]); o.w = pk2(sp[6 * 33], sp[7 * 33]);
        *(GAS v4u*)(WT + (size_t)(drow0 + n) * K + k0 + 8 * c16) = o; }
    LDS_WAIT(); asm volatile("" ::: "memory");
}
__device__ __forceinline__ void tr_plain(const float* W, int K, int N, const float* gain, bf16* WT, int drow_off, LAS float* scr, int item, int lane) {
    const int nblk = N / 32, kb = item / nblk, nb = item % nblk;
    tr_item(W, N, K, 128 * kb, 32 * nb, gain, WT, drow_off + 32 * nb, scr, lane);
}
__device__ __forceinline__ void tr_gated(const float* W, int K, int N, const float* gain, bf16* WT, int half, LAS float* scr, int item, int lane) {
    const int nblk = N / 32, kb = item / nblk, nb = item % nblk, n0 = 32 * nb;
    tr_item(W, N, K, 128 * kb, n0, gain, WT, (n0 >> 7) * 256 + half * 128 + (n0 & 127), scr, lane);
}
__device__ __forceinline__ unsigned pk_fp8x4(float a, float b, float c, float d) { int w = 0; w = __builtin_amdgcn_cvt_pk_fp8_f32(a, b, w, false); w = __builtin_amdgcn_cvt_pk_fp8_f32(c, d, w, true); return (unsigned)w; }
__device__ __forceinline__ void tr_item_f8(const float* W, int ldw, int K, int k0, int nsrc0, const float* gain, unsigned char* WT, int drow0, LAS float* scr, int lane) {
    const int c4 = lane & 7, r = lane >> 3;
    const GAS float* src = (const GAS float*)W + (size_t)(k0 + r) * ldw + nsrc0 + 4 * c4;
    f32x4 v[16];
#pragma unroll
    for (int i = 0; i < 16; ++i) v[i] = *(const GAS f32x4*)(src + (size_t)(8 * i) * ldw);
#pragma unroll
    for (int i = 0; i < 16; ++i) v[i] = v[i] * (gain ? gain[k0 + 8 * i + r] * 64.f : 64.f);
#pragma unroll
    for (int i = 0; i < 16; ++i) { LAS float* d = scr + (8 * i + r) * 33 + 4 * c4; d[0] = v[i].x; d[1] = v[i].y; d[2] = v[i].z; d[3] = v[i].w; }
    LDS_WAIT(); asm volatile("" ::: "memory");
    const int c8 = lane >> 3;
#pragma unroll
    for (int j = 0; j < 4; ++j) { const int n = (lane & 7) + 8 * j; const LAS float* sp = scr + (16 * c8) * 33 + n;
        v4u o; o.x = pk_fp8x4(sp[0 * 33], sp[1 * 33], sp[2 * 33], sp[3 * 33]); o.y = pk_fp8x4(sp[4 * 33], sp[5 * 33], sp[6 * 33], sp[7 * 33]);
        o.z = pk_fp8x4(sp[8 * 33], sp[9 * 33], sp[10 * 33], sp[11 * 33]); o.w = pk_fp8x4(sp[12 * 33], sp[13 * 33], sp[14 * 33], sp[15 * 33]);
        *(GAS v4u*)(WT + (size_t)(drow0 + n) * K + k0 + 16 * c8) = o; }
    LDS_WAIT(); asm volatile("" ::: "memory");
}
__device__ __forceinline__ float rms_row_to_bf16(const float* xrow, bf16* orow, int lane, f32x4 (&v)[4]) {
    const GAS f32x4* xr = (const GAS f32x4*)xrow + lane;
    float s = 0.f;
#pragma unroll
    for (int j = 0; j < 4; ++j) { v[j] = xr[64 * j]; s += (v[j].x * v[j].x + v[j].y * v[j].y) + (v[j].z * v[j].z + v[j].w * v[j].w); }
    const float rstd = 1.f / sqrtf(wave_sum(s) * (1.f / D) + EPS);
    GAS unsigned long long* o8 = (GAS unsigned long long*)orow + lane;
#pragma unroll
    for (int j = 0; j < 4; ++j) o8[64 * j] = (unsigned long long)pk2(v[j].x * rstd, v[j].y * rstd) | ((unsigned long long)pk2(v[j].z * rstd, v[j].w * rstd) << 32);
    return rstd;
}
__device__ __forceinline__ void norm_phase(const Frame& F, const float* x, bf16* xn) {
    const int tid = fresh((int)threadIdx.x), lane = tid & 63; (void)lane;
    const int gw = F.vcu * NWAVES + F.wave, NGW = F.G * NWAVES;
    for (int m = 2 * gw; m < M; m += 2 * NGW) {
        const GAS f32x4* xr = (const GAS f32x4*)(x + (size_t)m * D) + lane;
        f32x4 v[8]; float s0 = 0.f, s1 = 0.f;
#pragma unroll
        for (int j = 0; j < 8; ++j) v[j] = xr[64 * j];
#pragma unroll
        for (int j = 0; j < 4; ++j) { s0 += (v[j].x * v[j].x + v[j].y * v[j].y) + (v[j].z * v[j].z + v[j].w * v[j].w); s1 += (v[4 + j].x * v[4 + j].x + v[4 + j].y * v[4 + j].y) + (v[4 + j].z * v[4 + j].z + v[4 + j].w * v[4 + j].w); }
        const float r0 = 1.f / sqrtf(wave_sum(s0) * (1.f / D) + EPS), r1 = 1.f / sqrtf(wave_sum(s1) * (1.f / D) + EPS);
        GAS unsigned long long* o8 = (GAS unsigned long long*)(xn + (size_t)m * D) + lane;
#pragma unroll
        for (int j = 0; j < 8; ++j) { const float rr = j < 4 ? r0 : r1; o8[64 * j] = (unsigned long long)pk2(v[j].x * rr, v[j].y * rr) | ((unsigned long long)pk2(v[j].z * rr, v[j].w * rr) << 32); }
    }
}

__device__ __forceinline__ void p0_prologue(const Frame& F) {
    const int tid = fresh((int)threadIdx.x), lane = tid & 63; (void)lane;
    LAS float* scr = (LAS float*)(F.lds + RING_OFF + F.wave * P0_SCR);
    unsigned char* ws = WSP;
    const int gw = F.vcu * NWAVES + F.wave, NGW = F.G * NWAVES;
    constexpr int I_DQ = 8 * 12, I_DKV = 8 * 9, I_UQ = 3 * 48, I_UKV = 2 * 64, I_SQ = 8 * 32, I_F13 = 8 * 88, I_F2 = 22 * 32, I_M13 = 8 * 112, I_M2 = 28 * 32;
    constexpr int NSMALL = I_DQ + I_DKV + I_UQ + I_UKV + I_SQ + 2 * I_F13 + I_F2 + 4 * I_SQ;
    constexpr int NITEMS = NSMALL + NE * (2 * I_M13 + I_M2);
    for (int it = gw; it < NITEMS; it += NGW) {
        int r = it;
        if (r < I_DQ)  { tr_plain(INP(I_A_WDQ), D, QLORA, INP(I_ATTN_NORM), (bf16*)(ws + WS_WA), 0, scr, r, lane); continue; } r -= I_DQ;
        if (r < I_DKV) { tr_plain(INP(I_A_WDKV), D, KVLORA + ROPE_D, INP(I_ATTN_NORM), (bf16*)(ws + WS_WA), QLORA, scr, r, lane); continue; } r -= I_DKV;
        if (r < I_UQ)  { tr_plain(INP(I_A_WUQ), QLORA, NH * QKD, INP(I_A_GCQ), (bf16*)(ws + WS_WUQ), 0, scr, r, lane); continue; } r -= I_UQ;
        if (r < I_UKV) { const int kb = r / 64, n0 = 32 * (r % 64), head = n0 >> 7, within = n0 & 127;
            const int drow = within < 64 ? 256 * (head >> 2) + 128 * (within >> 5) + 32 * (head & 3) : 1024 + head * 64 + (within - 64);
            tr_item(INP(I_A_WUKV), NH * 128, KVLORA, 128 * kb, n0, INP(I_A_GCKV), (bf16*)(ws + WS_WUKV), drow, scr, lane); continue; } r -= I_UKV;
        if (r < I_SQ)  { tr_plain(INP(I_A_WO), D, D, nullptr, (bf16*)(ws + WS_WO), 0, scr, r, lane); continue; } r -= I_SQ;
        if (r < I_F13) { tr_gated(INP(I_FFN_W1), D, FF, INP(I_FFN_NORM), (bf16*)(ws + WS_WF1), 0, scr, r, lane); continue; } r -= I_F13;
        if (r < I_F13) { tr_gated(INP(I_FFN_W3), D, FF, INP(I_FFN_NORM), (bf16*)(ws + WS_WF1), 1, scr, r, lane); continue; } r -= I_F13;
        if (r < I_F2)  { tr_plain(INP(I_FFN_W2), FF, D, nullptr, (bf16*)(ws + WS_WF2), 0, scr, r, lane); continue; } r -= I_F2;
        if (r < I_SQ)  { const int kb = r / 32, n0 = 32 * (r % 32), head = n0 >> 6;
            tr_item(INP(I_KV_WK), D, D, 128 * kb, n0, INP(I_KV_NORM), (bf16*)(ws + WS_WKVQ), 256 * (head >> 2) + 128 * ((n0 >> 5) & 1) + 32 * (head & 3), scr, lane); continue; } r -= I_SQ;
        if (r < I_SQ)  { tr_plain(INP(I_KV_WV), D, D, INP(I_KV_NORM), (bf16*)(ws + WS_WKVQ), D, scr, r, lane); continue; } r -= I_SQ;
        if (r < I_SQ)  { const int kb = r / 32, n0 = 32 * (r % 32), head = n0 >> 6;
            tr_item(INP(I_B_WQ), D, D, 128 * kb, n0, INP(I_ATTN_NORM) + D, (bf16*)(ws + WS_WKVQ), 2 * D + 256 * (head >> 2) + 128 * ((n0 >> 5) & 1) + 32 * (head & 3), scr, lane); continue; } r -= I_SQ;
        if (r < I_SQ)  { tr_plain(INP(I_B_WO), D, D, nullptr, (bf16*)(ws + WS_WBO), 0, scr, r, lane); continue; } r -= I_SQ;
        const int e = r / (2 * I_M13 + I_M2); r -= e * (2 * I_M13 + I_M2);
        if (r < I_M13) { const int kb = r / 112, n0 = 32 * (r % 112);
            tr_item_f8(INP(I_MOE_W1) + (size_t)e * D * EFF, EFF, D, 128 * kb, n0, INP(I_FFN_NORM) + D, ws + WS_WM1 + (size_t)e * 2 * EFF * D, (n0 >> 7) * 256 + (n0 & 127), scr, lane); continue; } r -= I_M13;
        if (r < I_M13) { const int kb = r / 112, n0 = 32 * (r % 112);
            tr_item_f8(INP(I_MOE_W3) + (size_t)e * D * EFF, EFF, D, 128 * kb, n0, INP(I_FFN_NORM) + D, ws + WS_WM1 + (size_t)e * 2 * EFF * D, (n0 >> 7) * 256 + 128 + (n0 & 127), scr, lane); continue; } r -= I_M13;
        { const int kb = r / 32, n0 = 32 * (r % 32); tr_item_f8(INP(I_MOE_W2) + (size_t)e * EFF * D, D, EFF, 128 * kb, n0, nullptr, ws + WS_WM2 + (size_t)e * D * EFF, n0, scr, lane); }
    }
    const int gt = F.vcu * (NWAVES * 64) + tid, NGT = F.G * NWAVES * 64;
    for (int c = gt; c < 96 * D * 2 / 16; c += NGT) *((GAS v4u*)(ws + WS_WA + (size_t)(QLORA + KVLORA + ROPE_D) * D * 2) + c) = (v4u){0u, 0u, 0u, 0u};
    for (int c = gt; c < SEQ * 16; c += NGT) { const int pos = c >> 4, i = c & 15;
        const float inv = __builtin_amdgcn_exp2f(-(float)i * (13.287712379549449f / 16.f));
        const float rev = (float)pos * inv * 0.15915494309189535f; const float fr = rev - floorf(rev);
        ((GAS float*)(ws + WS_ROPE))[2 * c] = __builtin_amdgcn_cosf(fr); ((GAS float*)(ws + WS_ROPE))[2 * c + 1] = __builtin_amdgcn_sinf(fr); }
    norm_phase(F, INP(I_X), (bf16*)(ws + WS_XN));
}

__device__ __forceinline__ void route_phase(const Frame& F) {
    const int tid = fresh((int)threadIdx.x), lane = tid & 63;
    unsigned char* ws = WSP;
    LAS float* wrg = (LAS float*)(F.lds + RING_OFF);
    LAS int* cnt = (LAS int*)(F.lds + RING_OFF + 32768);
    const float* wr = INP(I_MOE_ROUTER); const float* g = INP(I_FFN_NORM) + D;
    for (int idx = tid; idx < D * NE; idx += NWAVES * 64) { const int k = idx >> 3, e = idx & 7, j = k >> 8, l = (k & 255) >> 2, q = k & 3;
        wrg[((j * 4 + q) * 2 + (e >> 2)) * 256 + 4 * l + (e & 3)] = wr[idx] * g[k]; }
    __syncthreads();
    const int b5 = (lane >> 5) & 1, b4 = (lane >> 4) & 1, b3 = (lane >> 3) & 1;
    for (int c = F.vcu; c < M / 256; c += F.G) {
        if (tid < 16) cnt[tid] = 0;
        __syncthreads();
        for (int i = 0; i < 32; ++i) {
            const int m = c * 256 + F.wave * 32 + i;
            f32x4 v[4]; float ssx = 0.f;
            { const GAS f32x4* xr = (const GAS f32x4*)(OUTP + (size_t)m * D) + lane;
#pragma unroll
              for (int j = 0; j < 4; ++j) v[j] = xr[64 * j];
#pragma unroll
              for (int j = 0; j < 4; ++j) ssx += (v[j].x * v[j].x + v[j].y * v[j].y) + (v[j].z * v[j].z + v[j].w * v[j].w); }
            float lg[8];
#pragma unroll
            for (int e = 0; e < 8; ++e) lg[e] = 0.f;
#pragma unroll
            for (int j = 0; j < 4; ++j)
#pragma unroll
                for (int q = 0; q < 4; ++q) { const float xv = v[j][q];
                    const f32x4 w0 = *(const LAS f32x4*)(wrg + ((j * 4 + q) * 2) * 256 + 4 * lane), w1 = *(const LAS f32x4*)(wrg + ((j * 4 + q) * 2 + 1) * 256 + 4 * lane);
                    lg[0] += xv * w0.x; lg[1] += xv * w0.y; lg[2] += xv * w0.z; lg[3] += xv * w0.w; lg[4] += xv * w1.x; lg[5] += xv * w1.y; lg[6] += xv * w1.z; lg[7] += xv * w1.w; }
            float r4[4], r2[2], r1;
#pragma unroll
            for (int e = 0; e < 4; ++e) { const float mine = b5 ? lg[4 + e] : lg[e], other = b5 ? lg[e] : lg[4 + e]; r4[e] = mine + __shfl_xor(other, 32); }
#pragma unroll
            for (int e = 0; e < 2; ++e) { const float mine = b4 ? r4[2 + e] : r4[e], other = b4 ? r4[e] : r4[2 + e]; r2[e] = mine + __shfl_xor(other, 16); }
            { const float mine = b3 ? r2[1] : r2[0], other = b3 ? r2[0] : r2[1]; r1 = mine + __shfl_xor(other, 8); }
            r1 += __shfl_xor(r1, 4); r1 += __shfl_xor(r1, 2); r1 += __shfl_xor(r1, 1);
            const float rstd = 1.f / sqrtf(wave_sum(ssx) * (1.f / D) + EPS);
#pragma unroll
            for (int e = 0; e < 8; ++e) lg[e] = __builtin_bit_cast(float, __builtin_amdgcn_readlane(__builtin_bit_cast(int, r1), 8 * e)) * rstd;
            int e1 = 0; float l1 = lg[0];
#pragma unroll
            for (int e = 1; e < 8; ++e) if (lg[e] > l1) { l1 = lg[e]; e1 = e; }
            int e2 = -1; float l2 = -INFINITY;
#pragma unroll
            for (int e = 0; e < 8; ++e) if (e != e1 && lg[e] > l2) { l2 = lg[e]; e2 = e; }
            const float g1 = 1.f / (1.f + __expf(l2 - l1)), g2 = 1.f - g1;
            const int elo = e1 < e2 ? e1 : e2, ehi = e1 < e2 ? e2 : e1;
            const float glo = e1 < e2 ? g1 : g2, ghi = e1 < e2 ? g2 : g1;
            if (lane == 0) { ((GAS float*)(ws + WS_TOKRSTD))[m] = rstd; ((GAS int*)(ws + WS_TOKE))[m] = elo | (ehi << 8); ((GAS float*)(ws + WS_TOKG))[2 * m] = glo; ((GAS float*)(ws + WS_TOKG))[2 * m + 1] = ghi;
                atomicAdd((int*)&cnt[elo], 1); atomicAdd((int*)&cnt[8 + ehi], 1); }
        }
        __syncthreads();
        if (tid < 16) ((GAS int*)(ws + WS_CNT))[c * 16 + tid] = cnt[tid];
        __syncthreads();
    }
}

__device__ __forceinline__ void slot_phase(const Frame& F, unsigned char* ws) {
    const int tid = fresh((int)threadIdx.x), lane = tid & 63; (void)lane;
    LAS int* call = (LAS int*)(F.lds + RING_OFF);
    LAS int* tot = call + 4096; LAS int* base = tot + 16; LAS int* pre = base + 16; LAS int* meta = pre + 16;
    LAS int* grp = meta + 16;
    LAS int* slot_of = grp + 512;
    for (int idx = tid; idx < 4096; idx += NWAVES * 64) call[idx] = ((const GAS int*)(ws + WS_CNT))[idx];
    __syncthreads();
    if (tid < 16) { int t = 0; for (int cc = 0; cc < 256; ++cc) t += call[cc * 16 + tid]; tot[tid] = t; }
    __syncthreads();
    if (tid == 0) { int off = 0; for (int g = 0; g < 16; ++g) { base[g] = off; off += (tot[g] + 255) & ~255; if (g == 7) meta[0] = off >> 8; } meta[1] = (off >> 8) - meta[0]; }
    __syncthreads();
    for (int c = F.vcu; c < M / 256; c += F.G) {
        if (tid < 16) { int p = 0; for (int cc = 0; cc < c; ++cc) p += call[cc * 16 + tid]; pre[tid] = p; }
        const int hf = tid >> 8, i = tid & 255, m = c * 256 + i;
        const int te = ((const GAS int*)(ws + WS_TOKE))[m];
        const int g = hf * 8 + (hf ? ((te >> 8) & 0xff) : (te & 0xff));
        grp[tid] = g;
        __syncthreads();
        int rank = 0;
        for (int j = 0; j < i; ++j) rank += (grp[hf * 256 + j] == g) ? 1 : 0;
        const int slot = base[g] + pre[g] + rank;
        ((GAS int*)(ws + WS_SLOTTOK))[slot] = m; ((GAS float*)(ws + WS_SLOTGATE))[slot] = ((const GAS float*)(ws + WS_TOKG))[2 * m + hf];
        ((GAS float*)(ws + WS_SLOTRSTD))[slot] = ((const GAS float*)(ws + WS_TOKRSTD))[m];
        slot_of[tid] = slot;
        __syncthreads();
        for (int p = F.wave; p < 512; p += NWAVES) { const int mm = c * 256 + (p & 255), sl = slot_of[p];
            const GAS v4u* src = (const GAS v4u*)(ws + WS_XR3 + (size_t)mm * D * 2); GAS v4u* dst = (GAS v4u*)(ws + WS_XG + (size_t)sl * D);
            const v4u x0 = src[2 * lane], x1 = src[2 * lane + 1];
            dst[lane] = (v4u){pk_fp8x4(bflo(x0.x), bfhi(x0.x), bflo(x0.y), bfhi(x0.y)), pk_fp8x4(bflo(x0.z), bfhi(x0.z), bflo(x0.w), bfhi(x0.w)),
                              pk_fp8x4(bflo(x1.x), bfhi(x1.x), bflo(x1.y), bfhi(x1.y)), pk_fp8x4(bflo(x1.z), bfhi(x1.z), bflo(x1.w), bfhi(x1.w))}; }
        __syncthreads();
    }
    for (int g = F.vcu; g < 16; g += F.G) {
        const int s0 = base[g] + tot[g], s1 = base[g] + ((tot[g] + 255) & ~255);
        for (int s = s0 + F.wave; s < s1; s += NWAVES) { GAS v4u* dst = (GAS v4u*)(ws + WS_XG + (size_t)s * D);
            dst[lane] = (v4u){0u, 0u, 0u, 0u};
            if (lane == 0) { ((GAS int*)(ws + WS_SLOTTOK))[s] = -1; ((GAS float*)(ws + WS_SLOTGATE))[s] = 0.f; ((GAS float*)(ws + WS_SLOTRSTD))[s] = 0.f; } }
    }
    if (F.vcu == 0) {
        if (tid < 16) { const int p0 = base[tid] >> 8, p1 = (base[tid] + ((tot[tid] + 255) & ~255)) >> 8; for (int p = p0; p < p1; ++p) ((GAS int*)(ws + WS_PANELE))[p] = tid & 7; }
        if (tid == 0) { ((GAS int*)(ws + WS_META))[0] = meta[0]; ((GAS int*)(ws + WS_META))[1] = meta[1]; }
    }
    __syncthreads();
}

__global__ void __launch_bounds__(NWAVES * 64, 2) yoco_fwd(Args args) {
    extern __shared__ __attribute__((aligned(16))) unsigned char lds_raw[];
    Frame F;
    F.lds = (LAS unsigned char*)lds_raw;
    F.wave = __builtin_amdgcn_readfirstlane((int)threadIdx.x >> 6);
    F.G = gridDim.x; { const int bx = blockIdx.x; F.vcu = (F.G % 8 == 0) ? (bx % 8) * (F.G / 8) + bx / 8 : bx; }
    unsigned char* ws = WSP;
    volatile LAS unsigned* MISC = (volatile LAS unsigned*)(F.lds + MISC_OFF);
    for (int u = fresh((int)threadIdx.x); u < (LDS_BYTES - LDSCTL_OFF) / 4; u += NWAVES * 64) ((LAS unsigned*)(F.lds + LDSCTL_OFF))[u] = 0u;
    __syncthreads();
    (void)xcd_barrier_post((unsigned*)(ws + WS_CTL) + CW_BAR, MISC + 8);
    LAS unsigned char* ring = F.lds + RING_OFF;
#define bid ((int)blockIdx.x)
#define GRID_BAR() do { XcdBarrier b_; b_.bar = (unsigned*)(WSP + WS_CTL) + CW_BAR; b_.x = xb_xcc_id(); b_.st = (volatile LAS unsigned*)(F.lds + MISC_OFF) + 8; xcd_barrier(b_); } while (0)
#define GEMM(EpiT, SchedT) pg8::gemm_phase<EpiT, SchedT, true, true>

    p0_prologue(F);
    GRID_BAR();
    { pg8::Gemm g{(const bf16*)(ws + WS_XN), (const bf16*)(ws + WS_WA), M, NA, D, D}; pg8::StaticOrder S; S.init(M, NA, F.G, bid);
      pg8::EpiQA E{(bf16*)(ws + WS_QA), (float*)(ws + WS_PARTQA)};
      GEMM(pg8::EpiQA, pg8::StaticOrder)(ring, g, S, E); }
    GRID_BAR();
    { pg8::Gemm g{(const bf16*)(ws + WS_QA), (const bf16*)(ws + WS_WUQ), M, NH * QKD, QLORA, NA}; pg8::StaticOrder S; S.init(M, NH * QKD, F.G, bid);
      pg8::EpiRowScaleBf16 E{(bf16*)(ws + WS_Q), NH * QKD, (const float*)(ws + WS_PARTQA), 1.f / QLORA};
      GEMM(pg8::EpiRowScaleBf16, pg8::StaticOrder)(ring, g, S, E); }
    { pg8::Gemm g{(const bf16*)(ws + WS_QA) + QLORA, (const bf16*)(ws + WS_WUKV), M, NH * 128, KVLORA, NA}; pg8::StaticOrder S; S.init(M, NH * 128, F.G, bid);
      pg8::EpiKVup E{(bf16*)(ws + WS_K), (bf16*)(ws + WS_V), (const float*)(ws + WS_PARTQA), (const bf16*)(ws + WS_QA), INP(I_A_GKN), (const float*)(ws + WS_ROPE)};
      GEMM(pg8::EpiKVup, pg8::StaticOrder)(ring, g, S, E); }
    GRID_BAR();
    for (int p = F.vcu; p < BATCH * NH * 4; p += F.G) {
        const int bh = p >> 2, pid = p & 3, b = bh >> 4, h = bh & 15;
        for (int u2 = 0; u2 < 2; ++u2) {
            const int qb = u2 ? 7 - pid : pid;
            att::attn_unit<96, false, 1536, 1536, D, D>(ring, (const bf16*)(ws + WS_Q) + (size_t)b * SEQ * 1536 + h * QKD, (const bf16*)(ws + WS_K) + (size_t)b * SEQ * 1536 + h * QKD,
                                      (const bf16*)(ws + WS_V) + (size_t)b * SEQ * D + h * 64, (bf16*)(ws + WS_O) + (size_t)b * SEQ * D + h * 64,
                                      256 * qb, 0, 4 * qb + 3, 0, 4 * qb + (F.wave >> 1), 0, nullptr, INP(I_A_GQN), (const float*)(ws + WS_ROPE));
        }
    }
    GRID_BAR();
    { pg8::Gemm g{(const bf16*)(ws + WS_O), (const bf16*)(ws + WS_WO), M, D, D, D}; pg8::StaticOrder S; S.init(M, D, F.G, bid);
      pg8::EpiResNorm<true> E{INP(I_X), OUTP, (bf16*)(ws + WS_XR1), (float*)(ws + WS_PART1)};
      GEMM(pg8::EpiResNorm<true>, pg8::StaticOrder)(ring, g, S, E); }
    GRID_BAR();
    { pg8::Gemm g{(const bf16*)(ws + WS_XR1), (const bf16*)(ws + WS_WF1), M, 2 * FF, D, D}; pg8::StaticOrder S; S.init(M, 2 * FF, F.G, bid);
      pg8::EpiGated<true> E{(bf16*)(ws + WS_H), FF, 0, (const float*)(ws + WS_PART1)};
      GEMM(pg8::EpiGated<true>, pg8::StaticOrder)(ring, g, S, E); }
    GRID_BAR();
    { pg8::Gemm g{(const bf16*)(ws + WS_H), (const bf16*)(ws + WS_WF2), M, D, FF, FF}; pg8::StaticOrder S; S.init(M, D, F.G, bid);
      pg8::EpiResNorm<true> E{OUTP, OUTP, (bf16*)(ws + WS_XR2), (float*)(ws + WS_PART2)};
      GEMM(pg8::EpiResNorm<true>, pg8::StaticOrder)(ring, g, S, E); }
    GRID_BAR();
    { pg8::Gemm g{(const bf16*)(ws + WS_XR2), (const bf16*)(ws + WS_WKVQ), M, 3 * D, D, D}; pg8::StaticOrder S; S.init(M, 3 * D, F.G, bid);
      pg8::EpiKVQ2 E{(bf16*)(ws + WS_KVQ2), (const float*)(ws + WS_PART2), INP(I_KV_GKN), INP(I_B_GQN)};
      GEMM(pg8::EpiKVQ2, pg8::StaticOrder)(ring, g, S, E); }
    GRID_BAR();
    for (int p = F.vcu; p < BATCH * NH * 8; p += F.G) {
        const int bh = p >> 3, cb = ((p & 7) + (p >> 8)) & 7, b = bh >> 4, h = bh & 15;
        const int c0 = 4 * cb, cc = c0 + (F.wave >> 1);
        const bf16* base = (const bf16*)(ws + WS_KVQ2) + (size_t)b * SEQ * 3072 + h * 64;
        att::attn_unit<64, true, 3072, 3072, 3072, D>(ring, base + 2048, base, base + 1024, (bf16*)(ws + WS_O2) + (size_t)b * SEQ * D + h * 64,
                                 256 * cb, c0 - 8 < 0 ? 0 : c0 - 8, c0 + 3, cc - 8 < 0 ? 0 : cc - 8, cc, cc, INP(I_B_RELB) + h * 257, nullptr, nullptr);
    }
    GRID_BAR();
    { pg8::Gemm g{(const bf16*)(ws + WS_O2), (const bf16*)(ws + WS_WBO), M, D, D, D}; pg8::StaticOrder S; S.init(M, D, F.G, bid);
      pg8::EpiResNorm<false> E{OUTP, OUTP, (bf16*)(ws + WS_XR3), nullptr};
      GEMM(pg8::EpiResNorm<false>, pg8::StaticOrder)(ring, g, S, E); }
    GRID_BAR();
    route_phase(F);
    GRID_BAR();
    slot_phase(F, ws);
    GRID_BAR();
    for (int hf = 0; hf < 2; ++hf) {
        { unsigned char* w2 = WSP;
          const int nPA = __builtin_amdgcn_readfirstlane(((const GAS int*)(w2 + WS_META))[0]), nPB = __builtin_amdgcn_readfirstlane(((const GAS int*)(w2 + WS_META))[1]);
          const int nP = hf ? nPB : nPA, p0 = hf ? nPA : 0;
          pg8::Gemm g{(const bf16*)(w2 + WS_XG + (size_t)p0 * 256 * D), (const bf16*)(w2 + WS_WM1), nP * 256, 2 * EFF, D / 2, D / 2};
          pg8::MoeOrder S; S.init(nP, 2 * EFF / 256, F.G, bid, (const int*)(w2 + WS_PANELE) + p0);
          pg8::EpiGatedF8 E{w2 + WS_HM, EFF, 2 * EFF / 256, (const float*)(w2 + WS_SLOTRSTD) + (size_t)p0 * 256};
          pg8::gemm_phase<pg8::EpiGatedF8, pg8::MoeOrder, true, true, true>(ring, g, S, E); }
        GRID_BAR();
        { unsigned char* w2 = WSP;
          const int nPA = __builtin_amdgcn_readfirstlane(((const GAS int*)(w2 + WS_META))[0]), nPB = __builtin_amdgcn_readfirstlane(((const GAS int*)(w2 + WS_META))[1]);
          const int nP = hf ? nPB : nPA, p0 = hf ? nPA : 0;
          pg8::Gemm g{(const bf16*)(w2 + WS_HM), (const bf16*)(w2 + WS_WM2), nP * 256, D, EFF / 2, EFF / 2};
          pg8::MoeOrder S; S.init(nP, D / 256, F.G, bid, (const int*)(w2 + WS_PANELE) + p0);
          pg8::EpiMoeDown E{OUTP, (const int*)(w2 + WS_SLOTTOK), (const float*)(w2 + WS_SLOTGATE), p0 * 256, D, 1.f / 64};
          pg8::gemm_phase<pg8::EpiMoeDown, pg8::MoeOrder, true, true, true>(ring, g, S, E); }
        if (hf == 0) GRID_BAR();
    }
#undef GRID_BAR
#undef bid
#undef GEMM
}

extern "C" void kernel_launch(void* const* d_in, const int* in_sizes, int n_in, void* d_out, int out_size, void* d_ws, size_t ws_size, hipStream_t stream) {
    static int grid = 0;
    if (grid == 0) {
        if (n_in != 27 || in_sizes[0] != M * D || out_size != M * D || ws_size < WS_END) { fprintf(stderr, "kernel_launch: unexpected shapes (n_in %d, in0 %d, out %d, ws %zu < %zu); nothing launched\n", n_in, n_in > 0 ? in_sizes[0] : -1, out_size, ws_size, (size_t)WS_END); grid = -1; return; }
        int dev = 0, cus = 0, per_cu = 0;
        if (hipGetDevice(&dev) != hipSuccess || hipDeviceGetAttribute(&cus, hipDeviceAttributeMultiprocessorCount, dev) != hipSuccess) { grid = -1; return; }
        if (hipFuncSetAttribute((const void*)yoco_fwd, hipFuncAttributeMaxDynamicSharedMemorySize, LDS_BYTES) != hipSuccess) { fprintf(stderr, "kernel_launch: hipFuncSetAttribute failed\n"); grid = -1; return; }
        if (hipOccupancyMaxActiveBlocksPerMultiprocessor(&per_cu, (const void*)yoco_fwd, NWAVES * 64, LDS_BYTES) != hipSuccess || per_cu < 1) { fprintf(stderr, "kernel_launch: occupancy query says %d\n", per_cu); }
        (void)hipGetLastError();
        grid = cus;
    }
    if (grid < 0) return;
    if (hipMemsetAsync((char*)d_ws + WS_CTL, 0, CTL_ZERO_BYTES, stream) != hipSuccess) return;
    Args a{};
    for (int i = 0; i < 27; ++i) a.in[i] = (const float*)d_in[i];
    a.out = (float*)d_out; a.ws = (unsigned char*)d_ws;
    hipLaunchKernelGGL(yoco_fwd, dim3(grid), dim3(NWAVES * 64), LDS_BYTES, stream, a);
}
```

```cpp
#include <hip/hip_runtime.h>
#include <cstdio>
#include <cstdint>
__device__ __forceinline__ int lane_id_() { unsigned m_ = ~0u; asm volatile("" : "+s"(m_)); return (int)__builtin_amdgcn_mbcnt_hi(m_, __builtin_amdgcn_mbcnt_lo(m_, 0u)); }
template <int X> __device__ __forceinline__ float swz_xor(float v) { return __builtin_bit_cast(float, __builtin_amdgcn_ds_swizzle(__builtin_bit_cast(int, v), (X << 10) | 0x1f)); }
__device__ __forceinline__ void halves32(float v, float& r_lo, float& r_hi) { unsigned a_ = __builtin_bit_cast(unsigned, v), b_ = a_;
    asm volatile("s_nop 1\n\tv_permlane32_swap_b32 %0, %1\n\ts_nop 1" : "+v"(a_), "+v"(b_)); r_lo = __builtin_bit_cast(float, a_); r_hi = __builtin_bit_cast(float, b_); }
__device__ __forceinline__ float xor32_partner(float v, int upper_half) { float lo, hi; halves32(v, lo, hi); return upper_half ? lo : hi; }
__device__ __forceinline__ float xor32_sum(float v) { float lo, hi; halves32(v, lo, hi); return lo + hi; }
__device__ __forceinline__ float xor32_max(float v) { float lo, hi; halves32(v, lo, hi); return fmaxf(lo, hi); }
namespace pg8 {
#define PG8_LAS __attribute__((address_space(3)))
typedef unsigned short bf16_t;
typedef short bf16x8 __attribute__((ext_vector_type(8)));
typedef float f32x4 __attribute__((ext_vector_type(4)));
typedef unsigned u32x4 __attribute__((ext_vector_type(4)));
constexpr int BM = 256, BK = 64, HALF = 128, HTB = HALF * BK * 2  , STAGE_BYTES = 8 * HTB, NXCD = 8, WGM = 8;

__host__ __device__ __forceinline__ int lds_byte(int r, int c) { const int st = (r >> 4) * 2 + (c >> 5), rr = r & 15, cc = c & 31, ob = rr * 64 + cc * 2; return st * 1024 + (ob ^ (((ob >> 9) & 1) << 5)); }
__host__ __device__ __forceinline__ void stage_rc(int b, int& R, int& C) { const int st = b / 1024, sb = b % 1024, swz = sb ^ (((sb >> 9) & 1) << 5); R = (st >> 1) * 16 + swz / 64; C = (st & 1) * 32 + (swz % 64) / 2; }
__host__ __device__ __forceinline__ int perm32(int rho) { const int n = rho >> 4, i = rho & 15; return 8 * (i >> 2) + 4 * n + (i & 3); }

struct Unit { int pm, pn; };
struct Gemm { const bf16_t* A; const bf16_t* Bt; int M, N, K, lda; };

struct StaticOrder {
    int nM, nN, nwg, G, c;
    __host__ __device__ void init(int M, int N, int G_, int c_) { nM = M / BM; nN = N / BM; nwg = nM * nN; G = G_; c = c_; }
    __host__ __device__ bool next(int i, Unit& u) const {
        const int L = i * G + c; if (L >= nwg) return false;
        int wgid = L; { const int q = nwg / NXCD, r = nwg % NXCD, xcd = wgid % NXCD, off = wgid / NXCD; wgid = (xcd < r ? xcd * (q + 1) : r * (q + 1) + (xcd - r) * q) + off; }
        const int nig = WGM * nN, gid = wgid / nig, fm = gid * WGM, gsz = (nM - fm) < WGM ? (nM - fm) : WGM;
        u.pm = fm + ((wgid % nig) % gsz); u.pn = (wgid % nig) / gsz; return true;
    }
    __device__ __forceinline__ void a_ready(const Unit&) const {}
    __device__ __forceinline__ void done(const Unit&) const {}
};
__device__ __forceinline__ unsigned cvt_pk_bf16(float lo, float hi) { unsigned r; asm volatile("v_cvt_pk_bf16_f32 %0, %1, %2" : "=v"(r) : "v"(lo), "v"(hi)); return r; }
__device__ __forceinline__ float silu_f(float x) { const float e = __builtin_amdgcn_exp2f(x * -1.4426950408889634f); return x * __builtin_amdgcn_rcpf(1.f + e); }

__device__ __forceinline__ float sum4(const f32x4& a) { return (a[0] + a[1]) + (a[2] + a[3]); }
__device__ __forceinline__ float part_sum8(const float* p) { return sum4(*(const f32x4*)p) + sum4(*(const f32x4*)(p + 4)); }
__device__ __forceinline__ float part_sum16(const float* p) { return (sum4(*(const f32x4*)p) + sum4(*(const f32x4*)(p + 4))) + (sum4(*(const f32x4*)(p + 8)) + sum4(*(const f32x4*)(p + 12))); }
__device__ __forceinline__ float fq_sum(float v) { v += swz_xor<16>(v); return xor32_sum(v); }
__device__ __forceinline__ float sq8(const f32x4& a, const f32x4& b) { return ((a[0] * a[0] + a[1] * a[1]) + (a[2] * a[2] + a[3] * a[3])) + ((b[0] * b[0] + b[1] * b[1]) + (b[2] * b[2] + b[3] * b[3])); }
__device__ __forceinline__ u32x4 pack8(const f32x4& a, const f32x4& b) { u32x4 w; w.x = cvt_pk_bf16(a[0], a[1]); w.y = cvt_pk_bf16(a[2], a[3]); w.z = cvt_pk_bf16(b[0], b[1]); w.w = cvt_pk_bf16(b[2], b[3]); return w; }
constexpr float EPS_ = 1e-6f;
__device__ __forceinline__ unsigned pk_fp8x4(float a, float b, float c, float d) { int w = 0; w = __builtin_amdgcn_cvt_pk_fp8_f32(a, b, w, false); w = __builtin_amdgcn_cvt_pk_fp8_f32(c, d, w, true); return (unsigned)w; }

struct EpiQA {
    static constexpr bool PERM = true, AFTER_DRAIN = false;
    bf16_t* O; float* part; float wscale;
    __device__ __forceinline__ void operator()(const f32x4 (&acc)[2][2][4][2], const Unit& u, int wr, int wc, int fr, int fq) const {
        { int t_ = lane_id_(); asm volatile("" : "+v"(t_)); fr = t_ & 15; fq = (t_ >> 4) & 3; }
        const int row0 = u.pm * BM + wr * 64 + fr, col0 = u.pn * BM + wc * 32 + 8 * fq;
#pragma unroll
        for (int ai = 0; ai < 2; ++ai)
#pragma unroll
            for (int m = 0; m < 4; ++m) { const int row = row0 + ai * HALF + m * 16; bf16_t* rowp = O + (size_t)row * 768 + col0;
                const f32x4 a0 = acc[ai][0][m][0] * wscale, a1 = acc[ai][0][m][1] * wscale, b0 = acc[ai][1][m][0] * wscale, b1 = acc[ai][1][m][1] * wscale;
                *(u32x4*)(rowp) = pack8(a0, a1); *(u32x4*)(rowp + HALF) = pack8(b0, b1);
                const float s0 = sq8(a0, a1), s1 = sq8(b0, b1);
                float* pr = part + (size_t)row * 16;
                if (u.pn == 0) { const float t = fq_sum(s0 + s1); if (fq == 0) pr[wc] = t; }
                else if (u.pn == 1) { const float t0 = fq_sum(s0), t1 = fq_sum(s1); if (fq == 0) { pr[4 + wc] = t0; pr[8 + wc] = t1; } }
                else { const float t = fq_sum(s0); if (fq == 0) pr[12 + wc] = t; } }
    }
};

struct EpiRowScaleBf16 {
    static constexpr bool PERM = true, AFTER_DRAIN = false;
    bf16_t* O; int ldc; const float* part; float inv_n;
    __device__ __forceinline__ void operator()(const f32x4 (&acc)[2][2][4][2], const Unit& u, int wr, int wc, int fr, int fq) const {
        { int t_ = lane_id_(); asm volatile("" : "+v"(t_)); fr = t_ & 15; fq = (t_ >> 4) & 3; }
        const int row0 = u.pm * BM + wr * 64 + fr, col0 = u.pn * BM + wc * 32 + 8 * fq;
#pragma unroll
        for (int ai = 0; ai < 2; ++ai)
#pragma unroll
            for (int m = 0; m < 4; ++m) { const int row = row0 + ai * HALF + m * 16; bf16_t* rowp = O + (size_t)row * ldc + col0;
                const float rs = __builtin_amdgcn_rsqf(part_sum8(part + (size_t)row * 16) * inv_n + EPS_);
                *(u32x4*)(rowp) = pack8(acc[ai][0][m][0] * rs, acc[ai][0][m][1] * rs); *(u32x4*)(rowp + HALF) = pack8(acc[ai][1][m][0] * rs, acc[ai][1][m][1] * rs); }
    }
};

struct EpiKVup {
    static constexpr bool PERM = true, AFTER_DRAIN = false;
    bf16_t* Kd; bf16_t* Vd; const float* part; const bf16_t* QA; const float* g_kn; const float* rope;
    __device__ __forceinline__ void operator()(const f32x4 (&acc)[2][2][4][2], const Unit& u, int wr, int wc, int fr, int fq) const {
        { int t_ = lane_id_(); asm volatile("" : "+v"(t_)); fr = t_ & 15; fq = (t_ >> 4) & 3; }
        const int row0 = u.pm * BM + wr * 64 + fr;
        if (u.pn >= 4) {
            const int col0 = (u.pn - 4) * BM + wc * 32 + 8 * fq;
#pragma unroll
            for (int ai = 0; ai < 2; ++ai)
#pragma unroll
                for (int m = 0; m < 4; ++m) { const int row = row0 + ai * HALF + m * 16; bf16_t* rowp = Vd + (size_t)row * 1024 + col0;
                    const float rs = __builtin_amdgcn_rsqf(part_sum8(part + (size_t)row * 16 + 8) * (1.f / 256) + EPS_);
                    *(u32x4*)(rowp) = pack8(acc[ai][0][m][0] * rs, acc[ai][0][m][1] * rs); *(u32x4*)(rowp + HALF) = pack8(acc[ai][1][m][0] * rs, acc[ai][1][m][1] * rs); }
            return;
        }
        const int head = 4 * u.pn + wc;
        f32x4 gA0 = *(const f32x4*)(g_kn + 8 * fq), gA1 = *(const f32x4*)(g_kn + 8 * fq + 4), gB0 = *(const f32x4*)(g_kn + 32 + 8 * fq), gB1 = *(const f32x4*)(g_kn + 32 + 8 * fq + 4);
        const f32x4 gR1 = *(const f32x4*)(g_kn + 64 + 4 * fq), gR2 = *(const f32x4*)(g_kn + 80 + 4 * fq);
#pragma unroll
        for (int ai = 0; ai < 2; ++ai)
#pragma unroll
            for (int m = 0; m < 4; ++m) { const int row = row0 + ai * HALF + m * 16;
                const float rs = __builtin_amdgcn_rsqf(part_sum8(part + (size_t)row * 16 + 8) * (1.f / 256) + EPS_);
                f32x4 a0 = acc[ai][0][m][0] * rs, a1 = acc[ai][0][m][1] * rs, b0 = acc[ai][1][m][0] * rs, b1 = acc[ai][1][m][1] * rs;
                const unsigned long long p1 = *(const unsigned long long*)(QA + (size_t)row * 768 + 640 + 4 * fq), p2 = *(const unsigned long long*)(QA + (size_t)row * 768 + 656 + 4 * fq);
                f32x4 x1, x2;
                x1[0] = __builtin_bit_cast(float, (unsigned)(p1 << 16)); x1[1] = __builtin_bit_cast(float, (unsigned)p1 & 0xffff0000u);
                x1[2] = __builtin_bit_cast(float, (unsigned)(p1 >> 32) << 16); x1[3] = __builtin_bit_cast(float, (unsigned)(p1 >> 32) & 0xffff0000u);
                x2[0] = __builtin_bit_cast(float, (unsigned)(p2 << 16)); x2[1] = __builtin_bit_cast(float, (unsigned)p2 & 0xffff0000u);
                x2[2] = __builtin_bit_cast(float, (unsigned)(p2 >> 32) << 16); x2[3] = __builtin_bit_cast(float, (unsigned)(p2 >> 32) & 0xffff0000u);
                const float ss = fq_sum(sq8(a0, a1) + sq8(b0, b1) + sq8(x1, x2));
                const float sh = __builtin_amdgcn_rsqf(ss * (1.f / 96) + EPS_);
                bf16_t* kp = Kd + (size_t)row * 1536 + head * 96;
                *(u32x4*)(kp + 8 * fq) = pack8(a0 * gA0 * sh, a1 * gA1 * sh); *(u32x4*)(kp + 32 + 8 * fq) = pack8(b0 * gB0 * sh, b1 * gB1 * sh);
                const f32x4* rp = (const f32x4*)(rope + ((size_t)(row & 2047) * 16 + 4 * fq) * 2);
                const f32x4 c01 = rp[0], c23 = rp[1];
                const f32x4 y1 = x1 * gR1 * sh, y2 = x2 * gR2 * sh;
                f32x4 o1, o2;
                o1[0] = y1[0] * c01[0] - y2[0] * c01[1]; o2[0] = y2[0] * c01[0] + y1[0] * c01[1];
                o1[1] = y1[1] * c01[2] - y2[1] * c01[3]; o2[1] = y2[1] * c01[2] + y1[1] * c01[3];
                o1[2] = y1[2] * c23[0] - y2[2] * c23[1]; o2[2] = y2[2] * c23[0] + y1[2] * c23[1];
                o1[3] = y1[3] * c23[2] - y2[3] * c23[3]; o2[3] = y2[3] * c23[2] + y1[3] * c23[3];
                unsigned long long w1 = (unsigned long long)cvt_pk_bf16(o1[0], o1[1]) | ((unsigned long long)cvt_pk_bf16(o1[2], o1[3]) << 32);
                unsigned long long w2 = (unsigned long long)cvt_pk_bf16(o2[0], o2[1]) | ((unsigned long long)cvt_pk_bf16(o2[2], o2[3]) << 32);
                *(unsigned long long*)(kp + 64 + 4 * fq) = w1; *(unsigned long long*)(kp + 80 + 4 * fq) = w2; }
    }
};

struct EpiK2Q2 {
    static constexpr bool PERM = true, AFTER_DRAIN = false;
    bf16_t* O; const float* pss; const float* gk; const float* gq; float wscale;
    __device__ __forceinline__ void operator()(const f32x4 (&acc)[2][2][4][2], const Unit& u, int wr, int wc, int fr, int fq) const {
        { int t_ = lane_id_(); asm volatile("" : "+v"(t_)); fr = t_ & 15; fq = (t_ >> 4) & 3; }
        const int row0 = u.pm * BM + wr * 64 + fr, isq = u.pn >> 2, tl = u.pn & 3;
        const float* g = isq ? gq : gk; const float post = isq ? 0.125f * 1.4426950408889634f : 1.f;
        const f32x4 gA0 = *(const f32x4*)(g + 8 * fq) * post, gA1 = *(const f32x4*)(g + 8 * fq + 4) * post, gB0 = *(const f32x4*)(g + 32 + 8 * fq) * post, gB1 = *(const f32x4*)(g + 32 + 8 * fq + 4) * post;
        const int colh = isq * 2048 + (4 * tl + wc) * 64;
        unsigned zhi_ = 0u; asm volatile("" : "+v"(zhi_));
        const unsigned long long coff = ((unsigned long long)zhi_ << 32) | (unsigned)((colh + 8 * fq) * 2);
#pragma unroll
        for (int ai = 0; ai < 2; ++ai)
#pragma unroll
            for (int m = 0; m < 4; ++m) { const int row = row0 + ai * HALF + m * 16; unsigned char* rowp = (unsigned char*)O + (size_t)row * 6144 + coff;
                const float rs = __builtin_amdgcn_rsqf(part_sum16(pss + (size_t)row * 16) * (1.f / 1024) + EPS_) * wscale;
                const f32x4 a0 = acc[ai][0][m][0] * rs, a1 = acc[ai][0][m][1] * rs, b0 = acc[ai][1][m][0] * rs, b1 = acc[ai][1][m][1] * rs;
                const float ss = fq_sum(sq8(a0, a1) + sq8(b0, b1));
                const float sh = __builtin_amdgcn_rsqf(ss * (1.f / 64) + EPS_);
                *(u32x4*)(rowp) = pack8(a0 * gA0 * sh, a1 * gA1 * sh); *(u32x4*)(rowp + 64) = pack8(b0 * gB0 * sh, b1 * gB1 * sh); }
    }
};
struct EpiRowScale16 {
    static constexpr bool PERM = true, AFTER_DRAIN = false;
    bf16_t* O; int ldc; int coff; const float* pss; float wscale;
    __device__ __forceinline__ void operator()(const f32x4 (&acc)[2][2][4][2], const Unit& u, int wr, int wc, int fr, int fq) const {
        { int t_ = lane_id_(); asm volatile("" : "+v"(t_)); fr = t_ & 15; fq = (t_ >> 4) & 3; }
        const int row0 = u.pm * BM + wr * 64 + fr, col0 = coff + u.pn * BM + wc * 32 + 8 * fq;
#pragma unroll
        for (int ai = 0; ai < 2; ++ai)
#pragma unroll
            for (int m = 0; m < 4; ++m) { const int row = row0 + ai * HALF + m * 16; bf16_t* rowp = O + (size_t)row * ldc + col0;
                const float rs = __builtin_amdgcn_rsqf(part_sum16(pss + (size_t)row * 16) * (1.f / 1024) + EPS_) * wscale;
                *(u32x4*)(rowp) = pack8(acc[ai][0][m][0] * rs, acc[ai][0][m][1] * rs); *(u32x4*)(rowp + HALF) = pack8(acc[ai][1][m][0] * rs, acc[ai][1][m][1] * rs); }
    }
};

template <bool SSQ> struct EpiGated {
    static constexpr bool PERM = true, AFTER_DRAIN = false;
    bf16_t* Hd; int ldc; int ntile; const float* rs;
    __device__ __forceinline__ void operator()(const f32x4 (&acc)[2][2][4][2], const Unit& u, int wr, int wc, int fr, int fq) const {
        { int t_ = lane_id_(); asm volatile("" : "+v"(t_)); fr = t_ & 15; fq = (t_ >> 4) & 3; }
        const int pnl = ntile ? (u.pn % ntile) : u.pn;
        const int row0 = u.pm * BM + wr * 64 + fr, col0 = pnl * HALF + wc * 32 + 8 * fq;
#pragma unroll
        for (int ai = 0; ai < 2; ++ai)
#pragma unroll
            for (int m = 0; m < 4; ++m) { const int row = row0 + ai * HALF + m * 16; bf16_t* rowp = Hd + (size_t)row * ldc + col0;
                const float r = SSQ ? __builtin_amdgcn_rsqf(part_sum16(rs + (size_t)row * 16) * (1.f / 1024) + EPS_) : rs[row];
                const f32x4 g0 = acc[ai][0][m][0] * r, g1 = acc[ai][0][m][1] * r, u0 = acc[ai][1][m][0] * r, u1 = acc[ai][1][m][1] * r;
                u32x4 w;
                w.x = cvt_pk_bf16(silu_f(g0[0]) * u0[0], silu_f(g0[1]) * u0[1]); w.y = cvt_pk_bf16(silu_f(g0[2]) * u0[2], silu_f(g0[3]) * u0[3]);
                w.z = cvt_pk_bf16(silu_f(g1[0]) * u1[0], silu_f(g1[1]) * u1[1]); w.w = cvt_pk_bf16(silu_f(g1[2]) * u1[2], silu_f(g1[3]) * u1[3]);
                *(u32x4*)rowp = w; }
    }
};

struct EpiGatedF8 {
    static constexpr bool PERM = true, AFTER_DRAIN = false;
    unsigned char* Hd; int ldc; int ntile;
    static __device__ __forceinline__ float gate(float g, float u) {
        const float e = __builtin_amdgcn_exp2f(g * (-1.4426950408889634f / 64.f)); return (g * u) * (__builtin_amdgcn_rcpf(1.f + e) * (1.f / 4096.f)); }
    __device__ __forceinline__ void operator()(const f32x4 (&acc)[2][2][4][2], const Unit& u, int wr, int wc, int fr, int fq) const {
        { int t_ = lane_id_(); asm volatile("" : "+v"(t_)); fr = t_ & 15; fq = (t_ >> 4) & 3; }
        const int pnl = u.pn % ntile;
        const int row0 = u.pm * BM + wr * 64 + fr, col0 = pnl * HALF + wc * 32 + 8 * fq;
#pragma unroll
        for (int ai = 0; ai < 2; ++ai)
#pragma unroll
            for (int m = 0; m < 4; ++m) { const int row = row0 + ai * HALF + m * 16; unsigned char* rowp = Hd + (size_t)row * ldc + col0;
                const f32x4 g0 = acc[ai][0][m][0], g1 = acc[ai][0][m][1], u0 = acc[ai][1][m][0], u1 = acc[ai][1][m][1];
                unsigned long long w = (unsigned long long)pk_fp8x4(gate(g0[0], u0[0]), gate(g0[1], u0[1]), gate(g0[2], u0[2]), gate(g0[3], u0[3]))
                                     | ((unsigned long long)pk_fp8x4(gate(g1[0], u1[0]), gate(g1[1], u1[1]), gate(g1[2], u1[2]), gate(g1[3], u1[3])) << 32);
                *(unsigned long long*)rowp = w; }
    }
};

template <bool SSQ, bool XF8 = false> struct EpiResNorm {
    static constexpr bool PERM = true, AFTER_DRAIN = false;
    const float* res; float* out; bf16_t* XR; float* ssq;
    __device__ __forceinline__ void operator()(const f32x4 (&acc)[2][2][4][2], const Unit& u, int wr, int wc, int fr, int fq) const {
        { int t_ = lane_id_(); asm volatile("" : "+v"(t_)); fr = t_ & 15; fq = (t_ >> 4) & 3; }
        const int row0 = u.pm * BM + wr * 64 + fr, col0 = u.pn * BM + wc * 32 + 8 * fq;
#pragma unroll
        for (int ai = 0; ai < 2; ++ai)
#pragma unroll
            for (int m = 0; m < 4; ++m) { const int row = row0 + ai * HALF + m * 16; const size_t ro = (size_t)row * 1024 + col0;
                f32x4 r[2][2];
#pragma unroll
                for (int bj = 0; bj < 2; ++bj)
#pragma unroll
                    for (int n = 0; n < 2; ++n) r[bj][n] = *(const f32x4*)(res + ro + bj * HALF + n * 4);
#pragma unroll
                for (int bj = 0; bj < 2; ++bj)
#pragma unroll
                    for (int n = 0; n < 2; ++n) { r[bj][n] = r[bj][n] + acc[ai][bj][m][n]; *(f32x4*)(out + ro + bj * HALF + n * 4) = r[bj][n]; }
                if constexpr (XF8) { unsigned char* x8 = (unsigned char*)XR + ro;
                    *(unsigned long long*)(x8) = (unsigned long long)pk_fp8x4(r[0][0][0], r[0][0][1], r[0][0][2], r[0][0][3]) | ((unsigned long long)pk_fp8x4(r[0][1][0], r[0][1][1], r[0][1][2], r[0][1][3]) << 32);
                    *(unsigned long long*)(x8 + HALF) = (unsigned long long)pk_fp8x4(r[1][0][0], r[1][0][1], r[1][0][2], r[1][0][3]) | ((unsigned long long)pk_fp8x4(r[1][1][0], r[1][1][1], r[1][1][2], r[1][1][3]) << 32); }
                else { *(u32x4*)(XR + ro) = pack8(r[0][0], r[0][1]); *(u32x4*)(XR + ro + HALF) = pack8(r[1][0], r[1][1]); }
                if (SSQ) { const float t = fq_sum(sq8(r[0][0], r[0][1]) + sq8(r[1][0], r[1][1])); if (fq == 0) ssq[(size_t)row * 16 + u.pn * 4 + wc] = t; } }
    }
};

struct EpiMoeDown {
    static constexpr bool PERM = false, AFTER_DRAIN = false;
    float* out; const int* slot_tok; const float* slot_gate; int slot_base; int ldc; float wscale;
    __device__ __forceinline__ void operator()(const f32x4 (&acc)[2][2][4][2], const Unit& u, int wr, int wc, int fr, int fq) const {
        { int t_ = lane_id_(); asm volatile("" : "+v"(t_)); fr = t_ & 15; fq = (t_ >> 4) & 3; }
        const int pnl = u.pn & 3;
        const int row0 = slot_base + u.pm * BM + wr * 64 + fr, col0 = pnl * BM + wc * 32 + 4 * fq;
#pragma unroll
        for (int ai = 0; ai < 2; ++ai)
#pragma unroll
            for (int m = 0; m < 4; ++m) { const int slot = row0 + ai * HALF + m * 16; const int tok = slot_tok[slot]; const float gt = slot_gate[slot] * wscale;
                if (tok >= 0) { float* rowp = out + (size_t)tok * ldc + col0;
                    f32x4 r[2][2];
#pragma unroll
                    for (int bj = 0; bj < 2; ++bj)
#pragma unroll
                        for (int n = 0; n < 2; ++n) r[bj][n] = *(const f32x4*)(rowp + bj * HALF + n * 16);
#pragma unroll
                    for (int bj = 0; bj < 2; ++bj)
#pragma unroll
                        for (int n = 0; n < 2; ++n) *(f32x4*)(rowp + bj * HALF + n * 16) = r[bj][n] + acc[ai][bj][m][n] * gt; } }
    }
};

struct MoeOrder {
    int nM, nN, nwg, G, c; const int* panel_e;
    __device__ void init(int nPanels, int nN_, int G_, int c_, const int* pe) { nM = nPanels; nN = nN_; nwg = nM * nN; G = G_; c = c_; panel_e = pe; }
    __device__ bool next(int i, Unit& u) const {
        const int L = i * G + c; if (L >= nwg) return false;
        int wgid = L; { const int q = nwg / NXCD, r = nwg % NXCD, xcd = wgid % NXCD, off = wgid / NXCD; wgid = (xcd < r ? xcd * (q + 1) : r * (q + 1) + (xcd - r) * q) + off; }
        const int nig = WGM * nN, gid = wgid / nig, fm = gid * WGM, gsz = (nM - fm) < WGM ? (nM - fm) : WGM;
        u.pm = fm + ((wgid % nig) % gsz); const int pnl = (wgid % nig) / gsz;
        const int e = __builtin_amdgcn_readfirstlane(panel_e[u.pm]);
        u.pn = e * nN + pnl; return true;
    }
    __device__ __forceinline__ void a_ready(const Unit&) const {}
    __device__ __forceinline__ void done(const Unit&) const {}
};
template <class Epi, class Sched, bool ALIGN_EPI = false, bool SP2 = false, bool F8 = false>
__device__ __forceinline__ void gemm_phase(PG8_LAS unsigned char* lds, const Gemm g, const Sched& S, const Epi& E, const int wave_idx) {
    int tid_ = wave_idx * 64 + lane_id_(); asm volatile("" : "+v"(tid_));
    const int tid = tid_, wid = __builtin_amdgcn_readfirstlane(tid >> 6), lane = tid & 63, wr = wid >> 2, wc = wid & 3, fr = lane & 15, fq = lane >> 4;
    const int K = g.K, nt = K / BK;
    unsigned voffA0, voffB0;
    { int R, C; stage_rc(tid * 16, R, C); const int Rb = Epi::PERM ? ((R & ~31) + perm32(R & 31)) : R;
      voffA0 = (unsigned)(R * g.lda + C) * 2u; voffB0 = (unsigned)(Rb * K + C) * 2u; }
    const size_t voffAR = (size_t)64 * g.lda * 2, voffBR = (size_t)64 * K * 2;
    const size_t kstep = (size_t)(BK * 2);
    const size_t hstepA = (size_t)HALF * g.lda * 2, hstepB = (size_t)HALF * K * 2;
    const size_t tstepA = 2 * hstepA, tstepB = 2 * hstepB;
    const unsigned lds0_ = (unsigned)(__UINTPTR_TYPE__)lds;
    const unsigned ldsw = (unsigned)wid * 1024u;
    const int aoff = lds_byte(wr * 64 + fr, fq * 8), boff = lds_byte(wc * 32 + fr, fq * 8);
#define PG8_SA(b, h) (((b) * 2 + (h)) * HTB)
#define PG8_SB(b, h) ((4 + (b) * 2 + (h)) * HTB)
#define PG8_STAGE(bufoff, gbase, voff) do { _Pragma("unroll") for (int _i = 0; _i < 2; ++_i) { unsigned keep_; const char* sb_ = (const char*)(gbase) + (size_t)_i * voff##R; \
        asm volatile("s_mov_b32 %0, m0\n\ts_mov_b32 m0, %3\n\ts_nop 0\n\tglobal_load_lds_dwordx4 %1, %2\n\ts_mov_b32 m0, %0" \
            : "=&s"(keep_) : "v"(voff##0), "s"(sb_), "s"(lds0_ + (unsigned)((bufoff) + _i * 8192) + ldsw) : "memory"); } } while (0)
#define PG8_LDA(dst, b, h) do { _Pragma("unroll") for (int m = 0; m < 4; ++m) _Pragma("unroll") for (int k = 0; k < 2; ++k) dst[m][k] = *(const PG8_LAS bf16x8*)(lds + PG8_SA(b, h) + aoff + m * 2048 + k * 1024); } while (0)
#define PG8_LDB(dst, b, h) do { _Pragma("unroll") for (int n = 0; n < 2; ++n) _Pragma("unroll") for (int k = 0; k < 2; ++k) dst[n][k] = *(const PG8_LAS bf16x8*)(lds + PG8_SB(b, h) + boff + n * 2048 + k * 1024); } while (0)
#define PG8_MMA(ai, bj, At, Bt) do { __builtin_amdgcn_s_setprio(1); _Pragma("unroll") for (int m = 0; m < 4; ++m) _Pragma("unroll") for (int n = 0; n < 2; ++n) { \
        if constexpr (F8) { typedef int v8i_ __attribute__((ext_vector_type(8))); typedef int v4i_ __attribute__((ext_vector_type(4))); \
            const v4i_ b0_ = __builtin_bit_cast(v4i_, Bt[n][0]), b1_ = __builtin_bit_cast(v4i_, Bt[n][1]), a0_ = __builtin_bit_cast(v4i_, At[m][0]), a1_ = __builtin_bit_cast(v4i_, At[m][1]); \
            const v8i_ bb_ = __builtin_shufflevector(b0_, b1_, 0, 1, 2, 3, 4, 5, 6, 7), aa_ = __builtin_shufflevector(a0_, a1_, 0, 1, 2, 3, 4, 5, 6, 7); \
            acc[ai][bj][m][n] = __builtin_amdgcn_mfma_scale_f32_16x16x128_f8f6f4(bb_, aa_, acc[ai][bj][m][n], 0, 0, 0, 0, 0, 0); } \
        else { _Pragma("unroll") for (int k = 0; k < 2; ++k) acc[ai][bj][m][n] = __builtin_amdgcn_mfma_f32_16x16x32_bf16(Bt[n][k], At[m][k], acc[ai][bj][m][n], 0, 0, 0); } } \
        __builtin_amdgcn_s_setprio(0); } while (0)
#define PG8_WAIT_V(n) asm volatile("s_waitcnt vmcnt(" #n ")" ::: "memory")
#define PG8_WAIT_L(n) asm volatile("s_waitcnt lgkmcnt(" #n ")" ::: "memory")
#define PG8_BAR __builtin_amdgcn_s_barrier()
#define PG8_SCHED __builtin_amdgcn_sched_barrier(0)
    Unit cur, nxt; int ui = 0;
    if (!S.next(0, cur)) return;
    f32x4 acc[2][2][4][2];
#pragma unroll
    for (int a = 0; a < 2; ++a)
#pragma unroll
        for (int b = 0; b < 2; ++b)
#pragma unroll
            for (int m = 0; m < 4; ++m)
#pragma unroll
                for (int n = 0; n < 2; ++n) acc[a][b][m][n] = (f32x4){0.f, 0.f, 0.f, 0.f};
    bf16x8 At[4][2], B0[2][2], B1[2][2];
    const char* cA = (const char*)g.A + (size_t)cur.pm * tstepA; const char* cB = (const char*)g.Bt + (size_t)cur.pn * tstepB;
    S.a_ready(cur);
    if constexpr (SP2) {
        PG8_STAGE(PG8_SB(0, 0), cB, voffB); PG8_STAGE(PG8_SB(0, 1), cB + hstepB, voffB); PG8_STAGE(PG8_SA(0, 0), cA, voffA); PG8_STAGE(PG8_SA(0, 1), cA + hstepA, voffA);
        if (wr == 1) PG8_BAR;
        PG8_WAIT_V(2); PG8_BAR;
        PG8_STAGE(PG8_SB(1, 0), cB + kstep, voffB); PG8_STAGE(PG8_SA(1, 0), cA + kstep, voffA); PG8_STAGE(PG8_SB(1, 1), cB + hstepB + kstep, voffB);
        PG8_WAIT_V(6); PG8_BAR;
    } else {
        PG8_STAGE(PG8_SB(0, 0), cB, voffB); PG8_STAGE(PG8_SA(0, 0), cA, voffA); PG8_STAGE(PG8_SB(0, 1), cB + hstepB, voffB); PG8_STAGE(PG8_SA(0, 1), cA + hstepA, voffA);
        if (wr == 1) PG8_BAR;
        PG8_WAIT_V(4); PG8_BAR;
        PG8_STAGE(PG8_SB(1, 0), cB + kstep, voffB); PG8_STAGE(PG8_SA(1, 0), cA + kstep, voffA); PG8_STAGE(PG8_SB(1, 1), cB + hstepB + kstep, voffB);
        PG8_WAIT_V(6); PG8_BAR;
    }
    for (;;) {
        const bool has_next = S.next(ui + 1, nxt);
        const char* nA = has_next ? (const char*)g.A + (size_t)nxt.pm * tstepA : cA; const char* nB = has_next ? (const char*)g.Bt + (size_t)nxt.pn * tstepB : cB;
#pragma unroll 1
        for (int t = 0; t < nt; t += 2) {
            const bool last = (t == nt - 2);
            const char* a1 = cA + (size_t)(t + 1) * kstep;
            const char* a2 = last ? nA : cA + (size_t)(t + 2) * kstep; const char* b2 = last ? nB : cB + (size_t)(t + 2) * kstep;
            const char* a3 = a2 + kstep; const char* b3 = b2 + kstep;
            if (last && has_next) S.a_ready(nxt);
            if constexpr (SP2) {
            PG8_LDB(B0, 0, 0); PG8_LDB(B1, 0, 1); PG8_SCHED; PG8_LDA(At, 0, 0); PG8_STAGE(PG8_SA(1, 1), a1 + hstepA, voffA);
            PG8_WAIT_V(8); PG8_WAIT_L(0); PG8_BAR; PG8_MMA(0, 0, At, B0); PG8_MMA(0, 1, At, B1); PG8_BAR; PG8_SCHED;
            PG8_LDA(At, 0, 1); PG8_STAGE(PG8_SB(0, 0), b2, voffB); PG8_STAGE(PG8_SB(0, 1), b2 + hstepB, voffB); PG8_STAGE(PG8_SA(0, 0), a2, voffA);
            PG8_WAIT_V(8); PG8_WAIT_L(0); PG8_BAR; PG8_MMA(1, 0, At, B0); PG8_MMA(1, 1, At, B1); PG8_BAR; PG8_SCHED;
            PG8_LDB(B0, 1, 0); PG8_LDB(B1, 1, 1); PG8_SCHED; PG8_LDA(At, 1, 0); PG8_STAGE(PG8_SA(0, 1), a2 + hstepA, voffA);
            PG8_WAIT_V(8); PG8_WAIT_L(0); PG8_BAR; PG8_MMA(0, 0, At, B0); PG8_MMA(0, 1, At, B1); PG8_BAR; PG8_SCHED;
            PG8_LDA(At, 1, 1); PG8_STAGE(PG8_SB(1, 0), b3, voffB); PG8_STAGE(PG8_SB(1, 1), b3 + hstepB, voffB); PG8_STAGE(PG8_SA(1, 0), a3, voffA);
            PG8_WAIT_V(8); PG8_WAIT_L(0); PG8_BAR; PG8_MMA(1, 0, At, B0); PG8_MMA(1, 1, At, B1); PG8_BAR; PG8_SCHED;
            } else {
            PG8_LDB(B0, 0, 0); PG8_SCHED; PG8_LDA(At, 0, 0); PG8_STAGE(PG8_SA(1, 1), a1 + hstepA, voffA);
            PG8_WAIT_L(8); PG8_BAR; PG8_WAIT_L(0); PG8_MMA(0, 0, At, B0); PG8_BAR; PG8_SCHED;
            PG8_LDB(B1, 0, 1); PG8_STAGE(PG8_SB(0, 0), b2, voffB);
            PG8_BAR; PG8_WAIT_L(0); PG8_MMA(0, 1, At, B1); PG8_BAR;
            PG8_LDA(At, 0, 1); PG8_STAGE(PG8_SA(0, 0), a2, voffA);
            PG8_BAR; PG8_WAIT_L(0); PG8_MMA(1, 0, At, B0); PG8_BAR; PG8_SCHED;
            PG8_STAGE(PG8_SB(0, 1), b2 + hstepB, voffB);
            PG8_WAIT_V(6); PG8_BAR; PG8_MMA(1, 1, At, B1); PG8_BAR;
            PG8_LDB(B0, 1, 0); PG8_SCHED; PG8_LDA(At, 1, 0); PG8_STAGE(PG8_SA(0, 1), a2 + hstepA, voffA);
            PG8_WAIT_L(8); PG8_BAR; PG8_WAIT_L(0); PG8_MMA(0, 0, At, B0); PG8_BAR; PG8_SCHED;
            PG8_LDB(B1, 1, 1); PG8_STAGE(PG8_SB(1, 0), b3, voffB);
            PG8_BAR; PG8_WAIT_L(0); PG8_MMA(0, 1, At, B1); PG8_BAR;
            PG8_LDA(At, 1, 1); PG8_STAGE(PG8_SA(1, 0), a3, voffA);
            PG8_BAR; PG8_WAIT_L(0); PG8_MMA(1, 0, At, B0); PG8_BAR; PG8_SCHED;
            PG8_STAGE(PG8_SB(1, 1), b3 + hstepB, voffB);
            PG8_WAIT_V(6); PG8_BAR; PG8_MMA(1, 1, At, B1); PG8_BAR;
            }
        }
        if constexpr (ALIGN_EPI) { if (wr == 0) PG8_BAR; }
        if constexpr (!Epi::AFTER_DRAIN) { E(acc, cur, wr, wc, fr, fq); S.done(cur); }
        if (!has_next) break;
#pragma unroll
        for (int a = 0; a < 2; ++a)
#pragma unroll
            for (int b = 0; b < 2; ++b)
#pragma unroll
                for (int m = 0; m < 4; ++m)
#pragma unroll
                    for (int n = 0; n < 2; ++n) acc[a][b][m][n] = (f32x4){0.f, 0.f, 0.f, 0.f};
        cur = nxt; cA = nA; cB = nB; ++ui;
        if constexpr (ALIGN_EPI) { if (wr == 1) PG8_BAR; }
    }
    PG8_WAIT_V(0);
    if constexpr (!ALIGN_EPI) { if (wr == 0) PG8_BAR; }
    PG8_BAR;
    if constexpr (Epi::AFTER_DRAIN) { E.fused(acc, cur, wr, wc, fr, fq, lds, wid, lane); S.done(cur); }
#undef PG8_SA
#undef PG8_SB
#undef PG8_STAGE
#undef PG8_LDA
#undef PG8_LDB
#undef PG8_MMA
#undef PG8_WAIT_V
#undef PG8_WAIT_L
#undef PG8_BAR
#undef PG8_SCHED
}
}
namespace att {
#define ATT_LAS __attribute__((address_space(3)))
typedef unsigned short bf16;
typedef short bf16x8 __attribute__((ext_vector_type(8)));
typedef short s16x4 __attribute__((ext_vector_type(4)));
typedef float f32x16 __attribute__((ext_vector_type(16)));
typedef float f32x4_t __attribute__((ext_vector_type(4)));
typedef unsigned u32x4 __attribute__((ext_vector_type(4)));
typedef unsigned u32x2 __attribute__((ext_vector_type(2)));
typedef float f32x2_t __attribute__((ext_vector_type(2))); typedef __bf16 bf16x2_t __attribute__((ext_vector_type(2)));
__device__ __forceinline__ unsigned cvtpk(float lo, float hi) { f32x2_t v = {lo, hi}; bf16x2_t b = __builtin_convertvector(v, bf16x2_t); return __builtin_bit_cast(unsigned, b); }
__device__ __forceinline__ s16x4 vtr(const ATT_LAS unsigned char* p) { return __builtin_bit_cast(s16x4, __builtin_amdgcn_ds_read_tr16_b64_v4i16((ATT_LAS s16x4*)p)); }
constexpr int VSTR = 192;
template <int DQK> struct Geo { static constexpr int KSTR = DQK * 2 + 16, KBUF = 64 * KSTR, VBUF = 64 * VSTR, CPR = DQK / 8, NKC = 64 * CPR, KIT = (NKC + 511) / 512; };
template <int DQK> constexpr int lds_bytes() { return 2 * Geo<DQK>::KBUF + 2 * Geo<DQK>::VBUF + 2048 + 8192; }

__device__ __forceinline__ float xhalf_sum(float m) { return xor32_sum(m); }
__device__ __forceinline__ float max3f(float a, float b, float c) { float r; asm("v_max3_f32 %0, %1, %2, %3" : "=v"(r) : "v"(a), "v"(b), "v"(c)); return r; }
__device__ __forceinline__ float max2f(float a, float b) { float r; asm("v_max_f32_e32 %0, %1, %2" : "=v"(r) : "v"(a), "v"(b)); return r; }
__device__ __forceinline__ float rowmax32(const f32x16& p0, const f32x16& p1) {
    float a = max2f(p0[0], p1[0]), b = max2f(p0[1], p1[1]);
#pragma unroll
    for (int r = 2; r < 16; r += 2) { a = max3f(a, p0[r], p1[r]); b = max3f(b, p0[r + 1], p1[r + 1]); }
    const float m = max2f(a, b);
    float lo_, hi_; halves32(m, lo_, hi_);
    return max2f(lo_, hi_);
}

template <int DQK, bool BAND, int qpitch, int kpitch, int vpitch, int opitch>
__device__ __forceinline__ void attn_unit(ATT_LAS unsigned char* lds, const bf16* Qb, const bf16* Kb, const bf16* Vb, bf16* Ob,
                                          int q0, int t_lo, int t_hi, int my_lo, int my_hi, int cc, const float* bias_g, const float* g_qn, const float* rope, const int wave_idx) {
    typedef Geo<DQK> G;
    int tid_ = wave_idx * 64 + lane_id_(); asm volatile("" : "+v"(tid_));
    const int tid = tid_, lane = tid & 63, r32 = lane & 31, hi = lane >> 5, wid = __builtin_amdgcn_readfirstlane(tid >> 6);
    ATT_LAS float* biasL = (ATT_LAS float*)(lds + 2 * G::KBUF + 2 * G::VBUF);
    bf16x8 qf[DQK / 16];
    { const bf16* qp = Qb + (size_t)(q0 + wid * 32 + r32) * qpitch + 8 * hi;
#pragma unroll
      for (int kk = 0; kk < DQK / 16; ++kk) qf[kk] = *(const bf16x8*)(qp + 16 * kk); }
    if constexpr (!BAND) {
        float qv[DQK / 16][8]; float ss = 0.f;
#pragma unroll
        for (int kk = 0; kk < DQK / 16; ++kk)
#pragma unroll
            for (int j = 0; j < 8; ++j) { qv[kk][j] = __builtin_bit_cast(float, (unsigned)(unsigned short)qf[kk][j] << 16); ss += qv[kk][j] * qv[kk][j]; }
        ss = xhalf_sum(ss);
        const float rs = __builtin_amdgcn_rsqf(ss * (1.f / DQK) + 1e-6f) * (0.10206207261596577f * 1.4426950408889634f);
#pragma unroll
        for (int kk = 0; kk < DQK / 16; ++kk) { const f32x4_t g0 = *(const f32x4_t*)(g_qn + 16 * kk + 8 * hi), g1 = *(const f32x4_t*)(g_qn + 16 * kk + 8 * hi + 4);
#pragma unroll
            for (int j = 0; j < 4; ++j) { qv[kk][j] *= rs * g0[j]; qv[kk][4 + j] *= rs * g1[j]; } }
        const f32x4_t* rp = (const f32x4_t*)(rope + ((size_t)(q0 + wid * 32 + r32) * 16 + 8 * hi) * 2);
#pragma unroll
        for (int j2 = 0; j2 < 4; ++j2) { const f32x4_t cs = rp[j2];
            { const float x1 = qv[4][2 * j2], x2 = qv[5][2 * j2]; qv[4][2 * j2] = x1 * cs[0] - x2 * cs[1]; qv[5][2 * j2] = x2 * cs[0] + x1 * cs[1]; }
            { const float x1 = qv[4][2 * j2 + 1], x2 = qv[5][2 * j2 + 1]; qv[4][2 * j2 + 1] = x1 * cs[2] - x2 * cs[3]; qv[5][2 * j2 + 1] = x2 * cs[2] + x1 * cs[3]; } }
#pragma unroll
        for (int kk = 0; kk < DQK / 16; ++kk) { u32x4 w; w.x = cvtpk(qv[kk][0], qv[kk][1]); w.y = cvtpk(qv[kk][2], qv[kk][3]); w.z = cvtpk(qv[kk][4], qv[kk][5]); w.w = cvtpk(qv[kk][6], qv[kk][7]);
            qf[kk] = __builtin_bit_cast(bf16x8, w); }
    }
    if (BAND) { if (tid < 257) biasL[tid] = bias_g[tid] * 1.4426950408889634f; }
    constexpr int KCPL = G::KSTR / 16, KNP = (64 * KCPL + 63) / 64;
    constexpr int VCPL = VSTR / 16, VNP = 64 * VCPL / 64;
    constexpr int KPP = (KNP + 7) / 8, VPP = (VNP + 7) / 8;
    ATT_LAS unsigned* dmaL = (ATT_LAS unsigned*)(lds + 2 * G::KBUF + 2 * G::VBUF + 2048) + wid * 256 + lane;
#pragma unroll
    for (int pp = 0; pp < KPP; ++pp) { const int pc = wid + 8 * pp, c = pc * 64 + lane, row = (c / KCPL) & 63, ch = c % KCPL; dmaL[64 * pp] = (unsigned)(row * kpitch + (ch < G::CPR ? ch : 0) * 8) * 2u; }
#pragma unroll
    for (int pp = 0; pp < VPP; ++pp) { const int pc = wid + 8 * pp, c = pc * 64 + lane, row = (c / VCPL) & 63, ch = c % VCPL; dmaL[128 + 64 * pp] = (unsigned)(row * vpitch + (ch < 8 ? ch : 0) * 8) * 2u; }
#define ATT_DMA_K(t, b) do { const char* kt_ = (const char*)(Kb + (size_t)(t) * 64 * kpitch); _Pragma("unroll") for (int pp = 0; pp < KPP; ++pp) { if (wid + 8 * pp < KNP) \
            __builtin_amdgcn_global_load_lds((const unsigned*)(kt_ + dmaL[64 * pp]), (ATT_LAS unsigned*)(lds + (b) * G::KBUF + (wid + 8 * pp) * 1024), 16, 0, 0); } } while (0)
#define ATT_DMA_V(t, b) do { const char* vt_ = (const char*)(Vb + (size_t)(t) * 64 * vpitch); _Pragma("unroll") for (int pp = 0; pp < VPP; ++pp) { if (wid + 8 * pp < VNP) \
            __builtin_amdgcn_global_load_lds((const unsigned*)(vt_ + dmaL[128 + 64 * pp]), (ATT_LAS unsigned*)(lds + 2 * G::KBUF + (b) * G::VBUF + (wid + 8 * pp) * 1024), 16, 0, 0); } } while (0)
    f32x16 o0, o1;
#pragma unroll
    for (int i = 0; i < 16; ++i) { o0[i] = 0.f; o1[i] = 0.f; }
    float mrun = -INFINITY, lsum = 0.f;
    const int koff = r32 * G::KSTR + hi * 16;
    const int voff = ((lane >> 5) * 4 + ((lane & 15) >> 2)) * VSTR + (((lane >> 4) & 1) * 16 + (lane & 3) * 4) * 2;
    const f32x16 zero16 = {0.f, 0.f, 0.f, 0.f, 0.f, 0.f, 0.f, 0.f, 0.f, 0.f, 0.f, 0.f, 0.f, 0.f, 0.f, 0.f};
#define ATT_QK(X0, X1, t) do { const ATT_LAS unsigned char* Kt = lds + ((t) & 1) * G::KBUF + koff; \
        _Pragma("unroll") for (int kk = 0; kk < DQK / 16; ++kk) { \
            const bf16x8 a0 = *(const ATT_LAS bf16x8*)(Kt + kk * 32); const bf16x8 a1 = *(const ATT_LAS bf16x8*)(Kt + 32 * G::KSTR + kk * 32); \
            X0 = __builtin_amdgcn_mfma_f32_32x32x16_bf16(a0, qf[kk], kk ? X0 : zero16, 0, 0, 0); X1 = __builtin_amdgcn_mfma_f32_32x32x16_bf16(a1, qf[kk], kk ? X1 : zero16, 0, 0, 0); } } while (0)
#define ATT_SMPV(X0, X1, t) do { \
        float cadd = 0.f; \
        if (BAND) { const int delta = cc - (t); \
            if (delta >= 3) cadd = biasL[256]; \
            else { const ATT_LAS float* bp = biasL + (64 * delta + (32 * (wid & 1) + r32) - 4 * hi + 128 - 63); \
                if (delta < 2) { _Pragma("unroll") for (int i = 0; i < 16; ++i) { const int kj = (i & 3) + 8 * (i >> 2); X0[i] += bp[63 - kj]; X1[i] += bp[31 - kj]; } } \
                else { const int relb = 64 * delta + (32 * (wid & 1) + r32) - 4 * hi + 128; \
                    _Pragma("unroll") for (int i = 0; i < 16; ++i) { const int kj = (i & 3) + 8 * (i >> 2); int i0 = relb - kj, i1 = relb - kj - 32; i0 = i0 > 256 ? 256 : i0; i1 = i1 > 256 ? 256 : i1; \
                        X0[i] += biasL[i0]; X1[i] += biasL[i1]; } } } } \
        const float mt = rowmax32(X0, X1) + cadd; \
        const float mnew = max2f(mrun, mt); \
        const float alpha = __builtin_amdgcn_exp2f(mrun - mnew); \
        const float msub = mnew - cadd; \
        mrun = mnew; \
        float ps = 0.f; \
        _Pragma("unroll") for (int i = 0; i < 16; ++i) { X0[i] = __builtin_amdgcn_exp2f(X0[i] - msub); X1[i] = __builtin_amdgcn_exp2f(X1[i] - msub); ps += X0[i] + X1[i]; } \
        lsum = lsum * alpha + ps; \
        _Pragma("unroll") for (int i = 0; i < 16; ++i) { o0[i] *= alpha; o1[i] *= alpha; } \
        bf16x8 pf[2][2]; \
        _Pragma("unroll") for (int s = 0; s < 2; ++s) { u32x4 w0, w1; \
            w0.x = cvtpk(X0[8 * s + 0], X0[8 * s + 1]); w0.y = cvtpk(X0[8 * s + 2], X0[8 * s + 3]); w0.z = cvtpk(X0[8 * s + 4], X0[8 * s + 5]); w0.w = cvtpk(X0[8 * s + 6], X0[8 * s + 7]); \
            w1.x = cvtpk(X1[8 * s + 0], X1[8 * s + 1]); w1.y = cvtpk(X1[8 * s + 2], X1[8 * s + 3]); w1.z = cvtpk(X1[8 * s + 4], X1[8 * s + 5]); w1.w = cvtpk(X1[8 * s + 6], X1[8 * s + 7]); \
            pf[0][s] = __builtin_bit_cast(bf16x8, w0); pf[1][s] = __builtin_bit_cast(bf16x8, w1); } \
        const ATT_LAS unsigned char* Vt = lds + 2 * G::KBUF + ((t) & 1) * G::VBUF + voff; \
        _Pragma("unroll") for (int kb = 0; kb < 2; ++kb) _Pragma("unroll") for (int s = 0; s < 2; ++s) { \
            const ATT_LAS unsigned char* vp = Vt + (32 * kb + 16 * s) * VSTR; \
            const s16x4 l0 = vtr(vp), h0 = vtr(vp + 8 * VSTR), l1 = vtr(vp + 64), h1 = vtr(vp + 8 * VSTR + 64); \
            const bf16x8 a0 = (bf16x8){l0[0], l0[1], l0[2], l0[3], h0[0], h0[1], h0[2], h0[3]}; \
            const bf16x8 a1 = (bf16x8){l1[0], l1[1], l1[2], l1[3], h1[0], h1[1], h1[2], h1[3]}; \
            o0 = __builtin_amdgcn_mfma_f32_32x32x16_bf16(a0, pf[kb][s], o0, 0, 0, 0); o1 = __builtin_amdgcn_mfma_f32_32x32x16_bf16(a1, pf[kb][s], o1, 0, 0, 0); } } while (0)
#define ATT_FUSED(C0, C1, N0, N1, t, tn) do { \
        bf16x8 kfa[DQK / 16], kfb[DQK / 16]; \
        { const ATT_LAS unsigned char* Kt = lds + ((tn) & 1) * G::KBUF + koff; \
          _Pragma("unroll") for (int kk = 0; kk < DQK / 16; ++kk) { kfa[kk] = *(const ATT_LAS bf16x8*)(Kt + kk * 32); kfb[kk] = *(const ATT_LAS bf16x8*)(Kt + 32 * G::KSTR + kk * 32); } } \
        __builtin_amdgcn_sched_barrier(0); \
        float cadd = 0.f; \
        if (BAND) { const int delta = cc - (t); \
            if (delta >= 3) cadd = biasL[256]; \
            else { const ATT_LAS float* bp = biasL + (64 * delta + (32 * (wid & 1) + r32) - 4 * hi + 128 - 63); \
                if (delta < 2) { _Pragma("unroll") for (int i = 0; i < 16; ++i) { const int kj = (i & 3) + 8 * (i >> 2); C0[i] += bp[63 - kj]; C1[i] += bp[31 - kj]; } } \
                else { const int relb = 64 * delta + (32 * (wid & 1) + r32) - 4 * hi + 128; \
                    _Pragma("unroll") for (int i = 0; i < 16; ++i) { const int kj = (i & 3) + 8 * (i >> 2); int i0 = relb - kj, i1 = relb - kj - 32; i0 = i0 > 256 ? 256 : i0; i1 = i1 > 256 ? 256 : i1; \
                        C0[i] += biasL[i0]; C1[i] += biasL[i1]; } } } } \
        const float mt = rowmax32(C0, C1) + cadd; \
        const float mnew = max2f(mrun, mt); \
        const float alpha = __builtin_amdgcn_exp2f(mrun - mnew); \
        const float msub = mnew - cadd; \
        if (__builtin_amdgcn_ballot_w64(mnew > mrun)) { _Pragma("unroll") for (int i = 0; i < 16; ++i) { o0[i] *= alpha; o1[i] *= alpha; } } \
        mrun = mnew; \
        __builtin_amdgcn_sched_barrier(0); \
        _Pragma("unroll") for (int kk = 0; kk < DQK / 16; ++kk) { \
            N0 = __builtin_amdgcn_mfma_f32_32x32x16_bf16(kfa[kk], qf[kk], kk ? N0 : zero16, 0, 0, 0); N1 = __builtin_amdgcn_mfma_f32_32x32x16_bf16(kfb[kk], qf[kk], kk ? N1 : zero16, 0, 0, 0); } \
        s16x4 vl0[4], vh0[4], vl1[4], vh1[4]; \
        { const ATT_LAS unsigned char* Vt = lds + 2 * G::KBUF + ((t) & 1) * G::VBUF + voff; \
          _Pragma("unroll") for (int ks = 0; ks < 4; ++ks) { const ATT_LAS unsigned char* vp = Vt + 16 * ks * VSTR; vl0[ks] = vtr(vp); vh0[ks] = vtr(vp + 8 * VSTR); vl1[ks] = vtr(vp + 64); vh1[ks] = vtr(vp + 8 * VSTR + 64); } } \
        float ps = 0.f; \
        _Pragma("unroll") for (int i = 0; i < 16; ++i) { C0[i] = __builtin_amdgcn_exp2f(C0[i] - msub); C1[i] = __builtin_amdgcn_exp2f(C1[i] - msub); ps += C0[i] + C1[i]; } \
        lsum = lsum * alpha + ps; \
        bf16x8 pf[4]; \
        _Pragma("unroll") for (int s = 0; s < 2; ++s) { u32x4 w0, w1; \
            w0.x = cvtpk(C0[8 * s + 0], C0[8 * s + 1]); w0.y = cvtpk(C0[8 * s + 2], C0[8 * s + 3]); w0.z = cvtpk(C0[8 * s + 4], C0[8 * s + 5]); w0.w = cvtpk(C0[8 * s + 6], C0[8 * s + 7]); \
            w1.x = cvtpk(C1[8 * s + 0], C1[8 * s + 1]); w1.y = cvtpk(C1[8 * s + 2], C1[8 * s + 3]); w1.z = cvtpk(C1[8 * s + 4], C1[8 * s + 5]); w1.w = cvtpk(C1[8 * s + 6], C1[8 * s + 7]); \
            pf[s] = __builtin_bit_cast(bf16x8, w0); pf[2 + s] = __builtin_bit_cast(bf16x8, w1); } \
        __builtin_amdgcn_sched_barrier(0); \
        _Pragma("unroll") for (int ks = 0; ks < 4; ++ks) { \
            const bf16x8 a0 = (bf16x8){vl0[ks][0], vl0[ks][1], vl0[ks][2], vl0[ks][3], vh0[ks][0], vh0[ks][1], vh0[ks][2], vh0[ks][3]}; \
            const bf16x8 a1 = (bf16x8){vl1[ks][0], vl1[ks][1], vl1[ks][2], vl1[ks][3], vh1[ks][0], vh1[ks][1], vh1[ks][2], vh1[ks][3]}; \
            o0 = __builtin_amdgcn_mfma_f32_32x32x16_bf16(a0, pf[ks], o0, 0, 0, 0); o1 = __builtin_amdgcn_mfma_f32_32x32x16_bf16(a1, pf[ks], o1, 0, 0, 0); } } while (0)
#define ATT_STAGE(t) do { if ((t) + 2 <= t_hi) ATT_DMA_K((t) + 2, (t) & 1); if ((t) + 1 <= t_hi) ATT_DMA_V((t) + 1, ((t) + 1) & 1); } while (0)
    f32x16 sa0, sa1, sb0, sb1;
    ATT_DMA_K(t_lo, t_lo & 1);
    __syncthreads();
    if (t_lo + 1 <= t_hi) ATT_DMA_K(t_lo + 1, (t_lo + 1) & 1);
    ATT_DMA_V(t_lo, t_lo & 1);
    if (my_lo == t_lo) ATT_QK(sa0, sa1, t_lo);
    __syncthreads();
    {
        int t = t_lo;
        for (; t < my_lo - 1; ++t) { ATT_STAGE(t); __syncthreads(); }
        if (my_lo > t_lo) { ATT_STAGE(t); ATT_QK(sa0, sa1, t + 1); __syncthreads(); ++t; }
        int nf = my_hi - my_lo;
        for (; nf >= 2; nf -= 2, t += 2) {
            ATT_STAGE(t); ATT_FUSED(sa0, sa1, sb0, sb1, t, t + 1); __syncthreads();
            ATT_STAGE(t + 1); ATT_FUSED(sb0, sb1, sa0, sa1, t + 1, t + 2); __syncthreads();
        }
        if (nf == 1) {
            ATT_STAGE(t); ATT_FUSED(sa0, sa1, sb0, sb1, t, t + 1); __syncthreads(); ++t;
            ATT_STAGE(t); ATT_SMPV(sb0, sb1, t); __syncthreads(); ++t;
        } else {
            ATT_STAGE(t); ATT_SMPV(sa0, sa1, t); __syncthreads(); ++t;
        }
        for (; t <= t_hi; ++t) { ATT_STAGE(t); __syncthreads(); }
    }
    const float ltot = xhalf_sum(lsum);
    const float inv = 1.f / ltot;
    bf16* op = Ob + (size_t)(q0 + wid * 32 + r32) * opitch + 4 * hi;
#pragma unroll
    for (int g4 = 0; g4 < 4; ++g4) {
        u32x2 w0, w1;
        w0.x = cvtpk(o0[4 * g4 + 0] * inv, o0[4 * g4 + 1] * inv); w0.y = cvtpk(o0[4 * g4 + 2] * inv, o0[4 * g4 + 3] * inv);
        w1.x = cvtpk(o1[4 * g4 + 0] * inv, o1[4 * g4 + 1] * inv); w1.y = cvtpk(o1[4 * g4 + 2] * inv, o1[4 * g4 + 3] * inv);
        *(u32x2*)(op + 8 * g4) = w0; *(u32x2*)(op + 32 + 8 * g4) = w1;
    }
#undef ATT_DMA_K
#undef ATT_DMA_V
#undef ATT_QK
#undef ATT_SMPV
#undef ATT_STAGE
#undef ATT_FUSED
}
}
constexpr int NWAVES = 8;
constexpr int D = 1024, BATCH = 32, SEQ = 2048, M = BATCH * SEQ;
constexpr int NH = 16, QLORA = 384, KVLORA = 256, ROPE_D = 32, NOPE = 64, QKD = 96;
constexpr int NA = 768;
constexpr int FF = 2816, EFF = 3584, NE = 8;
constexpr float EPS = 1e-6f, LOG2E = 1.4426950408889634f;
constexpr int MAXP_HALF = 264, MAXP = 528;
constexpr size_t MiB = 1u << 20;
constexpr size_t WS_CTL = 0, CTL_ZERO_BYTES = 1 * MiB;
constexpr size_t WS_ROPE = 1 * MiB;
constexpr size_t WS_CNT = WS_ROPE + 256 * 1024;
constexpr size_t WS_PANELE = WS_CNT + 16 * 1024;
constexpr size_t WS_META = WS_PANELE + 4096;
constexpr size_t WS_TOKE = 2 * MiB;
constexpr size_t WS_TOKG = WS_TOKE + (size_t)M * 4;
constexpr size_t WS_SLOTTOK = WS_TOKG + (size_t)M * 8;
constexpr size_t WS_SLOTGATE = WS_SLOTTOK + (size_t)MAXP * 256 * 4;
constexpr size_t WS_PARTQA = 976 * MiB, WS_PART1 = 980 * MiB, WS_PART2 = 984 * MiB;
constexpr size_t WS_TOKRSTD = 4 * MiB;
constexpr size_t WS_SLOTRSTD = WS_TOKRSTD + (size_t)M * 4;
static_assert(WS_SLOTGATE + (size_t)MAXP * 256 * 4 <= WS_TOKRSTD && WS_SLOTRSTD + (size_t)MAXP * 256 * 4 <= 8 * MiB, "small arrays");
constexpr size_t WS_W = 8 * MiB;
constexpr size_t WS_WA = WS_W, WS_WUQ = WS_WA + (size_t)NA * D * 2, WS_WUKV = WS_WUQ + (size_t)1536 * QLORA * 2, WS_WO = WS_WUKV + (size_t)2048 * KVLORA * 2;
constexpr size_t WS_WF1 = WS_WO + (size_t)D * D * 2, WS_WF2 = WS_WF1 + (size_t)2 * FF * D * 2, WS_WKVQ = WS_WF2 + (size_t)D * FF * 2, WS_WBO = WS_WKVQ + (size_t)3 * D * D * 2;
constexpr size_t WS_WM1 = WS_WBO + (size_t)D * D * 2, WS_WM2 = WS_WM1 + (size_t)NE * 2 * EFF * D * 2, WS_WEND = WS_WM2 + (size_t)NE * D * EFF * 2;
constexpr size_t ARENA = 208 * MiB;
static_assert(WS_WEND <= ARENA, "weights fit under the arena");
constexpr size_t WS_XN = ARENA;
constexpr size_t WS_QA = ARENA + 128 * MiB;
constexpr size_t WS_Q = ARENA + 224 * MiB;
constexpr size_t WS_K = ARENA + 416 * MiB;
constexpr size_t WS_V = ARENA + 608 * MiB;
constexpr size_t WS_O = ARENA;
static_assert(WS_V + (size_t)M * D * 2 <= 1024 * MiB, "MLA arena");
constexpr size_t WS_XR1 = ARENA + 128 * MiB;
constexpr size_t WS_H = ARENA + 256 * MiB;
constexpr size_t WS_XR2 = ARENA;
constexpr size_t WS_KVQ2 = ARENA + 128 * MiB;
constexpr size_t WS_O2 = ARENA + 512 * MiB;
constexpr size_t WS_XR3 = ARENA + 640 * MiB;
constexpr size_t WS_XG = ARENA;
constexpr size_t WS_HM = ARENA + 264 * MiB;
constexpr size_t WS_END = WS_HM + (size_t)MAXP_HALF * 256 * EFF * 2;
static_assert(WS_XG + (size_t)MAXP * 256 * D * 2 <= WS_HM && WS_END <= 1024 * MiB && WS_XR3 + (size_t)M * D * 2 <= 1024 * MiB && WS_H + (size_t)M * FF * 2 <= 1024 * MiB, "arena");
constexpr int CW_BAR = 4096;
constexpr int RING_OFF = 0, RING_BYTES = 131072;
constexpr int P0_SCR = 128 * 33 * 4;
constexpr int LDSCTL_OFF = 8 * P0_SCR, MISC_OFF = LDSCTL_OFF + 320;
static_assert(LDSCTL_OFF >= RING_BYTES, "control words above every phase's scratch");
constexpr int LDS_BYTES = 147456;
static_assert(MISC_OFF + 128 <= LDS_BYTES, "LDS map");
static_assert(att::lds_bytes<96>() <= RING_BYTES, "attention scratch fits the ring region");

#define GAS __attribute__((address_space(1)))
#define LAS __attribute__((address_space(3)))
typedef unsigned short bf16;
typedef unsigned v4u __attribute__((ext_vector_type(4)));
typedef unsigned v2u __attribute__((ext_vector_type(2)));
typedef float f32x4 __attribute__((ext_vector_type(4)));
typedef GAS unsigned gu32;
#define RLX_AGENT __ATOMIC_RELAXED, __HIP_MEMORY_SCOPE_AGENT
#define LDS_WAIT() asm volatile("s_waitcnt lgkmcnt(0)" ::: "memory")
__device__ __forceinline__ unsigned f2bf(float f) { unsigned u = __builtin_bit_cast(unsigned, f); return (u + 0x7fffu + ((u >> 16) & 1u)) >> 16; }
__device__ __forceinline__ unsigned pk2(float lo, float hi) { return f2bf(lo) | (f2bf(hi) << 16); }
__device__ __forceinline__ float bflo(unsigned u) { return __builtin_bit_cast(float, u << 16); }
__device__ __forceinline__ float bfhi(unsigned u) { return __builtin_bit_cast(float, u & 0xffff0000u); }
__device__ __forceinline__ float wave_sum(float v) {
    v += swz_xor<1>(v); v += swz_xor<2>(v); v += swz_xor<4>(v); v += swz_xor<8>(v); v += swz_xor<16>(v);
    return xor32_sum(v);
}

#define XB_TMO      128
#define XB_XCNT(j)  (256  + 64 * (j))
#define XB_XSUB(j)  (1280 + 64 * (j))
#define XB_XGEN(j)  (2304 + 64 * (j))
#define XB_TOP      3328
#define XB_TOPGEN   3392
#define XCD_BAR_WORDS 3456
#define XB_SPIN_CAP (1u << 18)

__device__ __forceinline__ unsigned xb_ld(unsigned* p)              { return __hip_atomic_load(p, __ATOMIC_RELAXED, __HIP_MEMORY_SCOPE_AGENT); }
__device__ __forceinline__ unsigned xb_add(unsigned* p, unsigned v) { return __hip_atomic_fetch_add(p, v, __ATOMIC_RELAXED, __HIP_MEMORY_SCOPE_AGENT); }
__device__ __forceinline__ unsigned xb_xcc_id() { return (unsigned)__builtin_amdgcn_s_getreg((3 << 11) | 20) & 0xFu; }
#define XB_SPIN(cond, bar) do { unsigned _sp = 0; while (cond) { __builtin_amdgcn_s_sleep(1); \
    if ((++_sp & 255u) == 0u) { if (xb_ld(&(bar)[XB_TMO])) break; if (_sp > XB_SPIN_CAP) { atomicAdd(&(bar)[XB_TMO], 1u); break; } } } } while (0)

struct XcdBarrier {
    int t0;
    unsigned* bar; unsigned x;
    volatile LAS unsigned* st;
};

__device__ __forceinline__ XcdBarrier xcd_barrier_post(unsigned* bar, volatile LAS unsigned* st, int t0) {
    XcdBarrier b; b.t0 = t0; b.bar = bar; b.x = xb_xcc_id(); b.st = st;
    if (b.t0) (void)xb_add(&bar[XB_XCNT(b.x)], 1u);
    return b;
}
__device__ __forceinline__ void xcd_barrier_complete(unsigned* bar, unsigned x, unsigned& nloc, unsigned& nx) {
    const unsigned G = gridDim.x * gridDim.y * gridDim.z;
    unsigned sum, cnt, mine, sp = 0u;
    for (;;) {
        sum = 0u; cnt = 0u; mine = 0u;
#pragma unroll
        for (unsigned j = 0; j < 16; ++j) { const unsigned c = xb_ld(&bar[XB_XCNT(j)]); sum += c; cnt += (c > 0u) ? 1u : 0u; mine = (j == x) ? c : mine; }
        if (sum == G) break;
        __builtin_amdgcn_s_sleep(1);
        if ((++sp & 255u) == 0u) { if (xb_ld(&bar[XB_TMO])) break; if (sp > XB_SPIN_CAP) { atomicAdd(&bar[XB_TMO], 1u); break; } }
    }
    nloc = mine > 0u ? mine : 1u; nx = cnt > 0u ? cnt : 1u;
}

__device__ __forceinline__ void xcd_barrier(const XcdBarrier& b) {
    asm volatile("s_waitcnt vmcnt(0)" ::: "memory");
    __syncthreads();
    if (b.t0) {
        unsigned* bar = b.bar;
        __builtin_amdgcn_s_waitcnt(0);
        unsigned nloc = b.st[0], nx = b.st[1];
        if (nloc == 0u) { xcd_barrier_complete(bar, b.x, nloc, nx); b.st[0] = nloc; b.st[1] = nx; }
        const unsigned old = xb_add(&bar[XB_XSUB(b.x)], 1u);
        const unsigned gen = old / nloc;
        if (old + 1u == (gen + 1u) * nloc) {
            __builtin_amdgcn_fence(__ATOMIC_RELEASE, "agent");
            asm volatile("s_waitcnt vmcnt(0)" ::: "memory");
            const unsigned og = xb_add(&bar[XB_TOP], 1u);
            const unsigned tg = og / nx;
            if (og + 1u == (tg + 1u) * nx) xb_add(&bar[XB_TOPGEN], 1u);
            else XB_SPIN(xb_ld(&bar[XB_TOPGEN]) == tg, bar);
            __builtin_amdgcn_fence(__ATOMIC_ACQUIRE, "agent");
            xb_add(&bar[XB_XGEN(b.x)], 1u);
            asm volatile("s_waitcnt vmcnt(0)" ::: "memory");
        } else {
            XB_SPIN(xb_ld(&bar[XB_XGEN(b.x)]) == gen, bar);
            __builtin_amdgcn_fence(__ATOMIC_ACQUIRE, "agent");
            asm volatile("s_waitcnt vmcnt(0)" ::: "memory");
        }
    }
    __syncthreads();
}

struct Args { const float* in[27]; float* out; unsigned char* ws; };
enum { I_X = 0, I_ATTN_NORM, I_FFN_NORM, I_A_WDQ, I_A_GCQ, I_A_WUQ, I_A_WDKV, I_A_GCKV, I_A_WUKV, I_A_GQN, I_A_GKN, I_A_WO, I_KV_NORM, I_KV_WK, I_KV_WV, I_KV_GKN,
       I_B_WQ, I_B_GQN, I_B_RELB, I_B_WO, I_FFN_W1, I_FFN_W3, I_FFN_W2, I_MOE_ROUTER, I_MOE_W1, I_MOE_W3, I_MOE_W2 };

struct Frame {
    LAS unsigned char* lds;
    int wave, vcu, G;
};
typedef const __attribute__((address_space(4))) Args* KArgs;
__device__ __forceinline__ KArgs kargs() { KArgs p = (KArgs)__builtin_amdgcn_kernarg_segment_ptr(); asm volatile("" : "+s"(p)); return p; }
#define INP(i) (kargs()->in[i])
#define OUTP (kargs()->out)
#define WSP (kargs()->ws)
__device__ __forceinline__ int fresh(int v) { asm volatile("" : "+v"(v)); return v; }

__device__ __forceinline__ void tr_item(const float* W, int ldw, int K, int k0, int nsrc0, const float* gain, bf16* WT, int drow0, LAS float* scr, int lane) {
    const int c4 = lane & 7, r = lane >> 3;
    const GAS float* src = (const GAS float*)W + (size_t)(k0 + r) * ldw + nsrc0 + 4 * c4;
    f32x4 v[16];
#pragma unroll
    for (int i = 0; i < 16; ++i) v[i] = *(const GAS f32x4*)(src + (size_t)(8 * i) * ldw);
    if (gain) {
#pragma unroll
        for (int i = 0; i < 16; ++i) v[i] = v[i] * gain[k0 + 8 * i + r];
    }
#pragma unroll
    for (int i = 0; i < 16; ++i) { LAS float* d = scr + (8 * i + r) * 33 + 4 * c4; d[0] = v[i].x; d[1] = v[i].y; d[2] = v[i].z; d[3] = v[i].w; }
    LDS_WAIT(); asm volatile("" ::: "memory");
    const int c16 = lane >> 2;
#pragma unroll
    for (int j = 0; j < 8; ++j) { const int n = (lane & 3) + 4 * j; const LAS float* sp = scr + (8 * c16) * 33 + n;
        v4u o; o.x = pk2(sp[0 * 33], sp[1 * 33]); o.y = pk2(sp[2 * 33], sp[3 * 33]); o.z = pk2(sp[4 * 33], sp[5 * 33]); o.w = pk2(sp[6 * 33], sp[7 * 33]);
        *(GAS v4u*)(WT + (size_t)(drow0 + n) * K + k0 + 8 * c16) = o; }
    LDS_WAIT(); asm volatile("" ::: "memory");
}
__device__ __forceinline__ void tr_plain(const float* W, int K, int N, const float* gain, bf16* WT, int drow_off, LAS float* scr, int item, int lane) {
    const int nblk = N / 32, kb = item / nblk, nb = item % nblk;
    tr_item(W, N, K, 128 * kb, 32 * nb, gain, WT, drow_off + 32 * nb, scr, lane);
}
__device__ __forceinline__ void tr_gated(const float* W, int K, int N, const float* gain, bf16* WT, int half, LAS float* scr, int item, int lane) {
    const int nblk = N / 32, kb = item / nblk, nb = item % nblk, n0 = 32 * nb;
    tr_item(W, N, K, 128 * kb, n0, gain, WT, (n0 >> 7) * 256 + half * 128 + (n0 & 127), scr, lane);
}
__device__ __forceinline__ unsigned pk_fp8x4(float a, float b, float c, float d) { int w = 0; w = __builtin_amdgcn_cvt_pk_fp8_f32(a, b, w, false); w = __builtin_amdgcn_cvt_pk_fp8_f32(c, d, w, true); return (unsigned)w; }
__device__ __forceinline__ void tr_item_f8(const float* W, int ldw, int K, int k0, int nsrc0, const float* gain, unsigned char* WT, int drow0, LAS float* scr, int lane) {
    const int c4 = lane & 7, r = lane >> 3;
    const GAS float* src = (const GAS float*)W + (size_t)(k0 + r) * ldw + nsrc0 + 4 * c4;
    f32x4 v[16];
#pragma unroll
    for (int i = 0; i < 16; ++i) v[i] = *(const GAS f32x4*)(src + (size_t)(8 * i) * ldw);
#pragma unroll
    for (int i = 0; i < 16; ++i) v[i] = v[i] * (gain ? gain[k0 + 8 * i + r] * 64.f : 64.f);
#pragma unroll
    for (int i = 0; i < 16; ++i) { LAS float* d = scr + (8 * i + r) * 33 + 4 * c4; d[0] = v[i].x; d[1] = v[i].y; d[2] = v[i].z; d[3] = v[i].w; }
    LDS_WAIT(); asm volatile("" ::: "memory");
    const int c8 = lane >> 3;
#pragma unroll
    for (int j = 0; j < 4; ++j) { const int n = (lane & 7) + 8 * j; const LAS float* sp = scr + (16 * c8) * 33 + n;
        v4u o; o.x = pk_fp8x4(sp[0 * 33], sp[1 * 33], sp[2 * 33], sp[3 * 33]); o.y = pk_fp8x4(sp[4 * 33], sp[5 * 33], sp[6 * 33], sp[7 * 33]);
        o.z = pk_fp8x4(sp[8 * 33], sp[9 * 33], sp[10 * 33], sp[11 * 33]); o.w = pk_fp8x4(sp[12 * 33], sp[13 * 33], sp[14 * 33], sp[15 * 33]);
        *(GAS v4u*)(WT + (size_t)(drow0 + n) * K + k0 + 16 * c8) = o; }
    LDS_WAIT(); asm volatile("" ::: "memory");
}
__device__ __forceinline__ float rms_row_to_bf16(const float* xrow, bf16* orow, int lane, f32x4 (&v)[4]) {
    const GAS f32x4* xr = (const GAS f32x4*)xrow + lane;
    float s = 0.f;
#pragma unroll
    for (int j = 0; j < 4; ++j) { v[j] = xr[64 * j]; s += (v[j].x * v[j].x + v[j].y * v[j].y) + (v[j].z * v[j].z + v[j].w * v[j].w); }
    const float rstd = 1.f / sqrtf(wave_sum(s) * (1.f / D) + EPS);
    GAS unsigned long long* o8 = (GAS unsigned long long*)orow + lane;
#pragma unroll
    for (int j = 0; j < 4; ++j) o8[64 * j] = (unsigned long long)pk2(v[j].x * rstd, v[j].y * rstd) | ((unsigned long long)pk2(v[j].z * rstd, v[j].w * rstd) << 32);
    return rstd;
}
__device__ __forceinline__ void norm_phase(const Frame& F, const float* x, bf16* xn) {
    const int tid = fresh(F.wave * 64 + lane_id_()), lane = tid & 63; (void)lane;
    const int gw = F.vcu * NWAVES + F.wave, NGW = F.G * NWAVES;
    for (int m = 2 * gw; m < M; m += 2 * NGW) {
        const GAS f32x4* xr = (const GAS f32x4*)(x + (size_t)m * D) + lane;
        f32x4 v[8]; float s0 = 0.f, s1 = 0.f;
#pragma unroll
        for (int j = 0; j < 8; ++j) v[j] = xr[64 * j];
#pragma unroll
        for (int j = 0; j < 4; ++j) { s0 += (v[j].x * v[j].x + v[j].y * v[j].y) + (v[j].z * v[j].z + v[j].w * v[j].w); s1 += (v[4 + j].x * v[4 + j].x + v[4 + j].y * v[4 + j].y) + (v[4 + j].z * v[4 + j].z + v[4 + j].w * v[4 + j].w); }
        const float r0 = 1.f / sqrtf(wave_sum(s0) * (1.f / D) + EPS), r1 = 1.f / sqrtf(wave_sum(s1) * (1.f / D) + EPS);
        GAS unsigned* o4 = (GAS unsigned*)((GAS unsigned char*)xn + (size_t)m * D) + lane;
#pragma unroll
        for (int j = 0; j < 8; ++j) { const float rr = j < 4 ? r0 : r1; o4[64 * j] = pk_fp8x4(v[j].x * rr, v[j].y * rr, v[j].z * rr, v[j].w * rr); }
    }
}

__device__ __forceinline__ void p0_prologue(const Frame& F) {
    const int tid = fresh(F.wave * 64 + lane_id_()), lane = tid & 63; (void)lane;
    LAS float* scr = (LAS float*)(F.lds + RING_OFF + F.wave * P0_SCR);
    unsigned char* ws = WSP;
    const int gw = F.vcu * NWAVES + F.wave, NGW = F.G * NWAVES;
    constexpr int I_DQ = 8 * 12, I_DKV = 8 * 9, I_UQ = 3 * 48, I_UKV = 2 * 64, I_SQ = 8 * 32, I_F13 = 8 * 88, I_F2 = 22 * 32, I_M13 = 8 * 112, I_M2 = 28 * 32;
    constexpr int NSMALL = I_DQ + I_DKV + I_UQ + I_UKV + I_SQ + 2 * I_F13 + I_F2 + 4 * I_SQ;
    constexpr int NITEMS = NSMALL + NE * (2 * I_M13 + I_M2);
    for (int it = gw; it < NITEMS; it += NGW) {
        int r = it;
        if (r < I_DQ)  { const int kb = r / 12, n0 = 32 * (r % 12); tr_item_f8(INP(I_A_WDQ), QLORA, D, 128 * kb, n0, INP(I_ATTN_NORM), ws + WS_WA, n0, scr, lane); continue; } r -= I_DQ;
        if (r < I_DKV) { const int kb = r / 9, n0 = 32 * (r % 9); tr_item_f8(INP(I_A_WDKV), KVLORA + ROPE_D, D, 128 * kb, n0, INP(I_ATTN_NORM), ws + WS_WA, QLORA + n0, scr, lane); continue; } r -= I_DKV;
        if (r < I_UQ)  { tr_plain(INP(I_A_WUQ), QLORA, NH * QKD, INP(I_A_GCQ), (bf16*)(ws + WS_WUQ), 0, scr, r, lane); continue; } r -= I_UQ;
        if (r < I_UKV) { const int kb = r / 64, n0 = 32 * (r % 64), head = n0 >> 7, within = n0 & 127;
            const int drow = within < 64 ? 256 * (head >> 2) + 128 * (within >> 5) + 32 * (head & 3) : 1024 + head * 64 + (within - 64);
            tr_item(INP(I_A_WUKV), NH * 128, KVLORA, 128 * kb, n0, INP(I_A_GCKV), (bf16*)(ws + WS_WUKV), drow, scr, lane); continue; } r -= I_UKV;
        if (r < I_SQ)  { tr_plain(INP(I_A_WO), D, D, nullptr, (bf16*)(ws + WS_WO), 0, scr, r, lane); continue; } r -= I_SQ;
        if (r < I_F13) { tr_gated(INP(I_FFN_W1), D, FF, INP(I_FFN_NORM), (bf16*)(ws + WS_WF1), 0, scr, r, lane); continue; } r -= I_F13;
        if (r < I_F13) { tr_gated(INP(I_FFN_W3), D, FF, INP(I_FFN_NORM), (bf16*)(ws + WS_WF1), 1, scr, r, lane); continue; } r -= I_F13;
        if (r < I_F2)  { tr_plain(INP(I_FFN_W2), FF, D, nullptr, (bf16*)(ws + WS_WF2), 0, scr, r, lane); continue; } r -= I_F2;
        if (r < I_SQ)  { const int kb = r / 32, n0 = 32 * (r % 32), head = n0 >> 6;
            tr_item_f8(INP(I_KV_WK), D, D, 128 * kb, n0, INP(I_KV_NORM), ws + WS_WKVQ, 256 * (head >> 2) + 128 * ((n0 >> 5) & 1) + 32 * (head & 3), scr, lane); continue; } r -= I_SQ;
        if (r < I_SQ)  { const int kb = r / 32, n0 = 32 * (r % 32); tr_item_f8(INP(I_KV_WV), D, D, 128 * kb, n0, INP(I_KV_NORM), ws + WS_WKVQ, 2 * D + n0, scr, lane); continue; } r -= I_SQ;
        if (r < I_SQ)  { const int kb = r / 32, n0 = 32 * (r % 32), head = n0 >> 6;
            tr_item_f8(INP(I_B_WQ), D, D, 128 * kb, n0, INP(I_ATTN_NORM) + D, ws + WS_WKVQ, D + 256 * (head >> 2) + 128 * ((n0 >> 5) & 1) + 32 * (head & 3), scr, lane); continue; } r -= I_SQ;
        if (r < I_SQ)  { tr_plain(INP(I_B_WO), D, D, nullptr, (bf16*)(ws + WS_WBO), 0, scr, r, lane); continue; } r -= I_SQ;
        const int e = r / (2 * I_M13 + I_M2); r -= e * (2 * I_M13 + I_M2);
        if (r < I_M13) { const int kb = r / 112, n0 = 32 * (r % 112);
            tr_item_f8(INP(I_MOE_W1) + (size_t)e * D * EFF, EFF, D, 128 * kb, n0, INP(I_FFN_NORM) + D, ws + WS_WM1 + (size_t)e * 2 * EFF * D, (n0 >> 7) * 256 + (n0 & 127), scr, lane); continue; } r -= I_M13;
        if (r < I_M13) { const int kb = r / 112, n0 = 32 * (r % 112);
            tr_item_f8(INP(I_MOE_W3) + (size_t)e * D * EFF, EFF, D, 128 * kb, n0, INP(I_FFN_NORM) + D, ws + WS_WM1 + (size_t)e * 2 * EFF * D, (n0 >> 7) * 256 + 128 + (n0 & 127), scr, lane); continue; } r -= I_M13;
        { const int kb = r / 32, n0 = 32 * (r % 32); tr_item_f8(INP(I_MOE_W2) + (size_t)e * EFF * D, D, EFF, 128 * kb, n0, nullptr, ws + WS_WM2 + (size_t)e * D * EFF, n0, scr, lane); }
    }
    const int gt = F.vcu * (NWAVES * 64) + tid, NGT = F.G * NWAVES * 64;
    for (int c = gt; c < 96 * D / 16; c += NGT) *((GAS v4u*)(ws + WS_WA + (size_t)(QLORA + KVLORA + ROPE_D) * D) + c) = (v4u){0u, 0u, 0u, 0u};
    for (int c = gt; c < SEQ * 16; c += NGT) { const int pos = c >> 4, i = c & 15;
        const float inv = __builtin_amdgcn_exp2f(-(float)i * (13.287712379549449f / 16.f));
        const float rev = (float)pos * inv * 0.15915494309189535f; const float fr = rev - floorf(rev);
        ((GAS float*)(ws + WS_ROPE))[2 * c] = __builtin_amdgcn_cosf(fr); ((GAS float*)(ws + WS_ROPE))[2 * c + 1] = __builtin_amdgcn_sinf(fr); }
    norm_phase(F, INP(I_X), (bf16*)(ws + WS_XN));
}

__device__ __forceinline__ void route_phase(const Frame& F) {
    const int tid = fresh(F.wave * 64 + lane_id_()), lane = tid & 63;
    unsigned char* ws = WSP;
    LAS float* wrg = (LAS float*)(F.lds + RING_OFF);
    LAS int* cnt = (LAS int*)(F.lds + RING_OFF + 32768);
    const float* wr = INP(I_MOE_ROUTER); const float* g = INP(I_FFN_NORM) + D;
    for (int idx = tid; idx < D * NE; idx += NWAVES * 64) { const int k = idx >> 3, e = idx & 7, j = k >> 8, l = (k & 255) >> 2, q = k & 3;
        wrg[((j * 4 + q) * 2 + (e >> 2)) * 256 + 4 * l + (e & 3)] = wr[idx] * g[k]; }
    __syncthreads();
    const int b5 = (lane >> 5) & 1, b4 = (lane >> 4) & 1, b3 = (lane >> 3) & 1;
    for (int c = F.vcu; c < M / 256; c += F.G) {
        if (tid < 16) cnt[tid] = 0;
        __syncthreads();
        for (int i = 0; i < 32; ++i) {
            const int m = c * 256 + F.wave * 32 + i;
            f32x4 v[4]; float ssx = 0.f;
            { const GAS f32x4* xr = (const GAS f32x4*)(OUTP + (size_t)m * D) + lane;
#pragma unroll
              for (int j = 0; j < 4; ++j) v[j] = xr[64 * j];
#pragma unroll
              for (int j = 0; j < 4; ++j) ssx += (v[j].x * v[j].x + v[j].y * v[j].y) + (v[j].z * v[j].z + v[j].w * v[j].w); }
            float lg[8];
#pragma unroll
            for (int e = 0; e < 8; ++e) lg[e] = 0.f;
#pragma unroll
            for (int j = 0; j < 4; ++j)
#pragma unroll
                for (int q = 0; q < 4; ++q) { const float xv = v[j][q];
                    const f32x4 w0 = *(const LAS f32x4*)(wrg + ((j * 4 + q) * 2) * 256 + 4 * lane), w1 = *(const LAS f32x4*)(wrg + ((j * 4 + q) * 2 + 1) * 256 + 4 * lane);
                    lg[0] += xv * w0.x; lg[1] += xv * w0.y; lg[2] += xv * w0.z; lg[3] += xv * w0.w; lg[4] += xv * w1.x; lg[5] += xv * w1.y; lg[6] += xv * w1.z; lg[7] += xv * w1.w; }
            float r4[4], r2[2], r1;
#pragma unroll
            for (int e = 0; e < 4; ++e) { const float mine = b5 ? lg[4 + e] : lg[e], other = b5 ? lg[e] : lg[4 + e]; r4[e] = mine + xor32_partner(other, b5); }
#pragma unroll
            for (int e = 0; e < 2; ++e) { const float mine = b4 ? r4[2 + e] : r4[e], other = b4 ? r4[e] : r4[2 + e]; r2[e] = mine + swz_xor<16>(other); }
            { const float mine = b3 ? r2[1] : r2[0], other = b3 ? r2[0] : r2[1]; r1 = mine + swz_xor<8>(other); }
            r1 += swz_xor<4>(r1); r1 += swz_xor<2>(r1); r1 += swz_xor<1>(r1);
            const float rstd = 1.f / sqrtf(wave_sum(ssx) * (1.f / D) + EPS);
#pragma unroll
            for (int e = 0; e < 8; ++e) lg[e] = __builtin_bit_cast(float, __builtin_amdgcn_readlane(__builtin_bit_cast(int, r1), 8 * e)) * rstd;
            int e1 = 0; float l1 = lg[0];
#pragma unroll
            for (int e = 1; e < 8; ++e) if (lg[e] > l1) { l1 = lg[e]; e1 = e; }
            int e2 = -1; float l2 = -INFINITY;
#pragma unroll
            for (int e = 0; e < 8; ++e) if (e != e1 && lg[e] > l2) { l2 = lg[e]; e2 = e; }
            const float g1 = 1.f / (1.f + __expf(l2 - l1)), g2 = 1.f - g1;
            const int elo = e1 < e2 ? e1 : e2, ehi = e1 < e2 ? e2 : e1;
            const float glo = e1 < e2 ? g1 : g2, ghi = e1 < e2 ? g2 : g1;
            if (lane == 0) { ((GAS float*)(ws + WS_TOKRSTD))[m] = rstd; ((GAS int*)(ws + WS_TOKE))[m] = elo | (ehi << 8); ((GAS float*)(ws + WS_TOKG))[2 * m] = glo; ((GAS float*)(ws + WS_TOKG))[2 * m + 1] = ghi;
                atomicAdd((int*)&cnt[elo], 1); atomicAdd((int*)&cnt[8 + ehi], 1); }
        }
        __syncthreads();
        if (tid < 16) ((GAS int*)(ws + WS_CNT))[c * 16 + tid] = cnt[tid];
        __syncthreads();
    }
}

__device__ __forceinline__ void slot_phase(const Frame& F, unsigned char* ws) {
    const int tid = fresh(F.wave * 64 + lane_id_()), lane = tid & 63; (void)lane;
    LAS int* call = (LAS int*)(F.lds + RING_OFF);
    LAS int* tot = call + 4096; LAS int* base = tot + 16; LAS int* pre = base + 16; LAS int* meta = pre + 16;
    LAS int* grp = meta + 16;
    LAS int* slot_of = grp + 512;
    for (int idx = tid; idx < 4096; idx += NWAVES * 64) call[idx] = ((const GAS int*)(ws + WS_CNT))[idx];
    __syncthreads();
    if (tid < 16) { int t = 0; for (int cc = 0; cc < 256; ++cc) t += call[cc * 16 + tid]; tot[tid] = t; }
    __syncthreads();
    if (tid == 0) { int off = 0; for (int g = 0; g < 16; ++g) { base[g] = off; off += (tot[g] + 255) & ~255; if (g == 7) meta[0] = off >> 8; } meta[1] = (off >> 8) - meta[0]; }
    __syncthreads();
    for (int c = F.vcu; c < M / 256; c += F.G) {
        if (tid < 16) { int p = 0; for (int cc = 0; cc < c; ++cc) p += call[cc * 16 + tid]; pre[tid] = p; }
        const int hf = tid >> 8, i = tid & 255, m = c * 256 + i;
        const int te = ((const GAS int*)(ws + WS_TOKE))[m];
        const int g = hf * 8 + (hf ? ((te >> 8) & 0xff) : (te & 0xff));
        grp[tid] = g;
        __syncthreads();
        int rank = 0;
        for (int j = 0; j < i; ++j) rank += (grp[hf * 256 + j] == g) ? 1 : 0;
        const int slot = base[g] + pre[g] + rank;
        ((GAS int*)(ws + WS_SLOTTOK))[slot] = m; ((GAS float*)(ws + WS_SLOTGATE))[slot] = ((const GAS float*)(ws + WS_TOKG))[2 * m + hf];
        slot_of[tid] = slot;
        __syncthreads();
        for (int p = F.wave; p < 512; p += NWAVES) { const int mm = c * 256 + (p & 255), sl = slot_of[p];
            const GAS v4u* src = (const GAS v4u*)(ws + WS_XR3 + (size_t)mm * D * 2); GAS v4u* dst = (GAS v4u*)(ws + WS_XG + (size_t)sl * D);
            const v4u x0 = src[2 * lane], x1 = src[2 * lane + 1]; const float rs = ((const GAS float*)(ws + WS_TOKRSTD))[mm];
            dst[lane] = (v4u){pk_fp8x4(bflo(x0.x) * rs, bfhi(x0.x) * rs, bflo(x0.y) * rs, bfhi(x0.y) * rs), pk_fp8x4(bflo(x0.z) * rs, bfhi(x0.z) * rs, bflo(x0.w) * rs, bfhi(x0.w) * rs),
                              pk_fp8x4(bflo(x1.x) * rs, bfhi(x1.x) * rs, bflo(x1.y) * rs, bfhi(x1.y) * rs), pk_fp8x4(bflo(x1.z) * rs, bfhi(x1.z) * rs, bflo(x1.w) * rs, bfhi(x1.w) * rs)}; }
        __syncthreads();
    }
    for (int g = F.vcu; g < 16; g += F.G) {
        const int s0 = base[g] + tot[g], s1 = base[g] + ((tot[g] + 255) & ~255);
        for (int s = s0 + F.wave; s < s1; s += NWAVES) { GAS v4u* dst = (GAS v4u*)(ws + WS_XG + (size_t)s * D);
            dst[lane] = (v4u){0u, 0u, 0u, 0u};
            if (lane == 0) { ((GAS int*)(ws + WS_SLOTTOK))[s] = -1; ((GAS float*)(ws + WS_SLOTGATE))[s] = 0.f; } }
    }
    if (F.vcu == 0) {
        if (tid < 16) { const int p0 = base[tid] >> 8, p1 = (base[tid] + ((tot[tid] + 255) & ~255)) >> 8; for (int p = p0; p < p1; ++p) ((GAS int*)(ws + WS_PANELE))[p] = tid & 7; }
        if (tid == 0) { ((GAS int*)(ws + WS_META))[0] = meta[0]; ((GAS int*)(ws + WS_META))[1] = meta[1]; }
    }
    __syncthreads();
}

__global__ void __launch_bounds__(NWAVES * 64, 2) yoco_fwd(Args args) {
    extern __shared__ __attribute__((aligned(16))) unsigned char lds_raw[];
    Frame F;
    F.lds = (LAS unsigned char*)lds_raw;
    F.wave = __builtin_amdgcn_readfirstlane((int)threadIdx.x >> 6);
    F.G = gridDim.x; { const int bx = blockIdx.x; F.vcu = (F.G % 8 == 0) ? (bx % 8) * (F.G / 8) + bx / 8 : bx; }
    unsigned char* ws = WSP;
    volatile LAS unsigned* MISC = (volatile LAS unsigned*)(F.lds + MISC_OFF);
    for (int u = fresh((int)threadIdx.x); u < (LDS_BYTES - LDSCTL_OFF) / 4; u += NWAVES * 64) ((LAS unsigned*)(F.lds + LDSCTL_OFF))[u] = 0u;
    __syncthreads();
    (void)xcd_barrier_post((unsigned*)(ws + WS_CTL) + CW_BAR, MISC + 8, (F.wave == 0 && lane_id_() == 0) ? 1 : 0);
    LAS unsigned char* ring = F.lds + RING_OFF;
#define bid ((int)blockIdx.x)
#define GRID_BAR() do { XcdBarrier b_; b_.t0 = (F.wave == 0 && lane_id_() == 0) ? 1 : 0; b_.bar = (unsigned*)(WSP + WS_CTL) + CW_BAR; b_.x = xb_xcc_id(); b_.st = (volatile LAS unsigned*)(F.lds + MISC_OFF) + 8; xcd_barrier(b_); } while (0)
#define GEMM(EpiT, SchedT) pg8::gemm_phase<EpiT, SchedT, true, true>

    p0_prologue(F);
    GRID_BAR();
    { pg8::Gemm g{(const bf16*)(ws + WS_XN), (const bf16*)(ws + WS_WA), M, NA, D / 2, D / 2}; pg8::StaticOrder S; S.init(M, NA, F.G, bid);
      pg8::EpiQA E{(bf16*)(ws + WS_QA), (float*)(ws + WS_PARTQA), 1.f / 64};
      pg8::gemm_phase<pg8::EpiQA, pg8::StaticOrder, true, true, true>(ring, g, S, E, F.wave); }
    GRID_BAR();
    { pg8::Gemm g{(const bf16*)(ws + WS_QA), (const bf16*)(ws + WS_WUQ), M, NH * QKD, QLORA, NA}; pg8::StaticOrder S; S.init(M, NH * QKD, F.G, bid);
      pg8::EpiRowScaleBf16 E{(bf16*)(ws + WS_Q), NH * QKD, (const float*)(ws + WS_PARTQA), 1.f / QLORA};
      GEMM(pg8::EpiRowScaleBf16, pg8::StaticOrder)(ring, g, S, E, F.wave); }
    { pg8::Gemm g{(const bf16*)(ws + WS_QA) + QLORA, (const bf16*)(ws + WS_WUKV), M, NH * 128, KVLORA, NA}; pg8::StaticOrder S; S.init(M, NH * 128, F.G, bid);
      pg8::EpiKVup E{(bf16*)(ws + WS_K), (bf16*)(ws + WS_V), (const float*)(ws + WS_PARTQA), (const bf16*)(ws + WS_QA), INP(I_A_GKN), (const float*)(ws + WS_ROPE)};
      GEMM(pg8::EpiKVup, pg8::StaticOrder)(ring, g, S, E, F.wave); }
    GRID_BAR();
    for (int p = F.vcu; p < BATCH * NH * 4; p += F.G) {
        const int bh = p >> 2, pid = p & 3, b = bh >> 4, h = bh & 15;
        for (int u2 = 0; u2 < 2; ++u2) {
            const int qb = u2 ? 7 - pid : pid;
            att::attn_unit<96, false, 1536, 1536, D, D>(ring, (const bf16*)(ws + WS_Q) + (size_t)b * SEQ * 1536 + h * QKD, (const bf16*)(ws + WS_K) + (size_t)b * SEQ * 1536 + h * QKD,
                                      (const bf16*)(ws + WS_V) + (size_t)b * SEQ * D + h * 64, (bf16*)(ws + WS_O) + (size_t)b * SEQ * D + h * 64,
                                      256 * qb, 0, 4 * qb + 3, 0, 4 * qb + (F.wave >> 1), 0, nullptr, INP(I_A_GQN), (const float*)(ws + WS_ROPE), F.wave);
        }
    }
    GRID_BAR();
    { pg8::Gemm g{(const bf16*)(ws + WS_O), (const bf16*)(ws + WS_WO), M, D, D, D}; pg8::StaticOrder S; S.init(M, D, F.G, bid);
      pg8::EpiResNorm<true> E{INP(I_X), OUTP, (bf16*)(ws + WS_XR1), (float*)(ws + WS_PART1)};
      GEMM(pg8::EpiResNorm<true>, pg8::StaticOrder)(ring, g, S, E, F.wave); }
    GRID_BAR();
    { pg8::Gemm g{(const bf16*)(ws + WS_XR1), (const bf16*)(ws + WS_WF1), M, 2 * FF, D, D}; pg8::StaticOrder S; S.init(M, 2 * FF, F.G, bid);
      pg8::EpiGated<true> E{(bf16*)(ws + WS_H), FF, 0, (const float*)(ws + WS_PART1)};
      GEMM(pg8::EpiGated<true>, pg8::StaticOrder)(ring, g, S, E, F.wave); }
    GRID_BAR();
    { pg8::Gemm g{(const bf16*)(ws + WS_H), (const bf16*)(ws + WS_WF2), M, D, FF, FF}; pg8::StaticOrder S; S.init(M, D, F.G, bid);
      pg8::EpiResNorm<true, true> E{OUTP, OUTP, (bf16*)(ws + WS_XR2), (float*)(ws + WS_PART2)};
      pg8::gemm_phase<pg8::EpiResNorm<true, true>, pg8::StaticOrder, true, true>(ring, g, S, E, F.wave); }
    GRID_BAR();
    { pg8::Gemm g{(const bf16*)(ws + WS_XR2), (const bf16*)(ws + WS_WKVQ), M, 2 * D, D / 2, D / 2}; pg8::StaticOrder S; S.init(M, 2 * D, F.G, bid);
      pg8::EpiK2Q2 E{(bf16*)(ws + WS_KVQ2), (const float*)(ws + WS_PART2), INP(I_KV_GKN), INP(I_B_GQN), 1.f / 64};
      pg8::gemm_phase<pg8::EpiK2Q2, pg8::StaticOrder, true, true, true>(ring, g, S, E, F.wave); }
    { pg8::Gemm g{(const bf16*)(ws + WS_XR2), (const bf16*)(ws + WS_WKVQ + (size_t)2 * D * D), M, D, D / 2, D / 2}; pg8::StaticOrder S; S.init(M, D, F.G, bid);
      pg8::EpiRowScale16 E{(bf16*)(ws + WS_KVQ2), 3 * D, D, (const float*)(ws + WS_PART2), 1.f / 64};
      pg8::gemm_phase<pg8::EpiRowScale16, pg8::StaticOrder, true, true, true>(ring, g, S, E, F.wave); }
    GRID_BAR();
    for (int p = F.vcu; p < BATCH * NH * 8; p += F.G) {
        const int bh = p >> 3, cb = ((p & 7) + (p >> 8)) & 7, b = bh >> 4, h = bh & 15;
        const int c0 = 4 * cb, cc = c0 + (F.wave >> 1);
        const bf16* base = (const bf16*)(ws + WS_KVQ2) + (size_t)b * SEQ * 3072 + h * 64;
        att::attn_unit<64, true, 3072, 3072, 3072, D>(ring, base + 2048, base, base + 1024, (bf16*)(ws + WS_O2) + (size_t)b * SEQ * D + h * 64,
                                 256 * cb, c0 - 8 < 0 ? 0 : c0 - 8, c0 + 3, cc - 8 < 0 ? 0 : cc - 8, cc, cc, INP(I_B_RELB) + h * 257, nullptr, nullptr, F.wave);
    }
    GRID_BAR();
    { pg8::Gemm g{(const bf16*)(ws + WS_O2), (const bf16*)(ws + WS_WBO), M, D, D, D}; pg8::StaticOrder S; S.init(M, D, F.G, bid);
      pg8::EpiResNorm<false> E{OUTP, OUTP, (bf16*)(ws + WS_XR3), nullptr};
      GEMM(pg8::EpiResNorm<false>, pg8::StaticOrder)(ring, g, S, E, F.wave); }
    GRID_BAR();
    route_phase(F);
    GRID_BAR();
    slot_phase(F, ws);
    GRID_BAR();
    for (int hf = 0; hf < 2; ++hf) {
        { unsigned char* w2 = WSP;
          const int nPA = __builtin_amdgcn_readfirstlane(((const GAS int*)(w2 + WS_META))[0]), nPB = __builtin_amdgcn_readfirstlane(((const GAS int*)(w2 + WS_META))[1]);
          const int nP = hf ? nPB : nPA, p0 = hf ? nPA : 0;
          pg8::Gemm g{(const bf16*)(w2 + WS_XG + (size_t)p0 * 256 * D), (const bf16*)(w2 + WS_WM1), nP * 256, 2 * EFF, D / 2, D / 2};
          pg8::MoeOrder S; S.init(nP, 2 * EFF / 256, F.G, bid, (const int*)(w2 + WS_PANELE) + p0);
          pg8::EpiGatedF8 E{w2 + WS_HM, EFF, 2 * EFF / 256};
          pg8::gemm_phase<pg8::EpiGatedF8, pg8::MoeOrder, true, true, true>(ring, g, S, E, F.wave); }
        GRID_BAR();
        { unsigned char* w2 = WSP;
          const int nPA = __builtin_amdgcn_readfirstlane(((const GAS int*)(w2 + WS_META))[0]), nPB = __builtin_amdgcn_readfirstlane(((const GAS int*)(w2 + WS_META))[1]);
          const int nP = hf ? nPB : nPA, p0 = hf ? nPA : 0;
          pg8::Gemm g{(const bf16*)(w2 + WS_HM), (const bf16*)(w2 + WS_WM2), nP * 256, D, EFF / 2, EFF / 2};
          pg8::MoeOrder S; S.init(nP, D / 256, F.G, bid, (const int*)(w2 + WS_PANELE) + p0);
          pg8::EpiMoeDown E{OUTP, (const int*)(w2 + WS_SLOTTOK), (const float*)(w2 + WS_SLOTGATE), p0 * 256, D, 1.f / 64};
          pg8::gemm_phase<pg8::EpiMoeDown, pg8::MoeOrder, true, true, true>(ring, g, S, E, F.wave); }
        if (hf == 0) GRID_BAR();
    }
#undef GRID_BAR
#undef bid
#undef GEMM
}

extern "C" void kernel_launch(void* const* d_in, const int* in_sizes, int n_in, void* d_out, int out_size, void* d_ws, size_t ws_size, hipStream_t stream) {
    static int grid = 0;
    if (grid == 0) {
        if (n_in != 27 || in_sizes[0] != M * D || out_size != M * D || ws_size < WS_END) { fprintf(stderr, "kernel_launch: unexpected shapes (n_in %d, in0 %d, out %d, ws %zu < %zu); nothing launched\n", n_in, n_in > 0 ? in_sizes[0] : -1, out_size, ws_size, (size_t)WS_END); grid = -1; return; }
        int dev = 0, cus = 0, per_cu = 0;
        if (hipGetDevice(&dev) != hipSuccess || hipDeviceGetAttribute(&cus, hipDeviceAttributeMultiprocessorCount, dev) != hipSuccess) { grid = -1; return; }
        if (hipFuncSetAttribute((const void*)yoco_fwd, hipFuncAttributeMaxDynamicSharedMemorySize, LDS_BYTES) != hipSuccess) { fprintf(stderr, "kernel_launch: hipFuncSetAttribute failed\n"); grid = -1; return; }
        if (hipOccupancyMaxActiveBlocksPerMultiprocessor(&per_cu, (const void*)yoco_fwd, NWAVES * 64, LDS_BYTES) != hipSuccess || per_cu < 1) { fprintf(stderr, "kernel_launch: occupancy query says %d\n", per_cu); }
        (void)hipGetLastError();
        grid = cus;
    }
    if (grid < 0) return;
    if (hipMemsetAsync((char*)d_ws + WS_CTL, 0, CTL_ZERO_BYTES, stream) != hipSuccess) return;
    Args a{};
    for (int i = 0; i < 27; ++i) a.in[i] = (const float*)d_in[i];
    a.out = (float*)d_out; a.ws = (unsigned char*)d_ws;
    hipLaunchKernelGGL(yoco_fwd, dim3(grid), dim3(NWAVES * 64), LDS_BYTES, stream, a);
}
```

```cpp
#include <hip/hip_runtime.h>
#include <cstdio>
#include <cstdint>
__device__ __forceinline__ int lane_id_() { unsigned m_ = ~0u; asm volatile("" : "+s"(m_)); return (int)__builtin_amdgcn_mbcnt_hi(m_, __builtin_amdgcn_mbcnt_lo(m_, 0u)); }
template <int X> __device__ __forceinline__ float swz_xor(float v) { return __builtin_bit_cast(float, __builtin_amdgcn_ds_swizzle(__builtin_bit_cast(int, v), (X << 10) | 0x1f)); }
__device__ __forceinline__ void halves32(float v, float& r_lo, float& r_hi) { unsigned a_ = __builtin_bit_cast(unsigned, v), b_ = a_;
    asm volatile("s_nop 1\n\tv_permlane32_swap_b32 %0, %1\n\ts_nop 1" : "+v"(a_), "+v"(b_)); r_lo = __builtin_bit_cast(float, a_); r_hi = __builtin_bit_cast(float, b_); }
__device__ __forceinline__ float xor32_partner(float v, int upper_half) { float lo, hi; halves32(v, lo, hi); return upper_half ? lo : hi; }
__device__ __forceinline__ float xor32_sum(float v) { float lo, hi; halves32(v, lo, hi); return lo + hi; }
__device__ __forceinline__ float xor32_max(float v) { float lo, hi; halves32(v, lo, hi); return fmaxf(lo, hi); }
namespace pg8 {
#define PG8_LAS __attribute__((address_space(3)))
typedef unsigned short bf16_t;
typedef short bf16x8 __attribute__((ext_vector_type(8)));
typedef float f32x4 __attribute__((ext_vector_type(4)));
typedef unsigned u32x4 __attribute__((ext_vector_type(4)));
constexpr int BM = 256, BK = 64, HALF = 128, HTB = HALF * BK * 2  , STAGE_BYTES = 8 * HTB, NXCD = 8, WGM = 8;

__host__ __device__ __forceinline__ int lds_byte(int r, int c) { const int st = (r >> 4) * 2 + (c >> 5), rr = r & 15, cc = c & 31, ob = rr * 64 + cc * 2; return st * 1024 + (ob ^ (((ob >> 9) & 1) << 5)); }
__host__ __device__ __forceinline__ void stage_rc(int b, int& R, int& C) { const int st = b / 1024, sb = b % 1024, swz = sb ^ (((sb >> 9) & 1) << 5); R = (st >> 1) * 16 + swz / 64; C = (st & 1) * 32 + (swz % 64) / 2; }
__host__ __device__ __forceinline__ int perm32(int rho) { const int n = rho >> 4, i = rho & 15; return 8 * (i >> 2) + 4 * n + (i & 3); }

struct Unit { int pm, pn; };
struct Gemm { const bf16_t* A; const bf16_t* Bt; int M, N, K, lda; };

struct StaticOrder {
    int nM, nN, nwg, G, c;
    __host__ __device__ void init(int M, int N, int G_, int c_) { nM = M / BM; nN = N / BM; nwg = nM * nN; G = G_; c = c_; }
    __host__ __device__ bool next(int i, Unit& u) const {
        const int L = i * G + c; if (L >= nwg) return false;
        int wgid = L; { const int q = nwg / NXCD, r = nwg % NXCD, xcd = wgid % NXCD, off = wgid / NXCD; wgid = (xcd < r ? xcd * (q + 1) : r * (q + 1) + (xcd - r) * q) + off; }
        const int nig = WGM * nN, gid = wgid / nig, fm = gid * WGM, gsz = (nM - fm) < WGM ? (nM - fm) : WGM;
        u.pm = fm + ((wgid % nig) % gsz); u.pn = (wgid % nig) / gsz; return true;
    }
    __device__ __forceinline__ void a_ready(const Unit&) const {}
    __device__ __forceinline__ void done(const Unit&) const {}
};
__device__ __forceinline__ unsigned cvt_pk_bf16(float lo, float hi) { unsigned r; asm volatile("v_cvt_pk_bf16_f32 %0, %1, %2" : "=v"(r) : "v"(lo), "v"(hi)); return r; }
__device__ __forceinline__ float silu_f(float x) { const float e = __builtin_amdgcn_exp2f(x * -1.4426950408889634f); return x * __builtin_amdgcn_rcpf(1.f + e); }

__device__ __forceinline__ float sum4(const f32x4& a) { return (a[0] + a[1]) + (a[2] + a[3]); }
__device__ __forceinline__ float part_sum8(const float* p) { return sum4(*(const f32x4*)p) + sum4(*(const f32x4*)(p + 4)); }
__device__ __forceinline__ float part_sum16(const float* p) { return (sum4(*(const f32x4*)p) + sum4(*(const f32x4*)(p + 4))) + (sum4(*(const f32x4*)(p + 8)) + sum4(*(const f32x4*)(p + 12))); }
__device__ __forceinline__ float fq_sum(float v) { v += swz_xor<16>(v); return xor32_sum(v); }
__device__ __forceinline__ float sq8(const f32x4& a, const f32x4& b) { return ((a[0] * a[0] + a[1] * a[1]) + (a[2] * a[2] + a[3] * a[3])) + ((b[0] * b[0] + b[1] * b[1]) + (b[2] * b[2] + b[3] * b[3])); }
__device__ __forceinline__ u32x4 pack8(const f32x4& a, const f32x4& b) { u32x4 w; w.x = cvt_pk_bf16(a[0], a[1]); w.y = cvt_pk_bf16(a[2], a[3]); w.z = cvt_pk_bf16(b[0], b[1]); w.w = cvt_pk_bf16(b[2], b[3]); return w; }
constexpr float EPS_ = 1e-6f;
__device__ __forceinline__ unsigned pk_fp8x4(float a, float b, float c, float d) { int w = 0; w = __builtin_amdgcn_cvt_pk_fp8_f32(a, b, w, false); w = __builtin_amdgcn_cvt_pk_fp8_f32(c, d, w, true); return (unsigned)w; }

struct EpiQA {
    static constexpr bool PERM = true, AFTER_DRAIN = false;
    bf16_t* O; float* part; float wscale;
    __device__ __forceinline__ void operator()(const f32x4 (&acc)[2][2][4][2], const Unit& u, int wr, int wc, int fr, int fq) const {
        { int t_ = lane_id_(); asm volatile("" : "+v"(t_)); fr = t_ & 15; fq = (t_ >> 4) & 3; }
        const int row0 = u.pm * BM + wr * 64 + fr, col0 = u.pn * BM + wc * 32 + 8 * fq;
#pragma unroll
        for (int ai = 0; ai < 2; ++ai)
#pragma unroll
            for (int m = 0; m < 4; ++m) { const int row = row0 + ai * HALF + m * 16; bf16_t* rowp = O + (size_t)row * 768 + col0;
                const f32x4 a0 = acc[ai][0][m][0] * wscale, a1 = acc[ai][0][m][1] * wscale, b0 = acc[ai][1][m][0] * wscale, b1 = acc[ai][1][m][1] * wscale;
                *(u32x4*)(rowp) = pack8(a0, a1); *(u32x4*)(rowp + HALF) = pack8(b0, b1);
                const float s0 = sq8(a0, a1), s1 = sq8(b0, b1);
                float* pr = part + (size_t)row * 16;
                if (u.pn == 0) { const float t = fq_sum(s0 + s1); if (fq == 0) pr[wc] = t; }
                else if (u.pn == 1) { const float t0 = fq_sum(s0), t1 = fq_sum(s1); if (fq == 0) { pr[4 + wc] = t0; pr[8 + wc] = t1; } }
                else { const float t = fq_sum(s0); if (fq == 0) pr[12 + wc] = t; } }
    }
};

struct EpiRowScaleBf16 {
    static constexpr bool PERM = true, AFTER_DRAIN = false;
    bf16_t* O; int ldc; const float* part; float inv_n;
    __device__ __forceinline__ void operator()(const f32x4 (&acc)[2][2][4][2], const Unit& u, int wr, int wc, int fr, int fq) const {
        { int t_ = lane_id_(); asm volatile("" : "+v"(t_)); fr = t_ & 15; fq = (t_ >> 4) & 3; }
        const int row0 = u.pm * BM + wr * 64 + fr, col0 = u.pn * BM + wc * 32 + 8 * fq;
#pragma unroll
        for (int ai = 0; ai < 2; ++ai)
#pragma unroll
            for (int m = 0; m < 4; ++m) { const int row = row0 + ai * HALF + m * 16; bf16_t* rowp = O + (size_t)row * ldc + col0;
                const float rs = __builtin_amdgcn_rsqf(part_sum8(part + (size_t)row * 16) * inv_n + EPS_);
                *(u32x4*)(rowp) = pack8(acc[ai][0][m][0] * rs, acc[ai][0][m][1] * rs); *(u32x4*)(rowp + HALF) = pack8(acc[ai][1][m][0] * rs, acc[ai][1][m][1] * rs); }
    }
};

struct EpiKVup {
    static constexpr bool PERM = true, AFTER_DRAIN = false;
    bf16_t* Kd; bf16_t* Vd; const float* part; const bf16_t* QA; const float* g_kn; const float* rope;
    __device__ __forceinline__ void operator()(const f32x4 (&acc)[2][2][4][2], const Unit& u, int wr, int wc, int fr, int fq) const {
        { int t_ = lane_id_(); asm volatile("" : "+v"(t_)); fr = t_ & 15; fq = (t_ >> 4) & 3; }
        const int row0 = u.pm * BM + wr * 64 + fr;
        if (u.pn >= 4) {
            const int col0 = (u.pn - 4) * BM + wc * 32 + 8 * fq;
#pragma unroll
            for (int ai = 0; ai < 2; ++ai)
#pragma unroll
                for (int m = 0; m < 4; ++m) { const int row = row0 + ai * HALF + m * 16; bf16_t* rowp = Vd + (size_t)row * 1024 + col0;
                    const float rs = __builtin_amdgcn_rsqf(part_sum8(part + (size_t)row * 16 + 8) * (1.f / 256) + EPS_);
                    *(u32x4*)(rowp) = pack8(acc[ai][0][m][0] * rs, acc[ai][0][m][1] * rs); *(u32x4*)(rowp + HALF) = pack8(acc[ai][1][m][0] * rs, acc[ai][1][m][1] * rs); }
            return;
        }
        const int head = 4 * u.pn + wc;
        f32x4 gA0 = *(const f32x4*)(g_kn + 8 * fq), gA1 = *(const f32x4*)(g_kn + 8 * fq + 4), gB0 = *(const f32x4*)(g_kn + 32 + 8 * fq), gB1 = *(const f32x4*)(g_kn + 32 + 8 * fq + 4);
        const f32x4 gR1 = *(const f32x4*)(g_kn + 64 + 4 * fq), gR2 = *(const f32x4*)(g_kn + 80 + 4 * fq);
#pragma unroll
        for (int ai = 0; ai < 2; ++ai)
#pragma unroll
            for (int m = 0; m < 4; ++m) { const int row = row0 + ai * HALF + m * 16;
                const float rs = __builtin_amdgcn_rsqf(part_sum8(part + (size_t)row * 16 + 8) * (1.f / 256) + EPS_);
                f32x4 a0 = acc[ai][0][m][0] * rs, a1 = acc[ai][0][m][1] * rs, b0 = acc[ai][1][m][0] * rs, b1 = acc[ai][1][m][1] * rs;
                const unsigned long long p1 = *(const unsigned long long*)(QA + (size_t)row * 768 + 640 + 4 * fq), p2 = *(const unsigned long long*)(QA + (size_t)row * 768 + 656 + 4 * fq);
                f32x4 x1, x2;
                x1[0] = __builtin_bit_cast(float, (unsigned)(p1 << 16)); x1[1] = __builtin_bit_cast(float, (unsigned)p1 & 0xffff0000u);
                x1[2] = __builtin_bit_cast(float, (unsigned)(p1 >> 32) << 16); x1[3] = __builtin_bit_cast(float, (unsigned)(p1 >> 32) & 0xffff0000u);
                x2[0] = __builtin_bit_cast(float, (unsigned)(p2 << 16)); x2[1] = __builtin_bit_cast(float, (unsigned)p2 & 0xffff0000u);
                x2[2] = __builtin_bit_cast(float, (unsigned)(p2 >> 32) << 16); x2[3] = __builtin_bit_cast(float, (unsigned)(p2 >> 32) & 0xffff0000u);
                const float ss = fq_sum(sq8(a0, a1) + sq8(b0, b1) + sq8(x1, x2));
                const float sh = __builtin_amdgcn_rsqf(ss * (1.f / 96) + EPS_);
                bf16_t* kp = Kd + (size_t)row * 1536 + head * 96;
                *(u32x4*)(kp + 8 * fq) = pack8(a0 * gA0 * sh, a1 * gA1 * sh); *(u32x4*)(kp + 32 + 8 * fq) = pack8(b0 * gB0 * sh, b1 * gB1 * sh);
                const f32x4* rp = (const f32x4*)(rope + ((size_t)(row & 2047) * 16 + 4 * fq) * 2);
                const f32x4 c01 = rp[0], c23 = rp[1];
                const f32x4 y1 = x1 * gR1 * sh, y2 = x2 * gR2 * sh;
                f32x4 o1, o2;
                o1[0] = y1[0] * c01[0] - y2[0] * c01[1]; o2[0] = y2[0] * c01[0] + y1[0] * c01[1];
                o1[1] = y1[1] * c01[2] - y2[1] * c01[3]; o2[1] = y2[1] * c01[2] + y1[1] * c01[3];
                o1[2] = y1[2] * c23[0] - y2[2] * c23[1]; o2[2] = y2[2] * c23[0] + y1[2] * c23[1];
                o1[3] = y1[3] * c23[2] - y2[3] * c23[3]; o2[3] = y2[3] * c23[2] + y1[3] * c23[3];
                unsigned long long w1 = (unsigned long long)cvt_pk_bf16(o1[0], o1[1]) | ((unsigned long long)cvt_pk_bf16(o1[2], o1[3]) << 32);
                unsigned long long w2 = (unsigned long long)cvt_pk_bf16(o2[0], o2[1]) | ((unsigned long long)cvt_pk_bf16(o2[2], o2[3]) << 32);
                *(unsigned long long*)(kp + 64 + 4 * fq) = w1; *(unsigned long long*)(kp + 80 + 4 * fq) = w2; }
    }
};

struct EpiK2Q2 {
    static constexpr bool PERM = true, AFTER_DRAIN = false;
    bf16_t* O; const float* pss; const float* gk; const float* gq; float wscale;
    __device__ __forceinline__ void operator()(const f32x4 (&acc)[2][2][4][2], const Unit& u, int wr, int wc, int fr, int fq) const {
        { int t_ = lane_id_(); asm volatile("" : "+v"(t_)); fr = t_ & 15; fq = (t_ >> 4) & 3; }
        const int row0 = u.pm * BM + wr * 64 + fr, isq = u.pn >> 2, tl = u.pn & 3;
        const float* g = isq ? gq : gk; const float post = isq ? 0.125f * 1.4426950408889634f : 1.f;
        const f32x4 gA0 = *(const f32x4*)(g + 8 * fq) * post, gA1 = *(const f32x4*)(g + 8 * fq + 4) * post, gB0 = *(const f32x4*)(g + 32 + 8 * fq) * post, gB1 = *(const f32x4*)(g + 32 + 8 * fq + 4) * post;
        const int colh = isq * 2048 + (4 * tl + wc) * 64;
        unsigned zhi_ = 0u; asm volatile("" : "+v"(zhi_));
        const unsigned long long coff = ((unsigned long long)zhi_ << 32) | (unsigned)((colh + 8 * fq) * 2);
#pragma unroll
        for (int ai = 0; ai < 2; ++ai)
#pragma unroll
            for (int m = 0; m < 4; ++m) { const int row = row0 + ai * HALF + m * 16; unsigned char* rowp = (unsigned char*)O + (size_t)row * 6144 + coff;
                const float rs = __builtin_amdgcn_rsqf(part_sum16(pss + (size_t)row * 16) * (1.f / 1024) + EPS_) * wscale;
                const f32x4 a0 = acc[ai][0][m][0] * rs, a1 = acc[ai][0][m][1] * rs, b0 = acc[ai][1][m][0] * rs, b1 = acc[ai][1][m][1] * rs;
                const float ss = fq_sum(sq8(a0, a1) + sq8(b0, b1));
                const float sh = __builtin_amdgcn_rsqf(ss * (1.f / 64) + EPS_);
                *(u32x4*)(rowp) = pack8(a0 * gA0 * sh, a1 * gA1 * sh); *(u32x4*)(rowp + 64) = pack8(b0 * gB0 * sh, b1 * gB1 * sh); }
    }
};
struct EpiRowScale16 {
    static constexpr bool PERM = true, AFTER_DRAIN = false;
    bf16_t* O; int ldc; int coff; const float* pss; float wscale;
    __device__ __forceinline__ void operator()(const f32x4 (&acc)[2][2][4][2], const Unit& u, int wr, int wc, int fr, int fq) const {
        { int t_ = lane_id_(); asm volatile("" : "+v"(t_)); fr = t_ & 15; fq = (t_ >> 4) & 3; }
        const int row0 = u.pm * BM + wr * 64 + fr, col0 = coff + u.pn * BM + wc * 32 + 8 * fq;
#pragma unroll
        for (int ai = 0; ai < 2; ++ai)
#pragma unroll
            for (int m = 0; m < 4; ++m) { const int row = row0 + ai * HALF + m * 16; bf16_t* rowp = O + (size_t)row * ldc + col0;
                const float rs = __builtin_amdgcn_rsqf(part_sum16(pss + (size_t)row * 16) * (1.f / 1024) + EPS_) * wscale;
                *(u32x4*)(rowp) = pack8(acc[ai][0][m][0] * rs, acc[ai][0][m][1] * rs); *(u32x4*)(rowp + HALF) = pack8(acc[ai][1][m][0] * rs, acc[ai][1][m][1] * rs); }
    }
};

template <bool SSQ> struct EpiGated {
    static constexpr bool PERM = true, AFTER_DRAIN = false;
    bf16_t* Hd; int ldc; int ntile; const float* rs;
    __device__ __forceinline__ void operator()(const f32x4 (&acc)[2][2][4][2], const Unit& u, int wr, int wc, int fr, int fq) const {
        { int t_ = lane_id_(); asm volatile("" : "+v"(t_)); fr = t_ & 15; fq = (t_ >> 4) & 3; }
        const int pnl = ntile ? (u.pn % ntile) : u.pn;
        const int row0 = u.pm * BM + wr * 64 + fr, col0 = pnl * HALF + wc * 32 + 8 * fq;
#pragma unroll
        for (int ai = 0; ai < 2; ++ai)
#pragma unroll
            for (int m = 0; m < 4; ++m) { const int row = row0 + ai * HALF + m * 16; bf16_t* rowp = Hd + (size_t)row * ldc + col0;
                const float r = SSQ ? __builtin_amdgcn_rsqf(part_sum16(rs + (size_t)row * 16) * (1.f / 1024) + EPS_) : rs[row];
                const f32x4 g0 = acc[ai][0][m][0] * r, g1 = acc[ai][0][m][1] * r, u0 = acc[ai][1][m][0] * r, u1 = acc[ai][1][m][1] * r;
                u32x4 w;
                w.x = cvt_pk_bf16(silu_f(g0[0]) * u0[0], silu_f(g0[1]) * u0[1]); w.y = cvt_pk_bf16(silu_f(g0[2]) * u0[2], silu_f(g0[3]) * u0[3]);
                w.z = cvt_pk_bf16(silu_f(g1[0]) * u1[0], silu_f(g1[1]) * u1[1]); w.w = cvt_pk_bf16(silu_f(g1[2]) * u1[2], silu_f(g1[3]) * u1[3]);
                *(u32x4*)rowp = w; }
    }
};

struct EpiGatedF8 {
    static constexpr bool PERM = true, AFTER_DRAIN = false;
    unsigned char* Hd; int ldc; int ntile;
    static __device__ __forceinline__ float gate(float g, float u) {
        const float e = __builtin_amdgcn_exp2f(g * (-1.4426950408889634f / 64.f)); return (g * u) * (__builtin_amdgcn_rcpf(1.f + e) * (1.f / 4096.f)); }
    __device__ __forceinline__ void operator()(const f32x4 (&acc)[2][2][4][2], const Unit& u, int wr, int wc, int fr, int fq) const {
        { int t_ = lane_id_(); asm volatile("" : "+v"(t_)); fr = t_ & 15; fq = (t_ >> 4) & 3; }
        const int pnl = u.pn % ntile;
        const int row0 = u.pm * BM + wr * 64 + fr, col0 = pnl * HALF + wc * 32 + 8 * fq;
#pragma unroll
        for (int ai = 0; ai < 2; ++ai)
#pragma unroll
            for (int m = 0; m < 4; ++m) { const int row = row0 + ai * HALF + m * 16; unsigned char* rowp = Hd + (size_t)row * ldc + col0;
                const f32x4 g0 = acc[ai][0][m][0], g1 = acc[ai][0][m][1], u0 = acc[ai][1][m][0], u1 = acc[ai][1][m][1];
                unsigned long long w = (unsigned long long)pk_fp8x4(gate(g0[0], u0[0]), gate(g0[1], u0[1]), gate(g0[2], u0[2]), gate(g0[3], u0[3]))
                                     | ((unsigned long long)pk_fp8x4(gate(g1[0], u1[0]), gate(g1[1], u1[1]), gate(g1[2], u1[2]), gate(g1[3], u1[3])) << 32);
                *(unsigned long long*)rowp = w; }
    }
};

template <bool SSQ, bool XF8 = false> struct EpiResNorm {
    static constexpr bool PERM = true, AFTER_DRAIN = false;
    const float* res; float* out; bf16_t* XR; float* ssq; float ascale;
    __device__ __forceinline__ void operator()(const f32x4 (&acc)[2][2][4][2], const Unit& u, int wr, int wc, int fr, int fq) const {
        { int t_ = lane_id_(); asm volatile("" : "+v"(t_)); fr = t_ & 15; fq = (t_ >> 4) & 3; }
        const int row0 = u.pm * BM + wr * 64 + fr, col0 = u.pn * BM + wc * 32 + 8 * fq;
#pragma unroll
        for (int ai = 0; ai < 2; ++ai)
#pragma unroll
            for (int m = 0; m < 4; ++m) { const int row = row0 + ai * HALF + m * 16; const size_t ro = (size_t)row * 1024 + col0;
                f32x4 r[2][2];
#pragma unroll
                for (int bj = 0; bj < 2; ++bj)
#pragma unroll
                    for (int n = 0; n < 2; ++n) r[bj][n] = *(const f32x4*)(res + ro + bj * HALF + n * 4);
#pragma unroll
                for (int bj = 0; bj < 2; ++bj)
#pragma unroll
                    for (int n = 0; n < 2; ++n) { r[bj][n] = r[bj][n] + acc[ai][bj][m][n] * ascale; *(f32x4*)(out + ro + bj * HALF + n * 4) = r[bj][n]; }
                if constexpr (XF8) { unsigned char* x8 = (unsigned char*)XR + ro;
                    *(unsigned long long*)(x8) = (unsigned long long)pk_fp8x4(r[0][0][0], r[0][0][1], r[0][0][2], r[0][0][3]) | ((unsigned long long)pk_fp8x4(r[0][1][0], r[0][1][1], r[0][1][2], r[0][1][3]) << 32);
                    *(unsigned long long*)(x8 + HALF) = (unsigned long long)pk_fp8x4(r[1][0][0], r[1][0][1], r[1][0][2], r[1][0][3]) | ((unsigned long long)pk_fp8x4(r[1][1][0], r[1][1][1], r[1][1][2], r[1][1][3]) << 32); }
                else { *(u32x4*)(XR + ro) = pack8(r[0][0], r[0][1]); *(u32x4*)(XR + ro + HALF) = pack8(r[1][0], r[1][1]); }
                if (SSQ) { const float t = fq_sum(sq8(r[0][0], r[0][1]) + sq8(r[1][0], r[1][1])); if (fq == 0) ssq[(size_t)row * 16 + u.pn * 4 + wc] = t; } }
    }
};

struct EpiMoeDown {
    static constexpr bool PERM = false, AFTER_DRAIN = false;
    float* out; const int* slot_tok; const float* slot_gate; int slot_base; int ldc; float wscale;
    __device__ __forceinline__ void operator()(const f32x4 (&acc)[2][2][4][2], const Unit& u, int wr, int wc, int fr, int fq) const {
        { int t_ = lane_id_(); asm volatile("" : "+v"(t_)); fr = t_ & 15; fq = (t_ >> 4) & 3; }
        const int pnl = u.pn & 3;
        const int row0 = slot_base + u.pm * BM + wr * 64 + fr, col0 = pnl * BM + wc * 32 + 4 * fq;
#pragma unroll
        for (int ai = 0; ai < 2; ++ai)
#pragma unroll
            for (int m = 0; m < 4; ++m) { const int slot = row0 + ai * HALF + m * 16; const int tok = slot_tok[slot]; const float gt = slot_gate[slot] * wscale;
                if (tok >= 0) { float* rowp = out + (size_t)tok * ldc + col0;
                    f32x4 r[2][2];
#pragma unroll
                    for (int bj = 0; bj < 2; ++bj)
#pragma unroll
                        for (int n = 0; n < 2; ++n) r[bj][n] = *(const f32x4*)(rowp + bj * HALF + n * 16);
#pragma unroll
                    for (int bj = 0; bj < 2; ++bj)
#pragma unroll
                        for (int n = 0; n < 2; ++n) *(f32x4*)(rowp + bj * HALF + n * 16) = r[bj][n] + acc[ai][bj][m][n] * gt; } }
    }
};

struct MoeOrder {
    int nM, nN, nwg, G, c; int pb[7];
    __device__ void init(int nPanels, int nN_, int G_, int c_) { nM = nPanels; nN = nN_; nwg = nM * nN; G = G_; c = c_; }
    __device__ bool next(int i, Unit& u) const {
        const int L = i * G + c; if (L >= nwg) return false;
        int wgid = L; { const int q = nwg / NXCD, r = nwg % NXCD, xcd = wgid % NXCD, off = wgid / NXCD; wgid = (xcd < r ? xcd * (q + 1) : r * (q + 1) + (xcd - r) * q) + off; }
        const int nig = WGM * nN, gid = wgid / nig, fm = gid * WGM, gsz = (nM - fm) < WGM ? (nM - fm) : WGM;
        u.pm = fm + ((wgid % nig) % gsz); const int pnl = (wgid % nig) / gsz;
        int e = 0;
#pragma unroll
        for (int k = 0; k < 7; ++k) e += (u.pm >= pb[k]) ? 1 : 0;
        u.pn = e * nN + pnl; return true;
    }
    __device__ __forceinline__ void a_ready(const Unit&) const {}
    __device__ __forceinline__ void done(const Unit&) const {}
};
template <class Epi, class Sched, bool ALIGN_EPI = false, bool SP2 = false, bool F8 = false>
__device__ __forceinline__ void gemm_phase(PG8_LAS unsigned char* lds, const Gemm g, const Sched& S, const Epi& E, const int wave_idx) {
    int tid_ = wave_idx * 64 + lane_id_(); asm volatile("" : "+v"(tid_));
    const int tid = tid_, wid = __builtin_amdgcn_readfirstlane(tid >> 6), lane = tid & 63, wr = wid >> 2, wc = wid & 3, fr = lane & 15, fq = lane >> 4;
    const int K = g.K, nt = K / BK;
    unsigned voffA0, voffB0;
    { int R, C; stage_rc(tid * 16, R, C); const int Rb = Epi::PERM ? ((R & ~31) + perm32(R & 31)) : R;
      voffA0 = (unsigned)(R * g.lda + C) * 2u; voffB0 = (unsigned)(Rb * K + C) * 2u; }
    const size_t voffAR = (size_t)64 * g.lda * 2, voffBR = (size_t)64 * K * 2;
    const size_t kstep = (size_t)(BK * 2);
    const size_t hstepA = (size_t)HALF * g.lda * 2, hstepB = (size_t)HALF * K * 2;
    const size_t tstepA = 2 * hstepA, tstepB = 2 * hstepB;
    const unsigned lds0_ = (unsigned)(__UINTPTR_TYPE__)lds;
    const unsigned ldsw = (unsigned)wid * 1024u;
    const int aoff = lds_byte(wr * 64 + fr, fq * 8), boff = lds_byte(wc * 32 + fr, fq * 8);
#define PG8_SA(b, h) (((b) * 2 + (h)) * HTB)
#define PG8_SB(b, h) ((4 + (b) * 2 + (h)) * HTB)
#define PG8_STAGE(bufoff, gbase, voff) do { _Pragma("unroll") for (int _i = 0; _i < 2; ++_i) { unsigned keep_; const char* sb_ = (const char*)(gbase) + (size_t)_i * voff##R; \
        asm volatile("s_mov_b32 %0, m0\n\ts_mov_b32 m0, %3\n\ts_nop 0\n\tglobal_load_lds_dwordx4 %1, %2\n\ts_mov_b32 m0, %0" \
            : "=&s"(keep_) : "v"(voff##0), "s"(sb_), "s"(lds0_ + (unsigned)((bufoff) + _i * 8192) + ldsw) : "memory"); } } while (0)
#define PG8_LDA(dst, b, h) do { _Pragma("unroll") for (int m = 0; m < 4; ++m) _Pragma("unroll") for (int k = 0; k < 2; ++k) dst[m][k] = *(const PG8_LAS bf16x8*)(lds + PG8_SA(b, h) + aoff + m * 2048 + k * 1024); } while (0)
#define PG8_LDB(dst, b, h) do { _Pragma("unroll") for (int n = 0; n < 2; ++n) _Pragma("unroll") for (int k = 0; k < 2; ++k) dst[n][k] = *(const PG8_LAS bf16x8*)(lds + PG8_SB(b, h) + boff + n * 2048 + k * 1024); } while (0)
#define PG8_MMA(ai, bj, At, Bt) do { __builtin_amdgcn_s_setprio(1); _Pragma("unroll") for (int m = 0; m < 4; ++m) _Pragma("unroll") for (int n = 0; n < 2; ++n) { \
        if constexpr (F8) { typedef int v8i_ __attribute__((ext_vector_type(8))); typedef int v4i_ __attribute__((ext_vector_type(4))); \
            const v4i_ b0_ = __builtin_bit_cast(v4i_, Bt[n][0]), b1_ = __builtin_bit_cast(v4i_, Bt[n][1]), a0_ = __builtin_bit_cast(v4i_, At[m][0]), a1_ = __builtin_bit_cast(v4i_, At[m][1]); \
            const v8i_ bb_ = __builtin_shufflevector(b0_, b1_, 0, 1, 2, 3, 4, 5, 6, 7), aa_ = __builtin_shufflevector(a0_, a1_, 0, 1, 2, 3, 4, 5, 6, 7); \
            acc[ai][bj][m][n] = __builtin_amdgcn_mfma_scale_f32_16x16x128_f8f6f4(bb_, aa_, acc[ai][bj][m][n], 0, 0, 0, 0, 0, 0); } \
        else { _Pragma("unroll") for (int k = 0; k < 2; ++k) acc[ai][bj][m][n] = __builtin_amdgcn_mfma_f32_16x16x32_bf16(Bt[n][k], At[m][k], acc[ai][bj][m][n], 0, 0, 0); } } \
        __builtin_amdgcn_s_setprio(0); } while (0)
#define PG8_WAIT_V(n) asm volatile("s_waitcnt vmcnt(" #n ")" ::: "memory")
#define PG8_WAIT_L(n) asm volatile("s_waitcnt lgkmcnt(" #n ")" ::: "memory")
#define PG8_BAR __builtin_amdgcn_s_barrier()
#define PG8_SCHED __builtin_amdgcn_sched_barrier(0)
    Unit cur, nxt; int ui = 0;
    if (!S.next(0, cur)) return;
    f32x4 acc[2][2][4][2];
#pragma unroll
    for (int a = 0; a < 2; ++a)
#pragma unroll
        for (int b = 0; b < 2; ++b)
#pragma unroll
            for (int m = 0; m < 4; ++m)
#pragma unroll
                for (int n = 0; n < 2; ++n) acc[a][b][m][n] = (f32x4){0.f, 0.f, 0.f, 0.f};
    bf16x8 At[4][2], B0[2][2], B1[2][2];
    const char* cA = (const char*)g.A + (size_t)cur.pm * tstepA; const char* cB = (const char*)g.Bt + (size_t)cur.pn * tstepB;
    S.a_ready(cur);
    if constexpr (SP2) {
        PG8_STAGE(PG8_SB(0, 0), cB, voffB); PG8_STAGE(PG8_SB(0, 1), cB + hstepB, voffB); PG8_STAGE(PG8_SA(0, 0), cA, voffA); PG8_STAGE(PG8_SA(0, 1), cA + hstepA, voffA);
        if (wr == 1) PG8_BAR;
        PG8_WAIT_V(2); PG8_BAR;
        PG8_STAGE(PG8_SB(1, 0), cB + kstep, voffB); PG8_STAGE(PG8_SA(1, 0), cA + kstep, voffA); PG8_STAGE(PG8_SB(1, 1), cB + hstepB + kstep, voffB);
        PG8_WAIT_V(6); PG8_BAR;
    } else {
        PG8_STAGE(PG8_SB(0, 0), cB, voffB); PG8_STAGE(PG8_SA(0, 0), cA, voffA); PG8_STAGE(PG8_SB(0, 1), cB + hstepB, voffB); PG8_STAGE(PG8_SA(0, 1), cA + hstepA, voffA);
        if (wr == 1) PG8_BAR;
        PG8_WAIT_V(4); PG8_BAR;
        PG8_STAGE(PG8_SB(1, 0), cB + kstep, voffB); PG8_STAGE(PG8_SA(1, 0), cA + kstep, voffA); PG8_STAGE(PG8_SB(1, 1), cB + hstepB + kstep, voffB);
        PG8_WAIT_V(6); PG8_BAR;
    }
    for (;;) {
        const bool has_next = S.next(ui + 1, nxt);
        const char* nA = has_next ? (const char*)g.A + (size_t)nxt.pm * tstepA : cA; const char* nB = has_next ? (const char*)g.Bt + (size_t)nxt.pn * tstepB : cB;
#pragma unroll 1
        for (int t = 0; t < nt; t += 2) {
            const bool last = (t == nt - 2);
            const char* a1 = cA + (size_t)(t + 1) * kstep;
            const char* a2 = last ? nA : cA + (size_t)(t + 2) * kstep; const char* b2 = last ? nB : cB + (size_t)(t + 2) * kstep;
            const char* a3 = a2 + kstep; const char* b3 = b2 + kstep;
            if (last && has_next) S.a_ready(nxt);
            if constexpr (SP2) {
            PG8_LDB(B0, 0, 0); PG8_LDB(B1, 0, 1); PG8_SCHED; PG8_LDA(At, 0, 0); PG8_STAGE(PG8_SA(1, 1), a1 + hstepA, voffA);
            PG8_WAIT_V(8); PG8_WAIT_L(0); PG8_BAR; PG8_MMA(0, 0, At, B0); PG8_MMA(0, 1, At, B1); PG8_BAR; PG8_SCHED;
            PG8_LDA(At, 0, 1); PG8_STAGE(PG8_SB(0, 0), b2, voffB); PG8_STAGE(PG8_SB(0, 1), b2 + hstepB, voffB); PG8_STAGE(PG8_SA(0, 0), a2, voffA);
            PG8_WAIT_V(8); PG8_WAIT_L(0); PG8_BAR; PG8_MMA(1, 0, At, B0); PG8_MMA(1, 1, At, B1); PG8_BAR; PG8_SCHED;
            PG8_LDB(B0, 1, 0); PG8_LDB(B1, 1, 1); PG8_SCHED; PG8_LDA(At, 1, 0); PG8_STAGE(PG8_SA(0, 1), a2 + hstepA, voffA);
            PG8_WAIT_V(8); PG8_WAIT_L(0); PG8_BAR; PG8_MMA(0, 0, At, B0); PG8_MMA(0, 1, At, B1); PG8_BAR; PG8_SCHED;
            PG8_LDA(At, 1, 1); PG8_STAGE(PG8_SB(1, 0), b3, voffB); PG8_STAGE(PG8_SB(1, 1), b3 + hstepB, voffB); PG8_STAGE(PG8_SA(1, 0), a3, voffA);
            PG8_WAIT_V(8); PG8_WAIT_L(0); PG8_BAR; PG8_MMA(1, 0, At, B0); PG8_MMA(1, 1, At, B1); PG8_BAR; PG8_SCHED;
            } else {
            PG8_LDB(B0, 0, 0); PG8_SCHED; PG8_LDA(At, 0, 0); PG8_STAGE(PG8_SA(1, 1), a1 + hstepA, voffA);
            PG8_WAIT_L(8); PG8_BAR; PG8_WAIT_L(0); PG8_MMA(0, 0, At, B0); PG8_BAR; PG8_SCHED;
            PG8_LDB(B1, 0, 1); PG8_STAGE(PG8_SB(0, 0), b2, voffB);
            PG8_BAR; PG8_WAIT_L(0); PG8_MMA(0, 1, At, B1); PG8_BAR;
            PG8_LDA(At, 0, 1); PG8_STAGE(PG8_SA(0, 0), a2, voffA);
            PG8_BAR; PG8_WAIT_L(0); PG8_MMA(1, 0, At, B0); PG8_BAR; PG8_SCHED;
            PG8_STAGE(PG8_SB(0, 1), b2 + hstepB, voffB);
            PG8_WAIT_V(6); PG8_BAR; PG8_MMA(1, 1, At, B1); PG8_BAR;
            PG8_LDB(B0, 1, 0); PG8_SCHED; PG8_LDA(At, 1, 0); PG8_STAGE(PG8_SA(0, 1), a2 + hstepA, voffA);
            PG8_WAIT_L(8); PG8_BAR; PG8_WAIT_L(0); PG8_MMA(0, 0, At, B0); PG8_BAR; PG8_SCHED;
            PG8_LDB(B1, 1, 1); PG8_STAGE(PG8_SB(1, 0), b3, voffB);
            PG8_BAR; PG8_WAIT_L(0); PG8_MMA(0, 1, At, B1); PG8_BAR;
            PG8_LDA(At, 1, 1); PG8_STAGE(PG8_SA(1, 0), a3, voffA);
            PG8_BAR; PG8_WAIT_L(0); PG8_MMA(1, 0, At, B0); PG8_BAR; PG8_SCHED;
            PG8_STAGE(PG8_SB(1, 1), b3 + hstepB, voffB);
            PG8_WAIT_V(6); PG8_BAR; PG8_MMA(1, 1, At, B1); PG8_BAR;
            }
        }
        if constexpr (ALIGN_EPI) { if (wr == 0) PG8_BAR; }
        if constexpr (!Epi::AFTER_DRAIN) { E(acc, cur, wr, wc, fr, fq); S.done(cur); }
        if (!has_next) break;
#pragma unroll
        for (int a = 0; a < 2; ++a)
#pragma unroll
            for (int b = 0; b < 2; ++b)
#pragma unroll
                for (int m = 0; m < 4; ++m)
#pragma unroll
                    for (int n = 0; n < 2; ++n) acc[a][b][m][n] = (f32x4){0.f, 0.f, 0.f, 0.f};
        cur = nxt; cA = nA; cB = nB; ++ui;
        if constexpr (ALIGN_EPI) { if (wr == 1) PG8_BAR; }
    }
    PG8_WAIT_V(0);
    if constexpr (!ALIGN_EPI) { if (wr == 0) PG8_BAR; }
    PG8_BAR;
    if constexpr (Epi::AFTER_DRAIN) { E.fused(acc, cur, wr, wc, fr, fq, lds, wid, lane); S.done(cur); }
#undef PG8_SA
#undef PG8_SB
#undef PG8_STAGE
#undef PG8_LDA
#undef PG8_LDB
#undef PG8_MMA
#undef PG8_WAIT_V
#undef PG8_WAIT_L
#undef PG8_BAR
#undef PG8_SCHED
}
}
namespace att {
#define ATT_LAS __attribute__((address_space(3)))
typedef unsigned short bf16;
typedef short bf16x8 __attribute__((ext_vector_type(8)));
typedef short s16x4 __attribute__((ext_vector_type(4)));
typedef float f32x16 __attribute__((ext_vector_type(16)));
typedef float f32x4_t __attribute__((ext_vector_type(4)));
typedef unsigned u32x4 __attribute__((ext_vector_type(4)));
typedef unsigned u32x2 __attribute__((ext_vector_type(2)));
typedef float f32x2_t __attribute__((ext_vector_type(2))); typedef __bf16 bf16x2_t __attribute__((ext_vector_type(2)));
__device__ __forceinline__ unsigned cvtpk(float lo, float hi) { f32x2_t v = {lo, hi}; bf16x2_t b = __builtin_convertvector(v, bf16x2_t); return __builtin_bit_cast(unsigned, b); }
__device__ __forceinline__ s16x4 vtr(const ATT_LAS unsigned char* p) { return __builtin_bit_cast(s16x4, __builtin_amdgcn_ds_read_tr16_b64_v4i16((ATT_LAS s16x4*)p)); }
constexpr int VSTR = 192;
template <int DQK> struct Geo { static constexpr int KSTR = DQK * 2 + 16, KBUF = 64 * KSTR, VBUF = 64 * VSTR, CPR = DQK / 8, NKC = 64 * CPR, KIT = (NKC + 511) / 512; };
template <int DQK> constexpr int lds_bytes() { return 2 * Geo<DQK>::KBUF + 2 * Geo<DQK>::VBUF + 2048 + 8192; }

__device__ __forceinline__ float xhalf_sum(float m) { return xor32_sum(m); }
__device__ __forceinline__ float max3f(float a, float b, float c) { float r; asm("v_max3_f32 %0, %1, %2, %3" : "=v"(r) : "v"(a), "v"(b), "v"(c)); return r; }
__device__ __forceinline__ float max2f(float a, float b) { float r; asm("v_max_f32_e32 %0, %1, %2" : "=v"(r) : "v"(a), "v"(b)); return r; }
__device__ __forceinline__ float rowmax32(const f32x16& p0, const f32x16& p1) {
    float a = max2f(p0[0], p1[0]), b = max2f(p0[1], p1[1]), c = max2f(p0[2], p1[2]), d = max2f(p0[3], p1[3]);
#pragma unroll
    for (int r = 4; r < 16; r += 4) { a = max3f(a, p0[r], p1[r]); b = max3f(b, p0[r + 1], p1[r + 1]); c = max3f(c, p0[r + 2], p1[r + 2]); d = max3f(d, p0[r + 3], p1[r + 3]); }
    const float m = max2f(max2f(a, b), max2f(c, d));
    float lo_, hi_; halves32(m, lo_, hi_);
    return max2f(lo_, hi_);
}

template <int DQK, bool BAND, int qpitch, int kpitch, int vpitch, int opitch, bool OF8 = false>
__device__ __forceinline__ void attn_unit(ATT_LAS unsigned char* lds, const bf16* Qb, const bf16* Kb, const bf16* Vb, bf16* Ob,
                                          int q0, int t_lo, int t_hi, int my_lo, int my_hi, int cc, const float* bias_g, const float* g_qn, const float* rope, const int wave_idx) {
    typedef Geo<DQK> G;
    int tid_ = wave_idx * 64 + lane_id_(); asm volatile("" : "+v"(tid_));
    const int tid = tid_, lane = tid & 63, r32 = lane & 31, hi = lane >> 5, wid = __builtin_amdgcn_readfirstlane(tid >> 6);
    ATT_LAS float* biasL = (ATT_LAS float*)(lds + 2 * G::KBUF + 2 * G::VBUF);
    bf16x8 qf[DQK / 16];
    { const bf16* qp = Qb + (size_t)(q0 + wid * 32 + r32) * qpitch + 8 * hi;
#pragma unroll
      for (int kk = 0; kk < DQK / 16; ++kk) qf[kk] = *(const bf16x8*)(qp + 16 * kk); }
    if constexpr (!BAND) {
        float qv[DQK / 16][8]; float ss = 0.f;
#pragma unroll
        for (int kk = 0; kk < DQK / 16; ++kk)
#pragma unroll
            for (int j = 0; j < 8; ++j) { qv[kk][j] = __builtin_bit_cast(float, (unsigned)(unsigned short)qf[kk][j] << 16); ss += qv[kk][j] * qv[kk][j]; }
        ss = xhalf_sum(ss);
        const float rs = __builtin_amdgcn_rsqf(ss * (1.f / DQK) + 1e-6f) * (0.10206207261596577f * 1.4426950408889634f);
#pragma unroll
        for (int kk = 0; kk < DQK / 16; ++kk) { const f32x4_t g0 = *(const f32x4_t*)(g_qn + 16 * kk + 8 * hi), g1 = *(const f32x4_t*)(g_qn + 16 * kk + 8 * hi + 4);
#pragma unroll
            for (int j = 0; j < 4; ++j) { qv[kk][j] *= rs * g0[j]; qv[kk][4 + j] *= rs * g1[j]; } }
        const f32x4_t* rp = (const f32x4_t*)(rope + ((size_t)(q0 + wid * 32 + r32) * 16 + 8 * hi) * 2);
#pragma unroll
        for (int j2 = 0; j2 < 4; ++j2) { const f32x4_t cs = rp[j2];
            { const float x1 = qv[4][2 * j2], x2 = qv[5][2 * j2]; qv[4][2 * j2] = x1 * cs[0] - x2 * cs[1]; qv[5][2 * j2] = x2 * cs[0] + x1 * cs[1]; }
            { const float x1 = qv[4][2 * j2 + 1], x2 = qv[5][2 * j2 + 1]; qv[4][2 * j2 + 1] = x1 * cs[2] - x2 * cs[3]; qv[5][2 * j2 + 1] = x2 * cs[2] + x1 * cs[3]; } }
#pragma unroll
        for (int kk = 0; kk < DQK / 16; ++kk) { u32x4 w; w.x = cvtpk(qv[kk][0], qv[kk][1]); w.y = cvtpk(qv[kk][2], qv[kk][3]); w.z = cvtpk(qv[kk][4], qv[kk][5]); w.w = cvtpk(qv[kk][6], qv[kk][7]);
            qf[kk] = __builtin_bit_cast(bf16x8, w); }
    }
    if (BAND) { if (tid < 257) biasL[tid] = bias_g[tid] * 1.4426950408889634f; }
    constexpr int KCPL = G::KSTR / 16, KNP = (64 * KCPL + 63) / 64;
    constexpr int VCPL = VSTR / 16, VNP = 64 * VCPL / 64;
    constexpr int KPP = (KNP + 7) / 8, VPP = (VNP + 7) / 8;
    ATT_LAS unsigned* dmaL = (ATT_LAS unsigned*)(lds + 2 * G::KBUF + 2 * G::VBUF + 2048) + wid * 256 + lane;
#pragma unroll
    for (int pp = 0; pp < KPP; ++pp) { const int pc = wid + 8 * pp, c = pc * 64 + lane, row = (c / KCPL) & 63, ch = c % KCPL; dmaL[64 * pp] = (unsigned)(row * kpitch + (ch < G::CPR ? ch : 0) * 8) * 2u; }
#pragma unroll
    for (int pp = 0; pp < VPP; ++pp) { const int pc = wid + 8 * pp, c = pc * 64 + lane, row = (c / VCPL) & 63, ch = c % VCPL; dmaL[128 + 64 * pp] = (unsigned)(row * vpitch + (ch < 8 ? ch : 0) * 8) * 2u; }
#define ATT_DMA_K(t, b) do { const char* kt_ = (const char*)(Kb + (size_t)(t) * 64 * kpitch); _Pragma("unroll") for (int pp = 0; pp < KPP; ++pp) { if (wid + 8 * pp < KNP) \
            __builtin_amdgcn_global_load_lds((const unsigned*)(kt_ + dmaL[64 * pp]), (ATT_LAS unsigned*)(lds + (b) * G::KBUF + (wid + 8 * pp) * 1024), 16, 0, 0); } } while (0)
#define ATT_DMA_V(t, b) do { const char* vt_ = (const char*)(Vb + (size_t)(t) * 64 * vpitch); _Pragma("unroll") for (int pp = 0; pp < VPP; ++pp) { if (wid + 8 * pp < VNP) \
            __builtin_amdgcn_global_load_lds((const unsigned*)(vt_ + dmaL[128 + 64 * pp]), (ATT_LAS unsigned*)(lds + 2 * G::KBUF + (b) * G::VBUF + (wid + 8 * pp) * 1024), 16, 0, 0); } } while (0)
    f32x16 o0, o1;
#pragma unroll
    for (int i = 0; i < 16; ++i) { o0[i] = 0.f; o1[i] = 0.f; }
    float mrun = -INFINITY, lsum = 0.f;
    const int koff = r32 * G::KSTR + hi * 16;
    const int voff = ((lane >> 5) * 4 + ((lane & 15) >> 2)) * VSTR + (((lane >> 4) & 1) * 16 + (lane & 3) * 4) * 2;
    const f32x16 zero16 = {0.f, 0.f, 0.f, 0.f, 0.f, 0.f, 0.f, 0.f, 0.f, 0.f, 0.f, 0.f, 0.f, 0.f, 0.f, 0.f};
#define ATT_QK(X0, X1, t) do { const ATT_LAS unsigned char* Kt = lds + ((t) & 1) * G::KBUF + koff; \
        _Pragma("unroll") for (int kk = 0; kk < DQK / 16; ++kk) { \
            const bf16x8 a0 = *(const ATT_LAS bf16x8*)(Kt + kk * 32); const bf16x8 a1 = *(const ATT_LAS bf16x8*)(Kt + 32 * G::KSTR + kk * 32); \
            X0 = __builtin_amdgcn_mfma_f32_32x32x16_bf16(a0, qf[kk], kk ? X0 : zero16, 0, 0, 0); X1 = __builtin_amdgcn_mfma_f32_32x32x16_bf16(a1, qf[kk], kk ? X1 : zero16, 0, 0, 0); } } while (0)
#define ATT_SMPV(X0, X1, t) do { \
        float cadd = 0.f; \
        if (BAND) { const int delta = cc - (t); \
            if (delta >= 3) cadd = biasL[256]; \
            else { const ATT_LAS float* bp = biasL + (64 * delta + (32 * (wid & 1) + r32) - 4 * hi + 128 - 63); \
                if (delta < 2) { _Pragma("unroll") for (int i = 0; i < 16; ++i) { const int kj = (i & 3) + 8 * (i >> 2); X0[i] += bp[63 - kj]; X1[i] += bp[31 - kj]; } } \
                else { const int relb = 64 * delta + (32 * (wid & 1) + r32) - 4 * hi + 128; \
                    _Pragma("unroll") for (int i = 0; i < 16; ++i) { const int kj = (i & 3) + 8 * (i >> 2); int i0 = relb - kj, i1 = relb - kj - 32; i0 = i0 > 256 ? 256 : i0; i1 = i1 > 256 ? 256 : i1; \
                        X0[i] += biasL[i0]; X1[i] += biasL[i1]; } } } } \
        const float mt = rowmax32(X0, X1) + cadd; \
        const float mnew = max2f(mrun, mt); \
        const float alpha = __builtin_amdgcn_exp2f(mrun - mnew); \
        const float msub = mnew - cadd; \
        mrun = mnew; \
        float psa[4] = {0.f, 0.f, 0.f, 0.f};   \
        _Pragma("unroll") for (int i = 0; i < 16; ++i) { X0[i] = __builtin_amdgcn_exp2f(X0[i] - msub); X1[i] = __builtin_amdgcn_exp2f(X1[i] - msub); psa[i & 3] += X0[i] + X1[i]; } \
        const float ps = (psa[0] + psa[1]) + (psa[2] + psa[3]); \
        lsum = lsum * alpha + ps; \
        _Pragma("unroll") for (int i = 0; i < 16; ++i) { o0[i] *= alpha; o1[i] *= alpha; } \
        bf16x8 pf[2][2]; \
        _Pragma("unroll") for (int s = 0; s < 2; ++s) { u32x4 w0, w1; \
            w0.x = cvtpk(X0[8 * s + 0], X0[8 * s + 1]); w0.y = cvtpk(X0[8 * s + 2], X0[8 * s + 3]); w0.z = cvtpk(X0[8 * s + 4], X0[8 * s + 5]); w0.w = cvtpk(X0[8 * s + 6], X0[8 * s + 7]); \
            w1.x = cvtpk(X1[8 * s + 0], X1[8 * s + 1]); w1.y = cvtpk(X1[8 * s + 2], X1[8 * s + 3]); w1.z = cvtpk(X1[8 * s + 4], X1[8 * s + 5]); w1.w = cvtpk(X1[8 * s + 6], X1[8 * s + 7]); \
            pf[0][s] = __builtin_bit_cast(bf16x8, w0); pf[1][s] = __builtin_bit_cast(bf16x8, w1); } \
        const ATT_LAS unsigned char* Vt = lds + 2 * G::KBUF + ((t) & 1) * G::VBUF + voff; \
        _Pragma("unroll") for (int kb = 0; kb < 2; ++kb) _Pragma("unroll") for (int s = 0; s < 2; ++s) { \
            const ATT_LAS unsigned char* vp = Vt + (32 * kb + 16 * s) * VSTR; \
            const s16x4 l0 = vtr(vp), h0 = vtr(vp + 8 * VSTR), l1 = vtr(vp + 64), h1 = vtr(vp + 8 * VSTR + 64); \
            const bf16x8 a0 = (bf16x8){l0[0], l0[1], l0[2], l0[3], h0[0], h0[1], h0[2], h0[3]}; \
            const bf16x8 a1 = (bf16x8){l1[0], l1[1], l1[2], l1[3], h1[0], h1[1], h1[2], h1[3]}; \
            o0 = __builtin_amdgcn_mfma_f32_32x32x16_bf16(a0, pf[kb][s], o0, 0, 0, 0); o1 = __builtin_amdgcn_mfma_f32_32x32x16_bf16(a1, pf[kb][s], o1, 0, 0, 0); } } while (0)
#define ATT_FUSED(C0, C1, N0, N1, t, tn) do { \
        bf16x8 kfa[DQK / 16], kfb[DQK / 16]; \
        { const ATT_LAS unsigned char* Kt = lds + ((tn) & 1) * G::KBUF + koff; \
          _Pragma("unroll") for (int kk = 0; kk < DQK / 16; ++kk) { kfa[kk] = *(const ATT_LAS bf16x8*)(Kt + kk * 32); kfb[kk] = *(const ATT_LAS bf16x8*)(Kt + 32 * G::KSTR + kk * 32); } } \
        __builtin_amdgcn_sched_barrier(0); \
        float cadd = 0.f; \
        if (BAND) { const int delta = cc - (t); \
            if (delta >= 3) cadd = biasL[256]; \
            else { const ATT_LAS float* bp = biasL + (64 * delta + (32 * (wid & 1) + r32) - 4 * hi + 128 - 63); \
                if (delta < 2) { _Pragma("unroll") for (int i = 0; i < 16; ++i) { const int kj = (i & 3) + 8 * (i >> 2); C0[i] += bp[63 - kj]; C1[i] += bp[31 - kj]; } } \
                else { const int relb = 64 * delta + (32 * (wid & 1) + r32) - 4 * hi + 128; \
                    _Pragma("unroll") for (int i = 0; i < 16; ++i) { const int kj = (i & 3) + 8 * (i >> 2); int i0 = relb - kj, i1 = relb - kj - 32; i0 = i0 > 256 ? 256 : i0; i1 = i1 > 256 ? 256 : i1; \
                        C0[i] += biasL[i0]; C1[i] += biasL[i1]; } } } } \
        const float mt = rowmax32(C0, C1) + cadd; \
        const float mnew = max2f(mrun, mt); \
        const float alpha = __builtin_amdgcn_exp2f(mrun - mnew); \
        const float msub = mnew - cadd; \
        if (__builtin_amdgcn_ballot_w64(mnew > mrun)) { _Pragma("unroll") for (int i = 0; i < 16; ++i) { o0[i] *= alpha; o1[i] *= alpha; } } \
        mrun = mnew; \
        __builtin_amdgcn_sched_barrier(0); \
        _Pragma("unroll") for (int kk = 0; kk < DQK / 16; ++kk) { \
            N0 = __builtin_amdgcn_mfma_f32_32x32x16_bf16(kfa[kk], qf[kk], kk ? N0 : zero16, 0, 0, 0); N1 = __builtin_amdgcn_mfma_f32_32x32x16_bf16(kfb[kk], qf[kk], kk ? N1 : zero16, 0, 0, 0); } \
        s16x4 vl0[4], vh0[4], vl1[4], vh1[4]; \
        { const ATT_LAS unsigned char* Vt = lds + 2 * G::KBUF + ((t) & 1) * G::VBUF + voff; \
          _Pragma("unroll") for (int ks = 0; ks < 4; ++ks) { const ATT_LAS unsigned char* vp = Vt + 16 * ks * VSTR; vl0[ks] = vtr(vp); vh0[ks] = vtr(vp + 8 * VSTR); vl1[ks] = vtr(vp + 64); vh1[ks] = vtr(vp + 8 * VSTR + 64); } } \
        float psa[4] = {0.f, 0.f, 0.f, 0.f}; \
        _Pragma("unroll") for (int i = 0; i < 16; ++i) { C0[i] = __builtin_amdgcn_exp2f(C0[i] - msub); C1[i] = __builtin_amdgcn_exp2f(C1[i] - msub); psa[i & 3] += C0[i] + C1[i]; } \
        const float ps = (psa[0] + psa[1]) + (psa[2] + psa[3]); \
        lsum = lsum * alpha + ps; \
        bf16x8 pf[4]; \
        _Pragma("unroll") for (int s = 0; s < 2; ++s) { u32x4 w0, w1; \
            w0.x = cvtpk(C0[8 * s + 0], C0[8 * s + 1]); w0.y = cvtpk(C0[8 * s + 2], C0[8 * s + 3]); w0.z = cvtpk(C0[8 * s + 4], C0[8 * s + 5]); w0.w = cvtpk(C0[8 * s + 6], C0[8 * s + 7]); \
            w1.x = cvtpk(C1[8 * s + 0], C1[8 * s + 1]); w1.y = cvtpk(C1[8 * s + 2], C1[8 * s + 3]); w1.z = cvtpk(C1[8 * s + 4], C1[8 * s + 5]); w1.w = cvtpk(C1[8 * s + 6], C1[8 * s + 7]); \
            pf[s] = __builtin_bit_cast(bf16x8, w0); pf[2 + s] = __builtin_bit_cast(bf16x8, w1); } \
        __builtin_amdgcn_sched_barrier(0); \
        _Pragma("unroll") for (int ks = 0; ks < 4; ++ks) { \
            const bf16x8 a0 = (bf16x8){vl0[ks][0], vl0[ks][1], vl0[ks][2], vl0[ks][3], vh0[ks][0], vh0[ks][1], vh0[ks][2], vh0[ks][3]}; \
            const bf16x8 a1 = (bf16x8){vl1[ks][0], vl1[ks][1], vl1[ks][2], vl1[ks][3], vh1[ks][0], vh1[ks][1], vh1[ks][2], vh1[ks][3]}; \
            o0 = __builtin_amdgcn_mfma_f32_32x32x16_bf16(a0, pf[ks], o0, 0, 0, 0); o1 = __builtin_amdgcn_mfma_f32_32x32x16_bf16(a1, pf[ks], o1, 0, 0, 0); } } while (0)
#define ATT_STAGE(t) do { if ((t) + 2 <= t_hi) ATT_DMA_K((t) + 2, (t) & 1); if ((t) + 1 <= t_hi) ATT_DMA_V((t) + 1, ((t) + 1) & 1); } while (0)
    f32x16 sa0, sa1, sb0, sb1;
    ATT_DMA_K(t_lo, t_lo & 1);
    __syncthreads();
    if (t_lo + 1 <= t_hi) ATT_DMA_K(t_lo + 1, (t_lo + 1) & 1);
    ATT_DMA_V(t_lo, t_lo & 1);
    if (my_lo == t_lo) ATT_QK(sa0, sa1, t_lo);
    __syncthreads();
    {
        int t = t_lo;
        for (; t < my_lo - 1; ++t) { ATT_STAGE(t); __syncthreads(); }
        if (my_lo > t_lo) { ATT_STAGE(t); ATT_QK(sa0, sa1, t + 1); __syncthreads(); ++t; }
        int nf = my_hi - my_lo;
        for (; nf >= 2; nf -= 2, t += 2) {
            ATT_STAGE(t); ATT_FUSED(sa0, sa1, sb0, sb1, t, t + 1); __syncthreads();
            ATT_STAGE(t + 1); ATT_FUSED(sb0, sb1, sa0, sa1, t + 1, t + 2); __syncthreads();
        }
        if (nf == 1) {
            ATT_STAGE(t); ATT_FUSED(sa0, sa1, sb0, sb1, t, t + 1); __syncthreads(); ++t;
            ATT_STAGE(t); ATT_SMPV(sb0, sb1, t); __syncthreads(); ++t;
        } else {
            ATT_STAGE(t); ATT_SMPV(sa0, sa1, t); __syncthreads(); ++t;
        }
        for (; t <= t_hi; ++t) { ATT_STAGE(t); __syncthreads(); }
    }
    const float ltot = xhalf_sum(lsum);
    const float inv = 1.f / ltot;
    if constexpr (OF8) {
        unsigned char* op = (unsigned char*)Ob + (size_t)(q0 + wid * 32 + r32) * opitch + 4 * hi; const float i64 = inv * 64.f;
#pragma unroll
        for (int g4 = 0; g4 < 4; ++g4) {
            int w0 = 0, w1 = 0;
            w0 = __builtin_amdgcn_cvt_pk_fp8_f32(o0[4 * g4 + 0] * i64, o0[4 * g4 + 1] * i64, w0, false); w0 = __builtin_amdgcn_cvt_pk_fp8_f32(o0[4 * g4 + 2] * i64, o0[4 * g4 + 3] * i64, w0, true);
            w1 = __builtin_amdgcn_cvt_pk_fp8_f32(o1[4 * g4 + 0] * i64, o1[4 * g4 + 1] * i64, w1, false); w1 = __builtin_amdgcn_cvt_pk_fp8_f32(o1[4 * g4 + 2] * i64, o1[4 * g4 + 3] * i64, w1, true);
            *(int*)(op + 8 * g4) = w0; *(int*)(op + 32 + 8 * g4) = w1;
        }
    } else {
    bf16* op = Ob + (size_t)(q0 + wid * 32 + r32) * opitch + 4 * hi;
#pragma unroll
    for (int g4 = 0; g4 < 4; ++g4) {
        u32x2 w0, w1;
        w0.x = cvtpk(o0[4 * g4 + 0] * inv, o0[4 * g4 + 1] * inv); w0.y = cvtpk(o0[4 * g4 + 2] * inv, o0[4 * g4 + 3] * inv);
        w1.x = cvtpk(o1[4 * g4 + 0] * inv, o1[4 * g4 + 1] * inv); w1.y = cvtpk(o1[4 * g4 + 2] * inv, o1[4 * g4 + 3] * inv);
        *(u32x2*)(op + 8 * g4) = w0; *(u32x2*)(op + 32 + 8 * g4) = w1;
    }
    }
#undef ATT_DMA_K
#undef ATT_DMA_V
#undef ATT_QK
#undef ATT_SMPV
#undef ATT_STAGE
#undef ATT_FUSED
}
}
constexpr int NWAVES = 8;
constexpr int D = 1024, BATCH = 32, SEQ = 2048, M = BATCH * SEQ;
constexpr int NH = 16, QLORA = 384, KVLORA = 256, ROPE_D = 32, NOPE = 64, QKD = 96;
constexpr int NA = 768;
constexpr int FF = 2816, EFF = 3584, NE = 8;
constexpr float EPS = 1e-6f, LOG2E = 1.4426950408889634f;
constexpr int MAXP_HALF = 264, MAXP = 528;
constexpr size_t MiB = 1u << 20;
constexpr size_t WS_CTL = 0, CTL_ZERO_BYTES = 1 * MiB;
constexpr size_t WS_ROPE = 1 * MiB;
constexpr size_t WS_CNT = WS_ROPE + 256 * 1024;
constexpr size_t WS_PANELE = WS_CNT + 16 * 1024;
constexpr size_t WS_META = WS_PANELE + 4096;
constexpr size_t WS_TOKE = 2 * MiB;
constexpr size_t WS_TOKG = WS_TOKE + (size_t)M * 4;
constexpr size_t WS_SLOTTOK = WS_TOKG + (size_t)M * 8;
constexpr size_t WS_SLOTGATE = WS_SLOTTOK + (size_t)MAXP * 256 * 4;
constexpr size_t WS_PARTQA = 976 * MiB, WS_PART1 = 980 * MiB, WS_PART2 = 984 * MiB;
constexpr size_t WS_TOKRSTD = 4 * MiB;
constexpr size_t WS_SLOTRSTD = WS_TOKRSTD + (size_t)M * 4;
static_assert(WS_SLOTGATE + (size_t)MAXP * 256 * 4 <= WS_TOKRSTD && WS_SLOTRSTD + (size_t)MAXP * 256 * 4 <= 8 * MiB, "small arrays");
constexpr size_t WS_W = 8 * MiB;
constexpr size_t WS_WA = WS_W, WS_WUQ = WS_WA + (size_t)NA * D * 2, WS_WUKV = WS_WUQ + (size_t)1536 * QLORA * 2, WS_WO = WS_WUKV + (size_t)2048 * KVLORA * 2;
constexpr size_t WS_WF1 = WS_WO + (size_t)D * D * 2, WS_WF2 = WS_WF1 + (size_t)2 * FF * D * 2, WS_WKVQ = WS_WF2 + (size_t)D * FF * 2, WS_WBO = WS_WKVQ + (size_t)3 * D * D * 2;
constexpr size_t WS_WM1 = WS_WBO + (size_t)D * D * 2, WS_WM2 = WS_WM1 + (size_t)NE * 2 * EFF * D * 2, WS_WEND = WS_WM2 + (size_t)NE * D * EFF * 2;
constexpr size_t ARENA = 208 * MiB;
static_assert(WS_WEND <= ARENA, "weights fit under the arena");
constexpr size_t WS_XN = ARENA;
constexpr size_t WS_QA = ARENA + 128 * MiB;
constexpr size_t WS_Q = ARENA + 224 * MiB;
constexpr size_t WS_K = ARENA + 416 * MiB;
constexpr size_t WS_V = ARENA + 608 * MiB;
constexpr size_t WS_O = ARENA;
static_assert(WS_V + (size_t)M * D * 2 <= 1024 * MiB, "MLA arena");
constexpr size_t WS_XR1 = ARENA + 128 * MiB;
constexpr size_t WS_H = ARENA + 256 * MiB;
constexpr size_t WS_XR2 = ARENA;
constexpr size_t WS_KVQ2 = ARENA + 128 * MiB;
constexpr size_t WS_O2 = ARENA + 512 * MiB;
constexpr size_t WS_XR3 = ARENA + 640 * MiB;
constexpr size_t WS_XG = ARENA;
constexpr size_t WS_HM = ARENA + 264 * MiB;
constexpr size_t WS_END = WS_HM + (size_t)MAXP_HALF * 256 * EFF * 2;
static_assert(WS_XG + (size_t)MAXP * 256 * D * 2 <= WS_HM && WS_END <= 1024 * MiB && WS_XR3 + (size_t)M * D * 2 <= 1024 * MiB && WS_H + (size_t)M * FF * 2 <= 1024 * MiB, "arena");
constexpr int CW_BAR = 4096;
constexpr int RING_OFF = 0, RING_BYTES = 131072;
constexpr int P0_SCR = 128 * 33 * 4;
constexpr int LDSCTL_OFF = 8 * P0_SCR, MISC_OFF = LDSCTL_OFF + 320;
static_assert(LDSCTL_OFF >= RING_BYTES, "control words above every phase's scratch");
constexpr int LDS_BYTES = 147456;
static_assert(MISC_OFF + 128 <= LDS_BYTES, "LDS map");
static_assert(att::lds_bytes<96>() <= RING_BYTES, "attention scratch fits the ring region");

#define GAS __attribute__((address_space(1)))
#define LAS __attribute__((address_space(3)))
typedef unsigned short bf16;
typedef unsigned v4u __attribute__((ext_vector_type(4)));
typedef unsigned v2u __attribute__((ext_vector_type(2)));
typedef float f32x4 __attribute__((ext_vector_type(4)));
typedef GAS unsigned gu32;
#define RLX_AGENT __ATOMIC_RELAXED, __HIP_MEMORY_SCOPE_AGENT
#define LDS_WAIT() asm volatile("s_waitcnt lgkmcnt(0)" ::: "memory")
__device__ __forceinline__ unsigned f2bf(float f) { unsigned u = __builtin_bit_cast(unsigned, f); return (u + 0x7fffu + ((u >> 16) & 1u)) >> 16; }
__device__ __forceinline__ unsigned pk2(float lo, float hi) { return f2bf(lo) | (f2bf(hi) << 16); }
__device__ __forceinline__ float bflo(unsigned u) { return __builtin_bit_cast(float, u << 16); }
__device__ __forceinline__ float bfhi(unsigned u) { return __builtin_bit_cast(float, u & 0xffff0000u); }
__device__ __forceinline__ float wave_sum(float v) {
    v += swz_xor<1>(v); v += swz_xor<2>(v); v += swz_xor<4>(v); v += swz_xor<8>(v); v += swz_xor<16>(v);
    return xor32_sum(v);
}

#define XB_TMO      128
#define XB_XCNT(j)  (256  + 64 * (j))
#define XB_XSUB(j)  (1280 + 64 * (j))
#define XB_XGEN(j)  (2304 + 64 * (j))
#define XB_TOP      3328
#define XB_TOPGEN   3392
#define XCD_BAR_WORDS 3456
#define XB_SPIN_CAP (1u << 18)

__device__ __forceinline__ unsigned xb_ld(unsigned* p)              { return __hip_atomic_load(p, __ATOMIC_RELAXED, __HIP_MEMORY_SCOPE_AGENT); }
__device__ __forceinline__ unsigned xb_add(unsigned* p, unsigned v) { return __hip_atomic_fetch_add(p, v, __ATOMIC_RELAXED, __HIP_MEMORY_SCOPE_AGENT); }
__device__ __forceinline__ unsigned xb_xcc_id() { return (unsigned)__builtin_amdgcn_s_getreg((3 << 11) | 20) & 0xFu; }
#define XB_SPIN(cond, bar) do { unsigned _sp = 0; while (cond) { __builtin_amdgcn_s_sleep(1); \
    if ((++_sp & 255u) == 0u) { if (xb_ld(&(bar)[XB_TMO])) break; if (_sp > XB_SPIN_CAP) { atomicAdd(&(bar)[XB_TMO], 1u); break; } } } } while (0)

struct XcdBarrier {
    int t0;
    unsigned* bar; unsigned x;
    volatile LAS unsigned* st;
};

__device__ __forceinline__ XcdBarrier xcd_barrier_post(unsigned* bar, volatile LAS unsigned* st, int t0) {
    XcdBarrier b; b.t0 = t0; b.bar = bar; b.x = xb_xcc_id(); b.st = st;
    if (b.t0) (void)xb_add(&bar[XB_XCNT(b.x)], 1u);
    return b;
}
__device__ __forceinline__ void xcd_barrier_complete(unsigned* bar, unsigned x, unsigned& nloc, unsigned& nx) {
    const unsigned G = gridDim.x * gridDim.y * gridDim.z;
    unsigned sum, cnt, mine, sp = 0u;
    for (;;) {
        sum = 0u; cnt = 0u; mine = 0u;
#pragma unroll
        for (unsigned j = 0; j < 16; ++j) { const unsigned c = xb_ld(&bar[XB_XCNT(j)]); sum += c; cnt += (c > 0u) ? 1u : 0u; mine = (j == x) ? c : mine; }
        if (sum == G) break;
        __builtin_amdgcn_s_sleep(1);
        if ((++sp & 255u) == 0u) { if (xb_ld(&bar[XB_TMO])) break; if (sp > XB_SPIN_CAP) { atomicAdd(&bar[XB_TMO], 1u); break; } }
    }
    nloc = mine > 0u ? mine : 1u; nx = cnt > 0u ? cnt : 1u;
}

__device__ __forceinline__ void xcd_barrier(const XcdBarrier& b) {
    asm volatile("s_waitcnt vmcnt(0)" ::: "memory");
    __syncthreads();
    if (b.t0) {
        unsigned* bar = b.bar;
        __builtin_amdgcn_s_waitcnt(0);
        unsigned nloc = b.st[0], nx = b.st[1];
        if (nloc == 0u) { xcd_barrier_complete(bar, b.x, nloc, nx); b.st[0] = nloc; b.st[1] = nx; }
        const unsigned old = xb_add(&bar[XB_XSUB(b.x)], 1u);
        const unsigned gen = old / nloc;
        if (old + 1u == (gen + 1u) * nloc) {
            __builtin_amdgcn_fence(__ATOMIC_RELEASE, "agent");
            asm volatile("s_waitcnt vmcnt(0)" ::: "memory");
            const unsigned og = xb_add(&bar[XB_TOP], 1u);
            const unsigned tg = og / nx;
            if (og + 1u == (tg + 1u) * nx) xb_add(&bar[XB_TOPGEN], 1u);
            else XB_SPIN(xb_ld(&bar[XB_TOPGEN]) == tg, bar);
            __builtin_amdgcn_fence(__ATOMIC_ACQUIRE, "agent");
            xb_add(&bar[XB_XGEN(b.x)], 1u);
            asm volatile("s_waitcnt vmcnt(0)" ::: "memory");
        } else {
            XB_SPIN(xb_ld(&bar[XB_XGEN(b.x)]) == gen, bar);
            __builtin_amdgcn_fence(__ATOMIC_ACQUIRE, "agent");
            asm volatile("s_waitcnt vmcnt(0)" ::: "memory");
        }
    }
    __syncthreads();
}

struct Args { const float* in[27]; float* out; unsigned char* ws; };
enum { I_X = 0, I_ATTN_NORM, I_FFN_NORM, I_A_WDQ, I_A_GCQ, I_A_WUQ, I_A_WDKV, I_A_GCKV, I_A_WUKV, I_A_GQN, I_A_GKN, I_A_WO, I_KV_NORM, I_KV_WK, I_KV_WV, I_KV_GKN,
       I_B_WQ, I_B_GQN, I_B_RELB, I_B_WO, I_FFN_W1, I_FFN_W3, I_FFN_W2, I_MOE_ROUTER, I_MOE_W1, I_MOE_W3, I_MOE_W2 };

struct Frame {
    LAS unsigned char* lds;
    int wave, vcu, G;
};
typedef const __attribute__((address_space(4))) Args* KArgs;
__device__ __forceinline__ KArgs kargs() { KArgs p = (KArgs)__builtin_amdgcn_kernarg_segment_ptr(); asm volatile("" : "+s"(p)); return p; }
#define INP(i) (kargs()->in[i])
#define OUTP (kargs()->out)
#define WSP (kargs()->ws)
__device__ __forceinline__ int fresh(int v) { asm volatile("" : "+v"(v)); return v; }

__device__ __forceinline__ void tr_item(const float* W, int ldw, int K, int k0, int nsrc0, const float* gain, bf16* WT, int drow0, LAS float* scr, int lane) {
    const int c4 = lane & 7, r = lane >> 3;
    const GAS float* src = (const GAS float*)W + (size_t)(k0 + r) * ldw + nsrc0 + 4 * c4;
    f32x4 v[16];
#pragma unroll
    for (int i = 0; i < 16; ++i) v[i] = *(const GAS f32x4*)(src + (size_t)(8 * i) * ldw);
    if (gain) {
#pragma unroll
        for (int i = 0; i < 16; ++i) v[i] = v[i] * gain[k0 + 8 * i + r];
    }
#pragma unroll
    for (int i = 0; i < 16; ++i) { LAS float* d = scr + (8 * i + r) * 33 + 4 * c4; d[0] = v[i].x; d[1] = v[i].y; d[2] = v[i].z; d[3] = v[i].w; }
    LDS_WAIT(); asm volatile("" ::: "memory");
    const int c16 = lane >> 2;
#pragma unroll
    for (int j = 0; j < 8; ++j) { const int n = (lane & 3) + 4 * j; const LAS float* sp = scr + (8 * c16) * 33 + n;
        v4u o; o.x = pk2(sp[0 * 33], sp[1 * 33]); o.y = pk2(sp[2 * 33], sp[3 * 33]); o.z = pk2(sp[4 * 33], sp[5 * 33]); o.w = pk2(sp[6 * 33], sp[7 * 33]);
        *(GAS v4u*)(WT + (size_t)(drow0 + n) * K + k0 + 8 * c16) = o; }
    LDS_WAIT(); asm volatile("" ::: "memory");
}
__device__ __forceinline__ void tr_plain(const float* W, int K, int N, const float* gain, bf16* WT, int drow_off, LAS float* scr, int item, int lane) {
    const int nblk = N / 32, kb = item / nblk, nb = item % nblk;
    tr_item(W, N, K, 128 * kb, 32 * nb, gain, WT, drow_off + 32 * nb, scr, lane);
}
__device__ __forceinline__ void tr_gated(const float* W, int K, int N, const float* gain, bf16* WT, int half, LAS float* scr, int item, int lane) {
    const int nblk = N / 32, kb = item / nblk, nb = item % nblk, n0 = 32 * nb;
    tr_item(W, N, K, 128 * kb, n0, gain, WT, (n0 >> 7) * 256 + half * 128 + (n0 & 127), scr, lane);
}
__device__ __forceinline__ unsigned pk_fp8x4(float a, float b, float c, float d) { int w = 0; w = __builtin_amdgcn_cvt_pk_fp8_f32(a, b, w, false); w = __builtin_amdgcn_cvt_pk_fp8_f32(c, d, w, true); return (unsigned)w; }
__device__ __forceinline__ void tr_item_f8(const float* W, int ldw, int K, int k0, int nsrc0, const float* gain, unsigned char* WT, int drow0, LAS float* scr, int lane) {
    const int c4 = lane & 7, r = lane >> 3;
    const GAS float* src = (const GAS float*)W + (size_t)(k0 + r) * ldw + nsrc0 + 4 * c4;
    f32x4 v[16];
#pragma unroll
    for (int i = 0; i < 16; ++i) v[i] = *(const GAS f32x4*)(src + (size_t)(8 * i) * ldw);
#pragma unroll
    for (int i = 0; i < 16; ++i) v[i] = v[i] * (gain ? gain[k0 + 8 * i + r] * 64.f : 64.f);
#pragma unroll
    for (int i = 0; i < 16; ++i) { LAS float* d = scr + (8 * i + r) * 33 + 4 * c4; d[0] = v[i].x; d[1] = v[i].y; d[2] = v[i].z; d[3] = v[i].w; }
    LDS_WAIT(); asm volatile("" ::: "memory");
    const int c8 = lane >> 3;
#pragma unroll
    for (int j = 0; j < 4; ++j) { const int n = (lane & 7) + 8 * j; const LAS float* sp = scr + (16 * c8) * 33 + n;
        v4u o; o.x = pk_fp8x4(sp[0 * 33], sp[1 * 33], sp[2 * 33], sp[3 * 33]); o.y = pk_fp8x4(sp[4 * 33], sp[5 * 33], sp[6 * 33], sp[7 * 33]);
        o.z = pk_fp8x4(sp[8 * 33], sp[9 * 33], sp[10 * 33], sp[11 * 33]); o.w = pk_fp8x4(sp[12 * 33], sp[13 * 33], sp[14 * 33], sp[15 * 33]);
        *(GAS v4u*)(WT + (size_t)(drow0 + n) * K + k0 + 16 * c8) = o; }
    LDS_WAIT(); asm volatile("" ::: "memory");
}
__device__ __forceinline__ float rms_row_to_bf16(const float* xrow, bf16* orow, int lane, f32x4 (&v)[4]) {
    const GAS f32x4* xr = (const GAS f32x4*)xrow + lane;
    float s = 0.f;
#pragma unroll
    for (int j = 0; j < 4; ++j) { v[j] = xr[64 * j]; s += (v[j].x * v[j].x + v[j].y * v[j].y) + (v[j].z * v[j].z + v[j].w * v[j].w); }
    const float rstd = 1.f / sqrtf(wave_sum(s) * (1.f / D) + EPS);
    GAS unsigned long long* o8 = (GAS unsigned long long*)orow + lane;
#pragma unroll
    for (int j = 0; j < 4; ++j) o8[64 * j] = (unsigned long long)pk2(v[j].x * rstd, v[j].y * rstd) | ((unsigned long long)pk2(v[j].z * rstd, v[j].w * rstd) << 32);
    return rstd;
}
__device__ __forceinline__ void norm_phase(const Frame& F, const float* x, bf16* xn) {
    const int tid = fresh(F.wave * 64 + lane_id_()), lane = tid & 63; (void)lane;
    const int gw = F.vcu * NWAVES + F.wave, NGW = F.G * NWAVES;
    for (int m = 2 * gw; m < M; m += 2 * NGW) {
        const GAS f32x4* xr = (const GAS f32x4*)(x + (size_t)m * D) + lane;
        f32x4 v[8]; float s0 = 0.f, s1 = 0.f;
#pragma unroll
        for (int j = 0; j < 8; ++j) v[j] = xr[64 * j];
#pragma unroll
        for (int j = 0; j < 4; ++j) { s0 += (v[j].x * v[j].x + v[j].y * v[j].y) + (v[j].z * v[j].z + v[j].w * v[j].w); s1 += (v[4 + j].x * v[4 + j].x + v[4 + j].y * v[4 + j].y) + (v[4 + j].z * v[4 + j].z + v[4 + j].w * v[4 + j].w); }
        const float r0 = 1.f / sqrtf(wave_sum(s0) * (1.f / D) + EPS), r1 = 1.f / sqrtf(wave_sum(s1) * (1.f / D) + EPS);
        GAS unsigned* o4 = (GAS unsigned*)((GAS unsigned char*)xn + (size_t)m * D) + lane;
#pragma unroll
        for (int j = 0; j < 8; ++j) { const float rr = j < 4 ? r0 : r1; o4[64 * j] = pk_fp8x4(v[j].x * rr, v[j].y * rr, v[j].z * rr, v[j].w * rr); }
    }
}

__device__ __forceinline__ void p0_prologue(const Frame& F) {
    const int tid = fresh(F.wave * 64 + lane_id_()), lane = tid & 63; (void)lane;
    LAS float* scr = (LAS float*)(F.lds + RING_OFF + F.wave * P0_SCR);
    unsigned char* ws = WSP;
    const int gw = F.vcu * NWAVES + F.wave, NGW = F.G * NWAVES;
    constexpr int I_DQ = 8 * 12, I_DKV = 8 * 9, I_UQ = 3 * 48, I_UKV = 2 * 64, I_SQ = 8 * 32, I_F13 = 8 * 88, I_F2 = 22 * 32, I_M13 = 8 * 112, I_M2 = 28 * 32;
    constexpr int NSMALL = I_DQ + I_DKV + I_UQ + I_UKV + I_SQ + 2 * I_F13 + I_F2 + 4 * I_SQ;
    constexpr int NITEMS = NSMALL + NE * (2 * I_M13 + I_M2);
    for (int it = gw; it < NITEMS; it += NGW) {
        int r = it;
        if (r < I_DQ)  { const int kb = r / 12, n0 = 32 * (r % 12); tr_item_f8(INP(I_A_WDQ), QLORA, D, 128 * kb, n0, INP(I_ATTN_NORM), ws + WS_WA, n0, scr, lane); continue; } r -= I_DQ;
        if (r < I_DKV) { const int kb = r / 9, n0 = 32 * (r % 9); tr_item_f8(INP(I_A_WDKV), KVLORA + ROPE_D, D, 128 * kb, n0, INP(I_ATTN_NORM), ws + WS_WA, QLORA + n0, scr, lane); continue; } r -= I_DKV;
        if (r < I_UQ)  { tr_plain(INP(I_A_WUQ), QLORA, NH * QKD, INP(I_A_GCQ), (bf16*)(ws + WS_WUQ), 0, scr, r, lane); continue; } r -= I_UQ;
        if (r < I_UKV) { const int kb = r / 64, n0 = 32 * (r % 64), head = n0 >> 7, within = n0 & 127;
            const int drow = within < 64 ? 256 * (head >> 2) + 128 * (within >> 5) + 32 * (head & 3) : 1024 + head * 64 + (within - 64);
            tr_item(INP(I_A_WUKV), NH * 128, KVLORA, 128 * kb, n0, INP(I_A_GCKV), (bf16*)(ws + WS_WUKV), drow, scr, lane); continue; } r -= I_UKV;
        if (r < I_SQ)  { const int kb = r / 32, n0 = 32 * (r % 32); tr_item_f8(INP(I_A_WO), D, D, 128 * kb, n0, nullptr, ws + WS_WO, n0, scr, lane); continue; } r -= I_SQ;
        if (r < I_F13) { tr_gated(INP(I_FFN_W1), D, FF, INP(I_FFN_NORM), (bf16*)(ws + WS_WF1), 0, scr, r, lane); continue; } r -= I_F13;
        if (r < I_F13) { tr_gated(INP(I_FFN_W3), D, FF, INP(I_FFN_NORM), (bf16*)(ws + WS_WF1), 1, scr, r, lane); continue; } r -= I_F13;
        if (r < I_F2)  { tr_plain(INP(I_FFN_W2), FF, D, nullptr, (bf16*)(ws + WS_WF2), 0, scr, r, lane); continue; } r -= I_F2;
        if (r < I_SQ)  { const int kb = r / 32, n0 = 32 * (r % 32), head = n0 >> 6;
            tr_item_f8(INP(I_KV_WK), D, D, 128 * kb, n0, INP(I_KV_NORM), ws + WS_WKVQ, 256 * (head >> 2) + 128 * ((n0 >> 5) & 1) + 32 * (head & 3), scr, lane); continue; } r -= I_SQ;
        if (r < I_SQ)  { const int kb = r / 32, n0 = 32 * (r % 32); tr_item_f8(INP(I_KV_WV), D, D, 128 * kb, n0, INP(I_KV_NORM), ws + WS_WKVQ, 2 * D + n0, scr, lane); continue; } r -= I_SQ;
        if (r < I_SQ)  { const int kb = r / 32, n0 = 32 * (r % 32), head = n0 >> 6;
            tr_item_f8(INP(I_B_WQ), D, D, 128 * kb, n0, INP(I_ATTN_NORM) + D, ws + WS_WKVQ, D + 256 * (head >> 2) + 128 * ((n0 >> 5) & 1) + 32 * (head & 3), scr, lane); continue; } r -= I_SQ;
        if (r < I_SQ)  { const int kb = r / 32, n0 = 32 * (r % 32); tr_item_f8(INP(I_B_WO), D, D, 128 * kb, n0, nullptr, ws + WS_WBO, n0, scr, lane); continue; } r -= I_SQ;
        const int e = r / (2 * I_M13 + I_M2); r -= e * (2 * I_M13 + I_M2);
        if (r < I_M13) { const int kb = r / 112, n0 = 32 * (r % 112);
            tr_item_f8(INP(I_MOE_W1) + (size_t)e * D * EFF, EFF, D, 128 * kb, n0, INP(I_FFN_NORM) + D, ws + WS_WM1 + (size_t)e * 2 * EFF * D, (n0 >> 7) * 256 + (n0 & 127), scr, lane); continue; } r -= I_M13;
        if (r < I_M13) { const int kb = r / 112, n0 = 32 * (r % 112);
            tr_item_f8(INP(I_MOE_W3) + (size_t)e * D * EFF, EFF, D, 128 * kb, n0, INP(I_FFN_NORM) + D, ws + WS_WM1 + (size_t)e * 2 * EFF * D, (n0 >> 7) * 256 + 128 + (n0 & 127), scr, lane); continue; } r -= I_M13;
        { const int kb = r / 32, n0 = 32 * (r % 32); tr_item_f8(INP(I_MOE_W2) + (size_t)e * EFF * D, D, EFF, 128 * kb, n0, nullptr, ws + WS_WM2 + (size_t)e * D * EFF, n0, scr, lane); }
    }
    const int gt = F.vcu * (NWAVES * 64) + tid, NGT = F.G * NWAVES * 64;
    for (int c = gt; c < 96 * D / 16; c += NGT) *((GAS v4u*)(ws + WS_WA + (size_t)(QLORA + KVLORA + ROPE_D) * D) + c) = (v4u){0u, 0u, 0u, 0u};
    for (int c = gt; c < SEQ * 16; c += NGT) { const int pos = c >> 4, i = c & 15;
        const float inv = __builtin_amdgcn_exp2f(-(float)i * (13.287712379549449f / 16.f));
        const float rev = (float)pos * inv * 0.15915494309189535f; const float fr = rev - floorf(rev);
        ((GAS float*)(ws + WS_ROPE))[2 * c] = __builtin_amdgcn_cosf(fr); ((GAS float*)(ws + WS_ROPE))[2 * c + 1] = __builtin_amdgcn_sinf(fr); }
    norm_phase(F, INP(I_X), (bf16*)(ws + WS_XN));
}

__device__ __forceinline__ void route_phase(const Frame& F) {
    const int tid = fresh(F.wave * 64 + lane_id_()), lane = tid & 63;
    unsigned char* ws = WSP;
    LAS float* wrg = (LAS float*)(F.lds + RING_OFF);
    LAS int* cnt = (LAS int*)(F.lds + RING_OFF + 32768);
    const float* wr = INP(I_MOE_ROUTER); const float* g = INP(I_FFN_NORM) + D;
    for (int idx = tid; idx < D * NE; idx += NWAVES * 64) { const int k = idx >> 3, e = idx & 7, j = k >> 8, l = (k & 255) >> 2, q = k & 3;
        wrg[((j * 4 + q) * 2 + (e >> 2)) * 256 + 4 * l + (e & 3)] = wr[idx] * g[k]; }
    __syncthreads();
    const int b5 = (lane >> 5) & 1, b4 = (lane >> 4) & 1, b3 = (lane >> 3) & 1;
    for (int c = F.vcu; c < M / 256; c += F.G) {
        if (tid < 16) cnt[tid] = 0;
        __syncthreads();
        for (int i = 0; i < 32; ++i) {
            const int m = c * 256 + F.wave * 32 + i;
            f32x4 v[4]; float ssx = 0.f;
            { const GAS f32x4* xr = (const GAS f32x4*)(OUTP + (size_t)m * D) + lane;
#pragma unroll
              for (int j = 0; j < 4; ++j) v[j] = xr[64 * j];
#pragma unroll
              for (int j = 0; j < 4; ++j) ssx += (v[j].x * v[j].x + v[j].y * v[j].y) + (v[j].z * v[j].z + v[j].w * v[j].w); }
            float lg[8];
#pragma unroll
            for (int e = 0; e < 8; ++e) lg[e] = 0.f;
#pragma unroll
            for (int j = 0; j < 4; ++j)
#pragma unroll
                for (int q = 0; q < 4; ++q) { const float xv = v[j][q];
                    const f32x4 w0 = *(const LAS f32x4*)(wrg + ((j * 4 + q) * 2) * 256 + 4 * lane), w1 = *(const LAS f32x4*)(wrg + ((j * 4 + q) * 2 + 1) * 256 + 4 * lane);
                    lg[0] += xv * w0.x; lg[1] += xv * w0.y; lg[2] += xv * w0.z; lg[3] += xv * w0.w; lg[4] += xv * w1.x; lg[5] += xv * w1.y; lg[6] += xv * w1.z; lg[7] += xv * w1.w; }
            float r4[4], r2[2], r1;
#pragma unroll
            for (int e = 0; e < 4; ++e) { const float mine = b5 ? lg[4 + e] : lg[e], other = b5 ? lg[e] : lg[4 + e]; r4[e] = mine + xor32_partner(other, b5); }
#pragma unroll
            for (int e = 0; e < 2; ++e) { const float mine = b4 ? r4[2 + e] : r4[e], other = b4 ? r4[e] : r4[2 + e]; r2[e] = mine + swz_xor<16>(other); }
            { const float mine = b3 ? r2[1] : r2[0], other = b3 ? r2[0] : r2[1]; r1 = mine + swz_xor<8>(other); }
            r1 += swz_xor<4>(r1); r1 += swz_xor<2>(r1); r1 += swz_xor<1>(r1);
            const float rstd = 1.f / sqrtf(wave_sum(ssx) * (1.f / D) + EPS);
#pragma unroll
            for (int e = 0; e < 8; ++e) lg[e] = __builtin_bit_cast(float, __builtin_amdgcn_readlane(__builtin_bit_cast(int, r1), 8 * e)) * rstd;
            int e1 = 0; float l1 = lg[0];
#pragma unroll
            for (int e = 1; e < 8; ++e) if (lg[e] > l1) { l1 = lg[e]; e1 = e; }
            int e2 = -1; float l2 = -INFINITY;
#pragma unroll
            for (int e = 0; e < 8; ++e) if (e != e1 && lg[e] > l2) { l2 = lg[e]; e2 = e; }
            const float g1 = 1.f / (1.f + __expf(l2 - l1)), g2 = 1.f - g1;
            const int elo = e1 < e2 ? e1 : e2, ehi = e1 < e2 ? e2 : e1;
            const float glo = e1 < e2 ? g1 : g2, ghi = e1 < e2 ? g2 : g1;
            if (lane == 0) { ((GAS float*)(ws + WS_TOKRSTD))[m] = rstd; ((GAS int*)(ws + WS_TOKE))[m] = elo | (ehi << 8); ((GAS float*)(ws + WS_TOKG))[2 * m] = glo; ((GAS float*)(ws + WS_TOKG))[2 * m + 1] = ghi;
                atomicAdd((int*)&cnt[elo], 1); atomicAdd((int*)&cnt[8 + ehi], 1); }
        }
        __syncthreads();
        if (tid < 16) ((GAS int*)(ws + WS_CNT))[c * 16 + tid] = cnt[tid];
        __syncthreads();
    }
}

__device__ __forceinline__ void slot_phase(const Frame& F, unsigned char* ws) {
    const int tid = fresh(F.wave * 64 + lane_id_()), lane = tid & 63; (void)lane;
    LAS int* call = (LAS int*)(F.lds + RING_OFF);
    LAS int* tot = call + 4096; LAS int* base = tot + 16; LAS int* pre = base + 16; LAS int* meta = pre + 16;
    LAS int* grp = meta + 16;
    LAS int* slot_of = grp + 512;
    for (int idx = tid; idx < 4096; idx += NWAVES * 64) call[idx] = ((const GAS int*)(ws + WS_CNT))[idx];
    __syncthreads();
    if (tid < 16) { int t = 0; for (int cc = 0; cc < 256; ++cc) t += call[cc * 16 + tid]; tot[tid] = t; }
    __syncthreads();
    if (tid == 0) { int off = 0; for (int g = 0; g < 16; ++g) { base[g] = off; off += (tot[g] + 255) & ~255; if (g == 7) meta[0] = off >> 8; } meta[1] = (off >> 8) - meta[0]; }
    __syncthreads();
    for (int c = F.vcu; c < M / 256; c += F.G) {
        if (tid < 16) { int p = 0; for (int cc = 0; cc < c; ++cc) p += call[cc * 16 + tid]; pre[tid] = p; }
        const int hf = tid >> 8, i = tid & 255, m = c * 256 + i;
        const int te = ((const GAS int*)(ws + WS_TOKE))[m];
        const int g = hf * 8 + (hf ? ((te >> 8) & 0xff) : (te & 0xff));
        grp[tid] = g;
        __syncthreads();
        int rank = 0;
        for (int j = 0; j < i; ++j) rank += (grp[hf * 256 + j] == g) ? 1 : 0;
        const int slot = base[g] + pre[g] + rank;
        ((GAS int*)(ws + WS_SLOTTOK))[slot] = m; ((GAS float*)(ws + WS_SLOTGATE))[slot] = ((const GAS float*)(ws + WS_TOKG))[2 * m + hf];
        slot_of[tid] = slot;
        __syncthreads();
        for (int p = F.wave; p < 512; p += NWAVES) { const int mm = c * 256 + (p & 255), sl = slot_of[p];
            const GAS v4u* src = (const GAS v4u*)(ws + WS_XR3 + (size_t)mm * D * 2); GAS v4u* dst = (GAS v4u*)(ws + WS_XG + (size_t)sl * D);
            const v4u x0 = src[2 * lane], x1 = src[2 * lane + 1]; const float rs = ((const GAS float*)(ws + WS_TOKRSTD))[mm];
            dst[lane] = (v4u){pk_fp8x4(bflo(x0.x) * rs, bfhi(x0.x) * rs, bflo(x0.y) * rs, bfhi(x0.y) * rs), pk_fp8x4(bflo(x0.z) * rs, bfhi(x0.z) * rs, bflo(x0.w) * rs, bfhi(x0.w) * rs),
                              pk_fp8x4(bflo(x1.x) * rs, bfhi(x1.x) * rs, bflo(x1.y) * rs, bfhi(x1.y) * rs), pk_fp8x4(bflo(x1.z) * rs, bfhi(x1.z) * rs, bflo(x1.w) * rs, bfhi(x1.w) * rs)}; }
        __syncthreads();
    }
    for (int g = F.vcu; g < 16; g += F.G) {
        const int s0 = base[g] + tot[g], s1 = base[g] + ((tot[g] + 255) & ~255);
        for (int s = s0 + F.wave; s < s1; s += NWAVES) { GAS v4u* dst = (GAS v4u*)(ws + WS_XG + (size_t)s * D);
            dst[lane] = (v4u){0u, 0u, 0u, 0u};
            if (lane == 0) { ((GAS int*)(ws + WS_SLOTTOK))[s] = -1; ((GAS float*)(ws + WS_SLOTGATE))[s] = 0.f; } }
    }
    if (F.vcu == 0) {
        if (tid < 16) { const int p0 = base[tid] >> 8, p1 = (base[tid] + ((tot[tid] + 255) & ~255)) >> 8; for (int p = p0; p < p1; ++p) ((GAS int*)(ws + WS_PANELE))[p] = tid & 7; }
        if (tid == 0) { ((GAS int*)(ws + WS_META))[0] = meta[0]; ((GAS int*)(ws + WS_META))[1] = meta[1]; }
        if (tid < 16) ((GAS int*)(ws + WS_META))[2 + tid] = base[tid] >> 8;
    }
    __syncthreads();
}

__global__ void __launch_bounds__(NWAVES * 64, 2) yoco_fwd(Args args) {
    extern __shared__ __attribute__((aligned(16))) unsigned char lds_raw[];
    Frame F;
    F.lds = (LAS unsigned char*)lds_raw;
    F.wave = __builtin_amdgcn_readfirstlane((int)threadIdx.x >> 6);
    F.G = gridDim.x; { const int bx = blockIdx.x; F.vcu = (F.G % 8 == 0) ? (bx % 8) * (F.G / 8) + bx / 8 : bx; }
    unsigned char* ws = WSP;
    volatile LAS unsigned* MISC = (volatile LAS unsigned*)(F.lds + MISC_OFF);
    for (int u = fresh((int)threadIdx.x); u < (LDS_BYTES - LDSCTL_OFF) / 4; u += NWAVES * 64) ((LAS unsigned*)(F.lds + LDSCTL_OFF))[u] = 0u;
    __syncthreads();
    (void)xcd_barrier_post((unsigned*)(ws + WS_CTL) + CW_BAR, MISC + 8, (F.wave == 0 && lane_id_() == 0) ? 1 : 0);
    LAS unsigned char* ring = F.lds + RING_OFF;
#define bid ((int)blockIdx.x)
#define GRID_BAR() do { XcdBarrier b_; b_.t0 = (F.wave == 0 && lane_id_() == 0) ? 1 : 0; b_.bar = (unsigned*)(WSP + WS_CTL) + CW_BAR; b_.x = xb_xcc_id(); b_.st = (volatile LAS unsigned*)(F.lds + MISC_OFF) + 8; xcd_barrier(b_); } while (0)
#define GEMM(EpiT, SchedT) pg8::gemm_phase<EpiT, SchedT, true, true>

    p0_prologue(F);
    GRID_BAR();
    { pg8::Gemm g{(const bf16*)(ws + WS_XN), (const bf16*)(ws + WS_WA), M, NA, D / 2, D / 2}; pg8::StaticOrder S; S.init(M, NA, F.G, bid);
      pg8::EpiQA E{(bf16*)(ws + WS_QA), (float*)(ws + WS_PARTQA), 1.f / 64};
      pg8::gemm_phase<pg8::EpiQA, pg8::StaticOrder, true, true, true>(ring, g, S, E, F.wave); }
    GRID_BAR();
    { pg8::Gemm g{(const bf16*)(ws + WS_QA), (const bf16*)(ws + WS_WUQ), M, NH * QKD, QLORA, NA}; pg8::StaticOrder S; S.init(M, NH * QKD, F.G, bid);
      pg8::EpiRowScaleBf16 E{(bf16*)(ws + WS_Q), NH * QKD, (const float*)(ws + WS_PARTQA), 1.f / QLORA};
      GEMM(pg8::EpiRowScaleBf16, pg8::StaticOrder)(ring, g, S, E, F.wave); }
    { pg8::Gemm g{(const bf16*)(ws + WS_QA) + QLORA, (const bf16*)(ws + WS_WUKV), M, NH * 128, KVLORA, NA}; pg8::StaticOrder S; S.init(M, NH * 128, F.G, bid);
      pg8::EpiKVup E{(bf16*)(ws + WS_K), (bf16*)(ws + WS_V), (const float*)(ws + WS_PARTQA), (const bf16*)(ws + WS_QA), INP(I_A_GKN), (const float*)(ws + WS_ROPE)};
      GEMM(pg8::EpiKVup, pg8::StaticOrder)(ring, g, S, E, F.wave); }
    GRID_BAR();
    for (int p = F.vcu; p < BATCH * NH * 4; p += F.G) {
        const int bh = p >> 2, pid = p & 3, b = bh >> 4, h = bh & 15;
        for (int u2 = 0; u2 < 2; ++u2) {
            const int qb = u2 ? 7 - pid : pid;
            att::attn_unit<96, false, 1536, 1536, D, D, true>(ring, (const bf16*)(ws + WS_Q) + (size_t)b * SEQ * 1536 + h * QKD, (const bf16*)(ws + WS_K) + (size_t)b * SEQ * 1536 + h * QKD,
                                      (const bf16*)(ws + WS_V) + (size_t)b * SEQ * D + h * 64, (bf16*)(ws + WS_O + (size_t)b * SEQ * D + h * 64),
                                      256 * qb, 0, 4 * qb + 3, 0, 4 * qb + (F.wave >> 1), 0, nullptr, INP(I_A_GQN), (const float*)(ws + WS_ROPE), F.wave);
        }
    }
    GRID_BAR();
    { pg8::Gemm g{(const bf16*)(ws + WS_O), (const bf16*)(ws + WS_WO), M, D, D / 2, D / 2}; pg8::StaticOrder S; S.init(M, D, F.G, bid);
      pg8::EpiResNorm<true> E{INP(I_X), OUTP, (bf16*)(ws + WS_XR1), (float*)(ws + WS_PART1), 1.f / 4096};
      pg8::gemm_phase<pg8::EpiResNorm<true>, pg8::StaticOrder, true, true, true>(ring, g, S, E, F.wave); }
    GRID_BAR();
    { pg8::Gemm g{(const bf16*)(ws + WS_XR1), (const bf16*)(ws + WS_WF1), M, 2 * FF, D, D}; pg8::StaticOrder S; S.init(M, 2 * FF, F.G, bid);
      pg8::EpiGated<true> E{(bf16*)(ws + WS_H), FF, 0, (const float*)(ws + WS_PART1)};
      GEMM(pg8::EpiGated<true>, pg8::StaticOrder)(ring, g, S, E, F.wave); }
    GRID_BAR();
    { pg8::Gemm g{(const bf16*)(ws + WS_H), (const bf16*)(ws + WS_WF2), M, D, FF, FF}; pg8::StaticOrder S; S.init(M, D, F.G, bid);
      pg8::EpiResNorm<true, true> E{OUTP, OUTP, (bf16*)(ws + WS_XR2), (float*)(ws + WS_PART2), 1.f};
      pg8::gemm_phase<pg8::EpiResNorm<true, true>, pg8::StaticOrder, true, true>(ring, g, S, E, F.wave); }
    GRID_BAR();
    { pg8::Gemm g{(const bf16*)(ws + WS_XR2), (const bf16*)(ws + WS_WKVQ), M, 2 * D, D / 2, D / 2}; pg8::StaticOrder S; S.init(M, 2 * D, F.G, bid);
      pg8::EpiK2Q2 E{(bf16*)(ws + WS_KVQ2), (const float*)(ws + WS_PART2), INP(I_KV_GKN), INP(I_B_GQN), 1.f / 64};
      pg8::gemm_phase<pg8::EpiK2Q2, pg8::StaticOrder, true, true, true>(ring, g, S, E, F.wave); }
    { pg8::Gemm g{(const bf16*)(ws + WS_XR2), (const bf16*)(ws + WS_WKVQ + (size_t)2 * D * D), M, D, D / 2, D / 2}; pg8::StaticOrder S; S.init(M, D, F.G, bid);
      pg8::EpiRowScale16 E{(bf16*)(ws + WS_KVQ2), 3 * D, D, (const float*)(ws + WS_PART2), 1.f / 64};
      pg8::gemm_phase<pg8::EpiRowScale16, pg8::StaticOrder, true, true, true>(ring, g, S, E, F.wave); }
    GRID_BAR();
    for (int p = F.vcu; p < BATCH * NH * 8; p += F.G) {
        const int bh = p >> 3, cb = ((p & 7) + (p >> 8)) & 7, b = bh >> 4, h = bh & 15;
        const int c0 = 4 * cb, cc = c0 + (F.wave >> 1);
        const bf16* base = (const bf16*)(ws + WS_KVQ2) + (size_t)b * SEQ * 3072 + h * 64;
        att::attn_unit<64, true, 3072, 3072, 3072, D, true>(ring, base + 2048, base, base + 1024, (bf16*)(ws + WS_O2 + (size_t)b * SEQ * D + h * 64),
                                 256 * cb, c0 - 8 < 0 ? 0 : c0 - 8, c0 + 3, cc - 8 < 0 ? 0 : cc - 8, cc, cc, INP(I_B_RELB) + h * 257, nullptr, nullptr, F.wave);
    }
    GRID_BAR();
    { pg8::Gemm g{(const bf16*)(ws + WS_O2), (const bf16*)(ws + WS_WBO), M, D, D / 2, D / 2}; pg8::StaticOrder S; S.init(M, D, F.G, bid);
      pg8::EpiResNorm<false> E{OUTP, OUTP, (bf16*)(ws + WS_XR3), nullptr, 1.f / 4096};
      pg8::gemm_phase<pg8::EpiResNorm<false>, pg8::StaticOrder, true, true, true>(ring, g, S, E, F.wave); }
    GRID_BAR();
    route_phase(F);
    GRID_BAR();
    slot_phase(F, ws);
    GRID_BAR();
    for (int hf = 0; hf < 2; ++hf) {
        { unsigned char* w2 = WSP;
          const int nPA = __builtin_amdgcn_readfirstlane(((const GAS int*)(w2 + WS_META))[0]), nPB = __builtin_amdgcn_readfirstlane(((const GAS int*)(w2 + WS_META))[1]);
          const int nP = hf ? nPB : nPA, p0 = hf ? nPA : 0;
          pg8::Gemm g{(const bf16*)(w2 + WS_XG + (size_t)p0 * 256 * D), (const bf16*)(w2 + WS_WM1), nP * 256, 2 * EFF, D / 2, D / 2};
          pg8::MoeOrder S; S.init(nP, 2 * EFF / 256, F.G, bid);
#pragma unroll
          for (int k = 0; k < 7; ++k) S.pb[k] = __builtin_amdgcn_readfirstlane(((const GAS int*)(w2 + WS_META))[2 + hf * 8 + 1 + k]) - p0;
          pg8::EpiGatedF8 E{w2 + WS_HM, EFF, 2 * EFF / 256};
          pg8::gemm_phase<pg8::EpiGatedF8, pg8::MoeOrder, true, true, true>(ring, g, S, E, F.wave); }
        GRID_BAR();
        { unsigned char* w2 = WSP;
          const int nPA = __builtin_amdgcn_readfirstlane(((const GAS int*)(w2 + WS_META))[0]), nPB = __builtin_amdgcn_readfirstlane(((const GAS int*)(w2 + WS_META))[1]);
          const int nP = hf ? nPB : nPA, p0 = hf ? nPA : 0;
          pg8::Gemm g{(const bf16*)(w2 + WS_HM), (const bf16*)(w2 + WS_WM2), nP * 256, D, EFF / 2, EFF / 2};
          pg8::MoeOrder S; S.init(nP, D / 256, F.G, bid);
#pragma unroll
          for (int k = 0; k < 7; ++k) S.pb[k] = __builtin_amdgcn_readfirstlane(((const GAS int*)(w2 + WS_META))[2 + hf * 8 + 1 + k]) - p0;
          pg8::EpiMoeDown E{OUTP, (const int*)(w2 + WS_SLOTTOK), (const float*)(w2 + WS_SLOTGATE), p0 * 256, D, 1.f / 64};
          pg8::gemm_phase<pg8::EpiMoeDown, pg8::MoeOrder, true, true, true>(ring, g, S, E, F.wave); }
        if (hf == 0) GRID_BAR();
    }
#undef GRID_BAR
#undef bid
#undef GEMM
}

extern "C" void kernel_launch(void* const* d_in, const int* in_sizes, int n_in, void* d_out, int out_size, void* d_ws, size_t ws_size, hipStream_t stream) {
    static int grid = 0;
    if (grid == 0) {
        if (n_in != 27 || in_sizes[0] != M * D || out_size != M * D || ws_size < WS_END) { fprintf(stderr, "kernel_launch: unexpected shapes (n_in %d, in0 %d, out %d, ws %zu < %zu); nothing launched\n", n_in, n_in > 0 ? in_sizes[0] : -1, out_size, ws_size, (size_t)WS_END); grid = -1; return; }
        int dev = 0, cus = 0, per_cu = 0;
        if (hipGetDevice(&dev) != hipSuccess || hipDeviceGetAttribute(&cus, hipDeviceAttributeMultiprocessorCount, dev) != hipSuccess) { grid = -1; return; }
        if (hipFuncSetAttribute((const void*)yoco_fwd, hipFuncAttributeMaxDynamicSharedMemorySize, LDS_BYTES) != hipSuccess) { fprintf(stderr, "kernel_launch: hipFuncSetAttribute failed\n"); grid = -1; return; }
        if (hipOccupancyMaxActiveBlocksPerMultiprocessor(&per_cu, (const void*)yoco_fwd, NWAVES * 64, LDS_BYTES) != hipSuccess || per_cu < 1) { fprintf(stderr, "kernel_launch: occupancy query says %d\n", per_cu); }
        (void)hipGetLastError();
        grid = cus;
    }
    if (grid < 0) return;
    if (hipMemsetAsync((char*)d_ws + WS_CTL, 0, CTL_ZERO_BYTES, stream) != hipSuccess) return;
    Args a{};
    for (int i = 0; i < 27; ++i) a.in[i] = (const float*)d_in[i];
    a.out = (float*)d_out; a.ws = (unsigned char*)d_ws;
    hipLaunchKernelGGL(yoco_fwd, dim3(grid), dim3(NWAVES * 64), LDS_BYTES, stream, a);
}
```

```cpp
#include <hip/hip_runtime.h>
#include <cstdio>
#include <cstdint>
__device__ __forceinline__ int lane_id_() { unsigned m_ = ~0u; asm volatile("" : "+s"(m_)); return (int)__builtin_amdgcn_mbcnt_hi(m_, __builtin_amdgcn_mbcnt_lo(m_, 0u)); }
template <int X> __device__ __forceinline__ float swz_xor(float v) { return __builtin_bit_cast(float, __builtin_amdgcn_ds_swizzle(__builtin_bit_cast(int, v), (X << 10) | 0x1f)); }
__device__ __forceinline__ void halves32(float v, float& r_lo, float& r_hi) { unsigned a_ = __builtin_bit_cast(unsigned, v), b_ = a_;
    asm volatile("s_nop 1\n\tv_permlane32_swap_b32 %0, %1\n\ts_nop 1" : "+v"(a_), "+v"(b_)); r_lo = __builtin_bit_cast(float, a_); r_hi = __builtin_bit_cast(float, b_); }
__device__ __forceinline__ float xor32_partner(float v, int upper_half) { float lo, hi; halves32(v, lo, hi); return upper_half ? lo : hi; }
__device__ __forceinline__ float xor32_sum(float v) { float lo, hi; halves32(v, lo, hi); return lo + hi; }
__device__ __forceinline__ float xor32_max(float v) { float lo, hi; halves32(v, lo, hi); return fmaxf(lo, hi); }
namespace pg8 {
#define PG8_LAS __attribute__((address_space(3)))
typedef unsigned short bf16_t;
typedef short bf16x8 __attribute__((ext_vector_type(8)));
typedef float f32x4 __attribute__((ext_vector_type(4)));
typedef unsigned u32x4 __attribute__((ext_vector_type(4)));
constexpr int BM = 256, BK = 64, HALF = 128, HTB = HALF * BK * 2  , STAGE_BYTES = 8 * HTB, NXCD = 8, WGM = 8;

__host__ __device__ __forceinline__ int lds_byte(int r, int c) { const int st = (r >> 4) * 2 + (c >> 5), rr = r & 15, cc = c & 31, ob = rr * 64 + cc * 2; return st * 1024 + (ob ^ (((ob >> 9) & 1) << 5)); }
__host__ __device__ __forceinline__ void stage_rc(int b, int& R, int& C) { const int st = b / 1024, sb = b % 1024, swz = sb ^ (((sb >> 9) & 1) << 5); R = (st >> 1) * 16 + swz / 64; C = (st & 1) * 32 + (swz % 64) / 2; }
__host__ __device__ __forceinline__ int perm32(int rho) { const int n = rho >> 4, i = rho & 15; return 8 * (i >> 2) + 4 * n + (i & 3); }

struct Unit { int pm, pn; };
struct Gemm { const bf16_t* A; const bf16_t* Bt; int M, N, K, lda; };

struct StaticOrder {
    int nM, nN, nwg, G, c;
    __host__ __device__ void init(int M, int N, int G_, int c_) { nM = M / BM; nN = N / BM; nwg = nM * nN; G = G_; c = c_; }
    __host__ __device__ bool next(int i, Unit& u) const {
        const int L = i * G + c; if (L >= nwg) return false;
        int wgid = L; { const int q = nwg / NXCD, r = nwg % NXCD, xcd = wgid % NXCD, off = wgid / NXCD; wgid = (xcd < r ? xcd * (q + 1) : r * (q + 1) + (xcd - r) * q) + off; }
        const int nig = WGM * nN, gid = wgid / nig, fm = gid * WGM, gsz = (nM - fm) < WGM ? (nM - fm) : WGM;
        u.pm = fm + ((wgid % nig) % gsz); u.pn = (wgid % nig) / gsz; return true;
    }
    __device__ __forceinline__ void a_ready(const Unit&) const {}
    __device__ __forceinline__ void done(const Unit&) const {}
};
__device__ __forceinline__ unsigned cvt_pk_bf16(float lo, float hi) { unsigned r; asm volatile("v_cvt_pk_bf16_f32 %0, %1, %2" : "=v"(r) : "v"(lo), "v"(hi)); return r; }
__device__ __forceinline__ float silu_f(float x) { const float e = __builtin_amdgcn_exp2f(x * -1.4426950408889634f); return x * __builtin_amdgcn_rcpf(1.f + e); }

__device__ __forceinline__ float sum4(const f32x4& a) { return (a[0] + a[1]) + (a[2] + a[3]); }
__device__ __forceinline__ float part_sum8(const float* p) { return sum4(*(const f32x4*)p) + sum4(*(const f32x4*)(p + 4)); }
__device__ __forceinline__ float part_sum16(const float* p) { return (sum4(*(const f32x4*)p) + sum4(*(const f32x4*)(p + 4))) + (sum4(*(const f32x4*)(p + 8)) + sum4(*(const f32x4*)(p + 12))); }
__device__ __forceinline__ float fq_sum(float v) { v += swz_xor<16>(v); return xor32_sum(v); }
__device__ __forceinline__ float sq8(const f32x4& a, const f32x4& b) { return ((a[0] * a[0] + a[1] * a[1]) + (a[2] * a[2] + a[3] * a[3])) + ((b[0] * b[0] + b[1] * b[1]) + (b[2] * b[2] + b[3] * b[3])); }
__device__ __forceinline__ u32x4 pack8(const f32x4& a, const f32x4& b) { u32x4 w; w.x = cvt_pk_bf16(a[0], a[1]); w.y = cvt_pk_bf16(a[2], a[3]); w.z = cvt_pk_bf16(b[0], b[1]); w.w = cvt_pk_bf16(b[2], b[3]); return w; }
constexpr float EPS_ = 1e-6f;
__device__ __forceinline__ unsigned pk_fp8x4(float a, float b, float c, float d) { int w = 0; w = __builtin_amdgcn_cvt_pk_fp8_f32(a, b, w, false); w = __builtin_amdgcn_cvt_pk_fp8_f32(c, d, w, true); return (unsigned)w; }

struct EpiQA {
    static constexpr bool PERM = true, AFTER_DRAIN = false;
    bf16_t* O; float* part; float wscale;
    __device__ __forceinline__ void operator()(const f32x4 (&acc)[2][2][4][2], const Unit& u, int wr, int wc, int fr, int fq) const {
        { int t_ = lane_id_(); asm volatile("" : "+v"(t_)); fr = t_ & 15; fq = (t_ >> 4) & 3; }
        const int row0 = u.pm * BM + wr * 64 + fr, col0 = u.pn * BM + wc * 32 + 8 * fq;
#pragma unroll
        for (int ai = 0; ai < 2; ++ai)
#pragma unroll
            for (int m = 0; m < 4; ++m) { const int row = row0 + ai * HALF + m * 16; bf16_t* rowp = O + (size_t)row * 768 + col0;
                const f32x4 a0 = acc[ai][0][m][0] * wscale, a1 = acc[ai][0][m][1] * wscale, b0 = acc[ai][1][m][0] * wscale, b1 = acc[ai][1][m][1] * wscale;
                *(u32x4*)(rowp) = pack8(a0, a1); *(u32x4*)(rowp + HALF) = pack8(b0, b1);
                const float s0 = sq8(a0, a1), s1 = sq8(b0, b1);
                float* pr = part + (size_t)row * 16;
                if (u.pn == 0) { const float t = fq_sum(s0 + s1); if (fq == 0) pr[wc] = t; }
                else if (u.pn == 1) { const float t0 = fq_sum(s0), t1 = fq_sum(s1); if (fq == 0) { pr[4 + wc] = t0; pr[8 + wc] = t1; } }
                else { const float t = fq_sum(s0); if (fq == 0) pr[12 + wc] = t; } }
    }
};

struct EpiRowScaleBf16 {
    static constexpr bool PERM = true, AFTER_DRAIN = false;
    bf16_t* O; int ldc; const float* part; float inv_n;
    __device__ __forceinline__ void operator()(const f32x4 (&acc)[2][2][4][2], const Unit& u, int wr, int wc, int fr, int fq) const {
        { int t_ = lane_id_(); asm volatile("" : "+v"(t_)); fr = t_ & 15; fq = (t_ >> 4) & 3; }
        const int row0 = u.pm * BM + wr * 64 + fr, col0 = u.pn * BM + wc * 32 + 8 * fq;
#pragma unroll
        for (int ai = 0; ai < 2; ++ai)
#pragma unroll
            for (int m = 0; m < 4; ++m) { const int row = row0 + ai * HALF + m * 16; bf16_t* rowp = O + (size_t)row * ldc + col0;
                const float rs = __builtin_amdgcn_rsqf(part_sum8(part + (size_t)row * 16) * inv_n + EPS_);
                *(u32x4*)(rowp) = pack8(acc[ai][0][m][0] * rs, acc[ai][0][m][1] * rs); *(u32x4*)(rowp + HALF) = pack8(acc[ai][1][m][0] * rs, acc[ai][1][m][1] * rs); }
    }
};

struct EpiKVup {
    static constexpr bool PERM = true, AFTER_DRAIN = false;
    bf16_t* Kd; bf16_t* Vd; const float* part; const bf16_t* QA; const float* g_kn; const float* rope;
    __device__ __forceinline__ void operator()(const f32x4 (&acc)[2][2][4][2], const Unit& u, int wr, int wc, int fr, int fq) const {
        { int t_ = lane_id_(); asm volatile("" : "+v"(t_)); fr = t_ & 15; fq = (t_ >> 4) & 3; }
        const int row0 = u.pm * BM + wr * 64 + fr;
        if (u.pn >= 4) {
            const int col0 = (u.pn - 4) * BM + wc * 32 + 8 * fq;
#pragma unroll
            for (int ai = 0; ai < 2; ++ai)
#pragma unroll
                for (int m = 0; m < 4; ++m) { const int row = row0 + ai * HALF + m * 16; bf16_t* rowp = Vd + (size_t)row * 1024 + col0;
                    const float rs = __builtin_amdgcn_rsqf(part_sum8(part + (size_t)row * 16 + 8) * (1.f / 256) + EPS_);
                    *(u32x4*)(rowp) = pack8(acc[ai][0][m][0] * rs, acc[ai][0][m][1] * rs); *(u32x4*)(rowp + HALF) = pack8(acc[ai][1][m][0] * rs, acc[ai][1][m][1] * rs); }
            return;
        }
        const int head = 4 * u.pn + wc;
        f32x4 gA0 = *(const f32x4*)(g_kn + 8 * fq), gA1 = *(const f32x4*)(g_kn + 8 * fq + 4), gB0 = *(const f32x4*)(g_kn + 32 + 8 * fq), gB1 = *(const f32x4*)(g_kn + 32 + 8 * fq + 4);
        const f32x4 gR1 = *(const f32x4*)(g_kn + 64 + 4 * fq), gR2 = *(const f32x4*)(g_kn + 80 + 4 * fq);
#pragma unroll
        for (int ai = 0; ai < 2; ++ai)
#pragma unroll
            for (int m = 0; m < 4; ++m) { const int row = row0 + ai * HALF + m * 16;
                const float rs = __builtin_amdgcn_rsqf(part_sum8(part + (size_t)row * 16 + 8) * (1.f / 256) + EPS_);
                f32x4 a0 = acc[ai][0][m][0] * rs, a1 = acc[ai][0][m][1] * rs, b0 = acc[ai][1][m][0] * rs, b1 = acc[ai][1][m][1] * rs;
                const unsigned long long p1 = *(const unsigned long long*)(QA + (size_t)row * 768 + 640 + 4 * fq), p2 = *(const unsigned long long*)(QA + (size_t)row * 768 + 656 + 4 * fq);
                f32x4 x1, x2;
                x1[0] = __builtin_bit_cast(float, (unsigned)(p1 << 16)); x1[1] = __builtin_bit_cast(float, (unsigned)p1 & 0xffff0000u);
                x1[2] = __builtin_bit_cast(float, (unsigned)(p1 >> 32) << 16); x1[3] = __builtin_bit_cast(float, (unsigned)(p1 >> 32) & 0xffff0000u);
                x2[0] = __builtin_bit_cast(float, (unsigned)(p2 << 16)); x2[1] = __builtin_bit_cast(float, (unsigned)p2 & 0xffff0000u);
                x2[2] = __builtin_bit_cast(float, (unsigned)(p2 >> 32) << 16); x2[3] = __builtin_bit_cast(float, (unsigned)(p2 >> 32) & 0xffff0000u);
                const float ss = fq_sum(sq8(a0, a1) + sq8(b0, b1) + sq8(x1, x2));
                const float sh = __builtin_amdgcn_rsqf(ss * (1.f / 96) + EPS_);
                bf16_t* kp = Kd + (size_t)row * 1536 + head * 96;
                *(u32x4*)(kp + 8 * fq) = pack8(a0 * gA0 * sh, a1 * gA1 * sh); *(u32x4*)(kp + 32 + 8 * fq) = pack8(b0 * gB0 * sh, b1 * gB1 * sh);
                const f32x4* rp = (const f32x4*)(rope + ((size_t)(row & 2047) * 16 + 4 * fq) * 2);
                const f32x4 c01 = rp[0], c23 = rp[1];
                const f32x4 y1 = x1 * gR1 * sh, y2 = x2 * gR2 * sh;
                f32x4 o1, o2;
                o1[0] = y1[0] * c01[0] - y2[0] * c01[1]; o2[0] = y2[0] * c01[0] + y1[0] * c01[1];
                o1[1] = y1[1] * c01[2] - y2[1] * c01[3]; o2[1] = y2[1] * c01[2] + y1[1] * c01[3];
                o1[2] = y1[2] * c23[0] - y2[2] * c23[1]; o2[2] = y2[2] * c23[0] + y1[2] * c23[1];
                o1[3] = y1[3] * c23[2] - y2[3] * c23[3]; o2[3] = y2[3] * c23[2] + y1[3] * c23[3];
                unsigned long long w1 = (unsigned long long)cvt_pk_bf16(o1[0], o1[1]) | ((unsigned long long)cvt_pk_bf16(o1[2], o1[3]) << 32);
                unsigned long long w2 = (unsigned long long)cvt_pk_bf16(o2[0], o2[1]) | ((unsigned long long)cvt_pk_bf16(o2[2], o2[3]) << 32);
                *(unsigned long long*)(kp + 64 + 4 * fq) = w1; *(unsigned long long*)(kp + 80 + 4 * fq) = w2; }
    }
};

struct EpiK2Q2 {
    static constexpr bool PERM = true, AFTER_DRAIN = false;
    bf16_t* O; const float* pss; const float* gk; const float* gq; float wscale;
    __device__ __forceinline__ void operator()(const f32x4 (&acc)[2][2][4][2], const Unit& u, int wr, int wc, int fr, int fq) const {
        { int t_ = lane_id_(); asm volatile("" : "+v"(t_)); fr = t_ & 15; fq = (t_ >> 4) & 3; }
        const int row0 = u.pm * BM + wr * 64 + fr, isq = u.pn >> 2, tl = u.pn & 3;
        const float* g = isq ? gq : gk; const float post = isq ? 0.125f * 1.4426950408889634f : 1.f;
        const f32x4 gA0 = *(const f32x4*)(g + 8 * fq) * post, gA1 = *(const f32x4*)(g + 8 * fq + 4) * post, gB0 = *(const f32x4*)(g + 32 + 8 * fq) * post, gB1 = *(const f32x4*)(g + 32 + 8 * fq + 4) * post;
        const int colh = isq * 2048 + (4 * tl + wc) * 64;
        unsigned zhi_ = 0u; asm volatile("" : "+v"(zhi_));
        const unsigned long long coff = ((unsigned long long)zhi_ << 32) | (unsigned)((colh + 8 * fq) * 2);
#pragma unroll
        for (int ai = 0; ai < 2; ++ai)
#pragma unroll
            for (int m = 0; m < 4; ++m) { const int row = row0 + ai * HALF + m * 16; unsigned char* rowp = (unsigned char*)O + (size_t)row * 6144 + coff;
                const float rs = __builtin_amdgcn_rsqf(part_sum16(pss + (size_t)row * 16) * (1.f / 1024) + EPS_) * wscale;
                const f32x4 a0 = acc[ai][0][m][0] * rs, a1 = acc[ai][0][m][1] * rs, b0 = acc[ai][1][m][0] * rs, b1 = acc[ai][1][m][1] * rs;
                const float ss = fq_sum(sq8(a0, a1) + sq8(b0, b1));
                const float sh = __builtin_amdgcn_rsqf(ss * (1.f / 64) + EPS_);
                *(u32x4*)(rowp) = pack8(a0 * gA0 * sh, a1 * gA1 * sh); *(u32x4*)(rowp + 64) = pack8(b0 * gB0 * sh, b1 * gB1 * sh); }
    }
};
struct EpiRowScale16 {
    static constexpr bool PERM = true, AFTER_DRAIN = false;
    bf16_t* O; int ldc; int coff; const float* pss; float wscale;
    __device__ __forceinline__ void operator()(const f32x4 (&acc)[2][2][4][2], const Unit& u, int wr, int wc, int fr, int fq) const {
        { int t_ = lane_id_(); asm volatile("" : "+v"(t_)); fr = t_ & 15; fq = (t_ >> 4) & 3; }
        const int row0 = u.pm * BM + wr * 64 + fr, col0 = coff + u.pn * BM + wc * 32 + 8 * fq;
#pragma unroll
        for (int ai = 0; ai < 2; ++ai)
#pragma unroll
            for (int m = 0; m < 4; ++m) { const int row = row0 + ai * HALF + m * 16; bf16_t* rowp = O + (size_t)row * ldc + col0;
                const float rs = __builtin_amdgcn_rsqf(part_sum16(pss + (size_t)row * 16) * (1.f / 1024) + EPS_) * wscale;
                *(u32x4*)(rowp) = pack8(acc[ai][0][m][0] * rs, acc[ai][0][m][1] * rs); *(u32x4*)(rowp + HALF) = pack8(acc[ai][1][m][0] * rs, acc[ai][1][m][1] * rs); }
    }
};

template <bool SSQ> struct EpiGated {
    static constexpr bool PERM = true, AFTER_DRAIN = false;
    bf16_t* Hd; int ldc; int ntile; const float* rs;
    __device__ __forceinline__ void operator()(const f32x4 (&acc)[2][2][4][2], const Unit& u, int wr, int wc, int fr, int fq) const {
        { int t_ = lane_id_(); asm volatile("" : "+v"(t_)); fr = t_ & 15; fq = (t_ >> 4) & 3; }
        const int pnl = ntile ? (u.pn % ntile) : u.pn;
        const int row0 = u.pm * BM + wr * 64 + fr, col0 = pnl * HALF + wc * 32 + 8 * fq;
#pragma unroll
        for (int ai = 0; ai < 2; ++ai)
#pragma unroll
            for (int m = 0; m < 4; ++m) { const int row = row0 + ai * HALF + m * 16; bf16_t* rowp = Hd + (size_t)row * ldc + col0;
                const float r = SSQ ? __builtin_amdgcn_rsqf(part_sum16(rs + (size_t)row * 16) * (1.f / 1024) + EPS_) : rs[row];
                const f32x4 g0 = acc[ai][0][m][0] * r, g1 = acc[ai][0][m][1] * r, u0 = acc[ai][1][m][0] * r, u1 = acc[ai][1][m][1] * r;
                u32x4 w;
                w.x = cvt_pk_bf16(silu_f(g0[0]) * u0[0], silu_f(g0[1]) * u0[1]); w.y = cvt_pk_bf16(silu_f(g0[2]) * u0[2], silu_f(g0[3]) * u0[3]);
                w.z = cvt_pk_bf16(silu_f(g1[0]) * u1[0], silu_f(g1[1]) * u1[1]); w.w = cvt_pk_bf16(silu_f(g1[2]) * u1[2], silu_f(g1[3]) * u1[3]);
                *(u32x4*)rowp = w; }
    }
};

struct EpiGatedF8 {
    static constexpr bool PERM = true, AFTER_DRAIN = false;
    unsigned char* Hd; int ldc; int ntile;
    static __device__ __forceinline__ float gate(float g, float u) {
        const float e = __builtin_amdgcn_exp2f(g * (-1.4426950408889634f / 64.f)); return (g * u) * (__builtin_amdgcn_rcpf(1.f + e) * (1.f / 4096.f)); }
    __device__ __forceinline__ void operator()(const f32x4 (&acc)[2][2][4][2], const Unit& u, int wr, int wc, int fr, int fq) const {
        { int t_ = lane_id_(); asm volatile("" : "+v"(t_)); fr = t_ & 15; fq = (t_ >> 4) & 3; }
        const int pnl = u.pn % ntile;
        const int row0 = u.pm * BM + wr * 64 + fr, col0 = pnl * HALF + wc * 32 + 8 * fq;
#pragma unroll
        for (int ai = 0; ai < 2; ++ai)
#pragma unroll
            for (int m = 0; m < 4; ++m) { const int row = row0 + ai * HALF + m * 16; unsigned char* rowp = Hd + (size_t)row * ldc + col0;
                const f32x4 g0 = acc[ai][0][m][0], g1 = acc[ai][0][m][1], u0 = acc[ai][1][m][0], u1 = acc[ai][1][m][1];
                unsigned long long w = (unsigned long long)pk_fp8x4(gate(g0[0], u0[0]), gate(g0[1], u0[1]), gate(g0[2], u0[2]), gate(g0[3], u0[3]))
                                     | ((unsigned long long)pk_fp8x4(gate(g1[0], u1[0]), gate(g1[1], u1[1]), gate(g1[2], u1[2]), gate(g1[3], u1[3])) << 32);
                *(unsigned long long*)rowp = w; }
    }
};

template <bool SSQ, bool XF8 = false> struct EpiResNorm {
    static constexpr bool PERM = true, AFTER_DRAIN = false;
    const float* res; float* out; bf16_t* XR; float* ssq; float ascale;
    __device__ __forceinline__ void operator()(const f32x4 (&acc)[2][2][4][2], const Unit& u, int wr, int wc, int fr, int fq) const {
        { int t_ = lane_id_(); asm volatile("" : "+v"(t_)); fr = t_ & 15; fq = (t_ >> 4) & 3; }
        const int row0 = u.pm * BM + wr * 64 + fr, col0 = u.pn * BM + wc * 32 + 8 * fq;
#pragma unroll
        for (int ai = 0; ai < 2; ++ai)
#pragma unroll
            for (int m = 0; m < 4; ++m) { const int row = row0 + ai * HALF + m * 16; const size_t ro = (size_t)row * 1024 + col0;
                f32x4 r[2][2];
#pragma unroll
                for (int bj = 0; bj < 2; ++bj)
#pragma unroll
                    for (int n = 0; n < 2; ++n) r[bj][n] = *(const f32x4*)(res + ro + bj * HALF + n * 4);
#pragma unroll
                for (int bj = 0; bj < 2; ++bj)
#pragma unroll
                    for (int n = 0; n < 2; ++n) { r[bj][n] = r[bj][n] + acc[ai][bj][m][n] * ascale; *(f32x4*)(out + ro + bj * HALF + n * 4) = r[bj][n]; }
                if constexpr (XF8) { unsigned char* x8 = (unsigned char*)XR + ro;
                    *(unsigned long long*)(x8) = (unsigned long long)pk_fp8x4(r[0][0][0], r[0][0][1], r[0][0][2], r[0][0][3]) | ((unsigned long long)pk_fp8x4(r[0][1][0], r[0][1][1], r[0][1][2], r[0][1][3]) << 32);
                    *(unsigned long long*)(x8 + HALF) = (unsigned long long)pk_fp8x4(r[1][0][0], r[1][0][1], r[1][0][2], r[1][0][3]) | ((unsigned long long)pk_fp8x4(r[1][1][0], r[1][1][1], r[1][1][2], r[1][1][3]) << 32); }
                else { *(u32x4*)(XR + ro) = pack8(r[0][0], r[0][1]); *(u32x4*)(XR + ro + HALF) = pack8(r[1][0], r[1][1]); }
                if (SSQ) { const float t = fq_sum(sq8(r[0][0], r[0][1]) + sq8(r[1][0], r[1][1])); if (fq == 0) ssq[(size_t)row * 16 + u.pn * 4 + wc] = t; } }
    }
};

struct EpiMoeDown {
    static constexpr bool PERM = false, AFTER_DRAIN = false;
    float* out; const int* slot_tok; const float* slot_gate; int slot_base; int ldc; float wscale;
    __device__ __forceinline__ void operator()(const f32x4 (&acc)[2][2][4][2], const Unit& u, int wr, int wc, int fr, int fq) const {
        { int t_ = lane_id_(); asm volatile("" : "+v"(t_)); fr = t_ & 15; fq = (t_ >> 4) & 3; }
        const int pnl = u.pn & 3;
        const int row0 = slot_base + u.pm * BM + wr * 64 + fr, col0 = pnl * BM + wc * 32 + 4 * fq;
#pragma unroll
        for (int ai = 0; ai < 2; ++ai)
#pragma unroll
            for (int m = 0; m < 4; ++m) { const int slot = row0 + ai * HALF + m * 16; const int tok = slot_tok[slot]; const float gt = slot_gate[slot] * wscale;
                if (tok >= 0) { float* rowp = out + (size_t)tok * ldc + col0;
                    f32x4 r[2][2];
#pragma unroll
                    for (int bj = 0; bj < 2; ++bj)
#pragma unroll
                        for (int n = 0; n < 2; ++n) r[bj][n] = *(const f32x4*)(rowp + bj * HALF + n * 16);
#pragma unroll
                    for (int bj = 0; bj < 2; ++bj)
#pragma unroll
                        for (int n = 0; n < 2; ++n) *(f32x4*)(rowp + bj * HALF + n * 16) = r[bj][n] + acc[ai][bj][m][n] * gt; } }
    }
};

struct MoeOrder {
    int nM, nN, nwg, G, c; int pb[7];
    __device__ void init(int nPanels, int nN_, int G_, int c_) { nM = nPanels; nN = nN_; nwg = nM * nN; G = G_; c = c_; }
    __device__ bool next(int i, Unit& u) const {
        const int L = i * G + c; if (L >= nwg) return false;
        int wgid = L; { const int q = nwg / NXCD, r = nwg % NXCD, xcd = wgid % NXCD, off = wgid / NXCD; wgid = (xcd < r ? xcd * (q + 1) : r * (q + 1) + (xcd - r) * q) + off; }
        const int nig = WGM * nN, gid = wgid / nig, fm = gid * WGM, gsz = (nM - fm) < WGM ? (nM - fm) : WGM;
        u.pm = fm + ((wgid % nig) % gsz); const int pnl = (wgid % nig) / gsz;
        int e = 0;
#pragma unroll
        for (int k = 0; k < 7; ++k) e += (u.pm >= pb[k]) ? 1 : 0;
        u.pn = e * nN + pnl; return true;
    }
    __device__ __forceinline__ void a_ready(const Unit&) const {}
    __device__ __forceinline__ void done(const Unit&) const {}
};
template <class Epi, class Sched, bool ALIGN_EPI = false, bool SP2 = false, bool F8 = false>
__device__ __forceinline__ void gemm_phase(PG8_LAS unsigned char* lds, const Gemm g, const Sched& S, const Epi& E, const int wave_idx) {
    int tid_ = wave_idx * 64 + lane_id_(); asm volatile("" : "+v"(tid_));
    const int tid = tid_, wid = __builtin_amdgcn_readfirstlane(tid >> 6), lane = tid & 63, wr = wid >> 2, wc = wid & 3, fr = lane & 15, fq = lane >> 4;
    const int K = g.K, nt = K / BK;
    unsigned voffA0, voffB0;
    { int R, C; stage_rc(tid * 16, R, C); const int Rb = Epi::PERM ? ((R & ~31) + perm32(R & 31)) : R;
      voffA0 = (unsigned)(R * g.lda + C) * 2u; voffB0 = (unsigned)(Rb * K + C) * 2u; }
    const size_t voffAR = (size_t)64 * g.lda * 2, voffBR = (size_t)64 * K * 2;
    const size_t kstep = (size_t)(BK * 2);
    const size_t hstepA = (size_t)HALF * g.lda * 2, hstepB = (size_t)HALF * K * 2;
    const size_t tstepA = 2 * hstepA, tstepB = 2 * hstepB;
    const unsigned lds0_ = (unsigned)(__UINTPTR_TYPE__)lds;
    const unsigned ldsw = (unsigned)wid * 1024u;
    const int aoff = lds_byte(wr * 64 + fr, fq * 8), boff = lds_byte(wc * 32 + fr, fq * 8);
#define PG8_SA(b, h) (((b) * 2 + (h)) * HTB)
#define PG8_SB(b, h) ((4 + (b) * 2 + (h)) * HTB)
#define PG8_STAGE(bufoff, gbase, voff) do { _Pragma("unroll") for (int _i = 0; _i < 2; ++_i) { unsigned keep_; const char* sb_ = (const char*)(gbase) + (size_t)_i * voff##R; \
        asm volatile("s_mov_b32 %0, m0\n\ts_mov_b32 m0, %3\n\ts_nop 0\n\tglobal_load_lds_dwordx4 %1, %2\n\ts_mov_b32 m0, %0" \
            : "=&s"(keep_) : "v"(voff##0), "s"(sb_), "s"(lds0_ + (unsigned)((bufoff) + _i * 8192) + ldsw) : "memory"); } } while (0)
#define PG8_LDA(dst, b, h) do { _Pragma("unroll") for (int m = 0; m < 4; ++m) _Pragma("unroll") for (int k = 0; k < 2; ++k) dst[m][k] = *(const PG8_LAS bf16x8*)(lds + PG8_SA(b, h) + aoff + m * 2048 + k * 1024); } while (0)
#define PG8_LDB(dst, b, h) do { _Pragma("unroll") for (int n = 0; n < 2; ++n) _Pragma("unroll") for (int k = 0; k < 2; ++k) dst[n][k] = *(const PG8_LAS bf16x8*)(lds + PG8_SB(b, h) + boff + n * 2048 + k * 1024); } while (0)
#define PG8_MMA(ai, bj, At, Bt) do { __builtin_amdgcn_s_setprio(1); _Pragma("unroll") for (int m = 0; m < 4; ++m) _Pragma("unroll") for (int n = 0; n < 2; ++n) { \
        if constexpr (F8) { typedef int v8i_ __attribute__((ext_vector_type(8))); typedef int v4i_ __attribute__((ext_vector_type(4))); \
            const v4i_ b0_ = __builtin_bit_cast(v4i_, Bt[n][0]), b1_ = __builtin_bit_cast(v4i_, Bt[n][1]), a0_ = __builtin_bit_cast(v4i_, At[m][0]), a1_ = __builtin_bit_cast(v4i_, At[m][1]); \
            const v8i_ bb_ = __builtin_shufflevector(b0_, b1_, 0, 1, 2, 3, 4, 5, 6, 7), aa_ = __builtin_shufflevector(a0_, a1_, 0, 1, 2, 3, 4, 5, 6, 7); \
            acc[ai][bj][m][n] = __builtin_amdgcn_mfma_scale_f32_16x16x128_f8f6f4(bb_, aa_, acc[ai][bj][m][n], 0, 0, 0, 0, 0, 0); } \
        else { _Pragma("unroll") for (int k = 0; k < 2; ++k) acc[ai][bj][m][n] = __builtin_amdgcn_mfma_f32_16x16x32_bf16(Bt[n][k], At[m][k], acc[ai][bj][m][n], 0, 0, 0); } } \
        __builtin_amdgcn_s_setprio(0); } while (0)
#define PG8_WAIT_V(n) asm volatile("s_waitcnt vmcnt(" #n ")" ::: "memory")
#define PG8_WAIT_L(n) asm volatile("s_waitcnt lgkmcnt(" #n ")" ::: "memory")
#define PG8_BAR __builtin_amdgcn_s_barrier()
#define PG8_SCHED __builtin_amdgcn_sched_barrier(0)
    Unit cur, nxt; int ui = 0;
    if (!S.next(0, cur)) return;
    f32x4 acc[2][2][4][2];
#pragma unroll
    for (int a = 0; a < 2; ++a)
#pragma unroll
        for (int b = 0; b < 2; ++b)
#pragma unroll
            for (int m = 0; m < 4; ++m)
#pragma unroll
                for (int n = 0; n < 2; ++n) acc[a][b][m][n] = (f32x4){0.f, 0.f, 0.f, 0.f};
    bf16x8 At[4][2], B0[2][2], B1[2][2];
    const char* cA = (const char*)g.A + (size_t)cur.pm * tstepA; const char* cB = (const char*)g.Bt + (size_t)cur.pn * tstepB;
    S.a_ready(cur);
    if constexpr (SP2) {
        PG8_STAGE(PG8_SB(0, 0), cB, voffB); PG8_STAGE(PG8_SB(0, 1), cB + hstepB, voffB); PG8_STAGE(PG8_SA(0, 0), cA, voffA); PG8_STAGE(PG8_SA(0, 1), cA + hstepA, voffA);
        if (wr == 1) PG8_BAR;
        PG8_WAIT_V(2); PG8_BAR;
        PG8_STAGE(PG8_SB(1, 0), cB + kstep, voffB); PG8_STAGE(PG8_SA(1, 0), cA + kstep, voffA); PG8_STAGE(PG8_SB(1, 1), cB + hstepB + kstep, voffB);
        PG8_WAIT_V(6); PG8_BAR;
    } else {
        PG8_STAGE(PG8_SB(0, 0), cB, voffB); PG8_STAGE(PG8_SA(0, 0), cA, voffA); PG8_STAGE(PG8_SB(0, 1), cB + hstepB, voffB); PG8_STAGE(PG8_SA(0, 1), cA + hstepA, voffA);
        if (wr == 1) PG8_BAR;
        PG8_WAIT_V(4); PG8_BAR;
        PG8_STAGE(PG8_SB(1, 0), cB + kstep, voffB); PG8_STAGE(PG8_SA(1, 0), cA + kstep, voffA); PG8_STAGE(PG8_SB(1, 1), cB + hstepB + kstep, voffB);
        PG8_WAIT_V(6); PG8_BAR;
    }
    for (;;) {
        const bool has_next = S.next(ui + 1, nxt);
        const char* nA = has_next ? (const char*)g.A + (size_t)nxt.pm * tstepA : cA; const char* nB = has_next ? (const char*)g.Bt + (size_t)nxt.pn * tstepB : cB;
#pragma unroll 1
        for (int t = 0; t < nt; t += 2) {
            const bool last = (t == nt - 2);
            const char* a1 = cA + (size_t)(t + 1) * kstep;
            const char* a2 = last ? nA : cA + (size_t)(t + 2) * kstep; const char* b2 = last ? nB : cB + (size_t)(t + 2) * kstep;
            const char* a3 = a2 + kstep; const char* b3 = b2 + kstep;
            if (last && has_next) S.a_ready(nxt);
            if constexpr (SP2) {
            PG8_LDB(B0, 0, 0); PG8_LDB(B1, 0, 1); PG8_SCHED; PG8_LDA(At, 0, 0); PG8_STAGE(PG8_SA(1, 1), a1 + hstepA, voffA);
            PG8_WAIT_V(8); PG8_WAIT_L(0); PG8_BAR; PG8_MMA(0, 0, At, B0); PG8_MMA(0, 1, At, B1); PG8_BAR; PG8_SCHED;
            PG8_LDA(At, 0, 1); PG8_STAGE(PG8_SB(0, 0), b2, voffB); PG8_STAGE(PG8_SB(0, 1), b2 + hstepB, voffB); PG8_STAGE(PG8_SA(0, 0), a2, voffA);
            PG8_WAIT_V(8); PG8_WAIT_L(0); PG8_BAR; PG8_MMA(1, 0, At, B0); PG8_MMA(1, 1, At, B1); PG8_BAR; PG8_SCHED;
            PG8_LDB(B0, 1, 0); PG8_LDB(B1, 1, 1); PG8_SCHED; PG8_LDA(At, 1, 0); PG8_STAGE(PG8_SA(0, 1), a2 + hstepA, voffA);
            PG8_WAIT_V(8); PG8_WAIT_L(0); PG8_BAR; PG8_MMA(0, 0, At, B0); PG8_MMA(0, 1, At, B1); PG8_BAR; PG8_SCHED;
            PG8_LDA(At, 1, 1); PG8_STAGE(PG8_SB(1, 0), b3, voffB); PG8_STAGE(PG8_SB(1, 1), b3 + hstepB, voffB); PG8_STAGE(PG8_SA(1, 0), a3, voffA);
            PG8_WAIT_V(8); PG8_WAIT_L(0); PG8_BAR; PG8_MMA(1, 0, At, B0); PG8_MMA(1, 1, At, B1); PG8_BAR; PG8_SCHED;
            } else {
            PG8_LDB(B0, 0, 0); PG8_SCHED; PG8_LDA(At, 0, 0); PG8_STAGE(PG8_SA(1, 1), a1 + hstepA, voffA);
            PG8_WAIT_L(8); PG8_BAR; PG8_WAIT_L(0); PG8_MMA(0, 0, At, B0); PG8_BAR; PG8_SCHED;
            PG8_LDB(B1, 0, 1); PG8_STAGE(PG8_SB(0, 0), b2, voffB);
            PG8_BAR; PG8_WAIT_L(0); PG8_MMA(0, 1, At, B1); PG8_BAR;
            PG8_LDA(At, 0, 1); PG8_STAGE(PG8_SA(0, 0), a2, voffA);
            PG8_BAR; PG8_WAIT_L(0); PG8_MMA(1, 0, At, B0); PG8_BAR; PG8_SCHED;
            PG8_STAGE(PG8_SB(0, 1), b2 + hstepB, voffB);
            PG8_WAIT_V(6); PG8_BAR; PG8_MMA(1, 1, At, B1); PG8_BAR;
            PG8_LDB(B0, 1, 0); PG8_SCHED; PG8_LDA(At, 1, 0); PG8_STAGE(PG8_SA(0, 1), a2 + hstepA, voffA);
            PG8_WAIT_L(8); PG8_BAR; PG8_WAIT_L(0); PG8_MMA(0, 0, At, B0); PG8_BAR; PG8_SCHED;
            PG8_LDB(B1, 1, 1); PG8_STAGE(PG8_SB(1, 0), b3, voffB);
            PG8_BAR; PG8_WAIT_L(0); PG8_MMA(0, 1, At, B1); PG8_BAR;
            PG8_LDA(At, 1, 1); PG8_STAGE(PG8_SA(1, 0), a3, voffA);
            PG8_BAR; PG8_WAIT_L(0); PG8_MMA(1, 0, At, B0); PG8_BAR; PG8_SCHED;
            PG8_STAGE(PG8_SB(1, 1), b3 + hstepB, voffB);
            PG8_WAIT_V(6); PG8_BAR; PG8_MMA(1, 1, At, B1); PG8_BAR;
            }
        }
        if constexpr (ALIGN_EPI) { if (wr == 0) PG8_BAR; }
        if constexpr (!Epi::AFTER_DRAIN) { E(acc, cur, wr, wc, fr, fq); S.done(cur); }
        if (!has_next) break;
#pragma unroll
        for (int a = 0; a < 2; ++a)
#pragma unroll
            for (int b = 0; b < 2; ++b)
#pragma unroll
                for (int m = 0; m < 4; ++m)
#pragma unroll
                    for (int n = 0; n < 2; ++n) acc[a][b][m][n] = (f32x4){0.f, 0.f, 0.f, 0.f};
        cur = nxt; cA = nA; cB = nB; ++ui;
        if constexpr (ALIGN_EPI) { if (wr == 1) PG8_BAR; }
    }
    PG8_WAIT_V(0);
    if constexpr (!ALIGN_EPI) { if (wr == 0) PG8_BAR; }
    PG8_BAR;
    if constexpr (Epi::AFTER_DRAIN) { E.fused(acc, cur, wr, wc, fr, fq, lds, wid, lane); S.done(cur); }
#undef PG8_SA
#undef PG8_SB
#undef PG8_STAGE
#undef PG8_LDA
#undef PG8_LDB
#undef PG8_MMA
#undef PG8_WAIT_V
#undef PG8_WAIT_L
#undef PG8_BAR
#undef PG8_SCHED
}
}
namespace att {
#define ATT_LAS __attribute__((address_space(3)))
typedef unsigned short bf16;
typedef short bf16x8 __attribute__((ext_vector_type(8)));
typedef short s16x4 __attribute__((ext_vector_type(4)));
typedef float f32x16 __attribute__((ext_vector_type(16)));
typedef float f32x4_t __attribute__((ext_vector_type(4)));
typedef unsigned u32x4 __attribute__((ext_vector_type(4)));
typedef unsigned u32x2 __attribute__((ext_vector_type(2)));
typedef float f32x2_t __attribute__((ext_vector_type(2))); typedef __bf16 bf16x2_t __attribute__((ext_vector_type(2)));
__device__ __forceinline__ unsigned cvtpk(float lo, float hi) { f32x2_t v = {lo, hi}; bf16x2_t b = __builtin_convertvector(v, bf16x2_t); return __builtin_bit_cast(unsigned, b); }
__device__ __forceinline__ s16x4 vtr(const ATT_LAS unsigned char* p) { return __builtin_bit_cast(s16x4, __builtin_amdgcn_ds_read_tr16_b64_v4i16((ATT_LAS s16x4*)p)); }
constexpr int VSTR = 192;
template <int DQK> struct Geo { static constexpr int KSTR = DQK * 2 + 16, KBUF = 64 * KSTR, VBUF = 64 * VSTR, CPR = DQK / 8, NKC = 64 * CPR, KIT = (NKC + 511) / 512; };
template <int DQK> constexpr int lds_bytes() { return 2 * Geo<DQK>::KBUF + 2 * Geo<DQK>::VBUF + 2048 + 8192; }

__device__ __forceinline__ float xhalf_sum(float m) { return xor32_sum(m); }
__device__ __forceinline__ float max3f(float a, float b, float c) { float r; asm("v_max3_f32 %0, %1, %2, %3" : "=v"(r) : "v"(a), "v"(b), "v"(c)); return r; }
__device__ __forceinline__ float max2f(float a, float b) { float r; asm("v_max_f32_e32 %0, %1, %2" : "=v"(r) : "v"(a), "v"(b)); return r; }
__device__ __forceinline__ float rowmax32(const f32x16& p0, const f32x16& p1) {
    float a = max2f(p0[0], p1[0]), b = max2f(p0[1], p1[1]), c = max2f(p0[2], p1[2]), d = max2f(p0[3], p1[3]);
#pragma unroll
    for (int r = 4; r < 16; r += 4) { a = max3f(a, p0[r], p1[r]); b = max3f(b, p0[r + 1], p1[r + 1]); c = max3f(c, p0[r + 2], p1[r + 2]); d = max3f(d, p0[r + 3], p1[r + 3]); }
    const float m = max2f(max2f(a, b), max2f(c, d));
    float lo_, hi_; halves32(m, lo_, hi_);
    return max2f(lo_, hi_);
}

template <int DQK, bool BAND, int qpitch, int kpitch, int vpitch, int opitch, bool OF8 = false>
__device__ __forceinline__ void attn_unit(ATT_LAS unsigned char* lds, const bf16* Qb, const bf16* Kb, const bf16* Vb, bf16* Ob,
                                          int q0, int t_lo, int t_hi, int my_lo, int my_hi, int cc, const float* bias_g, const float* g_qn, const float* rope, const int wave_idx) {
    typedef Geo<DQK> G;
    int tid_ = wave_idx * 64 + lane_id_(); asm volatile("" : "+v"(tid_));
    const int tid = tid_, lane = tid & 63, r32 = lane & 31, hi = lane >> 5, wid = __builtin_amdgcn_readfirstlane(tid >> 6);
    ATT_LAS float* biasL = (ATT_LAS float*)(lds + 2 * G::KBUF + 2 * G::VBUF);
    bf16x8 qf[DQK / 16];
    { const bf16* qp = Qb + (size_t)(q0 + wid * 32 + r32) * qpitch + 8 * hi;
#pragma unroll
      for (int kk = 0; kk < DQK / 16; ++kk) qf[kk] = *(const bf16x8*)(qp + 16 * kk); }
    if constexpr (!BAND) {
        float qv[DQK / 16][8]; float ss = 0.f;
#pragma unroll
        for (int kk = 0; kk < DQK / 16; ++kk)
#pragma unroll
            for (int j = 0; j < 8; ++j) { qv[kk][j] = __builtin_bit_cast(float, (unsigned)(unsigned short)qf[kk][j] << 16); ss += qv[kk][j] * qv[kk][j]; }
        ss = xhalf_sum(ss);
        const float rs = __builtin_amdgcn_rsqf(ss * (1.f / DQK) + 1e-6f) * (0.10206207261596577f * 1.4426950408889634f);
#pragma unroll
        for (int kk = 0; kk < DQK / 16; ++kk) { const f32x4_t g0 = *(const f32x4_t*)(g_qn + 16 * kk + 8 * hi), g1 = *(const f32x4_t*)(g_qn + 16 * kk + 8 * hi + 4);
#pragma unroll
            for (int j = 0; j < 4; ++j) { qv[kk][j] *= rs * g0[j]; qv[kk][4 + j] *= rs * g1[j]; } }
        const f32x4_t* rp = (const f32x4_t*)(rope + ((size_t)(q0 + wid * 32 + r32) * 16 + 8 * hi) * 2);
#pragma unroll
        for (int j2 = 0; j2 < 4; ++j2) { const f32x4_t cs = rp[j2];
            { const float x1 = qv[4][2 * j2], x2 = qv[5][2 * j2]; qv[4][2 * j2] = x1 * cs[0] - x2 * cs[1]; qv[5][2 * j2] = x2 * cs[0] + x1 * cs[1]; }
            { const float x1 = qv[4][2 * j2 + 1], x2 = qv[5][2 * j2 + 1]; qv[4][2 * j2 + 1] = x1 * cs[2] - x2 * cs[3]; qv[5][2 * j2 + 1] = x2 * cs[2] + x1 * cs[3]; } }
#pragma unroll
        for (int kk = 0; kk < DQK / 16; ++kk) { u32x4 w; w.x = cvtpk(qv[kk][0], qv[kk][1]); w.y = cvtpk(qv[kk][2], qv[kk][3]); w.z = cvtpk(qv[kk][4], qv[kk][5]); w.w = cvtpk(qv[kk][6], qv[kk][7]);
            qf[kk] = __builtin_bit_cast(bf16x8, w); }
    }
    if (BAND) { if (tid < 257) biasL[tid] = bias_g[tid] * 1.4426950408889634f; }
    constexpr int KCPL = G::KSTR / 16, KNP = (64 * KCPL + 63) / 64;
    constexpr int VCPL = VSTR / 16, VNP = 64 * VCPL / 64;
    constexpr int KPP = (KNP + 7) / 8, VPP = (VNP + 7) / 8;
    ATT_LAS unsigned* dmaL = (ATT_LAS unsigned*)(lds + 2 * G::KBUF + 2 * G::VBUF + 2048) + wid * 256 + lane;
#pragma unroll
    for (int pp = 0; pp < KPP; ++pp) { const int pc = wid + 8 * pp, c = pc * 64 + lane, row = (c / KCPL) & 63, ch = c % KCPL; dmaL[64 * pp] = (unsigned)(row * kpitch + (ch < G::CPR ? ch : 0) * 8) * 2u; }
#pragma unroll
    for (int pp = 0; pp < VPP; ++pp) { const int pc = wid + 8 * pp, c = pc * 64 + lane, row = (c / VCPL) & 63, ch = c % VCPL; dmaL[128 + 64 * pp] = (unsigned)(row * vpitch + (ch < 8 ? ch : 0) * 8) * 2u; }
#define ATT_DMA_K(t, b) do { const char* kt_ = (const char*)(Kb + (size_t)(t) * 64 * kpitch); _Pragma("unroll") for (int pp = 0; pp < KPP; ++pp) { if (wid + 8 * pp < KNP) \
            __builtin_amdgcn_global_load_lds((const unsigned*)(kt_ + dmaL[64 * pp]), (ATT_LAS unsigned*)(lds + (b) * G::KBUF + (wid + 8 * pp) * 1024), 16, 0, 0); } } while (0)
#define ATT_DMA_V(t, b) do { const char* vt_ = (const char*)(Vb + (size_t)(t) * 64 * vpitch); _Pragma("unroll") for (int pp = 0; pp < VPP; ++pp) { if (wid + 8 * pp < VNP) \
            __builtin_amdgcn_global_load_lds((const unsigned*)(vt_ + dmaL[128 + 64 * pp]), (ATT_LAS unsigned*)(lds + 2 * G::KBUF + (b) * G::VBUF + (wid + 8 * pp) * 1024), 16, 0, 0); } } while (0)
    f32x16 o0, o1;
#pragma unroll
    for (int i = 0; i < 16; ++i) { o0[i] = 0.f; o1[i] = 0.f; }
    float mrun = -INFINITY, lsum = 0.f;
    const int koff = r32 * G::KSTR + hi * 16;
    const int voff = ((lane >> 5) * 4 + ((lane & 15) >> 2)) * VSTR + (((lane >> 4) & 1) * 16 + (lane & 3) * 4) * 2;
    const f32x16 zero16 = {0.f, 0.f, 0.f, 0.f, 0.f, 0.f, 0.f, 0.f, 0.f, 0.f, 0.f, 0.f, 0.f, 0.f, 0.f, 0.f};
#define ATT_QK(X0, X1, t) do { const ATT_LAS unsigned char* Kt = lds + ((t) & 1) * G::KBUF + koff; \
        _Pragma("unroll") for (int kk = 0; kk < DQK / 16; ++kk) { \
            const bf16x8 a0 = *(const ATT_LAS bf16x8*)(Kt + kk * 32); const bf16x8 a1 = *(const ATT_LAS bf16x8*)(Kt + 32 * G::KSTR + kk * 32); \
            X0 = __builtin_amdgcn_mfma_f32_32x32x16_bf16(a0, qf[kk], kk ? X0 : zero16, 0, 0, 0); X1 = __builtin_amdgcn_mfma_f32_32x32x16_bf16(a1, qf[kk], kk ? X1 : zero16, 0, 0, 0); } } while (0)
#define ATT_SMPV(X0, X1, t) do { \
        float cadd = 0.f; \
        if (BAND) { const int delta = cc - (t); \
            if (delta >= 3) cadd = biasL[256]; \
            else { const ATT_LAS float* bp = biasL + (64 * delta + (32 * (wid & 1) + r32) - 4 * hi + 128 - 63); \
                if (delta < 2) { _Pragma("unroll") for (int i = 0; i < 16; ++i) { const int kj = (i & 3) + 8 * (i >> 2); X0[i] += bp[63 - kj]; X1[i] += bp[31 - kj]; } } \
                else { const int relb = 64 * delta + (32 * (wid & 1) + r32) - 4 * hi + 128; \
                    _Pragma("unroll") for (int i = 0; i < 16; ++i) { const int kj = (i & 3) + 8 * (i >> 2); int i0 = relb - kj, i1 = relb - kj - 32; i0 = i0 > 256 ? 256 : i0; i1 = i1 > 256 ? 256 : i1; \
                        X0[i] += biasL[i0]; X1[i] += biasL[i1]; } } } } \
        const float mt = rowmax32(X0, X1) + cadd; \
        const float mnew = max2f(mrun, mt); \
        const float alpha = __builtin_amdgcn_exp2f(mrun - mnew); \
        const float msub = mnew - cadd; \
        mrun = mnew; \
        float psa[4] = {0.f, 0.f, 0.f, 0.f};   \
        _Pragma("unroll") for (int i = 0; i < 16; ++i) { X0[i] = __builtin_amdgcn_exp2f(X0[i] - msub); X1[i] = __builtin_amdgcn_exp2f(X1[i] - msub); psa[i & 3] += X0[i] + X1[i]; } \
        const float ps = (psa[0] + psa[1]) + (psa[2] + psa[3]); \
        lsum = lsum * alpha + ps; \
        _Pragma("unroll") for (int i = 0; i < 16; ++i) { o0[i] *= alpha; o1[i] *= alpha; } \
        bf16x8 pf[2][2]; \
        _Pragma("unroll") for (int s = 0; s < 2; ++s) { u32x4 w0, w1; \
            w0.x = cvtpk(X0[8 * s + 0], X0[8 * s + 1]); w0.y = cvtpk(X0[8 * s + 2], X0[8 * s + 3]); w0.z = cvtpk(X0[8 * s + 4], X0[8 * s + 5]); w0.w = cvtpk(X0[8 * s + 6], X0[8 * s + 7]); \
            w1.x = cvtpk(X1[8 * s + 0], X1[8 * s + 1]); w1.y = cvtpk(X1[8 * s + 2], X1[8 * s + 3]); w1.z = cvtpk(X1[8 * s + 4], X1[8 * s + 5]); w1.w = cvtpk(X1[8 * s + 6], X1[8 * s + 7]); \
            pf[0][s] = __builtin_bit_cast(bf16x8, w0); pf[1][s] = __builtin_bit_cast(bf16x8, w1); } \
        const ATT_LAS unsigned char* Vt = lds + 2 * G::KBUF + ((t) & 1) * G::VBUF + voff; \
        _Pragma("unroll") for (int kb = 0; kb < 2; ++kb) _Pragma("unroll") for (int s = 0; s < 2; ++s) { \
            const ATT_LAS unsigned char* vp = Vt + (32 * kb + 16 * s) * VSTR; \
            const s16x4 l0 = vtr(vp), h0 = vtr(vp + 8 * VSTR), l1 = vtr(vp + 64), h1 = vtr(vp + 8 * VSTR + 64); \
            const bf16x8 a0 = (bf16x8){l0[0], l0[1], l0[2], l0[3], h0[0], h0[1], h0[2], h0[3]}; \
            const bf16x8 a1 = (bf16x8){l1[0], l1[1], l1[2], l1[3], h1[0], h1[1], h1[2], h1[3]}; \
            o0 = __builtin_amdgcn_mfma_f32_32x32x16_bf16(a0, pf[kb][s], o0, 0, 0, 0); o1 = __builtin_amdgcn_mfma_f32_32x32x16_bf16(a1, pf[kb][s], o1, 0, 0, 0); } } while (0)
#define ATT_FUSED(C0, C1, N0, N1, t, tn) do { \
        bf16x8 kfa[DQK / 16], kfb[DQK / 16]; \
        { const ATT_LAS unsigned char* Kt = lds + ((tn) & 1) * G::KBUF + koff; \
          _Pragma("unroll") for (int kk = 0; kk < DQK / 16; ++kk) { kfa[kk] = *(const ATT_LAS bf16x8*)(Kt + kk * 32); kfb[kk] = *(const ATT_LAS bf16x8*)(Kt + 32 * G::KSTR + kk * 32); } } \
        __builtin_amdgcn_sched_barrier(0); \
        float cadd = 0.f; \
        if (BAND) { const int delta = cc - (t); \
            if (delta >= 3) cadd = biasL[256]; \
            else { const ATT_LAS float* bp = biasL + (64 * delta + (32 * (wid & 1) + r32) - 4 * hi + 128 - 63); \
                if (delta < 2) { _Pragma("unroll") for (int i = 0; i < 16; ++i) { const int kj = (i & 3) + 8 * (i >> 2); C0[i] += bp[63 - kj]; C1[i] += bp[31 - kj]; } } \
                else { const int relb = 64 * delta + (32 * (wid & 1) + r32) - 4 * hi + 128; \
                    _Pragma("unroll") for (int i = 0; i < 16; ++i) { const int kj = (i & 3) + 8 * (i >> 2); int i0 = relb - kj, i1 = relb - kj - 32; i0 = i0 > 256 ? 256 : i0; i1 = i1 > 256 ? 256 : i1; \
                        C0[i] += biasL[i0]; C1[i] += biasL[i1]; } } } } \
        const float mt = rowmax32(C0, C1) + cadd; \
        const float mnew = max2f(mrun, mt); \
        const float alpha = __builtin_amdgcn_exp2f(mrun - mnew); \
        const float msub = mnew - cadd; \
        if (__builtin_amdgcn_ballot_w64(mnew > mrun)) { _Pragma("unroll") for (int i = 0; i < 16; ++i) { o0[i] *= alpha; o1[i] *= alpha; } } \
        mrun = mnew; \
        __builtin_amdgcn_sched_barrier(0); \
        _Pragma("unroll") for (int kk = 0; kk < DQK / 16; ++kk) { \
            N0 = __builtin_amdgcn_mfma_f32_32x32x16_bf16(kfa[kk], qf[kk], kk ? N0 : zero16, 0, 0, 0); N1 = __builtin_amdgcn_mfma_f32_32x32x16_bf16(kfb[kk], qf[kk], kk ? N1 : zero16, 0, 0, 0); } \
        s16x4 vl0[4], vh0[4], vl1[4], vh1[4]; \
        { const ATT_LAS unsigned char* Vt = lds + 2 * G::KBUF + ((t) & 1) * G::VBUF + voff; \
          _Pragma("unroll") for (int ks = 0; ks < 4; ++ks) { const ATT_LAS unsigned char* vp = Vt + 16 * ks * VSTR; vl0[ks] = vtr(vp); vh0[ks] = vtr(vp + 8 * VSTR); vl1[ks] = vtr(vp + 64); vh1[ks] = vtr(vp + 8 * VSTR + 64); } } \
        float psa[4] = {0.f, 0.f, 0.f, 0.f}; \
        _Pragma("unroll") for (int i = 0; i < 16; ++i) { C0[i] = __builtin_amdgcn_exp2f(C0[i] - msub); C1[i] = __builtin_amdgcn_exp2f(C1[i] - msub); psa[i & 3] += C0[i] + C1[i]; } \
        const float ps = (psa[0] + psa[1]) + (psa[2] + psa[3]); \
        lsum = lsum * alpha + ps; \
        bf16x8 pf[4]; \
        _Pragma("unroll") for (int s = 0; s < 2; ++s) { u32x4 w0, w1; \
            w0.x = cvtpk(C0[8 * s + 0], C0[8 * s + 1]); w0.y = cvtpk(C0[8 * s + 2], C0[8 * s + 3]); w0.z = cvtpk(C0[8 * s + 4], C0[8 * s + 5]); w0.w = cvtpk(C0[8 * s + 6], C0[8 * s + 7]); \
            w1.x = cvtpk(C1[8 * s + 0], C1[8 * s + 1]); w1.y = cvtpk(C1[8 * s + 2], C1[8 * s + 3]); w1.z = cvtpk(C1[8 * s + 4], C1[8 * s + 5]); w1.w = cvtpk(C1[8 * s + 6], C1[8 * s + 7]); \
            pf[s] = __builtin_bit_cast(bf16x8, w0); pf[2 + s] = __builtin_bit_cast(bf16x8, w1); } \
        __builtin_amdgcn_sched_barrier(0); \
        _Pragma("unroll") for (int ks = 0; ks < 4; ++ks) { \
            const bf16x8 a0 = (bf16x8){vl0[ks][0], vl0[ks][1], vl0[ks][2], vl0[ks][3], vh0[ks][0], vh0[ks][1], vh0[ks][2], vh0[ks][3]}; \
            const bf16x8 a1 = (bf16x8){vl1[ks][0], vl1[ks][1], vl1[ks][2], vl1[ks][3], vh1[ks][0], vh1[ks][1], vh1[ks][2], vh1[ks][3]}; \
            o0 = __builtin_amdgcn_mfma_f32_32x32x16_bf16(a0, pf[ks], o0, 0, 0, 0); o1 = __builtin_amdgcn_mfma_f32_32x32x16_bf16(a1, pf[ks], o1, 0, 0, 0); } } while (0)
#define ATT_STAGE(t) do { if ((t) + 2 <= t_hi) ATT_DMA_K((t) + 2, (t) & 1); if ((t) + 1 <= t_hi) ATT_DMA_V((t) + 1, ((t) + 1) & 1); } while (0)
    f32x16 sa0, sa1, sb0, sb1;
    ATT_DMA_K(t_lo, t_lo & 1);
    __syncthreads();
    if (t_lo + 1 <= t_hi) ATT_DMA_K(t_lo + 1, (t_lo + 1) & 1);
    ATT_DMA_V(t_lo, t_lo & 1);
    if (my_lo == t_lo) ATT_QK(sa0, sa1, t_lo);
    __syncthreads();
    {
        int t = t_lo;
        for (; t < my_lo - 1; ++t) { ATT_STAGE(t); __syncthreads(); }
        if (my_lo > t_lo) { ATT_STAGE(t); ATT_QK(sa0, sa1, t + 1); __syncthreads(); ++t; }
        int nf = my_hi - my_lo;
        for (; nf >= 2; nf -= 2, t += 2) {
            ATT_STAGE(t); ATT_FUSED(sa0, sa1, sb0, sb1, t, t + 1); __syncthreads();
            ATT_STAGE(t + 1); ATT_FUSED(sb0, sb1, sa0, sa1, t + 1, t + 2); __syncthreads();
        }
        if (nf == 1) {
            ATT_STAGE(t); ATT_FUSED(sa0, sa1, sb0, sb1, t, t + 1); __syncthreads(); ++t;
            ATT_STAGE(t); ATT_SMPV(sb0, sb1, t); __syncthreads(); ++t;
        } else {
            ATT_STAGE(t); ATT_SMPV(sa0, sa1, t); __syncthreads(); ++t;
        }
        for (; t <= t_hi; ++t) { ATT_STAGE(t); __syncthreads(); }
    }
    const float ltot = xhalf_sum(lsum);
    const float inv = 1.f / ltot;
    if constexpr (OF8) {
        unsigned char* op = (unsigned char*)Ob + (size_t)(q0 + wid * 32 + r32) * opitch + 4 * hi; const float i64 = inv * 64.f;
#pragma unroll
        for (int g4 = 0; g4 < 4; ++g4) {
            int w0 = 0, w1 = 0;
            w0 = __builtin_amdgcn_cvt_pk_fp8_f32(o0[4 * g4 + 0] * i64, o0[4 * g4 + 1] * i64, w0, false); w0 = __builtin_amdgcn_cvt_pk_fp8_f32(o0[4 * g4 + 2] * i64, o0[4 * g4 + 3] * i64, w0, true);
            w1 = __builtin_amdgcn_cvt_pk_fp8_f32(o1[4 * g4 + 0] * i64, o1[4 * g4 + 1] * i64, w1, false); w1 = __builtin_amdgcn_cvt_pk_fp8_f32(o1[4 * g4 + 2] * i64, o1[4 * g4 + 3] * i64, w1, true);
            *(int*)(op + 8 * g4) = w0; *(int*)(op + 32 + 8 * g4) = w1;
        }
    } else {
    bf16* op = Ob + (size_t)(q0 + wid * 32 + r32) * opitch + 4 * hi;
#pragma unroll
    for (int g4 = 0; g4 < 4; ++g4) {
        u32x2 w0, w1;
        w0.x = cvtpk(o0[4 * g4 + 0] * inv, o0[4 * g4 + 1] * inv); w0.y = cvtpk(o0[4 * g4 + 2] * inv, o0[4 * g4 + 3] * inv);
        w1.x = cvtpk(o1[4 * g4 + 0] * inv, o1[4 * g4 + 1] * inv); w1.y = cvtpk(o1[4 * g4 + 2] * inv, o1[4 * g4 + 3] * inv);
        *(u32x2*)(op + 8 * g4) = w0; *(u32x2*)(op + 32 + 8 * g4) = w1;
    }
    }
#undef ATT_DMA_K
#undef ATT_DMA_V
#undef ATT_QK
#undef ATT_SMPV
#undef ATT_STAGE
#undef ATT_FUSED
}
}
constexpr int NWAVES = 8;
constexpr int D = 1024, BATCH = 32, SEQ = 2048, M = BATCH * SEQ;
constexpr int NH = 16, QLORA = 384, KVLORA = 256, ROPE_D = 32, NOPE = 64, QKD = 96;
constexpr int NA = 768;
constexpr int FF = 2816, EFF = 3584, NE = 8;
constexpr float EPS = 1e-6f, LOG2E = 1.4426950408889634f;
constexpr int MAXP_HALF = 264, MAXP = 528;
constexpr size_t MiB = 1u << 20;
constexpr size_t WS_CTL = 0, CTL_ZERO_BYTES = 1 * MiB;
constexpr size_t WS_ROPE = 1 * MiB;
constexpr size_t WS_CNT = WS_ROPE + 256 * 1024;
constexpr size_t WS_PANELE = WS_CNT + 16 * 1024;
constexpr size_t WS_META = WS_PANELE + 4096;
constexpr size_t WS_TOKE = 2 * MiB;
constexpr size_t WS_TOKG = WS_TOKE + (size_t)M * 4;
constexpr size_t WS_SLOTTOK = WS_TOKG + (size_t)M * 8;
constexpr size_t WS_SLOTGATE = WS_SLOTTOK + (size_t)MAXP * 256 * 4;
constexpr size_t WS_PARTQA = 976 * MiB, WS_PART1 = 980 * MiB, WS_PART2 = 984 * MiB;
constexpr size_t WS_TOKRSTD = 4 * MiB;
constexpr size_t WS_SLOTRSTD = WS_TOKRSTD + (size_t)M * 4;
static_assert(WS_SLOTGATE + (size_t)MAXP * 256 * 4 <= WS_TOKRSTD && WS_SLOTRSTD + (size_t)MAXP * 256 * 4 <= 8 * MiB, "small arrays");
constexpr size_t WS_W = 8 * MiB;
constexpr size_t WS_WA = WS_W, WS_WUQ = WS_WA + (size_t)NA * D * 2, WS_WUKV = WS_WUQ + (size_t)1536 * QLORA * 2, WS_WO = WS_WUKV + (size_t)2048 * KVLORA * 2;
constexpr size_t WS_WF1 = WS_WO + (size_t)D * D * 2, WS_WF2 = WS_WF1 + (size_t)2 * FF * D * 2, WS_WKVQ = WS_WF2 + (size_t)D * FF * 2, WS_WBO = WS_WKVQ + (size_t)3 * D * D * 2;
constexpr size_t WS_WM1 = WS_WBO + (size_t)D * D * 2, WS_WM2 = WS_WM1 + (size_t)NE * 2 * EFF * D * 2, WS_WEND = WS_WM2 + (size_t)NE * D * EFF * 2;
constexpr size_t ARENA = 208 * MiB;
static_assert(WS_WEND <= ARENA, "weights fit under the arena");
constexpr size_t WS_XN = ARENA;
constexpr size_t WS_QA = ARENA + 128 * MiB;
constexpr size_t WS_Q = ARENA + 224 * MiB;
constexpr size_t WS_K = ARENA + 416 * MiB;
constexpr size_t WS_V = ARENA + 608 * MiB;
constexpr size_t WS_O = ARENA;
static_assert(WS_V + (size_t)M * D * 2 <= 1024 * MiB, "MLA arena");
constexpr size_t WS_XR1 = ARENA + 128 * MiB;
constexpr size_t WS_H = ARENA + 256 * MiB;
constexpr size_t WS_XR2 = ARENA;
constexpr size_t WS_KVQ2 = ARENA + 128 * MiB;
constexpr size_t WS_O2 = ARENA + 512 * MiB;
constexpr size_t WS_XR3 = ARENA + 640 * MiB;
constexpr size_t WS_XG = ARENA;
constexpr size_t WS_HM = ARENA + 264 * MiB;
constexpr size_t WS_END = WS_HM + (size_t)MAXP_HALF * 256 * EFF * 2;
static_assert(WS_XG + (size_t)MAXP * 256 * D * 2 <= WS_HM && WS_END <= 1024 * MiB && WS_XR3 + (size_t)M * D * 2 <= 1024 * MiB && WS_H + (size_t)M * FF * 2 <= 1024 * MiB, "arena");
constexpr int CW_BAR = 4096;
constexpr int RING_OFF = 0, RING_BYTES = 131072;
constexpr int P0_SCR = 128 * 33 * 4;
constexpr int LDSCTL_OFF = 8 * P0_SCR, MISC_OFF = LDSCTL_OFF + 320;
static_assert(LDSCTL_OFF >= RING_BYTES, "control words above every phase's scratch");
constexpr int LDS_BYTES = 147456;
static_assert(MISC_OFF + 128 <= LDS_BYTES, "LDS map");
static_assert(att::lds_bytes<96>() <= RING_BYTES, "attention scratch fits the ring region");

#define GAS __attribute__((address_space(1)))
#define LAS __attribute__((address_space(3)))
typedef unsigned short bf16;
typedef unsigned v4u __attribute__((ext_vector_type(4)));
typedef unsigned v2u __attribute__((ext_vector_type(2)));
typedef float f32x4 __attribute__((ext_vector_type(4)));
typedef GAS unsigned gu32;
#define RLX_AGENT __ATOMIC_RELAXED, __HIP_MEMORY_SCOPE_AGENT
#define LDS_WAIT() asm volatile("s_waitcnt lgkmcnt(0)" ::: "memory")
__device__ __forceinline__ unsigned f2bf(float f) { unsigned u = __builtin_bit_cast(unsigned, f); return (u + 0x7fffu + ((u >> 16) & 1u)) >> 16; }
__device__ __forceinline__ unsigned pk2(float lo, float hi) { return f2bf(lo) | (f2bf(hi) << 16); }
__device__ __forceinline__ float bflo(unsigned u) { return __builtin_bit_cast(float, u << 16); }
__device__ __forceinline__ float bfhi(unsigned u) { return __builtin_bit_cast(float, u & 0xffff0000u); }
__device__ __forceinline__ float wave_sum(float v) {
    v += swz_xor<1>(v); v += swz_xor<2>(v); v += swz_xor<4>(v); v += swz_xor<8>(v); v += swz_xor<16>(v);
    return xor32_sum(v);
}

#define XB_TMO      128
#define XB_XCNT(j)  (256  + 64 * (j))
#define XB_XSUB(j)  (1280 + 64 * (j))
#define XB_XGEN(j)  (2304 + 64 * (j))
#define XB_TOP      3328
#define XB_TOPGEN   3392
#define XCD_BAR_WORDS 3456
#define XB_SPIN_CAP (1u << 18)

__device__ __forceinline__ unsigned xb_ld(unsigned* p)              { return __hip_atomic_load(p, __ATOMIC_RELAXED, __HIP_MEMORY_SCOPE_AGENT); }
__device__ __forceinline__ unsigned xb_add(unsigned* p, unsigned v) { return __hip_atomic_fetch_add(p, v, __ATOMIC_RELAXED, __HIP_MEMORY_SCOPE_AGENT); }
__device__ __forceinline__ unsigned xb_xcc_id() { return (unsigned)__builtin_amdgcn_s_getreg((3 << 11) | 20) & 0xFu; }
#define XB_SPIN(cond, bar) do { unsigned _sp = 0; while (cond) { __builtin_amdgcn_s_sleep(1); \
    if ((++_sp & 255u) == 0u) { if (xb_ld(&(bar)[XB_TMO])) break; if (_sp > XB_SPIN_CAP) { atomicAdd(&(bar)[XB_TMO], 1u); break; } } } } while (0)

struct XcdBarrier {
    int t0;
    unsigned* bar; unsigned x;
    volatile LAS unsigned* st;
};

__device__ __forceinline__ XcdBarrier xcd_barrier_post(unsigned* bar, volatile LAS unsigned* st, int t0) {
    XcdBarrier b; b.t0 = t0; b.bar = bar; b.x = xb_xcc_id(); b.st = st;
    if (b.t0) (void)xb_add(&bar[XB_XCNT(b.x)], 1u);
    return b;
}
__device__ __forceinline__ void xcd_barrier_complete(unsigned* bar, unsigned x, unsigned& nloc, unsigned& nx) {
    const unsigned G = gridDim.x * gridDim.y * gridDim.z;
    unsigned sum, cnt, mine, sp = 0u;
    for (;;) {
        sum = 0u; cnt = 0u; mine = 0u;
#pragma unroll
        for (unsigned j = 0; j < 16; ++j) { const unsigned c = xb_ld(&bar[XB_XCNT(j)]); sum += c; cnt += (c > 0u) ? 1u : 0u; mine = (j == x) ? c : mine; }
        if (sum == G) break;
        __builtin_amdgcn_s_sleep(1);
        if ((++sp & 255u) == 0u) { if (xb_ld(&bar[XB_TMO])) break; if (sp > XB_SPIN_CAP) { atomicAdd(&bar[XB_TMO], 1u); break; } }
    }
    nloc = mine > 0u ? mine : 1u; nx = cnt > 0u ? cnt : 1u;
}

__device__ __forceinline__ void xcd_barrier(const XcdBarrier& b) {
    asm volatile("s_waitcnt vmcnt(0)" ::: "memory");
    __syncthreads();
    if (b.t0) {
        unsigned* bar = b.bar;
        __builtin_amdgcn_s_waitcnt(0);
        unsigned nloc = b.st[0], nx = b.st[1];
        if (nloc == 0u) { xcd_barrier_complete(bar, b.x, nloc, nx); b.st[0] = nloc; b.st[1] = nx; }
        const unsigned old = xb_add(&bar[XB_XSUB(b.x)], 1u);
        const unsigned gen = old / nloc;
        if (old + 1u == (gen + 1u) * nloc) {
            __builtin_amdgcn_fence(__ATOMIC_RELEASE, "agent");
            asm volatile("s_waitcnt vmcnt(0)" ::: "memory");
            const unsigned og = xb_add(&bar[XB_TOP], 1u);
            const unsigned tg = og / nx;
            if (og + 1u == (tg + 1u) * nx) xb_add(&bar[XB_TOPGEN], 1u);
            else XB_SPIN(xb_ld(&bar[XB_TOPGEN]) == tg, bar);
            __builtin_amdgcn_fence(__ATOMIC_ACQUIRE, "agent");
            xb_add(&bar[XB_XGEN(b.x)], 1u);
            asm volatile("s_waitcnt vmcnt(0)" ::: "memory");
        } else {
            XB_SPIN(xb_ld(&bar[XB_XGEN(b.x)]) == gen, bar);
            __builtin_amdgcn_fence(__ATOMIC_ACQUIRE, "agent");
            asm volatile("s_waitcnt vmcnt(0)" ::: "memory");
        }
    }
    __syncthreads();
}

struct Args { const float* in[27]; float* out; unsigned char* ws; };
enum { I_X = 0, I_ATTN_NORM, I_FFN_NORM, I_A_WDQ, I_A_GCQ, I_A_WUQ, I_A_WDKV, I_A_GCKV, I_A_WUKV, I_A_GQN, I_A_GKN, I_A_WO, I_KV_NORM, I_KV_WK, I_KV_WV, I_KV_GKN,
       I_B_WQ, I_B_GQN, I_B_RELB, I_B_WO, I_FFN_W1, I_FFN_W3, I_FFN_W2, I_MOE_ROUTER, I_MOE_W1, I_MOE_W3, I_MOE_W2 };

struct Frame {
    LAS unsigned char* lds;
    int wave, vcu, G;
};
typedef const __attribute__((address_space(4))) Args* KArgs;
__device__ __forceinline__ KArgs kargs() { KArgs p = (KArgs)__builtin_amdgcn_kernarg_segment_ptr(); asm volatile("" : "+s"(p)); return p; }
#define INP(i) (kargs()->in[i])
#define OUTP (kargs()->out)
#define WSP (kargs()->ws)
__device__ __forceinline__ int fresh(int v) { asm volatile("" : "+v"(v)); return v; }

__device__ __forceinline__ void tr_item(const float* W, int ldw, int K, int k0, int nsrc0, const float* gain, bf16* WT, int drow0, LAS float* scr, int lane) {
    const int c4 = lane & 7, r = lane >> 3;
    const GAS float* src = (const GAS float*)W + (size_t)(k0 + r) * ldw + nsrc0 + 4 * c4;
    f32x4 v[16];
#pragma unroll
    for (int i = 0; i < 16; ++i) v[i] = *(const GAS f32x4*)(src + (size_t)(8 * i) * ldw);
    if (gain) {
#pragma unroll
        for (int i = 0; i < 16; ++i) v[i] = v[i] * gain[k0 + 8 * i + r];
    }
#pragma unroll
    for (int i = 0; i < 16; ++i) { LAS float* d = scr + (8 * i + r) * 33 + 4 * c4; d[0] = v[i].x; d[1] = v[i].y; d[2] = v[i].z; d[3] = v[i].w; }
    LDS_WAIT(); asm volatile("" ::: "memory");
    const int c16 = lane >> 2;
#pragma unroll
    for (int j = 0; j < 8; ++j) { const int n = (lane & 3) + 4 * j; const LAS float* sp = scr + (8 * c16) * 33 + n;
        v4u o; o.x = pk2(sp[0 * 33], sp[1 * 33]); o.y = pk2(sp[2 * 33], sp[3 * 33]); o.z = pk2(sp[4 * 33], sp[5 * 33]); o.w = pk2(sp[6 * 33], sp[7 * 33]);
        *(GAS v4u*)(WT + (size_t)(drow0 + n) * K + k0 + 8 * c16) = o; }
    LDS_WAIT(); asm volatile("" ::: "memory");
}
__device__ __forceinline__ void tr_plain(const float* W, int K, int N, const float* gain, bf16* WT, int drow_off, LAS float* scr, int item, int lane) {
    const int nblk = N / 32, kb = item / nblk, nb = item % nblk;
    tr_item(W, N, K, 128 * kb, 32 * nb, gain, WT, drow_off + 32 * nb, scr, lane);
}
__device__ __forceinline__ void tr_gated(const float* W, int K, int N, const float* gain, bf16* WT, int half, LAS float* scr, int item, int lane) {
    const int nblk = N / 32, kb = item / nblk, nb = item % nblk, n0 = 32 * nb;
    tr_item(W, N, K, 128 * kb, n0, gain, WT, (n0 >> 7) * 256 + half * 128 + (n0 & 127), scr, lane);
}
__device__ __forceinline__ unsigned pk_fp8x4(float a, float b, float c, float d) { int w = 0; w = __builtin_amdgcn_cvt_pk_fp8_f32(a, b, w, false); w = __builtin_amdgcn_cvt_pk_fp8_f32(c, d, w, true); return (unsigned)w; }
__device__ __forceinline__ void tr_item_f8(const float* W, int ldw, int K, int k0, int nsrc0, const float* gain, unsigned char* WT, int drow0, LAS float* scr, int lane) {
    const int c4 = lane & 7, r = lane >> 3;
    const GAS float* src = (const GAS float*)W + (size_t)(k0 + r) * ldw + nsrc0 + 4 * c4;
    f32x4 v[16];
#pragma unroll
    for (int i = 0; i < 16; ++i) v[i] = *(const GAS f32x4*)(src + (size_t)(8 * i) * ldw);
#pragma unroll
    for (int i = 0; i < 16; ++i) v[i] = v[i] * (gain ? gain[k0 + 8 * i + r] * 64.f : 64.f);
#pragma unroll
    for (int i = 0; i < 16; ++i) { LAS float* d = scr + (8 * i + r) * 33 + 4 * c4; d[0] = v[i].x; d[1] = v[i].y; d[2] = v[i].z; d[3] = v[i].w; }
    LDS_WAIT(); asm volatile("" ::: "memory");
    const int c8 = lane >> 3;
#pragma unroll
    for (int j = 0; j < 4; ++j) { const int n = (lane & 7) + 8 * j; const LAS float* sp = scr + (16 * c8) * 33 + n;
        v4u o; o.x = pk_fp8x4(sp[0 * 33], sp[1 * 33], sp[2 * 33], sp[3 * 33]); o.y = pk_fp8x4(sp[4 * 33], sp[5 * 33], sp[6 * 33], sp[7 * 33]);
        o.z = pk_fp8x4(sp[8 * 33], sp[9 * 33], sp[10 * 33], sp[11 * 33]); o.w = pk_fp8x4(sp[12 * 33], sp[13 * 33], sp[14 * 33], sp[15 * 33]);
        *(GAS v4u*)(WT + (size_t)(drow0 + n) * K + k0 + 16 * c8) = o; }
    LDS_WAIT(); asm volatile("" ::: "memory");
}
__device__ __forceinline__ float rms_row_to_bf16(const float* xrow, bf16* orow, int lane, f32x4 (&v)[4]) {
    const GAS f32x4* xr = (const GAS f32x4*)xrow + lane;
    float s = 0.f;
#pragma unroll
    for (int j = 0; j < 4; ++j) { v[j] = xr[64 * j]; s += (v[j].x * v[j].x + v[j].y * v[j].y) + (v[j].z * v[j].z + v[j].w * v[j].w); }
    const float rstd = 1.f / sqrtf(wave_sum(s) * (1.f / D) + EPS);
    GAS unsigned long long* o8 = (GAS unsigned long long*)orow + lane;
#pragma unroll
    for (int j = 0; j < 4; ++j) o8[64 * j] = (unsigned long long)pk2(v[j].x * rstd, v[j].y * rstd) | ((unsigned long long)pk2(v[j].z * rstd, v[j].w * rstd) << 32);
    return rstd;
}
__device__ __forceinline__ void norm_phase(const Frame& F, const float* x, bf16* xn) {
    const int tid = fresh(F.wave * 64 + lane_id_()), lane = tid & 63; (void)lane;
    const int gw = F.vcu * NWAVES + F.wave, NGW = F.G * NWAVES;
    for (int m = 2 * gw; m < M; m += 2 * NGW) {
        const GAS f32x4* xr = (const GAS f32x4*)(x + (size_t)m * D) + lane;
        f32x4 v[8]; float s0 = 0.f, s1 = 0.f;
#pragma unroll
        for (int j = 0; j < 8; ++j) v[j] = xr[64 * j];
#pragma unroll
        for (int j = 0; j < 4; ++j) { s0 += (v[j].x * v[j].x + v[j].y * v[j].y) + (v[j].z * v[j].z + v[j].w * v[j].w); s1 += (v[4 + j].x * v[4 + j].x + v[4 + j].y * v[4 + j].y) + (v[4 + j].z * v[4 + j].z + v[4 + j].w * v[4 + j].w); }
        const float r0 = 1.f / sqrtf(wave_sum(s0) * (1.f / D) + EPS), r1 = 1.f / sqrtf(wave_sum(s1) * (1.f / D) + EPS);
        GAS unsigned* o4 = (GAS unsigned*)((GAS unsigned char*)xn + (size_t)m * D) + lane;
#pragma unroll
        for (int j = 0; j < 8; ++j) { const float rr = j < 4 ? r0 : r1; o4[64 * j] = pk_fp8x4(v[j].x * rr, v[j].y * rr, v[j].z * rr, v[j].w * rr); }
    }
}

__device__ __forceinline__ void p0_prologue(const Frame& F) {
    const int tid = fresh(F.wave * 64 + lane_id_()), lane = tid & 63; (void)lane;
    LAS float* scr = (LAS float*)(F.lds + RING_OFF + F.wave * P0_SCR);
    unsigned char* ws = WSP;
    const int gw = F.vcu * NWAVES + F.wave, NGW = F.G * NWAVES;
    constexpr int I_DQ = 8 * 12, I_DKV = 8 * 9, I_UQ = 3 * 48, I_UKV = 2 * 64, I_SQ = 8 * 32, I_F13 = 8 * 88, I_F2 = 22 * 32, I_M13 = 8 * 112, I_M2 = 28 * 32;
    constexpr int NSMALL = I_DQ + I_DKV + I_UQ + I_UKV + I_SQ + 2 * I_F13 + I_F2 + 4 * I_SQ;
    constexpr int NITEMS = NSMALL + NE * (2 * I_M13 + I_M2);
    for (int it = gw; it < NITEMS; it += NGW) {
        int r = it;
        if (r < I_DQ)  { const int kb = r / 12, n0 = 32 * (r % 12); tr_item_f8(INP(I_A_WDQ), QLORA, D, 128 * kb, n0, INP(I_ATTN_NORM), ws + WS_WA, n0, scr, lane); continue; } r -= I_DQ;
        if (r < I_DKV) { const int kb = r / 9, n0 = 32 * (r % 9); tr_item_f8(INP(I_A_WDKV), KVLORA + ROPE_D, D, 128 * kb, n0, INP(I_ATTN_NORM), ws + WS_WA, QLORA + n0, scr, lane); continue; } r -= I_DKV;
        if (r < I_UQ)  { tr_plain(INP(I_A_WUQ), QLORA, NH * QKD, INP(I_A_GCQ), (bf16*)(ws + WS_WUQ), 0, scr, r, lane); continue; } r -= I_UQ;
        if (r < I_UKV) { const int kb = r / 64, n0 = 32 * (r % 64), head = n0 >> 7, within = n0 & 127;
            const int drow = within < 64 ? 256 * (head >> 2) + 128 * (within >> 5) + 32 * (head & 3) : 1024 + head * 64 + (within - 64);
            tr_item(INP(I_A_WUKV), NH * 128, KVLORA, 128 * kb, n0, INP(I_A_GCKV), (bf16*)(ws + WS_WUKV), drow, scr, lane); continue; } r -= I_UKV;
        if (r < I_SQ)  { const int kb = r / 32, n0 = 32 * (r % 32); tr_item_f8(INP(I_A_WO), D, D, 128 * kb, n0, nullptr, ws + WS_WO, n0, scr, lane); continue; } r -= I_SQ;
        if (r < I_F13) { tr_gated(INP(I_FFN_W1), D, FF, INP(I_FFN_NORM), (bf16*)(ws + WS_WF1), 0, scr, r, lane); continue; } r -= I_F13;
        if (r < I_F13) { tr_gated(INP(I_FFN_W3), D, FF, INP(I_FFN_NORM), (bf16*)(ws + WS_WF1), 1, scr, r, lane); continue; } r -= I_F13;
        if (r < I_F2)  { tr_plain(INP(I_FFN_W2), FF, D, nullptr, (bf16*)(ws + WS_WF2), 0, scr, r, lane); continue; } r -= I_F2;
        if (r < I_SQ)  { const int kb = r / 32, n0 = 32 * (r % 32), head = n0 >> 6;
            tr_item_f8(INP(I_KV_WK), D, D, 128 * kb, n0, INP(I_KV_NORM), ws + WS_WKVQ, 256 * (head >> 2) + 128 * ((n0 >> 5) & 1) + 32 * (head & 3), scr, lane); continue; } r -= I_SQ;
        if (r < I_SQ)  { const int kb = r / 32, n0 = 32 * (r % 32); tr_item_f8(INP(I_KV_WV), D, D, 128 * kb, n0, INP(I_KV_NORM), ws + WS_WKVQ, 2 * D + n0, scr, lane); continue; } r -= I_SQ;
        if (r < I_SQ)  { const int kb = r / 32, n0 = 32 * (r % 32), head = n0 >> 6;
            tr_item_f8(INP(I_B_WQ), D, D, 128 * kb, n0, INP(I_ATTN_NORM) + D, ws + WS_WKVQ, D + 256 * (head >> 2) + 128 * ((n0 >> 5) & 1) + 32 * (head & 3), scr, lane); continue; } r -= I_SQ;
        if (r < I_SQ)  { const int kb = r / 32, n0 = 32 * (r % 32); tr_item_f8(INP(I_B_WO), D, D, 128 * kb, n0, nullptr, ws + WS_WBO, n0, scr, lane); continue; } r -= I_SQ;
        const int e = r / (2 * I_M13 + I_M2); r -= e * (2 * I_M13 + I_M2);
        if (r < I_M13) { const int kb = r / 112, n0 = 32 * (r % 112);
            tr_item_f8(INP(I_MOE_W1) + (size_t)e * D * EFF, EFF, D, 128 * kb, n0, INP(I_FFN_NORM) + D, ws + WS_WM1 + (size_t)e * 2 * EFF * D, (n0 >> 7) * 256 + (n0 & 127), scr, lane); continue; } r -= I_M13;
        if (r < I_M13) { const int kb = r / 112, n0 = 32 * (r % 112);
            tr_item_f8(INP(I_MOE_W3) + (size_t)e * D * EFF, EFF, D, 128 * kb, n0, INP(I_FFN_NORM) + D, ws + WS_WM1 + (size_t)e * 2 * EFF * D, (n0 >> 7) * 256 + 128 + (n0 & 127), scr, lane); continue; } r -= I_M13;
        { const int kb = r / 32, n0 = 32 * (r % 32); tr_item_f8(INP(I_MOE_W2) + (size_t)e * EFF * D, D, EFF, 128 * kb, n0, nullptr, ws + WS_WM2 + (size_t)e * D * EFF, n0, scr, lane); }
    }
    const int gt = F.vcu * (NWAVES * 64) + tid, NGT = F.G * NWAVES * 64;
    for (int c = gt; c < 96 * D / 16; c += NGT) *((GAS v4u*)(ws + WS_WA + (size_t)(QLORA + KVLORA + ROPE_D) * D) + c) = (v4u){0u, 0u, 0u, 0u};
    for (int c = gt; c < SEQ * 16; c += NGT) { const int pos = c >> 4, i = c & 15;
        const float inv = __builtin_amdgcn_exp2f(-(float)i * (13.287712379549449f / 16.f));
        const float rev = (float)pos * inv * 0.15915494309189535f; const float fr = rev - floorf(rev);
        ((GAS float*)(ws + WS_ROPE))[2 * c] = __builtin_amdgcn_cosf(fr); ((GAS float*)(ws + WS_ROPE))[2 * c + 1] = __builtin_amdgcn_sinf(fr); }
    norm_phase(F, INP(I_X), (bf16*)(ws + WS_XN));
}

__device__ __forceinline__ void route_phase(const Frame& F) {
    const int tid = fresh(F.wave * 64 + lane_id_()), lane = tid & 63;
    unsigned char* ws = WSP;
    LAS float* wrg = (LAS float*)(F.lds + RING_OFF);
    LAS int* cnt = (LAS int*)(F.lds + RING_OFF + 32768);
    const float* wr = INP(I_MOE_ROUTER); const float* g = INP(I_FFN_NORM) + D;
    for (int idx = tid; idx < D * NE; idx += NWAVES * 64) { const int k = idx >> 3, e = idx & 7, j = k >> 8, l = (k & 255) >> 2, q = k & 3;
        wrg[((j * 4 + q) * 2 + (e >> 2)) * 256 + 4 * l + (e & 3)] = wr[idx] * g[k]; }
    __syncthreads();
    const int b5 = (lane >> 5) & 1, b4 = (lane >> 4) & 1, b3 = (lane >> 3) & 1;
    for (int c = F.vcu; c < M / 256; c += F.G) {
        if (tid < 16) cnt[tid] = 0;
        __syncthreads();
        f32x4 vn[4];
        { const GAS f32x4* xr = (const GAS f32x4*)(OUTP + (size_t)(c * 256 + F.wave * 32) * D) + lane;
#pragma unroll
          for (int j = 0; j < 4; ++j) vn[j] = xr[64 * j]; }
        for (int i = 0; i < 32; ++i) {
            const int m = c * 256 + F.wave * 32 + i;
            f32x4 v[4]; float ssx = 0.f;
#pragma unroll
            for (int j = 0; j < 4; ++j) v[j] = vn[j];
            if (i + 1 < 32) { const GAS f32x4* xr = (const GAS f32x4*)(OUTP + (size_t)(m + 1) * D) + lane;
#pragma unroll
              for (int j = 0; j < 4; ++j) vn[j] = xr[64 * j]; }
#pragma unroll
            for (int j = 0; j < 4; ++j) ssx += (v[j].x * v[j].x + v[j].y * v[j].y) + (v[j].z * v[j].z + v[j].w * v[j].w);
            float lg[8];
#pragma unroll
            for (int e = 0; e < 8; ++e) lg[e] = 0.f;
#pragma unroll
            for (int j = 0; j < 4; ++j)
#pragma unroll
                for (int q = 0; q < 4; ++q) { const float xv = v[j][q];
                    const f32x4 w0 = *(const LAS f32x4*)(wrg + ((j * 4 + q) * 2) * 256 + 4 * lane), w1 = *(const LAS f32x4*)(wrg + ((j * 4 + q) * 2 + 1) * 256 + 4 * lane);
                    lg[0] += xv * w0.x; lg[1] += xv * w0.y; lg[2] += xv * w0.z; lg[3] += xv * w0.w; lg[4] += xv * w1.x; lg[5] += xv * w1.y; lg[6] += xv * w1.z; lg[7] += xv * w1.w; }
            float r4[4], r2[2], r1;
#pragma unroll
            for (int e = 0; e < 4; ++e) { const float mine = b5 ? lg[4 + e] : lg[e], other = b5 ? lg[e] : lg[4 + e]; r4[e] = mine + xor32_partner(other, b5); }
#pragma unroll
            for (int e = 0; e < 2; ++e) { const float mine = b4 ? r4[2 + e] : r4[e], other = b4 ? r4[e] : r4[2 + e]; r2[e] = mine + swz_xor<16>(other); }
            { const float mine = b3 ? r2[1] : r2[0], other = b3 ? r2[0] : r2[1]; r1 = mine + swz_xor<8>(other); }
            r1 += swz_xor<4>(r1); r1 += swz_xor<2>(r1); r1 += swz_xor<1>(r1);
            const float rstd = 1.f / sqrtf(wave_sum(ssx) * (1.f / D) + EPS);
#pragma unroll
            for (int e = 0; e < 8; ++e) lg[e] = __builtin_bit_cast(float, __builtin_amdgcn_readlane(__builtin_bit_cast(int, r1), 8 * e)) * rstd;
            int e1 = 0; float l1 = lg[0];
#pragma unroll
            for (int e = 1; e < 8; ++e) if (lg[e] > l1) { l1 = lg[e]; e1 = e; }
            int e2 = -1; float l2 = -INFINITY;
#pragma unroll
            for (int e = 0; e < 8; ++e) if (e != e1 && lg[e] > l2) { l2 = lg[e]; e2 = e; }
            const float g1 = 1.f / (1.f + __expf(l2 - l1)), g2 = 1.f - g1;
            const int elo = e1 < e2 ? e1 : e2, ehi = e1 < e2 ? e2 : e1;
            const float glo = e1 < e2 ? g1 : g2, ghi = e1 < e2 ? g2 : g1;
            if (lane == 0) { ((GAS float*)(ws + WS_TOKRSTD))[m] = rstd; ((GAS int*)(ws + WS_TOKE))[m] = elo | (ehi << 8); ((GAS float*)(ws + WS_TOKG))[2 * m] = glo; ((GAS float*)(ws + WS_TOKG))[2 * m + 1] = ghi;
                atomicAdd((int*)&cnt[elo], 1); atomicAdd((int*)&cnt[8 + ehi], 1); }
        }
        __syncthreads();
        if (tid < 16) ((GAS int*)(ws + WS_CNT))[c * 16 + tid] = cnt[tid];
        __syncthreads();
    }
}

__device__ __forceinline__ void slot_phase(const Frame& F, unsigned char* ws) {
    const int tid = fresh(F.wave * 64 + lane_id_()), lane = tid & 63; (void)lane;
    LAS int* call = (LAS int*)(F.lds + RING_OFF);
    LAS int* tot = call + 4096; LAS int* base = tot + 16; LAS int* pre = base + 16; LAS int* meta = pre + 16;
    LAS int* grp = meta + 16;
    LAS int* slot_of = grp + 512;
    for (int idx = tid; idx < 4096; idx += NWAVES * 64) call[idx] = ((const GAS int*)(ws + WS_CNT))[idx];
    __syncthreads();
    if (tid < 16) { int t = 0; for (int cc = 0; cc < 256; ++cc) t += call[cc * 16 + tid]; tot[tid] = t; }
    __syncthreads();
    if (tid == 0) { int off = 0; for (int g = 0; g < 16; ++g) { base[g] = off; off += (tot[g] + 255) & ~255; if (g == 7) meta[0] = off >> 8; } meta[1] = (off >> 8) - meta[0]; }
    __syncthreads();
    for (int c = F.vcu; c < M / 256; c += F.G) {
        if (tid < 16) { int p = 0; for (int cc = 0; cc < c; ++cc) p += call[cc * 16 + tid]; pre[tid] = p; }
        const int hf = tid >> 8, i = tid & 255, m = c * 256 + i;
        const int te = ((const GAS int*)(ws + WS_TOKE))[m];
        const int g = hf * 8 + (hf ? ((te >> 8) & 0xff) : (te & 0xff));
        grp[tid] = g;
        __syncthreads();
        int rank = 0;
        for (int j = 0; j < i; ++j) rank += (grp[hf * 256 + j] == g) ? 1 : 0;
        const int slot = base[g] + pre[g] + rank;
        ((GAS int*)(ws + WS_SLOTTOK))[slot] = m; ((GAS float*)(ws + WS_SLOTGATE))[slot] = ((const GAS float*)(ws + WS_TOKG))[2 * m + hf];
        slot_of[tid] = slot;
        __syncthreads();
        for (int i0 = F.wave; i0 < 256; i0 += 4 * NWAVES) {
            v4u x[4][2]; float rs[4];
#pragma unroll
            for (int k = 0; k < 4; ++k) { const int mm = c * 256 + i0 + 8 * k; const GAS v4u* src = (const GAS v4u*)(ws + WS_XR3 + (size_t)mm * D * 2);
                x[k][0] = src[2 * lane]; x[k][1] = src[2 * lane + 1]; rs[k] = ((const GAS float*)(ws + WS_TOKRSTD))[mm]; }
#pragma unroll
            for (int k = 0; k < 4; ++k) { const int i = i0 + 8 * k; const v4u x0 = x[k][0], x1 = x[k][1]; const float r = rs[k];
                const v4u o = (v4u){pk_fp8x4(bflo(x0.x) * r, bfhi(x0.x) * r, bflo(x0.y) * r, bfhi(x0.y) * r), pk_fp8x4(bflo(x0.z) * r, bfhi(x0.z) * r, bflo(x0.w) * r, bfhi(x0.w) * r),
                                    pk_fp8x4(bflo(x1.x) * r, bfhi(x1.x) * r, bflo(x1.y) * r, bfhi(x1.y) * r), pk_fp8x4(bflo(x1.z) * r, bfhi(x1.z) * r, bflo(x1.w) * r, bfhi(x1.w) * r)};
                ((GAS v4u*)(ws + WS_XG + (size_t)slot_of[i] * D))[lane] = o; ((GAS v4u*)(ws + WS_XG + (size_t)slot_of[256 + i] * D))[lane] = o; }
        }
        __syncthreads();
    }
    for (int g = F.vcu; g < 16; g += F.G) {
        const int s0 = base[g] + tot[g], s1 = base[g] + ((tot[g] + 255) & ~255);
        for (int s = s0 + F.wave; s < s1; s += NWAVES) { GAS v4u* dst = (GAS v4u*)(ws + WS_XG + (size_t)s * D);
            dst[lane] = (v4u){0u, 0u, 0u, 0u};
            if (lane == 0) { ((GAS int*)(ws + WS_SLOTTOK))[s] = -1; ((GAS float*)(ws + WS_SLOTGATE))[s] = 0.f; } }
    }
    if (F.vcu == 0) {
        if (tid < 16) { const int p0 = base[tid] >> 8, p1 = (base[tid] + ((tot[tid] + 255) & ~255)) >> 8; for (int p = p0; p < p1; ++p) ((GAS int*)(ws + WS_PANELE))[p] = tid & 7; }
        if (tid == 0) { ((GAS int*)(ws + WS_META))[0] = meta[0]; ((GAS int*)(ws + WS_META))[1] = meta[1]; }
        if (tid < 16) ((GAS int*)(ws + WS_META))[2 + tid] = base[tid] >> 8;
    }
    __syncthreads();
}

__global__ void __launch_bounds__(NWAVES * 64, 2) yoco_fwd(Args args) {
    extern __shared__ __attribute__((aligned(16))) unsigned char lds_raw[];
    Frame F;
    F.lds = (LAS unsigned char*)lds_raw;
    F.wave = __builtin_amdgcn_readfirstlane((int)threadIdx.x >> 6);
    F.G = gridDim.x; { const int bx = blockIdx.x; F.vcu = (F.G % 8 == 0) ? (bx % 8) * (F.G / 8) + bx / 8 : bx; }
    unsigned char* ws = WSP;
    volatile LAS unsigned* MISC = (volatile LAS unsigned*)(F.lds + MISC_OFF);
    for (int u = fresh((int)threadIdx.x); u < (LDS_BYTES - LDSCTL_OFF) / 4; u += NWAVES * 64) ((LAS unsigned*)(F.lds + LDSCTL_OFF))[u] = 0u;
    __syncthreads();
    (void)xcd_barrier_post((unsigned*)(ws + WS_CTL) + CW_BAR, MISC + 8, (F.wave == 0 && lane_id_() == 0) ? 1 : 0);
    LAS unsigned char* ring = F.lds + RING_OFF;
#define bid ((int)blockIdx.x)
#define GRID_BAR() do { XcdBarrier b_; b_.t0 = (F.wave == 0 && lane_id_() == 0) ? 1 : 0; b_.bar = (unsigned*)(WSP + WS_CTL) + CW_BAR; b_.x = xb_xcc_id(); b_.st = (volatile LAS unsigned*)(F.lds + MISC_OFF) + 8; xcd_barrier(b_); } while (0)
#define GEMM(EpiT, SchedT) pg8::gemm_phase<EpiT, SchedT, true, true>

    p0_prologue(F);
    GRID_BAR();
    { pg8::Gemm g{(const bf16*)(ws + WS_XN), (const bf16*)(ws + WS_WA), M, NA, D / 2, D / 2}; pg8::StaticOrder S; S.init(M, NA, F.G, bid);
      pg8::EpiQA E{(bf16*)(ws + WS_QA), (float*)(ws + WS_PARTQA), 1.f / 64};
      pg8::gemm_phase<pg8::EpiQA, pg8::StaticOrder, true, true, true>(ring, g, S, E, F.wave); }
    GRID_BAR();
    { pg8::Gemm g{(const bf16*)(ws + WS_QA), (const bf16*)(ws + WS_WUQ), M, NH * QKD, QLORA, NA}; pg8::StaticOrder S; S.init(M, NH * QKD, F.G, bid);
      pg8::EpiRowScaleBf16 E{(bf16*)(ws + WS_Q), NH * QKD, (const float*)(ws + WS_PARTQA), 1.f / QLORA};
      GEMM(pg8::EpiRowScaleBf16, pg8::StaticOrder)(ring, g, S, E, F.wave); }
    { pg8::Gemm g{(const bf16*)(ws + WS_QA) + QLORA, (const bf16*)(ws + WS_WUKV), M, NH * 128, KVLORA, NA}; pg8::StaticOrder S; S.init(M, NH * 128, F.G, bid);
      pg8::EpiKVup E{(bf16*)(ws + WS_K), (bf16*)(ws + WS_V), (const float*)(ws + WS_PARTQA), (const bf16*)(ws + WS_QA), INP(I_A_GKN), (const float*)(ws + WS_ROPE)};
      GEMM(pg8::EpiKVup, pg8::StaticOrder)(ring, g, S, E, F.wave); }
    GRID_BAR();
    for (int p = F.vcu; p < BATCH * NH * 4; p += F.G) {
        const int bh = p >> 2, pid = p & 3, b = bh >> 4, h = bh & 15;
        for (int u2 = 0; u2 < 2; ++u2) {
            const int qb = u2 ? 7 - pid : pid;
            att::attn_unit<96, false, 1536, 1536, D, D, true>(ring, (const bf16*)(ws + WS_Q) + (size_t)b * SEQ * 1536 + h * QKD, (const bf16*)(ws + WS_K) + (size_t)b * SEQ * 1536 + h * QKD,
                                      (const bf16*)(ws + WS_V) + (size_t)b * SEQ * D + h * 64, (bf16*)(ws + WS_O + (size_t)b * SEQ * D + h * 64),
                                      256 * qb, 0, 4 * qb + 3, 0, 4 * qb + (F.wave >> 1), 0, nullptr, INP(I_A_GQN), (const float*)(ws + WS_ROPE), F.wave);
        }
    }
    GRID_BAR();
    { pg8::Gemm g{(const bf16*)(ws + WS_O), (const bf16*)(ws + WS_WO), M, D, D / 2, D / 2}; pg8::StaticOrder S; S.init(M, D, F.G, bid);
      pg8::EpiResNorm<true> E{INP(I_X), OUTP, (bf16*)(ws + WS_XR1), (float*)(ws + WS_PART1), 1.f / 4096};
      pg8::gemm_phase<pg8::EpiResNorm<true>, pg8::StaticOrder, true, true, true>(ring, g, S, E, F.wave); }
    GRID_BAR();
    { pg8::Gemm g{(const bf16*)(ws + WS_XR1), (const bf16*)(ws + WS_WF1), M, 2 * FF, D, D}; pg8::StaticOrder S; S.init(M, 2 * FF, F.G, bid);
      pg8::EpiGated<true> E{(bf16*)(ws + WS_H), FF, 0, (const float*)(ws + WS_PART1)};
      GEMM(pg8::EpiGated<true>, pg8::StaticOrder)(ring, g, S, E, F.wave); }
    GRID_BAR();
    { pg8::Gemm g{(const bf16*)(ws + WS_H), (const bf16*)(ws + WS_WF2), M, D, FF, FF}; pg8::StaticOrder S; S.init(M, D, F.G, bid);
      pg8::EpiResNorm<true, true> E{OUTP, OUTP, (bf16*)(ws + WS_XR2), (float*)(ws + WS_PART2), 1.f};
      pg8::gemm_phase<pg8::EpiResNorm<true, true>, pg8::StaticOrder, true, true>(ring, g, S, E, F.wave); }
    GRID_BAR();
    { pg8::Gemm g{(const bf16*)(ws + WS_XR2), (const bf16*)(ws + WS_WKVQ), M, 2 * D, D / 2, D / 2}; pg8::StaticOrder S; S.init(M, 2 * D, F.G, bid);
      pg8::EpiK2Q2 E{(bf16*)(ws + WS_KVQ2), (const float*)(ws + WS_PART2), INP(I_KV_GKN), INP(I_B_GQN), 1.f / 64};
      pg8::gemm_phase<pg8::EpiK2Q2, pg8::StaticOrder, true, true, true>(ring, g, S, E, F.wave); }
    { pg8::Gemm g{(const bf16*)(ws + WS_XR2), (const bf16*)(ws + WS_WKVQ + (size_t)2 * D * D), M, D, D / 2, D / 2}; pg8::StaticOrder S; S.init(M, D, F.G, bid);
      pg8::EpiRowScale16 E{(bf16*)(ws + WS_KVQ2), 3 * D, D, (const float*)(ws + WS_PART2), 1.f / 64};
      pg8::gemm_phase<pg8::EpiRowScale16, pg8::StaticOrder, true, true, true>(ring, g, S, E, F.wave); }
    GRID_BAR();
    for (int p = F.vcu; p < BATCH * NH * 8; p += F.G) {
        const int bh = p >> 3, cb = ((p & 7) + (p >> 8)) & 7, b = bh >> 4, h = bh & 15;
        const int c0 = 4 * cb, cc = c0 + (F.wave >> 1);
        const bf16* base = (const bf16*)(ws + WS_KVQ2) + (size_t)b * SEQ * 3072 + h * 64;
        att::attn_unit<64, true, 3072, 3072, 3072, D, true>(ring, base + 2048, base, base + 1024, (bf16*)(ws + WS_O2 + (size_t)b * SEQ * D + h * 64),
                                 256 * cb, c0 - 8 < 0 ? 0 : c0 - 8, c0 + 3, cc - 8 < 0 ? 0 : cc - 8, cc, cc, INP(I_B_RELB) + h * 257, nullptr, nullptr, F.wave);
    }
    GRID_BAR();
    { pg8::Gemm g{(const bf16*)(ws + WS_O2), (const bf16*)(ws + WS_WBO), M, D, D / 2, D / 2}; pg8::StaticOrder S; S.init(M, D, F.G, bid);
      pg8::EpiResNorm<false> E{OUTP, OUTP, (bf16*)(ws + WS_XR3), nullptr, 1.f / 4096};
      pg8::gemm_phase<pg8::EpiResNorm<false>, pg8::StaticOrder, true, true, true>(ring, g, S, E, F.wave); }
    GRID_BAR();
    route_phase(F);
    GRID_BAR();
    slot_phase(F, ws);
    GRID_BAR();
    for (int hf = 0; hf < 2; ++hf) {
        { unsigned char* w2 = WSP;
          const int nPA = __builtin_amdgcn_readfirstlane(((const GAS int*)(w2 + WS_META))[0]), nPB = __builtin_amdgcn_readfirstlane(((const GAS int*)(w2 + WS_META))[1]);
          const int nP = hf ? nPB : nPA, p0 = hf ? nPA : 0;
          pg8::Gemm g{(const bf16*)(w2 + WS_XG + (size_t)p0 * 256 * D), (const bf16*)(w2 + WS_WM1), nP * 256, 2 * EFF, D / 2, D / 2};
          pg8::MoeOrder S; S.init(nP, 2 * EFF / 256, F.G, bid);
#pragma unroll
          for (int k = 0; k < 7; ++k) S.pb[k] = __builtin_amdgcn_readfirstlane(((const GAS int*)(w2 + WS_META))[2 + hf * 8 + 1 + k]) - p0;
          pg8::EpiGatedF8 E{w2 + WS_HM, EFF, 2 * EFF / 256};
          pg8::gemm_phase<pg8::EpiGatedF8, pg8::MoeOrder, true, true, true>(ring, g, S, E, F.wave); }
        GRID_BAR();
        { unsigned char* w2 = WSP;
          const int nPA = __builtin_amdgcn_readfirstlane(((const GAS int*)(w2 + WS_META))[0]), nPB = __builtin_amdgcn_readfirstlane(((const GAS int*)(w2 + WS_META))[1]);
          const int nP = hf ? nPB : nPA, p0 = hf ? nPA : 0;
          pg8::Gemm g{(const bf16*)(w2 + WS_HM), (const bf16*)(w2 + WS_WM2), nP * 256, D, EFF / 2, EFF / 2};
          pg8::MoeOrder S; S.init(nP, D / 256, F.G, bid);
#pragma unroll
          for (int k = 0; k < 7; ++k) S.pb[k] = __builtin_amdgcn_readfirstlane(((const GAS int*)(w2 + WS_META))[2 + hf * 8 + 1 + k]) - p0;
          pg8::EpiMoeDown E{OUTP, (const int*)(w2 + WS_SLOTTOK), (const float*)(w2 + WS_SLOTGATE), p0 * 256, D, 1.f / 64};
          pg8::gemm_phase<pg8::EpiMoeDown, pg8::MoeOrder, true, true, true>(ring, g, S, E, F.wave); }
        if (hf == 0) GRID_BAR();
    }
#undef GRID_BAR
#undef bid
#undef GEMM
}

extern "C" void kernel_launch(void* const* d_in, const int* in_sizes, int n_in, void* d_out, int out_size, void* d_ws, size_t ws_size, hipStream_t stream) {
    static int grid = 0;
    if (grid == 0) {
        if (n_in != 27 || in_sizes[0] != M * D || out_size != M * D || ws_size < WS_END) { fprintf(stderr, "kernel_launch: unexpected shapes (n_in %d, in0 %d, out %d, ws %zu < %zu); nothing launched\n", n_in, n_in > 0 ? in_sizes[0] : -1, out_size, ws_size, (size_t)WS_END); grid = -1; return; }
        int dev = 0, cus = 0, per_cu = 0;
        if (hipGetDevice(&dev) != hipSuccess || hipDeviceGetAttribute(&cus, hipDeviceAttributeMultiprocessorCount, dev) != hipSuccess) { grid = -1; return; }
        if (hipFuncSetAttribute((const void*)yoco_fwd, hipFuncAttributeMaxDynamicSharedMemorySize, LDS_BYTES) != hipSuccess) { fprintf(stderr, "kernel_launch: hipFuncSetAttribute failed\n"); grid = -1; return; }
        if (hipOccupancyMaxActiveBlocksPerMultiprocessor(&per_cu, (const void*)yoco_fwd, NWAVES * 64, LDS_BYTES) != hipSuccess || per_cu < 1) { fprintf(stderr, "kernel_launch: occupancy query says %d\n", per_cu); }
        (void)hipGetLastError();
        grid = cus;
    }
    if (grid < 0) return;
    if (hipMemsetAsync((char*)d_ws + WS_CTL, 0, CTL_ZERO_BYTES, stream) != hipSuccess) return;
    Args a{};
    for (int i = 0; i < 27; ++i) a.in[i] = (const float*)d_in[i];
    a.out = (float*)d_out; a.ws = (unsigned char*)d_ws;
    hipLaunchKernelGGL(yoco_fwd, dim3(grid), dim3(NWAVES * 64), LDS_BYTES, stream, a);
}
```

```cpp
#include <hip/hip_runtime.h>
#include <cstdio>
#include <cstdint>
__device__ __forceinline__ int lane_id_() { unsigned m_ = ~0u; asm volatile("" : "+s"(m_)); return (int)__builtin_amdgcn_mbcnt_hi(m_, __builtin_amdgcn_mbcnt_lo(m_, 0u)); }
template <int X> __device__ __forceinline__ float swz_xor(float v) { return __builtin_bit_cast(float, __builtin_amdgcn_ds_swizzle(__builtin_bit_cast(int, v), (X << 10) | 0x1f)); }
__device__ __forceinline__ void halves32(float v, float& r_lo, float& r_hi) { unsigned a_ = __builtin_bit_cast(unsigned, v), b_ = a_;
    asm volatile("s_nop 1\n\tv_permlane32_swap_b32 %0, %1\n\ts_nop 1" : "+v"(a_), "+v"(b_)); r_lo = __builtin_bit_cast(float, a_); r_hi = __builtin_bit_cast(float, b_); }
__device__ __forceinline__ float xor32_partner(float v, int upper_half) { float lo, hi; halves32(v, lo, hi); return upper_half ? lo : hi; }
__device__ __forceinline__ float xor32_sum(float v) { float lo, hi; halves32(v, lo, hi); return lo + hi; }
__device__ __forceinline__ float xor32_max(float v) { float lo, hi; halves32(v, lo, hi); return fmaxf(lo, hi); }
namespace pg8 {
#define PG8_LAS __attribute__((address_space(3)))
typedef unsigned short bf16_t;
typedef short bf16x8 __attribute__((ext_vector_type(8)));
typedef float f32x4 __attribute__((ext_vector_type(4)));
typedef unsigned u32x4 __attribute__((ext_vector_type(4)));
constexpr int BM = 256, BK = 64, HALF = 128, HTB = HALF * BK * 2  , STAGE_BYTES = 8 * HTB, NXCD = 8, WGM = 8;

__host__ __device__ __forceinline__ int lds_byte(int r, int c) { const int st = (r >> 4) * 2 + (c >> 5), rr = r & 15, cc = c & 31, ob = rr * 64 + cc * 2; return st * 1024 + (ob ^ (((ob >> 9) & 1) << 5)); }
__host__ __device__ __forceinline__ void stage_rc(int b, int& R, int& C) { const int st = b / 1024, sb = b % 1024, swz = sb ^ (((sb >> 9) & 1) << 5); R = (st >> 1) * 16 + swz / 64; C = (st & 1) * 32 + (swz % 64) / 2; }
__host__ __device__ __forceinline__ int perm32(int rho) { const int n = rho >> 4, i = rho & 15; return 8 * (i >> 2) + 4 * n + (i & 3); }

struct Unit { int pm, pn; };
struct Gemm { const bf16_t* A; const bf16_t* Bt; int M, N, K, lda; };

struct StaticOrder {
    int nM, nN, nwg, G, c;
    __host__ __device__ void init(int M, int N, int G_, int c_) { nM = M / BM; nN = N / BM; nwg = nM * nN; G = G_; c = c_; }
    __host__ __device__ bool next(int i, Unit& u) const {
        const int L = i * G + c; if (L >= nwg) return false;
        int wgid = L; { const int q = nwg / NXCD, r = nwg % NXCD, xcd = wgid % NXCD, off = wgid / NXCD; wgid = (xcd < r ? xcd * (q + 1) : r * (q + 1) + (xcd - r) * q) + off; }
        const int nig = WGM * nN, gid = wgid / nig, fm = gid * WGM, gsz = (nM - fm) < WGM ? (nM - fm) : WGM;
        u.pm = fm + ((wgid % nig) % gsz); u.pn = (wgid % nig) / gsz; return true;
    }
    __device__ __forceinline__ void a_ready(const Unit&) const {}
    __device__ __forceinline__ void done(const Unit&) const {}
};
__device__ __forceinline__ unsigned cvt_pk_bf16(float lo, float hi) { unsigned r; asm volatile("v_cvt_pk_bf16_f32 %0, %1, %2" : "=v"(r) : "v"(lo), "v"(hi)); return r; }
__device__ __forceinline__ float silu_f(float x) { const float e = __builtin_amdgcn_exp2f(x * -1.4426950408889634f); return x * __builtin_amdgcn_rcpf(1.f + e); }

__device__ __forceinline__ float sum4(const f32x4& a) { return (a[0] + a[1]) + (a[2] + a[3]); }
__device__ __forceinline__ float part_sum8(const float* p) { return sum4(*(const f32x4*)p) + sum4(*(const f32x4*)(p + 4)); }
__device__ __forceinline__ float part_sum16(const float* p) { return (sum4(*(const f32x4*)p) + sum4(*(const f32x4*)(p + 4))) + (sum4(*(const f32x4*)(p + 8)) + sum4(*(const f32x4*)(p + 12))); }
__device__ __forceinline__ float fq_sum(float v) { v += swz_xor<16>(v); return xor32_sum(v); }
__device__ __forceinline__ float sq8(const f32x4& a, const f32x4& b) { return ((a[0] * a[0] + a[1] * a[1]) + (a[2] * a[2] + a[3] * a[3])) + ((b[0] * b[0] + b[1] * b[1]) + (b[2] * b[2] + b[3] * b[3])); }
__device__ __forceinline__ u32x4 pack8(const f32x4& a, const f32x4& b) { u32x4 w; w.x = cvt_pk_bf16(a[0], a[1]); w.y = cvt_pk_bf16(a[2], a[3]); w.z = cvt_pk_bf16(b[0], b[1]); w.w = cvt_pk_bf16(b[2], b[3]); return w; }
constexpr float EPS_ = 1e-6f;
__device__ __forceinline__ unsigned pk_fp8x4(float a, float b, float c, float d) { int w = 0; w = __builtin_amdgcn_cvt_pk_fp8_f32(a, b, w, false); w = __builtin_amdgcn_cvt_pk_fp8_f32(c, d, w, true); return (unsigned)w; }

struct EpiQA {
    static constexpr bool PERM = true, AFTER_DRAIN = false;
    bf16_t* O; float* part; float wscale;
    __device__ __forceinline__ void operator()(const f32x4 (&acc)[2][2][4][2], const Unit& u, int wr, int wc, int fr, int fq) const {
        { int t_ = lane_id_(); asm volatile("" : "+v"(t_)); fr = t_ & 15; fq = (t_ >> 4) & 3; }
        const int row0 = u.pm * BM + wr * 64 + fr, col0 = u.pn * BM + wc * 32 + 8 * fq;
#pragma unroll
        for (int ai = 0; ai < 2; ++ai)
#pragma unroll
            for (int m = 0; m < 4; ++m) { const int row = row0 + ai * HALF + m * 16; bf16_t* rowp = O + (size_t)row * 768 + col0;
                const f32x4 a0 = acc[ai][0][m][0] * wscale, a1 = acc[ai][0][m][1] * wscale, b0 = acc[ai][1][m][0] * wscale, b1 = acc[ai][1][m][1] * wscale;
                *(u32x4*)(rowp) = pack8(a0, a1); *(u32x4*)(rowp + HALF) = pack8(b0, b1);
                const float s0 = sq8(a0, a1), s1 = sq8(b0, b1);
                float* pr = part + (size_t)row * 16;
                if (u.pn == 0) { const float t = fq_sum(s0 + s1); if (fq == 0) pr[wc] = t; }
                else if (u.pn == 1) { const float t0 = fq_sum(s0), t1 = fq_sum(s1); if (fq == 0) { pr[4 + wc] = t0; pr[8 + wc] = t1; } }
                else { const float t = fq_sum(s0); if (fq == 0) pr[12 + wc] = t; } }
    }
};

struct EpiRowScaleBf16 {
    static constexpr bool PERM = true, AFTER_DRAIN = false;
    bf16_t* O; int ldc; const float* part; float inv_n;
    __device__ __forceinline__ void operator()(const f32x4 (&acc)[2][2][4][2], const Unit& u, int wr, int wc, int fr, int fq) const {
        { int t_ = lane_id_(); asm volatile("" : "+v"(t_)); fr = t_ & 15; fq = (t_ >> 4) & 3; }
        const int row0 = u.pm * BM + wr * 64 + fr, col0 = u.pn * BM + wc * 32 + 8 * fq;
#pragma unroll
        for (int ai = 0; ai < 2; ++ai)
#pragma unroll
            for (int m = 0; m < 4; ++m) { const int row = row0 + ai * HALF + m * 16; bf16_t* rowp = O + (size_t)row * ldc + col0;
                const float rs = __builtin_amdgcn_rsqf(part_sum8(part + (size_t)row * 16) * inv_n + EPS_);
                *(u32x4*)(rowp) = pack8(acc[ai][0][m][0] * rs, acc[ai][0][m][1] * rs); *(u32x4*)(rowp + HALF) = pack8(acc[ai][1][m][0] * rs, acc[ai][1][m][1] * rs); }
    }
};

struct EpiKVup {
    static constexpr bool PERM = true, AFTER_DRAIN = false;
    bf16_t* Kd; bf16_t* Vd; const float* part; const bf16_t* QA; const float* g_kn; const float* rope;
    __device__ __forceinline__ void operator()(const f32x4 (&acc)[2][2][4][2], const Unit& u, int wr, int wc, int fr, int fq) const {
        { int t_ = lane_id_(); asm volatile("" : "+v"(t_)); fr = t_ & 15; fq = (t_ >> 4) & 3; }
        const int row0 = u.pm * BM + wr * 64 + fr;
        if (u.pn >= 4) {
            const int col0 = (u.pn - 4) * BM + wc * 32 + 8 * fq;
#pragma unroll
            for (int ai = 0; ai < 2; ++ai)
#pragma unroll
                for (int m = 0; m < 4; ++m) { const int row = row0 + ai * HALF + m * 16; bf16_t* rowp = Vd + (size_t)row * 1024 + col0;
                    const float rs = __builtin_amdgcn_rsqf(part_sum8(part + (size_t)row * 16 + 8) * (1.f / 256) + EPS_);
                    *(u32x4*)(rowp) = pack8(acc[ai][0][m][0] * rs, acc[ai][0][m][1] * rs); *(u32x4*)(rowp + HALF) = pack8(acc[ai][1][m][0] * rs, acc[ai][1][m][1] * rs); }
            return;
        }
        const int head = 4 * u.pn + wc;
        f32x4 gA0 = *(const f32x4*)(g_kn + 8 * fq), gA1 = *(const f32x4*)(g_kn + 8 * fq + 4), gB0 = *(const f32x4*)(g_kn + 32 + 8 * fq), gB1 = *(const f32x4*)(g_kn + 32 + 8 * fq + 4);
        const f32x4 gR1 = *(const f32x4*)(g_kn + 64 + 4 * fq), gR2 = *(const f32x4*)(g_kn + 80 + 4 * fq);
#pragma unroll
        for (int ai = 0; ai < 2; ++ai)
#pragma unroll
            for (int m = 0; m < 4; ++m) { const int row = row0 + ai * HALF + m * 16;
                const float rs = __builtin_amdgcn_rsqf(part_sum8(part + (size_t)row * 16 + 8) * (1.f / 256) + EPS_);
                f32x4 a0 = acc[ai][0][m][0] * rs, a1 = acc[ai][0][m][1] * rs, b0 = acc[ai][1][m][0] * rs, b1 = acc[ai][1][m][1] * rs;
                const unsigned long long p1 = *(const unsigned long long*)(QA + (size_t)row * 768 + 640 + 4 * fq), p2 = *(const unsigned long long*)(QA + (size_t)row * 768 + 656 + 4 * fq);
                f32x4 x1, x2;
                x1[0] = __builtin_bit_cast(float, (unsigned)(p1 << 16)); x1[1] = __builtin_bit_cast(float, (unsigned)p1 & 0xffff0000u);
                x1[2] = __builtin_bit_cast(float, (unsigned)(p1 >> 32) << 16); x1[3] = __builtin_bit_cast(float, (unsigned)(p1 >> 32) & 0xffff0000u);
                x2[0] = __builtin_bit_cast(float, (unsigned)(p2 << 16)); x2[1] = __builtin_bit_cast(float, (unsigned)p2 & 0xffff0000u);
                x2[2] = __builtin_bit_cast(float, (unsigned)(p2 >> 32) << 16); x2[3] = __builtin_bit_cast(float, (unsigned)(p2 >> 32) & 0xffff0000u);
                const float ss = fq_sum(sq8(a0, a1) + sq8(b0, b1) + sq8(x1, x2));
                const float sh = __builtin_amdgcn_rsqf(ss * (1.f / 96) + EPS_);
                bf16_t* kp = Kd + (size_t)row * 1536 + head * 96;
                *(u32x4*)(kp + 8 * fq) = pack8(a0 * gA0 * sh, a1 * gA1 * sh); *(u32x4*)(kp + 32 + 8 * fq) = pack8(b0 * gB0 * sh, b1 * gB1 * sh);
                const f32x4* rp = (const f32x4*)(rope + ((size_t)(row & 2047) * 16 + 4 * fq) * 2);
                const f32x4 c01 = rp[0], c23 = rp[1];
                const f32x4 y1 = x1 * gR1 * sh, y2 = x2 * gR2 * sh;
                f32x4 o1, o2;
                o1[0] = y1[0] * c01[0] - y2[0] * c01[1]; o2[0] = y2[0] * c01[0] + y1[0] * c01[1];
                o1[1] = y1[1] * c01[2] - y2[1] * c01[3]; o2[1] = y2[1] * c01[2] + y1[1] * c01[3];
                o1[2] = y1[2] * c23[0] - y2[2] * c23[1]; o2[2] = y2[2] * c23[0] + y1[2] * c23[1];
                o1[3] = y1[3] * c23[2] - y2[3] * c23[3]; o2[3] = y2[3] * c23[2] + y1[3] * c23[3];
                unsigned long long w1 = (unsigned long long)cvt_pk_bf16(o1[0], o1[1]) | ((unsigned long long)cvt_pk_bf16(o1[2], o1[3]) << 32);
                unsigned long long w2 = (unsigned long long)cvt_pk_bf16(o2[0], o2[1]) | ((unsigned long long)cvt_pk_bf16(o2[2], o2[3]) << 32);
                *(unsigned long long*)(kp + 64 + 4 * fq) = w1; *(unsigned long long*)(kp + 80 + 4 * fq) = w2; }
    }
};

struct EpiK2Q2 {
    static constexpr bool PERM = true, AFTER_DRAIN = false;
    bf16_t* O; const float* pss; const float* gk; const float* gq; float wscale;
    __device__ __forceinline__ void operator()(const f32x4 (&acc)[2][2][4][2], const Unit& u, int wr, int wc, int fr, int fq) const {
        { int t_ = lane_id_(); asm volatile("" : "+v"(t_)); fr = t_ & 15; fq = (t_ >> 4) & 3; }
        const int row0 = u.pm * BM + wr * 64 + fr, isq = u.pn >> 2, tl = u.pn & 3;
        const float* g = isq ? gq : gk; const float post = isq ? 0.125f * 1.4426950408889634f : 1.f;
        const f32x4 gA0 = *(const f32x4*)(g + 8 * fq) * post, gA1 = *(const f32x4*)(g + 8 * fq + 4) * post, gB0 = *(const f32x4*)(g + 32 + 8 * fq) * post, gB1 = *(const f32x4*)(g + 32 + 8 * fq + 4) * post;
        const int colh = isq * 2048 + (4 * tl + wc) * 64;
        unsigned zhi_ = 0u; asm volatile("" : "+v"(zhi_));
        const unsigned long long coff = ((unsigned long long)zhi_ << 32) | (unsigned)((colh + 8 * fq) * 2);
#pragma unroll
        for (int ai = 0; ai < 2; ++ai)
#pragma unroll
            for (int m = 0; m < 4; ++m) { const int row = row0 + ai * HALF + m * 16; unsigned char* rowp = (unsigned char*)O + (size_t)row * 6144 + coff;
                const float rs = __builtin_amdgcn_rsqf(part_sum16(pss + (size_t)row * 16) * (1.f / 1024) + EPS_) * wscale;
                const f32x4 a0 = acc[ai][0][m][0] * rs, a1 = acc[ai][0][m][1] * rs, b0 = acc[ai][1][m][0] * rs, b1 = acc[ai][1][m][1] * rs;
                const float ss = fq_sum(sq8(a0, a1) + sq8(b0, b1));
                const float sh = __builtin_amdgcn_rsqf(ss * (1.f / 64) + EPS_);
                *(u32x4*)(rowp) = pack8(a0 * gA0 * sh, a1 * gA1 * sh); *(u32x4*)(rowp + 64) = pack8(b0 * gB0 * sh, b1 * gB1 * sh); }
    }
};
struct EpiRowScale16 {
    static constexpr bool PERM = true, AFTER_DRAIN = false;
    bf16_t* O; int ldc; int coff; const float* pss; float wscale;
    __device__ __forceinline__ void operator()(const f32x4 (&acc)[2][2][4][2], const Unit& u, int wr, int wc, int fr, int fq) const {
        { int t_ = lane_id_(); asm volatile("" : "+v"(t_)); fr = t_ & 15; fq = (t_ >> 4) & 3; }
        const int row0 = u.pm * BM + wr * 64 + fr, col0 = coff + u.pn * BM + wc * 32 + 8 * fq;
#pragma unroll
        for (int ai = 0; ai < 2; ++ai)
#pragma unroll
            for (int m = 0; m < 4; ++m) { const int row = row0 + ai * HALF + m * 16; bf16_t* rowp = O + (size_t)row * ldc + col0;
                const float rs = __builtin_amdgcn_rsqf(part_sum16(pss + (size_t)row * 16) * (1.f / 1024) + EPS_) * wscale;
                *(u32x4*)(rowp) = pack8(acc[ai][0][m][0] * rs, acc[ai][0][m][1] * rs); *(u32x4*)(rowp + HALF) = pack8(acc[ai][1][m][0] * rs, acc[ai][1][m][1] * rs); }
    }
};

template <bool SSQ> struct EpiGated {
    static constexpr bool PERM = true, AFTER_DRAIN = false;
    bf16_t* Hd; int ldc; int ntile; const float* rs;
    __device__ __forceinline__ void operator()(const f32x4 (&acc)[2][2][4][2], const Unit& u, int wr, int wc, int fr, int fq) const {
        { int t_ = lane_id_(); asm volatile("" : "+v"(t_)); fr = t_ & 15; fq = (t_ >> 4) & 3; }
        const int pnl = ntile ? (u.pn % ntile) : u.pn;
        const int row0 = u.pm * BM + wr * 64 + fr, col0 = pnl * HALF + wc * 32 + 8 * fq;
#pragma unroll
        for (int ai = 0; ai < 2; ++ai)
#pragma unroll
            for (int m = 0; m < 4; ++m) { const int row = row0 + ai * HALF + m * 16; bf16_t* rowp = Hd + (size_t)row * ldc + col0;
                const float r = SSQ ? __builtin_amdgcn_rsqf(part_sum16(rs + (size_t)row * 16) * (1.f / 1024) + EPS_) : rs[row];
                const f32x4 g0 = acc[ai][0][m][0] * r, g1 = acc[ai][0][m][1] * r, u0 = acc[ai][1][m][0] * r, u1 = acc[ai][1][m][1] * r;
                u32x4 w;
                w.x = cvt_pk_bf16(silu_f(g0[0]) * u0[0], silu_f(g0[1]) * u0[1]); w.y = cvt_pk_bf16(silu_f(g0[2]) * u0[2], silu_f(g0[3]) * u0[3]);
                w.z = cvt_pk_bf16(silu_f(g1[0]) * u1[0], silu_f(g1[1]) * u1[1]); w.w = cvt_pk_bf16(silu_f(g1[2]) * u1[2], silu_f(g1[3]) * u1[3]);
                *(u32x4*)rowp = w; }
    }
};

struct EpiGatedF8 {
    static constexpr bool PERM = true, AFTER_DRAIN = false;
    unsigned char* Hd; int ldc; int ntile;
    static __device__ __forceinline__ float gate(float g, float u) {
        const float e = __builtin_amdgcn_exp2f(g * (-1.4426950408889634f / 64.f)); return (g * u) * (__builtin_amdgcn_rcpf(1.f + e) * (1.f / 4096.f)); }
    __device__ __forceinline__ void operator()(const f32x4 (&acc)[2][2][4][2], const Unit& u, int wr, int wc, int fr, int fq) const {
        { int t_ = lane_id_(); asm volatile("" : "+v"(t_)); fr = t_ & 15; fq = (t_ >> 4) & 3; }
        const int pnl = u.pn % ntile;
        const int row0 = u.pm * BM + wr * 64 + fr, col0 = pnl * HALF + wc * 32 + 8 * fq;
#pragma unroll
        for (int ai = 0; ai < 2; ++ai)
#pragma unroll
            for (int m = 0; m < 4; ++m) { const int row = row0 + ai * HALF + m * 16; unsigned char* rowp = Hd + (size_t)row * ldc + col0;
                const f32x4 g0 = acc[ai][0][m][0], g1 = acc[ai][0][m][1], u0 = acc[ai][1][m][0], u1 = acc[ai][1][m][1];
                unsigned long long w = (unsigned long long)pk_fp8x4(gate(g0[0], u0[0]), gate(g0[1], u0[1]), gate(g0[2], u0[2]), gate(g0[3], u0[3]))
                                     | ((unsigned long long)pk_fp8x4(gate(g1[0], u1[0]), gate(g1[1], u1[1]), gate(g1[2], u1[2]), gate(g1[3], u1[3])) << 32);
                *(unsigned long long*)rowp = w; }
    }
};

template <bool SSQ, bool XF8 = false> struct EpiResNorm {
    static constexpr bool PERM = true, AFTER_DRAIN = false;
    const float* res; float* out; bf16_t* XR; float* ssq; float ascale;
    __device__ __forceinline__ void operator()(const f32x4 (&acc)[2][2][4][2], const Unit& u, int wr, int wc, int fr, int fq) const {
        { int t_ = lane_id_(); asm volatile("" : "+v"(t_)); fr = t_ & 15; fq = (t_ >> 4) & 3; }
        const int row0 = u.pm * BM + wr * 64 + fr, col0 = u.pn * BM + wc * 32 + 8 * fq;
#pragma unroll
        for (int ai = 0; ai < 2; ++ai)
#pragma unroll
            for (int m = 0; m < 4; ++m) { const int row = row0 + ai * HALF + m * 16; const size_t ro = (size_t)row * 1024 + col0;
                f32x4 r[2][2];
#pragma unroll
                for (int bj = 0; bj < 2; ++bj)
#pragma unroll
                    for (int n = 0; n < 2; ++n) r[bj][n] = *(const f32x4*)(res + ro + bj * HALF + n * 4);
#pragma unroll
                for (int bj = 0; bj < 2; ++bj)
#pragma unroll
                    for (int n = 0; n < 2; ++n) { r[bj][n] = r[bj][n] + acc[ai][bj][m][n] * ascale; *(f32x4*)(out + ro + bj * HALF + n * 4) = r[bj][n]; }
                if constexpr (XF8) { unsigned char* x8 = (unsigned char*)XR + ro;
                    *(unsigned long long*)(x8) = (unsigned long long)pk_fp8x4(r[0][0][0], r[0][0][1], r[0][0][2], r[0][0][3]) | ((unsigned long long)pk_fp8x4(r[0][1][0], r[0][1][1], r[0][1][2], r[0][1][3]) << 32);
                    *(unsigned long long*)(x8 + HALF) = (unsigned long long)pk_fp8x4(r[1][0][0], r[1][0][1], r[1][0][2], r[1][0][3]) | ((unsigned long long)pk_fp8x4(r[1][1][0], r[1][1][1], r[1][1][2], r[1][1][3]) << 32); }
                else { *(u32x4*)(XR + ro) = pack8(r[0][0], r[0][1]); *(u32x4*)(XR + ro + HALF) = pack8(r[1][0], r[1][1]); }
                if (SSQ) { const float t = fq_sum(sq8(r[0][0], r[0][1]) + sq8(r[1][0], r[1][1])); if (fq == 0) ssq[(size_t)row * 16 + u.pn * 4 + wc] = t; } }
    }
};

struct EpiMoeDown {
    static constexpr bool PERM = false, AFTER_DRAIN = false;
    float* out; const int* slot_tok; const float* slot_gate; int slot_base; int ldc; float wscale;
    __device__ __forceinline__ void operator()(const f32x4 (&acc)[2][2][4][2], const Unit& u, int wr, int wc, int fr, int fq) const {
        { int t_ = lane_id_(); asm volatile("" : "+v"(t_)); fr = t_ & 15; fq = (t_ >> 4) & 3; }
        const int pnl = u.pn & 3;
        const int row0 = slot_base + u.pm * BM + wr * 64 + fr, col0 = pnl * BM + wc * 32 + 4 * fq;
#pragma unroll
        for (int ai = 0; ai < 2; ++ai)
#pragma unroll
            for (int m = 0; m < 4; ++m) { const int slot = row0 + ai * HALF + m * 16; const int tok = slot_tok[slot]; const float gt = slot_gate[slot] * wscale;
                if (tok >= 0) { float* rowp = out + (size_t)tok * ldc + col0;
                    f32x4 r[2][2];
#pragma unroll
                    for (int bj = 0; bj < 2; ++bj)
#pragma unroll
                        for (int n = 0; n < 2; ++n) r[bj][n] = *(const f32x4*)(rowp + bj * HALF + n * 16);
#pragma unroll
                    for (int bj = 0; bj < 2; ++bj)
#pragma unroll
                        for (int n = 0; n < 2; ++n) *(f32x4*)(rowp + bj * HALF + n * 16) = r[bj][n] + acc[ai][bj][m][n] * gt; } }
    }
};

struct MoeOrder {
    int nM, nN, nwg, G, c; int pb[7];
    int nBusy, SK;
    __device__ void init(int nPanels, int nN_, int G_, int c_) { nM = nPanels; nN = nN_; nwg = nM * nN; G = G_; c = c_; nBusy = 0; SK = 0; }
    __device__ __forceinline__ int expert_of(int pm) const { int e = 0;
#pragma unroll
        for (int k = 0; k < 7; ++k) e += (pm >= pb[k]) ? 1 : 0;
        return e; }
    __device__ bool next(int i, Unit& u) const {
        int L;
        if (nBusy == 0) L = i * G + c;
        else if (c >= nBusy) L = (i < SK) ? i * (G - nBusy) + (c - nBusy) : SK * (G - nBusy) + (i - SK) * G + c;
        else L = SK * (G - nBusy) + i * G + c;
        if (L >= nwg) return false;
        int wgid = L; { const int q = nwg / NXCD, r = nwg % NXCD, xcd = wgid % NXCD, off = wgid / NXCD; wgid = (xcd < r ? xcd * (q + 1) : r * (q + 1) + (xcd - r) * q) + off; }
        const int nig = WGM * nN, gid = wgid / nig, fm = gid * WGM, gsz = (nM - fm) < WGM ? (nM - fm) : WGM;
        u.pm = fm + ((wgid % nig) % gsz); const int pnl = (wgid % nig) / gsz;
        u.pn = expert_of(u.pm) * nN + pnl; return true;
    }
    __device__ __forceinline__ void a_ready(const Unit&) const {}
    __device__ __forceinline__ void done(const Unit&) const {}
};
struct LeftOrder {
    MoeOrder M; int nLeft;
    __device__ bool next(int i, Unit& u) const { if (i != 0 || M.c >= nLeft) return false; u.pm = 256 + (M.c >> 2); u.pn = M.expert_of(u.pm) * 4 + (M.c & 3); return true; }
    __device__ __forceinline__ void a_ready(const Unit&) const {}
    __device__ __forceinline__ void done(const Unit&) const {}
};
template <class Epi, class Sched, bool ALIGN_EPI = false, bool SP2 = false, bool F8 = false>
__device__ __forceinline__ void gemm_phase(PG8_LAS unsigned char* lds, const Gemm g, const Sched& S, const Epi& E, const int wave_idx) {
    int tid_ = wave_idx * 64 + lane_id_(); asm volatile("" : "+v"(tid_));
    const int tid = tid_, wid = __builtin_amdgcn_readfirstlane(tid >> 6), lane = tid & 63, wr = wid >> 2, wc = wid & 3, fr = lane & 15, fq = lane >> 4;
    const int K = g.K, nt = K / BK;
    unsigned voffA0, voffB0;
    { int R, C; stage_rc(tid * 16, R, C); const int Rb = Epi::PERM ? ((R & ~31) + perm32(R & 31)) : R;
      voffA0 = (unsigned)(R * g.lda + C) * 2u; voffB0 = (unsigned)(Rb * K + C) * 2u; }
    const size_t voffAR = (size_t)64 * g.lda * 2, voffBR = (size_t)64 * K * 2;
    const size_t kstep = (size_t)(BK * 2);
    const size_t hstepA = (size_t)HALF * g.lda * 2, hstepB = (size_t)HALF * K * 2;
    const size_t tstepA = 2 * hstepA, tstepB = 2 * hstepB;
    const unsigned lds0_ = (unsigned)(__UINTPTR_TYPE__)lds;
    const unsigned ldsw = (unsigned)wid * 1024u;
    const int aoff = lds_byte(wr * 64 + fr, fq * 8), boff = lds_byte(wc * 32 + fr, fq * 8);
#define PG8_SA(b, h) (((b) * 2 + (h)) * HTB)
#define PG8_SB(b, h) ((4 + (b) * 2 + (h)) * HTB)
#define PG8_STAGE(bufoff, gbase, voff) do { _Pragma("unroll") for (int _i = 0; _i < 2; ++_i) { unsigned keep_; const char* sb_ = (const char*)(gbase) + (size_t)_i * voff##R; \
        asm volatile("s_mov_b32 %0, m0\n\ts_mov_b32 m0, %3\n\ts_nop 0\n\tglobal_load_lds_dwordx4 %1, %2\n\ts_mov_b32 m0, %0" \
            : "=&s"(keep_) : "v"(voff##0), "s"(sb_), "s"(lds0_ + (unsigned)((bufoff) + _i * 8192) + ldsw) : "memory"); } } while (0)
#define PG8_LDA(dst, b, h) do { _Pragma("unroll") for (int m = 0; m < 4; ++m) _Pragma("unroll") for (int k = 0; k < 2; ++k) dst[m][k] = *(const PG8_LAS bf16x8*)(lds + PG8_SA(b, h) + aoff + m * 2048 + k * 1024); } while (0)
#define PG8_LDB(dst, b, h) do { _Pragma("unroll") for (int n = 0; n < 2; ++n) _Pragma("unroll") for (int k = 0; k < 2; ++k) dst[n][k] = *(const PG8_LAS bf16x8*)(lds + PG8_SB(b, h) + boff + n * 2048 + k * 1024); } while (0)
#define PG8_MMA(ai, bj, At, Bt) do { __builtin_amdgcn_s_setprio(1); _Pragma("unroll") for (int m = 0; m < 4; ++m) _Pragma("unroll") for (int n = 0; n < 2; ++n) { \
        if constexpr (F8) { typedef int v8i_ __attribute__((ext_vector_type(8))); typedef int v4i_ __attribute__((ext_vector_type(4))); \
            const v4i_ b0_ = __builtin_bit_cast(v4i_, Bt[n][0]), b1_ = __builtin_bit_cast(v4i_, Bt[n][1]), a0_ = __builtin_bit_cast(v4i_, At[m][0]), a1_ = __builtin_bit_cast(v4i_, At[m][1]); \
            const v8i_ bb_ = __builtin_shufflevector(b0_, b1_, 0, 1, 2, 3, 4, 5, 6, 7), aa_ = __builtin_shufflevector(a0_, a1_, 0, 1, 2, 3, 4, 5, 6, 7); \
            acc[ai][bj][m][n] = __builtin_amdgcn_mfma_scale_f32_16x16x128_f8f6f4(bb_, aa_, acc[ai][bj][m][n], 0, 0, 0, 0, 0, 0); } \
        else { _Pragma("unroll") for (int k = 0; k < 2; ++k) acc[ai][bj][m][n] = __builtin_amdgcn_mfma_f32_16x16x32_bf16(Bt[n][k], At[m][k], acc[ai][bj][m][n], 0, 0, 0); } } \
        __builtin_amdgcn_s_setprio(0); } while (0)
#define PG8_WAIT_V(n) asm volatile("s_waitcnt vmcnt(" #n ")" ::: "memory")
#define PG8_WAIT_L(n) asm volatile("s_waitcnt lgkmcnt(" #n ")" ::: "memory")
#define PG8_BAR __builtin_amdgcn_s_barrier()
#define PG8_SCHED __builtin_amdgcn_sched_barrier(0)
    Unit cur, nxt; int ui = 0;
    if (!S.next(0, cur)) return;
    f32x4 acc[2][2][4][2];
#pragma unroll
    for (int a = 0; a < 2; ++a)
#pragma unroll
        for (int b = 0; b < 2; ++b)
#pragma unroll
            for (int m = 0; m < 4; ++m)
#pragma unroll
                for (int n = 0; n < 2; ++n) acc[a][b][m][n] = (f32x4){0.f, 0.f, 0.f, 0.f};
    bf16x8 At[4][2], B0[2][2], B1[2][2];
    const char* cA = (const char*)g.A + (size_t)cur.pm * tstepA; const char* cB = (const char*)g.Bt + (size_t)cur.pn * tstepB;
    S.a_ready(cur);
    if constexpr (SP2) {
        PG8_STAGE(PG8_SB(0, 0), cB, voffB); PG8_STAGE(PG8_SB(0, 1), cB + hstepB, voffB); PG8_STAGE(PG8_SA(0, 0), cA, voffA); PG8_STAGE(PG8_SA(0, 1), cA + hstepA, voffA);
        if (wr == 1) PG8_BAR;
        PG8_WAIT_V(2); PG8_BAR;
        PG8_STAGE(PG8_SB(1, 0), cB + kstep, voffB); PG8_STAGE(PG8_SA(1, 0), cA + kstep, voffA); PG8_STAGE(PG8_SB(1, 1), cB + hstepB + kstep, voffB);
        PG8_WAIT_V(6); PG8_BAR;
    } else {
        PG8_STAGE(PG8_SB(0, 0), cB, voffB); PG8_STAGE(PG8_SA(0, 0), cA, voffA); PG8_STAGE(PG8_SB(0, 1), cB + hstepB, voffB); PG8_STAGE(PG8_SA(0, 1), cA + hstepA, voffA);
        if (wr == 1) PG8_BAR;
        PG8_WAIT_V(4); PG8_BAR;
        PG8_STAGE(PG8_SB(1, 0), cB + kstep, voffB); PG8_STAGE(PG8_SA(1, 0), cA + kstep, voffA); PG8_STAGE(PG8_SB(1, 1), cB + hstepB + kstep, voffB);
        PG8_WAIT_V(6); PG8_BAR;
    }
    for (;;) {
        const bool has_next = S.next(ui + 1, nxt);
        const char* nA = has_next ? (const char*)g.A + (size_t)nxt.pm * tstepA : cA; const char* nB = has_next ? (const char*)g.Bt + (size_t)nxt.pn * tstepB : cB;
#pragma unroll 1
        for (int t = 0; t < nt; t += 2) {
            const bool last = (t == nt - 2);
            const char* a1 = cA + (size_t)(t + 1) * kstep;
            const char* a2 = last ? nA : cA + (size_t)(t + 2) * kstep; const char* b2 = last ? nB : cB + (size_t)(t + 2) * kstep;
            const char* a3 = a2 + kstep; const char* b3 = b2 + kstep;
            if (last && has_next) S.a_ready(nxt);
            if constexpr (SP2) {
            PG8_LDB(B0, 0, 0); PG8_LDB(B1, 0, 1); PG8_SCHED; PG8_LDA(At, 0, 0); PG8_STAGE(PG8_SA(1, 1), a1 + hstepA, voffA);
            PG8_WAIT_V(8); PG8_WAIT_L(0); PG8_BAR; PG8_MMA(0, 0, At, B0); PG8_MMA(0, 1, At, B1); PG8_BAR; PG8_SCHED;
            PG8_LDA(At, 0, 1); PG8_STAGE(PG8_SB(0, 0), b2, voffB); PG8_STAGE(PG8_SB(0, 1), b2 + hstepB, voffB); PG8_STAGE(PG8_SA(0, 0), a2, voffA);
            PG8_WAIT_V(8); PG8_WAIT_L(0); PG8_BAR; PG8_MMA(1, 0, At, B0); PG8_MMA(1, 1, At, B1); PG8_BAR; PG8_SCHED;
            PG8_LDB(B0, 1, 0); PG8_LDB(B1, 1, 1); PG8_SCHED; PG8_LDA(At, 1, 0); PG8_STAGE(PG8_SA(0, 1), a2 + hstepA, voffA);
            PG8_WAIT_V(8); PG8_WAIT_L(0); PG8_BAR; PG8_MMA(0, 0, At, B0); PG8_MMA(0, 1, At, B1); PG8_BAR; PG8_SCHED;
            PG8_LDA(At, 1, 1); PG8_STAGE(PG8_SB(1, 0), b3, voffB); PG8_STAGE(PG8_SB(1, 1), b3 + hstepB, voffB); PG8_STAGE(PG8_SA(1, 0), a3, voffA);
            PG8_WAIT_V(8); PG8_WAIT_L(0); PG8_BAR; PG8_MMA(1, 0, At, B0); PG8_MMA(1, 1, At, B1); PG8_BAR; PG8_SCHED;
            } else {
            PG8_LDB(B0, 0, 0); PG8_SCHED; PG8_LDA(At, 0, 0); PG8_STAGE(PG8_SA(1, 1), a1 + hstepA, voffA);
            PG8_WAIT_L(8); PG8_BAR; PG8_WAIT_L(0); PG8_MMA(0, 0, At, B0); PG8_BAR; PG8_SCHED;
            PG8_LDB(B1, 0, 1); PG8_STAGE(PG8_SB(0, 0), b2, voffB);
            PG8_BAR; PG8_WAIT_L(0); PG8_MMA(0, 1, At, B1); PG8_BAR;
            PG8_LDA(At, 0, 1); PG8_STAGE(PG8_SA(0, 0), a2, voffA);
            PG8_BAR; PG8_WAIT_L(0); PG8_MMA(1, 0, At, B0); PG8_BAR; PG8_SCHED;
            PG8_STAGE(PG8_SB(0, 1), b2 + hstepB, voffB);
            PG8_WAIT_V(6); PG8_BAR; PG8_MMA(1, 1, At, B1); PG8_BAR;
            PG8_LDB(B0, 1, 0); PG8_SCHED; PG8_LDA(At, 1, 0); PG8_STAGE(PG8_SA(0, 1), a2 + hstepA, voffA);
            PG8_WAIT_L(8); PG8_BAR; PG8_WAIT_L(0); PG8_MMA(0, 0, At, B0); PG8_BAR; PG8_SCHED;
            PG8_LDB(B1, 1, 1); PG8_STAGE(PG8_SB(1, 0), b3, voffB);
            PG8_BAR; PG8_WAIT_L(0); PG8_MMA(0, 1, At, B1); PG8_BAR;
            PG8_LDA(At, 1, 1); PG8_STAGE(PG8_SA(1, 0), a3, voffA);
            PG8_BAR; PG8_WAIT_L(0); PG8_MMA(1, 0, At, B0); PG8_BAR; PG8_SCHED;
            PG8_STAGE(PG8_SB(1, 1), b3 + hstepB, voffB);
            PG8_WAIT_V(6); PG8_BAR; PG8_MMA(1, 1, At, B1); PG8_BAR;
            }
        }
        if constexpr (ALIGN_EPI) { if (wr == 0) PG8_BAR; }
        if constexpr (!Epi::AFTER_DRAIN) { E(acc, cur, wr, wc, fr, fq); S.done(cur); }
        if (!has_next) break;
#pragma unroll
        for (int a = 0; a < 2; ++a)
#pragma unroll
            for (int b = 0; b < 2; ++b)
#pragma unroll
                for (int m = 0; m < 4; ++m)
#pragma unroll
                    for (int n = 0; n < 2; ++n) acc[a][b][m][n] = (f32x4){0.f, 0.f, 0.f, 0.f};
        cur = nxt; cA = nA; cB = nB; ++ui;
        if constexpr (ALIGN_EPI) { if (wr == 1) PG8_BAR; }
    }
    PG8_WAIT_V(0);
    if constexpr (!ALIGN_EPI) { if (wr == 0) PG8_BAR; }
    PG8_BAR;
    if constexpr (Epi::AFTER_DRAIN) { E.fused(acc, cur, wr, wc, fr, fq, lds, wid, lane); S.done(cur); }
#undef PG8_SA
#undef PG8_SB
#undef PG8_STAGE
#undef PG8_LDA
#undef PG8_LDB
#undef PG8_MMA
#undef PG8_WAIT_V
#undef PG8_WAIT_L
#undef PG8_BAR
#undef PG8_SCHED
}
}
namespace att {
#define ATT_LAS __attribute__((address_space(3)))
typedef unsigned short bf16;
typedef short bf16x8 __attribute__((ext_vector_type(8)));
typedef short s16x4 __attribute__((ext_vector_type(4)));
typedef float f32x16 __attribute__((ext_vector_type(16)));
typedef float f32x4_t __attribute__((ext_vector_type(4)));
typedef unsigned u32x4 __attribute__((ext_vector_type(4)));
typedef unsigned u32x2 __attribute__((ext_vector_type(2)));
typedef float f32x2_t __attribute__((ext_vector_type(2))); typedef __bf16 bf16x2_t __attribute__((ext_vector_type(2)));
__device__ __forceinline__ unsigned cvtpk(float lo, float hi) { f32x2_t v = {lo, hi}; bf16x2_t b = __builtin_convertvector(v, bf16x2_t); return __builtin_bit_cast(unsigned, b); }
__device__ __forceinline__ s16x4 vtr(const ATT_LAS unsigned char* p) { return __builtin_bit_cast(s16x4, __builtin_amdgcn_ds_read_tr16_b64_v4i16((ATT_LAS s16x4*)p)); }
constexpr int VSTR = 192;
template <int DQK> struct Geo { static constexpr int KSTR = DQK * 2 + 16, KBUF = 64 * KSTR, VBUF = 64 * VSTR, CPR = DQK / 8, NKC = 64 * CPR, KIT = (NKC + 511) / 512; };
template <int DQK> constexpr int lds_bytes() { return 2 * Geo<DQK>::KBUF + 2 * Geo<DQK>::VBUF + 2048 + 8192; }

__device__ __forceinline__ float xhalf_sum(float m) { return xor32_sum(m); }
__device__ __forceinline__ float max3f(float a, float b, float c) { float r; asm("v_max3_f32 %0, %1, %2, %3" : "=v"(r) : "v"(a), "v"(b), "v"(c)); return r; }
__device__ __forceinline__ float max2f(float a, float b) { float r; asm("v_max_f32_e32 %0, %1, %2" : "=v"(r) : "v"(a), "v"(b)); return r; }
__device__ __forceinline__ float rowmax32(const f32x16& p0, const f32x16& p1) {
    float a = max2f(p0[0], p1[0]), b = max2f(p0[1], p1[1]), c = max2f(p0[2], p1[2]), d = max2f(p0[3], p1[3]);
#pragma unroll
    for (int r = 4; r < 16; r += 4) { a = max3f(a, p0[r], p1[r]); b = max3f(b, p0[r + 1], p1[r + 1]); c = max3f(c, p0[r + 2], p1[r + 2]); d = max3f(d, p0[r + 3], p1[r + 3]); }
    const float m = max2f(max2f(a, b), max2f(c, d));
    float lo_, hi_; halves32(m, lo_, hi_);
    return max2f(lo_, hi_);
}

template <int DQK, bool BAND, int qpitch, int kpitch, int vpitch, int opitch, bool OF8 = false>
__device__ __forceinline__ void attn_unit(ATT_LAS unsigned char* lds, const bf16* Qb, const bf16* Kb, const bf16* Vb, bf16* Ob,
                                          int q0, int t_lo, int t_hi, int my_lo, int my_hi, int cc, const float* bias_g, const float* g_qn, const float* rope, const int wave_idx) {
    typedef Geo<DQK> G;
    int tid_ = wave_idx * 64 + lane_id_(); asm volatile("" : "+v"(tid_));
    const int tid = tid_, lane = tid & 63, r32 = lane & 31, hi = lane >> 5, wid = __builtin_amdgcn_readfirstlane(tid >> 6);
    ATT_LAS float* biasL = (ATT_LAS float*)(lds + 2 * G::KBUF + 2 * G::VBUF);
    bf16x8 qf[DQK / 16];
    { const bf16* qp = Qb + (size_t)(q0 + wid * 32 + r32) * qpitch + 8 * hi;
#pragma unroll
      for (int kk = 0; kk < DQK / 16; ++kk) qf[kk] = *(const bf16x8*)(qp + 16 * kk); }
    if constexpr (!BAND) {
        float qv[DQK / 16][8]; float ss = 0.f;
#pragma unroll
        for (int kk = 0; kk < DQK / 16; ++kk)
#pragma unroll
            for (int j = 0; j < 8; ++j) { qv[kk][j] = __builtin_bit_cast(float, (unsigned)(unsigned short)qf[kk][j] << 16); ss += qv[kk][j] * qv[kk][j]; }
        ss = xhalf_sum(ss);
        const float rs = __builtin_amdgcn_rsqf(ss * (1.f / DQK) + 1e-6f) * (0.10206207261596577f * 1.4426950408889634f);
#pragma unroll
        for (int kk = 0; kk < DQK / 16; ++kk) { const f32x4_t g0 = *(const f32x4_t*)(g_qn + 16 * kk + 8 * hi), g1 = *(const f32x4_t*)(g_qn + 16 * kk + 8 * hi + 4);
#pragma unroll
            for (int j = 0; j < 4; ++j) { qv[kk][j] *= rs * g0[j]; qv[kk][4 + j] *= rs * g1[j]; } }
        const f32x4_t* rp = (const f32x4_t*)(rope + ((size_t)(q0 + wid * 32 + r32) * 16 + 8 * hi) * 2);
#pragma unroll
        for (int j2 = 0; j2 < 4; ++j2) { const f32x4_t cs = rp[j2];
            { const float x1 = qv[4][2 * j2], x2 = qv[5][2 * j2]; qv[4][2 * j2] = x1 * cs[0] - x2 * cs[1]; qv[5][2 * j2] = x2 * cs[0] + x1 * cs[1]; }
            { const float x1 = qv[4][2 * j2 + 1], x2 = qv[5][2 * j2 + 1]; qv[4][2 * j2 + 1] = x1 * cs[2] - x2 * cs[3]; qv[5][2 * j2 + 1] = x2 * cs[2] + x1 * cs[3]; } }
#pragma unroll
        for (int kk = 0; kk < DQK / 16; ++kk) { u32x4 w; w.x = cvtpk(qv[kk][0], qv[kk][1]); w.y = cvtpk(qv[kk][2], qv[kk][3]); w.z = cvtpk(qv[kk][4], qv[kk][5]); w.w = cvtpk(qv[kk][6], qv[kk][7]);
            qf[kk] = __builtin_bit_cast(bf16x8, w); }
    }
    if (BAND) { if (tid < 257) biasL[tid] = bias_g[tid] * 1.4426950408889634f; }
    constexpr int KCPL = G::KSTR / 16, KNP = (64 * KCPL + 63) / 64;
    constexpr int VCPL = VSTR / 16, VNP = 64 * VCPL / 64;
    constexpr int KPP = (KNP + 7) / 8, VPP = (VNP + 7) / 8;
    ATT_LAS unsigned* dmaL = (ATT_LAS unsigned*)(lds + 2 * G::KBUF + 2 * G::VBUF + 2048) + wid * 256 + lane;
#pragma unroll
    for (int pp = 0; pp < KPP; ++pp) { const int pc = wid + 8 * pp, c = pc * 64 + lane, row = (c / KCPL) & 63, ch = c % KCPL; dmaL[64 * pp] = (unsigned)(row * kpitch + (ch < G::CPR ? ch : 0) * 8) * 2u; }
#pragma unroll
    for (int pp = 0; pp < VPP; ++pp) { const int pc = wid + 8 * pp, c = pc * 64 + lane, row = (c / VCPL) & 63, ch = c % VCPL; dmaL[128 + 64 * pp] = (unsigned)(row * vpitch + (ch < 8 ? ch : 0) * 8) * 2u; }
#define ATT_DMA_K(t, b) do { const char* kt_ = (const char*)(Kb + (size_t)(t) * 64 * kpitch); _Pragma("unroll") for (int pp = 0; pp < KPP; ++pp) { if (wid + 8 * pp < KNP) \
            __builtin_amdgcn_global_load_lds((const unsigned*)(kt_ + dmaL[64 * pp]), (ATT_LAS unsigned*)(lds + (b) * G::KBUF + (wid + 8 * pp) * 1024), 16, 0, 0); } } while (0)
#define ATT_DMA_V(t, b) do { const char* vt_ = (const char*)(Vb + (size_t)(t) * 64 * vpitch); _Pragma("unroll") for (int pp = 0; pp < VPP; ++pp) { if (wid + 8 * pp < VNP) \
            __builtin_amdgcn_global_load_lds((const unsigned*)(vt_ + dmaL[128 + 64 * pp]), (ATT_LAS unsigned*)(lds + 2 * G::KBUF + (b) * G::VBUF + (wid + 8 * pp) * 1024), 16, 0, 0); } } while (0)
    f32x16 o0, o1;
#pragma unroll
    for (int i = 0; i < 16; ++i) { o0[i] = 0.f; o1[i] = 0.f; }
    float mrun = -INFINITY, lsum = 0.f;
    const int koff = r32 * G::KSTR + hi * 16;
    const int voff = ((lane >> 5) * 4 + ((lane & 15) >> 2)) * VSTR + (((lane >> 4) & 1) * 16 + (lane & 3) * 4) * 2;
    const f32x16 zero16 = {0.f, 0.f, 0.f, 0.f, 0.f, 0.f, 0.f, 0.f, 0.f, 0.f, 0.f, 0.f, 0.f, 0.f, 0.f, 0.f};
#define ATT_QK(X0, X1, t) do { const ATT_LAS unsigned char* Kt = lds + ((t) & 1) * G::KBUF + koff; \
        _Pragma("unroll") for (int kk = 0; kk < DQK / 16; ++kk) { \
            const bf16x8 a0 = *(const ATT_LAS bf16x8*)(Kt + kk * 32); const bf16x8 a1 = *(const ATT_LAS bf16x8*)(Kt + 32 * G::KSTR + kk * 32); \
            X0 = __builtin_amdgcn_mfma_f32_32x32x16_bf16(a0, qf[kk], kk ? X0 : zero16, 0, 0, 0); X1 = __builtin_amdgcn_mfma_f32_32x32x16_bf16(a1, qf[kk], kk ? X1 : zero16, 0, 0, 0); } } while (0)
#define ATT_SMPV(X0, X1, t) do { \
        float cadd = 0.f; \
        if (BAND) { const int delta = cc - (t); \
            if (delta >= 3) cadd = biasL[256]; \
            else { const ATT_LAS float* bp = biasL + (64 * delta + (32 * (wid & 1) + r32) - 4 * hi + 128 - 63); \
                if (delta < 2) { _Pragma("unroll") for (int i = 0; i < 16; ++i) { const int kj = (i & 3) + 8 * (i >> 2); X0[i] += bp[63 - kj]; X1[i] += bp[31 - kj]; } } \
                else { const int relb = 64 * delta + (32 * (wid & 1) + r32) - 4 * hi + 128; \
                    _Pragma("unroll") for (int i = 0; i < 16; ++i) { const int kj = (i & 3) + 8 * (i >> 2); int i0 = relb - kj, i1 = relb - kj - 32; i0 = i0 > 256 ? 256 : i0; i1 = i1 > 256 ? 256 : i1; \
                        X0[i] += biasL[i0]; X1[i] += biasL[i1]; } } } } \
        const float mt = rowmax32(X0, X1) + cadd; \
        const float mnew = max2f(mrun, mt); \
        const float alpha = __builtin_amdgcn_exp2f(mrun - mnew); \
        const float msub = mnew - cadd; \
        mrun = mnew; \
        float psa[4] = {0.f, 0.f, 0.f, 0.f};   \
        _Pragma("unroll") for (int i = 0; i < 16; ++i) { X0[i] = __builtin_amdgcn_exp2f(X0[i] - msub); X1[i] = __builtin_amdgcn_exp2f(X1[i] - msub); psa[i & 3] += X0[i] + X1[i]; } \
        const float ps = (psa[0] + psa[1]) + (psa[2] + psa[3]); \
        lsum = lsum * alpha + ps; \
        _Pragma("unroll") for (int i = 0; i < 16; ++i) { o0[i] *= alpha; o1[i] *= alpha; } \
        bf16x8 pf[2][2]; \
        _Pragma("unroll") for (int s = 0; s < 2; ++s) { u32x4 w0, w1; \
            w0.x = cvtpk(X0[8 * s + 0], X0[8 * s + 1]); w0.y = cvtpk(X0[8 * s + 2], X0[8 * s + 3]); w0.z = cvtpk(X0[8 * s + 4], X0[8 * s + 5]); w0.w = cvtpk(X0[8 * s + 6], X0[8 * s + 7]); \
            w1.x = cvtpk(X1[8 * s + 0], X1[8 * s + 1]); w1.y = cvtpk(X1[8 * s + 2], X1[8 * s + 3]); w1.z = cvtpk(X1[8 * s + 4], X1[8 * s + 5]); w1.w = cvtpk(X1[8 * s + 6], X1[8 * s + 7]); \
            pf[0][s] = __builtin_bit_cast(bf16x8, w0); pf[1][s] = __builtin_bit_cast(bf16x8, w1); } \
        const ATT_LAS unsigned char* Vt = lds + 2 * G::KBUF + ((t) & 1) * G::VBUF + voff; \
        _Pragma("unroll") for (int kb = 0; kb < 2; ++kb) _Pragma("unroll") for (int s = 0; s < 2; ++s) { \
            const ATT_LAS unsigned char* vp = Vt + (32 * kb + 16 * s) * VSTR; \
            const s16x4 l0 = vtr(vp), h0 = vtr(vp + 8 * VSTR), l1 = vtr(vp + 64), h1 = vtr(vp + 8 * VSTR + 64); \
            const bf16x8 a0 = (bf16x8){l0[0], l0[1], l0[2], l0[3], h0[0], h0[1], h0[2], h0[3]}; \
            const bf16x8 a1 = (bf16x8){l1[0], l1[1], l1[2], l1[3], h1[0], h1[1], h1[2], h1[3]}; \
            o0 = __builtin_amdgcn_mfma_f32_32x32x16_bf16(a0, pf[kb][s], o0, 0, 0, 0); o1 = __builtin_amdgcn_mfma_f32_32x32x16_bf16(a1, pf[kb][s], o1, 0, 0, 0); } } while (0)
#define ATT_FUSED(C0, C1, N0, N1, t, tn) do { \
        bf16x8 kfa[DQK / 16], kfb[DQK / 16]; \
        { const ATT_LAS unsigned char* Kt = lds + ((tn) & 1) * G::KBUF + koff; \
          _Pragma("unroll") for (int kk = 0; kk < DQK / 16; ++kk) { kfa[kk] = *(const ATT_LAS bf16x8*)(Kt + kk * 32); kfb[kk] = *(const ATT_LAS bf16x8*)(Kt + 32 * G::KSTR + kk * 32); } } \
        __builtin_amdgcn_sched_barrier(0); \
        float cadd = 0.f; \
        if (BAND) { const int delta = cc - (t); \
            if (delta >= 3) cadd = biasL[256]; \
            else { const ATT_LAS float* bp = biasL + (64 * delta + (32 * (wid & 1) + r32) - 4 * hi + 128 - 63); \
                if (delta < 2) { _Pragma("unroll") for (int i = 0; i < 16; ++i) { const int kj = (i & 3) + 8 * (i >> 2); C0[i] += bp[63 - kj]; C1[i] += bp[31 - kj]; } } \
                else { const int relb = 64 * delta + (32 * (wid & 1) + r32) - 4 * hi + 128; \
                    _Pragma("unroll") for (int i = 0; i < 16; ++i) { const int kj = (i & 3) + 8 * (i >> 2); int i0 = relb - kj, i1 = relb - kj - 32; i0 = i0 > 256 ? 256 : i0; i1 = i1 > 256 ? 256 : i1; \
                        C0[i] += biasL[i0]; C1[i] += biasL[i1]; } } } } \
        const float mt = rowmax32(C0, C1) + cadd; \
        const float mnew = max2f(mrun, mt); \
        const float alpha = __builtin_amdgcn_exp2f(mrun - mnew); \
        const float msub = mnew - cadd; \
        if (__builtin_amdgcn_ballot_w64(mnew > mrun)) { _Pragma("unroll") for (int i = 0; i < 16; ++i) { o0[i] *= alpha; o1[i] *= alpha; } } \
        mrun = mnew; \
        __builtin_amdgcn_sched_barrier(0); \
        _Pragma("unroll") for (int kk = 0; kk < DQK / 16; ++kk) { \
            N0 = __builtin_amdgcn_mfma_f32_32x32x16_bf16(kfa[kk], qf[kk], kk ? N0 : zero16, 0, 0, 0); N1 = __builtin_amdgcn_mfma_f32_32x32x16_bf16(kfb[kk], qf[kk], kk ? N1 : zero16, 0, 0, 0); } \
        s16x4 vl0[4], vh0[4], vl1[4], vh1[4]; \
        { const ATT_LAS unsigned char* Vt = lds + 2 * G::KBUF + ((t) & 1) * G::VBUF + voff; \
          _Pragma("unroll") for (int ks = 0; ks < 4; ++ks) { const ATT_LAS unsigned char* vp = Vt + 16 * ks * VSTR; vl0[ks] = vtr(vp); vh0[ks] = vtr(vp + 8 * VSTR); vl1[ks] = vtr(vp + 64); vh1[ks] = vtr(vp + 8 * VSTR + 64); } } \
        float psa[4] = {0.f, 0.f, 0.f, 0.f}; \
        _Pragma("unroll") for (int i = 0; i < 16; ++i) { C0[i] = __builtin_amdgcn_exp2f(C0[i] - msub); C1[i] = __builtin_amdgcn_exp2f(C1[i] - msub); psa[i & 3] += C0[i] + C1[i]; } \
        const float ps = (psa[0] + psa[1]) + (psa[2] + psa[3]); \
        lsum = lsum * alpha + ps; \
        bf16x8 pf[4]; \
        _Pragma("unroll") for (int s = 0; s < 2; ++s) { u32x4 w0, w1; \
            w0.x = cvtpk(C0[8 * s + 0], C0[8 * s + 1]); w0.y = cvtpk(C0[8 * s + 2], C0[8 * s + 3]); w0.z = cvtpk(C0[8 * s + 4], C0[8 * s + 5]); w0.w = cvtpk(C0[8 * s + 6], C0[8 * s + 7]); \
            w1.x = cvtpk(C1[8 * s + 0], C1[8 * s + 1]); w1.y = cvtpk(C1[8 * s + 2], C1[8 * s + 3]); w1.z = cvtpk(C1[8 * s + 4], C1[8 * s + 5]); w1.w = cvtpk(C1[8 * s + 6], C1[8 * s + 7]); \
            pf[s] = __builtin_bit_cast(bf16x8, w0); pf[2 + s] = __builtin_bit_cast(bf16x8, w1); } \
        __builtin_amdgcn_sched_barrier(0); \
        _Pragma("unroll") for (int ks = 0; ks < 4; ++ks) { \
            const bf16x8 a0 = (bf16x8){vl0[ks][0], vl0[ks][1], vl0[ks][2], vl0[ks][3], vh0[ks][0], vh0[ks][1], vh0[ks][2], vh0[ks][3]}; \
            const bf16x8 a1 = (bf16x8){vl1[ks][0], vl1[ks][1], vl1[ks][2], vl1[ks][3], vh1[ks][0], vh1[ks][1], vh1[ks][2], vh1[ks][3]}; \
            o0 = __builtin_amdgcn_mfma_f32_32x32x16_bf16(a0, pf[ks], o0, 0, 0, 0); o1 = __builtin_amdgcn_mfma_f32_32x32x16_bf16(a1, pf[ks], o1, 0, 0, 0); } } while (0)
#define ATT_STAGE(t) do { if ((t) + 2 <= t_hi) ATT_DMA_K((t) + 2, (t) & 1); if ((t) + 1 <= t_hi) ATT_DMA_V((t) + 1, ((t) + 1) & 1); } while (0)
    f32x16 sa0, sa1, sb0, sb1;
    ATT_DMA_K(t_lo, t_lo & 1);
    __syncthreads();
    if (t_lo + 1 <= t_hi) ATT_DMA_K(t_lo + 1, (t_lo + 1) & 1);
    ATT_DMA_V(t_lo, t_lo & 1);
    if (my_lo == t_lo) ATT_QK(sa0, sa1, t_lo);
    __syncthreads();
    {
        int t = t_lo;
        for (; t < my_lo - 1; ++t) { ATT_STAGE(t); __syncthreads(); }
        if (my_lo > t_lo) { ATT_STAGE(t); ATT_QK(sa0, sa1, t + 1); __syncthreads(); ++t; }
        int nf = my_hi - my_lo;
        for (; nf >= 2; nf -= 2, t += 2) {
            ATT_STAGE(t); ATT_FUSED(sa0, sa1, sb0, sb1, t, t + 1); __syncthreads();
            ATT_STAGE(t + 1); ATT_FUSED(sb0, sb1, sa0, sa1, t + 1, t + 2); __syncthreads();
        }
        if (nf == 1) {
            ATT_STAGE(t); ATT_FUSED(sa0, sa1, sb0, sb1, t, t + 1); __syncthreads(); ++t;
            ATT_STAGE(t); ATT_SMPV(sb0, sb1, t); __syncthreads(); ++t;
        } else {
            ATT_STAGE(t); ATT_SMPV(sa0, sa1, t); __syncthreads(); ++t;
        }
        for (; t <= t_hi; ++t) { ATT_STAGE(t); __syncthreads(); }
    }
    const float ltot = xhalf_sum(lsum);
    const float inv = 1.f / ltot;
    if constexpr (OF8) {
        unsigned char* op = (unsigned char*)Ob + (size_t)(q0 + wid * 32 + r32) * opitch + 4 * hi; const float i64 = inv * 32.f;
#pragma unroll
        for (int g4 = 0; g4 < 4; ++g4) {
            int w0 = 0, w1 = 0;
            w0 = __builtin_amdgcn_cvt_pk_fp8_f32(o0[4 * g4 + 0] * i64, o0[4 * g4 + 1] * i64, w0, false); w0 = __builtin_amdgcn_cvt_pk_fp8_f32(o0[4 * g4 + 2] * i64, o0[4 * g4 + 3] * i64, w0, true);
            w1 = __builtin_amdgcn_cvt_pk_fp8_f32(o1[4 * g4 + 0] * i64, o1[4 * g4 + 1] * i64, w1, false); w1 = __builtin_amdgcn_cvt_pk_fp8_f32(o1[4 * g4 + 2] * i64, o1[4 * g4 + 3] * i64, w1, true);
            *(int*)(op + 8 * g4) = w0; *(int*)(op + 32 + 8 * g4) = w1;
        }
    } else {
    bf16* op = Ob + (size_t)(q0 + wid * 32 + r32) * opitch + 4 * hi;
#pragma unroll
    for (int g4 = 0; g4 < 4; ++g4) {
        u32x2 w0, w1;
        w0.x = cvtpk(o0[4 * g4 + 0] * inv, o0[4 * g4 + 1] * inv); w0.y = cvtpk(o0[4 * g4 + 2] * inv, o0[4 * g4 + 3] * inv);
        w1.x = cvtpk(o1[4 * g4 + 0] * inv, o1[4 * g4 + 1] * inv); w1.y = cvtpk(o1[4 * g4 + 2] * inv, o1[4 * g4 + 3] * inv);
        *(u32x2*)(op + 8 * g4) = w0; *(u32x2*)(op + 32 + 8 * g4) = w1;
    }
    }
#undef ATT_DMA_K
#undef ATT_DMA_V
#undef ATT_QK
#undef ATT_SMPV
#undef ATT_STAGE
#undef ATT_FUSED
}
}
constexpr int NWAVES = 8;
constexpr int D = 1024, BATCH = 32, SEQ = 2048, M = BATCH * SEQ;
constexpr int NH = 16, QLORA = 384, KVLORA = 256, ROPE_D = 32, NOPE = 64, QKD = 96;
constexpr int NA = 768;
constexpr int FF = 2816, EFF = 3584, NE = 8;
constexpr float EPS = 1e-6f, LOG2E = 1.4426950408889634f;
constexpr int MAXP_HALF = 264, MAXP = 528;
constexpr size_t MiB = 1u << 20;
constexpr size_t WS_CTL = 0, CTL_ZERO_BYTES = 1 * MiB;
constexpr size_t WS_ROPE = 1 * MiB;
constexpr size_t WS_CNT = WS_ROPE + 256 * 1024;
constexpr size_t WS_PANELE = WS_CNT + 16 * 1024;
constexpr size_t WS_META = WS_PANELE + 4096;
constexpr size_t WS_TOKE = 2 * MiB;
constexpr size_t WS_TOKG = WS_TOKE + (size_t)M * 4;
constexpr size_t WS_SLOTTOK = WS_TOKG + (size_t)M * 8;
constexpr size_t WS_SLOTGATE = WS_SLOTTOK + (size_t)MAXP * 256 * 4;
constexpr size_t WS_PARTQA = 976 * MiB, WS_PART1 = 980 * MiB, WS_PART2 = 984 * MiB;
constexpr size_t WS_TOKRSTD = 4 * MiB;
constexpr size_t WS_SLOTRSTD = WS_TOKRSTD + (size_t)M * 4;
static_assert(WS_SLOTGATE + (size_t)MAXP * 256 * 4 <= WS_TOKRSTD && WS_SLOTRSTD + (size_t)MAXP * 256 * 4 <= 8 * MiB, "small arrays");
constexpr size_t WS_W = 8 * MiB;
constexpr size_t WS_WA = WS_W, WS_WUQ = WS_WA + (size_t)NA * D * 2, WS_WUKV = WS_WUQ + (size_t)1536 * QLORA * 2, WS_WO = WS_WUKV + (size_t)2048 * KVLORA * 2;
constexpr size_t WS_WF1 = WS_WO + (size_t)D * D * 2, WS_WF2 = WS_WF1 + (size_t)2 * FF * D * 2, WS_WKVQ = WS_WF2 + (size_t)D * FF * 2, WS_WBO = WS_WKVQ + (size_t)3 * D * D * 2;
constexpr size_t WS_WM1 = WS_WBO + (size_t)D * D * 2, WS_WM2 = WS_WM1 + (size_t)NE * 2 * EFF * D * 2, WS_WEND = WS_WM2 + (size_t)NE * D * EFF * 2;
constexpr size_t ARENA = 208 * MiB;
static_assert(WS_WEND <= ARENA, "weights fit under the arena");
constexpr size_t WS_XN = ARENA;
constexpr size_t WS_QA = ARENA + 128 * MiB;
constexpr size_t WS_Q = ARENA + 224 * MiB;
constexpr size_t WS_K = ARENA + 416 * MiB;
constexpr size_t WS_V = ARENA + 608 * MiB;
constexpr size_t WS_O = ARENA;
static_assert(WS_V + (size_t)M * D * 2 <= 1024 * MiB, "MLA arena");
constexpr size_t WS_XR1 = ARENA + 128 * MiB;
constexpr size_t WS_H = ARENA + 256 * MiB;
constexpr size_t WS_XR2 = ARENA;
constexpr size_t WS_KVQ2 = ARENA + 128 * MiB;
constexpr size_t WS_O2 = ARENA + 512 * MiB;
constexpr size_t WS_XR3 = ARENA + 640 * MiB;
constexpr size_t WS_XG = ARENA;
constexpr size_t WS_HM = ARENA + 264 * MiB;
constexpr size_t WS_END = WS_HM + (size_t)MAXP_HALF * 256 * EFF * 2;
static_assert(WS_XG + (size_t)MAXP * 256 * D * 2 <= WS_HM && WS_END <= 1024 * MiB && WS_XR3 + (size_t)M * D * 2 <= 1024 * MiB && WS_H + (size_t)M * FF * 2 <= 1024 * MiB, "arena");
constexpr int CW_BAR = 4096;
constexpr int RING_OFF = 0, RING_BYTES = 131072;
constexpr int P0_SCR = 128 * 33 * 4;
constexpr int LDSCTL_OFF = 8 * P0_SCR, MISC_OFF = LDSCTL_OFF + 320;
static_assert(LDSCTL_OFF >= RING_BYTES, "control words above every phase's scratch");
constexpr int LDS_BYTES = 147456;
static_assert(MISC_OFF + 128 <= LDS_BYTES, "LDS map");
static_assert(att::lds_bytes<96>() <= RING_BYTES, "attention scratch fits the ring region");

#define GAS __attribute__((address_space(1)))
#define LAS __attribute__((address_space(3)))
typedef unsigned short bf16;
typedef unsigned v4u __attribute__((ext_vector_type(4)));
typedef unsigned v2u __attribute__((ext_vector_type(2)));
typedef float f32x4 __attribute__((ext_vector_type(4)));
typedef GAS unsigned gu32;
#define RLX_AGENT __ATOMIC_RELAXED, __HIP_MEMORY_SCOPE_AGENT
#define LDS_WAIT() asm volatile("s_waitcnt lgkmcnt(0)" ::: "memory")
__device__ __forceinline__ unsigned f2bf(float f) { unsigned u = __builtin_bit_cast(unsigned, f); return (u + 0x7fffu + ((u >> 16) & 1u)) >> 16; }
__device__ __forceinline__ unsigned pk2(float lo, float hi) { return f2bf(lo) | (f2bf(hi) << 16); }
__device__ __forceinline__ float bflo(unsigned u) { return __builtin_bit_cast(float, u << 16); }
__device__ __forceinline__ float bfhi(unsigned u) { return __builtin_bit_cast(float, u & 0xffff0000u); }
__device__ __forceinline__ float wave_sum(float v) {
    v += swz_xor<1>(v); v += swz_xor<2>(v); v += swz_xor<4>(v); v += swz_xor<8>(v); v += swz_xor<16>(v);
    return xor32_sum(v);
}

#define XB_TMO      128
#define XB_XCNT(j)  (256  + 64 * (j))
#define XB_XSUB(j)  (1280 + 64 * (j))
#define XB_XGEN(j)  (2304 + 64 * (j))
#define XB_TOP      3328
#define XB_TOPGEN   3392
#define XCD_BAR_WORDS 3456
#define XB_SPIN_CAP (1u << 18)

__device__ __forceinline__ unsigned xb_ld(unsigned* p)              { return __hip_atomic_load(p, __ATOMIC_RELAXED, __HIP_MEMORY_SCOPE_AGENT); }
__device__ __forceinline__ unsigned xb_add(unsigned* p, unsigned v) { return __hip_atomic_fetch_add(p, v, __ATOMIC_RELAXED, __HIP_MEMORY_SCOPE_AGENT); }
__device__ __forceinline__ unsigned xb_xcc_id() { return (unsigned)__builtin_amdgcn_s_getreg((3 << 11) | 20) & 0xFu; }
#define XB_SPIN(cond, bar) do { unsigned _sp = 0; while (cond) { __builtin_amdgcn_s_sleep(1); \
    if ((++_sp & 255u) == 0u) { if (xb_ld(&(bar)[XB_TMO])) break; if (_sp > XB_SPIN_CAP) { atomicAdd(&(bar)[XB_TMO], 1u); break; } } } } while (0)

struct XcdBarrier {
    int t0;
    unsigned* bar; unsigned x;
    volatile LAS unsigned* st;
};

__device__ __forceinline__ XcdBarrier xcd_barrier_post(unsigned* bar, volatile LAS unsigned* st, int t0) {
    XcdBarrier b; b.t0 = t0; b.bar = bar; b.x = xb_xcc_id(); b.st = st;
    if (b.t0) (void)xb_add(&bar[XB_XCNT(b.x)], 1u);
    return b;
}
__device__ __forceinline__ void xcd_barrier_complete(unsigned* bar, unsigned x, unsigned& nloc, unsigned& nx) {
    const unsigned G = gridDim.x * gridDim.y * gridDim.z;
    unsigned sum, cnt, mine, sp = 0u;
    for (;;) {
        sum = 0u; cnt = 0u; mine = 0u;
#pragma unroll
        for (unsigned j = 0; j < 16; ++j) { const unsigned c = xb_ld(&bar[XB_XCNT(j)]); sum += c; cnt += (c > 0u) ? 1u : 0u; mine = (j == x) ? c : mine; }
        if (sum == G) break;
        __builtin_amdgcn_s_sleep(1);
        if ((++sp & 255u) == 0u) { if (xb_ld(&bar[XB_TMO])) break; if (sp > XB_SPIN_CAP) { atomicAdd(&bar[XB_TMO], 1u); break; } }
    }
    nloc = mine > 0u ? mine : 1u; nx = cnt > 0u ? cnt : 1u;
}

__device__ __forceinline__ void xcd_barrier(const XcdBarrier& b) {
    asm volatile("s_waitcnt vmcnt(0)" ::: "memory");
    __syncthreads();
    if (b.t0) {
        unsigned* bar = b.bar;
        __builtin_amdgcn_s_waitcnt(0);
        unsigned nloc = b.st[0], nx = b.st[1];
        if (nloc == 0u) { xcd_barrier_complete(bar, b.x, nloc, nx); b.st[0] = nloc; b.st[1] = nx; }
        const unsigned old = xb_add(&bar[XB_XSUB(b.x)], 1u);
        const unsigned gen = old / nloc;
        if (old + 1u == (gen + 1u) * nloc) {
            __builtin_amdgcn_fence(__ATOMIC_RELEASE, "agent");
            asm volatile("s_waitcnt vmcnt(0)" ::: "memory");
            const unsigned og = xb_add(&bar[XB_TOP], 1u);
            const unsigned tg = og / nx;
            if (og + 1u == (tg + 1u) * nx) xb_add(&bar[XB_TOPGEN], 1u);
            else XB_SPIN(xb_ld(&bar[XB_TOPGEN]) == tg, bar);
            __builtin_amdgcn_fence(__ATOMIC_ACQUIRE, "agent");
            xb_add(&bar[XB_XGEN(b.x)], 1u);
            asm volatile("s_waitcnt vmcnt(0)" ::: "memory");
        } else {
            XB_SPIN(xb_ld(&bar[XB_XGEN(b.x)]) == gen, bar);
            __builtin_amdgcn_fence(__ATOMIC_ACQUIRE, "agent");
            asm volatile("s_waitcnt vmcnt(0)" ::: "memory");
        }
    }
    __syncthreads();
}

struct Args { const float* in[27]; float* out; unsigned char* ws; };
enum { I_X = 0, I_ATTN_NORM, I_FFN_NORM, I_A_WDQ, I_A_GCQ, I_A_WUQ, I_A_WDKV, I_A_GCKV, I_A_WUKV, I_A_GQN, I_A_GKN, I_A_WO, I_KV_NORM, I_KV_WK, I_KV_WV, I_KV_GKN,
       I_B_WQ, I_B_GQN, I_B_RELB, I_B_WO, I_FFN_W1, I_FFN_W3, I_FFN_W2, I_MOE_ROUTER, I_MOE_W1, I_MOE_W3, I_MOE_W2 };

struct Frame {
    LAS unsigned char* lds;
    int wave, vcu, G;
};
typedef const __attribute__((address_space(4))) Args* KArgs;
__device__ __forceinline__ KArgs kargs() { KArgs p = (KArgs)__builtin_amdgcn_kernarg_segment_ptr(); asm volatile("" : "+s"(p)); return p; }
#define INP(i) (kargs()->in[i])
#define OUTP (kargs()->out)
#define WSP (kargs()->ws)
__device__ __forceinline__ int fresh(int v) { asm volatile("" : "+v"(v)); return v; }

__device__ __forceinline__ void tr_item(const float* W, int ldw, int K, int k0, int nsrc0, const float* gain, bf16* WT, int drow0, LAS float* scr, int lane) {
    const int c4 = lane & 7, r = lane >> 3;
    const GAS float* src = (const GAS float*)W + (size_t)(k0 + r) * ldw + nsrc0 + 4 * c4;
    f32x4 v[16];
#pragma unroll
    for (int i = 0; i < 16; ++i) v[i] = *(const GAS f32x4*)(src + (size_t)(8 * i) * ldw);
    if (gain) {
#pragma unroll
        for (int i = 0; i < 16; ++i) v[i] = v[i] * gain[k0 + 8 * i + r];
    }
#pragma unroll
    for (int i = 0; i < 16; ++i) { LAS float* d = scr + (8 * i + r) * 33 + 4 * c4; d[0] = v[i].x; d[1] = v[i].y; d[2] = v[i].z; d[3] = v[i].w; }
    LDS_WAIT(); asm volatile("" ::: "memory");
    const int c16 = lane >> 2;
#pragma unroll
    for (int j = 0; j < 8; ++j) { const int n = (lane & 3) + 4 * j; const LAS float* sp = scr + (8 * c16) * 33 + n;
        v4u o; o.x = pk2(sp[0 * 33], sp[1 * 33]); o.y = pk2(sp[2 * 33], sp[3 * 33]); o.z = pk2(sp[4 * 33], sp[5 * 33]); o.w = pk2(sp[6 * 33], sp[7 * 33]);
        *(GAS v4u*)(WT + (size_t)(drow0 + n) * K + k0 + 8 * c16) = o; }
    LDS_WAIT(); asm volatile("" ::: "memory");
}
__device__ __forceinline__ void tr_plain(const float* W, int K, int N, const float* gain, bf16* WT, int drow_off, LAS float* scr, int item, int lane) {
    const int nblk = N / 32, kb = item / nblk, nb = item % nblk;
    tr_item(W, N, K, 128 * kb, 32 * nb, gain, WT, drow_off + 32 * nb, scr, lane);
}
__device__ __forceinline__ void tr_gated(const float* W, int K, int N, const float* gain, bf16* WT, int half, LAS float* scr, int item, int lane) {
    const int nblk = N / 32, kb = item / nblk, nb = item % nblk, n0 = 32 * nb;
    tr_item(W, N, K, 128 * kb, n0, gain, WT, (n0 >> 7) * 256 + half * 128 + (n0 & 127), scr, lane);
}
__device__ __forceinline__ unsigned pk_fp8x4(float a, float b, float c, float d) { int w = 0; w = __builtin_amdgcn_cvt_pk_fp8_f32(a, b, w, false); w = __builtin_amdgcn_cvt_pk_fp8_f32(c, d, w, true); return (unsigned)w; }
__device__ __forceinline__ void tr_item_f8(const float* W, int ldw, int K, int k0, int nsrc0, const float* gain, unsigned char* WT, int drow0, LAS float* scr, int lane) {
    const int c4 = lane & 7, r = lane >> 3;
    const GAS float* src = (const GAS float*)W + (size_t)(k0 + r) * ldw + nsrc0 + 4 * c4;
    f32x4 v[16];
#pragma unroll
    for (int i = 0; i < 16; ++i) v[i] = *(const GAS f32x4*)(src + (size_t)(8 * i) * ldw);
#pragma unroll
    for (int i = 0; i < 16; ++i) v[i] = v[i] * (gain ? gain[k0 + 8 * i + r] * 64.f : 64.f);
#pragma unroll
    for (int i = 0; i < 16; ++i) { LAS float* d = scr + (8 * i + r) * 33 + 4 * c4; d[0] = v[i].x; d[1] = v[i].y; d[2] = v[i].z; d[3] = v[i].w; }
    LDS_WAIT(); asm volatile("" ::: "memory");
    const int c8 = lane >> 3;
#pragma unroll
    for (int j = 0; j < 4; ++j) { const int n = (lane & 7) + 8 * j; const LAS float* sp = scr + (16 * c8) * 33 + n;
        v4u o; o.x = pk_fp8x4(sp[0 * 33], sp[1 * 33], sp[2 * 33], sp[3 * 33]); o.y = pk_fp8x4(sp[4 * 33], sp[5 * 33], sp[6 * 33], sp[7 * 33]);
        o.z = pk_fp8x4(sp[8 * 33], sp[9 * 33], sp[10 * 33], sp[11 * 33]); o.w = pk_fp8x4(sp[12 * 33], sp[13 * 33], sp[14 * 33], sp[15 * 33]);
        *(GAS v4u*)(WT + (size_t)(drow0 + n) * K + k0 + 16 * c8) = o; }
    LDS_WAIT(); asm volatile("" ::: "memory");
}
__device__ __forceinline__ float rms_row_to_bf16(const float* xrow, bf16* orow, int lane, f32x4 (&v)[4]) {
    const GAS f32x4* xr = (const GAS f32x4*)xrow + lane;
    float s = 0.f;
#pragma unroll
    for (int j = 0; j < 4; ++j) { v[j] = xr[64 * j]; s += (v[j].x * v[j].x + v[j].y * v[j].y) + (v[j].z * v[j].z + v[j].w * v[j].w); }
    const float rstd = 1.f / sqrtf(wave_sum(s) * (1.f / D) + EPS);
    GAS unsigned long long* o8 = (GAS unsigned long long*)orow + lane;
#pragma unroll
    for (int j = 0; j < 4; ++j) o8[64 * j] = (unsigned long long)pk2(v[j].x * rstd, v[j].y * rstd) | ((unsigned long long)pk2(v[j].z * rstd, v[j].w * rstd) << 32);
    return rstd;
}
__device__ __forceinline__ void norm_phase(const Frame& F, const float* x, bf16* xn) {
    const int tid = fresh(F.wave * 64 + lane_id_()), lane = tid & 63; (void)lane;
    const int gw = F.vcu * NWAVES + F.wave, NGW = F.G * NWAVES;
    for (int m = 2 * gw; m < M; m += 2 * NGW) {
        const GAS f32x4* xr = (const GAS f32x4*)(x + (size_t)m * D) + lane;
        f32x4 v[8]; float s0 = 0.f, s1 = 0.f;
#pragma unroll
        for (int j = 0; j < 8; ++j) v[j] = xr[64 * j];
#pragma unroll
        for (int j = 0; j < 4; ++j) { s0 += (v[j].x * v[j].x + v[j].y * v[j].y) + (v[j].z * v[j].z + v[j].w * v[j].w); s1 += (v[4 + j].x * v[4 + j].x + v[4 + j].y * v[4 + j].y) + (v[4 + j].z * v[4 + j].z + v[4 + j].w * v[4 + j].w); }
        const float r0 = 1.f / sqrtf(wave_sum(s0) * (1.f / D) + EPS), r1 = 1.f / sqrtf(wave_sum(s1) * (1.f / D) + EPS);
        GAS unsigned* o4 = (GAS unsigned*)((GAS unsigned char*)xn + (size_t)m * D) + lane;
#pragma unroll
        for (int j = 0; j < 8; ++j) { const float rr = j < 4 ? r0 : r1; o4[64 * j] = pk_fp8x4(v[j].x * rr, v[j].y * rr, v[j].z * rr, v[j].w * rr); }
    }
}

__device__ __forceinline__ void p0_prologue(const Frame& F) {
    const int tid = fresh(F.wave * 64 + lane_id_()), lane = tid & 63; (void)lane;
    LAS float* scr = (LAS float*)(F.lds + RING_OFF + F.wave * P0_SCR);
    unsigned char* ws = WSP;
    const int gw = F.vcu * NWAVES + F.wave, NGW = F.G * NWAVES;
    constexpr int I_DQ = 8 * 12, I_DKV = 8 * 9, I_UQ = 3 * 48, I_UKV = 2 * 64, I_SQ = 8 * 32, I_F13 = 8 * 88, I_F2 = 22 * 32, I_M13 = 8 * 112, I_M2 = 28 * 32;
    constexpr int NSMALL = I_DQ + I_DKV + I_UQ + I_UKV + I_SQ + 2 * I_F13 + I_F2 + 4 * I_SQ;
    constexpr int NITEMS = NSMALL + NE * (2 * I_M13 + I_M2);
    for (int it = gw; it < NITEMS; it += NGW) {
        int r = it;
        if (r < I_DQ)  { const int kb = r / 12, n0 = 32 * (r % 12); tr_item_f8(INP(I_A_WDQ), QLORA, D, 128 * kb, n0, INP(I_ATTN_NORM), ws + WS_WA, n0, scr, lane); continue; } r -= I_DQ;
        if (r < I_DKV) { const int kb = r / 9, n0 = 32 * (r % 9); tr_item_f8(INP(I_A_WDKV), KVLORA + ROPE_D, D, 128 * kb, n0, INP(I_ATTN_NORM), ws + WS_WA, QLORA + n0, scr, lane); continue; } r -= I_DKV;
        if (r < I_UQ)  { tr_plain(INP(I_A_WUQ), QLORA, NH * QKD, INP(I_A_GCQ), (bf16*)(ws + WS_WUQ), 0, scr, r, lane); continue; } r -= I_UQ;
        if (r < I_UKV) { const int kb = r / 64, n0 = 32 * (r % 64), head = n0 >> 7, within = n0 & 127;
            const int drow = within < 64 ? 256 * (head >> 2) + 128 * (within >> 5) + 32 * (head & 3) : 1024 + head * 64 + (within - 64);
            tr_item(INP(I_A_WUKV), NH * 128, KVLORA, 128 * kb, n0, INP(I_A_GCKV), (bf16*)(ws + WS_WUKV), drow, scr, lane); continue; } r -= I_UKV;
        if (r < I_SQ)  { const int kb = r / 32, n0 = 32 * (r % 32); tr_item_f8(INP(I_A_WO), D, D, 128 * kb, n0, nullptr, ws + WS_WO, n0, scr, lane); continue; } r -= I_SQ;
        if (r < I_F13) { tr_gated(INP(I_FFN_W1), D, FF, INP(I_FFN_NORM), (bf16*)(ws + WS_WF1), 0, scr, r, lane); continue; } r -= I_F13;
        if (r < I_F13) { tr_gated(INP(I_FFN_W3), D, FF, INP(I_FFN_NORM), (bf16*)(ws + WS_WF1), 1, scr, r, lane); continue; } r -= I_F13;
        if (r < I_F2)  { tr_plain(INP(I_FFN_W2), FF, D, nullptr, (bf16*)(ws + WS_WF2), 0, scr, r, lane); continue; } r -= I_F2;
        if (r < I_SQ)  { const int kb = r / 32, n0 = 32 * (r % 32), head = n0 >> 6;
            tr_item_f8(INP(I_KV_WK), D, D, 128 * kb, n0, INP(I_KV_NORM), ws + WS_WKVQ, 256 * (head >> 2) + 128 * ((n0 >> 5) & 1) + 32 * (head & 3), scr, lane); continue; } r -= I_SQ;
        if (r < I_SQ)  { const int kb = r / 32, n0 = 32 * (r % 32); tr_item_f8(INP(I_KV_WV), D, D, 128 * kb, n0, INP(I_KV_NORM), ws + WS_WKVQ, 2 * D + n0, scr, lane); continue; } r -= I_SQ;
        if (r < I_SQ)  { const int kb = r / 32, n0 = 32 * (r % 32), head = n0 >> 6;
            tr_item_f8(INP(I_B_WQ), D, D, 128 * kb, n0, INP(I_ATTN_NORM) + D, ws + WS_WKVQ, D + 256 * (head >> 2) + 128 * ((n0 >> 5) & 1) + 32 * (head & 3), scr, lane); continue; } r -= I_SQ;
        if (r < I_SQ)  { const int kb = r / 32, n0 = 32 * (r % 32); tr_item_f8(INP(I_B_WO), D, D, 128 * kb, n0, nullptr, ws + WS_WBO, n0, scr, lane); continue; } r -= I_SQ;
        const int e = r / (2 * I_M13 + I_M2); r -= e * (2 * I_M13 + I_M2);
        if (r < I_M13) { const int kb = r / 112, n0 = 32 * (r % 112);
            tr_item_f8(INP(I_MOE_W1) + (size_t)e * D * EFF, EFF, D, 128 * kb, n0, INP(I_FFN_NORM) + D, ws + WS_WM1 + (size_t)e * 2 * EFF * D, (n0 >> 7) * 256 + (n0 & 127), scr, lane); continue; } r -= I_M13;
        if (r < I_M13) { const int kb = r / 112, n0 = 32 * (r % 112);
            tr_item_f8(INP(I_MOE_W3) + (size_t)e * D * EFF, EFF, D, 128 * kb, n0, INP(I_FFN_NORM) + D, ws + WS_WM1 + (size_t)e * 2 * EFF * D, (n0 >> 7) * 256 + 128 + (n0 & 127), scr, lane); continue; } r -= I_M13;
        { const int kb = r / 32, n0 = 32 * (r % 32); tr_item_f8(INP(I_MOE_W2) + (size_t)e * EFF * D, D, EFF, 128 * kb, n0, nullptr, ws + WS_WM2 + (size_t)e * D * EFF, n0, scr, lane); }
    }
    const int gt = F.vcu * (NWAVES * 64) + tid, NGT = F.G * NWAVES * 64;
    for (int c = gt; c < 96 * D / 16; c += NGT) *((GAS v4u*)(ws + WS_WA + (size_t)(QLORA + KVLORA + ROPE_D) * D) + c) = (v4u){0u, 0u, 0u, 0u};
    for (int c = gt; c < SEQ * 16; c += NGT) { const int pos = c >> 4, i = c & 15;
        const float inv = __builtin_amdgcn_exp2f(-(float)i * (13.287712379549449f / 16.f));
        const float rev = (float)pos * inv * 0.15915494309189535f; const float fr = rev - floorf(rev);
        ((GAS float*)(ws + WS_ROPE))[2 * c] = __builtin_amdgcn_cosf(fr); ((GAS float*)(ws + WS_ROPE))[2 * c + 1] = __builtin_amdgcn_sinf(fr); }
    norm_phase(F, INP(I_X), (bf16*)(ws + WS_XN));
}

__device__ __forceinline__ void route_phase(const Frame& F) {
    const int tid = fresh(F.wave * 64 + lane_id_()), lane = tid & 63;
    unsigned char* ws = WSP;
    LAS float* wrg = (LAS float*)(F.lds + RING_OFF);
    LAS int* cnt = (LAS int*)(F.lds + RING_OFF + 32768);
    const float* wr = INP(I_MOE_ROUTER); const float* g = INP(I_FFN_NORM) + D;
    for (int idx = tid; idx < D * NE; idx += NWAVES * 64) { const int k = idx >> 3, e = idx & 7, j = k >> 8, l = (k & 255) >> 2, q = k & 3;
        wrg[((j * 4 + q) * 2 + (e >> 2)) * 256 + 4 * l + (e & 3)] = wr[idx] * g[k]; }
    __syncthreads();
    const int b5 = (lane >> 5) & 1, b4 = (lane >> 4) & 1, b3 = (lane >> 3) & 1;
    for (int c = F.vcu; c < M / 256; c += F.G) {
        if (tid < 16) cnt[tid] = 0;
        __syncthreads();
        f32x4 vn[4];
        { const GAS f32x4* xr = (const GAS f32x4*)(OUTP + (size_t)(c * 256 + F.wave * 32) * D) + lane;
#pragma unroll
          for (int j = 0; j < 4; ++j) vn[j] = xr[64 * j]; }
        for (int i = 0; i < 32; ++i) {
            const int m = c * 256 + F.wave * 32 + i;
            f32x4 v[4]; float ssx = 0.f;
#pragma unroll
            for (int j = 0; j < 4; ++j) v[j] = vn[j];
            if (i + 1 < 32) { const GAS f32x4* xr = (const GAS f32x4*)(OUTP + (size_t)(m + 1) * D) + lane;
#pragma unroll
              for (int j = 0; j < 4; ++j) vn[j] = xr[64 * j]; }
#pragma unroll
            for (int j = 0; j < 4; ++j) ssx += (v[j].x * v[j].x + v[j].y * v[j].y) + (v[j].z * v[j].z + v[j].w * v[j].w);
            float lg[8];
#pragma unroll
            for (int e = 0; e < 8; ++e) lg[e] = 0.f;
#pragma unroll
            for (int j = 0; j < 4; ++j)
#pragma unroll
                for (int q = 0; q < 4; ++q) { const float xv = v[j][q];
                    const f32x4 w0 = *(const LAS f32x4*)(wrg + ((j * 4 + q) * 2) * 256 + 4 * lane), w1 = *(const LAS f32x4*)(wrg + ((j * 4 + q) * 2 + 1) * 256 + 4 * lane);
                    lg[0] += xv * w0.x; lg[1] += xv * w0.y; lg[2] += xv * w0.z; lg[3] += xv * w0.w; lg[4] += xv * w1.x; lg[5] += xv * w1.y; lg[6] += xv * w1.z; lg[7] += xv * w1.w; }
            float r4[4], r2[2], r1;
#pragma unroll
            for (int e = 0; e < 4; ++e) { const float mine = b5 ? lg[4 + e] : lg[e], other = b5 ? lg[e] : lg[4 + e]; r4[e] = mine + xor32_partner(other, b5); }
#pragma unroll
            for (int e = 0; e < 2; ++e) { const float mine = b4 ? r4[2 + e] : r4[e], other = b4 ? r4[e] : r4[2 + e]; r2[e] = mine + swz_xor<16>(other); }
            { const float mine = b3 ? r2[1] : r2[0], other = b3 ? r2[0] : r2[1]; r1 = mine + swz_xor<8>(other); }
            r1 += swz_xor<4>(r1); r1 += swz_xor<2>(r1); r1 += swz_xor<1>(r1);
            const float rstd = 1.f / sqrtf(wave_sum(ssx) * (1.f / D) + EPS);
#pragma unroll
            for (int e = 0; e < 8; ++e) lg[e] = __builtin_bit_cast(float, __builtin_amdgcn_readlane(__builtin_bit_cast(int, r1), 8 * e)) * rstd;
            int e1 = 0; float l1 = lg[0];
#pragma unroll
            for (int e = 1; e < 8; ++e) if (lg[e] > l1) { l1 = lg[e]; e1 = e; }
            int e2 = -1; float l2 = -INFINITY;
#pragma unroll
            for (int e = 0; e < 8; ++e) if (e != e1 && lg[e] > l2) { l2 = lg[e]; e2 = e; }
            const float g1 = 1.f / (1.f + __expf(l2 - l1)), g2 = 1.f - g1;
            const int elo = e1 < e2 ? e1 : e2, ehi = e1 < e2 ? e2 : e1;
            const float glo = e1 < e2 ? g1 : g2, ghi = e1 < e2 ? g2 : g1;
            if (lane == 0) { ((GAS float*)(ws + WS_TOKRSTD))[m] = rstd; ((GAS int*)(ws + WS_TOKE))[m] = elo | (ehi << 8); ((GAS float*)(ws + WS_TOKG))[2 * m] = glo; ((GAS float*)(ws + WS_TOKG))[2 * m + 1] = ghi;
                atomicAdd((int*)&cnt[elo], 1); atomicAdd((int*)&cnt[8 + ehi], 1); }
        }
        __syncthreads();
        if (tid < 16) ((GAS int*)(ws + WS_CNT))[c * 16 + tid] = cnt[tid];
        __syncthreads();
    }
}

__device__ __forceinline__ void slot_phase(const Frame& F, unsigned char* ws) {
    const int tid = fresh(F.wave * 64 + lane_id_()), lane = tid & 63; (void)lane;
    LAS int* call = (LAS int*)(F.lds + RING_OFF);
    LAS int* tot = call + 4096; LAS int* base = tot + 16; LAS int* pre = base + 16; LAS int* meta = pre + 16;
    LAS int* grp = meta + 16;
    LAS int* slot_of = grp + 512;
    for (int idx = tid; idx < 4096; idx += NWAVES * 64) call[idx] = ((const GAS int*)(ws + WS_CNT))[idx];
    __syncthreads();
    if (tid < 16) { int t = 0; for (int cc = 0; cc < 256; ++cc) t += call[cc * 16 + tid]; tot[tid] = t; }
    __syncthreads();
    if (tid == 0) { int off = 0; for (int g = 0; g < 16; ++g) { base[g] = off; off += (tot[g] + 255) & ~255; if (g == 7) meta[0] = off >> 8; } meta[1] = (off >> 8) - meta[0]; }
    __syncthreads();
    for (int c = F.vcu; c < M / 256; c += F.G) {
        if (tid < 16) { int p = 0; for (int cc = 0; cc < c; ++cc) p += call[cc * 16 + tid]; pre[tid] = p; }
        const int hf = tid >> 8, i = tid & 255, m = c * 256 + i;
        const int te = ((const GAS int*)(ws + WS_TOKE))[m];
        const int g = hf * 8 + (hf ? ((te >> 8) & 0xff) : (te & 0xff));
        grp[tid] = g;
        __syncthreads();
        int rank = 0;
        for (int j = 0; j < i; ++j) rank += (grp[hf * 256 + j] == g) ? 1 : 0;
        const int slot = base[g] + pre[g] + rank;
        ((GAS int*)(ws + WS_SLOTTOK))[slot] = m; ((GAS float*)(ws + WS_SLOTGATE))[slot] = ((const GAS float*)(ws + WS_TOKG))[2 * m + hf];
        slot_of[tid] = slot;
        __syncthreads();
        for (int i0 = F.wave; i0 < 256; i0 += 4 * NWAVES) {
            v4u x[4][2]; float rs[4];
#pragma unroll
            for (int k = 0; k < 4; ++k) { const int mm = c * 256 + i0 + 8 * k; const GAS v4u* src = (const GAS v4u*)(ws + WS_XR3 + (size_t)mm * D * 2);
                x[k][0] = src[2 * lane]; x[k][1] = src[2 * lane + 1]; rs[k] = ((const GAS float*)(ws + WS_TOKRSTD))[mm]; }
#pragma unroll
            for (int k = 0; k < 4; ++k) { const int i = i0 + 8 * k; const v4u x0 = x[k][0], x1 = x[k][1]; const float r = rs[k];
                const v4u o = (v4u){pk_fp8x4(bflo(x0.x) * r, bfhi(x0.x) * r, bflo(x0.y) * r, bfhi(x0.y) * r), pk_fp8x4(bflo(x0.z) * r, bfhi(x0.z) * r, bflo(x0.w) * r, bfhi(x0.w) * r),
                                    pk_fp8x4(bflo(x1.x) * r, bfhi(x1.x) * r, bflo(x1.y) * r, bfhi(x1.y) * r), pk_fp8x4(bflo(x1.z) * r, bfhi(x1.z) * r, bflo(x1.w) * r, bfhi(x1.w) * r)};
                ((GAS v4u*)(ws + WS_XG + (size_t)slot_of[i] * D))[lane] = o; ((GAS v4u*)(ws + WS_XG + (size_t)slot_of[256 + i] * D))[lane] = o; }
        }
        __syncthreads();
    }
    for (int g = F.vcu; g < 16; g += F.G) {
        const int s0 = base[g] + tot[g], s1 = base[g] + ((tot[g] + 255) & ~255);
        for (int s = s0 + F.wave; s < s1; s += NWAVES) { GAS v4u* dst = (GAS v4u*)(ws + WS_XG + (size_t)s * D);
            dst[lane] = (v4u){0u, 0u, 0u, 0u};
            if (lane == 0) { ((GAS int*)(ws + WS_SLOTTOK))[s] = -1; ((GAS float*)(ws + WS_SLOTGATE))[s] = 0.f; } }
    }
    if (F.vcu == 0) {
        if (tid < 16) { const int p0 = base[tid] >> 8, p1 = (base[tid] + ((tot[tid] + 255) & ~255)) >> 8; for (int p = p0; p < p1; ++p) ((GAS int*)(ws + WS_PANELE))[p] = tid & 7; }
        if (tid == 0) { ((GAS int*)(ws + WS_META))[0] = meta[0]; ((GAS int*)(ws + WS_META))[1] = meta[1]; }
        if (tid < 16) ((GAS int*)(ws + WS_META))[2 + tid] = base[tid] >> 8;
    }
    __syncthreads();
}

__global__ void __launch_bounds__(NWAVES * 64, 2) yoco_fwd(Args args) {
    extern __shared__ __attribute__((aligned(16))) unsigned char lds_raw[];
    Frame F;
    F.lds = (LAS unsigned char*)lds_raw;
    F.wave = __builtin_amdgcn_readfirstlane((int)threadIdx.x >> 6);
    F.G = gridDim.x; { const int bx = blockIdx.x; F.vcu = (F.G % 8 == 0) ? (bx % 8) * (F.G / 8) + bx / 8 : bx; }
    unsigned char* ws = WSP;
    volatile LAS unsigned* MISC = (volatile LAS unsigned*)(F.lds + MISC_OFF);
    for (int u = fresh((int)threadIdx.x); u < (LDS_BYTES - LDSCTL_OFF) / 4; u += NWAVES * 64) ((LAS unsigned*)(F.lds + LDSCTL_OFF))[u] = 0u;
    __syncthreads();
    (void)xcd_barrier_post((unsigned*)(ws + WS_CTL) + CW_BAR, MISC + 8, (F.wave == 0 && lane_id_() == 0) ? 1 : 0);
    LAS unsigned char* ring = F.lds + RING_OFF;
#define bid ((int)blockIdx.x)
#define GRID_BAR() do { XcdBarrier b_; b_.t0 = (F.wave == 0 && lane_id_() == 0) ? 1 : 0; b_.bar = (unsigned*)(WSP + WS_CTL) + CW_BAR; b_.x = xb_xcc_id(); b_.st = (volatile LAS unsigned*)(F.lds + MISC_OFF) + 8; xcd_barrier(b_); } while (0)
#define GEMM(EpiT, SchedT) pg8::gemm_phase<EpiT, SchedT, true, true>

    p0_prologue(F);
    GRID_BAR();
    { pg8::Gemm g{(const bf16*)(ws + WS_XN), (const bf16*)(ws + WS_WA), M, NA, D / 2, D / 2}; pg8::StaticOrder S; S.init(M, NA, F.G, bid);
      pg8::EpiQA E{(bf16*)(ws + WS_QA), (float*)(ws + WS_PARTQA), 1.f / 64};
      pg8::gemm_phase<pg8::EpiQA, pg8::StaticOrder, true, true, true>(ring, g, S, E, F.wave); }
    GRID_BAR();
    { pg8::Gemm g{(const bf16*)(ws + WS_QA), (const bf16*)(ws + WS_WUQ), M, NH * QKD, QLORA, NA}; pg8::StaticOrder S; S.init(M, NH * QKD, F.G, bid);
      pg8::EpiRowScaleBf16 E{(bf16*)(ws + WS_Q), NH * QKD, (const float*)(ws + WS_PARTQA), 1.f / QLORA};
      GEMM(pg8::EpiRowScaleBf16, pg8::StaticOrder)(ring, g, S, E, F.wave); }
    { pg8::Gemm g{(const bf16*)(ws + WS_QA) + QLORA, (const bf16*)(ws + WS_WUKV), M, NH * 128, KVLORA, NA}; pg8::StaticOrder S; S.init(M, NH * 128, F.G, bid);
      pg8::EpiKVup E{(bf16*)(ws + WS_K), (bf16*)(ws + WS_V), (const float*)(ws + WS_PARTQA), (const bf16*)(ws + WS_QA), INP(I_A_GKN), (const float*)(ws + WS_ROPE)};
      GEMM(pg8::EpiKVup, pg8::StaticOrder)(ring, g, S, E, F.wave); }
    GRID_BAR();
    for (int p = F.vcu; p < BATCH * NH * 4; p += F.G) {
        const int bh = p >> 2, pid = p & 3, b = bh >> 4, h = bh & 15;
        for (int u2 = 0; u2 < 2; ++u2) {
            const int qb = u2 ? 7 - pid : pid;
            att::attn_unit<96, false, 1536, 1536, D, D, true>(ring, (const bf16*)(ws + WS_Q) + (size_t)b * SEQ * 1536 + h * QKD, (const bf16*)(ws + WS_K) + (size_t)b * SEQ * 1536 + h * QKD,
                                      (const bf16*)(ws + WS_V) + (size_t)b * SEQ * D + h * 64, (bf16*)(ws + WS_O + (size_t)b * SEQ * D + h * 64),
                                      256 * qb, 0, 4 * qb + 3, 0, 4 * qb + (F.wave >> 1), 0, nullptr, INP(I_A_GQN), (const float*)(ws + WS_ROPE), F.wave);
        }
    }
    GRID_BAR();
    { pg8::Gemm g{(const bf16*)(ws + WS_O), (const bf16*)(ws + WS_WO), M, D, D / 2, D / 2}; pg8::StaticOrder S; S.init(M, D, F.G, bid);
      pg8::EpiResNorm<true> E{INP(I_X), OUTP, (bf16*)(ws + WS_XR1), (float*)(ws + WS_PART1), 1.f / 2048};
      pg8::gemm_phase<pg8::EpiResNorm<true>, pg8::StaticOrder, true, true, true>(ring, g, S, E, F.wave); }
    GRID_BAR();
    { pg8::Gemm g{(const bf16*)(ws + WS_XR1), (const bf16*)(ws + WS_WF1), M, 2 * FF, D, D}; pg8::StaticOrder S; S.init(M, 2 * FF, F.G, bid);
      pg8::EpiGated<true> E{(bf16*)(ws + WS_H), FF, 0, (const float*)(ws + WS_PART1)};
      GEMM(pg8::EpiGated<true>, pg8::StaticOrder)(ring, g, S, E, F.wave); }
    GRID_BAR();
    { pg8::Gemm g{(const bf16*)(ws + WS_H), (const bf16*)(ws + WS_WF2), M, D, FF, FF}; pg8::StaticOrder S; S.init(M, D, F.G, bid);
      pg8::EpiResNorm<true, true> E{OUTP, OUTP, (bf16*)(ws + WS_XR2), (float*)(ws + WS_PART2), 1.f};
      pg8::gemm_phase<pg8::EpiResNorm<true, true>, pg8::StaticOrder, true, true>(ring, g, S, E, F.wave); }
    GRID_BAR();
    { pg8::Gemm g{(const bf16*)(ws + WS_XR2), (const bf16*)(ws + WS_WKVQ), M, 2 * D, D / 2, D / 2}; pg8::StaticOrder S; S.init(M, 2 * D, F.G, bid);
      pg8::EpiK2Q2 E{(bf16*)(ws + WS_KVQ2), (const float*)(ws + WS_PART2), INP(I_KV_GKN), INP(I_B_GQN), 1.f / 64};
      pg8::gemm_phase<pg8::EpiK2Q2, pg8::StaticOrder, true, true, true>(ring, g, S, E, F.wave); }
    { pg8::Gemm g{(const bf16*)(ws + WS_XR2), (const bf16*)(ws + WS_WKVQ + (size_t)2 * D * D), M, D, D / 2, D / 2}; pg8::StaticOrder S; S.init(M, D, F.G, bid);
      pg8::EpiRowScale16 E{(bf16*)(ws + WS_KVQ2), 3 * D, D, (const float*)(ws + WS_PART2), 1.f / 64};
      pg8::gemm_phase<pg8::EpiRowScale16, pg8::StaticOrder, true, true, true>(ring, g, S, E, F.wave); }
    GRID_BAR();
    for (int p = F.vcu; p < BATCH * NH * 8; p += F.G) {
        const int bh = p >> 3, cb = ((p & 7) + (p >> 8)) & 7, b = bh >> 4, h = bh & 15;
        const int c0 = 4 * cb, cc = c0 + (F.wave >> 1);
        const bf16* base = (const bf16*)(ws + WS_KVQ2) + (size_t)b * SEQ * 3072 + h * 64;
        att::attn_unit<64, true, 3072, 3072, 3072, D, true>(ring, base + 2048, base, base + 1024, (bf16*)(ws + WS_O2 + (size_t)b * SEQ * D + h * 64),
                                 256 * cb, c0 - 8 < 0 ? 0 : c0 - 8, c0 + 3, cc - 8 < 0 ? 0 : cc - 8, cc, cc, INP(I_B_RELB) + h * 257, nullptr, nullptr, F.wave);
    }
    GRID_BAR();
    { pg8::Gemm g{(const bf16*)(ws + WS_O2), (const bf16*)(ws + WS_WBO), M, D, D / 2, D / 2}; pg8::StaticOrder S; S.init(M, D, F.G, bid);
      pg8::EpiResNorm<false> E{OUTP, OUTP, (bf16*)(ws + WS_XR3), nullptr, 1.f / 2048};
      pg8::gemm_phase<pg8::EpiResNorm<false>, pg8::StaticOrder, true, true, true>(ring, g, S, E, F.wave); }
    GRID_BAR();
    route_phase(F);
    GRID_BAR();
    slot_phase(F, ws);
    GRID_BAR();
#define MOE_LOAD(hf_) unsigned char* w2 = WSP; \
          const int nPA = __builtin_amdgcn_readfirstlane(((const GAS int*)(w2 + WS_META))[0]), nPB = __builtin_amdgcn_readfirstlane(((const GAS int*)(w2 + WS_META))[1]); (void)nPB; \
          const int p0 = (hf_) ? nPA : 0; int pbk[7]; \
          _Pragma("unroll") for (int k = 0; k < 7; ++k) pbk[k] = __builtin_amdgcn_readfirstlane(((const GAS int*)(w2 + WS_META))[2 + (hf_) * 8 + 1 + k]) - p0;
    constexpr size_t HMB_OFF = (size_t)MAXP_HALF * 256 * EFF;
    { MOE_LOAD(0)
      pg8::Gemm g{(const bf16*)(w2 + WS_XG), (const bf16*)(w2 + WS_WM1), nPA * 256, 2 * EFF, D / 2, D / 2};
      pg8::MoeOrder S; S.init(nPA, 2 * EFF / 256, F.G, bid);
#pragma unroll
      for (int k = 0; k < 7; ++k) S.pb[k] = pbk[k];
      pg8::EpiGatedF8 E{w2 + WS_HM, EFF, 2 * EFF / 256};
      pg8::gemm_phase<pg8::EpiGatedF8, pg8::MoeOrder, true, true, true>(ring, g, S, E, F.wave); }
    GRID_BAR();
    { MOE_LOAD(0)
      pg8::Gemm g{(const bf16*)(w2 + WS_HM), (const bf16*)(w2 + WS_WM2), 256 * 256, D, EFF / 2, EFF / 2};
      pg8::MoeOrder S; S.init(256, D / 256, F.G, bid);
#pragma unroll
      for (int k = 0; k < 7; ++k) S.pb[k] = pbk[k];
      pg8::EpiMoeDown E{OUTP, (const int*)(w2 + WS_SLOTTOK), (const float*)(w2 + WS_SLOTGATE), 0, D, 1.f / 64};
      pg8::gemm_phase<pg8::EpiMoeDown, pg8::MoeOrder, true, true, true>(ring, g, S, E, F.wave); }
    GRID_BAR();
    { MOE_LOAD(0)
      pg8::Gemm g{(const bf16*)(w2 + WS_HM), (const bf16*)(w2 + WS_WM2), nPA * 256, D, EFF / 2, EFF / 2};
      pg8::LeftOrder S; S.M.init(nPA, D / 256, F.G, bid); S.nLeft = 4 * (nPA - 256);
#pragma unroll
      for (int k = 0; k < 7; ++k) S.M.pb[k] = pbk[k];
      pg8::EpiMoeDown E{OUTP, (const int*)(w2 + WS_SLOTTOK), (const float*)(w2 + WS_SLOTGATE), 0, D, 1.f / 64};
      pg8::gemm_phase<pg8::EpiMoeDown, pg8::LeftOrder, true, true, true>(ring, g, S, E, F.wave); }
    { MOE_LOAD(1)
      pg8::Gemm g{(const bf16*)(w2 + WS_XG + (size_t)p0 * 256 * D), (const bf16*)(w2 + WS_WM1), nPB * 256, 2 * EFF, D / 2, D / 2};
      pg8::MoeOrder S; S.init(nPB, 2 * EFF / 256, F.G, bid); S.nBusy = 4 * (nPA - 256); S.SK = 4;
#pragma unroll
      for (int k = 0; k < 7; ++k) S.pb[k] = pbk[k];
      pg8::EpiGatedF8 E{w2 + WS_HM + HMB_OFF, EFF, 2 * EFF / 256};
      pg8::gemm_phase<pg8::EpiGatedF8, pg8::MoeOrder, true, true, true>(ring, g, S, E, F.wave); }
    GRID_BAR();
    { MOE_LOAD(1)
      pg8::Gemm g{(const bf16*)(w2 + WS_HM + HMB_OFF), (const bf16*)(w2 + WS_WM2), nPB * 256, D, EFF / 2, EFF / 2};
      pg8::MoeOrder S; S.init(nPB, D / 256, F.G, bid);
#pragma unroll
      for (int k = 0; k < 7; ++k) S.pb[k] = pbk[k];
      pg8::EpiMoeDown E{OUTP, (const int*)(w2 + WS_SLOTTOK), (const float*)(w2 + WS_SLOTGATE), p0 * 256, D, 1.f / 64};
      pg8::gemm_phase<pg8::EpiMoeDown, pg8::MoeOrder, true, true, true>(ring, g, S, E, F.wave); }
#undef MOE_LOAD
#undef GRID_BAR
#undef bid
#undef GEMM
}

extern "C" void kernel_launch(void* const* d_in, const int* in_sizes, int n_in, void* d_out, int out_size, void* d_ws, size_t ws_size, hipStream_t stream) {
    static int grid = 0;
    if (grid == 0) {
        if (n_in != 27 || in_sizes[0] != M * D || out_size != M * D || ws_size < WS_END) { fprintf(stderr, "kernel_launch: unexpected shapes (n_in %d, in0 %d, out %d, ws %zu < %zu); nothing launched\n", n_in, n_in > 0 ? in_sizes[0] : -1, out_size, ws_size, (size_t)WS_END); grid = -1; return; }
        int dev = 0, cus = 0, per_cu = 0;
        if (hipGetDevice(&dev) != hipSuccess || hipDeviceGetAttribute(&cus, hipDeviceAttributeMultiprocessorCount, dev) != hipSuccess) { grid = -1; return; }
        if (hipFuncSetAttribute((const void*)yoco_fwd, hipFuncAttributeMaxDynamicSharedMemorySize, LDS_BYTES) != hipSuccess) { fprintf(stderr, "kernel_launch: hipFuncSetAttribute failed\n"); grid = -1; return; }
        if (hipOccupancyMaxActiveBlocksPerMultiprocessor(&per_cu, (const void*)yoco_fwd, NWAVES * 64, LDS_BYTES) != hipSuccess || per_cu < 1) { fprintf(stderr, "kernel_launch: occupancy query says %d\n", per_cu); }
        (void)hipGetLastError();
        grid = cus;
    }
    if (grid < 0) return;
    if (hipMemsetAsync((char*)d_ws + WS_CTL, 0, CTL_ZERO_BYTES, stream) != hipSuccess) return;
    Args a{};
    for (int i = 0; i < 27; ++i) a.in[i] = (const float*)d_in[i];
    a.out = (float*)d_out; a.ws = (unsigned char*)d_ws;
    hipLaunchKernelGGL(yoco_fwd, dim3(grid), dim3(NWAVES * 64), LDS_BYTES, stream, a);
}
```

```cpp
#include <hip/hip_runtime.h>
#include <cstdio>
#include <cstdint>
__device__ __forceinline__ int lane_id_() { unsigned m_ = ~0u; asm volatile("" : "+s"(m_)); return (int)__builtin_amdgcn_mbcnt_hi(m_, __builtin_amdgcn_mbcnt_lo(m_, 0u)); }
template <int X> __device__ __forceinline__ float swz_xor(float v) { return __builtin_bit_cast(float, __builtin_amdgcn_ds_swizzle(__builtin_bit_cast(int, v), (X << 10) | 0x1f)); }
__device__ __forceinline__ void halves32(float v, float& r_lo, float& r_hi) { unsigned a_ = __builtin_bit_cast(unsigned, v), b_ = a_;
    asm volatile("s_nop 1\n\tv_permlane32_swap_b32 %0, %1\n\ts_nop 1" : "+v"(a_), "+v"(b_)); r_lo = __builtin_bit_cast(float, a_); r_hi = __builtin_bit_cast(float, b_); }
__device__ __forceinline__ float xor32_partner(float v, int upper_half) { float lo, hi; halves32(v, lo, hi); return upper_half ? lo : hi; }
__device__ __forceinline__ float xor32_sum(float v) { float lo, hi; halves32(v, lo, hi); return lo + hi; }
__device__ __forceinline__ float xor32_max(float v) { float lo, hi; halves32(v, lo, hi); return fmaxf(lo, hi); }
namespace pg8 {
#define PG8_LAS __attribute__((address_space(3)))
typedef unsigned short bf16_t;
typedef short bf16x8 __attribute__((ext_vector_type(8)));
typedef float f32x4 __attribute__((ext_vector_type(4)));
typedef unsigned u32x4 __attribute__((ext_vector_type(4)));
constexpr int BM = 256, BK = 64, HALF = 128, HTB = HALF * BK * 2  , STAGE_BYTES = 8 * HTB, NXCD = 8, WGM = 8;

__host__ __device__ __forceinline__ int lds_byte(int r, int c) { const int st = (r >> 4) * 2 + (c >> 5), rr = r & 15, cc = c & 31, ob = rr * 64 + cc * 2; return st * 1024 + (ob ^ (((ob >> 9) & 1) << 5)); }
__host__ __device__ __forceinline__ void stage_rc(int b, int& R, int& C) { const int st = b / 1024, sb = b % 1024, swz = sb ^ (((sb >> 9) & 1) << 5); R = (st >> 1) * 16 + swz / 64; C = (st & 1) * 32 + (swz % 64) / 2; }
__host__ __device__ __forceinline__ int perm32(int rho) { const int n = rho >> 4, i = rho & 15; return 8 * (i >> 2) + 4 * n + (i & 3); }

struct Unit { int pm, pn; };
struct Gemm { const bf16_t* A; const bf16_t* Bt; int M, N, K, lda; };

struct StaticOrder {
    int nM, nN, nwg, G, c;
    __host__ __device__ void init(int M, int N, int G_, int c_) { nM = M / BM; nN = N / BM; nwg = nM * nN; G = G_; c = c_; }
    __host__ __device__ bool next(int i, Unit& u) const {
        const int L = i * G + c; if (L >= nwg) return false;
        int wgid = L; { const int q = nwg / NXCD, r = nwg % NXCD, xcd = wgid % NXCD, off = wgid / NXCD; wgid = (xcd < r ? xcd * (q + 1) : r * (q + 1) + (xcd - r) * q) + off; }
        const int nig = WGM * nN, gid = wgid / nig, fm = gid * WGM, gsz = (nM - fm) < WGM ? (nM - fm) : WGM;
        u.pm = fm + ((wgid % nig) % gsz); u.pn = (wgid % nig) / gsz; return true;
    }
    __device__ __forceinline__ void a_ready(const Unit&) const {}
    __device__ __forceinline__ void done(const Unit&) const {}
};
__device__ __forceinline__ unsigned cvt_pk_bf16(float lo, float hi) { unsigned r; asm volatile("v_cvt_pk_bf16_f32 %0, %1, %2" : "=v"(r) : "v"(lo), "v"(hi)); return r; }
__device__ __forceinline__ float silu_f(float x) { const float e = __builtin_amdgcn_exp2f(x * -1.4426950408889634f); return x * __builtin_amdgcn_rcpf(1.f + e); }

__device__ __forceinline__ float sum4(const f32x4& a) { return (a[0] + a[1]) + (a[2] + a[3]); }
__device__ __forceinline__ float part_sum8(const float* p) { return sum4(*(const f32x4*)p) + sum4(*(const f32x4*)(p + 4)); }
__device__ __forceinline__ float part_sum16(const float* p) { return (sum4(*(const f32x4*)p) + sum4(*(const f32x4*)(p + 4))) + (sum4(*(const f32x4*)(p + 8)) + sum4(*(const f32x4*)(p + 12))); }
__device__ __forceinline__ float fq_sum(float v) { v += swz_xor<16>(v); return xor32_sum(v); }
__device__ __forceinline__ float sq8(const f32x4& a, const f32x4& b) { return ((a[0] * a[0] + a[1] * a[1]) + (a[2] * a[2] + a[3] * a[3])) + ((b[0] * b[0] + b[1] * b[1]) + (b[2] * b[2] + b[3] * b[3])); }
__device__ __forceinline__ u32x4 pack8(const f32x4& a, const f32x4& b) { u32x4 w; w.x = cvt_pk_bf16(a[0], a[1]); w.y = cvt_pk_bf16(a[2], a[3]); w.z = cvt_pk_bf16(b[0], b[1]); w.w = cvt_pk_bf16(b[2], b[3]); return w; }
constexpr float EPS_ = 1e-6f;
__device__ __forceinline__ unsigned pk_fp8x4(float a, float b, float c, float d) { int w = 0; w = __builtin_amdgcn_cvt_pk_fp8_f32(a, b, w, false); w = __builtin_amdgcn_cvt_pk_fp8_f32(c, d, w, true); return (unsigned)w; }

struct EpiQA {
    static constexpr bool PERM = true, AFTER_DRAIN = false;
    bf16_t* O; float* part; float wscale;
    __device__ __forceinline__ void operator()(const f32x4 (&acc)[2][2][4][2], const Unit& u, int wr, int wc, int fr, int fq) const {
        { int t_ = lane_id_(); asm volatile("" : "+v"(t_)); fr = t_ & 15; fq = (t_ >> 4) & 3; }
        const int row0 = u.pm * BM + wr * 64 + fr, col0 = u.pn * BM + wc * 32 + 8 * fq;
#pragma unroll
        for (int ai = 0; ai < 2; ++ai)
#pragma unroll
            for (int m = 0; m < 4; ++m) { const int row = row0 + ai * HALF + m * 16; bf16_t* rowp = O + (size_t)row * 768 + col0;
                const f32x4 a0 = acc[ai][0][m][0] * wscale, a1 = acc[ai][0][m][1] * wscale, b0 = acc[ai][1][m][0] * wscale, b1 = acc[ai][1][m][1] * wscale;
                *(u32x4*)(rowp) = pack8(a0, a1); *(u32x4*)(rowp + HALF) = pack8(b0, b1);
                const float s0 = sq8(a0, a1), s1 = sq8(b0, b1);
                float* pr = part + (size_t)row * 16;
                if (u.pn == 0) { const float t = fq_sum(s0 + s1); if (fq == 0) pr[wc] = t; }
                else if (u.pn == 1) { const float t0 = fq_sum(s0), t1 = fq_sum(s1); if (fq == 0) { pr[4 + wc] = t0; pr[8 + wc] = t1; } }
                else { const float t = fq_sum(s0); if (fq == 0) pr[12 + wc] = t; } }
    }
};

struct EpiRowScaleBf16 {
    static constexpr bool PERM = true, AFTER_DRAIN = false;
    bf16_t* O; int ldc; const float* part; float inv_n;
    __device__ __forceinline__ void operator()(const f32x4 (&acc)[2][2][4][2], const Unit& u, int wr, int wc, int fr, int fq) const {
        { int t_ = lane_id_(); asm volatile("" : "+v"(t_)); fr = t_ & 15; fq = (t_ >> 4) & 3; }
        const int row0 = u.pm * BM + wr * 64 + fr, col0 = u.pn * BM + wc * 32 + 8 * fq;
#pragma unroll
        for (int ai = 0; ai < 2; ++ai)
#pragma unroll
            for (int m = 0; m < 4; ++m) { const int row = row0 + ai * HALF + m * 16; bf16_t* rowp = O + (size_t)row * ldc + col0;
                const float rs = __builtin_amdgcn_rsqf(part_sum8(part + (size_t)row * 16) * inv_n + EPS_);
                *(u32x4*)(rowp) = pack8(acc[ai][0][m][0] * rs, acc[ai][0][m][1] * rs); *(u32x4*)(rowp + HALF) = pack8(acc[ai][1][m][0] * rs, acc[ai][1][m][1] * rs); }
    }
};

struct EpiKVup {
    static constexpr bool PERM = true, AFTER_DRAIN = false;
    bf16_t* Kd; bf16_t* Vd; const float* part; const bf16_t* QA; const float* g_kn; const float* rope;
    __device__ __forceinline__ void operator()(const f32x4 (&acc)[2][2][4][2], const Unit& u, int wr, int wc, int fr, int fq) const {
        { int t_ = lane_id_(); asm volatile("" : "+v"(t_)); fr = t_ & 15; fq = (t_ >> 4) & 3; }
        const int row0 = u.pm * BM + wr * 64 + fr;
        if (u.pn >= 4) {
            const int col0 = (u.pn - 4) * BM + wc * 32 + 8 * fq;
#pragma unroll
            for (int ai = 0; ai < 2; ++ai)
#pragma unroll
                for (int m = 0; m < 4; ++m) { const int row = row0 + ai * HALF + m * 16; bf16_t* rowp = Vd + (size_t)row * 1024 + col0;
                    const float rs = __builtin_amdgcn_rsqf(part_sum8(part + (size_t)row * 16 + 8) * (1.f / 256) + EPS_);
                    *(u32x4*)(rowp) = pack8(acc[ai][0][m][0] * rs, acc[ai][0][m][1] * rs); *(u32x4*)(rowp + HALF) = pack8(acc[ai][1][m][0] * rs, acc[ai][1][m][1] * rs); }
            return;
        }
        const int head = 4 * u.pn + wc;
        f32x4 gA0 = *(const f32x4*)(g_kn + 8 * fq), gA1 = *(const f32x4*)(g_kn + 8 * fq + 4), gB0 = *(const f32x4*)(g_kn + 32 + 8 * fq), gB1 = *(const f32x4*)(g_kn + 32 + 8 * fq + 4);
        const f32x4 gR1 = *(const f32x4*)(g_kn + 64 + 4 * fq), gR2 = *(const f32x4*)(g_kn + 80 + 4 * fq);
#pragma unroll
        for (int ai = 0; ai < 2; ++ai)
#pragma unroll
            for (int m = 0; m < 4; ++m) { const int row = row0 + ai * HALF + m * 16;
                const float rs = __builtin_amdgcn_rsqf(part_sum8(part + (size_t)row * 16 + 8) * (1.f / 256) + EPS_);
                f32x4 a0 = acc[ai][0][m][0] * rs, a1 = acc[ai][0][m][1] * rs, b0 = acc[ai][1][m][0] * rs, b1 = acc[ai][1][m][1] * rs;
                const unsigned long long p1 = *(const unsigned long long*)(QA + (size_t)row * 768 + 640 + 4 * fq), p2 = *(const unsigned long long*)(QA + (size_t)row * 768 + 656 + 4 * fq);
                f32x4 x1, x2;
                x1[0] = __builtin_bit_cast(float, (unsigned)(p1 << 16)); x1[1] = __builtin_bit_cast(float, (unsigned)p1 & 0xffff0000u);
                x1[2] = __builtin_bit_cast(float, (unsigned)(p1 >> 32) << 16); x1[3] = __builtin_bit_cast(float, (unsigned)(p1 >> 32) & 0xffff0000u);
                x2[0] = __builtin_bit_cast(float, (unsigned)(p2 << 16)); x2[1] = __builtin_bit_cast(float, (unsigned)p2 & 0xffff0000u);
                x2[2] = __builtin_bit_cast(float, (unsigned)(p2 >> 32) << 16); x2[3] = __builtin_bit_cast(float, (unsigned)(p2 >> 32) & 0xffff0000u);
                const float ss = fq_sum(sq8(a0, a1) + sq8(b0, b1) + sq8(x1, x2));
                const float sh = __builtin_amdgcn_rsqf(ss * (1.f / 96) + EPS_);
                bf16_t* kp = Kd + (size_t)row * 1536 + head * 96;
                *(u32x4*)(kp + 8 * fq) = pack8(a0 * gA0 * sh, a1 * gA1 * sh); *(u32x4*)(kp + 32 + 8 * fq) = pack8(b0 * gB0 * sh, b1 * gB1 * sh);
                const f32x4* rp = (const f32x4*)(rope + ((size_t)(row & 2047) * 16 + 4 * fq) * 2);
                const f32x4 c01 = rp[0], c23 = rp[1];
                const f32x4 y1 = x1 * gR1 * sh, y2 = x2 * gR2 * sh;
                f32x4 o1, o2;
                o1[0] = y1[0] * c01[0] - y2[0] * c01[1]; o2[0] = y2[0] * c01[0] + y1[0] * c01[1];
                o1[1] = y1[1] * c01[2] - y2[1] * c01[3]; o2[1] = y2[1] * c01[2] + y1[1] * c01[3];
                o1[2] = y1[2] * c23[0] - y2[2] * c23[1]; o2[2] = y2[2] * c23[0] + y1[2] * c23[1];
                o1[3] = y1[3] * c23[2] - y2[3] * c23[3]; o2[3] = y2[3] * c23[2] + y1[3] * c23[3];
                unsigned long long w1 = (unsigned long long)cvt_pk_bf16(o1[0], o1[1]) | ((unsigned long long)cvt_pk_bf16(o1[2], o1[3]) << 32);
                unsigned long long w2 = (unsigned long long)cvt_pk_bf16(o2[0], o2[1]) | ((unsigned long long)cvt_pk_bf16(o2[2], o2[3]) << 32);
                *(unsigned long long*)(kp + 64 + 4 * fq) = w1; *(unsigned long long*)(kp + 80 + 4 * fq) = w2; }
    }
};

struct EpiK2Q2 {
    static constexpr bool PERM = true, AFTER_DRAIN = false;
    bf16_t* O; const float* pss; const float* gk; const float* gq; float wscale;
    __device__ __forceinline__ void operator()(const f32x4 (&acc)[2][2][4][2], const Unit& u, int wr, int wc, int fr, int fq) const {
        { int t_ = lane_id_(); asm volatile("" : "+v"(t_)); fr = t_ & 15; fq = (t_ >> 4) & 3; }
        const int row0 = u.pm * BM + wr * 64 + fr, isq = u.pn >> 2, tl = u.pn & 3;
        const float* g = isq ? gq : gk; const float post = isq ? 0.125f * 1.4426950408889634f : 1.f;
        const f32x4 gA0 = *(const f32x4*)(g + 8 * fq) * post, gA1 = *(const f32x4*)(g + 8 * fq + 4) * post, gB0 = *(const f32x4*)(g + 32 + 8 * fq) * post, gB1 = *(const f32x4*)(g + 32 + 8 * fq + 4) * post;
        const int colh = isq * 2048 + (4 * tl + wc) * 64;
        unsigned zhi_ = 0u; asm volatile("" : "+v"(zhi_));
        const unsigned long long coff = ((unsigned long long)zhi_ << 32) | (unsigned)((colh + 8 * fq) * 2);
#pragma unroll
        for (int ai = 0; ai < 2; ++ai)
#pragma unroll
            for (int m = 0; m < 4; ++m) { const int row = row0 + ai * HALF + m * 16; unsigned char* rowp = (unsigned char*)O + (size_t)row * 6144 + coff;
                const float rs = __builtin_amdgcn_rsqf(part_sum16(pss + (size_t)row * 16) * (1.f / 1024) + EPS_) * wscale;
                const f32x4 a0 = acc[ai][0][m][0] * rs, a1 = acc[ai][0][m][1] * rs, b0 = acc[ai][1][m][0] * rs, b1 = acc[ai][1][m][1] * rs;
                const float ss = fq_sum(sq8(a0, a1) + sq8(b0, b1));
                const float sh = __builtin_amdgcn_rsqf(ss * (1.f / 64) + EPS_);
                *(u32x4*)(rowp) = pack8(a0 * gA0 * sh, a1 * gA1 * sh); *(u32x4*)(rowp + 64) = pack8(b0 * gB0 * sh, b1 * gB1 * sh); }
    }
};
struct EpiRowScale16 {
    static constexpr bool PERM = true, AFTER_DRAIN = false;
    bf16_t* O; int ldc; int coff; const float* pss; float wscale;
    __device__ __forceinline__ void operator()(const f32x4 (&acc)[2][2][4][2], const Unit& u, int wr, int wc, int fr, int fq) const {
        { int t_ = lane_id_(); asm volatile("" : "+v"(t_)); fr = t_ & 15; fq = (t_ >> 4) & 3; }
        const int row0 = u.pm * BM + wr * 64 + fr, col0 = coff + u.pn * BM + wc * 32 + 8 * fq;
#pragma unroll
        for (int ai = 0; ai < 2; ++ai)
#pragma unroll
            for (int m = 0; m < 4; ++m) { const int row = row0 + ai * HALF + m * 16; bf16_t* rowp = O + (size_t)row * ldc + col0;
                const float rs = __builtin_amdgcn_rsqf(part_sum16(pss + (size_t)row * 16) * (1.f / 1024) + EPS_) * wscale;
                *(u32x4*)(rowp) = pack8(acc[ai][0][m][0] * rs, acc[ai][0][m][1] * rs); *(u32x4*)(rowp + HALF) = pack8(acc[ai][1][m][0] * rs, acc[ai][1][m][1] * rs); }
    }
};

template <bool SSQ> struct EpiGated {
    static constexpr bool PERM = true, AFTER_DRAIN = false;
    bf16_t* Hd; int ldc; int ntile; const float* rs;
    __device__ __forceinline__ void operator()(const f32x4 (&acc)[2][2][4][2], const Unit& u, int wr, int wc, int fr, int fq) const {
        { int t_ = lane_id_(); asm volatile("" : "+v"(t_)); fr = t_ & 15; fq = (t_ >> 4) & 3; }
        const int pnl = ntile ? (u.pn % ntile) : u.pn;
        const int row0 = u.pm * BM + wr * 64 + fr, col0 = pnl * HALF + wc * 32 + 8 * fq;
#pragma unroll
        for (int ai = 0; ai < 2; ++ai)
#pragma unroll
            for (int m = 0; m < 4; ++m) { const int row = row0 + ai * HALF + m * 16; bf16_t* rowp = Hd + (size_t)row * ldc + col0;
                const float r = SSQ ? __builtin_amdgcn_rsqf(part_sum16(rs + (size_t)row * 16) * (1.f / 1024) + EPS_) : rs[row];
                const f32x4 g0 = acc[ai][0][m][0] * r, g1 = acc[ai][0][m][1] * r, u0 = acc[ai][1][m][0] * r, u1 = acc[ai][1][m][1] * r;
                u32x4 w;
                w.x = cvt_pk_bf16(silu_f(g0[0]) * u0[0], silu_f(g0[1]) * u0[1]); w.y = cvt_pk_bf16(silu_f(g0[2]) * u0[2], silu_f(g0[3]) * u0[3]);
                w.z = cvt_pk_bf16(silu_f(g1[0]) * u1[0], silu_f(g1[1]) * u1[1]); w.w = cvt_pk_bf16(silu_f(g1[2]) * u1[2], silu_f(g1[3]) * u1[3]);
                *(u32x4*)rowp = w; }
    }
};

struct EpiGatedF8 {
    static constexpr bool PERM = true, AFTER_DRAIN = false;
    unsigned char* Hd; int ldc; int ntile;
    static __device__ __forceinline__ float gate(float g, float u) {
        const float e = __builtin_amdgcn_exp2f(g * (-1.4426950408889634f / 64.f)); return (g * u) * (__builtin_amdgcn_rcpf(1.f + e) * (1.f / 4096.f)); }
    __device__ __forceinline__ void operator()(const f32x4 (&acc)[2][2][4][2], const Unit& u, int wr, int wc, int fr, int fq) const {
        { int t_ = lane_id_(); asm volatile("" : "+v"(t_)); fr = t_ & 15; fq = (t_ >> 4) & 3; }
        const int pnl = u.pn % ntile;
        const int row0 = u.pm * BM + wr * 64 + fr, col0 = pnl * HALF + wc * 32 + 8 * fq;
#pragma unroll
        for (int ai = 0; ai < 2; ++ai)
#pragma unroll
            for (int m = 0; m < 4; ++m) { const int row = row0 + ai * HALF + m * 16; unsigned char* rowp = Hd + (size_t)row * ldc + col0;
                const f32x4 g0 = acc[ai][0][m][0], g1 = acc[ai][0][m][1], u0 = acc[ai][1][m][0], u1 = acc[ai][1][m][1];
                unsigned long long w = (unsigned long long)pk_fp8x4(gate(g0[0], u0[0]), gate(g0[1], u0[1]), gate(g0[2], u0[2]), gate(g0[3], u0[3]))
                                     | ((unsigned long long)pk_fp8x4(gate(g1[0], u1[0]), gate(g1[1], u1[1]), gate(g1[2], u1[2]), gate(g1[3], u1[3])) << 32);
                *(unsigned long long*)rowp = w; }
    }
};

template <bool SSQ, bool XF8, bool RES16, bool F32OUT = false> struct EpiResStream {
    static constexpr bool PERM = true, AFTER_DRAIN = false;
    const void* res; bf16_t* XB; unsigned char* X8; float* ssq; float ascale; float* fout;
    __device__ __forceinline__ void operator()(const f32x4 (&acc)[2][2][4][2], const Unit& u, int wr, int wc, int fr, int fq) const {
        { int t_ = lane_id_(); asm volatile("" : "+v"(t_)); fr = t_ & 15; fq = (t_ >> 4) & 3; }
        const int row0 = u.pm * BM + wr * 64 + fr, col0 = u.pn * BM + wc * 32 + 8 * fq;
        f32x4 rw[4][2][2];
#define ERS_ROW(it) (row0 + ((it) >> 2) * HALF + ((it) & 3) * 16)
#define ERS_LOAD(it) do { const size_t ro_ = (size_t)ERS_ROW(it) * 1024 + col0; _Pragma("unroll") for (int bj = 0; bj < 2; ++bj) { \
            if constexpr (RES16) rw[(it) & 3][bj][0] = __builtin_bit_cast(f32x4, *(const u32x4*)((const bf16_t*)res + ro_ + bj * HALF)); \
            else { _Pragma("unroll") for (int n = 0; n < 2; ++n) rw[(it) & 3][bj][n] = *(const f32x4*)((const float*)res + ro_ + bj * HALF + n * 4); } } } while (0)
        ERS_LOAD(0); ERS_LOAD(1); ERS_LOAD(2); ERS_LOAD(3);
#pragma unroll
        for (int it = 0; it < 8; ++it) { const int ai = it >> 2, m = it & 3; const int row = ERS_ROW(it); const size_t ro = (size_t)row * 1024 + col0;
                f32x4 r[2][2];
#pragma unroll
                for (int bj = 0; bj < 2; ++bj) {
                    if constexpr (RES16) { const u32x4 w = __builtin_bit_cast(u32x4, rw[it & 3][bj][0]);
                        r[bj][0] = (f32x4){__builtin_bit_cast(float, w.x << 16), __builtin_bit_cast(float, w.x & 0xffff0000u), __builtin_bit_cast(float, w.y << 16), __builtin_bit_cast(float, w.y & 0xffff0000u)};
                        r[bj][1] = (f32x4){__builtin_bit_cast(float, w.z << 16), __builtin_bit_cast(float, w.z & 0xffff0000u), __builtin_bit_cast(float, w.w << 16), __builtin_bit_cast(float, w.w & 0xffff0000u)}; }
                    else { r[bj][0] = rw[it & 3][bj][0]; r[bj][1] = rw[it & 3][bj][1]; }
                    r[bj][0] = r[bj][0] + acc[ai][bj][m][0] * ascale; r[bj][1] = r[bj][1] + acc[ai][bj][m][1] * ascale; }
                if (it + 4 < 8) ERS_LOAD(it + 4);
                *(u32x4*)(XB + ro) = pack8(r[0][0], r[0][1]); *(u32x4*)(XB + ro + HALF) = pack8(r[1][0], r[1][1]);
                if constexpr (F32OUT) { _Pragma("unroll") for (int bj = 0; bj < 2; ++bj) _Pragma("unroll") for (int n = 0; n < 2; ++n) *(f32x4*)(fout + ro + bj * HALF + n * 4) = r[bj][n]; }
                if constexpr (XF8) { unsigned char* x8 = X8 + ro;
                    *(unsigned long long*)(x8) = (unsigned long long)pk_fp8x4(r[0][0][0], r[0][0][1], r[0][0][2], r[0][0][3]) | ((unsigned long long)pk_fp8x4(r[0][1][0], r[0][1][1], r[0][1][2], r[0][1][3]) << 32);
                    *(unsigned long long*)(x8 + HALF) = (unsigned long long)pk_fp8x4(r[1][0][0], r[1][0][1], r[1][0][2], r[1][0][3]) | ((unsigned long long)pk_fp8x4(r[1][1][0], r[1][1][1], r[1][1][2], r[1][1][3]) << 32); }
                if (SSQ) { const float t = fq_sum(sq8(r[0][0], r[0][1]) + sq8(r[1][0], r[1][1])); if (fq == 0) ssq[(size_t)row * 16 + u.pn * 4 + wc] = t; } }
#undef ERS_LOAD
#undef ERS_ROW
    }
};

template <bool FIRST> struct EpiMoeDown {
    static constexpr bool PERM = false, AFTER_DRAIN = false;
    float* out; const bf16_t* xb; const int* slot_tok; const float* slot_gate; int slot_base; int ldc; float wscale;
    __device__ __forceinline__ void operator()(const f32x4 (&acc)[2][2][4][2], const Unit& u, int wr, int wc, int fr, int fq) const {
        { int t_ = lane_id_(); asm volatile("" : "+v"(t_)); fr = t_ & 15; fq = (t_ >> 4) & 3; }
        const int pnl = u.pn & 3;
        const int row0 = slot_base + u.pm * BM + wr * 64 + fr, col0 = pnl * BM + wc * 32 + 4 * fq;
        int tk[8]; float gt[8];
#pragma unroll
        for (int it = 0; it < 8; ++it) { const int slot = row0 + (it >> 2) * HALF + (it & 3) * 16; tk[it] = slot_tok[slot]; gt[it] = slot_gate[slot] * wscale; }
        f32x4 rw[4][2][2];
#define EMD_LOAD(it) do { if (tk[it] >= 0) { _Pragma("unroll") for (int bj = 0; bj < 2; ++bj) _Pragma("unroll") for (int n = 0; n < 2; ++n) { \
            if constexpr (FIRST) { const unsigned long long q_ = *(const unsigned long long*)(xb + (size_t)tk[it] * ldc + col0 + bj * HALF + n * 16); \
                rw[(it) & 3][bj][n][0] = __builtin_bit_cast(float, (unsigned)q_); rw[(it) & 3][bj][n][1] = __builtin_bit_cast(float, (unsigned)(q_ >> 32)); } \
            else rw[(it) & 3][bj][n] = *(const f32x4*)(out + (size_t)tk[it] * ldc + col0 + bj * HALF + n * 16); } } } while (0)
        EMD_LOAD(0); EMD_LOAD(1); EMD_LOAD(2); EMD_LOAD(3);
#pragma unroll
        for (int it = 0; it < 8; ++it) { const int ai = it >> 2, m = it & 3;
            if (tk[it] >= 0) { float* rowp = out + (size_t)tk[it] * ldc + col0;
#pragma unroll
                for (int bj = 0; bj < 2; ++bj)
#pragma unroll
                    for (int n = 0; n < 2; ++n) { f32x4 r;
                        if constexpr (FIRST) { const unsigned lo = __builtin_bit_cast(unsigned, rw[it & 3][bj][n][0]), hi = __builtin_bit_cast(unsigned, rw[it & 3][bj][n][1]);
                            r = (f32x4){__builtin_bit_cast(float, lo << 16), __builtin_bit_cast(float, lo & 0xffff0000u), __builtin_bit_cast(float, hi << 16), __builtin_bit_cast(float, hi & 0xffff0000u)}; }
                        else r = rw[it & 3][bj][n];
                        *(f32x4*)(rowp + bj * HALF + n * 16) = r + acc[ai][bj][m][n] * gt[it]; } }
            if (it + 4 < 8) EMD_LOAD(it + 4); }
#undef EMD_LOAD
    }
};

struct MoeOrder {
    int nM, nN, nwg, G, c; int pb[7];
    int nBusy, SK;
    __device__ void init(int nPanels, int nN_, int G_, int c_) { nM = nPanels; nN = nN_; nwg = nM * nN; G = G_; c = c_; nBusy = 0; SK = 0; }
    __device__ __forceinline__ int expert_of(int pm) const { int e = 0;
#pragma unroll
        for (int k = 0; k < 7; ++k) e += (pm >= pb[k]) ? 1 : 0;
        return e; }
    __device__ bool next(int i, Unit& u) const {
        int L;
        if (nBusy == 0) L = i * G + c;
        else if (c >= nBusy) L = (i < SK) ? i * (G - nBusy) + (c - nBusy) : SK * (G - nBusy) + (i - SK) * G + c;
        else L = SK * (G - nBusy) + i * G + c;
        if (L >= nwg) return false;
        int wgid = L; { const int q = nwg / NXCD, r = nwg % NXCD, xcd = wgid % NXCD, off = wgid / NXCD; wgid = (xcd < r ? xcd * (q + 1) : r * (q + 1) + (xcd - r) * q) + off; }
        const int nig = WGM * nN, gid = wgid / nig, fm = gid * WGM, gsz = (nM - fm) < WGM ? (nM - fm) : WGM;
        u.pm = fm + ((wgid % nig) % gsz); const int pnl = (wgid % nig) / gsz;
        u.pn = expert_of(u.pm) * nN + pnl; return true;
    }
    __device__ __forceinline__ void a_ready(const Unit&) const {}
    __device__ __forceinline__ void done(const Unit&) const {}
};
struct LeftOrder {
    MoeOrder M; int nLeft;
    __device__ bool next(int i, Unit& u) const { if (i != 0 || M.c >= nLeft) return false; u.pm = 256 + (M.c >> 2); u.pn = M.expert_of(u.pm) * 4 + (M.c & 3); return true; }
    __device__ __forceinline__ void a_ready(const Unit&) const {}
    __device__ __forceinline__ void done(const Unit&) const {}
};
template <class Epi, class Sched, bool ALIGN_EPI = false, bool SP2 = false, bool F8 = false>
__device__ __forceinline__ void gemm_phase(PG8_LAS unsigned char* lds, const Gemm g, const Sched& S, const Epi& E, const int wave_idx) {
    int tid_ = wave_idx * 64 + lane_id_(); asm volatile("" : "+v"(tid_));
    const int tid = tid_, wid = __builtin_amdgcn_readfirstlane(tid >> 6), lane = tid & 63, wr = wid >> 2, wc = wid & 3, fr = lane & 15, fq = lane >> 4;
    const int K = g.K, nt = K / BK;
    unsigned voffA0, voffB0;
    { int R, C; stage_rc(tid * 16, R, C); const int Rb = Epi::PERM ? ((R & ~31) + perm32(R & 31)) : R;
      voffA0 = (unsigned)(R * g.lda + C) * 2u; voffB0 = (unsigned)(Rb * K + C) * 2u; }
    const size_t voffAR = (size_t)64 * g.lda * 2, voffBR = (size_t)64 * K * 2;
    const size_t kstep = (size_t)(BK * 2);
    const size_t hstepA = (size_t)HALF * g.lda * 2, hstepB = (size_t)HALF * K * 2;
    const size_t tstepA = 2 * hstepA, tstepB = 2 * hstepB;
    const unsigned lds0_ = (unsigned)(__UINTPTR_TYPE__)lds;
    const unsigned ldsw = (unsigned)wid * 1024u;
    const int aoff = lds_byte(wr * 64 + fr, fq * 8), boff = lds_byte(wc * 32 + fr, fq * 8);
#define PG8_SA(b, h) (((b) * 2 + (h)) * HTB)
#define PG8_SB(b, h) ((4 + (b) * 2 + (h)) * HTB)
#define PG8_STAGE(bufoff, gbase, voff) do { _Pragma("unroll") for (int _i = 0; _i < 2; ++_i) { unsigned keep_; const char* sb_ = (const char*)(gbase) + (size_t)_i * voff##R; \
        asm volatile("s_mov_b32 %0, m0\n\ts_mov_b32 m0, %3\n\ts_nop 0\n\tglobal_load_lds_dwordx4 %1, %2\n\ts_mov_b32 m0, %0" \
            : "=&s"(keep_) : "v"(voff##0), "s"(sb_), "s"(lds0_ + (unsigned)((bufoff) + _i * 8192) + ldsw) : "memory"); } } while (0)
#define PG8_LDA(dst, b, h) do { _Pragma("unroll") for (int m = 0; m < 4; ++m) _Pragma("unroll") for (int k = 0; k < 2; ++k) dst[m][k] = *(const PG8_LAS bf16x8*)(lds + PG8_SA(b, h) + aoff + m * 2048 + k * 1024); } while (0)
#define PG8_LDB(dst, b, h) do { _Pragma("unroll") for (int n = 0; n < 2; ++n) _Pragma("unroll") for (int k = 0; k < 2; ++k) dst[n][k] = *(const PG8_LAS bf16x8*)(lds + PG8_SB(b, h) + boff + n * 2048 + k * 1024); } while (0)
#define PG8_MMA(ai, bj, At, Bt) do { __builtin_amdgcn_s_setprio(1); _Pragma("unroll") for (int m = 0; m < 4; ++m) _Pragma("unroll") for (int n = 0; n < 2; ++n) { \
        if constexpr (F8) { typedef int v8i_ __attribute__((ext_vector_type(8))); typedef int v4i_ __attribute__((ext_vector_type(4))); \
            const v4i_ b0_ = __builtin_bit_cast(v4i_, Bt[n][0]), b1_ = __builtin_bit_cast(v4i_, Bt[n][1]), a0_ = __builtin_bit_cast(v4i_, At[m][0]), a1_ = __builtin_bit_cast(v4i_, At[m][1]); \
            const v8i_ bb_ = __builtin_shufflevector(b0_, b1_, 0, 1, 2, 3, 4, 5, 6, 7), aa_ = __builtin_shufflevector(a0_, a1_, 0, 1, 2, 3, 4, 5, 6, 7); \
            acc[ai][bj][m][n] = __builtin_amdgcn_mfma_scale_f32_16x16x128_f8f6f4(bb_, aa_, acc[ai][bj][m][n], 0, 0, 0, 0, 0, 0); } \
        else { _Pragma("unroll") for (int k = 0; k < 2; ++k) acc[ai][bj][m][n] = __builtin_amdgcn_mfma_f32_16x16x32_bf16(Bt[n][k], At[m][k], acc[ai][bj][m][n], 0, 0, 0); } } \
        __builtin_amdgcn_s_setprio(0); } while (0)
#define PG8_WAIT_V(n) asm volatile("s_waitcnt vmcnt(" #n ")" ::: "memory")
#define PG8_WAIT_L(n) asm volatile("s_waitcnt lgkmcnt(" #n ")" ::: "memory")
#define PG8_BAR __builtin_amdgcn_s_barrier()
#define PG8_SCHED __builtin_amdgcn_sched_barrier(0)
    Unit cur, nxt; int ui = 0;
    if (!S.next(0, cur)) return;
    f32x4 acc[2][2][4][2];
#pragma unroll
    for (int a = 0; a < 2; ++a)
#pragma unroll
        for (int b = 0; b < 2; ++b)
#pragma unroll
            for (int m = 0; m < 4; ++m)
#pragma unroll
                for (int n = 0; n < 2; ++n) acc[a][b][m][n] = (f32x4){0.f, 0.f, 0.f, 0.f};
    bf16x8 At[4][2], B0[2][2], B1[2][2];
    const char* cA = (const char*)g.A + (size_t)cur.pm * tstepA; const char* cB = (const char*)g.Bt + (size_t)cur.pn * tstepB;
    S.a_ready(cur);
    if constexpr (SP2) {
        PG8_STAGE(PG8_SB(0, 0), cB, voffB); PG8_STAGE(PG8_SB(0, 1), cB + hstepB, voffB); PG8_STAGE(PG8_SA(0, 0), cA, voffA); PG8_STAGE(PG8_SA(0, 1), cA + hstepA, voffA);
        if (wr == 1) PG8_BAR;
        PG8_WAIT_V(2); PG8_BAR;
        PG8_STAGE(PG8_SB(1, 0), cB + kstep, voffB); PG8_STAGE(PG8_SA(1, 0), cA + kstep, voffA); PG8_STAGE(PG8_SB(1, 1), cB + hstepB + kstep, voffB);
        PG8_WAIT_V(6); PG8_BAR;
    } else {
        PG8_STAGE(PG8_SB(0, 0), cB, voffB); PG8_STAGE(PG8_SA(0, 0), cA, voffA); PG8_STAGE(PG8_SB(0, 1), cB + hstepB, voffB); PG8_STAGE(PG8_SA(0, 1), cA + hstepA, voffA);
        if (wr == 1) PG8_BAR;
        PG8_WAIT_V(4); PG8_BAR;
        PG8_STAGE(PG8_SB(1, 0), cB + kstep, voffB); PG8_STAGE(PG8_SA(1, 0), cA + kstep, voffA); PG8_STAGE(PG8_SB(1, 1), cB + hstepB + kstep, voffB);
        PG8_WAIT_V(6); PG8_BAR;
    }
    for (;;) {
        const bool has_next = S.next(ui + 1, nxt);
        const char* nA = has_next ? (const char*)g.A + (size_t)nxt.pm * tstepA : cA; const char* nB = has_next ? (const char*)g.Bt + (size_t)nxt.pn * tstepB : cB;
#pragma unroll 1
        for (int t = 0; t < nt; t += 2) {
            const bool last = (t == nt - 2);
            const char* a1 = cA + (size_t)(t + 1) * kstep;
            const char* a2 = last ? nA : cA + (size_t)(t + 2) * kstep; const char* b2 = last ? nB : cB + (size_t)(t + 2) * kstep;
            const char* a3 = a2 + kstep; const char* b3 = b2 + kstep;
            if (last && has_next) S.a_ready(nxt);
            if constexpr (SP2) {
            PG8_LDB(B0, 0, 0); PG8_LDB(B1, 0, 1); PG8_SCHED; PG8_LDA(At, 0, 0); PG8_STAGE(PG8_SA(1, 1), a1 + hstepA, voffA);
            PG8_WAIT_V(8); PG8_WAIT_L(0); PG8_BAR; PG8_MMA(0, 0, At, B0); PG8_MMA(0, 1, At, B1); PG8_BAR; PG8_SCHED;
            PG8_LDA(At, 0, 1); PG8_STAGE(PG8_SB(0, 0), b2, voffB); PG8_STAGE(PG8_SB(0, 1), b2 + hstepB, voffB); PG8_STAGE(PG8_SA(0, 0), a2, voffA);
            PG8_WAIT_V(8); PG8_WAIT_L(0); PG8_BAR; PG8_MMA(1, 0, At, B0); PG8_MMA(1, 1, At, B1); PG8_BAR; PG8_SCHED;
            PG8_LDB(B0, 1, 0); PG8_LDB(B1, 1, 1); PG8_SCHED; PG8_LDA(At, 1, 0); PG8_STAGE(PG8_SA(0, 1), a2 + hstepA, voffA);
            PG8_WAIT_V(8); PG8_WAIT_L(0); PG8_BAR; PG8_MMA(0, 0, At, B0); PG8_MMA(0, 1, At, B1); PG8_BAR; PG8_SCHED;
            PG8_LDA(At, 1, 1); PG8_STAGE(PG8_SB(1, 0), b3, voffB); PG8_STAGE(PG8_SB(1, 1), b3 + hstepB, voffB); PG8_STAGE(PG8_SA(1, 0), a3, voffA);
            PG8_WAIT_V(8); PG8_WAIT_L(0); PG8_BAR; PG8_MMA(1, 0, At, B0); PG8_MMA(1, 1, At, B1); PG8_BAR; PG8_SCHED;
            } else {
            PG8_LDB(B0, 0, 0); PG8_SCHED; PG8_LDA(At, 0, 0); PG8_STAGE(PG8_SA(1, 1), a1 + hstepA, voffA);
            PG8_WAIT_L(8); PG8_BAR; PG8_WAIT_L(0); PG8_MMA(0, 0, At, B0); PG8_BAR; PG8_SCHED;
            PG8_LDB(B1, 0, 1); PG8_STAGE(PG8_SB(0, 0), b2, voffB);
            PG8_BAR; PG8_WAIT_L(0); PG8_MMA(0, 1, At, B1); PG8_BAR;
            PG8_LDA(At, 0, 1); PG8_STAGE(PG8_SA(0, 0), a2, voffA);
            PG8_BAR; PG8_WAIT_L(0); PG8_MMA(1, 0, At, B0); PG8_BAR; PG8_SCHED;
            PG8_STAGE(PG8_SB(0, 1), b2 + hstepB, voffB);
            PG8_WAIT_V(6); PG8_BAR; PG8_MMA(1, 1, At, B1); PG8_BAR;
            PG8_LDB(B0, 1, 0); PG8_SCHED; PG8_LDA(At, 1, 0); PG8_STAGE(PG8_SA(0, 1), a2 + hstepA, voffA);
            PG8_WAIT_L(8); PG8_BAR; PG8_WAIT_L(0); PG8_MMA(0, 0, At, B0); PG8_BAR; PG8_SCHED;
            PG8_LDB(B1, 1, 1); PG8_STAGE(PG8_SB(1, 0), b3, voffB);
            PG8_BAR; PG8_WAIT_L(0); PG8_MMA(0, 1, At, B1); PG8_BAR;
            PG8_LDA(At, 1, 1); PG8_STAGE(PG8_SA(1, 0), a3, voffA);
            PG8_BAR; PG8_WAIT_L(0); PG8_MMA(1, 0, At, B0); PG8_BAR; PG8_SCHED;
            PG8_STAGE(PG8_SB(1, 1), b3 + hstepB, voffB);
            PG8_WAIT_V(6); PG8_BAR; PG8_MMA(1, 1, At, B1); PG8_BAR;
            }
        }
        if constexpr (ALIGN_EPI) { if (wr == 0) PG8_BAR; }
        if constexpr (!Epi::AFTER_DRAIN) { E(acc, cur, wr, wc, fr, fq); S.done(cur); }
        if (!has_next) break;
#pragma unroll
        for (int a = 0; a < 2; ++a)
#pragma unroll
            for (int b = 0; b < 2; ++b)
#pragma unroll
                for (int m = 0; m < 4; ++m)
#pragma unroll
                    for (int n = 0; n < 2; ++n) acc[a][b][m][n] = (f32x4){0.f, 0.f, 0.f, 0.f};
        cur = nxt; cA = nA; cB = nB; ++ui;
        if constexpr (ALIGN_EPI) { if (wr == 1) PG8_BAR; }
    }
    PG8_WAIT_V(0);
    if constexpr (!ALIGN_EPI) { if (wr == 0) PG8_BAR; }
    PG8_BAR;
    if constexpr (Epi::AFTER_DRAIN) { E.fused(acc, cur, wr, wc, fr, fq, lds, wid, lane); S.done(cur); }
#undef PG8_SA
#undef PG8_SB
#undef PG8_STAGE
#undef PG8_LDA
#undef PG8_LDB
#undef PG8_MMA
#undef PG8_WAIT_V
#undef PG8_WAIT_L
#undef PG8_BAR
#undef PG8_SCHED
}
}
namespace att {
#define ATT_LAS __attribute__((address_space(3)))
typedef unsigned short bf16;
typedef short bf16x8 __attribute__((ext_vector_type(8)));
typedef short s16x4 __attribute__((ext_vector_type(4)));
typedef float f32x16 __attribute__((ext_vector_type(16)));
typedef float f32x4_t __attribute__((ext_vector_type(4)));
typedef unsigned u32x4 __attribute__((ext_vector_type(4)));
typedef unsigned u32x2 __attribute__((ext_vector_type(2)));
typedef float f32x2_t __attribute__((ext_vector_type(2))); typedef __bf16 bf16x2_t __attribute__((ext_vector_type(2)));
__device__ __forceinline__ unsigned cvtpk(float lo, float hi) { f32x2_t v = {lo, hi}; bf16x2_t b = __builtin_convertvector(v, bf16x2_t); return __builtin_bit_cast(unsigned, b); }
__device__ __forceinline__ s16x4 vtr(const ATT_LAS unsigned char* p) { return __builtin_bit_cast(s16x4, __builtin_amdgcn_ds_read_tr16_b64_v4i16((ATT_LAS s16x4*)p)); }
constexpr int VSTR = 192;
template <int DQK> struct Geo { static constexpr int KSTR = DQK * 2 + 16, KBUF = 64 * KSTR, VBUF = 64 * VSTR, CPR = DQK / 8, NKC = 64 * CPR, KIT = (NKC + 511) / 512; };
template <int DQK> constexpr int lds_bytes() { return 2 * Geo<DQK>::KBUF + 2 * Geo<DQK>::VBUF + 2048 + 8192; }

__device__ __forceinline__ float xhalf_sum(float m) { return xor32_sum(m); }
__device__ __forceinline__ float max3f(float a, float b, float c) { float r; asm("v_max3_f32 %0, %1, %2, %3" : "=v"(r) : "v"(a), "v"(b), "v"(c)); return r; }
__device__ __forceinline__ float max2f(float a, float b) { float r; asm("v_max_f32_e32 %0, %1, %2" : "=v"(r) : "v"(a), "v"(b)); return r; }
__device__ __forceinline__ float rowmax32(const f32x16& p0, const f32x16& p1) {
    float a = max2f(p0[0], p1[0]), b = max2f(p0[1], p1[1]), c = max2f(p0[2], p1[2]), d = max2f(p0[3], p1[3]);
#pragma unroll
    for (int r = 4; r < 16; r += 4) { a = max3f(a, p0[r], p1[r]); b = max3f(b, p0[r + 1], p1[r + 1]); c = max3f(c, p0[r + 2], p1[r + 2]); d = max3f(d, p0[r + 3], p1[r + 3]); }
    const float m = max2f(max2f(a, b), max2f(c, d));
    float lo_, hi_; halves32(m, lo_, hi_);
    return max2f(lo_, hi_);
}

template <int DQK, bool BAND, int qpitch, int kpitch, int vpitch, int opitch, bool OF8 = false>
__device__ __forceinline__ void attn_unit(ATT_LAS unsigned char* lds, const bf16* Qb, const bf16* Kb, const bf16* Vb, bf16* Ob,
                                          int q0, int t_lo, int t_hi, int my_lo, int my_hi, int cc, const float* bias_g, const float* g_qn, const float* rope, const int wave_idx) {
    typedef Geo<DQK> G;
    int tid_ = wave_idx * 64 + lane_id_(); asm volatile("" : "+v"(tid_));
    const int tid = tid_, lane = tid & 63, r32 = lane & 31, hi = lane >> 5, wid = __builtin_amdgcn_readfirstlane(tid >> 6);
    ATT_LAS float* biasL = (ATT_LAS float*)(lds + 2 * G::KBUF + 2 * G::VBUF);
    bf16x8 qf[DQK / 16];
    { const bf16* qp = Qb + (size_t)(q0 + wid * 32 + r32) * qpitch + 8 * hi;
#pragma unroll
      for (int kk = 0; kk < DQK / 16; ++kk) qf[kk] = *(const bf16x8*)(qp + 16 * kk); }
    if constexpr (!BAND) {
        float qv[DQK / 16][8]; float ss = 0.f;
#pragma unroll
        for (int kk = 0; kk < DQK / 16; ++kk)
#pragma unroll
            for (int j = 0; j < 8; ++j) { qv[kk][j] = __builtin_bit_cast(float, (unsigned)(unsigned short)qf[kk][j] << 16); ss += qv[kk][j] * qv[kk][j]; }
        ss = xhalf_sum(ss);
        const float rs = __builtin_amdgcn_rsqf(ss * (1.f / DQK) + 1e-6f) * (0.10206207261596577f * 1.4426950408889634f);
#pragma unroll
        for (int kk = 0; kk < DQK / 16; ++kk) { const f32x4_t g0 = *(const f32x4_t*)(g_qn + 16 * kk + 8 * hi), g1 = *(const f32x4_t*)(g_qn + 16 * kk + 8 * hi + 4);
#pragma unroll
            for (int j = 0; j < 4; ++j) { qv[kk][j] *= rs * g0[j]; qv[kk][4 + j] *= rs * g1[j]; } }
        const f32x4_t* rp = (const f32x4_t*)(rope + ((size_t)(q0 + wid * 32 + r32) * 16 + 8 * hi) * 2);
#pragma unroll
        for (int j2 = 0; j2 < 4; ++j2) { const f32x4_t cs = rp[j2];
            { const float x1 = qv[4][2 * j2], x2 = qv[5][2 * j2]; qv[4][2 * j2] = x1 * cs[0] - x2 * cs[1]; qv[5][2 * j2] = x2 * cs[0] + x1 * cs[1]; }
            { const float x1 = qv[4][2 * j2 + 1], x2 = qv[5][2 * j2 + 1]; qv[4][2 * j2 + 1] = x1 * cs[2] - x2 * cs[3]; qv[5][2 * j2 + 1] = x2 * cs[2] + x1 * cs[3]; } }
#pragma unroll
        for (int kk = 0; kk < DQK / 16; ++kk) { u32x4 w; w.x = cvtpk(qv[kk][0], qv[kk][1]); w.y = cvtpk(qv[kk][2], qv[kk][3]); w.z = cvtpk(qv[kk][4], qv[kk][5]); w.w = cvtpk(qv[kk][6], qv[kk][7]);
            qf[kk] = __builtin_bit_cast(bf16x8, w); }
    }
    if (BAND) { if (tid < 257) biasL[tid] = bias_g[tid] * 1.4426950408889634f; }
    constexpr int KCPL = G::KSTR / 16, KNP = (64 * KCPL + 63) / 64;
    constexpr int VCPL = VSTR / 16, VNP = 64 * VCPL / 64;
    constexpr int KPP = (KNP + 7) / 8, VPP = (VNP + 7) / 8;
    ATT_LAS unsigned* dmaL = (ATT_LAS unsigned*)(lds + 2 * G::KBUF + 2 * G::VBUF + 2048) + wid * 256 + lane;
#pragma unroll
    for (int pp = 0; pp < KPP; ++pp) { const int pc = wid + 8 * pp, c = pc * 64 + lane, row = (c / KCPL) & 63, ch = c % KCPL; dmaL[64 * pp] = (unsigned)(row * kpitch + (ch < G::CPR ? ch : 0) * 8) * 2u; }
#pragma unroll
    for (int pp = 0; pp < VPP; ++pp) { const int pc = wid + 8 * pp, c = pc * 64 + lane, row = (c / VCPL) & 63, ch = c % VCPL; dmaL[128 + 64 * pp] = (unsigned)(row * vpitch + (ch < 8 ? ch : 0) * 8) * 2u; }
#define ATT_DMA_K(t, b) do { const char* kt_ = (const char*)(Kb + (size_t)(t) * 64 * kpitch); _Pragma("unroll") for (int pp = 0; pp < KPP; ++pp) { if (wid + 8 * pp < KNP) \
            __builtin_amdgcn_global_load_lds((const unsigned*)(kt_ + dmaL[64 * pp]), (ATT_LAS unsigned*)(lds + (b) * G::KBUF + (wid + 8 * pp) * 1024), 16, 0, 0); } } while (0)
#define ATT_DMA_V(t, b) do { const char* vt_ = (const char*)(Vb + (size_t)(t) * 64 * vpitch); _Pragma("unroll") for (int pp = 0; pp < VPP; ++pp) { if (wid + 8 * pp < VNP) \
            __builtin_amdgcn_global_load_lds((const unsigned*)(vt_ + dmaL[128 + 64 * pp]), (ATT_LAS unsigned*)(lds + 2 * G::KBUF + (b) * G::VBUF + (wid + 8 * pp) * 1024), 16, 0, 0); } } while (0)
    f32x16 o0, o1;
#pragma unroll
    for (int i = 0; i < 16; ++i) { o0[i] = 0.f; o1[i] = 0.f; }
    float mrun = -INFINITY, lsum = 0.f;
    const int koff = r32 * G::KSTR + hi * 16;
    const int voff = ((lane >> 5) * 4 + ((lane & 15) >> 2)) * VSTR + (((lane >> 4) & 1) * 16 + (lane & 3) * 4) * 2;
    const f32x16 zero16 = {0.f, 0.f, 0.f, 0.f, 0.f, 0.f, 0.f, 0.f, 0.f, 0.f, 0.f, 0.f, 0.f, 0.f, 0.f, 0.f};
#define ATT_QK(X0, X1, t) do { const ATT_LAS unsigned char* Kt = lds + ((t) & 1) * G::KBUF + koff; \
        _Pragma("unroll") for (int kk = 0; kk < DQK / 16; ++kk) { \
            const bf16x8 a0 = *(const ATT_LAS bf16x8*)(Kt + kk * 32); const bf16x8 a1 = *(const ATT_LAS bf16x8*)(Kt + 32 * G::KSTR + kk * 32); \
            X0 = __builtin_amdgcn_mfma_f32_32x32x16_bf16(a0, qf[kk], kk ? X0 : zero16, 0, 0, 0); X1 = __builtin_amdgcn_mfma_f32_32x32x16_bf16(a1, qf[kk], kk ? X1 : zero16, 0, 0, 0); } } while (0)
#define ATT_SMPV(X0, X1, t) do { \
        float cadd = 0.f; \
        if (BAND) { const int delta = cc - (t); \
            if (delta >= 3) cadd = biasL[256]; \
            else { const ATT_LAS float* bp = biasL + (64 * delta + (32 * (wid & 1) + r32) - 4 * hi + 128 - 63); \
                if (delta < 2) { _Pragma("unroll") for (int i = 0; i < 16; ++i) { const int kj = (i & 3) + 8 * (i >> 2); X0[i] += bp[63 - kj]; X1[i] += bp[31 - kj]; } } \
                else { const int relb = 64 * delta + (32 * (wid & 1) + r32) - 4 * hi + 128; \
                    _Pragma("unroll") for (int i = 0; i < 16; ++i) { const int kj = (i & 3) + 8 * (i >> 2); int i0 = relb - kj, i1 = relb - kj - 32; i0 = i0 > 256 ? 256 : i0; i1 = i1 > 256 ? 256 : i1; \
                        X0[i] += biasL[i0]; X1[i] += biasL[i1]; } } } } \
        const float mt = rowmax32(X0, X1) + cadd; \
        const float mnew = max2f(mrun, mt); \
        const float alpha = __builtin_amdgcn_exp2f(mrun - mnew); \
        const float msub = mnew - cadd; \
        mrun = mnew; \
        float psa[4] = {0.f, 0.f, 0.f, 0.f};   \
        _Pragma("unroll") for (int i = 0; i < 16; ++i) { X0[i] = __builtin_amdgcn_exp2f(X0[i] - msub); X1[i] = __builtin_amdgcn_exp2f(X1[i] - msub); psa[i & 3] += X0[i] + X1[i]; } \
        const float ps = (psa[0] + psa[1]) + (psa[2] + psa[3]); \
        lsum = lsum * alpha + ps; \
        _Pragma("unroll") for (int i = 0; i < 16; ++i) { o0[i] *= alpha; o1[i] *= alpha; } \
        bf16x8 pf[2][2]; \
        _Pragma("unroll") for (int s = 0; s < 2; ++s) { u32x4 w0, w1; \
            w0.x = cvtpk(X0[8 * s + 0], X0[8 * s + 1]); w0.y = cvtpk(X0[8 * s + 2], X0[8 * s + 3]); w0.z = cvtpk(X0[8 * s + 4], X0[8 * s + 5]); w0.w = cvtpk(X0[8 * s + 6], X0[8 * s + 7]); \
            w1.x = cvtpk(X1[8 * s + 0], X1[8 * s + 1]); w1.y = cvtpk(X1[8 * s + 2], X1[8 * s + 3]); w1.z = cvtpk(X1[8 * s + 4], X1[8 * s + 5]); w1.w = cvtpk(X1[8 * s + 6], X1[8 * s + 7]); \
            pf[0][s] = __builtin_bit_cast(bf16x8, w0); pf[1][s] = __builtin_bit_cast(bf16x8, w1); } \
        const ATT_LAS unsigned char* Vt = lds + 2 * G::KBUF + ((t) & 1) * G::VBUF + voff; \
        _Pragma("unroll") for (int kb = 0; kb < 2; ++kb) _Pragma("unroll") for (int s = 0; s < 2; ++s) { \
            const ATT_LAS unsigned char* vp = Vt + (32 * kb + 16 * s) * VSTR; \
            const s16x4 l0 = vtr(vp), h0 = vtr(vp + 8 * VSTR), l1 = vtr(vp + 64), h1 = vtr(vp + 8 * VSTR + 64); \
            const bf16x8 a0 = (bf16x8){l0[0], l0[1], l0[2], l0[3], h0[0], h0[1], h0[2], h0[3]}; \
            const bf16x8 a1 = (bf16x8){l1[0], l1[1], l1[2], l1[3], h1[0], h1[1], h1[2], h1[3]}; \
            o0 = __builtin_amdgcn_mfma_f32_32x32x16_bf16(a0, pf[kb][s], o0, 0, 0, 0); o1 = __builtin_amdgcn_mfma_f32_32x32x16_bf16(a1, pf[kb][s], o1, 0, 0, 0); } } while (0)
#define ATT_FUSED(C0, C1, N0, N1, t, tn) do { \
        bf16x8 kfa[DQK / 16], kfb[DQK / 16]; \
        { const ATT_LAS unsigned char* Kt = lds + ((tn) & 1) * G::KBUF + koff; \
          _Pragma("unroll") for (int kk = 0; kk < DQK / 16; ++kk) { kfa[kk] = *(const ATT_LAS bf16x8*)(Kt + kk * 32); kfb[kk] = *(const ATT_LAS bf16x8*)(Kt + 32 * G::KSTR + kk * 32); } } \
        __builtin_amdgcn_sched_barrier(0); \
        float cadd = 0.f; \
        if (BAND) { const int delta = cc - (t); \
            if (delta >= 3) cadd = biasL[256]; \
            else { const ATT_LAS float* bp = biasL + (64 * delta + (32 * (wid & 1) + r32) - 4 * hi + 128 - 63); \
                if (delta < 2) { _Pragma("unroll") for (int i = 0; i < 16; ++i) { const int kj = (i & 3) + 8 * (i >> 2); C0[i] += bp[63 - kj]; C1[i] += bp[31 - kj]; } } \
                else { const int relb = 64 * delta + (32 * (wid & 1) + r32) - 4 * hi + 128; \
                    _Pragma("unroll") for (int i = 0; i < 16; ++i) { const int kj = (i & 3) + 8 * (i >> 2); int i0 = relb - kj, i1 = relb - kj - 32; i0 = i0 > 256 ? 256 : i0; i1 = i1 > 256 ? 256 : i1; \
                        C0[i] += biasL[i0]; C1[i] += biasL[i1]; } } } } \
        const float mt = rowmax32(C0, C1) + cadd; \
        const float mnew = max2f(mrun, mt); \
        const float alpha = __builtin_amdgcn_exp2f(mrun - mnew); \
        const float msub = mnew - cadd; \
        if (__builtin_amdgcn_ballot_w64(mnew > mrun)) { _Pragma("unroll") for (int i = 0; i < 16; ++i) { o0[i] *= alpha; o1[i] *= alpha; } } \
        mrun = mnew; \
        __builtin_amdgcn_sched_barrier(0); \
        _Pragma("unroll") for (int kk = 0; kk < DQK / 16; ++kk) { \
            N0 = __builtin_amdgcn_mfma_f32_32x32x16_bf16(kfa[kk], qf[kk], kk ? N0 : zero16, 0, 0, 0); N1 = __builtin_amdgcn_mfma_f32_32x32x16_bf16(kfb[kk], qf[kk], kk ? N1 : zero16, 0, 0, 0); } \
        s16x4 vl0[4], vh0[4], vl1[4], vh1[4]; \
        { const ATT_LAS unsigned char* Vt = lds + 2 * G::KBUF + ((t) & 1) * G::VBUF + voff; \
          _Pragma("unroll") for (int ks = 0; ks < 4; ++ks) { const ATT_LAS unsigned char* vp = Vt + 16 * ks * VSTR; vl0[ks] = vtr(vp); vh0[ks] = vtr(vp + 8 * VSTR); vl1[ks] = vtr(vp + 64); vh1[ks] = vtr(vp + 8 * VSTR + 64); } } \
        float psa[4] = {0.f, 0.f, 0.f, 0.f}; \
        _Pragma("unroll") for (int i = 0; i < 16; ++i) { C0[i] = __builtin_amdgcn_exp2f(C0[i] - msub); C1[i] = __builtin_amdgcn_exp2f(C1[i] - msub); psa[i & 3] += C0[i] + C1[i]; } \
        const float ps = (psa[0] + psa[1]) + (psa[2] + psa[3]); \
        lsum = lsum * alpha + ps; \
        bf16x8 pf[4]; \
        _Pragma("unroll") for (int s = 0; s < 2; ++s) { u32x4 w0, w1; \
            w0.x = cvtpk(C0[8 * s + 0], C0[8 * s + 1]); w0.y = cvtpk(C0[8 * s + 2], C0[8 * s + 3]); w0.z = cvtpk(C0[8 * s + 4], C0[8 * s + 5]); w0.w = cvtpk(C0[8 * s + 6], C0[8 * s + 7]); \
            w1.x = cvtpk(C1[8 * s + 0], C1[8 * s + 1]); w1.y = cvtpk(C1[8 * s + 2], C1[8 * s + 3]); w1.z = cvtpk(C1[8 * s + 4], C1[8 * s + 5]); w1.w = cvtpk(C1[8 * s + 6], C1[8 * s + 7]); \
            pf[s] = __builtin_bit_cast(bf16x8, w0); pf[2 + s] = __builtin_bit_cast(bf16x8, w1); } \
        __builtin_amdgcn_sched_barrier(0); \
        _Pragma("unroll") for (int ks = 0; ks < 4; ++ks) { \
            const bf16x8 a0 = (bf16x8){vl0[ks][0], vl0[ks][1], vl0[ks][2], vl0[ks][3], vh0[ks][0], vh0[ks][1], vh0[ks][2], vh0[ks][3]}; \
            const bf16x8 a1 = (bf16x8){vl1[ks][0], vl1[ks][1], vl1[ks][2], vl1[ks][3], vh1[ks][0], vh1[ks][1], vh1[ks][2], vh1[ks][3]}; \
            o0 = __builtin_amdgcn_mfma_f32_32x32x16_bf16(a0, pf[ks], o0, 0, 0, 0); o1 = __builtin_amdgcn_mfma_f32_32x32x16_bf16(a1, pf[ks], o1, 0, 0, 0); } } while (0)
#define ATT_STAGE(t) do { if ((t) + 2 <= t_hi) ATT_DMA_K((t) + 2, (t) & 1); if ((t) + 1 <= t_hi) ATT_DMA_V((t) + 1, ((t) + 1) & 1); } while (0)
    f32x16 sa0, sa1, sb0, sb1;
    ATT_DMA_K(t_lo, t_lo & 1);
    __syncthreads();
    if (t_lo + 1 <= t_hi) ATT_DMA_K(t_lo + 1, (t_lo + 1) & 1);
    ATT_DMA_V(t_lo, t_lo & 1);
    if (my_lo == t_lo) ATT_QK(sa0, sa1, t_lo);
    __syncthreads();
    {
        int t = t_lo;
        for (; t < my_lo - 1; ++t) { ATT_STAGE(t); __syncthreads(); }
        if (my_lo > t_lo) { ATT_STAGE(t); ATT_QK(sa0, sa1, t + 1); __syncthreads(); ++t; }
        int nf = my_hi - my_lo;
        for (; nf >= 2; nf -= 2, t += 2) {
            ATT_STAGE(t); ATT_FUSED(sa0, sa1, sb0, sb1, t, t + 1); __syncthreads();
            ATT_STAGE(t + 1); ATT_FUSED(sb0, sb1, sa0, sa1, t + 1, t + 2); __syncthreads();
        }
        if (nf == 1) {
            ATT_STAGE(t); ATT_FUSED(sa0, sa1, sb0, sb1, t, t + 1); __syncthreads(); ++t;
            ATT_STAGE(t); ATT_SMPV(sb0, sb1, t); __syncthreads(); ++t;
        } else {
            ATT_STAGE(t); ATT_SMPV(sa0, sa1, t); __syncthreads(); ++t;
        }
        for (; t <= t_hi; ++t) { ATT_STAGE(t); __syncthreads(); }
    }
    const float ltot = xhalf_sum(lsum);
    const float inv = 1.f / ltot;
    if constexpr (OF8) {
        unsigned char* op = (unsigned char*)Ob + (size_t)(q0 + wid * 32 + r32) * opitch + 4 * hi; const float i64 = inv * 32.f;
#pragma unroll
        for (int g4 = 0; g4 < 4; ++g4) {
            int w0 = 0, w1 = 0;
            w0 = __builtin_amdgcn_cvt_pk_fp8_f32(o0[4 * g4 + 0] * i64, o0[4 * g4 + 1] * i64, w0, false); w0 = __builtin_amdgcn_cvt_pk_fp8_f32(o0[4 * g4 + 2] * i64, o0[4 * g4 + 3] * i64, w0, true);
            w1 = __builtin_amdgcn_cvt_pk_fp8_f32(o1[4 * g4 + 0] * i64, o1[4 * g4 + 1] * i64, w1, false); w1 = __builtin_amdgcn_cvt_pk_fp8_f32(o1[4 * g4 + 2] * i64, o1[4 * g4 + 3] * i64, w1, true);
            *(int*)(op + 8 * g4) = w0; *(int*)(op + 32 + 8 * g4) = w1;
        }
    } else {
    bf16* op = Ob + (size_t)(q0 + wid * 32 + r32) * opitch + 4 * hi;
#pragma unroll
    for (int g4 = 0; g4 < 4; ++g4) {
        u32x2 w0, w1;
        w0.x = cvtpk(o0[4 * g4 + 0] * inv, o0[4 * g4 + 1] * inv); w0.y = cvtpk(o0[4 * g4 + 2] * inv, o0[4 * g4 + 3] * inv);
        w1.x = cvtpk(o1[4 * g4 + 0] * inv, o1[4 * g4 + 1] * inv); w1.y = cvtpk(o1[4 * g4 + 2] * inv, o1[4 * g4 + 3] * inv);
        *(u32x2*)(op + 8 * g4) = w0; *(u32x2*)(op + 32 + 8 * g4) = w1;
    }
    }
#undef ATT_DMA_K
#undef ATT_DMA_V
#undef ATT_QK
#undef ATT_SMPV
#undef ATT_STAGE
#undef ATT_FUSED
}
}
constexpr int NWAVES = 8;
constexpr int D = 1024, BATCH = 32, SEQ = 2048, M = BATCH * SEQ;
constexpr int NH = 16, QLORA = 384, KVLORA = 256, ROPE_D = 32, NOPE = 64, QKD = 96;
constexpr int NA = 768;
constexpr int FF = 2816, EFF = 3584, NE = 8;
constexpr float EPS = 1e-6f, LOG2E = 1.4426950408889634f;
constexpr int MAXP_HALF = 264, MAXP = 528;
constexpr size_t MiB = 1u << 20;
constexpr size_t WS_CTL = 0, CTL_ZERO_BYTES = 1 * MiB;
constexpr size_t WS_ROPE = 1 * MiB;
constexpr size_t WS_CNT = WS_ROPE + 256 * 1024;
constexpr size_t WS_PANELE = WS_CNT + 16 * 1024;
constexpr size_t WS_META = WS_PANELE + 4096;
constexpr size_t WS_TOKE = 2 * MiB;
constexpr size_t WS_TOKG = WS_TOKE + (size_t)M * 4;
constexpr size_t WS_SLOTTOK = WS_TOKG + (size_t)M * 8;
constexpr size_t WS_SLOTGATE = WS_SLOTTOK + (size_t)MAXP * 256 * 4;
constexpr size_t WS_PARTQA = 976 * MiB, WS_PART1 = 980 * MiB, WS_PART2 = 984 * MiB;
constexpr size_t WS_TOKRSTD = 4 * MiB;
constexpr size_t WS_SLOTRSTD = WS_TOKRSTD + (size_t)M * 4;
static_assert(WS_SLOTGATE + (size_t)MAXP * 256 * 4 <= WS_TOKRSTD && WS_SLOTRSTD + (size_t)MAXP * 256 * 4 <= 8 * MiB, "small arrays");
constexpr size_t WS_W = 8 * MiB;
constexpr size_t WS_WA = WS_W, WS_WUQ = WS_WA + (size_t)NA * D * 2, WS_WUKV = WS_WUQ + (size_t)1536 * QLORA * 2, WS_WO = WS_WUKV + (size_t)2048 * KVLORA * 2;
constexpr size_t WS_WF1 = WS_WO + (size_t)D * D * 2, WS_WF2 = WS_WF1 + (size_t)2 * FF * D * 2, WS_WKVQ = WS_WF2 + (size_t)D * FF * 2, WS_WBO = WS_WKVQ + (size_t)3 * D * D * 2;
constexpr size_t WS_WM1 = WS_WBO + (size_t)D * D * 2, WS_WM2 = WS_WM1 + (size_t)NE * 2 * EFF * D * 2, WS_WEND = WS_WM2 + (size_t)NE * D * EFF * 2;
constexpr size_t ARENA = 208 * MiB;
static_assert(WS_WEND <= ARENA, "weights fit under the arena");
constexpr size_t WS_XN = ARENA;
constexpr size_t WS_QA = ARENA + 128 * MiB;
constexpr size_t WS_Q = ARENA + 224 * MiB;
constexpr size_t WS_K = ARENA + 416 * MiB;
constexpr size_t WS_V = ARENA + 608 * MiB;
constexpr size_t WS_O = ARENA;
static_assert(WS_V + (size_t)M * D * 2 <= 1024 * MiB, "MLA arena");
constexpr size_t WS_XR1 = ARENA + 128 * MiB;
constexpr size_t WS_H = ARENA + 256 * MiB;
constexpr size_t WS_XR2 = ARENA;
constexpr size_t WS_X2B = ARENA + 608 * MiB;
constexpr size_t WS_KVQ2 = ARENA + 128 * MiB;
constexpr size_t WS_O2 = ARENA + 512 * MiB;
constexpr size_t WS_XR3 = ARENA + 132 * MiB;
constexpr size_t WS_XG = ARENA;
constexpr size_t WS_HM = ARENA + 264 * MiB;
constexpr size_t WS_END = WS_HM + (size_t)MAXP_HALF * 256 * EFF * 2;
static_assert(WS_XG + (size_t)MAXP * 256 * D <= WS_XR3 && WS_XR3 + (size_t)M * D * 2 <= WS_HM && WS_END <= 1024 * MiB && WS_H + (size_t)M * FF * 2 <= WS_X2B && WS_X2B + (size_t)M * D * 2 <= 976 * MiB && WS_O2 + (size_t)M * D <= WS_X2B, "arena");
constexpr int CW_BAR = 4096;
constexpr int RING_OFF = 0, RING_BYTES = 131072;
constexpr int P0_SCR = 128 * 33 * 4;
constexpr int LDSCTL_OFF = 8 * P0_SCR, MISC_OFF = LDSCTL_OFF + 320;
static_assert(LDSCTL_OFF >= RING_BYTES, "control words above every phase's scratch");
constexpr int LDS_BYTES = 147456;
static_assert(MISC_OFF + 128 <= LDS_BYTES, "LDS map");
static_assert(att::lds_bytes<96>() <= RING_BYTES, "attention scratch fits the ring region");

#define GAS __attribute__((address_space(1)))
#define LAS __attribute__((address_space(3)))
typedef unsigned short bf16;
typedef unsigned v4u __attribute__((ext_vector_type(4)));
typedef unsigned v2u __attribute__((ext_vector_type(2)));
typedef float f32x4 __attribute__((ext_vector_type(4)));
typedef GAS unsigned gu32;
#define RLX_AGENT __ATOMIC_RELAXED, __HIP_MEMORY_SCOPE_AGENT
#define LDS_WAIT() asm volatile("s_waitcnt lgkmcnt(0)" ::: "memory")
__device__ __forceinline__ unsigned f2bf(float f) { unsigned u = __builtin_bit_cast(unsigned, f); return (u + 0x7fffu + ((u >> 16) & 1u)) >> 16; }
__device__ __forceinline__ unsigned pk2(float lo, float hi) { return f2bf(lo) | (f2bf(hi) << 16); }
__device__ __forceinline__ float bflo(unsigned u) { return __builtin_bit_cast(float, u << 16); }
__device__ __forceinline__ float bfhi(unsigned u) { return __builtin_bit_cast(float, u & 0xffff0000u); }
__device__ __forceinline__ float wave_sum(float v) {
    v += swz_xor<1>(v); v += swz_xor<2>(v); v += swz_xor<4>(v); v += swz_xor<8>(v); v += swz_xor<16>(v);
    return xor32_sum(v);
}

#define XB_TMO      128
#define XB_XCNT(j)  (256  + 64 * (j))
#define XB_XSUB(j)  (1280 + 64 * (j))
#define XB_XGEN(j)  (2304 + 64 * (j))
#define XB_TOP      3328
#define XB_TOPGEN   3392
#define XCD_BAR_WORDS 3456
#define XB_SPIN_CAP (1u << 18)

__device__ __forceinline__ unsigned xb_ld(unsigned* p)              { return __hip_atomic_load(p, __ATOMIC_RELAXED, __HIP_MEMORY_SCOPE_AGENT); }
__device__ __forceinline__ unsigned xb_add(unsigned* p, unsigned v) { return __hip_atomic_fetch_add(p, v, __ATOMIC_RELAXED, __HIP_MEMORY_SCOPE_AGENT); }
__device__ __forceinline__ unsigned xb_xcc_id() { return (unsigned)__builtin_amdgcn_s_getreg((3 << 11) | 20) & 0xFu; }
#define XB_SPIN(cond, bar) do { unsigned _sp = 0; while (cond) { __builtin_amdgcn_s_sleep(1); \
    if ((++_sp & 255u) == 0u) { if (xb_ld(&(bar)[XB_TMO])) break; if (_sp > XB_SPIN_CAP) { atomicAdd(&(bar)[XB_TMO], 1u); break; } } } } while (0)

struct XcdBarrier {
    int t0;
    unsigned* bar; unsigned x;
    volatile LAS unsigned* st;
};

__device__ __forceinline__ XcdBarrier xcd_barrier_post(unsigned* bar, volatile LAS unsigned* st, int t0) {
    XcdBarrier b; b.t0 = t0; b.bar = bar; b.x = xb_xcc_id(); b.st = st;
    if (b.t0) (void)xb_add(&bar[XB_XCNT(b.x)], 1u);
    return b;
}
__device__ __forceinline__ void xcd_barrier_complete(unsigned* bar, unsigned x, unsigned& nloc, unsigned& nx) {
    const unsigned G = gridDim.x * gridDim.y * gridDim.z;
    unsigned sum, cnt, mine, sp = 0u;
    for (;;) {
        sum = 0u; cnt = 0u; mine = 0u;
#pragma unroll
        for (unsigned j = 0; j < 16; ++j) { const unsigned c = xb_ld(&bar[XB_XCNT(j)]); sum += c; cnt += (c > 0u) ? 1u : 0u; mine = (j == x) ? c : mine; }
        if (sum == G) break;
        __builtin_amdgcn_s_sleep(1);
        if ((++sp & 255u) == 0u) { if (xb_ld(&bar[XB_TMO])) break; if (sp > XB_SPIN_CAP) { atomicAdd(&bar[XB_TMO], 1u); break; } }
    }
    nloc = mine > 0u ? mine : 1u; nx = cnt > 0u ? cnt : 1u;
}

__device__ __forceinline__ void xcd_barrier(const XcdBarrier& b) {
    asm volatile("s_waitcnt vmcnt(0)" ::: "memory");
    __syncthreads();
    if (b.t0) {
        unsigned* bar = b.bar;
        __builtin_amdgcn_s_waitcnt(0);
        unsigned nloc = b.st[0], nx = b.st[1];
        if (nloc == 0u) { xcd_barrier_complete(bar, b.x, nloc, nx); b.st[0] = nloc; b.st[1] = nx; }
        const unsigned old = xb_add(&bar[XB_XSUB(b.x)], 1u);
        const unsigned gen = old / nloc;
        if (old + 1u == (gen + 1u) * nloc) {
            __builtin_amdgcn_fence(__ATOMIC_RELEASE, "agent");
            asm volatile("s_waitcnt vmcnt(0)" ::: "memory");
            const unsigned og = xb_add(&bar[XB_TOP], 1u);
            const unsigned tg = og / nx;
            if (og + 1u == (tg + 1u) * nx) xb_add(&bar[XB_TOPGEN], 1u);
            else XB_SPIN(xb_ld(&bar[XB_TOPGEN]) == tg, bar);
            __builtin_amdgcn_fence(__ATOMIC_ACQUIRE, "agent");
            xb_add(&bar[XB_XGEN(b.x)], 1u);
            asm volatile("s_waitcnt vmcnt(0)" ::: "memory");
        } else {
            XB_SPIN(xb_ld(&bar[XB_XGEN(b.x)]) == gen, bar);
            __builtin_amdgcn_fence(__ATOMIC_ACQUIRE, "agent");
            asm volatile("s_waitcnt vmcnt(0)" ::: "memory");
        }
    }
    __syncthreads();
}

struct Args { const float* in[27]; float* out; unsigned char* ws; };
enum { I_X = 0, I_ATTN_NORM, I_FFN_NORM, I_A_WDQ, I_A_GCQ, I_A_WUQ, I_A_WDKV, I_A_GCKV, I_A_WUKV, I_A_GQN, I_A_GKN, I_A_WO, I_KV_NORM, I_KV_WK, I_KV_WV, I_KV_GKN,
       I_B_WQ, I_B_GQN, I_B_RELB, I_B_WO, I_FFN_W1, I_FFN_W3, I_FFN_W2, I_MOE_ROUTER, I_MOE_W1, I_MOE_W3, I_MOE_W2 };

struct Frame {
    LAS unsigned char* lds;
    int wave, vcu, G;
};
typedef const __attribute__((address_space(4))) Args* KArgs;
__device__ __forceinline__ KArgs kargs() { KArgs p = (KArgs)__builtin_amdgcn_kernarg_segment_ptr(); asm volatile("" : "+s"(p)); return p; }
#define INP(i) (kargs()->in[i])
#define OUTP (kargs()->out)
#define WSP (kargs()->ws)
__device__ __forceinline__ int fresh(int v) { asm volatile("" : "+v"(v)); return v; }

__device__ __forceinline__ void tr_item(const float* W, int ldw, int K, int k0, int nsrc0, const float* gain, bf16* WT, int drow0, LAS float* scr, int lane) {
    const int c4 = lane & 7, r = lane >> 3;
    const GAS float* src = (const GAS float*)W + (size_t)(k0 + r) * ldw + nsrc0 + 4 * c4;
    f32x4 v[16];
#pragma unroll
    for (int i = 0; i < 16; ++i) v[i] = *(const GAS f32x4*)(src + (size_t)(8 * i) * ldw);
    if (gain) {
#pragma unroll
        for (int i = 0; i < 16; ++i) v[i] = v[i] * gain[k0 + 8 * i + r];
    }
#pragma unroll
    for (int i = 0; i < 16; ++i) { LAS float* d = scr + (8 * i + r) * 33 + 4 * c4; d[0] = v[i].x; d[1] = v[i].y; d[2] = v[i].z; d[3] = v[i].w; }
    LDS_WAIT(); asm volatile("" ::: "memory");
    const int c16 = lane >> 2;
#pragma unroll
    for (int j = 0; j < 8; ++j) { const int n = (lane & 3) + 4 * j; const LAS float* sp = scr + (8 * c16) * 33 + n;
        v4u o; o.x = pk2(sp[0 * 33], sp[1 * 33]); o.y = pk2(sp[2 * 33], sp[3 * 33]); o.z = pk2(sp[4 * 33], sp[5 * 33]); o.w = pk2(sp[6 * 33], sp[7 * 33]);
        *(GAS v4u*)(WT + (size_t)(drow0 + n) * K + k0 + 8 * c16) = o; }
    LDS_WAIT(); asm volatile("" ::: "memory");
}
__device__ __forceinline__ void tr_plain(const float* W, int K, int N, const float* gain, bf16* WT, int drow_off, LAS float* scr, int item, int lane) {
    const int nblk = N / 32, kb = item / nblk, nb = item % nblk;
    tr_item(W, N, K, 128 * kb, 32 * nb, gain, WT, drow_off + 32 * nb, scr, lane);
}
__device__ __forceinline__ void tr_gated(const float* W, int K, int N, const float* gain, bf16* WT, int half, LAS float* scr, int item, int lane) {
    const int nblk = N / 32, kb = item / nblk, nb = item % nblk, n0 = 32 * nb;
    tr_item(W, N, K, 128 * kb, n0, gain, WT, (n0 >> 7) * 256 + half * 128 + (n0 & 127), scr, lane);
}
__device__ __forceinline__ unsigned pk_fp8x4(float a, float b, float c, float d) { int w = 0; w = __builtin_amdgcn_cvt_pk_fp8_f32(a, b, w, false); w = __builtin_amdgcn_cvt_pk_fp8_f32(c, d, w, true); return (unsigned)w; }
__device__ __forceinline__ void tr_item_f8(const float* W, int ldw, int K, int k0, int nsrc0, const float* gain, unsigned char* WT, int drow0, LAS float* scr, int lane) {
    const int c4 = lane & 7, r = lane >> 3;
    const GAS float* src = (const GAS float*)W + (size_t)(k0 + r) * ldw + nsrc0 + 4 * c4;
    f32x4 v[16];
#pragma unroll
    for (int i = 0; i < 16; ++i) v[i] = *(const GAS f32x4*)(src + (size_t)(8 * i) * ldw);
#pragma unroll
    for (int i = 0; i < 16; ++i) v[i] = v[i] * (gain ? gain[k0 + 8 * i + r] * 64.f : 64.f);
#pragma unroll
    for (int i = 0; i < 16; ++i) { LAS float* d = scr + (8 * i + r) * 33 + 4 * c4; d[0] = v[i].x; d[1] = v[i].y; d[2] = v[i].z; d[3] = v[i].w; }
    LDS_WAIT(); asm volatile("" ::: "memory");
    const int c8 = lane >> 3;
#pragma unroll
    for (int j = 0; j < 4; ++j) { const int n = (lane & 7) + 8 * j; const LAS float* sp = scr + (16 * c8) * 33 + n;
        v4u o; o.x = pk_fp8x4(sp[0 * 33], sp[1 * 33], sp[2 * 33], sp[3 * 33]); o.y = pk_fp8x4(sp[4 * 33], sp[5 * 33], sp[6 * 33], sp[7 * 33]);
        o.z = pk_fp8x4(sp[8 * 33], sp[9 * 33], sp[10 * 33], sp[11 * 33]); o.w = pk_fp8x4(sp[12 * 33], sp[13 * 33], sp[14 * 33], sp[15 * 33]);
        *(GAS v4u*)(WT + (size_t)(drow0 + n) * K + k0 + 16 * c8) = o; }
    LDS_WAIT(); asm volatile("" ::: "memory");
}
__device__ __forceinline__ float rms_row_to_bf16(const float* xrow, bf16* orow, int lane, f32x4 (&v)[4]) {
    const GAS f32x4* xr = (const GAS f32x4*)xrow + lane;
    float s = 0.f;
#pragma unroll
    for (int j = 0; j < 4; ++j) { v[j] = xr[64 * j]; s += (v[j].x * v[j].x + v[j].y * v[j].y) + (v[j].z * v[j].z + v[j].w * v[j].w); }
    const float rstd = 1.f / sqrtf(wave_sum(s) * (1.f / D) + EPS);
    GAS unsigned long long* o8 = (GAS unsigned long long*)orow + lane;
#pragma unroll
    for (int j = 0; j < 4; ++j) o8[64 * j] = (unsigned long long)pk2(v[j].x * rstd, v[j].y * rstd) | ((unsigned long long)pk2(v[j].z * rstd, v[j].w * rstd) << 32);
    return rstd;
}
__device__ __forceinline__ void norm_phase(const Frame& F, const float* x, bf16* xn) {
    const int tid = fresh(F.wave * 64 + lane_id_()), lane = tid & 63; (void)lane;
    const int gw = F.vcu * NWAVES + F.wave, NGW = F.G * NWAVES;
    for (int m = 2 * gw; m < M; m += 2 * NGW) {
        const GAS f32x4* xr = (const GAS f32x4*)(x + (size_t)m * D) + lane;
        f32x4 v[8]; float s0 = 0.f, s1 = 0.f;
#pragma unroll
        for (int j = 0; j < 8; ++j) v[j] = xr[64 * j];
#pragma unroll
        for (int j = 0; j < 4; ++j) { s0 += (v[j].x * v[j].x + v[j].y * v[j].y) + (v[j].z * v[j].z + v[j].w * v[j].w); s1 += (v[4 + j].x * v[4 + j].x + v[4 + j].y * v[4 + j].y) + (v[4 + j].z * v[4 + j].z + v[4 + j].w * v[4 + j].w); }
        const float r0 = 1.f / sqrtf(wave_sum(s0) * (1.f / D) + EPS), r1 = 1.f / sqrtf(wave_sum(s1) * (1.f / D) + EPS);
        GAS unsigned* o4 = (GAS unsigned*)((GAS unsigned char*)xn + (size_t)m * D) + lane;
#pragma unroll
        for (int j = 0; j < 8; ++j) { const float rr = j < 4 ? r0 : r1; o4[64 * j] = pk_fp8x4(v[j].x * rr, v[j].y * rr, v[j].z * rr, v[j].w * rr); }
    }
}

__device__ __forceinline__ void p0_prologue(const Frame& F) {
    const int tid = fresh(F.wave * 64 + lane_id_()), lane = tid & 63; (void)lane;
    LAS float* scr = (LAS float*)(F.lds + RING_OFF + F.wave * P0_SCR);
    unsigned char* ws = WSP;
    const int gw = F.vcu * NWAVES + F.wave, NGW = F.G * NWAVES;
    constexpr int I_DQ = 8 * 12, I_DKV = 8 * 9, I_UQ = 3 * 48, I_UKV = 2 * 64, I_SQ = 8 * 32, I_F13 = 8 * 88, I_F2 = 22 * 32, I_M13 = 8 * 112, I_M2 = 28 * 32;
    constexpr int NSMALL = I_DQ + I_DKV + I_UQ + I_UKV + I_SQ + 2 * I_F13 + I_F2 + 4 * I_SQ;
    constexpr int NITEMS = NSMALL + NE * (2 * I_M13 + I_M2);
    for (int it = gw; it < NITEMS; it += NGW) {
        int r = it;
        if (r < I_DQ)  { const int kb = r / 12, n0 = 32 * (r % 12); tr_item_f8(INP(I_A_WDQ), QLORA, D, 128 * kb, n0, INP(I_ATTN_NORM), ws + WS_WA, n0, scr, lane); continue; } r -= I_DQ;
        if (r < I_DKV) { const int kb = r / 9, n0 = 32 * (r % 9); tr_item_f8(INP(I_A_WDKV), KVLORA + ROPE_D, D, 128 * kb, n0, INP(I_ATTN_NORM), ws + WS_WA, QLORA + n0, scr, lane); continue; } r -= I_DKV;
        if (r < I_UQ)  { tr_plain(INP(I_A_WUQ), QLORA, NH * QKD, INP(I_A_GCQ), (bf16*)(ws + WS_WUQ), 0, scr, r, lane); continue; } r -= I_UQ;
        if (r < I_UKV) { const int kb = r / 64, n0 = 32 * (r % 64), head = n0 >> 7, within = n0 & 127;
            const int drow = within < 64 ? 256 * (head >> 2) + 128 * (within >> 5) + 32 * (head & 3) : 1024 + head * 64 + (within - 64);
            tr_item(INP(I_A_WUKV), NH * 128, KVLORA, 128 * kb, n0, INP(I_A_GCKV), (bf16*)(ws + WS_WUKV), drow, scr, lane); continue; } r -= I_UKV;
        if (r < I_SQ)  { const int kb = r / 32, n0 = 32 * (r % 32); tr_item_f8(INP(I_A_WO), D, D, 128 * kb, n0, nullptr, ws + WS_WO, n0, scr, lane); continue; } r -= I_SQ;
        if (r < I_F13) { tr_gated(INP(I_FFN_W1), D, FF, INP(I_FFN_NORM), (bf16*)(ws + WS_WF1), 0, scr, r, lane); continue; } r -= I_F13;
        if (r < I_F13) { tr_gated(INP(I_FFN_W3), D, FF, INP(I_FFN_NORM), (bf16*)(ws + WS_WF1), 1, scr, r, lane); continue; } r -= I_F13;
        if (r < I_F2)  { tr_plain(INP(I_FFN_W2), FF, D, nullptr, (bf16*)(ws + WS_WF2), 0, scr, r, lane); continue; } r -= I_F2;
        if (r < I_SQ)  { const int kb = r / 32, n0 = 32 * (r % 32), head = n0 >> 6;
            tr_item_f8(INP(I_KV_WK), D, D, 128 * kb, n0, INP(I_KV_NORM), ws + WS_WKVQ, 256 * (head >> 2) + 128 * ((n0 >> 5) & 1) + 32 * (head & 3), scr, lane); continue; } r -= I_SQ;
        if (r < I_SQ)  { const int kb = r / 32, n0 = 32 * (r % 32); tr_item_f8(INP(I_KV_WV), D, D, 128 * kb, n0, INP(I_KV_NORM), ws + WS_WKVQ, 2 * D + n0, scr, lane); continue; } r -= I_SQ;
        if (r < I_SQ)  { const int kb = r / 32, n0 = 32 * (r % 32), head = n0 >> 6;
            tr_item_f8(INP(I_B_WQ), D, D, 128 * kb, n0, INP(I_ATTN_NORM) + D, ws + WS_WKVQ, D + 256 * (head >> 2) + 128 * ((n0 >> 5) & 1) + 32 * (head & 3), scr, lane); continue; } r -= I_SQ;
        if (r < I_SQ)  { const int kb = r / 32, n0 = 32 * (r % 32); tr_item_f8(INP(I_B_WO), D, D, 128 * kb, n0, nullptr, ws + WS_WBO, n0, scr, lane); continue; } r -= I_SQ;
        const int e = r / (2 * I_M13 + I_M2); r -= e * (2 * I_M13 + I_M2);
        if (r < I_M13) { const int kb = r / 112, n0 = 32 * (r % 112);
            tr_item_f8(INP(I_MOE_W1) + (size_t)e * D * EFF, EFF, D, 128 * kb, n0, INP(I_FFN_NORM) + D, ws + WS_WM1 + (size_t)e * 2 * EFF * D, (n0 >> 7) * 256 + (n0 & 127), scr, lane); continue; } r -= I_M13;
        if (r < I_M13) { const int kb = r / 112, n0 = 32 * (r % 112);
            tr_item_f8(INP(I_MOE_W3) + (size_t)e * D * EFF, EFF, D, 128 * kb, n0, INP(I_FFN_NORM) + D, ws + WS_WM1 + (size_t)e * 2 * EFF * D, (n0 >> 7) * 256 + 128 + (n0 & 127), scr, lane); continue; } r -= I_M13;
        { const int kb = r / 32, n0 = 32 * (r % 32); tr_item_f8(INP(I_MOE_W2) + (size_t)e * EFF * D, D, EFF, 128 * kb, n0, nullptr, ws + WS_WM2 + (size_t)e * D * EFF, n0, scr, lane); }
    }
    const int gt = F.vcu * (NWAVES * 64) + tid, NGT = F.G * NWAVES * 64;
    for (int c = gt; c < 96 * D / 16; c += NGT) *((GAS v4u*)(ws + WS_WA + (size_t)(QLORA + KVLORA + ROPE_D) * D) + c) = (v4u){0u, 0u, 0u, 0u};
    for (int c = gt; c < SEQ * 16; c += NGT) { const int pos = c >> 4, i = c & 15;
        const float inv = __builtin_amdgcn_exp2f(-(float)i * (13.287712379549449f / 16.f));
        const float rev = (float)pos * inv * 0.15915494309189535f; const float fr = rev - floorf(rev);
        ((GAS float*)(ws + WS_ROPE))[2 * c] = __builtin_amdgcn_cosf(fr); ((GAS float*)(ws + WS_ROPE))[2 * c + 1] = __builtin_amdgcn_sinf(fr); }
    norm_phase(F, INP(I_X), (bf16*)(ws + WS_XN));
}

__device__ __forceinline__ void route_phase(const Frame& F) {
    const int tid = fresh(F.wave * 64 + lane_id_()), lane = tid & 63;
    unsigned char* ws = WSP;
    LAS float* wrg = (LAS float*)(F.lds + RING_OFF);
    LAS int* cnt = (LAS int*)(F.lds + RING_OFF + 32768);
    const float* wr = INP(I_MOE_ROUTER); const float* g = INP(I_FFN_NORM) + D;
    for (int idx = tid; idx < D * NE; idx += NWAVES * 64) { const int k = idx >> 3, e = idx & 7, l = k >> 4, i = k & 15;
        wrg[((i * 2) + (e >> 2)) * 256 + 4 * l + (e & 3)] = wr[idx] * g[k]; }
    __syncthreads();
    const int b5 = (lane >> 5) & 1, b4 = (lane >> 4) & 1, b3 = (lane >> 3) & 1;
    for (int c = F.vcu; c < M / 256; c += F.G) {
        if (tid < 16) cnt[tid] = 0;
        __syncthreads();
        v4u vn[2];
        { const GAS v4u* xr = (const GAS v4u*)(ws + WS_XR3 + (size_t)(c * 256 + F.wave * 32) * D * 2) + 2 * lane; vn[0] = xr[0]; vn[1] = xr[1]; }
        for (int i = 0; i < 32; ++i) {
            const int m = c * 256 + F.wave * 32 + i;
            const v4u q0 = vn[0], q1 = vn[1];
            if (i + 1 < 32) { const GAS v4u* xr = (const GAS v4u*)(ws + WS_XR3 + (size_t)(m + 1) * D * 2) + 2 * lane; vn[0] = xr[0]; vn[1] = xr[1]; }
            const unsigned qw[8] = {q0.x, q0.y, q0.z, q0.w, q1.x, q1.y, q1.z, q1.w};
            float xv[16]; float ssx = 0.f;
#pragma unroll
            for (int j = 0; j < 8; ++j) { xv[2 * j] = bflo(qw[j]); xv[2 * j + 1] = bfhi(qw[j]); }
#pragma unroll
            for (int j = 0; j < 16; j += 4) ssx += (xv[j] * xv[j] + xv[j + 1] * xv[j + 1]) + (xv[j + 2] * xv[j + 2] + xv[j + 3] * xv[j + 3]);
            float lg[8];
#pragma unroll
            for (int e = 0; e < 8; ++e) lg[e] = 0.f;
#pragma unroll
            for (int j = 0; j < 16; ++j) { const float x1 = xv[j];
                const f32x4 w0 = *(const LAS f32x4*)(wrg + (j * 2) * 256 + 4 * lane), w1 = *(const LAS f32x4*)(wrg + (j * 2 + 1) * 256 + 4 * lane);
                lg[0] += x1 * w0.x; lg[1] += x1 * w0.y; lg[2] += x1 * w0.z; lg[3] += x1 * w0.w; lg[4] += x1 * w1.x; lg[5] += x1 * w1.y; lg[6] += x1 * w1.z; lg[7] += x1 * w1.w; }
            float r4[4], r2[2], r1;
#pragma unroll
            for (int e = 0; e < 4; ++e) { const float mine = b5 ? lg[4 + e] : lg[e], other = b5 ? lg[e] : lg[4 + e]; r4[e] = mine + xor32_partner(other, b5); }
#pragma unroll
            for (int e = 0; e < 2; ++e) { const float mine = b4 ? r4[2 + e] : r4[e], other = b4 ? r4[e] : r4[2 + e]; r2[e] = mine + swz_xor<16>(other); }
            { const float mine = b3 ? r2[1] : r2[0], other = b3 ? r2[0] : r2[1]; r1 = mine + swz_xor<8>(other); }
            r1 += swz_xor<4>(r1); r1 += swz_xor<2>(r1); r1 += swz_xor<1>(r1);
            const float rstd = 1.f / sqrtf(wave_sum(ssx) * (1.f / D) + EPS);
#pragma unroll
            for (int e = 0; e < 8; ++e) lg[e] = __builtin_bit_cast(float, __builtin_amdgcn_readlane(__builtin_bit_cast(int, r1), 8 * e)) * rstd;
            int e1 = 0; float l1 = lg[0];
#pragma unroll
            for (int e = 1; e < 8; ++e) if (lg[e] > l1) { l1 = lg[e]; e1 = e; }
            int e2 = -1; float l2 = -INFINITY;
#pragma unroll
            for (int e = 0; e < 8; ++e) if (e != e1 && lg[e] > l2) { l2 = lg[e]; e2 = e; }
            const float g1 = 1.f / (1.f + __expf(l2 - l1)), g2 = 1.f - g1;
            const int elo = e1 < e2 ? e1 : e2, ehi = e1 < e2 ? e2 : e1;
            const float glo = e1 < e2 ? g1 : g2, ghi = e1 < e2 ? g2 : g1;
            if (lane == 0) { ((GAS float*)(ws + WS_TOKRSTD))[m] = rstd; ((GAS int*)(ws + WS_TOKE))[m] = elo | (ehi << 8); ((GAS float*)(ws + WS_TOKG))[2 * m] = glo; ((GAS float*)(ws + WS_TOKG))[2 * m + 1] = ghi;
                atomicAdd((int*)&cnt[elo], 1); atomicAdd((int*)&cnt[8 + ehi], 1); }
        }
        __syncthreads();
        if (tid < 16) ((GAS int*)(ws + WS_CNT))[c * 16 + tid] = cnt[tid];
        __syncthreads();
    }
}

__device__ __forceinline__ void slot_phase(const Frame& F, unsigned char* ws) {
    const int tid = fresh(F.wave * 64 + lane_id_()), lane = tid & 63; (void)lane;
    LAS int* call = (LAS int*)(F.lds + RING_OFF);
    LAS int* tot = call + 4096; LAS int* base = tot + 16; LAS int* pre = base + 16; LAS int* meta = pre + 16;
    LAS int* grp = meta + 16;
    LAS int* slot_of = grp + 512;
    for (int idx = tid; idx < 4096; idx += NWAVES * 64) call[idx] = ((const GAS int*)(ws + WS_CNT))[idx];
    __syncthreads();
    if (tid < 16) { int t = 0; for (int cc = 0; cc < 256; ++cc) t += call[cc * 16 + tid]; tot[tid] = t; }
    __syncthreads();
    if (tid == 0) { int off = 0; for (int g = 0; g < 16; ++g) { base[g] = off; off += (tot[g] + 255) & ~255; if (g == 7) meta[0] = off >> 8; } meta[1] = (off >> 8) - meta[0]; }
    __syncthreads();
    for (int c = F.vcu; c < M / 256; c += F.G) {
        if (tid < 16) { int p = 0; for (int cc = 0; cc < c; ++cc) p += call[cc * 16 + tid]; pre[tid] = p; }
        const int hf = tid >> 8, i = tid & 255, m = c * 256 + i;
        const int te = ((const GAS int*)(ws + WS_TOKE))[m];
        const int g = hf * 8 + (hf ? ((te >> 8) & 0xff) : (te & 0xff));
        grp[tid] = g;
        __syncthreads();
        int rank = 0;
        for (int j = 0; j < i; ++j) rank += (grp[hf * 256 + j] == g) ? 1 : 0;
        const int slot = base[g] + pre[g] + rank;
        ((GAS int*)(ws + WS_SLOTTOK))[slot] = m; ((GAS float*)(ws + WS_SLOTGATE))[slot] = ((const GAS float*)(ws + WS_TOKG))[2 * m + hf];
        slot_of[tid] = slot;
        __syncthreads();
        for (int i0 = F.wave; i0 < 256; i0 += 4 * NWAVES) {
            v4u x[4][2]; float rs[4];
#pragma unroll
            for (int k = 0; k < 4; ++k) { const int mm = c * 256 + i0 + 8 * k; const GAS v4u* src = (const GAS v4u*)(ws + WS_XR3 + (size_t)mm * D * 2);
                x[k][0] = src[2 * lane]; x[k][1] = src[2 * lane + 1]; rs[k] = ((const GAS float*)(ws + WS_TOKRSTD))[mm]; }
#pragma unroll
            for (int k = 0; k < 4; ++k) { const int i = i0 + 8 * k; const v4u x0 = x[k][0], x1 = x[k][1]; const float r = rs[k];
                const v4u o = (v4u){pk_fp8x4(bflo(x0.x) * r, bfhi(x0.x) * r, bflo(x0.y) * r, bfhi(x0.y) * r), pk_fp8x4(bflo(x0.z) * r, bfhi(x0.z) * r, bflo(x0.w) * r, bfhi(x0.w) * r),
                                    pk_fp8x4(bflo(x1.x) * r, bfhi(x1.x) * r, bflo(x1.y) * r, bfhi(x1.y) * r), pk_fp8x4(bflo(x1.z) * r, bfhi(x1.z) * r, bflo(x1.w) * r, bfhi(x1.w) * r)};
                ((GAS v4u*)(ws + WS_XG + (size_t)slot_of[i] * D))[lane] = o; ((GAS v4u*)(ws + WS_XG + (size_t)slot_of[256 + i] * D))[lane] = o; }
        }
        __syncthreads();
    }
    for (int g = F.vcu; g < 16; g += F.G) {
        const int s0 = base[g] + tot[g], s1 = base[g] + ((tot[g] + 255) & ~255);
        for (int s = s0 + F.wave; s < s1; s += NWAVES) { GAS v4u* dst = (GAS v4u*)(ws + WS_XG + (size_t)s * D);
            dst[lane] = (v4u){0u, 0u, 0u, 0u};
            if (lane == 0) { ((GAS int*)(ws + WS_SLOTTOK))[s] = -1; ((GAS float*)(ws + WS_SLOTGATE))[s] = 0.f; } }
    }
    if (F.vcu == 0) {
        if (tid < 16) { const int p0 = base[tid] >> 8, p1 = (base[tid] + ((tot[tid] + 255) & ~255)) >> 8; for (int p = p0; p < p1; ++p) ((GAS int*)(ws + WS_PANELE))[p] = tid & 7; }
        if (tid == 0) { ((GAS int*)(ws + WS_META))[0] = meta[0]; ((GAS int*)(ws + WS_META))[1] = meta[1]; }
        if (tid < 16) ((GAS int*)(ws + WS_META))[2 + tid] = base[tid] >> 8;
    }
    __syncthreads();
}

__global__ void __launch_bounds__(NWAVES * 64, 2) yoco_fwd(Args args) {
    extern __shared__ __attribute__((aligned(16))) unsigned char lds_raw[];
    Frame F;
    F.lds = (LAS unsigned char*)lds_raw;
    F.wave = __builtin_amdgcn_readfirstlane((int)threadIdx.x >> 6);
    F.G = gridDim.x; { const int bx = blockIdx.x; F.vcu = (F.G % 8 == 0) ? (bx % 8) * (F.G / 8) + bx / 8 : bx; }
    unsigned char* ws = WSP;
    volatile LAS unsigned* MISC = (volatile LAS unsigned*)(F.lds + MISC_OFF);
    for (int u = fresh((int)threadIdx.x); u < (LDS_BYTES - LDSCTL_OFF) / 4; u += NWAVES * 64) ((LAS unsigned*)(F.lds + LDSCTL_OFF))[u] = 0u;
    __syncthreads();
    (void)xcd_barrier_post((unsigned*)(ws + WS_CTL) + CW_BAR, MISC + 8, (F.wave == 0 && lane_id_() == 0) ? 1 : 0);
    LAS unsigned char* ring = F.lds + RING_OFF;
#define bid ((int)blockIdx.x)
#define GRID_BAR() do { XcdBarrier b_; b_.t0 = (F.wave == 0 && lane_id_() == 0) ? 1 : 0; b_.bar = (unsigned*)(WSP + WS_CTL) + CW_BAR; b_.x = xb_xcc_id(); b_.st = (volatile LAS unsigned*)(F.lds + MISC_OFF) + 8; xcd_barrier(b_); } while (0)
#define GEMM(EpiT, SchedT) pg8::gemm_phase<EpiT, SchedT, true, true>

    p0_prologue(F);
    GRID_BAR();
    { pg8::Gemm g{(const bf16*)(ws + WS_XN), (const bf16*)(ws + WS_WA), M, NA, D / 2, D / 2}; pg8::StaticOrder S; S.init(M, NA, F.G, bid);
      pg8::EpiQA E{(bf16*)(ws + WS_QA), (float*)(ws + WS_PARTQA), 1.f / 64};
      pg8::gemm_phase<pg8::EpiQA, pg8::StaticOrder, true, true, true>(ring, g, S, E, F.wave); }
    GRID_BAR();
    { pg8::Gemm g{(const bf16*)(ws + WS_QA), (const bf16*)(ws + WS_WUQ), M, NH * QKD, QLORA, NA}; pg8::StaticOrder S; S.init(M, NH * QKD, F.G, bid);
      pg8::EpiRowScaleBf16 E{(bf16*)(ws + WS_Q), NH * QKD, (const float*)(ws + WS_PARTQA), 1.f / QLORA};
      GEMM(pg8::EpiRowScaleBf16, pg8::StaticOrder)(ring, g, S, E, F.wave); }
    { pg8::Gemm g{(const bf16*)(ws + WS_QA) + QLORA, (const bf16*)(ws + WS_WUKV), M, NH * 128, KVLORA, NA}; pg8::StaticOrder S; S.init(M, NH * 128, F.G, bid);
      pg8::EpiKVup E{(bf16*)(ws + WS_K), (bf16*)(ws + WS_V), (const float*)(ws + WS_PARTQA), (const bf16*)(ws + WS_QA), INP(I_A_GKN), (const float*)(ws + WS_ROPE)};
      GEMM(pg8::EpiKVup, pg8::StaticOrder)(ring, g, S, E, F.wave); }
    GRID_BAR();
    for (int p = F.vcu; p < BATCH * NH * 4; p += F.G) {
        const int bh = p >> 2, pid = p & 3, b = bh >> 4, h = bh & 15;
        for (int u2 = 0; u2 < 2; ++u2) {
            const int qb = u2 ? 7 - pid : pid;
            att::attn_unit<96, false, 1536, 1536, D, D, true>(ring, (const bf16*)(ws + WS_Q) + (size_t)b * SEQ * 1536 + h * QKD, (const bf16*)(ws + WS_K) + (size_t)b * SEQ * 1536 + h * QKD,
                                      (const bf16*)(ws + WS_V) + (size_t)b * SEQ * D + h * 64, (bf16*)(ws + WS_O + (size_t)b * SEQ * D + h * 64),
                                      256 * qb, 0, 4 * qb + 3, 0, 4 * qb + (F.wave >> 1), 0, nullptr, INP(I_A_GQN), (const float*)(ws + WS_ROPE), F.wave);
        }
    }
    GRID_BAR();
    { pg8::Gemm g{(const bf16*)(ws + WS_O), (const bf16*)(ws + WS_WO), M, D, D / 2, D / 2}; pg8::StaticOrder S; S.init(M, D, F.G, bid);
      pg8::EpiResStream<true, false, false> E{INP(I_X), (bf16*)(ws + WS_XR1), nullptr, (float*)(ws + WS_PART1), 1.f / 2048, nullptr};
      pg8::gemm_phase<pg8::EpiResStream<true, false, false>, pg8::StaticOrder, true, true, true>(ring, g, S, E, F.wave); }
    GRID_BAR();
    { pg8::Gemm g{(const bf16*)(ws + WS_XR1), (const bf16*)(ws + WS_WF1), M, 2 * FF, D, D}; pg8::StaticOrder S; S.init(M, 2 * FF, F.G, bid);
      pg8::EpiGated<true> E{(bf16*)(ws + WS_H), FF, 0, (const float*)(ws + WS_PART1)};
      GEMM(pg8::EpiGated<true>, pg8::StaticOrder)(ring, g, S, E, F.wave); }
    GRID_BAR();
    { pg8::Gemm g{(const bf16*)(ws + WS_H), (const bf16*)(ws + WS_WF2), M, D, FF, FF}; pg8::StaticOrder S; S.init(M, D, F.G, bid);
      pg8::EpiResStream<true, true, true> E{ws + WS_XR1, (bf16*)(ws + WS_X2B), ws + WS_XR2, (float*)(ws + WS_PART2), 1.f, nullptr};
      pg8::gemm_phase<pg8::EpiResStream<true, true, true>, pg8::StaticOrder, true, true>(ring, g, S, E, F.wave); }
    GRID_BAR();
    { pg8::Gemm g{(const bf16*)(ws + WS_XR2), (const bf16*)(ws + WS_WKVQ), M, 2 * D, D / 2, D / 2}; pg8::StaticOrder S; S.init(M, 2 * D, F.G, bid);
      pg8::EpiK2Q2 E{(bf16*)(ws + WS_KVQ2), (const float*)(ws + WS_PART2), INP(I_KV_GKN), INP(I_B_GQN), 1.f / 64};
      pg8::gemm_phase<pg8::EpiK2Q2, pg8::StaticOrder, true, true, true>(ring, g, S, E, F.wave); }
    { pg8::Gemm g{(const bf16*)(ws + WS_XR2), (const bf16*)(ws + WS_WKVQ + (size_t)2 * D * D), M, D, D / 2, D / 2}; pg8::StaticOrder S; S.init(M, D, F.G, bid);
      pg8::EpiRowScale16 E{(bf16*)(ws + WS_KVQ2), 3 * D, D, (const float*)(ws + WS_PART2), 1.f / 64};
      pg8::gemm_phase<pg8::EpiRowScale16, pg8::StaticOrder, true, true, true>(ring, g, S, E, F.wave); }
    GRID_BAR();
    for (int p = F.vcu; p < BATCH * NH * 8; p += F.G) {
        const int bh = p >> 3, cb = ((p & 7) + (p >> 8)) & 7, b = bh >> 4, h = bh & 15;
        const int c0 = 4 * cb, cc = c0 + (F.wave >> 1);
        const bf16* base = (const bf16*)(ws + WS_KVQ2) + (size_t)b * SEQ * 3072 + h * 64;
        att::attn_unit<64, true, 3072, 3072, 3072, D, true>(ring, base + 2048, base, base + 1024, (bf16*)(ws + WS_O2 + (size_t)b * SEQ * D + h * 64),
                                 256 * cb, c0 - 8 < 0 ? 0 : c0 - 8, c0 + 3, cc - 8 < 0 ? 0 : cc - 8, cc, cc, INP(I_B_RELB) + h * 257, nullptr, nullptr, F.wave);
    }
    GRID_BAR();
    { pg8::Gemm g{(const bf16*)(ws + WS_O2), (const bf16*)(ws + WS_WBO), M, D, D / 2, D / 2}; pg8::StaticOrder S; S.init(M, D, F.G, bid);
      pg8::EpiResStream<false, false, true> E{ws + WS_X2B, (bf16*)(ws + WS_XR3), nullptr, nullptr, 1.f / 2048, nullptr};
      pg8::gemm_phase<pg8::EpiResStream<false, false, true>, pg8::StaticOrder, true, true, true>(ring, g, S, E, F.wave); }
    GRID_BAR();
    { const int tid_ = fresh(F.wave * 64 + lane_id_()); unsigned char* w3 = WSP; float* o3 = OUTP;
      for (size_t i = (size_t)F.vcu * 512 + tid_; i < (size_t)M * D / 8; i += (size_t)F.G * 512) { const v4u q = ((const GAS v4u*)(w3 + WS_XR3))[i];
          ((f32x4*)o3)[2 * i] = (f32x4){bflo(q.x), bfhi(q.x), bflo(q.y), bfhi(q.y)}; ((f32x4*)o3)[2 * i + 1] = (f32x4){bflo(q.z), bfhi(q.z), bflo(q.w), bfhi(q.w)}; } }
    GRID_BAR();
    route_phase(F);
    GRID_BAR();
    slot_phase(F, ws);
    GRID_BAR();
#define MOE_LOAD(hf_) unsigned char* w2 = WSP; \
          const int nPA = __builtin_amdgcn_readfirstlane(((const GAS int*)(w2 + WS_META))[0]), nPB = __builtin_amdgcn_readfirstlane(((const GAS int*)(w2 + WS_META))[1]); (void)nPB; \
          const int p0 = (hf_) ? nPA : 0; int pbk[7]; \
          _Pragma("unroll") for (int k = 0; k < 7; ++k) pbk[k] = __builtin_amdgcn_readfirstlane(((const GAS int*)(w2 + WS_META))[2 + (hf_) * 8 + 1 + k]) - p0;
    constexpr size_t HMB_OFF = (size_t)MAXP_HALF * 256 * EFF;
    { MOE_LOAD(0)
      pg8::Gemm g{(const bf16*)(w2 + WS_XG), (const bf16*)(w2 + WS_WM1), nPA * 256, 2 * EFF, D / 2, D / 2};
      pg8::MoeOrder S; S.init(nPA, 2 * EFF / 256, F.G, bid);
#pragma unroll
      for (int k = 0; k < 7; ++k) S.pb[k] = pbk[k];
      pg8::EpiGatedF8 E{w2 + WS_HM, EFF, 2 * EFF / 256};
      pg8::gemm_phase<pg8::EpiGatedF8, pg8::MoeOrder, true, true, true>(ring, g, S, E, F.wave); }
    GRID_BAR();
    { MOE_LOAD(0)
      pg8::Gemm g{(const bf16*)(w2 + WS_HM), (const bf16*)(w2 + WS_WM2), 256 * 256, D, EFF / 2, EFF / 2};
      pg8::MoeOrder S; S.init(256, D / 256, F.G, bid);
#pragma unroll
      for (int k = 0; k < 7; ++k) S.pb[k] = pbk[k];
      pg8::EpiMoeDown<false> E{OUTP, nullptr, (const int*)(w2 + WS_SLOTTOK), (const float*)(w2 + WS_SLOTGATE), 0, D, 1.f / 64};
      pg8::gemm_phase<pg8::EpiMoeDown<false>, pg8::MoeOrder, true, true, true>(ring, g, S, E, F.wave); }
    GRID_BAR();
    { MOE_LOAD(0)
      pg8::Gemm g{(const bf16*)(w2 + WS_HM), (const bf16*)(w2 + WS_WM2), nPA * 256, D, EFF / 2, EFF / 2};
      pg8::LeftOrder S; S.M.init(nPA, D / 256, F.G, bid); S.nLeft = 4 * (nPA - 256);
#pragma unroll
      for (int k = 0; k < 7; ++k) S.M.pb[k] = pbk[k];
      pg8::EpiMoeDown<false> E{OUTP, nullptr, (const int*)(w2 + WS_SLOTTOK), (const float*)(w2 + WS_SLOTGATE), 0, D, 1.f / 64};
      pg8::gemm_phase<pg8::EpiMoeDown<false>, pg8::LeftOrder, true, true, true>(ring, g, S, E, F.wave); }
    { MOE_LOAD(1)
      pg8::Gemm g{(const bf16*)(w2 + WS_XG + (size_t)p0 * 256 * D), (const bf16*)(w2 + WS_WM1), nPB * 256, 2 * EFF, D / 2, D / 2};
      pg8::MoeOrder S; S.init(nPB, 2 * EFF / 256, F.G, bid); S.nBusy = 4 * (nPA - 256); S.SK = 4;
#pragma unroll
      for (int k = 0; k < 7; ++k) S.pb[k] = pbk[k];
      pg8::EpiGatedF8 E{w2 + WS_HM + HMB_OFF, EFF, 2 * EFF / 256};
      pg8::gemm_phase<pg8::EpiGatedF8, pg8::MoeOrder, true, true, true>(ring, g, S, E, F.wave); }
    GRID_BAR();
    { MOE_LOAD(1)
      pg8::Gemm g{(const bf16*)(w2 + WS_HM + HMB_OFF), (const bf16*)(w2 + WS_WM2), nPB * 256, D, EFF / 2, EFF / 2};
      pg8::MoeOrder S; S.init(nPB, D / 256, F.G, bid);
#pragma unroll
      for (int k = 0; k < 7; ++k) S.pb[k] = pbk[k];
      pg8::EpiMoeDown<false> E{OUTP, nullptr, (const int*)(w2 + WS_SLOTTOK), (const float*)(w2 + WS_SLOTGATE), p0 * 256, D, 1.f / 64};
      pg8::gemm_phase<pg8::EpiMoeDown<false>, pg8::MoeOrder, true, true, true>(ring, g, S, E, F.wave); }
#undef MOE_LOAD
#undef GRID_BAR
#undef bid
#undef GEMM
}

extern "C" void kernel_launch(void* const* d_in, const int* in_sizes, int n_in, void* d_out, int out_size, void* d_ws, size_t ws_size, hipStream_t stream) {
    static int grid = 0;
    if (grid == 0) {
        if (n_in != 27 || in_sizes[0] != M * D || out_size != M * D || ws_size < WS_END) { fprintf(stderr, "kernel_launch: unexpected shapes (n_in %d, in0 %d, out %d, ws %zu < %zu); nothing launched\n", n_in, n_in > 0 ? in_sizes[0] : -1, out_size, ws_size, (size_t)WS_END); grid = -1; return; }
        int dev = 0, cus = 0, per_cu = 0;
        if (hipGetDevice(&dev) != hipSuccess || hipDeviceGetAttribute(&cus, hipDeviceAttributeMultiprocessorCount, dev) != hipSuccess) { grid = -1; return; }
        if (hipFuncSetAttribute((const void*)yoco_fwd, hipFuncAttributeMaxDynamicSharedMemorySize, LDS_BYTES) != hipSuccess) { fprintf(stderr, "kernel_launch: hipFuncSetAttribute failed\n"); grid = -1; return; }
        if (hipOccupancyMaxActiveBlocksPerMultiprocessor(&per_cu, (const void*)yoco_fwd, NWAVES * 64, LDS_BYTES) != hipSuccess || per_cu < 1) { fprintf(stderr, "kernel_launch: occupancy query says %d\n", per_cu); }
        (void)hipGetLastError();
        grid = cus;
    }
    if (grid < 0) return;
    if (hipMemsetAsync((char*)d_ws + WS_CTL, 0, CTL_ZERO_BYTES, stream) != hipSuccess) return;
    Args a{};
    for (int i = 0; i < 27; ++i) a.in[i] = (const float*)d_in[i];
    a.out = (float*)d_out; a.ws = (unsigned char*)d_ws;
    hipLaunchKernelGGL(yoco_fwd, dim3(grid), dim3(NWAVES * 64), LDS_BYTES, stream, a);
}
```

```cpp
#include <hip/hip_runtime.h>
#include <cstdio>
#include <cstdint>
__device__ __forceinline__ int lane_id_() { unsigned m_ = ~0u; asm volatile("" : "+s"(m_)); return (int)__builtin_amdgcn_mbcnt_hi(m_, __builtin_amdgcn_mbcnt_lo(m_, 0u)); }
template <int X> __device__ __forceinline__ float swz_xor(float v) { return __builtin_bit_cast(float, __builtin_amdgcn_ds_swizzle(__builtin_bit_cast(int, v), (X << 10) | 0x1f)); }
__device__ __forceinline__ void halves32(float v, float& r_lo, float& r_hi) { unsigned a_ = __builtin_bit_cast(unsigned, v), b_ = a_;
    asm volatile("s_nop 1\n\tv_permlane32_swap_b32 %0, %1\n\ts_nop 1" : "+v"(a_), "+v"(b_)); r_lo = __builtin_bit_cast(float, a_); r_hi = __builtin_bit_cast(float, b_); }
__device__ __forceinline__ float xor32_partner(float v, int upper_half) { float lo, hi; halves32(v, lo, hi); return upper_half ? lo : hi; }
__device__ __forceinline__ float xor32_sum(float v) { float lo, hi; halves32(v, lo, hi); return lo + hi; }
__device__ __forceinline__ float xor32_max(float v) { float lo, hi; halves32(v, lo, hi); return fmaxf(lo, hi); }
namespace pg8 {
#define PG8_LAS __attribute__((address_space(3)))
typedef unsigned short bf16_t;
typedef short bf16x8 __attribute__((ext_vector_type(8)));
typedef float f32x4 __attribute__((ext_vector_type(4)));
typedef unsigned u32x4 __attribute__((ext_vector_type(4)));
constexpr int BM = 256, BK = 64, HALF = 128, HTB = HALF * BK * 2  , STAGE_BYTES = 8 * HTB, NXCD = 8, WGM = 8;

__host__ __device__ __forceinline__ int lds_byte(int r, int c) { const int st = (r >> 4) * 2 + (c >> 5), rr = r & 15, cc = c & 31, ob = rr * 64 + cc * 2; return st * 1024 + (ob ^ (((ob >> 9) & 1) << 5)); }
__host__ __device__ __forceinline__ void stage_rc(int b, int& R, int& C) { const int st = b / 1024, sb = b % 1024, swz = sb ^ (((sb >> 9) & 1) << 5); R = (st >> 1) * 16 + swz / 64; C = (st & 1) * 32 + (swz % 64) / 2; }
__host__ __device__ __forceinline__ int perm32(int rho) { const int n = rho >> 4, i = rho & 15; return 8 * (i >> 2) + 4 * n + (i & 3); }

struct Unit { int pm, pn; };
struct Gemm { const bf16_t* A; const bf16_t* Bt; int M, N, K, lda; };

struct StaticOrder {
    int nM, nN, nwg, G, c;
    __host__ __device__ void init(int M, int N, int G_, int c_) { nM = M / BM; nN = N / BM; nwg = nM * nN; G = G_; c = c_; }
    __host__ __device__ bool next(int i, Unit& u) const {
        const int L = i * G + c; if (L >= nwg) return false;
        int wgid = L; { const int q = nwg / NXCD, r = nwg % NXCD, xcd = wgid % NXCD, off = wgid / NXCD; wgid = (xcd < r ? xcd * (q + 1) : r * (q + 1) + (xcd - r) * q) + off; }
        const int nig = WGM * nN, gid = wgid / nig, fm = gid * WGM, gsz = (nM - fm) < WGM ? (nM - fm) : WGM;
        u.pm = fm + ((wgid % nig) % gsz); u.pn = (wgid % nig) / gsz; return true;
    }
    __device__ __forceinline__ void a_ready(const Unit&) const {}
    __device__ __forceinline__ void done(const Unit&) const {}
};
__device__ __forceinline__ unsigned cvt_pk_bf16(float lo, float hi) { unsigned r; asm volatile("v_cvt_pk_bf16_f32 %0, %1, %2" : "=v"(r) : "v"(lo), "v"(hi)); return r; }
__device__ __forceinline__ float silu_f(float x) { const float e = __builtin_amdgcn_exp2f(x * -1.4426950408889634f); return x * __builtin_amdgcn_rcpf(1.f + e); }

__device__ __forceinline__ float sum4(const f32x4& a) { return (a[0] + a[1]) + (a[2] + a[3]); }
__device__ __forceinline__ float part_sum8(const float* p) { return sum4(*(const f32x4*)p) + sum4(*(const f32x4*)(p + 4)); }
__device__ __forceinline__ float part_sum16(const float* p) { return (sum4(*(const f32x4*)p) + sum4(*(const f32x4*)(p + 4))) + (sum4(*(const f32x4*)(p + 8)) + sum4(*(const f32x4*)(p + 12))); }
__device__ __forceinline__ float fq_sum(float v) { v += swz_xor<16>(v); return xor32_sum(v); }
__device__ __forceinline__ float sq8(const f32x4& a, const f32x4& b) { return ((a[0] * a[0] + a[1] * a[1]) + (a[2] * a[2] + a[3] * a[3])) + ((b[0] * b[0] + b[1] * b[1]) + (b[2] * b[2] + b[3] * b[3])); }
__device__ __forceinline__ u32x4 pack8(const f32x4& a, const f32x4& b) { u32x4 w; w.x = cvt_pk_bf16(a[0], a[1]); w.y = cvt_pk_bf16(a[2], a[3]); w.z = cvt_pk_bf16(b[0], b[1]); w.w = cvt_pk_bf16(b[2], b[3]); return w; }
constexpr float EPS_ = 1e-6f;
__device__ __forceinline__ unsigned pk_fp8x4(float a, float b, float c, float d) { int w = 0; w = __builtin_amdgcn_cvt_pk_fp8_f32(a, b, w, false); w = __builtin_amdgcn_cvt_pk_fp8_f32(c, d, w, true); return (unsigned)w; }

struct EpiQA {
    static constexpr bool PERM = true, AFTER_DRAIN = false;
    bf16_t* O; float* part; float wscale;
    __device__ __forceinline__ void operator()(const f32x4 (&acc)[2][2][4][2], const Unit& u, int wr, int wc, int fr, int fq) const {
        { int t_ = lane_id_(); asm volatile("" : "+v"(t_)); fr = t_ & 15; fq = (t_ >> 4) & 3; }
        const int row0 = u.pm * BM + wr * 64 + fr, col0 = u.pn * BM + wc * 32 + 8 * fq;
#pragma unroll
        for (int ai = 0; ai < 2; ++ai)
#pragma unroll
            for (int m = 0; m < 4; ++m) { const int row = row0 + ai * HALF + m * 16; bf16_t* rowp = O + (size_t)row * 768 + col0;
                const f32x4 a0 = acc[ai][0][m][0] * wscale, a1 = acc[ai][0][m][1] * wscale, b0 = acc[ai][1][m][0] * wscale, b1 = acc[ai][1][m][1] * wscale;
                *(u32x4*)(rowp) = pack8(a0, a1); *(u32x4*)(rowp + HALF) = pack8(b0, b1);
                const float s0 = sq8(a0, a1), s1 = sq8(b0, b1);
                float* pr = part + (size_t)row * 16;
                if (u.pn == 0) { const float t = fq_sum(s0 + s1); if (fq == 0) pr[wc] = t; }
                else if (u.pn == 1) { const float t0 = fq_sum(s0), t1 = fq_sum(s1); if (fq == 0) { pr[4 + wc] = t0; pr[8 + wc] = t1; } }
                else { const float t = fq_sum(s0); if (fq == 0) pr[12 + wc] = t; } }
    }
};

struct EpiRowScaleBf16 {
    static constexpr bool PERM = true, AFTER_DRAIN = false;
    bf16_t* O; int ldc; const float* part; float inv_n;
    __device__ __forceinline__ void operator()(const f32x4 (&acc)[2][2][4][2], const Unit& u, int wr, int wc, int fr, int fq) const {
        { int t_ = lane_id_(); asm volatile("" : "+v"(t_)); fr = t_ & 15; fq = (t_ >> 4) & 3; }
        const int row0 = u.pm * BM + wr * 64 + fr, col0 = u.pn * BM + wc * 32 + 8 * fq;
#pragma unroll
        for (int ai = 0; ai < 2; ++ai)
#pragma unroll
            for (int m = 0; m < 4; ++m) { const int row = row0 + ai * HALF + m * 16; bf16_t* rowp = O + (size_t)row * ldc + col0;
                const float rs = __builtin_amdgcn_rsqf(part_sum8(part + (size_t)row * 16) * inv_n + EPS_);
                *(u32x4*)(rowp) = pack8(acc[ai][0][m][0] * rs, acc[ai][0][m][1] * rs); *(u32x4*)(rowp + HALF) = pack8(acc[ai][1][m][0] * rs, acc[ai][1][m][1] * rs); }
    }
};

struct EpiKVup {
    static constexpr bool PERM = true, AFTER_DRAIN = false;
    bf16_t* Kd; bf16_t* Vd; const float* part; const bf16_t* QA; const float* g_kn; const float* rope;
    __device__ __forceinline__ void operator()(const f32x4 (&acc)[2][2][4][2], const Unit& u, int wr, int wc, int fr, int fq) const {
        { int t_ = lane_id_(); asm volatile("" : "+v"(t_)); fr = t_ & 15; fq = (t_ >> 4) & 3; }
        const int row0 = u.pm * BM + wr * 64 + fr;
        if (u.pn >= 4) {
            const int col0 = (u.pn - 4) * BM + wc * 32 + 8 * fq;
#pragma unroll
            for (int ai = 0; ai < 2; ++ai)
#pragma unroll
                for (int m = 0; m < 4; ++m) { const int row = row0 + ai * HALF + m * 16; bf16_t* rowp = Vd + (size_t)row * 1024 + col0;
                    const float rs = __builtin_amdgcn_rsqf(part_sum8(part + (size_t)row * 16 + 8) * (1.f / 256) + EPS_);
                    *(u32x4*)(rowp) = pack8(acc[ai][0][m][0] * rs, acc[ai][0][m][1] * rs); *(u32x4*)(rowp + HALF) = pack8(acc[ai][1][m][0] * rs, acc[ai][1][m][1] * rs); }
            return;
        }
        const int head = 4 * u.pn + wc;
        f32x4 gA0 = *(const f32x4*)(g_kn + 8 * fq), gA1 = *(const f32x4*)(g_kn + 8 * fq + 4), gB0 = *(const f32x4*)(g_kn + 32 + 8 * fq), gB1 = *(const f32x4*)(g_kn + 32 + 8 * fq + 4);
        const f32x4 gR1 = *(const f32x4*)(g_kn + 64 + 4 * fq), gR2 = *(const f32x4*)(g_kn + 80 + 4 * fq);
#pragma unroll
        for (int ai = 0; ai < 2; ++ai)
#pragma unroll
            for (int m = 0; m < 4; ++m) { const int row = row0 + ai * HALF + m * 16;
                const float rs = __builtin_amdgcn_rsqf(part_sum8(part + (size_t)row * 16 + 8) * (1.f / 256) + EPS_);
                f32x4 a0 = acc[ai][0][m][0] * rs, a1 = acc[ai][0][m][1] * rs, b0 = acc[ai][1][m][0] * rs, b1 = acc[ai][1][m][1] * rs;
                const unsigned long long p1 = *(const unsigned long long*)(QA + (size_t)row * 768 + 640 + 4 * fq), p2 = *(const unsigned long long*)(QA + (size_t)row * 768 + 656 + 4 * fq);
                f32x4 x1, x2;
                x1[0] = __builtin_bit_cast(float, (unsigned)(p1 << 16)); x1[1] = __builtin_bit_cast(float, (unsigned)p1 & 0xffff0000u);
                x1[2] = __builtin_bit_cast(float, (unsigned)(p1 >> 32) << 16); x1[3] = __builtin_bit_cast(float, (unsigned)(p1 >> 32) & 0xffff0000u);
                x2[0] = __builtin_bit_cast(float, (unsigned)(p2 << 16)); x2[1] = __builtin_bit_cast(float, (unsigned)p2 & 0xffff0000u);
                x2[2] = __builtin_bit_cast(float, (unsigned)(p2 >> 32) << 16); x2[3] = __builtin_bit_cast(float, (unsigned)(p2 >> 32) & 0xffff0000u);
                const float ss = fq_sum(sq8(a0, a1) + sq8(b0, b1) + sq8(x1, x2));
                const float sh = __builtin_amdgcn_rsqf(ss * (1.f / 96) + EPS_);
                bf16_t* kp = Kd + (size_t)row * 1536 + head * 96;
                *(u32x4*)(kp + 8 * fq) = pack8(a0 * gA0 * sh, a1 * gA1 * sh); *(u32x4*)(kp + 32 + 8 * fq) = pack8(b0 * gB0 * sh, b1 * gB1 * sh);
                const f32x4* rp = (const f32x4*)(rope + ((size_t)(row & 2047) * 16 + 4 * fq) * 2);
                const f32x4 c01 = rp[0], c23 = rp[1];
                const f32x4 y1 = x1 * gR1 * sh, y2 = x2 * gR2 * sh;
                f32x4 o1, o2;
                o1[0] = y1[0] * c01[0] - y2[0] * c01[1]; o2[0] = y2[0] * c01[0] + y1[0] * c01[1];
                o1[1] = y1[1] * c01[2] - y2[1] * c01[3]; o2[1] = y2[1] * c01[2] + y1[1] * c01[3];
                o1[2] = y1[2] * c23[0] - y2[2] * c23[1]; o2[2] = y2[2] * c23[0] + y1[2] * c23[1];
                o1[3] = y1[3] * c23[2] - y2[3] * c23[3]; o2[3] = y2[3] * c23[2] + y1[3] * c23[3];
                unsigned long long w1 = (unsigned long long)cvt_pk_bf16(o1[0], o1[1]) | ((unsigned long long)cvt_pk_bf16(o1[2], o1[3]) << 32);
                unsigned long long w2 = (unsigned long long)cvt_pk_bf16(o2[0], o2[1]) | ((unsigned long long)cvt_pk_bf16(o2[2], o2[3]) << 32);
                *(unsigned long long*)(kp + 64 + 4 * fq) = w1; *(unsigned long long*)(kp + 80 + 4 * fq) = w2; }
    }
};

struct EpiK2Q2 {
    static constexpr bool PERM = true, AFTER_DRAIN = false;
    bf16_t* O; const float* pss; const float* gk; const float* gq; float wscale;
    __device__ __forceinline__ void operator()(const f32x4 (&acc)[2][2][4][2], const Unit& u, int wr, int wc, int fr, int fq) const {
        { int t_ = lane_id_(); asm volatile("" : "+v"(t_)); fr = t_ & 15; fq = (t_ >> 4) & 3; }
        const int row0 = u.pm * BM + wr * 64 + fr, isq = u.pn >> 2, tl = u.pn & 3;
        const float* g = isq ? gq : gk; const float post = isq ? 0.125f * 1.4426950408889634f : 1.f;
        const f32x4 gA0 = *(const f32x4*)(g + 8 * fq) * post, gA1 = *(const f32x4*)(g + 8 * fq + 4) * post, gB0 = *(const f32x4*)(g + 32 + 8 * fq) * post, gB1 = *(const f32x4*)(g + 32 + 8 * fq + 4) * post;
        const int colh = isq * 2048 + (4 * tl + wc) * 64;
        unsigned zhi_ = 0u; asm volatile("" : "+v"(zhi_));
        const unsigned long long coff = ((unsigned long long)zhi_ << 32) | (unsigned)((colh + 8 * fq) * 2);
#pragma unroll
        for (int ai = 0; ai < 2; ++ai)
#pragma unroll
            for (int m = 0; m < 4; ++m) { const int row = row0 + ai * HALF + m * 16; unsigned char* rowp = (unsigned char*)O + (size_t)row * 6144 + coff;
                const float rs = __builtin_amdgcn_rsqf(part_sum16(pss + (size_t)row * 16) * (1.f / 1024) + EPS_) * wscale;
                const f32x4 a0 = acc[ai][0][m][0] * rs, a1 = acc[ai][0][m][1] * rs, b0 = acc[ai][1][m][0] * rs, b1 = acc[ai][1][m][1] * rs;
                const float ss = fq_sum(sq8(a0, a1) + sq8(b0, b1));
                const float sh = __builtin_amdgcn_rsqf(ss * (1.f / 64) + EPS_);
                *(u32x4*)(rowp) = pack8(a0 * gA0 * sh, a1 * gA1 * sh); *(u32x4*)(rowp + 64) = pack8(b0 * gB0 * sh, b1 * gB1 * sh); }
    }
};
struct EpiRowScale16 {
    static constexpr bool PERM = true, AFTER_DRAIN = false;
    bf16_t* O; int ldc; int coff; const float* pss; float wscale;
    __device__ __forceinline__ void operator()(const f32x4 (&acc)[2][2][4][2], const Unit& u, int wr, int wc, int fr, int fq) const {
        { int t_ = lane_id_(); asm volatile("" : "+v"(t_)); fr = t_ & 15; fq = (t_ >> 4) & 3; }
        const int row0 = u.pm * BM + wr * 64 + fr, col0 = coff + u.pn * BM + wc * 32 + 8 * fq;
#pragma unroll
        for (int ai = 0; ai < 2; ++ai)
#pragma unroll
            for (int m = 0; m < 4; ++m) { const int row = row0 + ai * HALF + m * 16; bf16_t* rowp = O + (size_t)row * ldc + col0;
                const float rs = __builtin_amdgcn_rsqf(part_sum16(pss + (size_t)row * 16) * (1.f / 1024) + EPS_) * wscale;
                *(u32x4*)(rowp) = pack8(acc[ai][0][m][0] * rs, acc[ai][0][m][1] * rs); *(u32x4*)(rowp + HALF) = pack8(acc[ai][1][m][0] * rs, acc[ai][1][m][1] * rs); }
    }
};

template <bool SSQ> struct EpiGated {
    static constexpr bool PERM = true, AFTER_DRAIN = false;
    bf16_t* Hd; int ldc; int ntile; const float* rs;
    __device__ __forceinline__ void operator()(const f32x4 (&acc)[2][2][4][2], const Unit& u, int wr, int wc, int fr, int fq) const {
        { int t_ = lane_id_(); asm volatile("" : "+v"(t_)); fr = t_ & 15; fq = (t_ >> 4) & 3; }
        const int pnl = ntile ? (u.pn % ntile) : u.pn;
        const int row0 = u.pm * BM + wr * 64 + fr, col0 = pnl * HALF + wc * 32 + 8 * fq;
#pragma unroll
        for (int ai = 0; ai < 2; ++ai)
#pragma unroll
            for (int m = 0; m < 4; ++m) { const int row = row0 + ai * HALF + m * 16; bf16_t* rowp = Hd + (size_t)row * ldc + col0;
                const float r = SSQ ? __builtin_amdgcn_rsqf(part_sum16(rs + (size_t)row * 16) * (1.f / 1024) + EPS_) : rs[row];
                const f32x4 g0 = acc[ai][0][m][0] * r, g1 = acc[ai][0][m][1] * r, u0 = acc[ai][1][m][0] * r, u1 = acc[ai][1][m][1] * r;
                u32x4 w;
                w.x = cvt_pk_bf16(silu_f(g0[0]) * u0[0], silu_f(g0[1]) * u0[1]); w.y = cvt_pk_bf16(silu_f(g0[2]) * u0[2], silu_f(g0[3]) * u0[3]);
                w.z = cvt_pk_bf16(silu_f(g1[0]) * u1[0], silu_f(g1[1]) * u1[1]); w.w = cvt_pk_bf16(silu_f(g1[2]) * u1[2], silu_f(g1[3]) * u1[3]);
                *(u32x4*)rowp = w; }
    }
};

struct EpiGatedF8 {
    static constexpr bool PERM = true, AFTER_DRAIN = false;
    unsigned char* Hd; int ldc; int ntile;
    static __device__ __forceinline__ float gate(float g, float u) {
        const float e = __builtin_amdgcn_exp2f(g * (-1.4426950408889634f / 64.f)); return (g * u) * (__builtin_amdgcn_rcpf(1.f + e) * (1.f / 4096.f)); }
    __device__ __forceinline__ void operator()(const f32x4 (&acc)[2][2][4][2], const Unit& u, int wr, int wc, int fr, int fq) const {
        { int t_ = lane_id_(); asm volatile("" : "+v"(t_)); fr = t_ & 15; fq = (t_ >> 4) & 3; }
        const int pnl = u.pn % ntile;
        const int row0 = u.pm * BM + wr * 64 + fr, col0 = pnl * HALF + wc * 32 + 8 * fq;
#pragma unroll
        for (int ai = 0; ai < 2; ++ai)
#pragma unroll
            for (int m = 0; m < 4; ++m) { const int row = row0 + ai * HALF + m * 16; unsigned char* rowp = Hd + (size_t)row * ldc + col0;
                const f32x4 g0 = acc[ai][0][m][0], g1 = acc[ai][0][m][1], u0 = acc[ai][1][m][0], u1 = acc[ai][1][m][1];
                unsigned long long w = (unsigned long long)pk_fp8x4(gate(g0[0], u0[0]), gate(g0[1], u0[1]), gate(g0[2], u0[2]), gate(g0[3], u0[3]))
                                     | ((unsigned long long)pk_fp8x4(gate(g1[0], u1[0]), gate(g1[1], u1[1]), gate(g1[2], u1[2]), gate(g1[3], u1[3])) << 32);
                *(unsigned long long*)rowp = w; }
    }
};

template <bool SSQ, bool XF8, bool RES16> struct EpiResStream {
    static constexpr bool PERM = true, AFTER_DRAIN = false;
    const void* res; bf16_t* XB; unsigned char* X8; float* ssq; float ascale;
    __device__ __forceinline__ void operator()(const f32x4 (&acc)[2][2][4][2], const Unit& u, int wr, int wc, int fr, int fq) const {
        { int t_ = lane_id_(); asm volatile("" : "+v"(t_)); fr = t_ & 15; fq = (t_ >> 4) & 3; }
        const int row0 = u.pm * BM + wr * 64 + fr, col0 = u.pn * BM + wc * 32 + 8 * fq;
        f32x4 rw[4][2][2];
#define ERS_ROW(it) (row0 + ((it) >> 2) * HALF + ((it) & 3) * 16)
#define ERS_LOAD(it) do { const size_t ro_ = (size_t)ERS_ROW(it) * 1024 + col0; _Pragma("unroll") for (int bj = 0; bj < 2; ++bj) { \
            if constexpr (RES16) rw[(it) & 3][bj][0] = __builtin_bit_cast(f32x4, *(const u32x4*)((const bf16_t*)res + ro_ + bj * HALF)); \
            else { _Pragma("unroll") for (int n = 0; n < 2; ++n) rw[(it) & 3][bj][n] = *(const f32x4*)((const float*)res + ro_ + bj * HALF + n * 4); } } } while (0)
        ERS_LOAD(0); ERS_LOAD(1); ERS_LOAD(2); ERS_LOAD(3);
#pragma unroll
        for (int it = 0; it < 8; ++it) { const int ai = it >> 2, m = it & 3; const int row = ERS_ROW(it); const size_t ro = (size_t)row * 1024 + col0;
                f32x4 r[2][2];
#pragma unroll
                for (int bj = 0; bj < 2; ++bj) {
                    if constexpr (RES16) { const u32x4 w = __builtin_bit_cast(u32x4, rw[it & 3][bj][0]);
                        r[bj][0] = (f32x4){__builtin_bit_cast(float, w.x << 16), __builtin_bit_cast(float, w.x & 0xffff0000u), __builtin_bit_cast(float, w.y << 16), __builtin_bit_cast(float, w.y & 0xffff0000u)};
                        r[bj][1] = (f32x4){__builtin_bit_cast(float, w.z << 16), __builtin_bit_cast(float, w.z & 0xffff0000u), __builtin_bit_cast(float, w.w << 16), __builtin_bit_cast(float, w.w & 0xffff0000u)}; }
                    else { r[bj][0] = rw[it & 3][bj][0]; r[bj][1] = rw[it & 3][bj][1]; }
                    r[bj][0] = r[bj][0] + acc[ai][bj][m][0] * ascale; r[bj][1] = r[bj][1] + acc[ai][bj][m][1] * ascale; }
                if (it + 4 < 8) ERS_LOAD(it + 4);
                *(u32x4*)(XB + ro) = pack8(r[0][0], r[0][1]); *(u32x4*)(XB + ro + HALF) = pack8(r[1][0], r[1][1]);
                if constexpr (XF8) { unsigned char* x8 = X8 + ro;
                    *(unsigned long long*)(x8) = (unsigned long long)pk_fp8x4(r[0][0][0], r[0][0][1], r[0][0][2], r[0][0][3]) | ((unsigned long long)pk_fp8x4(r[0][1][0], r[0][1][1], r[0][1][2], r[0][1][3]) << 32);
                    *(unsigned long long*)(x8 + HALF) = (unsigned long long)pk_fp8x4(r[1][0][0], r[1][0][1], r[1][0][2], r[1][0][3]) | ((unsigned long long)pk_fp8x4(r[1][1][0], r[1][1][1], r[1][1][2], r[1][1][3]) << 32); }
                if (SSQ) { const float t = fq_sum(sq8(r[0][0], r[0][1]) + sq8(r[1][0], r[1][1])); if (fq == 0) ssq[(size_t)row * 16 + u.pn * 4 + wc] = t; } }
#undef ERS_LOAD
#undef ERS_ROW
    }
};

template <bool FIRST> struct EpiMoeDown {
    static constexpr bool PERM = false, AFTER_DRAIN = false;
    float* out; const bf16_t* xb; const int* slot_tok; const float* slot_gate; int slot_base; int ldc; float wscale;
    __device__ __forceinline__ void operator()(const f32x4 (&acc)[2][2][4][2], const Unit& u, int wr, int wc, int fr, int fq) const {
        { int t_ = lane_id_(); asm volatile("" : "+v"(t_)); fr = t_ & 15; fq = (t_ >> 4) & 3; }
        const int pnl = u.pn & 3;
        const int row0 = slot_base + u.pm * BM + wr * 64 + fr, col0 = pnl * BM + wc * 32 + 4 * fq;
        int tk[8]; float gt[8];
#pragma unroll
        for (int it = 0; it < 8; ++it) { const int slot = row0 + (it >> 2) * HALF + (it & 3) * 16; tk[it] = slot_tok[slot]; gt[it] = slot_gate[slot] * wscale; }
        f32x4 rw[4][2][2]; unsigned rlo[4][2][2], rhi[4][2][2];
#define EMD_LOAD(it) do { if (tk[it] >= 0) { _Pragma("unroll") for (int bj = 0; bj < 2; ++bj) _Pragma("unroll") for (int n = 0; n < 2; ++n) { \
            if constexpr (FIRST) { const unsigned long long q_ = *(const unsigned long long*)(xb + (size_t)tk[it] * ldc + col0 + bj * HALF + n * 16); \
                rlo[(it) & 3][bj][n] = (unsigned)q_; rhi[(it) & 3][bj][n] = (unsigned)(q_ >> 32); } \
            else rw[(it) & 3][bj][n] = *(const f32x4*)(out + (size_t)tk[it] * ldc + col0 + bj * HALF + n * 16); } } } while (0)
        EMD_LOAD(0); EMD_LOAD(1); EMD_LOAD(2); EMD_LOAD(3);
#pragma unroll
        for (int it = 0; it < 8; ++it) { const int ai = it >> 2, m = it & 3;
            if (tk[it] >= 0) { float* rowp = out + (size_t)tk[it] * ldc + col0;
#pragma unroll
                for (int bj = 0; bj < 2; ++bj)
#pragma unroll
                    for (int n = 0; n < 2; ++n) { f32x4 r;
                        if constexpr (FIRST) { const unsigned lo = rlo[it & 3][bj][n], hi = rhi[it & 3][bj][n];
                            r = (f32x4){__builtin_bit_cast(float, lo << 16), __builtin_bit_cast(float, lo & 0xffff0000u), __builtin_bit_cast(float, hi << 16), __builtin_bit_cast(float, hi & 0xffff0000u)}; }
                        else r = rw[it & 3][bj][n];
                        *(f32x4*)(rowp + bj * HALF + n * 16) = r + acc[ai][bj][m][n] * gt[it]; } }
            if (it + 4 < 8) EMD_LOAD(it + 4); }
#undef EMD_LOAD
    }
};

struct MoeOrder {
    int nM, nN, nwg, G, c; int pb[7];
    int nBusy, SK;
    __device__ void init(int nPanels, int nN_, int G_, int c_) { nM = nPanels; nN = nN_; nwg = nM * nN; G = G_; c = c_; nBusy = 0; SK = 0; }
    __device__ __forceinline__ int expert_of(int pm) const { int e = 0;
#pragma unroll
        for (int k = 0; k < 7; ++k) e += (pm >= pb[k]) ? 1 : 0;
        return e; }
    __device__ bool next(int i, Unit& u) const {
        int L;
        if (nBusy == 0) L = i * G + c;
        else if (c >= nBusy) L = (i < SK) ? i * (G - nBusy) + (c - nBusy) : SK * (G - nBusy) + (i - SK) * G + c;
        else L = SK * (G - nBusy) + i * G + c;
        if (L >= nwg) return false;
        int wgid = L; { const int q = nwg / NXCD, r = nwg % NXCD, xcd = wgid % NXCD, off = wgid / NXCD; wgid = (xcd < r ? xcd * (q + 1) : r * (q + 1) + (xcd - r) * q) + off; }
        const int nig = WGM * nN, gid = wgid / nig, fm = gid * WGM, gsz = (nM - fm) < WGM ? (nM - fm) : WGM;
        u.pm = fm + ((wgid % nig) % gsz); const int pnl = (wgid % nig) / gsz;
        u.pn = expert_of(u.pm) * nN + pnl; return true;
    }
    __device__ __forceinline__ void a_ready(const Unit&) const {}
    __device__ __forceinline__ void done(const Unit&) const {}
};
struct LeftOrder {
    MoeOrder M; int nLeft;
    __device__ bool next(int i, Unit& u) const { if (i != 0 || M.c >= nLeft) return false; u.pm = 256 + (M.c >> 2); u.pn = M.expert_of(u.pm) * 4 + (M.c & 3); return true; }
    __device__ __forceinline__ void a_ready(const Unit&) const {}
    __device__ __forceinline__ void done(const Unit&) const {}
};
template <class Epi, class Sched, bool ALIGN_EPI = false, bool SP2 = false, bool F8 = false>
__device__ __forceinline__ void gemm_phase(PG8_LAS unsigned char* lds, const Gemm g, const Sched& S, const Epi& E, const int wave_idx) {
    int tid_ = wave_idx * 64 + lane_id_(); asm volatile("" : "+v"(tid_));
    const int tid = tid_, wid = __builtin_amdgcn_readfirstlane(tid >> 6), lane = tid & 63, wr = wid >> 2, wc = wid & 3, fr = lane & 15, fq = lane >> 4;
    const int K = g.K, nt = K / BK;
    unsigned voffA0, voffB0;
    { int R, C; stage_rc(tid * 16, R, C); const int Rb = Epi::PERM ? ((R & ~31) + perm32(R & 31)) : R;
      voffA0 = (unsigned)(R * g.lda + C) * 2u; voffB0 = (unsigned)(Rb * K + C) * 2u; }
    const size_t voffAR = (size_t)64 * g.lda * 2, voffBR = (size_t)64 * K * 2;
    const size_t kstep = (size_t)(BK * 2);
    const size_t hstepA = (size_t)HALF * g.lda * 2, hstepB = (size_t)HALF * K * 2;
    const size_t tstepA = 2 * hstepA, tstepB = 2 * hstepB;
    const unsigned lds0_ = (unsigned)(__UINTPTR_TYPE__)lds;
    const unsigned ldsw = (unsigned)wid * 1024u;
    const int aoff = lds_byte(wr * 64 + fr, fq * 8), boff = lds_byte(wc * 32 + fr, fq * 8);
#define PG8_SA(b, h) (((b) * 2 + (h)) * HTB)
#define PG8_SB(b, h) ((4 + (b) * 2 + (h)) * HTB)
#define PG8_STAGE(bufoff, gbase, voff) do { _Pragma("unroll") for (int _i = 0; _i < 2; ++_i) { unsigned keep_; const char* sb_ = (const char*)(gbase) + (size_t)_i * voff##R; \
        asm volatile("s_mov_b32 %0, m0\n\ts_mov_b32 m0, %3\n\ts_nop 0\n\tglobal_load_lds_dwordx4 %1, %2\n\ts_mov_b32 m0, %0" \
            : "=&s"(keep_) : "v"(voff##0), "s"(sb_), "s"(lds0_ + (unsigned)((bufoff) + _i * 8192) + ldsw) : "memory"); } } while (0)
#define PG8_LDA(dst, b, h) do { _Pragma("unroll") for (int m = 0; m < 4; ++m) _Pragma("unroll") for (int k = 0; k < 2; ++k) dst[m][k] = *(const PG8_LAS bf16x8*)(lds + PG8_SA(b, h) + aoff + m * 2048 + k * 1024); } while (0)
#define PG8_LDB(dst, b, h) do { _Pragma("unroll") for (int n = 0; n < 2; ++n) _Pragma("unroll") for (int k = 0; k < 2; ++k) dst[n][k] = *(const PG8_LAS bf16x8*)(lds + PG8_SB(b, h) + boff + n * 2048 + k * 1024); } while (0)
#define PG8_MMA(ai, bj, At, Bt) do { __builtin_amdgcn_s_setprio(1); _Pragma("unroll") for (int m = 0; m < 4; ++m) _Pragma("unroll") for (int n = 0; n < 2; ++n) { \
        if constexpr (F8) { typedef int v8i_ __attribute__((ext_vector_type(8))); typedef int v4i_ __attribute__((ext_vector_type(4))); \
            const v4i_ b0_ = __builtin_bit_cast(v4i_, Bt[n][0]), b1_ = __builtin_bit_cast(v4i_, Bt[n][1]), a0_ = __builtin_bit_cast(v4i_, At[m][0]), a1_ = __builtin_bit_cast(v4i_, At[m][1]); \
            const v8i_ bb_ = __builtin_shufflevector(b0_, b1_, 0, 1, 2, 3, 4, 5, 6, 7), aa_ = __builtin_shufflevector(a0_, a1_, 0, 1, 2, 3, 4, 5, 6, 7); \
            acc[ai][bj][m][n] = __builtin_amdgcn_mfma_scale_f32_16x16x128_f8f6f4(bb_, aa_, acc[ai][bj][m][n], 0, 0, 0, 0, 0, 0); } \
        else { _Pragma("unroll") for (int k = 0; k < 2; ++k) acc[ai][bj][m][n] = __builtin_amdgcn_mfma_f32_16x16x32_bf16(Bt[n][k], At[m][k], acc[ai][bj][m][n], 0, 0, 0); } } \
        __builtin_amdgcn_s_setprio(0); } while (0)
#define PG8_WAIT_V(n) asm volatile("s_waitcnt vmcnt(" #n ")" ::: "memory")
#define PG8_WAIT_L(n) asm volatile("s_waitcnt lgkmcnt(" #n ")" ::: "memory")
#define PG8_BAR __builtin_amdgcn_s_barrier()
#define PG8_SCHED __builtin_amdgcn_sched_barrier(0)
    Unit cur, nxt; int ui = 0;
    if (!S.next(0, cur)) return;
    f32x4 acc[2][2][4][2];
#pragma unroll
    for (int a = 0; a < 2; ++a)
#pragma unroll
        for (int b = 0; b < 2; ++b)
#pragma unroll
            for (int m = 0; m < 4; ++m)
#pragma unroll
                for (int n = 0; n < 2; ++n) acc[a][b][m][n] = (f32x4){0.f, 0.f, 0.f, 0.f};
    bf16x8 At[4][2], B0[2][2], B1[2][2];
    const char* cA = (const char*)g.A + (size_t)cur.pm * tstepA; const char* cB = (const char*)g.Bt + (size_t)cur.pn * tstepB;
    S.a_ready(cur);
    if constexpr (SP2) {
        PG8_STAGE(PG8_SB(0, 0), cB, voffB); PG8_STAGE(PG8_SB(0, 1), cB + hstepB, voffB); PG8_STAGE(PG8_SA(0, 0), cA, voffA); PG8_STAGE(PG8_SA(0, 1), cA + hstepA, voffA);
        if (wr == 1) PG8_BAR;
        PG8_WAIT_V(2); PG8_BAR;
        PG8_STAGE(PG8_SB(1, 0), cB + kstep, voffB); PG8_STAGE(PG8_SA(1, 0), cA + kstep, voffA); PG8_STAGE(PG8_SB(1, 1), cB + hstepB + kstep, voffB);
        PG8_WAIT_V(6); PG8_BAR;
    } else {
        PG8_STAGE(PG8_SB(0, 0), cB, voffB); PG8_STAGE(PG8_SA(0, 0), cA, voffA); PG8_STAGE(PG8_SB(0, 1), cB + hstepB, voffB); PG8_STAGE(PG8_SA(0, 1), cA + hstepA, voffA);
        if (wr == 1) PG8_BAR;
        PG8_WAIT_V(4); PG8_BAR;
        PG8_STAGE(PG8_SB(1, 0), cB + kstep, voffB); PG8_STAGE(PG8_SA(1, 0), cA + kstep, voffA); PG8_STAGE(PG8_SB(1, 1), cB + hstepB + kstep, voffB);
        PG8_WAIT_V(6); PG8_BAR;
    }
    for (;;) {
        const bool has_next = S.next(ui + 1, nxt);
        const char* nA = has_next ? (const char*)g.A + (size_t)nxt.pm * tstepA : cA; const char* nB = has_next ? (const char*)g.Bt + (size_t)nxt.pn * tstepB : cB;
#pragma unroll 1
        for (int t = 0; t < nt; t += 2) {
            const bool last = (t == nt - 2);
            const char* a1 = cA + (size_t)(t + 1) * kstep;
            const char* a2 = last ? nA : cA + (size_t)(t + 2) * kstep; const char* b2 = last ? nB : cB + (size_t)(t + 2) * kstep;
            const char* a3 = a2 + kstep; const char* b3 = b2 + kstep;
            if (last && has_next) S.a_ready(nxt);
            if constexpr (SP2) {
            PG8_LDB(B0, 0, 0); PG8_LDB(B1, 0, 1); PG8_SCHED; PG8_LDA(At, 0, 0); PG8_STAGE(PG8_SA(1, 1), a1 + hstepA, voffA);
            PG8_WAIT_V(8); PG8_WAIT_L(0); PG8_BAR; PG8_MMA(0, 0, At, B0); PG8_MMA(0, 1, At, B1); PG8_BAR; PG8_SCHED;
            PG8_LDA(At, 0, 1); PG8_STAGE(PG8_SB(0, 0), b2, voffB); PG8_STAGE(PG8_SB(0, 1), b2 + hstepB, voffB); PG8_STAGE(PG8_SA(0, 0), a2, voffA);
            PG8_WAIT_V(8); PG8_WAIT_L(0); PG8_BAR; PG8_MMA(1, 0, At, B0); PG8_MMA(1, 1, At, B1); PG8_BAR; PG8_SCHED;
            PG8_LDB(B0, 1, 0); PG8_LDB(B1, 1, 1); PG8_SCHED; PG8_LDA(At, 1, 0); PG8_STAGE(PG8_SA(0, 1), a2 + hstepA, voffA);
            PG8_WAIT_V(8); PG8_WAIT_L(0); PG8_BAR; PG8_MMA(0, 0, At, B0); PG8_MMA(0, 1, At, B1); PG8_BAR; PG8_SCHED;
            PG8_LDA(At, 1, 1); PG8_STAGE(PG8_SB(1, 0), b3, voffB); PG8_STAGE(PG8_SB(1, 1), b3 + hstepB, voffB); PG8_STAGE(PG8_SA(1, 0), a3, voffA);
            PG8_WAIT_V(8); PG8_WAIT_L(0); PG8_BAR; PG8_MMA(1, 0, At, B0); PG8_MMA(1, 1, At, B1); PG8_BAR; PG8_SCHED;
            } else {
            PG8_LDB(B0, 0, 0); PG8_SCHED; PG8_LDA(At, 0, 0); PG8_STAGE(PG8_SA(1, 1), a1 + hstepA, voffA);
            PG8_WAIT_L(8); PG8_BAR; PG8_WAIT_L(0); PG8_MMA(0, 0, At, B0); PG8_BAR; PG8_SCHED;
            PG8_LDB(B1, 0, 1); PG8_STAGE(PG8_SB(0, 0), b2, voffB);
            PG8_BAR; PG8_WAIT_L(0); PG8_MMA(0, 1, At, B1); PG8_BAR;
            PG8_LDA(At, 0, 1); PG8_STAGE(PG8_SA(0, 0), a2, voffA);
            PG8_BAR; PG8_WAIT_L(0); PG8_MMA(1, 0, At, B0); PG8_BAR; PG8_SCHED;
            PG8_STAGE(PG8_SB(0, 1), b2 + hstepB, voffB);
            PG8_WAIT_V(6); PG8_BAR; PG8_MMA(1, 1, At, B1); PG8_BAR;
            PG8_LDB(B0, 1, 0); PG8_SCHED; PG8_LDA(At, 1, 0); PG8_STAGE(PG8_SA(0, 1), a2 + hstepA, voffA);
            PG8_WAIT_L(8); PG8_BAR; PG8_WAIT_L(0); PG8_MMA(0, 0, At, B0); PG8_BAR; PG8_SCHED;
            PG8_LDB(B1, 1, 1); PG8_STAGE(PG8_SB(1, 0), b3, voffB);
            PG8_BAR; PG8_WAIT_L(0); PG8_MMA(0, 1, At, B1); PG8_BAR;
            PG8_LDA(At, 1, 1); PG8_STAGE(PG8_SA(1, 0), a3, voffA);
            PG8_BAR; PG8_WAIT_L(0); PG8_MMA(1, 0, At, B0); PG8_BAR; PG8_SCHED;
            PG8_STAGE(PG8_SB(1, 1), b3 + hstepB, voffB);
            PG8_WAIT_V(6); PG8_BAR; PG8_MMA(1, 1, At, B1); PG8_BAR;
            }
        }
        if constexpr (ALIGN_EPI) { if (wr == 0) PG8_BAR; }
        if constexpr (!Epi::AFTER_DRAIN) { E(acc, cur, wr, wc, fr, fq); S.done(cur); }
        if (!has_next) break;
#pragma unroll
        for (int a = 0; a < 2; ++a)
#pragma unroll
            for (int b = 0; b < 2; ++b)
#pragma unroll
                for (int m = 0; m < 4; ++m)
#pragma unroll
                    for (int n = 0; n < 2; ++n) acc[a][b][m][n] = (f32x4){0.f, 0.f, 0.f, 0.f};
        cur = nxt; cA = nA; cB = nB; ++ui;
        if constexpr (ALIGN_EPI) { if (wr == 1) PG8_BAR; }
    }
    PG8_WAIT_V(0);
    if constexpr (!ALIGN_EPI) { if (wr == 0) PG8_BAR; }
    PG8_BAR;
    if constexpr (Epi::AFTER_DRAIN) { E.fused(acc, cur, wr, wc, fr, fq, lds, wid, lane); S.done(cur); }
#undef PG8_SA
#undef PG8_SB
#undef PG8_STAGE
#undef PG8_LDA
#undef PG8_LDB
#undef PG8_MMA
#undef PG8_WAIT_V
#undef PG8_WAIT_L
#undef PG8_BAR
#undef PG8_SCHED
}
}
namespace att {
#define ATT_LAS __attribute__((address_space(3)))
typedef unsigned short bf16;
typedef short bf16x8 __attribute__((ext_vector_type(8)));
typedef short s16x4 __attribute__((ext_vector_type(4)));
typedef float f32x16 __attribute__((ext_vector_type(16)));
typedef float f32x4_t __attribute__((ext_vector_type(4)));
typedef unsigned u32x4 __attribute__((ext_vector_type(4)));
typedef unsigned u32x2 __attribute__((ext_vector_type(2)));
typedef float f32x2_t __attribute__((ext_vector_type(2))); typedef __bf16 bf16x2_t __attribute__((ext_vector_type(2)));
__device__ __forceinline__ unsigned cvtpk(float lo, float hi) { f32x2_t v = {lo, hi}; bf16x2_t b = __builtin_convertvector(v, bf16x2_t); return __builtin_bit_cast(unsigned, b); }
__device__ __forceinline__ s16x4 vtr(const ATT_LAS unsigned char* p) { return __builtin_bit_cast(s16x4, __builtin_amdgcn_ds_read_tr16_b64_v4i16((ATT_LAS s16x4*)p)); }
constexpr int VSTR = 192;
template <int DQK> struct Geo { static constexpr int KSTR = DQK * 2 + 16, KBUF = 64 * KSTR, VBUF = 64 * VSTR, CPR = DQK / 8, NKC = 64 * CPR, KIT = (NKC + 511) / 512; };
template <int DQK> constexpr int lds_bytes() { return 2 * Geo<DQK>::KBUF + 2 * Geo<DQK>::VBUF + 2048 + 8192; }

__device__ __forceinline__ float xhalf_sum(float m) { return xor32_sum(m); }
__device__ __forceinline__ float max3f(float a, float b, float c) { float r; asm("v_max3_f32 %0, %1, %2, %3" : "=v"(r) : "v"(a), "v"(b), "v"(c)); return r; }
__device__ __forceinline__ float max2f(float a, float b) { float r; asm("v_max_f32_e32 %0, %1, %2" : "=v"(r) : "v"(a), "v"(b)); return r; }
__device__ __forceinline__ float rowmax32(const f32x16& p0, const f32x16& p1) {
    float a = max2f(p0[0], p1[0]), b = max2f(p0[1], p1[1]), c = max2f(p0[2], p1[2]), d = max2f(p0[3], p1[3]);
#pragma unroll
    for (int r = 4; r < 16; r += 4) { a = max3f(a, p0[r], p1[r]); b = max3f(b, p0[r + 1], p1[r + 1]); c = max3f(c, p0[r + 2], p1[r + 2]); d = max3f(d, p0[r + 3], p1[r + 3]); }
    const float m = max2f(max2f(a, b), max2f(c, d));
    float lo_, hi_; halves32(m, lo_, hi_);
    return max2f(lo_, hi_);
}

template <int DQK, bool BAND, int qpitch, int kpitch, int vpitch, int opitch, bool OF8 = false>
__device__ __forceinline__ void attn_unit(ATT_LAS unsigned char* lds, const bf16* Qb, const bf16* Kb, const bf16* Vb, bf16* Ob,
                                          int q0, int t_lo, int t_hi, int my_lo, int my_hi, int cc, const float* bias_g, const float* g_qn, const float* rope, const int wave_idx) {
    typedef Geo<DQK> G;
    int tid_ = wave_idx * 64 + lane_id_(); asm volatile("" : "+v"(tid_));
    const int tid = tid_, lane = tid & 63, r32 = lane & 31, hi = lane >> 5, wid = __builtin_amdgcn_readfirstlane(tid >> 6);
    ATT_LAS float* biasL = (ATT_LAS float*)(lds + 2 * G::KBUF + 2 * G::VBUF);
    bf16x8 qf[DQK / 16];
    { const bf16* qp = Qb + (size_t)(q0 + wid * 32 + r32) * qpitch + 8 * hi;
#pragma unroll
      for (int kk = 0; kk < DQK / 16; ++kk) qf[kk] = *(const bf16x8*)(qp + 16 * kk); }
    if constexpr (!BAND) {
        float qv[DQK / 16][8]; float ss = 0.f;
#pragma unroll
        for (int kk = 0; kk < DQK / 16; ++kk)
#pragma unroll
            for (int j = 0; j < 8; ++j) { qv[kk][j] = __builtin_bit_cast(float, (unsigned)(unsigned short)qf[kk][j] << 16); ss += qv[kk][j] * qv[kk][j]; }
        ss = xhalf_sum(ss);
        const float rs = __builtin_amdgcn_rsqf(ss * (1.f / DQK) + 1e-6f) * (0.10206207261596577f * 1.4426950408889634f);
#pragma unroll
        for (int kk = 0; kk < DQK / 16; ++kk) { const f32x4_t g0 = *(const f32x4_t*)(g_qn + 16 * kk + 8 * hi), g1 = *(const f32x4_t*)(g_qn + 16 * kk + 8 * hi + 4);
#pragma unroll
            for (int j = 0; j < 4; ++j) { qv[kk][j] *= rs * g0[j]; qv[kk][4 + j] *= rs * g1[j]; } }
        const f32x4_t* rp = (const f32x4_t*)(rope + ((size_t)(q0 + wid * 32 + r32) * 16 + 8 * hi) * 2);
#pragma unroll
        for (int j2 = 0; j2 < 4; ++j2) { const f32x4_t cs = rp[j2];
            { const float x1 = qv[4][2 * j2], x2 = qv[5][2 * j2]; qv[4][2 * j2] = x1 * cs[0] - x2 * cs[1]; qv[5][2 * j2] = x2 * cs[0] + x1 * cs[1]; }
            { const float x1 = qv[4][2 * j2 + 1], x2 = qv[5][2 * j2 + 1]; qv[4][2 * j2 + 1] = x1 * cs[2] - x2 * cs[3]; qv[5][2 * j2 + 1] = x2 * cs[2] + x1 * cs[3]; } }
#pragma unroll
        for (int kk = 0; kk < DQK / 16; ++kk) { u32x4 w; w.x = cvtpk(qv[kk][0], qv[kk][1]); w.y = cvtpk(qv[kk][2], qv[kk][3]); w.z = cvtpk(qv[kk][4], qv[kk][5]); w.w = cvtpk(qv[kk][6], qv[kk][7]);
            qf[kk] = __builtin_bit_cast(bf16x8, w); }
    }
    if (BAND) { if (tid < 257) biasL[tid] = bias_g[tid] * 1.4426950408889634f; }
    constexpr int KCPL = G::KSTR / 16, KNP = (64 * KCPL + 63) / 64;
    constexpr int VCPL = VSTR / 16, VNP = 64 * VCPL / 64;
    constexpr int KPP = (KNP + 7) / 8, VPP = (VNP + 7) / 8;
    ATT_LAS unsigned* dmaL = (ATT_LAS unsigned*)(lds + 2 * G::KBUF + 2 * G::VBUF + 2048) + wid * 256 + lane;
#pragma unroll
    for (int pp = 0; pp < KPP; ++pp) { const int pc = wid + 8 * pp, c = pc * 64 + lane, row = (c / KCPL) & 63, ch = c % KCPL; dmaL[64 * pp] = (unsigned)(row * kpitch + (ch < G::CPR ? ch : 0) * 8) * 2u; }
#pragma unroll
    for (int pp = 0; pp < VPP; ++pp) { const int pc = wid + 8 * pp, c = pc * 64 + lane, row = (c / VCPL) & 63, ch = c % VCPL; dmaL[128 + 64 * pp] = (unsigned)(row * vpitch + (ch < 8 ? ch : 0) * 8) * 2u; }
#define ATT_DMA_K(t, b) do { const char* kt_ = (const char*)(Kb + (size_t)(t) * 64 * kpitch); _Pragma("unroll") for (int pp = 0; pp < KPP; ++pp) { if (wid + 8 * pp < KNP) \
            __builtin_amdgcn_global_load_lds((const unsigned*)(kt_ + dmaL[64 * pp]), (ATT_LAS unsigned*)(lds + (b) * G::KBUF + (wid + 8 * pp) * 1024), 16, 0, 0); } } while (0)
#define ATT_DMA_V(t, b) do { const char* vt_ = (const char*)(Vb + (size_t)(t) * 64 * vpitch); _Pragma("unroll") for (int pp = 0; pp < VPP; ++pp) { if (wid + 8 * pp < VNP) \
            __builtin_amdgcn_global_load_lds((const unsigned*)(vt_ + dmaL[128 + 64 * pp]), (ATT_LAS unsigned*)(lds + 2 * G::KBUF + (b) * G::VBUF + (wid + 8 * pp) * 1024), 16, 0, 0); } } while (0)
    f32x16 o0, o1;
#pragma unroll
    for (int i = 0; i < 16; ++i) { o0[i] = 0.f; o1[i] = 0.f; }
    float mrun = -INFINITY, lsum = 0.f;
    const int koff = r32 * G::KSTR + hi * 16;
    const int voff = ((lane >> 5) * 4 + ((lane & 15) >> 2)) * VSTR + (((lane >> 4) & 1) * 16 + (lane & 3) * 4) * 2;
    const f32x16 zero16 = {0.f, 0.f, 0.f, 0.f, 0.f, 0.f, 0.f, 0.f, 0.f, 0.f, 0.f, 0.f, 0.f, 0.f, 0.f, 0.f};
#define ATT_QK(X0, X1, t) do { const ATT_LAS unsigned char* Kt = lds + ((t) & 1) * G::KBUF + koff; \
        _Pragma("unroll") for (int kk = 0; kk < DQK / 16; ++kk) { \
            const bf16x8 a0 = *(const ATT_LAS bf16x8*)(Kt + kk * 32); const bf16x8 a1 = *(const ATT_LAS bf16x8*)(Kt + 32 * G::KSTR + kk * 32); \
            X0 = __builtin_amdgcn_mfma_f32_32x32x16_bf16(a0, qf[kk], kk ? X0 : zero16, 0, 0, 0); X1 = __builtin_amdgcn_mfma_f32_32x32x16_bf16(a1, qf[kk], kk ? X1 : zero16, 0, 0, 0); } } while (0)
#define ATT_SMPV(X0, X1, t) do { \
        float cadd = 0.f; \
        if (BAND) { const int delta = cc - (t); \
            if (delta >= 3) cadd = biasL[256]; \
            else { const ATT_LAS float* bp = biasL + (64 * delta + (32 * (wid & 1) + r32) - 4 * hi + 128 - 63); \
                if (delta < 2) { _Pragma("unroll") for (int i = 0; i < 16; ++i) { const int kj = (i & 3) + 8 * (i >> 2); X0[i] += bp[63 - kj]; X1[i] += bp[31 - kj]; } } \
                else { const int relb = 64 * delta + (32 * (wid & 1) + r32) - 4 * hi + 128; \
                    _Pragma("unroll") for (int i = 0; i < 16; ++i) { const int kj = (i & 3) + 8 * (i >> 2); int i0 = relb - kj, i1 = relb - kj - 32; i0 = i0 > 256 ? 256 : i0; i1 = i1 > 256 ? 256 : i1; \
                        X0[i] += biasL[i0]; X1[i] += biasL[i1]; } } } } \
        const float mt = rowmax32(X0, X1) + cadd; \
        const float mnew = max2f(mrun, mt); \
        const float alpha = __builtin_amdgcn_exp2f(mrun - mnew); \
        const float msub = mnew - cadd; \
        mrun = mnew; \
        float psa[4] = {0.f, 0.f, 0.f, 0.f};   \
        _Pragma("unroll") for (int i = 0; i < 16; ++i) { X0[i] = __builtin_amdgcn_exp2f(X0[i] - msub); X1[i] = __builtin_amdgcn_exp2f(X1[i] - msub); psa[i & 3] += X0[i] + X1[i]; } \
        const float ps = (psa[0] + psa[1]) + (psa[2] + psa[3]); \
        lsum = lsum * alpha + ps; \
        _Pragma("unroll") for (int i = 0; i < 16; ++i) { o0[i] *= alpha; o1[i] *= alpha; } \
        bf16x8 pf[2][2]; \
        _Pragma("unroll") for (int s = 0; s < 2; ++s) { u32x4 w0, w1; \
            w0.x = cvtpk(X0[8 * s + 0], X0[8 * s + 1]); w0.y = cvtpk(X0[8 * s + 2], X0[8 * s + 3]); w0.z = cvtpk(X0[8 * s + 4], X0[8 * s + 5]); w0.w = cvtpk(X0[8 * s + 6], X0[8 * s + 7]); \
            w1.x = cvtpk(X1[8 * s + 0], X1[8 * s + 1]); w1.y = cvtpk(X1[8 * s + 2], X1[8 * s + 3]); w1.z = cvtpk(X1[8 * s + 4], X1[8 * s + 5]); w1.w = cvtpk(X1[8 * s + 6], X1[8 * s + 7]); \
            pf[0][s] = __builtin_bit_cast(bf16x8, w0); pf[1][s] = __builtin_bit_cast(bf16x8, w1); } \
        const ATT_LAS unsigned char* Vt = lds + 2 * G::KBUF + ((t) & 1) * G::VBUF + voff; \
        _Pragma("unroll") for (int kb = 0; kb < 2; ++kb) _Pragma("unroll") for (int s = 0; s < 2; ++s) { \
            const ATT_LAS unsigned char* vp = Vt + (32 * kb + 16 * s) * VSTR; \
            const s16x4 l0 = vtr(vp), h0 = vtr(vp + 8 * VSTR), l1 = vtr(vp + 64), h1 = vtr(vp + 8 * VSTR + 64); \
            const bf16x8 a0 = (bf16x8){l0[0], l0[1], l0[2], l0[3], h0[0], h0[1], h0[2], h0[3]}; \
            const bf16x8 a1 = (bf16x8){l1[0], l1[1], l1[2], l1[3], h1[0], h1[1], h1[2], h1[3]}; \
            o0 = __builtin_amdgcn_mfma_f32_32x32x16_bf16(a0, pf[kb][s], o0, 0, 0, 0); o1 = __builtin_amdgcn_mfma_f32_32x32x16_bf16(a1, pf[kb][s], o1, 0, 0, 0); } } while (0)
#define ATT_FUSED(C0, C1, N0, N1, t, tn) do { \
        bf16x8 kfa[DQK / 16], kfb[DQK / 16]; \
        { const ATT_LAS unsigned char* Kt = lds + ((tn) & 1) * G::KBUF + koff; \
          _Pragma("unroll") for (int kk = 0; kk < DQK / 16; ++kk) { kfa[kk] = *(const ATT_LAS bf16x8*)(Kt + kk * 32); kfb[kk] = *(const ATT_LAS bf16x8*)(Kt + 32 * G::KSTR + kk * 32); } } \
        __builtin_amdgcn_sched_barrier(0); \
        float cadd = 0.f; \
        if (BAND) { const int delta = cc - (t); \
            if (delta >= 3) cadd = biasL[256]; \
            else { const ATT_LAS float* bp = biasL + (64 * delta + (32 * (wid & 1) + r32) - 4 * hi + 128 - 63); \
                if (delta < 2) { _Pragma("unroll") for (int i = 0; i < 16; ++i) { const int kj = (i & 3) + 8 * (i >> 2); C0[i] += bp[63 - kj]; C1[i] += bp[31 - kj]; } } \
                else { const int relb = 64 * delta + (32 * (wid & 1) + r32) - 4 * hi + 128; \
                    _Pragma("unroll") for (int i = 0; i < 16; ++i) { const int kj = (i & 3) + 8 * (i >> 2); int i0 = relb - kj, i1 = relb - kj - 32; i0 = i0 > 256 ? 256 : i0; i1 = i1 > 256 ? 256 : i1; \
                        C0[i] += biasL[i0]; C1[i] += biasL[i1]; } } } } \
        const float mt = rowmax32(C0, C1) + cadd; \
        const float mnew = max2f(mrun, mt); \
        const float alpha = __builtin_amdgcn_exp2f(mrun - mnew); \
        const float msub = mnew - cadd; \
        if (__builtin_amdgcn_ballot_w64(mnew > mrun)) { _Pragma("unroll") for (int i = 0; i < 16; ++i) { o0[i] *= alpha; o1[i] *= alpha; } } \
        mrun = mnew; \
        __builtin_amdgcn_sched_barrier(0); \
        _Pragma("unroll") for (int kk = 0; kk < DQK / 16; ++kk) { \
            N0 = __builtin_amdgcn_mfma_f32_32x32x16_bf16(kfa[kk], qf[kk], kk ? N0 : zero16, 0, 0, 0); N1 = __builtin_amdgcn_mfma_f32_32x32x16_bf16(kfb[kk], qf[kk], kk ? N1 : zero16, 0, 0, 0); } \
        s16x4 vl0[4], vh0[4], vl1[4], vh1[4]; \
        { const ATT_LAS unsigned char* Vt = lds + 2 * G::KBUF + ((t) & 1) * G::VBUF + voff; \
          _Pragma("unroll") for (int ks = 0; ks < 4; ++ks) { const ATT_LAS unsigned char* vp = Vt + 16 * ks * VSTR; vl0[ks] = vtr(vp); vh0[ks] = vtr(vp + 8 * VSTR); vl1[ks] = vtr(vp + 64); vh1[ks] = vtr(vp + 8 * VSTR + 64); } } \
        float psa[4] = {0.f, 0.f, 0.f, 0.f}; \
        _Pragma("unroll") for (int i = 0; i < 16; ++i) { C0[i] = __builtin_amdgcn_exp2f(C0[i] - msub); C1[i] = __builtin_amdgcn_exp2f(C1[i] - msub); psa[i & 3] += C0[i] + C1[i]; } \
        const float ps = (psa[0] + psa[1]) + (psa[2] + psa[3]); \
        lsum = lsum * alpha + ps; \
        bf16x8 pf[4]; \
        _Pragma("unroll") for (int s = 0; s < 2; ++s) { u32x4 w0, w1; \
            w0.x = cvtpk(C0[8 * s + 0], C0[8 * s + 1]); w0.y = cvtpk(C0[8 * s + 2], C0[8 * s + 3]); w0.z = cvtpk(C0[8 * s + 4], C0[8 * s + 5]); w0.w = cvtpk(C0[8 * s + 6], C0[8 * s + 7]); \
            w1.x = cvtpk(C1[8 * s + 0], C1[8 * s + 1]); w1.y = cvtpk(C1[8 * s + 2], C1[8 * s + 3]); w1.z = cvtpk(C1[8 * s + 4], C1[8 * s + 5]); w1.w = cvtpk(C1[8 * s + 6], C1[8 * s + 7]); \
            pf[s] = __builtin_bit_cast(bf16x8, w0); pf[2 + s] = __builtin_bit_cast(bf16x8, w1); } \
        __builtin_amdgcn_sched_barrier(0); \
        _Pragma("unroll") for (int ks = 0; ks < 4; ++ks) { \
            const bf16x8 a0 = (bf16x8){vl0[ks][0], vl0[ks][1], vl0[ks][2], vl0[ks][3], vh0[ks][0], vh0[ks][1], vh0[ks][2], vh0[ks][3]}; \
            const bf16x8 a1 = (bf16x8){vl1[ks][0], vl1[ks][1], vl1[ks][2], vl1[ks][3], vh1[ks][0], vh1[ks][1], vh1[ks][2], vh1[ks][3]}; \
            o0 = __builtin_amdgcn_mfma_f32_32x32x16_bf16(a0, pf[ks], o0, 0, 0, 0); o1 = __builtin_amdgcn_mfma_f32_32x32x16_bf16(a1, pf[ks], o1, 0, 0, 0); } } while (0)
#define ATT_STAGE(t) do { if ((t) + 2 <= t_hi) ATT_DMA_K((t) + 2, (t) & 1); if ((t) + 1 <= t_hi) ATT_DMA_V((t) + 1, ((t) + 1) & 1); } while (0)
    f32x16 sa0, sa1, sb0, sb1;
    ATT_DMA_K(t_lo, t_lo & 1);
    __syncthreads();
    if (t_lo + 1 <= t_hi) ATT_DMA_K(t_lo + 1, (t_lo + 1) & 1);
    ATT_DMA_V(t_lo, t_lo & 1);
    if (my_lo == t_lo) ATT_QK(sa0, sa1, t_lo);
    __syncthreads();
    {
        int t = t_lo;
        for (; t < my_lo - 1; ++t) { ATT_STAGE(t); __syncthreads(); }
        if (my_lo > t_lo) { ATT_STAGE(t); ATT_QK(sa0, sa1, t + 1); __syncthreads(); ++t; }
        int nf = my_hi - my_lo;
        for (; nf >= 2; nf -= 2, t += 2) {
            ATT_STAGE(t); ATT_FUSED(sa0, sa1, sb0, sb1, t, t + 1); __syncthreads();
            ATT_STAGE(t + 1); ATT_FUSED(sb0, sb1, sa0, sa1, t + 1, t + 2); __syncthreads();
        }
        if (nf == 1) {
            ATT_STAGE(t); ATT_FUSED(sa0, sa1, sb0, sb1, t, t + 1); __syncthreads(); ++t;
            ATT_STAGE(t); ATT_SMPV(sb0, sb1, t); __syncthreads(); ++t;
        } else {
            ATT_STAGE(t); ATT_SMPV(sa0, sa1, t); __syncthreads(); ++t;
        }
        for (; t <= t_hi; ++t) { ATT_STAGE(t); __syncthreads(); }
    }
    const float ltot = xhalf_sum(lsum);
    const float inv = 1.f / ltot;
    if constexpr (OF8) {
        unsigned char* op = (unsigned char*)Ob + (size_t)(q0 + wid * 32 + r32) * opitch + 4 * hi; const float i64 = inv * 32.f;
#pragma unroll
        for (int g4 = 0; g4 < 4; ++g4) {
            int w0 = 0, w1 = 0;
            w0 = __builtin_amdgcn_cvt_pk_fp8_f32(o0[4 * g4 + 0] * i64, o0[4 * g4 + 1] * i64, w0, false); w0 = __builtin_amdgcn_cvt_pk_fp8_f32(o0[4 * g4 + 2] * i64, o0[4 * g4 + 3] * i64, w0, true);
            w1 = __builtin_amdgcn_cvt_pk_fp8_f32(o1[4 * g4 + 0] * i64, o1[4 * g4 + 1] * i64, w1, false); w1 = __builtin_amdgcn_cvt_pk_fp8_f32(o1[4 * g4 + 2] * i64, o1[4 * g4 + 3] * i64, w1, true);
            *(int*)(op + 8 * g4) = w0; *(int*)(op + 32 + 8 * g4) = w1;
        }
    } else {
    bf16* op = Ob + (size_t)(q0 + wid * 32 + r32) * opitch + 4 * hi;
#pragma unroll
    for (int g4 = 0; g4 < 4; ++g4) {
        u32x2 w0, w1;
        w0.x = cvtpk(o0[4 * g4 + 0] * inv, o0[4 * g4 + 1] * inv); w0.y = cvtpk(o0[4 * g4 + 2] * inv, o0[4 * g4 + 3] * inv);
        w1.x = cvtpk(o1[4 * g4 + 0] * inv, o1[4 * g4 + 1] * inv); w1.y = cvtpk(o1[4 * g4 + 2] * inv, o1[4 * g4 + 3] * inv);
        *(u32x2*)(op + 8 * g4) = w0; *(u32x2*)(op + 32 + 8 * g4) = w1;
    }
    }
#undef ATT_DMA_K
#undef ATT_DMA_V
#undef ATT_QK
#undef ATT_SMPV
#undef ATT_STAGE
#undef ATT_FUSED
}
}
constexpr int NWAVES = 8;
constexpr int D = 1024, BATCH = 32, SEQ = 2048, M = BATCH * SEQ;
constexpr int NH = 16, QLORA = 384, KVLORA = 256, ROPE_D = 32, NOPE = 64, QKD = 96;
constexpr int NA = 768;
constexpr int FF = 2816, EFF = 3584, NE = 8;
constexpr float EPS = 1e-6f, LOG2E = 1.4426950408889634f;
constexpr int MAXP_HALF = 264, MAXP = 528;
constexpr size_t MiB = 1u << 20;
constexpr size_t WS_CTL = 0, CTL_ZERO_BYTES = 1 * MiB;
constexpr size_t WS_ROPE = 1 * MiB;
constexpr size_t WS_CNT = WS_ROPE + 256 * 1024;
constexpr size_t WS_PANELE = WS_CNT + 16 * 1024;
constexpr size_t WS_META = WS_PANELE + 4096;
constexpr size_t WS_TOKE = 2 * MiB;
constexpr size_t WS_TOKG = WS_TOKE + (size_t)M * 4;
constexpr size_t WS_SLOTTOK = WS_TOKG + (size_t)M * 8;
constexpr size_t WS_SLOTGATE = WS_SLOTTOK + (size_t)MAXP * 256 * 4;
constexpr size_t WS_PARTQA = 976 * MiB, WS_PART1 = 980 * MiB, WS_PART2 = 984 * MiB;
constexpr size_t WS_TOKRSTD = 4 * MiB;
constexpr size_t WS_SLOTRSTD = WS_TOKRSTD + (size_t)M * 4;
static_assert(WS_SLOTGATE + (size_t)MAXP * 256 * 4 <= WS_TOKRSTD && WS_SLOTRSTD + (size_t)MAXP * 256 * 4 <= 8 * MiB, "small arrays");
constexpr size_t WS_W = 8 * MiB;
constexpr size_t WS_WA = WS_W, WS_WUQ = WS_WA + (size_t)NA * D * 2, WS_WUKV = WS_WUQ + (size_t)1536 * QLORA * 2, WS_WO = WS_WUKV + (size_t)2048 * KVLORA * 2;
constexpr size_t WS_WF1 = WS_WO + (size_t)D * D * 2, WS_WF2 = WS_WF1 + (size_t)2 * FF * D * 2, WS_WKVQ = WS_WF2 + (size_t)D * FF * 2, WS_WBO = WS_WKVQ + (size_t)3 * D * D * 2;
constexpr size_t WS_WM1 = WS_WBO + (size_t)D * D * 2, WS_WM2 = WS_WM1 + (size_t)NE * 2 * EFF * D * 2, WS_WEND = WS_WM2 + (size_t)NE * D * EFF * 2;
constexpr size_t ARENA = 208 * MiB;
static_assert(WS_WEND <= ARENA, "weights fit under the arena");
constexpr size_t WS_XN = ARENA;
constexpr size_t WS_QA = ARENA + 128 * MiB;
constexpr size_t WS_Q = ARENA + 224 * MiB;
constexpr size_t WS_K = ARENA + 416 * MiB;
constexpr size_t WS_V = ARENA + 608 * MiB;
constexpr size_t WS_O = ARENA;
static_assert(WS_V + (size_t)M * D * 2 <= 1024 * MiB, "MLA arena");
constexpr size_t WS_XR1 = ARENA + 128 * MiB;
constexpr size_t WS_H = ARENA + 256 * MiB;
constexpr size_t WS_XR2 = ARENA;
constexpr size_t WS_X2B = ARENA + 608 * MiB;
constexpr size_t WS_KVQ2 = ARENA + 128 * MiB;
constexpr size_t WS_O2 = ARENA + 512 * MiB;
constexpr size_t WS_XR3 = ARENA + 132 * MiB;
constexpr size_t WS_XG = ARENA;
constexpr size_t WS_HM = ARENA + 264 * MiB;
constexpr size_t WS_END = WS_HM + (size_t)MAXP_HALF * 256 * EFF * 2;
static_assert(WS_XG + (size_t)MAXP * 256 * D <= WS_XR3 && WS_XR3 + (size_t)M * D * 2 <= WS_HM && WS_END <= 1024 * MiB && WS_H + (size_t)M * FF * 2 <= WS_X2B && WS_X2B + (size_t)M * D * 2 <= 976 * MiB && WS_O2 + (size_t)M * D <= WS_X2B, "arena");
constexpr int CW_BAR = 4096;
constexpr int RING_OFF = 0, RING_BYTES = 131072;
constexpr int P0_SCR = 128 * 33 * 4;
constexpr int LDSCTL_OFF = 8 * P0_SCR, MISC_OFF = LDSCTL_OFF + 320;
static_assert(LDSCTL_OFF >= RING_BYTES, "control words above every phase's scratch");
constexpr int LDS_BYTES = 147456;
static_assert(MISC_OFF + 128 <= LDS_BYTES, "LDS map");
static_assert(att::lds_bytes<96>() <= RING_BYTES, "attention scratch fits the ring region");

#define GAS __attribute__((address_space(1)))
#define LAS __attribute__((address_space(3)))
typedef unsigned short bf16;
typedef unsigned v4u __attribute__((ext_vector_type(4)));
typedef unsigned v2u __attribute__((ext_vector_type(2)));
typedef float f32x4 __attribute__((ext_vector_type(4)));
typedef GAS unsigned gu32;
#define RLX_AGENT __ATOMIC_RELAXED, __HIP_MEMORY_SCOPE_AGENT
#define LDS_WAIT() asm volatile("s_waitcnt lgkmcnt(0)" ::: "memory")
__device__ __forceinline__ unsigned f2bf(float f) { unsigned u = __builtin_bit_cast(unsigned, f); return (u + 0x7fffu + ((u >> 16) & 1u)) >> 16; }
__device__ __forceinline__ unsigned pk2(float lo, float hi) { return f2bf(lo) | (f2bf(hi) << 16); }
__device__ __forceinline__ float bflo(unsigned u) { return __builtin_bit_cast(float, u << 16); }
__device__ __forceinline__ float bfhi(unsigned u) { return __builtin_bit_cast(float, u & 0xffff0000u); }
__device__ __forceinline__ float wave_sum(float v) {
    v += swz_xor<1>(v); v += swz_xor<2>(v); v += swz_xor<4>(v); v += swz_xor<8>(v); v += swz_xor<16>(v);
    return xor32_sum(v);
}

#define XB_TMO      128
#define XB_XCNT(j)  (256  + 64 * (j))
#define XB_XSUB(j)  (1280 + 64 * (j))
#define XB_XGEN(j)  (2304 + 64 * (j))
#define XB_TOP      3328
#define XB_TOPGEN   3392
#define XCD_BAR_WORDS 3456
#define XB_SPIN_CAP (1u << 18)

__device__ __forceinline__ unsigned xb_ld(unsigned* p)              { return __hip_atomic_load(p, __ATOMIC_RELAXED, __HIP_MEMORY_SCOPE_AGENT); }
__device__ __forceinline__ unsigned xb_add(unsigned* p, unsigned v) { return __hip_atomic_fetch_add(p, v, __ATOMIC_RELAXED, __HIP_MEMORY_SCOPE_AGENT); }
__device__ __forceinline__ unsigned xb_xcc_id() { return (unsigned)__builtin_amdgcn_s_getreg((3 << 11) | 20) & 0xFu; }
#define XB_SPIN(cond, bar) do { unsigned _sp = 0; while (cond) { __builtin_amdgcn_s_sleep(1); \
    if ((++_sp & 255u) == 0u) { if (xb_ld(&(bar)[XB_TMO])) break; if (_sp > XB_SPIN_CAP) { atomicAdd(&(bar)[XB_TMO], 1u); break; } } } } while (0)

struct XcdBarrier {
    int t0;
    unsigned* bar; unsigned x;
    volatile LAS unsigned* st;
};

__device__ __forceinline__ XcdBarrier xcd_barrier_post(unsigned* bar, volatile LAS unsigned* st, int t0) {
    XcdBarrier b; b.t0 = t0; b.bar = bar; b.x = xb_xcc_id(); b.st = st;
    if (b.t0) (void)xb_add(&bar[XB_XCNT(b.x)], 1u);
    return b;
}
__device__ __forceinline__ void xcd_barrier_complete(unsigned* bar, unsigned x, unsigned& nloc, unsigned& nx) {
    const unsigned G = gridDim.x * gridDim.y * gridDim.z;
    unsigned sum, cnt, mine, sp = 0u;
    for (;;) {
        sum = 0u; cnt = 0u; mine = 0u;
#pragma unroll
        for (unsigned j = 0; j < 16; ++j) { const unsigned c = xb_ld(&bar[XB_XCNT(j)]); sum += c; cnt += (c > 0u) ? 1u : 0u; mine = (j == x) ? c : mine; }
        if (sum == G) break;
        __builtin_amdgcn_s_sleep(1);
        if ((++sp & 255u) == 0u) { if (xb_ld(&bar[XB_TMO])) break; if (sp > XB_SPIN_CAP) { atomicAdd(&bar[XB_TMO], 1u); break; } }
    }
    nloc = mine > 0u ? mine : 1u; nx = cnt > 0u ? cnt : 1u;
}

__device__ __forceinline__ void xcd_barrier(const XcdBarrier& b) {
    asm volatile("s_waitcnt vmcnt(0)" ::: "memory");
    __syncthreads();
    if (b.t0) {
        unsigned* bar = b.bar;
        __builtin_amdgcn_s_waitcnt(0);
        unsigned nloc = b.st[0], nx = b.st[1];
        if (nloc == 0u) { xcd_barrier_complete(bar, b.x, nloc, nx); b.st[0] = nloc; b.st[1] = nx; }
        const unsigned old = xb_add(&bar[XB_XSUB(b.x)], 1u);
        const unsigned gen = old / nloc;
        if (old + 1u == (gen + 1u) * nloc) {
            __builtin_amdgcn_fence(__ATOMIC_RELEASE, "agent");
            asm volatile("s_waitcnt vmcnt(0)" ::: "memory");
            const unsigned og = xb_add(&bar[XB_TOP], 1u);
            const unsigned tg = og / nx;
            if (og + 1u == (tg + 1u) * nx) xb_add(&bar[XB_TOPGEN], 1u);
            else XB_SPIN(xb_ld(&bar[XB_TOPGEN]) == tg, bar);
            __builtin_amdgcn_fence(__ATOMIC_ACQUIRE, "agent");
            xb_add(&bar[XB_XGEN(b.x)], 1u);
            asm volatile("s_waitcnt vmcnt(0)" ::: "memory");
        } else {
            XB_SPIN(xb_ld(&bar[XB_XGEN(b.x)]) == gen, bar);
            __builtin_amdgcn_fence(__ATOMIC_ACQUIRE, "agent");
            asm volatile("s_waitcnt vmcnt(0)" ::: "memory");
        }
    }
    __syncthreads();
}

struct Args { const float* in[27]; float* out; unsigned char* ws; };
enum { I_X = 0, I_ATTN_NORM, I_FFN_NORM, I_A_WDQ, I_A_GCQ, I_A_WUQ, I_A_WDKV, I_A_GCKV, I_A_WUKV, I_A_GQN, I_A_GKN, I_A_WO, I_KV_NORM, I_KV_WK, I_KV_WV, I_KV_GKN,
       I_B_WQ, I_B_GQN, I_B_RELB, I_B_WO, I_FFN_W1, I_FFN_W3, I_FFN_W2, I_MOE_ROUTER, I_MOE_W1, I_MOE_W3, I_MOE_W2 };

struct Frame {
    LAS unsigned char* lds;
    int wave, vcu, G;
};
typedef const __attribute__((address_space(4))) Args* KArgs;
__device__ __forceinline__ KArgs kargs() { KArgs p = (KArgs)__builtin_amdgcn_kernarg_segment_ptr(); asm volatile("" : "+s"(p)); return p; }
#define INP(i) (kargs()->in[i])
#define OUTP (kargs()->out)
#define WSP (kargs()->ws)
__device__ __forceinline__ int fresh(int v) { asm volatile("" : "+v"(v)); return v; }

__device__ __forceinline__ void tr_item(const float* W, int ldw, int K, int k0, int nsrc0, const float* gain, bf16* WT, int drow0, LAS float* scr, int lane) {
    const int c4 = lane & 7, r = lane >> 3;
    const GAS float* src = (const GAS float*)W + (size_t)(k0 + r) * ldw + nsrc0 + 4 * c4;
    f32x4 v[16];
#pragma unroll
    for (int i = 0; i < 16; ++i) v[i] = *(const GAS f32x4*)(src + (size_t)(8 * i) * ldw);
    if (gain) {
#pragma unroll
        for (int i = 0; i < 16; ++i) v[i] = v[i] * gain[k0 + 8 * i + r];
    }
#pragma unroll
    for (int i = 0; i < 16; ++i) { LAS float* d = scr + (8 * i + r) * 33 + 4 * c4; d[0] = v[i].x; d[1] = v[i].y; d[2] = v[i].z; d[3] = v[i].w; }
    LDS_WAIT(); asm volatile("" ::: "memory");
    const int c16 = lane >> 2;
#pragma unroll
    for (int j = 0; j < 8; ++j) { const int n = (lane & 3) + 4 * j; const LAS float* sp = scr + (8 * c16) * 33 + n;
        v4u o; o.x = pk2(sp[0 * 33], sp[1 * 33]); o.y = pk2(sp[2 * 33], sp[3 * 33]); o.z = pk2(sp[4 * 33], sp[5 * 33]); o.w = pk2(sp[6 * 33], sp[7 * 33]);
        *(GAS v4u*)(WT + (size_t)(drow0 + n) * K + k0 + 8 * c16) = o; }
    LDS_WAIT(); asm volatile("" ::: "memory");
}
__device__ __forceinline__ void tr_plain(const float* W, int K, int N, const float* gain, bf16* WT, int drow_off, LAS float* scr, int item, int lane) {
    const int nblk = N / 32, kb = item / nblk, nb = item % nblk;
    tr_item(W, N, K, 128 * kb, 32 * nb, gain, WT, drow_off + 32 * nb, scr, lane);
}
__device__ __forceinline__ void tr_gated(const float* W, int K, int N, const float* gain, bf16* WT, int half, LAS float* scr, int item, int lane) {
    const int nblk = N / 32, kb = item / nblk, nb = item % nblk, n0 = 32 * nb;
    tr_item(W, N, K, 128 * kb, n0, gain, WT, (n0 >> 7) * 256 + half * 128 + (n0 & 127), scr, lane);
}
__device__ __forceinline__ unsigned pk_fp8x4(float a, float b, float c, float d) { int w = 0; w = __builtin_amdgcn_cvt_pk_fp8_f32(a, b, w, false); w = __builtin_amdgcn_cvt_pk_fp8_f32(c, d, w, true); return (unsigned)w; }
__device__ __forceinline__ void tr_item_f8(const float* W, int ldw, int K, int k0, int nsrc0, const float* gain, unsigned char* WT, int drow0, LAS float* scr, int lane) {
    const int c4 = lane & 7, r = lane >> 3;
    const GAS float* src = (const GAS float*)W + (size_t)(k0 + r) * ldw + nsrc0 + 4 * c4;
    f32x4 v[16];
#pragma unroll
    for (int i = 0; i < 16; ++i) v[i] = *(const GAS f32x4*)(src + (size_t)(8 * i) * ldw);
#pragma unroll
    for (int i = 0; i < 16; ++i) v[i] = v[i] * (gain ? gain[k0 + 8 * i + r] * 64.f : 64.f);
#pragma unroll
    for (int i = 0; i < 16; ++i) { LAS float* d = scr + (8 * i + r) * 33 + 4 * c4; d[0] = v[i].x; d[1] = v[i].y; d[2] = v[i].z; d[3] = v[i].w; }
    LDS_WAIT(); asm volatile("" ::: "memory");
    const int c8 = lane >> 3;
#pragma unroll
    for (int j = 0; j < 4; ++j) { const int n = (lane & 7) + 8 * j; const LAS float* sp = scr + (16 * c8) * 33 + n;
        v4u o; o.x = pk_fp8x4(sp[0 * 33], sp[1 * 33], sp[2 * 33], sp[3 * 33]); o.y = pk_fp8x4(sp[4 * 33], sp[5 * 33], sp[6 * 33], sp[7 * 33]);
        o.z = pk_fp8x4(sp[8 * 33], sp[9 * 33], sp[10 * 33], sp[11 * 33]); o.w = pk_fp8x4(sp[12 * 33], sp[13 * 33], sp[14 * 33], sp[15 * 33]);
        *(GAS v4u*)(WT + (size_t)(drow0 + n) * K + k0 + 16 * c8) = o; }
    LDS_WAIT(); asm volatile("" ::: "memory");
}
__device__ __forceinline__ float rms_row_to_bf16(const float* xrow, bf16* orow, int lane, f32x4 (&v)[4]) {
    const GAS f32x4* xr = (const GAS f32x4*)xrow + lane;
    float s = 0.f;
#pragma unroll
    for (int j = 0; j < 4; ++j) { v[j] = xr[64 * j]; s += (v[j].x * v[j].x + v[j].y * v[j].y) + (v[j].z * v[j].z + v[j].w * v[j].w); }
    const float rstd = 1.f / sqrtf(wave_sum(s) * (1.f / D) + EPS);
    GAS unsigned long long* o8 = (GAS unsigned long long*)orow + lane;
#pragma unroll
    for (int j = 0; j < 4; ++j) o8[64 * j] = (unsigned long long)pk2(v[j].x * rstd, v[j].y * rstd) | ((unsigned long long)pk2(v[j].z * rstd, v[j].w * rstd) << 32);
    return rstd;
}
__device__ __forceinline__ void norm_phase(const Frame& F, const float* x, bf16* xn) {
    const int tid = fresh(F.wave * 64 + lane_id_()), lane = tid & 63; (void)lane;
    const int gw = F.vcu * NWAVES + F.wave, NGW = F.G * NWAVES;
    for (int m = 2 * gw; m < M; m += 2 * NGW) {
        const GAS f32x4* xr = (const GAS f32x4*)(x + (size_t)m * D) + lane;
        f32x4 v[8]; float s0 = 0.f, s1 = 0.f;
#pragma unroll
        for (int j = 0; j < 8; ++j) v[j] = xr[64 * j];
#pragma unroll
        for (int j = 0; j < 4; ++j) { s0 += (v[j].x * v[j].x + v[j].y * v[j].y) + (v[j].z * v[j].z + v[j].w * v[j].w); s1 += (v[4 + j].x * v[4 + j].x + v[4 + j].y * v[4 + j].y) + (v[4 + j].z * v[4 + j].z + v[4 + j].w * v[4 + j].w); }
        const float r0 = 1.f / sqrtf(wave_sum(s0) * (1.f / D) + EPS), r1 = 1.f / sqrtf(wave_sum(s1) * (1.f / D) + EPS);
        GAS unsigned* o4 = (GAS unsigned*)((GAS unsigned char*)xn + (size_t)m * D) + lane;
#pragma unroll
        for (int j = 0; j < 8; ++j) { const float rr = j < 4 ? r0 : r1; o4[64 * j] = pk_fp8x4(v[j].x * rr, v[j].y * rr, v[j].z * rr, v[j].w * rr); }
    }
}

__device__ __forceinline__ void p0_prologue(const Frame& F) {
    const int tid = fresh(F.wave * 64 + lane_id_()), lane = tid & 63; (void)lane;
    LAS float* scr = (LAS float*)(F.lds + RING_OFF + F.wave * P0_SCR);
    unsigned char* ws = WSP;
    const int gw = F.vcu * NWAVES + F.wave, NGW = F.G * NWAVES;
    constexpr int I_DQ = 8 * 12, I_DKV = 8 * 9, I_UQ = 3 * 48, I_UKV = 2 * 64, I_SQ = 8 * 32, I_F13 = 8 * 88, I_F2 = 22 * 32, I_M13 = 8 * 112, I_M2 = 28 * 32;
    constexpr int NSMALL = I_DQ + I_DKV + I_UQ + I_UKV + I_SQ + 2 * I_F13 + I_F2 + 4 * I_SQ;
    constexpr int NITEMS = NSMALL + NE * (2 * I_M13 + I_M2);
    for (int it = gw; it < NITEMS; it += NGW) {
        int r = it;
        if (r < I_DQ)  { const int kb = r / 12, n0 = 32 * (r % 12); tr_item_f8(INP(I_A_WDQ), QLORA, D, 128 * kb, n0, INP(I_ATTN_NORM), ws + WS_WA, n0, scr, lane); continue; } r -= I_DQ;
        if (r < I_DKV) { const int kb = r / 9, n0 = 32 * (r % 9); tr_item_f8(INP(I_A_WDKV), KVLORA + ROPE_D, D, 128 * kb, n0, INP(I_ATTN_NORM), ws + WS_WA, QLORA + n0, scr, lane); continue; } r -= I_DKV;
        if (r < I_UQ)  { tr_plain(INP(I_A_WUQ), QLORA, NH * QKD, INP(I_A_GCQ), (bf16*)(ws + WS_WUQ), 0, scr, r, lane); continue; } r -= I_UQ;
        if (r < I_UKV) { const int kb = r / 64, n0 = 32 * (r % 64), head = n0 >> 7, within = n0 & 127;
            const int drow = within < 64 ? 256 * (head >> 2) + 128 * (within >> 5) + 32 * (head & 3) : 1024 + head * 64 + (within - 64);
            tr_item(INP(I_A_WUKV), NH * 128, KVLORA, 128 * kb, n0, INP(I_A_GCKV), (bf16*)(ws + WS_WUKV), drow, scr, lane); continue; } r -= I_UKV;
        if (r < I_SQ)  { const int kb = r / 32, n0 = 32 * (r % 32); tr_item_f8(INP(I_A_WO), D, D, 128 * kb, n0, nullptr, ws + WS_WO, n0, scr, lane); continue; } r -= I_SQ;
        if (r < I_F13) { tr_gated(INP(I_FFN_W1), D, FF, INP(I_FFN_NORM), (bf16*)(ws + WS_WF1), 0, scr, r, lane); continue; } r -= I_F13;
        if (r < I_F13) { tr_gated(INP(I_FFN_W3), D, FF, INP(I_FFN_NORM), (bf16*)(ws + WS_WF1), 1, scr, r, lane); continue; } r -= I_F13;
        if (r < I_F2)  { tr_plain(INP(I_FFN_W2), FF, D, nullptr, (bf16*)(ws + WS_WF2), 0, scr, r, lane); continue; } r -= I_F2;
        if (r < I_SQ)  { const int kb = r / 32, n0 = 32 * (r % 32), head = n0 >> 6;
            tr_item_f8(INP(I_KV_WK), D, D, 128 * kb, n0, INP(I_KV_NORM), ws + WS_WKVQ, 256 * (head >> 2) + 128 * ((n0 >> 5) & 1) + 32 * (head & 3), scr, lane); continue; } r -= I_SQ;
        if (r < I_SQ)  { const int kb = r / 32, n0 = 32 * (r % 32); tr_item_f8(INP(I_KV_WV), D, D, 128 * kb, n0, INP(I_KV_NORM), ws + WS_WKVQ, 2 * D + n0, scr, lane); continue; } r -= I_SQ;
        if (r < I_SQ)  { const int kb = r / 32, n0 = 32 * (r % 32), head = n0 >> 6;
            tr_item_f8(INP(I_B_WQ), D, D, 128 * kb, n0, INP(I_ATTN_NORM) + D, ws + WS_WKVQ, D + 256 * (head >> 2) + 128 * ((n0 >> 5) & 1) + 32 * (head & 3), scr, lane); continue; } r -= I_SQ;
        if (r < I_SQ)  { const int kb = r / 32, n0 = 32 * (r % 32); tr_item_f8(INP(I_B_WO), D, D, 128 * kb, n0, nullptr, ws + WS_WBO, n0, scr, lane); continue; } r -= I_SQ;
        const int e = r / (2 * I_M13 + I_M2); r -= e * (2 * I_M13 + I_M2);
        if (r < I_M13) { const int kb = r / 112, n0 = 32 * (r % 112);
            tr_item_f8(INP(I_MOE_W1) + (size_t)e * D * EFF, EFF, D, 128 * kb, n0, INP(I_FFN_NORM) + D, ws + WS_WM1 + (size_t)e * 2 * EFF * D, (n0 >> 7) * 256 + (n0 & 127), scr, lane); continue; } r -= I_M13;
        if (r < I_M13) { const int kb = r / 112, n0 = 32 * (r % 112);
            tr_item_f8(INP(I_MOE_W3) + (size_t)e * D * EFF, EFF, D, 128 * kb, n0, INP(I_FFN_NORM) + D, ws + WS_WM1 + (size_t)e * 2 * EFF * D, (n0 >> 7) * 256 + 128 + (n0 & 127), scr, lane); continue; } r -= I_M13;
        { const int kb = r / 32, n0 = 32 * (r % 32); tr_item_f8(INP(I_MOE_W2) + (size_t)e * EFF * D, D, EFF, 128 * kb, n0, nullptr, ws + WS_WM2 + (size_t)e * D * EFF, n0, scr, lane); }
    }
    const int gt = F.vcu * (NWAVES * 64) + tid, NGT = F.G * NWAVES * 64;
    for (int c = gt; c < 96 * D / 16; c += NGT) *((GAS v4u*)(ws + WS_WA + (size_t)(QLORA + KVLORA + ROPE_D) * D) + c) = (v4u){0u, 0u, 0u, 0u};
    for (int c = gt; c < SEQ * 16; c += NGT) { const int pos = c >> 4, i = c & 15;
        const float inv = __builtin_amdgcn_exp2f(-(float)i * (13.287712379549449f / 16.f));
        const float rev = (float)pos * inv * 0.15915494309189535f; const float fr = rev - floorf(rev);
        ((GAS float*)(ws + WS_ROPE))[2 * c] = __builtin_amdgcn_cosf(fr); ((GAS float*)(ws + WS_ROPE))[2 * c + 1] = __builtin_amdgcn_sinf(fr); }
    norm_phase(F, INP(I_X), (bf16*)(ws + WS_XN));
}

__device__ __forceinline__ void route_phase(const Frame& F) {
    const int tid = fresh(F.wave * 64 + lane_id_()), lane = tid & 63;
    unsigned char* ws = WSP;
    LAS float* wrg = (LAS float*)(F.lds + RING_OFF);
    LAS int* cnt = (LAS int*)(F.lds + RING_OFF + 32768);
    const float* wr = INP(I_MOE_ROUTER); const float* g = INP(I_FFN_NORM) + D;
    for (int idx = tid; idx < D * NE; idx += NWAVES * 64) { const int k = idx >> 3, e = idx & 7, l = k >> 4, i = k & 15;
        wrg[((i * 2) + (e >> 2)) * 256 + 4 * l + (e & 3)] = wr[idx] * g[k]; }
    __syncthreads();
    const int b5 = (lane >> 5) & 1, b4 = (lane >> 4) & 1, b3 = (lane >> 3) & 1;
    for (int c = F.vcu; c < M / 256; c += F.G) {
        if (tid < 16) cnt[tid] = 0;
        __syncthreads();
        v4u vn[2];
        { const GAS v4u* xr = (const GAS v4u*)(ws + WS_XR3 + (size_t)(c * 256 + F.wave * 32) * D * 2) + 2 * lane; vn[0] = xr[0]; vn[1] = xr[1]; }
        for (int i = 0; i < 32; ++i) {
            const int m = c * 256 + F.wave * 32 + i;
            const v4u q0 = vn[0], q1 = vn[1];
            if (i + 1 < 32) { const GAS v4u* xr = (const GAS v4u*)(ws + WS_XR3 + (size_t)(m + 1) * D * 2) + 2 * lane; vn[0] = xr[0]; vn[1] = xr[1]; }
            const unsigned qw[8] = {q0.x, q0.y, q0.z, q0.w, q1.x, q1.y, q1.z, q1.w};
            float xv[16]; float ssx = 0.f;
#pragma unroll
            for (int j = 0; j < 8; ++j) { xv[2 * j] = bflo(qw[j]); xv[2 * j + 1] = bfhi(qw[j]); }
#pragma unroll
            for (int j = 0; j < 16; j += 4) ssx += (xv[j] * xv[j] + xv[j + 1] * xv[j + 1]) + (xv[j + 2] * xv[j + 2] + xv[j + 3] * xv[j + 3]);
            float lg[8];
#pragma unroll
            for (int e = 0; e < 8; ++e) lg[e] = 0.f;
#pragma unroll
            for (int j = 0; j < 16; ++j) { const float x1 = xv[j];
                const f32x4 w0 = *(const LAS f32x4*)(wrg + (j * 2) * 256 + 4 * lane), w1 = *(const LAS f32x4*)(wrg + (j * 2 + 1) * 256 + 4 * lane);
                lg[0] += x1 * w0.x; lg[1] += x1 * w0.y; lg[2] += x1 * w0.z; lg[3] += x1 * w0.w; lg[4] += x1 * w1.x; lg[5] += x1 * w1.y; lg[6] += x1 * w1.z; lg[7] += x1 * w1.w; }
            float r4[4], r2[2], r1;
#pragma unroll
            for (int e = 0; e < 4; ++e) { const float mine = b5 ? lg[4 + e] : lg[e], other = b5 ? lg[e] : lg[4 + e]; r4[e] = mine + xor32_partner(other, b5); }
#pragma unroll
            for (int e = 0; e < 2; ++e) { const float mine = b4 ? r4[2 + e] : r4[e], other = b4 ? r4[e] : r4[2 + e]; r2[e] = mine + swz_xor<16>(other); }
            { const float mine = b3 ? r2[1] : r2[0], other = b3 ? r2[0] : r2[1]; r1 = mine + swz_xor<8>(other); }
            r1 += swz_xor<4>(r1); r1 += swz_xor<2>(r1); r1 += swz_xor<1>(r1);
            const float rstd = 1.f / sqrtf(wave_sum(ssx) * (1.f / D) + EPS);
#pragma unroll
            for (int e = 0; e < 8; ++e) lg[e] = __builtin_bit_cast(float, __builtin_amdgcn_readlane(__builtin_bit_cast(int, r1), 8 * e)) * rstd;
            int e1 = 0; float l1 = lg[0];
#pragma unroll
            for (int e = 1; e < 8; ++e) if (lg[e] > l1) { l1 = lg[e]; e1 = e; }
            int e2 = -1; float l2 = -INFINITY;
#pragma unroll
            for (int e = 0; e < 8; ++e) if (e != e1 && lg[e] > l2) { l2 = lg[e]; e2 = e; }
            const float g1 = 1.f / (1.f + __expf(l2 - l1)), g2 = 1.f - g1;
            const int elo = e1 < e2 ? e1 : e2, ehi = e1 < e2 ? e2 : e1;
            const float glo = e1 < e2 ? g1 : g2, ghi = e1 < e2 ? g2 : g1;
            if (lane == 0) { ((GAS float*)(ws + WS_TOKRSTD))[m] = rstd; ((GAS int*)(ws + WS_TOKE))[m] = elo | (ehi << 8); ((GAS float*)(ws + WS_TOKG))[2 * m] = glo; ((GAS float*)(ws + WS_TOKG))[2 * m + 1] = ghi;
                atomicAdd((int*)&cnt[elo], 1); atomicAdd((int*)&cnt[8 + ehi], 1); }
        }
        __syncthreads();
        if (tid < 16) ((GAS int*)(ws + WS_CNT))[c * 16 + tid] = cnt[tid];
        __syncthreads();
    }
}

__device__ __forceinline__ void slot_phase(const Frame& F, unsigned char* ws) {
    const int tid = fresh(F.wave * 64 + lane_id_()), lane = tid & 63; (void)lane;
    LAS int* call = (LAS int*)(F.lds + RING_OFF);
    LAS int* tot = call + 4096; LAS int* base = tot + 16; LAS int* pre = base + 16; LAS int* meta = pre + 16;
    LAS int* grp = meta + 16;
    LAS int* slot_of = grp + 512;
    for (int idx = tid; idx < 4096; idx += NWAVES * 64) call[idx] = ((const GAS int*)(ws + WS_CNT))[idx];
    __syncthreads();
    if (tid < 16) { int t = 0; for (int cc = 0; cc < 256; ++cc) t += call[cc * 16 + tid]; tot[tid] = t; }
    __syncthreads();
    if (tid == 0) { int off = 0; for (int g = 0; g < 16; ++g) { base[g] = off; off += (tot[g] + 255) & ~255; if (g == 7) meta[0] = off >> 8; } meta[1] = (off >> 8) - meta[0]; }
    __syncthreads();
    for (int c = F.vcu; c < M / 256; c += F.G) {
        if (tid < 16) { int p = 0; for (int cc = 0; cc < c; ++cc) p += call[cc * 16 + tid]; pre[tid] = p; }
        const int hf = tid >> 8, i = tid & 255, m = c * 256 + i;
        const int te = ((const GAS int*)(ws + WS_TOKE))[m];
        const int g = hf * 8 + (hf ? ((te >> 8) & 0xff) : (te & 0xff));
        grp[tid] = g;
        __syncthreads();
        int rank = 0;
        for (int j = 0; j < i; ++j) rank += (grp[hf * 256 + j] == g) ? 1 : 0;
        const int slot = base[g] + pre[g] + rank;
        ((GAS int*)(ws + WS_SLOTTOK))[slot] = m; ((GAS float*)(ws + WS_SLOTGATE))[slot] = ((const GAS float*)(ws + WS_TOKG))[2 * m + hf];
        slot_of[tid] = slot;
        __syncthreads();
        for (int i0 = F.wave; i0 < 256; i0 += 4 * NWAVES) {
            v4u x[4][2]; float rs[4];
#pragma unroll
            for (int k = 0; k < 4; ++k) { const int mm = c * 256 + i0 + 8 * k; const GAS v4u* src = (const GAS v4u*)(ws + WS_XR3 + (size_t)mm * D * 2);
                x[k][0] = src[2 * lane]; x[k][1] = src[2 * lane + 1]; rs[k] = ((const GAS float*)(ws + WS_TOKRSTD))[mm]; }
#pragma unroll
            for (int k = 0; k < 4; ++k) { const int i = i0 + 8 * k; const v4u x0 = x[k][0], x1 = x[k][1]; const float r = rs[k];
                const v4u o = (v4u){pk_fp8x4(bflo(x0.x) * r, bfhi(x0.x) * r, bflo(x0.y) * r, bfhi(x0.y) * r), pk_fp8x4(bflo(x0.z) * r, bfhi(x0.z) * r, bflo(x0.w) * r, bfhi(x0.w) * r),
                                    pk_fp8x4(bflo(x1.x) * r, bfhi(x1.x) * r, bflo(x1.y) * r, bfhi(x1.y) * r), pk_fp8x4(bflo(x1.z) * r, bfhi(x1.z) * r, bflo(x1.w) * r, bfhi(x1.w) * r)};
                ((GAS v4u*)(ws + WS_XG + (size_t)slot_of[i] * D))[lane] = o; ((GAS v4u*)(ws + WS_XG + (size_t)slot_of[256 + i] * D))[lane] = o; }
        }
        __syncthreads();
    }
    for (int g = F.vcu; g < 16; g += F.G) {
        const int s0 = base[g] + tot[g], s1 = base[g] + ((tot[g] + 255) & ~255);
        for (int s = s0 + F.wave; s < s1; s += NWAVES) { GAS v4u* dst = (GAS v4u*)(ws + WS_XG + (size_t)s * D);
            dst[lane] = (v4u){0u, 0u, 0u, 0u};
            if (lane == 0) { ((GAS int*)(ws + WS_SLOTTOK))[s] = -1; ((GAS float*)(ws + WS_SLOTGATE))[s] = 0.f; } }
    }
    if (F.vcu == 0) {
        if (tid < 16) { const int p0 = base[tid] >> 8, p1 = (base[tid] + ((tot[tid] + 255) & ~255)) >> 8; for (int p = p0; p < p1; ++p) ((GAS int*)(ws + WS_PANELE))[p] = tid & 7; }
        if (tid == 0) { ((GAS int*)(ws + WS_META))[0] = meta[0]; ((GAS int*)(ws + WS_META))[1] = meta[1]; }
        if (tid < 16) ((GAS int*)(ws + WS_META))[2 + tid] = base[tid] >> 8;
    }
    __syncthreads();
}

__global__ void __launch_bounds__(NWAVES * 64, 2) yoco_fwd(Args args) {
    extern __shared__ __attribute__((aligned(16))) unsigned char lds_raw[];
    Frame F;
    F.lds = (LAS unsigned char*)lds_raw;
    F.wave = __builtin_amdgcn_readfirstlane((int)threadIdx.x >> 6);
    F.G = gridDim.x; { const int bx = blockIdx.x; F.vcu = (F.G % 8 == 0) ? (bx % 8) * (F.G / 8) + bx / 8 : bx; }
    unsigned char* ws = WSP;
    volatile LAS unsigned* MISC = (volatile LAS unsigned*)(F.lds + MISC_OFF);
    for (int u = fresh((int)threadIdx.x); u < (LDS_BYTES - LDSCTL_OFF) / 4; u += NWAVES * 64) ((LAS unsigned*)(F.lds + LDSCTL_OFF))[u] = 0u;
    __syncthreads();
    (void)xcd_barrier_post((unsigned*)(ws + WS_CTL) + CW_BAR, MISC + 8, (F.wave == 0 && lane_id_() == 0) ? 1 : 0);
    LAS unsigned char* ring = F.lds + RING_OFF;
#define bid ((int)blockIdx.x)
#define GRID_BAR() do { XcdBarrier b_; b_.t0 = (F.wave == 0 && lane_id_() == 0) ? 1 : 0; b_.bar = (unsigned*)(WSP + WS_CTL) + CW_BAR; b_.x = xb_xcc_id(); b_.st = (volatile LAS unsigned*)(F.lds + MISC_OFF) + 8; xcd_barrier(b_); } while (0)
#define GEMM(EpiT, SchedT) pg8::gemm_phase<EpiT, SchedT, true, true>

    p0_prologue(F);
    GRID_BAR();
    { pg8::Gemm g{(const bf16*)(ws + WS_XN), (const bf16*)(ws + WS_WA), M, NA, D / 2, D / 2}; pg8::StaticOrder S; S.init(M, NA, F.G, bid);
      pg8::EpiQA E{(bf16*)(ws + WS_QA), (float*)(ws + WS_PARTQA), 1.f / 64};
      pg8::gemm_phase<pg8::EpiQA, pg8::StaticOrder, true, true, true>(ring, g, S, E, F.wave); }
    GRID_BAR();
    { pg8::Gemm g{(const bf16*)(ws + WS_QA), (const bf16*)(ws + WS_WUQ), M, NH * QKD, QLORA, NA}; pg8::StaticOrder S; S.init(M, NH * QKD, F.G, bid);
      pg8::EpiRowScaleBf16 E{(bf16*)(ws + WS_Q), NH * QKD, (const float*)(ws + WS_PARTQA), 1.f / QLORA};
      GEMM(pg8::EpiRowScaleBf16, pg8::StaticOrder)(ring, g, S, E, F.wave); }
    { pg8::Gemm g{(const bf16*)(ws + WS_QA) + QLORA, (const bf16*)(ws + WS_WUKV), M, NH * 128, KVLORA, NA}; pg8::StaticOrder S; S.init(M, NH * 128, F.G, bid);
      pg8::EpiKVup E{(bf16*)(ws + WS_K), (bf16*)(ws + WS_V), (const float*)(ws + WS_PARTQA), (const bf16*)(ws + WS_QA), INP(I_A_GKN), (const float*)(ws + WS_ROPE)};
      GEMM(pg8::EpiKVup, pg8::StaticOrder)(ring, g, S, E, F.wave); }
    GRID_BAR();
    for (int p = F.vcu; p < BATCH * NH * 4; p += F.G) {
        const int bh = p >> 2, pid = p & 3, b = bh >> 4, h = bh & 15;
        for (int u2 = 0; u2 < 2; ++u2) {
            const int qb = u2 ? 7 - pid : pid;
            att::attn_unit<96, false, 1536, 1536, D, D, true>(ring, (const bf16*)(ws + WS_Q) + (size_t)b * SEQ * 1536 + h * QKD, (const bf16*)(ws + WS_K) + (size_t)b * SEQ * 1536 + h * QKD,
                                      (const bf16*)(ws + WS_V) + (size_t)b * SEQ * D + h * 64, (bf16*)(ws + WS_O + (size_t)b * SEQ * D + h * 64),
                                      256 * qb, 0, 4 * qb + 3, 0, 4 * qb + (F.wave >> 1), 0, nullptr, INP(I_A_GQN), (const float*)(ws + WS_ROPE), F.wave);
        }
    }
    GRID_BAR();
    { pg8::Gemm g{(const bf16*)(ws + WS_O), (const bf16*)(ws + WS_WO), M, D, D / 2, D / 2}; pg8::StaticOrder S; S.init(M, D, F.G, bid);
      pg8::EpiResStream<true, false, false> E{INP(I_X), (bf16*)(ws + WS_XR1), nullptr, (float*)(ws + WS_PART1), 1.f / 2048};
      pg8::gemm_phase<pg8::EpiResStream<true, false, false>, pg8::StaticOrder, true, true, true>(ring, g, S, E, F.wave); }
    GRID_BAR();
    { pg8::Gemm g{(const bf16*)(ws + WS_XR1), (const bf16*)(ws + WS_WF1), M, 2 * FF, D, D}; pg8::StaticOrder S; S.init(M, 2 * FF, F.G, bid);
      pg8::EpiGated<true> E{(bf16*)(ws + WS_H), FF, 0, (const float*)(ws + WS_PART1)};
      GEMM(pg8::EpiGated<true>, pg8::StaticOrder)(ring, g, S, E, F.wave); }
    GRID_BAR();
    { pg8::Gemm g{(const bf16*)(ws + WS_H), (const bf16*)(ws + WS_WF2), M, D, FF, FF}; pg8::StaticOrder S; S.init(M, D, F.G, bid);
      pg8::EpiResStream<true, true, true> E{ws + WS_XR1, (bf16*)(ws + WS_X2B), ws + WS_XR2, (float*)(ws + WS_PART2), 1.f};
      pg8::gemm_phase<pg8::EpiResStream<true, true, true>, pg8::StaticOrder, true, true>(ring, g, S, E, F.wave); }
    GRID_BAR();
    { pg8::Gemm g{(const bf16*)(ws + WS_XR2), (const bf16*)(ws + WS_WKVQ), M, 2 * D, D / 2, D / 2}; pg8::StaticOrder S; S.init(M, 2 * D, F.G, bid);
      pg8::EpiK2Q2 E{(bf16*)(ws + WS_KVQ2), (const float*)(ws + WS_PART2), INP(I_KV_GKN), INP(I_B_GQN), 1.f / 64};
      pg8::gemm_phase<pg8::EpiK2Q2, pg8::StaticOrder, true, true, true>(ring, g, S, E, F.wave); }
    { pg8::Gemm g{(const bf16*)(ws + WS_XR2), (const bf16*)(ws + WS_WKVQ + (size_t)2 * D * D), M, D, D / 2, D / 2}; pg8::StaticOrder S; S.init(M, D, F.G, bid);
      pg8::EpiRowScale16 E{(bf16*)(ws + WS_KVQ2), 3 * D, D, (const float*)(ws + WS_PART2), 1.f / 64};
      pg8::gemm_phase<pg8::EpiRowScale16, pg8::StaticOrder, true, true, true>(ring, g, S, E, F.wave); }
    GRID_BAR();
    for (int p = F.vcu; p < BATCH * NH * 8; p += F.G) {
        const int bh = p >> 3, cb = ((p & 7) + (p >> 8)) & 7, b = bh >> 4, h = bh & 15;
        const int c0 = 4 * cb, cc = c0 + (F.wave >> 1);
        const bf16* base = (const bf16*)(ws + WS_KVQ2) + (size_t)b * SEQ * 3072 + h * 64;
        att::attn_unit<64, true, 3072, 3072, 3072, D, true>(ring, base + 2048, base, base + 1024, (bf16*)(ws + WS_O2 + (size_t)b * SEQ * D + h * 64),
                                 256 * cb, c0 - 8 < 0 ? 0 : c0 - 8, c0 + 3, cc - 8 < 0 ? 0 : cc - 8, cc, cc, INP(I_B_RELB) + h * 257, nullptr, nullptr, F.wave);
    }
    GRID_BAR();
    { pg8::Gemm g{(const bf16*)(ws + WS_O2), (const bf16*)(ws + WS_WBO), M, D, D / 2, D / 2}; pg8::StaticOrder S; S.init(M, D, F.G, bid);
      pg8::EpiResStream<false, false, true> E{ws + WS_X2B, (bf16*)(ws + WS_XR3), nullptr, nullptr, 1.f / 2048};
      pg8::gemm_phase<pg8::EpiResStream<false, false, true>, pg8::StaticOrder, true, true, true>(ring, g, S, E, F.wave); }
    GRID_BAR();
    route_phase(F);
    GRID_BAR();
    slot_phase(F, ws);
    GRID_BAR();
#define MOE_LOAD(hf_) unsigned char* w2 = WSP; \
          const int nPA = __builtin_amdgcn_readfirstlane(((const GAS int*)(w2 + WS_META))[0]), nPB = __builtin_amdgcn_readfirstlane(((const GAS int*)(w2 + WS_META))[1]); (void)nPB; \
          const int p0 = (hf_) ? nPA : 0; int pbk[7]; \
          _Pragma("unroll") for (int k = 0; k < 7; ++k) pbk[k] = __builtin_amdgcn_readfirstlane(((const GAS int*)(w2 + WS_META))[2 + (hf_) * 8 + 1 + k]) - p0;
    constexpr size_t HMB_OFF = (size_t)MAXP_HALF * 256 * EFF;
    { MOE_LOAD(0)
      pg8::Gemm g{(const bf16*)(w2 + WS_XG), (const bf16*)(w2 + WS_WM1), nPA * 256, 2 * EFF, D / 2, D / 2};
      pg8::MoeOrder S; S.init(nPA, 2 * EFF / 256, F.G, bid);
#pragma unroll
      for (int k = 0; k < 7; ++k) S.pb[k] = pbk[k];
      pg8::EpiGatedF8 E{w2 + WS_HM, EFF, 2 * EFF / 256};
      pg8::gemm_phase<pg8::EpiGatedF8, pg8::MoeOrder, true, true, true>(ring, g, S, E, F.wave); }
    GRID_BAR();
    { MOE_LOAD(0)
      pg8::Gemm g{(const bf16*)(w2 + WS_HM), (const bf16*)(w2 + WS_WM2), 256 * 256, D, EFF / 2, EFF / 2};
      pg8::MoeOrder S; S.init(256, D / 256, F.G, bid);
#pragma unroll
      for (int k = 0; k < 7; ++k) S.pb[k] = pbk[k];
      pg8::EpiMoeDown<true> E{OUTP, (const bf16*)(w2 + WS_XR3), (const int*)(w2 + WS_SLOTTOK), (const float*)(w2 + WS_SLOTGATE), 0, D, 1.f / 64};
      pg8::gemm_phase<pg8::EpiMoeDown<true>, pg8::MoeOrder, true, true, true>(ring, g, S, E, F.wave); }
    GRID_BAR();
    { MOE_LOAD(0)
      pg8::Gemm g{(const bf16*)(w2 + WS_HM), (const bf16*)(w2 + WS_WM2), nPA * 256, D, EFF / 2, EFF / 2};
      pg8::LeftOrder S; S.M.init(nPA, D / 256, F.G, bid); S.nLeft = 4 * (nPA - 256);
#pragma unroll
      for (int k = 0; k < 7; ++k) S.M.pb[k] = pbk[k];
      pg8::EpiMoeDown<true> E{OUTP, (const bf16*)(w2 + WS_XR3), (const int*)(w2 + WS_SLOTTOK), (const float*)(w2 + WS_SLOTGATE), 0, D, 1.f / 64};
      pg8::gemm_phase<pg8::EpiMoeDown<true>, pg8::LeftOrder, true, true, true>(ring, g, S, E, F.wave); }
    { MOE_LOAD(1)
      pg8::Gemm g{(const bf16*)(w2 + WS_XG + (size_t)p0 * 256 * D), (const bf16*)(w2 + WS_WM1), nPB * 256, 2 * EFF, D / 2, D / 2};
      pg8::MoeOrder S; S.init(nPB, 2 * EFF / 256, F.G, bid); S.nBusy = 4 * (nPA - 256); S.SK = 4;
#pragma unroll
      for (int k = 0; k < 7; ++k) S.pb[k] = pbk[k];
      pg8::EpiGatedF8 E{w2 + WS_HM + HMB_OFF, EFF, 2 * EFF / 256};
      pg8::gemm_phase<pg8::EpiGatedF8, pg8::MoeOrder, true, true, true>(ring, g, S, E, F.wave); }
    GRID_BAR();
    { MOE_LOAD(1)
      pg8::Gemm g{(const bf16*)(w2 + WS_HM + HMB_OFF), (const bf16*)(w2 + WS_WM2), nPB * 256, D, EFF / 2, EFF / 2};
      pg8::MoeOrder S; S.init(nPB, D / 256, F.G, bid);
#pragma unroll
      for (int k = 0; k < 7; ++k) S.pb[k] = pbk[k];
      pg8::EpiMoeDown<false> E{OUTP, nullptr, (const int*)(w2 + WS_SLOTTOK), (const float*)(w2 + WS_SLOTGATE), p0 * 256, D, 1.f / 64};
      pg8::gemm_phase<pg8::EpiMoeDown<false>, pg8::MoeOrder, true, true, true>(ring, g, S, E, F.wave); }
#undef MOE_LOAD
#undef GRID_BAR
#undef bid
#undef GEMM
}

extern "C" void kernel_launch(void* const* d_in, const int* in_sizes, int n_in, void* d_out, int out_size, void* d_ws, size_t ws_size, hipStream_t stream) {
    static int grid = 0;
    if (grid == 0) {
        if (n_in != 27 || in_sizes[0] != M * D || out_size != M * D || ws_size < WS_END) { fprintf(stderr, "kernel_launch: unexpected shapes (n_in %d, in0 %d, out %d, ws %zu < %zu); nothing launched\n", n_in, n_in > 0 ? in_sizes[0] : -1, out_size, ws_size, (size_t)WS_END); grid = -1; return; }
        int dev = 0, cus = 0, per_cu = 0;
        if (hipGetDevice(&dev) != hipSuccess || hipDeviceGetAttribute(&cus, hipDeviceAttributeMultiprocessorCount, dev) != hipSuccess) { grid = -1; return; }
        if (hipFuncSetAttribute((const void*)yoco_fwd, hipFuncAttributeMaxDynamicSharedMemorySize, LDS_BYTES) != hipSuccess) { fprintf(stderr, "kernel_launch: hipFuncSetAttribute failed\n"); grid = -1; return; }
        if (hipOccupancyMaxActiveBlocksPerMultiprocessor(&per_cu, (const void*)yoco_fwd, NWAVES * 64, LDS_BYTES) != hipSuccess || per_cu < 1) { fprintf(stderr, "kernel_launch: occupancy query says %d\n", per_cu); }
        (void)hipGetLastError();
        grid = cus;
    }
    if (grid < 0) return;
    if (hipMemsetAsync((char*)d_ws + WS_CTL, 0, CTL_ZERO_BYTES, stream) != hipSuccess) return;
    Args a{};
    for (int i = 0; i < 27; ++i) a.in[i] = (const float*)d_in[i];
    a.out = (float*)d_out; a.ws = (unsigned char*)d_ws;
    hipLaunchKernelGGL(yoco_fwd, dim3(grid), dim3(NWAVES * 64), LDS_BYTES, stream, a);
}
```

```cpp
#include <hip/hip_runtime.h>
#include <cstdio>
#include <cstdint>
__device__ __forceinline__ int lane_id_() { unsigned m_ = ~0u; asm volatile("" : "+s"(m_)); return (int)__builtin_amdgcn_mbcnt_hi(m_, __builtin_amdgcn_mbcnt_lo(m_, 0u)); }
template <int X> __device__ __forceinline__ float swz_xor(float v) { return __builtin_bit_cast(float, __builtin_amdgcn_ds_swizzle(__builtin_bit_cast(int, v), (X << 10) | 0x1f)); }
__device__ __forceinline__ void halves32(float v, float& r_lo, float& r_hi) { unsigned a_ = __builtin_bit_cast(unsigned, v), b_ = a_;
    asm volatile("s_nop 1\n\tv_permlane32_swap_b32 %0, %1\n\ts_nop 1" : "+v"(a_), "+v"(b_)); r_lo = __builtin_bit_cast(float, a_); r_hi = __builtin_bit_cast(float, b_); }
__device__ __forceinline__ float xor32_partner(float v, int upper_half) { float lo, hi; halves32(v, lo, hi); return upper_half ? lo : hi; }
__device__ __forceinline__ float xor32_sum(float v) { float lo, hi; halves32(v, lo, hi); return lo + hi; }
__device__ __forceinline__ float xor32_max(float v) { float lo, hi; halves32(v, lo, hi); return fmaxf(lo, hi); }
namespace pg8 {
#define PG8_LAS __attribute__((address_space(3)))
typedef unsigned short bf16_t;
typedef short bf16x8 __attribute__((ext_vector_type(8)));
typedef float f32x4 __attribute__((ext_vector_type(4)));
typedef unsigned u32x4 __attribute__((ext_vector_type(4)));
constexpr int BM = 256, BK = 64, HALF = 128, HTB = HALF * BK * 2  , STAGE_BYTES = 8 * HTB, NXCD = 8, WGM = 8;

__host__ __device__ __forceinline__ int lds_byte(int r, int c) { const int st = (r >> 4) * 2 + (c >> 5), rr = r & 15, cc = c & 31, ob = rr * 64 + cc * 2; return st * 1024 + (ob ^ (((ob >> 9) & 1) << 5)); }
__host__ __device__ __forceinline__ void stage_rc(int b, int& R, int& C) { const int st = b / 1024, sb = b % 1024, swz = sb ^ (((sb >> 9) & 1) << 5); R = (st >> 1) * 16 + swz / 64; C = (st & 1) * 32 + (swz % 64) / 2; }
__host__ __device__ __forceinline__ int perm32(int rho) { const int n = rho >> 4, i = rho & 15; return 8 * (i >> 2) + 4 * n + (i & 3); }

struct Unit { int pm, pn; };
struct Gemm { const bf16_t* A; const bf16_t* Bt; int M, N, K, lda; };

struct StaticOrder {
    int nM, nN, nwg, G, c;
    __host__ __device__ void init(int M, int N, int G_, int c_) { nM = M / BM; nN = N / BM; nwg = nM * nN; G = G_; c = c_; }
    __host__ __device__ bool next(int i, Unit& u) const {
        const int L = i * G + c; if (L >= nwg) return false;
        int wgid = L; { const int q = nwg / NXCD, r = nwg % NXCD, xcd = wgid % NXCD, off = wgid / NXCD; wgid = (xcd < r ? xcd * (q + 1) : r * (q + 1) + (xcd - r) * q) + off; }
        const int nig = WGM * nN, gid = wgid / nig, fm = gid * WGM, gsz = (nM - fm) < WGM ? (nM - fm) : WGM;
        u.pm = fm + ((wgid % nig) % gsz); u.pn = (wgid % nig) / gsz; return true;
    }
    __device__ __forceinline__ void a_ready(const Unit&) const {}
    __device__ __forceinline__ void done(const Unit&) const {}
};
__device__ __forceinline__ unsigned cvt_pk_bf16(float lo, float hi) { unsigned r; asm volatile("v_cvt_pk_bf16_f32 %0, %1, %2" : "=v"(r) : "v"(lo), "v"(hi)); return r; }
__device__ __forceinline__ float silu_f(float x) { const float e = __builtin_amdgcn_exp2f(x * -1.4426950408889634f); return x * __builtin_amdgcn_rcpf(1.f + e); }

__device__ __forceinline__ float sum4(const f32x4& a) { return (a[0] + a[1]) + (a[2] + a[3]); }
__device__ __forceinline__ float part_sum8(const float* p) { return sum4(*(const f32x4*)p) + sum4(*(const f32x4*)(p + 4)); }
__device__ __forceinline__ float part_sum16(const float* p) { return (sum4(*(const f32x4*)p) + sum4(*(const f32x4*)(p + 4))) + (sum4(*(const f32x4*)(p + 8)) + sum4(*(const f32x4*)(p + 12))); }
__device__ __forceinline__ float fq_sum(float v) { v += swz_xor<16>(v); return xor32_sum(v); }
__device__ __forceinline__ float sq8(const f32x4& a, const f32x4& b) { return ((a[0] * a[0] + a[1] * a[1]) + (a[2] * a[2] + a[3] * a[3])) + ((b[0] * b[0] + b[1] * b[1]) + (b[2] * b[2] + b[3] * b[3])); }
__device__ __forceinline__ u32x4 pack8(const f32x4& a, const f32x4& b) { u32x4 w; w.x = cvt_pk_bf16(a[0], a[1]); w.y = cvt_pk_bf16(a[2], a[3]); w.z = cvt_pk_bf16(b[0], b[1]); w.w = cvt_pk_bf16(b[2], b[3]); return w; }
constexpr float EPS_ = 1e-6f;
__device__ __forceinline__ unsigned pk_fp8x4(float a, float b, float c, float d) { int w = 0; w = __builtin_amdgcn_cvt_pk_fp8_f32(a, b, w, false); w = __builtin_amdgcn_cvt_pk_fp8_f32(c, d, w, true); return (unsigned)w; }

struct EpiQA {
    static constexpr bool PERM = true, AFTER_DRAIN = false;
    bf16_t* O; float* part; float wscale;
    __device__ __forceinline__ void operator()(const f32x4 (&acc)[2][2][4][2], const Unit& u, int wr, int wc, int fr, int fq) const {
        { int t_ = lane_id_(); asm volatile("" : "+v"(t_)); fr = t_ & 15; fq = (t_ >> 4) & 3; }
        const int row0 = u.pm * BM + wr * 64 + fr, col0 = u.pn * BM + wc * 32 + 8 * fq;
#pragma unroll
        for (int ai = 0; ai < 2; ++ai)
#pragma unroll
            for (int m = 0; m < 4; ++m) { const int row = row0 + ai * HALF + m * 16; bf16_t* rowp = O + (size_t)row * 768 + col0;
                const f32x4 a0 = acc[ai][0][m][0] * wscale, a1 = acc[ai][0][m][1] * wscale, b0 = acc[ai][1][m][0] * wscale, b1 = acc[ai][1][m][1] * wscale;
                *(u32x4*)(rowp) = pack8(a0, a1); *(u32x4*)(rowp + HALF) = pack8(b0, b1);
                const float s0 = sq8(a0, a1), s1 = sq8(b0, b1);
                float* pr = part + (size_t)row * 16;
                if (u.pn == 0) { const float t = fq_sum(s0 + s1); if (fq == 0) pr[wc] = t; }
                else if (u.pn == 1) { const float t0 = fq_sum(s0), t1 = fq_sum(s1); if (fq == 0) { pr[4 + wc] = t0; pr[8 + wc] = t1; } }
                else { const float t = fq_sum(s0); if (fq == 0) pr[12 + wc] = t; } }
    }
};

struct EpiRowScaleBf16 {
    static constexpr bool PERM = true, AFTER_DRAIN = false;
    bf16_t* O; int ldc; const float* part; float inv_n;
    __device__ __forceinline__ void operator()(const f32x4 (&acc)[2][2][4][2], const Unit& u, int wr, int wc, int fr, int fq) const {
        { int t_ = lane_id_(); asm volatile("" : "+v"(t_)); fr = t_ & 15; fq = (t_ >> 4) & 3; }
        const int row0 = u.pm * BM + wr * 64 + fr, col0 = u.pn * BM + wc * 32 + 8 * fq;
#pragma unroll
        for (int ai = 0; ai < 2; ++ai)
#pragma unroll
            for (int m = 0; m < 4; ++m) { const int row = row0 + ai * HALF + m * 16; bf16_t* rowp = O + (size_t)row * ldc + col0;
                const float rs = __builtin_amdgcn_rsqf(part_sum8(part + (size_t)row * 16) * inv_n + EPS_);
                *(u32x4*)(rowp) = pack8(acc[ai][0][m][0] * rs, acc[ai][0][m][1] * rs); *(u32x4*)(rowp + HALF) = pack8(acc[ai][1][m][0] * rs, acc[ai][1][m][1] * rs); }
    }
};

struct EpiKVup {
    static constexpr bool PERM = true, AFTER_DRAIN = false;
    bf16_t* Kd; bf16_t* Vd; const float* part; const bf16_t* QA; const float* g_kn; const float* rope;
    __device__ __forceinline__ void operator()(const f32x4 (&acc)[2][2][4][2], const Unit& u, int wr, int wc, int fr, int fq) const {
        { int t_ = lane_id_(); asm volatile("" : "+v"(t_)); fr = t_ & 15; fq = (t_ >> 4) & 3; }
        const int row0 = u.pm * BM + wr * 64 + fr;
        if (u.pn >= 4) {
            const int col0 = (u.pn - 4) * BM + wc * 32 + 8 * fq;
#pragma unroll
            for (int ai = 0; ai < 2; ++ai)
#pragma unroll
                for (int m = 0; m < 4; ++m) { const int row = row0 + ai * HALF + m * 16; bf16_t* rowp = Vd + (size_t)row * 1024 + col0;
                    const float rs = __builtin_amdgcn_rsqf(part_sum8(part + (size_t)row * 16 + 8) * (1.f / 256) + EPS_);
                    *(u32x4*)(rowp) = pack8(acc[ai][0][m][0] * rs, acc[ai][0][m][1] * rs); *(u32x4*)(rowp + HALF) = pack8(acc[ai][1][m][0] * rs, acc[ai][1][m][1] * rs); }
            return;
        }
        const int head = 4 * u.pn + wc;
        f32x4 gA0 = *(const f32x4*)(g_kn + 8 * fq), gA1 = *(const f32x4*)(g_kn + 8 * fq + 4), gB0 = *(const f32x4*)(g_kn + 32 + 8 * fq), gB1 = *(const f32x4*)(g_kn + 32 + 8 * fq + 4);
        const f32x4 gR1 = *(const f32x4*)(g_kn + 64 + 4 * fq), gR2 = *(const f32x4*)(g_kn + 80 + 4 * fq);
#pragma unroll
        for (int ai = 0; ai < 2; ++ai)
#pragma unroll
            for (int m = 0; m < 4; ++m) { const int row = row0 + ai * HALF + m * 16;
                const float rs = __builtin_amdgcn_rsqf(part_sum8(part + (size_t)row * 16 + 8) * (1.f / 256) + EPS_);
                f32x4 a0 = acc[ai][0][m][0] * rs, a1 = acc[ai][0][m][1] * rs, b0 = acc[ai][1][m][0] * rs, b1 = acc[ai][1][m][1] * rs;
                const unsigned long long p1 = *(const unsigned long long*)(QA + (size_t)row * 768 + 640 + 4 * fq), p2 = *(const unsigned long long*)(QA + (size_t)row * 768 + 656 + 4 * fq);
                f32x4 x1, x2;
                x1[0] = __builtin_bit_cast(float, (unsigned)(p1 << 16)); x1[1] = __builtin_bit_cast(float, (unsigned)p1 & 0xffff0000u);
                x1[2] = __builtin_bit_cast(float, (unsigned)(p1 >> 32) << 16); x1[3] = __builtin_bit_cast(float, (unsigned)(p1 >> 32) & 0xffff0000u);
                x2[0] = __builtin_bit_cast(float, (unsigned)(p2 << 16)); x2[1] = __builtin_bit_cast(float, (unsigned)p2 & 0xffff0000u);
                x2[2] = __builtin_bit_cast(float, (unsigned)(p2 >> 32) << 16); x2[3] = __builtin_bit_cast(float, (unsigned)(p2 >> 32) & 0xffff0000u);
                const float ss = fq_sum(sq8(a0, a1) + sq8(b0, b1) + sq8(x1, x2));
                const float sh = __builtin_amdgcn_rsqf(ss * (1.f / 96) + EPS_);
                bf16_t* kp = Kd + (size_t)row * 1536 + head * 96;
                *(u32x4*)(kp + 8 * fq) = pack8(a0 * gA0 * sh, a1 * gA1 * sh); *(u32x4*)(kp + 32 + 8 * fq) = pack8(b0 * gB0 * sh, b1 * gB1 * sh);
                const f32x4* rp = (const f32x4*)(rope + ((size_t)(row & 2047) * 16 + 4 * fq) * 2);
                const f32x4 c01 = rp[0], c23 = rp[1];
                const f32x4 y1 = x1 * gR1 * sh, y2 = x2 * gR2 * sh;
                f32x4 o1, o2;
                o1[0] = y1[0] * c01[0] - y2[0] * c01[1]; o2[0] = y2[0] * c01[0] + y1[0] * c01[1];
                o1[1] = y1[1] * c01[2] - y2[1] * c01[3]; o2[1] = y2[1] * c01[2] + y1[1] * c01[3];
                o1[2] = y1[2] * c23[0] - y2[2] * c23[1]; o2[2] = y2[2] * c23[0] + y1[2] * c23[1];
                o1[3] = y1[3] * c23[2] - y2[3] * c23[3]; o2[3] = y2[3] * c23[2] + y1[3] * c23[3];
                unsigned long long w1 = (unsigned long long)cvt_pk_bf16(o1[0], o1[1]) | ((unsigned long long)cvt_pk_bf16(o1[2], o1[3]) << 32);
                unsigned long long w2 = (unsigned long long)cvt_pk_bf16(o2[0], o2[1]) | ((unsigned long long)cvt_pk_bf16(o2[2], o2[3]) << 32);
                *(unsigned long long*)(kp + 64 + 4 * fq) = w1; *(unsigned long long*)(kp + 80 + 4 * fq) = w2; }
    }
};

struct EpiK2Q2 {
    static constexpr bool PERM = true, AFTER_DRAIN = false;
    bf16_t* O; const float* pss; const float* gk; const float* gq; float wscale;
    __device__ __forceinline__ void operator()(const f32x4 (&acc)[2][2][4][2], const Unit& u, int wr, int wc, int fr, int fq) const {
        { int t_ = lane_id_(); asm volatile("" : "+v"(t_)); fr = t_ & 15; fq = (t_ >> 4) & 3; }
        const int row0 = u.pm * BM + wr * 64 + fr, isq = u.pn >> 2, tl = u.pn & 3;
        const float* g = isq ? gq : gk; const float post = isq ? 0.125f * 1.4426950408889634f : 1.f;
        const f32x4 gA0 = *(const f32x4*)(g + 8 * fq) * post, gA1 = *(const f32x4*)(g + 8 * fq + 4) * post, gB0 = *(const f32x4*)(g + 32 + 8 * fq) * post, gB1 = *(const f32x4*)(g + 32 + 8 * fq + 4) * post;
        const int colh = isq * 2048 + (4 * tl + wc) * 64;
        unsigned zhi_ = 0u; asm volatile("" : "+v"(zhi_));
        const unsigned long long coff = ((unsigned long long)zhi_ << 32) | (unsigned)((colh + 8 * fq) * 2);
#pragma unroll
        for (int ai = 0; ai < 2; ++ai)
#pragma unroll
            for (int m = 0; m < 4; ++m) { const int row = row0 + ai * HALF + m * 16; unsigned char* rowp = (unsigned char*)O + (size_t)row * 6144 + coff;
                const float rs = __builtin_amdgcn_rsqf(part_sum16(pss + (size_t)row * 16) * (1.f / 1024) + EPS_) * wscale;
                const f32x4 a0 = acc[ai][0][m][0] * rs, a1 = acc[ai][0][m][1] * rs, b0 = acc[ai][1][m][0] * rs, b1 = acc[ai][1][m][1] * rs;
                const float ss = fq_sum(sq8(a0, a1) + sq8(b0, b1));
                const float sh = __builtin_amdgcn_rsqf(ss * (1.f / 64) + EPS_);
                *(u32x4*)(rowp) = pack8(a0 * gA0 * sh, a1 * gA1 * sh); *(u32x4*)(rowp + 64) = pack8(b0 * gB0 * sh, b1 * gB1 * sh); }
    }
};
struct EpiRowScale16 {
    static constexpr bool PERM = true, AFTER_DRAIN = false;
    bf16_t* O; int ldc; int coff; const float* pss; float wscale;
    __device__ __forceinline__ void operator()(const f32x4 (&acc)[2][2][4][2], const Unit& u, int wr, int wc, int fr, int fq) const {
        { int t_ = lane_id_(); asm volatile("" : "+v"(t_)); fr = t_ & 15; fq = (t_ >> 4) & 3; }
        const int row0 = u.pm * BM + wr * 64 + fr, col0 = coff + u.pn * BM + wc * 32 + 8 * fq;
#pragma unroll
        for (int ai = 0; ai < 2; ++ai)
#pragma unroll
            for (int m = 0; m < 4; ++m) { const int row = row0 + ai * HALF + m * 16; bf16_t* rowp = O + (size_t)row * ldc + col0;
                const float rs = __builtin_amdgcn_rsqf(part_sum16(pss + (size_t)row * 16) * (1.f / 1024) + EPS_) * wscale;
                *(u32x4*)(rowp) = pack8(acc[ai][0][m][0] * rs, acc[ai][0][m][1] * rs); *(u32x4*)(rowp + HALF) = pack8(acc[ai][1][m][0] * rs, acc[ai][1][m][1] * rs); }
    }
};

template <bool SSQ> struct EpiGated {
    static constexpr bool PERM = true, AFTER_DRAIN = false;
    bf16_t* Hd; int ldc; int ntile; const float* rs;
    __device__ __forceinline__ void operator()(const f32x4 (&acc)[2][2][4][2], const Unit& u, int wr, int wc, int fr, int fq) const {
        { int t_ = lane_id_(); asm volatile("" : "+v"(t_)); fr = t_ & 15; fq = (t_ >> 4) & 3; }
        const int pnl = ntile ? (u.pn % ntile) : u.pn;
        const int row0 = u.pm * BM + wr * 64 + fr, col0 = pnl * HALF + wc * 32 + 8 * fq;
#pragma unroll
        for (int ai = 0; ai < 2; ++ai)
#pragma unroll
            for (int m = 0; m < 4; ++m) { const int row = row0 + ai * HALF + m * 16; bf16_t* rowp = Hd + (size_t)row * ldc + col0;
                const float r = SSQ ? __builtin_amdgcn_rsqf(part_sum16(rs + (size_t)row * 16) * (1.f / 1024) + EPS_) : rs[row];
                const f32x4 g0 = acc[ai][0][m][0] * r, g1 = acc[ai][0][m][1] * r, u0 = acc[ai][1][m][0] * r, u1 = acc[ai][1][m][1] * r;
                u32x4 w;
                w.x = cvt_pk_bf16(silu_f(g0[0]) * u0[0], silu_f(g0[1]) * u0[1]); w.y = cvt_pk_bf16(silu_f(g0[2]) * u0[2], silu_f(g0[3]) * u0[3]);
                w.z = cvt_pk_bf16(silu_f(g1[0]) * u1[0], silu_f(g1[1]) * u1[1]); w.w = cvt_pk_bf16(silu_f(g1[2]) * u1[2], silu_f(g1[3]) * u1[3]);
                *(u32x4*)rowp = w; }
    }
};

struct EpiGatedF8 {
    static constexpr bool PERM = true, AFTER_DRAIN = false;
    unsigned char* Hd; int ldc; int ntile;
    static __device__ __forceinline__ float gate(float g, float u) {
        const float e = __builtin_amdgcn_exp2f(g * (-1.4426950408889634f / 64.f)); return (g * u) * (__builtin_amdgcn_rcpf(1.f + e) * (1.f / 4096.f)); }
    __device__ __forceinline__ void operator()(const f32x4 (&acc)[2][2][4][2], const Unit& u, int wr, int wc, int fr, int fq) const {
        { int t_ = lane_id_(); asm volatile("" : "+v"(t_)); fr = t_ & 15; fq = (t_ >> 4) & 3; }
        const int pnl = u.pn % ntile;
        const int row0 = u.pm * BM + wr * 64 + fr, col0 = pnl * HALF + wc * 32 + 8 * fq;
#pragma unroll
        for (int ai = 0; ai < 2; ++ai)
#pragma unroll
            for (int m = 0; m < 4; ++m) { const int row = row0 + ai * HALF + m * 16; unsigned char* rowp = Hd + (size_t)row * ldc + col0;
                const f32x4 g0 = acc[ai][0][m][0], g1 = acc[ai][0][m][1], u0 = acc[ai][1][m][0], u1 = acc[ai][1][m][1];
                unsigned long long w = (unsigned long long)pk_fp8x4(gate(g0[0], u0[0]), gate(g0[1], u0[1]), gate(g0[2], u0[2]), gate(g0[3], u0[3]))
                                     | ((unsigned long long)pk_fp8x4(gate(g1[0], u1[0]), gate(g1[1], u1[1]), gate(g1[2], u1[2]), gate(g1[3], u1[3])) << 32);
                *(unsigned long long*)rowp = w; }
    }
};

template <bool SSQ, bool XF8, bool RES16> struct EpiResStream {
    static constexpr bool PERM = true, AFTER_DRAIN = false;
    const void* res; bf16_t* XB; unsigned char* X8; float* ssq; float ascale;
    __device__ __forceinline__ void operator()(const f32x4 (&acc)[2][2][4][2], const Unit& u, int wr, int wc, int fr, int fq) const {
        { int t_ = lane_id_(); asm volatile("" : "+v"(t_)); fr = t_ & 15; fq = (t_ >> 4) & 3; }
        const int row0 = u.pm * BM + wr * 64 + fr, col0 = u.pn * BM + wc * 32 + 8 * fq;
        f32x4 rw[4][2][2];
#define ERS_ROW(it) (row0 + ((it) >> 2) * HALF + ((it) & 3) * 16)
#define ERS_LOAD(it) do { const size_t ro_ = (size_t)ERS_ROW(it) * 1024 + col0; _Pragma("unroll") for (int bj = 0; bj < 2; ++bj) { \
            if constexpr (RES16) rw[(it) & 3][bj][0] = __builtin_bit_cast(f32x4, *(const u32x4*)((const bf16_t*)res + ro_ + bj * HALF)); \
            else { _Pragma("unroll") for (int n = 0; n < 2; ++n) rw[(it) & 3][bj][n] = *(const f32x4*)((const float*)res + ro_ + bj * HALF + n * 4); } } } while (0)
        ERS_LOAD(0); ERS_LOAD(1); ERS_LOAD(2); ERS_LOAD(3);
#pragma unroll
        for (int it = 0; it < 8; ++it) { const int ai = it >> 2, m = it & 3; const int row = ERS_ROW(it); const size_t ro = (size_t)row * 1024 + col0;
                f32x4 r[2][2];
#pragma unroll
                for (int bj = 0; bj < 2; ++bj) {
                    if constexpr (RES16) { const u32x4 w = __builtin_bit_cast(u32x4, rw[it & 3][bj][0]);
                        r[bj][0] = (f32x4){__builtin_bit_cast(float, w.x << 16), __builtin_bit_cast(float, w.x & 0xffff0000u), __builtin_bit_cast(float, w.y << 16), __builtin_bit_cast(float, w.y & 0xffff0000u)};
                        r[bj][1] = (f32x4){__builtin_bit_cast(float, w.z << 16), __builtin_bit_cast(float, w.z & 0xffff0000u), __builtin_bit_cast(float, w.w << 16), __builtin_bit_cast(float, w.w & 0xffff0000u)}; }
                    else { r[bj][0] = rw[it & 3][bj][0]; r[bj][1] = rw[it & 3][bj][1]; }
                    r[bj][0] = r[bj][0] + acc[ai][bj][m][0] * ascale; r[bj][1] = r[bj][1] + acc[ai][bj][m][1] * ascale; }
                if (it + 4 < 8) ERS_LOAD(it + 4);
                *(u32x4*)(XB + ro) = pack8(r[0][0], r[0][1]); *(u32x4*)(XB + ro + HALF) = pack8(r[1][0], r[1][1]);
                if constexpr (XF8) { unsigned char* x8 = X8 + ro;
                    *(unsigned long long*)(x8) = (unsigned long long)pk_fp8x4(r[0][0][0], r[0][0][1], r[0][0][2], r[0][0][3]) | ((unsigned long long)pk_fp8x4(r[0][1][0], r[0][1][1], r[0][1][2], r[0][1][3]) << 32);
                    *(unsigned long long*)(x8 + HALF) = (unsigned long long)pk_fp8x4(r[1][0][0], r[1][0][1], r[1][0][2], r[1][0][3]) | ((unsigned long long)pk_fp8x4(r[1][1][0], r[1][1][1], r[1][1][2], r[1][1][3]) << 32); }
                if (SSQ) { const float t = fq_sum(sq8(r[0][0], r[0][1]) + sq8(r[1][0], r[1][1])); if (fq == 0) ssq[(size_t)row * 16 + u.pn * 4 + wc] = t; } }
#undef ERS_LOAD
#undef ERS_ROW
    }
};

template <bool FIRST> struct EpiMoeDown {
    static constexpr bool PERM = false, AFTER_DRAIN = false;
    float* out; const bf16_t* xb; const int* slot_tok; const float* slot_gate; int slot_base; int ldc; float wscale;
    __device__ __forceinline__ void operator()(const f32x4 (&acc)[2][2][4][2], const Unit& u, int wr, int wc, int fr, int fq) const {
        { int t_ = lane_id_(); asm volatile("" : "+v"(t_)); fr = t_ & 15; fq = (t_ >> 4) & 3; }
        const int pnl = u.pn & 3;
        const int row0 = slot_base + u.pm * BM + wr * 64 + fr, col0 = pnl * BM + wc * 32 + 4 * fq;
        int tk[8]; float gt[8];
#pragma unroll
        for (int it = 0; it < 8; ++it) { const int slot = row0 + (it >> 2) * HALF + (it & 3) * 16; tk[it] = slot_tok[slot]; gt[it] = slot_gate[slot] * wscale; }
        f32x4 rw[4][2][2]; unsigned rlo[4][2][2], rhi[4][2][2];
#define EMD_LOAD(it) do { if (tk[it] >= 0) { _Pragma("unroll") for (int bj = 0; bj < 2; ++bj) _Pragma("unroll") for (int n = 0; n < 2; ++n) { \
            if constexpr (FIRST) { const unsigned long long q_ = *(const unsigned long long*)(xb + (size_t)tk[it] * ldc + col0 + bj * HALF + n * 16); \
                rlo[(it) & 3][bj][n] = (unsigned)q_; rhi[(it) & 3][bj][n] = (unsigned)(q_ >> 32); } \
            else rw[(it) & 3][bj][n] = *(const f32x4*)(out + (size_t)tk[it] * ldc + col0 + bj * HALF + n * 16); } } } while (0)
        EMD_LOAD(0); EMD_LOAD(1); EMD_LOAD(2); EMD_LOAD(3);
#pragma unroll
        for (int it = 0; it < 8; ++it) { const int ai = it >> 2, m = it & 3;
            if (tk[it] >= 0) { float* rowp = out + (size_t)tk[it] * ldc + col0;
#pragma unroll
                for (int bj = 0; bj < 2; ++bj)
#pragma unroll
                    for (int n = 0; n < 2; ++n) { f32x4 r;
                        if constexpr (FIRST) { const unsigned lo = rlo[it & 3][bj][n], hi = rhi[it & 3][bj][n];
                            r = (f32x4){__builtin_bit_cast(float, lo << 16), __builtin_bit_cast(float, lo & 0xffff0000u), __builtin_bit_cast(float, hi << 16), __builtin_bit_cast(float, hi & 0xffff0000u)}; }
                        else r = rw[it & 3][bj][n];
                        *(f32x4*)(rowp + bj * HALF + n * 16) = r + acc[ai][bj][m][n] * gt[it]; } }
            if (it + 4 < 8) EMD_LOAD(it + 4); }
#undef EMD_LOAD
    }
};

struct MoeOrder {
    int nM, nN, nwg, G, c; int pb[7];
    int nBusy, SK;
    __device__ void init(int nPanels, int nN_, int G_, int c_) { nM = nPanels; nN = nN_; nwg = nM * nN; G = G_; c = c_; nBusy = 0; SK = 0; }
    __device__ __forceinline__ int expert_of(int pm) const { int e = 0;
#pragma unroll
        for (int k = 0; k < 7; ++k) e += (pm >= pb[k]) ? 1 : 0;
        return e; }
    __device__ bool next(int i, Unit& u) const {
        int L;
        if (nBusy == 0) L = i * G + c;
        else if (c >= nBusy) L = (i < SK) ? i * (G - nBusy) + (c - nBusy) : SK * (G - nBusy) + (i - SK) * G + c;
        else L = SK * (G - nBusy) + i * G + c;
        if (L >= nwg) return false;
        int wgid = L; { const int q = nwg / NXCD, r = nwg % NXCD, xcd = wgid % NXCD, off = wgid / NXCD; wgid = (xcd < r ? xcd * (q + 1) : r * (q + 1) + (xcd - r) * q) + off; }
        const int nig = WGM * nN, gid = wgid / nig, fm = gid * WGM, gsz = (nM - fm) < WGM ? (nM - fm) : WGM;
        u.pm = fm + ((wgid % nig) % gsz); const int pnl = (wgid % nig) / gsz;
        u.pn = expert_of(u.pm) * nN + pnl; return true;
    }
    __device__ __forceinline__ void a_ready(const Unit&) const {}
    __device__ __forceinline__ void done(const Unit&) const {}
};
struct LeftOrder {
    MoeOrder M; int nLeft;
    __device__ bool next(int i, Unit& u) const { if (i != 0 || M.c >= nLeft) return false; u.pm = 256 + (M.c >> 2); u.pn = M.expert_of(u.pm) * 4 + (M.c & 3); return true; }
    __device__ __forceinline__ void a_ready(const Unit&) const {}
    __device__ __forceinline__ void done(const Unit&) const {}
};
template <class Epi, class Sched, bool ALIGN_EPI = false, bool SP2 = false, bool F8 = false>
__device__ __forceinline__ void gemm_phase(PG8_LAS unsigned char* lds, const Gemm g, const Sched& S, const Epi& E, const int wave_idx) {
    int tid_ = wave_idx * 64 + lane_id_(); asm volatile("" : "+v"(tid_));
    const int tid = tid_, wid = __builtin_amdgcn_readfirstlane(tid >> 6), lane = tid & 63, wr = wid >> 2, wc = wid & 3, fr = lane & 15, fq = lane >> 4;
    const int K = g.K, nt = K / BK;
    unsigned voffA0, voffB0;
    { int R, C; stage_rc(tid * 16, R, C); const int Rb = Epi::PERM ? ((R & ~31) + perm32(R & 31)) : R;
      voffA0 = (unsigned)(R * g.lda + C) * 2u; voffB0 = (unsigned)(Rb * K + C) * 2u; }
    const size_t voffAR = (size_t)64 * g.lda * 2, voffBR = (size_t)64 * K * 2;
    const size_t kstep = (size_t)(BK * 2);
    const size_t hstepA = (size_t)HALF * g.lda * 2, hstepB = (size_t)HALF * K * 2;
    const size_t tstepA = 2 * hstepA, tstepB = 2 * hstepB;
    const unsigned lds0_ = (unsigned)(__UINTPTR_TYPE__)lds;
    const unsigned ldsw = (unsigned)wid * 1024u;
    const int aoff = lds_byte(wr * 64 + fr, fq * 8), boff = lds_byte(wc * 32 + fr, fq * 8);
#define PG8_SA(b, h) (((b) * 2 + (h)) * HTB)
#define PG8_SB(b, h) ((4 + (b) * 2 + (h)) * HTB)
#define PG8_STAGE(bufoff, gbase, voff) do { _Pragma("unroll") for (int _i = 0; _i < 2; ++_i) { unsigned keep_; const char* sb_ = (const char*)(gbase) + (size_t)_i * voff##R; \
        asm volatile("s_mov_b32 %0, m0\n\ts_mov_b32 m0, %3\n\ts_nop 0\n\tglobal_load_lds_dwordx4 %1, %2\n\ts_mov_b32 m0, %0" \
            : "=&s"(keep_) : "v"(voff##0), "s"(sb_), "s"(lds0_ + (unsigned)((bufoff) + _i * 8192) + ldsw) : "memory"); } } while (0)
#define PG8_LDA(dst, b, h) do { _Pragma("unroll") for (int m = 0; m < 4; ++m) _Pragma("unroll") for (int k = 0; k < 2; ++k) dst[m][k] = *(const PG8_LAS bf16x8*)(lds + PG8_SA(b, h) + aoff + m * 2048 + k * 1024); } while (0)
#define PG8_LDB(dst, b, h) do { _Pragma("unroll") for (int n = 0; n < 2; ++n) _Pragma("unroll") for (int k = 0; k < 2; ++k) dst[n][k] = *(const PG8_LAS bf16x8*)(lds + PG8_SB(b, h) + boff + n * 2048 + k * 1024); } while (0)
#define PG8_MMA(ai, bj, At, Bt) do { __builtin_amdgcn_s_setprio(1); _Pragma("unroll") for (int m = 0; m < 4; ++m) _Pragma("unroll") for (int n = 0; n < 2; ++n) { \
        if constexpr (F8) { typedef int v8i_ __attribute__((ext_vector_type(8))); typedef int v4i_ __attribute__((ext_vector_type(4))); \
            const v4i_ b0_ = __builtin_bit_cast(v4i_, Bt[n][0]), b1_ = __builtin_bit_cast(v4i_, Bt[n][1]), a0_ = __builtin_bit_cast(v4i_, At[m][0]), a1_ = __builtin_bit_cast(v4i_, At[m][1]); \
            const v8i_ bb_ = __builtin_shufflevector(b0_, b1_, 0, 1, 2, 3, 4, 5, 6, 7), aa_ = __builtin_shufflevector(a0_, a1_, 0, 1, 2, 3, 4, 5, 6, 7); \
            acc[ai][bj][m][n] = __builtin_amdgcn_mfma_scale_f32_16x16x128_f8f6f4(bb_, aa_, acc[ai][bj][m][n], 0, 0, 0, 0, 0, 0); } \
        else { _Pragma("unroll") for (int k = 0; k < 2; ++k) acc[ai][bj][m][n] = __builtin_amdgcn_mfma_f32_16x16x32_bf16(Bt[n][k], At[m][k], acc[ai][bj][m][n], 0, 0, 0); } } \
        __builtin_amdgcn_s_setprio(0); } while (0)
#define PG8_WAIT_V(n) asm volatile("s_waitcnt vmcnt(" #n ")" ::: "memory")
#define PG8_WAIT_L(n) asm volatile("s_waitcnt lgkmcnt(" #n ")" ::: "memory")
#define PG8_BAR __builtin_amdgcn_s_barrier()
#define PG8_SCHED __builtin_amdgcn_sched_barrier(0)
    Unit cur, nxt; int ui = 0;
    if (!S.next(0, cur)) return;
    f32x4 acc[2][2][4][2];
#pragma unroll
    for (int a = 0; a < 2; ++a)
#pragma unroll
        for (int b = 0; b < 2; ++b)
#pragma unroll
            for (int m = 0; m < 4; ++m)
#pragma unroll
                for (int n = 0; n < 2; ++n) acc[a][b][m][n] = (f32x4){0.f, 0.f, 0.f, 0.f};
    bf16x8 At[4][2], B0[2][2], B1[2][2];
    const char* cA = (const char*)g.A + (size_t)cur.pm * tstepA; const char* cB = (const char*)g.Bt + (size_t)cur.pn * tstepB;
    S.a_ready(cur);
    if constexpr (SP2) {
        PG8_STAGE(PG8_SB(0, 0), cB, voffB); PG8_STAGE(PG8_SB(0, 1), cB + hstepB, voffB); PG8_STAGE(PG8_SA(0, 0), cA, voffA); PG8_STAGE(PG8_SA(0, 1), cA + hstepA, voffA);
        if (wr == 1) PG8_BAR;
        PG8_WAIT_V(2); PG8_BAR;
        PG8_STAGE(PG8_SB(1, 0), cB + kstep, voffB); PG8_STAGE(PG8_SA(1, 0), cA + kstep, voffA); PG8_STAGE(PG8_SB(1, 1), cB + hstepB + kstep, voffB);
        PG8_WAIT_V(6); PG8_BAR;
    } else {
        PG8_STAGE(PG8_SB(0, 0), cB, voffB); PG8_STAGE(PG8_SA(0, 0), cA, voffA); PG8_STAGE(PG8_SB(0, 1), cB + hstepB, voffB); PG8_STAGE(PG8_SA(0, 1), cA + hstepA, voffA);
        if (wr == 1) PG8_BAR;
        PG8_WAIT_V(4); PG8_BAR;
        PG8_STAGE(PG8_SB(1, 0), cB + kstep, voffB); PG8_STAGE(PG8_SA(1, 0), cA + kstep, voffA); PG8_STAGE(PG8_SB(1, 1), cB + hstepB + kstep, voffB);
        PG8_WAIT_V(6); PG8_BAR;
    }
    for (;;) {
        const bool has_next = S.next(ui + 1, nxt);
        const char* nA = has_next ? (const char*)g.A + (size_t)nxt.pm * tstepA : cA; const char* nB = has_next ? (const char*)g.Bt + (size_t)nxt.pn * tstepB : cB;
#pragma unroll 1
        for (int t = 0; t < nt; t += 2) {
            const bool last = (t == nt - 2);
            const char* a1 = cA + (size_t)(t + 1) * kstep;
            const char* a2 = last ? nA : cA + (size_t)(t + 2) * kstep; const char* b2 = last ? nB : cB + (size_t)(t + 2) * kstep;
            const char* a3 = a2 + kstep; const char* b3 = b2 + kstep;
            if (last && has_next) S.a_ready(nxt);
            if constexpr (SP2) {
            PG8_LDB(B0, 0, 0); PG8_LDB(B1, 0, 1); PG8_SCHED; PG8_LDA(At, 0, 0); PG8_STAGE(PG8_SA(1, 1), a1 + hstepA, voffA);
            PG8_WAIT_V(8); PG8_WAIT_L(0); PG8_BAR; PG8_MMA(0, 0, At, B0); PG8_MMA(0, 1, At, B1); PG8_BAR; PG8_SCHED;
            PG8_LDA(At, 0, 1); PG8_STAGE(PG8_SB(0, 0), b2, voffB); PG8_STAGE(PG8_SB(0, 1), b2 + hstepB, voffB); PG8_STAGE(PG8_SA(0, 0), a2, voffA);
            PG8_WAIT_V(8); PG8_WAIT_L(0); PG8_BAR; PG8_MMA(1, 0, At, B0); PG8_MMA(1, 1, At, B1); PG8_BAR; PG8_SCHED;
            PG8_LDB(B0, 1, 0); PG8_LDB(B1, 1, 1); PG8_SCHED; PG8_LDA(At, 1, 0); PG8_STAGE(PG8_SA(0, 1), a2 + hstepA, voffA);
            PG8_WAIT_V(8); PG8_WAIT_L(0); PG8_BAR; PG8_MMA(0, 0, At, B0); PG8_MMA(0, 1, At, B1); PG8_BAR; PG8_SCHED;
            PG8_LDA(At, 1, 1); PG8_STAGE(PG8_SB(1, 0), b3, voffB); PG8_STAGE(PG8_SB(1, 1), b3 + hstepB, voffB); PG8_STAGE(PG8_SA(1, 0), a3, voffA);
            PG8_WAIT_V(8); PG8_WAIT_L(0); PG8_BAR; PG8_MMA(1, 0, At, B0); PG8_MMA(1, 1, At, B1); PG8_BAR; PG8_SCHED;
            } else {
            PG8_LDB(B0, 0, 0); PG8_SCHED; PG8_LDA(At, 0, 0); PG8_STAGE(PG8_SA(1, 1), a1 + hstepA, voffA);
            PG8_WAIT_L(8); PG8_BAR; PG8_WAIT_L(0); PG8_MMA(0, 0, At, B0); PG8_BAR; PG8_SCHED;
            PG8_LDB(B1, 0, 1); PG8_STAGE(PG8_SB(0, 0), b2, voffB);
            PG8_BAR; PG8_WAIT_L(0); PG8_MMA(0, 1, At, B1); PG8_BAR;
            PG8_LDA(At, 0, 1); PG8_STAGE(PG8_SA(0, 0), a2, voffA);
            PG8_BAR; PG8_WAIT_L(0); PG8_MMA(1, 0, At, B0); PG8_BAR; PG8_SCHED;
            PG8_STAGE(PG8_SB(0, 1), b2 + hstepB, voffB);
            PG8_WAIT_V(6); PG8_BAR; PG8_MMA(1, 1, At, B1); PG8_BAR;
            PG8_LDB(B0, 1, 0); PG8_SCHED; PG8_LDA(At, 1, 0); PG8_STAGE(PG8_SA(0, 1), a2 + hstepA, voffA);
            PG8_WAIT_L(8); PG8_BAR; PG8_WAIT_L(0); PG8_MMA(0, 0, At, B0); PG8_BAR; PG8_SCHED;
            PG8_LDB(B1, 1, 1); PG8_STAGE(PG8_SB(1, 0), b3, voffB);
            PG8_BAR; PG8_WAIT_L(0); PG8_MMA(0, 1, At, B1); PG8_BAR;
            PG8_LDA(At, 1, 1); PG8_STAGE(PG8_SA(1, 0), a3, voffA);
            PG8_BAR; PG8_WAIT_L(0); PG8_MMA(1, 0, At, B0); PG8_BAR; PG8_SCHED;
            PG8_STAGE(PG8_SB(1, 1), b3 + hstepB, voffB);
            PG8_WAIT_V(6); PG8_BAR; PG8_MMA(1, 1, At, B1); PG8_BAR;
            }
        }
        if constexpr (ALIGN_EPI) { if (wr == 0) PG8_BAR; }
        if constexpr (!Epi::AFTER_DRAIN) { E(acc, cur, wr, wc, fr, fq); S.done(cur); }
        if (!has_next) break;
#pragma unroll
        for (int a = 0; a < 2; ++a)
#pragma unroll
            for (int b = 0; b < 2; ++b)
#pragma unroll
                for (int m = 0; m < 4; ++m)
#pragma unroll
                    for (int n = 0; n < 2; ++n) acc[a][b][m][n] = (f32x4){0.f, 0.f, 0.f, 0.f};
        cur = nxt; cA = nA; cB = nB; ++ui;
        if constexpr (ALIGN_EPI) { if (wr == 1) PG8_BAR; }
    }
    PG8_WAIT_V(0);
    if constexpr (!ALIGN_EPI) { if (wr == 0) PG8_BAR; }
    PG8_BAR;
    if constexpr (Epi::AFTER_DRAIN) { E.fused(acc, cur, wr, wc, fr, fq, lds, wid, lane); S.done(cur); }
#undef PG8_SA
#undef PG8_SB
#undef PG8_STAGE
#undef PG8_LDA
#undef PG8_LDB
#undef PG8_MMA
#undef PG8_WAIT_V
#undef PG8_WAIT_L
#undef PG8_BAR
#undef PG8_SCHED
}
}
namespace att {
#define ATT_LAS __attribute__((address_space(3)))
typedef unsigned short bf16;
typedef short bf16x8 __attribute__((ext_vector_type(8)));
typedef short s16x4 __attribute__((ext_vector_type(4)));
typedef float f32x16 __attribute__((ext_vector_type(16)));
typedef float f32x4_t __attribute__((ext_vector_type(4)));
typedef unsigned u32x4 __attribute__((ext_vector_type(4)));
typedef unsigned u32x2 __attribute__((ext_vector_type(2)));
typedef float f32x2_t __attribute__((ext_vector_type(2))); typedef __bf16 bf16x2_t __attribute__((ext_vector_type(2)));
__device__ __forceinline__ unsigned cvtpk(float lo, float hi) { f32x2_t v = {lo, hi}; bf16x2_t b = __builtin_convertvector(v, bf16x2_t); return __builtin_bit_cast(unsigned, b); }
__device__ __forceinline__ s16x4 vtr(const ATT_LAS unsigned char* p) { return __builtin_bit_cast(s16x4, __builtin_amdgcn_ds_read_tr16_b64_v4i16((ATT_LAS s16x4*)p)); }
constexpr int VSTR = 192;
template <int DQK> struct Geo { static constexpr int KSTR = DQK * 2 + 16, KBUF = 64 * KSTR, VBUF = 64 * VSTR, CPR = DQK / 8, NKC = 64 * CPR, KIT = (NKC + 511) / 512; };
template <int DQK> constexpr int lds_bytes() { return 2 * Geo<DQK>::KBUF + 2 * Geo<DQK>::VBUF + 2048 + 8192; }

__device__ __forceinline__ float xhalf_sum(float m) { return xor32_sum(m); }
__device__ __forceinline__ float max3f(float a, float b, float c) { float r; asm("v_max3_f32 %0, %1, %2, %3" : "=v"(r) : "v"(a), "v"(b), "v"(c)); return r; }
__device__ __forceinline__ float max2f(float a, float b) { float r; asm("v_max_f32_e32 %0, %1, %2" : "=v"(r) : "v"(a), "v"(b)); return r; }
__device__ __forceinline__ float rowmax32(const f32x16& p0, const f32x16& p1) {
    float a = max2f(p0[0], p1[0]), b = max2f(p0[1], p1[1]), c = max2f(p0[2], p1[2]), d = max2f(p0[3], p1[3]);
#pragma unroll
    for (int r = 4; r < 16; r += 4) { a = max3f(a, p0[r], p1[r]); b = max3f(b, p0[r + 1], p1[r + 1]); c = max3f(c, p0[r + 2], p1[r + 2]); d = max3f(d, p0[r + 3], p1[r + 3]); }
    const float m = max2f(max2f(a, b), max2f(c, d));
    float lo_, hi_; halves32(m, lo_, hi_);
    return max2f(lo_, hi_);
}

template <int DQK, bool BAND, int qpitch, int kpitch, int vpitch, int opitch, bool OF8 = false, bool NOMAX = false>
__device__ __forceinline__ void attn_unit(ATT_LAS unsigned char* lds, const bf16* Qb, const bf16* Kb, const bf16* Vb, bf16* Ob,
                                          int q0, int t_lo, int t_hi, int my_lo, int my_hi, int cc, const float* bias_g, const float* g_qn, const float* rope, const int wave_idx) {
    typedef Geo<DQK> G;
    int tid_ = wave_idx * 64 + lane_id_(); asm volatile("" : "+v"(tid_));
    const int tid = tid_, lane = tid & 63, r32 = lane & 31, hi = lane >> 5, wid = __builtin_amdgcn_readfirstlane(tid >> 6);
    ATT_LAS float* biasL = (ATT_LAS float*)(lds + 2 * G::KBUF + 2 * G::VBUF);
    bf16x8 qf[DQK / 16];
    { const bf16* qp = Qb + (size_t)(q0 + wid * 32 + r32) * qpitch + 8 * hi;
#pragma unroll
      for (int kk = 0; kk < DQK / 16; ++kk) qf[kk] = *(const bf16x8*)(qp + 16 * kk); }
    if constexpr (!BAND) {
        float qv[DQK / 16][8]; float ss = 0.f;
#pragma unroll
        for (int kk = 0; kk < DQK / 16; ++kk)
#pragma unroll
            for (int j = 0; j < 8; ++j) { qv[kk][j] = __builtin_bit_cast(float, (unsigned)(unsigned short)qf[kk][j] << 16); ss += qv[kk][j] * qv[kk][j]; }
        ss = xhalf_sum(ss);
        const float rs = __builtin_amdgcn_rsqf(ss * (1.f / DQK) + 1e-6f) * (0.10206207261596577f * 1.4426950408889634f);
#pragma unroll
        for (int kk = 0; kk < DQK / 16; ++kk) { const f32x4_t g0 = *(const f32x4_t*)(g_qn + 16 * kk + 8 * hi), g1 = *(const f32x4_t*)(g_qn + 16 * kk + 8 * hi + 4);
#pragma unroll
            for (int j = 0; j < 4; ++j) { qv[kk][j] *= rs * g0[j]; qv[kk][4 + j] *= rs * g1[j]; } }
        const f32x4_t* rp = (const f32x4_t*)(rope + ((size_t)(q0 + wid * 32 + r32) * 16 + 8 * hi) * 2);
#pragma unroll
        for (int j2 = 0; j2 < 4; ++j2) { const f32x4_t cs = rp[j2];
            { const float x1 = qv[4][2 * j2], x2 = qv[5][2 * j2]; qv[4][2 * j2] = x1 * cs[0] - x2 * cs[1]; qv[5][2 * j2] = x2 * cs[0] + x1 * cs[1]; }
            { const float x1 = qv[4][2 * j2 + 1], x2 = qv[5][2 * j2 + 1]; qv[4][2 * j2 + 1] = x1 * cs[2] - x2 * cs[3]; qv[5][2 * j2 + 1] = x2 * cs[2] + x1 * cs[3]; } }
#pragma unroll
        for (int kk = 0; kk < DQK / 16; ++kk) { u32x4 w; w.x = cvtpk(qv[kk][0], qv[kk][1]); w.y = cvtpk(qv[kk][2], qv[kk][3]); w.z = cvtpk(qv[kk][4], qv[kk][5]); w.w = cvtpk(qv[kk][6], qv[kk][7]);
            qf[kk] = __builtin_bit_cast(bf16x8, w); }
    }
    if (BAND) { if (tid < 257) biasL[tid] = bias_g[tid] * 1.4426950408889634f; }
    constexpr int KCPL = G::KSTR / 16, KNP = (64 * KCPL + 63) / 64;
    constexpr int VCPL = VSTR / 16, VNP = 64 * VCPL / 64;
    constexpr int KPP = (KNP + 7) / 8, VPP = (VNP + 7) / 8;
    ATT_LAS unsigned* dmaL = (ATT_LAS unsigned*)(lds + 2 * G::KBUF + 2 * G::VBUF + 2048) + wid * 256 + lane;
#pragma unroll
    for (int pp = 0; pp < KPP; ++pp) { const int pc = wid + 8 * pp, c = pc * 64 + lane, row = (c / KCPL) & 63, ch = c % KCPL; dmaL[64 * pp] = (unsigned)(row * kpitch + (ch < G::CPR ? ch : 0) * 8) * 2u; }
#pragma unroll
    for (int pp = 0; pp < VPP; ++pp) { const int pc = wid + 8 * pp, c = pc * 64 + lane, row = (c / VCPL) & 63, ch = c % VCPL; dmaL[128 + 64 * pp] = (unsigned)(row * vpitch + (ch < 8 ? ch : 0) * 8) * 2u; }
    const unsigned ldsb = __builtin_amdgcn_readfirstlane((unsigned)(size_t)lds);
#define ATT_MOD3(x) ((x) & 1)
#define ATT_DMA1(gptr, voff_, ldsaddr) do { unsigned keep_; asm volatile("s_mov_b32 %0, m0\n\ts_mov_b32 m0, %3\n\ts_nop 0\n\tglobal_load_lds_dwordx4 %1, %2\n\ts_mov_b32 m0, %0" \
            : "=&s"(keep_) : "v"(voff_), "s"(gptr), "s"(ldsaddr) : "memory"); } while (0)
#define ATT_DMA_K(t) do { const int t_ = (t); const char* kt_ = (const char*)(Kb + (size_t)t_ * 64 * kpitch); const unsigned d_ = ldsb + ATT_MOD3(t_) * G::KBUF + wid * 1024; \
        _Pragma("unroll") for (int pp = 0; pp < KPP; ++pp) { if (wid + 8 * pp < KNP) { const unsigned vo_ = dmaL[64 * pp]; ATT_DMA1(kt_, vo_, d_ + pp * 8192); } } } while (0)
#define ATT_DMA_V(t) do { const int t_ = (t); const char* vt_ = (const char*)(Vb + (size_t)t_ * 64 * vpitch); const unsigned d_ = ldsb + 2 * G::KBUF + ATT_MOD3(t_) * G::VBUF + wid * 1024; \
        _Pragma("unroll") for (int pp = 0; pp < VPP; ++pp) { if (wid + 8 * pp < VNP) { const unsigned vo_ = dmaL[128 + 64 * pp]; ATT_DMA1(vt_, vo_, d_ + pp * 8192); } } } while (0)
#define ATT_WAITBAR(n) do { const int n_ = (n); \
        if (n_ == 0) asm volatile("s_waitcnt vmcnt(0) lgkmcnt(0)\n\ts_barrier" ::: "memory"); else if (n_ == 1) asm volatile("s_waitcnt vmcnt(1) lgkmcnt(0)\n\ts_barrier" ::: "memory"); \
        else if (n_ == 2) asm volatile("s_waitcnt vmcnt(2) lgkmcnt(0)\n\ts_barrier" ::: "memory"); else if (n_ == 3) asm volatile("s_waitcnt vmcnt(3) lgkmcnt(0)\n\ts_barrier" ::: "memory"); \
        else asm volatile("s_waitcnt vmcnt(4) lgkmcnt(0)\n\ts_barrier" ::: "memory"); } while (0)
    f32x16 o0, o1;
#pragma unroll
    for (int i = 0; i < 16; ++i) { o0[i] = 0.f; o1[i] = 0.f; }
    float mrun = -INFINITY, lsum = 0.f; float ls4[4] = {0.f, 0.f, 0.f, 0.f};
    const int koff = r32 * G::KSTR + hi * 16;
    const int voff = ((lane >> 5) * 4 + ((lane & 15) >> 2)) * VSTR + (((lane >> 4) & 1) * 16 + (lane & 3) * 4) * 2;
    const f32x16 zero16 = {0.f, 0.f, 0.f, 0.f, 0.f, 0.f, 0.f, 0.f, 0.f, 0.f, 0.f, 0.f, 0.f, 0.f, 0.f, 0.f};
#define ATT_QK(X0, X1, t) do { const ATT_LAS unsigned char* Kt = lds + ATT_MOD3(t) * G::KBUF + koff; \
        _Pragma("unroll") for (int kk = 0; kk < DQK / 16; ++kk) { \
            const bf16x8 a0 = *(const ATT_LAS bf16x8*)(Kt + kk * 32); const bf16x8 a1 = *(const ATT_LAS bf16x8*)(Kt + 32 * G::KSTR + kk * 32); \
            X0 = __builtin_amdgcn_mfma_f32_32x32x16_bf16(a0, qf[kk], kk ? X0 : zero16, 0, 0, 0); X1 = __builtin_amdgcn_mfma_f32_32x32x16_bf16(a1, qf[kk], kk ? X1 : zero16, 0, 0, 0); } } while (0)
#define ATT_FARSCALE() do { const float f_ = __builtin_amdgcn_exp2f(biasL[256]); _Pragma("unroll") for (int i = 0; i < 16; ++i) { o0[i] *= f_; o1[i] *= f_; } \
        ls4[0] *= f_; ls4[1] *= f_; ls4[2] *= f_; ls4[3] *= f_; } while (0)
#define ATT_SMPV(X0, X1, t) do { \
        float cadd = 0.f; \
        if (BAND) { const int delta = cc - (t); \
            if (delta >= 3) { if constexpr (!NOMAX) cadd = biasL[256]; } \
            else { const ATT_LAS float* bp = biasL + (64 * delta + (32 * (wid & 1) + r32) - 4 * hi + 128 - 63); \
                if (delta < 2) { _Pragma("unroll") for (int i = 0; i < 16; ++i) { const int kj = (i & 3) + 8 * (i >> 2); X0[i] += bp[63 - kj]; X1[i] += bp[31 - kj]; } } \
                else { const int relb = 64 * delta + (32 * (wid & 1) + r32) - 4 * hi + 128; \
                    _Pragma("unroll") for (int i = 0; i < 16; ++i) { const int kj = (i & 3) + 8 * (i >> 2); int i0 = relb - kj, i1 = relb - kj - 32; i0 = i0 > 256 ? 256 : i0; i1 = i1 > 256 ? 256 : i1; \
                        X0[i] += biasL[i0]; X1[i] += biasL[i1]; } } } } \
        if constexpr (NOMAX) { \
            _Pragma("unroll") for (int i = 0; i < 16; ++i) { X0[i] = __builtin_amdgcn_exp2f(X0[i]); X1[i] = __builtin_amdgcn_exp2f(X1[i]); ls4[i & 3] += X0[i] + X1[i]; } \
        } else { \
        const float mt = rowmax32(X0, X1) + cadd; \
        const float mnew = max2f(mrun, mt); \
        const float alpha = __builtin_amdgcn_exp2f(mrun - mnew); \
        const float msub = mnew - cadd; \
        mrun = mnew; \
        float psa[4] = {0.f, 0.f, 0.f, 0.f};   \
        _Pragma("unroll") for (int i = 0; i < 16; ++i) { X0[i] = __builtin_amdgcn_exp2f(X0[i] - msub); X1[i] = __builtin_amdgcn_exp2f(X1[i] - msub); psa[i & 3] += X0[i] + X1[i]; } \
        const float ps = (psa[0] + psa[1]) + (psa[2] + psa[3]); \
        lsum = lsum * alpha + ps; \
        _Pragma("unroll") for (int i = 0; i < 16; ++i) { o0[i] *= alpha; o1[i] *= alpha; } } \
        bf16x8 pf[2][2]; \
        _Pragma("unroll") for (int s = 0; s < 2; ++s) { u32x4 w0, w1; \
            w0.x = cvtpk(X0[8 * s + 0], X0[8 * s + 1]); w0.y = cvtpk(X0[8 * s + 2], X0[8 * s + 3]); w0.z = cvtpk(X0[8 * s + 4], X0[8 * s + 5]); w0.w = cvtpk(X0[8 * s + 6], X0[8 * s + 7]); \
            w1.x = cvtpk(X1[8 * s + 0], X1[8 * s + 1]); w1.y = cvtpk(X1[8 * s + 2], X1[8 * s + 3]); w1.z = cvtpk(X1[8 * s + 4], X1[8 * s + 5]); w1.w = cvtpk(X1[8 * s + 6], X1[8 * s + 7]); \
            pf[0][s] = __builtin_bit_cast(bf16x8, w0); pf[1][s] = __builtin_bit_cast(bf16x8, w1); } \
        const ATT_LAS unsigned char* Vt = lds + 2 * G::KBUF + ATT_MOD3(t) * G::VBUF + voff; \
        _Pragma("unroll") for (int kb = 0; kb < 2; ++kb) _Pragma("unroll") for (int s = 0; s < 2; ++s) { \
            const ATT_LAS unsigned char* vp = Vt + (32 * kb + 16 * s) * VSTR; \
            const s16x4 l0 = vtr(vp), h0 = vtr(vp + 8 * VSTR), l1 = vtr(vp + 64), h1 = vtr(vp + 8 * VSTR + 64); \
            const bf16x8 a0 = (bf16x8){l0[0], l0[1], l0[2], l0[3], h0[0], h0[1], h0[2], h0[3]}; \
            const bf16x8 a1 = (bf16x8){l1[0], l1[1], l1[2], l1[3], h1[0], h1[1], h1[2], h1[3]}; \
            o0 = __builtin_amdgcn_mfma_f32_32x32x16_bf16(a0, pf[kb][s], o0, 0, 0, 0); o1 = __builtin_amdgcn_mfma_f32_32x32x16_bf16(a1, pf[kb][s], o1, 0, 0, 0); } \
        if constexpr (NOMAX && BAND) { if (cc - (t) == 3) ATT_FARSCALE(); } } while (0)
#define ATT_FUSED(C0, C1, N0, N1, t, tn) do { \
        bf16x8 kfa[DQK / 16], kfb[DQK / 16]; \
        { const ATT_LAS unsigned char* Kt = lds + ATT_MOD3(tn) * G::KBUF + koff; \
          _Pragma("unroll") for (int kk = 0; kk < DQK / 16; ++kk) { kfa[kk] = *(const ATT_LAS bf16x8*)(Kt + kk * 32); kfb[kk] = *(const ATT_LAS bf16x8*)(Kt + 32 * G::KSTR + kk * 32); } } \
        __builtin_amdgcn_sched_barrier(0); \
        float cadd = 0.f; \
        if (BAND) { const int delta = cc - (t); \
            if (delta >= 3) { if constexpr (!NOMAX) cadd = biasL[256]; } \
            else { const ATT_LAS float* bp = biasL + (64 * delta + (32 * (wid & 1) + r32) - 4 * hi + 128 - 63); \
                if (delta < 2) { _Pragma("unroll") for (int i = 0; i < 16; ++i) { const int kj = (i & 3) + 8 * (i >> 2); C0[i] += bp[63 - kj]; C1[i] += bp[31 - kj]; } } \
                else { const int relb = 64 * delta + (32 * (wid & 1) + r32) - 4 * hi + 128; \
                    _Pragma("unroll") for (int i = 0; i < 16; ++i) { const int kj = (i & 3) + 8 * (i >> 2); int i0 = relb - kj, i1 = relb - kj - 32; i0 = i0 > 256 ? 256 : i0; i1 = i1 > 256 ? 256 : i1; \
                        C0[i] += biasL[i0]; C1[i] += biasL[i1]; } } } } \
        float alpha = 1.f, msub = 0.f; \
        if constexpr (!NOMAX) { \
        const float mt = rowmax32(C0, C1) + cadd; \
        const float mnew = max2f(mrun, mt); \
        alpha = __builtin_amdgcn_exp2f(mrun - mnew); \
        msub = mnew - cadd; \
        if (__builtin_amdgcn_ballot_w64(mnew > mrun)) { _Pragma("unroll") for (int i = 0; i < 16; ++i) { o0[i] *= alpha; o1[i] *= alpha; } } \
        mrun = mnew; } \
        __builtin_amdgcn_sched_barrier(0); \
        _Pragma("unroll") for (int kk = 0; kk < DQK / 16; ++kk) { \
            N0 = __builtin_amdgcn_mfma_f32_32x32x16_bf16(kfa[kk], qf[kk], kk ? N0 : zero16, 0, 0, 0); N1 = __builtin_amdgcn_mfma_f32_32x32x16_bf16(kfb[kk], qf[kk], kk ? N1 : zero16, 0, 0, 0); } \
        s16x4 vl0[4], vh0[4], vl1[4], vh1[4]; \
        { const ATT_LAS unsigned char* Vt = lds + 2 * G::KBUF + ATT_MOD3(t) * G::VBUF + voff; \
          _Pragma("unroll") for (int ks = 0; ks < 4; ++ks) { const ATT_LAS unsigned char* vp = Vt + 16 * ks * VSTR; vl0[ks] = vtr(vp); vh0[ks] = vtr(vp + 8 * VSTR); vl1[ks] = vtr(vp + 64); vh1[ks] = vtr(vp + 8 * VSTR + 64); } } \
        if constexpr (NOMAX) { \
            _Pragma("unroll") for (int i = 0; i < 16; ++i) { C0[i] = __builtin_amdgcn_exp2f(C0[i]); C1[i] = __builtin_amdgcn_exp2f(C1[i]); ls4[i & 3] += C0[i] + C1[i]; } \
        } else { \
        float psa[4] = {0.f, 0.f, 0.f, 0.f}; \
        _Pragma("unroll") for (int i = 0; i < 16; ++i) { C0[i] = __builtin_amdgcn_exp2f(C0[i] - msub); C1[i] = __builtin_amdgcn_exp2f(C1[i] - msub); psa[i & 3] += C0[i] + C1[i]; } \
        const float ps = (psa[0] + psa[1]) + (psa[2] + psa[3]); \
        lsum = lsum * alpha + ps; } \
        bf16x8 pf[4]; \
        _Pragma("unroll") for (int s = 0; s < 2; ++s) { u32x4 w0, w1; \
            w0.x = cvtpk(C0[8 * s + 0], C0[8 * s + 1]); w0.y = cvtpk(C0[8 * s + 2], C0[8 * s + 3]); w0.z = cvtpk(C0[8 * s + 4], C0[8 * s + 5]); w0.w = cvtpk(C0[8 * s + 6], C0[8 * s + 7]); \
            w1.x = cvtpk(C1[8 * s + 0], C1[8 * s + 1]); w1.y = cvtpk(C1[8 * s + 2], C1[8 * s + 3]); w1.z = cvtpk(C1[8 * s + 4], C1[8 * s + 5]); w1.w = cvtpk(C1[8 * s + 6], C1[8 * s + 7]); \
            pf[s] = __builtin_bit_cast(bf16x8, w0); pf[2 + s] = __builtin_bit_cast(bf16x8, w1); } \
        __builtin_amdgcn_sched_barrier(0); \
        _Pragma("unroll") for (int ks = 0; ks < 4; ++ks) { \
            const bf16x8 a0 = (bf16x8){vl0[ks][0], vl0[ks][1], vl0[ks][2], vl0[ks][3], vh0[ks][0], vh0[ks][1], vh0[ks][2], vh0[ks][3]}; \
            const bf16x8 a1 = (bf16x8){vl1[ks][0], vl1[ks][1], vl1[ks][2], vl1[ks][3], vh1[ks][0], vh1[ks][1], vh1[ks][2], vh1[ks][3]}; \
            o0 = __builtin_amdgcn_mfma_f32_32x32x16_bf16(a0, pf[ks], o0, 0, 0, 0); o1 = __builtin_amdgcn_mfma_f32_32x32x16_bf16(a1, pf[ks], o1, 0, 0, 0); } \
        if constexpr (NOMAX && BAND) { if (cc - (t) == 3) ATT_FARSCALE(); } } while (0)
#define ATT_STAGE(t) do { if ((t) + 2 <= t_hi) ATT_DMA_K((t) + 2); if ((t) + 1 <= t_hi) ATT_DMA_V((t) + 1); } while (0)
#define ATT_NFL(t) 0
    f32x16 sa0, sa1, sb0, sb1;
    ATT_DMA_K(t_lo); ATT_DMA_V(t_lo);
    if (t_lo + 1 <= t_hi) ATT_DMA_K(t_lo + 1);
    ATT_WAITBAR(0);
    if (my_lo == t_lo) ATT_QK(sa0, sa1, t_lo);
    ATT_WAITBAR(0);
    {
        int t = t_lo;
        for (; t < my_lo - 1; ++t) { ATT_STAGE(t); ATT_WAITBAR(ATT_NFL(t)); }
        if (my_lo > t_lo) { ATT_STAGE(t); ATT_QK(sa0, sa1, t + 1); ATT_WAITBAR(ATT_NFL(t)); ++t; }
        int nf = my_hi - my_lo;
        for (; nf >= 2; nf -= 2, t += 2) {
            ATT_STAGE(t); ATT_FUSED(sa0, sa1, sb0, sb1, t, t + 1); ATT_WAITBAR(ATT_NFL(t));
            ATT_STAGE(t + 1); ATT_FUSED(sb0, sb1, sa0, sa1, t + 1, t + 2); ATT_WAITBAR(ATT_NFL(t + 1));
        }
        if (nf == 1) {
            ATT_STAGE(t); ATT_FUSED(sa0, sa1, sb0, sb1, t, t + 1); ATT_WAITBAR(ATT_NFL(t)); ++t;
            ATT_STAGE(t); ATT_SMPV(sb0, sb1, t); ATT_WAITBAR(ATT_NFL(t)); ++t;
        } else {
            ATT_STAGE(t); ATT_SMPV(sa0, sa1, t); ATT_WAITBAR(ATT_NFL(t)); ++t;
        }
        for (; t <= t_hi; ++t) { ATT_STAGE(t); ATT_WAITBAR(ATT_NFL(t)); }
    }
    if constexpr (NOMAX) lsum = (ls4[0] + ls4[1]) + (ls4[2] + ls4[3]);
    const float ltot = xhalf_sum(lsum);
    const float inv = 1.f / ltot;
    if constexpr (OF8) {
        unsigned char* op = (unsigned char*)Ob + (size_t)(q0 + wid * 32 + r32) * opitch + 4 * hi; const float i64 = inv * 32.f;
#pragma unroll
        for (int g4 = 0; g4 < 4; ++g4) {
            int w0 = 0, w1 = 0;
            w0 = __builtin_amdgcn_cvt_pk_fp8_f32(o0[4 * g4 + 0] * i64, o0[4 * g4 + 1] * i64, w0, false); w0 = __builtin_amdgcn_cvt_pk_fp8_f32(o0[4 * g4 + 2] * i64, o0[4 * g4 + 3] * i64, w0, true);
            w1 = __builtin_amdgcn_cvt_pk_fp8_f32(o1[4 * g4 + 0] * i64, o1[4 * g4 + 1] * i64, w1, false); w1 = __builtin_amdgcn_cvt_pk_fp8_f32(o1[4 * g4 + 2] * i64, o1[4 * g4 + 3] * i64, w1, true);
            *(int*)(op + 8 * g4) = w0; *(int*)(op + 32 + 8 * g4) = w1;
        }
    } else {
    bf16* op = Ob + (size_t)(q0 + wid * 32 + r32) * opitch + 4 * hi;
#pragma unroll
    for (int g4 = 0; g4 < 4; ++g4) {
        u32x2 w0, w1;
        w0.x = cvtpk(o0[4 * g4 + 0] * inv, o0[4 * g4 + 1] * inv); w0.y = cvtpk(o0[4 * g4 + 2] * inv, o0[4 * g4 + 3] * inv);
        w1.x = cvtpk(o1[4 * g4 + 0] * inv, o1[4 * g4 + 1] * inv); w1.y = cvtpk(o1[4 * g4 + 2] * inv, o1[4 * g4 + 3] * inv);
        *(u32x2*)(op + 8 * g4) = w0; *(u32x2*)(op + 32 + 8 * g4) = w1;
    }
    }
#undef ATT_DMA_K
#undef ATT_DMA_V
#undef ATT_QK
#undef ATT_SMPV
#undef ATT_STAGE
#undef ATT_FUSED
#undef ATT_MOD3
#undef ATT_DMA1
#undef ATT_WAITBAR
#undef ATT_NFL
#undef ATT_FARSCALE
}
}
constexpr int NWAVES = 8;
constexpr int D = 1024, BATCH = 32, SEQ = 2048, M = BATCH * SEQ;
constexpr int NH = 16, QLORA = 384, KVLORA = 256, ROPE_D = 32, NOPE = 64, QKD = 96;
constexpr int NA = 768;
constexpr int FF = 2816, EFF = 3584, NE = 8;
constexpr float EPS = 1e-6f, LOG2E = 1.4426950408889634f;
constexpr int MAXP_HALF = 264, MAXP = 528;
constexpr size_t MiB = 1u << 20;
constexpr size_t WS_CTL = 0, CTL_ZERO_BYTES = 1 * MiB;
constexpr size_t WS_ROPE = 1 * MiB;
constexpr size_t WS_CNT = WS_ROPE + 256 * 1024;
constexpr size_t WS_PANELE = WS_CNT + 16 * 1024;
constexpr size_t WS_META = WS_PANELE + 4096;
constexpr size_t WS_TOKE = 2 * MiB;
constexpr size_t WS_TOKG = WS_TOKE + (size_t)M * 4;
constexpr size_t WS_SLOTTOK = WS_TOKG + (size_t)M * 8;
constexpr size_t WS_SLOTGATE = WS_SLOTTOK + (size_t)MAXP * 256 * 4;
constexpr size_t WS_PARTQA = 976 * MiB, WS_PART1 = 980 * MiB, WS_PART2 = 984 * MiB;
constexpr size_t WS_TOKRSTD = 4 * MiB;
constexpr size_t WS_SLOTRSTD = WS_TOKRSTD + (size_t)M * 4;
static_assert(WS_SLOTGATE + (size_t)MAXP * 256 * 4 <= WS_TOKRSTD && WS_SLOTRSTD + (size_t)MAXP * 256 * 4 <= 8 * MiB, "small arrays");
constexpr size_t WS_W = 8 * MiB;
constexpr size_t WS_WA = WS_W, WS_WUQ = WS_WA + (size_t)NA * D * 2, WS_WUKV = WS_WUQ + (size_t)1536 * QLORA * 2, WS_WO = WS_WUKV + (size_t)2048 * KVLORA * 2;
constexpr size_t WS_WF1 = WS_WO + (size_t)D * D * 2, WS_WF2 = WS_WF1 + (size_t)2 * FF * D * 2, WS_WKVQ = WS_WF2 + (size_t)D * FF * 2, WS_WBO = WS_WKVQ + (size_t)3 * D * D * 2;
constexpr size_t WS_WM1 = WS_WBO + (size_t)D * D * 2, WS_WM2 = WS_WM1 + (size_t)NE * 2 * EFF * D * 2, WS_WEND = WS_WM2 + (size_t)NE * D * EFF * 2;
constexpr size_t ARENA = 208 * MiB;
static_assert(WS_WEND <= ARENA, "weights fit under the arena");
constexpr size_t WS_XN = ARENA;
constexpr size_t WS_QA = ARENA + 128 * MiB;
constexpr size_t WS_Q = ARENA + 224 * MiB;
constexpr size_t WS_K = ARENA + 416 * MiB;
constexpr size_t WS_V = ARENA + 608 * MiB;
constexpr size_t WS_O = ARENA;
static_assert(WS_V + (size_t)M * D * 2 <= 1024 * MiB, "MLA arena");
constexpr size_t WS_XR1 = ARENA + 128 * MiB;
constexpr size_t WS_H = ARENA + 256 * MiB;
constexpr size_t WS_XR2 = ARENA;
constexpr size_t WS_X2B = ARENA + 608 * MiB;
constexpr size_t WS_KVQ2 = ARENA + 128 * MiB;
constexpr size_t WS_O2 = ARENA + 512 * MiB;
constexpr size_t WS_XR3 = ARENA + 132 * MiB;
constexpr size_t WS_XG = ARENA;
constexpr size_t WS_HM = ARENA + 264 * MiB;
constexpr size_t WS_END = WS_HM + (size_t)MAXP_HALF * 256 * EFF * 2;
static_assert(WS_XG + (size_t)MAXP * 256 * D <= WS_XR3 && WS_XR3 + (size_t)M * D * 2 <= WS_HM && WS_END <= 1024 * MiB && WS_H + (size_t)M * FF * 2 <= WS_X2B && WS_X2B + (size_t)M * D * 2 <= 976 * MiB && WS_O2 + (size_t)M * D <= WS_X2B, "arena");
constexpr int CW_BAR = 4096;
constexpr int RING_OFF = 0, RING_BYTES = 131072;
constexpr int P0_SCR = 128 * 33 * 4;
constexpr int LDSCTL_OFF = 8 * P0_SCR, MISC_OFF = LDSCTL_OFF + 320;
static_assert(LDSCTL_OFF >= RING_BYTES, "control words above every phase's scratch");
constexpr int LDS_BYTES = 147456;
static_assert(MISC_OFF + 128 <= LDS_BYTES, "LDS map");
static_assert(att::lds_bytes<96>() <= RING_BYTES, "attention scratch fits the ring region");

#define GAS __attribute__((address_space(1)))
#define LAS __attribute__((address_space(3)))
typedef unsigned short bf16;
typedef unsigned v4u __attribute__((ext_vector_type(4)));
typedef unsigned v2u __attribute__((ext_vector_type(2)));
typedef float f32x4 __attribute__((ext_vector_type(4)));
typedef GAS unsigned gu32;
#define RLX_AGENT __ATOMIC_RELAXED, __HIP_MEMORY_SCOPE_AGENT
#define LDS_WAIT() asm volatile("s_waitcnt lgkmcnt(0)" ::: "memory")
__device__ __forceinline__ unsigned f2bf(float f) { unsigned u = __builtin_bit_cast(unsigned, f); return (u + 0x7fffu + ((u >> 16) & 1u)) >> 16; }
__device__ __forceinline__ unsigned pk2(float lo, float hi) { return f2bf(lo) | (f2bf(hi) << 16); }
__device__ __forceinline__ float bflo(unsigned u) { return __builtin_bit_cast(float, u << 16); }
__device__ __forceinline__ float bfhi(unsigned u) { return __builtin_bit_cast(float, u & 0xffff0000u); }
__device__ __forceinline__ float wave_sum(float v) {
    v += swz_xor<1>(v); v += swz_xor<2>(v); v += swz_xor<4>(v); v += swz_xor<8>(v); v += swz_xor<16>(v);
    return xor32_sum(v);
}
__device__ __forceinline__ float wave_maxf(float v) {
    v = fmaxf(v, swz_xor<1>(v)); v = fmaxf(v, swz_xor<2>(v)); v = fmaxf(v, swz_xor<4>(v)); v = fmaxf(v, swz_xor<8>(v)); v = fmaxf(v, swz_xor<16>(v));
    return xor32_max(v);
}

#define XB_TMO      128
#define XB_XCNT(j)  (256  + 64 * (j))
#define XB_XSUB(j)  (1280 + 64 * (j))
#define XB_XGEN(j)  (2304 + 64 * (j))
#define XB_TOP      3328
#define XB_TOPGEN   3392
#define XCD_BAR_WORDS 3456
#define XB_SPIN_CAP (1u << 18)

__device__ __forceinline__ unsigned xb_ld(unsigned* p)              { return __hip_atomic_load(p, __ATOMIC_RELAXED, __HIP_MEMORY_SCOPE_AGENT); }
__device__ __forceinline__ unsigned xb_add(unsigned* p, unsigned v) { return __hip_atomic_fetch_add(p, v, __ATOMIC_RELAXED, __HIP_MEMORY_SCOPE_AGENT); }
__device__ __forceinline__ unsigned xb_xcc_id() { return (unsigned)__builtin_amdgcn_s_getreg((3 << 11) | 20) & 0xFu; }
#define XB_SPIN(cond, bar) do { unsigned _sp = 0; while (cond) { __builtin_amdgcn_s_sleep(1); \
    if ((++_sp & 255u) == 0u) { if (xb_ld(&(bar)[XB_TMO])) break; if (_sp > XB_SPIN_CAP) { atomicAdd(&(bar)[XB_TMO], 1u); break; } } } } while (0)

struct XcdBarrier {
    int t0;
    unsigned* bar; unsigned x;
    volatile LAS unsigned* st;
};

__device__ __forceinline__ XcdBarrier xcd_barrier_post(unsigned* bar, volatile LAS unsigned* st, int t0) {
    XcdBarrier b; b.t0 = t0; b.bar = bar; b.x = xb_xcc_id(); b.st = st;
    if (b.t0) (void)xb_add(&bar[XB_XCNT(b.x)], 1u);
    return b;
}
__device__ __forceinline__ void xcd_barrier_complete(unsigned* bar, unsigned x, unsigned& nloc, unsigned& nx) {
    const unsigned G = gridDim.x * gridDim.y * gridDim.z;
    unsigned sum, cnt, mine, sp = 0u;
    for (;;) {
        sum = 0u; cnt = 0u; mine = 0u;
#pragma unroll
        for (unsigned j = 0; j < 16; ++j) { const unsigned c = xb_ld(&bar[XB_XCNT(j)]); sum += c; cnt += (c > 0u) ? 1u : 0u; mine = (j == x) ? c : mine; }
        if (sum == G) break;
        __builtin_amdgcn_s_sleep(1);
        if ((++sp & 255u) == 0u) { if (xb_ld(&bar[XB_TMO])) break; if (sp > XB_SPIN_CAP) { atomicAdd(&bar[XB_TMO], 1u); break; } }
    }
    nloc = mine > 0u ? mine : 1u; nx = cnt > 0u ? cnt : 1u;
}

__device__ __forceinline__ void xcd_barrier(const XcdBarrier& b) {
    asm volatile("s_waitcnt vmcnt(0)" ::: "memory");
    __syncthreads();
    if (b.t0) {
        unsigned* bar = b.bar;
        __builtin_amdgcn_s_waitcnt(0);
        unsigned nloc = b.st[0], nx = b.st[1];
        if (nloc == 0u) { xcd_barrier_complete(bar, b.x, nloc, nx); b.st[0] = nloc; b.st[1] = nx; }
        const unsigned old = xb_add(&bar[XB_XSUB(b.x)], 1u);
        const unsigned gen = old / nloc;
        if (old + 1u == (gen + 1u) * nloc) {
            __builtin_amdgcn_fence(__ATOMIC_RELEASE, "agent");
            asm volatile("s_waitcnt vmcnt(0)" ::: "memory");
            const unsigned og = xb_add(&bar[XB_TOP], 1u);
            const unsigned tg = og / nx;
            if (og + 1u == (tg + 1u) * nx) xb_add(&bar[XB_TOPGEN], 1u);
            else XB_SPIN(xb_ld(&bar[XB_TOPGEN]) == tg, bar);
            __builtin_amdgcn_fence(__ATOMIC_ACQUIRE, "agent");
            xb_add(&bar[XB_XGEN(b.x)], 1u);
            asm volatile("s_waitcnt vmcnt(0)" ::: "memory");
        } else {
            XB_SPIN(xb_ld(&bar[XB_XGEN(b.x)]) == gen, bar);
            __builtin_amdgcn_fence(__ATOMIC_ACQUIRE, "agent");
            asm volatile("s_waitcnt vmcnt(0)" ::: "memory");
        }
    }
    __syncthreads();
}

struct Args { const float* in[27]; float* out; unsigned char* ws; };
enum { I_X = 0, I_ATTN_NORM, I_FFN_NORM, I_A_WDQ, I_A_GCQ, I_A_WUQ, I_A_WDKV, I_A_GCKV, I_A_WUKV, I_A_GQN, I_A_GKN, I_A_WO, I_KV_NORM, I_KV_WK, I_KV_WV, I_KV_GKN,
       I_B_WQ, I_B_GQN, I_B_RELB, I_B_WO, I_FFN_W1, I_FFN_W3, I_FFN_W2, I_MOE_ROUTER, I_MOE_W1, I_MOE_W3, I_MOE_W2 };

struct Frame {
    LAS unsigned char* lds;
    int wave, vcu, G;
};
typedef const __attribute__((address_space(4))) Args* KArgs;
__device__ __forceinline__ KArgs kargs() { KArgs p = (KArgs)__builtin_amdgcn_kernarg_segment_ptr(); asm volatile("" : "+s"(p)); return p; }
#define INP(i) (kargs()->in[i])
#define OUTP (kargs()->out)
#define WSP (kargs()->ws)
__device__ __forceinline__ int fresh(int v) { asm volatile("" : "+v"(v)); return v; }

__device__ __forceinline__ void tr_item(const float* W, int ldw, int K, int k0, int nsrc0, const float* gain, bf16* WT, int drow0, LAS float* scr, int lane) {
    const int c4 = lane & 7, r = lane >> 3;
    const GAS float* src = (const GAS float*)W + (size_t)(k0 + r) * ldw + nsrc0 + 4 * c4;
    f32x4 v[16];
#pragma unroll
    for (int i = 0; i < 16; ++i) v[i] = *(const GAS f32x4*)(src + (size_t)(8 * i) * ldw);
    if (gain) {
#pragma unroll
        for (int i = 0; i < 16; ++i) v[i] = v[i] * gain[k0 + 8 * i + r];
    }
#pragma unroll
    for (int i = 0; i < 16; ++i) { LAS float* d = scr + (8 * i + r) * 33 + 4 * c4; d[0] = v[i].x; d[1] = v[i].y; d[2] = v[i].z; d[3] = v[i].w; }
    LDS_WAIT(); asm volatile("" ::: "memory");
    const int c16 = lane >> 2;
#pragma unroll
    for (int j = 0; j < 8; ++j) { const int n = (lane & 3) + 4 * j; const LAS float* sp = scr + (8 * c16) * 33 + n;
        v4u o; o.x = pk2(sp[0 * 33], sp[1 * 33]); o.y = pk2(sp[2 * 33], sp[3 * 33]); o.z = pk2(sp[4 * 33], sp[5 * 33]); o.w = pk2(sp[6 * 33], sp[7 * 33]);
        *(GAS v4u*)(WT + (size_t)(drow0 + n) * K + k0 + 8 * c16) = o; }
    LDS_WAIT(); asm volatile("" ::: "memory");
}
__device__ __forceinline__ void tr_plain(const float* W, int K, int N, const float* gain, bf16* WT, int drow_off, LAS float* scr, int item, int lane) {
    const int nblk = N / 32, kb = item / nblk, nb = item % nblk;
    tr_item(W, N, K, 128 * kb, 32 * nb, gain, WT, drow_off + 32 * nb, scr, lane);
}
__device__ __forceinline__ void tr_gated(const float* W, int K, int N, const float* gain, bf16* WT, int half, LAS float* scr, int item, int lane) {
    const int nblk = N / 32, kb = item / nblk, nb = item % nblk, n0 = 32 * nb;
    tr_item(W, N, K, 128 * kb, n0, gain, WT, (n0 >> 7) * 256 + half * 128 + (n0 & 127), scr, lane);
}
__device__ __forceinline__ unsigned pk_fp8x4(float a, float b, float c, float d) { int w = 0; w = __builtin_amdgcn_cvt_pk_fp8_f32(a, b, w, false); w = __builtin_amdgcn_cvt_pk_fp8_f32(c, d, w, true); return (unsigned)w; }
__device__ __forceinline__ void tr_item_f8(const float* W, int ldw, int K, int k0, int nsrc0, const float* gain, unsigned char* WT, int drow0, LAS float* scr, int lane) {
    const int c4 = lane & 7, r = lane >> 3;
    const GAS float* src = (const GAS float*)W + (size_t)(k0 + r) * ldw + nsrc0 + 4 * c4;
    f32x4 v[16];
#pragma unroll
    for (int i = 0; i < 16; ++i) v[i] = *(const GAS f32x4*)(src + (size_t)(8 * i) * ldw);
#pragma unroll
    for (int i = 0; i < 16; ++i) v[i] = v[i] * (gain ? gain[k0 + 8 * i + r] * 64.f : 64.f);
#pragma unroll
    for (int i = 0; i < 16; ++i) { LAS float* d = scr + (8 * i + r) * 33 + 4 * c4; d[0] = v[i].x; d[1] = v[i].y; d[2] = v[i].z; d[3] = v[i].w; }
    LDS_WAIT(); asm volatile("" ::: "memory");
    const int c8 = lane >> 3;
#pragma unroll
    for (int j = 0; j < 4; ++j) { const int n = (lane & 7) + 8 * j; const LAS float* sp = scr + (16 * c8) * 33 + n;
        v4u o; o.x = pk_fp8x4(sp[0 * 33], sp[1 * 33], sp[2 * 33], sp[3 * 33]); o.y = pk_fp8x4(sp[4 * 33], sp[5 * 33], sp[6 * 33], sp[7 * 33]);
        o.z = pk_fp8x4(sp[8 * 33], sp[9 * 33], sp[10 * 33], sp[11 * 33]); o.w = pk_fp8x4(sp[12 * 33], sp[13 * 33], sp[14 * 33], sp[15 * 33]);
        *(GAS v4u*)(WT + (size_t)(drow0 + n) * K + k0 + 16 * c8) = o; }
    LDS_WAIT(); asm volatile("" ::: "memory");
}
__device__ __forceinline__ float rms_row_to_bf16(const float* xrow, bf16* orow, int lane, f32x4 (&v)[4]) {
    const GAS f32x4* xr = (const GAS f32x4*)xrow + lane;
    float s = 0.f;
#pragma unroll
    for (int j = 0; j < 4; ++j) { v[j] = xr[64 * j]; s += (v[j].x * v[j].x + v[j].y * v[j].y) + (v[j].z * v[j].z + v[j].w * v[j].w); }
    const float rstd = 1.f / sqrtf(wave_sum(s) * (1.f / D) + EPS);
    GAS unsigned long long* o8 = (GAS unsigned long long*)orow + lane;
#pragma unroll
    for (int j = 0; j < 4; ++j) o8[64 * j] = (unsigned long long)pk2(v[j].x * rstd, v[j].y * rstd) | ((unsigned long long)pk2(v[j].z * rstd, v[j].w * rstd) << 32);
    return rstd;
}
__device__ __forceinline__ void norm_phase(const Frame& F, const float* x, bf16* xn) {
    const int tid = fresh(F.wave * 64 + lane_id_()), lane = tid & 63; (void)lane;
    const int gw = F.vcu * NWAVES + F.wave, NGW = F.G * NWAVES;
    for (int m = 2 * gw; m < M; m += 2 * NGW) {
        const GAS f32x4* xr = (const GAS f32x4*)(x + (size_t)m * D) + lane;
        f32x4 v[8]; float s0 = 0.f, s1 = 0.f;
#pragma unroll
        for (int j = 0; j < 8; ++j) v[j] = xr[64 * j];
#pragma unroll
        for (int j = 0; j < 4; ++j) { s0 += (v[j].x * v[j].x + v[j].y * v[j].y) + (v[j].z * v[j].z + v[j].w * v[j].w); s1 += (v[4 + j].x * v[4 + j].x + v[4 + j].y * v[4 + j].y) + (v[4 + j].z * v[4 + j].z + v[4 + j].w * v[4 + j].w); }
        const float r0 = 1.f / sqrtf(wave_sum(s0) * (1.f / D) + EPS), r1 = 1.f / sqrtf(wave_sum(s1) * (1.f / D) + EPS);
        GAS unsigned* o4 = (GAS unsigned*)((GAS unsigned char*)xn + (size_t)m * D) + lane;
#pragma unroll
        for (int j = 0; j < 8; ++j) { const float rr = j < 4 ? r0 : r1; o4[64 * j] = pk_fp8x4(v[j].x * rr, v[j].y * rr, v[j].z * rr, v[j].w * rr); }
    }
}

__device__ __forceinline__ void p0_prologue(const Frame& F) {
    const int tid = fresh(F.wave * 64 + lane_id_()), lane = tid & 63; (void)lane;
    LAS float* scr = (LAS float*)(F.lds + RING_OFF + F.wave * P0_SCR);
    unsigned char* ws = WSP;
    const int gw = F.vcu * NWAVES + F.wave, NGW = F.G * NWAVES;
    constexpr int I_DQ = 8 * 12, I_DKV = 8 * 9, I_UQ = 3 * 48, I_UKV = 2 * 64, I_SQ = 8 * 32, I_F13 = 8 * 88, I_F2 = 22 * 32, I_M13 = 8 * 112, I_M2 = 28 * 32;
    constexpr int NSMALL = I_DQ + I_DKV + I_UQ + I_UKV + I_SQ + 2 * I_F13 + I_F2 + 4 * I_SQ;
    constexpr int NITEMS = NSMALL + NE * (2 * I_M13 + I_M2);
    for (int it = gw; it < NITEMS; it += NGW) {
        int r = it;
        if (r < I_DQ)  { const int kb = r / 12, n0 = 32 * (r % 12); tr_item_f8(INP(I_A_WDQ), QLORA, D, 128 * kb, n0, INP(I_ATTN_NORM), ws + WS_WA, n0, scr, lane); continue; } r -= I_DQ;
        if (r < I_DKV) { const int kb = r / 9, n0 = 32 * (r % 9); tr_item_f8(INP(I_A_WDKV), KVLORA + ROPE_D, D, 128 * kb, n0, INP(I_ATTN_NORM), ws + WS_WA, QLORA + n0, scr, lane); continue; } r -= I_DKV;
        if (r < I_UQ)  { tr_plain(INP(I_A_WUQ), QLORA, NH * QKD, INP(I_A_GCQ), (bf16*)(ws + WS_WUQ), 0, scr, r, lane); continue; } r -= I_UQ;
        if (r < I_UKV) { const int kb = r / 64, n0 = 32 * (r % 64), head = n0 >> 7, within = n0 & 127;
            const int drow = within < 64 ? 256 * (head >> 2) + 128 * (within >> 5) + 32 * (head & 3) : 1024 + head * 64 + (within - 64);
            tr_item(INP(I_A_WUKV), NH * 128, KVLORA, 128 * kb, n0, INP(I_A_GCKV), (bf16*)(ws + WS_WUKV), drow, scr, lane); continue; } r -= I_UKV;
        if (r < I_SQ)  { const int kb = r / 32, n0 = 32 * (r % 32); tr_item_f8(INP(I_A_WO), D, D, 128 * kb, n0, nullptr, ws + WS_WO, n0, scr, lane); continue; } r -= I_SQ;
        if (r < I_F13) { tr_gated(INP(I_FFN_W1), D, FF, INP(I_FFN_NORM), (bf16*)(ws + WS_WF1), 0, scr, r, lane); continue; } r -= I_F13;
        if (r < I_F13) { tr_gated(INP(I_FFN_W3), D, FF, INP(I_FFN_NORM), (bf16*)(ws + WS_WF1), 1, scr, r, lane); continue; } r -= I_F13;
        if (r < I_F2)  { tr_plain(INP(I_FFN_W2), FF, D, nullptr, (bf16*)(ws + WS_WF2), 0, scr, r, lane); continue; } r -= I_F2;
        if (r < I_SQ)  { const int kb = r / 32, n0 = 32 * (r % 32), head = n0 >> 6;
            tr_item_f8(INP(I_KV_WK), D, D, 128 * kb, n0, INP(I_KV_NORM), ws + WS_WKVQ, 256 * (head >> 2) + 128 * ((n0 >> 5) & 1) + 32 * (head & 3), scr, lane); continue; } r -= I_SQ;
        if (r < I_SQ)  { const int kb = r / 32, n0 = 32 * (r % 32); tr_item_f8(INP(I_KV_WV), D, D, 128 * kb, n0, INP(I_KV_NORM), ws + WS_WKVQ, 2 * D + n0, scr, lane); continue; } r -= I_SQ;
        if (r < I_SQ)  { const int kb = r / 32, n0 = 32 * (r % 32), head = n0 >> 6;
            tr_item_f8(INP(I_B_WQ), D, D, 128 * kb, n0, INP(I_ATTN_NORM) + D, ws + WS_WKVQ, D + 256 * (head >> 2) + 128 * ((n0 >> 5) & 1) + 32 * (head & 3), scr, lane); continue; } r -= I_SQ;
        if (r < I_SQ)  { const int kb = r / 32, n0 = 32 * (r % 32); tr_item_f8(INP(I_B_WO), D, D, 128 * kb, n0, nullptr, ws + WS_WBO, n0, scr, lane); continue; } r -= I_SQ;
        const int e = r / (2 * I_M13 + I_M2); r -= e * (2 * I_M13 + I_M2);
        if (r < I_M13) { const int kb = r / 112, n0 = 32 * (r % 112);
            tr_item_f8(INP(I_MOE_W1) + (size_t)e * D * EFF, EFF, D, 128 * kb, n0, INP(I_FFN_NORM) + D, ws + WS_WM1 + (size_t)e * 2 * EFF * D, (n0 >> 7) * 256 + (n0 & 127), scr, lane); continue; } r -= I_M13;
        if (r < I_M13) { const int kb = r / 112, n0 = 32 * (r % 112);
            tr_item_f8(INP(I_MOE_W3) + (size_t)e * D * EFF, EFF, D, 128 * kb, n0, INP(I_FFN_NORM) + D, ws + WS_WM1 + (size_t)e * 2 * EFF * D, (n0 >> 7) * 256 + 128 + (n0 & 127), scr, lane); continue; } r -= I_M13;
        { const int kb = r / 32, n0 = 32 * (r % 32); tr_item_f8(INP(I_MOE_W2) + (size_t)e * EFF * D, D, EFF, 128 * kb, n0, nullptr, ws + WS_WM2 + (size_t)e * D * EFF, n0, scr, lane); }
    }
    const int gt = F.vcu * (NWAVES * 64) + tid, NGT = F.G * NWAVES * 64;
    for (int c = gt; c < 96 * D / 16; c += NGT) *((GAS v4u*)(ws + WS_WA + (size_t)(QLORA + KVLORA + ROPE_D) * D) + c) = (v4u){0u, 0u, 0u, 0u};
    for (int c = gt; c < SEQ * 16; c += NGT) { const int pos = c >> 4, i = c & 15;
        const float inv = __builtin_amdgcn_exp2f(-(float)i * (13.287712379549449f / 16.f));
        const float rev = (float)pos * inv * 0.15915494309189535f; const float fr = rev - floorf(rev);
        ((GAS float*)(ws + WS_ROPE))[2 * c] = __builtin_amdgcn_cosf(fr); ((GAS float*)(ws + WS_ROPE))[2 * c + 1] = __builtin_amdgcn_sinf(fr); }
    norm_phase(F, INP(I_X), (bf16*)(ws + WS_XN));
}

__device__ __forceinline__ void route_phase(const Frame& F) {
    const int tid = fresh(F.wave * 64 + lane_id_()), lane = tid & 63;
    unsigned char* ws = WSP;
    LAS float* wrg = (LAS float*)(F.lds + RING_OFF);
    LAS int* cnt = (LAS int*)(F.lds + RING_OFF + 32768);
    const float* wr = INP(I_MOE_ROUTER); const float* g = INP(I_FFN_NORM) + D;
    for (int idx = tid; idx < D * NE; idx += NWAVES * 64) { const int k = idx >> 3, e = idx & 7, l = k >> 4, i = k & 15;
        wrg[((i * 2) + (e >> 2)) * 256 + 4 * l + (e & 3)] = wr[idx] * g[k]; }
    __syncthreads();
    const int b5 = (lane >> 5) & 1, b4 = (lane >> 4) & 1, b3 = (lane >> 3) & 1;
    for (int c = F.vcu; c < M / 256; c += F.G) {
        if (tid < 16) cnt[tid] = 0;
        __syncthreads();
        v4u vn[2];
        { const GAS v4u* xr = (const GAS v4u*)(ws + WS_XR3 + (size_t)(c * 256 + F.wave * 32) * D * 2) + 2 * lane; vn[0] = xr[0]; vn[1] = xr[1]; }
        for (int i = 0; i < 32; ++i) {
            const int m = c * 256 + F.wave * 32 + i;
            const v4u q0 = vn[0], q1 = vn[1];
            if (i + 1 < 32) { const GAS v4u* xr = (const GAS v4u*)(ws + WS_XR3 + (size_t)(m + 1) * D * 2) + 2 * lane; vn[0] = xr[0]; vn[1] = xr[1]; }
            const unsigned qw[8] = {q0.x, q0.y, q0.z, q0.w, q1.x, q1.y, q1.z, q1.w};
            float xv[16]; float ssx = 0.f;
#pragma unroll
            for (int j = 0; j < 8; ++j) { xv[2 * j] = bflo(qw[j]); xv[2 * j + 1] = bfhi(qw[j]); }
#pragma unroll
            for (int j = 0; j < 16; j += 4) ssx += (xv[j] * xv[j] + xv[j + 1] * xv[j + 1]) + (xv[j + 2] * xv[j + 2] + xv[j + 3] * xv[j + 3]);
            float lg[8];
#pragma unroll
            for (int e = 0; e < 8; ++e) lg[e] = 0.f;
#pragma unroll
            for (int j = 0; j < 16; ++j) { const float x1 = xv[j];
                const f32x4 w0 = *(const LAS f32x4*)(wrg + (j * 2) * 256 + 4 * lane), w1 = *(const LAS f32x4*)(wrg + (j * 2 + 1) * 256 + 4 * lane);
                lg[0] += x1 * w0.x; lg[1] += x1 * w0.y; lg[2] += x1 * w0.z; lg[3] += x1 * w0.w; lg[4] += x1 * w1.x; lg[5] += x1 * w1.y; lg[6] += x1 * w1.z; lg[7] += x1 * w1.w; }
            float r4[4], r2[2], r1;
#pragma unroll
            for (int e = 0; e < 4; ++e) { const float mine = b5 ? lg[4 + e] : lg[e], other = b5 ? lg[e] : lg[4 + e]; r4[e] = mine + xor32_partner(other, b5); }
#pragma unroll
            for (int e = 0; e < 2; ++e) { const float mine = b4 ? r4[2 + e] : r4[e], other = b4 ? r4[e] : r4[2 + e]; r2[e] = mine + swz_xor<16>(other); }
            { const float mine = b3 ? r2[1] : r2[0], other = b3 ? r2[0] : r2[1]; r1 = mine + swz_xor<8>(other); }
            r1 += swz_xor<4>(r1); r1 += swz_xor<2>(r1); r1 += swz_xor<1>(r1);
            const float rstd = 1.f / sqrtf(wave_sum(ssx) * (1.f / D) + EPS);
#pragma unroll
            for (int e = 0; e < 8; ++e) lg[e] = __builtin_bit_cast(float, __builtin_amdgcn_readlane(__builtin_bit_cast(int, r1), 8 * e)) * rstd;
            int e1 = 0; float l1 = lg[0];
#pragma unroll
            for (int e = 1; e < 8; ++e) if (lg[e] > l1) { l1 = lg[e]; e1 = e; }
            int e2 = -1; float l2 = -INFINITY;
#pragma unroll
            for (int e = 0; e < 8; ++e) if (e != e1 && lg[e] > l2) { l2 = lg[e]; e2 = e; }
            const float g1 = 1.f / (1.f + __expf(l2 - l1)), g2 = 1.f - g1;
            const int elo = e1 < e2 ? e1 : e2, ehi = e1 < e2 ? e2 : e1;
            const float glo = e1 < e2 ? g1 : g2, ghi = e1 < e2 ? g2 : g1;
            if (lane == 0) { ((GAS float*)(ws + WS_TOKRSTD))[m] = rstd; ((GAS int*)(ws + WS_TOKE))[m] = elo | (ehi << 8); ((GAS float*)(ws + WS_TOKG))[2 * m] = glo; ((GAS float*)(ws + WS_TOKG))[2 * m + 1] = ghi;
                atomicAdd((int*)&cnt[elo], 1); atomicAdd((int*)&cnt[8 + ehi], 1); }
        }
        __syncthreads();
        if (tid < 16) ((GAS int*)(ws + WS_CNT))[c * 16 + tid] = cnt[tid];
        __syncthreads();
    }
}

__device__ __forceinline__ void slot_phase(const Frame& F, unsigned char* ws) {
    const int tid = fresh(F.wave * 64 + lane_id_()), lane = tid & 63; (void)lane;
    LAS int* call = (LAS int*)(F.lds + RING_OFF);
    LAS int* tot = call + 4096; LAS int* base = tot + 16; LAS int* pre = base + 16; LAS int* meta = pre + 16;
    LAS int* grp = meta + 16;
    LAS int* slot_of = grp + 512;
    for (int idx = tid; idx < 4096; idx += NWAVES * 64) call[idx] = ((const GAS int*)(ws + WS_CNT))[idx];
    __syncthreads();
    if (tid < 16) { int t = 0; for (int cc = 0; cc < 256; ++cc) t += call[cc * 16 + tid]; tot[tid] = t; }
    __syncthreads();
    if (tid == 0) { int off = 0; for (int g = 0; g < 16; ++g) { base[g] = off; off += (tot[g] + 255) & ~255; if (g == 7) meta[0] = off >> 8; } meta[1] = (off >> 8) - meta[0]; }
    __syncthreads();
    for (int c = F.vcu; c < M / 256; c += F.G) {
        if (tid < 16) { int p = 0; for (int cc = 0; cc < c; ++cc) p += call[cc * 16 + tid]; pre[tid] = p; }
        const int hf = tid >> 8, i = tid & 255, m = c * 256 + i;
        const int te = ((const GAS int*)(ws + WS_TOKE))[m];
        const int g = hf * 8 + (hf ? ((te >> 8) & 0xff) : (te & 0xff));
        grp[tid] = g;
        __syncthreads();
        int rank = 0;
        for (int j = 0; j < i; ++j) rank += (grp[hf * 256 + j] == g) ? 1 : 0;
        const int slot = base[g] + pre[g] + rank;
        ((GAS int*)(ws + WS_SLOTTOK))[slot] = m; ((GAS float*)(ws + WS_SLOTGATE))[slot] = ((const GAS float*)(ws + WS_TOKG))[2 * m + hf];
        slot_of[tid] = slot;
        __syncthreads();
        for (int i0 = F.wave; i0 < 256; i0 += 4 * NWAVES) {
            v4u x[4][2]; float rs[4];
#pragma unroll
            for (int k = 0; k < 4; ++k) { const int mm = c * 256 + i0 + 8 * k; const GAS v4u* src = (const GAS v4u*)(ws + WS_XR3 + (size_t)mm * D * 2);
                x[k][0] = src[2 * lane]; x[k][1] = src[2 * lane + 1]; rs[k] = ((const GAS float*)(ws + WS_TOKRSTD))[mm]; }
#pragma unroll
            for (int k = 0; k < 4; ++k) { const int i = i0 + 8 * k; const v4u x0 = x[k][0], x1 = x[k][1]; const float r = rs[k];
                const v4u o = (v4u){pk_fp8x4(bflo(x0.x) * r, bfhi(x0.x) * r, bflo(x0.y) * r, bfhi(x0.y) * r), pk_fp8x4(bflo(x0.z) * r, bfhi(x0.z) * r, bflo(x0.w) * r, bfhi(x0.w) * r),
                                    pk_fp8x4(bflo(x1.x) * r, bfhi(x1.x) * r, bflo(x1.y) * r, bfhi(x1.y) * r), pk_fp8x4(bflo(x1.z) * r, bfhi(x1.z) * r, bflo(x1.w) * r, bfhi(x1.w) * r)};
                ((GAS v4u*)(ws + WS_XG + (size_t)slot_of[i] * D))[lane] = o; ((GAS v4u*)(ws + WS_XG + (size_t)slot_of[256 + i] * D))[lane] = o; }
        }
        __syncthreads();
    }
    for (int g = F.vcu; g < 16; g += F.G) {
        const int s0 = base[g] + tot[g], s1 = base[g] + ((tot[g] + 255) & ~255);
        for (int s = s0 + F.wave; s < s1; s += NWAVES) { GAS v4u* dst = (GAS v4u*)(ws + WS_XG + (size_t)s * D);
            dst[lane] = (v4u){0u, 0u, 0u, 0u};
            if (lane == 0) { ((GAS int*)(ws + WS_SLOTTOK))[s] = -1; ((GAS float*)(ws + WS_SLOTGATE))[s] = 0.f; } }
    }
    if (F.vcu == 0) {
        if (tid < 16) { const int p0 = base[tid] >> 8, p1 = (base[tid] + ((tot[tid] + 255) & ~255)) >> 8; for (int p = p0; p < p1; ++p) ((GAS int*)(ws + WS_PANELE))[p] = tid & 7; }
        if (tid == 0) { ((GAS int*)(ws + WS_META))[0] = meta[0]; ((GAS int*)(ws + WS_META))[1] = meta[1]; }
        if (tid < 16) ((GAS int*)(ws + WS_META))[2 + tid] = base[tid] >> 8;
    }
    __syncthreads();
}

__global__ void __launch_bounds__(NWAVES * 64, 2) yoco_fwd(Args args) {
    extern __shared__ __attribute__((aligned(16))) unsigned char lds_raw[];
    Frame F;
    F.lds = (LAS unsigned char*)lds_raw;
    F.wave = __builtin_amdgcn_readfirstlane((int)threadIdx.x >> 6);
    F.G = gridDim.x; { const int bx = blockIdx.x; F.vcu = (F.G % 8 == 0) ? (bx % 8) * (F.G / 8) + bx / 8 : bx; }
    unsigned char* ws = WSP;
    volatile LAS unsigned* MISC = (volatile LAS unsigned*)(F.lds + MISC_OFF);
    for (int u = fresh((int)threadIdx.x); u < (LDS_BYTES - LDSCTL_OFF) / 4; u += NWAVES * 64) ((LAS unsigned*)(F.lds + LDSCTL_OFF))[u] = 0u;
    __syncthreads();
    (void)xcd_barrier_post((unsigned*)(ws + WS_CTL) + CW_BAR, MISC + 8, (F.wave == 0 && lane_id_() == 0) ? 1 : 0);
    LAS unsigned char* ring = F.lds + RING_OFF;
#define bid ((int)blockIdx.x)
#define GRID_BAR() do { XcdBarrier b_; b_.t0 = (F.wave == 0 && lane_id_() == 0) ? 1 : 0; b_.bar = (unsigned*)(WSP + WS_CTL) + CW_BAR; b_.x = xb_xcc_id(); b_.st = (volatile LAS unsigned*)(F.lds + MISC_OFF) + 8; xcd_barrier(b_); } while (0)
#define GEMM(EpiT, SchedT) pg8::gemm_phase<EpiT, SchedT, true, true>

    p0_prologue(F);
    GRID_BAR();
    { pg8::Gemm g{(const bf16*)(ws + WS_XN), (const bf16*)(ws + WS_WA), M, NA, D / 2, D / 2}; pg8::StaticOrder S; S.init(M, NA, F.G, bid);
      pg8::EpiQA E{(bf16*)(ws + WS_QA), (float*)(ws + WS_PARTQA), 1.f / 64};
      pg8::gemm_phase<pg8::EpiQA, pg8::StaticOrder, true, true, true>(ring, g, S, E, F.wave); }
    GRID_BAR();
    { pg8::Gemm g{(const bf16*)(ws + WS_QA), (const bf16*)(ws + WS_WUQ), M, NH * QKD, QLORA, NA}; pg8::StaticOrder S; S.init(M, NH * QKD, F.G, bid);
      pg8::EpiRowScaleBf16 E{(bf16*)(ws + WS_Q), NH * QKD, (const float*)(ws + WS_PARTQA), 1.f / QLORA};
      GEMM(pg8::EpiRowScaleBf16, pg8::StaticOrder)(ring, g, S, E, F.wave); }
    { pg8::Gemm g{(const bf16*)(ws + WS_QA) + QLORA, (const bf16*)(ws + WS_WUKV), M, NH * 128, KVLORA, NA}; pg8::StaticOrder S; S.init(M, NH * 128, F.G, bid);
      pg8::EpiKVup E{(bf16*)(ws + WS_K), (bf16*)(ws + WS_V), (const float*)(ws + WS_PARTQA), (const bf16*)(ws + WS_QA), INP(I_A_GKN), (const float*)(ws + WS_ROPE)};
      GEMM(pg8::EpiKVup, pg8::StaticOrder)(ring, g, S, E, F.wave); }
    GRID_BAR();
    bool fastA;
    { float bq = 0.f, bk = 0.f; const int l_ = lane_id_(); for (int i = l_; i < QKD; i += 64) { bq = fmaxf(bq, fabsf(INP(I_A_GQN)[i])); bk = fmaxf(bk, fabsf(INP(I_A_GKN)[i])); }
      bq = wave_maxf(bq); bk = wave_maxf(bk); fastA = __builtin_amdgcn_readfirstlane((int)(14.42f * bq * bk <= 40.f)) != 0; }
#define P5_UNIT(NM) att::attn_unit<96, false, 1536, 1536, D, D, true, NM>(ring, (const bf16*)(ws + WS_Q) + (size_t)b * SEQ * 1536 + h * QKD, (const bf16*)(ws + WS_K) + (size_t)b * SEQ * 1536 + h * QKD, \
                                      (const bf16*)(ws + WS_V) + (size_t)b * SEQ * D + h * 64, (bf16*)(ws + WS_O + (size_t)b * SEQ * D + h * 64), \
                                      256 * qb, 0, 4 * qb + 3, 0, 4 * qb + (F.wave >> 1), 0, nullptr, INP(I_A_GQN), (const float*)(ws + WS_ROPE), F.wave)
    for (int p = F.vcu; p < BATCH * NH * 4; p += F.G) {
        const int bh = p >> 2, pid = p & 3, b = bh >> 4, h = bh & 15;
        for (int u2 = 0; u2 < 2; ++u2) {
            const int qb = u2 ? 7 - pid : pid;
            if (fastA) P5_UNIT(true); else P5_UNIT(false);
        }
    }
    GRID_BAR();
    { pg8::Gemm g{(const bf16*)(ws + WS_O), (const bf16*)(ws + WS_WO), M, D, D / 2, D / 2}; pg8::StaticOrder S; S.init(M, D, F.G, bid);
      pg8::EpiResStream<true, false, false> E{INP(I_X), (bf16*)(ws + WS_XR1), nullptr, (float*)(ws + WS_PART1), 1.f / 2048};
      pg8::gemm_phase<pg8::EpiResStream<true, false, false>, pg8::StaticOrder, true, true, true>(ring, g, S, E, F.wave); }
    GRID_BAR();
    { pg8::Gemm g{(const bf16*)(ws + WS_XR1), (const bf16*)(ws + WS_WF1), M, 2 * FF, D, D}; pg8::StaticOrder S; S.init(M, 2 * FF, F.G, bid);
      pg8::EpiGated<true> E{(bf16*)(ws + WS_H), FF, 0, (const float*)(ws + WS_PART1)};
      GEMM(pg8::EpiGated<true>, pg8::StaticOrder)(ring, g, S, E, F.wave); }
    GRID_BAR();
    { pg8::Gemm g{(const bf16*)(ws + WS_H), (const bf16*)(ws + WS_WF2), M, D, FF, FF}; pg8::StaticOrder S; S.init(M, D, F.G, bid);
      pg8::EpiResStream<true, true, true> E{ws + WS_XR1, (bf16*)(ws + WS_X2B), ws + WS_XR2, (float*)(ws + WS_PART2), 1.f};
      pg8::gemm_phase<pg8::EpiResStream<true, true, true>, pg8::StaticOrder, true, true>(ring, g, S, E, F.wave); }
    GRID_BAR();
    { pg8::Gemm g{(const bf16*)(ws + WS_XR2), (const bf16*)(ws + WS_WKVQ), M, 2 * D, D / 2, D / 2}; pg8::StaticOrder S; S.init(M, 2 * D, F.G, bid);
      pg8::EpiK2Q2 E{(bf16*)(ws + WS_KVQ2), (const float*)(ws + WS_PART2), INP(I_KV_GKN), INP(I_B_GQN), 1.f / 64};
      pg8::gemm_phase<pg8::EpiK2Q2, pg8::StaticOrder, true, true, true>(ring, g, S, E, F.wave); }
    { pg8::Gemm g{(const bf16*)(ws + WS_XR2), (const bf16*)(ws + WS_WKVQ + (size_t)2 * D * D), M, D, D / 2, D / 2}; pg8::StaticOrder S; S.init(M, D, F.G, bid);
      pg8::EpiRowScale16 E{(bf16*)(ws + WS_KVQ2), 3 * D, D, (const float*)(ws + WS_PART2), 1.f / 64};
      pg8::gemm_phase<pg8::EpiRowScale16, pg8::StaticOrder, true, true, true>(ring, g, S, E, F.wave); }
    GRID_BAR();
    bool fastB;
    { float bq = 0.f, bk = 0.f, bb = 0.f; const int l_ = lane_id_(); bq = fabsf(INP(I_B_GQN)[l_]); bk = fabsf(INP(I_KV_GKN)[l_]);
      for (int i = l_; i < NH * 257; i += 64) bb = fmaxf(bb, fabsf(INP(I_B_RELB)[i]));
      bq = wave_maxf(bq); bk = wave_maxf(bk); bb = wave_maxf(bb); fastB = __builtin_amdgcn_readfirstlane((int)(11.78f * bq * bk + 1.4427f * bb <= 40.f)) != 0; }
    for (int p = F.vcu; p < BATCH * NH * 8; p += F.G) {
        const int bh = p >> 3, cb = ((p & 7) + (p >> 8)) & 7, b = bh >> 4, h = bh & 15;
        const int c0 = 4 * cb, cc = c0 + (F.wave >> 1);
        const bf16* base = (const bf16*)(ws + WS_KVQ2) + (size_t)b * SEQ * 3072 + h * 64;
#define P13_UNIT(NM) att::attn_unit<64, true, 3072, 3072, 3072, D, true, NM>(ring, base + 2048, base, base + 1024, (bf16*)(ws + WS_O2 + (size_t)b * SEQ * D + h * 64), \
                                 256 * cb, c0 - 8 < 0 ? 0 : c0 - 8, c0 + 3, cc - 8 < 0 ? 0 : cc - 8, cc, cc, INP(I_B_RELB) + h * 257, nullptr, nullptr, F.wave)
        if (fastB) P13_UNIT(true); else P13_UNIT(false);
    }
    GRID_BAR();
    { pg8::Gemm g{(const bf16*)(ws + WS_O2), (const bf16*)(ws + WS_WBO), M, D, D / 2, D / 2}; pg8::StaticOrder S; S.init(M, D, F.G, bid);
      pg8::EpiResStream<false, false, true> E{ws + WS_X2B, (bf16*)(ws + WS_XR3), nullptr, nullptr, 1.f / 2048};
      pg8::gemm_phase<pg8::EpiResStream<false, false, true>, pg8::StaticOrder, true, true, true>(ring, g, S, E, F.wave); }
    GRID_BAR();
    route_phase(F);
    GRID_BAR();
    slot_phase(F, ws);
    GRID_BAR();
#define MOE_LOAD(hf_) unsigned char* w2 = WSP; \
          const int nPA = __builtin_amdgcn_readfirstlane(((const GAS int*)(w2 + WS_META))[0]), nPB = __builtin_amdgcn_readfirstlane(((const GAS int*)(w2 + WS_META))[1]); (void)nPB; \
          const int p0 = (hf_) ? nPA : 0; int pbk[7]; \
          _Pragma("unroll") for (int k = 0; k < 7; ++k) pbk[k] = __builtin_amdgcn_readfirstlane(((const GAS int*)(w2 + WS_META))[2 + (hf_) * 8 + 1 + k]) - p0;
    constexpr size_t HMB_OFF = (size_t)MAXP_HALF * 256 * EFF;
    { MOE_LOAD(0)
      pg8::Gemm g{(const bf16*)(w2 + WS_XG), (const bf16*)(w2 + WS_WM1), nPA * 256, 2 * EFF, D / 2, D / 2};
      pg8::MoeOrder S; S.init(nPA, 2 * EFF / 256, F.G, bid);
#pragma unroll
      for (int k = 0; k < 7; ++k) S.pb[k] = pbk[k];
      pg8::EpiGatedF8 E{w2 + WS_HM, EFF, 2 * EFF / 256};
      pg8::gemm_phase<pg8::EpiGatedF8, pg8::MoeOrder, true, true, true>(ring, g, S, E, F.wave); }
    GRID_BAR();
    { MOE_LOAD(0)
      pg8::Gemm g{(const bf16*)(w2 + WS_HM), (const bf16*)(w2 + WS_WM2), 256 * 256, D, EFF / 2, EFF / 2};
      pg8::MoeOrder S; S.init(256, D / 256, F.G, bid);
#pragma unroll
      for (int k = 0; k < 7; ++k) S.pb[k] = pbk[k];
      pg8::EpiMoeDown<true> E{OUTP, (const bf16*)(w2 + WS_XR3), (const int*)(w2 + WS_SLOTTOK), (const float*)(w2 + WS_SLOTGATE), 0, D, 1.f / 64};
      pg8::gemm_phase<pg8::EpiMoeDown<true>, pg8::MoeOrder, true, true, true>(ring, g, S, E, F.wave); }
    GRID_BAR();
    { MOE_LOAD(0)
      pg8::Gemm g{(const bf16*)(w2 + WS_HM), (const bf16*)(w2 + WS_WM2), nPA * 256, D, EFF / 2, EFF / 2};
      pg8::LeftOrder S; S.M.init(nPA, D / 256, F.G, bid); S.nLeft = 4 * (nPA - 256);
#pragma unroll
      for (int k = 0; k < 7; ++k) S.M.pb[k] = pbk[k];
      pg8::EpiMoeDown<true> E{OUTP, (const bf16*)(w2 + WS_XR3), (const int*)(w2 + WS_SLOTTOK), (const float*)(w2 + WS_SLOTGATE), 0, D, 1.f / 64};
      pg8::gemm_phase<pg8::EpiMoeDown<true>, pg8::LeftOrder, true, true, true>(ring, g, S, E, F.wave); }
    { MOE_LOAD(1)
      pg8::Gemm g{(const bf16*)(w2 + WS_XG + (size_t)p0 * 256 * D), (const bf16*)(w2 + WS_WM1), nPB * 256, 2 * EFF, D / 2, D / 2};
      pg8::MoeOrder S; S.init(nPB, 2 * EFF / 256, F.G, bid); S.nBusy = 4 * (nPA - 256); S.SK = 4;
#pragma unroll
      for (int k = 0; k < 7; ++k) S.pb[k] = pbk[k];
      pg8::EpiGatedF8 E{w2 + WS_HM + HMB_OFF, EFF, 2 * EFF / 256};
      pg8::gemm_phase<pg8::EpiGatedF8, pg8::MoeOrder, true, true, true>(ring, g, S, E, F.wave); }
    GRID_BAR();
    { MOE_LOAD(1)
      pg8::Gemm g{(const bf16*)(w2 + WS_HM + HMB_OFF), (const bf16*)(w2 + WS_WM2), nPB * 256, D, EFF / 2, EFF / 2};
      pg8::MoeOrder S; S.init(nPB, D / 256, F.G, bid);
#pragma unroll
      for (int k = 0; k < 7; ++k) S.pb[k] = pbk[k];
      pg8::EpiMoeDown<false> E{OUTP, nullptr, (const int*)(w2 + WS_SLOTTOK), (const float*)(w2 + WS_SLOTGATE), p0 * 256, D, 1.f / 64};
      pg8::gemm_phase<pg8::EpiMoeDown<false>, pg8::MoeOrder, true, true, true>(ring, g, S, E, F.wave); }
#undef MOE_LOAD
#undef GRID_BAR
#undef bid
#undef GEMM
}

extern "C" void kernel_launch(void* const* d_in, const int* in_sizes, int n_in, void* d_out, int out_size, void* d_ws, size_t ws_size, hipStream_t stream) {
    static int grid = 0;
    if (grid == 0) {
        if (n_in != 27 || in_sizes[0] != M * D || out_size != M * D || ws_size < WS_END) { fprintf(stderr, "kernel_launch: unexpected shapes (n_in %d, in0 %d, out %d, ws %zu < %zu); nothing launched\n", n_in, n_in > 0 ? in_sizes[0] : -1, out_size, ws_size, (size_t)WS_END); grid = -1; return; }
        int dev = 0, cus = 0, per_cu = 0;
        if (hipGetDevice(&dev) != hipSuccess || hipDeviceGetAttribute(&cus, hipDeviceAttributeMultiprocessorCount, dev) != hipSuccess) { grid = -1; return; }
        if (hipFuncSetAttribute((const void*)yoco_fwd, hipFuncAttributeMaxDynamicSharedMemorySize, LDS_BYTES) != hipSuccess) { fprintf(stderr, "kernel_launch: hipFuncSetAttribute failed\n"); grid = -1; return; }
        if (hipOccupancyMaxActiveBlocksPerMultiprocessor(&per_cu, (const void*)yoco_fwd, NWAVES * 64, LDS_BYTES) != hipSuccess || per_cu < 1) { fprintf(stderr, "kernel_launch: occupancy query says %d\n", per_cu); }
        (void)hipGetLastError();
        grid = cus;
    }
    if (grid < 0) return;
    if (hipMemsetAsync((char*)d_ws + WS_CTL, 0, CTL_ZERO_BYTES, stream) != hipSuccess) return;
    Args a{};
    for (int i = 0; i < 27; ++i) a.in[i] = (const float*)d_in[i];
    a.out = (float*)d_out; a.ws = (unsigned char*)d_ws;
    hipLaunchKernelGGL(yoco_fwd, dim3(grid), dim3(NWAVES * 64), LDS_BYTES, stream, a);
}
```

```cpp
#include <hip/hip_runtime.h>
#include <cstdio>
#include <cstdint>
__device__ __forceinline__ int lane_id_() { unsigned m_ = ~0u; asm volatile("" : "+s"(m_)); return (int)__builtin_amdgcn_mbcnt_hi(m_, __builtin_amdgcn_mbcnt_lo(m_, 0u)); }
template <int X> __device__ __forceinline__ float swz_xor(float v) { return __builtin_bit_cast(float, __builtin_amdgcn_ds_swizzle(__builtin_bit_cast(int, v), (X << 10) | 0x1f)); }
__device__ __forceinline__ void halves32(float v, float& r_lo, float& r_hi) { unsigned a_ = __builtin_bit_cast(unsigned, v), b_ = a_;
    asm volatile("s_nop 1\n\tv_permlane32_swap_b32 %0, %1\n\ts_nop 1" : "+v"(a_), "+v"(b_)); r_lo = __builtin_bit_cast(float, a_); r_hi = __builtin_bit_cast(float, b_); }
__device__ __forceinline__ float xor32_partner(float v, int upper_half) { float lo, hi; halves32(v, lo, hi); return upper_half ? lo : hi; }
__device__ __forceinline__ float xor32_sum(float v) { float lo, hi; halves32(v, lo, hi); return lo + hi; }
__device__ __forceinline__ float xor32_max(float v) { float lo, hi; halves32(v, lo, hi); return fmaxf(lo, hi); }
namespace pg8 {
#define PG8_LAS __attribute__((address_space(3)))
typedef unsigned short bf16_t;
typedef short bf16x8 __attribute__((ext_vector_type(8)));
typedef float f32x4 __attribute__((ext_vector_type(4)));
typedef unsigned u32x4 __attribute__((ext_vector_type(4)));
constexpr int BM = 256, BK = 64, HALF = 128, HTB = HALF * BK * 2  , STAGE_BYTES = 8 * HTB, NXCD = 8, WGM = 8;

__host__ __device__ __forceinline__ int lds_byte(int r, int c) { const int st = (r >> 4) * 2 + (c >> 5), rr = r & 15, cc = c & 31, ob = rr * 64 + cc * 2; return st * 1024 + (ob ^ (((ob >> 9) & 1) << 5)); }
__host__ __device__ __forceinline__ void stage_rc(int b, int& R, int& C) { const int st = b / 1024, sb = b % 1024, swz = sb ^ (((sb >> 9) & 1) << 5); R = (st >> 1) * 16 + swz / 64; C = (st & 1) * 32 + (swz % 64) / 2; }
__host__ __device__ __forceinline__ int perm32(int rho) { const int n = rho >> 4, i = rho & 15; return 8 * (i >> 2) + 4 * n + (i & 3); }

struct Unit { int pm, pn; };
struct Gemm { const bf16_t* A; const bf16_t* Bt; int M, N, K, lda; };

struct StaticOrder {
    int nM, nN, nwg, G, c;
    __host__ __device__ void init(int M, int N, int G_, int c_) { nM = M / BM; nN = N / BM; nwg = nM * nN; G = G_; c = c_; }
    __host__ __device__ bool next(int i, Unit& u) const {
        const int L = i * G + c; if (L >= nwg) return false;
        int wgid = L; { const int q = nwg / NXCD, r = nwg % NXCD, xcd = wgid % NXCD, off = wgid / NXCD; wgid = (xcd < r ? xcd * (q + 1) : r * (q + 1) + (xcd - r) * q) + off; }
        const int nig = WGM * nN, gid = wgid / nig, fm = gid * WGM, gsz = (nM - fm) < WGM ? (nM - fm) : WGM;
        u.pm = fm + ((wgid % nig) % gsz); u.pn = (wgid % nig) / gsz; return true;
    }
    __device__ __forceinline__ void a_ready(const Unit&) const {}
    __device__ __forceinline__ void done(const Unit&) const {}
};
__device__ __forceinline__ unsigned cvt_pk_bf16(float lo, float hi) { unsigned r; asm volatile("v_cvt_pk_bf16_f32 %0, %1, %2" : "=v"(r) : "v"(lo), "v"(hi)); return r; }
__device__ __forceinline__ float silu_f(float x) { const float e = __builtin_amdgcn_exp2f(x * -1.4426950408889634f); return x * __builtin_amdgcn_rcpf(1.f + e); }

__device__ __forceinline__ float sum4(const f32x4& a) { return (a[0] + a[1]) + (a[2] + a[3]); }
__device__ __forceinline__ float part_sum8(const float* p) { return sum4(*(const f32x4*)p) + sum4(*(const f32x4*)(p + 4)); }
__device__ __forceinline__ float part_sum16(const float* p) { return (sum4(*(const f32x4*)p) + sum4(*(const f32x4*)(p + 4))) + (sum4(*(const f32x4*)(p + 8)) + sum4(*(const f32x4*)(p + 12))); }
__device__ __forceinline__ float fq_sum(float v) { v += swz_xor<16>(v); return xor32_sum(v); }
__device__ __forceinline__ float sq8(const f32x4& a, const f32x4& b) { return ((a[0] * a[0] + a[1] * a[1]) + (a[2] * a[2] + a[3] * a[3])) + ((b[0] * b[0] + b[1] * b[1]) + (b[2] * b[2] + b[3] * b[3])); }
__device__ __forceinline__ u32x4 pack8(const f32x4& a, const f32x4& b) { u32x4 w; w.x = cvt_pk_bf16(a[0], a[1]); w.y = cvt_pk_bf16(a[2], a[3]); w.z = cvt_pk_bf16(b[0], b[1]); w.w = cvt_pk_bf16(b[2], b[3]); return w; }
constexpr float EPS_ = 1e-6f;
__device__ __forceinline__ unsigned pk_fp8x4(float a, float b, float c, float d) { int w = 0; w = __builtin_amdgcn_cvt_pk_fp8_f32(a, b, w, false); w = __builtin_amdgcn_cvt_pk_fp8_f32(c, d, w, true); return (unsigned)w; }

struct EpiQA {
    static constexpr bool PERM = true, AFTER_DRAIN = false;
    bf16_t* O; float* part; float wscale;
    __device__ __forceinline__ void operator()(const f32x4 (&acc)[2][2][4][2], const Unit& u, int wr, int wc, int fr, int fq) const {
        { int t_ = lane_id_(); asm volatile("" : "+v"(t_)); fr = t_ & 15; fq = (t_ >> 4) & 3; }
        const int row0 = u.pm * BM + wr * 64 + fr, col0 = u.pn * BM + wc * 32 + 8 * fq;
#pragma unroll
        for (int ai = 0; ai < 2; ++ai)
#pragma unroll
            for (int m = 0; m < 4; ++m) { const int row = row0 + ai * HALF + m * 16; bf16_t* rowp = O + (size_t)row * 768 + col0;
                const f32x4 a0 = acc[ai][0][m][0] * wscale, a1 = acc[ai][0][m][1] * wscale, b0 = acc[ai][1][m][0] * wscale, b1 = acc[ai][1][m][1] * wscale;
                *(u32x4*)(rowp) = pack8(a0, a1); *(u32x4*)(rowp + HALF) = pack8(b0, b1);
                const float s0 = sq8(a0, a1), s1 = sq8(b0, b1);
                float* pr = part + (size_t)row * 16;
                if (u.pn == 0) { const float t = fq_sum(s0 + s1); if (fq == 0) pr[wc] = t; }
                else if (u.pn == 1) { const float t0 = fq_sum(s0), t1 = fq_sum(s1); if (fq == 0) { pr[4 + wc] = t0; pr[8 + wc] = t1; } }
                else { const float t = fq_sum(s0); if (fq == 0) pr[12 + wc] = t; } }
    }
};

struct EpiRowScaleBf16 {
    static constexpr bool PERM = true, AFTER_DRAIN = false;
    bf16_t* O; int ldc; const float* part; float inv_n;
    __device__ __forceinline__ void operator()(const f32x4 (&acc)[2][2][4][2], const Unit& u, int wr, int wc, int fr, int fq) const {
        { int t_ = lane_id_(); asm volatile("" : "+v"(t_)); fr = t_ & 15; fq = (t_ >> 4) & 3; }
        const int row0 = u.pm * BM + wr * 64 + fr, col0 = u.pn * BM + wc * 32 + 8 * fq;
#pragma unroll
        for (int ai = 0; ai < 2; ++ai)
#pragma unroll
            for (int m = 0; m < 4; ++m) { const int row = row0 + ai * HALF + m * 16; bf16_t* rowp = O + (size_t)row * ldc + col0;
                const float rs = __builtin_amdgcn_rsqf(part_sum8(part + (size_t)row * 16) * inv_n + EPS_);
                *(u32x4*)(rowp) = pack8(acc[ai][0][m][0] * rs, acc[ai][0][m][1] * rs); *(u32x4*)(rowp + HALF) = pack8(acc[ai][1][m][0] * rs, acc[ai][1][m][1] * rs); }
    }
};

struct EpiKVup {
    static constexpr bool PERM = true, AFTER_DRAIN = false;
    bf16_t* Kd; bf16_t* Vd; const float* part; const bf16_t* QA; const float* g_kn; const float* rope;
    __device__ __forceinline__ void operator()(const f32x4 (&acc)[2][2][4][2], const Unit& u, int wr, int wc, int fr, int fq) const {
        { int t_ = lane_id_(); asm volatile("" : "+v"(t_)); fr = t_ & 15; fq = (t_ >> 4) & 3; }
        const int row0 = u.pm * BM + wr * 64 + fr;
        if (u.pn >= 4) {
            const int col0 = (u.pn - 4) * BM + wc * 32 + 8 * fq;
#pragma unroll
            for (int ai = 0; ai < 2; ++ai)
#pragma unroll
                for (int m = 0; m < 4; ++m) { const int row = row0 + ai * HALF + m * 16; bf16_t* rowp = Vd + (size_t)row * 1024 + col0;
                    const float rs = __builtin_amdgcn_rsqf(part_sum8(part + (size_t)row * 16 + 8) * (1.f / 256) + EPS_);
                    *(u32x4*)(rowp) = pack8(acc[ai][0][m][0] * rs, acc[ai][0][m][1] * rs); *(u32x4*)(rowp + HALF) = pack8(acc[ai][1][m][0] * rs, acc[ai][1][m][1] * rs); }
            return;
        }
        const int head = 4 * u.pn + wc;
        f32x4 gA0 = *(const f32x4*)(g_kn + 8 * fq), gA1 = *(const f32x4*)(g_kn + 8 * fq + 4), gB0 = *(const f32x4*)(g_kn + 32 + 8 * fq), gB1 = *(const f32x4*)(g_kn + 32 + 8 * fq + 4);
        const f32x4 gR1 = *(const f32x4*)(g_kn + 64 + 4 * fq), gR2 = *(const f32x4*)(g_kn + 80 + 4 * fq);
#pragma unroll
        for (int ai = 0; ai < 2; ++ai)
#pragma unroll
            for (int m = 0; m < 4; ++m) { const int row = row0 + ai * HALF + m * 16;
                const float rs = __builtin_amdgcn_rsqf(part_sum8(part + (size_t)row * 16 + 8) * (1.f / 256) + EPS_);
                f32x4 a0 = acc[ai][0][m][0] * rs, a1 = acc[ai][0][m][1] * rs, b0 = acc[ai][1][m][0] * rs, b1 = acc[ai][1][m][1] * rs;
                const unsigned long long p1 = *(const unsigned long long*)(QA + (size_t)row * 768 + 640 + 4 * fq), p2 = *(const unsigned long long*)(QA + (size_t)row * 768 + 656 + 4 * fq);
                f32x4 x1, x2;
                x1[0] = __builtin_bit_cast(float, (unsigned)(p1 << 16)); x1[1] = __builtin_bit_cast(float, (unsigned)p1 & 0xffff0000u);
                x1[2] = __builtin_bit_cast(float, (unsigned)(p1 >> 32) << 16); x1[3] = __builtin_bit_cast(float, (unsigned)(p1 >> 32) & 0xffff0000u);
                x2[0] = __builtin_bit_cast(float, (unsigned)(p2 << 16)); x2[1] = __builtin_bit_cast(float, (unsigned)p2 & 0xffff0000u);
                x2[2] = __builtin_bit_cast(float, (unsigned)(p2 >> 32) << 16); x2[3] = __builtin_bit_cast(float, (unsigned)(p2 >> 32) & 0xffff0000u);
                const float ss = fq_sum(sq8(a0, a1) + sq8(b0, b1) + sq8(x1, x2));
                const float sh = __builtin_amdgcn_rsqf(ss * (1.f / 96) + EPS_);
                bf16_t* kp = Kd + (size_t)row * 1536 + head * 96;
                *(u32x4*)(kp + 8 * fq) = pack8(a0 * gA0 * sh, a1 * gA1 * sh); *(u32x4*)(kp + 32 + 8 * fq) = pack8(b0 * gB0 * sh, b1 * gB1 * sh);
                const f32x4* rp = (const f32x4*)(rope + ((size_t)(row & 2047) * 16 + 4 * fq) * 2);
                const f32x4 c01 = rp[0], c23 = rp[1];
                const f32x4 y1 = x1 * gR1 * sh, y2 = x2 * gR2 * sh;
                f32x4 o1, o2;
                o1[0] = y1[0] * c01[0] - y2[0] * c01[1]; o2[0] = y2[0] * c01[0] + y1[0] * c01[1];
                o1[1] = y1[1] * c01[2] - y2[1] * c01[3]; o2[1] = y2[1] * c01[2] + y1[1] * c01[3];
                o1[2] = y1[2] * c23[0] - y2[2] * c23[1]; o2[2] = y2[2] * c23[0] + y1[2] * c23[1];
                o1[3] = y1[3] * c23[2] - y2[3] * c23[3]; o2[3] = y2[3] * c23[2] + y1[3] * c23[3];
                unsigned long long w1 = (unsigned long long)cvt_pk_bf16(o1[0], o1[1]) | ((unsigned long long)cvt_pk_bf16(o1[2], o1[3]) << 32);
                unsigned long long w2 = (unsigned long long)cvt_pk_bf16(o2[0], o2[1]) | ((unsigned long long)cvt_pk_bf16(o2[2], o2[3]) << 32);
                *(unsigned long long*)(kp + 64 + 4 * fq) = w1; *(unsigned long long*)(kp + 80 + 4 * fq) = w2; }
    }
};

struct EpiK2Q2 {
    static constexpr bool PERM = true, AFTER_DRAIN = false;
    bf16_t* O; const float* pss; const float* gk; const float* gq; float wscale;
    __device__ __forceinline__ void operator()(const f32x4 (&acc)[2][2][4][2], const Unit& u, int wr, int wc, int fr, int fq) const {
        { int t_ = lane_id_(); asm volatile("" : "+v"(t_)); fr = t_ & 15; fq = (t_ >> 4) & 3; }
        const int row0 = u.pm * BM + wr * 64 + fr, isq = u.pn >> 2, tl = u.pn & 3;
        const float* g = isq ? gq : gk; const float post = isq ? 0.125f * 1.4426950408889634f : 1.f;
        const f32x4 gA0 = *(const f32x4*)(g + 8 * fq) * post, gA1 = *(const f32x4*)(g + 8 * fq + 4) * post, gB0 = *(const f32x4*)(g + 32 + 8 * fq) * post, gB1 = *(const f32x4*)(g + 32 + 8 * fq + 4) * post;
        const int colh = isq * 2048 + (4 * tl + wc) * 64;
        unsigned zhi_ = 0u; asm volatile("" : "+v"(zhi_));
        const unsigned long long coff = ((unsigned long long)zhi_ << 32) | (unsigned)((colh + 8 * fq) * 2);
#pragma unroll
        for (int ai = 0; ai < 2; ++ai)
#pragma unroll
            for (int m = 0; m < 4; ++m) { const int row = row0 + ai * HALF + m * 16; unsigned char* rowp = (unsigned char*)O + (size_t)row * 6144 + coff;
                const float rs = __builtin_amdgcn_rsqf(part_sum16(pss + (size_t)row * 16) * (1.f / 1024) + EPS_) * wscale;
                const f32x4 a0 = acc[ai][0][m][0] * rs, a1 = acc[ai][0][m][1] * rs, b0 = acc[ai][1][m][0] * rs, b1 = acc[ai][1][m][1] * rs;
                const float ss = fq_sum(sq8(a0, a1) + sq8(b0, b1));
                const float sh = __builtin_amdgcn_rsqf(ss * (1.f / 64) + EPS_);
                *(u32x4*)(rowp) = pack8(a0 * gA0 * sh, a1 * gA1 * sh); *(u32x4*)(rowp + 64) = pack8(b0 * gB0 * sh, b1 * gB1 * sh); }
    }
};
struct EpiRowScale16 {
    static constexpr bool PERM = true, AFTER_DRAIN = false;
    bf16_t* O; int ldc; int coff; const float* pss; float wscale;
    __device__ __forceinline__ void operator()(const f32x4 (&acc)[2][2][4][2], const Unit& u, int wr, int wc, int fr, int fq) const {
        { int t_ = lane_id_(); asm volatile("" : "+v"(t_)); fr = t_ & 15; fq = (t_ >> 4) & 3; }
        const int row0 = u.pm * BM + wr * 64 + fr, col0 = coff + u.pn * BM + wc * 32 + 8 * fq;
#pragma unroll
        for (int ai = 0; ai < 2; ++ai)
#pragma unroll
            for (int m = 0; m < 4; ++m) { const int row = row0 + ai * HALF + m * 16; bf16_t* rowp = O + (size_t)row * ldc + col0;
                const float rs = __builtin_amdgcn_rsqf(part_sum16(pss + (size_t)row * 16) * (1.f / 1024) + EPS_) * wscale;
                *(u32x4*)(rowp) = pack8(acc[ai][0][m][0] * rs, acc[ai][0][m][1] * rs); *(u32x4*)(rowp + HALF) = pack8(acc[ai][1][m][0] * rs, acc[ai][1][m][1] * rs); }
    }
};

template <bool SSQ> struct EpiGated {
    static constexpr bool PERM = true, AFTER_DRAIN = false;
    bf16_t* Hd; int ldc; int ntile; const float* rs;
    __device__ __forceinline__ void operator()(const f32x4 (&acc)[2][2][4][2], const Unit& u, int wr, int wc, int fr, int fq) const {
        { int t_ = lane_id_(); asm volatile("" : "+v"(t_)); fr = t_ & 15; fq = (t_ >> 4) & 3; }
        const int pnl = ntile ? (u.pn % ntile) : u.pn;
        const int row0 = u.pm * BM + wr * 64 + fr, col0 = pnl * HALF + wc * 32 + 8 * fq;
#pragma unroll
        for (int ai = 0; ai < 2; ++ai)
#pragma unroll
            for (int m = 0; m < 4; ++m) { const int row = row0 + ai * HALF + m * 16; bf16_t* rowp = Hd + (size_t)row * ldc + col0;
                const float r = SSQ ? __builtin_amdgcn_rsqf(part_sum16(rs + (size_t)row * 16) * (1.f / 1024) + EPS_) : rs[row];
                const f32x4 g0 = acc[ai][0][m][0] * r, g1 = acc[ai][0][m][1] * r, u0 = acc[ai][1][m][0] * r, u1 = acc[ai][1][m][1] * r;
                u32x4 w;
                w.x = cvt_pk_bf16(silu_f(g0[0]) * u0[0], silu_f(g0[1]) * u0[1]); w.y = cvt_pk_bf16(silu_f(g0[2]) * u0[2], silu_f(g0[3]) * u0[3]);
                w.z = cvt_pk_bf16(silu_f(g1[0]) * u1[0], silu_f(g1[1]) * u1[1]); w.w = cvt_pk_bf16(silu_f(g1[2]) * u1[2], silu_f(g1[3]) * u1[3]);
                *(u32x4*)rowp = w; }
    }
};

struct EpiGatedF8 {
    static constexpr bool PERM = true, AFTER_DRAIN = false;
    unsigned char* Hd; int ldc; int ntile;
    static __device__ __forceinline__ float gate(float g, float u) {
        const float e = __builtin_amdgcn_exp2f(g * (-1.4426950408889634f / 64.f)); return (g * u) * (__builtin_amdgcn_rcpf(1.f + e) * (1.f / 4096.f)); }
    __device__ __forceinline__ void operator()(const f32x4 (&acc)[2][2][4][2], const Unit& u, int wr, int wc, int fr, int fq) const {
        { int t_ = lane_id_(); asm volatile("" : "+v"(t_)); fr = t_ & 15; fq = (t_ >> 4) & 3; }
        const int pnl = u.pn % ntile;
        const int row0 = u.pm * BM + wr * 64 + fr, col0 = pnl * HALF + wc * 32 + 8 * fq;
#pragma unroll
        for (int ai = 0; ai < 2; ++ai)
#pragma unroll
            for (int m = 0; m < 4; ++m) { const int row = row0 + ai * HALF + m * 16; unsigned char* rowp = Hd + (size_t)row * ldc + col0;
                const f32x4 g0 = acc[ai][0][m][0], g1 = acc[ai][0][m][1], u0 = acc[ai][1][m][0], u1 = acc[ai][1][m][1];
                unsigned long long w = (unsigned long long)pk_fp8x4(gate(g0[0], u0[0]), gate(g0[1], u0[1]), gate(g0[2], u0[2]), gate(g0[3], u0[3]))
                                     | ((unsigned long long)pk_fp8x4(gate(g1[0], u1[0]), gate(g1[1], u1[1]), gate(g1[2], u1[2]), gate(g1[3], u1[3])) << 32);
                *(unsigned long long*)rowp = w; }
    }
};

template <bool SSQ, bool XF8, bool RES16> struct EpiResStream {
    static constexpr bool PERM = true, AFTER_DRAIN = false;
    const void* res; bf16_t* XB; unsigned char* X8; float* ssq; float ascale;
    __device__ __forceinline__ void operator()(const f32x4 (&acc)[2][2][4][2], const Unit& u, int wr, int wc, int fr, int fq) const {
        { int t_ = lane_id_(); asm volatile("" : "+v"(t_)); fr = t_ & 15; fq = (t_ >> 4) & 3; }
        const int row0 = u.pm * BM + wr * 64 + fr, col0 = u.pn * BM + wc * 32 + 8 * fq;
        f32x4 rw[4][2][2];
#define ERS_ROW(it) (row0 + ((it) >> 2) * HALF + ((it) & 3) * 16)
#define ERS_LOAD(it) do { const size_t ro_ = (size_t)ERS_ROW(it) * 1024 + col0; _Pragma("unroll") for (int bj = 0; bj < 2; ++bj) { \
            if constexpr (RES16) rw[(it) & 3][bj][0] = __builtin_bit_cast(f32x4, *(const u32x4*)((const bf16_t*)res + ro_ + bj * HALF)); \
            else { _Pragma("unroll") for (int n = 0; n < 2; ++n) rw[(it) & 3][bj][n] = *(const f32x4*)((const float*)res + ro_ + bj * HALF + n * 4); } } } while (0)
        ERS_LOAD(0); ERS_LOAD(1); ERS_LOAD(2); ERS_LOAD(3);
#pragma unroll
        for (int it = 0; it < 8; ++it) { const int ai = it >> 2, m = it & 3; const int row = ERS_ROW(it); const size_t ro = (size_t)row * 1024 + col0;
                f32x4 r[2][2];
#pragma unroll
                for (int bj = 0; bj < 2; ++bj) {
                    if constexpr (RES16) { const u32x4 w = __builtin_bit_cast(u32x4, rw[it & 3][bj][0]);
                        r[bj][0] = (f32x4){__builtin_bit_cast(float, w.x << 16), __builtin_bit_cast(float, w.x & 0xffff0000u), __builtin_bit_cast(float, w.y << 16), __builtin_bit_cast(float, w.y & 0xffff0000u)};
                        r[bj][1] = (f32x4){__builtin_bit_cast(float, w.z << 16), __builtin_bit_cast(float, w.z & 0xffff0000u), __builtin_bit_cast(float, w.w << 16), __builtin_bit_cast(float, w.w & 0xffff0000u)}; }
                    else { r[bj][0] = rw[it & 3][bj][0]; r[bj][1] = rw[it & 3][bj][1]; }
                    r[bj][0] = r[bj][0] + acc[ai][bj][m][0] * ascale; r[bj][1] = r[bj][1] + acc[ai][bj][m][1] * ascale; }
                if (it + 4 < 8) ERS_LOAD(it + 4);
                *(u32x4*)(XB + ro) = pack8(r[0][0], r[0][1]); *(u32x4*)(XB + ro + HALF) = pack8(r[1][0], r[1][1]);
                if constexpr (XF8) { unsigned char* x8 = X8 + ro;
                    *(unsigned long long*)(x8) = (unsigned long long)pk_fp8x4(r[0][0][0], r[0][0][1], r[0][0][2], r[0][0][3]) | ((unsigned long long)pk_fp8x4(r[0][1][0], r[0][1][1], r[0][1][2], r[0][1][3]) << 32);
                    *(unsigned long long*)(x8 + HALF) = (unsigned long long)pk_fp8x4(r[1][0][0], r[1][0][1], r[1][0][2], r[1][0][3]) | ((unsigned long long)pk_fp8x4(r[1][1][0], r[1][1][1], r[1][1][2], r[1][1][3]) << 32); }
                if (SSQ) { const float t = fq_sum(sq8(r[0][0], r[0][1]) + sq8(r[1][0], r[1][1])); if (fq == 0) ssq[(size_t)row * 16 + u.pn * 4 + wc] = t; } }
#undef ERS_LOAD
#undef ERS_ROW
    }
};

template <bool FIRST> struct EpiMoeDown {
    static constexpr bool PERM = false, AFTER_DRAIN = false;
    float* out; const bf16_t* xb; const int* slot_tok; const float* slot_gate; int slot_base; int ldc; float wscale;
    __device__ __forceinline__ void operator()(const f32x4 (&acc)[2][2][4][2], const Unit& u, int wr, int wc, int fr, int fq) const {
        { int t_ = lane_id_(); asm volatile("" : "+v"(t_)); fr = t_ & 15; fq = (t_ >> 4) & 3; }
        const int pnl = u.pn & 3;
        const int row0 = slot_base + u.pm * BM + wr * 64 + fr, col0 = pnl * BM + wc * 32 + 4 * fq;
        int tk[8]; float gt[8];
#pragma unroll
        for (int it = 0; it < 8; ++it) { const int slot = row0 + (it >> 2) * HALF + (it & 3) * 16; tk[it] = slot_tok[slot]; gt[it] = slot_gate[slot] * wscale; }
        f32x4 rw[4][2][2]; unsigned rlo[4][2][2], rhi[4][2][2];
#define EMD_LOAD(it) do { if (tk[it] >= 0) { _Pragma("unroll") for (int bj = 0; bj < 2; ++bj) _Pragma("unroll") for (int n = 0; n < 2; ++n) { \
            if constexpr (FIRST) { const unsigned long long q_ = *(const unsigned long long*)(xb + (size_t)tk[it] * ldc + col0 + bj * HALF + n * 16); \
                rlo[(it) & 3][bj][n] = (unsigned)q_; rhi[(it) & 3][bj][n] = (unsigned)(q_ >> 32); } \
            else rw[(it) & 3][bj][n] = *(const f32x4*)(out + (size_t)tk[it] * ldc + col0 + bj * HALF + n * 16); } } } while (0)
        EMD_LOAD(0); EMD_LOAD(1); EMD_LOAD(2); EMD_LOAD(3);
#pragma unroll
        for (int it = 0; it < 8; ++it) { const int ai = it >> 2, m = it & 3;
            if (tk[it] >= 0) { float* rowp = out + (size_t)tk[it] * ldc + col0;
#pragma unroll
                for (int bj = 0; bj < 2; ++bj)
#pragma unroll
                    for (int n = 0; n < 2; ++n) { f32x4 r;
                        if constexpr (FIRST) { const unsigned lo = rlo[it & 3][bj][n], hi = rhi[it & 3][bj][n];
                            r = (f32x4){__builtin_bit_cast(float, lo << 16), __builtin_bit_cast(float, lo & 0xffff0000u), __builtin_bit_cast(float, hi << 16), __builtin_bit_cast(float, hi & 0xffff0000u)}; }
                        else r = rw[it & 3][bj][n];
                        *(f32x4*)(rowp + bj * HALF + n * 16) = r + acc[ai][bj][m][n] * gt[it]; } }
            if (it + 4 < 8) EMD_LOAD(it + 4); }
#undef EMD_LOAD
    }
};

struct MoeOrder {
    int nM, nN, nwg, G, c; int pb[7];
    int rot;
    int nBusy, SK;
    __device__ void init(int nPanels, int nN_, int G_, int c_) { nM = nPanels; nN = nN_; nwg = nM * nN; G = G_; c = c_; nBusy = 0; SK = 0; rot = 0; }
    __device__ __forceinline__ int expert_of(int pm) const { int e = 0;
#pragma unroll
        for (int k = 0; k < 7; ++k) e += (pm >= pb[k]) ? 1 : 0;
        return e; }
    __device__ bool next(int i, Unit& u) const {
        int L;
        if (nBusy == 0) { int ce = c - rot; if (ce < 0) ce += G; L = i * G + ce; }
        else if (c >= nBusy) L = (i < SK) ? i * (G - nBusy) + (c - nBusy) : SK * (G - nBusy) + (i - SK) * G + c;
        else L = SK * (G - nBusy) + i * G + c;
        if (L >= nwg) return false;
        int wgid = L; { const int q = nwg / NXCD, r = nwg % NXCD, xcd = wgid % NXCD, off = wgid / NXCD; wgid = (xcd < r ? xcd * (q + 1) : r * (q + 1) + (xcd - r) * q) + off; }
        const int nig = WGM * nN, gid = wgid / nig, fm = gid * WGM, gsz = (nM - fm) < WGM ? (nM - fm) : WGM;
        u.pm = fm + ((wgid % nig) % gsz); const int pnl = (wgid % nig) / gsz;
        u.pn = expert_of(u.pm) * nN + pnl; return true;
    }
    __device__ __forceinline__ void a_ready(const Unit&) const {}
    __device__ __forceinline__ void done(const Unit&) const {}
};
struct LeftOrder {
    MoeOrder M; int nLeft, c0, pbase;
    __device__ bool next(int i, Unit& u) const { const int j = M.c - c0; if (i != 0 || j < 0 || j >= nLeft) return false; u.pm = pbase + (j >> 2); u.pn = M.expert_of(u.pm) * 4 + (j & 3); return true; }
    __device__ __forceinline__ void a_ready(const Unit&) const {}
    __device__ __forceinline__ void done(const Unit&) const {}
};
template <class Epi, class Sched, bool ALIGN_EPI = false, bool SP2 = false, bool F8 = false>
__device__ __forceinline__ void gemm_phase(PG8_LAS unsigned char* lds, const Gemm g, const Sched& S, const Epi& E, const int wave_idx) {
    int tid_ = wave_idx * 64 + lane_id_(); asm volatile("" : "+v"(tid_));
    const int tid = tid_, wid = __builtin_amdgcn_readfirstlane(tid >> 6), lane = tid & 63, wr = wid >> 2, wc = wid & 3, fr = lane & 15, fq = lane >> 4;
    const int K = g.K, nt = K / BK;
    unsigned voffA0, voffB0;
    { int R, C; stage_rc(tid * 16, R, C); const int Rb = Epi::PERM ? ((R & ~31) + perm32(R & 31)) : R;
      voffA0 = (unsigned)(R * g.lda + C) * 2u; voffB0 = (unsigned)(Rb * K + C) * 2u; }
    const size_t voffAR = (size_t)64 * g.lda * 2, voffBR = (size_t)64 * K * 2;
    const size_t kstep = (size_t)(BK * 2);
    const size_t hstepA = (size_t)HALF * g.lda * 2, hstepB = (size_t)HALF * K * 2;
    const size_t tstepA = 2 * hstepA, tstepB = 2 * hstepB;
    const unsigned lds0_ = (unsigned)(__UINTPTR_TYPE__)lds;
    const unsigned ldsw = (unsigned)wid * 1024u;
    const int aoff = lds_byte(wr * 64 + fr, fq * 8), boff = lds_byte(wc * 32 + fr, fq * 8);
#define PG8_SA(b, h) (((b) * 2 + (h)) * HTB)
#define PG8_SB(b, h) ((4 + (b) * 2 + (h)) * HTB)
#define PG8_STAGE(bufoff, gbase, voff) do { _Pragma("unroll") for (int _i = 0; _i < 2; ++_i) { unsigned keep_; const char* sb_ = (const char*)(gbase) + (size_t)_i * voff##R; \
        asm volatile("s_mov_b32 %0, m0\n\ts_mov_b32 m0, %3\n\ts_nop 0\n\tglobal_load_lds_dwordx4 %1, %2\n\ts_mov_b32 m0, %0" \
            : "=&s"(keep_) : "v"(voff##0), "s"(sb_), "s"(lds0_ + (unsigned)((bufoff) + _i * 8192) + ldsw) : "memory"); } } while (0)
#define PG8_LDA(dst, b, h) do { _Pragma("unroll") for (int m = 0; m < 4; ++m) _Pragma("unroll") for (int k = 0; k < 2; ++k) dst[m][k] = *(const PG8_LAS bf16x8*)(lds + PG8_SA(b, h) + aoff + m * 2048 + k * 1024); } while (0)
#define PG8_LDB(dst, b, h) do { _Pragma("unroll") for (int n = 0; n < 2; ++n) _Pragma("unroll") for (int k = 0; k < 2; ++k) dst[n][k] = *(const PG8_LAS bf16x8*)(lds + PG8_SB(b, h) + boff + n * 2048 + k * 1024); } while (0)
#define PG8_MMA(ai, bj, At, Bt) do { __builtin_amdgcn_s_setprio(1); _Pragma("unroll") for (int m = 0; m < 4; ++m) _Pragma("unroll") for (int n = 0; n < 2; ++n) { \
        if constexpr (F8) { typedef int v8i_ __attribute__((ext_vector_type(8))); typedef int v4i_ __attribute__((ext_vector_type(4))); \
            const v4i_ b0_ = __builtin_bit_cast(v4i_, Bt[n][0]), b1_ = __builtin_bit_cast(v4i_, Bt[n][1]), a0_ = __builtin_bit_cast(v4i_, At[m][0]), a1_ = __builtin_bit_cast(v4i_, At[m][1]); \
            const v8i_ bb_ = __builtin_shufflevector(b0_, b1_, 0, 1, 2, 3, 4, 5, 6, 7), aa_ = __builtin_shufflevector(a0_, a1_, 0, 1, 2, 3, 4, 5, 6, 7); \
            acc[ai][bj][m][n] = __builtin_amdgcn_mfma_scale_f32_16x16x128_f8f6f4(bb_, aa_, acc[ai][bj][m][n], 0, 0, 0, 0, 0, 0); } \
        else { _Pragma("unroll") for (int k = 0; k < 2; ++k) acc[ai][bj][m][n] = __builtin_amdgcn_mfma_f32_16x16x32_bf16(Bt[n][k], At[m][k], acc[ai][bj][m][n], 0, 0, 0); } } \
        __builtin_amdgcn_s_setprio(0); } while (0)
#define PG8_WAIT_V(n) asm volatile("s_waitcnt vmcnt(" #n ")" ::: "memory")
#define PG8_WAIT_L(n) asm volatile("s_waitcnt lgkmcnt(" #n ")" ::: "memory")
#define PG8_BAR __builtin_amdgcn_s_barrier()
#define PG8_SCHED __builtin_amdgcn_sched_barrier(0)
    Unit cur, nxt; int ui = 0;
    if (!S.next(0, cur)) return;
    f32x4 acc[2][2][4][2];
#pragma unroll
    for (int a = 0; a < 2; ++a)
#pragma unroll
        for (int b = 0; b < 2; ++b)
#pragma unroll
            for (int m = 0; m < 4; ++m)
#pragma unroll
                for (int n = 0; n < 2; ++n) acc[a][b][m][n] = (f32x4){0.f, 0.f, 0.f, 0.f};
    bf16x8 At[4][2], B0[2][2], B1[2][2];
    const char* cA = (const char*)g.A + (size_t)cur.pm * tstepA; const char* cB = (const char*)g.Bt + (size_t)cur.pn * tstepB;
    S.a_ready(cur);
    if constexpr (SP2) {
        PG8_STAGE(PG8_SB(0, 0), cB, voffB); PG8_STAGE(PG8_SB(0, 1), cB + hstepB, voffB); PG8_STAGE(PG8_SA(0, 0), cA, voffA); PG8_STAGE(PG8_SA(0, 1), cA + hstepA, voffA);
        if (wr == 1) PG8_BAR;
        PG8_WAIT_V(2); PG8_BAR;
        PG8_STAGE(PG8_SB(1, 0), cB + kstep, voffB); PG8_STAGE(PG8_SA(1, 0), cA + kstep, voffA); PG8_STAGE(PG8_SB(1, 1), cB + hstepB + kstep, voffB);
        PG8_WAIT_V(6); PG8_BAR;
    } else {
        PG8_STAGE(PG8_SB(0, 0), cB, voffB); PG8_STAGE(PG8_SA(0, 0), cA, voffA); PG8_STAGE(PG8_SB(0, 1), cB + hstepB, voffB); PG8_STAGE(PG8_SA(0, 1), cA + hstepA, voffA);
        if (wr == 1) PG8_BAR;
        PG8_WAIT_V(4); PG8_BAR;
        PG8_STAGE(PG8_SB(1, 0), cB + kstep, voffB); PG8_STAGE(PG8_SA(1, 0), cA + kstep, voffA); PG8_STAGE(PG8_SB(1, 1), cB + hstepB + kstep, voffB);
        PG8_WAIT_V(6); PG8_BAR;
    }
    for (;;) {
        const bool has_next = S.next(ui + 1, nxt);
        const char* nA = has_next ? (const char*)g.A + (size_t)nxt.pm * tstepA : cA; const char* nB = has_next ? (const char*)g.Bt + (size_t)nxt.pn * tstepB : cB;
#pragma unroll 1
        for (int t = 0; t < nt; t += 2) {
            const bool last = (t == nt - 2);
            const char* a1 = cA + (size_t)(t + 1) * kstep;
            const char* a2 = last ? nA : cA + (size_t)(t + 2) * kstep; const char* b2 = last ? nB : cB + (size_t)(t + 2) * kstep;
            const char* a3 = a2 + kstep; const char* b3 = b2 + kstep;
            if (last && has_next) S.a_ready(nxt);
            if constexpr (SP2) {
            PG8_LDB(B0, 0, 0); PG8_LDB(B1, 0, 1); PG8_SCHED; PG8_LDA(At, 0, 0); PG8_STAGE(PG8_SA(1, 1), a1 + hstepA, voffA);
            PG8_WAIT_V(8); PG8_WAIT_L(0); PG8_BAR; PG8_MMA(0, 0, At, B0); PG8_MMA(0, 1, At, B1); PG8_BAR; PG8_SCHED;
            PG8_LDA(At, 0, 1); PG8_STAGE(PG8_SB(0, 0), b2, voffB); PG8_STAGE(PG8_SB(0, 1), b2 + hstepB, voffB); PG8_STAGE(PG8_SA(0, 0), a2, voffA);
            PG8_WAIT_V(8); PG8_WAIT_L(0); PG8_BAR; PG8_MMA(1, 0, At, B0); PG8_MMA(1, 1, At, B1); PG8_BAR; PG8_SCHED;
            PG8_LDB(B0, 1, 0); PG8_LDB(B1, 1, 1); PG8_SCHED; PG8_LDA(At, 1, 0); PG8_STAGE(PG8_SA(0, 1), a2 + hstepA, voffA);
            PG8_WAIT_V(8); PG8_WAIT_L(0); PG8_BAR; PG8_MMA(0, 0, At, B0); PG8_MMA(0, 1, At, B1); PG8_BAR; PG8_SCHED;
            PG8_LDA(At, 1, 1); PG8_STAGE(PG8_SB(1, 0), b3, voffB); PG8_STAGE(PG8_SB(1, 1), b3 + hstepB, voffB); PG8_STAGE(PG8_SA(1, 0), a3, voffA);
            PG8_WAIT_V(8); PG8_WAIT_L(0); PG8_BAR; PG8_MMA(1, 0, At, B0); PG8_MMA(1, 1, At, B1); PG8_BAR; PG8_SCHED;
            } else {
            PG8_LDB(B0, 0, 0); PG8_SCHED; PG8_LDA(At, 0, 0); PG8_STAGE(PG8_SA(1, 1), a1 + hstepA, voffA);
            PG8_WAIT_L(8); PG8_BAR; PG8_WAIT_L(0); PG8_MMA(0, 0, At, B0); PG8_BAR; PG8_SCHED;
            PG8_LDB(B1, 0, 1); PG8_STAGE(PG8_SB(0, 0), b2, voffB);
            PG8_BAR; PG8_WAIT_L(0); PG8_MMA(0, 1, At, B1); PG8_BAR;
            PG8_LDA(At, 0, 1); PG8_STAGE(PG8_SA(0, 0), a2, voffA);
            PG8_BAR; PG8_WAIT_L(0); PG8_MMA(1, 0, At, B0); PG8_BAR; PG8_SCHED;
            PG8_STAGE(PG8_SB(0, 1), b2 + hstepB, voffB);
            PG8_WAIT_V(6); PG8_BAR; PG8_MMA(1, 1, At, B1); PG8_BAR;
            PG8_LDB(B0, 1, 0); PG8_SCHED; PG8_LDA(At, 1, 0); PG8_STAGE(PG8_SA(0, 1), a2 + hstepA, voffA);
            PG8_WAIT_L(8); PG8_BAR; PG8_WAIT_L(0); PG8_MMA(0, 0, At, B0); PG8_BAR; PG8_SCHED;
            PG8_LDB(B1, 1, 1); PG8_STAGE(PG8_SB(1, 0), b3, voffB);
            PG8_BAR; PG8_WAIT_L(0); PG8_MMA(0, 1, At, B1); PG8_BAR;
            PG8_LDA(At, 1, 1); PG8_STAGE(PG8_SA(1, 0), a3, voffA);
            PG8_BAR; PG8_WAIT_L(0); PG8_MMA(1, 0, At, B0); PG8_BAR; PG8_SCHED;
            PG8_STAGE(PG8_SB(1, 1), b3 + hstepB, voffB);
            PG8_WAIT_V(6); PG8_BAR; PG8_MMA(1, 1, At, B1); PG8_BAR;
            }
        }
        if constexpr (ALIGN_EPI) { if (wr == 0) PG8_BAR; }
        if constexpr (!Epi::AFTER_DRAIN) { E(acc, cur, wr, wc, fr, fq); S.done(cur); }
        if (!has_next) break;
#pragma unroll
        for (int a = 0; a < 2; ++a)
#pragma unroll
            for (int b = 0; b < 2; ++b)
#pragma unroll
                for (int m = 0; m < 4; ++m)
#pragma unroll
                    for (int n = 0; n < 2; ++n) acc[a][b][m][n] = (f32x4){0.f, 0.f, 0.f, 0.f};
        cur = nxt; cA = nA; cB = nB; ++ui;
        if constexpr (ALIGN_EPI) { if (wr == 1) PG8_BAR; }
    }
    PG8_WAIT_V(0);
    if constexpr (!ALIGN_EPI) { if (wr == 0) PG8_BAR; }
    PG8_BAR;
    if constexpr (Epi::AFTER_DRAIN) { E.fused(acc, cur, wr, wc, fr, fq, lds, wid, lane); S.done(cur); }
#undef PG8_SA
#undef PG8_SB
#undef PG8_STAGE
#undef PG8_LDA
#undef PG8_LDB
#undef PG8_MMA
#undef PG8_WAIT_V
#undef PG8_WAIT_L
#undef PG8_BAR
#undef PG8_SCHED
}
}
namespace att {
#define ATT_LAS __attribute__((address_space(3)))
typedef unsigned short bf16;
typedef short bf16x8 __attribute__((ext_vector_type(8)));
typedef short s16x4 __attribute__((ext_vector_type(4)));
typedef float f32x16 __attribute__((ext_vector_type(16)));
typedef float f32x4_t __attribute__((ext_vector_type(4)));
typedef unsigned u32x4 __attribute__((ext_vector_type(4)));
typedef unsigned u32x2 __attribute__((ext_vector_type(2)));
typedef float f32x2_t __attribute__((ext_vector_type(2))); typedef __bf16 bf16x2_t __attribute__((ext_vector_type(2)));
__device__ __forceinline__ unsigned cvtpk(float lo, float hi) { f32x2_t v = {lo, hi}; bf16x2_t b = __builtin_convertvector(v, bf16x2_t); return __builtin_bit_cast(unsigned, b); }
__device__ __forceinline__ s16x4 vtr(const ATT_LAS unsigned char* p) { return __builtin_bit_cast(s16x4, __builtin_amdgcn_ds_read_tr16_b64_v4i16((ATT_LAS s16x4*)p)); }
constexpr int VSTR = 192;
template <int DQK> struct Geo { static constexpr int KSTR = DQK * 2 + 16, KBUF = 64 * KSTR, VBUF = 64 * VSTR, CPR = DQK / 8, NKC = 64 * CPR, KIT = (NKC + 511) / 512; };
template <int DQK> constexpr int lds_bytes() { return 3 * Geo<DQK>::KBUF + 3 * Geo<DQK>::VBUF + 2048 + 8192; }

__device__ __forceinline__ float xhalf_sum(float m) { return xor32_sum(m); }
__device__ __forceinline__ float max3f(float a, float b, float c) { float r; asm("v_max3_f32 %0, %1, %2, %3" : "=v"(r) : "v"(a), "v"(b), "v"(c)); return r; }
__device__ __forceinline__ float max2f(float a, float b) { float r; asm("v_max_f32_e32 %0, %1, %2" : "=v"(r) : "v"(a), "v"(b)); return r; }
__device__ __forceinline__ float rowmax32(const f32x16& p0, const f32x16& p1) {
    float a = max2f(p0[0], p1[0]), b = max2f(p0[1], p1[1]), c = max2f(p0[2], p1[2]), d = max2f(p0[3], p1[3]);
#pragma unroll
    for (int r = 4; r < 16; r += 4) { a = max3f(a, p0[r], p1[r]); b = max3f(b, p0[r + 1], p1[r + 1]); c = max3f(c, p0[r + 2], p1[r + 2]); d = max3f(d, p0[r + 3], p1[r + 3]); }
    const float m = max2f(max2f(a, b), max2f(c, d));
    float lo_, hi_; halves32(m, lo_, hi_);
    return max2f(lo_, hi_);
}

template <int DQK, bool BAND, int qpitch, int kpitch, int vpitch, int opitch, bool OF8 = false, bool NOMAX = false, int NS = 2>
__device__ __forceinline__ void attn_unit(ATT_LAS unsigned char* lds, const bf16* Qb, const bf16* Kb, const bf16* Vb, bf16* Ob,
                                          int q0, int t_lo, int t_hi, int my_lo, int my_hi, int cc, const float* bias_g, const float* g_qn, const float* rope, const int wave_idx) {
    typedef Geo<DQK> G;
    int tid_ = wave_idx * 64 + lane_id_(); asm volatile("" : "+v"(tid_));
    const int tid = tid_, lane = tid & 63, r32 = lane & 31, hi = lane >> 5, wid = __builtin_amdgcn_readfirstlane(tid >> 6);
    ATT_LAS float* biasL = (ATT_LAS float*)(lds + NS * G::KBUF + NS * G::VBUF);
    bf16x8 qf[DQK / 16];
    { const bf16* qp = Qb + (size_t)(q0 + wid * 32 + r32) * qpitch + 8 * hi;
#pragma unroll
      for (int kk = 0; kk < DQK / 16; ++kk) qf[kk] = *(const bf16x8*)(qp + 16 * kk); }
    if constexpr (!BAND) {
        float qv[DQK / 16][8]; float ss = 0.f;
#pragma unroll
        for (int kk = 0; kk < DQK / 16; ++kk)
#pragma unroll
            for (int j = 0; j < 8; ++j) { qv[kk][j] = __builtin_bit_cast(float, (unsigned)(unsigned short)qf[kk][j] << 16); ss += qv[kk][j] * qv[kk][j]; }
        ss = xhalf_sum(ss);
        const float rs = __builtin_amdgcn_rsqf(ss * (1.f / DQK) + 1e-6f) * (0.10206207261596577f * 1.4426950408889634f);
#pragma unroll
        for (int kk = 0; kk < DQK / 16; ++kk) { const f32x4_t g0 = *(const f32x4_t*)(g_qn + 16 * kk + 8 * hi), g1 = *(const f32x4_t*)(g_qn + 16 * kk + 8 * hi + 4);
#pragma unroll
            for (int j = 0; j < 4; ++j) { qv[kk][j] *= rs * g0[j]; qv[kk][4 + j] *= rs * g1[j]; } }
        const f32x4_t* rp = (const f32x4_t*)(rope + ((size_t)(q0 + wid * 32 + r32) * 16 + 8 * hi) * 2);
#pragma unroll
        for (int j2 = 0; j2 < 4; ++j2) { const f32x4_t cs = rp[j2];
            { const float x1 = qv[4][2 * j2], x2 = qv[5][2 * j2]; qv[4][2 * j2] = x1 * cs[0] - x2 * cs[1]; qv[5][2 * j2] = x2 * cs[0] + x1 * cs[1]; }
            { const float x1 = qv[4][2 * j2 + 1], x2 = qv[5][2 * j2 + 1]; qv[4][2 * j2 + 1] = x1 * cs[2] - x2 * cs[3]; qv[5][2 * j2 + 1] = x2 * cs[2] + x1 * cs[3]; } }
#pragma unroll
        for (int kk = 0; kk < DQK / 16; ++kk) { u32x4 w; w.x = cvtpk(qv[kk][0], qv[kk][1]); w.y = cvtpk(qv[kk][2], qv[kk][3]); w.z = cvtpk(qv[kk][4], qv[kk][5]); w.w = cvtpk(qv[kk][6], qv[kk][7]);
            qf[kk] = __builtin_bit_cast(bf16x8, w); }
    }
    if (BAND) { if (tid < 257) biasL[tid] = bias_g[tid] * 1.4426950408889634f; }
    constexpr int KCPL = G::KSTR / 16, KNP = (64 * KCPL + 63) / 64;
    constexpr int VCPL = VSTR / 16, VNP = 64 * VCPL / 64;
    constexpr int KPP = (KNP + 7) / 8, VPP = (VNP + 7) / 8;
    ATT_LAS unsigned* dmaL = (ATT_LAS unsigned*)(lds + NS * G::KBUF + NS * G::VBUF + 2048) + wid * 256 + lane;
#pragma unroll
    for (int pp = 0; pp < KPP; ++pp) { const int pc = wid + 8 * pp, c = pc * 64 + lane, row = (c / KCPL) & 63, ch = c % KCPL; dmaL[64 * pp] = (unsigned)(row * kpitch + (ch < G::CPR ? ch : 0) * 8) * 2u; }
#pragma unroll
    for (int pp = 0; pp < VPP; ++pp) { const int pc = wid + 8 * pp, c = pc * 64 + lane, row = (c / VCPL) & 63, ch = c % VCPL; dmaL[128 + 64 * pp] = (unsigned)(row * vpitch + (ch < 8 ? ch : 0) * 8) * 2u; }
    const unsigned ldsb = __builtin_amdgcn_readfirstlane((unsigned)(size_t)lds);
    const int kc = (KNP - 1 - wid) / 8 + 1, vc = (VNP - 1 - wid) / 8 + 1;
#define ATT_MOD3(x) (NS == 3 ? (x) - 3 * (((x) * 43) >> 7) : ((x) & 1))
#define ATT_DMA1(gptr, voff_, ldsaddr) do { unsigned keep_; asm volatile("s_mov_b32 %0, m0\n\ts_mov_b32 m0, %3\n\ts_nop 0\n\tglobal_load_lds_dwordx4 %1, %2\n\ts_mov_b32 m0, %0" \
            : "=&s"(keep_) : "v"(voff_), "s"(gptr), "s"(ldsaddr) : "memory"); } while (0)
#define ATT_DMA_K(t) do { const int t_ = (t); const char* kt_ = (const char*)(Kb + (size_t)t_ * 64 * kpitch); const unsigned d_ = ldsb + ATT_MOD3(t_) * G::KBUF + wid * 1024; \
        _Pragma("unroll") for (int pp = 0; pp < KPP; ++pp) { if (wid + 8 * pp < KNP) { const unsigned vo_ = dmaL[64 * pp]; ATT_DMA1(kt_, vo_, d_ + pp * 8192); } } } while (0)
#define ATT_DMA_V(t) do { const int t_ = (t); const char* vt_ = (const char*)(Vb + (size_t)t_ * 64 * vpitch); const unsigned d_ = ldsb + NS * G::KBUF + ATT_MOD3(t_) * G::VBUF + wid * 1024; \
        _Pragma("unroll") for (int pp = 0; pp < VPP; ++pp) { if (wid + 8 * pp < VNP) { const unsigned vo_ = dmaL[128 + 64 * pp]; ATT_DMA1(vt_, vo_, d_ + pp * 8192); } } } while (0)
#define ATT_WAITBAR(n) do { const int n_ = (n); \
        if (n_ == 0) asm volatile("s_waitcnt vmcnt(0) lgkmcnt(0)\n\ts_barrier" ::: "memory"); else if (n_ == 1) asm volatile("s_waitcnt vmcnt(1) lgkmcnt(0)\n\ts_barrier" ::: "memory"); \
        else if (n_ == 2) asm volatile("s_waitcnt vmcnt(2) lgkmcnt(0)\n\ts_barrier" ::: "memory"); else if (n_ == 3) asm volatile("s_waitcnt vmcnt(3) lgkmcnt(0)\n\ts_barrier" ::: "memory"); \
        else asm volatile("s_waitcnt vmcnt(4) lgkmcnt(0)\n\ts_barrier" ::: "memory"); } while (0)
    f32x16 o0, o1;
#pragma unroll
    for (int i = 0; i < 16; ++i) { o0[i] = 0.f; o1[i] = 0.f; }
    float mrun = -INFINITY, lsum = 0.f; float ls4[4] = {0.f, 0.f, 0.f, 0.f};
    const int koff = r32 * G::KSTR + hi * 16;
    const int voff = ((lane >> 5) * 4 + ((lane & 15) >> 2)) * VSTR + (((lane >> 4) & 1) * 16 + (lane & 3) * 4) * 2;
    const f32x16 zero16 = {0.f, 0.f, 0.f, 0.f, 0.f, 0.f, 0.f, 0.f, 0.f, 0.f, 0.f, 0.f, 0.f, 0.f, 0.f, 0.f};
#define ATT_QK(X0, X1, t) do { const ATT_LAS unsigned char* Kt = lds + ATT_MOD3(t) * G::KBUF + koff; \
        _Pragma("unroll") for (int kk = 0; kk < DQK / 16; ++kk) { \
            const bf16x8 a0 = *(const ATT_LAS bf16x8*)(Kt + kk * 32); const bf16x8 a1 = *(const ATT_LAS bf16x8*)(Kt + 32 * G::KSTR + kk * 32); \
            X0 = __builtin_amdgcn_mfma_f32_32x32x16_bf16(a0, qf[kk], kk ? X0 : zero16, 0, 0, 0); X1 = __builtin_amdgcn_mfma_f32_32x32x16_bf16(a1, qf[kk], kk ? X1 : zero16, 0, 0, 0); } } while (0)
#define ATT_FARSCALE() do { const float f_ = __builtin_amdgcn_exp2f(biasL[256]); _Pragma("unroll") for (int i = 0; i < 16; ++i) { o0[i] *= f_; o1[i] *= f_; } \
        ls4[0] *= f_; ls4[1] *= f_; ls4[2] *= f_; ls4[3] *= f_; } while (0)
#define ATT_SMPV(X0, X1, t) do { \
        float cadd = 0.f; \
        if (BAND) { const int delta = cc - (t); \
            if (delta >= 3) { if constexpr (!NOMAX) cadd = biasL[256]; } \
            else { const ATT_LAS float* bp = biasL + (64 * delta + (32 * (wid & 1) + r32) - 4 * hi + 128 - 63); \
                if (delta < 2) { _Pragma("unroll") for (int i = 0; i < 16; ++i) { const int kj = (i & 3) + 8 * (i >> 2); X0[i] += bp[63 - kj]; X1[i] += bp[31 - kj]; } } \
                else { const int relb = 64 * delta + (32 * (wid & 1) + r32) - 4 * hi + 128; \
                    _Pragma("unroll") for (int i = 0; i < 16; ++i) { const int kj = (i & 3) + 8 * (i >> 2); int i0 = relb - kj, i1 = relb - kj - 32; i0 = i0 > 256 ? 256 : i0; i1 = i1 > 256 ? 256 : i1; \
                        X0[i] += biasL[i0]; X1[i] += biasL[i1]; } } } } \
        if constexpr (NOMAX) { \
            _Pragma("unroll") for (int i = 0; i < 16; ++i) { X0[i] = __builtin_amdgcn_exp2f(X0[i]); X1[i] = __builtin_amdgcn_exp2f(X1[i]); ls4[i & 3] += X0[i] + X1[i]; } \
        } else { \
        const float mt = rowmax32(X0, X1) + cadd; \
        const float mnew = max2f(mrun, mt); \
        const float alpha = __builtin_amdgcn_exp2f(mrun - mnew); \
        const float msub = mnew - cadd; \
        mrun = mnew; \
        float psa[4] = {0.f, 0.f, 0.f, 0.f};   \
        _Pragma("unroll") for (int i = 0; i < 16; ++i) { X0[i] = __builtin_amdgcn_exp2f(X0[i] - msub); X1[i] = __builtin_amdgcn_exp2f(X1[i] - msub); psa[i & 3] += X0[i] + X1[i]; } \
        const float ps = (psa[0] + psa[1]) + (psa[2] + psa[3]); \
        lsum = lsum * alpha + ps; \
        _Pragma("unroll") for (int i = 0; i < 16; ++i) { o0[i] *= alpha; o1[i] *= alpha; } } \
        bf16x8 pf[2][2]; \
        _Pragma("unroll") for (int s = 0; s < 2; ++s) { u32x4 w0, w1; \
            w0.x = cvtpk(X0[8 * s + 0], X0[8 * s + 1]); w0.y = cvtpk(X0[8 * s + 2], X0[8 * s + 3]); w0.z = cvtpk(X0[8 * s + 4], X0[8 * s + 5]); w0.w = cvtpk(X0[8 * s + 6], X0[8 * s + 7]); \
            w1.x = cvtpk(X1[8 * s + 0], X1[8 * s + 1]); w1.y = cvtpk(X1[8 * s + 2], X1[8 * s + 3]); w1.z = cvtpk(X1[8 * s + 4], X1[8 * s + 5]); w1.w = cvtpk(X1[8 * s + 6], X1[8 * s + 7]); \
            pf[0][s] = __builtin_bit_cast(bf16x8, w0); pf[1][s] = __builtin_bit_cast(bf16x8, w1); } \
        const ATT_LAS unsigned char* Vt = lds + NS * G::KBUF + ATT_MOD3(t) * G::VBUF + voff; \
        _Pragma("unroll") for (int kb = 0; kb < 2; ++kb) _Pragma("unroll") for (int s = 0; s < 2; ++s) { \
            const ATT_LAS unsigned char* vp = Vt + (32 * kb + 16 * s) * VSTR; \
            const s16x4 l0 = vtr(vp), h0 = vtr(vp + 8 * VSTR), l1 = vtr(vp + 64), h1 = vtr(vp + 8 * VSTR + 64); \
            const bf16x8 a0 = (bf16x8){l0[0], l0[1], l0[2], l0[3], h0[0], h0[1], h0[2], h0[3]}; \
            const bf16x8 a1 = (bf16x8){l1[0], l1[1], l1[2], l1[3], h1[0], h1[1], h1[2], h1[3]}; \
            o0 = __builtin_amdgcn_mfma_f32_32x32x16_bf16(a0, pf[kb][s], o0, 0, 0, 0); o1 = __builtin_amdgcn_mfma_f32_32x32x16_bf16(a1, pf[kb][s], o1, 0, 0, 0); } \
        if constexpr (NOMAX && BAND) { if (cc - (t) == 3) ATT_FARSCALE(); } } while (0)
#define ATT_FUSED(C0, C1, N0, N1, t, tn) do { \
        bf16x8 kfa[DQK / 16], kfb[DQK / 16]; \
        { const ATT_LAS unsigned char* Kt = lds + ATT_MOD3(tn) * G::KBUF + koff; \
          _Pragma("unroll") for (int kk = 0; kk < DQK / 16; ++kk) { kfa[kk] = *(const ATT_LAS bf16x8*)(Kt + kk * 32); kfb[kk] = *(const ATT_LAS bf16x8*)(Kt + 32 * G::KSTR + kk * 32); } } \
        __builtin_amdgcn_sched_barrier(0); \
        float cadd = 0.f; \
        if (BAND) { const int delta = cc - (t); \
            if (delta >= 3) { if constexpr (!NOMAX) cadd = biasL[256]; } \
            else { const ATT_LAS float* bp = biasL + (64 * delta + (32 * (wid & 1) + r32) - 4 * hi + 128 - 63); \
                if (delta < 2) { _Pragma("unroll") for (int i = 0; i < 16; ++i) { const int kj = (i & 3) + 8 * (i >> 2); C0[i] += bp[63 - kj]; C1[i] += bp[31 - kj]; } } \
                else { const int relb = 64 * delta + (32 * (wid & 1) + r32) - 4 * hi + 128; \
                    _Pragma("unroll") for (int i = 0; i < 16; ++i) { const int kj = (i & 3) + 8 * (i >> 2); int i0 = relb - kj, i1 = relb - kj - 32; i0 = i0 > 256 ? 256 : i0; i1 = i1 > 256 ? 256 : i1; \
                        C0[i] += biasL[i0]; C1[i] += biasL[i1]; } } } } \
        float alpha = 1.f, msub = 0.f; \
        if constexpr (!NOMAX) { \
        const float mt = rowmax32(C0, C1) + cadd; \
        const float mnew = max2f(mrun, mt); \
        alpha = __builtin_amdgcn_exp2f(mrun - mnew); \
        msub = mnew - cadd; \
        if (__builtin_amdgcn_ballot_w64(mnew > mrun)) { _Pragma("unroll") for (int i = 0; i < 16; ++i) { o0[i] *= alpha; o1[i] *= alpha; } } \
        mrun = mnew; } \
        __builtin_amdgcn_sched_barrier(0); \
        _Pragma("unroll") for (int kk = 0; kk < DQK / 16; ++kk) { \
            N0 = __builtin_amdgcn_mfma_f32_32x32x16_bf16(kfa[kk], qf[kk], kk ? N0 : zero16, 0, 0, 0); N1 = __builtin_amdgcn_mfma_f32_32x32x16_bf16(kfb[kk], qf[kk], kk ? N1 : zero16, 0, 0, 0); } \
        s16x4 vl0[4], vh0[4], vl1[4], vh1[4]; \
        { const ATT_LAS unsigned char* Vt = lds + NS * G::KBUF + ATT_MOD3(t) * G::VBUF + voff; \
          _Pragma("unroll") for (int ks = 0; ks < 4; ++ks) { const ATT_LAS unsigned char* vp = Vt + 16 * ks * VSTR; vl0[ks] = vtr(vp); vh0[ks] = vtr(vp + 8 * VSTR); vl1[ks] = vtr(vp + 64); vh1[ks] = vtr(vp + 8 * VSTR + 64); } } \
        if constexpr (NOMAX) { \
            _Pragma("unroll") for (int i = 0; i < 16; ++i) { C0[i] = __builtin_amdgcn_exp2f(C0[i]); C1[i] = __builtin_amdgcn_exp2f(C1[i]); ls4[i & 3] += C0[i] + C1[i]; } \
        } else { \
        float psa[4] = {0.f, 0.f, 0.f, 0.f}; \
        _Pragma("unroll") for (int i = 0; i < 16; ++i) { C0[i] = __builtin_amdgcn_exp2f(C0[i] - msub); C1[i] = __builtin_amdgcn_exp2f(C1[i] - msub); psa[i & 3] += C0[i] + C1[i]; } \
        const float ps = (psa[0] + psa[1]) + (psa[2] + psa[3]); \
        lsum = lsum * alpha + ps; } \
        bf16x8 pf[4]; \
        _Pragma("unroll") for (int s = 0; s < 2; ++s) { u32x4 w0, w1; \
            w0.x = cvtpk(C0[8 * s + 0], C0[8 * s + 1]); w0.y = cvtpk(C0[8 * s + 2], C0[8 * s + 3]); w0.z = cvtpk(C0[8 * s + 4], C0[8 * s + 5]); w0.w = cvtpk(C0[8 * s + 6], C0[8 * s + 7]); \
            w1.x = cvtpk(C1[8 * s + 0], C1[8 * s + 1]); w1.y = cvtpk(C1[8 * s + 2], C1[8 * s + 3]); w1.z = cvtpk(C1[8 * s + 4], C1[8 * s + 5]); w1.w = cvtpk(C1[8 * s + 6], C1[8 * s + 7]); \
            pf[s] = __builtin_bit_cast(bf16x8, w0); pf[2 + s] = __builtin_bit_cast(bf16x8, w1); } \
        __builtin_amdgcn_sched_barrier(0); \
        _Pragma("unroll") for (int ks = 0; ks < 4; ++ks) { \
            const bf16x8 a0 = (bf16x8){vl0[ks][0], vl0[ks][1], vl0[ks][2], vl0[ks][3], vh0[ks][0], vh0[ks][1], vh0[ks][2], vh0[ks][3]}; \
            const bf16x8 a1 = (bf16x8){vl1[ks][0], vl1[ks][1], vl1[ks][2], vl1[ks][3], vh1[ks][0], vh1[ks][1], vh1[ks][2], vh1[ks][3]}; \
            o0 = __builtin_amdgcn_mfma_f32_32x32x16_bf16(a0, pf[ks], o0, 0, 0, 0); o1 = __builtin_amdgcn_mfma_f32_32x32x16_bf16(a1, pf[ks], o1, 0, 0, 0); } \
        if constexpr (NOMAX && BAND) { if (cc - (t) == 3) ATT_FARSCALE(); } } while (0)
#define ATT_STAGE(t) do { if ((t) + NS <= t_hi) ATT_DMA_K((t) + NS); if ((t) + NS - 1 <= t_hi) ATT_DMA_V((t) + NS - 1); } while (0)
#define ATT_NFL(t) (NS == 3 ? ((t) + 3 <= t_hi ? kc : 0) + ((t) + 2 <= t_hi ? vc : 0) : 0)
    f32x16 sa0, sa1, sb0, sb1;
    ATT_DMA_K(t_lo); ATT_DMA_V(t_lo);
    if (t_lo + 1 <= t_hi) { ATT_DMA_K(t_lo + 1); if (NS == 3) ATT_DMA_V(t_lo + 1); }
    if (NS == 3) { if (t_lo + 2 <= t_hi) ATT_DMA_K(t_lo + 2); }
    ATT_WAITBAR(0);
    if (my_lo == t_lo) ATT_QK(sa0, sa1, t_lo);
    ATT_WAITBAR(0);
    {
        int t = t_lo;
        for (; t < my_lo - 1; ++t) { ATT_STAGE(t); ATT_WAITBAR(ATT_NFL(t)); }
        if (my_lo > t_lo) { ATT_STAGE(t); ATT_QK(sa0, sa1, t + 1); ATT_WAITBAR(ATT_NFL(t)); ++t; }
        int nf = my_hi - my_lo;
        for (; nf >= 2; nf -= 2, t += 2) {
            ATT_STAGE(t); ATT_FUSED(sa0, sa1, sb0, sb1, t, t + 1); ATT_WAITBAR(ATT_NFL(t));
            ATT_STAGE(t + 1); ATT_FUSED(sb0, sb1, sa0, sa1, t + 1, t + 2); ATT_WAITBAR(ATT_NFL(t + 1));
        }
        if (nf == 1) {
            ATT_STAGE(t); ATT_FUSED(sa0, sa1, sb0, sb1, t, t + 1); ATT_WAITBAR(ATT_NFL(t)); ++t;
            ATT_STAGE(t); ATT_SMPV(sb0, sb1, t); ATT_WAITBAR(ATT_NFL(t)); ++t;
        } else {
            ATT_STAGE(t); ATT_SMPV(sa0, sa1, t); ATT_WAITBAR(ATT_NFL(t)); ++t;
        }
        for (; t <= t_hi; ++t) { ATT_STAGE(t); ATT_WAITBAR(ATT_NFL(t)); }
    }
    if constexpr (NOMAX) lsum = (ls4[0] + ls4[1]) + (ls4[2] + ls4[3]);
    const float ltot = xhalf_sum(lsum);
    const float inv = 1.f / ltot;
    if constexpr (OF8) {
        unsigned char* op = (unsigned char*)Ob + (size_t)(q0 + wid * 32 + r32) * opitch + 4 * hi; const float i64 = inv * 32.f;
#pragma unroll
        for (int g4 = 0; g4 < 4; ++g4) {
            int w0 = 0, w1 = 0;
            w0 = __builtin_amdgcn_cvt_pk_fp8_f32(o0[4 * g4 + 0] * i64, o0[4 * g4 + 1] * i64, w0, false); w0 = __builtin_amdgcn_cvt_pk_fp8_f32(o0[4 * g4 + 2] * i64, o0[4 * g4 + 3] * i64, w0, true);
            w1 = __builtin_amdgcn_cvt_pk_fp8_f32(o1[4 * g4 + 0] * i64, o1[4 * g4 + 1] * i64, w1, false); w1 = __builtin_amdgcn_cvt_pk_fp8_f32(o1[4 * g4 + 2] * i64, o1[4 * g4 + 3] * i64, w1, true);
            *(int*)(op + 8 * g4) = w0; *(int*)(op + 32 + 8 * g4) = w1;
        }
    } else {
    bf16* op = Ob + (size_t)(q0 + wid * 32 + r32) * opitch + 4 * hi;
#pragma unroll
    for (int g4 = 0; g4 < 4; ++g4) {
        u32x2 w0, w1;
        w0.x = cvtpk(o0[4 * g4 + 0] * inv, o0[4 * g4 + 1] * inv); w0.y = cvtpk(o0[4 * g4 + 2] * inv, o0[4 * g4 + 3] * inv);
        w1.x = cvtpk(o1[4 * g4 + 0] * inv, o1[4 * g4 + 1] * inv); w1.y = cvtpk(o1[4 * g4 + 2] * inv, o1[4 * g4 + 3] * inv);
        *(u32x2*)(op + 8 * g4) = w0; *(u32x2*)(op + 32 + 8 * g4) = w1;
    }
    }
#undef ATT_DMA_K
#undef ATT_DMA_V
#undef ATT_QK
#undef ATT_SMPV
#undef ATT_STAGE
#undef ATT_FUSED
#undef ATT_MOD3
#undef ATT_DMA1
#undef ATT_WAITBAR
#undef ATT_NFL
#undef ATT_FARSCALE
}
}
constexpr int NWAVES = 8;
constexpr int D = 1024, BATCH = 32, SEQ = 2048, M = BATCH * SEQ;
constexpr int NH = 16, QLORA = 384, KVLORA = 256, ROPE_D = 32, NOPE = 64, QKD = 96;
constexpr int NA = 768;
constexpr int FF = 2816, EFF = 3584, NE = 8;
constexpr float EPS = 1e-6f, LOG2E = 1.4426950408889634f;
constexpr int MAXP_HALF = 264, MAXP = 528;
constexpr size_t MiB = 1u << 20;
constexpr size_t WS_CTL = 0, CTL_ZERO_BYTES = 1 * MiB;
constexpr size_t WS_ROPE = 1 * MiB;
constexpr size_t WS_CNT = WS_ROPE + 256 * 1024;
constexpr size_t WS_PANELE = WS_CNT + 16 * 1024;
constexpr size_t WS_META = WS_PANELE + 4096;
constexpr size_t WS_TOKE = 2 * MiB;
constexpr size_t WS_TOKG = WS_TOKE + (size_t)M * 4;
constexpr size_t WS_SLOTTOK = WS_TOKG + (size_t)M * 8;
constexpr size_t WS_SLOTGATE = WS_SLOTTOK + (size_t)MAXP * 256 * 4;
constexpr size_t WS_PARTQA = 976 * MiB, WS_PART1 = 980 * MiB, WS_PART2 = 984 * MiB;
constexpr size_t WS_TOKRSTD = 4 * MiB;
constexpr size_t WS_SLOTRSTD = WS_TOKRSTD + (size_t)M * 4;
static_assert(WS_SLOTGATE + (size_t)MAXP * 256 * 4 <= WS_TOKRSTD && WS_SLOTRSTD + (size_t)MAXP * 256 * 4 <= 8 * MiB, "small arrays");
constexpr size_t WS_W = 8 * MiB;
constexpr size_t WS_WA = WS_W, WS_WUQ = WS_WA + (size_t)NA * D * 2, WS_WUKV = WS_WUQ + (size_t)1536 * QLORA * 2, WS_WO = WS_WUKV + (size_t)2048 * KVLORA * 2;
constexpr size_t WS_WF1 = WS_WO + (size_t)D * D * 2, WS_WF2 = WS_WF1 + (size_t)2 * FF * D * 2, WS_WKVQ = WS_WF2 + (size_t)D * FF * 2, WS_WBO = WS_WKVQ + (size_t)3 * D * D * 2;
constexpr size_t WS_WM1 = WS_WBO + (size_t)D * D * 2, WS_WM2 = WS_WM1 + (size_t)NE * 2 * EFF * D * 2, WS_WEND = WS_WM2 + (size_t)NE * D * EFF * 2;
constexpr size_t ARENA = 208 * MiB;
static_assert(WS_WEND <= ARENA, "weights fit under the arena");
constexpr size_t WS_XN = ARENA;
constexpr size_t WS_QA = ARENA + 128 * MiB;
constexpr size_t WS_Q = ARENA + 224 * MiB;
constexpr size_t WS_K = ARENA + 416 * MiB;
constexpr size_t WS_V = ARENA + 608 * MiB;
constexpr size_t WS_O = ARENA;
static_assert(WS_V + (size_t)M * D * 2 <= 1024 * MiB, "MLA arena");
constexpr size_t WS_XR1 = ARENA + 128 * MiB;
constexpr size_t WS_H = ARENA + 256 * MiB;
constexpr size_t WS_XR2 = ARENA;
constexpr size_t WS_X2B = ARENA + 608 * MiB;
constexpr size_t WS_KVQ2 = ARENA + 128 * MiB;
constexpr size_t WS_O2 = ARENA + 512 * MiB;
constexpr size_t WS_XR3 = ARENA + 132 * MiB;
constexpr size_t WS_XG = ARENA;
constexpr size_t WS_HM = ARENA + 264 * MiB;
constexpr size_t WS_END = WS_HM + (size_t)MAXP_HALF * 256 * EFF * 2;
static_assert(WS_XG + (size_t)MAXP * 256 * D <= WS_XR3 && WS_XR3 + (size_t)M * D * 2 <= WS_HM && WS_END <= 1024 * MiB && WS_H + (size_t)M * FF * 2 <= WS_X2B && WS_X2B + (size_t)M * D * 2 <= 976 * MiB && WS_O2 + (size_t)M * D <= WS_X2B, "arena");
constexpr int CW_BAR = 4096;
constexpr int RING_OFF = 0, RING_BYTES = 131072;
constexpr int P0_SCR = 128 * 33 * 4;
constexpr int LDSCTL_OFF = 8 * P0_SCR, MISC_OFF = LDSCTL_OFF + 320;
static_assert(LDSCTL_OFF >= RING_BYTES, "control words above every phase's scratch");
constexpr int LDS_BYTES = 147456;
static_assert(MISC_OFF + 128 <= LDS_BYTES, "LDS map");
static_assert(att::lds_bytes<96>() <= RING_BYTES, "attention scratch fits the ring region");

#define GAS __attribute__((address_space(1)))
#define LAS __attribute__((address_space(3)))
typedef unsigned short bf16;
typedef unsigned v4u __attribute__((ext_vector_type(4)));
typedef unsigned v2u __attribute__((ext_vector_type(2)));
typedef float f32x4 __attribute__((ext_vector_type(4)));
typedef GAS unsigned gu32;
#define RLX_AGENT __ATOMIC_RELAXED, __HIP_MEMORY_SCOPE_AGENT
#define LDS_WAIT() asm volatile("s_waitcnt lgkmcnt(0)" ::: "memory")
__device__ __forceinline__ unsigned f2bf(float f) { unsigned u = __builtin_bit_cast(unsigned, f); return (u + 0x7fffu + ((u >> 16) & 1u)) >> 16; }
__device__ __forceinline__ unsigned pk2(float lo, float hi) { return f2bf(lo) | (f2bf(hi) << 16); }
__device__ __forceinline__ float bflo(unsigned u) { return __builtin_bit_cast(float, u << 16); }
__device__ __forceinline__ float bfhi(unsigned u) { return __builtin_bit_cast(float, u & 0xffff0000u); }
__device__ __forceinline__ float wave_sum(float v) {
    v += swz_xor<1>(v); v += swz_xor<2>(v); v += swz_xor<4>(v); v += swz_xor<8>(v); v += swz_xor<16>(v);
    return xor32_sum(v);
}
__device__ __forceinline__ float wave_maxf(float v) {
    v = fmaxf(v, swz_xor<1>(v)); v = fmaxf(v, swz_xor<2>(v)); v = fmaxf(v, swz_xor<4>(v)); v = fmaxf(v, swz_xor<8>(v)); v = fmaxf(v, swz_xor<16>(v));
    return xor32_max(v);
}

#define XB_TMO      128
#define XB_XCNT(j)  (256  + 64 * (j))
#define XB_XSUB(j)  (1280 + 64 * (j))
#define XB_XGEN(j)  (2304 + 64 * (j))
#define XB_TOP      3328
#define XB_TOPGEN   3392
#define XCD_BAR_WORDS 3456
#define XB_SPIN_CAP (1u << 18)

__device__ __forceinline__ unsigned xb_ld(unsigned* p)              { return __hip_atomic_load(p, __ATOMIC_RELAXED, __HIP_MEMORY_SCOPE_AGENT); }
__device__ __forceinline__ unsigned xb_add(unsigned* p, unsigned v) { return __hip_atomic_fetch_add(p, v, __ATOMIC_RELAXED, __HIP_MEMORY_SCOPE_AGENT); }
__device__ __forceinline__ unsigned xb_xcc_id() { return (unsigned)__builtin_amdgcn_s_getreg((3 << 11) | 20) & 0xFu; }
#define XB_SPIN(cond, bar) do { unsigned _sp = 0; while (cond) { __builtin_amdgcn_s_sleep(1); \
    if ((++_sp & 255u) == 0u) { if (xb_ld(&(bar)[XB_TMO])) break; if (_sp > XB_SPIN_CAP) { atomicAdd(&(bar)[XB_TMO], 1u); break; } } } } while (0)

struct XcdBarrier {
    int t0;
    unsigned* bar; unsigned x;
    volatile LAS unsigned* st;
};

__device__ __forceinline__ XcdBarrier xcd_barrier_post(unsigned* bar, volatile LAS unsigned* st, int t0) {
    XcdBarrier b; b.t0 = t0; b.bar = bar; b.x = xb_xcc_id(); b.st = st;
    if (b.t0) (void)xb_add(&bar[XB_XCNT(b.x)], 1u);
    return b;
}
__device__ __forceinline__ void xcd_barrier_complete(unsigned* bar, unsigned x, unsigned& nloc, unsigned& nx) {
    const unsigned G = gridDim.x * gridDim.y * gridDim.z;
    unsigned sum, cnt, mine, sp = 0u;
    for (;;) {
        sum = 0u; cnt = 0u; mine = 0u;
#pragma unroll
        for (unsigned j = 0; j < 16; ++j) { const unsigned c = xb_ld(&bar[XB_XCNT(j)]); sum += c; cnt += (c > 0u) ? 1u : 0u; mine = (j == x) ? c : mine; }
        if (sum == G) break;
        __builtin_amdgcn_s_sleep(1);
        if ((++sp & 255u) == 0u) { if (xb_ld(&bar[XB_TMO])) break; if (sp > XB_SPIN_CAP) { atomicAdd(&bar[XB_TMO], 1u); break; } }
    }
    nloc = mine > 0u ? mine : 1u; nx = cnt > 0u ? cnt : 1u;
}

__device__ __forceinline__ void xcd_barrier(const XcdBarrier& b) {
    asm volatile("s_waitcnt vmcnt(0)" ::: "memory");
    __syncthreads();
    if (b.t0) {
        unsigned* bar = b.bar;
        __builtin_amdgcn_s_waitcnt(0);
        unsigned nloc = b.st[0], nx = b.st[1];
        if (nloc == 0u) { xcd_barrier_complete(bar, b.x, nloc, nx); b.st[0] = nloc; b.st[1] = nx; }
        const unsigned old = xb_add(&bar[XB_XSUB(b.x)], 1u);
        const unsigned gen = old / nloc;
        if (old + 1u == (gen + 1u) * nloc) {
            __builtin_amdgcn_fence(__ATOMIC_RELEASE, "agent");
            asm volatile("s_waitcnt vmcnt(0)" ::: "memory");
            const unsigned og = xb_add(&bar[XB_TOP], 1u);
            const unsigned tg = og / nx;
            if (og + 1u == (tg + 1u) * nx) xb_add(&bar[XB_TOPGEN], 1u);
            else XB_SPIN(xb_ld(&bar[XB_TOPGEN]) == tg, bar);
            __builtin_amdgcn_fence(__ATOMIC_ACQUIRE, "agent");
            xb_add(&bar[XB_XGEN(b.x)], 1u);
            asm volatile("s_waitcnt vmcnt(0)" ::: "memory");
        } else {
            XB_SPIN(xb_ld(&bar[XB_XGEN(b.x)]) == gen, bar);
            __builtin_amdgcn_fence(__ATOMIC_ACQUIRE, "agent");
            asm volatile("s_waitcnt vmcnt(0)" ::: "memory");
        }
    }
    __syncthreads();
}

struct Args { const float* in[27]; float* out; unsigned char* ws; };
enum { I_X = 0, I_ATTN_NORM, I_FFN_NORM, I_A_WDQ, I_A_GCQ, I_A_WUQ, I_A_WDKV, I_A_GCKV, I_A_WUKV, I_A_GQN, I_A_GKN, I_A_WO, I_KV_NORM, I_KV_WK, I_KV_WV, I_KV_GKN,
       I_B_WQ, I_B_GQN, I_B_RELB, I_B_WO, I_FFN_W1, I_FFN_W3, I_FFN_W2, I_MOE_ROUTER, I_MOE_W1, I_MOE_W3, I_MOE_W2 };

struct Frame {
    LAS unsigned char* lds;
    int wave, vcu, G;
};
typedef const __attribute__((address_space(4))) Args* KArgs;
__device__ __forceinline__ KArgs kargs() { KArgs p = (KArgs)__builtin_amdgcn_kernarg_segment_ptr(); asm volatile("" : "+s"(p)); return p; }
#define INP(i) (kargs()->in[i])
#define OUTP (kargs()->out)
#define WSP (kargs()->ws)
__device__ __forceinline__ int fresh(int v) { asm volatile("" : "+v"(v)); return v; }

__device__ __forceinline__ void tr_item(const float* W, int ldw, int K, int k0, int nsrc0, const float* gain, bf16* WT, int drow0, LAS float* scr, int lane) {
    const int c4 = lane & 7, r = lane >> 3;
    const GAS float* src = (const GAS float*)W + (size_t)(k0 + r) * ldw + nsrc0 + 4 * c4;
    f32x4 v[16];
#pragma unroll
    for (int i = 0; i < 16; ++i) v[i] = *(const GAS f32x4*)(src + (size_t)(8 * i) * ldw);
    if (gain) {
#pragma unroll
        for (int i = 0; i < 16; ++i) v[i] = v[i] * gain[k0 + 8 * i + r];
    }
#pragma unroll
    for (int i = 0; i < 16; ++i) { LAS float* d = scr + (8 * i + r) * 33 + 4 * c4; d[0] = v[i].x; d[1] = v[i].y; d[2] = v[i].z; d[3] = v[i].w; }
    LDS_WAIT(); asm volatile("" ::: "memory");
    const int c16 = lane >> 2;
#pragma unroll
    for (int j = 0; j < 8; ++j) { const int n = (lane & 3) + 4 * j; const LAS float* sp = scr + (8 * c16) * 33 + n;
        v4u o; o.x = pk2(sp[0 * 33], sp[1 * 33]); o.y = pk2(sp[2 * 33], sp[3 * 33]); o.z = pk2(sp[4 * 33], sp[5 * 33]); o.w = pk2(sp[6 * 33], sp[7 * 33]);
        *(GAS v4u*)(WT + (size_t)(drow0 + n) * K + k0 + 8 * c16) = o; }
    LDS_WAIT(); asm volatile("" ::: "memory");
}
__device__ __forceinline__ void tr_plain(const float* W, int K, int N, const float* gain, bf16* WT, int drow_off, LAS float* scr, int item, int lane) {
    const int nblk = N / 32, kb = item / nblk, nb = item % nblk;
    tr_item(W, N, K, 128 * kb, 32 * nb, gain, WT, drow_off + 32 * nb, scr, lane);
}
__device__ __forceinline__ void tr_gated(const float* W, int K, int N, const float* gain, bf16* WT, int half, LAS float* scr, int item, int lane) {
    const int nblk = N / 32, kb = item / nblk, nb = item % nblk, n0 = 32 * nb;
    tr_item(W, N, K, 128 * kb, n0, gain, WT, (n0 >> 7) * 256 + half * 128 + (n0 & 127), scr, lane);
}
__device__ __forceinline__ unsigned pk_fp8x4(float a, float b, float c, float d) { int w = 0; w = __builtin_amdgcn_cvt_pk_fp8_f32(a, b, w, false); w = __builtin_amdgcn_cvt_pk_fp8_f32(c, d, w, true); return (unsigned)w; }
__device__ __forceinline__ void tr_item_f8(const float* W, int ldw, int K, int k0, int nsrc0, const float* gain, unsigned char* WT, int drow0, LAS float* scr, int lane) {
    const int c4 = lane & 7, r = lane >> 3;
    const GAS float* src = (const GAS float*)W + (size_t)(k0 + r) * ldw + nsrc0 + 4 * c4;
    f32x4 v[16];
#pragma unroll
    for (int i = 0; i < 16; ++i) v[i] = *(const GAS f32x4*)(src + (size_t)(8 * i) * ldw);
#pragma unroll
    for (int i = 0; i < 16; ++i) v[i] = v[i] * (gain ? gain[k0 + 8 * i + r] * 64.f : 64.f);
#pragma unroll
    for (int i = 0; i < 16; ++i) { LAS float* d = scr + (8 * i + r) * 33 + 4 * c4; d[0] = v[i].x; d[1] = v[i].y; d[2] = v[i].z; d[3] = v[i].w; }
    LDS_WAIT(); asm volatile("" ::: "memory");
    const int c8 = lane >> 3;
#pragma unroll
    for (int j = 0; j < 4; ++j) { const int n = (lane & 7) + 8 * j; const LAS float* sp = scr + (16 * c8) * 33 + n;
        v4u o; o.x = pk_fp8x4(sp[0 * 33], sp[1 * 33], sp[2 * 33], sp[3 * 33]); o.y = pk_fp8x4(sp[4 * 33], sp[5 * 33], sp[6 * 33], sp[7 * 33]);
        o.z = pk_fp8x4(sp[8 * 33], sp[9 * 33], sp[10 * 33], sp[11 * 33]); o.w = pk_fp8x4(sp[12 * 33], sp[13 * 33], sp[14 * 33], sp[15 * 33]);
        *(GAS v4u*)(WT + (size_t)(drow0 + n) * K + k0 + 16 * c8) = o; }
    LDS_WAIT(); asm volatile("" ::: "memory");
}
__device__ __forceinline__ float rms_row_to_bf16(const float* xrow, bf16* orow, int lane, f32x4 (&v)[4]) {
    const GAS f32x4* xr = (const GAS f32x4*)xrow + lane;
    float s = 0.f;
#pragma unroll
    for (int j = 0; j < 4; ++j) { v[j] = xr[64 * j]; s += (v[j].x * v[j].x + v[j].y * v[j].y) + (v[j].z * v[j].z + v[j].w * v[j].w); }
    const float rstd = 1.f / sqrtf(wave_sum(s) * (1.f / D) + EPS);
    GAS unsigned long long* o8 = (GAS unsigned long long*)orow + lane;
#pragma unroll
    for (int j = 0; j < 4; ++j) o8[64 * j] = (unsigned long long)pk2(v[j].x * rstd, v[j].y * rstd) | ((unsigned long long)pk2(v[j].z * rstd, v[j].w * rstd) << 32);
    return rstd;
}
__device__ __forceinline__ void norm_phase(const Frame& F, const float* x, bf16* xn) {
    const int tid = fresh(F.wave * 64 + lane_id_()), lane = tid & 63; (void)lane;
    const int gw = F.vcu * NWAVES + F.wave, NGW = F.G * NWAVES;
    for (int m = 2 * gw; m < M; m += 2 * NGW) {
        const GAS f32x4* xr = (const GAS f32x4*)(x + (size_t)m * D) + lane;
        f32x4 v[8]; float s0 = 0.f, s1 = 0.f;
#pragma unroll
        for (int j = 0; j < 8; ++j) v[j] = xr[64 * j];
#pragma unroll
        for (int j = 0; j < 4; ++j) { s0 += (v[j].x * v[j].x + v[j].y * v[j].y) + (v[j].z * v[j].z + v[j].w * v[j].w); s1 += (v[4 + j].x * v[4 + j].x + v[4 + j].y * v[4 + j].y) + (v[4 + j].z * v[4 + j].z + v[4 + j].w * v[4 + j].w); }
        const float r0 = 1.f / sqrtf(wave_sum(s0) * (1.f / D) + EPS), r1 = 1.f / sqrtf(wave_sum(s1) * (1.f / D) + EPS);
        GAS unsigned* o4 = (GAS unsigned*)((GAS unsigned char*)xn + (size_t)m * D) + lane;
#pragma unroll
        for (int j = 0; j < 8; ++j) { const float rr = j < 4 ? r0 : r1; o4[64 * j] = pk_fp8x4(v[j].x * rr, v[j].y * rr, v[j].z * rr, v[j].w * rr); }
    }
}

__device__ __forceinline__ void p0_prologue(const Frame& F) {
    const int tid = fresh(F.wave * 64 + lane_id_()), lane = tid & 63; (void)lane;
    LAS float* scr = (LAS float*)(F.lds + RING_OFF + F.wave * P0_SCR);
    unsigned char* ws = WSP;
    const int gw = F.vcu * NWAVES + F.wave, NGW = F.G * NWAVES;
    constexpr int I_DQ = 8 * 12, I_DKV = 8 * 9, I_UQ = 3 * 48, I_UKV = 2 * 64, I_SQ = 8 * 32, I_F13 = 8 * 88, I_F2 = 22 * 32, I_M13 = 8 * 112, I_M2 = 28 * 32;
    constexpr int NSMALL = I_DQ + I_DKV + I_UQ + I_UKV + I_SQ + 2 * I_F13 + I_F2 + 4 * I_SQ;
    constexpr int NITEMS = NSMALL + NE * (2 * I_M13 + I_M2);
    for (int it = gw; it < NITEMS; it += NGW) {
        int r = it;
        if (r < I_DQ)  { const int kb = r / 12, n0 = 32 * (r % 12); tr_item_f8(INP(I_A_WDQ), QLORA, D, 128 * kb, n0, INP(I_ATTN_NORM), ws + WS_WA, n0, scr, lane); continue; } r -= I_DQ;
        if (r < I_DKV) { const int kb = r / 9, n0 = 32 * (r % 9); tr_item_f8(INP(I_A_WDKV), KVLORA + ROPE_D, D, 128 * kb, n0, INP(I_ATTN_NORM), ws + WS_WA, QLORA + n0, scr, lane); continue; } r -= I_DKV;
        if (r < I_UQ)  { tr_plain(INP(I_A_WUQ), QLORA, NH * QKD, INP(I_A_GCQ), (bf16*)(ws + WS_WUQ), 0, scr, r, lane); continue; } r -= I_UQ;
        if (r < I_UKV) { const int kb = r / 64, n0 = 32 * (r % 64), head = n0 >> 7, within = n0 & 127;
            const int drow = within < 64 ? 256 * (head >> 2) + 128 * (within >> 5) + 32 * (head & 3) : 1024 + head * 64 + (within - 64);
            tr_item(INP(I_A_WUKV), NH * 128, KVLORA, 128 * kb, n0, INP(I_A_GCKV), (bf16*)(ws + WS_WUKV), drow, scr, lane); continue; } r -= I_UKV;
        if (r < I_SQ)  { const int kb = r / 32, n0 = 32 * (r % 32); tr_item_f8(INP(I_A_WO), D, D, 128 * kb, n0, nullptr, ws + WS_WO, n0, scr, lane); continue; } r -= I_SQ;
        if (r < I_F13) { tr_gated(INP(I_FFN_W1), D, FF, INP(I_FFN_NORM), (bf16*)(ws + WS_WF1), 0, scr, r, lane); continue; } r -= I_F13;
        if (r < I_F13) { tr_gated(INP(I_FFN_W3), D, FF, INP(I_FFN_NORM), (bf16*)(ws + WS_WF1), 1, scr, r, lane); continue; } r -= I_F13;
        if (r < I_F2)  { tr_plain(INP(I_FFN_W2), FF, D, nullptr, (bf16*)(ws + WS_WF2), 0, scr, r, lane); continue; } r -= I_F2;
        if (r < I_SQ)  { const int kb = r / 32, n0 = 32 * (r % 32), head = n0 >> 6;
            tr_item_f8(INP(I_KV_WK), D, D, 128 * kb, n0, INP(I_KV_NORM), ws + WS_WKVQ, 256 * (head >> 2) + 128 * ((n0 >> 5) & 1) + 32 * (head & 3), scr, lane); continue; } r -= I_SQ;
        if (r < I_SQ)  { const int kb = r / 32, n0 = 32 * (r % 32); tr_item_f8(INP(I_KV_WV), D, D, 128 * kb, n0, INP(I_KV_NORM), ws + WS_WKVQ, 2 * D + n0, scr, lane); continue; } r -= I_SQ;
        if (r < I_SQ)  { const int kb = r / 32, n0 = 32 * (r % 32), head = n0 >> 6;
            tr_item_f8(INP(I_B_WQ), D, D, 128 * kb, n0, INP(I_ATTN_NORM) + D, ws + WS_WKVQ, D + 256 * (head >> 2) + 128 * ((n0 >> 5) & 1) + 32 * (head & 3), scr, lane); continue; } r -= I_SQ;
        if (r < I_SQ)  { const int kb = r / 32, n0 = 32 * (r % 32); tr_item_f8(INP(I_B_WO), D, D, 128 * kb, n0, nullptr, ws + WS_WBO, n0, scr, lane); continue; } r -= I_SQ;
        const int e = r / (2 * I_M13 + I_M2); r -= e * (2 * I_M13 + I_M2);
        if (r < I_M13) { const int kb = r / 112, n0 = 32 * (r % 112);
            tr_item_f8(INP(I_MOE_W1) + (size_t)e * D * EFF, EFF, D, 128 * kb, n0, INP(I_FFN_NORM) + D, ws + WS_WM1 + (size_t)e * 2 * EFF * D, (n0 >> 7) * 256 + (n0 & 127), scr, lane); continue; } r -= I_M13;
        if (r < I_M13) { const int kb = r / 112, n0 = 32 * (r % 112);
            tr_item_f8(INP(I_MOE_W3) + (size_t)e * D * EFF, EFF, D, 128 * kb, n0, INP(I_FFN_NORM) + D, ws + WS_WM1 + (size_t)e * 2 * EFF * D, (n0 >> 7) * 256 + 128 + (n0 & 127), scr, lane); continue; } r -= I_M13;
        { const int kb = r / 32, n0 = 32 * (r % 32); tr_item_f8(INP(I_MOE_W2) + (size_t)e * EFF * D, D, EFF, 128 * kb, n0, nullptr, ws + WS_WM2 + (size_t)e * D * EFF, n0, scr, lane); }
    }
    const int gt = F.vcu * (NWAVES * 64) + tid, NGT = F.G * NWAVES * 64;
    for (int c = gt; c < 96 * D / 16; c += NGT) *((GAS v4u*)(ws + WS_WA + (size_t)(QLORA + KVLORA + ROPE_D) * D) + c) = (v4u){0u, 0u, 0u, 0u};
    for (int c = gt; c < SEQ * 16; c += NGT) { const int pos = c >> 4, i = c & 15;
        const float inv = __builtin_amdgcn_exp2f(-(float)i * (13.287712379549449f / 16.f));
        const float rev = (float)pos * inv * 0.15915494309189535f; const float fr = rev - floorf(rev);
        ((GAS float*)(ws + WS_ROPE))[2 * c] = __builtin_amdgcn_cosf(fr); ((GAS float*)(ws + WS_ROPE))[2 * c + 1] = __builtin_amdgcn_sinf(fr); }
    norm_phase(F, INP(I_X), (bf16*)(ws + WS_XN));
}

__device__ __forceinline__ void route_phase(const Frame& F) {
    const int tid = fresh(F.wave * 64 + lane_id_()), lane = tid & 63;
    unsigned char* ws = WSP;
    LAS float* wrg = (LAS float*)(F.lds + RING_OFF);
    LAS int* cnt = (LAS int*)(F.lds + RING_OFF + 32768);
    const float* wr = INP(I_MOE_ROUTER); const float* g = INP(I_FFN_NORM) + D;
    for (int idx = tid; idx < D * NE; idx += NWAVES * 64) { const int k = idx >> 3, e = idx & 7, l = k >> 4, i = k & 15;
        wrg[((i * 2) + (e >> 2)) * 256 + 4 * l + (e & 3)] = wr[idx] * g[k]; }
    __syncthreads();
    const int b5 = (lane >> 5) & 1, b4 = (lane >> 4) & 1, b3 = (lane >> 3) & 1;
    for (int c = F.vcu; c < M / 256; c += F.G) {
        if (tid < 16) cnt[tid] = 0;
        __syncthreads();
        v4u vn[2];
        { const GAS v4u* xr = (const GAS v4u*)(ws + WS_XR3 + (size_t)(c * 256 + F.wave * 32) * D * 2) + 2 * lane; vn[0] = xr[0]; vn[1] = xr[1]; }
        for (int i = 0; i < 32; ++i) {
            const int m = c * 256 + F.wave * 32 + i;
            const v4u q0 = vn[0], q1 = vn[1];
            if (i + 1 < 32) { const GAS v4u* xr = (const GAS v4u*)(ws + WS_XR3 + (size_t)(m + 1) * D * 2) + 2 * lane; vn[0] = xr[0]; vn[1] = xr[1]; }
            const unsigned qw[8] = {q0.x, q0.y, q0.z, q0.w, q1.x, q1.y, q1.z, q1.w};
            float xv[16]; float ssx = 0.f;
#pragma unroll
            for (int j = 0; j < 8; ++j) { xv[2 * j] = bflo(qw[j]); xv[2 * j + 1] = bfhi(qw[j]); }
#pragma unroll
            for (int j = 0; j < 16; j += 4) ssx += (xv[j] * xv[j] + xv[j + 1] * xv[j + 1]) + (xv[j + 2] * xv[j + 2] + xv[j + 3] * xv[j + 3]);
            float lg[8];
#pragma unroll
            for (int e = 0; e < 8; ++e) lg[e] = 0.f;
#pragma unroll
            for (int j = 0; j < 16; ++j) { const float x1 = xv[j];
                const f32x4 w0 = *(const LAS f32x4*)(wrg + (j * 2) * 256 + 4 * lane), w1 = *(const LAS f32x4*)(wrg + (j * 2 + 1) * 256 + 4 * lane);
                lg[0] += x1 * w0.x; lg[1] += x1 * w0.y; lg[2] += x1 * w0.z; lg[3] += x1 * w0.w; lg[4] += x1 * w1.x; lg[5] += x1 * w1.y; lg[6] += x1 * w1.z; lg[7] += x1 * w1.w; }
            float r4[4], r2[2], r1;
#pragma unroll
            for (int e = 0; e < 4; ++e) { const float mine = b5 ? lg[4 + e] : lg[e], other = b5 ? lg[e] : lg[4 + e]; r4[e] = mine + xor32_partner(other, b5); }
#pragma unroll
            for (int e = 0; e < 2; ++e) { const float mine = b4 ? r4[2 + e] : r4[e], other = b4 ? r4[e] : r4[2 + e]; r2[e] = mine + swz_xor<16>(other); }
            { const float mine = b3 ? r2[1] : r2[0], other = b3 ? r2[0] : r2[1]; r1 = mine + swz_xor<8>(other); }
            r1 += swz_xor<4>(r1); r1 += swz_xor<2>(r1); r1 += swz_xor<1>(r1);
            const float rstd = 1.f / sqrtf(wave_sum(ssx) * (1.f / D) + EPS);
#pragma unroll
            for (int e = 0; e < 8; ++e) lg[e] = __builtin_bit_cast(float, __builtin_amdgcn_readlane(__builtin_bit_cast(int, r1), 8 * e)) * rstd;
            int e1 = 0; float l1 = lg[0];
#pragma unroll
            for (int e = 1; e < 8; ++e) if (lg[e] > l1) { l1 = lg[e]; e1 = e; }
            int e2 = -1; float l2 = -INFINITY;
#pragma unroll
            for (int e = 0; e < 8; ++e) if (e != e1 && lg[e] > l2) { l2 = lg[e]; e2 = e; }
            const float g1 = 1.f / (1.f + __expf(l2 - l1)), g2 = 1.f - g1;
            const int elo = e1 < e2 ? e1 : e2, ehi = e1 < e2 ? e2 : e1;
            const float glo = e1 < e2 ? g1 : g2, ghi = e1 < e2 ? g2 : g1;
            if (lane == 0) { ((GAS float*)(ws + WS_TOKRSTD))[m] = rstd; ((GAS int*)(ws + WS_TOKE))[m] = elo | (ehi << 8); ((GAS float*)(ws + WS_TOKG))[2 * m] = glo; ((GAS float*)(ws + WS_TOKG))[2 * m + 1] = ghi;
                atomicAdd((int*)&cnt[elo], 1); atomicAdd((int*)&cnt[8 + ehi], 1); }
        }
        __syncthreads();
        if (tid < 16) ((GAS int*)(ws + WS_CNT))[c * 16 + tid] = cnt[tid];
        __syncthreads();
    }
}

__device__ __forceinline__ void slot_phase(const Frame& F, unsigned char* ws) {
    const int tid = fresh(F.wave * 64 + lane_id_()), lane = tid & 63; (void)lane;
    LAS int* call = (LAS int*)(F.lds + RING_OFF);
    LAS int* tot = call + 4096; LAS int* base = tot + 16; LAS int* pre = base + 16; LAS int* meta = pre + 16;
    LAS int* grp = meta + 16;
    LAS int* slot_of = grp + 512;
    for (int idx = tid; idx < 4096; idx += NWAVES * 64) call[idx] = ((const GAS int*)(ws + WS_CNT))[idx];
    __syncthreads();
    if (tid < 16) { int t = 0; for (int cc = 0; cc < 256; ++cc) t += call[cc * 16 + tid]; tot[tid] = t; }
    __syncthreads();
    if (tid == 0) { int off = 0; for (int g = 0; g < 16; ++g) { base[g] = off; off += (tot[g] + 255) & ~255; if (g == 7) meta[0] = off >> 8; } meta[1] = (off >> 8) - meta[0]; }
    __syncthreads();
    for (int c = F.vcu; c < M / 256; c += F.G) {
        if (tid < 16) { int p = 0; for (int cc = 0; cc < c; ++cc) p += call[cc * 16 + tid]; pre[tid] = p; }
        const int hf = tid >> 8, i = tid & 255, m = c * 256 + i;
        const int te = ((const GAS int*)(ws + WS_TOKE))[m];
        const int g = hf * 8 + (hf ? ((te >> 8) & 0xff) : (te & 0xff));
        grp[tid] = g;
        __syncthreads();
        int rank = 0;
        for (int j = 0; j < i; ++j) rank += (grp[hf * 256 + j] == g) ? 1 : 0;
        const int slot = base[g] + pre[g] + rank;
        ((GAS int*)(ws + WS_SLOTTOK))[slot] = m; ((GAS float*)(ws + WS_SLOTGATE))[slot] = ((const GAS float*)(ws + WS_TOKG))[2 * m + hf];
        slot_of[tid] = slot;
        __syncthreads();
        for (int i0 = F.wave; i0 < 256; i0 += 4 * NWAVES) {
            v4u x[4][2]; float rs[4];
#pragma unroll
            for (int k = 0; k < 4; ++k) { const int mm = c * 256 + i0 + 8 * k; const GAS v4u* src = (const GAS v4u*)(ws + WS_XR3 + (size_t)mm * D * 2);
                x[k][0] = src[2 * lane]; x[k][1] = src[2 * lane + 1]; rs[k] = ((const GAS float*)(ws + WS_TOKRSTD))[mm]; }
#pragma unroll
            for (int k = 0; k < 4; ++k) { const int i = i0 + 8 * k; const v4u x0 = x[k][0], x1 = x[k][1]; const float r = rs[k];
                const v4u o = (v4u){pk_fp8x4(bflo(x0.x) * r, bfhi(x0.x) * r, bflo(x0.y) * r, bfhi(x0.y) * r), pk_fp8x4(bflo(x0.z) * r, bfhi(x0.z) * r, bflo(x0.w) * r, bfhi(x0.w) * r),
                                    pk_fp8x4(bflo(x1.x) * r, bfhi(x1.x) * r, bflo(x1.y) * r, bfhi(x1.y) * r), pk_fp8x4(bflo(x1.z) * r, bfhi(x1.z) * r, bflo(x1.w) * r, bfhi(x1.w) * r)};
                ((GAS v4u*)(ws + WS_XG + (size_t)slot_of[i] * D))[lane] = o; ((GAS v4u*)(ws + WS_XG + (size_t)slot_of[256 + i] * D))[lane] = o; }
        }
        __syncthreads();
    }
    for (int g = F.vcu; g < 16; g += F.G) {
        const int s0 = base[g] + tot[g], s1 = base[g] + ((tot[g] + 255) & ~255);
        for (int s = s0 + F.wave; s < s1; s += NWAVES) { GAS v4u* dst = (GAS v4u*)(ws + WS_XG + (size_t)s * D);
            dst[lane] = (v4u){0u, 0u, 0u, 0u};
            if (lane == 0) { ((GAS int*)(ws + WS_SLOTTOK))[s] = -1; ((GAS float*)(ws + WS_SLOTGATE))[s] = 0.f; } }
    }
    if (F.vcu == 0) {
        if (tid < 16) { const int p0 = base[tid] >> 8, p1 = (base[tid] + ((tot[tid] + 255) & ~255)) >> 8; for (int p = p0; p < p1; ++p) ((GAS int*)(ws + WS_PANELE))[p] = tid & 7; }
        if (tid == 0) { ((GAS int*)(ws + WS_META))[0] = meta[0]; ((GAS int*)(ws + WS_META))[1] = meta[1]; }
        if (tid < 16) ((GAS int*)(ws + WS_META))[2 + tid] = base[tid] >> 8;
        if (tid == 0) { const int nPA = meta[0], nPB = meta[1]; int x = nPB > 256 ? nPB - 256 : 0;
            if (x > 0 && nPA > 256) { int LA = 0, HB = 7;
                for (int g = 0; g < 8; ++g) { const int q0 = base[g] >> 8, q1 = q0 + ((tot[g] + 255) >> 8); if (q0 <= 256 && 256 < q1) LA = g; }
                for (int g = 8; g < 16; ++g) { const int q0 = base[g] >> 8, q1 = q0 + ((tot[g] + 255) >> 8), P = nPA + x - 1; if (q0 <= P && P < q1) HB = g - 8; }
                if (LA < HB) x = 0; }
            ((GAS int*)(ws + WS_META))[18] = x; }
    }
    __syncthreads();
}

__global__ void __launch_bounds__(NWAVES * 64, 2) yoco_fwd(Args args) {
    extern __shared__ __attribute__((aligned(16))) unsigned char lds_raw[];
    Frame F;
    F.lds = (LAS unsigned char*)lds_raw;
    F.wave = __builtin_amdgcn_readfirstlane((int)threadIdx.x >> 6);
    F.G = gridDim.x; { const int bx = blockIdx.x; F.vcu = (F.G % 8 == 0) ? (bx % 8) * (F.G / 8) + bx / 8 : bx; }
    unsigned char* ws = WSP;
    volatile LAS unsigned* MISC = (volatile LAS unsigned*)(F.lds + MISC_OFF);
    for (int u = fresh((int)threadIdx.x); u < (LDS_BYTES - LDSCTL_OFF) / 4; u += NWAVES * 64) ((LAS unsigned*)(F.lds + LDSCTL_OFF))[u] = 0u;
    __syncthreads();
    (void)xcd_barrier_post((unsigned*)(ws + WS_CTL) + CW_BAR, MISC + 8, (F.wave == 0 && lane_id_() == 0) ? 1 : 0);
    LAS unsigned char* ring = F.lds + RING_OFF;
#define bid ((int)blockIdx.x)
#define GRID_BAR() do { XcdBarrier b_; b_.t0 = (F.wave == 0 && lane_id_() == 0) ? 1 : 0; b_.bar = (unsigned*)(WSP + WS_CTL) + CW_BAR; b_.x = xb_xcc_id(); b_.st = (volatile LAS unsigned*)(F.lds + MISC_OFF) + 8; xcd_barrier(b_); } while (0)
#define GEMM(EpiT, SchedT) pg8::gemm_phase<EpiT, SchedT, true, true>

    p0_prologue(F);
    GRID_BAR();
    { pg8::Gemm g{(const bf16*)(ws + WS_XN), (const bf16*)(ws + WS_WA), M, NA, D / 2, D / 2}; pg8::StaticOrder S; S.init(M, NA, F.G, bid);
      pg8::EpiQA E{(bf16*)(ws + WS_QA), (float*)(ws + WS_PARTQA), 1.f / 64};
      pg8::gemm_phase<pg8::EpiQA, pg8::StaticOrder, true, true, true>(ring, g, S, E, F.wave); }
    GRID_BAR();
    { pg8::Gemm g{(const bf16*)(ws + WS_QA), (const bf16*)(ws + WS_WUQ), M, NH * QKD, QLORA, NA}; pg8::StaticOrder S; S.init(M, NH * QKD, F.G, bid);
      pg8::EpiRowScaleBf16 E{(bf16*)(ws + WS_Q), NH * QKD, (const float*)(ws + WS_PARTQA), 1.f / QLORA};
      GEMM(pg8::EpiRowScaleBf16, pg8::StaticOrder)(ring, g, S, E, F.wave); }
    { pg8::Gemm g{(const bf16*)(ws + WS_QA) + QLORA, (const bf16*)(ws + WS_WUKV), M, NH * 128, KVLORA, NA}; pg8::StaticOrder S; S.init(M, NH * 128, F.G, bid);
      pg8::EpiKVup E{(bf16*)(ws + WS_K), (bf16*)(ws + WS_V), (const float*)(ws + WS_PARTQA), (const bf16*)(ws + WS_QA), INP(I_A_GKN), (const float*)(ws + WS_ROPE)};
      GEMM(pg8::EpiKVup, pg8::StaticOrder)(ring, g, S, E, F.wave); }
    GRID_BAR();
    bool fastA;
    { float bq = 0.f, bk = 0.f; const int l_ = lane_id_(); for (int i = l_; i < QKD; i += 64) { bq = fmaxf(bq, fabsf(INP(I_A_GQN)[i])); bk = fmaxf(bk, fabsf(INP(I_A_GKN)[i])); }
      bq = wave_maxf(bq); bk = wave_maxf(bk); fastA = __builtin_amdgcn_readfirstlane((int)(14.42f * bq * bk <= 40.f)) != 0; }
#define P5_UNIT(NM) att::attn_unit<96, false, 1536, 1536, D, D, true, NM, 2>(ring, (const bf16*)(ws + WS_Q) + (size_t)b * SEQ * 1536 + h * QKD, (const bf16*)(ws + WS_K) + (size_t)b * SEQ * 1536 + h * QKD, \
                                      (const bf16*)(ws + WS_V) + (size_t)b * SEQ * D + h * 64, (bf16*)(ws + WS_O + (size_t)b * SEQ * D + h * 64), \
                                      256 * qb, 0, 4 * qb + 3, 0, 4 * qb + (F.wave >> 1), 0, nullptr, INP(I_A_GQN), (const float*)(ws + WS_ROPE), F.wave)
    for (int p = F.vcu; p < BATCH * NH * 4; p += F.G) {
        const int bh = p >> 2, pid = p & 3, b = bh >> 4, h = bh & 15;
        for (int u2 = 0; u2 < 2; ++u2) {
            const int qb = u2 ? 7 - pid : pid;
            if (fastA) P5_UNIT(true); else P5_UNIT(false);
        }
    }
    GRID_BAR();
    { pg8::Gemm g{(const bf16*)(ws + WS_O), (const bf16*)(ws + WS_WO), M, D, D / 2, D / 2}; pg8::StaticOrder S; S.init(M, D, F.G, bid);
      pg8::EpiResStream<true, false, false> E{INP(I_X), (bf16*)(ws + WS_XR1), nullptr, (float*)(ws + WS_PART1), 1.f / 2048};
      pg8::gemm_phase<pg8::EpiResStream<true, false, false>, pg8::StaticOrder, true, true, true>(ring, g, S, E, F.wave); }
    GRID_BAR();
    { pg8::Gemm g{(const bf16*)(ws + WS_XR1), (const bf16*)(ws + WS_WF1), M, 2 * FF, D, D}; pg8::StaticOrder S; S.init(M, 2 * FF, F.G, bid);
      pg8::EpiGated<true> E{(bf16*)(ws + WS_H), FF, 0, (const float*)(ws + WS_PART1)};
      GEMM(pg8::EpiGated<true>, pg8::StaticOrder)(ring, g, S, E, F.wave); }
    GRID_BAR();
    { pg8::Gemm g{(const bf16*)(ws + WS_H), (const bf16*)(ws + WS_WF2), M, D, FF, FF}; pg8::StaticOrder S; S.init(M, D, F.G, bid);
      pg8::EpiResStream<true, true, true> E{ws + WS_XR1, (bf16*)(ws + WS_X2B), ws + WS_XR2, (float*)(ws + WS_PART2), 1.f};
      pg8::gemm_phase<pg8::EpiResStream<true, true, true>, pg8::StaticOrder, true, true>(ring, g, S, E, F.wave); }
    GRID_BAR();
    { pg8::Gemm g{(const bf16*)(ws + WS_XR2), (const bf16*)(ws + WS_WKVQ), M, 2 * D, D / 2, D / 2}; pg8::StaticOrder S; S.init(M, 2 * D, F.G, bid);
      pg8::EpiK2Q2 E{(bf16*)(ws + WS_KVQ2), (const float*)(ws + WS_PART2), INP(I_KV_GKN), INP(I_B_GQN), 1.f / 64};
      pg8::gemm_phase<pg8::EpiK2Q2, pg8::StaticOrder, true, true, true>(ring, g, S, E, F.wave); }
    { pg8::Gemm g{(const bf16*)(ws + WS_XR2), (const bf16*)(ws + WS_WKVQ + (size_t)2 * D * D), M, D, D / 2, D / 2}; pg8::StaticOrder S; S.init(M, D, F.G, bid);
      pg8::EpiRowScale16 E{(bf16*)(ws + WS_KVQ2), 3 * D, D, (const float*)(ws + WS_PART2), 1.f / 64};
      pg8::gemm_phase<pg8::EpiRowScale16, pg8::StaticOrder, true, true, true>(ring, g, S, E, F.wave); }
    GRID_BAR();
    bool fastB;
    { float bq = 0.f, bk = 0.f, bb = 0.f; const int l_ = lane_id_(); bq = fabsf(INP(I_B_GQN)[l_]); bk = fabsf(INP(I_KV_GKN)[l_]);
      for (int i = l_; i < NH * 257; i += 64) bb = fmaxf(bb, fabsf(INP(I_B_RELB)[i]));
      bq = wave_maxf(bq); bk = wave_maxf(bk); bb = wave_maxf(bb); fastB = __builtin_amdgcn_readfirstlane((int)(11.78f * bq * bk + 1.4427f * bb <= 40.f)) != 0; }
    for (int p = F.vcu; p < BATCH * NH * 8; p += F.G) {
        const int bh = p >> 3, cb = ((p & 7) + (p >> 8)) & 7, b = bh >> 4, h = bh & 15;
        const int c0 = 4 * cb, cc = c0 + (F.wave >> 1);
        const bf16* base = (const bf16*)(ws + WS_KVQ2) + (size_t)b * SEQ * 3072 + h * 64;
#define P13_UNIT(NM) att::attn_unit<64, true, 3072, 3072, 3072, D, true, NM, 2>(ring, base + 2048, base, base + 1024, (bf16*)(ws + WS_O2 + (size_t)b * SEQ * D + h * 64), \
                                 256 * cb, c0 - 8 < 0 ? 0 : c0 - 8, c0 + 3, cc - 8 < 0 ? 0 : cc - 8, cc, cc, INP(I_B_RELB) + h * 257, nullptr, nullptr, F.wave)
        if (fastB) P13_UNIT(true); else P13_UNIT(false);
    }
    GRID_BAR();
    { pg8::Gemm g{(const bf16*)(ws + WS_O2), (const bf16*)(ws + WS_WBO), M, D, D / 2, D / 2}; pg8::StaticOrder S; S.init(M, D, F.G, bid);
      pg8::EpiResStream<false, false, true> E{ws + WS_X2B, (bf16*)(ws + WS_XR3), nullptr, nullptr, 1.f / 2048};
      pg8::gemm_phase<pg8::EpiResStream<false, false, true>, pg8::StaticOrder, true, true, true>(ring, g, S, E, F.wave); }
    GRID_BAR();
    route_phase(F);
    GRID_BAR();
    slot_phase(F, ws);
    GRID_BAR();
#define MOE_LOAD(hf_) unsigned char* w2 = WSP; \
          const int nPA = __builtin_amdgcn_readfirstlane(((const GAS int*)(w2 + WS_META))[0]), nPB = __builtin_amdgcn_readfirstlane(((const GAS int*)(w2 + WS_META))[1]); (void)nPB; \
          const int xB = __builtin_amdgcn_readfirstlane(((const GAS int*)(w2 + WS_META))[18]); (void)xB; \
          const int p0 = (hf_) ? nPA : 0; int pbk[7]; \
          _Pragma("unroll") for (int k = 0; k < 7; ++k) pbk[k] = __builtin_amdgcn_readfirstlane(((const GAS int*)(w2 + WS_META))[2 + (hf_) * 8 + 1 + k]) - p0;
    constexpr size_t HMB_OFF = (size_t)MAXP_HALF * 256 * EFF;
    { MOE_LOAD(0)
      pg8::Gemm g{(const bf16*)(w2 + WS_XG), (const bf16*)(w2 + WS_WM1), nPA * 256, 2 * EFF, D / 2, D / 2};
      pg8::MoeOrder S; S.init(nPA, 2 * EFF / 256, F.G, bid);
#pragma unroll
      for (int k = 0; k < 7; ++k) S.pb[k] = pbk[k];
      pg8::EpiGatedF8 E{w2 + WS_HM, EFF, 2 * EFF / 256};
      pg8::gemm_phase<pg8::EpiGatedF8, pg8::MoeOrder, true, true, true>(ring, g, S, E, F.wave); }
    { MOE_LOAD(1)
      pg8::Gemm g{(const bf16*)(w2 + WS_XG + (size_t)p0 * 256 * D), (const bf16*)(w2 + WS_WM1), xB * 256, 2 * EFF, D / 2, D / 2};
      pg8::MoeOrder S; S.init(xB, 2 * EFF / 256, F.G, bid); S.rot = (nPA * (2 * EFF / 256)) % F.G;
#pragma unroll
      for (int k = 0; k < 7; ++k) S.pb[k] = pbk[k];
      pg8::EpiGatedF8 E{w2 + WS_HM + HMB_OFF, EFF, 2 * EFF / 256};
      pg8::gemm_phase<pg8::EpiGatedF8, pg8::MoeOrder, true, true, true>(ring, g, S, E, F.wave); }
    GRID_BAR();
    { MOE_LOAD(0)
      pg8::Gemm g{(const bf16*)(w2 + WS_HM), (const bf16*)(w2 + WS_WM2), 256 * 256, D, EFF / 2, EFF / 2};
      pg8::MoeOrder S; S.init(256, D / 256, F.G, bid);
#pragma unroll
      for (int k = 0; k < 7; ++k) S.pb[k] = pbk[k];
      pg8::EpiMoeDown<true> E{OUTP, (const bf16*)(w2 + WS_XR3), (const int*)(w2 + WS_SLOTTOK), (const float*)(w2 + WS_SLOTGATE), 0, D, 1.f / 64};
      pg8::gemm_phase<pg8::EpiMoeDown<true>, pg8::MoeOrder, true, true, true>(ring, g, S, E, F.wave); }
    GRID_BAR();
    { MOE_LOAD(0)
      pg8::Gemm g{(const bf16*)(w2 + WS_HM), (const bf16*)(w2 + WS_WM2), nPA * 256, D, EFF / 2, EFF / 2};
      pg8::LeftOrder S; S.M.init(nPA, D / 256, F.G, bid); S.nLeft = 4 * (nPA - 256); S.c0 = 0; S.pbase = 256;
#pragma unroll
      for (int k = 0; k < 7; ++k) S.M.pb[k] = pbk[k];
      pg8::EpiMoeDown<true> E{OUTP, (const bf16*)(w2 + WS_XR3), (const int*)(w2 + WS_SLOTTOK), (const float*)(w2 + WS_SLOTGATE), 0, D, 1.f / 64};
      pg8::gemm_phase<pg8::EpiMoeDown<true>, pg8::LeftOrder, true, true, true>(ring, g, S, E, F.wave); }
    { MOE_LOAD(1)
      pg8::Gemm g{(const bf16*)(w2 + WS_HM + HMB_OFF), (const bf16*)(w2 + WS_WM2), xB * 256, D, EFF / 2, EFF / 2};
      pg8::LeftOrder S; S.M.init(xB, D / 256, F.G, bid); S.nLeft = 4 * xB; S.c0 = 4 * (nPA - 256); S.pbase = 0;
#pragma unroll
      for (int k = 0; k < 7; ++k) S.M.pb[k] = pbk[k];
      pg8::EpiMoeDown<false> E{OUTP, nullptr, (const int*)(w2 + WS_SLOTTOK), (const float*)(w2 + WS_SLOTGATE), p0 * 256, D, 1.f / 64};
      pg8::gemm_phase<pg8::EpiMoeDown<false>, pg8::LeftOrder, true, true, true>(ring, g, S, E, F.wave); }
    { MOE_LOAD(1)
      pg8::Gemm g{(const bf16*)(w2 + WS_XG + (size_t)(p0 + xB) * 256 * D), (const bf16*)(w2 + WS_WM1), (nPB - xB) * 256, 2 * EFF, D / 2, D / 2};
      pg8::MoeOrder S; S.init(nPB - xB, 2 * EFF / 256, F.G, bid); S.nBusy = 4 * (nPA - 256) + 4 * xB; S.SK = 4;
#pragma unroll
      for (int k = 0; k < 7; ++k) S.pb[k] = pbk[k] - xB;
      pg8::EpiGatedF8 E{w2 + WS_HM + HMB_OFF + (size_t)xB * 256 * EFF, EFF, 2 * EFF / 256};
      pg8::gemm_phase<pg8::EpiGatedF8, pg8::MoeOrder, true, true, true>(ring, g, S, E, F.wave); }
    GRID_BAR();
    { MOE_LOAD(1)
      pg8::Gemm g{(const bf16*)(w2 + WS_HM + HMB_OFF + (size_t)xB * 256 * EFF), (const bf16*)(w2 + WS_WM2), (nPB - xB) * 256, D, EFF / 2, EFF / 2};
      pg8::MoeOrder S; S.init(nPB - xB, D / 256, F.G, bid);
#pragma unroll
      for (int k = 0; k < 7; ++k) S.pb[k] = pbk[k] - xB;
      pg8::EpiMoeDown<false> E{OUTP, nullptr, (const int*)(w2 + WS_SLOTTOK), (const float*)(w2 + WS_SLOTGATE), (p0 + xB) * 256, D, 1.f / 64};
      pg8::gemm_phase<pg8::EpiMoeDown<false>, pg8::MoeOrder, true, true, true>(ring, g, S, E, F.wave); }
#undef MOE_LOAD
#undef GRID_BAR
#undef bid
#undef GEMM
}

extern "C" void kernel_launch(void* const* d_in, const int* in_sizes, int n_in, void* d_out, int out_size, void* d_ws, size_t ws_size, hipStream_t stream) {
    static int grid = 0;
    if (grid == 0) {
        if (n_in != 27 || in_sizes[0] != M * D || out_size != M * D || ws_size < WS_END) { fprintf(stderr, "kernel_launch: unexpected shapes (n_in %d, in0 %d, out %d, ws %zu < %zu); nothing launched\n", n_in, n_in > 0 ? in_sizes[0] : -1, out_size, ws_size, (size_t)WS_END); grid = -1; return; }
        int dev = 0, cus = 0, per_cu = 0;
        if (hipGetDevice(&dev) != hipSuccess || hipDeviceGetAttribute(&cus, hipDeviceAttributeMultiprocessorCount, dev) != hipSuccess) { grid = -1; return; }
        if (hipFuncSetAttribute((const void*)yoco_fwd, hipFuncAttributeMaxDynamicSharedMemorySize, LDS_BYTES) != hipSuccess) { fprintf(stderr, "kernel_launch: hipFuncSetAttribute failed\n"); grid = -1; return; }
        if (hipOccupancyMaxActiveBlocksPerMultiprocessor(&per_cu, (const void*)yoco_fwd, NWAVES * 64, LDS_BYTES) != hipSuccess || per_cu < 1) { fprintf(stderr, "kernel_launch: occupancy query says %d\n", per_cu); }
        (void)hipGetLastError();
        grid = cus;
    }
    if (grid < 0) return;
    if (hipMemsetAsync((char*)d_ws + WS_CTL, 0, CTL_ZERO_BYTES, stream) != hipSuccess) return;
    Args a{};
    for (int i = 0; i < 27; ++i) a.in[i] = (const float*)d_in[i];
    a.out = (float*)d_out; a.ws = (unsigned char*)d_ws;
    hipLaunchKernelGGL(yoco_fwd, dim3(grid), dim3(NWAVES * 64), LDS_BYTES, stream, a);
}
```

```cpp
#include <hip/hip_runtime.h>
#include <cstdio>
#include <cstdint>
__device__ __forceinline__ int lane_id_() { unsigned m_ = ~0u; asm volatile("" : "+s"(m_)); return (int)__builtin_amdgcn_mbcnt_hi(m_, __builtin_amdgcn_mbcnt_lo(m_, 0u)); }
template <int X> __device__ __forceinline__ float swz_xor(float v) { return __builtin_bit_cast(float, __builtin_amdgcn_ds_swizzle(__builtin_bit_cast(int, v), (X << 10) | 0x1f)); }
__device__ __forceinline__ void halves32(float v, float& r_lo, float& r_hi) { unsigned a_ = __builtin_bit_cast(unsigned, v), b_ = a_;
    asm volatile("s_nop 1\n\tv_permlane32_swap_b32 %0, %1\n\ts_nop 1" : "+v"(a_), "+v"(b_)); r_lo = __builtin_bit_cast(float, a_); r_hi = __builtin_bit_cast(float, b_); }
__device__ __forceinline__ float xor32_partner(float v, int upper_half) { float lo, hi; halves32(v, lo, hi); return upper_half ? lo : hi; }
__device__ __forceinline__ float xor32_sum(float v) { float lo, hi; halves32(v, lo, hi); return lo + hi; }
__device__ __forceinline__ float xor32_max(float v) { float lo, hi; halves32(v, lo, hi); return fmaxf(lo, hi); }
namespace pg8 {
#define PG8_LAS __attribute__((address_space(3)))
typedef unsigned short bf16_t;
typedef short bf16x8 __attribute__((ext_vector_type(8)));
typedef float f32x4 __attribute__((ext_vector_type(4)));
typedef unsigned u32x4 __attribute__((ext_vector_type(4)));
constexpr int BM = 256, BK = 64, HALF = 128, HTB = HALF * BK * 2  , STAGE_BYTES = 8 * HTB, NXCD = 8, WGM = 8;

__host__ __device__ __forceinline__ int lds_byte(int r, int c) { const int st = (r >> 4) * 2 + (c >> 5), rr = r & 15, cc = c & 31, ob = rr * 64 + cc * 2; return st * 1024 + (ob ^ (((ob >> 9) & 1) << 5)); }
__host__ __device__ __forceinline__ void stage_rc(int b, int& R, int& C) { const int st = b / 1024, sb = b % 1024, swz = sb ^ (((sb >> 9) & 1) << 5); R = (st >> 1) * 16 + swz / 64; C = (st & 1) * 32 + (swz % 64) / 2; }
__host__ __device__ __forceinline__ int perm32(int rho) { const int n = rho >> 4, i = rho & 15; return 8 * (i >> 2) + 4 * n + (i & 3); }

struct Unit { int pm, pn; };
struct Gemm { const bf16_t* A; const bf16_t* Bt; int M, N, K, lda; };

struct StaticOrder {
    int nM, nN, nwg, G, c;
    __host__ __device__ void init(int M, int N, int G_, int c_) { nM = M / BM; nN = N / BM; nwg = nM * nN; G = G_; c = c_; }
    __host__ __device__ bool next(int i, Unit& u) const {
        const int L = i * G + c; if (L >= nwg) return false;
        int wgid = L; { const int q = nwg / NXCD, r = nwg % NXCD, xcd = wgid % NXCD, off = wgid / NXCD; wgid = (xcd < r ? xcd * (q + 1) : r * (q + 1) + (xcd - r) * q) + off; }
        const int nig = WGM * nN, gid = wgid / nig, fm = gid * WGM, gsz = (nM - fm) < WGM ? (nM - fm) : WGM;
        u.pm = fm + ((wgid % nig) % gsz); u.pn = (wgid % nig) / gsz; return true;
    }
    __device__ __forceinline__ void a_ready(const Unit&) const {}
    __device__ __forceinline__ void done(const Unit&) const {}
};
__device__ __forceinline__ unsigned cvt_pk_bf16(float lo, float hi) { unsigned r; asm volatile("v_cvt_pk_bf16_f32 %0, %1, %2" : "=v"(r) : "v"(lo), "v"(hi)); return r; }
__device__ __forceinline__ float silu_f(float x) { const float e = __builtin_amdgcn_exp2f(x * -1.4426950408889634f); return x * __builtin_amdgcn_rcpf(1.f + e); }

__device__ __forceinline__ float sum4(const f32x4& a) { return (a[0] + a[1]) + (a[2] + a[3]); }
__device__ __forceinline__ float part_sum8(const float* p) { return sum4(*(const f32x4*)p) + sum4(*(const f32x4*)(p + 4)); }
__device__ __forceinline__ float part_sum16(const float* p) { return (sum4(*(const f32x4*)p) + sum4(*(const f32x4*)(p + 4))) + (sum4(*(const f32x4*)(p + 8)) + sum4(*(const f32x4*)(p + 12))); }
__device__ __forceinline__ float fq_sum(float v) { v += swz_xor<16>(v); return xor32_sum(v); }
__device__ __forceinline__ float sq8(const f32x4& a, const f32x4& b) { return ((a[0] * a[0] + a[1] * a[1]) + (a[2] * a[2] + a[3] * a[3])) + ((b[0] * b[0] + b[1] * b[1]) + (b[2] * b[2] + b[3] * b[3])); }
__device__ __forceinline__ u32x4 pack8(const f32x4& a, const f32x4& b) { u32x4 w; w.x = cvt_pk_bf16(a[0], a[1]); w.y = cvt_pk_bf16(a[2], a[3]); w.z = cvt_pk_bf16(b[0], b[1]); w.w = cvt_pk_bf16(b[2], b[3]); return w; }
constexpr float EPS_ = 1e-6f;
__device__ __forceinline__ unsigned pk_fp8x4(float a, float b, float c, float d) { int w = 0; w = __builtin_amdgcn_cvt_pk_fp8_f32(a, b, w, false); w = __builtin_amdgcn_cvt_pk_fp8_f32(c, d, w, true); return (unsigned)w; }

struct EpiQA {
    static constexpr bool PERM = true, AFTER_DRAIN = false;
    bf16_t* O; float* part; float wscale;
    __device__ __forceinline__ void operator()(const f32x4 (&acc)[2][2][4][2], const Unit& u, int wr, int wc, int fr, int fq) const {
        { int t_ = lane_id_(); asm volatile("" : "+v"(t_)); fr = t_ & 15; fq = (t_ >> 4) & 3; }
        const int row0 = u.pm * BM + wr * 64 + fr, col0 = u.pn * BM + wc * 32 + 8 * fq;
#pragma unroll
        for (int ai = 0; ai < 2; ++ai)
#pragma unroll
            for (int m = 0; m < 4; ++m) { const int row = row0 + ai * HALF + m * 16; bf16_t* rowp = O + (size_t)row * 768 + col0;
                const f32x4 a0 = acc[ai][0][m][0] * wscale, a1 = acc[ai][0][m][1] * wscale, b0 = acc[ai][1][m][0] * wscale, b1 = acc[ai][1][m][1] * wscale;
                *(u32x4*)(rowp) = pack8(a0, a1); *(u32x4*)(rowp + HALF) = pack8(b0, b1);
                const float s0 = sq8(a0, a1), s1 = sq8(b0, b1);
                float* pr = part + (size_t)row * 16;
                if (u.pn == 0) { const float t = fq_sum(s0 + s1); if (fq == 0) pr[wc] = t; }
                else if (u.pn == 1) { const float t0 = fq_sum(s0), t1 = fq_sum(s1); if (fq == 0) { pr[4 + wc] = t0; pr[8 + wc] = t1; } }
                else { const float t = fq_sum(s0); if (fq == 0) pr[12 + wc] = t; } }
    }
};

struct EpiRowScaleBf16 {
    static constexpr bool PERM = true, AFTER_DRAIN = false;
    bf16_t* O; int ldc; const float* part; float inv_n;
    __device__ __forceinline__ void operator()(const f32x4 (&acc)[2][2][4][2], const Unit& u, int wr, int wc, int fr, int fq) const {
        { int t_ = lane_id_(); asm volatile("" : "+v"(t_)); fr = t_ & 15; fq = (t_ >> 4) & 3; }
        const int row0 = u.pm * BM + wr * 64 + fr, col0 = u.pn * BM + wc * 32 + 8 * fq;
#pragma unroll
        for (int ai = 0; ai < 2; ++ai)
#pragma unroll
            for (int m = 0; m < 4; ++m) { const int row = row0 + ai * HALF + m * 16; bf16_t* rowp = O + (size_t)row * ldc + col0;
                const float rs = __builtin_amdgcn_rsqf(part_sum8(part + (size_t)row * 16) * inv_n + EPS_);
                *(u32x4*)(rowp) = pack8(acc[ai][0][m][0] * rs, acc[ai][0][m][1] * rs); *(u32x4*)(rowp + HALF) = pack8(acc[ai][1][m][0] * rs, acc[ai][1][m][1] * rs); }
    }
};

struct EpiKVup {
    static constexpr bool PERM = true, AFTER_DRAIN = false;
    bf16_t* Kd; bf16_t* Vd; const float* part; const bf16_t* QA; const float* g_kn; const float* rope;
    __device__ __forceinline__ void operator()(const f32x4 (&acc)[2][2][4][2], const Unit& u, int wr, int wc, int fr, int fq) const {
        { int t_ = lane_id_(); asm volatile("" : "+v"(t_)); fr = t_ & 15; fq = (t_ >> 4) & 3; }
        const int row0 = u.pm * BM + wr * 64 + fr;
        if (u.pn >= 4) {
            const int col0 = (u.pn - 4) * BM + wc * 32 + 8 * fq;
#pragma unroll
            for (int ai = 0; ai < 2; ++ai)
#pragma unroll
                for (int m = 0; m < 4; ++m) { const int row = row0 + ai * HALF + m * 16; bf16_t* rowp = Vd + (size_t)row * 1024 + col0;
                    const float rs = __builtin_amdgcn_rsqf(part_sum8(part + (size_t)row * 16 + 8) * (1.f / 256) + EPS_);
                    *(u32x4*)(rowp) = pack8(acc[ai][0][m][0] * rs, acc[ai][0][m][1] * rs); *(u32x4*)(rowp + HALF) = pack8(acc[ai][1][m][0] * rs, acc[ai][1][m][1] * rs); }
            return;
        }
        const int head = 4 * u.pn + wc;
        f32x4 gA0 = *(const f32x4*)(g_kn + 8 * fq), gA1 = *(const f32x4*)(g_kn + 8 * fq + 4), gB0 = *(const f32x4*)(g_kn + 32 + 8 * fq), gB1 = *(const f32x4*)(g_kn + 32 + 8 * fq + 4);
        const f32x4 gR1 = *(const f32x4*)(g_kn + 64 + 4 * fq), gR2 = *(const f32x4*)(g_kn + 80 + 4 * fq);
#pragma unroll
        for (int ai = 0; ai < 2; ++ai)
#pragma unroll
            for (int m = 0; m < 4; ++m) { const int row = row0 + ai * HALF + m * 16;
                const float rs = __builtin_amdgcn_rsqf(part_sum8(part + (size_t)row * 16 + 8) * (1.f / 256) + EPS_);
                f32x4 a0 = acc[ai][0][m][0] * rs, a1 = acc[ai][0][m][1] * rs, b0 = acc[ai][1][m][0] * rs, b1 = acc[ai][1][m][1] * rs;
                const unsigned long long p1 = *(const unsigned long long*)(QA + (size_t)row * 768 + 640 + 4 * fq), p2 = *(const unsigned long long*)(QA + (size_t)row * 768 + 656 + 4 * fq);
                f32x4 x1, x2;
                x1[0] = __builtin_bit_cast(float, (unsigned)(p1 << 16)); x1[1] = __builtin_bit_cast(float, (unsigned)p1 & 0xffff0000u);
                x1[2] = __builtin_bit_cast(float, (unsigned)(p1 >> 32) << 16); x1[3] = __builtin_bit_cast(float, (unsigned)(p1 >> 32) & 0xffff0000u);
                x2[0] = __builtin_bit_cast(float, (unsigned)(p2 << 16)); x2[1] = __builtin_bit_cast(float, (unsigned)p2 & 0xffff0000u);
                x2[2] = __builtin_bit_cast(float, (unsigned)(p2 >> 32) << 16); x2[3] = __builtin_bit_cast(float, (unsigned)(p2 >> 32) & 0xffff0000u);
                const float ss = fq_sum(sq8(a0, a1) + sq8(b0, b1) + sq8(x1, x2));
                const float sh = __builtin_amdgcn_rsqf(ss * (1.f / 96) + EPS_);
                bf16_t* kp = Kd + (size_t)row * 1536 + head * 96;
                *(u32x4*)(kp + 8 * fq) = pack8(a0 * gA0 * sh, a1 * gA1 * sh); *(u32x4*)(kp + 32 + 8 * fq) = pack8(b0 * gB0 * sh, b1 * gB1 * sh);
                const f32x4* rp = (const f32x4*)(rope + ((size_t)(row & 2047) * 16 + 4 * fq) * 2);
                const f32x4 c01 = rp[0], c23 = rp[1];
                const f32x4 y1 = x1 * gR1 * sh, y2 = x2 * gR2 * sh;
                f32x4 o1, o2;
                o1[0] = y1[0] * c01[0] - y2[0] * c01[1]; o2[0] = y2[0] * c01[0] + y1[0] * c01[1];
                o1[1] = y1[1] * c01[2] - y2[1] * c01[3]; o2[1] = y2[1] * c01[2] + y1[1] * c01[3];
                o1[2] = y1[2] * c23[0] - y2[2] * c23[1]; o2[2] = y2[2] * c23[0] + y1[2] * c23[1];
                o1[3] = y1[3] * c23[2] - y2[3] * c23[3]; o2[3] = y2[3] * c23[2] + y1[3] * c23[3];
                unsigned long long w1 = (unsigned long long)cvt_pk_bf16(o1[0], o1[1]) | ((unsigned long long)cvt_pk_bf16(o1[2], o1[3]) << 32);
                unsigned long long w2 = (unsigned long long)cvt_pk_bf16(o2[0], o2[1]) | ((unsigned long long)cvt_pk_bf16(o2[2], o2[3]) << 32);
                *(unsigned long long*)(kp + 64 + 4 * fq) = w1; *(unsigned long long*)(kp + 80 + 4 * fq) = w2; }
    }
};

struct EpiK2Q2 {
    static constexpr bool PERM = true, AFTER_DRAIN = false;
    bf16_t* O; const float* pss; const float* gk; const float* gq; float wscale;
    __device__ __forceinline__ void operator()(const f32x4 (&acc)[2][2][4][2], const Unit& u, int wr, int wc, int fr, int fq) const {
        { int t_ = lane_id_(); asm volatile("" : "+v"(t_)); fr = t_ & 15; fq = (t_ >> 4) & 3; }
        const int row0 = u.pm * BM + wr * 64 + fr, isq = u.pn >> 2, tl = u.pn & 3;
        const float* g = isq ? gq : gk; const float post = isq ? 0.125f * 1.4426950408889634f : 1.f;
        const f32x4 gA0 = *(const f32x4*)(g + 8 * fq) * post, gA1 = *(const f32x4*)(g + 8 * fq + 4) * post, gB0 = *(const f32x4*)(g + 32 + 8 * fq) * post, gB1 = *(const f32x4*)(g + 32 + 8 * fq + 4) * post;
        const int colh = isq * 2048 + (4 * tl + wc) * 64;
        unsigned zhi_ = 0u; asm volatile("" : "+v"(zhi_));
        const unsigned long long coff = ((unsigned long long)zhi_ << 32) | (unsigned)((colh + 8 * fq) * 2);
#pragma unroll
        for (int ai = 0; ai < 2; ++ai)
#pragma unroll
            for (int m = 0; m < 4; ++m) { const int row = row0 + ai * HALF + m * 16; unsigned char* rowp = (unsigned char*)O + (size_t)row * 6144 + coff;
                const float rs = __builtin_amdgcn_rsqf(part_sum16(pss + (size_t)row * 16) * (1.f / 1024) + EPS_) * wscale;
                const f32x4 a0 = acc[ai][0][m][0] * rs, a1 = acc[ai][0][m][1] * rs, b0 = acc[ai][1][m][0] * rs, b1 = acc[ai][1][m][1] * rs;
                const float ss = fq_sum(sq8(a0, a1) + sq8(b0, b1));
                const float sh = __builtin_amdgcn_rsqf(ss * (1.f / 64) + EPS_);
                *(u32x4*)(rowp) = pack8(a0 * gA0 * sh, a1 * gA1 * sh); *(u32x4*)(rowp + 64) = pack8(b0 * gB0 * sh, b1 * gB1 * sh); }
    }
};
struct EpiRowScale16 {
    static constexpr bool PERM = true, AFTER_DRAIN = false;
    bf16_t* O; int ldc; int coff; const float* pss; float wscale;
    __device__ __forceinline__ void operator()(const f32x4 (&acc)[2][2][4][2], const Unit& u, int wr, int wc, int fr, int fq) const {
        { int t_ = lane_id_(); asm volatile("" : "+v"(t_)); fr = t_ & 15; fq = (t_ >> 4) & 3; }
        const int row0 = u.pm * BM + wr * 64 + fr, col0 = coff + u.pn * BM + wc * 32 + 8 * fq;
#pragma unroll
        for (int ai = 0; ai < 2; ++ai)
#pragma unroll
            for (int m = 0; m < 4; ++m) { const int row = row0 + ai * HALF + m * 16; bf16_t* rowp = O + (size_t)row * ldc + col0;
                const float rs = __builtin_amdgcn_rsqf(part_sum16(pss + (size_t)row * 16) * (1.f / 1024) + EPS_) * wscale;
                *(u32x4*)(rowp) = pack8(acc[ai][0][m][0] * rs, acc[ai][0][m][1] * rs); *(u32x4*)(rowp + HALF) = pack8(acc[ai][1][m][0] * rs, acc[ai][1][m][1] * rs); }
    }
};

template <bool SSQ> struct EpiGated {
    static constexpr bool PERM = true, AFTER_DRAIN = false;
    bf16_t* Hd; int ldc; int ntile; const float* rs;
    __device__ __forceinline__ void operator()(const f32x4 (&acc)[2][2][4][2], const Unit& u, int wr, int wc, int fr, int fq) const {
        { int t_ = lane_id_(); asm volatile("" : "+v"(t_)); fr = t_ & 15; fq = (t_ >> 4) & 3; }
        const int pnl = ntile ? (u.pn % ntile) : u.pn;
        const int row0 = u.pm * BM + wr * 64 + fr, col0 = pnl * HALF + wc * 32 + 8 * fq;
#pragma unroll
        for (int ai = 0; ai < 2; ++ai)
#pragma unroll
            for (int m = 0; m < 4; ++m) { const int row = row0 + ai * HALF + m * 16; bf16_t* rowp = Hd + (size_t)row * ldc + col0;
                const float r = SSQ ? __builtin_amdgcn_rsqf(part_sum16(rs + (size_t)row * 16) * (1.f / 1024) + EPS_) : rs[row];
                const f32x4 g0 = acc[ai][0][m][0] * r, g1 = acc[ai][0][m][1] * r, u0 = acc[ai][1][m][0] * r, u1 = acc[ai][1][m][1] * r;
                u32x4 w;
                w.x = cvt_pk_bf16(silu_f(g0[0]) * u0[0], silu_f(g0[1]) * u0[1]); w.y = cvt_pk_bf16(silu_f(g0[2]) * u0[2], silu_f(g0[3]) * u0[3]);
                w.z = cvt_pk_bf16(silu_f(g1[0]) * u1[0], silu_f(g1[1]) * u1[1]); w.w = cvt_pk_bf16(silu_f(g1[2]) * u1[2], silu_f(g1[3]) * u1[3]);
                *(u32x4*)rowp = w; }
    }
};

struct EpiGatedF8 {
    static constexpr bool PERM = true, AFTER_DRAIN = false;
    unsigned char* Hd; int ldc; int ntile;
    static __device__ __forceinline__ float gate(float g, float u) {
        const float e = __builtin_amdgcn_exp2f(g * (-1.4426950408889634f / 64.f)); return (g * u) * (__builtin_amdgcn_rcpf(1.f + e) * (1.f / 4096.f)); }
    __device__ __forceinline__ void operator()(const f32x4 (&acc)[2][2][4][2], const Unit& u, int wr, int wc, int fr, int fq) const {
        { int t_ = lane_id_(); asm volatile("" : "+v"(t_)); fr = t_ & 15; fq = (t_ >> 4) & 3; }
        const int pnl = u.pn % ntile;
        const int row0 = u.pm * BM + wr * 64 + fr, col0 = pnl * HALF + wc * 32 + 8 * fq;
#pragma unroll
        for (int ai = 0; ai < 2; ++ai)
#pragma unroll
            for (int m = 0; m < 4; ++m) { const int row = row0 + ai * HALF + m * 16; unsigned char* rowp = Hd + (size_t)row * ldc + col0;
                const f32x4 g0 = acc[ai][0][m][0], g1 = acc[ai][0][m][1], u0 = acc[ai][1][m][0], u1 = acc[ai][1][m][1];
                unsigned long long w = (unsigned long long)pk_fp8x4(gate(g0[0], u0[0]), gate(g0[1], u0[1]), gate(g0[2], u0[2]), gate(g0[3], u0[3]))
                                     | ((unsigned long long)pk_fp8x4(gate(g1[0], u1[0]), gate(g1[1], u1[1]), gate(g1[2], u1[2]), gate(g1[3], u1[3])) << 32);
                *(unsigned long long*)rowp = w; }
    }
};

template <bool SSQ, bool XF8, bool RES16> struct EpiResStream {
    static constexpr bool PERM = true, AFTER_DRAIN = false;
    const void* res; bf16_t* XB; unsigned char* X8; float* ssq; float ascale;
    __device__ __forceinline__ void operator()(const f32x4 (&acc)[2][2][4][2], const Unit& u, int wr, int wc, int fr, int fq) const {
        { int t_ = lane_id_(); asm volatile("" : "+v"(t_)); fr = t_ & 15; fq = (t_ >> 4) & 3; }
        const int row0 = u.pm * BM + wr * 64 + fr, col0 = u.pn * BM + wc * 32 + 8 * fq;
        f32x4 rw[4][2][2];
#define ERS_ROW(it) (row0 + ((it) >> 2) * HALF + ((it) & 3) * 16)
#define ERS_LOAD(it) do { const size_t ro_ = (size_t)ERS_ROW(it) * 1024 + col0; _Pragma("unroll") for (int bj = 0; bj < 2; ++bj) { \
            if constexpr (RES16) rw[(it) & 3][bj][0] = __builtin_bit_cast(f32x4, *(const u32x4*)((const bf16_t*)res + ro_ + bj * HALF)); \
            else { _Pragma("unroll") for (int n = 0; n < 2; ++n) rw[(it) & 3][bj][n] = *(const f32x4*)((const float*)res + ro_ + bj * HALF + n * 4); } } } while (0)
        ERS_LOAD(0); ERS_LOAD(1); ERS_LOAD(2); ERS_LOAD(3);
#pragma unroll
        for (int it = 0; it < 8; ++it) { const int ai = it >> 2, m = it & 3; const int row = ERS_ROW(it); const size_t ro = (size_t)row * 1024 + col0;
                f32x4 r[2][2];
#pragma unroll
                for (int bj = 0; bj < 2; ++bj) {
                    if constexpr (RES16) { const u32x4 w = __builtin_bit_cast(u32x4, rw[it & 3][bj][0]);
                        r[bj][0] = (f32x4){__builtin_bit_cast(float, w.x << 16), __builtin_bit_cast(float, w.x & 0xffff0000u), __builtin_bit_cast(float, w.y << 16), __builtin_bit_cast(float, w.y & 0xffff0000u)};
                        r[bj][1] = (f32x4){__builtin_bit_cast(float, w.z << 16), __builtin_bit_cast(float, w.z & 0xffff0000u), __builtin_bit_cast(float, w.w << 16), __builtin_bit_cast(float, w.w & 0xffff0000u)}; }
                    else { r[bj][0] = rw[it & 3][bj][0]; r[bj][1] = rw[it & 3][bj][1]; }
                    r[bj][0] = r[bj][0] + acc[ai][bj][m][0] * ascale; r[bj][1] = r[bj][1] + acc[ai][bj][m][1] * ascale; }
                if (it + 4 < 8) ERS_LOAD(it + 4);
                *(u32x4*)(XB + ro) = pack8(r[0][0], r[0][1]); *(u32x4*)(XB + ro + HALF) = pack8(r[1][0], r[1][1]);
                if constexpr (XF8) { unsigned char* x8 = X8 + ro;
                    *(unsigned long long*)(x8) = (unsigned long long)pk_fp8x4(r[0][0][0], r[0][0][1], r[0][0][2], r[0][0][3]) | ((unsigned long long)pk_fp8x4(r[0][1][0], r[0][1][1], r[0][1][2], r[0][1][3]) << 32);
                    *(unsigned long long*)(x8 + HALF) = (unsigned long long)pk_fp8x4(r[1][0][0], r[1][0][1], r[1][0][2], r[1][0][3]) | ((unsigned long long)pk_fp8x4(r[1][1][0], r[1][1][1], r[1][1][2], r[1][1][3]) << 32); }
                if (SSQ) { const float t = fq_sum(sq8(r[0][0], r[0][1]) + sq8(r[1][0], r[1][1])); if (fq == 0) ssq[(size_t)row * 16 + u.pn * 4 + wc] = t; } }
#undef ERS_LOAD
#undef ERS_ROW
    }
};

template <bool FIRST> struct EpiMoeDown {
    static constexpr bool PERM = false, AFTER_DRAIN = false;
    float* out; const bf16_t* xb; const int* slot_tok; const float* slot_gate; int slot_base; int ldc; float wscale;
    __device__ __forceinline__ void operator()(const f32x4 (&acc)[2][2][4][2], const Unit& u, int wr, int wc, int fr, int fq) const {
        { int t_ = lane_id_(); asm volatile("" : "+v"(t_)); fr = t_ & 15; fq = (t_ >> 4) & 3; }
        const int pnl = u.pn & 3;
        const int row0 = slot_base + u.pm * BM + wr * 64 + fr, col0 = pnl * BM + wc * 32 + 4 * fq;
        int tk[8]; float gt[8];
#pragma unroll
        for (int it = 0; it < 8; ++it) { const int slot = row0 + (it >> 2) * HALF + (it & 3) * 16; tk[it] = slot_tok[slot]; gt[it] = slot_gate[slot] * wscale; }
        f32x4 rw[4][2][2]; unsigned rlo[4][2][2], rhi[4][2][2];
#define EMD_LOAD(it) do { if (tk[it] >= 0) { _Pragma("unroll") for (int bj = 0; bj < 2; ++bj) _Pragma("unroll") for (int n = 0; n < 2; ++n) { \
            if constexpr (FIRST) { const unsigned long long q_ = *(const unsigned long long*)(xb + (size_t)tk[it] * ldc + col0 + bj * HALF + n * 16); \
                rlo[(it) & 3][bj][n] = (unsigned)q_; rhi[(it) & 3][bj][n] = (unsigned)(q_ >> 32); } \
            else rw[(it) & 3][bj][n] = *(const f32x4*)(out + (size_t)tk[it] * ldc + col0 + bj * HALF + n * 16); } } } while (0)
        EMD_LOAD(0); EMD_LOAD(1); EMD_LOAD(2); EMD_LOAD(3);
#pragma unroll
        for (int it = 0; it < 8; ++it) { const int ai = it >> 2, m = it & 3;
            if (tk[it] >= 0) { float* rowp = out + (size_t)tk[it] * ldc + col0;
#pragma unroll
                for (int bj = 0; bj < 2; ++bj)
#pragma unroll
                    for (int n = 0; n < 2; ++n) { f32x4 r;
                        if constexpr (FIRST) { const unsigned lo = rlo[it & 3][bj][n], hi = rhi[it & 3][bj][n];
                            r = (f32x4){__builtin_bit_cast(float, lo << 16), __builtin_bit_cast(float, lo & 0xffff0000u), __builtin_bit_cast(float, hi << 16), __builtin_bit_cast(float, hi & 0xffff0000u)}; }
                        else r = rw[it & 3][bj][n];
                        *(f32x4*)(rowp + bj * HALF + n * 16) = r + acc[ai][bj][m][n] * gt[it]; } }
            if (it + 4 < 8) EMD_LOAD(it + 4); }
#undef EMD_LOAD
    }
};

struct MoeOrder {
    int nM, nN, nwg, G, c; int pb[7];
    int rot;
    int nBusy, SK;
    __device__ void init(int nPanels, int nN_, int G_, int c_) { nM = nPanels; nN = nN_; nwg = nM * nN; G = G_; c = c_; nBusy = 0; SK = 0; rot = 0; }
    __device__ __forceinline__ int expert_of(int pm) const { int e = 0;
#pragma unroll
        for (int k = 0; k < 7; ++k) e += (pm >= pb[k]) ? 1 : 0;
        return e; }
    __device__ bool next(int i, Unit& u) const {
        int L;
        if (nBusy == 0) { int ce = c - rot; if (ce < 0) ce += G; L = i * G + ce; }
        else if (c >= nBusy) L = (i < SK) ? i * (G - nBusy) + (c - nBusy) : SK * (G - nBusy) + (i - SK) * G + c;
        else L = SK * (G - nBusy) + i * G + c;
        if (L >= nwg) return false;
        int wgid = L; { const int q = nwg / NXCD, r = nwg % NXCD, xcd = wgid % NXCD, off = wgid / NXCD; wgid = (xcd < r ? xcd * (q + 1) : r * (q + 1) + (xcd - r) * q) + off; }
        const int nig = WGM * nN, gid = wgid / nig, fm = gid * WGM, gsz = (nM - fm) < WGM ? (nM - fm) : WGM;
        u.pm = fm + ((wgid % nig) % gsz); const int pnl = (wgid % nig) / gsz;
        u.pn = expert_of(u.pm) * nN + pnl; return true;
    }
    __device__ __forceinline__ void a_ready(const Unit&) const {}
    __device__ __forceinline__ void done(const Unit&) const {}
};
struct LeftOrder {
    MoeOrder M; int nLeft, c0, pbase;
    __device__ bool next(int i, Unit& u) const { const int j = M.c - c0; if (i != 0 || j < 0 || j >= nLeft) return false; u.pm = pbase + (j >> 2); u.pn = M.expert_of(u.pm) * 4 + (j & 3); return true; }
    __device__ __forceinline__ void a_ready(const Unit&) const {}
    __device__ __forceinline__ void done(const Unit&) const {}
};
template <class Epi, class Sched, bool ALIGN_EPI = false, bool SP2 = false, bool F8 = false>
__device__ __forceinline__ void gemm_phase(PG8_LAS unsigned char* lds, const Gemm g, const Sched& S, const Epi& E, const int wave_idx) {
    int tid_ = wave_idx * 64 + lane_id_(); asm volatile("" : "+v"(tid_));
    const int tid = tid_, wid = __builtin_amdgcn_readfirstlane(tid >> 6), lane = tid & 63, wr = wid >> 2, wc = wid & 3, fr = lane & 15, fq = lane >> 4;
    const int K = g.K, nt = K / BK;
    unsigned voffA0, voffB0;
    { int R, C; stage_rc(tid * 16, R, C); const int Rb = Epi::PERM ? ((R & ~31) + perm32(R & 31)) : R;
      voffA0 = (unsigned)(R * g.lda + C) * 2u; voffB0 = (unsigned)(Rb * K + C) * 2u; }
    const size_t voffAR = (size_t)64 * g.lda * 2, voffBR = (size_t)64 * K * 2;
    const size_t kstep = (size_t)(BK * 2);
    const size_t hstepA = (size_t)HALF * g.lda * 2, hstepB = (size_t)HALF * K * 2;
    const size_t tstepA = 2 * hstepA, tstepB = 2 * hstepB;
    const unsigned lds0_ = (unsigned)(__UINTPTR_TYPE__)lds;
    const unsigned ldsw = (unsigned)wid * 1024u;
    const int aoff = lds_byte(wr * 64 + fr, fq * 8), boff = lds_byte(wc * 32 + fr, fq * 8);
#define PG8_SA(b, h) (((b) * 2 + (h)) * HTB)
#define PG8_SB(b, h) ((4 + (b) * 2 + (h)) * HTB)
#define PG8_STAGE(bufoff, gbase, voff) do { _Pragma("unroll") for (int _i = 0; _i < 2; ++_i) { unsigned keep_; const char* sb_ = (const char*)(gbase) + (size_t)_i * voff##R; \
        asm volatile("s_mov_b32 %0, m0\n\ts_mov_b32 m0, %3\n\ts_nop 0\n\tglobal_load_lds_dwordx4 %1, %2\n\ts_mov_b32 m0, %0" \
            : "=&s"(keep_) : "v"(voff##0), "s"(sb_), "s"(lds0_ + (unsigned)((bufoff) + _i * 8192) + ldsw) : "memory"); } } while (0)
#define PG8_LDA(dst, b, h) do { _Pragma("unroll") for (int m = 0; m < 4; ++m) _Pragma("unroll") for (int k = 0; k < 2; ++k) dst[m][k] = *(const PG8_LAS bf16x8*)(lds + PG8_SA(b, h) + aoff + m * 2048 + k * 1024); } while (0)
#define PG8_LDB(dst, b, h) do { _Pragma("unroll") for (int n = 0; n < 2; ++n) _Pragma("unroll") for (int k = 0; k < 2; ++k) dst[n][k] = *(const PG8_LAS bf16x8*)(lds + PG8_SB(b, h) + boff + n * 2048 + k * 1024); } while (0)
#define PG8_MMA(ai, bj, At, Bt) do { __builtin_amdgcn_s_setprio(1); _Pragma("unroll") for (int m = 0; m < 4; ++m) _Pragma("unroll") for (int n = 0; n < 2; ++n) { \
        if constexpr (F8) { typedef int v8i_ __attribute__((ext_vector_type(8))); typedef int v4i_ __attribute__((ext_vector_type(4))); \
            const v4i_ b0_ = __builtin_bit_cast(v4i_, Bt[n][0]), b1_ = __builtin_bit_cast(v4i_, Bt[n][1]), a0_ = __builtin_bit_cast(v4i_, At[m][0]), a1_ = __builtin_bit_cast(v4i_, At[m][1]); \
            const v8i_ bb_ = __builtin_shufflevector(b0_, b1_, 0, 1, 2, 3, 4, 5, 6, 7), aa_ = __builtin_shufflevector(a0_, a1_, 0, 1, 2, 3, 4, 5, 6, 7); \
            acc[ai][bj][m][n] = __builtin_amdgcn_mfma_scale_f32_16x16x128_f8f6f4(bb_, aa_, acc[ai][bj][m][n], 0, 0, 0, 0, 0, 0); } \
        else { _Pragma("unroll") for (int k = 0; k < 2; ++k) acc[ai][bj][m][n] = __builtin_amdgcn_mfma_f32_16x16x32_bf16(Bt[n][k], At[m][k], acc[ai][bj][m][n], 0, 0, 0); } } \
        __builtin_amdgcn_s_setprio(0); } while (0)
#define PG8_WAIT_V(n) asm volatile("s_waitcnt vmcnt(" #n ")" ::: "memory")
#define PG8_WAIT_L(n) asm volatile("s_waitcnt lgkmcnt(" #n ")" ::: "memory")
#define PG8_BAR __builtin_amdgcn_s_barrier()
#define PG8_SCHED __builtin_amdgcn_sched_barrier(0)
    Unit cur, nxt; int ui = 0;
    if (!S.next(0, cur)) return;
    f32x4 acc[2][2][4][2];
#pragma unroll
    for (int a = 0; a < 2; ++a)
#pragma unroll
        for (int b = 0; b < 2; ++b)
#pragma unroll
            for (int m = 0; m < 4; ++m)
#pragma unroll
                for (int n = 0; n < 2; ++n) acc[a][b][m][n] = (f32x4){0.f, 0.f, 0.f, 0.f};
    bf16x8 At[4][2], B0[2][2], B1[2][2];
    const char* cA = (const char*)g.A + (size_t)cur.pm * tstepA; const char* cB = (const char*)g.Bt + (size_t)cur.pn * tstepB;
    S.a_ready(cur);
    if constexpr (SP2) {
        PG8_STAGE(PG8_SB(0, 0), cB, voffB); PG8_STAGE(PG8_SB(0, 1), cB + hstepB, voffB); PG8_STAGE(PG8_SA(0, 0), cA, voffA); PG8_STAGE(PG8_SA(0, 1), cA + hstepA, voffA);
        if (wr == 1) PG8_BAR;
        PG8_WAIT_V(2); PG8_BAR;
        PG8_STAGE(PG8_SB(1, 0), cB + kstep, voffB); PG8_STAGE(PG8_SA(1, 0), cA + kstep, voffA); PG8_STAGE(PG8_SB(1, 1), cB + hstepB + kstep, voffB);
        PG8_WAIT_V(6); PG8_BAR;
    } else {
        PG8_STAGE(PG8_SB(0, 0), cB, voffB); PG8_STAGE(PG8_SA(0, 0), cA, voffA); PG8_STAGE(PG8_SB(0, 1), cB + hstepB, voffB); PG8_STAGE(PG8_SA(0, 1), cA + hstepA, voffA);
        if (wr == 1) PG8_BAR;
        PG8_WAIT_V(4); PG8_BAR;
        PG8_STAGE(PG8_SB(1, 0), cB + kstep, voffB); PG8_STAGE(PG8_SA(1, 0), cA + kstep, voffA); PG8_STAGE(PG8_SB(1, 1), cB + hstepB + kstep, voffB);
        PG8_WAIT_V(6); PG8_BAR;
    }
    for (;;) {
        const bool has_next = S.next(ui + 1, nxt);
        const char* nA = has_next ? (const char*)g.A + (size_t)nxt.pm * tstepA : cA; const char* nB = has_next ? (const char*)g.Bt + (size_t)nxt.pn * tstepB : cB;
#pragma unroll 1
        for (int t = 0; t < nt; t += 2) {
            const bool last = (t == nt - 2);
            const char* a1 = cA + (size_t)(t + 1) * kstep;
            const char* a2 = last ? nA : cA + (size_t)(t + 2) * kstep; const char* b2 = last ? nB : cB + (size_t)(t + 2) * kstep;
            const char* a3 = a2 + kstep; const char* b3 = b2 + kstep;
            if (last && has_next) S.a_ready(nxt);
            if constexpr (SP2) {
            PG8_LDB(B0, 0, 0); PG8_LDB(B1, 0, 1); PG8_SCHED; PG8_LDA(At, 0, 0); PG8_STAGE(PG8_SA(1, 1), a1 + hstepA, voffA);
            PG8_WAIT_V(8); PG8_WAIT_L(0); PG8_BAR; PG8_MMA(0, 0, At, B0); PG8_MMA(0, 1, At, B1); PG8_BAR; PG8_SCHED;
            PG8_LDA(At, 0, 1); PG8_STAGE(PG8_SB(0, 0), b2, voffB); PG8_STAGE(PG8_SB(0, 1), b2 + hstepB, voffB); PG8_STAGE(PG8_SA(0, 0), a2, voffA);
            PG8_WAIT_V(8); PG8_WAIT_L(0); PG8_BAR; PG8_MMA(1, 0, At, B0); PG8_MMA(1, 1, At, B1); PG8_BAR; PG8_SCHED;
            PG8_LDB(B0, 1, 0); PG8_LDB(B1, 1, 1); PG8_SCHED; PG8_LDA(At, 1, 0); PG8_STAGE(PG8_SA(0, 1), a2 + hstepA, voffA);
            PG8_WAIT_V(8); PG8_WAIT_L(0); PG8_BAR; PG8_MMA(0, 0, At, B0); PG8_MMA(0, 1, At, B1); PG8_BAR; PG8_SCHED;
            PG8_LDA(At, 1, 1); PG8_STAGE(PG8_SB(1, 0), b3, voffB); PG8_STAGE(PG8_SB(1, 1), b3 + hstepB, voffB); PG8_STAGE(PG8_SA(1, 0), a3, voffA);
            PG8_WAIT_V(8); PG8_WAIT_L(0); PG8_BAR; PG8_MMA(1, 0, At, B0); PG8_MMA(1, 1, At, B1); PG8_BAR; PG8_SCHED;
            } else {
            PG8_LDB(B0, 0, 0); PG8_SCHED; PG8_LDA(At, 0, 0); PG8_STAGE(PG8_SA(1, 1), a1 + hstepA, voffA);
            PG8_WAIT_L(8); PG8_BAR; PG8_WAIT_L(0); PG8_MMA(0, 0, At, B0); PG8_BAR; PG8_SCHED;
            PG8_LDB(B1, 0, 1); PG8_STAGE(PG8_SB(0, 0), b2, voffB);
            PG8_BAR; PG8_WAIT_L(0); PG8_MMA(0, 1, At, B1); PG8_BAR;
            PG8_LDA(At, 0, 1); PG8_STAGE(PG8_SA(0, 0), a2, voffA);
            PG8_BAR; PG8_WAIT_L(0); PG8_MMA(1, 0, At, B0); PG8_BAR; PG8_SCHED;
            PG8_STAGE(PG8_SB(0, 1), b2 + hstepB, voffB);
            PG8_WAIT_V(6); PG8_BAR; PG8_MMA(1, 1, At, B1); PG8_BAR;
            PG8_LDB(B0, 1, 0); PG8_SCHED; PG8_LDA(At, 1, 0); PG8_STAGE(PG8_SA(0, 1), a2 + hstepA, voffA);
            PG8_WAIT_L(8); PG8_BAR; PG8_WAIT_L(0); PG8_MMA(0, 0, At, B0); PG8_BAR; PG8_SCHED;
            PG8_LDB(B1, 1, 1); PG8_STAGE(PG8_SB(1, 0), b3, voffB);
            PG8_BAR; PG8_WAIT_L(0); PG8_MMA(0, 1, At, B1); PG8_BAR;
            PG8_LDA(At, 1, 1); PG8_STAGE(PG8_SA(1, 0), a3, voffA);
            PG8_BAR; PG8_WAIT_L(0); PG8_MMA(1, 0, At, B0); PG8_BAR; PG8_SCHED;
            PG8_STAGE(PG8_SB(1, 1), b3 + hstepB, voffB);
            PG8_WAIT_V(6); PG8_BAR; PG8_MMA(1, 1, At, B1); PG8_BAR;
            }
        }
        if constexpr (ALIGN_EPI) { if (wr == 0) PG8_BAR; }
        if constexpr (!Epi::AFTER_DRAIN) { E(acc, cur, wr, wc, fr, fq); S.done(cur); }
        if (!has_next) break;
#pragma unroll
        for (int a = 0; a < 2; ++a)
#pragma unroll
            for (int b = 0; b < 2; ++b)
#pragma unroll
                for (int m = 0; m < 4; ++m)
#pragma unroll
                    for (int n = 0; n < 2; ++n) acc[a][b][m][n] = (f32x4){0.f, 0.f, 0.f, 0.f};
        cur = nxt; cA = nA; cB = nB; ++ui;
        if constexpr (ALIGN_EPI) { if (wr == 1) PG8_BAR; }
    }
    PG8_WAIT_V(0);
    if constexpr (!ALIGN_EPI) { if (wr == 0) PG8_BAR; }
    PG8_BAR;
    if constexpr (Epi::AFTER_DRAIN) { E.fused(acc, cur, wr, wc, fr, fq, lds, wid, lane); S.done(cur); }
#undef PG8_SA
#undef PG8_SB
#undef PG8_STAGE
#undef PG8_LDA
#undef PG8_LDB
#undef PG8_MMA
#undef PG8_WAIT_V
#undef PG8_WAIT_L
#undef PG8_BAR
#undef PG8_SCHED
}
}
namespace att {
#define ATT_LAS __attribute__((address_space(3)))
typedef unsigned short bf16;
typedef short bf16x8 __attribute__((ext_vector_type(8)));
typedef short s16x4 __attribute__((ext_vector_type(4)));
typedef float f32x16 __attribute__((ext_vector_type(16)));
typedef float f32x4_t __attribute__((ext_vector_type(4)));
typedef unsigned u32x4 __attribute__((ext_vector_type(4)));
typedef unsigned u32x2 __attribute__((ext_vector_type(2)));
typedef float f32x2_t __attribute__((ext_vector_type(2))); typedef __bf16 bf16x2_t __attribute__((ext_vector_type(2)));
__device__ __forceinline__ unsigned cvtpk(float lo, float hi) { f32x2_t v = {lo, hi}; bf16x2_t b = __builtin_convertvector(v, bf16x2_t); return __builtin_bit_cast(unsigned, b); }
__device__ __forceinline__ s16x4 vtr(const ATT_LAS unsigned char* p) { return __builtin_bit_cast(s16x4, __builtin_amdgcn_ds_read_tr16_b64_v4i16((ATT_LAS s16x4*)p)); }
constexpr int VSTR = 192;
template <int DQK> struct Geo { static constexpr int KSTR = DQK * 2 + 16, KBUF = 64 * KSTR, VBUF = 64 * VSTR, CPR = DQK / 8, NKC = 64 * CPR, KIT = (NKC + 511) / 512; };
template <int DQK> constexpr int lds_bytes() { return 3 * Geo<DQK>::KBUF + 3 * Geo<DQK>::VBUF + 2048 + 8192; }

__device__ __forceinline__ float xhalf_sum(float m) { return xor32_sum(m); }
__device__ __forceinline__ float max3f(float a, float b, float c) { float r; asm("v_max3_f32 %0, %1, %2, %3" : "=v"(r) : "v"(a), "v"(b), "v"(c)); return r; }
__device__ __forceinline__ float max2f(float a, float b) { float r; asm("v_max_f32_e32 %0, %1, %2" : "=v"(r) : "v"(a), "v"(b)); return r; }
__device__ __forceinline__ float rowmax32(const f32x16& p0, const f32x16& p1) {
    float a = max2f(p0[0], p1[0]), b = max2f(p0[1], p1[1]), c = max2f(p0[2], p1[2]), d = max2f(p0[3], p1[3]);
#pragma unroll
    for (int r = 4; r < 16; r += 4) { a = max3f(a, p0[r], p1[r]); b = max3f(b, p0[r + 1], p1[r + 1]); c = max3f(c, p0[r + 2], p1[r + 2]); d = max3f(d, p0[r + 3], p1[r + 3]); }
    const float m = max2f(max2f(a, b), max2f(c, d));
    float lo_, hi_; halves32(m, lo_, hi_);
    return max2f(lo_, hi_);
}

template <int DQK, bool BAND, int qpitch, int kpitch, int vpitch, int opitch, bool OF8 = false, bool NOMAX = false, int NS = 2>
__device__ __forceinline__ void attn_unit(ATT_LAS unsigned char* lds, const bf16* Qb, const bf16* Kb, const bf16* Vb, bf16* Ob,
                                          int q0, int t_lo, int t_hi, int my_lo, int my_hi, int cc, const float* bias_g, const float* g_qn, const float* rope, const int wave_idx) {
    typedef Geo<DQK> G;
    int tid_ = wave_idx * 64 + lane_id_(); asm volatile("" : "+v"(tid_));
    const int tid = tid_, lane = tid & 63, r32 = lane & 31, hi = lane >> 5, wid = __builtin_amdgcn_readfirstlane(tid >> 6);
    ATT_LAS float* biasL = (ATT_LAS float*)(lds + NS * G::KBUF + NS * G::VBUF);
    bf16x8 qf[DQK / 16];
    { const bf16* qp = Qb + (size_t)(q0 + wid * 32 + r32) * qpitch + 8 * hi;
#pragma unroll
      for (int kk = 0; kk < DQK / 16; ++kk) qf[kk] = *(const bf16x8*)(qp + 16 * kk); }
    if constexpr (!BAND) {
        float qv[DQK / 16][8]; float ss = 0.f;
#pragma unroll
        for (int kk = 0; kk < DQK / 16; ++kk)
#pragma unroll
            for (int j = 0; j < 8; ++j) { qv[kk][j] = __builtin_bit_cast(float, (unsigned)(unsigned short)qf[kk][j] << 16); ss += qv[kk][j] * qv[kk][j]; }
        ss = xhalf_sum(ss);
        const float rs = __builtin_amdgcn_rsqf(ss * (1.f / DQK) + 1e-6f) * (0.10206207261596577f * 1.4426950408889634f);
#pragma unroll
        for (int kk = 0; kk < DQK / 16; ++kk) { const f32x4_t g0 = *(const f32x4_t*)(g_qn + 16 * kk + 8 * hi), g1 = *(const f32x4_t*)(g_qn + 16 * kk + 8 * hi + 4);
#pragma unroll
            for (int j = 0; j < 4; ++j) { qv[kk][j] *= rs * g0[j]; qv[kk][4 + j] *= rs * g1[j]; } }
        const f32x4_t* rp = (const f32x4_t*)(rope + ((size_t)(q0 + wid * 32 + r32) * 16 + 8 * hi) * 2);
#pragma unroll
        for (int j2 = 0; j2 < 4; ++j2) { const f32x4_t cs = rp[j2];
            { const float x1 = qv[4][2 * j2], x2 = qv[5][2 * j2]; qv[4][2 * j2] = x1 * cs[0] - x2 * cs[1]; qv[5][2 * j2] = x2 * cs[0] + x1 * cs[1]; }
            { const float x1 = qv[4][2 * j2 + 1], x2 = qv[5][2 * j2 + 1]; qv[4][2 * j2 + 1] = x1 * cs[2] - x2 * cs[3]; qv[5][2 * j2 + 1] = x2 * cs[2] + x1 * cs[3]; } }
#pragma unroll
        for (int kk = 0; kk < DQK / 16; ++kk) { u32x4 w; w.x = cvtpk(qv[kk][0], qv[kk][1]); w.y = cvtpk(qv[kk][2], qv[kk][3]); w.z = cvtpk(qv[kk][4], qv[kk][5]); w.w = cvtpk(qv[kk][6], qv[kk][7]);
            qf[kk] = __builtin_bit_cast(bf16x8, w); }
    }
    if (BAND) { if (tid < 257) biasL[tid] = bias_g[tid] * 1.4426950408889634f; }
    constexpr int KCPL = G::KSTR / 16, KNP = (64 * KCPL + 63) / 64;
    constexpr int VCPL = VSTR / 16, VNP = 64 * VCPL / 64;
    constexpr int KPP = (KNP + 7) / 8, VPP = (VNP + 7) / 8;
    ATT_LAS unsigned* dmaL = (ATT_LAS unsigned*)(lds + NS * G::KBUF + NS * G::VBUF + 2048) + wid * 256 + lane;
#pragma unroll
    for (int pp = 0; pp < KPP; ++pp) { const int pc = wid + 8 * pp, c = pc * 64 + lane, row = (c / KCPL) & 63, ch = c % KCPL; dmaL[64 * pp] = (unsigned)(row * kpitch + (ch < G::CPR ? ch : 0) * 8) * 2u; }
#pragma unroll
    for (int pp = 0; pp < VPP; ++pp) { const int pc = wid + 8 * pp, c = pc * 64 + lane, row = (c / VCPL) & 63, ch = c % VCPL; dmaL[128 + 64 * pp] = (unsigned)(row * vpitch + (ch < 8 ? ch : 0) * 8) * 2u; }
    const unsigned ldsb = __builtin_amdgcn_readfirstlane((unsigned)(size_t)lds);
    const int kc = (KNP - 1 - wid) / 8 + 1, vc = (VNP - 1 - wid) / 8 + 1;
#define ATT_MOD3(x) (NS == 3 ? (x) - 3 * (((x) * 43) >> 7) : ((x) & 1))
#define ATT_DMA1(gptr, voff_, ldsaddr) do { unsigned keep_; asm volatile("s_mov_b32 %0, m0\n\ts_mov_b32 m0, %3\n\ts_nop 0\n\tglobal_load_lds_dwordx4 %1, %2\n\ts_mov_b32 m0, %0" \
            : "=&s"(keep_) : "v"(voff_), "s"(gptr), "s"(ldsaddr) : "memory"); } while (0)
#define ATT_DMA_K(t) do { const int t_ = (t); const char* kt_ = (const char*)(Kb + (size_t)t_ * 64 * kpitch); const unsigned d_ = ldsb + ATT_MOD3(t_) * G::KBUF + wid * 1024; \
        _Pragma("unroll") for (int pp = 0; pp < KPP; ++pp) { if (wid + 8 * pp < KNP) { const unsigned vo_ = dmaL[64 * pp]; ATT_DMA1(kt_, vo_, d_ + pp * 8192); } } } while (0)
#define ATT_DMA_V(t) do { const int t_ = (t); const char* vt_ = (const char*)(Vb + (size_t)t_ * 64 * vpitch); const unsigned d_ = ldsb + NS * G::KBUF + ATT_MOD3(t_) * G::VBUF + wid * 1024; \
        _Pragma("unroll") for (int pp = 0; pp < VPP; ++pp) { if (wid + 8 * pp < VNP) { const unsigned vo_ = dmaL[128 + 64 * pp]; ATT_DMA1(vt_, vo_, d_ + pp * 8192); } } } while (0)
#define ATT_WAITBAR(n) do { const int n_ = (n); \
        if (n_ == 0) asm volatile("s_waitcnt vmcnt(0) lgkmcnt(0)\n\ts_barrier" ::: "memory"); else if (n_ == 1) asm volatile("s_waitcnt vmcnt(1) lgkmcnt(0)\n\ts_barrier" ::: "memory"); \
        else if (n_ == 2) asm volatile("s_waitcnt vmcnt(2) lgkmcnt(0)\n\ts_barrier" ::: "memory"); else if (n_ == 3) asm volatile("s_waitcnt vmcnt(3) lgkmcnt(0)\n\ts_barrier" ::: "memory"); \
        else asm volatile("s_waitcnt vmcnt(4) lgkmcnt(0)\n\ts_barrier" ::: "memory"); } while (0)
    f32x16 o0, o1;
#pragma unroll
    for (int i = 0; i < 16; ++i) { o0[i] = 0.f; o1[i] = 0.f; }
    float mrun = -INFINITY, lsum = 0.f; float ls4[4] = {0.f, 0.f, 0.f, 0.f};
    const int koff = r32 * G::KSTR + hi * 16;
    const int voff = ((lane >> 5) * 4 + ((lane & 15) >> 2)) * VSTR + (((lane >> 4) & 1) * 16 + (lane & 3) * 4) * 2;
    const f32x16 zero16 = {0.f, 0.f, 0.f, 0.f, 0.f, 0.f, 0.f, 0.f, 0.f, 0.f, 0.f, 0.f, 0.f, 0.f, 0.f, 0.f};
#define ATT_QK(X0, X1, t) do { const ATT_LAS unsigned char* Kt = lds + ATT_MOD3(t) * G::KBUF + koff; \
        _Pragma("unroll") for (int kk = 0; kk < DQK / 16; ++kk) { \
            const bf16x8 a0 = *(const ATT_LAS bf16x8*)(Kt + kk * 32); const bf16x8 a1 = *(const ATT_LAS bf16x8*)(Kt + 32 * G::KSTR + kk * 32); \
            X0 = __builtin_amdgcn_mfma_f32_32x32x16_bf16(a0, qf[kk], kk ? X0 : zero16, 0, 0, 0); X1 = __builtin_amdgcn_mfma_f32_32x32x16_bf16(a1, qf[kk], kk ? X1 : zero16, 0, 0, 0); } } while (0)
#define ATT_FARSCALE() do { const float f_ = __builtin_amdgcn_exp2f(biasL[256]); _Pragma("unroll") for (int i = 0; i < 16; ++i) { o0[i] *= f_; o1[i] *= f_; } \
        ls4[0] *= f_; ls4[1] *= f_; ls4[2] *= f_; ls4[3] *= f_; } while (0)
#define ATT_SMPV(X0, X1, t) do { \
        float cadd = 0.f; \
        if (BAND) { const int delta = cc - (t); \
            if (delta >= 3) { if constexpr (!NOMAX) cadd = biasL[256]; } \
            else { const ATT_LAS float* bp = biasL + (64 * delta + (32 * (wid & 1) + r32) - 4 * hi + 128 - 63); \
                if (delta < 2) { _Pragma("unroll") for (int i = 0; i < 16; ++i) { const int kj = (i & 3) + 8 * (i >> 2); X0[i] += bp[63 - kj]; X1[i] += bp[31 - kj]; } } \
                else { const int relb = 64 * delta + (32 * (wid & 1) + r32) - 4 * hi + 128; \
                    _Pragma("unroll") for (int i = 0; i < 16; ++i) { const int kj = (i & 3) + 8 * (i >> 2); int i0 = relb - kj, i1 = relb - kj - 32; i0 = i0 > 256 ? 256 : i0; i1 = i1 > 256 ? 256 : i1; \
                        X0[i] += biasL[i0]; X1[i] += biasL[i1]; } } } } \
        if constexpr (NOMAX) { \
            _Pragma("unroll") for (int i = 0; i < 16; ++i) { X0[i] = __builtin_amdgcn_exp2f(X0[i]); X1[i] = __builtin_amdgcn_exp2f(X1[i]); ls4[i & 3] += X0[i] + X1[i]; } \
        } else { \
        const float mt = rowmax32(X0, X1) + cadd; \
        const float mnew = max2f(mrun, mt); \
        const float alpha = __builtin_amdgcn_exp2f(mrun - mnew); \
        const float msub = mnew - cadd; \
        mrun = mnew; \
        float psa[4] = {0.f, 0.f, 0.f, 0.f};   \
        _Pragma("unroll") for (int i = 0; i < 16; ++i) { X0[i] = __builtin_amdgcn_exp2f(X0[i] - msub); X1[i] = __builtin_amdgcn_exp2f(X1[i] - msub); psa[i & 3] += X0[i] + X1[i]; } \
        const float ps = (psa[0] + psa[1]) + (psa[2] + psa[3]); \
        lsum = lsum * alpha + ps; \
        _Pragma("unroll") for (int i = 0; i < 16; ++i) { o0[i] *= alpha; o1[i] *= alpha; } } \
        bf16x8 pf[2][2]; \
        _Pragma("unroll") for (int s = 0; s < 2; ++s) { u32x4 w0, w1; \
            w0.x = cvtpk(X0[8 * s + 0], X0[8 * s + 1]); w0.y = cvtpk(X0[8 * s + 2], X0[8 * s + 3]); w0.z = cvtpk(X0[8 * s + 4], X0[8 * s + 5]); w0.w = cvtpk(X0[8 * s + 6], X0[8 * s + 7]); \
            w1.x = cvtpk(X1[8 * s + 0], X1[8 * s + 1]); w1.y = cvtpk(X1[8 * s + 2], X1[8 * s + 3]); w1.z = cvtpk(X1[8 * s + 4], X1[8 * s + 5]); w1.w = cvtpk(X1[8 * s + 6], X1[8 * s + 7]); \
            pf[0][s] = __builtin_bit_cast(bf16x8, w0); pf[1][s] = __builtin_bit_cast(bf16x8, w1); } \
        const ATT_LAS unsigned char* Vt = lds + NS * G::KBUF + ATT_MOD3(t) * G::VBUF + voff; \
        _Pragma("unroll") for (int kb = 0; kb < 2; ++kb) _Pragma("unroll") for (int s = 0; s < 2; ++s) { \
            const ATT_LAS unsigned char* vp = Vt + (32 * kb + 16 * s) * VSTR; \
            const s16x4 l0 = vtr(vp), h0 = vtr(vp + 8 * VSTR), l1 = vtr(vp + 64), h1 = vtr(vp + 8 * VSTR + 64); \
            const bf16x8 a0 = (bf16x8){l0[0], l0[1], l0[2], l0[3], h0[0], h0[1], h0[2], h0[3]}; \
            const bf16x8 a1 = (bf16x8){l1[0], l1[1], l1[2], l1[3], h1[0], h1[1], h1[2], h1[3]}; \
            o0 = __builtin_amdgcn_mfma_f32_32x32x16_bf16(a0, pf[kb][s], o0, 0, 0, 0); o1 = __builtin_amdgcn_mfma_f32_32x32x16_bf16(a1, pf[kb][s], o1, 0, 0, 0); } \
        if constexpr (NOMAX && BAND) { if (cc - (t) == 3) ATT_FARSCALE(); } } while (0)
#define ATT_FUSED(C0, C1, N0, N1, t, tn) do { \
        bf16x8 kfa[DQK / 16], kfb[DQK / 16]; \
        { const ATT_LAS unsigned char* Kt = lds + ATT_MOD3(tn) * G::KBUF + koff; \
          _Pragma("unroll") for (int kk = 0; kk < DQK / 16; ++kk) { kfa[kk] = *(const ATT_LAS bf16x8*)(Kt + kk * 32); kfb[kk] = *(const ATT_LAS bf16x8*)(Kt + 32 * G::KSTR + kk * 32); } } \
        if constexpr (!NOMAX) __builtin_amdgcn_sched_barrier(0); \
        float cadd = 0.f; \
        if (BAND) { const int delta = cc - (t); \
            if (delta >= 3) { if constexpr (!NOMAX) cadd = biasL[256]; } \
            else { const ATT_LAS float* bp = biasL + (64 * delta + (32 * (wid & 1) + r32) - 4 * hi + 128 - 63); \
                if (delta < 2) { _Pragma("unroll") for (int i = 0; i < 16; ++i) { const int kj = (i & 3) + 8 * (i >> 2); C0[i] += bp[63 - kj]; C1[i] += bp[31 - kj]; } } \
                else { const int relb = 64 * delta + (32 * (wid & 1) + r32) - 4 * hi + 128; \
                    _Pragma("unroll") for (int i = 0; i < 16; ++i) { const int kj = (i & 3) + 8 * (i >> 2); int i0 = relb - kj, i1 = relb - kj - 32; i0 = i0 > 256 ? 256 : i0; i1 = i1 > 256 ? 256 : i1; \
                        C0[i] += biasL[i0]; C1[i] += biasL[i1]; } } } } \
        float alpha = 1.f, msub = 0.f; \
        if constexpr (!NOMAX) { \
        const float mt = rowmax32(C0, C1) + cadd; \
        const float mnew = max2f(mrun, mt); \
        alpha = __builtin_amdgcn_exp2f(mrun - mnew); \
        msub = mnew - cadd; \
        if (__builtin_amdgcn_ballot_w64(mnew > mrun)) { _Pragma("unroll") for (int i = 0; i < 16; ++i) { o0[i] *= alpha; o1[i] *= alpha; } } \
        mrun = mnew; } \
        if constexpr (!NOMAX || BAND) __builtin_amdgcn_sched_barrier(0); \
        _Pragma("unroll") for (int kk = 0; kk < DQK / 16; ++kk) { \
            N0 = __builtin_amdgcn_mfma_f32_32x32x16_bf16(kfa[kk], qf[kk], kk ? N0 : zero16, 0, 0, 0); N1 = __builtin_amdgcn_mfma_f32_32x32x16_bf16(kfb[kk], qf[kk], kk ? N1 : zero16, 0, 0, 0); } \
        s16x4 vl0[4], vh0[4], vl1[4], vh1[4]; \
        { const ATT_LAS unsigned char* Vt = lds + NS * G::KBUF + ATT_MOD3(t) * G::VBUF + voff; \
          _Pragma("unroll") for (int ks = 0; ks < 4; ++ks) { const ATT_LAS unsigned char* vp = Vt + 16 * ks * VSTR; vl0[ks] = vtr(vp); vh0[ks] = vtr(vp + 8 * VSTR); vl1[ks] = vtr(vp + 64); vh1[ks] = vtr(vp + 8 * VSTR + 64); } } \
        if constexpr (NOMAX) { \
            _Pragma("unroll") for (int i = 0; i < 16; ++i) { C0[i] = __builtin_amdgcn_exp2f(C0[i]); C1[i] = __builtin_amdgcn_exp2f(C1[i]); ls4[i & 3] += C0[i] + C1[i]; } \
        } else { \
        float psa[4] = {0.f, 0.f, 0.f, 0.f}; \
        _Pragma("unroll") for (int i = 0; i < 16; ++i) { C0[i] = __builtin_amdgcn_exp2f(C0[i] - msub); C1[i] = __builtin_amdgcn_exp2f(C1[i] - msub); psa[i & 3] += C0[i] + C1[i]; } \
        const float ps = (psa[0] + psa[1]) + (psa[2] + psa[3]); \
        lsum = lsum * alpha + ps; } \
        bf16x8 pf[4]; \
        _Pragma("unroll") for (int s = 0; s < 2; ++s) { u32x4 w0, w1; \
            w0.x = cvtpk(C0[8 * s + 0], C0[8 * s + 1]); w0.y = cvtpk(C0[8 * s + 2], C0[8 * s + 3]); w0.z = cvtpk(C0[8 * s + 4], C0[8 * s + 5]); w0.w = cvtpk(C0[8 * s + 6], C0[8 * s + 7]); \
            w1.x = cvtpk(C1[8 * s + 0], C1[8 * s + 1]); w1.y = cvtpk(C1[8 * s + 2], C1[8 * s + 3]); w1.z = cvtpk(C1[8 * s + 4], C1[8 * s + 5]); w1.w = cvtpk(C1[8 * s + 6], C1[8 * s + 7]); \
            pf[s] = __builtin_bit_cast(bf16x8, w0); pf[2 + s] = __builtin_bit_cast(bf16x8, w1); } \
        __builtin_amdgcn_sched_barrier(0); \
        _Pragma("unroll") for (int ks = 0; ks < 4; ++ks) { \
            const bf16x8 a0 = (bf16x8){vl0[ks][0], vl0[ks][1], vl0[ks][2], vl0[ks][3], vh0[ks][0], vh0[ks][1], vh0[ks][2], vh0[ks][3]}; \
            const bf16x8 a1 = (bf16x8){vl1[ks][0], vl1[ks][1], vl1[ks][2], vl1[ks][3], vh1[ks][0], vh1[ks][1], vh1[ks][2], vh1[ks][3]}; \
            o0 = __builtin_amdgcn_mfma_f32_32x32x16_bf16(a0, pf[ks], o0, 0, 0, 0); o1 = __builtin_amdgcn_mfma_f32_32x32x16_bf16(a1, pf[ks], o1, 0, 0, 0); } \
        if constexpr (NOMAX && BAND) { if (cc - (t) == 3) ATT_FARSCALE(); } } while (0)
#define ATT_STAGE(t) do { if ((t) + NS <= t_hi) ATT_DMA_K((t) + NS); if ((t) + NS - 1 <= t_hi) ATT_DMA_V((t) + NS - 1); } while (0)
#define ATT_NFL(t) (NS == 3 ? ((t) + 3 <= t_hi ? kc : 0) + ((t) + 2 <= t_hi ? vc : 0) : 0)
    f32x16 sa0, sa1, sb0, sb1;
    ATT_DMA_K(t_lo); ATT_DMA_V(t_lo);
    if (t_lo + 1 <= t_hi) { ATT_DMA_K(t_lo + 1); if (NS == 3) ATT_DMA_V(t_lo + 1); }
    if (NS == 3) { if (t_lo + 2 <= t_hi) ATT_DMA_K(t_lo + 2); }
    ATT_WAITBAR(0);
    if (my_lo == t_lo) ATT_QK(sa0, sa1, t_lo);
    ATT_WAITBAR(0);
    {
        int t = t_lo;
        for (; t < my_lo - 1; ++t) { ATT_STAGE(t); ATT_WAITBAR(ATT_NFL(t)); }
        if (my_lo > t_lo) { ATT_STAGE(t); ATT_QK(sa0, sa1, t + 1); ATT_WAITBAR(ATT_NFL(t)); ++t; }
        int nf = my_hi - my_lo;
        for (; nf >= 2; nf -= 2, t += 2) {
            ATT_STAGE(t); ATT_FUSED(sa0, sa1, sb0, sb1, t, t + 1); ATT_WAITBAR(ATT_NFL(t));
            ATT_STAGE(t + 1); ATT_FUSED(sb0, sb1, sa0, sa1, t + 1, t + 2); ATT_WAITBAR(ATT_NFL(t + 1));
        }
        if (nf == 1) {
            ATT_STAGE(t); ATT_FUSED(sa0, sa1, sb0, sb1, t, t + 1); ATT_WAITBAR(ATT_NFL(t)); ++t;
            ATT_STAGE(t); ATT_SMPV(sb0, sb1, t); ATT_WAITBAR(ATT_NFL(t)); ++t;
        } else {
            ATT_STAGE(t); ATT_SMPV(sa0, sa1, t); ATT_WAITBAR(ATT_NFL(t)); ++t;
        }
        for (; t <= t_hi; ++t) { ATT_STAGE(t); ATT_WAITBAR(ATT_NFL(t)); }
    }
    if constexpr (NOMAX) lsum = (ls4[0] + ls4[1]) + (ls4[2] + ls4[3]);
    const float ltot = xhalf_sum(lsum);
    const float inv = 1.f / ltot;
    if constexpr (OF8) {
        unsigned char* op = (unsigned char*)Ob + (size_t)(q0 + wid * 32 + r32) * opitch + 4 * hi; const float i64 = inv * 32.f;
#pragma unroll
        for (int g4 = 0; g4 < 4; ++g4) {
            int w0 = 0, w1 = 0;
            w0 = __builtin_amdgcn_cvt_pk_fp8_f32(o0[4 * g4 + 0] * i64, o0[4 * g4 + 1] * i64, w0, false); w0 = __builtin_amdgcn_cvt_pk_fp8_f32(o0[4 * g4 + 2] * i64, o0[4 * g4 + 3] * i64, w0, true);
            w1 = __builtin_amdgcn_cvt_pk_fp8_f32(o1[4 * g4 + 0] * i64, o1[4 * g4 + 1] * i64, w1, false); w1 = __builtin_amdgcn_cvt_pk_fp8_f32(o1[4 * g4 + 2] * i64, o1[4 * g4 + 3] * i64, w1, true);
            *(int*)(op + 8 * g4) = w0; *(int*)(op + 32 + 8 * g4) = w1;
        }
    } else {
    bf16* op = Ob + (size_t)(q0 + wid * 32 + r32) * opitch + 4 * hi;
#pragma unroll
    for (int g4 = 0; g4 < 4; ++g4) {
        u32x2 w0, w1;
        w0.x = cvtpk(o0[4 * g4 + 0] * inv, o0[4 * g4 + 1] * inv); w0.y = cvtpk(o0[4 * g4 + 2] * inv, o0[4 * g4 + 3] * inv);
        w1.x = cvtpk(o1[4 * g4 + 0] * inv, o1[4 * g4 + 1] * inv); w1.y = cvtpk(o1[4 * g4 + 2] * inv, o1[4 * g4 + 3] * inv);
        *(u32x2*)(op + 8 * g4) = w0; *(u32x2*)(op + 32 + 8 * g4) = w1;
    }
    }
#undef ATT_DMA_K
#undef ATT_DMA_V
#undef ATT_QK
#undef ATT_SMPV
#undef ATT_STAGE
#undef ATT_FUSED
#undef ATT_MOD3
#undef ATT_DMA1
#undef ATT_WAITBAR
#undef ATT_NFL
#undef ATT_FARSCALE
}
}
constexpr int NWAVES = 8;
constexpr int D = 1024, BATCH = 32, SEQ = 2048, M = BATCH * SEQ;
constexpr int NH = 16, QLORA = 384, KVLORA = 256, ROPE_D = 32, NOPE = 64, QKD = 96;
constexpr int NA = 768;
constexpr int FF = 2816, EFF = 3584, NE = 8;
constexpr float EPS = 1e-6f, LOG2E = 1.4426950408889634f;
constexpr int MAXP_HALF = 264, MAXP = 528;
constexpr size_t MiB = 1u << 20;
constexpr size_t WS_CTL = 0, CTL_ZERO_BYTES = 1 * MiB;
constexpr size_t WS_ROPE = 1 * MiB;
constexpr size_t WS_CNT = WS_ROPE + 256 * 1024;
constexpr size_t WS_PANELE = WS_CNT + 16 * 1024;
constexpr size_t WS_META = WS_PANELE + 4096;
constexpr size_t WS_TOKE = 2 * MiB;
constexpr size_t WS_TOKG = WS_TOKE + (size_t)M * 4;
constexpr size_t WS_SLOTTOK = WS_TOKG + (size_t)M * 8;
constexpr size_t WS_SLOTGATE = WS_SLOTTOK + (size_t)MAXP * 256 * 4;
constexpr size_t WS_PARTQA = 976 * MiB, WS_PART1 = 980 * MiB, WS_PART2 = 984 * MiB;
constexpr size_t WS_TOKRSTD = 4 * MiB;
constexpr size_t WS_SLOTRSTD = WS_TOKRSTD + (size_t)M * 4;
static_assert(WS_SLOTGATE + (size_t)MAXP * 256 * 4 <= WS_TOKRSTD && WS_SLOTRSTD + (size_t)MAXP * 256 * 4 <= 8 * MiB, "small arrays");
constexpr size_t WS_W = 8 * MiB;
constexpr size_t WS_WA = WS_W, WS_WUQ = WS_WA + (size_t)NA * D * 2, WS_WUKV = WS_WUQ + (size_t)1536 * QLORA * 2, WS_WO = WS_WUKV + (size_t)2048 * KVLORA * 2;
constexpr size_t WS_WF1 = WS_WO + (size_t)D * D * 2, WS_WF2 = WS_WF1 + (size_t)2 * FF * D * 2, WS_WKVQ = WS_WF2 + (size_t)D * FF * 2, WS_WBO = WS_WKVQ + (size_t)3 * D * D * 2;
constexpr size_t WS_WM1 = WS_WBO + (size_t)D * D * 2, WS_WM2 = WS_WM1 + (size_t)NE * 2 * EFF * D * 2, WS_WEND = WS_WM2 + (size_t)NE * D * EFF * 2;
constexpr size_t ARENA = 208 * MiB;
static_assert(WS_WEND <= ARENA, "weights fit under the arena");
constexpr size_t WS_XN = ARENA;
constexpr size_t WS_QA = ARENA + 128 * MiB;
constexpr size_t WS_Q = ARENA + 224 * MiB;
constexpr size_t WS_K = ARENA + 416 * MiB;
constexpr size_t WS_V = ARENA + 608 * MiB;
constexpr size_t WS_O = ARENA;
static_assert(WS_V + (size_t)M * D * 2 <= 1024 * MiB, "MLA arena");
constexpr size_t WS_XR1 = ARENA + 128 * MiB;
constexpr size_t WS_H = ARENA + 256 * MiB;
constexpr size_t WS_XR2 = ARENA;
constexpr size_t WS_X2B = ARENA + 608 * MiB;
constexpr size_t WS_KVQ2 = ARENA + 128 * MiB;
constexpr size_t WS_O2 = ARENA + 512 * MiB;
constexpr size_t WS_XR3 = ARENA + 132 * MiB;
constexpr size_t WS_XG = ARENA;
constexpr size_t WS_HM = ARENA + 264 * MiB;
constexpr size_t WS_END = WS_HM + (size_t)MAXP_HALF * 256 * EFF * 2;
static_assert(WS_XG + (size_t)MAXP * 256 * D <= WS_XR3 && WS_XR3 + (size_t)M * D * 2 <= WS_HM && WS_END <= 1024 * MiB && WS_H + (size_t)M * FF * 2 <= WS_X2B && WS_X2B + (size_t)M * D * 2 <= 976 * MiB && WS_O2 + (size_t)M * D <= WS_X2B, "arena");
constexpr int CW_BAR = 4096;
constexpr int RING_OFF = 0, RING_BYTES = 131072;
constexpr int P0_SCR = 128 * 33 * 4;
constexpr int LDSCTL_OFF = 8 * P0_SCR, MISC_OFF = LDSCTL_OFF + 320;
static_assert(LDSCTL_OFF >= RING_BYTES, "control words above every phase's scratch");
constexpr int LDS_BYTES = 147456;
static_assert(MISC_OFF + 128 <= LDS_BYTES, "LDS map");
static_assert(att::lds_bytes<96>() <= RING_BYTES, "attention scratch fits the ring region");

#define GAS __attribute__((address_space(1)))
#define LAS __attribute__((address_space(3)))
typedef unsigned short bf16;
typedef unsigned v4u __attribute__((ext_vector_type(4)));
typedef unsigned v2u __attribute__((ext_vector_type(2)));
typedef float f32x4 __attribute__((ext_vector_type(4)));
typedef GAS unsigned gu32;
#define RLX_AGENT __ATOMIC_RELAXED, __HIP_MEMORY_SCOPE_AGENT
#define LDS_WAIT() asm volatile("s_waitcnt lgkmcnt(0)" ::: "memory")
__device__ __forceinline__ unsigned f2bf(float f) { unsigned u = __builtin_bit_cast(unsigned, f); return (u + 0x7fffu + ((u >> 16) & 1u)) >> 16; }
__device__ __forceinline__ unsigned pk2(float lo, float hi) { return f2bf(lo) | (f2bf(hi) << 16); }
__device__ __forceinline__ float bflo(unsigned u) { return __builtin_bit_cast(float, u << 16); }
__device__ __forceinline__ float bfhi(unsigned u) { return __builtin_bit_cast(float, u & 0xffff0000u); }
__device__ __forceinline__ float wave_sum(float v) {
    v += swz_xor<1>(v); v += swz_xor<2>(v); v += swz_xor<4>(v); v += swz_xor<8>(v); v += swz_xor<16>(v);
    return xor32_sum(v);
}
__device__ __forceinline__ float wave_maxf(float v) {
    v = fmaxf(v, swz_xor<1>(v)); v = fmaxf(v, swz_xor<2>(v)); v = fmaxf(v, swz_xor<4>(v)); v = fmaxf(v, swz_xor<8>(v)); v = fmaxf(v, swz_xor<16>(v));
    return xor32_max(v);
}

#define XB_TMO      128
#define XB_XCNT(j)  (256  + 64 * (j))
#define XB_XSUB(j)  (1280 + 64 * (j))
#define XB_XGEN(j)  (2304 + 64 * (j))
#define XB_TOP      3328
#define XB_TOPGEN   3392
#define XCD_BAR_WORDS 3456
#define XB_SPIN_CAP (1u << 18)

__device__ __forceinline__ unsigned xb_ld(unsigned* p)              { return __hip_atomic_load(p, __ATOMIC_RELAXED, __HIP_MEMORY_SCOPE_AGENT); }
__device__ __forceinline__ unsigned xb_add(unsigned* p, unsigned v) { return __hip_atomic_fetch_add(p, v, __ATOMIC_RELAXED, __HIP_MEMORY_SCOPE_AGENT); }
__device__ __forceinline__ unsigned xb_xcc_id() { return (unsigned)__builtin_amdgcn_s_getreg((3 << 11) | 20) & 0xFu; }
#define XB_SPIN(cond, bar) do { unsigned _sp = 0; while (cond) { __builtin_amdgcn_s_sleep(1); \
    if ((++_sp & 255u) == 0u) { if (xb_ld(&(bar)[XB_TMO])) break; if (_sp > XB_SPIN_CAP) { atomicAdd(&(bar)[XB_TMO], 1u); break; } } } } while (0)

struct XcdBarrier {
    int t0;
    unsigned* bar; unsigned x;
    volatile LAS unsigned* st;
};

__device__ __forceinline__ XcdBarrier xcd_barrier_post(unsigned* bar, volatile LAS unsigned* st, int t0) {
    XcdBarrier b; b.t0 = t0; b.bar = bar; b.x = xb_xcc_id(); b.st = st;
    if (b.t0) (void)xb_add(&bar[XB_XCNT(b.x)], 1u);
    return b;
}
__device__ __forceinline__ void xcd_barrier_complete(unsigned* bar, unsigned x, unsigned& nloc, unsigned& nx) {
    const unsigned G = gridDim.x * gridDim.y * gridDim.z;
    unsigned sum, cnt, mine, sp = 0u;
    for (;;) {
        sum = 0u; cnt = 0u; mine = 0u;
#pragma unroll
        for (unsigned j = 0; j < 16; ++j) { const unsigned c = xb_ld(&bar[XB_XCNT(j)]); sum += c; cnt += (c > 0u) ? 1u : 0u; mine = (j == x) ? c : mine; }
        if (sum == G) break;
        __builtin_amdgcn_s_sleep(1);
        if ((++sp & 255u) == 0u) { if (xb_ld(&bar[XB_TMO])) break; if (sp > XB_SPIN_CAP) { atomicAdd(&bar[XB_TMO], 1u); break; } }
    }
    nloc = mine > 0u ? mine : 1u; nx = cnt > 0u ? cnt : 1u;
}

__device__ __forceinline__ void xcd_barrier(const XcdBarrier& b) {
    asm volatile("s_waitcnt vmcnt(0)" ::: "memory");
    __syncthreads();
    if (b.t0) {
        unsigned* bar = b.bar;
        __builtin_amdgcn_s_waitcnt(0);
        unsigned nloc = b.st[0], nx = b.st[1];
        if (nloc == 0u) { xcd_barrier_complete(bar, b.x, nloc, nx); b.st[0] = nloc; b.st[1] = nx; }
        const unsigned old = xb_add(&bar[XB_XSUB(b.x)], 1u);
        const unsigned gen = old / nloc;
        if (old + 1u == (gen + 1u) * nloc) {
            __builtin_amdgcn_fence(__ATOMIC_RELEASE, "agent");
            asm volatile("s_waitcnt vmcnt(0)" ::: "memory");
            const unsigned og = xb_add(&bar[XB_TOP], 1u);
            const unsigned tg = og / nx;
            if (og + 1u == (tg + 1u) * nx) xb_add(&bar[XB_TOPGEN], 1u);
            else XB_SPIN(xb_ld(&bar[XB_TOPGEN]) == tg, bar);
            __builtin_amdgcn_fence(__ATOMIC_ACQUIRE, "agent");
            xb_add(&bar[XB_XGEN(b.x)], 1u);
            asm volatile("s_waitcnt vmcnt(0)" ::: "memory");
        } else {
            XB_SPIN(xb_ld(&bar[XB_XGEN(b.x)]) == gen, bar);
            __builtin_amdgcn_fence(__ATOMIC_ACQUIRE, "agent");
            asm volatile("s_waitcnt vmcnt(0)" ::: "memory");
        }
    }
    __syncthreads();
}

struct Args { const float* in[27]; float* out; unsigned char* ws; };
enum { I_X = 0, I_ATTN_NORM, I_FFN_NORM, I_A_WDQ, I_A_GCQ, I_A_WUQ, I_A_WDKV, I_A_GCKV, I_A_WUKV, I_A_GQN, I_A_GKN, I_A_WO, I_KV_NORM, I_KV_WK, I_KV_WV, I_KV_GKN,
       I_B_WQ, I_B_GQN, I_B_RELB, I_B_WO, I_FFN_W1, I_FFN_W3, I_FFN_W2, I_MOE_ROUTER, I_MOE_W1, I_MOE_W3, I_MOE_W2 };

struct Frame {
    LAS unsigned char* lds;
    int wave, vcu, G;
};
typedef const __attribute__((address_space(4))) Args* KArgs;
__device__ __forceinline__ KArgs kargs() { KArgs p = (KArgs)__builtin_amdgcn_kernarg_segment_ptr(); asm volatile("" : "+s"(p)); return p; }
#define INP(i) (kargs()->in[i])
#define OUTP (kargs()->out)
#define WSP (kargs()->ws)
__device__ __forceinline__ int fresh(int v) { asm volatile("" : "+v"(v)); return v; }

__device__ __forceinline__ void tr_item(const float* W, int ldw, int K, int k0, int nsrc0, const float* gain, bf16* WT, int drow0, LAS float* scr, int lane) {
    const int c4 = lane & 7, r = lane >> 3;
    const GAS float* src = (const GAS float*)W + (size_t)(k0 + r) * ldw + nsrc0 + 4 * c4;
    f32x4 v[16];
#pragma unroll
    for (int i = 0; i < 16; ++i) v[i] = *(const GAS f32x4*)(src + (size_t)(8 * i) * ldw);
    if (gain) {
#pragma unroll
        for (int i = 0; i < 16; ++i) v[i] = v[i] * gain[k0 + 8 * i + r];
    }
#pragma unroll
    for (int i = 0; i < 16; ++i) { LAS float* d = scr + (8 * i + r) * 33 + 4 * c4; d[0] = v[i].x; d[1] = v[i].y; d[2] = v[i].z; d[3] = v[i].w; }
    LDS_WAIT(); asm volatile("" ::: "memory");
    const int c16 = lane >> 2;
#pragma unroll
    for (int j = 0; j < 8; ++j) { const int n = (lane & 3) + 4 * j; const LAS float* sp = scr + (8 * c16) * 33 + n;
        v4u o; o.x = pk2(sp[0 * 33], sp[1 * 33]); o.y = pk2(sp[2 * 33], sp[3 * 33]); o.z = pk2(sp[4 * 33], sp[5 * 33]); o.w = pk2(sp[6 * 33], sp[7 * 33]);
        *(GAS v4u*)(WT + (size_t)(drow0 + n) * K + k0 + 8 * c16) = o; }
    LDS_WAIT(); asm volatile("" ::: "memory");
}
__device__ __forceinline__ void tr_plain(const float* W, int K, int N, const float* gain, bf16* WT, int drow_off, LAS float* scr, int item, int lane) {
    const int nblk = N / 32, kb = item / nblk, nb = item % nblk;
    tr_item(W, N, K, 128 * kb, 32 * nb, gain, WT, drow_off + 32 * nb, scr, lane);
}
__device__ __forceinline__ void tr_gated(const float* W, int K, int N, const float* gain, bf16* WT, int half, LAS float* scr, int item, int lane) {
    const int nblk = N / 32, kb = item / nblk, nb = item % nblk, n0 = 32 * nb;
    tr_item(W, N, K, 128 * kb, n0, gain, WT, (n0 >> 7) * 256 + half * 128 + (n0 & 127), scr, lane);
}
__device__ __forceinline__ unsigned pk_fp8x4(float a, float b, float c, float d) { int w = 0; w = __builtin_amdgcn_cvt_pk_fp8_f32(a, b, w, false); w = __builtin_amdgcn_cvt_pk_fp8_f32(c, d, w, true); return (unsigned)w; }
__device__ __forceinline__ void tr_item_f8(const float* W, int ldw, int K, int k0, int nsrc0, const float* gain, unsigned char* WT, int drow0, LAS float* scr, int lane) {
    const int c4 = lane & 7, r = lane >> 3;
    const GAS float* src = (const GAS float*)W + (size_t)(k0 + r) * ldw + nsrc0 + 4 * c4;
    f32x4 v[16];
#pragma unroll
    for (int i = 0; i < 16; ++i) v[i] = *(const GAS f32x4*)(src + (size_t)(8 * i) * ldw);
#pragma unroll
    for (int i = 0; i < 16; ++i) v[i] = v[i] * (gain ? gain[k0 + 8 * i + r] * 64.f : 64.f);
#pragma unroll
    for (int i = 0; i < 16; ++i) { LAS float* d = scr + (8 * i + r) * 33 + 4 * c4; d[0] = v[i].x; d[1] = v[i].y; d[2] = v[i].z; d[3] = v[i].w; }
    LDS_WAIT(); asm volatile("" ::: "memory");
    const int c8 = lane >> 3;
#pragma unroll
    for (int j = 0; j < 4; ++j) { const int n = (lane & 7) + 8 * j; const LAS float* sp = scr + (16 * c8) * 33 + n;
        v4u o; o.x = pk_fp8x4(sp[0 * 33], sp[1 * 33], sp[2 * 33], sp[3 * 33]); o.y = pk_fp8x4(sp[4 * 33], sp[5 * 33], sp[6 * 33], sp[7 * 33]);
        o.z = pk_fp8x4(sp[8 * 33], sp[9 * 33], sp[10 * 33], sp[11 * 33]); o.w = pk_fp8x4(sp[12 * 33], sp[13 * 33], sp[14 * 33], sp[15 * 33]);
        *(GAS v4u*)(WT + (size_t)(drow0 + n) * K + k0 + 16 * c8) = o; }
    LDS_WAIT(); asm volatile("" ::: "memory");
}
__device__ __forceinline__ float rms_row_to_bf16(const float* xrow, bf16* orow, int lane, f32x4 (&v)[4]) {
    const GAS f32x4* xr = (const GAS f32x4*)xrow + lane;
    float s = 0.f;
#pragma unroll
    for (int j = 0; j < 4; ++j) { v[j] = xr[64 * j]; s += (v[j].x * v[j].x + v[j].y * v[j].y) + (v[j].z * v[j].z + v[j].w * v[j].w); }
    const float rstd = 1.f / sqrtf(wave_sum(s) * (1.f / D) + EPS);
    GAS unsigned long long* o8 = (GAS unsigned long long*)orow + lane;
#pragma unroll
    for (int j = 0; j < 4; ++j) o8[64 * j] = (unsigned long long)pk2(v[j].x * rstd, v[j].y * rstd) | ((unsigned long long)pk2(v[j].z * rstd, v[j].w * rstd) << 32);
    return rstd;
}
__device__ __forceinline__ void norm_phase(const Frame& F, const float* x, bf16* xn) {
    const int tid = fresh(F.wave * 64 + lane_id_()), lane = tid & 63; (void)lane;
    const int gw = F.vcu * NWAVES + F.wave, NGW = F.G * NWAVES;
    for (int m = 2 * gw; m < M; m += 2 * NGW) {
        const GAS f32x4* xr = (const GAS f32x4*)(x + (size_t)m * D) + lane;
        f32x4 v[8]; float s0 = 0.f, s1 = 0.f;
#pragma unroll
        for (int j = 0; j < 8; ++j) v[j] = xr[64 * j];
#pragma unroll
        for (int j = 0; j < 4; ++j) { s0 += (v[j].x * v[j].x + v[j].y * v[j].y) + (v[j].z * v[j].z + v[j].w * v[j].w); s1 += (v[4 + j].x * v[4 + j].x + v[4 + j].y * v[4 + j].y) + (v[4 + j].z * v[4 + j].z + v[4 + j].w * v[4 + j].w); }
        const float r0 = 1.f / sqrtf(wave_sum(s0) * (1.f / D) + EPS), r1 = 1.f / sqrtf(wave_sum(s1) * (1.f / D) + EPS);
        GAS unsigned* o4 = (GAS unsigned*)((GAS unsigned char*)xn + (size_t)m * D) + lane;
#pragma unroll
        for (int j = 0; j < 8; ++j) { const float rr = j < 4 ? r0 : r1; o4[64 * j] = pk_fp8x4(v[j].x * rr, v[j].y * rr, v[j].z * rr, v[j].w * rr); }
    }
}

__device__ __forceinline__ void p0_prologue(const Frame& F) {
    const int tid = fresh(F.wave * 64 + lane_id_()), lane = tid & 63; (void)lane;
    LAS float* scr = (LAS float*)(F.lds + RING_OFF + F.wave * P0_SCR);
    unsigned char* ws = WSP;
    const int gw = F.vcu * NWAVES + F.wave, NGW = F.G * NWAVES;
    constexpr int I_DQ = 8 * 12, I_DKV = 8 * 9, I_UQ = 3 * 48, I_UKV = 2 * 64, I_SQ = 8 * 32, I_F13 = 8 * 88, I_F2 = 22 * 32, I_M13 = 8 * 112, I_M2 = 28 * 32;
    constexpr int NSMALL = I_DQ + I_DKV + I_UQ + I_UKV + I_SQ + 2 * I_F13 + I_F2 + 4 * I_SQ;
    constexpr int NITEMS = NSMALL + NE * (2 * I_M13 + I_M2);
    for (int it = gw; it < NITEMS; it += NGW) {
        int r = it;
        if (r < I_DQ)  { const int kb = r / 12, n0 = 32 * (r % 12); tr_item_f8(INP(I_A_WDQ), QLORA, D, 128 * kb, n0, INP(I_ATTN_NORM), ws + WS_WA, n0, scr, lane); continue; } r -= I_DQ;
        if (r < I_DKV) { const int kb = r / 9, n0 = 32 * (r % 9); tr_item_f8(INP(I_A_WDKV), KVLORA + ROPE_D, D, 128 * kb, n0, INP(I_ATTN_NORM), ws + WS_WA, QLORA + n0, scr, lane); continue; } r -= I_DKV;
        if (r < I_UQ)  { tr_plain(INP(I_A_WUQ), QLORA, NH * QKD, INP(I_A_GCQ), (bf16*)(ws + WS_WUQ), 0, scr, r, lane); continue; } r -= I_UQ;
        if (r < I_UKV) { const int kb = r / 64, n0 = 32 * (r % 64), head = n0 >> 7, within = n0 & 127;
            const int drow = within < 64 ? 256 * (head >> 2) + 128 * (within >> 5) + 32 * (head & 3) : 1024 + head * 64 + (within - 64);
            tr_item(INP(I_A_WUKV), NH * 128, KVLORA, 128 * kb, n0, INP(I_A_GCKV), (bf16*)(ws + WS_WUKV), drow, scr, lane); continue; } r -= I_UKV;
        if (r < I_SQ)  { const int kb = r / 32, n0 = 32 * (r % 32); tr_item_f8(INP(I_A_WO), D, D, 128 * kb, n0, nullptr, ws + WS_WO, n0, scr, lane); continue; } r -= I_SQ;
        if (r < I_F13) { tr_gated(INP(I_FFN_W1), D, FF, INP(I_FFN_NORM), (bf16*)(ws + WS_WF1), 0, scr, r, lane); continue; } r -= I_F13;
        if (r < I_F13) { tr_gated(INP(I_FFN_W3), D, FF, INP(I_FFN_NORM), (bf16*)(ws + WS_WF1), 1, scr, r, lane); continue; } r -= I_F13;
        if (r < I_F2)  { tr_plain(INP(I_FFN_W2), FF, D, nullptr, (bf16*)(ws + WS_WF2), 0, scr, r, lane); continue; } r -= I_F2;
        if (r < I_SQ)  { const int kb = r / 32, n0 = 32 * (r % 32), head = n0 >> 6;
            tr_item_f8(INP(I_KV_WK), D, D, 128 * kb, n0, INP(I_KV_NORM), ws + WS_WKVQ, 256 * (head >> 2) + 128 * ((n0 >> 5) & 1) + 32 * (head & 3), scr, lane); continue; } r -= I_SQ;
        if (r < I_SQ)  { const int kb = r / 32, n0 = 32 * (r % 32); tr_item_f8(INP(I_KV_WV), D, D, 128 * kb, n0, INP(I_KV_NORM), ws + WS_WKVQ, 2 * D + n0, scr, lane); continue; } r -= I_SQ;
        if (r < I_SQ)  { const int kb = r / 32, n0 = 32 * (r % 32), head = n0 >> 6;
            tr_item_f8(INP(I_B_WQ), D, D, 128 * kb, n0, INP(I_ATTN_NORM) + D, ws + WS_WKVQ, D + 256 * (head >> 2) + 128 * ((n0 >> 5) & 1) + 32 * (head & 3), scr, lane); continue; } r -= I_SQ;
        if (r < I_SQ)  { const int kb = r / 32, n0 = 32 * (r % 32); tr_item_f8(INP(I_B_WO), D, D, 128 * kb, n0, nullptr, ws + WS_WBO, n0, scr, lane); continue; } r -= I_SQ;
        const int e = r / (2 * I_M13 + I_M2); r -= e * (2 * I_M13 + I_M2);
        if (r < I_M13) { const int kb = r / 112, n0 = 32 * (r % 112);
            tr_item_f8(INP(I_MOE_W1) + (size_t)e * D * EFF, EFF, D, 128 * kb, n0, INP(I_FFN_NORM) + D, ws + WS_WM1 + (size_t)e * 2 * EFF * D, (n0 >> 7) * 256 + (n0 & 127), scr, lane); continue; } r -= I_M13;
        if (r < I_M13) { const int kb = r / 112, n0 = 32 * (r % 112);
            tr_item_f8(INP(I_MOE_W3) + (size_t)e * D * EFF, EFF, D, 128 * kb, n0, INP(I_FFN_NORM) + D, ws + WS_WM1 + (size_t)e * 2 * EFF * D, (n0 >> 7) * 256 + 128 + (n0 & 127), scr, lane); continue; } r -= I_M13;
        { const int kb = r / 32, n0 = 32 * (r % 32); tr_item_f8(INP(I_MOE_W2) + (size_t)e * EFF * D, D, EFF, 128 * kb, n0, nullptr, ws + WS_WM2 + (size_t)e * D * EFF, n0, scr, lane); }
    }
    const int gt = F.vcu * (NWAVES * 64) + tid, NGT = F.G * NWAVES * 64;
    for (int c = gt; c < 96 * D / 16; c += NGT) *((GAS v4u*)(ws + WS_WA + (size_t)(QLORA + KVLORA + ROPE_D) * D) + c) = (v4u){0u, 0u, 0u, 0u};
    for (int c = gt; c < SEQ * 16; c += NGT) { const int pos = c >> 4, i = c & 15;
        const float inv = __builtin_amdgcn_exp2f(-(float)i * (13.287712379549449f / 16.f));
        const float rev = (float)pos * inv * 0.15915494309189535f; const float fr = rev - floorf(rev);
        ((GAS float*)(ws + WS_ROPE))[2 * c] = __builtin_amdgcn_cosf(fr); ((GAS float*)(ws + WS_ROPE))[2 * c + 1] = __builtin_amdgcn_sinf(fr); }
    norm_phase(F, INP(I_X), (bf16*)(ws + WS_XN));
}

__device__ __forceinline__ void route_phase(const Frame& F) {
    const int tid = fresh(F.wave * 64 + lane_id_()), lane = tid & 63;
    unsigned char* ws = WSP;
    LAS float* wrg = (LAS float*)(F.lds + RING_OFF);
    LAS int* cnt = (LAS int*)(F.lds + RING_OFF + 32768);
    const float* wr = INP(I_MOE_ROUTER); const float* g = INP(I_FFN_NORM) + D;
    for (int idx = tid; idx < D * NE; idx += NWAVES * 64) { const int k = idx >> 3, e = idx & 7, l = k >> 4, i = k & 15;
        wrg[((i * 2) + (e >> 2)) * 256 + 4 * l + (e & 3)] = wr[idx] * g[k]; }
    __syncthreads();
    const int b5 = (lane >> 5) & 1, b4 = (lane >> 4) & 1, b3 = (lane >> 3) & 1;
    for (int c = F.vcu; c < M / 256; c += F.G) {
        if (tid < 16) cnt[tid] = 0;
        __syncthreads();
        v4u vn[2];
        { const GAS v4u* xr = (const GAS v4u*)(ws + WS_XR3 + (size_t)(c * 256 + F.wave * 32) * D * 2) + 2 * lane; vn[0] = xr[0]; vn[1] = xr[1]; }
        for (int i = 0; i < 32; ++i) {
            const int m = c * 256 + F.wave * 32 + i;
            const v4u q0 = vn[0], q1 = vn[1];
            if (i + 1 < 32) { const GAS v4u* xr = (const GAS v4u*)(ws + WS_XR3 + (size_t)(m + 1) * D * 2) + 2 * lane; vn[0] = xr[0]; vn[1] = xr[1]; }
            const unsigned qw[8] = {q0.x, q0.y, q0.z, q0.w, q1.x, q1.y, q1.z, q1.w};
            float xv[16]; float ssx = 0.f;
#pragma unroll
            for (int j = 0; j < 8; ++j) { xv[2 * j] = bflo(qw[j]); xv[2 * j + 1] = bfhi(qw[j]); }
#pragma unroll
            for (int j = 0; j < 16; j += 4) ssx += (xv[j] * xv[j] + xv[j + 1] * xv[j + 1]) + (xv[j + 2] * xv[j + 2] + xv[j + 3] * xv[j + 3]);
            float lg[8];
#pragma unroll
            for (int e = 0; e < 8; ++e) lg[e] = 0.f;
#pragma unroll
            for (int j = 0; j < 16; ++j) { const float x1 = xv[j];
                const f32x4 w0 = *(const LAS f32x4*)(wrg + (j * 2) * 256 + 4 * lane), w1 = *(const LAS f32x4*)(wrg + (j * 2 + 1) * 256 + 4 * lane);
                lg[0] += x1 * w0.x; lg[1] += x1 * w0.y; lg[2] += x1 * w0.z; lg[3] += x1 * w0.w; lg[4] += x1 * w1.x; lg[5] += x1 * w1.y; lg[6] += x1 * w1.z; lg[7] += x1 * w1.w; }
            float r4[4], r2[2], r1;
#pragma unroll
            for (int e = 0; e < 4; ++e) { const float mine = b5 ? lg[4 + e] : lg[e], other = b5 ? lg[e] : lg[4 + e]; r4[e] = mine + xor32_partner(other, b5); }
#pragma unroll
            for (int e = 0; e < 2; ++e) { const float mine = b4 ? r4[2 + e] : r4[e], other = b4 ? r4[e] : r4[2 + e]; r2[e] = mine + swz_xor<16>(other); }
            { const float mine = b3 ? r2[1] : r2[0], other = b3 ? r2[0] : r2[1]; r1 = mine + swz_xor<8>(other); }
            r1 += swz_xor<4>(r1); r1 += swz_xor<2>(r1); r1 += swz_xor<1>(r1);
            const float rstd = 1.f / sqrtf(wave_sum(ssx) * (1.f / D) + EPS);
#pragma unroll
            for (int e = 0; e < 8; ++e) lg[e] = __builtin_bit_cast(float, __builtin_amdgcn_readlane(__builtin_bit_cast(int, r1), 8 * e)) * rstd;
            int e1 = 0; float l1 = lg[0];
#pragma unroll
            for (int e = 1; e < 8; ++e) if (lg[e] > l1) { l1 = lg[e]; e1 = e; }
            int e2 = -1; float l2 = -INFINITY;
#pragma unroll
            for (int e = 0; e < 8; ++e) if (e != e1 && lg[e] > l2) { l2 = lg[e]; e2 = e; }
            const float g1 = 1.f / (1.f + __expf(l2 - l1)), g2 = 1.f - g1;
            const int elo = e1 < e2 ? e1 : e2, ehi = e1 < e2 ? e2 : e1;
            const float glo = e1 < e2 ? g1 : g2, ghi = e1 < e2 ? g2 : g1;
            if (lane == 0) { ((GAS float*)(ws + WS_TOKRSTD))[m] = rstd; ((GAS int*)(ws + WS_TOKE))[m] = elo | (ehi << 8); ((GAS float*)(ws + WS_TOKG))[2 * m] = glo; ((GAS float*)(ws + WS_TOKG))[2 * m + 1] = ghi;
                atomicAdd((int*)&cnt[elo], 1); atomicAdd((int*)&cnt[8 + ehi], 1); }
        }
        __syncthreads();
        if (tid < 16) ((GAS int*)(ws + WS_CNT))[c * 16 + tid] = cnt[tid];
        __syncthreads();
    }
}

__device__ __forceinline__ void slot_phase(const Frame& F, unsigned char* ws) {
    const int tid = fresh(F.wave * 64 + lane_id_()), lane = tid & 63; (void)lane;
    LAS int* call = (LAS int*)(F.lds + RING_OFF);
    LAS int* tot = call + 4096; LAS int* base = tot + 16; LAS int* pre = base + 16; LAS int* meta = pre + 16;
    LAS int* grp = meta + 16;
    LAS int* slot_of = grp + 512;
    for (int idx = tid; idx < 4096; idx += NWAVES * 64) call[idx] = ((const GAS int*)(ws + WS_CNT))[idx];
    __syncthreads();
    if (tid < 16) { int t = 0; for (int cc = 0; cc < 256; ++cc) t += call[cc * 16 + tid]; tot[tid] = t; }
    __syncthreads();
    if (tid == 0) { int off = 0; for (int g = 0; g < 16; ++g) { base[g] = off; off += (tot[g] + 255) & ~255; if (g == 7) meta[0] = off >> 8; } meta[1] = (off >> 8) - meta[0]; }
    __syncthreads();
    for (int c = F.vcu; c < M / 256; c += F.G) {
        if (tid < 16) { int p = 0; for (int cc = 0; cc < c; ++cc) p += call[cc * 16 + tid]; pre[tid] = p; }
        const int hf = tid >> 8, i = tid & 255, m = c * 256 + i;
        const int te = ((const GAS int*)(ws + WS_TOKE))[m];
        const int g = hf * 8 + (hf ? ((te >> 8) & 0xff) : (te & 0xff));
        grp[tid] = g;
        __syncthreads();
        int rank = 0;
        for (int j = 0; j < i; ++j) rank += (grp[hf * 256 + j] == g) ? 1 : 0;
        const int slot = base[g] + pre[g] + rank;
        ((GAS int*)(ws + WS_SLOTTOK))[slot] = m; ((GAS float*)(ws + WS_SLOTGATE))[slot] = ((const GAS float*)(ws + WS_TOKG))[2 * m + hf];
        slot_of[tid] = slot;
        __syncthreads();
        for (int i0 = F.wave; i0 < 256; i0 += 4 * NWAVES) {
            v4u x[4][2]; float rs[4];
#pragma unroll
            for (int k = 0; k < 4; ++k) { const int mm = c * 256 + i0 + 8 * k; const GAS v4u* src = (const GAS v4u*)(ws + WS_XR3 + (size_t)mm * D * 2);
                x[k][0] = src[2 * lane]; x[k][1] = src[2 * lane + 1]; rs[k] = ((const GAS float*)(ws + WS_TOKRSTD))[mm]; }
#pragma unroll
            for (int k = 0; k < 4; ++k) { const int i = i0 + 8 * k; const v4u x0 = x[k][0], x1 = x[k][1]; const float r = rs[k];
                const v4u o = (v4u){pk_fp8x4(bflo(x0.x) * r, bfhi(x0.x) * r, bflo(x0.y) * r, bfhi(x0.y) * r), pk_fp8x4(bflo(x0.z) * r, bfhi(x0.z) * r, bflo(x0.w) * r, bfhi(x0.w) * r),
                                    pk_fp8x4(bflo(x1.x) * r, bfhi(x1.x) * r, bflo(x1.y) * r, bfhi(x1.y) * r), pk_fp8x4(bflo(x1.z) * r, bfhi(x1.z) * r, bflo(x1.w) * r, bfhi(x1.w) * r)};
                ((GAS v4u*)(ws + WS_XG + (size_t)slot_of[i] * D))[lane] = o; ((GAS v4u*)(ws + WS_XG + (size_t)slot_of[256 + i] * D))[lane] = o; }
        }
        __syncthreads();
    }
    for (int g = F.vcu; g < 16; g += F.G) {
        const int s0 = base[g] + tot[g], s1 = base[g] + ((tot[g] + 255) & ~255);
        for (int s = s0 + F.wave; s < s1; s += NWAVES) { GAS v4u* dst = (GAS v4u*)(ws + WS_XG + (size_t)s * D);
            dst[lane] = (v4u){0u, 0u, 0u, 0u};
            if (lane == 0) { ((GAS int*)(ws + WS_SLOTTOK))[s] = -1; ((GAS float*)(ws + WS_SLOTGATE))[s] = 0.f; } }
    }
    if (F.vcu == 0) {
        if (tid < 16) { const int p0 = base[tid] >> 8, p1 = (base[tid] + ((tot[tid] + 255) & ~255)) >> 8; for (int p = p0; p < p1; ++p) ((GAS int*)(ws + WS_PANELE))[p] = tid & 7; }
        if (tid == 0) { ((GAS int*)(ws + WS_META))[0] = meta[0]; ((GAS int*)(ws + WS_META))[1] = meta[1]; }
        if (tid < 16) ((GAS int*)(ws + WS_META))[2 + tid] = base[tid] >> 8;
        if (tid == 0) { const int nPA = meta[0], nPB = meta[1]; int x = nPB > 256 ? nPB - 256 : 0;
            if (x > 0 && nPA > 256) { int LA = 0, HB = 7;
                for (int g = 0; g < 8; ++g) { const int q0 = base[g] >> 8, q1 = q0 + ((tot[g] + 255) >> 8); if (q0 <= 256 && 256 < q1) LA = g; }
                for (int g = 8; g < 16; ++g) { const int q0 = base[g] >> 8, q1 = q0 + ((tot[g] + 255) >> 8), P = nPA + x - 1; if (q0 <= P && P < q1) HB = g - 8; }
                if (LA < HB) x = 0; }
            ((GAS int*)(ws + WS_META))[18] = x; }
    }
    __syncthreads();
}

__global__ void __launch_bounds__(NWAVES * 64, 2) yoco_fwd(Args args) {
    extern __shared__ __attribute__((aligned(16))) unsigned char lds_raw[];
    Frame F;
    F.lds = (LAS unsigned char*)lds_raw;
    F.wave = __builtin_amdgcn_readfirstlane((int)threadIdx.x >> 6);
    F.G = gridDim.x; { const int bx = blockIdx.x; F.vcu = (F.G % 8 == 0) ? (bx % 8) * (F.G / 8) + bx / 8 : bx; }
    unsigned char* ws = WSP;
    volatile LAS unsigned* MISC = (volatile LAS unsigned*)(F.lds + MISC_OFF);
    for (int u = fresh((int)threadIdx.x); u < (LDS_BYTES - LDSCTL_OFF) / 4; u += NWAVES * 64) ((LAS unsigned*)(F.lds + LDSCTL_OFF))[u] = 0u;
    __syncthreads();
    (void)xcd_barrier_post((unsigned*)(ws + WS_CTL) + CW_BAR, MISC + 8, (F.wave == 0 && lane_id_() == 0) ? 1 : 0);
    LAS unsigned char* ring = F.lds + RING_OFF;
#define bid ((int)blockIdx.x)
#define GRID_BAR() do { XcdBarrier b_; b_.t0 = (F.wave == 0 && lane_id_() == 0) ? 1 : 0; b_.bar = (unsigned*)(WSP + WS_CTL) + CW_BAR; b_.x = xb_xcc_id(); b_.st = (volatile LAS unsigned*)(F.lds + MISC_OFF) + 8; xcd_barrier(b_); } while (0)
#define GEMM(EpiT, SchedT) pg8::gemm_phase<EpiT, SchedT, true, true>

    p0_prologue(F);
    GRID_BAR();
    { pg8::Gemm g{(const bf16*)(ws + WS_XN), (const bf16*)(ws + WS_WA), M, NA, D / 2, D / 2}; pg8::StaticOrder S; S.init(M, NA, F.G, bid);
      pg8::EpiQA E{(bf16*)(ws + WS_QA), (float*)(ws + WS_PARTQA), 1.f / 64};
      pg8::gemm_phase<pg8::EpiQA, pg8::StaticOrder, true, true, true>(ring, g, S, E, F.wave); }
    GRID_BAR();
    { pg8::Gemm g{(const bf16*)(ws + WS_QA), (const bf16*)(ws + WS_WUQ), M, NH * QKD, QLORA, NA}; pg8::StaticOrder S; S.init(M, NH * QKD, F.G, bid);
      pg8::EpiRowScaleBf16 E{(bf16*)(ws + WS_Q), NH * QKD, (const float*)(ws + WS_PARTQA), 1.f / QLORA};
      GEMM(pg8::EpiRowScaleBf16, pg8::StaticOrder)(ring, g, S, E, F.wave); }
    { pg8::Gemm g{(const bf16*)(ws + WS_QA) + QLORA, (const bf16*)(ws + WS_WUKV), M, NH * 128, KVLORA, NA}; pg8::StaticOrder S; S.init(M, NH * 128, F.G, bid);
      pg8::EpiKVup E{(bf16*)(ws + WS_K), (bf16*)(ws + WS_V), (const float*)(ws + WS_PARTQA), (const bf16*)(ws + WS_QA), INP(I_A_GKN), (const float*)(ws + WS_ROPE)};
      GEMM(pg8::EpiKVup, pg8::StaticOrder)(ring, g, S, E, F.wave); }
    GRID_BAR();
    bool fastA;
    { float bq = 0.f, bk = 0.f; const int l_ = lane_id_(); for (int i = l_; i < QKD; i += 64) { bq = fmaxf(bq, fabsf(INP(I_A_GQN)[i])); bk = fmaxf(bk, fabsf(INP(I_A_GKN)[i])); }
      bq = wave_maxf(bq); bk = wave_maxf(bk); fastA = __builtin_amdgcn_readfirstlane((int)(14.42f * bq * bk <= 40.f)) != 0; }
#define P5_UNIT(NM) att::attn_unit<96, false, 1536, 1536, D, D, true, NM, 2>(ring, (const bf16*)(ws + WS_Q) + (size_t)b * SEQ * 1536 + h * QKD, (const bf16*)(ws + WS_K) + (size_t)b * SEQ * 1536 + h * QKD, \
                                      (const bf16*)(ws + WS_V) + (size_t)b * SEQ * D + h * 64, (bf16*)(ws + WS_O + (size_t)b * SEQ * D + h * 64), \
                                      256 * qb, 0, 4 * qb + 3, 0, 4 * qb + (F.wave >> 1), 0, nullptr, INP(I_A_GQN), (const float*)(ws + WS_ROPE), F.wave)
    for (int p = F.vcu; p < BATCH * NH * 4; p += F.G) {
        const int bh = p >> 2, pid = p & 3, b = bh >> 4, h = bh & 15;
        for (int u2 = 0; u2 < 2; ++u2) {
            const int qb = u2 ? 7 - pid : pid;
            if (fastA) P5_UNIT(true); else P5_UNIT(false);
        }
    }
    GRID_BAR();
    { pg8::Gemm g{(const bf16*)(ws + WS_O), (const bf16*)(ws + WS_WO), M, D, D / 2, D / 2}; pg8::StaticOrder S; S.init(M, D, F.G, bid);
      pg8::EpiResStream<true, false, false> E{INP(I_X), (bf16*)(ws + WS_XR1), nullptr, (float*)(ws + WS_PART1), 1.f / 2048};
      pg8::gemm_phase<pg8::EpiResStream<true, false, false>, pg8::StaticOrder, true, true, true>(ring, g, S, E, F.wave); }
    GRID_BAR();
    { pg8::Gemm g{(const bf16*)(ws + WS_XR1), (const bf16*)(ws + WS_WF1), M, 2 * FF, D, D}; pg8::StaticOrder S; S.init(M, 2 * FF, F.G, bid);
      pg8::EpiGated<true> E{(bf16*)(ws + WS_H), FF, 0, (const float*)(ws + WS_PART1)};
      GEMM(pg8::EpiGated<true>, pg8::StaticOrder)(ring, g, S, E, F.wave); }
    GRID_BAR();
    { pg8::Gemm g{(const bf16*)(ws + WS_H), (const bf16*)(ws + WS_WF2), M, D, FF, FF}; pg8::StaticOrder S; S.init(M, D, F.G, bid);
      pg8::EpiResStream<true, true, true> E{ws + WS_XR1, (bf16*)(ws + WS_X2B), ws + WS_XR2, (float*)(ws + WS_PART2), 1.f};
      pg8::gemm_phase<pg8::EpiResStream<true, true, true>, pg8::StaticOrder, true, true>(ring, g, S, E, F.wave); }
    GRID_BAR();
    { pg8::Gemm g{(const bf16*)(ws + WS_XR2), (const bf16*)(ws + WS_WKVQ), M, 2 * D, D / 2, D / 2}; pg8::StaticOrder S; S.init(M, 2 * D, F.G, bid);
      pg8::EpiK2Q2 E{(bf16*)(ws + WS_KVQ2), (const float*)(ws + WS_PART2), INP(I_KV_GKN), INP(I_B_GQN), 1.f / 64};
      pg8::gemm_phase<pg8::EpiK2Q2, pg8::StaticOrder, true, true, true>(ring, g, S, E, F.wave); }
    { pg8::Gemm g{(const bf16*)(ws + WS_XR2), (const bf16*)(ws + WS_WKVQ + (size_t)2 * D * D), M, D, D / 2, D / 2}; pg8::StaticOrder S; S.init(M, D, F.G, bid);
      pg8::EpiRowScale16 E{(bf16*)(ws + WS_KVQ2), 3 * D, D, (const float*)(ws + WS_PART2), 1.f / 64};
      pg8::gemm_phase<pg8::EpiRowScale16, pg8::StaticOrder, true, true, true>(ring, g, S, E, F.wave); }
    GRID_BAR();
    bool fastB;
    { float bq = 0.f, bk = 0.f, bb = 0.f; const int l_ = lane_id_(); bq = fabsf(INP(I_B_GQN)[l_]); bk = fabsf(INP(I_KV_GKN)[l_]);
      for (int i = l_; i < NH * 257; i += 64) bb = fmaxf(bb, fabsf(INP(I_B_RELB)[i]));
      bq = wave_maxf(bq); bk = wave_maxf(bk); bb = wave_maxf(bb); fastB = __builtin_amdgcn_readfirstlane((int)(11.78f * bq * bk + 1.4427f * bb <= 40.f)) != 0; }
    for (int p = F.vcu; p < BATCH * NH * 8; p += F.G) {
        const int bh = p >> 3, cb = ((p & 7) + (p >> 8)) & 7, b = bh >> 4, h = bh & 15;
        const int c0 = 4 * cb, cc = c0 + (F.wave >> 1);
        const bf16* base = (const bf16*)(ws + WS_KVQ2) + (size_t)b * SEQ * 3072 + h * 64;
#define P13_UNIT(NM) att::attn_unit<64, true, 3072, 3072, 3072, D, true, NM, 2>(ring, base + 2048, base, base + 1024, (bf16*)(ws + WS_O2 + (size_t)b * SEQ * D + h * 64), \
                                 256 * cb, c0 - 8 < 0 ? 0 : c0 - 8, c0 + 3, cc - 8 < 0 ? 0 : cc - 8, cc, cc, INP(I_B_RELB) + h * 257, nullptr, nullptr, F.wave)
        if (fastB) P13_UNIT(true); else P13_UNIT(false);
    }
    GRID_BAR();
    { pg8::Gemm g{(const bf16*)(ws + WS_O2), (const bf16*)(ws + WS_WBO), M, D, D / 2, D / 2}; pg8::StaticOrder S; S.init(M, D, F.G, bid);
      pg8::EpiResStream<false, false, true> E{ws + WS_X2B, (bf16*)(ws + WS_XR3), nullptr, nullptr, 1.f / 2048};
      pg8::gemm_phase<pg8::EpiResStream<false, false, true>, pg8::StaticOrder, true, true, true>(ring, g, S, E, F.wave); }
    GRID_BAR();
    route_phase(F);
    GRID_BAR();
    slot_phase(F, ws);
    GRID_BAR();
#define MOE_LOAD(hf_) unsigned char* w2 = WSP; \
          const int nPA = __builtin_amdgcn_readfirstlane(((const GAS int*)(w2 + WS_META))[0]), nPB = __builtin_amdgcn_readfirstlane(((const GAS int*)(w2 + WS_META))[1]); (void)nPB; \
          const int xB = __builtin_amdgcn_readfirstlane(((const GAS int*)(w2 + WS_META))[18]); (void)xB; \
          const int p0 = (hf_) ? nPA : 0; int pbk[7]; \
          _Pragma("unroll") for (int k = 0; k < 7; ++k) pbk[k] = __builtin_amdgcn_readfirstlane(((const GAS int*)(w2 + WS_META))[2 + (hf_) * 8 + 1 + k]) - p0;
    constexpr size_t HMB_OFF = (size_t)MAXP_HALF * 256 * EFF;
    { MOE_LOAD(0)
      pg8::Gemm g{(const bf16*)(w2 + WS_XG), (const bf16*)(w2 + WS_WM1), nPA * 256, 2 * EFF, D / 2, D / 2};
      pg8::MoeOrder S; S.init(nPA, 2 * EFF / 256, F.G, bid);
#pragma unroll
      for (int k = 0; k < 7; ++k) S.pb[k] = pbk[k];
      pg8::EpiGatedF8 E{w2 + WS_HM, EFF, 2 * EFF / 256};
      pg8::gemm_phase<pg8::EpiGatedF8, pg8::MoeOrder, true, true, true>(ring, g, S, E, F.wave); }
    { MOE_LOAD(1)
      pg8::Gemm g{(const bf16*)(w2 + WS_XG + (size_t)p0 * 256 * D), (const bf16*)(w2 + WS_WM1), xB * 256, 2 * EFF, D / 2, D / 2};
      pg8::MoeOrder S; S.init(xB, 2 * EFF / 256, F.G, bid); S.rot = (nPA * (2 * EFF / 256)) % F.G;
#pragma unroll
      for (int k = 0; k < 7; ++k) S.pb[k] = pbk[k];
      pg8::EpiGatedF8 E{w2 + WS_HM + HMB_OFF, EFF, 2 * EFF / 256};
      pg8::gemm_phase<pg8::EpiGatedF8, pg8::MoeOrder, true, true, true>(ring, g, S, E, F.wave); }
    GRID_BAR();
    { MOE_LOAD(0)
      pg8::Gemm g{(const bf16*)(w2 + WS_HM), (const bf16*)(w2 + WS_WM2), 256 * 256, D, EFF / 2, EFF / 2};
      pg8::MoeOrder S; S.init(256, D / 256, F.G, bid);
#pragma unroll
      for (int k = 0; k < 7; ++k) S.pb[k] = pbk[k];
      pg8::EpiMoeDown<true> E{OUTP, (const bf16*)(w2 + WS_XR3), (const int*)(w2 + WS_SLOTTOK), (const float*)(w2 + WS_SLOTGATE), 0, D, 1.f / 64};
      pg8::gemm_phase<pg8::EpiMoeDown<true>, pg8::MoeOrder, true, true, true>(ring, g, S, E, F.wave); }
    GRID_BAR();
    { MOE_LOAD(0)
      pg8::Gemm g{(const bf16*)(w2 + WS_HM), (const bf16*)(w2 + WS_WM2), nPA * 256, D, EFF / 2, EFF / 2};
      pg8::LeftOrder S; S.M.init(nPA, D / 256, F.G, bid); S.nLeft = 4 * (nPA - 256); S.c0 = 0; S.pbase = 256;
#pragma unroll
      for (int k = 0; k < 7; ++k) S.M.pb[k] = pbk[k];
      pg8::EpiMoeDown<true> E{OUTP, (const bf16*)(w2 + WS_XR3), (const int*)(w2 + WS_SLOTTOK), (const float*)(w2 + WS_SLOTGATE), 0, D, 1.f / 64};
      pg8::gemm_phase<pg8::EpiMoeDown<true>, pg8::LeftOrder, true, true, true>(ring, g, S, E, F.wave); }
    { MOE_LOAD(1)
      pg8::Gemm g{(const bf16*)(w2 + WS_HM + HMB_OFF), (const bf16*)(w2 + WS_WM2), xB * 256, D, EFF / 2, EFF / 2};
      pg8::LeftOrder S; S.M.init(xB, D / 256, F.G, bid); S.nLeft = 4 * xB; S.c0 = 4 * (nPA - 256); S.pbase = 0;
#pragma unroll
      for (int k = 0; k < 7; ++k) S.M.pb[k] = pbk[k];
      pg8::EpiMoeDown<false> E{OUTP, nullptr, (const int*)(w2 + WS_SLOTTOK), (const float*)(w2 + WS_SLOTGATE), p0 * 256, D, 1.f / 64};
      pg8::gemm_phase<pg8::EpiMoeDown<false>, pg8::LeftOrder, true, true, true>(ring, g, S, E, F.wave); }
    { MOE_LOAD(1)
      pg8::Gemm g{(const bf16*)(w2 + WS_XG + (size_t)(p0 + xB) * 256 * D), (const bf16*)(w2 + WS_WM1), (nPB - xB) * 256, 2 * EFF, D / 2, D / 2};
      pg8::MoeOrder S; S.init(nPB - xB, 2 * EFF / 256, F.G, bid); S.nBusy = 4 * (nPA - 256) + 4 * xB; S.SK = 4;
#pragma unroll
      for (int k = 0; k < 7; ++k) S.pb[k] = pbk[k] - xB;
      pg8::EpiGatedF8 E{w2 + WS_HM + HMB_OFF + (size_t)xB * 256 * EFF, EFF, 2 * EFF / 256};
      pg8::gemm_phase<pg8::EpiGatedF8, pg8::MoeOrder, true, true, true>(ring, g, S, E, F.wave); }
    GRID_BAR();
    { MOE_LOAD(1)
      pg8::Gemm g{(const bf16*)(w2 + WS_HM + HMB_OFF + (size_t)xB * 256 * EFF), (const bf16*)(w2 + WS_WM2), (nPB - xB) * 256, D, EFF / 2, EFF / 2};
      pg8::MoeOrder S; S.init(nPB - xB, D / 256, F.G, bid);
#pragma unroll
      for (int k = 0; k < 7; ++k) S.pb[k] = pbk[k] - xB;
      pg8::EpiMoeDown<false> E{OUTP, nullptr, (const int*)(w2 + WS_SLOTTOK), (const float*)(w2 + WS_SLOTGATE), (p0 + xB) * 256, D, 1.f / 64};
      pg8::gemm_phase<pg8::EpiMoeDown<false>, pg8::MoeOrder, true, true, true>(ring, g, S, E, F.wave); }
#undef MOE_LOAD
#undef GRID_BAR
#undef bid
#undef GEMM
}

extern "C" void kernel_launch(void* const* d_in, const int* in_sizes, int n_in, void* d_out, int out_size, void* d_ws, size_t ws_size, hipStream_t stream) {
    static int grid = 0;
    if (grid == 0) {
        if (n_in != 27 || in_sizes[0] != M * D || out_size != M * D || ws_size < WS_END) { fprintf(stderr, "kernel_launch: unexpected shapes (n_in %d, in0 %d, out %d, ws %zu < %zu); nothing launched\n", n_in, n_in > 0 ? in_sizes[0] : -1, out_size, ws_size, (size_t)WS_END); grid = -1; return; }
        int dev = 0, cus = 0, per_cu = 0;
        if (hipGetDevice(&dev) != hipSuccess || hipDeviceGetAttribute(&cus, hipDeviceAttributeMultiprocessorCount, dev) != hipSuccess) { grid = -1; return; }
        if (hipFuncSetAttribute((const void*)yoco_fwd, hipFuncAttributeMaxDynamicSharedMemorySize, LDS_BYTES) != hipSuccess) { fprintf(stderr, "kernel_launch: hipFuncSetAttribute failed\n"); grid = -1; return; }
        if (hipOccupancyMaxActiveBlocksPerMultiprocessor(&per_cu, (const void*)yoco_fwd, NWAVES * 64, LDS_BYTES) != hipSuccess || per_cu < 1) { fprintf(stderr, "kernel_launch: occupancy query says %d\n", per_cu); }
        (void)hipGetLastError();
        grid = cus;
    }
    if (grid < 0) return;
    if (hipMemsetAsync((char*)d_ws + WS_CTL, 0, CTL_ZERO_BYTES, stream) != hipSuccess) return;
    Args a{};
    for (int i = 0; i < 27; ++i) a.in[i] = (const float*)d_in[i];
    a.out = (float*)d_out; a.ws = (unsigned char*)d_ws;
    hipLaunchKernelGGL(yoco_fwd, dim3(grid), dim3(NWAVES * 64), LDS_BYTES, stream, a);
}
```

```cpp
#include <hip/hip_runtime.h>
#include <cstdio>
#include <cstdint>
__device__ __forceinline__ int lane_id_() { unsigned m_ = ~0u; asm volatile("" : "+s"(m_)); return (int)__builtin_amdgcn_mbcnt_hi(m_, __builtin_amdgcn_mbcnt_lo(m_, 0u)); }
template <int X> __device__ __forceinline__ float swz_xor(float v) { return __builtin_bit_cast(float, __builtin_amdgcn_ds_swizzle(__builtin_bit_cast(int, v), (X << 10) | 0x1f)); }
__device__ __forceinline__ void halves32(float v, float& r_lo, float& r_hi) { unsigned a_ = __builtin_bit_cast(unsigned, v), b_ = a_;
    asm volatile("s_nop 1\n\tv_permlane32_swap_b32 %0, %1\n\ts_nop 1" : "+v"(a_), "+v"(b_)); r_lo = __builtin_bit_cast(float, a_); r_hi = __builtin_bit_cast(float, b_); }
__device__ __forceinline__ float xor32_partner(float v, int upper_half) { float lo, hi; halves32(v, lo, hi); return upper_half ? lo : hi; }
__device__ __forceinline__ float xor32_sum(float v) { float lo, hi; halves32(v, lo, hi); return lo + hi; }
__device__ __forceinline__ float xor32_max(float v) { float lo, hi; halves32(v, lo, hi); return fmaxf(lo, hi); }
namespace pg8 {
#define PG8_LAS __attribute__((address_space(3)))
typedef unsigned short bf16_t;
typedef short bf16x8 __attribute__((ext_vector_type(8)));
typedef float f32x4 __attribute__((ext_vector_type(4)));
typedef unsigned u32x4 __attribute__((ext_vector_type(4)));
constexpr int BM = 256, BK = 64, HALF = 128, HTB = HALF * BK * 2  , STAGE_BYTES = 8 * HTB, NXCD = 8, WGM = 8;

__host__ __device__ __forceinline__ int lds_byte(int r, int c) { const int st = (r >> 4) * 2 + (c >> 5), rr = r & 15, cc = c & 31, ob = rr * 64 + cc * 2; return st * 1024 + (ob ^ (((ob >> 9) & 1) << 5)); }
__host__ __device__ __forceinline__ void stage_rc(int b, int& R, int& C) { const int st = b / 1024, sb = b % 1024, swz = sb ^ (((sb >> 9) & 1) << 5); R = (st >> 1) * 16 + swz / 64; C = (st & 1) * 32 + (swz % 64) / 2; }
__host__ __device__ __forceinline__ int perm32(int rho) { const int n = rho >> 4, i = rho & 15; return 8 * (i >> 2) + 4 * n + (i & 3); }

struct Unit { int pm, pn; };
struct Gemm { const bf16_t* A; const bf16_t* Bt; int M, N, K, lda; };

struct StaticOrder {
    int nM, nN, nwg, G, c;
    __host__ __device__ void init(int M, int N, int G_, int c_) { nM = M / BM; nN = N / BM; nwg = nM * nN; G = G_; c = c_; }
    __host__ __device__ bool next(int i, Unit& u) const {
        const int L = i * G + c; if (L >= nwg) return false;
        int wgid = L; { const int q = nwg / NXCD, r = nwg % NXCD, xcd = wgid % NXCD, off = wgid / NXCD; wgid = (xcd < r ? xcd * (q + 1) : r * (q + 1) + (xcd - r) * q) + off; }
        const int nig = WGM * nN, gid = wgid / nig, fm = gid * WGM, gsz = (nM - fm) < WGM ? (nM - fm) : WGM;
        u.pm = fm + ((wgid % nig) % gsz); u.pn = (wgid % nig) / gsz; return true;
    }
    __device__ __forceinline__ void a_ready(const Unit&) const {}
    __device__ __forceinline__ void done(const Unit&) const {}
};
__device__ __forceinline__ unsigned cvt_pk_bf16(float lo, float hi) { unsigned r; asm volatile("v_cvt_pk_bf16_f32 %0, %1, %2" : "=v"(r) : "v"(lo), "v"(hi)); return r; }
__device__ __forceinline__ float silu_f(float x) { const float e = __builtin_amdgcn_exp2f(x * -1.4426950408889634f); return x * __builtin_amdgcn_rcpf(1.f + e); }

__device__ __forceinline__ float sum4(const f32x4& a) { return (a[0] + a[1]) + (a[2] + a[3]); }
__device__ __forceinline__ float part_sum8(const float* p) { return sum4(*(const f32x4*)p) + sum4(*(const f32x4*)(p + 4)); }
__device__ __forceinline__ float part_sum16(const float* p) { return (sum4(*(const f32x4*)p) + sum4(*(const f32x4*)(p + 4))) + (sum4(*(const f32x4*)(p + 8)) + sum4(*(const f32x4*)(p + 12))); }
__device__ __forceinline__ float fq_sum(float v) { v += swz_xor<16>(v); return xor32_sum(v); }
__device__ __forceinline__ float sq8(const f32x4& a, const f32x4& b) { return ((a[0] * a[0] + a[1] * a[1]) + (a[2] * a[2] + a[3] * a[3])) + ((b[0] * b[0] + b[1] * b[1]) + (b[2] * b[2] + b[3] * b[3])); }
__device__ __forceinline__ u32x4 pack8(const f32x4& a, const f32x4& b) { u32x4 w; w.x = cvt_pk_bf16(a[0], a[1]); w.y = cvt_pk_bf16(a[2], a[3]); w.z = cvt_pk_bf16(b[0], b[1]); w.w = cvt_pk_bf16(b[2], b[3]); return w; }
constexpr float EPS_ = 1e-6f;
__device__ __forceinline__ unsigned pk_fp8x4(float a, float b, float c, float d) { int w = 0; w = __builtin_amdgcn_cvt_pk_fp8_f32(a, b, w, false); w = __builtin_amdgcn_cvt_pk_fp8_f32(c, d, w, true); return (unsigned)w; }

struct EpiQA {
    static constexpr bool PERM = true, AFTER_DRAIN = false;
    bf16_t* O; float* part; float wscale;
    __device__ __forceinline__ void operator()(const f32x4 (&acc)[2][2][4][2], const Unit& u, int wr, int wc, int fr, int fq) const {
        { int t_ = lane_id_(); asm volatile("" : "+v"(t_)); fr = t_ & 15; fq = (t_ >> 4) & 3; }
        const int row0 = u.pm * BM + wr * 64 + fr, col0 = u.pn * BM + wc * 32 + 8 * fq;
#pragma unroll
        for (int ai = 0; ai < 2; ++ai)
#pragma unroll
            for (int m = 0; m < 4; ++m) { const int row = row0 + ai * HALF + m * 16; bf16_t* rowp = O + (size_t)row * 768 + col0;
                const f32x4 a0 = acc[ai][0][m][0] * wscale, a1 = acc[ai][0][m][1] * wscale, b0 = acc[ai][1][m][0] * wscale, b1 = acc[ai][1][m][1] * wscale;
                *(u32x4*)(rowp) = pack8(a0, a1); *(u32x4*)(rowp + HALF) = pack8(b0, b1);
                const float s0 = sq8(a0, a1), s1 = sq8(b0, b1);
                float* pr = part + (size_t)row * 16;
                if (u.pn == 0) { const float t = fq_sum(s0 + s1); if (fq == 0) pr[wc] = t; }
                else if (u.pn == 1) { const float t0 = fq_sum(s0), t1 = fq_sum(s1); if (fq == 0) { pr[4 + wc] = t0; pr[8 + wc] = t1; } }
                else { const float t = fq_sum(s0); if (fq == 0) pr[12 + wc] = t; } }
    }
};

struct EpiRowScaleBf16 {
    static constexpr bool PERM = true, AFTER_DRAIN = false;
    bf16_t* O; int ldc; const float* part; float inv_n;
    __device__ __forceinline__ void operator()(const f32x4 (&acc)[2][2][4][2], const Unit& u, int wr, int wc, int fr, int fq) const {
        { int t_ = lane_id_(); asm volatile("" : "+v"(t_)); fr = t_ & 15; fq = (t_ >> 4) & 3; }
        const int row0 = u.pm * BM + wr * 64 + fr, col0 = u.pn * BM + wc * 32 + 8 * fq;
#pragma unroll
        for (int ai = 0; ai < 2; ++ai)
#pragma unroll
            for (int m = 0; m < 4; ++m) { const int row = row0 + ai * HALF + m * 16; bf16_t* rowp = O + (size_t)row * ldc + col0;
                const float rs = __builtin_amdgcn_rsqf(part_sum8(part + (size_t)row * 16) * inv_n + EPS_);
                *(u32x4*)(rowp) = pack8(acc[ai][0][m][0] * rs, acc[ai][0][m][1] * rs); *(u32x4*)(rowp + HALF) = pack8(acc[ai][1][m][0] * rs, acc[ai][1][m][1] * rs); }
    }
};

struct EpiKVup {
    static constexpr bool PERM = true, AFTER_DRAIN = false;
    bf16_t* Kd; bf16_t* Vd; const float* part; const bf16_t* QA; const float* g_kn; const float* rope;
    __device__ __forceinline__ void operator()(const f32x4 (&acc)[2][2][4][2], const Unit& u, int wr, int wc, int fr, int fq) const {
        { int t_ = lane_id_(); asm volatile("" : "+v"(t_)); fr = t_ & 15; fq = (t_ >> 4) & 3; }
        const int row0 = u.pm * BM + wr * 64 + fr;
        if (u.pn >= 4) {
            const int col0 = (u.pn - 4) * BM + wc * 32 + 8 * fq;
#pragma unroll
            for (int ai = 0; ai < 2; ++ai)
#pragma unroll
                for (int m = 0; m < 4; ++m) { const int row = row0 + ai * HALF + m * 16; bf16_t* rowp = Vd + (size_t)row * 1024 + col0;
                    const float rs = __builtin_amdgcn_rsqf(part_sum8(part + (size_t)row * 16 + 8) * (1.f / 256) + EPS_);
                    *(u32x4*)(rowp) = pack8(acc[ai][0][m][0] * rs, acc[ai][0][m][1] * rs); *(u32x4*)(rowp + HALF) = pack8(acc[ai][1][m][0] * rs, acc[ai][1][m][1] * rs); }
            return;
        }
        const int head = 4 * u.pn + wc;
        f32x4 gA0 = *(const f32x4*)(g_kn + 8 * fq), gA1 = *(const f32x4*)(g_kn + 8 * fq + 4), gB0 = *(const f32x4*)(g_kn + 32 + 8 * fq), gB1 = *(const f32x4*)(g_kn + 32 + 8 * fq + 4);
        const f32x4 gR1 = *(const f32x4*)(g_kn + 64 + 4 * fq), gR2 = *(const f32x4*)(g_kn + 80 + 4 * fq);
#pragma unroll
        for (int ai = 0; ai < 2; ++ai)
#pragma unroll
            for (int m = 0; m < 4; ++m) { const int row = row0 + ai * HALF + m * 16;
                const float rs = __builtin_amdgcn_rsqf(part_sum8(part + (size_t)row * 16 + 8) * (1.f / 256) + EPS_);
                f32x4 a0 = acc[ai][0][m][0] * rs, a1 = acc[ai][0][m][1] * rs, b0 = acc[ai][1][m][0] * rs, b1 = acc[ai][1][m][1] * rs;
                const unsigned long long p1 = *(const unsigned long long*)(QA + (size_t)row * 768 + 640 + 4 * fq), p2 = *(const unsigned long long*)(QA + (size_t)row * 768 + 656 + 4 * fq);
                f32x4 x1, x2;
                x1[0] = __builtin_bit_cast(float, (unsigned)(p1 << 16)); x1[1] = __builtin_bit_cast(float, (unsigned)p1 & 0xffff0000u);
                x1[2] = __builtin_bit_cast(float, (unsigned)(p1 >> 32) << 16); x1[3] = __builtin_bit_cast(float, (unsigned)(p1 >> 32) & 0xffff0000u);
                x2[0] = __builtin_bit_cast(float, (unsigned)(p2 << 16)); x2[1] = __builtin_bit_cast(float, (unsigned)p2 & 0xffff0000u);
                x2[2] = __builtin_bit_cast(float, (unsigned)(p2 >> 32) << 16); x2[3] = __builtin_bit_cast(float, (unsigned)(p2 >> 32) & 0xffff0000u);
                const float ss = fq_sum(sq8(a0, a1) + sq8(b0, b1) + sq8(x1, x2));
                const float sh = __builtin_amdgcn_rsqf(ss * (1.f / 96) + EPS_);
                bf16_t* kp = Kd + (size_t)row * 1536 + head * 96;
                *(u32x4*)(kp + 8 * fq) = pack8(a0 * gA0 * sh, a1 * gA1 * sh); *(u32x4*)(kp + 32 + 8 * fq) = pack8(b0 * gB0 * sh, b1 * gB1 * sh);
                const f32x4* rp = (const f32x4*)(rope + ((size_t)(row & 2047) * 16 + 4 * fq) * 2);
                const f32x4 c01 = rp[0], c23 = rp[1];
                const f32x4 y1 = x1 * gR1 * sh, y2 = x2 * gR2 * sh;
                f32x4 o1, o2;
                o1[0] = y1[0] * c01[0] - y2[0] * c01[1]; o2[0] = y2[0] * c01[0] + y1[0] * c01[1];
                o1[1] = y1[1] * c01[2] - y2[1] * c01[3]; o2[1] = y2[1] * c01[2] + y1[1] * c01[3];
                o1[2] = y1[2] * c23[0] - y2[2] * c23[1]; o2[2] = y2[2] * c23[0] + y1[2] * c23[1];
                o1[3] = y1[3] * c23[2] - y2[3] * c23[3]; o2[3] = y2[3] * c23[2] + y1[3] * c23[3];
                unsigned long long w1 = (unsigned long long)cvt_pk_bf16(o1[0], o1[1]) | ((unsigned long long)cvt_pk_bf16(o1[2], o1[3]) << 32);
                unsigned long long w2 = (unsigned long long)cvt_pk_bf16(o2[0], o2[1]) | ((unsigned long long)cvt_pk_bf16(o2[2], o2[3]) << 32);
                *(unsigned long long*)(kp + 64 + 4 * fq) = w1; *(unsigned long long*)(kp + 80 + 4 * fq) = w2; }
    }
};

struct EpiK2Q2 {
    static constexpr bool PERM = true, AFTER_DRAIN = false;
    bf16_t* O; const float* pss; const float* gk; const float* gq; float wscale;
    __device__ __forceinline__ void operator()(const f32x4 (&acc)[2][2][4][2], const Unit& u, int wr, int wc, int fr, int fq) const {
        { int t_ = lane_id_(); asm volatile("" : "+v"(t_)); fr = t_ & 15; fq = (t_ >> 4) & 3; }
        const int row0 = u.pm * BM + wr * 64 + fr, isq = u.pn >> 2, tl = u.pn & 3;
        const float* g = isq ? gq : gk; const float post = isq ? 0.125f * 1.4426950408889634f : 1.f;
        const f32x4 gA0 = *(const f32x4*)(g + 8 * fq) * post, gA1 = *(const f32x4*)(g + 8 * fq + 4) * post, gB0 = *(const f32x4*)(g + 32 + 8 * fq) * post, gB1 = *(const f32x4*)(g + 32 + 8 * fq + 4) * post;
        const int colh = isq * 2048 + (4 * tl + wc) * 64;
        unsigned zhi_ = 0u; asm volatile("" : "+v"(zhi_));
        const unsigned long long coff = ((unsigned long long)zhi_ << 32) | (unsigned)((colh + 8 * fq) * 2);
#pragma unroll
        for (int ai = 0; ai < 2; ++ai)
#pragma unroll
            for (int m = 0; m < 4; ++m) { const int row = row0 + ai * HALF + m * 16; unsigned char* rowp = (unsigned char*)O + (size_t)row * 6144 + coff;
                const float rs = __builtin_amdgcn_rsqf(part_sum16(pss + (size_t)row * 16) * (1.f / 1024) + EPS_) * wscale;
                const f32x4 a0 = acc[ai][0][m][0] * rs, a1 = acc[ai][0][m][1] * rs, b0 = acc[ai][1][m][0] * rs, b1 = acc[ai][1][m][1] * rs;
                const float ss = fq_sum(sq8(a0, a1) + sq8(b0, b1));
                const float sh = __builtin_amdgcn_rsqf(ss * (1.f / 64) + EPS_);
                *(u32x4*)(rowp) = pack8(a0 * gA0 * sh, a1 * gA1 * sh); *(u32x4*)(rowp + 64) = pack8(b0 * gB0 * sh, b1 * gB1 * sh); }
    }
};
struct EpiRowScale16 {
    static constexpr bool PERM = true, AFTER_DRAIN = false;
    bf16_t* O; int ldc; int coff; const float* pss; float wscale;
    __device__ __forceinline__ void operator()(const f32x4 (&acc)[2][2][4][2], const Unit& u, int wr, int wc, int fr, int fq) const {
        { int t_ = lane_id_(); asm volatile("" : "+v"(t_)); fr = t_ & 15; fq = (t_ >> 4) & 3; }
        const int row0 = u.pm * BM + wr * 64 + fr, col0 = coff + u.pn * BM + wc * 32 + 8 * fq;
#pragma unroll
        for (int ai = 0; ai < 2; ++ai)
#pragma unroll
            for (int m = 0; m < 4; ++m) { const int row = row0 + ai * HALF + m * 16; bf16_t* rowp = O + (size_t)row * ldc + col0;
                const float rs = __builtin_amdgcn_rsqf(part_sum16(pss + (size_t)row * 16) * (1.f / 1024) + EPS_) * wscale;
                *(u32x4*)(rowp) = pack8(acc[ai][0][m][0] * rs, acc[ai][0][m][1] * rs); *(u32x4*)(rowp + HALF) = pack8(acc[ai][1][m][0] * rs, acc[ai][1][m][1] * rs); }
    }
};

template <bool SSQ> struct EpiGated {
    static constexpr bool PERM = true, AFTER_DRAIN = false;
    bf16_t* Hd; int ldc; int ntile; const float* rs;
    __device__ __forceinline__ void operator()(const f32x4 (&acc)[2][2][4][2], const Unit& u, int wr, int wc, int fr, int fq) const {
        { int t_ = lane_id_(); asm volatile("" : "+v"(t_)); fr = t_ & 15; fq = (t_ >> 4) & 3; }
        const int pnl = ntile ? (u.pn % ntile) : u.pn;
        const int row0 = u.pm * BM + wr * 64 + fr, col0 = pnl * HALF + wc * 32 + 8 * fq;
#pragma unroll
        for (int ai = 0; ai < 2; ++ai)
#pragma unroll
            for (int m = 0; m < 4; ++m) { const int row = row0 + ai * HALF + m * 16; bf16_t* rowp = Hd + (size_t)row * ldc + col0;
                const float r = SSQ ? __builtin_amdgcn_rsqf(part_sum16(rs + (size_t)row * 16) * (1.f / 1024) + EPS_) : rs[row];
                const f32x4 g0 = acc[ai][0][m][0] * r, g1 = acc[ai][0][m][1] * r, u0 = acc[ai][1][m][0] * r, u1 = acc[ai][1][m][1] * r;
                u32x4 w;
                w.x = cvt_pk_bf16(silu_f(g0[0]) * u0[0], silu_f(g0[1]) * u0[1]); w.y = cvt_pk_bf16(silu_f(g0[2]) * u0[2], silu_f(g0[3]) * u0[3]);
                w.z = cvt_pk_bf16(silu_f(g1[0]) * u1[0], silu_f(g1[1]) * u1[1]); w.w = cvt_pk_bf16(silu_f(g1[2]) * u1[2], silu_f(g1[3]) * u1[3]);
                *(u32x4*)rowp = w; }
    }
};

struct EpiGatedF8 {
    static constexpr bool PERM = true, AFTER_DRAIN = false;
    unsigned char* Hd; int ldc; int ntile;
    static __device__ __forceinline__ float gate(float g, float u) {
        const float e = __builtin_amdgcn_exp2f(g * (-1.4426950408889634f / 64.f)); return (g * u) * (__builtin_amdgcn_rcpf(1.f + e) * (1.f / 4096.f)); }
    __device__ __forceinline__ void operator()(const f32x4 (&acc)[2][2][4][2], const Unit& u, int wr, int wc, int fr, int fq) const {
        { int t_ = lane_id_(); asm volatile("" : "+v"(t_)); fr = t_ & 15; fq = (t_ >> 4) & 3; }
        const int pnl = u.pn % ntile;
        const int row0 = u.pm * BM + wr * 64 + fr, col0 = pnl * HALF + wc * 32 + 8 * fq;
#pragma unroll
        for (int ai = 0; ai < 2; ++ai)
#pragma unroll
            for (int m = 0; m < 4; ++m) { const int row = row0 + ai * HALF + m * 16; unsigned char* rowp = Hd + (size_t)row * ldc + col0;
                const f32x4 g0 = acc[ai][0][m][0], g1 = acc[ai][0][m][1], u0 = acc[ai][1][m][0], u1 = acc[ai][1][m][1];
                unsigned long long w = (unsigned long long)pk_fp8x4(gate(g0[0], u0[0]), gate(g0[1], u0[1]), gate(g0[2], u0[2]), gate(g0[3], u0[3]))
                                     | ((unsigned long long)pk_fp8x4(gate(g1[0], u1[0]), gate(g1[1], u1[1]), gate(g1[2], u1[2]), gate(g1[3], u1[3])) << 32);
                *(unsigned long long*)rowp = w; }
    }
};

template <bool SSQ, bool XF8, bool RES16> struct EpiResStream {
    static constexpr bool PERM = true, AFTER_DRAIN = false;
    const void* res; bf16_t* XB; unsigned char* X8; float* ssq; float ascale;
    __device__ __forceinline__ void operator()(const f32x4 (&acc)[2][2][4][2], const Unit& u, int wr, int wc, int fr, int fq) const {
        { int t_ = lane_id_(); asm volatile("" : "+v"(t_)); fr = t_ & 15; fq = (t_ >> 4) & 3; }
        const int row0 = u.pm * BM + wr * 64 + fr, col0 = u.pn * BM + wc * 32 + 8 * fq;
        f32x4 rw[4][2][2];
#define ERS_ROW(it) (row0 + ((it) >> 2) * HALF + ((it) & 3) * 16)
#define ERS_LOAD(it) do { const size_t ro_ = (size_t)ERS_ROW(it) * 1024 + col0; _Pragma("unroll") for (int bj = 0; bj < 2; ++bj) { \
            if constexpr (RES16) rw[(it) & 3][bj][0] = __builtin_bit_cast(f32x4, *(const u32x4*)((const bf16_t*)res + ro_ + bj * HALF)); \
            else { _Pragma("unroll") for (int n = 0; n < 2; ++n) rw[(it) & 3][bj][n] = *(const f32x4*)((const float*)res + ro_ + bj * HALF + n * 4); } } } while (0)
        ERS_LOAD(0); ERS_LOAD(1); ERS_LOAD(2); ERS_LOAD(3);
#pragma unroll
        for (int it = 0; it < 8; ++it) { const int ai = it >> 2, m = it & 3; const int row = ERS_ROW(it); const size_t ro = (size_t)row * 1024 + col0;
                f32x4 r[2][2];
#pragma unroll
                for (int bj = 0; bj < 2; ++bj) {
                    if constexpr (RES16) { const u32x4 w = __builtin_bit_cast(u32x4, rw[it & 3][bj][0]);
                        r[bj][0] = (f32x4){__builtin_bit_cast(float, w.x << 16), __builtin_bit_cast(float, w.x & 0xffff0000u), __builtin_bit_cast(float, w.y << 16), __builtin_bit_cast(float, w.y & 0xffff0000u)};
                        r[bj][1] = (f32x4){__builtin_bit_cast(float, w.z << 16), __builtin_bit_cast(float, w.z & 0xffff0000u), __builtin_bit_cast(float, w.w << 16), __builtin_bit_cast(float, w.w & 0xffff0000u)}; }
                    else { r[bj][0] = rw[it & 3][bj][0]; r[bj][1] = rw[it & 3][bj][1]; }
                    r[bj][0] = r[bj][0] + acc[ai][bj][m][0] * ascale; r[bj][1] = r[bj][1] + acc[ai][bj][m][1] * ascale; }
                if (it + 4 < 8) ERS_LOAD(it + 4);
                *(u32x4*)(XB + ro) = pack8(r[0][0], r[0][1]); *(u32x4*)(XB + ro + HALF) = pack8(r[1][0], r[1][1]);
                if constexpr (XF8) { unsigned char* x8 = X8 + ro;
                    *(unsigned long long*)(x8) = (unsigned long long)pk_fp8x4(r[0][0][0], r[0][0][1], r[0][0][2], r[0][0][3]) | ((unsigned long long)pk_fp8x4(r[0][1][0], r[0][1][1], r[0][1][2], r[0][1][3]) << 32);
                    *(unsigned long long*)(x8 + HALF) = (unsigned long long)pk_fp8x4(r[1][0][0], r[1][0][1], r[1][0][2], r[1][0][3]) | ((unsigned long long)pk_fp8x4(r[1][1][0], r[1][1][1], r[1][1][2], r[1][1][3]) << 32); }
                if (SSQ) { const float t = fq_sum(sq8(r[0][0], r[0][1]) + sq8(r[1][0], r[1][1])); if (fq == 0) ssq[(size_t)row * 16 + u.pn * 4 + wc] = t; } }
#undef ERS_LOAD
#undef ERS_ROW
    }
};

template <bool FIRST> struct EpiMoeDown {
    static constexpr bool PERM = false, AFTER_DRAIN = false;
    float* out; const bf16_t* xb; const int* slot_tok; const float* slot_gate; int slot_base; int ldc; float wscale;
    __device__ __forceinline__ void operator()(const f32x4 (&acc)[2][2][4][2], const Unit& u, int wr, int wc, int fr, int fq) const {
        { int t_ = lane_id_(); asm volatile("" : "+v"(t_)); fr = t_ & 15; fq = (t_ >> 4) & 3; }
        const int pnl = u.pn & 3;
        const int row0 = slot_base + u.pm * BM + wr * 64 + fr, col0 = pnl * BM + wc * 32 + 4 * fq;
        int tk[8]; float gt[8];
#pragma unroll
        for (int it = 0; it < 8; ++it) { const int slot = row0 + (it >> 2) * HALF + (it & 3) * 16; tk[it] = slot_tok[slot]; gt[it] = slot_gate[slot] * wscale; }
        f32x4 rw[4][2][2]; unsigned rlo[4][2][2], rhi[4][2][2];
#define EMD_LOAD(it) do { if (tk[it] >= 0) { _Pragma("unroll") for (int bj = 0; bj < 2; ++bj) _Pragma("unroll") for (int n = 0; n < 2; ++n) { \
            if constexpr (FIRST) { const unsigned long long q_ = *(const unsigned long long*)(xb + (size_t)tk[it] * ldc + col0 + bj * HALF + n * 16); \
                rlo[(it) & 3][bj][n] = (unsigned)q_; rhi[(it) & 3][bj][n] = (unsigned)(q_ >> 32); } \
            else rw[(it) & 3][bj][n] = *(const f32x4*)(out + (size_t)tk[it] * ldc + col0 + bj * HALF + n * 16); } } } while (0)
        EMD_LOAD(0); EMD_LOAD(1); EMD_LOAD(2); EMD_LOAD(3);
#pragma unroll
        for (int it = 0; it < 8; ++it) { const int ai = it >> 2, m = it & 3;
            if (tk[it] >= 0) { float* rowp = out + (size_t)tk[it] * ldc + col0;
#pragma unroll
                for (int bj = 0; bj < 2; ++bj)
#pragma unroll
                    for (int n = 0; n < 2; ++n) { f32x4 r;
                        if constexpr (FIRST) { const unsigned lo = rlo[it & 3][bj][n], hi = rhi[it & 3][bj][n];
                            r = (f32x4){__builtin_bit_cast(float, lo << 16), __builtin_bit_cast(float, lo & 0xffff0000u), __builtin_bit_cast(float, hi << 16), __builtin_bit_cast(float, hi & 0xffff0000u)}; }
                        else r = rw[it & 3][bj][n];
                        *(f32x4*)(rowp + bj * HALF + n * 16) = r + acc[ai][bj][m][n] * gt[it]; } }
            if (it + 4 < 8) EMD_LOAD(it + 4); }
#undef EMD_LOAD
    }
};

struct MoeOrder {
    int nM, nN, nwg, G, c; int pb[7];
    int rot;
    int nBusy, SK;
    __device__ void init(int nPanels, int nN_, int G_, int c_) { nM = nPanels; nN = nN_; nwg = nM * nN; G = G_; c = c_; nBusy = 0; SK = 0; rot = 0; }
    __device__ __forceinline__ int expert_of(int pm) const { int e = 0;
#pragma unroll
        for (int k = 0; k < 7; ++k) e += (pm >= pb[k]) ? 1 : 0;
        return e; }
    __device__ bool next(int i, Unit& u) const {
        int L;
        if (nBusy == 0) { int ce = c - rot; if (ce < 0) ce += G; L = i * G + ce; }
        else if (c >= nBusy) L = (i < SK) ? i * (G - nBusy) + (c - nBusy) : SK * (G - nBusy) + (i - SK) * G + c;
        else L = SK * (G - nBusy) + i * G + c;
        if (L >= nwg) return false;
        int wgid = L; { const int q = nwg / NXCD, r = nwg % NXCD, xcd = wgid % NXCD, off = wgid / NXCD; wgid = (xcd < r ? xcd * (q + 1) : r * (q + 1) + (xcd - r) * q) + off; }
        const int nig = WGM * nN, gid = wgid / nig, fm = gid * WGM, gsz = (nM - fm) < WGM ? (nM - fm) : WGM;
        u.pm = fm + ((wgid % nig) % gsz); const int pnl = (wgid % nig) / gsz;
        u.pn = expert_of(u.pm) * nN + pnl; return true;
    }
    __device__ __forceinline__ void a_ready(const Unit&) const {}
    __device__ __forceinline__ void done(const Unit&) const {}
};
struct LeftOrder {
    MoeOrder M; int nLeft, c0, pbase;
    __device__ bool next(int i, Unit& u) const { const int j = M.c - c0; if (i != 0 || j < 0 || j >= nLeft) return false; u.pm = pbase + (j >> 2); u.pn = M.expert_of(u.pm) * 4 + (j & 3); return true; }
    __device__ __forceinline__ void a_ready(const Unit&) const {}
    __device__ __forceinline__ void done(const Unit&) const {}
};
template <class Epi, class Sched, bool ALIGN_EPI = false, bool SP2 = false, bool F8 = false>
__device__ __forceinline__ void gemm_phase(PG8_LAS unsigned char* lds, const Gemm g, const Sched& S, const Epi& E, const int wave_idx) {
    int tid_ = wave_idx * 64 + lane_id_(); asm volatile("" : "+v"(tid_));
    const int tid = tid_, wid = __builtin_amdgcn_readfirstlane(tid >> 6), lane = tid & 63, wr = wid >> 2, wc = wid & 3, fr = lane & 15, fq = lane >> 4;
    const int K = g.K, nt = K / BK;
    unsigned voffA0, voffB0;
    { int R, C; stage_rc(tid * 16, R, C); const int Rb = Epi::PERM ? ((R & ~31) + perm32(R & 31)) : R;
      voffA0 = (unsigned)(R * g.lda + C) * 2u; voffB0 = (unsigned)(Rb * K + C) * 2u; }
    const size_t voffAR = (size_t)64 * g.lda * 2, voffBR = (size_t)64 * K * 2;
    const size_t kstep = (size_t)(BK * 2);
    const size_t hstepA = (size_t)HALF * g.lda * 2, hstepB = (size_t)HALF * K * 2;
    const size_t tstepA = 2 * hstepA, tstepB = 2 * hstepB;
    const unsigned lds0_ = (unsigned)(__UINTPTR_TYPE__)lds;
    const unsigned ldsw = (unsigned)wid * 1024u;
    const int aoff = lds_byte(wr * 64 + fr, fq * 8), boff = lds_byte(wc * 32 + fr, fq * 8);
#define PG8_SA(b, h) (((b) * 2 + (h)) * HTB)
#define PG8_SB(b, h) ((4 + (b) * 2 + (h)) * HTB)
#define PG8_STAGE(bufoff, gbase, voff) do { _Pragma("unroll") for (int _i = 0; _i < 2; ++_i) { unsigned keep_; const char* sb_ = (const char*)(gbase) + (size_t)_i * voff##R; \
        asm volatile("s_mov_b32 %0, m0\n\ts_mov_b32 m0, %3\n\ts_nop 0\n\tglobal_load_lds_dwordx4 %1, %2\n\ts_mov_b32 m0, %0" \
            : "=&s"(keep_) : "v"(voff##0), "s"(sb_), "s"(lds0_ + (unsigned)((bufoff) + _i * 8192) + ldsw) : "memory"); } } while (0)
#define PG8_LDA(dst, b, h) do { _Pragma("unroll") for (int m = 0; m < 4; ++m) _Pragma("unroll") for (int k = 0; k < 2; ++k) dst[m][k] = *(const PG8_LAS bf16x8*)(lds + PG8_SA(b, h) + aoff + m * 2048 + k * 1024); } while (0)
#define PG8_LDB(dst, b, h) do { _Pragma("unroll") for (int n = 0; n < 2; ++n) _Pragma("unroll") for (int k = 0; k < 2; ++k) dst[n][k] = *(const PG8_LAS bf16x8*)(lds + PG8_SB(b, h) + boff + n * 2048 + k * 1024); } while (0)
#define PG8_MMA(ai, bj, At, Bt) do { __builtin_amdgcn_s_setprio(1); _Pragma("unroll") for (int m = 0; m < 4; ++m) _Pragma("unroll") for (int n = 0; n < 2; ++n) { \
        if constexpr (F8) { typedef int v8i_ __attribute__((ext_vector_type(8))); typedef int v4i_ __attribute__((ext_vector_type(4))); \
            const v4i_ b0_ = __builtin_bit_cast(v4i_, Bt[n][0]), b1_ = __builtin_bit_cast(v4i_, Bt[n][1]), a0_ = __builtin_bit_cast(v4i_, At[m][0]), a1_ = __builtin_bit_cast(v4i_, At[m][1]); \
            const v8i_ bb_ = __builtin_shufflevector(b0_, b1_, 0, 1, 2, 3, 4, 5, 6, 7), aa_ = __builtin_shufflevector(a0_, a1_, 0, 1, 2, 3, 4, 5, 6, 7); \
            acc[ai][bj][m][n] = __builtin_amdgcn_mfma_scale_f32_16x16x128_f8f6f4(bb_, aa_, acc[ai][bj][m][n], 0, 0, 0, 0, 0, 0); } \
        else { _Pragma("unroll") for (int k = 0; k < 2; ++k) acc[ai][bj][m][n] = __builtin_amdgcn_mfma_f32_16x16x32_bf16(Bt[n][k], At[m][k], acc[ai][bj][m][n], 0, 0, 0); } } \
        __builtin_amdgcn_s_setprio(0); } while (0)
#define PG8_WAIT_V(n) asm volatile("s_waitcnt vmcnt(" #n ")" ::: "memory")
#define PG8_WAIT_L(n) asm volatile("s_waitcnt lgkmcnt(" #n ")" ::: "memory")
#define PG8_BAR __builtin_amdgcn_s_barrier()
#define PG8_SCHED __builtin_amdgcn_sched_barrier(0)
    Unit cur, nxt; int ui = 0;
    if (!S.next(0, cur)) return;
    f32x4 acc[2][2][4][2];
#pragma unroll
    for (int a = 0; a < 2; ++a)
#pragma unroll
        for (int b = 0; b < 2; ++b)
#pragma unroll
            for (int m = 0; m < 4; ++m)
#pragma unroll
                for (int n = 0; n < 2; ++n) acc[a][b][m][n] = (f32x4){0.f, 0.f, 0.f, 0.f};
    bf16x8 At[4][2], B0[2][2], B1[2][2];
    const char* cA = (const char*)g.A + (size_t)cur.pm * tstepA; const char* cB = (const char*)g.Bt + (size_t)cur.pn * tstepB;
    S.a_ready(cur);
    if constexpr (SP2) {
        PG8_STAGE(PG8_SB(0, 0), cB, voffB); PG8_STAGE(PG8_SB(0, 1), cB + hstepB, voffB); PG8_STAGE(PG8_SA(0, 0), cA, voffA); PG8_STAGE(PG8_SA(0, 1), cA + hstepA, voffA);
        if (wr == 1) PG8_BAR;
        PG8_WAIT_V(2); PG8_BAR;
        PG8_STAGE(PG8_SB(1, 0), cB + kstep, voffB); PG8_STAGE(PG8_SA(1, 0), cA + kstep, voffA); PG8_STAGE(PG8_SB(1, 1), cB + hstepB + kstep, voffB);
        PG8_WAIT_V(6); PG8_BAR;
    } else {
        PG8_STAGE(PG8_SB(0, 0), cB, voffB); PG8_STAGE(PG8_SA(0, 0), cA, voffA); PG8_STAGE(PG8_SB(0, 1), cB + hstepB, voffB); PG8_STAGE(PG8_SA(0, 1), cA + hstepA, voffA);
        if (wr == 1) PG8_BAR;
        PG8_WAIT_V(4); PG8_BAR;
        PG8_STAGE(PG8_SB(1, 0), cB + kstep, voffB); PG8_STAGE(PG8_SA(1, 0), cA + kstep, voffA); PG8_STAGE(PG8_SB(1, 1), cB + hstepB + kstep, voffB);
        PG8_WAIT_V(6); PG8_BAR;
    }
    for (;;) {
        const bool has_next = S.next(ui + 1, nxt);
        const char* nA = has_next ? (const char*)g.A + (size_t)nxt.pm * tstepA : cA; const char* nB = has_next ? (const char*)g.Bt + (size_t)nxt.pn * tstepB : cB;
#pragma unroll 1
        for (int t = 0; t < nt; t += 2) {
            const bool last = (t == nt - 2);
            const char* a1 = cA + (size_t)(t + 1) * kstep;
            const char* a2 = last ? nA : cA + (size_t)(t + 2) * kstep; const char* b2 = last ? nB : cB + (size_t)(t + 2) * kstep;
            const char* a3 = a2 + kstep; const char* b3 = b2 + kstep;
            if (last && has_next) S.a_ready(nxt);
            if constexpr (SP2) {
            PG8_LDB(B0, 0, 0); PG8_LDB(B1, 0, 1); PG8_SCHED; PG8_LDA(At, 0, 0); PG8_STAGE(PG8_SA(1, 1), a1 + hstepA, voffA);
            PG8_WAIT_V(8); PG8_WAIT_L(0); PG8_BAR; PG8_MMA(0, 0, At, B0); PG8_MMA(0, 1, At, B1); PG8_BAR; PG8_SCHED;
            PG8_LDA(At, 0, 1); PG8_STAGE(PG8_SB(0, 0), b2, voffB); PG8_STAGE(PG8_SB(0, 1), b2 + hstepB, voffB); PG8_STAGE(PG8_SA(0, 0), a2, voffA);
            PG8_WAIT_V(8); PG8_WAIT_L(0); PG8_BAR; PG8_MMA(1, 0, At, B0); PG8_MMA(1, 1, At, B1); PG8_BAR; PG8_SCHED;
            PG8_LDB(B0, 1, 0); PG8_LDB(B1, 1, 1); PG8_SCHED; PG8_LDA(At, 1, 0); PG8_STAGE(PG8_SA(0, 1), a2 + hstepA, voffA);
            PG8_WAIT_V(8); PG8_WAIT_L(0); PG8_BAR; PG8_MMA(0, 0, At, B0); PG8_MMA(0, 1, At, B1); PG8_BAR; PG8_SCHED;
            PG8_LDA(At, 1, 1); PG8_STAGE(PG8_SB(1, 0), b3, voffB); PG8_STAGE(PG8_SB(1, 1), b3 + hstepB, voffB); PG8_STAGE(PG8_SA(1, 0), a3, voffA);
            PG8_WAIT_V(8); PG8_WAIT_L(0); PG8_BAR; PG8_MMA(1, 0, At, B0); PG8_MMA(1, 1, At, B1); PG8_BAR; PG8_SCHED;
            } else {
            PG8_LDB(B0, 0, 0); PG8_SCHED; PG8_LDA(At, 0, 0); PG8_STAGE(PG8_SA(1, 1), a1 + hstepA, voffA);
            PG8_WAIT_L(8); PG8_BAR; PG8_WAIT_L(0); PG8_MMA(0, 0, At, B0); PG8_BAR; PG8_SCHED;
            PG8_LDB(B1, 0, 1); PG8_STAGE(PG8_SB(0, 0), b2, voffB);
            PG8_BAR; PG8_WAIT_L(0); PG8_MMA(0, 1, At, B1); PG8_BAR;
            PG8_LDA(At, 0, 1); PG8_STAGE(PG8_SA(0, 0), a2, voffA);
            PG8_BAR; PG8_WAIT_L(0); PG8_MMA(1, 0, At, B0); PG8_BAR; PG8_SCHED;
            PG8_STAGE(PG8_SB(0, 1), b2 + hstepB, voffB);
            PG8_WAIT_V(6); PG8_BAR; PG8_MMA(1, 1, At, B1); PG8_BAR;
            PG8_LDB(B0, 1, 0); PG8_SCHED; PG8_LDA(At, 1, 0); PG8_STAGE(PG8_SA(0, 1), a2 + hstepA, voffA);
            PG8_WAIT_L(8); PG8_BAR; PG8_WAIT_L(0); PG8_MMA(0, 0, At, B0); PG8_BAR; PG8_SCHED;
            PG8_LDB(B1, 1, 1); PG8_STAGE(PG8_SB(1, 0), b3, voffB);
            PG8_BAR; PG8_WAIT_L(0); PG8_MMA(0, 1, At, B1); PG8_BAR;
            PG8_LDA(At, 1, 1); PG8_STAGE(PG8_SA(1, 0), a3, voffA);
            PG8_BAR; PG8_WAIT_L(0); PG8_MMA(1, 0, At, B0); PG8_BAR; PG8_SCHED;
            PG8_STAGE(PG8_SB(1, 1), b3 + hstepB, voffB);
            PG8_WAIT_V(6); PG8_BAR; PG8_MMA(1, 1, At, B1); PG8_BAR;
            }
        }
        if constexpr (ALIGN_EPI) { if (wr == 0) PG8_BAR; }
        if constexpr (!Epi::AFTER_DRAIN) { E(acc, cur, wr, wc, fr, fq); S.done(cur); }
        if (!has_next) break;
#pragma unroll
        for (int a = 0; a < 2; ++a)
#pragma unroll
            for (int b = 0; b < 2; ++b)
#pragma unroll
                for (int m = 0; m < 4; ++m)
#pragma unroll
                    for (int n = 0; n < 2; ++n) acc[a][b][m][n] = (f32x4){0.f, 0.f, 0.f, 0.f};
        cur = nxt; cA = nA; cB = nB; ++ui;
        if constexpr (ALIGN_EPI) { if (wr == 1) PG8_BAR; }
    }
    PG8_WAIT_V(0);
    if constexpr (!ALIGN_EPI) { if (wr == 0) PG8_BAR; }
    PG8_BAR;
    if constexpr (Epi::AFTER_DRAIN) { E.fused(acc, cur, wr, wc, fr, fq, lds, wid, lane); S.done(cur); }
#undef PG8_SA
#undef PG8_SB
#undef PG8_STAGE
#undef PG8_LDA
#undef PG8_LDB
#undef PG8_MMA
#undef PG8_WAIT_V
#undef PG8_WAIT_L
#undef PG8_BAR
#undef PG8_SCHED
}
}
namespace att {
#define ATT_LAS __attribute__((address_space(3)))
typedef unsigned short bf16;
typedef short bf16x8 __attribute__((ext_vector_type(8)));
typedef short s16x4 __attribute__((ext_vector_type(4)));
typedef float f32x16 __attribute__((ext_vector_type(16)));
typedef float f32x4_t __attribute__((ext_vector_type(4)));
typedef unsigned u32x4 __attribute__((ext_vector_type(4)));
typedef unsigned u32x2 __attribute__((ext_vector_type(2)));
typedef float f32x2_t __attribute__((ext_vector_type(2))); typedef __bf16 bf16x2_t __attribute__((ext_vector_type(2)));
__device__ __forceinline__ unsigned cvtpk(float lo, float hi) { f32x2_t v = {lo, hi}; bf16x2_t b = __builtin_convertvector(v, bf16x2_t); return __builtin_bit_cast(unsigned, b); }
__device__ __forceinline__ s16x4 vtr(const ATT_LAS unsigned char* p) { return __builtin_bit_cast(s16x4, __builtin_amdgcn_ds_read_tr16_b64_v4i16((ATT_LAS s16x4*)p)); }
constexpr int VSTR = 192;
template <int DQK> struct Geo { static constexpr int KSTR = DQK * 2 + 16, KBUF = 64 * KSTR, VBUF = 64 * VSTR, CPR = DQK / 8, NKC = 64 * CPR, KIT = (NKC + 511) / 512; };
template <int DQK> constexpr int lds_bytes() { return 3 * Geo<DQK>::KBUF + 3 * Geo<DQK>::VBUF + 2048 + 8192; }

__device__ __forceinline__ float xhalf_sum(float m) { return xor32_sum(m); }
__device__ __forceinline__ float max3f(float a, float b, float c) { float r; asm("v_max3_f32 %0, %1, %2, %3" : "=v"(r) : "v"(a), "v"(b), "v"(c)); return r; }
__device__ __forceinline__ float max2f(float a, float b) { float r; asm("v_max_f32_e32 %0, %1, %2" : "=v"(r) : "v"(a), "v"(b)); return r; }
__device__ __forceinline__ float rowmax32(const f32x16& p0, const f32x16& p1) {
    float a = max2f(p0[0], p1[0]), b = max2f(p0[1], p1[1]), c = max2f(p0[2], p1[2]), d = max2f(p0[3], p1[3]);
#pragma unroll
    for (int r = 4; r < 16; r += 4) { a = max3f(a, p0[r], p1[r]); b = max3f(b, p0[r + 1], p1[r + 1]); c = max3f(c, p0[r + 2], p1[r + 2]); d = max3f(d, p0[r + 3], p1[r + 3]); }
    const float m = max2f(max2f(a, b), max2f(c, d));
    float lo_, hi_; halves32(m, lo_, hi_);
    return max2f(lo_, hi_);
}

template <int DQK, int kpitch, int vpitch, int NS>
__device__ __forceinline__ void attn_init(ATT_LAS unsigned char* lds, const int wave_idx) {
    typedef Geo<DQK> G;
    const int lane = lane_id_(), wid = wave_idx;
    constexpr int KCPL = G::KSTR / 16, KNP = (64 * KCPL + 63) / 64, VCPL = VSTR / 16, VNP = 64 * VCPL / 64, KPP = (KNP + 7) / 8, VPP = (VNP + 7) / 8;
    ATT_LAS unsigned* dmaL = (ATT_LAS unsigned*)(lds + NS * G::KBUF + NS * G::VBUF + 2048) + wid * 256 + lane;
#pragma unroll
    for (int pp = 0; pp < KPP; ++pp) { const int pc = wid + 8 * pp, c = pc * 64 + lane, row = (c / KCPL) & 63, ch = c % KCPL; dmaL[64 * pp] = (unsigned)(row * kpitch + (ch < G::CPR ? ch : 0) * 8) * 2u; }
#pragma unroll
    for (int pp = 0; pp < VPP; ++pp) { const int pc = wid + 8 * pp, c = pc * 64 + lane, row = (c / VCPL) & 63, ch = c % VCPL; dmaL[128 + 64 * pp] = (unsigned)(row * vpitch + (ch < 8 ? ch : 0) * 8) * 2u; }
}

template <int DQK, bool BAND, int qpitch, int kpitch, int vpitch, int opitch, bool OF8 = false, bool NOMAX = false, int NS = 2, int DBG = 0>
__device__ __forceinline__ void attn_unit(ATT_LAS unsigned char* lds, const bf16* Qb, const bf16* Kb, const bf16* Vb, bf16* Ob,
                                          int q0, int t_lo, int t_hi, int my_lo, int my_hi, int cc, const float* bias_g, const float* g_qn, const float* rope, const int wave_idx, const bool load_bias = true) {
    typedef Geo<DQK> G;
    int tid_ = wave_idx * 64 + lane_id_(); asm volatile("" : "+v"(tid_));
    const int tid = tid_, lane = tid & 63, r32 = lane & 31, hi = lane >> 5, wid = __builtin_amdgcn_readfirstlane(tid >> 6);
    ATT_LAS float* biasL = (ATT_LAS float*)(lds + NS * G::KBUF + NS * G::VBUF);
    constexpr int KCPL = G::KSTR / 16, KNP = (64 * KCPL + 63) / 64;
    constexpr int VCPL = VSTR / 16, VNP = 64 * VCPL / 64;
    constexpr int KPP = (KNP + 7) / 8, VPP = (VNP + 7) / 8;
    ATT_LAS unsigned* dmaL = (ATT_LAS unsigned*)(lds + NS * G::KBUF + NS * G::VBUF + 2048) + wid * 256 + lane;
    const unsigned ldsb = __builtin_amdgcn_readfirstlane((unsigned)(size_t)lds);
    const int kc = (KNP - 1 - wid) / 8 + 1, vc = (VNP - 1 - wid) / 8 + 1;
#define ATT_MOD3(x) (NS == 3 ? (x) - 3 * (((x) * 43) >> 7) : ((x) & 1))
#define ATT_DMA1(gptr, voff_, ldsaddr) do { unsigned keep_; asm volatile("s_mov_b32 %0, m0\n\ts_mov_b32 m0, %3\n\ts_nop 0\n\tglobal_load_lds_dwordx4 %1, %2\n\ts_mov_b32 m0, %0" \
            : "=&s"(keep_) : "v"(voff_), "s"(gptr), "s"(ldsaddr) : "memory"); } while (0)
#define ATT_DMA_K(t) do { const int t_ = (t); const char* kt_ = (const char*)(Kb + (size_t)t_ * 64 * kpitch); const unsigned d_ = ldsb + ATT_MOD3(t_) * G::KBUF + wid * 1024; \
        _Pragma("unroll") for (int pp = 0; pp < KPP; ++pp) { if (wid + 8 * pp < KNP) { const unsigned vo_ = dmaL[64 * pp]; ATT_DMA1(kt_, vo_, d_ + pp * 8192); } } } while (0)
#define ATT_DMA_V(t) do { const int t_ = (t); const char* vt_ = (const char*)(Vb + (size_t)t_ * 64 * vpitch); const unsigned d_ = ldsb + NS * G::KBUF + ATT_MOD3(t_) * G::VBUF + wid * 1024; \
        _Pragma("unroll") for (int pp = 0; pp < VPP; ++pp) { if (wid + 8 * pp < VNP) { const unsigned vo_ = dmaL[128 + 64 * pp]; ATT_DMA1(vt_, vo_, d_ + pp * 8192); } } } while (0)
#define ATT_WAITBAR(n) do { const int n_ = (n); \
        if (n_ == 0) asm volatile("s_waitcnt vmcnt(0) lgkmcnt(0)\n\ts_barrier" ::: "memory"); else if (n_ == 1) asm volatile("s_waitcnt vmcnt(1) lgkmcnt(0)\n\ts_barrier" ::: "memory"); \
        else if (n_ == 2) asm volatile("s_waitcnt vmcnt(2) lgkmcnt(0)\n\ts_barrier" ::: "memory"); else if (n_ == 3) asm volatile("s_waitcnt vmcnt(3) lgkmcnt(0)\n\ts_barrier" ::: "memory"); \
        else asm volatile("s_waitcnt vmcnt(4) lgkmcnt(0)\n\ts_barrier" ::: "memory"); } while (0)
    ATT_DMA_K(t_lo); ATT_DMA_V(t_lo);
    if (t_lo + 1 <= t_hi) { ATT_DMA_K(t_lo + 1); if (NS == 3) ATT_DMA_V(t_lo + 1); }
    if (NS == 3) { if (t_lo + 2 <= t_hi) ATT_DMA_K(t_lo + 2); }
    if (BAND) { if (load_bias && tid < 257) biasL[tid] = bias_g[tid] * 1.4426950408889634f; }
    bf16x8 qf[DQK / 16];
    { const bf16* qp = Qb + (size_t)(q0 + wid * 32 + r32) * qpitch + 8 * hi;
#pragma unroll
      for (int kk = 0; kk < DQK / 16; ++kk) { if constexpr (DBG & 8) qf[kk] = (bf16x8){(short)lane, 1, 2, 3, 4, 5, 6, 7}; else qf[kk] = *(const bf16x8*)(qp + 16 * kk); } }
    if constexpr (!BAND) {
        float qv[DQK / 16][8]; float ss = 0.f;
#pragma unroll
        for (int kk = 0; kk < DQK / 16; ++kk)
#pragma unroll
            for (int j = 0; j < 8; ++j) { qv[kk][j] = __builtin_bit_cast(float, (unsigned)(unsigned short)qf[kk][j] << 16); ss += qv[kk][j] * qv[kk][j]; }
        ss = xhalf_sum(ss);
        const float rs = __builtin_amdgcn_rsqf(ss * (1.f / DQK) + 1e-6f) * (0.10206207261596577f * 1.4426950408889634f);
#pragma unroll
        for (int kk = 0; kk < DQK / 16; ++kk) { const f32x4_t g0 = *(const f32x4_t*)(g_qn + 16 * kk + 8 * hi), g1 = *(const f32x4_t*)(g_qn + 16 * kk + 8 * hi + 4);
#pragma unroll
            for (int j = 0; j < 4; ++j) { qv[kk][j] *= rs * g0[j]; qv[kk][4 + j] *= rs * g1[j]; } }
        const f32x4_t* rp = (const f32x4_t*)(rope + ((size_t)(q0 + wid * 32 + r32) * 16 + 8 * hi) * 2);
#pragma unroll
        for (int j2 = 0; j2 < 4; ++j2) { const f32x4_t cs = rp[j2];
            { const float x1 = qv[4][2 * j2], x2 = qv[5][2 * j2]; qv[4][2 * j2] = x1 * cs[0] - x2 * cs[1]; qv[5][2 * j2] = x2 * cs[0] + x1 * cs[1]; }
            { const float x1 = qv[4][2 * j2 + 1], x2 = qv[5][2 * j2 + 1]; qv[4][2 * j2 + 1] = x1 * cs[2] - x2 * cs[3]; qv[5][2 * j2 + 1] = x2 * cs[2] + x1 * cs[3]; } }
#pragma unroll
        for (int kk = 0; kk < DQK / 16; ++kk) { u32x4 w; w.x = cvtpk(qv[kk][0], qv[kk][1]); w.y = cvtpk(qv[kk][2], qv[kk][3]); w.z = cvtpk(qv[kk][4], qv[kk][5]); w.w = cvtpk(qv[kk][6], qv[kk][7]);
            qf[kk] = __builtin_bit_cast(bf16x8, w); }
    }
    f32x16 o0, o1;
#pragma unroll
    for (int i = 0; i < 16; ++i) { o0[i] = 0.f; o1[i] = 0.f; }
    float mrun = -INFINITY, lsum = 0.f; float ls4[4] = {0.f, 0.f, 0.f, 0.f};
    const int koff = r32 * G::KSTR + hi * 16;
    const int voff = ((lane >> 5) * 4 + ((lane & 15) >> 2)) * VSTR + (((lane >> 4) & 1) * 16 + (lane & 3) * 4) * 2;
    const f32x16 zero16 = {0.f, 0.f, 0.f, 0.f, 0.f, 0.f, 0.f, 0.f, 0.f, 0.f, 0.f, 0.f, 0.f, 0.f, 0.f, 0.f};
#define ATT_QK(X0, X1, t) do { const ATT_LAS unsigned char* Kt = lds + ATT_MOD3(t) * G::KBUF + koff; \
        _Pragma("unroll") for (int kk = 0; kk < DQK / 16; ++kk) { \
            const bf16x8 a0 = *(const ATT_LAS bf16x8*)(Kt + kk * 32); const bf16x8 a1 = *(const ATT_LAS bf16x8*)(Kt + 32 * G::KSTR + kk * 32); \
            X0 = __builtin_amdgcn_mfma_f32_32x32x16_bf16(a0, qf[kk], kk ? X0 : zero16, 0, 0, 0); X1 = __builtin_amdgcn_mfma_f32_32x32x16_bf16(a1, qf[kk], kk ? X1 : zero16, 0, 0, 0); } } while (0)
#define ATT_FARSCALE() do { const float f_ = __builtin_amdgcn_exp2f(biasL[256]); _Pragma("unroll") for (int i = 0; i < 16; ++i) { o0[i] *= f_; o1[i] *= f_; } \
        ls4[0] *= f_; ls4[1] *= f_; ls4[2] *= f_; ls4[3] *= f_; } while (0)
#define ATT_SMPV(X0, X1, t) do { \
        float cadd = 0.f; \
        if (BAND && !(DBG & 2)) { const int delta = cc - (t); \
            if (delta >= 3) { if constexpr (!NOMAX) cadd = biasL[256]; } \
            else { const ATT_LAS float* bp = biasL + (64 * delta + (32 * (wid & 1) + r32) - 4 * hi + 128 - 63); \
                if (delta < 2) { _Pragma("unroll") for (int i = 0; i < 16; ++i) { const int kj = (i & 3) + 8 * (i >> 2); X0[i] += bp[63 - kj]; X1[i] += bp[31 - kj]; } } \
                else { const int relb = 64 * delta + (32 * (wid & 1) + r32) - 4 * hi + 128; \
                    _Pragma("unroll") for (int i = 0; i < 16; ++i) { const int kj = (i & 3) + 8 * (i >> 2); int i0 = relb - kj, i1 = relb - kj - 32; i0 = i0 > 256 ? 256 : i0; i1 = i1 > 256 ? 256 : i1; \
                        X0[i] += biasL[i0]; X1[i] += biasL[i1]; } } } } \
        if constexpr (NOMAX) { \
            _Pragma("unroll") for (int i = 0; i < 16; ++i) { X0[i] = __builtin_amdgcn_exp2f(X0[i]); X1[i] = __builtin_amdgcn_exp2f(X1[i]); ls4[i & 3] += X0[i] + X1[i]; } \
        } else { \
        const float mt = rowmax32(X0, X1) + cadd; \
        const float mnew = max2f(mrun, mt); \
        const float alpha = __builtin_amdgcn_exp2f(mrun - mnew); \
        const float msub = mnew - cadd; \
        mrun = mnew; \
        float psa[4] = {0.f, 0.f, 0.f, 0.f};   \
        _Pragma("unroll") for (int i = 0; i < 16; ++i) { X0[i] = __builtin_amdgcn_exp2f(X0[i] - msub); X1[i] = __builtin_amdgcn_exp2f(X1[i] - msub); psa[i & 3] += X0[i] + X1[i]; } \
        const float ps = (psa[0] + psa[1]) + (psa[2] + psa[3]); \
        lsum = lsum * alpha + ps; \
        _Pragma("unroll") for (int i = 0; i < 16; ++i) { o0[i] *= alpha; o1[i] *= alpha; } } \
        bf16x8 pf[2][2]; \
        _Pragma("unroll") for (int s = 0; s < 2; ++s) { u32x4 w0, w1; \
            w0.x = cvtpk(X0[8 * s + 0], X0[8 * s + 1]); w0.y = cvtpk(X0[8 * s + 2], X0[8 * s + 3]); w0.z = cvtpk(X0[8 * s + 4], X0[8 * s + 5]); w0.w = cvtpk(X0[8 * s + 6], X0[8 * s + 7]); \
            w1.x = cvtpk(X1[8 * s + 0], X1[8 * s + 1]); w1.y = cvtpk(X1[8 * s + 2], X1[8 * s + 3]); w1.z = cvtpk(X1[8 * s + 4], X1[8 * s + 5]); w1.w = cvtpk(X1[8 * s + 6], X1[8 * s + 7]); \
            pf[0][s] = __builtin_bit_cast(bf16x8, w0); pf[1][s] = __builtin_bit_cast(bf16x8, w1); } \
        const ATT_LAS unsigned char* Vt = lds + NS * G::KBUF + ATT_MOD3(t) * G::VBUF + voff; \
        _Pragma("unroll") for (int kb = 0; kb < 2; ++kb) _Pragma("unroll") for (int s = 0; s < 2; ++s) { \
            const ATT_LAS unsigned char* vp = Vt + (32 * kb + 16 * s) * VSTR; \
            const s16x4 l0 = vtr(vp), h0 = vtr(vp + 8 * VSTR), l1 = vtr(vp + 64), h1 = vtr(vp + 8 * VSTR + 64); \
            const bf16x8 a0 = (bf16x8){l0[0], l0[1], l0[2], l0[3], h0[0], h0[1], h0[2], h0[3]}; \
            const bf16x8 a1 = (bf16x8){l1[0], l1[1], l1[2], l1[3], h1[0], h1[1], h1[2], h1[3]}; \
            o0 = __builtin_amdgcn_mfma_f32_32x32x16_bf16(a0, pf[kb][s], o0, 0, 0, 0); o1 = __builtin_amdgcn_mfma_f32_32x32x16_bf16(a1, pf[kb][s], o1, 0, 0, 0); } \
        if constexpr (NOMAX && BAND) { if (cc - (t) == 3) ATT_FARSCALE(); } } while (0)
#define ATT_FUSED(C0, C1, N0, N1, t, tn) do { \
        bf16x8 kfa[DQK / 16], kfb[DQK / 16]; \
        { const ATT_LAS unsigned char* Kt = lds + ATT_MOD3(tn) * G::KBUF + koff; \
          _Pragma("unroll") for (int kk = 0; kk < DQK / 16; ++kk) { kfa[kk] = *(const ATT_LAS bf16x8*)(Kt + kk * 32); kfb[kk] = *(const ATT_LAS bf16x8*)(Kt + 32 * G::KSTR + kk * 32); } } \
        if constexpr (!NOMAX) __builtin_amdgcn_sched_barrier(0); \
        float cadd = 0.f; \
        if (BAND && !(DBG & 2)) { const int delta = cc - (t); \
            if (delta >= 3) { if constexpr (!NOMAX) cadd = biasL[256]; } \
            else { const ATT_LAS float* bp = biasL + (64 * delta + (32 * (wid & 1) + r32) - 4 * hi + 128 - 63); \
                if (delta < 2) { _Pragma("unroll") for (int i = 0; i < 16; ++i) { const int kj = (i & 3) + 8 * (i >> 2); C0[i] += bp[63 - kj]; C1[i] += bp[31 - kj]; } } \
                else { const int relb = 64 * delta + (32 * (wid & 1) + r32) - 4 * hi + 128; \
                    _Pragma("unroll") for (int i = 0; i < 16; ++i) { const int kj = (i & 3) + 8 * (i >> 2); int i0 = relb - kj, i1 = relb - kj - 32; i0 = i0 > 256 ? 256 : i0; i1 = i1 > 256 ? 256 : i1; \
                        C0[i] += biasL[i0]; C1[i] += biasL[i1]; } } } } \
        float alpha = 1.f, msub = 0.f; \
        if constexpr (!NOMAX) { \
        const float mt = rowmax32(C0, C1) + cadd; \
        const float mnew = max2f(mrun, mt); \
        alpha = __builtin_amdgcn_exp2f(mrun - mnew); \
        msub = mnew - cadd; \
        if (__builtin_amdgcn_ballot_w64(mnew > mrun)) { _Pragma("unroll") for (int i = 0; i < 16; ++i) { o0[i] *= alpha; o1[i] *= alpha; } } \
        mrun = mnew; } \
        if constexpr (!NOMAX || BAND) __builtin_amdgcn_sched_barrier(0); \
        _Pragma("unroll") for (int kk = 0; kk < DQK / 16; ++kk) { \
            N0 = __builtin_amdgcn_mfma_f32_32x32x16_bf16(kfa[kk], qf[kk], kk ? N0 : zero16, 0, 0, 0); N1 = __builtin_amdgcn_mfma_f32_32x32x16_bf16(kfb[kk], qf[kk], kk ? N1 : zero16, 0, 0, 0); } \
        s16x4 vl0[4], vh0[4], vl1[4], vh1[4]; \
        { const ATT_LAS unsigned char* Vt = lds + NS * G::KBUF + ATT_MOD3(t) * G::VBUF + voff; \
          _Pragma("unroll") for (int ks = 0; ks < 4; ++ks) { const ATT_LAS unsigned char* vp = Vt + 16 * ks * VSTR; vl0[ks] = vtr(vp); vh0[ks] = vtr(vp + 8 * VSTR); vl1[ks] = vtr(vp + 64); vh1[ks] = vtr(vp + 8 * VSTR + 64); } } \
        if constexpr (NOMAX) { \
            _Pragma("unroll") for (int i = 0; i < 16; ++i) { C0[i] = __builtin_amdgcn_exp2f(C0[i]); C1[i] = __builtin_amdgcn_exp2f(C1[i]); ls4[i & 3] += C0[i] + C1[i]; } \
        } else { \
        float psa[4] = {0.f, 0.f, 0.f, 0.f}; \
        _Pragma("unroll") for (int i = 0; i < 16; ++i) { C0[i] = __builtin_amdgcn_exp2f(C0[i] - msub); C1[i] = __builtin_amdgcn_exp2f(C1[i] - msub); psa[i & 3] += C0[i] + C1[i]; } \
        const float ps = (psa[0] + psa[1]) + (psa[2] + psa[3]); \
        lsum = lsum * alpha + ps; } \
        bf16x8 pf[4]; \
        _Pragma("unroll") for (int s = 0; s < 2; ++s) { u32x4 w0, w1; \
            w0.x = cvtpk(C0[8 * s + 0], C0[8 * s + 1]); w0.y = cvtpk(C0[8 * s + 2], C0[8 * s + 3]); w0.z = cvtpk(C0[8 * s + 4], C0[8 * s + 5]); w0.w = cvtpk(C0[8 * s + 6], C0[8 * s + 7]); \
            w1.x = cvtpk(C1[8 * s + 0], C1[8 * s + 1]); w1.y = cvtpk(C1[8 * s + 2], C1[8 * s + 3]); w1.z = cvtpk(C1[8 * s + 4], C1[8 * s + 5]); w1.w = cvtpk(C1[8 * s + 6], C1[8 * s + 7]); \
            pf[s] = __builtin_bit_cast(bf16x8, w0); pf[2 + s] = __builtin_bit_cast(bf16x8, w1); } \
        __builtin_amdgcn_sched_barrier(0); \
        _Pragma("unroll") for (int ks = 0; ks < 4; ++ks) { \
            const bf16x8 a0 = (bf16x8){vl0[ks][0], vl0[ks][1], vl0[ks][2], vl0[ks][3], vh0[ks][0], vh0[ks][1], vh0[ks][2], vh0[ks][3]}; \
            const bf16x8 a1 = (bf16x8){vl1[ks][0], vl1[ks][1], vl1[ks][2], vl1[ks][3], vh1[ks][0], vh1[ks][1], vh1[ks][2], vh1[ks][3]}; \
            o0 = __builtin_amdgcn_mfma_f32_32x32x16_bf16(a0, pf[ks], o0, 0, 0, 0); o1 = __builtin_amdgcn_mfma_f32_32x32x16_bf16(a1, pf[ks], o1, 0, 0, 0); } \
        if constexpr (NOMAX && BAND) { if (cc - (t) == 3) ATT_FARSCALE(); } } while (0)
#define ATT_STAGE(t) do { if ((t) + NS <= t_hi) ATT_DMA_K((t) + NS); if ((t) + NS - 1 <= t_hi) ATT_DMA_V((t) + NS - 1); } while (0)
#define ATT_NFL(t) (NS == 3 ? ((t) + 3 <= t_hi ? kc : 0) + ((t) + 2 <= t_hi ? vc : 0) : 0)
    f32x16 sa0, sa1, sb0, sb1;
    ATT_WAITBAR(0);
    if (my_lo == t_lo) ATT_QK(sa0, sa1, t_lo);
    ATT_WAITBAR(0);
    {
        int t = t_lo;
        for (; t < my_lo - 1; ++t) { ATT_STAGE(t); ATT_WAITBAR(ATT_NFL(t)); }
        if (my_lo > t_lo) { ATT_STAGE(t); ATT_QK(sa0, sa1, t + 1); ATT_WAITBAR(ATT_NFL(t)); ++t; }
        int nf = my_hi - my_lo;
        for (; nf >= 2; nf -= 2, t += 2) {
            ATT_STAGE(t); ATT_FUSED(sa0, sa1, sb0, sb1, t, t + 1); ATT_WAITBAR(ATT_NFL(t));
            ATT_STAGE(t + 1); ATT_FUSED(sb0, sb1, sa0, sa1, t + 1, t + 2); ATT_WAITBAR(ATT_NFL(t + 1));
        }
        if (nf == 1) {
            ATT_STAGE(t); ATT_FUSED(sa0, sa1, sb0, sb1, t, t + 1); ATT_WAITBAR(ATT_NFL(t)); ++t;
            ATT_STAGE(t); ATT_SMPV(sb0, sb1, t); ATT_WAITBAR(ATT_NFL(t)); ++t;
        } else {
            ATT_STAGE(t); ATT_SMPV(sa0, sa1, t); ATT_WAITBAR(ATT_NFL(t)); ++t;
        }
        for (; t <= t_hi; ++t) { ATT_STAGE(t); ATT_WAITBAR(ATT_NFL(t)); }
    }
    if constexpr (NOMAX) lsum = (ls4[0] + ls4[1]) + (ls4[2] + ls4[3]);
    const float ltot = xhalf_sum(lsum);
    const float inv = 1.f / ltot;
    if constexpr (DBG & 4) { if (ltot == 12345.678f) *(float*)Ob = o0[0] + o1[0]; } else
    if constexpr (OF8) {
        const float i64 = inv * 32.f;
        int w0[4], w1[4];
#pragma unroll
        for (int g4 = 0; g4 < 4; ++g4) { w0[g4] = 0; w1[g4] = 0;
            w0[g4] = __builtin_amdgcn_cvt_pk_fp8_f32(o0[4 * g4 + 0] * i64, o0[4 * g4 + 1] * i64, w0[g4], false); w0[g4] = __builtin_amdgcn_cvt_pk_fp8_f32(o0[4 * g4 + 2] * i64, o0[4 * g4 + 3] * i64, w0[g4], true);
            w1[g4] = __builtin_amdgcn_cvt_pk_fp8_f32(o1[4 * g4 + 0] * i64, o1[4 * g4 + 1] * i64, w1[g4], false); w1[g4] = __builtin_amdgcn_cvt_pk_fp8_f32(o1[4 * g4 + 2] * i64, o1[4 * g4 + 3] * i64, w1[g4], true); }
        asm volatile("s_nop 1\n\tv_permlane32_swap_b32 %0, %1\n\tv_permlane32_swap_b32 %2, %3\n\tv_permlane32_swap_b32 %4, %5\n\tv_permlane32_swap_b32 %6, %7\n\ts_nop 1"
                     : "+v"(w0[2]), "+v"(w0[0]), "+v"(w0[3]), "+v"(w0[1]), "+v"(w1[2]), "+v"(w1[0]), "+v"(w1[3]), "+v"(w1[1]));
        unsigned char* op = (unsigned char*)Ob + (size_t)(q0 + wid * 32 + r32) * opitch + (hi ? 0 : 16);
        *(u32x4*)op = (u32x4){(unsigned)w0[2], (unsigned)w0[0], (unsigned)w0[3], (unsigned)w0[1]};
        *(u32x4*)(op + 32) = (u32x4){(unsigned)w1[2], (unsigned)w1[0], (unsigned)w1[3], (unsigned)w1[1]};
    } else {
    bf16* op = Ob + (size_t)(q0 + wid * 32 + r32) * opitch + 4 * hi;
#pragma unroll
    for (int g4 = 0; g4 < 4; ++g4) {
        u32x2 w0, w1;
        w0.x = cvtpk(o0[4 * g4 + 0] * inv, o0[4 * g4 + 1] * inv); w0.y = cvtpk(o0[4 * g4 + 2] * inv, o0[4 * g4 + 3] * inv);
        w1.x = cvtpk(o1[4 * g4 + 0] * inv, o1[4 * g4 + 1] * inv); w1.y = cvtpk(o1[4 * g4 + 2] * inv, o1[4 * g4 + 3] * inv);
        *(u32x2*)(op + 8 * g4) = w0; *(u32x2*)(op + 32 + 8 * g4) = w1;
    }
    }
#undef ATT_DMA_K
#undef ATT_DMA_V
#undef ATT_QK
#undef ATT_SMPV
#undef ATT_STAGE
#undef ATT_FUSED
#undef ATT_MOD3
#undef ATT_DMA1
#undef ATT_WAITBAR
#undef ATT_NFL
#undef ATT_FARSCALE
}
}
constexpr int NWAVES = 8;
constexpr int D = 1024, BATCH = 32, SEQ = 2048, M = BATCH * SEQ;
constexpr int NH = 16, QLORA = 384, KVLORA = 256, ROPE_D = 32, NOPE = 64, QKD = 96;
constexpr int NA = 768;
constexpr int FF = 2816, EFF = 3584, NE = 8;
constexpr float EPS = 1e-6f, LOG2E = 1.4426950408889634f;
constexpr int MAXP_HALF = 264, MAXP = 528;
constexpr size_t MiB = 1u << 20;
constexpr size_t WS_CTL = 0, CTL_ZERO_BYTES = 1 * MiB;
constexpr size_t WS_ROPE = 1 * MiB;
constexpr size_t WS_CNT = WS_ROPE + 256 * 1024;
constexpr size_t WS_PANELE = WS_CNT + 16 * 1024;
constexpr size_t WS_META = WS_PANELE + 4096;
constexpr size_t WS_TOKE = 2 * MiB;
constexpr size_t WS_TOKG = WS_TOKE + (size_t)M * 4;
constexpr size_t WS_SLOTTOK = WS_TOKG + (size_t)M * 8;
constexpr size_t WS_SLOTGATE = WS_SLOTTOK + (size_t)MAXP * 256 * 4;
constexpr size_t WS_PARTQA = 976 * MiB, WS_PART1 = 980 * MiB, WS_PART2 = 984 * MiB;
constexpr size_t WS_TOKRSTD = 4 * MiB;
constexpr size_t WS_SLOTRSTD = WS_TOKRSTD + (size_t)M * 4;
static_assert(WS_SLOTGATE + (size_t)MAXP * 256 * 4 <= WS_TOKRSTD && WS_SLOTRSTD + (size_t)MAXP * 256 * 4 <= 8 * MiB, "small arrays");
constexpr size_t WS_W = 8 * MiB;
constexpr size_t WS_WA = WS_W, WS_WUQ = WS_WA + (size_t)NA * D * 2, WS_WUKV = WS_WUQ + (size_t)1536 * QLORA * 2, WS_WO = WS_WUKV + (size_t)2048 * KVLORA * 2;
constexpr size_t WS_WF1 = WS_WO + (size_t)D * D * 2, WS_WF2 = WS_WF1 + (size_t)2 * FF * D * 2, WS_WKVQ = WS_WF2 + (size_t)D * FF * 2, WS_WBO = WS_WKVQ + (size_t)3 * D * D * 2;
constexpr size_t WS_WM1 = WS_WBO + (size_t)D * D * 2, WS_WM2 = WS_WM1 + (size_t)NE * 2 * EFF * D * 2, WS_WEND = WS_WM2 + (size_t)NE * D * EFF * 2;
constexpr size_t ARENA = 208 * MiB;
static_assert(WS_WEND <= ARENA, "weights fit under the arena");
constexpr size_t WS_XN = ARENA;
constexpr size_t WS_QA = ARENA + 128 * MiB;
constexpr size_t WS_Q = ARENA + 224 * MiB;
constexpr size_t WS_K = ARENA + 416 * MiB;
constexpr size_t WS_V = ARENA + 608 * MiB;
constexpr size_t WS_O = ARENA;
static_assert(WS_V + (size_t)M * D * 2 <= 1024 * MiB, "MLA arena");
constexpr size_t WS_XR1 = ARENA + 128 * MiB;
constexpr size_t WS_H = ARENA + 256 * MiB;
constexpr size_t WS_XR2 = ARENA;
constexpr size_t WS_X2B = ARENA + 608 * MiB;
constexpr size_t WS_KVQ2 = ARENA + 128 * MiB;
constexpr size_t WS_O2 = ARENA + 512 * MiB;
constexpr size_t WS_XR3 = ARENA + 132 * MiB;
constexpr size_t WS_XG = ARENA;
constexpr size_t WS_HM = ARENA + 264 * MiB;
constexpr size_t WS_END = WS_HM + (size_t)MAXP_HALF * 256 * EFF * 2;
static_assert(WS_XG + (size_t)MAXP * 256 * D <= WS_XR3 && WS_XR3 + (size_t)M * D * 2 <= WS_HM && WS_END <= 1024 * MiB && WS_H + (size_t)M * FF * 2 <= WS_X2B && WS_X2B + (size_t)M * D * 2 <= 976 * MiB && WS_O2 + (size_t)M * D <= WS_X2B, "arena");
constexpr int CW_BAR = 4096;
constexpr int RING_OFF = 0, RING_BYTES = 131072;
constexpr int P0_SCR = 128 * 33 * 4;
constexpr int LDSCTL_OFF = 8 * P0_SCR, MISC_OFF = LDSCTL_OFF + 320;
static_assert(LDSCTL_OFF >= RING_BYTES, "control words above every phase's scratch");
constexpr int LDS_BYTES = 147456;
static_assert(MISC_OFF + 128 <= LDS_BYTES, "LDS map");
static_assert(att::lds_bytes<96>() <= RING_BYTES, "attention scratch fits the ring region");

#define GAS __attribute__((address_space(1)))
#define LAS __attribute__((address_space(3)))
typedef unsigned short bf16;
typedef unsigned v4u __attribute__((ext_vector_type(4)));
typedef unsigned v2u __attribute__((ext_vector_type(2)));
typedef float f32x4 __attribute__((ext_vector_type(4)));
typedef GAS unsigned gu32;
#define RLX_AGENT __ATOMIC_RELAXED, __HIP_MEMORY_SCOPE_AGENT
#define LDS_WAIT() asm volatile("s_waitcnt lgkmcnt(0)" ::: "memory")
__device__ __forceinline__ unsigned f2bf(float f) { unsigned u = __builtin_bit_cast(unsigned, f); return (u + 0x7fffu + ((u >> 16) & 1u)) >> 16; }
__device__ __forceinline__ unsigned pk2(float lo, float hi) { return f2bf(lo) | (f2bf(hi) << 16); }
__device__ __forceinline__ float bflo(unsigned u) { return __builtin_bit_cast(float, u << 16); }
__device__ __forceinline__ float bfhi(unsigned u) { return __builtin_bit_cast(float, u & 0xffff0000u); }
__device__ __forceinline__ float wave_sum(float v) {
    v += swz_xor<1>(v); v += swz_xor<2>(v); v += swz_xor<4>(v); v += swz_xor<8>(v); v += swz_xor<16>(v);
    return xor32_sum(v);
}
__device__ __forceinline__ float wave_maxf(float v) {
    v = fmaxf(v, swz_xor<1>(v)); v = fmaxf(v, swz_xor<2>(v)); v = fmaxf(v, swz_xor<4>(v)); v = fmaxf(v, swz_xor<8>(v)); v = fmaxf(v, swz_xor<16>(v));
    return xor32_max(v);
}

#define XB_TMO      128
#define XB_XCNT(j)  (256  + 64 * (j))
#define XB_XSUB(j)  (1280 + 64 * (j))
#define XB_XGEN(j)  (2304 + 64 * (j))
#define XB_TOP      3328
#define XB_TOPGEN   3392
#define XCD_BAR_WORDS 3456
#define XB_SPIN_CAP (1u << 18)

__device__ __forceinline__ unsigned xb_ld(unsigned* p)              { return __hip_atomic_load(p, __ATOMIC_RELAXED, __HIP_MEMORY_SCOPE_AGENT); }
__device__ __forceinline__ unsigned xb_add(unsigned* p, unsigned v) { return __hip_atomic_fetch_add(p, v, __ATOMIC_RELAXED, __HIP_MEMORY_SCOPE_AGENT); }
__device__ __forceinline__ unsigned xb_xcc_id() { return (unsigned)__builtin_amdgcn_s_getreg((3 << 11) | 20) & 0xFu; }
#define XB_SPIN(cond, bar) do { unsigned _sp = 0; while (cond) { __builtin_amdgcn_s_sleep(1); \
    if ((++_sp & 255u) == 0u) { if (xb_ld(&(bar)[XB_TMO])) break; if (_sp > XB_SPIN_CAP) { atomicAdd(&(bar)[XB_TMO], 1u); break; } } } } while (0)

struct XcdBarrier {
    int t0;
    unsigned* bar; unsigned x;
    volatile LAS unsigned* st;
};

__device__ __forceinline__ XcdBarrier xcd_barrier_post(unsigned* bar, volatile LAS unsigned* st, int t0) {
    XcdBarrier b; b.t0 = t0; b.bar = bar; b.x = xb_xcc_id(); b.st = st;
    if (b.t0) (void)xb_add(&bar[XB_XCNT(b.x)], 1u);
    return b;
}
__device__ __forceinline__ void xcd_barrier_complete(unsigned* bar, unsigned x, unsigned& nloc, unsigned& nx) {
    const unsigned G = gridDim.x * gridDim.y * gridDim.z;
    unsigned sum, cnt, mine, sp = 0u;
    for (;;) {
        sum = 0u; cnt = 0u; mine = 0u;
#pragma unroll
        for (unsigned j = 0; j < 16; ++j) { const unsigned c = xb_ld(&bar[XB_XCNT(j)]); sum += c; cnt += (c > 0u) ? 1u : 0u; mine = (j == x) ? c : mine; }
        if (sum == G) break;
        __builtin_amdgcn_s_sleep(1);
        if ((++sp & 255u) == 0u) { if (xb_ld(&bar[XB_TMO])) break; if (sp > XB_SPIN_CAP) { atomicAdd(&bar[XB_TMO], 1u); break; } }
    }
    nloc = mine > 0u ? mine : 1u; nx = cnt > 0u ? cnt : 1u;
}

__device__ __forceinline__ void xcd_barrier(const XcdBarrier& b) {
    asm volatile("s_waitcnt vmcnt(0)" ::: "memory");
    __syncthreads();
    if (b.t0) {
        unsigned* bar = b.bar;
        __builtin_amdgcn_s_waitcnt(0);
        unsigned nloc = b.st[0], nx = b.st[1];
        if (nloc == 0u) { xcd_barrier_complete(bar, b.x, nloc, nx); b.st[0] = nloc; b.st[1] = nx; }
        const unsigned old = xb_add(&bar[XB_XSUB(b.x)], 1u);
        const unsigned gen = old / nloc;
        if (old + 1u == (gen + 1u) * nloc) {
            __builtin_amdgcn_fence(__ATOMIC_RELEASE, "agent");
            asm volatile("s_waitcnt vmcnt(0)" ::: "memory");
            const unsigned og = xb_add(&bar[XB_TOP], 1u);
            const unsigned tg = og / nx;
            if (og + 1u == (tg + 1u) * nx) xb_add(&bar[XB_TOPGEN], 1u);
            else XB_SPIN(xb_ld(&bar[XB_TOPGEN]) == tg, bar);
            __builtin_amdgcn_fence(__ATOMIC_ACQUIRE, "agent");
            xb_add(&bar[XB_XGEN(b.x)], 1u);
            asm volatile("s_waitcnt vmcnt(0)" ::: "memory");
        } else {
            XB_SPIN(xb_ld(&bar[XB_XGEN(b.x)]) == gen, bar);
            __builtin_amdgcn_fence(__ATOMIC_ACQUIRE, "agent");
            asm volatile("s_waitcnt vmcnt(0)" ::: "memory");
        }
    }
    __syncthreads();
}

struct Args { const float* in[27]; float* out; unsigned char* ws; };
enum { I_X = 0, I_ATTN_NORM, I_FFN_NORM, I_A_WDQ, I_A_GCQ, I_A_WUQ, I_A_WDKV, I_A_GCKV, I_A_WUKV, I_A_GQN, I_A_GKN, I_A_WO, I_KV_NORM, I_KV_WK, I_KV_WV, I_KV_GKN,
       I_B_WQ, I_B_GQN, I_B_RELB, I_B_WO, I_FFN_W1, I_FFN_W3, I_FFN_W2, I_MOE_ROUTER, I_MOE_W1, I_MOE_W3, I_MOE_W2 };

struct Frame {
    LAS unsigned char* lds;
    int wave, vcu, G;
};
typedef const __attribute__((address_space(4))) Args* KArgs;
__device__ __forceinline__ KArgs kargs() { KArgs p = (KArgs)__builtin_amdgcn_kernarg_segment_ptr(); asm volatile("" : "+s"(p)); return p; }
#define INP(i) (kargs()->in[i])
#define OUTP (kargs()->out)
#define WSP (kargs()->ws)
__device__ __forceinline__ int fresh(int v) { asm volatile("" : "+v"(v)); return v; }

__device__ __forceinline__ void tr_item(const float* W, int ldw, int K, int k0, int nsrc0, const float* gain, bf16* WT, int drow0, LAS float* scr, int lane) {
    const int c4 = lane & 7, r = lane >> 3;
    const GAS float* src = (const GAS float*)W + (size_t)(k0 + r) * ldw + nsrc0 + 4 * c4;
    f32x4 v[16];
#pragma unroll
    for (int i = 0; i < 16; ++i) v[i] = *(const GAS f32x4*)(src + (size_t)(8 * i) * ldw);
    if (gain) {
#pragma unroll
        for (int i = 0; i < 16; ++i) v[i] = v[i] * gain[k0 + 8 * i + r];
    }
#pragma unroll
    for (int i = 0; i < 16; ++i) { LAS float* d = scr + (8 * i + r) * 33 + 4 * c4; d[0] = v[i].x; d[1] = v[i].y; d[2] = v[i].z; d[3] = v[i].w; }
    LDS_WAIT(); asm volatile("" ::: "memory");
    const int c16 = lane >> 2;
#pragma unroll
    for (int j = 0; j < 8; ++j) { const int n = (lane & 3) + 4 * j; const LAS float* sp = scr + (8 * c16) * 33 + n;
        v4u o; o.x = pk2(sp[0 * 33], sp[1 * 33]); o.y = pk2(sp[2 * 33], sp[3 * 33]); o.z = pk2(sp[4 * 33], sp[5 * 33]); o.w = pk2(sp[6 * 33], sp[7 * 33]);
        *(GAS v4u*)(WT + (size_t)(drow0 + n) * K + k0 + 8 * c16) = o; }
    LDS_WAIT(); asm volatile("" ::: "memory");
}
__device__ __forceinline__ void tr_plain(const float* W, int K, int N, const float* gain, bf16* WT, int drow_off, LAS float* scr, int item, int lane) {
    const int nblk = N / 32, kb = item / nblk, nb = item % nblk;
    tr_item(W, N, K, 128 * kb, 32 * nb, gain, WT, drow_off + 32 * nb, scr, lane);
}
__device__ __forceinline__ void tr_gated(const float* W, int K, int N, const float* gain, bf16* WT, int half, LAS float* scr, int item, int lane) {
    const int nblk = N / 32, kb = item / nblk, nb = item % nblk, n0 = 32 * nb;
    tr_item(W, N, K, 128 * kb, n0, gain, WT, (n0 >> 7) * 256 + half * 128 + (n0 & 127), scr, lane);
}
__device__ __forceinline__ unsigned pk_fp8x4(float a, float b, float c, float d) { int w = 0; w = __builtin_amdgcn_cvt_pk_fp8_f32(a, b, w, false); w = __builtin_amdgcn_cvt_pk_fp8_f32(c, d, w, true); return (unsigned)w; }
__device__ __forceinline__ void tr_item_f8(const float* W, int ldw, int K, int k0, int nsrc0, const float* gain, unsigned char* WT, int drow0, LAS float* scr, int lane) {
    const int c4 = lane & 7, r = lane >> 3;
    const GAS float* src = (const GAS float*)W + (size_t)(k0 + r) * ldw + nsrc0 + 4 * c4;
    f32x4 v[16];
#pragma unroll
    for (int i = 0; i < 16; ++i) v[i] = *(const GAS f32x4*)(src + (size_t)(8 * i) * ldw);
#pragma unroll
    for (int i = 0; i < 16; ++i) v[i] = v[i] * (gain ? gain[k0 + 8 * i + r] * 64.f : 64.f);
#pragma unroll
    for (int i = 0; i < 16; ++i) { LAS float* d = scr + (8 * i + r) * 33 + 4 * c4; d[0] = v[i].x; d[1] = v[i].y; d[2] = v[i].z; d[3] = v[i].w; }
    LDS_WAIT(); asm volatile("" ::: "memory");
    const int c8 = lane >> 3;
#pragma unroll
    for (int j = 0; j < 4; ++j) { const int n = (lane & 7) + 8 * j; const LAS float* sp = scr + (16 * c8) * 33 + n;
        v4u o; o.x = pk_fp8x4(sp[0 * 33], sp[1 * 33], sp[2 * 33], sp[3 * 33]); o.y = pk_fp8x4(sp[4 * 33], sp[5 * 33], sp[6 * 33], sp[7 * 33]);
        o.z = pk_fp8x4(sp[8 * 33], sp[9 * 33], sp[10 * 33], sp[11 * 33]); o.w = pk_fp8x4(sp[12 * 33], sp[13 * 33], sp[14 * 33], sp[15 * 33]);
        *(GAS v4u*)(WT + (size_t)(drow0 + n) * K + k0 + 16 * c8) = o; }
    LDS_WAIT(); asm volatile("" ::: "memory");
}
__device__ __forceinline__ float rms_row_to_bf16(const float* xrow, bf16* orow, int lane, f32x4 (&v)[4]) {
    const GAS f32x4* xr = (const GAS f32x4*)xrow + lane;
    float s = 0.f;
#pragma unroll
    for (int j = 0; j < 4; ++j) { v[j] = xr[64 * j]; s += (v[j].x * v[j].x + v[j].y * v[j].y) + (v[j].z * v[j].z + v[j].w * v[j].w); }
    const float rstd = 1.f / sqrtf(wave_sum(s) * (1.f / D) + EPS);
    GAS unsigned long long* o8 = (GAS unsigned long long*)orow + lane;
#pragma unroll
    for (int j = 0; j < 4; ++j) o8[64 * j] = (unsigned long long)pk2(v[j].x * rstd, v[j].y * rstd) | ((unsigned long long)pk2(v[j].z * rstd, v[j].w * rstd) << 32);
    return rstd;
}
__device__ __forceinline__ void norm_phase(const Frame& F, const float* x, bf16* xn) {
    const int tid = fresh(F.wave * 64 + lane_id_()), lane = tid & 63; (void)lane;
    const int gw = F.vcu * NWAVES + F.wave, NGW = F.G * NWAVES;
    for (int m = 2 * gw; m < M; m += 2 * NGW) {
        const GAS f32x4* xr = (const GAS f32x4*)(x + (size_t)m * D) + lane;
        f32x4 v[8]; float s0 = 0.f, s1 = 0.f;
#pragma unroll
        for (int j = 0; j < 8; ++j) v[j] = xr[64 * j];
#pragma unroll
        for (int j = 0; j < 4; ++j) { s0 += (v[j].x * v[j].x + v[j].y * v[j].y) + (v[j].z * v[j].z + v[j].w * v[j].w); s1 += (v[4 + j].x * v[4 + j].x + v[4 + j].y * v[4 + j].y) + (v[4 + j].z * v[4 + j].z + v[4 + j].w * v[4 + j].w); }
        const float r0 = 1.f / sqrtf(wave_sum(s0) * (1.f / D) + EPS), r1 = 1.f / sqrtf(wave_sum(s1) * (1.f / D) + EPS);
        GAS unsigned* o4 = (GAS unsigned*)((GAS unsigned char*)xn + (size_t)m * D) + lane;
#pragma unroll
        for (int j = 0; j < 8; ++j) { const float rr = j < 4 ? r0 : r1; o4[64 * j] = pk_fp8x4(v[j].x * rr, v[j].y * rr, v[j].z * rr, v[j].w * rr); }
    }
}

__device__ __forceinline__ void p0_prologue(const Frame& F) {
    const int tid = fresh(F.wave * 64 + lane_id_()), lane = tid & 63; (void)lane;
    LAS float* scr = (LAS float*)(F.lds + RING_OFF + F.wave * P0_SCR);
    unsigned char* ws = WSP;
    const int gw = F.vcu * NWAVES + F.wave, NGW = F.G * NWAVES;
    constexpr int I_DQ = 8 * 12, I_DKV = 8 * 9, I_UQ = 3 * 48, I_UKV = 2 * 64, I_SQ = 8 * 32, I_F13 = 8 * 88, I_F2 = 22 * 32, I_M13 = 8 * 112, I_M2 = 28 * 32;
    constexpr int NSMALL = I_DQ + I_DKV + I_UQ + I_UKV + I_SQ + 2 * I_F13 + I_F2 + 4 * I_SQ;
    constexpr int NITEMS = NSMALL + NE * (2 * I_M13 + I_M2);
    for (int it = gw; it < NITEMS; it += NGW) {
        int r = it;
        if (r < I_DQ)  { const int kb = r / 12, n0 = 32 * (r % 12); tr_item_f8(INP(I_A_WDQ), QLORA, D, 128 * kb, n0, INP(I_ATTN_NORM), ws + WS_WA, n0, scr, lane); continue; } r -= I_DQ;
        if (r < I_DKV) { const int kb = r / 9, n0 = 32 * (r % 9); tr_item_f8(INP(I_A_WDKV), KVLORA + ROPE_D, D, 128 * kb, n0, INP(I_ATTN_NORM), ws + WS_WA, QLORA + n0, scr, lane); continue; } r -= I_DKV;
        if (r < I_UQ)  { tr_plain(INP(I_A_WUQ), QLORA, NH * QKD, INP(I_A_GCQ), (bf16*)(ws + WS_WUQ), 0, scr, r, lane); continue; } r -= I_UQ;
        if (r < I_UKV) { const int kb = r / 64, n0 = 32 * (r % 64), head = n0 >> 7, within = n0 & 127;
            const int drow = within < 64 ? 256 * (head >> 2) + 128 * (within >> 5) + 32 * (head & 3) : 1024 + head * 64 + (within - 64);
            tr_item(INP(I_A_WUKV), NH * 128, KVLORA, 128 * kb, n0, INP(I_A_GCKV), (bf16*)(ws + WS_WUKV), drow, scr, lane); continue; } r -= I_UKV;
        if (r < I_SQ)  { const int kb = r / 32, n0 = 32 * (r % 32); tr_item_f8(INP(I_A_WO), D, D, 128 * kb, n0, nullptr, ws + WS_WO, n0, scr, lane); continue; } r -= I_SQ;
        if (r < I_F13) { tr_gated(INP(I_FFN_W1), D, FF, INP(I_FFN_NORM), (bf16*)(ws + WS_WF1), 0, scr, r, lane); continue; } r -= I_F13;
        if (r < I_F13) { tr_gated(INP(I_FFN_W3), D, FF, INP(I_FFN_NORM), (bf16*)(ws + WS_WF1), 1, scr, r, lane); continue; } r -= I_F13;
        if (r < I_F2)  { tr_plain(INP(I_FFN_W2), FF, D, nullptr, (bf16*)(ws + WS_WF2), 0, scr, r, lane); continue; } r -= I_F2;
        if (r < I_SQ)  { const int kb = r / 32, n0 = 32 * (r % 32), head = n0 >> 6;
            tr_item_f8(INP(I_KV_WK), D, D, 128 * kb, n0, INP(I_KV_NORM), ws + WS_WKVQ, 256 * (head >> 2) + 128 * ((n0 >> 5) & 1) + 32 * (head & 3), scr, lane); continue; } r -= I_SQ;
        if (r < I_SQ)  { const int kb = r / 32, n0 = 32 * (r % 32); tr_item_f8(INP(I_KV_WV), D, D, 128 * kb, n0, INP(I_KV_NORM), ws + WS_WKVQ, 2 * D + n0, scr, lane); continue; } r -= I_SQ;
        if (r < I_SQ)  { const int kb = r / 32, n0 = 32 * (r % 32), head = n0 >> 6;
            tr_item_f8(INP(I_B_WQ), D, D, 128 * kb, n0, INP(I_ATTN_NORM) + D, ws + WS_WKVQ, D + 256 * (head >> 2) + 128 * ((n0 >> 5) & 1) + 32 * (head & 3), scr, lane); continue; } r -= I_SQ;
        if (r < I_SQ)  { const int kb = r / 32, n0 = 32 * (r % 32); tr_item_f8(INP(I_B_WO), D, D, 128 * kb, n0, nullptr, ws + WS_WBO, n0, scr, lane); continue; } r -= I_SQ;
        const int e = r / (2 * I_M13 + I_M2); r -= e * (2 * I_M13 + I_M2);
        if (r < I_M13) { const int kb = r / 112, n0 = 32 * (r % 112);
            tr_item_f8(INP(I_MOE_W1) + (size_t)e * D * EFF, EFF, D, 128 * kb, n0, INP(I_FFN_NORM) + D, ws + WS_WM1 + (size_t)e * 2 * EFF * D, (n0 >> 7) * 256 + (n0 & 127), scr, lane); continue; } r -= I_M13;
        if (r < I_M13) { const int kb = r / 112, n0 = 32 * (r % 112);
            tr_item_f8(INP(I_MOE_W3) + (size_t)e * D * EFF, EFF, D, 128 * kb, n0, INP(I_FFN_NORM) + D, ws + WS_WM1 + (size_t)e * 2 * EFF * D, (n0 >> 7) * 256 + 128 + (n0 & 127), scr, lane); continue; } r -= I_M13;
        { const int kb = r / 32, n0 = 32 * (r % 32); tr_item_f8(INP(I_MOE_W2) + (size_t)e * EFF * D, D, EFF, 128 * kb, n0, nullptr, ws + WS_WM2 + (size_t)e * D * EFF, n0, scr, lane); }
    }
    const int gt = F.vcu * (NWAVES * 64) + tid, NGT = F.G * NWAVES * 64;
    for (int c = gt; c < 96 * D / 16; c += NGT) *((GAS v4u*)(ws + WS_WA + (size_t)(QLORA + KVLORA + ROPE_D) * D) + c) = (v4u){0u, 0u, 0u, 0u};
    for (int c = gt; c < SEQ * 16; c += NGT) { const int pos = c >> 4, i = c & 15;
        const float inv = __builtin_amdgcn_exp2f(-(float)i * (13.287712379549449f / 16.f));
        const float rev = (float)pos * inv * 0.15915494309189535f; const float fr = rev - floorf(rev);
        ((GAS float*)(ws + WS_ROPE))[2 * c] = __builtin_amdgcn_cosf(fr); ((GAS float*)(ws + WS_ROPE))[2 * c + 1] = __builtin_amdgcn_sinf(fr); }
    norm_phase(F, INP(I_X), (bf16*)(ws + WS_XN));
}

__device__ __forceinline__ void route_phase(const Frame& F) {
    const int tid = fresh(F.wave * 64 + lane_id_()), lane = tid & 63;
    unsigned char* ws = WSP;
    LAS float* wrg = (LAS float*)(F.lds + RING_OFF);
    LAS int* cnt = (LAS int*)(F.lds + RING_OFF + 32768);
    const float* wr = INP(I_MOE_ROUTER); const float* g = INP(I_FFN_NORM) + D;
    for (int idx = tid; idx < D * NE; idx += NWAVES * 64) { const int k = idx >> 3, e = idx & 7, l = k >> 4, i = k & 15;
        wrg[((i * 2) + (e >> 2)) * 256 + 4 * l + (e & 3)] = wr[idx] * g[k]; }
    __syncthreads();
    const int b5 = (lane >> 5) & 1, b4 = (lane >> 4) & 1, b3 = (lane >> 3) & 1;
    for (int c = F.vcu; c < M / 256; c += F.G) {
        if (tid < 16) cnt[tid] = 0;
        __syncthreads();
        v4u vn[2];
        { const GAS v4u* xr = (const GAS v4u*)(ws + WS_XR3 + (size_t)(c * 256 + F.wave * 32) * D * 2) + 2 * lane; vn[0] = xr[0]; vn[1] = xr[1]; }
        for (int i = 0; i < 32; ++i) {
            const int m = c * 256 + F.wave * 32 + i;
            const v4u q0 = vn[0], q1 = vn[1];
            if (i + 1 < 32) { const GAS v4u* xr = (const GAS v4u*)(ws + WS_XR3 + (size_t)(m + 1) * D * 2) + 2 * lane; vn[0] = xr[0]; vn[1] = xr[1]; }
            const unsigned qw[8] = {q0.x, q0.y, q0.z, q0.w, q1.x, q1.y, q1.z, q1.w};
            float xv[16]; float ssx = 0.f;
#pragma unroll
            for (int j = 0; j < 8; ++j) { xv[2 * j] = bflo(qw[j]); xv[2 * j + 1] = bfhi(qw[j]); }
#pragma unroll
            for (int j = 0; j < 16; j += 4) ssx += (xv[j] * xv[j] + xv[j + 1] * xv[j + 1]) + (xv[j + 2] * xv[j + 2] + xv[j + 3] * xv[j + 3]);
            float lg[8];
#pragma unroll
            for (int e = 0; e < 8; ++e) lg[e] = 0.f;
#pragma unroll
            for (int j = 0; j < 16; ++j) { const float x1 = xv[j];
                const f32x4 w0 = *(const LAS f32x4*)(wrg + (j * 2) * 256 + 4 * lane), w1 = *(const LAS f32x4*)(wrg + (j * 2 + 1) * 256 + 4 * lane);
                lg[0] += x1 * w0.x; lg[1] += x1 * w0.y; lg[2] += x1 * w0.z; lg[3] += x1 * w0.w; lg[4] += x1 * w1.x; lg[5] += x1 * w1.y; lg[6] += x1 * w1.z; lg[7] += x1 * w1.w; }
            float r4[4], r2[2], r1;
#pragma unroll
            for (int e = 0; e < 4; ++e) { const float mine = b5 ? lg[4 + e] : lg[e], other = b5 ? lg[e] : lg[4 + e]; r4[e] = mine + xor32_partner(other, b5); }
#pragma unroll
            for (int e = 0; e < 2; ++e) { const float mine = b4 ? r4[2 + e] : r4[e], other = b4 ? r4[e] : r4[2 + e]; r2[e] = mine + swz_xor<16>(other); }
            { const float mine = b3 ? r2[1] : r2[0], other = b3 ? r2[0] : r2[1]; r1 = mine + swz_xor<8>(other); }
            r1 += swz_xor<4>(r1); r1 += swz_xor<2>(r1); r1 += swz_xor<1>(r1);
            const float rstd = 1.f / sqrtf(wave_sum(ssx) * (1.f / D) + EPS);
#pragma unroll
            for (int e = 0; e < 8; ++e) lg[e] = __builtin_bit_cast(float, __builtin_amdgcn_readlane(__builtin_bit_cast(int, r1), 8 * e)) * rstd;
            int e1 = 0; float l1 = lg[0];
#pragma unroll
            for (int e = 1; e < 8; ++e) if (lg[e] > l1) { l1 = lg[e]; e1 = e; }
            int e2 = -1; float l2 = -INFINITY;
#pragma unroll
            for (int e = 0; e < 8; ++e) if (e != e1 && lg[e] > l2) { l2 = lg[e]; e2 = e; }
            const float g1 = 1.f / (1.f + __expf(l2 - l1)), g2 = 1.f - g1;
            const int elo = e1 < e2 ? e1 : e2, ehi = e1 < e2 ? e2 : e1;
            const float glo = e1 < e2 ? g1 : g2, ghi = e1 < e2 ? g2 : g1;
            if (lane == 0) { ((GAS float*)(ws + WS_TOKRSTD))[m] = rstd; ((GAS int*)(ws + WS_TOKE))[m] = elo | (ehi << 8); ((GAS float*)(ws + WS_TOKG))[2 * m] = glo; ((GAS float*)(ws + WS_TOKG))[2 * m + 1] = ghi;
                atomicAdd((int*)&cnt[elo], 1); atomicAdd((int*)&cnt[8 + ehi], 1); }
        }
        __syncthreads();
        if (tid < 16) ((GAS int*)(ws + WS_CNT))[c * 16 + tid] = cnt[tid];
        __syncthreads();
    }
}

__device__ __forceinline__ void slot_phase(const Frame& F, unsigned char* ws) {
    const int tid = fresh(F.wave * 64 + lane_id_()), lane = tid & 63; (void)lane;
    LAS int* call = (LAS int*)(F.lds + RING_OFF);
    LAS int* tot = call + 4096; LAS int* base = tot + 16; LAS int* pre = base + 16; LAS int* meta = pre + 16;
    LAS int* grp = meta + 16;
    LAS int* slot_of = grp + 512;
    for (int idx = tid; idx < 4096; idx += NWAVES * 64) call[idx] = ((const GAS int*)(ws + WS_CNT))[idx];
    __syncthreads();
    if (tid < 16) { int t = 0; for (int cc = 0; cc < 256; ++cc) t += call[cc * 16 + tid]; tot[tid] = t; }
    __syncthreads();
    if (tid == 0) { int off = 0; for (int g = 0; g < 16; ++g) { base[g] = off; off += (tot[g] + 255) & ~255; if (g == 7) meta[0] = off >> 8; } meta[1] = (off >> 8) - meta[0]; }
    __syncthreads();
    for (int c = F.vcu; c < M / 256; c += F.G) {
        if (tid < 16) { int p = 0; for (int cc = 0; cc < c; ++cc) p += call[cc * 16 + tid]; pre[tid] = p; }
        const int hf = tid >> 8, i = tid & 255, m = c * 256 + i;
        const int te = ((const GAS int*)(ws + WS_TOKE))[m];
        const int g = hf * 8 + (hf ? ((te >> 8) & 0xff) : (te & 0xff));
        grp[tid] = g;
        __syncthreads();
        int rank = 0;
        for (int j = 0; j < i; ++j) rank += (grp[hf * 256 + j] == g) ? 1 : 0;
        const int slot = base[g] + pre[g] + rank;
        ((GAS int*)(ws + WS_SLOTTOK))[slot] = m; ((GAS float*)(ws + WS_SLOTGATE))[slot] = ((const GAS float*)(ws + WS_TOKG))[2 * m + hf];
        slot_of[tid] = slot;
        __syncthreads();
        for (int i0 = F.wave; i0 < 256; i0 += 4 * NWAVES) {
            v4u x[4][2]; float rs[4];
#pragma unroll
            for (int k = 0; k < 4; ++k) { const int mm = c * 256 + i0 + 8 * k; const GAS v4u* src = (const GAS v4u*)(ws + WS_XR3 + (size_t)mm * D * 2);
                x[k][0] = src[2 * lane]; x[k][1] = src[2 * lane + 1]; rs[k] = ((const GAS float*)(ws + WS_TOKRSTD))[mm]; }
#pragma unroll
            for (int k = 0; k < 4; ++k) { const int i = i0 + 8 * k; const v4u x0 = x[k][0], x1 = x[k][1]; const float r = rs[k];
                const v4u o = (v4u){pk_fp8x4(bflo(x0.x) * r, bfhi(x0.x) * r, bflo(x0.y) * r, bfhi(x0.y) * r), pk_fp8x4(bflo(x0.z) * r, bfhi(x0.z) * r, bflo(x0.w) * r, bfhi(x0.w) * r),
                                    pk_fp8x4(bflo(x1.x) * r, bfhi(x1.x) * r, bflo(x1.y) * r, bfhi(x1.y) * r), pk_fp8x4(bflo(x1.z) * r, bfhi(x1.z) * r, bflo(x1.w) * r, bfhi(x1.w) * r)};
                ((GAS v4u*)(ws + WS_XG + (size_t)slot_of[i] * D))[lane] = o; ((GAS v4u*)(ws + WS_XG + (size_t)slot_of[256 + i] * D))[lane] = o; }
        }
        __syncthreads();
    }
    for (int g = F.vcu; g < 16; g += F.G) {
        const int s0 = base[g] + tot[g], s1 = base[g] + ((tot[g] + 255) & ~255);
        for (int s = s0 + F.wave; s < s1; s += NWAVES) { GAS v4u* dst = (GAS v4u*)(ws + WS_XG + (size_t)s * D);
            dst[lane] = (v4u){0u, 0u, 0u, 0u};
            if (lane == 0) { ((GAS int*)(ws + WS_SLOTTOK))[s] = -1; ((GAS float*)(ws + WS_SLOTGATE))[s] = 0.f; } }
    }
    if (F.vcu == 0) {
        if (tid < 16) { const int p0 = base[tid] >> 8, p1 = (base[tid] + ((tot[tid] + 255) & ~255)) >> 8; for (int p = p0; p < p1; ++p) ((GAS int*)(ws + WS_PANELE))[p] = tid & 7; }
        if (tid == 0) { ((GAS int*)(ws + WS_META))[0] = meta[0]; ((GAS int*)(ws + WS_META))[1] = meta[1]; }
        if (tid < 16) ((GAS int*)(ws + WS_META))[2 + tid] = base[tid] >> 8;
        if (tid == 0) { const int nPA = meta[0], nPB = meta[1]; int x = nPB > 256 ? nPB - 256 : 0;
            if (x > 0 && nPA > 256) { int LA = 0, HB = 7;
                for (int g = 0; g < 8; ++g) { const int q0 = base[g] >> 8, q1 = q0 + ((tot[g] + 255) >> 8); if (q0 <= 256 && 256 < q1) LA = g; }
                for (int g = 8; g < 16; ++g) { const int q0 = base[g] >> 8, q1 = q0 + ((tot[g] + 255) >> 8), P = nPA + x - 1; if (q0 <= P && P < q1) HB = g - 8; }
                if (LA < HB) x = 0; }
            ((GAS int*)(ws + WS_META))[18] = x; }
    }
    __syncthreads();
}

__global__ void __launch_bounds__(NWAVES * 64, 2) yoco_fwd(Args args) {
    extern __shared__ __attribute__((aligned(16))) unsigned char lds_raw[];
    Frame F;
    F.lds = (LAS unsigned char*)lds_raw;
    F.wave = __builtin_amdgcn_readfirstlane((int)threadIdx.x >> 6);
    F.G = gridDim.x; { const int bx = blockIdx.x; F.vcu = (F.G % 8 == 0) ? (bx % 8) * (F.G / 8) + bx / 8 : bx; }
    unsigned char* ws = WSP;
    volatile LAS unsigned* MISC = (volatile LAS unsigned*)(F.lds + MISC_OFF);
    for (int u = fresh((int)threadIdx.x); u < (LDS_BYTES - LDSCTL_OFF) / 4; u += NWAVES * 64) ((LAS unsigned*)(F.lds + LDSCTL_OFF))[u] = 0u;
    __syncthreads();
    (void)xcd_barrier_post((unsigned*)(ws + WS_CTL) + CW_BAR, MISC + 8, (F.wave == 0 && lane_id_() == 0) ? 1 : 0);
    LAS unsigned char* ring = F.lds + RING_OFF;
#define bid ((int)blockIdx.x)
#define GRID_BAR() do { XcdBarrier b_; b_.t0 = (F.wave == 0 && lane_id_() == 0) ? 1 : 0; b_.bar = (unsigned*)(WSP + WS_CTL) + CW_BAR; b_.x = xb_xcc_id(); b_.st = (volatile LAS unsigned*)(F.lds + MISC_OFF) + 8; xcd_barrier(b_); } while (0)
#define GEMM(EpiT, SchedT) pg8::gemm_phase<EpiT, SchedT, true, true>

    p0_prologue(F);
    GRID_BAR();
    { pg8::Gemm g{(const bf16*)(ws + WS_XN), (const bf16*)(ws + WS_WA), M, NA, D / 2, D / 2}; pg8::StaticOrder S; S.init(M, NA, F.G, bid);
      pg8::EpiQA E{(bf16*)(ws + WS_QA), (float*)(ws + WS_PARTQA), 1.f / 64};
      pg8::gemm_phase<pg8::EpiQA, pg8::StaticOrder, true, true, true>(ring, g, S, E, F.wave); }
    GRID_BAR();
    { pg8::Gemm g{(const bf16*)(ws + WS_QA), (const bf16*)(ws + WS_WUQ), M, NH * QKD, QLORA, NA}; pg8::StaticOrder S; S.init(M, NH * QKD, F.G, bid);
      pg8::EpiRowScaleBf16 E{(bf16*)(ws + WS_Q), NH * QKD, (const float*)(ws + WS_PARTQA), 1.f / QLORA};
      GEMM(pg8::EpiRowScaleBf16, pg8::StaticOrder)(ring, g, S, E, F.wave); }
    { pg8::Gemm g{(const bf16*)(ws + WS_QA) + QLORA, (const bf16*)(ws + WS_WUKV), M, NH * 128, KVLORA, NA}; pg8::StaticOrder S; S.init(M, NH * 128, F.G, bid);
      pg8::EpiKVup E{(bf16*)(ws + WS_K), (bf16*)(ws + WS_V), (const float*)(ws + WS_PARTQA), (const bf16*)(ws + WS_QA), INP(I_A_GKN), (const float*)(ws + WS_ROPE)};
      GEMM(pg8::EpiKVup, pg8::StaticOrder)(ring, g, S, E, F.wave); }
    GRID_BAR();
    bool fastA;
    { float bq = 0.f, bk = 0.f; const int l_ = lane_id_(); for (int i = l_; i < QKD; i += 64) { bq = fmaxf(bq, fabsf(INP(I_A_GQN)[i])); bk = fmaxf(bk, fabsf(INP(I_A_GKN)[i])); }
      bq = wave_maxf(bq); bk = wave_maxf(bk); fastA = __builtin_amdgcn_readfirstlane((int)(14.42f * bq * bk <= 40.f)) != 0; }
#define P5_UNIT(NM) att::attn_unit<96, false, 1536, 1536, D, D, true, NM, 2>(ring, (const bf16*)(ws + WS_Q) + (size_t)b * SEQ * 1536 + h * QKD, (const bf16*)(ws + WS_K) + (size_t)b * SEQ * 1536 + h * QKD, \
                                      (const bf16*)(ws + WS_V) + (size_t)b * SEQ * D + h * 64, (bf16*)(ws + WS_O + (size_t)b * SEQ * D + h * 64), \
                                      256 * qb, 0, 4 * qb + 3, 0, 4 * qb + (F.wave >> 1), 0, nullptr, INP(I_A_GQN), (const float*)(ws + WS_ROPE), F.wave)
    att::attn_init<96, 1536, D, 2>(ring, F.wave);
    for (int p = F.vcu; p < BATCH * NH * 4; p += F.G) {
        const int bh = p >> 2, pid = p & 3, b = bh >> 4, h = bh & 15;
        for (int u2 = 0; u2 < 2; ++u2) {
            const int qb = u2 ? 7 - pid : pid;
            if (fastA) P5_UNIT(true); else P5_UNIT(false);
        }
    }
    GRID_BAR();
    { pg8::Gemm g{(const bf16*)(ws + WS_O), (const bf16*)(ws + WS_WO), M, D, D / 2, D / 2}; pg8::StaticOrder S; S.init(M, D, F.G, bid);
      pg8::EpiResStream<true, false, false> E{INP(I_X), (bf16*)(ws + WS_XR1), nullptr, (float*)(ws + WS_PART1), 1.f / 2048};
      pg8::gemm_phase<pg8::EpiResStream<true, false, false>, pg8::StaticOrder, true, true, true>(ring, g, S, E, F.wave); }
    GRID_BAR();
    { pg8::Gemm g{(const bf16*)(ws + WS_XR1), (const bf16*)(ws + WS_WF1), M, 2 * FF, D, D}; pg8::StaticOrder S; S.init(M, 2 * FF, F.G, bid);
      pg8::EpiGated<true> E{(bf16*)(ws + WS_H), FF, 0, (const float*)(ws + WS_PART1)};
      GEMM(pg8::EpiGated<true>, pg8::StaticOrder)(ring, g, S, E, F.wave); }
    GRID_BAR();
    { pg8::Gemm g{(const bf16*)(ws + WS_H), (const bf16*)(ws + WS_WF2), M, D, FF, FF}; pg8::StaticOrder S; S.init(M, D, F.G, bid);
      pg8::EpiResStream<true, true, true> E{ws + WS_XR1, (bf16*)(ws + WS_X2B), ws + WS_XR2, (float*)(ws + WS_PART2), 1.f};
      pg8::gemm_phase<pg8::EpiResStream<true, true, true>, pg8::StaticOrder, true, true>(ring, g, S, E, F.wave); }
    GRID_BAR();
    { pg8::Gemm g{(const bf16*)(ws + WS_XR2), (const bf16*)(ws + WS_WKVQ), M, 2 * D, D / 2, D / 2}; pg8::StaticOrder S; S.init(M, 2 * D, F.G, bid);
      pg8::EpiK2Q2 E{(bf16*)(ws + WS_KVQ2), (const float*)(ws + WS_PART2), INP(I_KV_GKN), INP(I_B_GQN), 1.f / 64};
      pg8::gemm_phase<pg8::EpiK2Q2, pg8::StaticOrder, true, true, true>(ring, g, S, E, F.wave); }
    { pg8::Gemm g{(const bf16*)(ws + WS_XR2), (const bf16*)(ws + WS_WKVQ + (size_t)2 * D * D), M, D, D / 2, D / 2}; pg8::StaticOrder S; S.init(M, D, F.G, bid);
      pg8::EpiRowScale16 E{(bf16*)(ws + WS_KVQ2), 3 * D, D, (const float*)(ws + WS_PART2), 1.f / 64};
      pg8::gemm_phase<pg8::EpiRowScale16, pg8::StaticOrder, true, true, true>(ring, g, S, E, F.wave); }
    GRID_BAR();
    bool fastB;
    { float bq = 0.f, bk = 0.f, bb = 0.f; const int l_ = lane_id_(); bq = fabsf(INP(I_B_GQN)[l_]); bk = fabsf(INP(I_KV_GKN)[l_]);
      for (int i = l_; i < NH * 257; i += 64) bb = fmaxf(bb, fabsf(INP(I_B_RELB)[i]));
      bq = wave_maxf(bq); bk = wave_maxf(bk); bb = wave_maxf(bb); fastB = __builtin_amdgcn_readfirstlane((int)(11.78f * bq * bk + 1.4427f * bb <= 40.f)) != 0; }
    att::attn_init<64, 3072, 3072, 2>(ring, F.wave);
    int last_h = -1;
    for (int p = F.vcu; p < BATCH * NH * 8; p += F.G) {
        const int bh = p >> 3, cb = ((p & 7) + (p >> 8)) & 7, b = bh >> 4, h = bh & 15;
        const bool ldb = h != last_h; last_h = h;
        const int c0 = 4 * cb, cc = c0 + (F.wave >> 1);
        const bf16* base = (const bf16*)(ws + WS_KVQ2) + (size_t)b * SEQ * 3072 + h * 64;
#define P13_UNIT(NM) att::attn_unit<64, true, 3072, 3072, 3072, D, true, NM, 2>(ring, base + 2048, base, base + 1024, (bf16*)(ws + WS_O2 + (size_t)b * SEQ * D + h * 64), \
                                 256 * cb, c0 - 8 < 0 ? 0 : c0 - 8, c0 + 3, cc - 8 < 0 ? 0 : cc - 8, cc, cc, INP(I_B_RELB) + h * 257, nullptr, nullptr, F.wave, ldb)
        if (fastB) P13_UNIT(true); else P13_UNIT(false);
    }
    GRID_BAR();
    { pg8::Gemm g{(const bf16*)(ws + WS_O2), (const bf16*)(ws + WS_WBO), M, D, D / 2, D / 2}; pg8::StaticOrder S; S.init(M, D, F.G, bid);
      pg8::EpiResStream<false, false, true> E{ws + WS_X2B, (bf16*)(ws + WS_XR3), nullptr, nullptr, 1.f / 2048};
      pg8::gemm_phase<pg8::EpiResStream<false, false, true>, pg8::StaticOrder, true, true, true>(ring, g, S, E, F.wave); }
    GRID_BAR();
    route_phase(F);
    GRID_BAR();
    slot_phase(F, ws);
    GRID_BAR();
#define MOE_LOAD(hf_) unsigned char* w2 = WSP; \
          const int nPA = __builtin_amdgcn_readfirstlane(((const GAS int*)(w2 + WS_META))[0]), nPB = __builtin_amdgcn_readfirstlane(((const GAS int*)(w2 + WS_META))[1]); (void)nPB; \
          const int xB = __builtin_amdgcn_readfirstlane(((const GAS int*)(w2 + WS_META))[18]); (void)xB; \
          const int p0 = (hf_) ? nPA : 0; int pbk[7]; \
          _Pragma("unroll") for (int k = 0; k < 7; ++k) pbk[k] = __builtin_amdgcn_readfirstlane(((const GAS int*)(w2 + WS_META))[2 + (hf_) * 8 + 1 + k]) - p0;
    constexpr size_t HMB_OFF = (size_t)MAXP_HALF * 256 * EFF;
    { MOE_LOAD(0)
      pg8::Gemm g{(const bf16*)(w2 + WS_XG), (const bf16*)(w2 + WS_WM1), nPA * 256, 2 * EFF, D / 2, D / 2};
      pg8::MoeOrder S; S.init(nPA, 2 * EFF / 256, F.G, bid);
#pragma unroll
      for (int k = 0; k < 7; ++k) S.pb[k] = pbk[k];
      pg8::EpiGatedF8 E{w2 + WS_HM, EFF, 2 * EFF / 256};
      pg8::gemm_phase<pg8::EpiGatedF8, pg8::MoeOrder, true, true, true>(ring, g, S, E, F.wave); }
    { MOE_LOAD(1)
      pg8::Gemm g{(const bf16*)(w2 + WS_XG + (size_t)p0 * 256 * D), (const bf16*)(w2 + WS_WM1), xB * 256, 2 * EFF, D / 2, D / 2};
      pg8::MoeOrder S; S.init(xB, 2 * EFF / 256, F.G, bid); S.rot = (nPA * (2 * EFF / 256)) % F.G;
#pragma unroll
      for (int k = 0; k < 7; ++k) S.pb[k] = pbk[k];
      pg8::EpiGatedF8 E{w2 + WS_HM + HMB_OFF, EFF, 2 * EFF / 256};
      pg8::gemm_phase<pg8::EpiGatedF8, pg8::MoeOrder, true, true, true>(ring, g, S, E, F.wave); }
    GRID_BAR();
    { MOE_LOAD(0)
      pg8::Gemm g{(const bf16*)(w2 + WS_HM), (const bf16*)(w2 + WS_WM2), 256 * 256, D, EFF / 2, EFF / 2};
      pg8::MoeOrder S; S.init(256, D / 256, F.G, bid);
#pragma unroll
      for (int k = 0; k < 7; ++k) S.pb[k] = pbk[k];
      pg8::EpiMoeDown<true> E{OUTP, (const bf16*)(w2 + WS_XR3), (const int*)(w2 + WS_SLOTTOK), (const float*)(w2 + WS_SLOTGATE), 0, D, 1.f / 64};
      pg8::gemm_phase<pg8::EpiMoeDown<true>, pg8::MoeOrder, true, true, true>(ring, g, S, E, F.wave); }
    GRID_BAR();
    { MOE_LOAD(0)
      pg8::Gemm g{(const bf16*)(w2 + WS_HM), (const bf16*)(w2 + WS_WM2), nPA * 256, D, EFF / 2, EFF / 2};
      pg8::LeftOrder S; S.M.init(nPA, D / 256, F.G, bid); S.nLeft = 4 * (nPA - 256); S.c0 = 0; S.pbase = 256;
#pragma unroll
      for (int k = 0; k < 7; ++k) S.M.pb[k] = pbk[k];
      pg8::EpiMoeDown<true> E{OUTP, (const bf16*)(w2 + WS_XR3), (const int*)(w2 + WS_SLOTTOK), (const float*)(w2 + WS_SLOTGATE), 0, D, 1.f / 64};
      pg8::gemm_phase<pg8::EpiMoeDown<true>, pg8::LeftOrder, true, true, true>(ring, g, S, E, F.wave); }
    { MOE_LOAD(1)
      pg8::Gemm g{(const bf16*)(w2 + WS_HM + HMB_OFF), (const bf16*)(w2 + WS_WM2), xB * 256, D, EFF / 2, EFF / 2};
      pg8::LeftOrder S; S.M.init(xB, D / 256, F.G, bid); S.nLeft = 4 * xB; S.c0 = 4 * (nPA - 256); S.pbase = 0;
#pragma unroll
      for (int k = 0; k < 7; ++k) S.M.pb[k] = pbk[k];
      pg8::EpiMoeDown<false> E{OUTP, nullptr, (const int*)(w2 + WS_SLOTTOK), (const float*)(w2 + WS_SLOTGATE), p0 * 256, D, 1.f / 64};
      pg8::gemm_phase<pg8::EpiMoeDown<false>, pg8::LeftOrder, true, true, true>(ring, g, S, E, F.wave); }
    { MOE_LOAD(1)
      pg8::Gemm g{(const bf16*)(w2 + WS_XG + (size_t)(p0 + xB) * 256 * D), (const bf16*)(w2 + WS_WM1), (nPB - xB) * 256, 2 * EFF, D / 2, D / 2};
      pg8::MoeOrder S; S.init(nPB - xB, 2 * EFF / 256, F.G, bid); S.nBusy = 4 * (nPA - 256) + 4 * xB; S.SK = 4;
#pragma unroll
      for (int k = 0; k < 7; ++k) S.pb[k] = pbk[k] - xB;
      pg8::EpiGatedF8 E{w2 + WS_HM + HMB_OFF + (size_t)xB * 256 * EFF, EFF, 2 * EFF / 256};
      pg8::gemm_phase<pg8::EpiGatedF8, pg8::MoeOrder, true, true, true>(ring, g, S, E, F.wave); }
    GRID_BAR();
    { MOE_LOAD(1)
      pg8::Gemm g{(const bf16*)(w2 + WS_HM + HMB_OFF + (size_t)xB * 256 * EFF), (const bf16*)(w2 + WS_WM2), (nPB - xB) * 256, D, EFF / 2, EFF / 2};
      pg8::MoeOrder S; S.init(nPB - xB, D / 256, F.G, bid);
#pragma unroll
      for (int k = 0; k < 7; ++k) S.pb[k] = pbk[k] - xB;
      pg8::EpiMoeDown<false> E{OUTP, nullptr, (const int*)(w2 + WS_SLOTTOK), (const float*)(w2 + WS_SLOTGATE), (p0 + xB) * 256, D, 1.f / 64};
      pg8::gemm_phase<pg8::EpiMoeDown<false>, pg8::MoeOrder, true, true, true>(ring, g, S, E, F.wave); }
#undef MOE_LOAD
#undef GRID_BAR
#undef bid
#undef GEMM
}

extern "C" void kernel_launch(void* const* d_in, const int* in_sizes, int n_in, void* d_out, int out_size, void* d_ws, size_t ws_size, hipStream_t stream) {
    static int grid = 0;
    if (grid == 0) {
        if (n_in != 27 || in_sizes[0] != M * D || out_size != M * D || ws_size < WS_END) { fprintf(stderr, "kernel_launch: unexpected shapes (n_in %d, in0 %d, out %d, ws %zu < %zu); nothing launched\n", n_in, n_in > 0 ? in_sizes[0] : -1, out_size, ws_size, (size_t)WS_END); grid = -1; return; }
        int dev = 0, cus = 0, per_cu = 0;
        if (hipGetDevice(&dev) != hipSuccess || hipDeviceGetAttribute(&cus, hipDeviceAttributeMultiprocessorCount, dev) != hipSuccess) { grid = -1; return; }
        if (hipFuncSetAttribute((const void*)yoco_fwd, hipFuncAttributeMaxDynamicSharedMemorySize, LDS_BYTES) != hipSuccess) { fprintf(stderr, "kernel_launch: hipFuncSetAttribute failed\n"); grid = -1; return; }
        if (hipOccupancyMaxActiveBlocksPerMultiprocessor(&per_cu, (const void*)yoco_fwd, NWAVES * 64, LDS_BYTES) != hipSuccess || per_cu < 1) { fprintf(stderr, "kernel_launch: occupancy query says %d\n", per_cu); }
        (void)hipGetLastError();
        grid = cus;
    }
    if (grid < 0) return;
    if (hipMemsetAsync((char*)d_ws + WS_CTL, 0, CTL_ZERO_BYTES, stream) != hipSuccess) return;
    Args a{};
    for (int i = 0; i < 27; ++i) a.in[i] = (const float*)d_in[i];
    a.out = (float*)d_out; a.ws = (unsigned char*)d_ws;
    hipLaunchKernelGGL(yoco_fwd, dim3(grid), dim3(NWAVES * 64), LDS_BYTES, stream, a);
}
```

```cpp
#include <hip/hip_runtime.h>
#include <cstdio>
#include <cstdint>
__device__ __forceinline__ int lane_id_() { unsigned m_ = ~0u; asm volatile("" : "+s"(m_)); return (int)__builtin_amdgcn_mbcnt_hi(m_, __builtin_amdgcn_mbcnt_lo(m_, 0u)); }
template <int X> __device__ __forceinline__ float swz_xor(float v) { return __builtin_bit_cast(float, __builtin_amdgcn_ds_swizzle(__builtin_bit_cast(int, v), (X << 10) | 0x1f)); }
__device__ __forceinline__ void halves32(float v, float& r_lo, float& r_hi) { unsigned a_ = __builtin_bit_cast(unsigned, v), b_ = a_;
    asm volatile("s_nop 1\n\tv_permlane32_swap_b32 %0, %1\n\ts_nop 1" : "+v"(a_), "+v"(b_)); r_lo = __builtin_bit_cast(float, a_); r_hi = __builtin_bit_cast(float, b_); }
__device__ __forceinline__ float xor32_partner(float v, int upper_half) { float lo, hi; halves32(v, lo, hi); return upper_half ? lo : hi; }
__device__ __forceinline__ float xor32_sum(float v) { float lo, hi; halves32(v, lo, hi); return lo + hi; }
__device__ __forceinline__ float xor32_max(float v) { float lo, hi; halves32(v, lo, hi); return fmaxf(lo, hi); }
namespace pg8 {
#define PG8_LAS __attribute__((address_space(3)))
typedef unsigned short bf16_t;
typedef short bf16x8 __attribute__((ext_vector_type(8)));
typedef float f32x4 __attribute__((ext_vector_type(4)));
typedef unsigned u32x4 __attribute__((ext_vector_type(4)));
constexpr int BM = 256, BK = 64, HALF = 128, HTB = HALF * BK * 2  , STAGE_BYTES = 8 * HTB, NXCD = 8, WGM = 8;

__host__ __device__ __forceinline__ int lds_byte(int r, int c) { const int st = (r >> 4) * 2 + (c >> 5), rr = r & 15, cc = c & 31, ob = rr * 64 + cc * 2; return st * 1024 + (ob ^ (((ob >> 9) & 1) << 5)); }
__host__ __device__ __forceinline__ void stage_rc(int b, int& R, int& C) { const int st = b / 1024, sb = b % 1024, swz = sb ^ (((sb >> 9) & 1) << 5); R = (st >> 1) * 16 + swz / 64; C = (st & 1) * 32 + (swz % 64) / 2; }
__host__ __device__ __forceinline__ int perm32(int rho) { const int n = rho >> 4, i = rho & 15; return 8 * (i >> 2) + 4 * n + (i & 3); }

struct Unit { int pm, pn; };
struct Gemm { const bf16_t* A; const bf16_t* Bt; int M, N, K, lda; };

struct StaticOrder {
    int nM, nN, nwg, G, c;
    __host__ __device__ void init(int M, int N, int G_, int c_) { nM = M / BM; nN = N / BM; nwg = nM * nN; G = G_; c = c_; }
    __host__ __device__ bool next(int i, Unit& u) const {
        const int L = i * G + c; if (L >= nwg) return false;
        int wgid = L; { const int q = nwg / NXCD, r = nwg % NXCD, xcd = wgid % NXCD, off = wgid / NXCD; wgid = (xcd < r ? xcd * (q + 1) : r * (q + 1) + (xcd - r) * q) + off; }
        const int nig = WGM * nN, gid = wgid / nig, fm = gid * WGM, gsz = (nM - fm) < WGM ? (nM - fm) : WGM;
        u.pm = fm + ((wgid % nig) % gsz); u.pn = (wgid % nig) / gsz; return true;
    }
    __device__ __forceinline__ void a_ready(const Unit&) const {}
    __device__ __forceinline__ void done(const Unit&) const {}
};
__device__ __forceinline__ unsigned cvt_pk_bf16(float lo, float hi) { unsigned r; asm volatile("v_cvt_pk_bf16_f32 %0, %1, %2" : "=v"(r) : "v"(lo), "v"(hi)); return r; }
__device__ __forceinline__ float silu_f(float x) { const float e = __builtin_amdgcn_exp2f(x * -1.4426950408889634f); return x * __builtin_amdgcn_rcpf(1.f + e); }

__device__ __forceinline__ float sum4(const f32x4& a) { return (a[0] + a[1]) + (a[2] + a[3]); }
__device__ __forceinline__ float part_sum8(const float* p) { return sum4(*(const f32x4*)p) + sum4(*(const f32x4*)(p + 4)); }
__device__ __forceinline__ float part_sum16(const float* p) { return (sum4(*(const f32x4*)p) + sum4(*(const f32x4*)(p + 4))) + (sum4(*(const f32x4*)(p + 8)) + sum4(*(const f32x4*)(p + 12))); }
__device__ __forceinline__ float fq_sum(float v) { v += swz_xor<16>(v); return xor32_sum(v); }
__device__ __forceinline__ float sq8(const f32x4& a, const f32x4& b) { return ((a[0] * a[0] + a[1] * a[1]) + (a[2] * a[2] + a[3] * a[3])) + ((b[0] * b[0] + b[1] * b[1]) + (b[2] * b[2] + b[3] * b[3])); }
__device__ __forceinline__ u32x4 pack8(const f32x4& a, const f32x4& b) { u32x4 w; w.x = cvt_pk_bf16(a[0], a[1]); w.y = cvt_pk_bf16(a[2], a[3]); w.z = cvt_pk_bf16(b[0], b[1]); w.w = cvt_pk_bf16(b[2], b[3]); return w; }
constexpr float EPS_ = 1e-6f;
__device__ __forceinline__ unsigned pk_fp8x4(float a, float b, float c, float d) { int w = 0; w = __builtin_amdgcn_cvt_pk_fp8_f32(a, b, w, false); w = __builtin_amdgcn_cvt_pk_fp8_f32(c, d, w, true); return (unsigned)w; }

struct EpiQA {
    static constexpr bool PERM = true, AFTER_DRAIN = false;
    bf16_t* O; float* part; float wscale;
    __device__ __forceinline__ void operator()(const f32x4 (&acc)[2][2][4][2], const Unit& u, int wr, int wc, int fr, int fq) const {
        { int t_ = lane_id_(); asm volatile("" : "+v"(t_)); fr = t_ & 15; fq = (t_ >> 4) & 3; }
        const int row0 = u.pm * BM + wr * 64 + fr, col0 = u.pn * BM + wc * 32 + 8 * fq;
#pragma unroll
        for (int ai = 0; ai < 2; ++ai)
#pragma unroll
            for (int m = 0; m < 4; ++m) { const int row = row0 + ai * HALF + m * 16; bf16_t* rowp = O + (size_t)row * 768 + col0;
                const f32x4 a0 = acc[ai][0][m][0] * wscale, a1 = acc[ai][0][m][1] * wscale, b0 = acc[ai][1][m][0] * wscale, b1 = acc[ai][1][m][1] * wscale;
                *(u32x4*)(rowp) = pack8(a0, a1); *(u32x4*)(rowp + HALF) = pack8(b0, b1);
                const float s0 = sq8(a0, a1), s1 = sq8(b0, b1);
                float* pr = part + (size_t)row * 16;
                if (u.pn == 0) { const float t = fq_sum(s0 + s1); if (fq == 0) pr[wc] = t; }
                else if (u.pn == 1) { const float t0 = fq_sum(s0), t1 = fq_sum(s1); if (fq == 0) { pr[4 + wc] = t0; pr[8 + wc] = t1; } }
                else { const float t = fq_sum(s0); if (fq == 0) pr[12 + wc] = t; } }
    }
};

struct EpiRowScaleBf16 {
    static constexpr bool PERM = true, AFTER_DRAIN = false;
    bf16_t* O; int ldc; const float* part; float inv_n;
    __device__ __forceinline__ void operator()(const f32x4 (&acc)[2][2][4][2], const Unit& u, int wr, int wc, int fr, int fq) const {
        { int t_ = lane_id_(); asm volatile("" : "+v"(t_)); fr = t_ & 15; fq = (t_ >> 4) & 3; }
        const int row0 = u.pm * BM + wr * 64 + fr, col0 = u.pn * BM + wc * 32 + 8 * fq;
#pragma unroll
        for (int ai = 0; ai < 2; ++ai)
#pragma unroll
            for (int m = 0; m < 4; ++m) { const int row = row0 + ai * HALF + m * 16; bf16_t* rowp = O + (size_t)row * ldc + col0;
                const float rs = __builtin_amdgcn_rsqf(part_sum8(part + (size_t)row * 16) * inv_n + EPS_);
                *(u32x4*)(rowp) = pack8(acc[ai][0][m][0] * rs, acc[ai][0][m][1] * rs); *(u32x4*)(rowp + HALF) = pack8(acc[ai][1][m][0] * rs, acc[ai][1][m][1] * rs); }
    }
};

struct EpiKVup {
    static constexpr bool PERM = true, AFTER_DRAIN = false;
    bf16_t* Kd; bf16_t* Vd; const float* part; const bf16_t* QA; const float* g_kn; const float* rope;
    __device__ __forceinline__ void operator()(const f32x4 (&acc)[2][2][4][2], const Unit& u, int wr, int wc, int fr, int fq) const {
        { int t_ = lane_id_(); asm volatile("" : "+v"(t_)); fr = t_ & 15; fq = (t_ >> 4) & 3; }
        const int row0 = u.pm * BM + wr * 64 + fr;
        if (u.pn >= 4) {
            const int col0 = (u.pn - 4) * BM + wc * 32 + 8 * fq;
#pragma unroll
            for (int ai = 0; ai < 2; ++ai)
#pragma unroll
                for (int m = 0; m < 4; ++m) { const int row = row0 + ai * HALF + m * 16; bf16_t* rowp = Vd + (size_t)row * 1024 + col0;
                    const float rs = __builtin_amdgcn_rsqf(part_sum8(part + (size_t)row * 16 + 8) * (1.f / 256) + EPS_);
                    *(u32x4*)(rowp) = pack8(acc[ai][0][m][0] * rs, acc[ai][0][m][1] * rs); *(u32x4*)(rowp + HALF) = pack8(acc[ai][1][m][0] * rs, acc[ai][1][m][1] * rs); }
            return;
        }
        const int head = 4 * u.pn + wc;
        f32x4 gA0 = *(const f32x4*)(g_kn + 8 * fq), gA1 = *(const f32x4*)(g_kn + 8 * fq + 4), gB0 = *(const f32x4*)(g_kn + 32 + 8 * fq), gB1 = *(const f32x4*)(g_kn + 32 + 8 * fq + 4);
        const f32x4 gR1 = *(const f32x4*)(g_kn + 64 + 4 * fq), gR2 = *(const f32x4*)(g_kn + 80 + 4 * fq);
#pragma unroll
        for (int ai = 0; ai < 2; ++ai)
#pragma unroll
            for (int m = 0; m < 4; ++m) { const int row = row0 + ai * HALF + m * 16;
                const float rs = __builtin_amdgcn_rsqf(part_sum8(part + (size_t)row * 16 + 8) * (1.f / 256) + EPS_);
                f32x4 a0 = acc[ai][0][m][0] * rs, a1 = acc[ai][0][m][1] * rs, b0 = acc[ai][1][m][0] * rs, b1 = acc[ai][1][m][1] * rs;
                const unsigned long long p1 = *(const unsigned long long*)(QA + (size_t)row * 768 + 640 + 4 * fq), p2 = *(const unsigned long long*)(QA + (size_t)row * 768 + 656 + 4 * fq);
                f32x4 x1, x2;
                x1[0] = __builtin_bit_cast(float, (unsigned)(p1 << 16)); x1[1] = __builtin_bit_cast(float, (unsigned)p1 & 0xffff0000u);
                x1[2] = __builtin_bit_cast(float, (unsigned)(p1 >> 32) << 16); x1[3] = __builtin_bit_cast(float, (unsigned)(p1 >> 32) & 0xffff0000u);
                x2[0] = __builtin_bit_cast(float, (unsigned)(p2 << 16)); x2[1] = __builtin_bit_cast(float, (unsigned)p2 & 0xffff0000u);
                x2[2] = __builtin_bit_cast(float, (unsigned)(p2 >> 32) << 16); x2[3] = __builtin_bit_cast(float, (unsigned)(p2 >> 32) & 0xffff0000u);
                const float ss = fq_sum(sq8(a0, a1) + sq8(b0, b1) + sq8(x1, x2));
                const float sh = __builtin_amdgcn_rsqf(ss * (1.f / 96) + EPS_);
                bf16_t* kp = Kd + (size_t)row * 1536 + head * 96;
                *(u32x4*)(kp + 8 * fq) = pack8(a0 * gA0 * sh, a1 * gA1 * sh); *(u32x4*)(kp + 32 + 8 * fq) = pack8(b0 * gB0 * sh, b1 * gB1 * sh);
                const f32x4* rp = (const f32x4*)(rope + ((size_t)(row & 2047) * 16 + 4 * fq) * 2);
                const f32x4 c01 = rp[0], c23 = rp[1];
                const f32x4 y1 = x1 * gR1 * sh, y2 = x2 * gR2 * sh;
                f32x4 o1, o2;
                o1[0] = y1[0] * c01[0] - y2[0] * c01[1]; o2[0] = y2[0] * c01[0] + y1[0] * c01[1];
                o1[1] = y1[1] * c01[2] - y2[1] * c01[3]; o2[1] = y2[1] * c01[2] + y1[1] * c01[3];
                o1[2] = y1[2] * c23[0] - y2[2] * c23[1]; o2[2] = y2[2] * c23[0] + y1[2] * c23[1];
                o1[3] = y1[3] * c23[2] - y2[3] * c23[3]; o2[3] = y2[3] * c23[2] + y1[3] * c23[3];
                unsigned long long w1 = (unsigned long long)cvt_pk_bf16(o1[0], o1[1]) | ((unsigned long long)cvt_pk_bf16(o1[2], o1[3]) << 32);
                unsigned long long w2 = (unsigned long long)cvt_pk_bf16(o2[0], o2[1]) | ((unsigned long long)cvt_pk_bf16(o2[2], o2[3]) << 32);
                *(unsigned long long*)(kp + 64 + 4 * fq) = w1; *(unsigned long long*)(kp + 80 + 4 * fq) = w2; }
    }
};

struct EpiK2Q2 {
    static constexpr bool PERM = true, AFTER_DRAIN = false;
    bf16_t* O; const float* pss; const float* gk; const float* gq; float wscale;
    __device__ __forceinline__ void operator()(const f32x4 (&acc)[2][2][4][2], const Unit& u, int wr, int wc, int fr, int fq) const {
        { int t_ = lane_id_(); asm volatile("" : "+v"(t_)); fr = t_ & 15; fq = (t_ >> 4) & 3; }
        const int row0 = u.pm * BM + wr * 64 + fr, isq = u.pn >> 2, tl = u.pn & 3;
        const float* g = isq ? gq : gk; const float post = isq ? 0.125f * 1.4426950408889634f : 1.f;
        const f32x4 gA0 = *(const f32x4*)(g + 8 * fq) * post, gA1 = *(const f32x4*)(g + 8 * fq + 4) * post, gB0 = *(const f32x4*)(g + 32 + 8 * fq) * post, gB1 = *(const f32x4*)(g + 32 + 8 * fq + 4) * post;
        const int colh = isq * 2048 + (4 * tl + wc) * 64;
        unsigned zhi_ = 0u; asm volatile("" : "+v"(zhi_));
        const unsigned long long coff = ((unsigned long long)zhi_ << 32) | (unsigned)((colh + 8 * fq) * 2);
#pragma unroll
        for (int ai = 0; ai < 2; ++ai)
#pragma unroll
            for (int m = 0; m < 4; ++m) { const int row = row0 + ai * HALF + m * 16; unsigned char* rowp = (unsigned char*)O + (size_t)row * 6144 + coff;
                const float rs = __builtin_amdgcn_rsqf(part_sum16(pss + (size_t)row * 16) * (1.f / 1024) + EPS_) * wscale;
                const f32x4 a0 = acc[ai][0][m][0] * rs, a1 = acc[ai][0][m][1] * rs, b0 = acc[ai][1][m][0] * rs, b1 = acc[ai][1][m][1] * rs;
                const float ss = fq_sum(sq8(a0, a1) + sq8(b0, b1));
                const float sh = __builtin_amdgcn_rsqf(ss * (1.f / 64) + EPS_);
                *(u32x4*)(rowp) = pack8(a0 * gA0 * sh, a1 * gA1 * sh); *(u32x4*)(rowp + 64) = pack8(b0 * gB0 * sh, b1 * gB1 * sh); }
    }
};
struct EpiRowScale16 {
    static constexpr bool PERM = true, AFTER_DRAIN = false;
    bf16_t* O; int ldc; int coff; const float* pss; float wscale;
    __device__ __forceinline__ void operator()(const f32x4 (&acc)[2][2][4][2], const Unit& u, int wr, int wc, int fr, int fq) const {
        { int t_ = lane_id_(); asm volatile("" : "+v"(t_)); fr = t_ & 15; fq = (t_ >> 4) & 3; }
        const int row0 = u.pm * BM + wr * 64 + fr, col0 = coff + u.pn * BM + wc * 32 + 8 * fq;
#pragma unroll
        for (int ai = 0; ai < 2; ++ai)
#pragma unroll
            for (int m = 0; m < 4; ++m) { const int row = row0 + ai * HALF + m * 16; bf16_t* rowp = O + (size_t)row * ldc + col0;
                const float rs = __builtin_amdgcn_rsqf(part_sum16(pss + (size_t)row * 16) * (1.f / 1024) + EPS_) * wscale;
                *(u32x4*)(rowp) = pack8(acc[ai][0][m][0] * rs, acc[ai][0][m][1] * rs); *(u32x4*)(rowp + HALF) = pack8(acc[ai][1][m][0] * rs, acc[ai][1][m][1] * rs); }
    }
};

template <bool SSQ> struct EpiGated {
    static constexpr bool PERM = true, AFTER_DRAIN = false;
    bf16_t* Hd; int ldc; int ntile; const float* rs;
    __device__ __forceinline__ void operator()(const f32x4 (&acc)[2][2][4][2], const Unit& u, int wr, int wc, int fr, int fq) const {
        { int t_ = lane_id_(); asm volatile("" : "+v"(t_)); fr = t_ & 15; fq = (t_ >> 4) & 3; }
        const int pnl = ntile ? (u.pn % ntile) : u.pn;
        const int row0 = u.pm * BM + wr * 64 + fr, col0 = pnl * HALF + wc * 32 + 8 * fq;
#pragma unroll
        for (int ai = 0; ai < 2; ++ai)
#pragma unroll
            for (int m = 0; m < 4; ++m) { const int row = row0 + ai * HALF + m * 16; bf16_t* rowp = Hd + (size_t)row * ldc + col0;
                const float r = SSQ ? __builtin_amdgcn_rsqf(part_sum16(rs + (size_t)row * 16) * (1.f / 1024) + EPS_) : rs[row];
                const f32x4 g0 = acc[ai][0][m][0] * r, g1 = acc[ai][0][m][1] * r, u0 = acc[ai][1][m][0] * r, u1 = acc[ai][1][m][1] * r;
                u32x4 w;
                w.x = cvt_pk_bf16(silu_f(g0[0]) * u0[0], silu_f(g0[1]) * u0[1]); w.y = cvt_pk_bf16(silu_f(g0[2]) * u0[2], silu_f(g0[3]) * u0[3]);
                w.z = cvt_pk_bf16(silu_f(g1[0]) * u1[0], silu_f(g1[1]) * u1[1]); w.w = cvt_pk_bf16(silu_f(g1[2]) * u1[2], silu_f(g1[3]) * u1[3]);
                *(u32x4*)rowp = w; }
    }
};

struct EpiGatedF8 {
    static constexpr bool PERM = true, AFTER_DRAIN = false;
    unsigned char* Hd; int ldc; int ntile;
    static __device__ __forceinline__ float gate(float g, float u) {
        const float e = __builtin_amdgcn_exp2f(g * (-1.4426950408889634f / 64.f)); return (g * u) * (__builtin_amdgcn_rcpf(1.f + e) * (1.f / 4096.f)); }
    __device__ __forceinline__ void operator()(const f32x4 (&acc)[2][2][4][2], const Unit& u, int wr, int wc, int fr, int fq) const {
        { int t_ = lane_id_(); asm volatile("" : "+v"(t_)); fr = t_ & 15; fq = (t_ >> 4) & 3; }
        const int pnl = u.pn % ntile;
        const int row0 = u.pm * BM + wr * 64 + fr, col0 = pnl * HALF + wc * 32 + 8 * fq;
#pragma unroll
        for (int ai = 0; ai < 2; ++ai)
#pragma unroll
            for (int m = 0; m < 4; ++m) { const int row = row0 + ai * HALF + m * 16; unsigned char* rowp = Hd + (size_t)row * ldc + col0;
                const f32x4 g0 = acc[ai][0][m][0], g1 = acc[ai][0][m][1], u0 = acc[ai][1][m][0], u1 = acc[ai][1][m][1];
                unsigned long long w = (unsigned long long)pk_fp8x4(gate(g0[0], u0[0]), gate(g0[1], u0[1]), gate(g0[2], u0[2]), gate(g0[3], u0[3]))
                                     | ((unsigned long long)pk_fp8x4(gate(g1[0], u1[0]), gate(g1[1], u1[1]), gate(g1[2], u1[2]), gate(g1[3], u1[3])) << 32);
                *(unsigned long long*)rowp = w; }
    }
};

template <bool SSQ, bool XF8, bool RES16> struct EpiResStream {
    static constexpr bool PERM = true, AFTER_DRAIN = false;
    const void* res; bf16_t* XB; unsigned char* X8; float* ssq; float ascale;
    __device__ __forceinline__ void operator()(const f32x4 (&acc)[2][2][4][2], const Unit& u, int wr, int wc, int fr, int fq) const {
        { int t_ = lane_id_(); asm volatile("" : "+v"(t_)); fr = t_ & 15; fq = (t_ >> 4) & 3; }
        const int row0 = u.pm * BM + wr * 64 + fr, col0 = u.pn * BM + wc * 32 + 8 * fq;
        f32x4 rw[4][2][2];
#define ERS_ROW(it) (row0 + ((it) >> 2) * HALF + ((it) & 3) * 16)
#define ERS_LOAD(it) do { const size_t ro_ = (size_t)ERS_ROW(it) * 1024 + col0; _Pragma("unroll") for (int bj = 0; bj < 2; ++bj) { \
            if constexpr (RES16) rw[(it) & 3][bj][0] = __builtin_bit_cast(f32x4, *(const u32x4*)((const bf16_t*)res + ro_ + bj * HALF)); \
            else { _Pragma("unroll") for (int n = 0; n < 2; ++n) rw[(it) & 3][bj][n] = *(const f32x4*)((const float*)res + ro_ + bj * HALF + n * 4); } } } while (0)
        ERS_LOAD(0); ERS_LOAD(1); ERS_LOAD(2); ERS_LOAD(3);
#pragma unroll
        for (int it = 0; it < 8; ++it) { const int ai = it >> 2, m = it & 3; const int row = ERS_ROW(it); const size_t ro = (size_t)row * 1024 + col0;
                f32x4 r[2][2];
#pragma unroll
                for (int bj = 0; bj < 2; ++bj) {
                    if constexpr (RES16) { const u32x4 w = __builtin_bit_cast(u32x4, rw[it & 3][bj][0]);
                        r[bj][0] = (f32x4){__builtin_bit_cast(float, w.x << 16), __builtin_bit_cast(float, w.x & 0xffff0000u), __builtin_bit_cast(float, w.y << 16), __builtin_bit_cast(float, w.y & 0xffff0000u)};
                        r[bj][1] = (f32x4){__builtin_bit_cast(float, w.z << 16), __builtin_bit_cast(float, w.z & 0xffff0000u), __builtin_bit_cast(float, w.w << 16), __builtin_bit_cast(float, w.w & 0xffff0000u)}; }
                    else { r[bj][0] = rw[it & 3][bj][0]; r[bj][1] = rw[it & 3][bj][1]; }
                    r[bj][0] = r[bj][0] + acc[ai][bj][m][0] * ascale; r[bj][1] = r[bj][1] + acc[ai][bj][m][1] * ascale; }
                if (it + 4 < 8) ERS_LOAD(it + 4);
                *(u32x4*)(XB + ro) = pack8(r[0][0], r[0][1]); *(u32x4*)(XB + ro + HALF) = pack8(r[1][0], r[1][1]);
                if constexpr (XF8) { unsigned char* x8 = X8 + ro;
                    *(unsigned long long*)(x8) = (unsigned long long)pk_fp8x4(r[0][0][0], r[0][0][1], r[0][0][2], r[0][0][3]) | ((unsigned long long)pk_fp8x4(r[0][1][0], r[0][1][1], r[0][1][2], r[0][1][3]) << 32);
                    *(unsigned long long*)(x8 + HALF) = (unsigned long long)pk_fp8x4(r[1][0][0], r[1][0][1], r[1][0][2], r[1][0][3]) | ((unsigned long long)pk_fp8x4(r[1][1][0], r[1][1][1], r[1][1][2], r[1][1][3]) << 32); }
                if (SSQ) { const float t = fq_sum(sq8(r[0][0], r[0][1]) + sq8(r[1][0], r[1][1])); if (fq == 0) ssq[(size_t)row * 16 + u.pn * 4 + wc] = t; } }
#undef ERS_LOAD
#undef ERS_ROW
    }
};

template <bool FIRST> struct EpiMoeDown {
    static constexpr bool PERM = false, AFTER_DRAIN = false;
    float* out; const bf16_t* xb; const int* slot_tok; const float* slot_gate; int slot_base; int ldc; float wscale;
    __device__ __forceinline__ void operator()(const f32x4 (&acc)[2][2][4][2], const Unit& u, int wr, int wc, int fr, int fq) const {
        { int t_ = lane_id_(); asm volatile("" : "+v"(t_)); fr = t_ & 15; fq = (t_ >> 4) & 3; }
        const int pnl = u.pn & 3;
        const int row0 = slot_base + u.pm * BM + wr * 64 + fr, col0 = pnl * BM + wc * 32 + 4 * fq;
        int tk[8]; float gt[8];
#pragma unroll
        for (int it = 0; it < 8; ++it) { const int slot = row0 + (it >> 2) * HALF + (it & 3) * 16; tk[it] = slot_tok[slot]; gt[it] = slot_gate[slot] * wscale; }
        f32x4 rw[4][2][2]; unsigned rlo[4][2][2], rhi[4][2][2];
#define EMD_LOAD(it) do { if (tk[it] >= 0) { _Pragma("unroll") for (int bj = 0; bj < 2; ++bj) _Pragma("unroll") for (int n = 0; n < 2; ++n) { \
            if constexpr (FIRST) { const unsigned long long q_ = *(const unsigned long long*)(xb + (size_t)tk[it] * ldc + col0 + bj * HALF + n * 16); \
                rlo[(it) & 3][bj][n] = (unsigned)q_; rhi[(it) & 3][bj][n] = (unsigned)(q_ >> 32); } \
            else rw[(it) & 3][bj][n] = *(const f32x4*)(out + (size_t)tk[it] * ldc + col0 + bj * HALF + n * 16); } } } while (0)
        EMD_LOAD(0); EMD_LOAD(1); EMD_LOAD(2); EMD_LOAD(3);
#pragma unroll
        for (int it = 0; it < 8; ++it) { const int ai = it >> 2, m = it & 3;
            if (tk[it] >= 0) { float* rowp = out + (size_t)tk[it] * ldc + col0;
#pragma unroll
                for (int bj = 0; bj < 2; ++bj)
#pragma unroll
                    for (int n = 0; n < 2; ++n) { f32x4 r;
                        if constexpr (FIRST) { const unsigned lo = rlo[it & 3][bj][n], hi = rhi[it & 3][bj][n];
                            r = (f32x4){__builtin_bit_cast(float, lo << 16), __builtin_bit_cast(float, lo & 0xffff0000u), __builtin_bit_cast(float, hi << 16), __builtin_bit_cast(float, hi & 0xffff0000u)}; }
                        else r = rw[it & 3][bj][n];
                        *(f32x4*)(rowp + bj * HALF + n * 16) = r + acc[ai][bj][m][n] * gt[it]; } }
            if (it + 4 < 8) EMD_LOAD(it + 4); }
#undef EMD_LOAD
    }
};

struct MoeOrder {
    int nM, nN, nwg, G, c; int pb[7];
    int rot;
    int nBusy, SK;
    __device__ void init(int nPanels, int nN_, int G_, int c_) { nM = nPanels; nN = nN_; nwg = nM * nN; G = G_; c = c_; nBusy = 0; SK = 0; rot = 0; }
    __device__ __forceinline__ int expert_of(int pm) const { int e = 0;
#pragma unroll
        for (int k = 0; k < 7; ++k) e += (pm >= pb[k]) ? 1 : 0;
        return e; }
    __device__ bool next(int i, Unit& u) const {
        int L;
        if (nBusy == 0) { int ce = c - rot; if (ce < 0) ce += G; L = i * G + ce; }
        else if (c >= nBusy) L = (i < SK) ? i * (G - nBusy) + (c - nBusy) : SK * (G - nBusy) + (i - SK) * G + c;
        else L = SK * (G - nBusy) + i * G + c;
        if (L >= nwg) return false;
        int wgid = L; { const int q = nwg / NXCD, r = nwg % NXCD, xcd = wgid % NXCD, off = wgid / NXCD; wgid = (xcd < r ? xcd * (q + 1) : r * (q + 1) + (xcd - r) * q) + off; }
        const int nig = WGM * nN, gid = wgid / nig, fm = gid * WGM, gsz = (nM - fm) < WGM ? (nM - fm) : WGM;
        u.pm = fm + ((wgid % nig) % gsz); const int pnl = (wgid % nig) / gsz;
        u.pn = expert_of(u.pm) * nN + pnl; return true;
    }
    __device__ __forceinline__ void a_ready(const Unit&) const {}
    __device__ __forceinline__ void done(const Unit&) const {}
};
struct LeftOrder {
    MoeOrder M; int nLeft, c0, pbase;
    __device__ bool next(int i, Unit& u) const { const int j = M.c - c0; if (i != 0 || j < 0 || j >= nLeft) return false; u.pm = pbase + (j >> 2); u.pn = M.expert_of(u.pm) * 4 + (j & 3); return true; }
    __device__ __forceinline__ void a_ready(const Unit&) const {}
    __device__ __forceinline__ void done(const Unit&) const {}
};
template <class Epi, class Sched, bool ALIGN_EPI = false, bool SP2 = false, bool F8 = false>
__device__ __forceinline__ void gemm_phase(PG8_LAS unsigned char* lds, const Gemm g, const Sched& S, const Epi& E, const int wave_idx) {
    int tid_ = wave_idx * 64 + lane_id_(); asm volatile("" : "+v"(tid_));
    const int tid = tid_, wid = __builtin_amdgcn_readfirstlane(tid >> 6), lane = tid & 63, wr = wid >> 2, wc = wid & 3, fr = lane & 15, fq = lane >> 4;
    const int K = g.K, nt = K / BK;
    unsigned voffA0, voffB0;
    { int R, C; stage_rc(tid * 16, R, C); const int Rb = Epi::PERM ? ((R & ~31) + perm32(R & 31)) : R;
      voffA0 = (unsigned)(R * g.lda + C) * 2u; voffB0 = (unsigned)(Rb * K + C) * 2u; }
    const size_t voffAR = (size_t)64 * g.lda * 2, voffBR = (size_t)64 * K * 2;
    const size_t kstep = (size_t)(BK * 2);
    const size_t hstepA = (size_t)HALF * g.lda * 2, hstepB = (size_t)HALF * K * 2;
    const size_t tstepA = 2 * hstepA, tstepB = 2 * hstepB;
    const unsigned lds0_ = (unsigned)(__UINTPTR_TYPE__)lds;
    const unsigned ldsw = (unsigned)wid * 1024u;
    const int aoff = lds_byte(wr * 64 + fr, fq * 8), boff = lds_byte(wc * 32 + fr, fq * 8);
#define PG8_SA(b, h) (((b) * 2 + (h)) * HTB)
#define PG8_SB(b, h) ((4 + (b) * 2 + (h)) * HTB)
#define PG8_STAGE(bufoff, gbase, voff) do { _Pragma("unroll") for (int _i = 0; _i < 2; ++_i) { unsigned keep_; const char* sb_ = (const char*)(gbase) + (size_t)_i * voff##R; \
        asm volatile("s_mov_b32 %0, m0\n\ts_mov_b32 m0, %3\n\ts_nop 0\n\tglobal_load_lds_dwordx4 %1, %2\n\ts_mov_b32 m0, %0" \
            : "=&s"(keep_) : "v"(voff##0), "s"(sb_), "s"(lds0_ + (unsigned)((bufoff) + _i * 8192) + ldsw) : "memory"); } } while (0)
#define PG8_LDA(dst, b, h) do { _Pragma("unroll") for (int m = 0; m < 4; ++m) _Pragma("unroll") for (int k = 0; k < 2; ++k) dst[m][k] = *(const PG8_LAS bf16x8*)(lds + PG8_SA(b, h) + aoff + m * 2048 + k * 1024); } while (0)
#define PG8_LDB(dst, b, h) do { _Pragma("unroll") for (int n = 0; n < 2; ++n) _Pragma("unroll") for (int k = 0; k < 2; ++k) dst[n][k] = *(const PG8_LAS bf16x8*)(lds + PG8_SB(b, h) + boff + n * 2048 + k * 1024); } while (0)
#define PG8_MMA(ai, bj, At, Bt) do { __builtin_amdgcn_s_setprio(1); _Pragma("unroll") for (int m = 0; m < 4; ++m) _Pragma("unroll") for (int n = 0; n < 2; ++n) { \
        if constexpr (F8) { typedef int v8i_ __attribute__((ext_vector_type(8))); typedef int v4i_ __attribute__((ext_vector_type(4))); \
            const v4i_ b0_ = __builtin_bit_cast(v4i_, Bt[n][0]), b1_ = __builtin_bit_cast(v4i_, Bt[n][1]), a0_ = __builtin_bit_cast(v4i_, At[m][0]), a1_ = __builtin_bit_cast(v4i_, At[m][1]); \
            const v8i_ bb_ = __builtin_shufflevector(b0_, b1_, 0, 1, 2, 3, 4, 5, 6, 7), aa_ = __builtin_shufflevector(a0_, a1_, 0, 1, 2, 3, 4, 5, 6, 7); \
            acc[ai][bj][m][n] = __builtin_amdgcn_mfma_scale_f32_16x16x128_f8f6f4(bb_, aa_, acc[ai][bj][m][n], 0, 0, 0, 0, 0, 0); } \
        else { _Pragma("unroll") for (int k = 0; k < 2; ++k) acc[ai][bj][m][n] = __builtin_amdgcn_mfma_f32_16x16x32_bf16(Bt[n][k], At[m][k], acc[ai][bj][m][n], 0, 0, 0); } } \
        __builtin_amdgcn_s_setprio(0); } while (0)
#define PG8_WAIT_V(n) asm volatile("s_waitcnt vmcnt(" #n ")" ::: "memory")
#define PG8_WAIT_L(n) asm volatile("s_waitcnt lgkmcnt(" #n ")" ::: "memory")
#define PG8_BAR __builtin_amdgcn_s_barrier()
#define PG8_SCHED __builtin_amdgcn_sched_barrier(0)
    Unit cur, nxt; int ui = 0;
    if (!S.next(0, cur)) return;
    f32x4 acc[2][2][4][2];
#pragma unroll
    for (int a = 0; a < 2; ++a)
#pragma unroll
        for (int b = 0; b < 2; ++b)
#pragma unroll
            for (int m = 0; m < 4; ++m)
#pragma unroll
                for (int n = 0; n < 2; ++n) acc[a][b][m][n] = (f32x4){0.f, 0.f, 0.f, 0.f};
    bf16x8 At[4][2], B0[2][2], B1[2][2];
    const char* cA = (const char*)g.A + (size_t)cur.pm * tstepA; const char* cB = (const char*)g.Bt + (size_t)cur.pn * tstepB;
    S.a_ready(cur);
    if constexpr (SP2) {
        PG8_STAGE(PG8_SB(0, 0), cB, voffB); PG8_STAGE(PG8_SB(0, 1), cB + hstepB, voffB); PG8_STAGE(PG8_SA(0, 0), cA, voffA); PG8_STAGE(PG8_SA(0, 1), cA + hstepA, voffA);
        if (wr == 1) PG8_BAR;
        PG8_WAIT_V(2); PG8_BAR;
        PG8_STAGE(PG8_SB(1, 0), cB + kstep, voffB); PG8_STAGE(PG8_SA(1, 0), cA + kstep, voffA); PG8_STAGE(PG8_SB(1, 1), cB + hstepB + kstep, voffB);
        PG8_WAIT_V(6); PG8_BAR;
    } else {
        PG8_STAGE(PG8_SB(0, 0), cB, voffB); PG8_STAGE(PG8_SA(0, 0), cA, voffA); PG8_STAGE(PG8_SB(0, 1), cB + hstepB, voffB); PG8_STAGE(PG8_SA(0, 1), cA + hstepA, voffA);
        if (wr == 1) PG8_BAR;
        PG8_WAIT_V(4); PG8_BAR;
        PG8_STAGE(PG8_SB(1, 0), cB + kstep, voffB); PG8_STAGE(PG8_SA(1, 0), cA + kstep, voffA); PG8_STAGE(PG8_SB(1, 1), cB + hstepB + kstep, voffB);
        PG8_WAIT_V(6); PG8_BAR;
    }
    for (;;) {
        const bool has_next = S.next(ui + 1, nxt);
        const char* nA = has_next ? (const char*)g.A + (size_t)nxt.pm * tstepA : cA; const char* nB = has_next ? (const char*)g.Bt + (size_t)nxt.pn * tstepB : cB;
#pragma unroll 1
        for (int t = 0; t < nt; t += 2) {
            const bool last = (t == nt - 2);
            const char* a1 = cA + (size_t)(t + 1) * kstep;
            const char* a2 = last ? nA : cA + (size_t)(t + 2) * kstep; const char* b2 = last ? nB : cB + (size_t)(t + 2) * kstep;
            const char* a3 = a2 + kstep; const char* b3 = b2 + kstep;
            if (last && has_next) S.a_ready(nxt);
            if constexpr (SP2) {
            PG8_LDB(B0, 0, 0); PG8_LDB(B1, 0, 1); PG8_SCHED; PG8_LDA(At, 0, 0); PG8_STAGE(PG8_SA(1, 1), a1 + hstepA, voffA);
            PG8_WAIT_V(8); PG8_WAIT_L(0); PG8_BAR; PG8_MMA(0, 0, At, B0); PG8_MMA(0, 1, At, B1); PG8_BAR; PG8_SCHED;
            PG8_LDA(At, 0, 1); PG8_STAGE(PG8_SB(0, 0), b2, voffB); PG8_STAGE(PG8_SB(0, 1), b2 + hstepB, voffB); PG8_STAGE(PG8_SA(0, 0), a2, voffA);
            PG8_WAIT_V(8); PG8_WAIT_L(0); PG8_BAR; PG8_MMA(1, 0, At, B0); PG8_MMA(1, 1, At, B1); PG8_BAR; PG8_SCHED;
            PG8_LDB(B0, 1, 0); PG8_LDB(B1, 1, 1); PG8_SCHED; PG8_LDA(At, 1, 0); PG8_STAGE(PG8_SA(0, 1), a2 + hstepA, voffA);
            PG8_WAIT_V(8); PG8_WAIT_L(0); PG8_BAR; PG8_MMA(0, 0, At, B0); PG8_MMA(0, 1, At, B1); PG8_BAR; PG8_SCHED;
            PG8_LDA(At, 1, 1); PG8_STAGE(PG8_SB(1, 0), b3, voffB); PG8_STAGE(PG8_SB(1, 1), b3 + hstepB, voffB); PG8_STAGE(PG8_SA(1, 0), a3, voffA);
            PG8_WAIT_V(8); PG8_WAIT_L(0); PG8_BAR; PG8_MMA(1, 0, At, B0); PG8_MMA(1, 1, At, B1); PG8_BAR; PG8_SCHED;
            } else {
            PG8_LDB(B0, 0, 0); PG8_SCHED; PG8_LDA(At, 0, 0); PG8_STAGE(PG8_SA(1, 1), a1 + hstepA, voffA);
            PG8_WAIT_L(8); PG8_BAR; PG8_WAIT_L(0); PG8_MMA(0, 0, At, B0); PG8_BAR; PG8_SCHED;
            PG8_LDB(B1, 0, 1); PG8_STAGE(PG8_SB(0, 0), b2, voffB);
            PG8_BAR; PG8_WAIT_L(0); PG8_MMA(0, 1, At, B1); PG8_BAR;
            PG8_LDA(At, 0, 1); PG8_STAGE(PG8_SA(0, 0), a2, voffA);
            PG8_BAR; PG8_WAIT_L(0); PG8_MMA(1, 0, At, B0); PG8_BAR; PG8_SCHED;
            PG8_STAGE(PG8_SB(0, 1), b2 + hstepB, voffB);
            PG8_WAIT_V(6); PG8_BAR; PG8_MMA(1, 1, At, B1); PG8_BAR;
            PG8_LDB(B0, 1, 0); PG8_SCHED; PG8_LDA(At, 1, 0); PG8_STAGE(PG8_SA(0, 1), a2 + hstepA, voffA);
            PG8_WAIT_L(8); PG8_BAR; PG8_WAIT_L(0); PG8_MMA(0, 0, At, B0); PG8_BAR; PG8_SCHED;
            PG8_LDB(B1, 1, 1); PG8_STAGE(PG8_SB(1, 0), b3, voffB);
            PG8_BAR; PG8_WAIT_L(0); PG8_MMA(0, 1, At, B1); PG8_BAR;
            PG8_LDA(At, 1, 1); PG8_STAGE(PG8_SA(1, 0), a3, voffA);
            PG8_BAR; PG8_WAIT_L(0); PG8_MMA(1, 0, At, B0); PG8_BAR; PG8_SCHED;
            PG8_STAGE(PG8_SB(1, 1), b3 + hstepB, voffB);
            PG8_WAIT_V(6); PG8_BAR; PG8_MMA(1, 1, At, B1); PG8_BAR;
            }
        }
        if constexpr (ALIGN_EPI) { if (wr == 0) PG8_BAR; }
        if constexpr (!Epi::AFTER_DRAIN) { E(acc, cur, wr, wc, fr, fq); S.done(cur); }
        if (!has_next) break;
#pragma unroll
        for (int a = 0; a < 2; ++a)
#pragma unroll
            for (int b = 0; b < 2; ++b)
#pragma unroll
                for (int m = 0; m < 4; ++m)
#pragma unroll
                    for (int n = 0; n < 2; ++n) acc[a][b][m][n] = (f32x4){0.f, 0.f, 0.f, 0.f};
        cur = nxt; cA = nA; cB = nB; ++ui;
        if constexpr (ALIGN_EPI) { if (wr == 1) PG8_BAR; }
    }
    PG8_WAIT_V(0);
    if constexpr (!ALIGN_EPI) { if (wr == 0) PG8_BAR; }
    PG8_BAR;
    if constexpr (Epi::AFTER_DRAIN) { E.fused(acc, cur, wr, wc, fr, fq, lds, wid, lane); S.done(cur); }
#undef PG8_SA
#undef PG8_SB
#undef PG8_STAGE
#undef PG8_LDA
#undef PG8_LDB
#undef PG8_MMA
#undef PG8_WAIT_V
#undef PG8_WAIT_L
#undef PG8_BAR
#undef PG8_SCHED
}
}
namespace att {
#define ATT_LAS __attribute__((address_space(3)))
typedef unsigned short bf16;
typedef short bf16x8 __attribute__((ext_vector_type(8)));
typedef short s16x4 __attribute__((ext_vector_type(4)));
typedef float f32x16 __attribute__((ext_vector_type(16)));
typedef float f32x4_t __attribute__((ext_vector_type(4)));
typedef unsigned u32x4 __attribute__((ext_vector_type(4)));
typedef unsigned u32x2 __attribute__((ext_vector_type(2)));
typedef float f32x2_t __attribute__((ext_vector_type(2))); typedef __bf16 bf16x2_t __attribute__((ext_vector_type(2)));
__device__ __forceinline__ unsigned cvtpk(float lo, float hi) { f32x2_t v = {lo, hi}; bf16x2_t b = __builtin_convertvector(v, bf16x2_t); return __builtin_bit_cast(unsigned, b); }
__device__ __forceinline__ s16x4 vtr(const ATT_LAS unsigned char* p) { return __builtin_bit_cast(s16x4, __builtin_amdgcn_ds_read_tr16_b64_v4i16((ATT_LAS s16x4*)p)); }
constexpr int VSTR = 192;
template <int DQK> struct Geo { static constexpr int KSTR = DQK * 2 + 16, KBUF = 64 * KSTR, VBUF = 64 * VSTR, CPR = DQK / 8, NKC = 64 * CPR, KIT = (NKC + 511) / 512; };
template <int DQK> constexpr int lds_bytes() { return 3 * Geo<DQK>::KBUF + 3 * Geo<DQK>::VBUF + 2048 + 8192; }

__device__ __forceinline__ float xhalf_sum(float m) { return xor32_sum(m); }
__device__ __forceinline__ float max3f(float a, float b, float c) { float r; asm("v_max3_f32 %0, %1, %2, %3" : "=v"(r) : "v"(a), "v"(b), "v"(c)); return r; }
__device__ __forceinline__ float max2f(float a, float b) { float r; asm("v_max_f32_e32 %0, %1, %2" : "=v"(r) : "v"(a), "v"(b)); return r; }
__device__ __forceinline__ float rowmax32(const f32x16& p0, const f32x16& p1) {
    float a = max2f(p0[0], p1[0]), b = max2f(p0[1], p1[1]), c = max2f(p0[2], p1[2]), d = max2f(p0[3], p1[3]);
#pragma unroll
    for (int r = 4; r < 16; r += 4) { a = max3f(a, p0[r], p1[r]); b = max3f(b, p0[r + 1], p1[r + 1]); c = max3f(c, p0[r + 2], p1[r + 2]); d = max3f(d, p0[r + 3], p1[r + 3]); }
    const float m = max2f(max2f(a, b), max2f(c, d));
    float lo_, hi_; halves32(m, lo_, hi_);
    return max2f(lo_, hi_);
}

template <int DQK, int kpitch, int vpitch, int NS>
__device__ __forceinline__ void attn_init(ATT_LAS unsigned char* lds, const int wave_idx) {
    typedef Geo<DQK> G;
    const int lane = lane_id_(), wid = wave_idx;
    constexpr int KCPL = G::KSTR / 16, KNP = (64 * KCPL + 63) / 64, VCPL = VSTR / 16, VNP = 64 * VCPL / 64, KPP = (KNP + 7) / 8, VPP = (VNP + 7) / 8;
    ATT_LAS unsigned* dmaL = (ATT_LAS unsigned*)(lds + NS * G::KBUF + NS * G::VBUF + 2048) + wid * 256 + lane;
#pragma unroll
    for (int pp = 0; pp < KPP; ++pp) { const int pc = wid + 8 * pp, c = pc * 64 + lane, row = (c / KCPL) & 63, ch = c % KCPL; dmaL[64 * pp] = (unsigned)(row * kpitch + (ch < G::CPR ? ch : 0) * 8) * 2u; }
#pragma unroll
    for (int pp = 0; pp < VPP; ++pp) { const int pc = wid + 8 * pp, c = pc * 64 + lane, row = (c / VCPL) & 63, ch = c % VCPL; dmaL[128 + 64 * pp] = (unsigned)(row * vpitch + (ch < 8 ? ch : 0) * 8) * 2u; }
}

template <int DQK, bool BAND, int qpitch, int kpitch, int vpitch, int opitch, bool OF8 = false, bool NOMAX = false, int NS = 2, int DBG = 0>
__device__ __forceinline__ void attn_unit(ATT_LAS unsigned char* lds, const bf16* Qb, const bf16* Kb, const bf16* Vb, bf16* Ob,
                                          int q0, int t_lo, int t_hi, int my_lo, int my_hi, int cc, const float* bias_g, const float* g_qn, const float* rope, const int wave_idx, const bool load_bias,
                                          bf16x8 (&qf)[DQK / 16], const bool q_loaded, const bool has_next, const bf16* Qn) {
    typedef Geo<DQK> G;
    int tid_ = wave_idx * 64 + lane_id_(); asm volatile("" : "+v"(tid_));
    const int tid = tid_, lane = tid & 63, r32 = lane & 31, hi = lane >> 5, wid = __builtin_amdgcn_readfirstlane(tid >> 6);
    ATT_LAS float* biasL = (ATT_LAS float*)(lds + NS * G::KBUF + NS * G::VBUF);
    constexpr int KCPL = G::KSTR / 16, KNP = (64 * KCPL + 63) / 64;
    constexpr int VCPL = VSTR / 16, VNP = 64 * VCPL / 64;
    constexpr int KPP = (KNP + 7) / 8, VPP = (VNP + 7) / 8;
    ATT_LAS unsigned* dmaL = (ATT_LAS unsigned*)(lds + NS * G::KBUF + NS * G::VBUF + 2048) + wid * 256 + lane;
    const unsigned ldsb = __builtin_amdgcn_readfirstlane((unsigned)(size_t)lds);
    const int kc = (KNP - 1 - wid) / 8 + 1, vc = (VNP - 1 - wid) / 8 + 1;
#define ATT_MOD3(x) (NS == 3 ? (x) - 3 * (((x) * 43) >> 7) : ((x) & 1))
#define ATT_DMA1(gptr, voff_, ldsaddr) do { unsigned keep_; asm volatile("s_mov_b32 %0, m0\n\ts_mov_b32 m0, %3\n\ts_nop 0\n\tglobal_load_lds_dwordx4 %1, %2\n\ts_mov_b32 m0, %0" \
            : "=&s"(keep_) : "v"(voff_), "s"(gptr), "s"(ldsaddr) : "memory"); } while (0)
#define ATT_DMA_K(t) do { const int t_ = (t); const char* kt_ = (const char*)(Kb + (size_t)t_ * 64 * kpitch); const unsigned d_ = ldsb + ATT_MOD3(t_) * G::KBUF + wid * 1024; \
        _Pragma("unroll") for (int pp = 0; pp < KPP; ++pp) { if (wid + 8 * pp < KNP) { const unsigned vo_ = dmaL[64 * pp]; ATT_DMA1(kt_, vo_, d_ + pp * 8192); } } } while (0)
#define ATT_DMA_V(t) do { const int t_ = (t); const char* vt_ = (const char*)(Vb + (size_t)t_ * 64 * vpitch); const unsigned d_ = ldsb + NS * G::KBUF + ATT_MOD3(t_) * G::VBUF + wid * 1024; \
        _Pragma("unroll") for (int pp = 0; pp < VPP; ++pp) { if (wid + 8 * pp < VNP) { const unsigned vo_ = dmaL[128 + 64 * pp]; ATT_DMA1(vt_, vo_, d_ + pp * 8192); } } } while (0)
#define ATT_WAITBAR(n) do { const int n_ = (n); \
        if (n_ == 0) asm volatile("s_waitcnt vmcnt(0) lgkmcnt(0)\n\ts_barrier" ::: "memory"); else if (n_ == 1) asm volatile("s_waitcnt vmcnt(1) lgkmcnt(0)\n\ts_barrier" ::: "memory"); \
        else if (n_ == 2) asm volatile("s_waitcnt vmcnt(2) lgkmcnt(0)\n\ts_barrier" ::: "memory"); else if (n_ == 3) asm volatile("s_waitcnt vmcnt(3) lgkmcnt(0)\n\ts_barrier" ::: "memory"); \
        else if (n_ == 4) asm volatile("s_waitcnt vmcnt(4) lgkmcnt(0)\n\ts_barrier" ::: "memory"); else if (n_ == 5) asm volatile("s_waitcnt vmcnt(5) lgkmcnt(0)\n\ts_barrier" ::: "memory"); \
        else asm volatile("s_waitcnt vmcnt(6) lgkmcnt(0)\n\ts_barrier" ::: "memory"); } while (0)
    ATT_DMA_K(t_lo); ATT_DMA_V(t_lo);
    if (t_lo + 1 <= t_hi) { ATT_DMA_K(t_lo + 1); if (NS == 3) ATT_DMA_V(t_lo + 1); }
    if (NS == 3) { if (t_lo + 2 <= t_hi) ATT_DMA_K(t_lo + 2); }
    if (BAND) { if (load_bias && tid < 257) biasL[tid] = bias_g[tid] * 1.4426950408889634f; }
    if (!q_loaded) { const bf16* qp = Qb + (size_t)(q0 + wid * 32 + r32) * qpitch + 8 * hi;
#pragma unroll
      for (int kk = 0; kk < DQK / 16; ++kk) { if constexpr (DBG & 8) qf[kk] = (bf16x8){(short)lane, 1, 2, 3, 4, 5, 6, 7}; else qf[kk] = *(const bf16x8*)(qp + 16 * kk); } }
    if constexpr (!BAND) {
        float qv[DQK / 16][8]; float ss = 0.f;
#pragma unroll
        for (int kk = 0; kk < DQK / 16; ++kk)
#pragma unroll
            for (int j = 0; j < 8; ++j) { qv[kk][j] = __builtin_bit_cast(float, (unsigned)(unsigned short)qf[kk][j] << 16); ss += qv[kk][j] * qv[kk][j]; }
        ss = xhalf_sum(ss);
        const float rs = __builtin_amdgcn_rsqf(ss * (1.f / DQK) + 1e-6f) * (0.10206207261596577f * 1.4426950408889634f);
#pragma unroll
        for (int kk = 0; kk < DQK / 16; ++kk) { const f32x4_t g0 = *(const f32x4_t*)(g_qn + 16 * kk + 8 * hi), g1 = *(const f32x4_t*)(g_qn + 16 * kk + 8 * hi + 4);
#pragma unroll
            for (int j = 0; j < 4; ++j) { qv[kk][j] *= rs * g0[j]; qv[kk][4 + j] *= rs * g1[j]; } }
        const f32x4_t* rp = (const f32x4_t*)(rope + ((size_t)(q0 + wid * 32 + r32) * 16 + 8 * hi) * 2);
#pragma unroll
        for (int j2 = 0; j2 < 4; ++j2) { const f32x4_t cs = rp[j2];
            { const float x1 = qv[4][2 * j2], x2 = qv[5][2 * j2]; qv[4][2 * j2] = x1 * cs[0] - x2 * cs[1]; qv[5][2 * j2] = x2 * cs[0] + x1 * cs[1]; }
            { const float x1 = qv[4][2 * j2 + 1], x2 = qv[5][2 * j2 + 1]; qv[4][2 * j2 + 1] = x1 * cs[2] - x2 * cs[3]; qv[5][2 * j2 + 1] = x2 * cs[2] + x1 * cs[3]; } }
#pragma unroll
        for (int kk = 0; kk < DQK / 16; ++kk) { u32x4 w; w.x = cvtpk(qv[kk][0], qv[kk][1]); w.y = cvtpk(qv[kk][2], qv[kk][3]); w.z = cvtpk(qv[kk][4], qv[kk][5]); w.w = cvtpk(qv[kk][6], qv[kk][7]);
            qf[kk] = __builtin_bit_cast(bf16x8, w); }
    }
    f32x16 o0, o1;
#pragma unroll
    for (int i = 0; i < 16; ++i) { o0[i] = 0.f; o1[i] = 0.f; }
    float mrun = -INFINITY, lsum = 0.f; float ls4[4] = {0.f, 0.f, 0.f, 0.f};
    const int koff = r32 * G::KSTR + hi * 16;
    const int voff = ((lane >> 5) * 4 + ((lane & 15) >> 2)) * VSTR + (((lane >> 4) & 1) * 16 + (lane & 3) * 4) * 2;
    const f32x16 zero16 = {0.f, 0.f, 0.f, 0.f, 0.f, 0.f, 0.f, 0.f, 0.f, 0.f, 0.f, 0.f, 0.f, 0.f, 0.f, 0.f};
#define ATT_QK(X0, X1, t) do { const ATT_LAS unsigned char* Kt = lds + ATT_MOD3(t) * G::KBUF + koff; \
        _Pragma("unroll") for (int kk = 0; kk < DQK / 16; ++kk) { \
            const bf16x8 a0 = *(const ATT_LAS bf16x8*)(Kt + kk * 32); const bf16x8 a1 = *(const ATT_LAS bf16x8*)(Kt + 32 * G::KSTR + kk * 32); \
            X0 = __builtin_amdgcn_mfma_f32_32x32x16_bf16(a0, qf[kk], kk ? X0 : zero16, 0, 0, 0); X1 = __builtin_amdgcn_mfma_f32_32x32x16_bf16(a1, qf[kk], kk ? X1 : zero16, 0, 0, 0); } } while (0)
#define ATT_FARSCALE() do { const float f_ = __builtin_amdgcn_exp2f(biasL[256]); _Pragma("unroll") for (int i = 0; i < 16; ++i) { o0[i] *= f_; o1[i] *= f_; } \
        ls4[0] *= f_; ls4[1] *= f_; ls4[2] *= f_; ls4[3] *= f_; } while (0)
#define ATT_SMPV(X0, X1, t) do { \
        float cadd = 0.f; \
        if (BAND && !(DBG & 2)) { const int delta = cc - (t); \
            if (delta >= 3) { if constexpr (!NOMAX) cadd = biasL[256]; } \
            else { const ATT_LAS float* bp = biasL + (64 * delta + (32 * (wid & 1) + r32) - 4 * hi + 128 - 63); \
                if (delta < 2) { _Pragma("unroll") for (int i = 0; i < 16; ++i) { const int kj = (i & 3) + 8 * (i >> 2); X0[i] += bp[63 - kj]; X1[i] += bp[31 - kj]; } } \
                else { const int relb = 64 * delta + (32 * (wid & 1) + r32) - 4 * hi + 128; \
                    _Pragma("unroll") for (int i = 0; i < 16; ++i) { const int kj = (i & 3) + 8 * (i >> 2); int i0 = relb - kj, i1 = relb - kj - 32; i0 = i0 > 256 ? 256 : i0; i1 = i1 > 256 ? 256 : i1; \
                        X0[i] += biasL[i0]; X1[i] += biasL[i1]; } } } } \
        if constexpr (NOMAX) { \
            _Pragma("unroll") for (int i = 0; i < 16; ++i) { X0[i] = __builtin_amdgcn_exp2f(X0[i]); X1[i] = __builtin_amdgcn_exp2f(X1[i]); ls4[i & 3] += X0[i] + X1[i]; } \
        } else { \
        const float mt = rowmax32(X0, X1) + cadd; \
        const float mnew = max2f(mrun, mt); \
        const float alpha = __builtin_amdgcn_exp2f(mrun - mnew); \
        const float msub = mnew - cadd; \
        mrun = mnew; \
        float psa[4] = {0.f, 0.f, 0.f, 0.f};   \
        _Pragma("unroll") for (int i = 0; i < 16; ++i) { X0[i] = __builtin_amdgcn_exp2f(X0[i] - msub); X1[i] = __builtin_amdgcn_exp2f(X1[i] - msub); psa[i & 3] += X0[i] + X1[i]; } \
        const float ps = (psa[0] + psa[1]) + (psa[2] + psa[3]); \
        lsum = lsum * alpha + ps; \
        _Pragma("unroll") for (int i = 0; i < 16; ++i) { o0[i] *= alpha; o1[i] *= alpha; } } \
        bf16x8 pf[2][2]; \
        _Pragma("unroll") for (int s = 0; s < 2; ++s) { u32x4 w0, w1; \
            w0.x = cvtpk(X0[8 * s + 0], X0[8 * s + 1]); w0.y = cvtpk(X0[8 * s + 2], X0[8 * s + 3]); w0.z = cvtpk(X0[8 * s + 4], X0[8 * s + 5]); w0.w = cvtpk(X0[8 * s + 6], X0[8 * s + 7]); \
            w1.x = cvtpk(X1[8 * s + 0], X1[8 * s + 1]); w1.y = cvtpk(X1[8 * s + 2], X1[8 * s + 3]); w1.z = cvtpk(X1[8 * s + 4], X1[8 * s + 5]); w1.w = cvtpk(X1[8 * s + 6], X1[8 * s + 7]); \
            pf[0][s] = __builtin_bit_cast(bf16x8, w0); pf[1][s] = __builtin_bit_cast(bf16x8, w1); } \
        const ATT_LAS unsigned char* Vt = lds + NS * G::KBUF + ATT_MOD3(t) * G::VBUF + voff; \
        _Pragma("unroll") for (int kb = 0; kb < 2; ++kb) _Pragma("unroll") for (int s = 0; s < 2; ++s) { \
            const ATT_LAS unsigned char* vp = Vt + (32 * kb + 16 * s) * VSTR; \
            const s16x4 l0 = vtr(vp), h0 = vtr(vp + 8 * VSTR), l1 = vtr(vp + 64), h1 = vtr(vp + 8 * VSTR + 64); \
            const bf16x8 a0 = (bf16x8){l0[0], l0[1], l0[2], l0[3], h0[0], h0[1], h0[2], h0[3]}; \
            const bf16x8 a1 = (bf16x8){l1[0], l1[1], l1[2], l1[3], h1[0], h1[1], h1[2], h1[3]}; \
            o0 = __builtin_amdgcn_mfma_f32_32x32x16_bf16(a0, pf[kb][s], o0, 0, 0, 0); o1 = __builtin_amdgcn_mfma_f32_32x32x16_bf16(a1, pf[kb][s], o1, 0, 0, 0); } \
        if constexpr (NOMAX && BAND) { if (cc - (t) == 3) ATT_FARSCALE(); } } while (0)
#define ATT_FUSED(C0, C1, N0, N1, t, tn) do { \
        bf16x8 kfa[DQK / 16], kfb[DQK / 16]; \
        { const ATT_LAS unsigned char* Kt = lds + ATT_MOD3(tn) * G::KBUF + koff; \
          _Pragma("unroll") for (int kk = 0; kk < DQK / 16; ++kk) { kfa[kk] = *(const ATT_LAS bf16x8*)(Kt + kk * 32); kfb[kk] = *(const ATT_LAS bf16x8*)(Kt + 32 * G::KSTR + kk * 32); } } \
        if constexpr (!NOMAX) __builtin_amdgcn_sched_barrier(0); \
        float cadd = 0.f; \
        if (BAND && !(DBG & 2)) { const int delta = cc - (t); \
            if (delta >= 3) { if constexpr (!NOMAX) cadd = biasL[256]; } \
            else { const ATT_LAS float* bp = biasL + (64 * delta + (32 * (wid & 1) + r32) - 4 * hi + 128 - 63); \
                if (delta < 2) { _Pragma("unroll") for (int i = 0; i < 16; ++i) { const int kj = (i & 3) + 8 * (i >> 2); C0[i] += bp[63 - kj]; C1[i] += bp[31 - kj]; } } \
                else { const int relb = 64 * delta + (32 * (wid & 1) + r32) - 4 * hi + 128; \
                    _Pragma("unroll") for (int i = 0; i < 16; ++i) { const int kj = (i & 3) + 8 * (i >> 2); int i0 = relb - kj, i1 = relb - kj - 32; i0 = i0 > 256 ? 256 : i0; i1 = i1 > 256 ? 256 : i1; \
                        C0[i] += biasL[i0]; C1[i] += biasL[i1]; } } } } \
        float alpha = 1.f, msub = 0.f; \
        if constexpr (!NOMAX) { \
        const float mt = rowmax32(C0, C1) + cadd; \
        const float mnew = max2f(mrun, mt); \
        alpha = __builtin_amdgcn_exp2f(mrun - mnew); \
        msub = mnew - cadd; \
        if (__builtin_amdgcn_ballot_w64(mnew > mrun)) { _Pragma("unroll") for (int i = 0; i < 16; ++i) { o0[i] *= alpha; o1[i] *= alpha; } } \
        mrun = mnew; } \
        if constexpr (!NOMAX || BAND) __builtin_amdgcn_sched_barrier(0); \
        _Pragma("unroll") for (int kk = 0; kk < DQK / 16; ++kk) { \
            N0 = __builtin_amdgcn_mfma_f32_32x32x16_bf16(kfa[kk], qf[kk], kk ? N0 : zero16, 0, 0, 0); N1 = __builtin_amdgcn_mfma_f32_32x32x16_bf16(kfb[kk], qf[kk], kk ? N1 : zero16, 0, 0, 0); } \
        s16x4 vl0[4], vh0[4], vl1[4], vh1[4]; \
        { const ATT_LAS unsigned char* Vt = lds + NS * G::KBUF + ATT_MOD3(t) * G::VBUF + voff; \
          _Pragma("unroll") for (int ks = 0; ks < 4; ++ks) { const ATT_LAS unsigned char* vp = Vt + 16 * ks * VSTR; vl0[ks] = vtr(vp); vh0[ks] = vtr(vp + 8 * VSTR); vl1[ks] = vtr(vp + 64); vh1[ks] = vtr(vp + 8 * VSTR + 64); } } \
        if constexpr (NOMAX) { \
            _Pragma("unroll") for (int i = 0; i < 16; ++i) { C0[i] = __builtin_amdgcn_exp2f(C0[i]); C1[i] = __builtin_amdgcn_exp2f(C1[i]); ls4[i & 3] += C0[i] + C1[i]; } \
        } else { \
        float psa[4] = {0.f, 0.f, 0.f, 0.f}; \
        _Pragma("unroll") for (int i = 0; i < 16; ++i) { C0[i] = __builtin_amdgcn_exp2f(C0[i] - msub); C1[i] = __builtin_amdgcn_exp2f(C1[i] - msub); psa[i & 3] += C0[i] + C1[i]; } \
        const float ps = (psa[0] + psa[1]) + (psa[2] + psa[3]); \
        lsum = lsum * alpha + ps; } \
        bf16x8 pf[4]; \
        _Pragma("unroll") for (int s = 0; s < 2; ++s) { u32x4 w0, w1; \
            w0.x = cvtpk(C0[8 * s + 0], C0[8 * s + 1]); w0.y = cvtpk(C0[8 * s + 2], C0[8 * s + 3]); w0.z = cvtpk(C0[8 * s + 4], C0[8 * s + 5]); w0.w = cvtpk(C0[8 * s + 6], C0[8 * s + 7]); \
            w1.x = cvtpk(C1[8 * s + 0], C1[8 * s + 1]); w1.y = cvtpk(C1[8 * s + 2], C1[8 * s + 3]); w1.z = cvtpk(C1[8 * s + 4], C1[8 * s + 5]); w1.w = cvtpk(C1[8 * s + 6], C1[8 * s + 7]); \
            pf[s] = __builtin_bit_cast(bf16x8, w0); pf[2 + s] = __builtin_bit_cast(bf16x8, w1); } \
        __builtin_amdgcn_sched_barrier(0); \
        _Pragma("unroll") for (int ks = 0; ks < 4; ++ks) { \
            const bf16x8 a0 = (bf16x8){vl0[ks][0], vl0[ks][1], vl0[ks][2], vl0[ks][3], vh0[ks][0], vh0[ks][1], vh0[ks][2], vh0[ks][3]}; \
            const bf16x8 a1 = (bf16x8){vl1[ks][0], vl1[ks][1], vl1[ks][2], vl1[ks][3], vh1[ks][0], vh1[ks][1], vh1[ks][2], vh1[ks][3]}; \
            o0 = __builtin_amdgcn_mfma_f32_32x32x16_bf16(a0, pf[ks], o0, 0, 0, 0); o1 = __builtin_amdgcn_mfma_f32_32x32x16_bf16(a1, pf[ks], o1, 0, 0, 0); } \
        if constexpr (NOMAX && BAND) { if (cc - (t) == 3) ATT_FARSCALE(); } } while (0)
#define ATT_STAGE(t) do { if ((t) + NS <= t_hi) ATT_DMA_K((t) + NS); if ((t) + NS - 1 <= t_hi) ATT_DMA_V((t) + NS - 1); } while (0)
#define ATT_STAGE_T(t) do { ATT_STAGE(t); \
        if ((t) == t_hi && has_next) { const bf16* qp_ = Qn + (size_t)(wid * 32 + r32) * qpitch + 8 * hi; _Pragma("unroll") for (int kk = 0; kk < DQK / 16; ++kk) qf[kk] = *(const bf16x8*)(qp_ + 16 * kk); } } while (0)
#define ATT_NFL(t) ((NS == 3 ? ((t) + 3 <= t_hi ? kc : 0) + ((t) + 2 <= t_hi ? vc : 0) : 0) + (((t) == t_hi && has_next) ? DQK / 16 : 0))
    f32x16 sa0, sa1, sb0, sb1;
    ATT_WAITBAR(0);
    if (my_lo == t_lo) ATT_QK(sa0, sa1, t_lo);
    ATT_WAITBAR(0);
    {
        int t = t_lo;
        for (; t < my_lo - 1; ++t) { ATT_STAGE(t); ATT_WAITBAR(ATT_NFL(t)); }
        if (my_lo > t_lo) { ATT_STAGE(t); ATT_QK(sa0, sa1, t + 1); ATT_WAITBAR(ATT_NFL(t)); ++t; }
        int nf = my_hi - my_lo;
        for (; nf >= 2; nf -= 2, t += 2) {
            ATT_STAGE(t); ATT_FUSED(sa0, sa1, sb0, sb1, t, t + 1); ATT_WAITBAR(ATT_NFL(t));
            ATT_STAGE(t + 1); ATT_FUSED(sb0, sb1, sa0, sa1, t + 1, t + 2); ATT_WAITBAR(ATT_NFL(t + 1));
        }
        if (nf == 1) {
            ATT_STAGE(t); ATT_FUSED(sa0, sa1, sb0, sb1, t, t + 1); ATT_WAITBAR(ATT_NFL(t)); ++t;
            ATT_STAGE_T(t); ATT_SMPV(sb0, sb1, t); ATT_WAITBAR(ATT_NFL(t)); ++t;
        } else {
            ATT_STAGE_T(t); ATT_SMPV(sa0, sa1, t); ATT_WAITBAR(ATT_NFL(t)); ++t;
        }
        for (; t <= t_hi; ++t) { ATT_STAGE_T(t); ATT_WAITBAR(ATT_NFL(t)); }
    }
    if constexpr (NOMAX) lsum = (ls4[0] + ls4[1]) + (ls4[2] + ls4[3]);
    const float ltot = xhalf_sum(lsum);
    const float inv = 1.f / ltot;
    if constexpr (DBG & 4) { if (ltot == 12345.678f) *(float*)Ob = o0[0] + o1[0]; } else
    if constexpr (OF8) {
        const float i64 = inv * 32.f;
        int w0[4], w1[4];
#pragma unroll
        for (int g4 = 0; g4 < 4; ++g4) { w0[g4] = 0; w1[g4] = 0;
            w0[g4] = __builtin_amdgcn_cvt_pk_fp8_f32(o0[4 * g4 + 0] * i64, o0[4 * g4 + 1] * i64, w0[g4], false); w0[g4] = __builtin_amdgcn_cvt_pk_fp8_f32(o0[4 * g4 + 2] * i64, o0[4 * g4 + 3] * i64, w0[g4], true);
            w1[g4] = __builtin_amdgcn_cvt_pk_fp8_f32(o1[4 * g4 + 0] * i64, o1[4 * g4 + 1] * i64, w1[g4], false); w1[g4] = __builtin_amdgcn_cvt_pk_fp8_f32(o1[4 * g4 + 2] * i64, o1[4 * g4 + 3] * i64, w1[g4], true); }
        asm volatile("s_nop 1\n\tv_permlane32_swap_b32 %0, %1\n\tv_permlane32_swap_b32 %2, %3\n\tv_permlane32_swap_b32 %4, %5\n\tv_permlane32_swap_b32 %6, %7\n\ts_nop 1"
                     : "+v"(w0[2]), "+v"(w0[0]), "+v"(w0[3]), "+v"(w0[1]), "+v"(w1[2]), "+v"(w1[0]), "+v"(w1[3]), "+v"(w1[1]));
        unsigned char* op = (unsigned char*)Ob + (size_t)(q0 + wid * 32 + r32) * opitch + (hi ? 0 : 16);
        *(u32x4*)op = (u32x4){(unsigned)w0[2], (unsigned)w0[0], (unsigned)w0[3], (unsigned)w0[1]};
        *(u32x4*)(op + 32) = (u32x4){(unsigned)w1[2], (unsigned)w1[0], (unsigned)w1[3], (unsigned)w1[1]};
    } else {
    bf16* op = Ob + (size_t)(q0 + wid * 32 + r32) * opitch + 4 * hi;
#pragma unroll
    for (int g4 = 0; g4 < 4; ++g4) {
        u32x2 w0, w1;
        w0.x = cvtpk(o0[4 * g4 + 0] * inv, o0[4 * g4 + 1] * inv); w0.y = cvtpk(o0[4 * g4 + 2] * inv, o0[4 * g4 + 3] * inv);
        w1.x = cvtpk(o1[4 * g4 + 0] * inv, o1[4 * g4 + 1] * inv); w1.y = cvtpk(o1[4 * g4 + 2] * inv, o1[4 * g4 + 3] * inv);
        *(u32x2*)(op + 8 * g4) = w0; *(u32x2*)(op + 32 + 8 * g4) = w1;
    }
    }
#undef ATT_DMA_K
#undef ATT_DMA_V
#undef ATT_QK
#undef ATT_SMPV
#undef ATT_STAGE
#undef ATT_STAGE_T
#undef ATT_FUSED
#undef ATT_MOD3
#undef ATT_DMA1
#undef ATT_WAITBAR
#undef ATT_NFL
#undef ATT_FARSCALE
}
}
constexpr int NWAVES = 8;
constexpr int D = 1024, BATCH = 32, SEQ = 2048, M = BATCH * SEQ;
constexpr int NH = 16, QLORA = 384, KVLORA = 256, ROPE_D = 32, NOPE = 64, QKD = 96;
constexpr int NA = 768;
constexpr int FF = 2816, EFF = 3584, NE = 8;
constexpr float EPS = 1e-6f, LOG2E = 1.4426950408889634f;
constexpr int MAXP_HALF = 264, MAXP = 528;
constexpr size_t MiB = 1u << 20;
constexpr size_t WS_CTL = 0, CTL_ZERO_BYTES = 1 * MiB;
constexpr size_t WS_ROPE = 1 * MiB;
constexpr size_t WS_CNT = WS_ROPE + 256 * 1024;
constexpr size_t WS_PANELE = WS_CNT + 16 * 1024;
constexpr size_t WS_META = WS_PANELE + 4096;
constexpr size_t WS_TOKE = 2 * MiB;
constexpr size_t WS_TOKG = WS_TOKE + (size_t)M * 4;
constexpr size_t WS_SLOTTOK = WS_TOKG + (size_t)M * 8;
constexpr size_t WS_SLOTGATE = WS_SLOTTOK + (size_t)MAXP * 256 * 4;
constexpr size_t WS_PARTQA = 976 * MiB, WS_PART1 = 980 * MiB, WS_PART2 = 984 * MiB;
constexpr size_t WS_TOKRSTD = 4 * MiB;
constexpr size_t WS_SLOTRSTD = WS_TOKRSTD + (size_t)M * 4;
static_assert(WS_SLOTGATE + (size_t)MAXP * 256 * 4 <= WS_TOKRSTD && WS_SLOTRSTD + (size_t)MAXP * 256 * 4 <= 8 * MiB, "small arrays");
constexpr size_t WS_W = 8 * MiB;
constexpr size_t WS_WA = WS_W, WS_WUQ = WS_WA + (size_t)NA * D * 2, WS_WUKV = WS_WUQ + (size_t)1536 * QLORA * 2, WS_WO = WS_WUKV + (size_t)2048 * KVLORA * 2;
constexpr size_t WS_WF1 = WS_WO + (size_t)D * D * 2, WS_WF2 = WS_WF1 + (size_t)2 * FF * D * 2, WS_WKVQ = WS_WF2 + (size_t)D * FF * 2, WS_WBO = WS_WKVQ + (size_t)3 * D * D * 2;
constexpr size_t WS_WM1 = WS_WBO + (size_t)D * D * 2, WS_WM2 = WS_WM1 + (size_t)NE * 2 * EFF * D * 2, WS_WEND = WS_WM2 + (size_t)NE * D * EFF * 2;
constexpr size_t ARENA = 208 * MiB;
static_assert(WS_WEND <= ARENA, "weights fit under the arena");
constexpr size_t WS_XN = ARENA;
constexpr size_t WS_QA = ARENA + 128 * MiB;
constexpr size_t WS_Q = ARENA + 224 * MiB;
constexpr size_t WS_K = ARENA + 416 * MiB;
constexpr size_t WS_V = ARENA + 608 * MiB;
constexpr size_t WS_O = ARENA;
static_assert(WS_V + (size_t)M * D * 2 <= 1024 * MiB, "MLA arena");
constexpr size_t WS_XR1 = ARENA + 128 * MiB;
constexpr size_t WS_H = ARENA + 256 * MiB;
constexpr size_t WS_XR2 = ARENA;
constexpr size_t WS_X2B = ARENA + 608 * MiB;
constexpr size_t WS_KVQ2 = ARENA + 128 * MiB;
constexpr size_t WS_O2 = ARENA + 512 * MiB;
constexpr size_t WS_XR3 = ARENA + 132 * MiB;
constexpr size_t WS_XG = ARENA;
constexpr size_t WS_HM = ARENA + 264 * MiB;
constexpr size_t WS_END = WS_HM + (size_t)MAXP_HALF * 256 * EFF * 2;
static_assert(WS_XG + (size_t)MAXP * 256 * D <= WS_XR3 && WS_XR3 + (size_t)M * D * 2 <= WS_HM && WS_END <= 1024 * MiB && WS_H + (size_t)M * FF * 2 <= WS_X2B && WS_X2B + (size_t)M * D * 2 <= 976 * MiB && WS_O2 + (size_t)M * D <= WS_X2B, "arena");
constexpr int CW_BAR = 4096;
constexpr int RING_OFF = 0, RING_BYTES = 131072;
constexpr int P0_SCR = 128 * 33 * 4;
constexpr int LDSCTL_OFF = 8 * P0_SCR, MISC_OFF = LDSCTL_OFF + 320;
static_assert(LDSCTL_OFF >= RING_BYTES, "control words above every phase's scratch");
constexpr int LDS_BYTES = 147456;
static_assert(MISC_OFF + 128 <= LDS_BYTES, "LDS map");
static_assert(att::lds_bytes<96>() <= RING_BYTES, "attention scratch fits the ring region");

#define GAS __attribute__((address_space(1)))
#define LAS __attribute__((address_space(3)))
typedef unsigned short bf16;
typedef unsigned v4u __attribute__((ext_vector_type(4)));
typedef unsigned v2u __attribute__((ext_vector_type(2)));
typedef float f32x4 __attribute__((ext_vector_type(4)));
typedef GAS unsigned gu32;
#define RLX_AGENT __ATOMIC_RELAXED, __HIP_MEMORY_SCOPE_AGENT
#define LDS_WAIT() asm volatile("s_waitcnt lgkmcnt(0)" ::: "memory")
__device__ __forceinline__ unsigned f2bf(float f) { unsigned u = __builtin_bit_cast(unsigned, f); return (u + 0x7fffu + ((u >> 16) & 1u)) >> 16; }
__device__ __forceinline__ unsigned pk2(float lo, float hi) { return f2bf(lo) | (f2bf(hi) << 16); }
__device__ __forceinline__ float bflo(unsigned u) { return __builtin_bit_cast(float, u << 16); }
__device__ __forceinline__ float bfhi(unsigned u) { return __builtin_bit_cast(float, u & 0xffff0000u); }
__device__ __forceinline__ float wave_sum(float v) {
    v += swz_xor<1>(v); v += swz_xor<2>(v); v += swz_xor<4>(v); v += swz_xor<8>(v); v += swz_xor<16>(v);
    return xor32_sum(v);
}
__device__ __forceinline__ float wave_maxf(float v) {
    v = fmaxf(v, swz_xor<1>(v)); v = fmaxf(v, swz_xor<2>(v)); v = fmaxf(v, swz_xor<4>(v)); v = fmaxf(v, swz_xor<8>(v)); v = fmaxf(v, swz_xor<16>(v));
    return xor32_max(v);
}

#define XB_TMO      128
#define XB_XCNT(j)  (256  + 64 * (j))
#define XB_XSUB(j)  (1280 + 64 * (j))
#define XB_XGEN(j)  (2304 + 64 * (j))
#define XB_TOP      3328
#define XB_TOPGEN   3392
#define XCD_BAR_WORDS 3456
#define XB_SPIN_CAP (1u << 18)

__device__ __forceinline__ unsigned xb_ld(unsigned* p)              { return __hip_atomic_load(p, __ATOMIC_RELAXED, __HIP_MEMORY_SCOPE_AGENT); }
__device__ __forceinline__ unsigned xb_add(unsigned* p, unsigned v) { return __hip_atomic_fetch_add(p, v, __ATOMIC_RELAXED, __HIP_MEMORY_SCOPE_AGENT); }
__device__ __forceinline__ unsigned xb_xcc_id() { return (unsigned)__builtin_amdgcn_s_getreg((3 << 11) | 20) & 0xFu; }
#define XB_SPIN(cond, bar) do { unsigned _sp = 0; while (cond) { __builtin_amdgcn_s_sleep(1); \
    if ((++_sp & 255u) == 0u) { if (xb_ld(&(bar)[XB_TMO])) break; if (_sp > XB_SPIN_CAP) { atomicAdd(&(bar)[XB_TMO], 1u); break; } } } } while (0)

struct XcdBarrier {
    int t0;
    unsigned* bar; unsigned x;
    volatile LAS unsigned* st;
};

__device__ __forceinline__ XcdBarrier xcd_barrier_post(unsigned* bar, volatile LAS unsigned* st, int t0) {
    XcdBarrier b; b.t0 = t0; b.bar = bar; b.x = xb_xcc_id(); b.st = st;
    if (b.t0) (void)xb_add(&bar[XB_XCNT(b.x)], 1u);
    return b;
}
__device__ __forceinline__ void xcd_barrier_complete(unsigned* bar, unsigned x, unsigned& nloc, unsigned& nx) {
    const unsigned G = gridDim.x * gridDim.y * gridDim.z;
    unsigned sum, cnt, mine, sp = 0u;
    for (;;) {
        sum = 0u; cnt = 0u; mine = 0u;
#pragma unroll
        for (unsigned j = 0; j < 16; ++j) { const unsigned c = xb_ld(&bar[XB_XCNT(j)]); sum += c; cnt += (c > 0u) ? 1u : 0u; mine = (j == x) ? c : mine; }
        if (sum == G) break;
        __builtin_amdgcn_s_sleep(1);
        if ((++sp & 255u) == 0u) { if (xb_ld(&bar[XB_TMO])) break; if (sp > XB_SPIN_CAP) { atomicAdd(&bar[XB_TMO], 1u); break; } }
    }
    nloc = mine > 0u ? mine : 1u; nx = cnt > 0u ? cnt : 1u;
}

__device__ __forceinline__ void xcd_barrier(const XcdBarrier& b) {
    asm volatile("s_waitcnt vmcnt(0)" ::: "memory");
    __syncthreads();
    if (b.t0) {
        unsigned* bar = b.bar;
        __builtin_amdgcn_s_waitcnt(0);
        unsigned nloc = b.st[0], nx = b.st[1];
        if (nloc == 0u) { xcd_barrier_complete(bar, b.x, nloc, nx); b.st[0] = nloc; b.st[1] = nx; }
        const unsigned old = xb_add(&bar[XB_XSUB(b.x)], 1u);
        const unsigned gen = old / nloc;
        if (old + 1u == (gen + 1u) * nloc) {
            __builtin_amdgcn_fence(__ATOMIC_RELEASE, "agent");
            asm volatile("s_waitcnt vmcnt(0)" ::: "memory");
            const unsigned og = xb_add(&bar[XB_TOP], 1u);
            const unsigned tg = og / nx;
            if (og + 1u == (tg + 1u) * nx) xb_add(&bar[XB_TOPGEN], 1u);
            else XB_SPIN(xb_ld(&bar[XB_TOPGEN]) == tg, bar);
            __builtin_amdgcn_fence(__ATOMIC_ACQUIRE, "agent");
            xb_add(&bar[XB_XGEN(b.x)], 1u);
            asm volatile("s_waitcnt vmcnt(0)" ::: "memory");
        } else {
            XB_SPIN(xb_ld(&bar[XB_XGEN(b.x)]) == gen, bar);
            __builtin_amdgcn_fence(__ATOMIC_ACQUIRE, "agent");
            asm volatile("s_waitcnt vmcnt(0)" ::: "memory");
        }
    }
    __syncthreads();
}

struct Args { const float* in[27]; float* out; unsigned char* ws; };
enum { I_X = 0, I_ATTN_NORM, I_FFN_NORM, I_A_WDQ, I_A_GCQ, I_A_WUQ, I_A_WDKV, I_A_GCKV, I_A_WUKV, I_A_GQN, I_A_GKN, I_A_WO, I_KV_NORM, I_KV_WK, I_KV_WV, I_KV_GKN,
       I_B_WQ, I_B_GQN, I_B_RELB, I_B_WO, I_FFN_W1, I_FFN_W3, I_FFN_W2, I_MOE_ROUTER, I_MOE_W1, I_MOE_W3, I_MOE_W2 };

struct Frame {
    LAS unsigned char* lds;
    int wave, vcu, G;
};
typedef const __attribute__((address_space(4))) Args* KArgs;
__device__ __forceinline__ KArgs kargs() { KArgs p = (KArgs)__builtin_amdgcn_kernarg_segment_ptr(); asm volatile("" : "+s"(p)); return p; }
#define INP(i) (kargs()->in[i])
#define OUTP (kargs()->out)
#define WSP (kargs()->ws)
__device__ __forceinline__ int fresh(int v) { asm volatile("" : "+v"(v)); return v; }

__device__ __forceinline__ void tr_item(const float* W, int ldw, int K, int k0, int nsrc0, const float* gain, bf16* WT, int drow0, LAS float* scr, int lane) {
    const int c4 = lane & 7, r = lane >> 3;
    const GAS float* src = (const GAS float*)W + (size_t)(k0 + r) * ldw + nsrc0 + 4 * c4;
    f32x4 v[16];
#pragma unroll
    for (int i = 0; i < 16; ++i) v[i] = *(const GAS f32x4*)(src + (size_t)(8 * i) * ldw);
    if (gain) {
#pragma unroll
        for (int i = 0; i < 16; ++i) v[i] = v[i] * gain[k0 + 8 * i + r];
    }
#pragma unroll
    for (int i = 0; i < 16; ++i) { LAS float* d = scr + (8 * i + r) * 33 + 4 * c4; d[0] = v[i].x; d[1] = v[i].y; d[2] = v[i].z; d[3] = v[i].w; }
    LDS_WAIT(); asm volatile("" ::: "memory");
    const int c16 = lane >> 2;
#pragma unroll
    for (int j = 0; j < 8; ++j) { const int n = (lane & 3) + 4 * j; const LAS float* sp = scr + (8 * c16) * 33 + n;
        v4u o; o.x = pk2(sp[0 * 33], sp[1 * 33]); o.y = pk2(sp[2 * 33], sp[3 * 33]); o.z = pk2(sp[4 * 33], sp[5 * 33]); o.w = pk2(sp[6 * 33], sp[7 * 33]);
        *(GAS v4u*)(WT + (size_t)(drow0 + n) * K + k0 + 8 * c16) = o; }
    LDS_WAIT(); asm volatile("" ::: "memory");
}
__device__ __forceinline__ void tr_plain(const float* W, int K, int N, const float* gain, bf16* WT, int drow_off, LAS float* scr, int item, int lane) {
    const int nblk = N / 32, kb = item / nblk, nb = item % nblk;
    tr_item(W, N, K, 128 * kb, 32 * nb, gain, WT, drow_off + 32 * nb, scr, lane);
}
__device__ __forceinline__ void tr_gated(const float* W, int K, int N, const float* gain, bf16* WT, int half, LAS float* scr, int item, int lane) {
    const int nblk = N / 32, kb = item / nblk, nb = item % nblk, n0 = 32 * nb;
    tr_item(W, N, K, 128 * kb, n0, gain, WT, (n0 >> 7) * 256 + half * 128 + (n0 & 127), scr, lane);
}
__device__ __forceinline__ unsigned pk_fp8x4(float a, float b, float c, float d) { int w = 0; w = __builtin_amdgcn_cvt_pk_fp8_f32(a, b, w, false); w = __builtin_amdgcn_cvt_pk_fp8_f32(c, d, w, true); return (unsigned)w; }
__device__ __forceinline__ void tr_item_f8(const float* W, int ldw, int K, int k0, int nsrc0, const float* gain, unsigned char* WT, int drow0, LAS float* scr, int lane) {
    const int c4 = lane & 7, r = lane >> 3;
    const GAS float* src = (const GAS float*)W + (size_t)(k0 + r) * ldw + nsrc0 + 4 * c4;
    f32x4 v[16];
#pragma unroll
    for (int i = 0; i < 16; ++i) v[i] = *(const GAS f32x4*)(src + (size_t)(8 * i) * ldw);
#pragma unroll
    for (int i = 0; i < 16; ++i) v[i] = v[i] * (gain ? gain[k0 + 8 * i + r] * 64.f : 64.f);
#pragma unroll
    for (int i = 0; i < 16; ++i) { LAS float* d = scr + (8 * i + r) * 33 + 4 * c4; d[0] = v[i].x; d[1] = v[i].y; d[2] = v[i].z; d[3] = v[i].w; }
    LDS_WAIT(); asm volatile("" ::: "memory");
    const int c8 = lane >> 3;
#pragma unroll
    for (int j = 0; j < 4; ++j) { const int n = (lane & 7) + 8 * j; const LAS float* sp = scr + (16 * c8) * 33 + n;
        v4u o; o.x = pk_fp8x4(sp[0 * 33], sp[1 * 33], sp[2 * 33], sp[3 * 33]); o.y = pk_fp8x4(sp[4 * 33], sp[5 * 33], sp[6 * 33], sp[7 * 33]);
        o.z = pk_fp8x4(sp[8 * 33], sp[9 * 33], sp[10 * 33], sp[11 * 33]); o.w = pk_fp8x4(sp[12 * 33], sp[13 * 33], sp[14 * 33], sp[15 * 33]);
        *(GAS v4u*)(WT + (size_t)(drow0 + n) * K + k0 + 16 * c8) = o; }
    LDS_WAIT(); asm volatile("" ::: "memory");
}
__device__ __forceinline__ float rms_row_to_bf16(const float* xrow, bf16* orow, int lane, f32x4 (&v)[4]) {
    const GAS f32x4* xr = (const GAS f32x4*)xrow + lane;
    float s = 0.f;
#pragma unroll
    for (int j = 0; j < 4; ++j) { v[j] = xr[64 * j]; s += (v[j].x * v[j].x + v[j].y * v[j].y) + (v[j].z * v[j].z + v[j].w * v[j].w); }
    const float rstd = 1.f / sqrtf(wave_sum(s) * (1.f / D) + EPS);
    GAS unsigned long long* o8 = (GAS unsigned long long*)orow + lane;
#pragma unroll
    for (int j = 0; j < 4; ++j) o8[64 * j] = (unsigned long long)pk2(v[j].x * rstd, v[j].y * rstd) | ((unsigned long long)pk2(v[j].z * rstd, v[j].w * rstd) << 32);
    return rstd;
}
__device__ __forceinline__ void norm_phase(const Frame& F, const float* x, bf16* xn) {
    const int tid = fresh(F.wave * 64 + lane_id_()), lane = tid & 63; (void)lane;
    const int gw = F.vcu * NWAVES + F.wave, NGW = F.G * NWAVES;
    for (int m = 2 * gw; m < M; m += 2 * NGW) {
        const GAS f32x4* xr = (const GAS f32x4*)(x + (size_t)m * D) + lane;
        f32x4 v[8]; float s0 = 0.f, s1 = 0.f;
#pragma unroll
        for (int j = 0; j < 8; ++j) v[j] = xr[64 * j];
#pragma unroll
        for (int j = 0; j < 4; ++j) { s0 += (v[j].x * v[j].x + v[j].y * v[j].y) + (v[j].z * v[j].z + v[j].w * v[j].w); s1 += (v[4 + j].x * v[4 + j].x + v[4 + j].y * v[4 + j].y) + (v[4 + j].z * v[4 + j].z + v[4 + j].w * v[4 + j].w); }
        const float r0 = 1.f / sqrtf(wave_sum(s0) * (1.f / D) + EPS), r1 = 1.f / sqrtf(wave_sum(s1) * (1.f / D) + EPS);
        GAS unsigned* o4 = (GAS unsigned*)((GAS unsigned char*)xn + (size_t)m * D) + lane;
#pragma unroll
        for (int j = 0; j < 8; ++j) { const float rr = j < 4 ? r0 : r1; o4[64 * j] = pk_fp8x4(v[j].x * rr, v[j].y * rr, v[j].z * rr, v[j].w * rr); }
    }
}

__device__ __forceinline__ void p0_prologue(const Frame& F) {
    const int tid = fresh(F.wave * 64 + lane_id_()), lane = tid & 63; (void)lane;
    LAS float* scr = (LAS float*)(F.lds + RING_OFF + F.wave * P0_SCR);
    unsigned char* ws = WSP;
    const int gw = F.vcu * NWAVES + F.wave, NGW = F.G * NWAVES;
    constexpr int I_DQ = 8 * 12, I_DKV = 8 * 9, I_UQ = 3 * 48, I_UKV = 2 * 64, I_SQ = 8 * 32, I_F13 = 8 * 88, I_F2 = 22 * 32, I_M13 = 8 * 112, I_M2 = 28 * 32;
    constexpr int NSMALL = I_DQ + I_DKV + I_UQ + I_UKV + I_SQ + 2 * I_F13 + I_F2 + 4 * I_SQ;
    constexpr int NITEMS = NSMALL + NE * (2 * I_M13 + I_M2);
    for (int it = gw; it < NITEMS; it += NGW) {
        int r = it;
        if (r < I_DQ)  { const int kb = r / 12, n0 = 32 * (r % 12); tr_item_f8(INP(I_A_WDQ), QLORA, D, 128 * kb, n0, INP(I_ATTN_NORM), ws + WS_WA, n0, scr, lane); continue; } r -= I_DQ;
        if (r < I_DKV) { const int kb = r / 9, n0 = 32 * (r % 9); tr_item_f8(INP(I_A_WDKV), KVLORA + ROPE_D, D, 128 * kb, n0, INP(I_ATTN_NORM), ws + WS_WA, QLORA + n0, scr, lane); continue; } r -= I_DKV;
        if (r < I_UQ)  { tr_plain(INP(I_A_WUQ), QLORA, NH * QKD, INP(I_A_GCQ), (bf16*)(ws + WS_WUQ), 0, scr, r, lane); continue; } r -= I_UQ;
        if (r < I_UKV) { const int kb = r / 64, n0 = 32 * (r % 64), head = n0 >> 7, within = n0 & 127;
            const int drow = within < 64 ? 256 * (head >> 2) + 128 * (within >> 5) + 32 * (head & 3) : 1024 + head * 64 + (within - 64);
            tr_item(INP(I_A_WUKV), NH * 128, KVLORA, 128 * kb, n0, INP(I_A_GCKV), (bf16*)(ws + WS_WUKV), drow, scr, lane); continue; } r -= I_UKV;
        if (r < I_SQ)  { const int kb = r / 32, n0 = 32 * (r % 32); tr_item_f8(INP(I_A_WO), D, D, 128 * kb, n0, nullptr, ws + WS_WO, n0, scr, lane); continue; } r -= I_SQ;
        if (r < I_F13) { tr_gated(INP(I_FFN_W1), D, FF, INP(I_FFN_NORM), (bf16*)(ws + WS_WF1), 0, scr, r, lane); continue; } r -= I_F13;
        if (r < I_F13) { tr_gated(INP(I_FFN_W3), D, FF, INP(I_FFN_NORM), (bf16*)(ws + WS_WF1), 1, scr, r, lane); continue; } r -= I_F13;
        if (r < I_F2)  { tr_plain(INP(I_FFN_W2), FF, D, nullptr, (bf16*)(ws + WS_WF2), 0, scr, r, lane); continue; } r -= I_F2;
        if (r < I_SQ)  { const int kb = r / 32, n0 = 32 * (r % 32), head = n0 >> 6;
            tr_item_f8(INP(I_KV_WK), D, D, 128 * kb, n0, INP(I_KV_NORM), ws + WS_WKVQ, 256 * (head >> 2) + 128 * ((n0 >> 5) & 1) + 32 * (head & 3), scr, lane); continue; } r -= I_SQ;
        if (r < I_SQ)  { const int kb = r / 32, n0 = 32 * (r % 32); tr_item_f8(INP(I_KV_WV), D, D, 128 * kb, n0, INP(I_KV_NORM), ws + WS_WKVQ, 2 * D + n0, scr, lane); continue; } r -= I_SQ;
        if (r < I_SQ)  { const int kb = r / 32, n0 = 32 * (r % 32), head = n0 >> 6;
            tr_item_f8(INP(I_B_WQ), D, D, 128 * kb, n0, INP(I_ATTN_NORM) + D, ws + WS_WKVQ, D + 256 * (head >> 2) + 128 * ((n0 >> 5) & 1) + 32 * (head & 3), scr, lane); continue; } r -= I_SQ;
        if (r < I_SQ)  { const int kb = r / 32, n0 = 32 * (r % 32); tr_item_f8(INP(I_B_WO), D, D, 128 * kb, n0, nullptr, ws + WS_WBO, n0, scr, lane); continue; } r -= I_SQ;
        const int e = r / (2 * I_M13 + I_M2); r -= e * (2 * I_M13 + I_M2);
        if (r < I_M13) { const int kb = r / 112, n0 = 32 * (r % 112);
            tr_item_f8(INP(I_MOE_W1) + (size_t)e * D * EFF, EFF, D, 128 * kb, n0, INP(I_FFN_NORM) + D, ws + WS_WM1 + (size_t)e * 2 * EFF * D, (n0 >> 7) * 256 + (n0 & 127), scr, lane); continue; } r -= I_M13;
        if (r < I_M13) { const int kb = r / 112, n0 = 32 * (r % 112);
            tr_item_f8(INP(I_MOE_W3) + (size_t)e * D * EFF, EFF, D, 128 * kb, n0, INP(I_FFN_NORM) + D, ws + WS_WM1 + (size_t)e * 2 * EFF * D, (n0 >> 7) * 256 + 128 + (n0 & 127), scr, lane); continue; } r -= I_M13;
        { const int kb = r / 32, n0 = 32 * (r % 32); tr_item_f8(INP(I_MOE_W2) + (size_t)e * EFF * D, D, EFF, 128 * kb, n0, nullptr, ws + WS_WM2 + (size_t)e * D * EFF, n0, scr, lane); }
    }
    const int gt = F.vcu * (NWAVES * 64) + tid, NGT = F.G * NWAVES * 64;
    for (int c = gt; c < 96 * D / 16; c += NGT) *((GAS v4u*)(ws + WS_WA + (size_t)(QLORA + KVLORA + ROPE_D) * D) + c) = (v4u){0u, 0u, 0u, 0u};
    for (int c = gt; c < SEQ * 16; c += NGT) { const int pos = c >> 4, i = c & 15;
        const float inv = __builtin_amdgcn_exp2f(-(float)i * (13.287712379549449f / 16.f));
        const float rev = (float)pos * inv * 0.15915494309189535f; const float fr = rev - floorf(rev);
        ((GAS float*)(ws + WS_ROPE))[2 * c] = __builtin_amdgcn_cosf(fr); ((GAS float*)(ws + WS_ROPE))[2 * c + 1] = __builtin_amdgcn_sinf(fr); }
    norm_phase(F, INP(I_X), (bf16*)(ws + WS_XN));
}

__device__ __forceinline__ void route_phase(const Frame& F) {
    const int tid = fresh(F.wave * 64 + lane_id_()), lane = tid & 63;
    unsigned char* ws = WSP;
    LAS float* wrg = (LAS float*)(F.lds + RING_OFF);
    LAS int* cnt = (LAS int*)(F.lds + RING_OFF + 32768);
    const float* wr = INP(I_MOE_ROUTER); const float* g = INP(I_FFN_NORM) + D;
    for (int idx = tid; idx < D * NE; idx += NWAVES * 64) { const int k = idx >> 3, e = idx & 7, l = k >> 4, i = k & 15;
        wrg[((i * 2) + (e >> 2)) * 256 + 4 * l + (e & 3)] = wr[idx] * g[k]; }
    __syncthreads();
    const int b5 = (lane >> 5) & 1, b4 = (lane >> 4) & 1, b3 = (lane >> 3) & 1;
    for (int c = F.vcu; c < M / 256; c += F.G) {
        if (tid < 16) cnt[tid] = 0;
        __syncthreads();
        v4u vn[2];
        { const GAS v4u* xr = (const GAS v4u*)(ws + WS_XR3 + (size_t)(c * 256 + F.wave * 32) * D * 2) + 2 * lane; vn[0] = xr[0]; vn[1] = xr[1]; }
        for (int i = 0; i < 32; ++i) {
            const int m = c * 256 + F.wave * 32 + i;
            const v4u q0 = vn[0], q1 = vn[1];
            if (i + 1 < 32) { const GAS v4u* xr = (const GAS v4u*)(ws + WS_XR3 + (size_t)(m + 1) * D * 2) + 2 * lane; vn[0] = xr[0]; vn[1] = xr[1]; }
            const unsigned qw[8] = {q0.x, q0.y, q0.z, q0.w, q1.x, q1.y, q1.z, q1.w};
            float xv[16]; float ssx = 0.f;
#pragma unroll
            for (int j = 0; j < 8; ++j) { xv[2 * j] = bflo(qw[j]); xv[2 * j + 1] = bfhi(qw[j]); }
#pragma unroll
            for (int j = 0; j < 16; j += 4) ssx += (xv[j] * xv[j] + xv[j + 1] * xv[j + 1]) + (xv[j + 2] * xv[j + 2] + xv[j + 3] * xv[j + 3]);
            float lg[8];
#pragma unroll
            for (int e = 0; e < 8; ++e) lg[e] = 0.f;
#pragma unroll
            for (int j = 0; j < 16; ++j) { const float x1 = xv[j];
                const f32x4 w0 = *(const LAS f32x4*)(wrg + (j * 2) * 256 + 4 * lane), w1 = *(const LAS f32x4*)(wrg + (j * 2 + 1) * 256 + 4 * lane);
                lg[0] += x1 * w0.x; lg[1] += x1 * w0.y; lg[2] += x1 * w0.z; lg[3] += x1 * w0.w; lg[4] += x1 * w1.x; lg[5] += x1 * w1.y; lg[6] += x1 * w1.z; lg[7] += x1 * w1.w; }
            float r4[4], r2[2], r1;
#pragma unroll
            for (int e = 0; e < 4; ++e) { const float mine = b5 ? lg[4 + e] : lg[e], other = b5 ? lg[e] : lg[4 + e]; r4[e] = mine + xor32_partner(other, b5); }
#pragma unroll
            for (int e = 0; e < 2; ++e) { const float mine = b4 ? r4[2 + e] : r4[e], other = b4 ? r4[e] : r4[2 + e]; r2[e] = mine + swz_xor<16>(other); }
            { const float mine = b3 ? r2[1] : r2[0], other = b3 ? r2[0] : r2[1]; r1 = mine + swz_xor<8>(other); }
            r1 += swz_xor<4>(r1); r1 += swz_xor<2>(r1); r1 += swz_xor<1>(r1);
            const float rstd = 1.f / sqrtf(wave_sum(ssx) * (1.f / D) + EPS);
#pragma unroll
            for (int e = 0; e < 8; ++e) lg[e] = __builtin_bit_cast(float, __builtin_amdgcn_readlane(__builtin_bit_cast(int, r1), 8 * e)) * rstd;
            int e1 = 0; float l1 = lg[0];
#pragma unroll
            for (int e = 1; e < 8; ++e) if (lg[e] > l1) { l1 = lg[e]; e1 = e; }
            int e2 = -1; float l2 = -INFINITY;
#pragma unroll
            for (int e = 0; e < 8; ++e) if (e != e1 && lg[e] > l2) { l2 = lg[e]; e2 = e; }
            const float g1 = 1.f / (1.f + __expf(l2 - l1)), g2 = 1.f - g1;
            const int elo = e1 < e2 ? e1 : e2, ehi = e1 < e2 ? e2 : e1;
            const float glo = e1 < e2 ? g1 : g2, ghi = e1 < e2 ? g2 : g1;
            if (lane == 0) { ((GAS float*)(ws + WS_TOKRSTD))[m] = rstd; ((GAS int*)(ws + WS_TOKE))[m] = elo | (ehi << 8); ((GAS float*)(ws + WS_TOKG))[2 * m] = glo; ((GAS float*)(ws + WS_TOKG))[2 * m + 1] = ghi;
                atomicAdd((int*)&cnt[elo], 1); atomicAdd((int*)&cnt[8 + ehi], 1); }
        }
        __syncthreads();
        if (tid < 16) ((GAS int*)(ws + WS_CNT))[c * 16 + tid] = cnt[tid];
        __syncthreads();
    }
}

__device__ __forceinline__ void slot_phase(const Frame& F, unsigned char* ws) {
    const int tid = fresh(F.wave * 64 + lane_id_()), lane = tid & 63; (void)lane;
    LAS int* call = (LAS int*)(F.lds + RING_OFF);
    LAS int* tot = call + 4096; LAS int* base = tot + 16; LAS int* pre = base + 16; LAS int* meta = pre + 16;
    LAS int* grp = meta + 16;
    LAS int* slot_of = grp + 512;
    for (int idx = tid; idx < 4096; idx += NWAVES * 64) call[idx] = ((const GAS int*)(ws + WS_CNT))[idx];
    __syncthreads();
    if (tid < 16) { int t = 0; for (int cc = 0; cc < 256; ++cc) t += call[cc * 16 + tid]; tot[tid] = t; }
    __syncthreads();
    if (tid == 0) { int off = 0; for (int g = 0; g < 16; ++g) { base[g] = off; off += (tot[g] + 255) & ~255; if (g == 7) meta[0] = off >> 8; } meta[1] = (off >> 8) - meta[0]; }
    __syncthreads();
    for (int c = F.vcu; c < M / 256; c += F.G) {
        if (tid < 16) { int p = 0; for (int cc = 0; cc < c; ++cc) p += call[cc * 16 + tid]; pre[tid] = p; }
        const int hf = tid >> 8, i = tid & 255, m = c * 256 + i;
        const int te = ((const GAS int*)(ws + WS_TOKE))[m];
        const int g = hf * 8 + (hf ? ((te >> 8) & 0xff) : (te & 0xff));
        grp[tid] = g;
        __syncthreads();
        int rank = 0;
        for (int j = 0; j < i; ++j) rank += (grp[hf * 256 + j] == g) ? 1 : 0;
        const int slot = base[g] + pre[g] + rank;
        ((GAS int*)(ws + WS_SLOTTOK))[slot] = m; ((GAS float*)(ws + WS_SLOTGATE))[slot] = ((const GAS float*)(ws + WS_TOKG))[2 * m + hf];
        slot_of[tid] = slot;
        __syncthreads();
        for (int i0 = F.wave; i0 < 256; i0 += 4 * NWAVES) {
            v4u x[4][2]; float rs[4];
#pragma unroll
            for (int k = 0; k < 4; ++k) { const int mm = c * 256 + i0 + 8 * k; const GAS v4u* src = (const GAS v4u*)(ws + WS_XR3 + (size_t)mm * D * 2);
                x[k][0] = src[2 * lane]; x[k][1] = src[2 * lane + 1]; rs[k] = ((const GAS float*)(ws + WS_TOKRSTD))[mm]; }
#pragma unroll
            for (int k = 0; k < 4; ++k) { const int i = i0 + 8 * k; const v4u x0 = x[k][0], x1 = x[k][1]; const float r = rs[k];
                const v4u o = (v4u){pk_fp8x4(bflo(x0.x) * r, bfhi(x0.x) * r, bflo(x0.y) * r, bfhi(x0.y) * r), pk_fp8x4(bflo(x0.z) * r, bfhi(x0.z) * r, bflo(x0.w) * r, bfhi(x0.w) * r),
                                    pk_fp8x4(bflo(x1.x) * r, bfhi(x1.x) * r, bflo(x1.y) * r, bfhi(x1.y) * r), pk_fp8x4(bflo(x1.z) * r, bfhi(x1.z) * r, bflo(x1.w) * r, bfhi(x1.w) * r)};
                ((GAS v4u*)(ws + WS_XG + (size_t)slot_of[i] * D))[lane] = o; ((GAS v4u*)(ws + WS_XG + (size_t)slot_of[256 + i] * D))[lane] = o; }
        }
        __syncthreads();
    }
    for (int g = F.vcu; g < 16; g += F.G) {
        const int s0 = base[g] + tot[g], s1 = base[g] + ((tot[g] + 255) & ~255);
        for (int s = s0 + F.wave; s < s1; s += NWAVES) { GAS v4u* dst = (GAS v4u*)(ws + WS_XG + (size_t)s * D);
            dst[lane] = (v4u){0u, 0u, 0u, 0u};
            if (lane == 0) { ((GAS int*)(ws + WS_SLOTTOK))[s] = -1; ((GAS float*)(ws + WS_SLOTGATE))[s] = 0.f; } }
    }
    if (F.vcu == 0) {
        if (tid < 16) { const int p0 = base[tid] >> 8, p1 = (base[tid] + ((tot[tid] + 255) & ~255)) >> 8; for (int p = p0; p < p1; ++p) ((GAS int*)(ws + WS_PANELE))[p] = tid & 7; }
        if (tid == 0) { ((GAS int*)(ws + WS_META))[0] = meta[0]; ((GAS int*)(ws + WS_META))[1] = meta[1]; }
        if (tid < 16) ((GAS int*)(ws + WS_META))[2 + tid] = base[tid] >> 8;
        if (tid == 0) { const int nPA = meta[0], nPB = meta[1]; int x = nPB > 256 ? nPB - 256 : 0;
            if (x > 0 && nPA > 256) { int LA = 0, HB = 7;
                for (int g = 0; g < 8; ++g) { const int q0 = base[g] >> 8, q1 = q0 + ((tot[g] + 255) >> 8); if (q0 <= 256 && 256 < q1) LA = g; }
                for (int g = 8; g < 16; ++g) { const int q0 = base[g] >> 8, q1 = q0 + ((tot[g] + 255) >> 8), P = nPA + x - 1; if (q0 <= P && P < q1) HB = g - 8; }
                if (LA < HB) x = 0; }
            ((GAS int*)(ws + WS_META))[18] = x; }
    }
    __syncthreads();
}

__global__ void __launch_bounds__(NWAVES * 64, 2) yoco_fwd(Args args) {
    extern __shared__ __attribute__((aligned(16))) unsigned char lds_raw[];
    Frame F;
    F.lds = (LAS unsigned char*)lds_raw;
    F.wave = __builtin_amdgcn_readfirstlane((int)threadIdx.x >> 6);
    F.G = gridDim.x; { const int bx = blockIdx.x; F.vcu = (F.G % 8 == 0) ? (bx % 8) * (F.G / 8) + bx / 8 : bx; }
    unsigned char* ws = WSP;
    volatile LAS unsigned* MISC = (volatile LAS unsigned*)(F.lds + MISC_OFF);
    for (int u = fresh((int)threadIdx.x); u < (LDS_BYTES - LDSCTL_OFF) / 4; u += NWAVES * 64) ((LAS unsigned*)(F.lds + LDSCTL_OFF))[u] = 0u;
    __syncthreads();
    (void)xcd_barrier_post((unsigned*)(ws + WS_CTL) + CW_BAR, MISC + 8, (F.wave == 0 && lane_id_() == 0) ? 1 : 0);
    LAS unsigned char* ring = F.lds + RING_OFF;
#define bid ((int)blockIdx.x)
#define GRID_BAR() do { XcdBarrier b_; b_.t0 = (F.wave == 0 && lane_id_() == 0) ? 1 : 0; b_.bar = (unsigned*)(WSP + WS_CTL) + CW_BAR; b_.x = xb_xcc_id(); b_.st = (volatile LAS unsigned*)(F.lds + MISC_OFF) + 8; xcd_barrier(b_); } while (0)
#define GEMM(EpiT, SchedT) pg8::gemm_phase<EpiT, SchedT, true, true>

    p0_prologue(F);
    GRID_BAR();
    { pg8::Gemm g{(const bf16*)(ws + WS_XN), (const bf16*)(ws + WS_WA), M, NA, D / 2, D / 2}; pg8::StaticOrder S; S.init(M, NA, F.G, bid);
      pg8::EpiQA E{(bf16*)(ws + WS_QA), (float*)(ws + WS_PARTQA), 1.f / 64};
      pg8::gemm_phase<pg8::EpiQA, pg8::StaticOrder, true, true, true>(ring, g, S, E, F.wave); }
    GRID_BAR();
    { pg8::Gemm g{(const bf16*)(ws + WS_QA), (const bf16*)(ws + WS_WUQ), M, NH * QKD, QLORA, NA}; pg8::StaticOrder S; S.init(M, NH * QKD, F.G, bid);
      pg8::EpiRowScaleBf16 E{(bf16*)(ws + WS_Q), NH * QKD, (const float*)(ws + WS_PARTQA), 1.f / QLORA};
      GEMM(pg8::EpiRowScaleBf16, pg8::StaticOrder)(ring, g, S, E, F.wave); }
    { pg8::Gemm g{(const bf16*)(ws + WS_QA) + QLORA, (const bf16*)(ws + WS_WUKV), M, NH * 128, KVLORA, NA}; pg8::StaticOrder S; S.init(M, NH * 128, F.G, bid);
      pg8::EpiKVup E{(bf16*)(ws + WS_K), (bf16*)(ws + WS_V), (const float*)(ws + WS_PARTQA), (const bf16*)(ws + WS_QA), INP(I_A_GKN), (const float*)(ws + WS_ROPE)};
      GEMM(pg8::EpiKVup, pg8::StaticOrder)(ring, g, S, E, F.wave); }
    GRID_BAR();
    bool fastA;
    { float bq = 0.f, bk = 0.f; const int l_ = lane_id_(); for (int i = l_; i < QKD; i += 64) { bq = fmaxf(bq, fabsf(INP(I_A_GQN)[i])); bk = fmaxf(bk, fabsf(INP(I_A_GKN)[i])); }
      bq = wave_maxf(bq); bk = wave_maxf(bk); fastA = __builtin_amdgcn_readfirstlane((int)(14.42f * bq * bk <= 40.f)) != 0; }
#define P5_UNIT(NM) att::attn_unit<96, false, 1536, 1536, D, D, true, NM, 2>(ring, (const bf16*)(ws + WS_Q) + (size_t)b * SEQ * 1536 + h * QKD, (const bf16*)(ws + WS_K) + (size_t)b * SEQ * 1536 + h * QKD, \
                                      (const bf16*)(ws + WS_V) + (size_t)b * SEQ * D + h * 64, (bf16*)(ws + WS_O + (size_t)b * SEQ * D + h * 64), \
                                      256 * qb, 0, 4 * qb + 3, 0, 4 * qb + (F.wave >> 1), 0, nullptr, INP(I_A_GQN), (const float*)(ws + WS_ROPE), F.wave, true, qfA, false, false, \
                                      (const bf16*)(ws + WS_Q) + (size_t)bn * SEQ * 1536 + hh * QKD + (size_t)(256 * qbn) * 1536)
    att::attn_init<96, 1536, D, 2>(ring, F.wave);
    att::bf16x8 qfA[6]; bool qldA = false;
    for (int p = F.vcu; p < BATCH * NH * 4; p += F.G) {
        const int bh = p >> 2, pid = p & 3, b = bh >> 4, h = bh & 15;
        for (int u2 = 0; u2 < 2; ++u2) {
            const int qb = u2 ? 7 - pid : pid;
            const int pn = u2 ? p + F.G : p; const bool hn = pn < BATCH * NH * 4;
            const int bhn = pn >> 2, pidn = pn & 3, bn = bhn >> 4, hh = bhn & 15, qbn = u2 ? pidn : 7 - pidn;
            if (fastA) P5_UNIT(true); else P5_UNIT(false);
        }
    }
    GRID_BAR();
    { pg8::Gemm g{(const bf16*)(ws + WS_O), (const bf16*)(ws + WS_WO), M, D, D / 2, D / 2}; pg8::StaticOrder S; S.init(M, D, F.G, bid);
      pg8::EpiResStream<true, false, false> E{INP(I_X), (bf16*)(ws + WS_XR1), nullptr, (float*)(ws + WS_PART1), 1.f / 2048};
      pg8::gemm_phase<pg8::EpiResStream<true, false, false>, pg8::StaticOrder, true, true, true>(ring, g, S, E, F.wave); }
    GRID_BAR();
    { pg8::Gemm g{(const bf16*)(ws + WS_XR1), (const bf16*)(ws + WS_WF1), M, 2 * FF, D, D}; pg8::StaticOrder S; S.init(M, 2 * FF, F.G, bid);
      pg8::EpiGated<true> E{(bf16*)(ws + WS_H), FF, 0, (const float*)(ws + WS_PART1)};
      GEMM(pg8::EpiGated<true>, pg8::StaticOrder)(ring, g, S, E, F.wave); }
    GRID_BAR();
    { pg8::Gemm g{(const bf16*)(ws + WS_H), (const bf16*)(ws + WS_WF2), M, D, FF, FF}; pg8::StaticOrder S; S.init(M, D, F.G, bid);
      pg8::EpiResStream<true, true, true> E{ws + WS_XR1, (bf16*)(ws + WS_X2B), ws + WS_XR2, (float*)(ws + WS_PART2), 1.f};
      pg8::gemm_phase<pg8::EpiResStream<true, true, true>, pg8::StaticOrder, true, true>(ring, g, S, E, F.wave); }
    GRID_BAR();
    { pg8::Gemm g{(const bf16*)(ws + WS_XR2), (const bf16*)(ws + WS_WKVQ), M, 2 * D, D / 2, D / 2}; pg8::StaticOrder S; S.init(M, 2 * D, F.G, bid);
      pg8::EpiK2Q2 E{(bf16*)(ws + WS_KVQ2), (const float*)(ws + WS_PART2), INP(I_KV_GKN), INP(I_B_GQN), 1.f / 64};
      pg8::gemm_phase<pg8::EpiK2Q2, pg8::StaticOrder, true, true, true>(ring, g, S, E, F.wave); }
    { pg8::Gemm g{(const bf16*)(ws + WS_XR2), (const bf16*)(ws + WS_WKVQ + (size_t)2 * D * D), M, D, D / 2, D / 2}; pg8::StaticOrder S; S.init(M, D, F.G, bid);
      pg8::EpiRowScale16 E{(bf16*)(ws + WS_KVQ2), 3 * D, D, (const float*)(ws + WS_PART2), 1.f / 64};
      pg8::gemm_phase<pg8::EpiRowScale16, pg8::StaticOrder, true, true, true>(ring, g, S, E, F.wave); }
    GRID_BAR();
    bool fastB;
    { float bq = 0.f, bk = 0.f, bb = 0.f; const int l_ = lane_id_(); bq = fabsf(INP(I_B_GQN)[l_]); bk = fabsf(INP(I_KV_GKN)[l_]);
      for (int i = l_; i < NH * 257; i += 64) bb = fmaxf(bb, fabsf(INP(I_B_RELB)[i]));
      bq = wave_maxf(bq); bk = wave_maxf(bk); bb = wave_maxf(bb); fastB = __builtin_amdgcn_readfirstlane((int)(11.78f * bq * bk + 1.4427f * bb <= 40.f)) != 0; }
    att::attn_init<64, 3072, 3072, 2>(ring, F.wave);
    att::bf16x8 qfB[4]; bool qldB = false;
    int last_h = -1;
    for (int p = F.vcu; p < BATCH * NH * 8; p += F.G) {
        const int bh = p >> 3, cb = ((p & 7) + (p >> 8)) & 7, b = bh >> 4, h = bh & 15;
        const bool ldb = h != last_h; last_h = h;
        const int pn = p + F.G; const bool hn = pn < BATCH * NH * 8; const int bhn = pn >> 3, cbn = ((pn & 7) + (pn >> 8)) & 7;
        const int c0 = 4 * cb, cc = c0 + (F.wave >> 1);
        const bf16* base = (const bf16*)(ws + WS_KVQ2) + (size_t)b * SEQ * 3072 + h * 64;
#define P13_UNIT(NM) att::attn_unit<64, true, 3072, 3072, 3072, D, true, NM, 2>(ring, base + 2048, base, base + 1024, (bf16*)(ws + WS_O2 + (size_t)b * SEQ * D + h * 64), \
                                 256 * cb, c0 - 8 < 0 ? 0 : c0 - 8, c0 + 3, cc - 8 < 0 ? 0 : cc - 8, cc, cc, INP(I_B_RELB) + h * 257, nullptr, nullptr, F.wave, ldb, qfB, qldB, hn, \
                                 (const bf16*)(ws + WS_KVQ2) + (size_t)(bhn >> 4) * SEQ * 3072 + (bhn & 15) * 64 + 2048 + (size_t)(256 * cbn) * 3072)
        if (fastB) P13_UNIT(true); else P13_UNIT(false);
        qldB = hn;
    }
    GRID_BAR();
    { pg8::Gemm g{(const bf16*)(ws + WS_O2), (const bf16*)(ws + WS_WBO), M, D, D / 2, D / 2}; pg8::StaticOrder S; S.init(M, D, F.G, bid);
      pg8::EpiResStream<false, false, true> E{ws + WS_X2B, (bf16*)(ws + WS_XR3), nullptr, nullptr, 1.f / 2048};
      pg8::gemm_phase<pg8::EpiResStream<false, false, true>, pg8::StaticOrder, true, true, true>(ring, g, S, E, F.wave); }
    GRID_BAR();
    route_phase(F);
    GRID_BAR();
    slot_phase(F, ws);
    GRID_BAR();
#define MOE_LOAD(hf_) unsigned char* w2 = WSP; \
          const int nPA = __builtin_amdgcn_readfirstlane(((const GAS int*)(w2 + WS_META))[0]), nPB = __builtin_amdgcn_readfirstlane(((const GAS int*)(w2 + WS_META))[1]); (void)nPB; \
          const int xB = __builtin_amdgcn_readfirstlane(((const GAS int*)(w2 + WS_META))[18]); (void)xB; \
          const int p0 = (hf_) ? nPA : 0; int pbk[7]; \
          _Pragma("unroll") for (int k = 0; k < 7; ++k) pbk[k] = __builtin_amdgcn_readfirstlane(((const GAS int*)(w2 + WS_META))[2 + (hf_) * 8 + 1 + k]) - p0;
    constexpr size_t HMB_OFF = (size_t)MAXP_HALF * 256 * EFF;
    { MOE_LOAD(0)
      pg8::Gemm g{(const bf16*)(w2 + WS_XG), (const bf16*)(w2 + WS_WM1), nPA * 256, 2 * EFF, D / 2, D / 2};
      pg8::MoeOrder S; S.init(nPA, 2 * EFF / 256, F.G, bid);
#pragma unroll
      for (int k = 0; k < 7; ++k) S.pb[k] = pbk[k];
      pg8::EpiGatedF8 E{w2 + WS_HM, EFF, 2 * EFF / 256};
      pg8::gemm_phase<pg8::EpiGatedF8, pg8::MoeOrder, true, true, true>(ring, g, S, E, F.wave); }
    { MOE_LOAD(1)
      pg8::Gemm g{(const bf16*)(w2 + WS_XG + (size_t)p0 * 256 * D), (const bf16*)(w2 + WS_WM1), xB * 256, 2 * EFF, D / 2, D / 2};
      pg8::MoeOrder S; S.init(xB, 2 * EFF / 256, F.G, bid); S.rot = (nPA * (2 * EFF / 256)) % F.G;
#pragma unroll
      for (int k = 0; k < 7; ++k) S.pb[k] = pbk[k];
      pg8::EpiGatedF8 E{w2 + WS_HM + HMB_OFF, EFF, 2 * EFF / 256};
      pg8::gemm_phase<pg8::EpiGatedF8, pg8::MoeOrder, true, true, true>(ring, g, S, E, F.wave); }
    GRID_BAR();
    { MOE_LOAD(0)
      pg8::Gemm g{(const bf16*)(w2 + WS_HM), (const bf16*)(w2 + WS_WM2), 256 * 256, D, EFF / 2, EFF / 2};
      pg8::MoeOrder S; S.init(256, D / 256, F.G, bid);
#pragma unroll
      for (int k = 0; k < 7; ++k) S.pb[k] = pbk[k];
      pg8::EpiMoeDown<true> E{OUTP, (const bf16*)(w2 + WS_XR3), (const int*)(w2 + WS_SLOTTOK), (const float*)(w2 + WS_SLOTGATE), 0, D, 1.f / 64};
      pg8::gemm_phase<pg8::EpiMoeDown<true>, pg8::MoeOrder, true, true, true>(ring, g, S, E, F.wave); }
    GRID_BAR();
    { MOE_LOAD(0)
      pg8::Gemm g{(const bf16*)(w2 + WS_HM), (const bf16*)(w2 + WS_WM2), nPA * 256, D, EFF / 2, EFF / 2};
      pg8::LeftOrder S; S.M.init(nPA, D / 256, F.G, bid); S.nLeft = 4 * (nPA - 256); S.c0 = 0; S.pbase = 256;
#pragma unroll
      for (int k = 0; k < 7; ++k) S.M.pb[k] = pbk[k];
      pg8::EpiMoeDown<true> E{OUTP, (const bf16*)(w2 + WS_XR3), (const int*)(w2 + WS_SLOTTOK), (const float*)(w2 + WS_SLOTGATE), 0, D, 1.f / 64};
      pg8::gemm_phase<pg8::EpiMoeDown<true>, pg8::LeftOrder, true, true, true>(ring, g, S, E, F.wave); }
    { MOE_LOAD(1)
      pg8::Gemm g{(const bf16*)(w2 + WS_HM + HMB_OFF), (const bf16*)(w2 + WS_WM2), xB * 256, D, EFF / 2, EFF / 2};
      pg8::LeftOrder S; S.M.init(xB, D / 256, F.G, bid); S.nLeft = 4 * xB; S.c0 = 4 * (nPA - 256); S.pbase = 0;
#pragma unroll
      for (int k = 0; k < 7; ++k) S.M.pb[k] = pbk[k];
      pg8::EpiMoeDown<false> E{OUTP, nullptr, (const int*)(w2 + WS_SLOTTOK), (const float*)(w2 + WS_SLOTGATE), p0 * 256, D, 1.f / 64};
      pg8::gemm_phase<pg8::EpiMoeDown<false>, pg8::LeftOrder, true, true, true>(ring, g, S, E, F.wave); }
    { MOE_LOAD(1)
      pg8::Gemm g{(const bf16*)(w2 + WS_XG + (size_t)(p0 + xB) * 256 * D), (const bf16*)(w2 + WS_WM1), (nPB - xB) * 256, 2 * EFF, D / 2, D / 2};
      pg8::MoeOrder S; S.init(nPB - xB, 2 * EFF / 256, F.G, bid); S.nBusy = 4 * (nPA - 256) + 4 * xB; S.SK = 4;
#pragma unroll
      for (int k = 0; k < 7; ++k) S.pb[k] = pbk[k] - xB;
      pg8::EpiGatedF8 E{w2 + WS_HM + HMB_OFF + (size_t)xB * 256 * EFF, EFF, 2 * EFF / 256};
      pg8::gemm_phase<pg8::EpiGatedF8, pg8::MoeOrder, true, true, true>(ring, g, S, E, F.wave); }
    GRID_BAR();
    { MOE_LOAD(1)
      pg8::Gemm g{(const bf16*)(w2 + WS_HM + HMB_OFF + (size_t)xB * 256 * EFF), (const bf16*)(w2 + WS_WM2), (nPB - xB) * 256, D, EFF / 2, EFF / 2};
      pg8::MoeOrder S; S.init(nPB - xB, D / 256, F.G, bid);
#pragma unroll
      for (int k = 0; k < 7; ++k) S.pb[k] = pbk[k] - xB;
      pg8::EpiMoeDown<false> E{OUTP, nullptr, (const int*)(w2 + WS_SLOTTOK), (const float*)(w2 + WS_SLOTGATE), (p0 + xB) * 256, D, 1.f / 64};
      pg8::gemm_phase<pg8::EpiMoeDown<false>, pg8::MoeOrder, true, true, true>(ring, g, S, E, F.wave); }
#undef MOE_LOAD
#undef GRID_BAR
#undef bid
#undef GEMM
}

extern "C" void kernel_launch(void* const* d_in, const int* in_sizes, int n_in, void* d_out, int out_size, void* d_ws, size_t ws_size, hipStream_t stream) {
    static int grid = 0;
    if (grid == 0) {
        if (n_in != 27 || in_sizes[0] != M * D || out_size != M * D || ws_size < WS_END) { fprintf(stderr, "kernel_launch: unexpected shapes (n_in %d, in0 %d, out %d, ws %zu < %zu); nothing launched\n", n_in, n_in > 0 ? in_sizes[0] : -1, out_size, ws_size, (size_t)WS_END); grid = -1; return; }
        int dev = 0, cus = 0, per_cu = 0;
        if (hipGetDevice(&dev) != hipSuccess || hipDeviceGetAttribute(&cus, hipDeviceAttributeMultiprocessorCount, dev) != hipSuccess) { grid = -1; return; }
        if (hipFuncSetAttribute((const void*)yoco_fwd, hipFuncAttributeMaxDynamicSharedMemorySize, LDS_BYTES) != hipSuccess) { fprintf(stderr, "kernel_launch: hipFuncSetAttribute failed\n"); grid = -1; return; }
        if (hipOccupancyMaxActiveBlocksPerMultiprocessor(&per_cu, (const void*)yoco_fwd, NWAVES * 64, LDS_BYTES) != hipSuccess || per_cu < 1) { fprintf(stderr, "kernel_launch: occupancy query says %d\n", per_cu); }
        (void)hipGetLastError();
        grid = cus;
    }
    if (grid < 0) return;
    if (hipMemsetAsync((char*)d_ws + WS_CTL, 0, CTL_ZERO_BYTES, stream) != hipSuccess) return;
    Args a{};
    for (int i = 0; i < 27; ++i) a.in[i] = (const float*)d_in[i];
    a.out = (float*)d_out; a.ws = (unsigned char*)d_ws;
    hipLaunchKernelGGL(yoco_fwd, dim3(grid), dim3(NWAVES * 64), LDS_BYTES, stream, a);
}
```

```cpp
#include <hip/hip_runtime.h>
#include <cstdio>
#include <cstdint>
__device__ __forceinline__ int lane_id_() { unsigned m_ = ~0u; asm volatile("" : "+s"(m_)); return (int)__builtin_amdgcn_mbcnt_hi(m_, __builtin_amdgcn_mbcnt_lo(m_, 0u)); }
template <int X> __device__ __forceinline__ float swz_xor(float v) { return __builtin_bit_cast(float, __builtin_amdgcn_ds_swizzle(__builtin_bit_cast(int, v), (X << 10) | 0x1f)); }
__device__ __forceinline__ void halves32(float v, float& r_lo, float& r_hi) { unsigned a_ = __builtin_bit_cast(unsigned, v), b_ = a_;
    asm volatile("s_nop 1\n\tv_permlane32_swap_b32 %0, %1\n\ts_nop 1" : "+v"(a_), "+v"(b_)); r_lo = __builtin_bit_cast(float, a_); r_hi = __builtin_bit_cast(float, b_); }
__device__ __forceinline__ float xor32_partner(float v, int upper_half) { float lo, hi; halves32(v, lo, hi); return upper_half ? lo : hi; }
__device__ __forceinline__ float xor32_sum(float v) { float lo, hi; halves32(v, lo, hi); return lo + hi; }
__device__ __forceinline__ float xor32_max(float v) { float lo, hi; halves32(v, lo, hi); return fmaxf(lo, hi); }
namespace pg8 {
#define PG8_LAS __attribute__((address_space(3)))
typedef unsigned short bf16_t;
typedef short bf16x8 __attribute__((ext_vector_type(8)));
typedef float f32x4 __attribute__((ext_vector_type(4)));
typedef unsigned u32x4 __attribute__((ext_vector_type(4)));
constexpr int BM = 256, BK = 64, HALF = 128, HTB = HALF * BK * 2  , STAGE_BYTES = 8 * HTB, NXCD = 8, WGM = 8;

__host__ __device__ __forceinline__ int lds_byte(int r, int c) { const int st = (r >> 4) * 2 + (c >> 5), rr = r & 15, cc = c & 31, ob = rr * 64 + cc * 2; return st * 1024 + (ob ^ (((ob >> 9) & 1) << 5)); }
__host__ __device__ __forceinline__ void stage_rc(int b, int& R, int& C) { const int st = b / 1024, sb = b % 1024, swz = sb ^ (((sb >> 9) & 1) << 5); R = (st >> 1) * 16 + swz / 64; C = (st & 1) * 32 + (swz % 64) / 2; }
__host__ __device__ __forceinline__ int perm32(int rho) { const int n = rho >> 4, i = rho & 15; return 8 * (i >> 2) + 4 * n + (i & 3); }

struct Unit { int pm, pn; };
struct Gemm { const bf16_t* A; const bf16_t* Bt; int M, N, K, lda; };

struct StaticOrder {
    int nM, nN, nwg, G, c;
    __host__ __device__ void init(int M, int N, int G_, int c_) { nM = M / BM; nN = N / BM; nwg = nM * nN; G = G_; c = c_; }
    __host__ __device__ bool next(int i, Unit& u) const {
        const int L = i * G + c; if (L >= nwg) return false;
        int wgid = L; { const int q = nwg / NXCD, r = nwg % NXCD, xcd = wgid % NXCD, off = wgid / NXCD; wgid = (xcd < r ? xcd * (q + 1) : r * (q + 1) + (xcd - r) * q) + off; }
        const int nig = WGM * nN, gid = wgid / nig, fm = gid * WGM, gsz = (nM - fm) < WGM ? (nM - fm) : WGM;
        u.pm = fm + ((wgid % nig) % gsz); u.pn = (wgid % nig) / gsz; return true;
    }
    __device__ __forceinline__ void a_ready(const Unit&) const {}
    __device__ __forceinline__ void done(const Unit&) const {}
};
__device__ __forceinline__ unsigned cvt_pk_bf16(float lo, float hi) { unsigned r; asm volatile("v_cvt_pk_bf16_f32 %0, %1, %2" : "=v"(r) : "v"(lo), "v"(hi)); return r; }
__device__ __forceinline__ float silu_f(float x) { const float e = __builtin_amdgcn_exp2f(x * -1.4426950408889634f); return x * __builtin_amdgcn_rcpf(1.f + e); }

__device__ __forceinline__ float sum4(const f32x4& a) { return (a[0] + a[1]) + (a[2] + a[3]); }
__device__ __forceinline__ float part_sum8(const float* p) { return sum4(*(const f32x4*)p) + sum4(*(const f32x4*)(p + 4)); }
__device__ __forceinline__ float part_sum16(const float* p) { return (sum4(*(const f32x4*)p) + sum4(*(const f32x4*)(p + 4))) + (sum4(*(const f32x4*)(p + 8)) + sum4(*(const f32x4*)(p + 12))); }
__device__ __forceinline__ float fq_sum(float v) { v += swz_xor<16>(v); return xor32_sum(v); }
__device__ __forceinline__ float sq8(const f32x4& a, const f32x4& b) { return ((a[0] * a[0] + a[1] * a[1]) + (a[2] * a[2] + a[3] * a[3])) + ((b[0] * b[0] + b[1] * b[1]) + (b[2] * b[2] + b[3] * b[3])); }
__device__ __forceinline__ u32x4 pack8(const f32x4& a, const f32x4& b) { u32x4 w; w.x = cvt_pk_bf16(a[0], a[1]); w.y = cvt_pk_bf16(a[2], a[3]); w.z = cvt_pk_bf16(b[0], b[1]); w.w = cvt_pk_bf16(b[2], b[3]); return w; }
constexpr float EPS_ = 1e-6f;
__device__ __forceinline__ unsigned pk_fp8x4(float a, float b, float c, float d) { int w = 0; w = __builtin_amdgcn_cvt_pk_fp8_f32(a, b, w, false); w = __builtin_amdgcn_cvt_pk_fp8_f32(c, d, w, true); return (unsigned)w; }

struct EpiQA {
    static constexpr bool PERM = true, AFTER_DRAIN = false;
    bf16_t* O; float* part; float wscale;
    __device__ __forceinline__ void operator()(const f32x4 (&acc)[2][2][4][2], const Unit& u, int wr, int wc, int fr, int fq) const {
        { int t_ = lane_id_(); asm volatile("" : "+v"(t_)); fr = t_ & 15; fq = (t_ >> 4) & 3; }
        const int row0 = u.pm * BM + wr * 64 + fr, col0 = u.pn * BM + wc * 32 + 8 * fq;
#pragma unroll
        for (int ai = 0; ai < 2; ++ai)
#pragma unroll
            for (int m = 0; m < 4; ++m) { const int row = row0 + ai * HALF + m * 16; bf16_t* rowp = O + (size_t)row * 768 + col0;
                const f32x4 a0 = acc[ai][0][m][0] * wscale, a1 = acc[ai][0][m][1] * wscale, b0 = acc[ai][1][m][0] * wscale, b1 = acc[ai][1][m][1] * wscale;
                *(u32x4*)(rowp) = pack8(a0, a1); *(u32x4*)(rowp + HALF) = pack8(b0, b1);
                const float s0 = sq8(a0, a1), s1 = sq8(b0, b1);
                float* pr = part + (size_t)row * 16;
                if (u.pn == 0) { const float t = fq_sum(s0 + s1); if (fq == 0) pr[wc] = t; }
                else if (u.pn == 1) { const float t0 = fq_sum(s0), t1 = fq_sum(s1); if (fq == 0) { pr[4 + wc] = t0; pr[8 + wc] = t1; } }
                else { const float t = fq_sum(s0); if (fq == 0) pr[12 + wc] = t; } }
    }
};

struct EpiRowScaleBf16 {
    static constexpr bool PERM = true, AFTER_DRAIN = false;
    bf16_t* O; int ldc; const float* part; float inv_n;
    __device__ __forceinline__ void operator()(const f32x4 (&acc)[2][2][4][2], const Unit& u, int wr, int wc, int fr, int fq) const {
        { int t_ = lane_id_(); asm volatile("" : "+v"(t_)); fr = t_ & 15; fq = (t_ >> 4) & 3; }
        const int row0 = u.pm * BM + wr * 64 + fr, col0 = u.pn * BM + wc * 32 + 8 * fq;
#pragma unroll
        for (int ai = 0; ai < 2; ++ai)
#pragma unroll
            for (int m = 0; m < 4; ++m) { const int row = row0 + ai * HALF + m * 16; bf16_t* rowp = O + (size_t)row * ldc + col0;
                const float rs = __builtin_amdgcn_rsqf(part_sum8(part + (size_t)row * 16) * inv_n + EPS_);
                *(u32x4*)(rowp) = pack8(acc[ai][0][m][0] * rs, acc[ai][0][m][1] * rs); *(u32x4*)(rowp + HALF) = pack8(acc[ai][1][m][0] * rs, acc[ai][1][m][1] * rs); }
    }
};

struct EpiKVup {
    static constexpr bool PERM = true, AFTER_DRAIN = false;
    bf16_t* Kd; bf16_t* Vd; const float* part; const bf16_t* QA; const float* g_kn; const float* rope;
    __device__ __forceinline__ void operator()(const f32x4 (&acc)[2][2][4][2], const Unit& u, int wr, int wc, int fr, int fq) const {
        { int t_ = lane_id_(); asm volatile("" : "+v"(t_)); fr = t_ & 15; fq = (t_ >> 4) & 3; }
        const int row0 = u.pm * BM + wr * 64 + fr;
        if (u.pn >= 4) {
            const int col0 = (u.pn - 4) * BM + wc * 32 + 8 * fq;
#pragma unroll
            for (int ai = 0; ai < 2; ++ai)
#pragma unroll
                for (int m = 0; m < 4; ++m) { const int row = row0 + ai * HALF + m * 16; bf16_t* rowp = Vd + (size_t)row * 1024 + col0;
                    const float rs = __builtin_amdgcn_rsqf(part_sum8(part + (size_t)row * 16 + 8) * (1.f / 256) + EPS_);
                    *(u32x4*)(rowp) = pack8(acc[ai][0][m][0] * rs, acc[ai][0][m][1] * rs); *(u32x4*)(rowp + HALF) = pack8(acc[ai][1][m][0] * rs, acc[ai][1][m][1] * rs); }
            return;
        }
        const int head = 4 * u.pn + wc;
        f32x4 gA0 = *(const f32x4*)(g_kn + 8 * fq), gA1 = *(const f32x4*)(g_kn + 8 * fq + 4), gB0 = *(const f32x4*)(g_kn + 32 + 8 * fq), gB1 = *(const f32x4*)(g_kn + 32 + 8 * fq + 4);
        const f32x4 gR1 = *(const f32x4*)(g_kn + 64 + 4 * fq), gR2 = *(const f32x4*)(g_kn + 80 + 4 * fq);
#pragma unroll
        for (int ai = 0; ai < 2; ++ai)
#pragma unroll
            for (int m = 0; m < 4; ++m) { const int row = row0 + ai * HALF + m * 16;
                const float rs = __builtin_amdgcn_rsqf(part_sum8(part + (size_t)row * 16 + 8) * (1.f / 256) + EPS_);
                f32x4 a0 = acc[ai][0][m][0] * rs, a1 = acc[ai][0][m][1] * rs, b0 = acc[ai][1][m][0] * rs, b1 = acc[ai][1][m][1] * rs;
                const unsigned long long p1 = *(const unsigned long long*)(QA + (size_t)row * 768 + 640 + 4 * fq), p2 = *(const unsigned long long*)(QA + (size_t)row * 768 + 656 + 4 * fq);
                f32x4 x1, x2;
                x1[0] = __builtin_bit_cast(float, (unsigned)(p1 << 16)); x1[1] = __builtin_bit_cast(float, (unsigned)p1 & 0xffff0000u);
                x1[2] = __builtin_bit_cast(float, (unsigned)(p1 >> 32) << 16); x1[3] = __builtin_bit_cast(float, (unsigned)(p1 >> 32) & 0xffff0000u);
                x2[0] = __builtin_bit_cast(float, (unsigned)(p2 << 16)); x2[1] = __builtin_bit_cast(float, (unsigned)p2 & 0xffff0000u);
                x2[2] = __builtin_bit_cast(float, (unsigned)(p2 >> 32) << 16); x2[3] = __builtin_bit_cast(float, (unsigned)(p2 >> 32) & 0xffff0000u);
                const float ss = fq_sum(sq8(a0, a1) + sq8(b0, b1) + sq8(x1, x2));
                const float sh = __builtin_amdgcn_rsqf(ss * (1.f / 96) + EPS_);
                bf16_t* kp = Kd + (size_t)row * 1536 + head * 96;
                *(u32x4*)(kp + 8 * fq) = pack8(a0 * gA0 * sh, a1 * gA1 * sh); *(u32x4*)(kp + 32 + 8 * fq) = pack8(b0 * gB0 * sh, b1 * gB1 * sh);
                const f32x4* rp = (const f32x4*)(rope + ((size_t)(row & 2047) * 16 + 4 * fq) * 2);
                const f32x4 c01 = rp[0], c23 = rp[1];
                const f32x4 y1 = x1 * gR1 * sh, y2 = x2 * gR2 * sh;
                f32x4 o1, o2;
                o1[0] = y1[0] * c01[0] - y2[0] * c01[1]; o2[0] = y2[0] * c01[0] + y1[0] * c01[1];
                o1[1] = y1[1] * c01[2] - y2[1] * c01[3]; o2[1] = y2[1] * c01[2] + y1[1] * c01[3];
                o1[2] = y1[2] * c23[0] - y2[2] * c23[1]; o2[2] = y2[2] * c23[0] + y1[2] * c23[1];
                o1[3] = y1[3] * c23[2] - y2[3] * c23[3]; o2[3] = y2[3] * c23[2] + y1[3] * c23[3];
                unsigned long long w1 = (unsigned long long)cvt_pk_bf16(o1[0], o1[1]) | ((unsigned long long)cvt_pk_bf16(o1[2], o1[3]) << 32);
                unsigned long long w2 = (unsigned long long)cvt_pk_bf16(o2[0], o2[1]) | ((unsigned long long)cvt_pk_bf16(o2[2], o2[3]) << 32);
                *(unsigned long long*)(kp + 64 + 4 * fq) = w1; *(unsigned long long*)(kp + 80 + 4 * fq) = w2; }
    }
};

struct EpiK2Q2 {
    static constexpr bool PERM = true, AFTER_DRAIN = false;
    bf16_t* O; const float* pss; const float* gk; const float* gq; float wscale;
    __device__ __forceinline__ void operator()(const f32x4 (&acc)[2][2][4][2], const Unit& u, int wr, int wc, int fr, int fq) const {
        { int t_ = lane_id_(); asm volatile("" : "+v"(t_)); fr = t_ & 15; fq = (t_ >> 4) & 3; }
        const int row0 = u.pm * BM + wr * 64 + fr, isq = u.pn >> 2, tl = u.pn & 3;
        const float* g = isq ? gq : gk; const float post = isq ? 0.125f * 1.4426950408889634f : 1.f;
        const f32x4 gA0 = *(const f32x4*)(g + 8 * fq) * post, gA1 = *(const f32x4*)(g + 8 * fq + 4) * post, gB0 = *(const f32x4*)(g + 32 + 8 * fq) * post, gB1 = *(const f32x4*)(g + 32 + 8 * fq + 4) * post;
        const int colh = isq * 2048 + (4 * tl + wc) * 64;
        unsigned zhi_ = 0u; asm volatile("" : "+v"(zhi_));
        const unsigned long long coff = ((unsigned long long)zhi_ << 32) | (unsigned)((colh + 8 * fq) * 2);
#pragma unroll
        for (int ai = 0; ai < 2; ++ai)
#pragma unroll
            for (int m = 0; m < 4; ++m) { const int row = row0 + ai * HALF + m * 16; unsigned char* rowp = (unsigned char*)O + (size_t)row * 6144 + coff;
                const float rs = __builtin_amdgcn_rsqf(part_sum16(pss + (size_t)row * 16) * (1.f / 1024) + EPS_) * wscale;
                const f32x4 a0 = acc[ai][0][m][0] * rs, a1 = acc[ai][0][m][1] * rs, b0 = acc[ai][1][m][0] * rs, b1 = acc[ai][1][m][1] * rs;
                const float ss = fq_sum(sq8(a0, a1) + sq8(b0, b1));
                const float sh = __builtin_amdgcn_rsqf(ss * (1.f / 64) + EPS_);
                *(u32x4*)(rowp) = pack8(a0 * gA0 * sh, a1 * gA1 * sh); *(u32x4*)(rowp + 64) = pack8(b0 * gB0 * sh, b1 * gB1 * sh); }
    }
};
struct EpiRowScale16 {
    static constexpr bool PERM = true, AFTER_DRAIN = false;
    bf16_t* O; int ldc; int coff; const float* pss; float wscale;
    __device__ __forceinline__ void operator()(const f32x4 (&acc)[2][2][4][2], const Unit& u, int wr, int wc, int fr, int fq) const {
        { int t_ = lane_id_(); asm volatile("" : "+v"(t_)); fr = t_ & 15; fq = (t_ >> 4) & 3; }
        const int row0 = u.pm * BM + wr * 64 + fr, col0 = coff + u.pn * BM + wc * 32 + 8 * fq;
#pragma unroll
        for (int ai = 0; ai < 2; ++ai)
#pragma unroll
            for (int m = 0; m < 4; ++m) { const int row = row0 + ai * HALF + m * 16; bf16_t* rowp = O + (size_t)row * ldc + col0;
                const float rs = __builtin_amdgcn_rsqf(part_sum16(pss + (size_t)row * 16) * (1.f / 1024) + EPS_) * wscale;
                *(u32x4*)(rowp) = pack8(acc[ai][0][m][0] * rs, acc[ai][0][m][1] * rs); *(u32x4*)(rowp + HALF) = pack8(acc[ai][1][m][0] * rs, acc[ai][1][m][1] * rs); }
    }
};

template <bool SSQ> struct EpiGated {
    static constexpr bool PERM = true, AFTER_DRAIN = false;
    bf16_t* Hd; int ldc; int ntile; const float* rs;
    __device__ __forceinline__ void operator()(const f32x4 (&acc)[2][2][4][2], const Unit& u, int wr, int wc, int fr, int fq) const {
        { int t_ = lane_id_(); asm volatile("" : "+v"(t_)); fr = t_ & 15; fq = (t_ >> 4) & 3; }
        const int pnl = ntile ? (u.pn % ntile) : u.pn;
        const int row0 = u.pm * BM + wr * 64 + fr, col0 = pnl * HALF + wc * 32 + 8 * fq;
#pragma unroll
        for (int ai = 0; ai < 2; ++ai)
#pragma unroll
            for (int m = 0; m < 4; ++m) { const int row = row0 + ai * HALF + m * 16; bf16_t* rowp = Hd + (size_t)row * ldc + col0;
                const float r = SSQ ? __builtin_amdgcn_rsqf(part_sum16(rs + (size_t)row * 16) * (1.f / 1024) + EPS_) : rs[row];
                const f32x4 g0 = acc[ai][0][m][0] * r, g1 = acc[ai][0][m][1] * r, u0 = acc[ai][1][m][0] * r, u1 = acc[ai][1][m][1] * r;
                u32x4 w;
                w.x = cvt_pk_bf16(silu_f(g0[0]) * u0[0], silu_f(g0[1]) * u0[1]); w.y = cvt_pk_bf16(silu_f(g0[2]) * u0[2], silu_f(g0[3]) * u0[3]);
                w.z = cvt_pk_bf16(silu_f(g1[0]) * u1[0], silu_f(g1[1]) * u1[1]); w.w = cvt_pk_bf16(silu_f(g1[2]) * u1[2], silu_f(g1[3]) * u1[3]);
                *(u32x4*)rowp = w; }
    }
};

struct EpiGatedF8 {
    static constexpr bool PERM = true, AFTER_DRAIN = false;
    unsigned char* Hd; int ldc; int ntile;
    static __device__ __forceinline__ float gate(float g, float u) {
        const float e = __builtin_amdgcn_exp2f(g * (-1.4426950408889634f / 64.f)); return (g * u) * (__builtin_amdgcn_rcpf(1.f + e) * (1.f / 4096.f)); }
    __device__ __forceinline__ void operator()(const f32x4 (&acc)[2][2][4][2], const Unit& u, int wr, int wc, int fr, int fq) const {
        { int t_ = lane_id_(); asm volatile("" : "+v"(t_)); fr = t_ & 15; fq = (t_ >> 4) & 3; }
        const int pnl = u.pn % ntile;
        const int row0 = u.pm * BM + wr * 64 + fr, col0 = pnl * HALF + wc * 32 + 8 * fq;
#pragma unroll
        for (int ai = 0; ai < 2; ++ai)
#pragma unroll
            for (int m = 0; m < 4; ++m) { const int row = row0 + ai * HALF + m * 16; unsigned char* rowp = Hd + (size_t)row * ldc + col0;
                const f32x4 g0 = acc[ai][0][m][0], g1 = acc[ai][0][m][1], u0 = acc[ai][1][m][0], u1 = acc[ai][1][m][1];
                unsigned long long w = (unsigned long long)pk_fp8x4(gate(g0[0], u0[0]), gate(g0[1], u0[1]), gate(g0[2], u0[2]), gate(g0[3], u0[3]))
                                     | ((unsigned long long)pk_fp8x4(gate(g1[0], u1[0]), gate(g1[1], u1[1]), gate(g1[2], u1[2]), gate(g1[3], u1[3])) << 32);
                *(unsigned long long*)rowp = w; }
    }
};

template <bool SSQ, bool XF8, bool RES16> struct EpiResStream {
    static constexpr bool PERM = true, AFTER_DRAIN = false;
    const void* res; bf16_t* XB; unsigned char* X8; float* ssq; float ascale;
    __device__ __forceinline__ void operator()(const f32x4 (&acc)[2][2][4][2], const Unit& u, int wr, int wc, int fr, int fq) const {
        { int t_ = lane_id_(); asm volatile("" : "+v"(t_)); fr = t_ & 15; fq = (t_ >> 4) & 3; }
        const int row0 = u.pm * BM + wr * 64 + fr, col0 = u.pn * BM + wc * 32 + 8 * fq;
        f32x4 rw[4][2][2];
#define ERS_ROW(it) (row0 + ((it) >> 2) * HALF + ((it) & 3) * 16)
#define ERS_LOAD(it) do { const size_t ro_ = (size_t)ERS_ROW(it) * 1024 + col0; _Pragma("unroll") for (int bj = 0; bj < 2; ++bj) { \
            if constexpr (RES16) rw[(it) & 3][bj][0] = __builtin_bit_cast(f32x4, *(const u32x4*)((const bf16_t*)res + ro_ + bj * HALF)); \
            else { _Pragma("unroll") for (int n = 0; n < 2; ++n) rw[(it) & 3][bj][n] = *(const f32x4*)((const float*)res + ro_ + bj * HALF + n * 4); } } } while (0)
        ERS_LOAD(0); ERS_LOAD(1); ERS_LOAD(2); ERS_LOAD(3);
#pragma unroll
        for (int it = 0; it < 8; ++it) { const int ai = it >> 2, m = it & 3; const int row = ERS_ROW(it); const size_t ro = (size_t)row * 1024 + col0;
                f32x4 r[2][2];
#pragma unroll
                for (int bj = 0; bj < 2; ++bj) {
                    if constexpr (RES16) { const u32x4 w = __builtin_bit_cast(u32x4, rw[it & 3][bj][0]);
                        r[bj][0] = (f32x4){__builtin_bit_cast(float, w.x << 16), __builtin_bit_cast(float, w.x & 0xffff0000u), __builtin_bit_cast(float, w.y << 16), __builtin_bit_cast(float, w.y & 0xffff0000u)};
                        r[bj][1] = (f32x4){__builtin_bit_cast(float, w.z << 16), __builtin_bit_cast(float, w.z & 0xffff0000u), __builtin_bit_cast(float, w.w << 16), __builtin_bit_cast(float, w.w & 0xffff0000u)}; }
                    else { r[bj][0] = rw[it & 3][bj][0]; r[bj][1] = rw[it & 3][bj][1]; }
                    r[bj][0] = r[bj][0] + acc[ai][bj][m][0] * ascale; r[bj][1] = r[bj][1] + acc[ai][bj][m][1] * ascale; }
                if (it + 4 < 8) ERS_LOAD(it + 4);
                *(u32x4*)(XB + ro) = pack8(r[0][0], r[0][1]); *(u32x4*)(XB + ro + HALF) = pack8(r[1][0], r[1][1]);
                if constexpr (XF8) { unsigned char* x8 = X8 + ro;
                    *(unsigned long long*)(x8) = (unsigned long long)pk_fp8x4(r[0][0][0], r[0][0][1], r[0][0][2], r[0][0][3]) | ((unsigned long long)pk_fp8x4(r[0][1][0], r[0][1][1], r[0][1][2], r[0][1][3]) << 32);
                    *(unsigned long long*)(x8 + HALF) = (unsigned long long)pk_fp8x4(r[1][0][0], r[1][0][1], r[1][0][2], r[1][0][3]) | ((unsigned long long)pk_fp8x4(r[1][1][0], r[1][1][1], r[1][1][2], r[1][1][3]) << 32); }
                if (SSQ) { const float t = fq_sum(sq8(r[0][0], r[0][1]) + sq8(r[1][0], r[1][1])); if (fq == 0) ssq[(size_t)row * 16 + u.pn * 4 + wc] = t; } }
#undef ERS_LOAD
#undef ERS_ROW
    }
};

template <bool FIRST> struct EpiMoeDown {
    static constexpr bool PERM = false, AFTER_DRAIN = false;
    float* out; bf16_t* xb; const int* slot_tok; const float* slot_gate; int slot_base; int ldc; float wscale;
    __device__ __forceinline__ void operator()(const f32x4 (&acc)[2][2][4][2], const Unit& u, int wr, int wc, int fr, int fq) const {
        { int t_ = lane_id_(); asm volatile("" : "+v"(t_)); fr = t_ & 15; fq = (t_ >> 4) & 3; }
        const int pnl = u.pn & 3;
        const int row0 = slot_base + u.pm * BM + wr * 64 + fr, col0 = pnl * BM + wc * 32 + 4 * fq;
        int tk[8]; float gt[8];
#pragma unroll
        for (int it = 0; it < 8; ++it) { const int slot = row0 + (it >> 2) * HALF + (it & 3) * 16; tk[it] = slot_tok[slot]; gt[it] = slot_gate[slot] * wscale; }
        unsigned rlo[4][2][2], rhi[4][2][2];
#define EMD_LOAD(it) do { if (tk[it] >= 0) { _Pragma("unroll") for (int bj = 0; bj < 2; ++bj) _Pragma("unroll") for (int n = 0; n < 2; ++n) { \
            const unsigned long long q_ = *(const unsigned long long*)(xb + (size_t)tk[it] * ldc + col0 + bj * HALF + n * 16); \
            rlo[(it) & 3][bj][n] = (unsigned)q_; rhi[(it) & 3][bj][n] = (unsigned)(q_ >> 32); } } } while (0)
        EMD_LOAD(0); EMD_LOAD(1); EMD_LOAD(2); EMD_LOAD(3);
#pragma unroll
        for (int it = 0; it < 8; ++it) { const int ai = it >> 2, m = it & 3;
            if (tk[it] >= 0) { const size_t ro = (size_t)tk[it] * ldc + col0;
#pragma unroll
                for (int bj = 0; bj < 2; ++bj)
#pragma unroll
                    for (int n = 0; n < 2; ++n) { const unsigned lo = rlo[it & 3][bj][n], hi = rhi[it & 3][bj][n];
                        f32x4 r = (f32x4){__builtin_bit_cast(float, lo << 16), __builtin_bit_cast(float, lo & 0xffff0000u), __builtin_bit_cast(float, hi << 16), __builtin_bit_cast(float, hi & 0xffff0000u)};
                        r = r + acc[ai][bj][m][n] * gt[it];
                        if constexpr (FIRST) *(unsigned long long*)(xb + ro + bj * HALF + n * 16) = (unsigned long long)cvt_pk_bf16(r[0], r[1]) | ((unsigned long long)cvt_pk_bf16(r[2], r[3]) << 32);
                        else *(f32x4*)(out + ro + bj * HALF + n * 16) = r; } }
            if (it + 4 < 8) EMD_LOAD(it + 4); }
#undef EMD_LOAD
    }
};

struct MoeOrder {
    int nM, nN, nwg, G, c; int pb[7];
    int rot;
    int nBusy, SK;
    __device__ void init(int nPanels, int nN_, int G_, int c_) { nM = nPanels; nN = nN_; nwg = nM * nN; G = G_; c = c_; nBusy = 0; SK = 0; rot = 0; }
    __device__ __forceinline__ int expert_of(int pm) const { int e = 0;
#pragma unroll
        for (int k = 0; k < 7; ++k) e += (pm >= pb[k]) ? 1 : 0;
        return e; }
    __device__ bool next(int i, Unit& u) const {
        int L;
        if (nBusy == 0) { int ce = c - rot; if (ce < 0) ce += G; L = i * G + ce; }
        else if (c >= nBusy) L = (i < SK) ? i * (G - nBusy) + (c - nBusy) : SK * (G - nBusy) + (i - SK) * G + c;
        else L = SK * (G - nBusy) + i * G + c;
        if (L >= nwg) return false;
        int wgid = L; { const int q = nwg / NXCD, r = nwg % NXCD, xcd = wgid % NXCD, off = wgid / NXCD; wgid = (xcd < r ? xcd * (q + 1) : r * (q + 1) + (xcd - r) * q) + off; }
        const int nig = WGM * nN, gid = wgid / nig, fm = gid * WGM, gsz = (nM - fm) < WGM ? (nM - fm) : WGM;
        u.pm = fm + ((wgid % nig) % gsz); const int pnl = (wgid % nig) / gsz;
        u.pn = expert_of(u.pm) * nN + pnl; return true;
    }
    __device__ __forceinline__ void a_ready(const Unit&) const {}
    __device__ __forceinline__ void done(const Unit&) const {}
};
struct LeftOrder {
    MoeOrder M; int nLeft, c0, pbase;
    __device__ bool next(int i, Unit& u) const { const int j = M.c - c0; if (i != 0 || j < 0 || j >= nLeft) return false; u.pm = pbase + (j >> 2); u.pn = M.expert_of(u.pm) * 4 + (j & 3); return true; }
    __device__ __forceinline__ void a_ready(const Unit&) const {}
    __device__ __forceinline__ void done(const Unit&) const {}
};
template <class Epi, class Sched, bool ALIGN_EPI = false, bool SP2 = false, bool F8 = false>
__device__ __forceinline__ void gemm_phase(PG8_LAS unsigned char* lds, const Gemm g, const Sched& S, const Epi& E, const int wave_idx) {
    int tid_ = wave_idx * 64 + lane_id_(); asm volatile("" : "+v"(tid_));
    const int tid = tid_, wid = __builtin_amdgcn_readfirstlane(tid >> 6), lane = tid & 63, wr = wid >> 2, wc = wid & 3, fr = lane & 15, fq = lane >> 4;
    const int K = g.K, nt = K / BK;
    unsigned voffA0, voffB0;
    { int R, C; stage_rc(tid * 16, R, C); const int Rb = Epi::PERM ? ((R & ~31) + perm32(R & 31)) : R;
      voffA0 = (unsigned)(R * g.lda + C) * 2u; voffB0 = (unsigned)(Rb * K + C) * 2u; }
    const size_t voffAR = (size_t)64 * g.lda * 2, voffBR = (size_t)64 * K * 2;
    const size_t kstep = (size_t)(BK * 2);
    const size_t hstepA = (size_t)HALF * g.lda * 2, hstepB = (size_t)HALF * K * 2;
    const size_t tstepA = 2 * hstepA, tstepB = 2 * hstepB;
    const unsigned lds0_ = (unsigned)(__UINTPTR_TYPE__)lds;
    const unsigned ldsw = (unsigned)wid * 1024u;
    const int aoff = lds_byte(wr * 64 + fr, fq * 8), boff = lds_byte(wc * 32 + fr, fq * 8);
#define PG8_SA(b, h) (((b) * 2 + (h)) * HTB)
#define PG8_SB(b, h) ((4 + (b) * 2 + (h)) * HTB)
#define PG8_STAGE(bufoff, gbase, voff) do { _Pragma("unroll") for (int _i = 0; _i < 2; ++_i) { unsigned keep_; const char* sb_ = (const char*)(gbase) + (size_t)_i * voff##R; \
        asm volatile("s_mov_b32 %0, m0\n\ts_mov_b32 m0, %3\n\ts_nop 0\n\tglobal_load_lds_dwordx4 %1, %2\n\ts_mov_b32 m0, %0" \
            : "=&s"(keep_) : "v"(voff##0), "s"(sb_), "s"(lds0_ + (unsigned)((bufoff) + _i * 8192) + ldsw) : "memory"); } } while (0)
#define PG8_LDA(dst, b, h) do { _Pragma("unroll") for (int m = 0; m < 4; ++m) _Pragma("unroll") for (int k = 0; k < 2; ++k) dst[m][k] = *(const PG8_LAS bf16x8*)(lds + PG8_SA(b, h) + aoff + m * 2048 + k * 1024); } while (0)
#define PG8_LDB(dst, b, h) do { _Pragma("unroll") for (int n = 0; n < 2; ++n) _Pragma("unroll") for (int k = 0; k < 2; ++k) dst[n][k] = *(const PG8_LAS bf16x8*)(lds + PG8_SB(b, h) + boff + n * 2048 + k * 1024); } while (0)
#define PG8_MMA(ai, bj, At, Bt) do { __builtin_amdgcn_s_setprio(1); _Pragma("unroll") for (int m = 0; m < 4; ++m) _Pragma("unroll") for (int n = 0; n < 2; ++n) { \
        if constexpr (F8) { typedef int v8i_ __attribute__((ext_vector_type(8))); typedef int v4i_ __attribute__((ext_vector_type(4))); \
            const v4i_ b0_ = __builtin_bit_cast(v4i_, Bt[n][0]), b1_ = __builtin_bit_cast(v4i_, Bt[n][1]), a0_ = __builtin_bit_cast(v4i_, At[m][0]), a1_ = __builtin_bit_cast(v4i_, At[m][1]); \
            const v8i_ bb_ = __builtin_shufflevector(b0_, b1_, 0, 1, 2, 3, 4, 5, 6, 7), aa_ = __builtin_shufflevector(a0_, a1_, 0, 1, 2, 3, 4, 5, 6, 7); \
            acc[ai][bj][m][n] = __builtin_amdgcn_mfma_scale_f32_16x16x128_f8f6f4(bb_, aa_, acc[ai][bj][m][n], 0, 0, 0, 0, 0, 0); } \
        else { _Pragma("unroll") for (int k = 0; k < 2; ++k) acc[ai][bj][m][n] = __builtin_amdgcn_mfma_f32_16x16x32_bf16(Bt[n][k], At[m][k], acc[ai][bj][m][n], 0, 0, 0); } } \
        __builtin_amdgcn_s_setprio(0); } while (0)
#define PG8_WAIT_V(n) asm volatile("s_waitcnt vmcnt(" #n ")" ::: "memory")
#define PG8_WAIT_L(n) asm volatile("s_waitcnt lgkmcnt(" #n ")" ::: "memory")
#define PG8_BAR __builtin_amdgcn_s_barrier()
#define PG8_SCHED __builtin_amdgcn_sched_barrier(0)
    Unit cur, nxt; int ui = 0;
    if (!S.next(0, cur)) return;
    f32x4 acc[2][2][4][2];
#pragma unroll
    for (int a = 0; a < 2; ++a)
#pragma unroll
        for (int b = 0; b < 2; ++b)
#pragma unroll
            for (int m = 0; m < 4; ++m)
#pragma unroll
                for (int n = 0; n < 2; ++n) acc[a][b][m][n] = (f32x4){0.f, 0.f, 0.f, 0.f};
    bf16x8 At[4][2], B0[2][2], B1[2][2];
    const char* cA = (const char*)g.A + (size_t)cur.pm * tstepA; const char* cB = (const char*)g.Bt + (size_t)cur.pn * tstepB;
    S.a_ready(cur);
    if constexpr (SP2) {
        PG8_STAGE(PG8_SB(0, 0), cB, voffB); PG8_STAGE(PG8_SB(0, 1), cB + hstepB, voffB); PG8_STAGE(PG8_SA(0, 0), cA, voffA); PG8_STAGE(PG8_SA(0, 1), cA + hstepA, voffA);
        if (wr == 1) PG8_BAR;
        PG8_WAIT_V(2); PG8_BAR;
        PG8_STAGE(PG8_SB(1, 0), cB + kstep, voffB); PG8_STAGE(PG8_SA(1, 0), cA + kstep, voffA); PG8_STAGE(PG8_SB(1, 1), cB + hstepB + kstep, voffB);
        PG8_WAIT_V(6); PG8_BAR;
    } else {
        PG8_STAGE(PG8_SB(0, 0), cB, voffB); PG8_STAGE(PG8_SA(0, 0), cA, voffA); PG8_STAGE(PG8_SB(0, 1), cB + hstepB, voffB); PG8_STAGE(PG8_SA(0, 1), cA + hstepA, voffA);
        if (wr == 1) PG8_BAR;
        PG8_WAIT_V(4); PG8_BAR;
        PG8_STAGE(PG8_SB(1, 0), cB + kstep, voffB); PG8_STAGE(PG8_SA(1, 0), cA + kstep, voffA); PG8_STAGE(PG8_SB(1, 1), cB + hstepB + kstep, voffB);
        PG8_WAIT_V(6); PG8_BAR;
    }
    for (;;) {
        const bool has_next = S.next(ui + 1, nxt);
        const char* nA = has_next ? (const char*)g.A + (size_t)nxt.pm * tstepA : cA; const char* nB = has_next ? (const char*)g.Bt + (size_t)nxt.pn * tstepB : cB;
#pragma unroll 1
        for (int t = 0; t < nt; t += 2) {
            const bool last = (t == nt - 2);
            const char* a1 = cA + (size_t)(t + 1) * kstep;
            const char* a2 = last ? nA : cA + (size_t)(t + 2) * kstep; const char* b2 = last ? nB : cB + (size_t)(t + 2) * kstep;
            const char* a3 = a2 + kstep; const char* b3 = b2 + kstep;
            if (last && has_next) S.a_ready(nxt);
            if constexpr (SP2) {
            PG8_LDB(B0, 0, 0); PG8_LDB(B1, 0, 1); PG8_SCHED; PG8_LDA(At, 0, 0); PG8_STAGE(PG8_SA(1, 1), a1 + hstepA, voffA);
            PG8_WAIT_V(8); PG8_WAIT_L(0); PG8_BAR; PG8_MMA(0, 0, At, B0); PG8_MMA(0, 1, At, B1); PG8_BAR; PG8_SCHED;
            PG8_LDA(At, 0, 1); PG8_STAGE(PG8_SB(0, 0), b2, voffB); PG8_STAGE(PG8_SB(0, 1), b2 + hstepB, voffB); PG8_STAGE(PG8_SA(0, 0), a2, voffA);
            PG8_WAIT_V(8); PG8_WAIT_L(0); PG8_BAR; PG8_MMA(1, 0, At, B0); PG8_MMA(1, 1, At, B1); PG8_BAR; PG8_SCHED;
            PG8_LDB(B0, 1, 0); PG8_LDB(B1, 1, 1); PG8_SCHED; PG8_LDA(At, 1, 0); PG8_STAGE(PG8_SA(0, 1), a2 + hstepA, voffA);
            PG8_WAIT_V(8); PG8_WAIT_L(0); PG8_BAR; PG8_MMA(0, 0, At, B0); PG8_MMA(0, 1, At, B1); PG8_BAR; PG8_SCHED;
            PG8_LDA(At, 1, 1); PG8_STAGE(PG8_SB(1, 0), b3, voffB); PG8_STAGE(PG8_SB(1, 1), b3 + hstepB, voffB); PG8_STAGE(PG8_SA(1, 0), a3, voffA);
            PG8_WAIT_V(8); PG8_WAIT_L(0); PG8_BAR; PG8_MMA(1, 0, At, B0); PG8_MMA(1, 1, At, B1); PG8_BAR; PG8_SCHED;
            } else {
            PG8_LDB(B0, 0, 0); PG8_SCHED; PG8_LDA(At, 0, 0); PG8_STAGE(PG8_SA(1, 1), a1 + hstepA, voffA);
            PG8_WAIT_L(8); PG8_BAR; PG8_WAIT_L(0); PG8_MMA(0, 0, At, B0); PG8_BAR; PG8_SCHED;
            PG8_LDB(B1, 0, 1); PG8_STAGE(PG8_SB(0, 0), b2, voffB);
            PG8_BAR; PG8_WAIT_L(0); PG8_MMA(0, 1, At, B1); PG8_BAR;
            PG8_LDA(At, 0, 1); PG8_STAGE(PG8_SA(0, 0), a2, voffA);
            PG8_BAR; PG8_WAIT_L(0); PG8_MMA(1, 0, At, B0); PG8_BAR; PG8_SCHED;
            PG8_STAGE(PG8_SB(0, 1), b2 + hstepB, voffB);
            PG8_WAIT_V(6); PG8_BAR; PG8_MMA(1, 1, At, B1); PG8_BAR;
            PG8_LDB(B0, 1, 0); PG8_SCHED; PG8_LDA(At, 1, 0); PG8_STAGE(PG8_SA(0, 1), a2 + hstepA, voffA);
            PG8_WAIT_L(8); PG8_BAR; PG8_WAIT_L(0); PG8_MMA(0, 0, At, B0); PG8_BAR; PG8_SCHED;
            PG8_LDB(B1, 1, 1); PG8_STAGE(PG8_SB(1, 0), b3, voffB);
            PG8_BAR; PG8_WAIT_L(0); PG8_MMA(0, 1, At, B1); PG8_BAR;
            PG8_LDA(At, 1, 1); PG8_STAGE(PG8_SA(1, 0), a3, voffA);
            PG8_BAR; PG8_WAIT_L(0); PG8_MMA(1, 0, At, B0); PG8_BAR; PG8_SCHED;
            PG8_STAGE(PG8_SB(1, 1), b3 + hstepB, voffB);
            PG8_WAIT_V(6); PG8_BAR; PG8_MMA(1, 1, At, B1); PG8_BAR;
            }
        }
        if constexpr (ALIGN_EPI) { if (wr == 0) PG8_BAR; }
        if constexpr (!Epi::AFTER_DRAIN) { E(acc, cur, wr, wc, fr, fq); S.done(cur); }
        if (!has_next) break;
#pragma unroll
        for (int a = 0; a < 2; ++a)
#pragma unroll
            for (int b = 0; b < 2; ++b)
#pragma unroll
                for (int m = 0; m < 4; ++m)
#pragma unroll
                    for (int n = 0; n < 2; ++n) acc[a][b][m][n] = (f32x4){0.f, 0.f, 0.f, 0.f};
        cur = nxt; cA = nA; cB = nB; ++ui;
        if constexpr (ALIGN_EPI) { if (wr == 1) PG8_BAR; }
    }
    PG8_WAIT_V(0);
    if constexpr (!ALIGN_EPI) { if (wr == 0) PG8_BAR; }
    PG8_BAR;
    if constexpr (Epi::AFTER_DRAIN) { E.fused(acc, cur, wr, wc, fr, fq, lds, wid, lane); S.done(cur); }
#undef PG8_SA
#undef PG8_SB
#undef PG8_STAGE
#undef PG8_LDA
#undef PG8_LDB
#undef PG8_MMA
#undef PG8_WAIT_V
#undef PG8_WAIT_L
#undef PG8_BAR
#undef PG8_SCHED
}
}
namespace att {
#define ATT_LAS __attribute__((address_space(3)))
typedef unsigned short bf16;
typedef short bf16x8 __attribute__((ext_vector_type(8)));
typedef short s16x4 __attribute__((ext_vector_type(4)));
typedef float f32x16 __attribute__((ext_vector_type(16)));
typedef float f32x4_t __attribute__((ext_vector_type(4)));
typedef unsigned u32x4 __attribute__((ext_vector_type(4)));
typedef unsigned u32x2 __attribute__((ext_vector_type(2)));
typedef float f32x2_t __attribute__((ext_vector_type(2))); typedef __bf16 bf16x2_t __attribute__((ext_vector_type(2)));
__device__ __forceinline__ unsigned cvtpk(float lo, float hi) { f32x2_t v = {lo, hi}; bf16x2_t b = __builtin_convertvector(v, bf16x2_t); return __builtin_bit_cast(unsigned, b); }
__device__ __forceinline__ s16x4 vtr(const ATT_LAS unsigned char* p) { return __builtin_bit_cast(s16x4, __builtin_amdgcn_ds_read_tr16_b64_v4i16((ATT_LAS s16x4*)p)); }
constexpr int VSTR = 192;
template <int DQK> struct Geo { static constexpr int KSTR = DQK * 2 + 16, KBUF = 64 * KSTR, VBUF = 64 * VSTR, CPR = DQK / 8, NKC = 64 * CPR, KIT = (NKC + 511) / 512; };
template <int DQK> constexpr int lds_bytes() { return 3 * Geo<DQK>::KBUF + 3 * Geo<DQK>::VBUF + 2048 + 8192; }

__device__ __forceinline__ float xhalf_sum(float m) { return xor32_sum(m); }
__device__ __forceinline__ float max3f(float a, float b, float c) { float r; asm("v_max3_f32 %0, %1, %2, %3" : "=v"(r) : "v"(a), "v"(b), "v"(c)); return r; }
__device__ __forceinline__ float max2f(float a, float b) { float r; asm("v_max_f32_e32 %0, %1, %2" : "=v"(r) : "v"(a), "v"(b)); return r; }
__device__ __forceinline__ float rowmax32(const f32x16& p0, const f32x16& p1) {
    float a = max2f(p0[0], p1[0]), b = max2f(p0[1], p1[1]), c = max2f(p0[2], p1[2]), d = max2f(p0[3], p1[3]);
#pragma unroll
    for (int r = 4; r < 16; r += 4) { a = max3f(a, p0[r], p1[r]); b = max3f(b, p0[r + 1], p1[r + 1]); c = max3f(c, p0[r + 2], p1[r + 2]); d = max3f(d, p0[r + 3], p1[r + 3]); }
    const float m = max2f(max2f(a, b), max2f(c, d));
    float lo_, hi_; halves32(m, lo_, hi_);
    return max2f(lo_, hi_);
}

template <int DQK, int kpitch, int vpitch, int NS>
__device__ __forceinline__ void attn_init(ATT_LAS unsigned char* lds, const int wave_idx) {
    typedef Geo<DQK> G;
    const int lane = lane_id_(), wid = wave_idx;
    constexpr int KCPL = G::KSTR / 16, KNP = (64 * KCPL + 63) / 64, VCPL = VSTR / 16, VNP = 64 * VCPL / 64, KPP = (KNP + 7) / 8, VPP = (VNP + 7) / 8;
    ATT_LAS unsigned* dmaL = (ATT_LAS unsigned*)(lds + NS * G::KBUF + NS * G::VBUF + 2048) + wid * 256 + lane;
#pragma unroll
    for (int pp = 0; pp < KPP; ++pp) { const int pc = wid + 8 * pp, c = pc * 64 + lane, row = (c / KCPL) & 63, ch = c % KCPL; dmaL[64 * pp] = (unsigned)(row * kpitch + (ch < G::CPR ? ch : 0) * 8) * 2u; }
#pragma unroll
    for (int pp = 0; pp < VPP; ++pp) { const int pc = wid + 8 * pp, c = pc * 64 + lane, row = (c / VCPL) & 63, ch = c % VCPL; dmaL[128 + 64 * pp] = (unsigned)(row * vpitch + (ch < 8 ? ch : 0) * 8) * 2u; }
}

template <int DQK, bool BAND, int qpitch, int kpitch, int vpitch, int opitch, bool OF8 = false, bool NOMAX = false, int NS = 2, int DBG = 0>
__device__ __forceinline__ void attn_unit(ATT_LAS unsigned char* lds, const bf16* Qb, const bf16* Kb, const bf16* Vb, bf16* Ob,
                                          int q0, int t_lo, int t_hi, int my_lo, int my_hi, int cc, const float* bias_g, const float* g_qn, const float* rope, const int wave_idx, const bool load_bias,
                                          bf16x8 (&qf)[DQK / 16], const bool q_loaded, const bool has_next, const bf16* Qn) {
    typedef Geo<DQK> G;
    int tid_ = wave_idx * 64 + lane_id_(); asm volatile("" : "+v"(tid_));
    const int tid = tid_, lane = tid & 63, r32 = lane & 31, hi = lane >> 5, wid = __builtin_amdgcn_readfirstlane(tid >> 6);
    ATT_LAS float* biasL = (ATT_LAS float*)(lds + NS * G::KBUF + NS * G::VBUF);
    constexpr int KCPL = G::KSTR / 16, KNP = (64 * KCPL + 63) / 64;
    constexpr int VCPL = VSTR / 16, VNP = 64 * VCPL / 64;
    constexpr int KPP = (KNP + 7) / 8, VPP = (VNP + 7) / 8;
    ATT_LAS unsigned* dmaL = (ATT_LAS unsigned*)(lds + NS * G::KBUF + NS * G::VBUF + 2048) + wid * 256 + lane;
    const unsigned ldsb = __builtin_amdgcn_readfirstlane((unsigned)(size_t)lds);
    const int kc = (KNP - 1 - wid) / 8 + 1, vc = (VNP - 1 - wid) / 8 + 1;
#define ATT_MOD3(x) (NS == 3 ? (x) - 3 * (((x) * 43) >> 7) : ((x) & 1))
#define ATT_DMA1(gptr, voff_, ldsaddr) do { unsigned keep_; asm volatile("s_mov_b32 %0, m0\n\ts_mov_b32 m0, %3\n\ts_nop 0\n\tglobal_load_lds_dwordx4 %1, %2\n\ts_mov_b32 m0, %0" \
            : "=&s"(keep_) : "v"(voff_), "s"(gptr), "s"(ldsaddr) : "memory"); } while (0)
#define ATT_DMA_K(t) do { const int t_ = (t); const char* kt_ = (const char*)(Kb + (size_t)t_ * 64 * kpitch); const unsigned d_ = ldsb + ATT_MOD3(t_) * G::KBUF + wid * 1024; \
        _Pragma("unroll") for (int pp = 0; pp < KPP; ++pp) { if (wid + 8 * pp < KNP) { const unsigned vo_ = dmaL[64 * pp]; ATT_DMA1(kt_, vo_, d_ + pp * 8192); } } } while (0)
#define ATT_DMA_V(t) do { const int t_ = (t); const char* vt_ = (const char*)(Vb + (size_t)t_ * 64 * vpitch); const unsigned d_ = ldsb + NS * G::KBUF + ATT_MOD3(t_) * G::VBUF + wid * 1024; \
        _Pragma("unroll") for (int pp = 0; pp < VPP; ++pp) { if (wid + 8 * pp < VNP) { const unsigned vo_ = dmaL[128 + 64 * pp]; ATT_DMA1(vt_, vo_, d_ + pp * 8192); } } } while (0)
#define ATT_WAITBAR(n) do { const int n_ = (n); \
        if (n_ == 0) asm volatile("s_waitcnt vmcnt(0) lgkmcnt(0)\n\ts_barrier" ::: "memory"); else if (n_ == 1) asm volatile("s_waitcnt vmcnt(1) lgkmcnt(0)\n\ts_barrier" ::: "memory"); \
        else if (n_ == 2) asm volatile("s_waitcnt vmcnt(2) lgkmcnt(0)\n\ts_barrier" ::: "memory"); else if (n_ == 3) asm volatile("s_waitcnt vmcnt(3) lgkmcnt(0)\n\ts_barrier" ::: "memory"); \
        else if (n_ == 4) asm volatile("s_waitcnt vmcnt(4) lgkmcnt(0)\n\ts_barrier" ::: "memory"); else if (n_ == 5) asm volatile("s_waitcnt vmcnt(5) lgkmcnt(0)\n\ts_barrier" ::: "memory"); \
        else asm volatile("s_waitcnt vmcnt(6) lgkmcnt(0)\n\ts_barrier" ::: "memory"); } while (0)
    ATT_DMA_K(t_lo); ATT_DMA_V(t_lo);
    if (t_lo + 1 <= t_hi) { ATT_DMA_K(t_lo + 1); if (NS == 3) ATT_DMA_V(t_lo + 1); }
    if (NS == 3) { if (t_lo + 2 <= t_hi) ATT_DMA_K(t_lo + 2); }
    if (BAND) { if (load_bias && tid < 257) biasL[tid] = bias_g[tid] * 1.4426950408889634f; }
    if (!q_loaded) { const bf16* qp = Qb + (size_t)(q0 + wid * 32 + r32) * qpitch + 8 * hi;
#pragma unroll
      for (int kk = 0; kk < DQK / 16; ++kk) { if constexpr (DBG & 8) qf[kk] = (bf16x8){(short)lane, 1, 2, 3, 4, 5, 6, 7}; else qf[kk] = *(const bf16x8*)(qp + 16 * kk); } }
    if constexpr (!BAND) {
        float qv[DQK / 16][8]; float ss = 0.f;
#pragma unroll
        for (int kk = 0; kk < DQK / 16; ++kk)
#pragma unroll
            for (int j = 0; j < 8; ++j) { qv[kk][j] = __builtin_bit_cast(float, (unsigned)(unsigned short)qf[kk][j] << 16); ss += qv[kk][j] * qv[kk][j]; }
        ss = xhalf_sum(ss);
        const float rs = __builtin_amdgcn_rsqf(ss * (1.f / DQK) + 1e-6f) * (0.10206207261596577f * 1.4426950408889634f);
#pragma unroll
        for (int kk = 0; kk < DQK / 16; ++kk) { const f32x4_t g0 = *(const f32x4_t*)(g_qn + 16 * kk + 8 * hi), g1 = *(const f32x4_t*)(g_qn + 16 * kk + 8 * hi + 4);
#pragma unroll
            for (int j = 0; j < 4; ++j) { qv[kk][j] *= rs * g0[j]; qv[kk][4 + j] *= rs * g1[j]; } }
        const f32x4_t* rp = (const f32x4_t*)(rope + ((size_t)(q0 + wid * 32 + r32) * 16 + 8 * hi) * 2);
#pragma unroll
        for (int j2 = 0; j2 < 4; ++j2) { const f32x4_t cs = rp[j2];
            { const float x1 = qv[4][2 * j2], x2 = qv[5][2 * j2]; qv[4][2 * j2] = x1 * cs[0] - x2 * cs[1]; qv[5][2 * j2] = x2 * cs[0] + x1 * cs[1]; }
            { const float x1 = qv[4][2 * j2 + 1], x2 = qv[5][2 * j2 + 1]; qv[4][2 * j2 + 1] = x1 * cs[2] - x2 * cs[3]; qv[5][2 * j2 + 1] = x2 * cs[2] + x1 * cs[3]; } }
#pragma unroll
        for (int kk = 0; kk < DQK / 16; ++kk) { u32x4 w; w.x = cvtpk(qv[kk][0], qv[kk][1]); w.y = cvtpk(qv[kk][2], qv[kk][3]); w.z = cvtpk(qv[kk][4], qv[kk][5]); w.w = cvtpk(qv[kk][6], qv[kk][7]);
            qf[kk] = __builtin_bit_cast(bf16x8, w); }
    }
    f32x16 o0, o1;
#pragma unroll
    for (int i = 0; i < 16; ++i) { o0[i] = 0.f; o1[i] = 0.f; }
    float mrun = -INFINITY, lsum = 0.f; float ls4[4] = {0.f, 0.f, 0.f, 0.f};
    const int koff = r32 * G::KSTR + hi * 16;
    const int voff = ((lane >> 5) * 4 + ((lane & 15) >> 2)) * VSTR + (((lane >> 4) & 1) * 16 + (lane & 3) * 4) * 2;
    const f32x16 zero16 = {0.f, 0.f, 0.f, 0.f, 0.f, 0.f, 0.f, 0.f, 0.f, 0.f, 0.f, 0.f, 0.f, 0.f, 0.f, 0.f};
#define ATT_QK(X0, X1, t) do { const ATT_LAS unsigned char* Kt = lds + ATT_MOD3(t) * G::KBUF + koff; \
        _Pragma("unroll") for (int kk = 0; kk < DQK / 16; ++kk) { \
            const bf16x8 a0 = *(const ATT_LAS bf16x8*)(Kt + kk * 32); const bf16x8 a1 = *(const ATT_LAS bf16x8*)(Kt + 32 * G::KSTR + kk * 32); \
            X0 = __builtin_amdgcn_mfma_f32_32x32x16_bf16(a0, qf[kk], kk ? X0 : zero16, 0, 0, 0); X1 = __builtin_amdgcn_mfma_f32_32x32x16_bf16(a1, qf[kk], kk ? X1 : zero16, 0, 0, 0); } } while (0)
#define ATT_FARSCALE() do { const float f_ = __builtin_amdgcn_exp2f(biasL[256]); _Pragma("unroll") for (int i = 0; i < 16; ++i) { o0[i] *= f_; o1[i] *= f_; } \
        ls4[0] *= f_; ls4[1] *= f_; ls4[2] *= f_; ls4[3] *= f_; } while (0)
#define ATT_SMPV(X0, X1, t) do { \
        float cadd = 0.f; \
        if (BAND && !(DBG & 2)) { const int delta = cc - (t); \
            if (delta >= 3) { if constexpr (!NOMAX) cadd = biasL[256]; } \
            else { const ATT_LAS float* bp = biasL + (64 * delta + (32 * (wid & 1) + r32) - 4 * hi + 128 - 63); \
                if (delta < 2) { _Pragma("unroll") for (int i = 0; i < 16; ++i) { const int kj = (i & 3) + 8 * (i >> 2); X0[i] += bp[63 - kj]; X1[i] += bp[31 - kj]; } } \
                else { const int relb = 64 * delta + (32 * (wid & 1) + r32) - 4 * hi + 128; \
                    _Pragma("unroll") for (int i = 0; i < 16; ++i) { const int kj = (i & 3) + 8 * (i >> 2); int i0 = relb - kj, i1 = relb - kj - 32; i0 = i0 > 256 ? 256 : i0; i1 = i1 > 256 ? 256 : i1; \
                        X0[i] += biasL[i0]; X1[i] += biasL[i1]; } } } } \
        if constexpr (NOMAX) { \
            _Pragma("unroll") for (int i = 0; i < 16; ++i) { X0[i] = __builtin_amdgcn_exp2f(X0[i]); X1[i] = __builtin_amdgcn_exp2f(X1[i]); ls4[i & 3] += X0[i] + X1[i]; } \
        } else { \
        const float mt = rowmax32(X0, X1) + cadd; \
        const float mnew = max2f(mrun, mt); \
        const float alpha = __builtin_amdgcn_exp2f(mrun - mnew); \
        const float msub = mnew - cadd; \
        mrun = mnew; \
        float psa[4] = {0.f, 0.f, 0.f, 0.f};   \
        _Pragma("unroll") for (int i = 0; i < 16; ++i) { X0[i] = __builtin_amdgcn_exp2f(X0[i] - msub); X1[i] = __builtin_amdgcn_exp2f(X1[i] - msub); psa[i & 3] += X0[i] + X1[i]; } \
        const float ps = (psa[0] + psa[1]) + (psa[2] + psa[3]); \
        lsum = lsum * alpha + ps; \
        _Pragma("unroll") for (int i = 0; i < 16; ++i) { o0[i] *= alpha; o1[i] *= alpha; } } \
        bf16x8 pf[2][2]; \
        _Pragma("unroll") for (int s = 0; s < 2; ++s) { u32x4 w0, w1; \
            w0.x = cvtpk(X0[8 * s + 0], X0[8 * s + 1]); w0.y = cvtpk(X0[8 * s + 2], X0[8 * s + 3]); w0.z = cvtpk(X0[8 * s + 4], X0[8 * s + 5]); w0.w = cvtpk(X0[8 * s + 6], X0[8 * s + 7]); \
            w1.x = cvtpk(X1[8 * s + 0], X1[8 * s + 1]); w1.y = cvtpk(X1[8 * s + 2], X1[8 * s + 3]); w1.z = cvtpk(X1[8 * s + 4], X1[8 * s + 5]); w1.w = cvtpk(X1[8 * s + 6], X1[8 * s + 7]); \
            pf[0][s] = __builtin_bit_cast(bf16x8, w0); pf[1][s] = __builtin_bit_cast(bf16x8, w1); } \
        const ATT_LAS unsigned char* Vt = lds + NS * G::KBUF + ATT_MOD3(t) * G::VBUF + voff; \
        _Pragma("unroll") for (int kb = 0; kb < 2; ++kb) _Pragma("unroll") for (int s = 0; s < 2; ++s) { \
            const ATT_LAS unsigned char* vp = Vt + (32 * kb + 16 * s) * VSTR; \
            const s16x4 l0 = vtr(vp), h0 = vtr(vp + 8 * VSTR), l1 = vtr(vp + 64), h1 = vtr(vp + 8 * VSTR + 64); \
            const bf16x8 a0 = (bf16x8){l0[0], l0[1], l0[2], l0[3], h0[0], h0[1], h0[2], h0[3]}; \
            const bf16x8 a1 = (bf16x8){l1[0], l1[1], l1[2], l1[3], h1[0], h1[1], h1[2], h1[3]}; \
            o0 = __builtin_amdgcn_mfma_f32_32x32x16_bf16(a0, pf[kb][s], o0, 0, 0, 0); o1 = __builtin_amdgcn_mfma_f32_32x32x16_bf16(a1, pf[kb][s], o1, 0, 0, 0); } \
        if constexpr (NOMAX && BAND) { if (cc - (t) == 3) ATT_FARSCALE(); } } while (0)
#define ATT_FUSED(C0, C1, N0, N1, t, tn) do { \
        bf16x8 kfa[DQK / 16], kfb[DQK / 16]; \
        { const ATT_LAS unsigned char* Kt = lds + ATT_MOD3(tn) * G::KBUF + koff; \
          _Pragma("unroll") for (int kk = 0; kk < DQK / 16; ++kk) { kfa[kk] = *(const ATT_LAS bf16x8*)(Kt + kk * 32); kfb[kk] = *(const ATT_LAS bf16x8*)(Kt + 32 * G::KSTR + kk * 32); } } \
        if constexpr (!NOMAX) __builtin_amdgcn_sched_barrier(0); \
        float cadd = 0.f; \
        if (BAND && !(DBG & 2)) { const int delta = cc - (t); \
            if (delta >= 3) { if constexpr (!NOMAX) cadd = biasL[256]; } \
            else { const ATT_LAS float* bp = biasL + (64 * delta + (32 * (wid & 1) + r32) - 4 * hi + 128 - 63); \
                if (delta < 2) { _Pragma("unroll") for (int i = 0; i < 16; ++i) { const int kj = (i & 3) + 8 * (i >> 2); C0[i] += bp[63 - kj]; C1[i] += bp[31 - kj]; } } \
                else { const int relb = 64 * delta + (32 * (wid & 1) + r32) - 4 * hi + 128; \
                    _Pragma("unroll") for (int i = 0; i < 16; ++i) { const int kj = (i & 3) + 8 * (i >> 2); int i0 = relb - kj, i1 = relb - kj - 32; i0 = i0 > 256 ? 256 : i0; i1 = i1 > 256 ? 256 : i1; \
                        C0[i] += biasL[i0]; C1[i] += biasL[i1]; } } } } \
        float alpha = 1.f, msub = 0.f; \
        if constexpr (!NOMAX) { \
        const float mt = rowmax32(C0, C1) + cadd; \
        const float mnew = max2f(mrun, mt); \
        alpha = __builtin_amdgcn_exp2f(mrun - mnew); \
        msub = mnew - cadd; \
        if (__builtin_amdgcn_ballot_w64(mnew > mrun)) { _Pragma("unroll") for (int i = 0; i < 16; ++i) { o0[i] *= alpha; o1[i] *= alpha; } } \
        mrun = mnew; } \
        if constexpr (!NOMAX || BAND) __builtin_amdgcn_sched_barrier(0); \
        _Pragma("unroll") for (int kk = 0; kk < DQK / 16; ++kk) { \
            N0 = __builtin_amdgcn_mfma_f32_32x32x16_bf16(kfa[kk], qf[kk], kk ? N0 : zero16, 0, 0, 0); N1 = __builtin_amdgcn_mfma_f32_32x32x16_bf16(kfb[kk], qf[kk], kk ? N1 : zero16, 0, 0, 0); } \
        s16x4 vl0[4], vh0[4], vl1[4], vh1[4]; \
        { const ATT_LAS unsigned char* Vt = lds + NS * G::KBUF + ATT_MOD3(t) * G::VBUF + voff; \
          _Pragma("unroll") for (int ks = 0; ks < 4; ++ks) { const ATT_LAS unsigned char* vp = Vt + 16 * ks * VSTR; vl0[ks] = vtr(vp); vh0[ks] = vtr(vp + 8 * VSTR); vl1[ks] = vtr(vp + 64); vh1[ks] = vtr(vp + 8 * VSTR + 64); } } \
        if constexpr (NOMAX) { \
            _Pragma("unroll") for (int i = 0; i < 16; ++i) { C0[i] = __builtin_amdgcn_exp2f(C0[i]); C1[i] = __builtin_amdgcn_exp2f(C1[i]); ls4[i & 3] += C0[i] + C1[i]; } \
        } else { \
        float psa[4] = {0.f, 0.f, 0.f, 0.f}; \
        _Pragma("unroll") for (int i = 0; i < 16; ++i) { C0[i] = __builtin_amdgcn_exp2f(C0[i] - msub); C1[i] = __builtin_amdgcn_exp2f(C1[i] - msub); psa[i & 3] += C0[i] + C1[i]; } \
        const float ps = (psa[0] + psa[1]) + (psa[2] + psa[3]); \
        lsum = lsum * alpha + ps; } \
        bf16x8 pf[4]; \
        _Pragma("unroll") for (int s = 0; s < 2; ++s) { u32x4 w0, w1; \
            w0.x = cvtpk(C0[8 * s + 0], C0[8 * s + 1]); w0.y = cvtpk(C0[8 * s + 2], C0[8 * s + 3]); w0.z = cvtpk(C0[8 * s + 4], C0[8 * s + 5]); w0.w = cvtpk(C0[8 * s + 6], C0[8 * s + 7]); \
            w1.x = cvtpk(C1[8 * s + 0], C1[8 * s + 1]); w1.y = cvtpk(C1[8 * s + 2], C1[8 * s + 3]); w1.z = cvtpk(C1[8 * s + 4], C1[8 * s + 5]); w1.w = cvtpk(C1[8 * s + 6], C1[8 * s + 7]); \
            pf[s] = __builtin_bit_cast(bf16x8, w0); pf[2 + s] = __builtin_bit_cast(bf16x8, w1); } \
        __builtin_amdgcn_sched_barrier(0); \
        _Pragma("unroll") for (int ks = 0; ks < 4; ++ks) { \
            const bf16x8 a0 = (bf16x8){vl0[ks][0], vl0[ks][1], vl0[ks][2], vl0[ks][3], vh0[ks][0], vh0[ks][1], vh0[ks][2], vh0[ks][3]}; \
            const bf16x8 a1 = (bf16x8){vl1[ks][0], vl1[ks][1], vl1[ks][2], vl1[ks][3], vh1[ks][0], vh1[ks][1], vh1[ks][2], vh1[ks][3]}; \
            o0 = __builtin_amdgcn_mfma_f32_32x32x16_bf16(a0, pf[ks], o0, 0, 0, 0); o1 = __builtin_amdgcn_mfma_f32_32x32x16_bf16(a1, pf[ks], o1, 0, 0, 0); } \
        if constexpr (NOMAX && BAND) { if (cc - (t) == 3) ATT_FARSCALE(); } } while (0)
#define ATT_STAGE(t) do { if ((t) + NS <= t_hi) ATT_DMA_K((t) + NS); if ((t) + NS - 1 <= t_hi) ATT_DMA_V((t) + NS - 1); } while (0)
#define ATT_STAGE_T(t) do { ATT_STAGE(t); \
        if ((t) == t_hi && has_next) { const bf16* qp_ = Qn + (size_t)(wid * 32 + r32) * qpitch + 8 * hi; _Pragma("unroll") for (int kk = 0; kk < DQK / 16; ++kk) qf[kk] = *(const bf16x8*)(qp_ + 16 * kk); } } while (0)
#define ATT_NFL(t) ((NS == 3 ? ((t) + 3 <= t_hi ? kc : 0) + ((t) + 2 <= t_hi ? vc : 0) : 0) + (((t) == t_hi && has_next) ? DQK / 16 : 0))
    f32x16 sa0, sa1, sb0, sb1;
    ATT_WAITBAR(0);
    if (my_lo == t_lo) ATT_QK(sa0, sa1, t_lo);
    ATT_WAITBAR(0);
    {
        int t = t_lo;
        for (; t < my_lo - 1; ++t) { ATT_STAGE(t); ATT_WAITBAR(ATT_NFL(t)); }
        if (my_lo > t_lo) { ATT_STAGE(t); ATT_QK(sa0, sa1, t + 1); ATT_WAITBAR(ATT_NFL(t)); ++t; }
        int nf = my_hi - my_lo;
        for (; nf >= 2; nf -= 2, t += 2) {
            ATT_STAGE(t); ATT_FUSED(sa0, sa1, sb0, sb1, t, t + 1); ATT_WAITBAR(ATT_NFL(t));
            ATT_STAGE(t + 1); ATT_FUSED(sb0, sb1, sa0, sa1, t + 1, t + 2); ATT_WAITBAR(ATT_NFL(t + 1));
        }
        if (nf == 1) {
            ATT_STAGE(t); ATT_FUSED(sa0, sa1, sb0, sb1, t, t + 1); ATT_WAITBAR(ATT_NFL(t)); ++t;
            ATT_STAGE_T(t); ATT_SMPV(sb0, sb1, t); ATT_WAITBAR(ATT_NFL(t)); ++t;
        } else {
            ATT_STAGE_T(t); ATT_SMPV(sa0, sa1, t); ATT_WAITBAR(ATT_NFL(t)); ++t;
        }
        for (; t <= t_hi; ++t) { ATT_STAGE_T(t); ATT_WAITBAR(ATT_NFL(t)); }
    }
    if constexpr (NOMAX) lsum = (ls4[0] + ls4[1]) + (ls4[2] + ls4[3]);
    const float ltot = xhalf_sum(lsum);
    const float inv = 1.f / ltot;
    if constexpr (DBG & 4) { if (ltot == 12345.678f) *(float*)Ob = o0[0] + o1[0]; } else
    if constexpr (OF8) {
        const float i64 = inv * 32.f;
        int w0[4], w1[4];
#pragma unroll
        for (int g4 = 0; g4 < 4; ++g4) { w0[g4] = 0; w1[g4] = 0;
            w0[g4] = __builtin_amdgcn_cvt_pk_fp8_f32(o0[4 * g4 + 0] * i64, o0[4 * g4 + 1] * i64, w0[g4], false); w0[g4] = __builtin_amdgcn_cvt_pk_fp8_f32(o0[4 * g4 + 2] * i64, o0[4 * g4 + 3] * i64, w0[g4], true);
            w1[g4] = __builtin_amdgcn_cvt_pk_fp8_f32(o1[4 * g4 + 0] * i64, o1[4 * g4 + 1] * i64, w1[g4], false); w1[g4] = __builtin_amdgcn_cvt_pk_fp8_f32(o1[4 * g4 + 2] * i64, o1[4 * g4 + 3] * i64, w1[g4], true); }
        asm volatile("s_nop 1\n\tv_permlane32_swap_b32 %0, %1\n\tv_permlane32_swap_b32 %2, %3\n\tv_permlane32_swap_b32 %4, %5\n\tv_permlane32_swap_b32 %6, %7\n\ts_nop 1"
                     : "+v"(w0[2]), "+v"(w0[0]), "+v"(w0[3]), "+v"(w0[1]), "+v"(w1[2]), "+v"(w1[0]), "+v"(w1[3]), "+v"(w1[1]));
        unsigned char* op = (unsigned char*)Ob + (size_t)(q0 + wid * 32 + r32) * opitch + (hi ? 0 : 16);
        *(u32x4*)op = (u32x4){(unsigned)w0[2], (unsigned)w0[0], (unsigned)w0[3], (unsigned)w0[1]};
        *(u32x4*)(op + 32) = (u32x4){(unsigned)w1[2], (unsigned)w1[0], (unsigned)w1[3], (unsigned)w1[1]};
    } else {
    bf16* op = Ob + (size_t)(q0 + wid * 32 + r32) * opitch + 4 * hi;
#pragma unroll
    for (int g4 = 0; g4 < 4; ++g4) {
        u32x2 w0, w1;
        w0.x = cvtpk(o0[4 * g4 + 0] * inv, o0[4 * g4 + 1] * inv); w0.y = cvtpk(o0[4 * g4 + 2] * inv, o0[4 * g4 + 3] * inv);
        w1.x = cvtpk(o1[4 * g4 + 0] * inv, o1[4 * g4 + 1] * inv); w1.y = cvtpk(o1[4 * g4 + 2] * inv, o1[4 * g4 + 3] * inv);
        *(u32x2*)(op + 8 * g4) = w0; *(u32x2*)(op + 32 + 8 * g4) = w1;
    }
    }
#undef ATT_DMA_K
#undef ATT_DMA_V
#undef ATT_QK
#undef ATT_SMPV
#undef ATT_STAGE
#undef ATT_STAGE_T
#undef ATT_FUSED
#undef ATT_MOD3
#undef ATT_DMA1
#undef ATT_WAITBAR
#undef ATT_NFL
#undef ATT_FARSCALE
}
}
constexpr int NWAVES = 8;
constexpr int D = 1024, BATCH = 32, SEQ = 2048, M = BATCH * SEQ;
constexpr int NH = 16, QLORA = 384, KVLORA = 256, ROPE_D = 32, NOPE = 64, QKD = 96;
constexpr int NA = 768;
constexpr int FF = 2816, EFF = 3584, NE = 8;
constexpr float EPS = 1e-6f, LOG2E = 1.4426950408889634f;
constexpr int MAXP_HALF = 264, MAXP = 528;
constexpr size_t MiB = 1u << 20;
constexpr size_t WS_CTL = 0, CTL_ZERO_BYTES = 1 * MiB;
constexpr size_t WS_ROPE = 1 * MiB;
constexpr size_t WS_CNT = WS_ROPE + 256 * 1024;
constexpr size_t WS_PANELE = WS_CNT + 16 * 1024;
constexpr size_t WS_META = WS_PANELE + 4096;
constexpr size_t WS_TOKE = 2 * MiB;
constexpr size_t WS_TOKG = WS_TOKE + (size_t)M * 4;
constexpr size_t WS_SLOTTOK = WS_TOKG + (size_t)M * 8;
constexpr size_t WS_SLOTGATE = WS_SLOTTOK + (size_t)MAXP * 256 * 4;
constexpr size_t WS_PARTQA = 976 * MiB, WS_PART1 = 980 * MiB, WS_PART2 = 984 * MiB;
constexpr size_t WS_TOKRSTD = 4 * MiB;
constexpr size_t WS_SLOTRSTD = WS_TOKRSTD + (size_t)M * 4;
static_assert(WS_SLOTGATE + (size_t)MAXP * 256 * 4 <= WS_TOKRSTD && WS_SLOTRSTD + (size_t)MAXP * 256 * 4 <= 8 * MiB, "small arrays");
constexpr size_t WS_W = 8 * MiB;
constexpr size_t WS_WA = WS_W, WS_WUQ = WS_WA + (size_t)NA * D * 2, WS_WUKV = WS_WUQ + (size_t)1536 * QLORA * 2, WS_WO = WS_WUKV + (size_t)2048 * KVLORA * 2;
constexpr size_t WS_WF1 = WS_WO + (size_t)D * D * 2, WS_WF2 = WS_WF1 + (size_t)2 * FF * D * 2, WS_WKVQ = WS_WF2 + (size_t)D * FF * 2, WS_WBO = WS_WKVQ + (size_t)3 * D * D * 2;
constexpr size_t WS_WM1 = WS_WBO + (size_t)D * D * 2, WS_WM2 = WS_WM1 + (size_t)NE * 2 * EFF * D * 2, WS_WEND = WS_WM2 + (size_t)NE * D * EFF * 2;
constexpr size_t ARENA = 208 * MiB;
static_assert(WS_WEND <= ARENA, "weights fit under the arena");
constexpr size_t WS_XN = ARENA;
constexpr size_t WS_QA = ARENA + 128 * MiB;
constexpr size_t WS_Q = ARENA + 224 * MiB;
constexpr size_t WS_K = ARENA + 416 * MiB;
constexpr size_t WS_V = ARENA + 608 * MiB;
constexpr size_t WS_O = ARENA;
static_assert(WS_V + (size_t)M * D * 2 <= 1024 * MiB, "MLA arena");
constexpr size_t WS_XR1 = ARENA + 128 * MiB;
constexpr size_t WS_H = ARENA + 256 * MiB;
constexpr size_t WS_XR2 = ARENA;
constexpr size_t WS_X2B = ARENA + 608 * MiB;
constexpr size_t WS_KVQ2 = ARENA + 128 * MiB;
constexpr size_t WS_O2 = ARENA + 512 * MiB;
constexpr size_t WS_XR3 = ARENA + 132 * MiB;
constexpr size_t WS_XG = ARENA;
constexpr size_t WS_HM = ARENA + 264 * MiB;
constexpr size_t WS_END = WS_HM + (size_t)MAXP_HALF * 256 * EFF * 2;
static_assert(WS_XG + (size_t)MAXP * 256 * D <= WS_XR3 && WS_XR3 + (size_t)M * D * 2 <= WS_HM && WS_END <= 1024 * MiB && WS_H + (size_t)M * FF * 2 <= WS_X2B && WS_X2B + (size_t)M * D * 2 <= 976 * MiB && WS_O2 + (size_t)M * D <= WS_X2B, "arena");
constexpr int CW_BAR = 4096;
constexpr int RING_OFF = 0, RING_BYTES = 131072;
constexpr int P0_SCR = 128 * 33 * 4;
constexpr int LDSCTL_OFF = 8 * P0_SCR, MISC_OFF = LDSCTL_OFF + 320;
static_assert(LDSCTL_OFF >= RING_BYTES, "control words above every phase's scratch");
constexpr int LDS_BYTES = 147456;
static_assert(MISC_OFF + 128 <= LDS_BYTES, "LDS map");
static_assert(att::lds_bytes<96>() <= RING_BYTES, "attention scratch fits the ring region");

#define GAS __attribute__((address_space(1)))
#define LAS __attribute__((address_space(3)))
typedef unsigned short bf16;
typedef unsigned v4u __attribute__((ext_vector_type(4)));
typedef unsigned v2u __attribute__((ext_vector_type(2)));
typedef float f32x4 __attribute__((ext_vector_type(4)));
typedef GAS unsigned gu32;
#define RLX_AGENT __ATOMIC_RELAXED, __HIP_MEMORY_SCOPE_AGENT
#define LDS_WAIT() asm volatile("s_waitcnt lgkmcnt(0)" ::: "memory")
__device__ __forceinline__ unsigned f2bf(float f) { unsigned u = __builtin_bit_cast(unsigned, f); return (u + 0x7fffu + ((u >> 16) & 1u)) >> 16; }
__device__ __forceinline__ unsigned pk2(float lo, float hi) { return f2bf(lo) | (f2bf(hi) << 16); }
__device__ __forceinline__ float bflo(unsigned u) { return __builtin_bit_cast(float, u << 16); }
__device__ __forceinline__ float bfhi(unsigned u) { return __builtin_bit_cast(float, u & 0xffff0000u); }
__device__ __forceinline__ float wave_sum(float v) {
    v += swz_xor<1>(v); v += swz_xor<2>(v); v += swz_xor<4>(v); v += swz_xor<8>(v); v += swz_xor<16>(v);
    return xor32_sum(v);
}
__device__ __forceinline__ float wave_maxf(float v) {
    v = fmaxf(v, swz_xor<1>(v)); v = fmaxf(v, swz_xor<2>(v)); v = fmaxf(v, swz_xor<4>(v)); v = fmaxf(v, swz_xor<8>(v)); v = fmaxf(v, swz_xor<16>(v));
    return xor32_max(v);
}

#define XB_TMO      128
#define XB_XCNT(j)  (256  + 64 * (j))
#define XB_XSUB(j)  (1280 + 64 * (j))
#define XB_XGEN(j)  (2304 + 64 * (j))
#define XB_TOP      3328
#define XB_TOPGEN   3392
#define XCD_BAR_WORDS 3456
#define XB_SPIN_CAP (1u << 18)

__device__ __forceinline__ unsigned xb_ld(unsigned* p)              { return __hip_atomic_load(p, __ATOMIC_RELAXED, __HIP_MEMORY_SCOPE_AGENT); }
__device__ __forceinline__ unsigned xb_add(unsigned* p, unsigned v) { return __hip_atomic_fetch_add(p, v, __ATOMIC_RELAXED, __HIP_MEMORY_SCOPE_AGENT); }
__device__ __forceinline__ unsigned xb_xcc_id() { return (unsigned)__builtin_amdgcn_s_getreg((3 << 11) | 20) & 0xFu; }
#define XB_SPIN(cond, bar) do { unsigned _sp = 0; while (cond) { __builtin_amdgcn_s_sleep(1); \
    if ((++_sp & 255u) == 0u) { if (xb_ld(&(bar)[XB_TMO])) break; if (_sp > XB_SPIN_CAP) { atomicAdd(&(bar)[XB_TMO], 1u); break; } } } } while (0)

struct XcdBarrier {
    int t0;
    unsigned* bar; unsigned x;
    volatile LAS unsigned* st;
};

__device__ __forceinline__ XcdBarrier xcd_barrier_post(unsigned* bar, volatile LAS unsigned* st, int t0) {
    XcdBarrier b; b.t0 = t0; b.bar = bar; b.x = xb_xcc_id(); b.st = st;
    if (b.t0) (void)xb_add(&bar[XB_XCNT(b.x)], 1u);
    return b;
}
__device__ __forceinline__ void xcd_barrier_complete(unsigned* bar, unsigned x, unsigned& nloc, unsigned& nx) {
    const unsigned G = gridDim.x * gridDim.y * gridDim.z;
    unsigned sum, cnt, mine, sp = 0u;
    for (;;) {
        sum = 0u; cnt = 0u; mine = 0u;
#pragma unroll
        for (unsigned j = 0; j < 16; ++j) { const unsigned c = xb_ld(&bar[XB_XCNT(j)]); sum += c; cnt += (c > 0u) ? 1u : 0u; mine = (j == x) ? c : mine; }
        if (sum == G) break;
        __builtin_amdgcn_s_sleep(1);
        if ((++sp & 255u) == 0u) { if (xb_ld(&bar[XB_TMO])) break; if (sp > XB_SPIN_CAP) { atomicAdd(&bar[XB_TMO], 1u); break; } }
    }
    nloc = mine > 0u ? mine : 1u; nx = cnt > 0u ? cnt : 1u;
}

__device__ __forceinline__ void xcd_barrier(const XcdBarrier& b) {
    asm volatile("s_waitcnt vmcnt(0)" ::: "memory");
    __syncthreads();
    if (b.t0) {
        unsigned* bar = b.bar;
        __builtin_amdgcn_s_waitcnt(0);
        unsigned nloc = b.st[0], nx = b.st[1];
        if (nloc == 0u) { xcd_barrier_complete(bar, b.x, nloc, nx); b.st[0] = nloc; b.st[1] = nx; }
        const unsigned old = xb_add(&bar[XB_XSUB(b.x)], 1u);
        const unsigned gen = old / nloc;
        if (old + 1u == (gen + 1u) * nloc) {
            __builtin_amdgcn_fence(__ATOMIC_RELEASE, "agent");
            asm volatile("s_waitcnt vmcnt(0)" ::: "memory");
            const unsigned og = xb_add(&bar[XB_TOP], 1u);
            const unsigned tg = og / nx;
            if (og + 1u == (tg + 1u) * nx) xb_add(&bar[XB_TOPGEN], 1u);
            else XB_SPIN(xb_ld(&bar[XB_TOPGEN]) == tg, bar);
            __builtin_amdgcn_fence(__ATOMIC_ACQUIRE, "agent");
            xb_add(&bar[XB_XGEN(b.x)], 1u);
            asm volatile("s_waitcnt vmcnt(0)" ::: "memory");
        } else {
            XB_SPIN(xb_ld(&bar[XB_XGEN(b.x)]) == gen, bar);
            __builtin_amdgcn_fence(__ATOMIC_ACQUIRE, "agent");
            asm volatile("s_waitcnt vmcnt(0)" ::: "memory");
        }
    }
    __syncthreads();
}

struct Args { const float* in[27]; float* out; unsigned char* ws; };
enum { I_X = 0, I_ATTN_NORM, I_FFN_NORM, I_A_WDQ, I_A_GCQ, I_A_WUQ, I_A_WDKV, I_A_GCKV, I_A_WUKV, I_A_GQN, I_A_GKN, I_A_WO, I_KV_NORM, I_KV_WK, I_KV_WV, I_KV_GKN,
       I_B_WQ, I_B_GQN, I_B_RELB, I_B_WO, I_FFN_W1, I_FFN_W3, I_FFN_W2, I_MOE_ROUTER, I_MOE_W1, I_MOE_W3, I_MOE_W2 };

struct Frame {
    LAS unsigned char* lds;
    int wave, vcu, G;
};
typedef const __attribute__((address_space(4))) Args* KArgs;
__device__ __forceinline__ KArgs kargs() { KArgs p = (KArgs)__builtin_amdgcn_kernarg_segment_ptr(); asm volatile("" : "+s"(p)); return p; }
#define INP(i) (kargs()->in[i])
#define OUTP (kargs()->out)
#define WSP (kargs()->ws)
__device__ __forceinline__ int fresh(int v) { asm volatile("" : "+v"(v)); return v; }

__device__ __forceinline__ void tr_item(const float* W, int ldw, int K, int k0, int nsrc0, const float* gain, bf16* WT, int drow0, LAS float* scr, int lane) {
    const int c4 = lane & 7, r = lane >> 3;
    const GAS float* src = (const GAS float*)W + (size_t)(k0 + r) * ldw + nsrc0 + 4 * c4;
    f32x4 v[16];
#pragma unroll
    for (int i = 0; i < 16; ++i) v[i] = *(const GAS f32x4*)(src + (size_t)(8 * i) * ldw);
    if (gain) {
#pragma unroll
        for (int i = 0; i < 16; ++i) v[i] = v[i] * gain[k0 + 8 * i + r];
    }
#pragma unroll
    for (int i = 0; i < 16; ++i) { LAS float* d = scr + (8 * i + r) * 33 + 4 * c4; d[0] = v[i].x; d[1] = v[i].y; d[2] = v[i].z; d[3] = v[i].w; }
    LDS_WAIT(); asm volatile("" ::: "memory");
    const int c16 = lane >> 2;
#pragma unroll
    for (int j = 0; j < 8; ++j) { const int n = (lane & 3) + 4 * j; const LAS float* sp = scr + (8 * c16) * 33 + n;
        v4u o; o.x = pk2(sp[0 * 33], sp[1 * 33]); o.y = pk2(sp[2 * 33], sp[3 * 33]); o.z = pk2(sp[4 * 33], sp[5 * 33]); o.w = pk2(sp[6 * 33], sp[7 * 33]);
        *(GAS v4u*)(WT + (size_t)(drow0 + n) * K + k0 + 8 * c16) = o; }
    LDS_WAIT(); asm volatile("" ::: "memory");
}
__device__ __forceinline__ void tr_plain(const float* W, int K, int N, const float* gain, bf16* WT, int drow_off, LAS float* scr, int item, int lane) {
    const int nblk = N / 32, kb = item / nblk, nb = item % nblk;
    tr_item(W, N, K, 128 * kb, 32 * nb, gain, WT, drow_off + 32 * nb, scr, lane);
}
__device__ __forceinline__ void tr_gated(const float* W, int K, int N, const float* gain, bf16* WT, int half, LAS float* scr, int item, int lane) {
    const int nblk = N / 32, kb = item / nblk, nb = item % nblk, n0 = 32 * nb;
    tr_item(W, N, K, 128 * kb, n0, gain, WT, (n0 >> 7) * 256 + half * 128 + (n0 & 127), scr, lane);
}
__device__ __forceinline__ unsigned pk_fp8x4(float a, float b, float c, float d) { int w = 0; w = __builtin_amdgcn_cvt_pk_fp8_f32(a, b, w, false); w = __builtin_amdgcn_cvt_pk_fp8_f32(c, d, w, true); return (unsigned)w; }
__device__ __forceinline__ void tr_item_f8(const float* W, int ldw, int K, int k0, int nsrc0, const float* gain, unsigned char* WT, int drow0, LAS float* scr, int lane) {
    const int c4 = lane & 7, r = lane >> 3;
    const GAS float* src = (const GAS float*)W + (size_t)(k0 + r) * ldw + nsrc0 + 4 * c4;
    f32x4 v[16];
#pragma unroll
    for (int i = 0; i < 16; ++i) v[i] = *(const GAS f32x4*)(src + (size_t)(8 * i) * ldw);
#pragma unroll
    for (int i = 0; i < 16; ++i) v[i] = v[i] * (gain ? gain[k0 + 8 * i + r] * 64.f : 64.f);
#pragma unroll
    for (int i = 0; i < 16; ++i) { LAS float* d = scr + (8 * i + r) * 33 + 4 * c4; d[0] = v[i].x; d[1] = v[i].y; d[2] = v[i].z; d[3] = v[i].w; }
    LDS_WAIT(); asm volatile("" ::: "memory");
    const int c8 = lane >> 3;
#pragma unroll
    for (int j = 0; j < 4; ++j) { const int n = (lane & 7) + 8 * j; const LAS float* sp = scr + (16 * c8) * 33 + n;
        v4u o; o.x = pk_fp8x4(sp[0 * 33], sp[1 * 33], sp[2 * 33], sp[3 * 33]); o.y = pk_fp8x4(sp[4 * 33], sp[5 * 33], sp[6 * 33], sp[7 * 33]);
        o.z = pk_fp8x4(sp[8 * 33], sp[9 * 33], sp[10 * 33], sp[11 * 33]); o.w = pk_fp8x4(sp[12 * 33], sp[13 * 33], sp[14 * 33], sp[15 * 33]);
        *(GAS v4u*)(WT + (size_t)(drow0 + n) * K + k0 + 16 * c8) = o; }
    LDS_WAIT(); asm volatile("" ::: "memory");
}
__device__ __forceinline__ float rms_row_to_bf16(const float* xrow, bf16* orow, int lane, f32x4 (&v)[4]) {
    const GAS f32x4* xr = (const GAS f32x4*)xrow + lane;
    float s = 0.f;
#pragma unroll
    for (int j = 0; j < 4; ++j) { v[j] = xr[64 * j]; s += (v[j].x * v[j].x + v[j].y * v[j].y) + (v[j].z * v[j].z + v[j].w * v[j].w); }
    const float rstd = 1.f / sqrtf(wave_sum(s) * (1.f / D) + EPS);
    GAS unsigned long long* o8 = (GAS unsigned long long*)orow + lane;
#pragma unroll
    for (int j = 0; j < 4; ++j) o8[64 * j] = (unsigned long long)pk2(v[j].x * rstd, v[j].y * rstd) | ((unsigned long long)pk2(v[j].z * rstd, v[j].w * rstd) << 32);
    return rstd;
}
__device__ __forceinline__ void norm_phase(const Frame& F, const float* x, bf16* xn) {
    const int tid = fresh(F.wave * 64 + lane_id_()), lane = tid & 63; (void)lane;
    const int gw = F.vcu * NWAVES + F.wave, NGW = F.G * NWAVES;
    for (int m = 2 * gw; m < M; m += 2 * NGW) {
        const GAS f32x4* xr = (const GAS f32x4*)(x + (size_t)m * D) + lane;
        f32x4 v[8]; float s0 = 0.f, s1 = 0.f;
#pragma unroll
        for (int j = 0; j < 8; ++j) v[j] = xr[64 * j];
#pragma unroll
        for (int j = 0; j < 4; ++j) { s0 += (v[j].x * v[j].x + v[j].y * v[j].y) + (v[j].z * v[j].z + v[j].w * v[j].w); s1 += (v[4 + j].x * v[4 + j].x + v[4 + j].y * v[4 + j].y) + (v[4 + j].z * v[4 + j].z + v[4 + j].w * v[4 + j].w); }
        const float r0 = 1.f / sqrtf(wave_sum(s0) * (1.f / D) + EPS), r1 = 1.f / sqrtf(wave_sum(s1) * (1.f / D) + EPS);
        GAS unsigned* o4 = (GAS unsigned*)((GAS unsigned char*)xn + (size_t)m * D) + lane;
#pragma unroll
        for (int j = 0; j < 8; ++j) { const float rr = j < 4 ? r0 : r1; o4[64 * j] = pk_fp8x4(v[j].x * rr, v[j].y * rr, v[j].z * rr, v[j].w * rr); }
    }
}

__device__ __forceinline__ void p0_prologue(const Frame& F) {
    const int tid = fresh(F.wave * 64 + lane_id_()), lane = tid & 63; (void)lane;
    LAS float* scr = (LAS float*)(F.lds + RING_OFF + F.wave * P0_SCR);
    unsigned char* ws = WSP;
    const int gw = F.vcu * NWAVES + F.wave, NGW = F.G * NWAVES;
    constexpr int I_DQ = 8 * 12, I_DKV = 8 * 9, I_UQ = 3 * 48, I_UKV = 2 * 64, I_SQ = 8 * 32, I_F13 = 8 * 88, I_F2 = 22 * 32, I_M13 = 8 * 112, I_M2 = 28 * 32;
    constexpr int NSMALL = I_DQ + I_DKV + I_UQ + I_UKV + I_SQ + 2 * I_F13 + I_F2 + 4 * I_SQ;
    constexpr int NITEMS = NSMALL + NE * (2 * I_M13 + I_M2);
    for (int it = gw; it < NITEMS; it += NGW) {
        int r = it;
        if (r < I_DQ)  { const int kb = r / 12, n0 = 32 * (r % 12); tr_item_f8(INP(I_A_WDQ), QLORA, D, 128 * kb, n0, INP(I_ATTN_NORM), ws + WS_WA, n0, scr, lane); continue; } r -= I_DQ;
        if (r < I_DKV) { const int kb = r / 9, n0 = 32 * (r % 9); tr_item_f8(INP(I_A_WDKV), KVLORA + ROPE_D, D, 128 * kb, n0, INP(I_ATTN_NORM), ws + WS_WA, QLORA + n0, scr, lane); continue; } r -= I_DKV;
        if (r < I_UQ)  { tr_plain(INP(I_A_WUQ), QLORA, NH * QKD, INP(I_A_GCQ), (bf16*)(ws + WS_WUQ), 0, scr, r, lane); continue; } r -= I_UQ;
        if (r < I_UKV) { const int kb = r / 64, n0 = 32 * (r % 64), head = n0 >> 7, within = n0 & 127;
            const int drow = within < 64 ? 256 * (head >> 2) + 128 * (within >> 5) + 32 * (head & 3) : 1024 + head * 64 + (within - 64);
            tr_item(INP(I_A_WUKV), NH * 128, KVLORA, 128 * kb, n0, INP(I_A_GCKV), (bf16*)(ws + WS_WUKV), drow, scr, lane); continue; } r -= I_UKV;
        if (r < I_SQ)  { const int kb = r / 32, n0 = 32 * (r % 32); tr_item_f8(INP(I_A_WO), D, D, 128 * kb, n0, nullptr, ws + WS_WO, n0, scr, lane); continue; } r -= I_SQ;
        if (r < I_F13) { tr_gated(INP(I_FFN_W1), D, FF, INP(I_FFN_NORM), (bf16*)(ws + WS_WF1), 0, scr, r, lane); continue; } r -= I_F13;
        if (r < I_F13) { tr_gated(INP(I_FFN_W3), D, FF, INP(I_FFN_NORM), (bf16*)(ws + WS_WF1), 1, scr, r, lane); continue; } r -= I_F13;
        if (r < I_F2)  { tr_plain(INP(I_FFN_W2), FF, D, nullptr, (bf16*)(ws + WS_WF2), 0, scr, r, lane); continue; } r -= I_F2;
        if (r < I_SQ)  { const int kb = r / 32, n0 = 32 * (r % 32), head = n0 >> 6;
            tr_item_f8(INP(I_KV_WK), D, D, 128 * kb, n0, INP(I_KV_NORM), ws + WS_WKVQ, 256 * (head >> 2) + 128 * ((n0 >> 5) & 1) + 32 * (head & 3), scr, lane); continue; } r -= I_SQ;
        if (r < I_SQ)  { const int kb = r / 32, n0 = 32 * (r % 32); tr_item_f8(INP(I_KV_WV), D, D, 128 * kb, n0, INP(I_KV_NORM), ws + WS_WKVQ, 2 * D + n0, scr, lane); continue; } r -= I_SQ;
        if (r < I_SQ)  { const int kb = r / 32, n0 = 32 * (r % 32), head = n0 >> 6;
            tr_item_f8(INP(I_B_WQ), D, D, 128 * kb, n0, INP(I_ATTN_NORM) + D, ws + WS_WKVQ, D + 256 * (head >> 2) + 128 * ((n0 >> 5) & 1) + 32 * (head & 3), scr, lane); continue; } r -= I_SQ;
        if (r < I_SQ)  { const int kb = r / 32, n0 = 32 * (r % 32); tr_item_f8(INP(I_B_WO), D, D, 128 * kb, n0, nullptr, ws + WS_WBO, n0, scr, lane); continue; } r -= I_SQ;
        const int e = r / (2 * I_M13 + I_M2); r -= e * (2 * I_M13 + I_M2);
        if (r < I_M13) { const int kb = r / 112, n0 = 32 * (r % 112);
            tr_item_f8(INP(I_MOE_W1) + (size_t)e * D * EFF, EFF, D, 128 * kb, n0, INP(I_FFN_NORM) + D, ws + WS_WM1 + (size_t)e * 2 * EFF * D, (n0 >> 7) * 256 + (n0 & 127), scr, lane); continue; } r -= I_M13;
        if (r < I_M13) { const int kb = r / 112, n0 = 32 * (r % 112);
            tr_item_f8(INP(I_MOE_W3) + (size_t)e * D * EFF, EFF, D, 128 * kb, n0, INP(I_FFN_NORM) + D, ws + WS_WM1 + (size_t)e * 2 * EFF * D, (n0 >> 7) * 256 + 128 + (n0 & 127), scr, lane); continue; } r -= I_M13;
        { const int kb = r / 32, n0 = 32 * (r % 32); tr_item_f8(INP(I_MOE_W2) + (size_t)e * EFF * D, D, EFF, 128 * kb, n0, nullptr, ws + WS_WM2 + (size_t)e * D * EFF, n0, scr, lane); }
    }
    const int gt = F.vcu * (NWAVES * 64) + tid, NGT = F.G * NWAVES * 64;
    for (int c = gt; c < 96 * D / 16; c += NGT) *((GAS v4u*)(ws + WS_WA + (size_t)(QLORA + KVLORA + ROPE_D) * D) + c) = (v4u){0u, 0u, 0u, 0u};
    for (int c = gt; c < SEQ * 16; c += NGT) { const int pos = c >> 4, i = c & 15;
        const float inv = __builtin_amdgcn_exp2f(-(float)i * (13.287712379549449f / 16.f));
        const float rev = (float)pos * inv * 0.15915494309189535f; const float fr = rev - floorf(rev);
        ((GAS float*)(ws + WS_ROPE))[2 * c] = __builtin_amdgcn_cosf(fr); ((GAS float*)(ws + WS_ROPE))[2 * c + 1] = __builtin_amdgcn_sinf(fr); }
    norm_phase(F, INP(I_X), (bf16*)(ws + WS_XN));
}

__device__ __forceinline__ void route_phase(const Frame& F) {
    const int tid = fresh(F.wave * 64 + lane_id_()), lane = tid & 63;
    unsigned char* ws = WSP;
    LAS float* wrg = (LAS float*)(F.lds + RING_OFF);
    LAS int* cnt = (LAS int*)(F.lds + RING_OFF + 32768);
    const float* wr = INP(I_MOE_ROUTER); const float* g = INP(I_FFN_NORM) + D;
    for (int idx = tid; idx < D * NE; idx += NWAVES * 64) { const int k = idx >> 3, e = idx & 7, l = k >> 4, i = k & 15;
        wrg[((i * 2) + (e >> 2)) * 256 + 4 * l + (e & 3)] = wr[idx] * g[k]; }
    __syncthreads();
    const int b5 = (lane >> 5) & 1, b4 = (lane >> 4) & 1, b3 = (lane >> 3) & 1;
    for (int c = F.vcu; c < M / 256; c += F.G) {
        if (tid < 16) cnt[tid] = 0;
        __syncthreads();
        v4u vn[2];
        { const GAS v4u* xr = (const GAS v4u*)(ws + WS_XR3 + (size_t)(c * 256 + F.wave * 32) * D * 2) + 2 * lane; vn[0] = xr[0]; vn[1] = xr[1]; }
        for (int i = 0; i < 32; ++i) {
            const int m = c * 256 + F.wave * 32 + i;
            const v4u q0 = vn[0], q1 = vn[1];
            if (i + 1 < 32) { const GAS v4u* xr = (const GAS v4u*)(ws + WS_XR3 + (size_t)(m + 1) * D * 2) + 2 * lane; vn[0] = xr[0]; vn[1] = xr[1]; }
            const unsigned qw[8] = {q0.x, q0.y, q0.z, q0.w, q1.x, q1.y, q1.z, q1.w};
            float xv[16]; float ssx = 0.f;
#pragma unroll
            for (int j = 0; j < 8; ++j) { xv[2 * j] = bflo(qw[j]); xv[2 * j + 1] = bfhi(qw[j]); }
#pragma unroll
            for (int j = 0; j < 16; j += 4) ssx += (xv[j] * xv[j] + xv[j + 1] * xv[j + 1]) + (xv[j + 2] * xv[j + 2] + xv[j + 3] * xv[j + 3]);
            float lg[8];
#pragma unroll
            for (int e = 0; e < 8; ++e) lg[e] = 0.f;
#pragma unroll
            for (int j = 0; j < 16; ++j) { const float x1 = xv[j];
                const f32x4 w0 = *(const LAS f32x4*)(wrg + (j * 2) * 256 + 4 * lane), w1 = *(const LAS f32x4*)(wrg + (j * 2 + 1) * 256 + 4 * lane);
                lg[0] += x1 * w0.x; lg[1] += x1 * w0.y; lg[2] += x1 * w0.z; lg[3] += x1 * w0.w; lg[4] += x1 * w1.x; lg[5] += x1 * w1.y; lg[6] += x1 * w1.z; lg[7] += x1 * w1.w; }
            float r4[4], r2[2], r1;
#pragma unroll
            for (int e = 0; e < 4; ++e) { const float mine = b5 ? lg[4 + e] : lg[e], other = b5 ? lg[e] : lg[4 + e]; r4[e] = mine + xor32_partner(other, b5); }
#pragma unroll
            for (int e = 0; e < 2; ++e) { const float mine = b4 ? r4[2 + e] : r4[e], other = b4 ? r4[e] : r4[2 + e]; r2[e] = mine + swz_xor<16>(other); }
            { const float mine = b3 ? r2[1] : r2[0], other = b3 ? r2[0] : r2[1]; r1 = mine + swz_xor<8>(other); }
            r1 += swz_xor<4>(r1); r1 += swz_xor<2>(r1); r1 += swz_xor<1>(r1);
            const float rstd = 1.f / sqrtf(wave_sum(ssx) * (1.f / D) + EPS);
#pragma unroll
            for (int e = 0; e < 8; ++e) lg[e] = __builtin_bit_cast(float, __builtin_amdgcn_readlane(__builtin_bit_cast(int, r1), 8 * e)) * rstd;
            int e1 = 0; float l1 = lg[0];
#pragma unroll
            for (int e = 1; e < 8; ++e) if (lg[e] > l1) { l1 = lg[e]; e1 = e; }
            int e2 = -1; float l2 = -INFINITY;
#pragma unroll
            for (int e = 0; e < 8; ++e) if (e != e1 && lg[e] > l2) { l2 = lg[e]; e2 = e; }
            const float g1 = 1.f / (1.f + __expf(l2 - l1)), g2 = 1.f - g1;
            const int elo = e1 < e2 ? e1 : e2, ehi = e1 < e2 ? e2 : e1;
            const float glo = e1 < e2 ? g1 : g2, ghi = e1 < e2 ? g2 : g1;
            if (lane == 0) { ((GAS float*)(ws + WS_TOKRSTD))[m] = rstd; ((GAS int*)(ws + WS_TOKE))[m] = elo | (ehi << 8); ((GAS float*)(ws + WS_TOKG))[2 * m] = glo; ((GAS float*)(ws + WS_TOKG))[2 * m + 1] = ghi;
                atomicAdd((int*)&cnt[elo], 1); atomicAdd((int*)&cnt[8 + ehi], 1); }
        }
        __syncthreads();
        if (tid < 16) ((GAS int*)(ws + WS_CNT))[c * 16 + tid] = cnt[tid];
        __syncthreads();
    }
}

__device__ __forceinline__ void slot_phase(const Frame& F, unsigned char* ws) {
    const int tid = fresh(F.wave * 64 + lane_id_()), lane = tid & 63; (void)lane;
    LAS int* call = (LAS int*)(F.lds + RING_OFF);
    LAS int* tot = call + 4096; LAS int* base = tot + 16; LAS int* pre = base + 16; LAS int* meta = pre + 16;
    LAS int* grp = meta + 16;
    LAS int* slot_of = grp + 512;
    for (int idx = tid; idx < 4096; idx += NWAVES * 64) call[idx] = ((const GAS int*)(ws + WS_CNT))[idx];
    __syncthreads();
    if (tid < 16) { int t = 0; for (int cc = 0; cc < 256; ++cc) t += call[cc * 16 + tid]; tot[tid] = t; }
    __syncthreads();
    if (tid == 0) { int off = 0; for (int g = 0; g < 16; ++g) { base[g] = off; off += (tot[g] + 255) & ~255; if (g == 7) meta[0] = off >> 8; } meta[1] = (off >> 8) - meta[0]; }
    __syncthreads();
    for (int c = F.vcu; c < M / 256; c += F.G) {
        if (tid < 16) { int p = 0; for (int cc = 0; cc < c; ++cc) p += call[cc * 16 + tid]; pre[tid] = p; }
        const int hf = tid >> 8, i = tid & 255, m = c * 256 + i;
        const int te = ((const GAS int*)(ws + WS_TOKE))[m];
        const int g = hf * 8 + (hf ? ((te >> 8) & 0xff) : (te & 0xff));
        grp[tid] = g;
        __syncthreads();
        int rank = 0;
        for (int j = 0; j < i; ++j) rank += (grp[hf * 256 + j] == g) ? 1 : 0;
        const int slot = base[g] + pre[g] + rank;
        ((GAS int*)(ws + WS_SLOTTOK))[slot] = m; ((GAS float*)(ws + WS_SLOTGATE))[slot] = ((const GAS float*)(ws + WS_TOKG))[2 * m + hf];
        slot_of[tid] = slot;
        __syncthreads();
        for (int i0 = F.wave; i0 < 256; i0 += 4 * NWAVES) {
            v4u x[4][2]; float rs[4];
#pragma unroll
            for (int k = 0; k < 4; ++k) { const int mm = c * 256 + i0 + 8 * k; const GAS v4u* src = (const GAS v4u*)(ws + WS_XR3 + (size_t)mm * D * 2);
                x[k][0] = src[2 * lane]; x[k][1] = src[2 * lane + 1]; rs[k] = ((const GAS float*)(ws + WS_TOKRSTD))[mm]; }
#pragma unroll
            for (int k = 0; k < 4; ++k) { const int i = i0 + 8 * k; const v4u x0 = x[k][0], x1 = x[k][1]; const float r = rs[k];
                const v4u o = (v4u){pk_fp8x4(bflo(x0.x) * r, bfhi(x0.x) * r, bflo(x0.y) * r, bfhi(x0.y) * r), pk_fp8x4(bflo(x0.z) * r, bfhi(x0.z) * r, bflo(x0.w) * r, bfhi(x0.w) * r),
                                    pk_fp8x4(bflo(x1.x) * r, bfhi(x1.x) * r, bflo(x1.y) * r, bfhi(x1.y) * r), pk_fp8x4(bflo(x1.z) * r, bfhi(x1.z) * r, bflo(x1.w) * r, bfhi(x1.w) * r)};
                ((GAS v4u*)(ws + WS_XG + (size_t)slot_of[i] * D))[lane] = o; ((GAS v4u*)(ws + WS_XG + (size_t)slot_of[256 + i] * D))[lane] = o; }
        }
        __syncthreads();
    }
    for (int g = F.vcu; g < 16; g += F.G) {
        const int s0 = base[g] + tot[g], s1 = base[g] + ((tot[g] + 255) & ~255);
        for (int s = s0 + F.wave; s < s1; s += NWAVES) { GAS v4u* dst = (GAS v4u*)(ws + WS_XG + (size_t)s * D);
            dst[lane] = (v4u){0u, 0u, 0u, 0u};
            if (lane == 0) { ((GAS int*)(ws + WS_SLOTTOK))[s] = -1; ((GAS float*)(ws + WS_SLOTGATE))[s] = 0.f; } }
    }
    if (F.vcu == 0) {
        if (tid < 16) { const int p0 = base[tid] >> 8, p1 = (base[tid] + ((tot[tid] + 255) & ~255)) >> 8; for (int p = p0; p < p1; ++p) ((GAS int*)(ws + WS_PANELE))[p] = tid & 7; }
        if (tid == 0) { ((GAS int*)(ws + WS_META))[0] = meta[0]; ((GAS int*)(ws + WS_META))[1] = meta[1]; }
        if (tid < 16) ((GAS int*)(ws + WS_META))[2 + tid] = base[tid] >> 8;
        if (tid == 0) { const int nPA = meta[0], nPB = meta[1]; int x = nPB > 256 ? nPB - 256 : 0;
            if (x > 0 && nPA > 256) { int LA = 0, HB = 7;
                for (int g = 0; g < 8; ++g) { const int q0 = base[g] >> 8, q1 = q0 + ((tot[g] + 255) >> 8); if (q0 <= 256 && 256 < q1) LA = g; }
                for (int g = 8; g < 16; ++g) { const int q0 = base[g] >> 8, q1 = q0 + ((tot[g] + 255) >> 8), P = nPA + x - 1; if (q0 <= P && P < q1) HB = g - 8; }
                if (LA < HB) x = 0; }
            ((GAS int*)(ws + WS_META))[18] = x; }
    }
    __syncthreads();
}

__global__ void __launch_bounds__(NWAVES * 64, 2) yoco_fwd(Args args) {
    extern __shared__ __attribute__((aligned(16))) unsigned char lds_raw[];
    Frame F;
    F.lds = (LAS unsigned char*)lds_raw;
    F.wave = __builtin_amdgcn_readfirstlane((int)threadIdx.x >> 6);
    F.G = gridDim.x; { const int bx = blockIdx.x; F.vcu = (F.G % 8 == 0) ? (bx % 8) * (F.G / 8) + bx / 8 : bx; }
    unsigned char* ws = WSP;
    volatile LAS unsigned* MISC = (volatile LAS unsigned*)(F.lds + MISC_OFF);
    for (int u = fresh((int)threadIdx.x); u < (LDS_BYTES - LDSCTL_OFF) / 4; u += NWAVES * 64) ((LAS unsigned*)(F.lds + LDSCTL_OFF))[u] = 0u;
    __syncthreads();
    (void)xcd_barrier_post((unsigned*)(ws + WS_CTL) + CW_BAR, MISC + 8, (F.wave == 0 && lane_id_() == 0) ? 1 : 0);
    LAS unsigned char* ring = F.lds + RING_OFF;
#define bid ((int)blockIdx.x)
#define GRID_BAR() do { XcdBarrier b_; b_.t0 = (F.wave == 0 && lane_id_() == 0) ? 1 : 0; b_.bar = (unsigned*)(WSP + WS_CTL) + CW_BAR; b_.x = xb_xcc_id(); b_.st = (volatile LAS unsigned*)(F.lds + MISC_OFF) + 8; xcd_barrier(b_); } while (0)
#define GEMM(EpiT, SchedT) pg8::gemm_phase<EpiT, SchedT, true, true>

    p0_prologue(F);
    GRID_BAR();
    { pg8::Gemm g{(const bf16*)(ws + WS_XN), (const bf16*)(ws + WS_WA), M, NA, D / 2, D / 2}; pg8::StaticOrder S; S.init(M, NA, F.G, bid);
      pg8::EpiQA E{(bf16*)(ws + WS_QA), (float*)(ws + WS_PARTQA), 1.f / 64};
      pg8::gemm_phase<pg8::EpiQA, pg8::StaticOrder, true, true, true>(ring, g, S, E, F.wave); }
    GRID_BAR();
    { pg8::Gemm g{(const bf16*)(ws + WS_QA), (const bf16*)(ws + WS_WUQ), M, NH * QKD, QLORA, NA}; pg8::StaticOrder S; S.init(M, NH * QKD, F.G, bid);
      pg8::EpiRowScaleBf16 E{(bf16*)(ws + WS_Q), NH * QKD, (const float*)(ws + WS_PARTQA), 1.f / QLORA};
      GEMM(pg8::EpiRowScaleBf16, pg8::StaticOrder)(ring, g, S, E, F.wave); }
    { pg8::Gemm g{(const bf16*)(ws + WS_QA) + QLORA, (const bf16*)(ws + WS_WUKV), M, NH * 128, KVLORA, NA}; pg8::StaticOrder S; S.init(M, NH * 128, F.G, bid);
      pg8::EpiKVup E{(bf16*)(ws + WS_K), (bf16*)(ws + WS_V), (const float*)(ws + WS_PARTQA), (const bf16*)(ws + WS_QA), INP(I_A_GKN), (const float*)(ws + WS_ROPE)};
      GEMM(pg8::EpiKVup, pg8::StaticOrder)(ring, g, S, E, F.wave); }
    GRID_BAR();
    bool fastA;
    { float bq = 0.f, bk = 0.f; const int l_ = lane_id_(); for (int i = l_; i < QKD; i += 64) { bq = fmaxf(bq, fabsf(INP(I_A_GQN)[i])); bk = fmaxf(bk, fabsf(INP(I_A_GKN)[i])); }
      bq = wave_maxf(bq); bk = wave_maxf(bk); fastA = __builtin_amdgcn_readfirstlane((int)(14.42f * bq * bk <= 40.f)) != 0; }
#define P5_UNIT(NM) att::attn_unit<96, false, 1536, 1536, D, D, true, NM, 2>(ring, (const bf16*)(ws + WS_Q) + (size_t)b * SEQ * 1536 + h * QKD, (const bf16*)(ws + WS_K) + (size_t)b * SEQ * 1536 + h * QKD, \
                                      (const bf16*)(ws + WS_V) + (size_t)b * SEQ * D + h * 64, (bf16*)(ws + WS_O + (size_t)b * SEQ * D + h * 64), \
                                      256 * qb, 0, 4 * qb + 3, 0, 4 * qb + (F.wave >> 1), 0, nullptr, INP(I_A_GQN), (const float*)(ws + WS_ROPE), F.wave, true, qfA, false, false, \
                                      (const bf16*)(ws + WS_Q) + (size_t)bn * SEQ * 1536 + hh * QKD + (size_t)(256 * qbn) * 1536)
    att::attn_init<96, 1536, D, 2>(ring, F.wave);
    att::bf16x8 qfA[6]; bool qldA = false;
    for (int p = F.vcu; p < BATCH * NH * 4; p += F.G) {
        const int bh = p >> 2, pid = p & 3, b = bh >> 4, h = bh & 15;
        for (int u2 = 0; u2 < 2; ++u2) {
            const int qb = u2 ? 7 - pid : pid;
            const int pn = u2 ? p + F.G : p; const bool hn = pn < BATCH * NH * 4;
            const int bhn = pn >> 2, pidn = pn & 3, bn = bhn >> 4, hh = bhn & 15, qbn = u2 ? pidn : 7 - pidn;
            if (fastA) P5_UNIT(true); else P5_UNIT(false);
        }
    }
    GRID_BAR();
    { pg8::Gemm g{(const bf16*)(ws + WS_O), (const bf16*)(ws + WS_WO), M, D, D / 2, D / 2}; pg8::StaticOrder S; S.init(M, D, F.G, bid);
      pg8::EpiResStream<true, false, false> E{INP(I_X), (bf16*)(ws + WS_XR1), nullptr, (float*)(ws + WS_PART1), 1.f / 2048};
      pg8::gemm_phase<pg8::EpiResStream<true, false, false>, pg8::StaticOrder, true, true, true>(ring, g, S, E, F.wave); }
    GRID_BAR();
    { pg8::Gemm g{(const bf16*)(ws + WS_XR1), (const bf16*)(ws + WS_WF1), M, 2 * FF, D, D}; pg8::StaticOrder S; S.init(M, 2 * FF, F.G, bid);
      pg8::EpiGated<true> E{(bf16*)(ws + WS_H), FF, 0, (const float*)(ws + WS_PART1)};
      GEMM(pg8::EpiGated<true>, pg8::StaticOrder)(ring, g, S, E, F.wave); }
    GRID_BAR();
    { pg8::Gemm g{(const bf16*)(ws + WS_H), (const bf16*)(ws + WS_WF2), M, D, FF, FF}; pg8::StaticOrder S; S.init(M, D, F.G, bid);
      pg8::EpiResStream<true, true, true> E{ws + WS_XR1, (bf16*)(ws + WS_X2B), ws + WS_XR2, (float*)(ws + WS_PART2), 1.f};
      pg8::gemm_phase<pg8::EpiResStream<true, true, true>, pg8::StaticOrder, true, true>(ring, g, S, E, F.wave); }
    GRID_BAR();
    { pg8::Gemm g{(const bf16*)(ws + WS_XR2), (const bf16*)(ws + WS_WKVQ), M, 2 * D, D / 2, D / 2}; pg8::StaticOrder S; S.init(M, 2 * D, F.G, bid);
      pg8::EpiK2Q2 E{(bf16*)(ws + WS_KVQ2), (const float*)(ws + WS_PART2), INP(I_KV_GKN), INP(I_B_GQN), 1.f / 64};
      pg8::gemm_phase<pg8::EpiK2Q2, pg8::StaticOrder, true, true, true>(ring, g, S, E, F.wave); }
    { pg8::Gemm g{(const bf16*)(ws + WS_XR2), (const bf16*)(ws + WS_WKVQ + (size_t)2 * D * D), M, D, D / 2, D / 2}; pg8::StaticOrder S; S.init(M, D, F.G, bid);
      pg8::EpiRowScale16 E{(bf16*)(ws + WS_KVQ2), 3 * D, D, (const float*)(ws + WS_PART2), 1.f / 64};
      pg8::gemm_phase<pg8::EpiRowScale16, pg8::StaticOrder, true, true, true>(ring, g, S, E, F.wave); }
    GRID_BAR();
    bool fastB;
    { float bq = 0.f, bk = 0.f, bb = 0.f; const int l_ = lane_id_(); bq = fabsf(INP(I_B_GQN)[l_]); bk = fabsf(INP(I_KV_GKN)[l_]);
      for (int i = l_; i < NH * 257; i += 64) bb = fmaxf(bb, fabsf(INP(I_B_RELB)[i]));
      bq = wave_maxf(bq); bk = wave_maxf(bk); bb = wave_maxf(bb); fastB = __builtin_amdgcn_readfirstlane((int)(11.78f * bq * bk + 1.4427f * bb <= 40.f)) != 0; }
    att::attn_init<64, 3072, 3072, 2>(ring, F.wave);
    att::bf16x8 qfB[4]; bool qldB = false;
    int last_h = -1;
    for (int p = F.vcu; p < BATCH * NH * 8; p += F.G) {
        const int bh = p >> 3, cb = ((p & 7) + (p >> 8)) & 7, b = bh >> 4, h = bh & 15;
        const bool ldb = h != last_h; last_h = h;
        const int pn = p + F.G; const bool hn = pn < BATCH * NH * 8; const int bhn = pn >> 3, cbn = ((pn & 7) + (pn >> 8)) & 7;
        const int c0 = 4 * cb, cc = c0 + (F.wave >> 1);
        const bf16* base = (const bf16*)(ws + WS_KVQ2) + (size_t)b * SEQ * 3072 + h * 64;
#define P13_UNIT(NM) att::attn_unit<64, true, 3072, 3072, 3072, D, true, NM, 2>(ring, base + 2048, base, base + 1024, (bf16*)(ws + WS_O2 + (size_t)b * SEQ * D + h * 64), \
                                 256 * cb, c0 - 8 < 0 ? 0 : c0 - 8, c0 + 3, cc - 8 < 0 ? 0 : cc - 8, cc, cc, INP(I_B_RELB) + h * 257, nullptr, nullptr, F.wave, ldb, qfB, qldB, hn, \
                                 (const bf16*)(ws + WS_KVQ2) + (size_t)(bhn >> 4) * SEQ * 3072 + (bhn & 15) * 64 + 2048 + (size_t)(256 * cbn) * 3072)
        if (fastB) P13_UNIT(true); else P13_UNIT(false);
        qldB = hn;
    }
    GRID_BAR();
    { pg8::Gemm g{(const bf16*)(ws + WS_O2), (const bf16*)(ws + WS_WBO), M, D, D / 2, D / 2}; pg8::StaticOrder S; S.init(M, D, F.G, bid);
      pg8::EpiResStream<false, false, true> E{ws + WS_X2B, (bf16*)(ws + WS_XR3), nullptr, nullptr, 1.f / 2048};
      pg8::gemm_phase<pg8::EpiResStream<false, false, true>, pg8::StaticOrder, true, true, true>(ring, g, S, E, F.wave); }
    GRID_BAR();
    route_phase(F);
    GRID_BAR();
    slot_phase(F, ws);
    GRID_BAR();
#define MOE_LOAD(hf_) unsigned char* w2 = WSP; \
          const int nPA = __builtin_amdgcn_readfirstlane(((const GAS int*)(w2 + WS_META))[0]), nPB = __builtin_amdgcn_readfirstlane(((const GAS int*)(w2 + WS_META))[1]); (void)nPB; \
          const int xB = __builtin_amdgcn_readfirstlane(((const GAS int*)(w2 + WS_META))[18]); (void)xB; \
          const int p0 = (hf_) ? nPA : 0; int pbk[7]; \
          _Pragma("unroll") for (int k = 0; k < 7; ++k) pbk[k] = __builtin_amdgcn_readfirstlane(((const GAS int*)(w2 + WS_META))[2 + (hf_) * 8 + 1 + k]) - p0;
    constexpr size_t HMB_OFF = (size_t)MAXP_HALF * 256 * EFF;
    { MOE_LOAD(0)
      pg8::Gemm g{(const bf16*)(w2 + WS_XG), (const bf16*)(w2 + WS_WM1), nPA * 256, 2 * EFF, D / 2, D / 2};
      pg8::MoeOrder S; S.init(nPA, 2 * EFF / 256, F.G, bid);
#pragma unroll
      for (int k = 0; k < 7; ++k) S.pb[k] = pbk[k];
      pg8::EpiGatedF8 E{w2 + WS_HM, EFF, 2 * EFF / 256};
      pg8::gemm_phase<pg8::EpiGatedF8, pg8::MoeOrder, true, true, true>(ring, g, S, E, F.wave); }
    { MOE_LOAD(1)
      pg8::Gemm g{(const bf16*)(w2 + WS_XG + (size_t)p0 * 256 * D), (const bf16*)(w2 + WS_WM1), xB * 256, 2 * EFF, D / 2, D / 2};
      pg8::MoeOrder S; S.init(xB, 2 * EFF / 256, F.G, bid); S.rot = (nPA * (2 * EFF / 256)) % F.G;
#pragma unroll
      for (int k = 0; k < 7; ++k) S.pb[k] = pbk[k];
      pg8::EpiGatedF8 E{w2 + WS_HM + HMB_OFF, EFF, 2 * EFF / 256};
      pg8::gemm_phase<pg8::EpiGatedF8, pg8::MoeOrder, true, true, true>(ring, g, S, E, F.wave); }
    GRID_BAR();
    { MOE_LOAD(0)
      pg8::Gemm g{(const bf16*)(w2 + WS_HM), (const bf16*)(w2 + WS_WM2), 256 * 256, D, EFF / 2, EFF / 2};
      pg8::MoeOrder S; S.init(256, D / 256, F.G, bid);
#pragma unroll
      for (int k = 0; k < 7; ++k) S.pb[k] = pbk[k];
      pg8::EpiMoeDown<true> E{nullptr, (bf16*)(w2 + WS_XR3), (const int*)(w2 + WS_SLOTTOK), (const float*)(w2 + WS_SLOTGATE), 0, D, 1.f / 64};
      pg8::gemm_phase<pg8::EpiMoeDown<true>, pg8::MoeOrder, true, true, true>(ring, g, S, E, F.wave); }
    GRID_BAR();
    { MOE_LOAD(0)
      pg8::Gemm g{(const bf16*)(w2 + WS_HM), (const bf16*)(w2 + WS_WM2), nPA * 256, D, EFF / 2, EFF / 2};
      pg8::LeftOrder S; S.M.init(nPA, D / 256, F.G, bid); S.nLeft = 4 * (nPA - 256); S.c0 = 0; S.pbase = 256;
#pragma unroll
      for (int k = 0; k < 7; ++k) S.M.pb[k] = pbk[k];
      pg8::EpiMoeDown<true> E{nullptr, (bf16*)(w2 + WS_XR3), (const int*)(w2 + WS_SLOTTOK), (const float*)(w2 + WS_SLOTGATE), 0, D, 1.f / 64};
      pg8::gemm_phase<pg8::EpiMoeDown<true>, pg8::LeftOrder, true, true, true>(ring, g, S, E, F.wave); }
    { MOE_LOAD(1)
      pg8::Gemm g{(const bf16*)(w2 + WS_HM + HMB_OFF), (const bf16*)(w2 + WS_WM2), xB * 256, D, EFF / 2, EFF / 2};
      pg8::LeftOrder S; S.M.init(xB, D / 256, F.G, bid); S.nLeft = 4 * xB; S.c0 = 4 * (nPA - 256); S.pbase = 0;
#pragma unroll
      for (int k = 0; k < 7; ++k) S.M.pb[k] = pbk[k];
      pg8::EpiMoeDown<false> E{OUTP, (bf16*)(w2 + WS_XR3), (const int*)(w2 + WS_SLOTTOK), (const float*)(w2 + WS_SLOTGATE), p0 * 256, D, 1.f / 64};
      pg8::gemm_phase<pg8::EpiMoeDown<false>, pg8::LeftOrder, true, true, true>(ring, g, S, E, F.wave); }
    { MOE_LOAD(1)
      pg8::Gemm g{(const bf16*)(w2 + WS_XG + (size_t)(p0 + xB) * 256 * D), (const bf16*)(w2 + WS_WM1), (nPB - xB) * 256, 2 * EFF, D / 2, D / 2};
      pg8::MoeOrder S; S.init(nPB - xB, 2 * EFF / 256, F.G, bid); S.nBusy = 4 * (nPA - 256) + 4 * xB; S.SK = 4;
#pragma unroll
      for (int k = 0; k < 7; ++k) S.pb[k] = pbk[k] - xB;
      pg8::EpiGatedF8 E{w2 + WS_HM + HMB_OFF + (size_t)xB * 256 * EFF, EFF, 2 * EFF / 256};
      pg8::gemm_phase<pg8::EpiGatedF8, pg8::MoeOrder, true, true, true>(ring, g, S, E, F.wave); }
    GRID_BAR();
    { MOE_LOAD(1)
      pg8::Gemm g{(const bf16*)(w2 + WS_HM + HMB_OFF + (size_t)xB * 256 * EFF), (const bf16*)(w2 + WS_WM2), (nPB - xB) * 256, D, EFF / 2, EFF / 2};
      pg8::MoeOrder S; S.init(nPB - xB, D / 256, F.G, bid);
#pragma unroll
      for (int k = 0; k < 7; ++k) S.pb[k] = pbk[k] - xB;
      pg8::EpiMoeDown<false> E{OUTP, (bf16*)(w2 + WS_XR3), (const int*)(w2 + WS_SLOTTOK), (const float*)(w2 + WS_SLOTGATE), (p0 + xB) * 256, D, 1.f / 64};
      pg8::gemm_phase<pg8::EpiMoeDown<false>, pg8::MoeOrder, true, true, true>(ring, g, S, E, F.wave); }
#undef MOE_LOAD
#undef GRID_BAR
#undef bid
#undef GEMM
}

extern "C" void kernel_launch(void* const* d_in, const int* in_sizes, int n_in, void* d_out, int out_size, void* d_ws, size_t ws_size, hipStream_t stream) {
    static int grid = 0;
    if (grid == 0) {
        if (n_in != 27 || in_sizes[0] != M * D || out_size != M * D || ws_size < WS_END) { fprintf(stderr, "kernel_launch: unexpected shapes (n_in %d, in0 %d, out %d, ws %zu < %zu); nothing launched\n", n_in, n_in > 0 ? in_sizes[0] : -1, out_size, ws_size, (size_t)WS_END); grid = -1; return; }
        int dev = 0, cus = 0, per_cu = 0;
        if (hipGetDevice(&dev) != hipSuccess || hipDeviceGetAttribute(&cus, hipDeviceAttributeMultiprocessorCount, dev) != hipSuccess) { grid = -1; return; }
        if (hipFuncSetAttribute((const void*)yoco_fwd, hipFuncAttributeMaxDynamicSharedMemorySize, LDS_BYTES) != hipSuccess) { fprintf(stderr, "kernel_launch: hipFuncSetAttribute failed\n"); grid = -1; return; }
        if (hipOccupancyMaxActiveBlocksPerMultiprocessor(&per_cu, (const void*)yoco_fwd, NWAVES * 64, LDS_BYTES) != hipSuccess || per_cu < 1) { fprintf(stderr, "kernel_launch: occupancy query says %d\n", per_cu); }
        (void)hipGetLastError();
        grid = cus;
    }
    if (grid < 0) return;
    if (hipMemsetAsync((char*)d_ws + WS_CTL, 0, CTL_ZERO_BYTES, stream) != hipSuccess) return;
    Args a{};
    for (int i = 0; i < 27; ++i) a.in[i] = (const float*)d_in[i];
    a.out = (float*)d_out; a.ws = (unsigned char*)d_ws;
    hipLaunchKernelGGL(yoco_fwd, dim3(grid), dim3(NWAVES * 64), LDS_BYTES, stream, a);
}
```

```cpp
#include <hip/hip_runtime.h>
#include <cstdio>
#include <cstdint>
__device__ __forceinline__ int lane_id_() { unsigned m_ = ~0u; asm volatile("" : "+s"(m_)); return (int)__builtin_amdgcn_mbcnt_hi(m_, __builtin_amdgcn_mbcnt_lo(m_, 0u)); }
template <int X> __device__ __forceinline__ float swz_xor(float v) { return __builtin_bit_cast(float, __builtin_amdgcn_ds_swizzle(__builtin_bit_cast(int, v), (X << 10) | 0x1f)); }
__device__ __forceinline__ void halves32(float v, float& r_lo, float& r_hi) { unsigned a_ = __builtin_bit_cast(unsigned, v), b_ = a_;
    asm volatile("s_nop 1\n\tv_permlane32_swap_b32 %0, %1\n\ts_nop 1" : "+v"(a_), "+v"(b_)); r_lo = __builtin_bit_cast(float, a_); r_hi = __builtin_bit_cast(float, b_); }
__device__ __forceinline__ float xor32_partner(float v, int upper_half) { float lo, hi; halves32(v, lo, hi); return upper_half ? lo : hi; }
__device__ __forceinline__ float xor32_sum(float v) { float lo, hi; halves32(v, lo, hi); return lo + hi; }
__device__ __forceinline__ float xor32_max(float v) { float lo, hi; halves32(v, lo, hi); return fmaxf(lo, hi); }
namespace pg8 {
#define PG8_LAS __attribute__((address_space(3)))
typedef unsigned short bf16_t;
typedef short bf16x8 __attribute__((ext_vector_type(8)));
typedef float f32x4 __attribute__((ext_vector_type(4)));
typedef unsigned u32x4 __attribute__((ext_vector_type(4)));
constexpr int BM = 256, BK = 64, HALF = 128, HTB = HALF * BK * 2  , STAGE_BYTES = 8 * HTB, NXCD = 8, WGM = 8;

__host__ __device__ __forceinline__ int lds_byte(int r, int c) { const int st = (r >> 4) * 2 + (c >> 5), rr = r & 15, cc = c & 31, ob = rr * 64 + cc * 2; return st * 1024 + (ob ^ (((ob >> 9) & 1) << 5)); }
__host__ __device__ __forceinline__ void stage_rc(int b, int& R, int& C) { const int st = b / 1024, sb = b % 1024, swz = sb ^ (((sb >> 9) & 1) << 5); R = (st >> 1) * 16 + swz / 64; C = (st & 1) * 32 + (swz % 64) / 2; }
__host__ __device__ __forceinline__ int perm32(int rho) { const int n = rho >> 4, i = rho & 15; return 8 * (i >> 2) + 4 * n + (i & 3); }

struct Unit { int pm, pn; };
struct Gemm { const bf16_t* A; const bf16_t* Bt; int M, N, K, lda; };

struct StaticOrder {
    int nM, nN, nwg, G, c;
    __host__ __device__ void init(int M, int N, int G_, int c_) { nM = M / BM; nN = N / BM; nwg = nM * nN; G = G_; c = c_; }
    __host__ __device__ bool next(int i, Unit& u) const {
        const int L = i * G + c; if (L >= nwg) return false;
        int wgid = L; { const int q = nwg / NXCD, r = nwg % NXCD, xcd = wgid % NXCD, off = wgid / NXCD; wgid = (xcd < r ? xcd * (q + 1) : r * (q + 1) + (xcd - r) * q) + off; }
        const int nig = WGM * nN, gid = wgid / nig, fm = gid * WGM, gsz = (nM - fm) < WGM ? (nM - fm) : WGM;
        u.pm = fm + ((wgid % nig) % gsz); u.pn = (wgid % nig) / gsz; return true;
    }
    __device__ __forceinline__ void a_ready(const Unit&) const {}
    __device__ __forceinline__ void done(const Unit&) const {}
};
__device__ __forceinline__ unsigned cvt_pk_bf16(float lo, float hi) { unsigned r; asm volatile("v_cvt_pk_bf16_f32 %0, %1, %2" : "=v"(r) : "v"(lo), "v"(hi)); return r; }
__device__ __forceinline__ float silu_f(float x) { const float e = __builtin_amdgcn_exp2f(x * -1.4426950408889634f); return x * __builtin_amdgcn_rcpf(1.f + e); }

__device__ __forceinline__ float sum4(const f32x4& a) { return (a[0] + a[1]) + (a[2] + a[3]); }
__device__ __forceinline__ float part_sum8(const float* p) { return sum4(*(const f32x4*)p) + sum4(*(const f32x4*)(p + 4)); }
__device__ __forceinline__ float part_sum16(const float* p) { return (sum4(*(const f32x4*)p) + sum4(*(const f32x4*)(p + 4))) + (sum4(*(const f32x4*)(p + 8)) + sum4(*(const f32x4*)(p + 12))); }
__device__ __forceinline__ float fq_sum(float v) { v += swz_xor<16>(v); return xor32_sum(v); }
__device__ __forceinline__ float sq8(const f32x4& a, const f32x4& b) { return ((a[0] * a[0] + a[1] * a[1]) + (a[2] * a[2] + a[3] * a[3])) + ((b[0] * b[0] + b[1] * b[1]) + (b[2] * b[2] + b[3] * b[3])); }
__device__ __forceinline__ u32x4 pack8(const f32x4& a, const f32x4& b) { u32x4 w; w.x = cvt_pk_bf16(a[0], a[1]); w.y = cvt_pk_bf16(a[2], a[3]); w.z = cvt_pk_bf16(b[0], b[1]); w.w = cvt_pk_bf16(b[2], b[3]); return w; }
constexpr float EPS_ = 1e-6f;
__device__ __forceinline__ unsigned pk_fp8x4(float a, float b, float c, float d) { int w = 0; w = __builtin_amdgcn_cvt_pk_fp8_f32(a, b, w, false); w = __builtin_amdgcn_cvt_pk_fp8_f32(c, d, w, true); return (unsigned)w; }

struct EpiQA {
    static constexpr bool PERM = true, AFTER_DRAIN = false;
    bf16_t* O; float* part; float wscale;
    __device__ __forceinline__ void operator()(const f32x4 (&acc)[2][2][4][2], const Unit& u, int wr, int wc, int fr, int fq) const {
        { int t_ = lane_id_(); asm volatile("" : "+v"(t_)); fr = t_ & 15; fq = (t_ >> 4) & 3; }
        const int row0 = u.pm * BM + wr * 64 + fr, col0 = u.pn * BM + wc * 32 + 8 * fq;
#pragma unroll
        for (int ai = 0; ai < 2; ++ai)
#pragma unroll
            for (int m = 0; m < 4; ++m) { const int row = row0 + ai * HALF + m * 16; bf16_t* rowp = O + (size_t)row * 768 + col0;
                const f32x4 a0 = acc[ai][0][m][0] * wscale, a1 = acc[ai][0][m][1] * wscale, b0 = acc[ai][1][m][0] * wscale, b1 = acc[ai][1][m][1] * wscale;
                *(u32x4*)(rowp) = pack8(a0, a1); *(u32x4*)(rowp + HALF) = pack8(b0, b1);
                const float s0 = sq8(a0, a1), s1 = sq8(b0, b1);
                float* pr = part + (size_t)row * 16;
                if (u.pn == 0) { const float t = fq_sum(s0 + s1); if (fq == 0) pr[wc] = t; }
                else if (u.pn == 1) { const float t0 = fq_sum(s0), t1 = fq_sum(s1); if (fq == 0) { pr[4 + wc] = t0; pr[8 + wc] = t1; } }
                else { const float t = fq_sum(s0); if (fq == 0) pr[12 + wc] = t; } }
    }
};

struct EpiRowScaleBf16 {
    static constexpr bool PERM = true, AFTER_DRAIN = false;
    bf16_t* O; int ldc; const float* part; float inv_n;
    __device__ __forceinline__ void operator()(const f32x4 (&acc)[2][2][4][2], const Unit& u, int wr, int wc, int fr, int fq) const {
        { int t_ = lane_id_(); asm volatile("" : "+v"(t_)); fr = t_ & 15; fq = (t_ >> 4) & 3; }
        const int row0 = u.pm * BM + wr * 64 + fr, col0 = u.pn * BM + wc * 32 + 8 * fq;
#pragma unroll
        for (int ai = 0; ai < 2; ++ai)
#pragma unroll
            for (int m = 0; m < 4; ++m) { const int row = row0 + ai * HALF + m * 16; bf16_t* rowp = O + (size_t)row * ldc + col0;
                const float rs = __builtin_amdgcn_rsqf(part_sum8(part + (size_t)row * 16) * inv_n + EPS_);
                *(u32x4*)(rowp) = pack8(acc[ai][0][m][0] * rs, acc[ai][0][m][1] * rs); *(u32x4*)(rowp + HALF) = pack8(acc[ai][1][m][0] * rs, acc[ai][1][m][1] * rs); }
    }
};

struct EpiKVup {
    static constexpr bool PERM = true, AFTER_DRAIN = false;
    bf16_t* Kd; bf16_t* Vd; const float* part; const bf16_t* QA; const float* g_kn; const float* rope;
    __device__ __forceinline__ void operator()(const f32x4 (&acc)[2][2][4][2], const Unit& u, int wr, int wc, int fr, int fq) const {
        { int t_ = lane_id_(); asm volatile("" : "+v"(t_)); fr = t_ & 15; fq = (t_ >> 4) & 3; }
        const int row0 = u.pm * BM + wr * 64 + fr;
        if (u.pn >= 4) {
            const int col0 = (u.pn - 4) * BM + wc * 32 + 8 * fq;
#pragma unroll
            for (int ai = 0; ai < 2; ++ai)
#pragma unroll
                for (int m = 0; m < 4; ++m) { const int row = row0 + ai * HALF + m * 16; bf16_t* rowp = Vd + (size_t)row * 1024 + col0;
                    const float rs = __builtin_amdgcn_rsqf(part_sum8(part + (size_t)row * 16 + 8) * (1.f / 256) + EPS_);
                    *(u32x4*)(rowp) = pack8(acc[ai][0][m][0] * rs, acc[ai][0][m][1] * rs); *(u32x4*)(rowp + HALF) = pack8(acc[ai][1][m][0] * rs, acc[ai][1][m][1] * rs); }
            return;
        }
        const int head = 4 * u.pn + wc;
        f32x4 gA0 = *(const f32x4*)(g_kn + 8 * fq), gA1 = *(const f32x4*)(g_kn + 8 * fq + 4), gB0 = *(const f32x4*)(g_kn + 32 + 8 * fq), gB1 = *(const f32x4*)(g_kn + 32 + 8 * fq + 4);
        const f32x4 gR1 = *(const f32x4*)(g_kn + 64 + 4 * fq), gR2 = *(const f32x4*)(g_kn + 80 + 4 * fq);
#pragma unroll
        for (int ai = 0; ai < 2; ++ai)
#pragma unroll
            for (int m = 0; m < 4; ++m) { const int row = row0 + ai * HALF + m * 16;
                const float rs = __builtin_amdgcn_rsqf(part_sum8(part + (size_t)row * 16 + 8) * (1.f / 256) + EPS_);
                f32x4 a0 = acc[ai][0][m][0] * rs, a1 = acc[ai][0][m][1] * rs, b0 = acc[ai][1][m][0] * rs, b1 = acc[ai][1][m][1] * rs;
                const unsigned long long p1 = *(const unsigned long long*)(QA + (size_t)row * 768 + 640 + 4 * fq), p2 = *(const unsigned long long*)(QA + (size_t)row * 768 + 656 + 4 * fq);
                f32x4 x1, x2;
                x1[0] = __builtin_bit_cast(float, (unsigned)(p1 << 16)); x1[1] = __builtin_bit_cast(float, (unsigned)p1 & 0xffff0000u);
                x1[2] = __builtin_bit_cast(float, (unsigned)(p1 >> 32) << 16); x1[3] = __builtin_bit_cast(float, (unsigned)(p1 >> 32) & 0xffff0000u);
                x2[0] = __builtin_bit_cast(float, (unsigned)(p2 << 16)); x2[1] = __builtin_bit_cast(float, (unsigned)p2 & 0xffff0000u);
                x2[2] = __builtin_bit_cast(float, (unsigned)(p2 >> 32) << 16); x2[3] = __builtin_bit_cast(float, (unsigned)(p2 >> 32) & 0xffff0000u);
                const float ss = fq_sum(sq8(a0, a1) + sq8(b0, b1) + sq8(x1, x2));
                const float sh = __builtin_amdgcn_rsqf(ss * (1.f / 96) + EPS_);
                bf16_t* kp = Kd + (size_t)row * 1536 + head * 96;
                *(u32x4*)(kp + 8 * fq) = pack8(a0 * gA0 * sh, a1 * gA1 * sh); *(u32x4*)(kp + 32 + 8 * fq) = pack8(b0 * gB0 * sh, b1 * gB1 * sh);
                const f32x4* rp = (const f32x4*)(rope + ((size_t)(row & 2047) * 16 + 4 * fq) * 2);
                const f32x4 c01 = rp[0], c23 = rp[1];
                const f32x4 y1 = x1 * gR1 * sh, y2 = x2 * gR2 * sh;
                f32x4 o1, o2;
                o1[0] = y1[0] * c01[0] - y2[0] * c01[1]; o2[0] = y2[0] * c01[0] + y1[0] * c01[1];
                o1[1] = y1[1] * c01[2] - y2[1] * c01[3]; o2[1] = y2[1] * c01[2] + y1[1] * c01[3];
                o1[2] = y1[2] * c23[0] - y2[2] * c23[1]; o2[2] = y2[2] * c23[0] + y1[2] * c23[1];
                o1[3] = y1[3] * c23[2] - y2[3] * c23[3]; o2[3] = y2[3] * c23[2] + y1[3] * c23[3];
                unsigned long long w1 = (unsigned long long)cvt_pk_bf16(o1[0], o1[1]) | ((unsigned long long)cvt_pk_bf16(o1[2], o1[3]) << 32);
                unsigned long long w2 = (unsigned long long)cvt_pk_bf16(o2[0], o2[1]) | ((unsigned long long)cvt_pk_bf16(o2[2], o2[3]) << 32);
                *(unsigned long long*)(kp + 64 + 4 * fq) = w1; *(unsigned long long*)(kp + 80 + 4 * fq) = w2; }
    }
};

struct EpiK2Q2 {
    static constexpr bool PERM = true, AFTER_DRAIN = false;
    bf16_t* O; const float* pss; const float* gk; const float* gq; float wscale;
    __device__ __forceinline__ void operator()(const f32x4 (&acc)[2][2][4][2], const Unit& u, int wr, int wc, int fr, int fq) const {
        { int t_ = lane_id_(); asm volatile("" : "+v"(t_)); fr = t_ & 15; fq = (t_ >> 4) & 3; }
        const int row0 = u.pm * BM + wr * 64 + fr, isq = u.pn >> 2, tl = u.pn & 3;
        const float* g = isq ? gq : gk; const float post = isq ? 0.125f * 1.4426950408889634f : 1.f;
        const f32x4 gA0 = *(const f32x4*)(g + 8 * fq) * post, gA1 = *(const f32x4*)(g + 8 * fq + 4) * post, gB0 = *(const f32x4*)(g + 32 + 8 * fq) * post, gB1 = *(const f32x4*)(g + 32 + 8 * fq + 4) * post;
        const int colh = isq * 2048 + (4 * tl + wc) * 64;
        unsigned zhi_ = 0u; asm volatile("" : "+v"(zhi_));
        const unsigned long long coff = ((unsigned long long)zhi_ << 32) | (unsigned)((colh + 8 * fq) * 2);
#pragma unroll
        for (int ai = 0; ai < 2; ++ai)
#pragma unroll
            for (int m = 0; m < 4; ++m) { const int row = row0 + ai * HALF + m * 16; unsigned char* rowp = (unsigned char*)O + (size_t)row * 6144 + coff;
                const float rs = __builtin_amdgcn_rsqf(part_sum16(pss + (size_t)row * 16) * (1.f / 1024) + EPS_) * wscale;
                const f32x4 a0 = acc[ai][0][m][0] * rs, a1 = acc[ai][0][m][1] * rs, b0 = acc[ai][1][m][0] * rs, b1 = acc[ai][1][m][1] * rs;
                const float ss = fq_sum(sq8(a0, a1) + sq8(b0, b1));
                const float sh = __builtin_amdgcn_rsqf(ss * (1.f / 64) + EPS_);
                *(u32x4*)(rowp) = pack8(a0 * gA0 * sh, a1 * gA1 * sh); *(u32x4*)(rowp + 64) = pack8(b0 * gB0 * sh, b1 * gB1 * sh); }
    }
};
struct EpiRowScale16 {
    static constexpr bool PERM = true, AFTER_DRAIN = false;
    bf16_t* O; int ldc; int coff; const float* pss; float wscale;
    __device__ __forceinline__ void operator()(const f32x4 (&acc)[2][2][4][2], const Unit& u, int wr, int wc, int fr, int fq) const {
        { int t_ = lane_id_(); asm volatile("" : "+v"(t_)); fr = t_ & 15; fq = (t_ >> 4) & 3; }
        const int row0 = u.pm * BM + wr * 64 + fr, col0 = coff + u.pn * BM + wc * 32 + 8 * fq;
#pragma unroll
        for (int ai = 0; ai < 2; ++ai)
#pragma unroll
            for (int m = 0; m < 4; ++m) { const int row = row0 + ai * HALF + m * 16; bf16_t* rowp = O + (size_t)row * ldc + col0;
                const float rs = __builtin_amdgcn_rsqf(part_sum16(pss + (size_t)row * 16) * (1.f / 1024) + EPS_) * wscale;
                *(u32x4*)(rowp) = pack8(acc[ai][0][m][0] * rs, acc[ai][0][m][1] * rs); *(u32x4*)(rowp + HALF) = pack8(acc[ai][1][m][0] * rs, acc[ai][1][m][1] * rs); }
    }
};

template <bool SSQ> struct EpiGated {
    static constexpr bool PERM = true, AFTER_DRAIN = false;
    bf16_t* Hd; int ldc; int ntile; const float* rs;
    __device__ __forceinline__ void operator()(const f32x4 (&acc)[2][2][4][2], const Unit& u, int wr, int wc, int fr, int fq) const {
        { int t_ = lane_id_(); asm volatile("" : "+v"(t_)); fr = t_ & 15; fq = (t_ >> 4) & 3; }
        const int pnl = ntile ? (u.pn % ntile) : u.pn;
        const int row0 = u.pm * BM + wr * 64 + fr, col0 = pnl * HALF + wc * 32 + 8 * fq;
#pragma unroll
        for (int ai = 0; ai < 2; ++ai)
#pragma unroll
            for (int m = 0; m < 4; ++m) { const int row = row0 + ai * HALF + m * 16; bf16_t* rowp = Hd + (size_t)row * ldc + col0;
                const float r = SSQ ? __builtin_amdgcn_rsqf(part_sum16(rs + (size_t)row * 16) * (1.f / 1024) + EPS_) : rs[row];
                const f32x4 g0 = acc[ai][0][m][0] * r, g1 = acc[ai][0][m][1] * r, u0 = acc[ai][1][m][0] * r, u1 = acc[ai][1][m][1] * r;
                u32x4 w;
                w.x = cvt_pk_bf16(silu_f(g0[0]) * u0[0], silu_f(g0[1]) * u0[1]); w.y = cvt_pk_bf16(silu_f(g0[2]) * u0[2], silu_f(g0[3]) * u0[3]);
                w.z = cvt_pk_bf16(silu_f(g1[0]) * u1[0], silu_f(g1[1]) * u1[1]); w.w = cvt_pk_bf16(silu_f(g1[2]) * u1[2], silu_f(g1[3]) * u1[3]);
                *(u32x4*)rowp = w; }
    }
};

struct EpiGatedF8 {
    static constexpr bool PERM = true, AFTER_DRAIN = false;
    unsigned char* Hd; int ldc; int ntile;
    static __device__ __forceinline__ float gate(float g, float u) {
        const float e = __builtin_amdgcn_exp2f(g * (-1.4426950408889634f / 64.f)); return (g * u) * (__builtin_amdgcn_rcpf(1.f + e) * (1.f / 4096.f)); }
    __device__ __forceinline__ void operator()(const f32x4 (&acc)[2][2][4][2], const Unit& u, int wr, int wc, int fr, int fq) const {
        { int t_ = lane_id_(); asm volatile("" : "+v"(t_)); fr = t_ & 15; fq = (t_ >> 4) & 3; }
        const int pnl = u.pn % ntile;
        const int row0 = u.pm * BM + wr * 64 + fr, col0 = pnl * HALF + wc * 32 + 8 * fq;
#pragma unroll
        for (int ai = 0; ai < 2; ++ai)
#pragma unroll
            for (int m = 0; m < 4; ++m) { const int row = row0 + ai * HALF + m * 16; unsigned char* rowp = Hd + (size_t)row * ldc + col0;
                const f32x4 g0 = acc[ai][0][m][0], g1 = acc[ai][0][m][1], u0 = acc[ai][1][m][0], u1 = acc[ai][1][m][1];
                unsigned long long w = (unsigned long long)pk_fp8x4(gate(g0[0], u0[0]), gate(g0[1], u0[1]), gate(g0[2], u0[2]), gate(g0[3], u0[3]))
                                     | ((unsigned long long)pk_fp8x4(gate(g1[0], u1[0]), gate(g1[1], u1[1]), gate(g1[2], u1[2]), gate(g1[3], u1[3])) << 32);
                *(unsigned long long*)rowp = w; }
    }
};

template <bool SSQ, bool XF8, bool RES16> struct EpiResStream {
    static constexpr bool PERM = true, AFTER_DRAIN = false;
    const void* res; bf16_t* XB; unsigned char* X8; float* ssq; float ascale;
    __device__ __forceinline__ void operator()(const f32x4 (&acc)[2][2][4][2], const Unit& u, int wr, int wc, int fr, int fq) const {
        { int t_ = lane_id_(); asm volatile("" : "+v"(t_)); fr = t_ & 15; fq = (t_ >> 4) & 3; }
        const int row0 = u.pm * BM + wr * 64 + fr, col0 = u.pn * BM + wc * 32 + 8 * fq;
        f32x4 rw[4][2][2];
#define ERS_ROW(it) (row0 + ((it) >> 2) * HALF + ((it) & 3) * 16)
#define ERS_LOAD(it) do { const size_t ro_ = (size_t)ERS_ROW(it) * 1024 + col0; _Pragma("unroll") for (int bj = 0; bj < 2; ++bj) { \
            if constexpr (RES16) rw[(it) & 3][bj][0] = __builtin_bit_cast(f32x4, *(const u32x4*)((const bf16_t*)res + ro_ + bj * HALF)); \
            else { _Pragma("unroll") for (int n = 0; n < 2; ++n) rw[(it) & 3][bj][n] = *(const f32x4*)((const float*)res + ro_ + bj * HALF + n * 4); } } } while (0)
        ERS_LOAD(0); ERS_LOAD(1); ERS_LOAD(2); ERS_LOAD(3);
#pragma unroll
        for (int it = 0; it < 8; ++it) { const int ai = it >> 2, m = it & 3; const int row = ERS_ROW(it); const size_t ro = (size_t)row * 1024 + col0;
                f32x4 r[2][2];
#pragma unroll
                for (int bj = 0; bj < 2; ++bj) {
                    if constexpr (RES16) { const u32x4 w = __builtin_bit_cast(u32x4, rw[it & 3][bj][0]);
                        r[bj][0] = (f32x4){__builtin_bit_cast(float, w.x << 16), __builtin_bit_cast(float, w.x & 0xffff0000u), __builtin_bit_cast(float, w.y << 16), __builtin_bit_cast(float, w.y & 0xffff0000u)};
                        r[bj][1] = (f32x4){__builtin_bit_cast(float, w.z << 16), __builtin_bit_cast(float, w.z & 0xffff0000u), __builtin_bit_cast(float, w.w << 16), __builtin_bit_cast(float, w.w & 0xffff0000u)}; }
                    else { r[bj][0] = rw[it & 3][bj][0]; r[bj][1] = rw[it & 3][bj][1]; }
                    r[bj][0] = r[bj][0] + acc[ai][bj][m][0] * ascale; r[bj][1] = r[bj][1] + acc[ai][bj][m][1] * ascale; }
                if (it + 4 < 8) ERS_LOAD(it + 4);
                *(u32x4*)(XB + ro) = pack8(r[0][0], r[0][1]); *(u32x4*)(XB + ro + HALF) = pack8(r[1][0], r[1][1]);
                if constexpr (XF8) { unsigned char* x8 = X8 + ro;
                    *(unsigned long long*)(x8) = (unsigned long long)pk_fp8x4(r[0][0][0], r[0][0][1], r[0][0][2], r[0][0][3]) | ((unsigned long long)pk_fp8x4(r[0][1][0], r[0][1][1], r[0][1][2], r[0][1][3]) << 32);
                    *(unsigned long long*)(x8 + HALF) = (unsigned long long)pk_fp8x4(r[1][0][0], r[1][0][1], r[1][0][2], r[1][0][3]) | ((unsigned long long)pk_fp8x4(r[1][1][0], r[1][1][1], r[1][1][2], r[1][1][3]) << 32); }
                if (SSQ) { const float t = fq_sum(sq8(r[0][0], r[0][1]) + sq8(r[1][0], r[1][1])); if (fq == 0) ssq[(size_t)row * 16 + u.pn * 4 + wc] = t; } }
#undef ERS_LOAD
#undef ERS_ROW
    }
};

template <bool FIRST> struct EpiMoeDown {
    static constexpr bool PERM = false, AFTER_DRAIN = false;
    float* out; bf16_t* xb; const int* slot_tok; const float* slot_gate; int slot_base; int ldc; float wscale;
    __device__ __forceinline__ void operator()(const f32x4 (&acc)[2][2][4][2], const Unit& u, int wr, int wc, int fr, int fq) const {
        { int t_ = lane_id_(); asm volatile("" : "+v"(t_)); fr = t_ & 15; fq = (t_ >> 4) & 3; }
        const int pnl = u.pn & 3;
        const int row0 = slot_base + u.pm * BM + wr * 64 + fr, col0 = pnl * BM + wc * 32 + 4 * fq;
        int tk[8]; float gt[8];
#pragma unroll
        for (int it = 0; it < 8; ++it) { const int slot = row0 + (it >> 2) * HALF + (it & 3) * 16; tk[it] = slot_tok[slot]; gt[it] = slot_gate[slot] * wscale; }
        unsigned rlo[4][2][2], rhi[4][2][2];
#define EMD_LOAD(it) do { if (tk[it] >= 0) { _Pragma("unroll") for (int bj = 0; bj < 2; ++bj) _Pragma("unroll") for (int n = 0; n < 2; ++n) { \
            const unsigned long long q_ = *(const unsigned long long*)(xb + (size_t)tk[it] * ldc + col0 + bj * HALF + n * 16); \
            rlo[(it) & 3][bj][n] = (unsigned)q_; rhi[(it) & 3][bj][n] = (unsigned)(q_ >> 32); } } } while (0)
        EMD_LOAD(0); EMD_LOAD(1); EMD_LOAD(2); EMD_LOAD(3);
#pragma unroll
        for (int it = 0; it < 8; ++it) { const int ai = it >> 2, m = it & 3;
            if (tk[it] >= 0) { const size_t ro = (size_t)tk[it] * ldc + col0;
#pragma unroll
                for (int bj = 0; bj < 2; ++bj)
#pragma unroll
                    for (int n = 0; n < 2; ++n) { const unsigned lo = rlo[it & 3][bj][n], hi = rhi[it & 3][bj][n];
                        f32x4 r = (f32x4){__builtin_bit_cast(float, lo << 16), __builtin_bit_cast(float, lo & 0xffff0000u), __builtin_bit_cast(float, hi << 16), __builtin_bit_cast(float, hi & 0xffff0000u)};
                        r = r + acc[ai][bj][m][n] * gt[it];
                        if constexpr (FIRST) *(unsigned long long*)(xb + ro + bj * HALF + n * 16) = (unsigned long long)cvt_pk_bf16(r[0], r[1]) | ((unsigned long long)cvt_pk_bf16(r[2], r[3]) << 32);
                        else *(f32x4*)(out + ro + bj * HALF + n * 16) = r; } }
            if (it + 4 < 8) EMD_LOAD(it + 4); }
#undef EMD_LOAD
    }
};

struct MoeOrder {
    int nM, nN, nwg, G, c; int pb[7];
    int rot;
    int nBusy, SK;
    __device__ void init(int nPanels, int nN_, int G_, int c_) { nM = nPanels; nN = nN_; nwg = nM * nN; G = G_; c = c_; nBusy = 0; SK = 0; rot = 0; }
    __device__ __forceinline__ int expert_of(int pm) const { int e = 0;
#pragma unroll
        for (int k = 0; k < 7; ++k) e += (pm >= pb[k]) ? 1 : 0;
        return e; }
    __device__ bool next(int i, Unit& u) const {
        int L;
        if (nBusy == 0) { int ce = c - rot; if (ce < 0) ce += G; L = i * G + ce; }
        else if (c >= nBusy) L = (i < SK) ? i * (G - nBusy) + (c - nBusy) : SK * (G - nBusy) + (i - SK) * G + c;
        else L = SK * (G - nBusy) + i * G + c;
        if (L >= nwg) return false;
        int wgid = L; { const int q = nwg / NXCD, r = nwg % NXCD, xcd = wgid % NXCD, off = wgid / NXCD; wgid = (xcd < r ? xcd * (q + 1) : r * (q + 1) + (xcd - r) * q) + off; }
        const int nig = WGM * nN, gid = wgid / nig, fm = gid * WGM, gsz = (nM - fm) < WGM ? (nM - fm) : WGM;
        u.pm = fm + ((wgid % nig) % gsz); const int pnl = (wgid % nig) / gsz;
        u.pn = expert_of(u.pm) * nN + pnl; return true;
    }
    __device__ __forceinline__ void a_ready(const Unit&) const {}
    __device__ __forceinline__ void done(const Unit&) const {}
};
struct LeftOrder {
    MoeOrder M; int nLeft, c0, pbase;
    __device__ bool next(int i, Unit& u) const { const int j = M.c - c0; if (i != 0 || j < 0 || j >= nLeft) return false; u.pm = pbase + (j >> 2); u.pn = M.expert_of(u.pm) * 4 + (j & 3); return true; }
    __device__ __forceinline__ void a_ready(const Unit&) const {}
    __device__ __forceinline__ void done(const Unit&) const {}
};
template <class Epi, class Sched, bool ALIGN_EPI = false, bool SP2 = false, bool F8 = false>
__device__ __forceinline__ void gemm_phase(PG8_LAS unsigned char* lds, const Gemm g, const Sched& S, const Epi& E, const int wave_idx) {
    int tid_ = wave_idx * 64 + lane_id_(); asm volatile("" : "+v"(tid_));
    const int tid = tid_, wid = __builtin_amdgcn_readfirstlane(tid >> 6), lane = tid & 63, wr = wid >> 2, wc = wid & 3, fr = lane & 15, fq = lane >> 4;
    const int K = g.K, nt = K / BK;
    unsigned voffA0, voffB0;
    { int R, C; stage_rc(tid * 16, R, C); const int Rb = Epi::PERM ? ((R & ~31) + perm32(R & 31)) : R;
      voffA0 = (unsigned)(R * g.lda + C) * 2u; voffB0 = (unsigned)(Rb * K + C) * 2u; }
    const size_t voffAR = (size_t)64 * g.lda * 2, voffBR = (size_t)64 * K * 2;
    const size_t kstep = (size_t)(BK * 2);
    const size_t hstepA = (size_t)HALF * g.lda * 2, hstepB = (size_t)HALF * K * 2;
    const size_t tstepA = 2 * hstepA, tstepB = 2 * hstepB;
    const unsigned lds0_ = (unsigned)(__UINTPTR_TYPE__)lds;
    const unsigned ldsw = (unsigned)wid * 1024u;
    const int aoff = lds_byte(wr * 64 + fr, fq * 8), boff = lds_byte(wc * 32 + fr, fq * 8);
#define PG8_SA(b, h) (((b) * 2 + (h)) * HTB)
#define PG8_SB(b, h) ((4 + (b) * 2 + (h)) * HTB)
#define PG8_STAGE(bufoff, gbase, voff) do { _Pragma("unroll") for (int _i = 0; _i < 2; ++_i) { unsigned keep_; const char* sb_ = (const char*)(gbase) + (size_t)_i * voff##R; \
        asm volatile("s_mov_b32 %0, m0\n\ts_mov_b32 m0, %3\n\ts_nop 0\n\tglobal_load_lds_dwordx4 %1, %2\n\ts_mov_b32 m0, %0" \
            : "=&s"(keep_) : "v"(voff##0), "s"(sb_), "s"(lds0_ + (unsigned)((bufoff) + _i * 8192) + ldsw) : "memory"); } } while (0)
#define PG8_LDA(dst, b, h) do { _Pragma("unroll") for (int m = 0; m < 4; ++m) _Pragma("unroll") for (int k = 0; k < 2; ++k) dst[m][k] = *(const PG8_LAS bf16x8*)(lds + PG8_SA(b, h) + aoff + m * 2048 + k * 1024); } while (0)
#define PG8_LDB(dst, b, h) do { _Pragma("unroll") for (int n = 0; n < 2; ++n) _Pragma("unroll") for (int k = 0; k < 2; ++k) dst[n][k] = *(const PG8_LAS bf16x8*)(lds + PG8_SB(b, h) + boff + n * 2048 + k * 1024); } while (0)
#define PG8_MMA(ai, bj, At, Bt) do { __builtin_amdgcn_s_setprio(1); _Pragma("unroll") for (int m = 0; m < 4; ++m) _Pragma("unroll") for (int n = 0; n < 2; ++n) { \
        if constexpr (F8) { typedef int v8i_ __attribute__((ext_vector_type(8))); typedef int v4i_ __attribute__((ext_vector_type(4))); \
            const v4i_ b0_ = __builtin_bit_cast(v4i_, Bt[n][0]), b1_ = __builtin_bit_cast(v4i_, Bt[n][1]), a0_ = __builtin_bit_cast(v4i_, At[m][0]), a1_ = __builtin_bit_cast(v4i_, At[m][1]); \
            const v8i_ bb_ = __builtin_shufflevector(b0_, b1_, 0, 1, 2, 3, 4, 5, 6, 7), aa_ = __builtin_shufflevector(a0_, a1_, 0, 1, 2, 3, 4, 5, 6, 7); \
            acc[ai][bj][m][n] = __builtin_amdgcn_mfma_scale_f32_16x16x128_f8f6f4(bb_, aa_, acc[ai][bj][m][n], 0, 0, 0, 0, 0, 0); } \
        else { _Pragma("unroll") for (int k = 0; k < 2; ++k) acc[ai][bj][m][n] = __builtin_amdgcn_mfma_f32_16x16x32_bf16(Bt[n][k], At[m][k], acc[ai][bj][m][n], 0, 0, 0); } } \
        __builtin_amdgcn_s_setprio(0); } while (0)
#define PG8_WAIT_V(n) asm volatile("s_waitcnt vmcnt(" #n ")" ::: "memory")
#define PG8_WAIT_L(n) asm volatile("s_waitcnt lgkmcnt(" #n ")" ::: "memory")
#define PG8_BAR __builtin_amdgcn_s_barrier()
#define PG8_SCHED __builtin_amdgcn_sched_barrier(0)
    Unit cur, nxt; int ui = 0;
    if (!S.next(0, cur)) return;
    f32x4 acc[2][2][4][2];
#pragma unroll
    for (int a = 0; a < 2; ++a)
#pragma unroll
        for (int b = 0; b < 2; ++b)
#pragma unroll
            for (int m = 0; m < 4; ++m)
#pragma unroll
                for (int n = 0; n < 2; ++n) acc[a][b][m][n] = (f32x4){0.f, 0.f, 0.f, 0.f};
    bf16x8 At[4][2], B0[2][2], B1[2][2];
    const char* cA = (const char*)g.A + (size_t)cur.pm * tstepA; const char* cB = (const char*)g.Bt + (size_t)cur.pn * tstepB;
    S.a_ready(cur);
    if constexpr (SP2) {
        PG8_STAGE(PG8_SB(0, 0), cB, voffB); PG8_STAGE(PG8_SB(0, 1), cB + hstepB, voffB); PG8_STAGE(PG8_SA(0, 0), cA, voffA); PG8_STAGE(PG8_SA(0, 1), cA + hstepA, voffA);
        if (wr == 1) PG8_BAR;
        PG8_WAIT_V(2); PG8_BAR;
        PG8_STAGE(PG8_SB(1, 0), cB + kstep, voffB); PG8_STAGE(PG8_SA(1, 0), cA + kstep, voffA); PG8_STAGE(PG8_SB(1, 1), cB + hstepB + kstep, voffB);
        PG8_WAIT_V(6); PG8_BAR;
    } else {
        PG8_STAGE(PG8_SB(0, 0), cB, voffB); PG8_STAGE(PG8_SA(0, 0), cA, voffA); PG8_STAGE(PG8_SB(0, 1), cB + hstepB, voffB); PG8_STAGE(PG8_SA(0, 1), cA + hstepA, voffA);
        if (wr == 1) PG8_BAR;
        PG8_WAIT_V(4); PG8_BAR;
        PG8_STAGE(PG8_SB(1, 0), cB + kstep, voffB); PG8_STAGE(PG8_SA(1, 0), cA + kstep, voffA); PG8_STAGE(PG8_SB(1, 1), cB + hstepB + kstep, voffB);
        PG8_WAIT_V(6); PG8_BAR;
    }
    for (;;) {
        const bool has_next = S.next(ui + 1, nxt);
        const char* nA = has_next ? (const char*)g.A + (size_t)nxt.pm * tstepA : cA; const char* nB = has_next ? (const char*)g.Bt + (size_t)nxt.pn * tstepB : cB;
#pragma unroll 1
        for (int t = 0; t < nt; t += 2) {
            const bool last = (t == nt - 2);
            const char* a1 = cA + (size_t)(t + 1) * kstep;
            const char* a2 = last ? nA : cA + (size_t)(t + 2) * kstep; const char* b2 = last ? nB : cB + (size_t)(t + 2) * kstep;
            const char* a3 = a2 + kstep; const char* b3 = b2 + kstep;
            if (last && has_next) S.a_ready(nxt);
            if constexpr (SP2) {
            PG8_LDB(B0, 0, 0); PG8_LDB(B1, 0, 1); PG8_SCHED; PG8_LDA(At, 0, 0); PG8_STAGE(PG8_SA(1, 1), a1 + hstepA, voffA);
            PG8_WAIT_V(8); PG8_WAIT_L(0); PG8_BAR; PG8_MMA(0, 0, At, B0); PG8_MMA(0, 1, At, B1); PG8_BAR; PG8_SCHED;
            PG8_LDA(At, 0, 1); PG8_STAGE(PG8_SB(0, 0), b2, voffB); PG8_STAGE(PG8_SB(0, 1), b2 + hstepB, voffB); PG8_STAGE(PG8_SA(0, 0), a2, voffA);
            PG8_WAIT_V(8); PG8_WAIT_L(0); PG8_BAR; PG8_MMA(1, 0, At, B0); PG8_MMA(1, 1, At, B1); PG8_BAR; PG8_SCHED;
            PG8_LDB(B0, 1, 0); PG8_LDB(B1, 1, 1); PG8_SCHED; PG8_LDA(At, 1, 0); PG8_STAGE(PG8_SA(0, 1), a2 + hstepA, voffA);
            PG8_WAIT_V(8); PG8_WAIT_L(0); PG8_BAR; PG8_MMA(0, 0, At, B0); PG8_MMA(0, 1, At, B1); PG8_BAR; PG8_SCHED;
            PG8_LDA(At, 1, 1); PG8_STAGE(PG8_SB(1, 0), b3, voffB); PG8_STAGE(PG8_SB(1, 1), b3 + hstepB, voffB); PG8_STAGE(PG8_SA(1, 0), a3, voffA);
            PG8_WAIT_V(8); PG8_WAIT_L(0); PG8_BAR; PG8_MMA(1, 0, At, B0); PG8_MMA(1, 1, At, B1); PG8_BAR; PG8_SCHED;
            } else {
            PG8_LDB(B0, 0, 0); PG8_SCHED; PG8_LDA(At, 0, 0); PG8_STAGE(PG8_SA(1, 1), a1 + hstepA, voffA);
            PG8_WAIT_L(8); PG8_BAR; PG8_WAIT_L(0); PG8_MMA(0, 0, At, B0); PG8_BAR; PG8_SCHED;
            PG8_LDB(B1, 0, 1); PG8_STAGE(PG8_SB(0, 0), b2, voffB);
            PG8_BAR; PG8_WAIT_L(0); PG8_MMA(0, 1, At, B1); PG8_BAR;
            PG8_LDA(At, 0, 1); PG8_STAGE(PG8_SA(0, 0), a2, voffA);
            PG8_BAR; PG8_WAIT_L(0); PG8_MMA(1, 0, At, B0); PG8_BAR; PG8_SCHED;
            PG8_STAGE(PG8_SB(0, 1), b2 + hstepB, voffB);
            PG8_WAIT_V(6); PG8_BAR; PG8_MMA(1, 1, At, B1); PG8_BAR;
            PG8_LDB(B0, 1, 0); PG8_SCHED; PG8_LDA(At, 1, 0); PG8_STAGE(PG8_SA(0, 1), a2 + hstepA, voffA);
            PG8_WAIT_L(8); PG8_BAR; PG8_WAIT_L(0); PG8_MMA(0, 0, At, B0); PG8_BAR; PG8_SCHED;
            PG8_LDB(B1, 1, 1); PG8_STAGE(PG8_SB(1, 0), b3, voffB);
            PG8_BAR; PG8_WAIT_L(0); PG8_MMA(0, 1, At, B1); PG8_BAR;
            PG8_LDA(At, 1, 1); PG8_STAGE(PG8_SA(1, 0), a3, voffA);
            PG8_BAR; PG8_WAIT_L(0); PG8_MMA(1, 0, At, B0); PG8_BAR; PG8_SCHED;
            PG8_STAGE(PG8_SB(1, 1), b3 + hstepB, voffB);
            PG8_WAIT_V(6); PG8_BAR; PG8_MMA(1, 1, At, B1); PG8_BAR;
            }
        }
        if constexpr (ALIGN_EPI) { if (wr == 0) PG8_BAR; }
        if constexpr (!Epi::AFTER_DRAIN) { E(acc, cur, wr, wc, fr, fq); S.done(cur); }
        if (!has_next) break;
#pragma unroll
        for (int a = 0; a < 2; ++a)
#pragma unroll
            for (int b = 0; b < 2; ++b)
#pragma unroll
                for (int m = 0; m < 4; ++m)
#pragma unroll
                    for (int n = 0; n < 2; ++n) acc[a][b][m][n] = (f32x4){0.f, 0.f, 0.f, 0.f};
        cur = nxt; cA = nA; cB = nB; ++ui;
        if constexpr (ALIGN_EPI) { if (wr == 1) PG8_BAR; }
    }
    PG8_WAIT_V(0);
    if constexpr (!ALIGN_EPI) { if (wr == 0) PG8_BAR; }
    PG8_BAR;
    if constexpr (Epi::AFTER_DRAIN) { E.fused(acc, cur, wr, wc, fr, fq, lds, wid, lane); S.done(cur); }
#undef PG8_SA
#undef PG8_SB
#undef PG8_STAGE
#undef PG8_LDA
#undef PG8_LDB
#undef PG8_MMA
#undef PG8_WAIT_V
#undef PG8_WAIT_L
#undef PG8_BAR
#undef PG8_SCHED
}
}
namespace att {
#define ATT_LAS __attribute__((address_space(3)))
typedef unsigned short bf16;
typedef short bf16x8 __attribute__((ext_vector_type(8)));
typedef short s16x4 __attribute__((ext_vector_type(4)));
typedef float f32x16 __attribute__((ext_vector_type(16)));
typedef float f32x4_t __attribute__((ext_vector_type(4)));
typedef unsigned u32x4 __attribute__((ext_vector_type(4)));
typedef unsigned u32x2 __attribute__((ext_vector_type(2)));
typedef float f32x2_t __attribute__((ext_vector_type(2))); typedef __bf16 bf16x2_t __attribute__((ext_vector_type(2)));
__device__ __forceinline__ unsigned cvtpk(float lo, float hi) { f32x2_t v = {lo, hi}; bf16x2_t b = __builtin_convertvector(v, bf16x2_t); return __builtin_bit_cast(unsigned, b); }
__device__ __forceinline__ s16x4 vtr(const ATT_LAS unsigned char* p) { return __builtin_bit_cast(s16x4, __builtin_amdgcn_ds_read_tr16_b64_v4i16((ATT_LAS s16x4*)p)); }
constexpr int VSTR = 192;
template <int DQK> struct Geo { static constexpr int KSTR = DQK * 2 + 16, KBUF = 64 * KSTR, VBUF = 64 * VSTR, CPR = DQK / 8, NKC = 64 * CPR, KIT = (NKC + 511) / 512; };
template <int DQK> constexpr int lds_bytes() { return 3 * Geo<DQK>::KBUF + 3 * Geo<DQK>::VBUF + 2048 + 8192; }

__device__ __forceinline__ float xhalf_sum(float m) { return xor32_sum(m); }
__device__ __forceinline__ float max3f(float a, float b, float c) { float r; asm("v_max3_f32 %0, %1, %2, %3" : "=v"(r) : "v"(a), "v"(b), "v"(c)); return r; }
__device__ __forceinline__ float max2f(float a, float b) { float r; asm("v_max_f32_e32 %0, %1, %2" : "=v"(r) : "v"(a), "v"(b)); return r; }
__device__ __forceinline__ float rowmax32(const f32x16& p0, const f32x16& p1) {
    float a = max2f(p0[0], p1[0]), b = max2f(p0[1], p1[1]), c = max2f(p0[2], p1[2]), d = max2f(p0[3], p1[3]);
#pragma unroll
    for (int r = 4; r < 16; r += 4) { a = max3f(a, p0[r], p1[r]); b = max3f(b, p0[r + 1], p1[r + 1]); c = max3f(c, p0[r + 2], p1[r + 2]); d = max3f(d, p0[r + 3], p1[r + 3]); }
    const float m = max2f(max2f(a, b), max2f(c, d));
    float lo_, hi_; halves32(m, lo_, hi_);
    return max2f(lo_, hi_);
}

template <int DQK, int kpitch, int vpitch, int NS>
__device__ __forceinline__ void attn_init(ATT_LAS unsigned char* lds, const int wave_idx) {
    typedef Geo<DQK> G;
    const int lane = lane_id_(), wid = wave_idx;
    constexpr int KCPL = G::KSTR / 16, KNP = (64 * KCPL + 63) / 64, VCPL = VSTR / 16, VNP = 64 * VCPL / 64, KPP = (KNP + 7) / 8, VPP = (VNP + 7) / 8;
    ATT_LAS unsigned* dmaL = (ATT_LAS unsigned*)(lds + NS * G::KBUF + NS * G::VBUF + 2048) + wid * 256 + lane;
#pragma unroll
    for (int pp = 0; pp < KPP; ++pp) { const int pc = wid + 8 * pp, c = pc * 64 + lane, row = (c / KCPL) & 63, ch = c % KCPL; dmaL[64 * pp] = (unsigned)(row * kpitch + (ch < G::CPR ? ch : 0) * 8) * 2u; }
#pragma unroll
    for (int pp = 0; pp < VPP; ++pp) { const int pc = wid + 8 * pp, c = pc * 64 + lane, row = (c / VCPL) & 63, ch = c % VCPL; dmaL[128 + 64 * pp] = (unsigned)(row * vpitch + (ch < 8 ? ch : 0) * 8) * 2u; }
}

template <int DQK, bool BAND, int qpitch, int kpitch, int vpitch, int opitch, bool OF8 = false, bool NOMAX = false, int NS = 2, int DBG = 0>
__device__ __forceinline__ void attn_unit(ATT_LAS unsigned char* lds, const bf16* Qb, const bf16* Kb, const bf16* Vb, bf16* Ob,
                                          int q0, int t_lo, int t_hi, int my_lo, int my_hi, int cc, const float* bias_g, const float* g_qn, const float* rope, const int wave_idx, const bool load_bias,
                                          bf16x8 (&qf)[DQK / 16], const bool q_loaded, const bool has_next, const bf16* Qn) {
    typedef Geo<DQK> G;
    int tid_ = wave_idx * 64 + lane_id_(); asm volatile("" : "+v"(tid_));
    const int tid = tid_, lane = tid & 63, r32 = lane & 31, hi = lane >> 5, wid = __builtin_amdgcn_readfirstlane(tid >> 6);
    ATT_LAS float* biasL = (ATT_LAS float*)(lds + NS * G::KBUF + NS * G::VBUF);
    constexpr int KCPL = G::KSTR / 16, KNP = (64 * KCPL + 63) / 64;
    constexpr int VCPL = VSTR / 16, VNP = 64 * VCPL / 64;
    constexpr int KPP = (KNP + 7) / 8, VPP = (VNP + 7) / 8;
    ATT_LAS unsigned* dmaL = (ATT_LAS unsigned*)(lds + NS * G::KBUF + NS * G::VBUF + 2048) + wid * 256 + lane;
    const unsigned ldsb = __builtin_amdgcn_readfirstlane((unsigned)(size_t)lds);
    const int kc = (KNP - 1 - wid) / 8 + 1, vc = (VNP - 1 - wid) / 8 + 1;
#define ATT_MOD3(x) (NS == 3 ? (x) - 3 * (((x) * 43) >> 7) : ((x) & 1))
#define ATT_DMA1(gptr, voff_, ldsaddr) do { unsigned keep_; asm volatile("s_mov_b32 %0, m0\n\ts_mov_b32 m0, %3\n\ts_nop 0\n\tglobal_load_lds_dwordx4 %1, %2\n\ts_mov_b32 m0, %0" \
            : "=&s"(keep_) : "v"(voff_), "s"(gptr), "s"(ldsaddr) : "memory"); } while (0)
#define ATT_DMA_K(t) do { const int t_ = (t); const char* kt_ = (const char*)(Kb + (size_t)t_ * 64 * kpitch); const unsigned d_ = ldsb + ATT_MOD3(t_) * G::KBUF + wid * 1024; \
        _Pragma("unroll") for (int pp = 0; pp < KPP; ++pp) { if (wid + 8 * pp < KNP) { const unsigned vo_ = dmaL[64 * pp]; ATT_DMA1(kt_, vo_, d_ + pp * 8192); } } } while (0)
#define ATT_DMA_V(t) do { const int t_ = (t); const char* vt_ = (const char*)(Vb + (size_t)t_ * 64 * vpitch); const unsigned d_ = ldsb + NS * G::KBUF + ATT_MOD3(t_) * G::VBUF + wid * 1024; \
        _Pragma("unroll") for (int pp = 0; pp < VPP; ++pp) { if (wid + 8 * pp < VNP) { const unsigned vo_ = dmaL[128 + 64 * pp]; ATT_DMA1(vt_, vo_, d_ + pp * 8192); } } } while (0)
#define ATT_WAITBAR(n) do { const int n_ = (n); \
        if (n_ == 0) asm volatile("s_waitcnt vmcnt(0) lgkmcnt(0)\n\ts_barrier" ::: "memory"); else if (n_ == 1) asm volatile("s_waitcnt vmcnt(1) lgkmcnt(0)\n\ts_barrier" ::: "memory"); \
        else if (n_ == 2) asm volatile("s_waitcnt vmcnt(2) lgkmcnt(0)\n\ts_barrier" ::: "memory"); else if (n_ == 3) asm volatile("s_waitcnt vmcnt(3) lgkmcnt(0)\n\ts_barrier" ::: "memory"); \
        else if (n_ == 4) asm volatile("s_waitcnt vmcnt(4) lgkmcnt(0)\n\ts_barrier" ::: "memory"); else if (n_ == 5) asm volatile("s_waitcnt vmcnt(5) lgkmcnt(0)\n\ts_barrier" ::: "memory"); \
        else asm volatile("s_waitcnt vmcnt(6) lgkmcnt(0)\n\ts_barrier" ::: "memory"); } while (0)
    ATT_DMA_K(t_lo); ATT_DMA_V(t_lo);
    if (t_lo + 1 <= t_hi) { ATT_DMA_K(t_lo + 1); if (NS == 3) ATT_DMA_V(t_lo + 1); }
    if (NS == 3) { if (t_lo + 2 <= t_hi) ATT_DMA_K(t_lo + 2); }
    if (BAND) { if (load_bias && tid < 257) biasL[tid] = bias_g[tid] * 1.4426950408889634f; }
    if (!q_loaded) { const bf16* qp = Qb + (size_t)(q0 + wid * 32 + r32) * qpitch + 8 * hi;
#pragma unroll
      for (int kk = 0; kk < DQK / 16; ++kk) { if constexpr (DBG & 8) qf[kk] = (bf16x8){(short)lane, 1, 2, 3, 4, 5, 6, 7}; else qf[kk] = *(const bf16x8*)(qp + 16 * kk); } }
    if constexpr (!BAND) {
        float qv[DQK / 16][8]; float ss = 0.f;
#pragma unroll
        for (int kk = 0; kk < DQK / 16; ++kk)
#pragma unroll
            for (int j = 0; j < 8; ++j) { qv[kk][j] = __builtin_bit_cast(float, (unsigned)(unsigned short)qf[kk][j] << 16); ss += qv[kk][j] * qv[kk][j]; }
        ss = xhalf_sum(ss);
        const float rs = __builtin_amdgcn_rsqf(ss * (1.f / DQK) + 1e-6f) * (0.10206207261596577f * 1.4426950408889634f);
#pragma unroll
        for (int kk = 0; kk < DQK / 16; ++kk) { const f32x4_t g0 = *(const f32x4_t*)(g_qn + 16 * kk + 8 * hi), g1 = *(const f32x4_t*)(g_qn + 16 * kk + 8 * hi + 4);
#pragma unroll
            for (int j = 0; j < 4; ++j) { qv[kk][j] *= rs * g0[j]; qv[kk][4 + j] *= rs * g1[j]; } }
        const f32x4_t* rp = (const f32x4_t*)(rope + ((size_t)(q0 + wid * 32 + r32) * 16 + 8 * hi) * 2);
#pragma unroll
        for (int j2 = 0; j2 < 4; ++j2) { const f32x4_t cs = rp[j2];
            { const float x1 = qv[4][2 * j2], x2 = qv[5][2 * j2]; qv[4][2 * j2] = x1 * cs[0] - x2 * cs[1]; qv[5][2 * j2] = x2 * cs[0] + x1 * cs[1]; }
            { const float x1 = qv[4][2 * j2 + 1], x2 = qv[5][2 * j2 + 1]; qv[4][2 * j2 + 1] = x1 * cs[2] - x2 * cs[3]; qv[5][2 * j2 + 1] = x2 * cs[2] + x1 * cs[3]; } }
#pragma unroll
        for (int kk = 0; kk < DQK / 16; ++kk) { u32x4 w; w.x = cvtpk(qv[kk][0], qv[kk][1]); w.y = cvtpk(qv[kk][2], qv[kk][3]); w.z = cvtpk(qv[kk][4], qv[kk][5]); w.w = cvtpk(qv[kk][6], qv[kk][7]);
            qf[kk] = __builtin_bit_cast(bf16x8, w); }
    }
    f32x16 o0, o1;
#pragma unroll
    for (int i = 0; i < 16; ++i) { o0[i] = 0.f; o1[i] = 0.f; }
    float mrun = -INFINITY, lsum = 0.f; float ls4[4] = {0.f, 0.f, 0.f, 0.f};
    const int koff = r32 * G::KSTR + hi * 16;
    const int voff = ((lane >> 5) * 4 + ((lane & 15) >> 2)) * VSTR + (((lane >> 4) & 1) * 16 + (lane & 3) * 4) * 2;
    const f32x16 zero16 = {0.f, 0.f, 0.f, 0.f, 0.f, 0.f, 0.f, 0.f, 0.f, 0.f, 0.f, 0.f, 0.f, 0.f, 0.f, 0.f};
#define ATT_QK(X0, X1, t) do { const ATT_LAS unsigned char* Kt = lds + ATT_MOD3(t) * G::KBUF + koff; \
        _Pragma("unroll") for (int kk = 0; kk < DQK / 16; ++kk) { \
            const bf16x8 a0 = *(const ATT_LAS bf16x8*)(Kt + kk * 32); const bf16x8 a1 = *(const ATT_LAS bf16x8*)(Kt + 32 * G::KSTR + kk * 32); \
            X0 = __builtin_amdgcn_mfma_f32_32x32x16_bf16(a0, qf[kk], kk ? X0 : zero16, 0, 0, 0); X1 = __builtin_amdgcn_mfma_f32_32x32x16_bf16(a1, qf[kk], kk ? X1 : zero16, 0, 0, 0); } } while (0)
#define ATT_FARSCALE() do { const float f_ = __builtin_amdgcn_exp2f(biasL[256]); _Pragma("unroll") for (int i = 0; i < 16; ++i) { o0[i] *= f_; o1[i] *= f_; } \
        ls4[0] *= f_; ls4[1] *= f_; ls4[2] *= f_; ls4[3] *= f_; } while (0)
#define ATT_SMPV(X0, X1, t) do { \
        float cadd = 0.f; \
        if (BAND && !(DBG & 2)) { const int delta = cc - (t); \
            if (delta >= 3) { if constexpr (!NOMAX) cadd = biasL[256]; } \
            else { const ATT_LAS float* bp = biasL + (64 * delta + (32 * (wid & 1) + r32) - 4 * hi + 128 - 63); \
                if (delta < 2) { _Pragma("unroll") for (int i = 0; i < 16; ++i) { const int kj = (i & 3) + 8 * (i >> 2); X0[i] += bp[63 - kj]; X1[i] += bp[31 - kj]; } } \
                else { const int relb = 64 * delta + (32 * (wid & 1) + r32) - 4 * hi + 128; \
                    _Pragma("unroll") for (int i = 0; i < 16; ++i) { const int kj = (i & 3) + 8 * (i >> 2); int i0 = relb - kj, i1 = relb - kj - 32; i0 = i0 > 256 ? 256 : i0; i1 = i1 > 256 ? 256 : i1; \
                        X0[i] += biasL[i0]; X1[i] += biasL[i1]; } } } } \
        if constexpr (NOMAX) { \
            _Pragma("unroll") for (int i = 0; i < 16; ++i) { X0[i] = __builtin_amdgcn_exp2f(X0[i]); X1[i] = __builtin_amdgcn_exp2f(X1[i]); ls4[i & 3] += X0[i] + X1[i]; } \
        } else { \
        const float mt = rowmax32(X0, X1) + cadd; \
        const float mnew = max2f(mrun, mt); \
        const float alpha = __builtin_amdgcn_exp2f(mrun - mnew); \
        const float msub = mnew - cadd; \
        mrun = mnew; \
        float psa[4] = {0.f, 0.f, 0.f, 0.f};   \
        _Pragma("unroll") for (int i = 0; i < 16; ++i) { X0[i] = __builtin_amdgcn_exp2f(X0[i] - msub); X1[i] = __builtin_amdgcn_exp2f(X1[i] - msub); psa[i & 3] += X0[i] + X1[i]; } \
        const float ps = (psa[0] + psa[1]) + (psa[2] + psa[3]); \
        lsum = lsum * alpha + ps; \
        _Pragma("unroll") for (int i = 0; i < 16; ++i) { o0[i] *= alpha; o1[i] *= alpha; } } \
        bf16x8 pf[2][2]; \
        _Pragma("unroll") for (int s = 0; s < 2; ++s) { u32x4 w0, w1; \
            w0.x = cvtpk(X0[8 * s + 0], X0[8 * s + 1]); w0.y = cvtpk(X0[8 * s + 2], X0[8 * s + 3]); w0.z = cvtpk(X0[8 * s + 4], X0[8 * s + 5]); w0.w = cvtpk(X0[8 * s + 6], X0[8 * s + 7]); \
            w1.x = cvtpk(X1[8 * s + 0], X1[8 * s + 1]); w1.y = cvtpk(X1[8 * s + 2], X1[8 * s + 3]); w1.z = cvtpk(X1[8 * s + 4], X1[8 * s + 5]); w1.w = cvtpk(X1[8 * s + 6], X1[8 * s + 7]); \
            pf[0][s] = __builtin_bit_cast(bf16x8, w0); pf[1][s] = __builtin_bit_cast(bf16x8, w1); } \
        const ATT_LAS unsigned char* Vt = lds + NS * G::KBUF + ATT_MOD3(t) * G::VBUF + voff; \
        _Pragma("unroll") for (int kb = 0; kb < 2; ++kb) _Pragma("unroll") for (int s = 0; s < 2; ++s) { \
            const ATT_LAS unsigned char* vp = Vt + (32 * kb + 16 * s) * VSTR; \
            const s16x4 l0 = vtr(vp), h0 = vtr(vp + 8 * VSTR), l1 = vtr(vp + 64), h1 = vtr(vp + 8 * VSTR + 64); \
            const bf16x8 a0 = (bf16x8){l0[0], l0[1], l0[2], l0[3], h0[0], h0[1], h0[2], h0[3]}; \
            const bf16x8 a1 = (bf16x8){l1[0], l1[1], l1[2], l1[3], h1[0], h1[1], h1[2], h1[3]}; \
            o0 = __builtin_amdgcn_mfma_f32_32x32x16_bf16(a0, pf[kb][s], o0, 0, 0, 0); o1 = __builtin_amdgcn_mfma_f32_32x32x16_bf16(a1, pf[kb][s], o1, 0, 0, 0); } \
        if constexpr (NOMAX && BAND) { if (cc - (t) == 3) ATT_FARSCALE(); } } while (0)
#define ATT_FUSED(C0, C1, N0, N1, t, tn) do { \
        bf16x8 kfa[DQK / 16], kfb[DQK / 16]; \
        { const ATT_LAS unsigned char* Kt = lds + ATT_MOD3(tn) * G::KBUF + koff; \
          _Pragma("unroll") for (int kk = 0; kk < DQK / 16; ++kk) { kfa[kk] = *(const ATT_LAS bf16x8*)(Kt + kk * 32); kfb[kk] = *(const ATT_LAS bf16x8*)(Kt + 32 * G::KSTR + kk * 32); } } \
        if constexpr (!NOMAX) __builtin_amdgcn_sched_barrier(0); \
        float cadd = 0.f; \
        if (BAND && !(DBG & 2)) { const int delta = cc - (t); \
            if (delta >= 3) { if constexpr (!NOMAX) cadd = biasL[256]; } \
            else { const ATT_LAS float* bp = biasL + (64 * delta + (32 * (wid & 1) + r32) - 4 * hi + 128 - 63); \
                if (delta < 2) { _Pragma("unroll") for (int i = 0; i < 16; ++i) { const int kj = (i & 3) + 8 * (i >> 2); C0[i] += bp[63 - kj]; C1[i] += bp[31 - kj]; } } \
                else { const int relb = 64 * delta + (32 * (wid & 1) + r32) - 4 * hi + 128; \
                    _Pragma("unroll") for (int i = 0; i < 16; ++i) { const int kj = (i & 3) + 8 * (i >> 2); int i0 = relb - kj, i1 = relb - kj - 32; i0 = i0 > 256 ? 256 : i0; i1 = i1 > 256 ? 256 : i1; \
                        C0[i] += biasL[i0]; C1[i] += biasL[i1]; } } } } \
        float alpha = 1.f, msub = 0.f; \
        if constexpr (!NOMAX) { \
        const float mt = rowmax32(C0, C1) + cadd; \
        const float mnew = max2f(mrun, mt); \
        alpha = __builtin_amdgcn_exp2f(mrun - mnew); \
        msub = mnew - cadd; \
        if (__builtin_amdgcn_ballot_w64(mnew > mrun)) { _Pragma("unroll") for (int i = 0; i < 16; ++i) { o0[i] *= alpha; o1[i] *= alpha; } } \
        mrun = mnew; } \
        if constexpr (!NOMAX || BAND) __builtin_amdgcn_sched_barrier(0); \
        _Pragma("unroll") for (int kk = 0; kk < DQK / 16; ++kk) { \
            N0 = __builtin_amdgcn_mfma_f32_32x32x16_bf16(kfa[kk], qf[kk], kk ? N0 : zero16, 0, 0, 0); N1 = __builtin_amdgcn_mfma_f32_32x32x16_bf16(kfb[kk], qf[kk], kk ? N1 : zero16, 0, 0, 0); } \
        s16x4 vl0[4], vh0[4], vl1[4], vh1[4]; \
        { const ATT_LAS unsigned char* Vt = lds + NS * G::KBUF + ATT_MOD3(t) * G::VBUF + voff; \
          _Pragma("unroll") for (int ks = 0; ks < 4; ++ks) { const ATT_LAS unsigned char* vp = Vt + 16 * ks * VSTR; vl0[ks] = vtr(vp); vh0[ks] = vtr(vp + 8 * VSTR); vl1[ks] = vtr(vp + 64); vh1[ks] = vtr(vp + 8 * VSTR + 64); } } \
        if constexpr (NOMAX) { \
            _Pragma("unroll") for (int i = 0; i < 16; ++i) { C0[i] = __builtin_amdgcn_exp2f(C0[i]); C1[i] = __builtin_amdgcn_exp2f(C1[i]); ls4[i & 3] += C0[i] + C1[i]; } \
        } else { \
        float psa[4] = {0.f, 0.f, 0.f, 0.f}; \
        _Pragma("unroll") for (int i = 0; i < 16; ++i) { C0[i] = __builtin_amdgcn_exp2f(C0[i] - msub); C1[i] = __builtin_amdgcn_exp2f(C1[i] - msub); psa[i & 3] += C0[i] + C1[i]; } \
        const float ps = (psa[0] + psa[1]) + (psa[2] + psa[3]); \
        lsum = lsum * alpha + ps; } \
        bf16x8 pf[4]; \
        _Pragma("unroll") for (int s = 0; s < 2; ++s) { u32x4 w0, w1; \
            w0.x = cvtpk(C0[8 * s + 0], C0[8 * s + 1]); w0.y = cvtpk(C0[8 * s + 2], C0[8 * s + 3]); w0.z = cvtpk(C0[8 * s + 4], C0[8 * s + 5]); w0.w = cvtpk(C0[8 * s + 6], C0[8 * s + 7]); \
            w1.x = cvtpk(C1[8 * s + 0], C1[8 * s + 1]); w1.y = cvtpk(C1[8 * s + 2], C1[8 * s + 3]); w1.z = cvtpk(C1[8 * s + 4], C1[8 * s + 5]); w1.w = cvtpk(C1[8 * s + 6], C1[8 * s + 7]); \
            pf[s] = __builtin_bit_cast(bf16x8, w0); pf[2 + s] = __builtin_bit_cast(bf16x8, w1); } \
        __builtin_amdgcn_sched_barrier(0); \
        _Pragma("unroll") for (int ks = 0; ks < 4; ++ks) { \
            const bf16x8 a0 = (bf16x8){vl0[ks][0], vl0[ks][1], vl0[ks][2], vl0[ks][3], vh0[ks][0], vh0[ks][1], vh0[ks][2], vh0[ks][3]}; \
            const bf16x8 a1 = (bf16x8){vl1[ks][0], vl1[ks][1], vl1[ks][2], vl1[ks][3], vh1[ks][0], vh1[ks][1], vh1[ks][2], vh1[ks][3]}; \
            o0 = __builtin_amdgcn_mfma_f32_32x32x16_bf16(a0, pf[ks], o0, 0, 0, 0); o1 = __builtin_amdgcn_mfma_f32_32x32x16_bf16(a1, pf[ks], o1, 0, 0, 0); } \
        if constexpr (NOMAX && BAND) { if (cc - (t) == 3) ATT_FARSCALE(); } } while (0)
#define ATT_STAGE(t) do { if ((t) + NS <= t_hi) ATT_DMA_K((t) + NS); if ((t) + NS - 1 <= t_hi) ATT_DMA_V((t) + NS - 1); } while (0)
#define ATT_STAGE_T(t) do { ATT_STAGE(t); \
        if ((t) == t_hi && has_next) { const bf16* qp_ = Qn + (size_t)(wid * 32 + r32) * qpitch + 8 * hi; _Pragma("unroll") for (int kk = 0; kk < DQK / 16; ++kk) qf[kk] = *(const bf16x8*)(qp_ + 16 * kk); } } while (0)
#define ATT_NFL(t) ((NS == 3 ? ((t) + 3 <= t_hi ? kc : 0) + ((t) + 2 <= t_hi ? vc : 0) : 0) + (((t) == t_hi && has_next) ? DQK / 16 : 0))
    f32x16 sa0, sa1, sb0, sb1;
    ATT_WAITBAR(0);
    if (my_lo == t_lo) ATT_QK(sa0, sa1, t_lo);
    ATT_WAITBAR(0);
    {
        int t = t_lo;
        for (; t < my_lo - 1; ++t) { ATT_STAGE(t); ATT_WAITBAR(ATT_NFL(t)); }
        if (my_lo > t_lo) { ATT_STAGE(t); ATT_QK(sa0, sa1, t + 1); ATT_WAITBAR(ATT_NFL(t)); ++t; }
        int nf = my_hi - my_lo;
        for (; nf >= 2; nf -= 2, t += 2) {
            ATT_STAGE(t); ATT_FUSED(sa0, sa1, sb0, sb1, t, t + 1); ATT_WAITBAR(ATT_NFL(t));
            ATT_STAGE(t + 1); ATT_FUSED(sb0, sb1, sa0, sa1, t + 1, t + 2); ATT_WAITBAR(ATT_NFL(t + 1));
        }
        if (nf == 1) {
            ATT_STAGE(t); ATT_FUSED(sa0, sa1, sb0, sb1, t, t + 1); ATT_WAITBAR(ATT_NFL(t)); ++t;
            ATT_STAGE_T(t); ATT_SMPV(sb0, sb1, t); ATT_WAITBAR(ATT_NFL(t)); ++t;
        } else {
            ATT_STAGE_T(t); ATT_SMPV(sa0, sa1, t); ATT_WAITBAR(ATT_NFL(t)); ++t;
        }
        for (; t <= t_hi; ++t) { ATT_STAGE_T(t); ATT_WAITBAR(ATT_NFL(t)); }
    }
    if constexpr (NOMAX) lsum = (ls4[0] + ls4[1]) + (ls4[2] + ls4[3]);
    const float ltot = xhalf_sum(lsum);
    const float inv = 1.f / ltot;
    if constexpr (DBG & 4) { if (ltot == 12345.678f) *(float*)Ob = o0[0] + o1[0]; } else
    if constexpr (OF8) {
        const float i64 = inv * 32.f;
        int w0[4], w1[4];
#pragma unroll
        for (int g4 = 0; g4 < 4; ++g4) { w0[g4] = 0; w1[g4] = 0;
            w0[g4] = __builtin_amdgcn_cvt_pk_fp8_f32(o0[4 * g4 + 0] * i64, o0[4 * g4 + 1] * i64, w0[g4], false); w0[g4] = __builtin_amdgcn_cvt_pk_fp8_f32(o0[4 * g4 + 2] * i64, o0[4 * g4 + 3] * i64, w0[g4], true);
            w1[g4] = __builtin_amdgcn_cvt_pk_fp8_f32(o1[4 * g4 + 0] * i64, o1[4 * g4 + 1] * i64, w1[g4], false); w1[g4] = __builtin_amdgcn_cvt_pk_fp8_f32(o1[4 * g4 + 2] * i64, o1[4 * g4 + 3] * i64, w1[g4], true); }
        asm volatile("s_nop 1\n\tv_permlane32_swap_b32 %0, %1\n\tv_permlane32_swap_b32 %2, %3\n\tv_permlane32_swap_b32 %4, %5\n\tv_permlane32_swap_b32 %6, %7\n\ts_nop 1"
                     : "+v"(w0[2]), "+v"(w0[0]), "+v"(w0[3]), "+v"(w0[1]), "+v"(w1[2]), "+v"(w1[0]), "+v"(w1[3]), "+v"(w1[1]));
        unsigned char* op = (unsigned char*)Ob + (size_t)(q0 + wid * 32 + r32) * opitch + (hi ? 0 : 16);
        *(u32x4*)op = (u32x4){(unsigned)w0[2], (unsigned)w0[0], (unsigned)w0[3], (unsigned)w0[1]};
        *(u32x4*)(op + 32) = (u32x4){(unsigned)w1[2], (unsigned)w1[0], (unsigned)w1[3], (unsigned)w1[1]};
    } else {
    bf16* op = Ob + (size_t)(q0 + wid * 32 + r32) * opitch + 4 * hi;
#pragma unroll
    for (int g4 = 0; g4 < 4; ++g4) {
        u32x2 w0, w1;
        w0.x = cvtpk(o0[4 * g4 + 0] * inv, o0[4 * g4 + 1] * inv); w0.y = cvtpk(o0[4 * g4 + 2] * inv, o0[4 * g4 + 3] * inv);
        w1.x = cvtpk(o1[4 * g4 + 0] * inv, o1[4 * g4 + 1] * inv); w1.y = cvtpk(o1[4 * g4 + 2] * inv, o1[4 * g4 + 3] * inv);
        *(u32x2*)(op + 8 * g4) = w0; *(u32x2*)(op + 32 + 8 * g4) = w1;
    }
    }
#undef ATT_DMA_K
#undef ATT_DMA_V
#undef ATT_QK
#undef ATT_SMPV
#undef ATT_STAGE
#undef ATT_STAGE_T
#undef ATT_FUSED
#undef ATT_MOD3
#undef ATT_DMA1
#undef ATT_WAITBAR
#undef ATT_NFL
#undef ATT_FARSCALE
}
}
constexpr int NWAVES = 8;
constexpr int D = 1024, BATCH = 32, SEQ = 2048, M = BATCH * SEQ;
constexpr int NH = 16, QLORA = 384, KVLORA = 256, ROPE_D = 32, NOPE = 64, QKD = 96;
constexpr int NA = 768;
constexpr int FF = 2816, EFF = 3584, NE = 8;
constexpr float EPS = 1e-6f, LOG2E = 1.4426950408889634f;
constexpr int MAXP_HALF = 264, MAXP = 528;
constexpr size_t MiB = 1u << 20;
constexpr size_t WS_CTL = 0, CTL_ZERO_BYTES = 1 * MiB;
constexpr size_t WS_ROPE = 1 * MiB;
constexpr size_t WS_CNT = WS_ROPE + 256 * 1024;
constexpr size_t WS_PANELE = WS_CNT + 16 * 1024;
constexpr size_t WS_META = WS_PANELE + 4096;
constexpr size_t WS_TOKE = 2 * MiB;
constexpr size_t WS_TOKG = WS_TOKE + (size_t)M * 4;
constexpr size_t WS_SLOTTOK = WS_TOKG + (size_t)M * 8;
constexpr size_t WS_SLOTGATE = WS_SLOTTOK + (size_t)MAXP * 256 * 4;
constexpr size_t WS_PARTQA = 976 * MiB, WS_PART1 = 980 * MiB, WS_PART2 = 984 * MiB;
constexpr size_t WS_TOKRSTD = 4 * MiB;
constexpr size_t WS_SLOTRSTD = WS_TOKRSTD + (size_t)M * 4;
static_assert(WS_SLOTGATE + (size_t)MAXP * 256 * 4 <= WS_TOKRSTD && WS_SLOTRSTD + (size_t)MAXP * 256 * 4 <= 8 * MiB, "small arrays");
constexpr size_t WS_W = 8 * MiB;
constexpr size_t WS_WA = WS_W, WS_WUQ = WS_WA + (size_t)NA * D * 2, WS_WUKV = WS_WUQ + (size_t)1536 * QLORA * 2, WS_WO = WS_WUKV + (size_t)2048 * KVLORA * 2;
constexpr size_t WS_WF1 = WS_WO + (size_t)D * D * 2, WS_WF2 = WS_WF1 + (size_t)2 * FF * D * 2, WS_WKVQ = WS_WF2 + (size_t)D * FF * 2, WS_WBO = WS_WKVQ + (size_t)3 * D * D * 2;
constexpr size_t WS_WM1 = WS_WBO + (size_t)D * D * 2, WS_WM2 = WS_WM1 + (size_t)NE * 2 * EFF * D * 2, WS_WEND = WS_WM2 + (size_t)NE * D * EFF * 2;
constexpr size_t ARENA = 208 * MiB;
static_assert(WS_WEND <= ARENA, "weights fit under the arena");
constexpr size_t WS_XN = ARENA;
constexpr size_t WS_QA = ARENA + 128 * MiB;
constexpr size_t WS_Q = ARENA + 224 * MiB;
constexpr size_t WS_K = ARENA + 416 * MiB;
constexpr size_t WS_V = ARENA + 608 * MiB;
constexpr size_t WS_O = ARENA;
static_assert(WS_V + (size_t)M * D * 2 <= 1024 * MiB, "MLA arena");
constexpr size_t WS_XR1 = ARENA + 128 * MiB;
constexpr size_t WS_H = ARENA + 256 * MiB;
constexpr size_t WS_XR2 = ARENA;
constexpr size_t WS_X2B = ARENA + 608 * MiB;
constexpr size_t WS_KVQ2 = ARENA + 128 * MiB;
constexpr size_t WS_O2 = ARENA + 512 * MiB;
constexpr size_t WS_XR3 = ARENA + 132 * MiB;
constexpr size_t WS_XG = ARENA;
constexpr size_t WS_HM = ARENA + 264 * MiB;
constexpr size_t WS_END = WS_HM + (size_t)MAXP_HALF * 256 * EFF * 2;
static_assert(WS_XG + (size_t)MAXP * 256 * D <= WS_XR3 && WS_XR3 + (size_t)M * D * 2 <= WS_HM && WS_END <= 1024 * MiB && WS_H + (size_t)M * FF * 2 <= WS_X2B && WS_X2B + (size_t)M * D * 2 <= 976 * MiB && WS_O2 + (size_t)M * D <= WS_X2B, "arena");
constexpr int CW_BAR = 4096;
constexpr int RING_OFF = 0, RING_BYTES = 131072;
constexpr int P0_SCR = 128 * 33 * 4;
constexpr int LDSCTL_OFF = 8 * P0_SCR, MISC_OFF = LDSCTL_OFF + 320;
static_assert(LDSCTL_OFF >= RING_BYTES, "control words above every phase's scratch");
constexpr int LDS_BYTES = 147456;
static_assert(MISC_OFF + 128 <= LDS_BYTES, "LDS map");
static_assert(att::lds_bytes<96>() <= RING_BYTES, "attention scratch fits the ring region");

#define GAS __attribute__((address_space(1)))
#define LAS __attribute__((address_space(3)))
typedef unsigned short bf16;
typedef unsigned v4u __attribute__((ext_vector_type(4)));
typedef unsigned v2u __attribute__((ext_vector_type(2)));
typedef float f32x4 __attribute__((ext_vector_type(4)));
typedef GAS unsigned gu32;
#define RLX_AGENT __ATOMIC_RELAXED, __HIP_MEMORY_SCOPE_AGENT
#define LDS_WAIT() asm volatile("s_waitcnt lgkmcnt(0)" ::: "memory")
__device__ __forceinline__ unsigned f2bf(float f) { unsigned u = __builtin_bit_cast(unsigned, f); return (u + 0x7fffu + ((u >> 16) & 1u)) >> 16; }
__device__ __forceinline__ unsigned pk2(float lo, float hi) { return f2bf(lo) | (f2bf(hi) << 16); }
__device__ __forceinline__ float bflo(unsigned u) { return __builtin_bit_cast(float, u << 16); }
__device__ __forceinline__ float bfhi(unsigned u) { return __builtin_bit_cast(float, u & 0xffff0000u); }
__device__ __forceinline__ float wave_sum(float v) {
    v += swz_xor<1>(v); v += swz_xor<2>(v); v += swz_xor<4>(v); v += swz_xor<8>(v); v += swz_xor<16>(v);
    return xor32_sum(v);
}
__device__ __forceinline__ float wave_maxf(float v) {
    v = fmaxf(v, swz_xor<1>(v)); v = fmaxf(v, swz_xor<2>(v)); v = fmaxf(v, swz_xor<4>(v)); v = fmaxf(v, swz_xor<8>(v)); v = fmaxf(v, swz_xor<16>(v));
    return xor32_max(v);
}

#define XB_TMO      128
#define XB_XCNT(j)  (256  + 64 * (j))
#define XB_XSUB(j)  (1280 + 64 * (j))
#define XB_XGEN(j)  (2304 + 64 * (j))
#define XB_TOP      3328
#define XB_TOPGEN   3392
#define XCD_BAR_WORDS 3456
#define XB_SPIN_CAP (1u << 18)

__device__ __forceinline__ unsigned xb_ld(unsigned* p)              { return __hip_atomic_load(p, __ATOMIC_RELAXED, __HIP_MEMORY_SCOPE_AGENT); }
__device__ __forceinline__ unsigned xb_add(unsigned* p, unsigned v) { return __hip_atomic_fetch_add(p, v, __ATOMIC_RELAXED, __HIP_MEMORY_SCOPE_AGENT); }
__device__ __forceinline__ unsigned xb_xcc_id() { return (unsigned)__builtin_amdgcn_s_getreg((3 << 11) | 20) & 0xFu; }
#define XB_SPIN(cond, bar) do { unsigned _sp = 0; while (cond) { __builtin_amdgcn_s_sleep(1); \
    if ((++_sp & 255u) == 0u) { if (xb_ld(&(bar)[XB_TMO])) break; if (_sp > XB_SPIN_CAP) { atomicAdd(&(bar)[XB_TMO], 1u); break; } } } } while (0)

struct XcdBarrier {
    int t0;
    unsigned* bar; unsigned x;
    volatile LAS unsigned* st;
};

__device__ __forceinline__ XcdBarrier xcd_barrier_post(unsigned* bar, volatile LAS unsigned* st, int t0) {
    XcdBarrier b; b.t0 = t0; b.bar = bar; b.x = xb_xcc_id(); b.st = st;
    if (b.t0) (void)xb_add(&bar[XB_XCNT(b.x)], 1u);
    return b;
}
__device__ __forceinline__ void xcd_barrier_complete(unsigned* bar, unsigned x, unsigned& nloc, unsigned& nx) {
    const unsigned G = gridDim.x * gridDim.y * gridDim.z;
    unsigned sum, cnt, mine, sp = 0u;
    for (;;) {
        sum = 0u; cnt = 0u; mine = 0u;
#pragma unroll
        for (unsigned j = 0; j < 16; ++j) { const unsigned c = xb_ld(&bar[XB_XCNT(j)]); sum += c; cnt += (c > 0u) ? 1u : 0u; mine = (j == x) ? c : mine; }
        if (sum == G) break;
        __builtin_amdgcn_s_sleep(1);
        if ((++sp & 255u) == 0u) { if (xb_ld(&bar[XB_TMO])) break; if (sp > XB_SPIN_CAP) { atomicAdd(&bar[XB_TMO], 1u); break; } }
    }
    nloc = mine > 0u ? mine : 1u; nx = cnt > 0u ? cnt : 1u;
}

__device__ __forceinline__ void xcd_barrier(const XcdBarrier& b) {
    asm volatile("s_waitcnt vmcnt(0)" ::: "memory");
    __syncthreads();
    if (b.t0) {
        unsigned* bar = b.bar;
        __builtin_amdgcn_s_waitcnt(0);
        unsigned nloc = b.st[0], nx = b.st[1];
        if (nloc == 0u) { xcd_barrier_complete(bar, b.x, nloc, nx); b.st[0] = nloc; b.st[1] = nx; }
        const unsigned old = xb_add(&bar[XB_XSUB(b.x)], 1u);
        const unsigned gen = old / nloc;
        if (old + 1u == (gen + 1u) * nloc) {
            __builtin_amdgcn_fence(__ATOMIC_RELEASE, "agent");
            asm volatile("s_waitcnt vmcnt(0)" ::: "memory");
            const unsigned og = xb_add(&bar[XB_TOP], 1u);
            const unsigned tg = og / nx;
            if (og + 1u == (tg + 1u) * nx) xb_add(&bar[XB_TOPGEN], 1u);
            else XB_SPIN(xb_ld(&bar[XB_TOPGEN]) == tg, bar);
            __builtin_amdgcn_fence(__ATOMIC_ACQUIRE, "agent");
            xb_add(&bar[XB_XGEN(b.x)], 1u);
            asm volatile("s_waitcnt vmcnt(0)" ::: "memory");
        } else {
            XB_SPIN(xb_ld(&bar[XB_XGEN(b.x)]) == gen, bar);
            __builtin_amdgcn_fence(__ATOMIC_ACQUIRE, "agent");
            asm volatile("s_waitcnt vmcnt(0)" ::: "memory");
        }
    }
    __syncthreads();
}

struct Args { const float* in[27]; float* out; unsigned char* ws; };
enum { I_X = 0, I_ATTN_NORM, I_FFN_NORM, I_A_WDQ, I_A_GCQ, I_A_WUQ, I_A_WDKV, I_A_GCKV, I_A_WUKV, I_A_GQN, I_A_GKN, I_A_WO, I_KV_NORM, I_KV_WK, I_KV_WV, I_KV_GKN,
       I_B_WQ, I_B_GQN, I_B_RELB, I_B_WO, I_FFN_W1, I_FFN_W3, I_FFN_W2, I_MOE_ROUTER, I_MOE_W1, I_MOE_W3, I_MOE_W2 };

struct Frame {
    LAS unsigned char* lds;
    int wave, vcu, G;
};
typedef const __attribute__((address_space(4))) Args* KArgs;
__device__ __forceinline__ KArgs kargs() { KArgs p = (KArgs)__builtin_amdgcn_kernarg_segment_ptr(); asm volatile("" : "+s"(p)); return p; }
#define INP(i) (kargs()->in[i])
#define OUTP (kargs()->out)
#define WSP (kargs()->ws)
__device__ __forceinline__ int fresh(int v) { asm volatile("" : "+v"(v)); return v; }

__device__ __forceinline__ void tr_item(const float* W, int ldw, int K, int k0, int nsrc0, const float* gain, bf16* WT, int drow0, LAS float* scr, int lane) {
    const int c4 = lane & 7, r = lane >> 3;
    const GAS float* src = (const GAS float*)W + (size_t)(k0 + r) * ldw + nsrc0 + 4 * c4;
    f32x4 v[16];
#pragma unroll
    for (int i = 0; i < 16; ++i) v[i] = *(const GAS f32x4*)(src + (size_t)(8 * i) * ldw);
    if (gain) {
#pragma unroll
        for (int i = 0; i < 16; ++i) v[i] = v[i] * gain[k0 + 8 * i + r];
    }
#pragma unroll
    for (int i = 0; i < 16; ++i) { LAS float* d = scr + (8 * i + r) * 33 + 4 * c4; d[0] = v[i].x; d[1] = v[i].y; d[2] = v[i].z; d[3] = v[i].w; }
    LDS_WAIT(); asm volatile("" ::: "memory");
    const int c16 = lane >> 2;
#pragma unroll
    for (int j = 0; j < 8; ++j) { const int n = (lane & 3) + 4 * j; const LAS float* sp = scr + (8 * c16) * 33 + n;
        v4u o; o.x = pk2(sp[0 * 33], sp[1 * 33]); o.y = pk2(sp[2 * 33], sp[3 * 33]); o.z = pk2(sp[4 * 33], sp[5 * 33]); o.w = pk2(sp[6 * 33], sp[7 * 33]);
        *(GAS v4u*)(WT + (size_t)(drow0 + n) * K + k0 + 8 * c16) = o; }
    LDS_WAIT(); asm volatile("" ::: "memory");
}
__device__ __forceinline__ void tr_plain(const float* W, int K, int N, const float* gain, bf16* WT, int drow_off, LAS float* scr, int item, int lane) {
    const int nblk = N / 32, kb = item / nblk, nb = item % nblk;
    tr_item(W, N, K, 128 * kb, 32 * nb, gain, WT, drow_off + 32 * nb, scr, lane);
}
__device__ __forceinline__ void tr_gated(const float* W, int K, int N, const float* gain, bf16* WT, int half, LAS float* scr, int item, int lane) {
    const int nblk = N / 32, kb = item / nblk, nb = item % nblk, n0 = 32 * nb;
    tr_item(W, N, K, 128 * kb, n0, gain, WT, (n0 >> 7) * 256 + half * 128 + (n0 & 127), scr, lane);
}
__device__ __forceinline__ unsigned pk_fp8x4(float a, float b, float c, float d) { int w = 0; w = __builtin_amdgcn_cvt_pk_fp8_f32(a, b, w, false); w = __builtin_amdgcn_cvt_pk_fp8_f32(c, d, w, true); return (unsigned)w; }
__device__ __forceinline__ void tr_item_f8(const float* W, int ldw, int K, int k0, int nsrc0, const float* gain, unsigned char* WT, int drow0, LAS float* scr, int lane) {
    const int c4 = lane & 7, r = lane >> 3;
    const GAS float* src = (const GAS float*)W + (size_t)(k0 + r) * ldw + nsrc0 + 4 * c4;
    f32x4 v[16];
#pragma unroll
    for (int i = 0; i < 16; ++i) v[i] = *(const GAS f32x4*)(src + (size_t)(8 * i) * ldw);
#pragma unroll
    for (int i = 0; i < 16; ++i) v[i] = v[i] * (gain ? gain[k0 + 8 * i + r] * 64.f : 64.f);
#pragma unroll
    for (int i = 0; i < 16; ++i) { LAS float* d = scr + (8 * i + r) * 33 + 4 * c4; d[0] = v[i].x; d[1] = v[i].y; d[2] = v[i].z; d[3] = v[i].w; }
    LDS_WAIT(); asm volatile("" ::: "memory");
    const int c8 = lane >> 3;
#pragma unroll
    for (int j = 0; j < 4; ++j) { const int n = (lane & 7) + 8 * j; const LAS float* sp = scr + (16 * c8) * 33 + n;
        v4u o; o.x = pk_fp8x4(sp[0 * 33], sp[1 * 33], sp[2 * 33], sp[3 * 33]); o.y = pk_fp8x4(sp[4 * 33], sp[5 * 33], sp[6 * 33], sp[7 * 33]);
        o.z = pk_fp8x4(sp[8 * 33], sp[9 * 33], sp[10 * 33], sp[11 * 33]); o.w = pk_fp8x4(sp[12 * 33], sp[13 * 33], sp[14 * 33], sp[15 * 33]);
        *(GAS v4u*)(WT + (size_t)(drow0 + n) * K + k0 + 16 * c8) = o; }
    LDS_WAIT(); asm volatile("" ::: "memory");
}
__device__ __forceinline__ float rms_row_to_bf16(const float* xrow, bf16* orow, int lane, f32x4 (&v)[4]) {
    const GAS f32x4* xr = (const GAS f32x4*)xrow + lane;
    float s = 0.f;
#pragma unroll
    for (int j = 0; j < 4; ++j) { v[j] = xr[64 * j]; s += (v[j].x * v[j].x + v[j].y * v[j].y) + (v[j].z * v[j].z + v[j].w * v[j].w); }
    const float rstd = 1.f / sqrtf(wave_sum(s) * (1.f / D) + EPS);
    GAS unsigned long long* o8 = (GAS unsigned long long*)orow + lane;
#pragma unroll
    for (int j = 0; j < 4; ++j) o8[64 * j] = (unsigned long long)pk2(v[j].x * rstd, v[j].y * rstd) | ((unsigned long long)pk2(v[j].z * rstd, v[j].w * rstd) << 32);
    return rstd;
}
__device__ __forceinline__ void norm_phase(const Frame& F, const float* x, bf16* xn) {
    const int tid = fresh(F.wave * 64 + lane_id_()), lane = tid & 63; (void)lane;
    const int gw = F.vcu * NWAVES + F.wave, NGW = F.G * NWAVES;
    for (int m = 2 * gw; m < M; m += 2 * NGW) {
        const GAS f32x4* xr = (const GAS f32x4*)(x + (size_t)m * D) + lane;
        f32x4 v[8]; float s0 = 0.f, s1 = 0.f;
#pragma unroll
        for (int j = 0; j < 8; ++j) v[j] = xr[64 * j];
#pragma unroll
        for (int j = 0; j < 4; ++j) { s0 += (v[j].x * v[j].x + v[j].y * v[j].y) + (v[j].z * v[j].z + v[j].w * v[j].w); s1 += (v[4 + j].x * v[4 + j].x + v[4 + j].y * v[4 + j].y) + (v[4 + j].z * v[4 + j].z + v[4 + j].w * v[4 + j].w); }
        const float r0 = 1.f / sqrtf(wave_sum(s0) * (1.f / D) + EPS), r1 = 1.f / sqrtf(wave_sum(s1) * (1.f / D) + EPS);
        GAS unsigned* o4 = (GAS unsigned*)((GAS unsigned char*)xn + (size_t)m * D) + lane;
#pragma unroll
        for (int j = 0; j < 8; ++j) { const float rr = j < 4 ? r0 : r1; o4[64 * j] = pk_fp8x4(v[j].x * rr, v[j].y * rr, v[j].z * rr, v[j].w * rr); }
    }
}

__device__ __forceinline__ void p0_prologue(const Frame& F) {
    const int tid = fresh(F.wave * 64 + lane_id_()), lane = tid & 63; (void)lane;
    LAS float* scr = (LAS float*)(F.lds + RING_OFF + F.wave * P0_SCR);
    unsigned char* ws = WSP;
    const int gw = F.vcu * NWAVES + F.wave, NGW = F.G * NWAVES;
    constexpr int I_DQ = 8 * 12, I_DKV = 8 * 9, I_UQ = 3 * 48, I_UKV = 2 * 64, I_SQ = 8 * 32, I_F13 = 8 * 88, I_F2 = 22 * 32, I_M13 = 8 * 112, I_M2 = 28 * 32;
    constexpr int NSMALL = I_DQ + I_DKV + I_UQ + I_UKV + I_SQ + 2 * I_F13 + I_F2 + 4 * I_SQ;
    constexpr int NITEMS = NSMALL + NE * (2 * I_M13 + I_M2);
    for (int it = gw; it < NITEMS; it += NGW) {
        int r = it;
        if (r < I_DQ)  { const int kb = r / 12, n0 = 32 * (r % 12); tr_item_f8(INP(I_A_WDQ), QLORA, D, 128 * kb, n0, INP(I_ATTN_NORM), ws + WS_WA, n0, scr, lane); continue; } r -= I_DQ;
        if (r < I_DKV) { const int kb = r / 9, n0 = 32 * (r % 9); tr_item_f8(INP(I_A_WDKV), KVLORA + ROPE_D, D, 128 * kb, n0, INP(I_ATTN_NORM), ws + WS_WA, QLORA + n0, scr, lane); continue; } r -= I_DKV;
        if (r < I_UQ)  { tr_plain(INP(I_A_WUQ), QLORA, NH * QKD, INP(I_A_GCQ), (bf16*)(ws + WS_WUQ), 0, scr, r, lane); continue; } r -= I_UQ;
        if (r < I_UKV) { const int kb = r / 64, n0 = 32 * (r % 64), head = n0 >> 7, within = n0 & 127;
            const int drow = within < 64 ? 256 * (head >> 2) + 128 * (within >> 5) + 32 * (head & 3) : 1024 + head * 64 + (within - 64);
            tr_item(INP(I_A_WUKV), NH * 128, KVLORA, 128 * kb, n0, INP(I_A_GCKV), (bf16*)(ws + WS_WUKV), drow, scr, lane); continue; } r -= I_UKV;
        if (r < I_SQ)  { const int kb = r / 32, n0 = 32 * (r % 32); tr_item_f8(INP(I_A_WO), D, D, 128 * kb, n0, nullptr, ws + WS_WO, n0, scr, lane); continue; } r -= I_SQ;
        if (r < I_F13) { tr_gated(INP(I_FFN_W1), D, FF, INP(I_FFN_NORM), (bf16*)(ws + WS_WF1), 0, scr, r, lane); continue; } r -= I_F13;
        if (r < I_F13) { tr_gated(INP(I_FFN_W3), D, FF, INP(I_FFN_NORM), (bf16*)(ws + WS_WF1), 1, scr, r, lane); continue; } r -= I_F13;
        if (r < I_F2)  { tr_plain(INP(I_FFN_W2), FF, D, nullptr, (bf16*)(ws + WS_WF2), 0, scr, r, lane); continue; } r -= I_F2;
        if (r < I_SQ)  { const int kb = r / 32, n0 = 32 * (r % 32), head = n0 >> 6;
            tr_item_f8(INP(I_KV_WK), D, D, 128 * kb, n0, INP(I_KV_NORM), ws + WS_WKVQ, 256 * (head >> 2) + 128 * ((n0 >> 5) & 1) + 32 * (head & 3), scr, lane); continue; } r -= I_SQ;
        if (r < I_SQ)  { const int kb = r / 32, n0 = 32 * (r % 32); tr_item_f8(INP(I_KV_WV), D, D, 128 * kb, n0, INP(I_KV_NORM), ws + WS_WKVQ, 2 * D + n0, scr, lane); continue; } r -= I_SQ;
        if (r < I_SQ)  { const int kb = r / 32, n0 = 32 * (r % 32), head = n0 >> 6;
            tr_item_f8(INP(I_B_WQ), D, D, 128 * kb, n0, INP(I_ATTN_NORM) + D, ws + WS_WKVQ, D + 256 * (head >> 2) + 128 * ((n0 >> 5) & 1) + 32 * (head & 3), scr, lane); continue; } r -= I_SQ;
        if (r < I_SQ)  { const int kb = r / 32, n0 = 32 * (r % 32); tr_item_f8(INP(I_B_WO), D, D, 128 * kb, n0, nullptr, ws + WS_WBO, n0, scr, lane); continue; } r -= I_SQ;
        const int e = r / (2 * I_M13 + I_M2); r -= e * (2 * I_M13 + I_M2);
        if (r < I_M13) { const int kb = r / 112, n0 = 32 * (r % 112);
            tr_item_f8(INP(I_MOE_W1) + (size_t)e * D * EFF, EFF, D, 128 * kb, n0, INP(I_FFN_NORM) + D, ws + WS_WM1 + (size_t)e * 2 * EFF * D, (n0 >> 7) * 256 + (n0 & 127), scr, lane); continue; } r -= I_M13;
        if (r < I_M13) { const int kb = r / 112, n0 = 32 * (r % 112);
            tr_item_f8(INP(I_MOE_W3) + (size_t)e * D * EFF, EFF, D, 128 * kb, n0, INP(I_FFN_NORM) + D, ws + WS_WM1 + (size_t)e * 2 * EFF * D, (n0 >> 7) * 256 + 128 + (n0 & 127), scr, lane); continue; } r -= I_M13;
        { const int kb = r / 32, n0 = 32 * (r % 32); tr_item_f8(INP(I_MOE_W2) + (size_t)e * EFF * D, D, EFF, 128 * kb, n0, nullptr, ws + WS_WM2 + (size_t)e * D * EFF, n0, scr, lane); }
    }
    const int gt = F.vcu * (NWAVES * 64) + tid, NGT = F.G * NWAVES * 64;
    for (int c = gt; c < 96 * D / 16; c += NGT) *((GAS v4u*)(ws + WS_WA + (size_t)(QLORA + KVLORA + ROPE_D) * D) + c) = (v4u){0u, 0u, 0u, 0u};
    for (int c = gt; c < SEQ * 16; c += NGT) { const int pos = c >> 4, i = c & 15;
        const float inv = __builtin_amdgcn_exp2f(-(float)i * (13.287712379549449f / 16.f));
        const float rev = (float)pos * inv * 0.15915494309189535f; const float fr = rev - floorf(rev);
        ((GAS float*)(ws + WS_ROPE))[2 * c] = __builtin_amdgcn_cosf(fr); ((GAS float*)(ws + WS_ROPE))[2 * c + 1] = __builtin_amdgcn_sinf(fr); }
    norm_phase(F, INP(I_X), (bf16*)(ws + WS_XN));
}

__device__ __forceinline__ void route_phase(const Frame& F) {
    const int tid = fresh(F.wave * 64 + lane_id_()), lane = tid & 63;
    unsigned char* ws = WSP;
    LAS float* wrg = (LAS float*)(F.lds + RING_OFF);
    LAS int* cnt = (LAS int*)(F.lds + RING_OFF + 32768);
    const float* wr = INP(I_MOE_ROUTER); const float* g = INP(I_FFN_NORM) + D;
    { float wv[16], gv[16];
#pragma unroll
      for (int it = 0; it < 16; ++it) { const int idx = tid + it * NWAVES * 64; wv[it] = wr[idx]; gv[it] = g[idx >> 3]; }
#pragma unroll
      for (int it = 0; it < 16; ++it) { const int idx = tid + it * NWAVES * 64, k = idx >> 3, e = idx & 7, l = k >> 4, i = k & 15;
          wrg[((i * 2) + (e >> 2)) * 256 + 4 * l + (e & 3)] = wv[it] * gv[it]; } }
    __syncthreads();
    const int b5 = (lane >> 5) & 1, b4 = (lane >> 4) & 1, b3 = (lane >> 3) & 1;
    typedef float f32x2 __attribute__((ext_vector_type(2)));
    f32x2 wreg[16][4];
#pragma unroll
    for (int j = 0; j < 16; ++j) { const f32x4 w0 = *(const LAS f32x4*)(wrg + (j * 2) * 256 + 4 * lane), w1 = *(const LAS f32x4*)(wrg + (j * 2 + 1) * 256 + 4 * lane);
        wreg[j][0] = (f32x2){w0.x, w0.y}; wreg[j][1] = (f32x2){w0.z, w0.w}; wreg[j][2] = (f32x2){w1.x, w1.y}; wreg[j][3] = (f32x2){w1.z, w1.w}; }
    for (int c = F.vcu; c < M / 256; c += F.G) {
        if (tid < 16) cnt[tid] = 0;
        __syncthreads();
        v4u vn[2], vm[2];
        { const GAS v4u* xr = (const GAS v4u*)(ws + WS_XR3 + (size_t)(c * 256 + F.wave * 32) * D * 2) + 2 * lane; vn[0] = xr[0]; vn[1] = xr[1]; vm[0] = xr[D * 2 / 16]; vm[1] = xr[D * 2 / 16 + 1]; }
#pragma unroll 2
        for (int i = 0; i < 32; ++i) {
            const int m = c * 256 + F.wave * 32 + i;
            const v4u q0 = vn[0], q1 = vn[1];
            vn[0] = vm[0]; vn[1] = vm[1];
            if (i + 2 < 32) { const GAS v4u* xr = (const GAS v4u*)(ws + WS_XR3 + (size_t)(m + 2) * D * 2) + 2 * lane; vm[0] = xr[0]; vm[1] = xr[1]; }
            const unsigned qw[8] = {q0.x, q0.y, q0.z, q0.w, q1.x, q1.y, q1.z, q1.w};
            float xv[16]; float ssx = 0.f;
#pragma unroll
            for (int j = 0; j < 8; ++j) { xv[2 * j] = bflo(qw[j]); xv[2 * j + 1] = bfhi(qw[j]); }
#pragma unroll
            for (int j = 0; j < 16; j += 4) ssx += (xv[j] * xv[j] + xv[j + 1] * xv[j + 1]) + (xv[j + 2] * xv[j + 2] + xv[j + 3] * xv[j + 3]);
            float lg[8];
            { f32x2 l2[4] = {{0.f, 0.f}, {0.f, 0.f}, {0.f, 0.f}, {0.f, 0.f}};
#pragma unroll
              for (int j = 0; j < 16; ++j) { const f32x2 xx = {xv[j], xv[j]};
#pragma unroll
                  for (int q = 0; q < 4; ++q) l2[q] = l2[q] + xx * wreg[j][q]; }
#pragma unroll
              for (int q = 0; q < 4; ++q) { lg[2 * q] = l2[q].x; lg[2 * q + 1] = l2[q].y; } }
            float r4[4], r2[2], r1;
#pragma unroll
            for (int e = 0; e < 4; ++e) { const float mine = b5 ? lg[4 + e] : lg[e], other = b5 ? lg[e] : lg[4 + e]; r4[e] = mine + xor32_partner(other, b5); }
#pragma unroll
            for (int e = 0; e < 2; ++e) { const float mine = b4 ? r4[2 + e] : r4[e], other = b4 ? r4[e] : r4[2 + e]; r2[e] = mine + swz_xor<16>(other); }
            { const float mine = b3 ? r2[1] : r2[0], other = b3 ? r2[0] : r2[1]; r1 = mine + swz_xor<8>(other); }
            r1 += swz_xor<4>(r1); r1 += swz_xor<2>(r1); r1 += swz_xor<1>(r1);
            const float rstd = 1.f / sqrtf(wave_sum(ssx) * (1.f / D) + EPS);
#pragma unroll
            for (int e = 0; e < 8; ++e) lg[e] = __builtin_bit_cast(float, __builtin_amdgcn_readlane(__builtin_bit_cast(int, r1), 8 * e)) * rstd;
            int e1 = 0; float l1 = lg[0];
#pragma unroll
            for (int e = 1; e < 8; ++e) if (lg[e] > l1) { l1 = lg[e]; e1 = e; }
            int e2 = -1; float l2 = -INFINITY;
#pragma unroll
            for (int e = 0; e < 8; ++e) if (e != e1 && lg[e] > l2) { l2 = lg[e]; e2 = e; }
            const float g1 = 1.f / (1.f + __expf(l2 - l1)), g2 = 1.f - g1;
            const int elo = e1 < e2 ? e1 : e2, ehi = e1 < e2 ? e2 : e1;
            const float glo = e1 < e2 ? g1 : g2, ghi = e1 < e2 ? g2 : g1;
            if (lane == 0) { ((GAS float*)(ws + WS_TOKRSTD))[m] = rstd; ((GAS int*)(ws + WS_TOKE))[m] = elo | (ehi << 8); ((GAS float*)(ws + WS_TOKG))[2 * m] = glo; ((GAS float*)(ws + WS_TOKG))[2 * m + 1] = ghi;
                atomicAdd((int*)&cnt[elo], 1); atomicAdd((int*)&cnt[8 + ehi], 1); }
        }
        __syncthreads();
        if (tid < 16) ((GAS int*)(ws + WS_CNT))[c * 16 + tid] = cnt[tid];
        __syncthreads();
    }
}

__device__ __forceinline__ void slot_phase(const Frame& F, unsigned char* ws) {
    const int tid = fresh(F.wave * 64 + lane_id_()), lane = tid & 63; (void)lane;
    LAS int* call = (LAS int*)(F.lds + RING_OFF);
    LAS int* tot = call + 4096; LAS int* base = tot + 16; LAS int* pre = base + 16; LAS int* meta = pre + 16;
    LAS int* grp = meta + 16;
    LAS int* slot_of = grp + 512;
    for (int idx = tid; idx < 4096; idx += NWAVES * 64) call[idx] = ((const GAS int*)(ws + WS_CNT))[idx];
    __syncthreads();
    if (tid < 16) { int t = 0; for (int cc = 0; cc < 256; ++cc) t += call[cc * 16 + tid]; tot[tid] = t; }
    __syncthreads();
    if (tid == 0) { int off = 0; for (int g = 0; g < 16; ++g) { base[g] = off; off += (tot[g] + 255) & ~255; if (g == 7) meta[0] = off >> 8; } meta[1] = (off >> 8) - meta[0]; }
    __syncthreads();
    for (int c = F.vcu; c < M / 256; c += F.G) {
        if (tid < 16) { int p = 0; for (int cc = 0; cc < c; ++cc) p += call[cc * 16 + tid]; pre[tid] = p; }
        const int hf = tid >> 8, i = tid & 255, m = c * 256 + i;
        const int te = ((const GAS int*)(ws + WS_TOKE))[m];
        const int g = hf * 8 + (hf ? ((te >> 8) & 0xff) : (te & 0xff));
        grp[tid] = g;
        __syncthreads();
        int rank = 0;
        for (int j = 0; j < i; ++j) rank += (grp[hf * 256 + j] == g) ? 1 : 0;
        const int slot = base[g] + pre[g] + rank;
        ((GAS int*)(ws + WS_SLOTTOK))[slot] = m; ((GAS float*)(ws + WS_SLOTGATE))[slot] = ((const GAS float*)(ws + WS_TOKG))[2 * m + hf];
        slot_of[tid] = slot;
        __syncthreads();
        for (int i0 = F.wave; i0 < 256; i0 += 4 * NWAVES) {
            v4u x[4][2]; float rs[4];
#pragma unroll
            for (int k = 0; k < 4; ++k) { const int mm = c * 256 + i0 + 8 * k; const GAS v4u* src = (const GAS v4u*)(ws + WS_XR3 + (size_t)mm * D * 2);
                x[k][0] = src[2 * lane]; x[k][1] = src[2 * lane + 1]; rs[k] = ((const GAS float*)(ws + WS_TOKRSTD))[mm]; }
#pragma unroll
            for (int k = 0; k < 4; ++k) { const int i = i0 + 8 * k; const v4u x0 = x[k][0], x1 = x[k][1]; const float r = rs[k];
                const v4u o = (v4u){pk_fp8x4(bflo(x0.x) * r, bfhi(x0.x) * r, bflo(x0.y) * r, bfhi(x0.y) * r), pk_fp8x4(bflo(x0.z) * r, bfhi(x0.z) * r, bflo(x0.w) * r, bfhi(x0.w) * r),
                                    pk_fp8x4(bflo(x1.x) * r, bfhi(x1.x) * r, bflo(x1.y) * r, bfhi(x1.y) * r), pk_fp8x4(bflo(x1.z) * r, bfhi(x1.z) * r, bflo(x1.w) * r, bfhi(x1.w) * r)};
                ((GAS v4u*)(ws + WS_XG + (size_t)slot_of[i] * D))[lane] = o; ((GAS v4u*)(ws + WS_XG + (size_t)slot_of[256 + i] * D))[lane] = o; }
        }
        __syncthreads();
    }
    for (int g = F.vcu; g < 16; g += F.G) {
        const int s0 = base[g] + tot[g], s1 = base[g] + ((tot[g] + 255) & ~255);
        for (int s = s0 + F.wave; s < s1; s += NWAVES) { GAS v4u* dst = (GAS v4u*)(ws + WS_XG + (size_t)s * D);
            dst[lane] = (v4u){0u, 0u, 0u, 0u};
            if (lane == 0) { ((GAS int*)(ws + WS_SLOTTOK))[s] = -1; ((GAS float*)(ws + WS_SLOTGATE))[s] = 0.f; } }
    }
    if (F.vcu == 0) {
        if (tid < 16) { const int p0 = base[tid] >> 8, p1 = (base[tid] + ((tot[tid] + 255) & ~255)) >> 8; for (int p = p0; p < p1; ++p) ((GAS int*)(ws + WS_PANELE))[p] = tid & 7; }
        if (tid == 0) { ((GAS int*)(ws + WS_META))[0] = meta[0]; ((GAS int*)(ws + WS_META))[1] = meta[1]; }
        if (tid < 16) ((GAS int*)(ws + WS_META))[2 + tid] = base[tid] >> 8;
        if (tid == 0) { const int nPA = meta[0], nPB = meta[1]; int x = nPB > 256 ? nPB - 256 : 0;
            if (x > 0 && nPA > 256) { int LA = 0, HB = 7;
                for (int g = 0; g < 8; ++g) { const int q0 = base[g] >> 8, q1 = q0 + ((tot[g] + 255) >> 8); if (q0 <= 256 && 256 < q1) LA = g; }
                for (int g = 8; g < 16; ++g) { const int q0 = base[g] >> 8, q1 = q0 + ((tot[g] + 255) >> 8), P = nPA + x - 1; if (q0 <= P && P < q1) HB = g - 8; }
                if (LA < HB) x = 0; }
            ((GAS int*)(ws + WS_META))[18] = x; }
    }
    __syncthreads();
}

__global__ void __launch_bounds__(NWAVES * 64, 2) yoco_fwd(Args args) {
    extern __shared__ __attribute__((aligned(16))) unsigned char lds_raw[];
    Frame F;
    F.lds = (LAS unsigned char*)lds_raw;
    F.wave = __builtin_amdgcn_readfirstlane((int)threadIdx.x >> 6);
    F.G = gridDim.x; { const int bx = blockIdx.x; F.vcu = (F.G % 8 == 0) ? (bx % 8) * (F.G / 8) + bx / 8 : bx; }
    unsigned char* ws = WSP;
    volatile LAS unsigned* MISC = (volatile LAS unsigned*)(F.lds + MISC_OFF);
    for (int u = fresh((int)threadIdx.x); u < (LDS_BYTES - LDSCTL_OFF) / 4; u += NWAVES * 64) ((LAS unsigned*)(F.lds + LDSCTL_OFF))[u] = 0u;
    __syncthreads();
    (void)xcd_barrier_post((unsigned*)(ws + WS_CTL) + CW_BAR, MISC + 8, (F.wave == 0 && lane_id_() == 0) ? 1 : 0);
    LAS unsigned char* ring = F.lds + RING_OFF;
#define bid ((int)blockIdx.x)
#define GRID_BAR() do { XcdBarrier b_; b_.t0 = (F.wave == 0 && lane_id_() == 0) ? 1 : 0; b_.bar = (unsigned*)(WSP + WS_CTL) + CW_BAR; b_.x = xb_xcc_id(); b_.st = (volatile LAS unsigned*)(F.lds + MISC_OFF) + 8; xcd_barrier(b_); } while (0)
#define GEMM(EpiT, SchedT) pg8::gemm_phase<EpiT, SchedT, true, true>

    p0_prologue(F);
    GRID_BAR();
    { pg8::Gemm g{(const bf16*)(ws + WS_XN), (const bf16*)(ws + WS_WA), M, NA, D / 2, D / 2}; pg8::StaticOrder S; S.init(M, NA, F.G, bid);
      pg8::EpiQA E{(bf16*)(ws + WS_QA), (float*)(ws + WS_PARTQA), 1.f / 64};
      pg8::gemm_phase<pg8::EpiQA, pg8::StaticOrder, true, true, true>(ring, g, S, E, F.wave); }
    GRID_BAR();
    { pg8::Gemm g{(const bf16*)(ws + WS_QA), (const bf16*)(ws + WS_WUQ), M, NH * QKD, QLORA, NA}; pg8::StaticOrder S; S.init(M, NH * QKD, F.G, bid);
      pg8::EpiRowScaleBf16 E{(bf16*)(ws + WS_Q), NH * QKD, (const float*)(ws + WS_PARTQA), 1.f / QLORA};
      GEMM(pg8::EpiRowScaleBf16, pg8::StaticOrder)(ring, g, S, E, F.wave); }
    { pg8::Gemm g{(const bf16*)(ws + WS_QA) + QLORA, (const bf16*)(ws + WS_WUKV), M, NH * 128, KVLORA, NA}; pg8::StaticOrder S; S.init(M, NH * 128, F.G, bid);
      pg8::EpiKVup E{(bf16*)(ws + WS_K), (bf16*)(ws + WS_V), (const float*)(ws + WS_PARTQA), (const bf16*)(ws + WS_QA), INP(I_A_GKN), (const float*)(ws + WS_ROPE)};
      GEMM(pg8::EpiKVup, pg8::StaticOrder)(ring, g, S, E, F.wave); }
    GRID_BAR();
    bool fastA;
    { float bq = 0.f, bk = 0.f; const int l_ = lane_id_(); for (int i = l_; i < QKD; i += 64) { bq = fmaxf(bq, fabsf(INP(I_A_GQN)[i])); bk = fmaxf(bk, fabsf(INP(I_A_GKN)[i])); }
      bq = wave_maxf(bq); bk = wave_maxf(bk); fastA = __builtin_amdgcn_readfirstlane((int)(14.42f * bq * bk <= 40.f)) != 0; }
#define P5_UNIT(NM) att::attn_unit<96, false, 1536, 1536, D, D, true, NM, 2>(ring, (const bf16*)(ws + WS_Q) + (size_t)b * SEQ * 1536 + h * QKD, (const bf16*)(ws + WS_K) + (size_t)b * SEQ * 1536 + h * QKD, \
                                      (const bf16*)(ws + WS_V) + (size_t)b * SEQ * D + h * 64, (bf16*)(ws + WS_O + (size_t)b * SEQ * D + h * 64), \
                                      256 * qb, 0, 4 * qb + 3, 0, 4 * qb + (F.wave >> 1), 0, nullptr, INP(I_A_GQN), (const float*)(ws + WS_ROPE), F.wave, true, qfA, false, false, \
                                      (const bf16*)(ws + WS_Q) + (size_t)bn * SEQ * 1536 + hh * QKD + (size_t)(256 * qbn) * 1536)
    att::attn_init<96, 1536, D, 2>(ring, F.wave);
    att::bf16x8 qfA[6]; bool qldA = false;
    for (int p = F.vcu; p < BATCH * NH * 4; p += F.G) {
        const int bh = p >> 2, pid = p & 3, b = bh >> 4, h = bh & 15;
        for (int u2 = 0; u2 < 2; ++u2) {
            const int qb = u2 ? 7 - pid : pid;
            const int pn = u2 ? p + F.G : p; const bool hn = pn < BATCH * NH * 4;
            const int bhn = pn >> 2, pidn = pn & 3, bn = bhn >> 4, hh = bhn & 15, qbn = u2 ? pidn : 7 - pidn;
            if (fastA) P5_UNIT(true); else P5_UNIT(false);
        }
    }
    GRID_BAR();
    { pg8::Gemm g{(const bf16*)(ws + WS_O), (const bf16*)(ws + WS_WO), M, D, D / 2, D / 2}; pg8::StaticOrder S; S.init(M, D, F.G, bid);
      pg8::EpiResStream<true, false, false> E{INP(I_X), (bf16*)(ws + WS_XR1), nullptr, (float*)(ws + WS_PART1), 1.f / 2048};
      pg8::gemm_phase<pg8::EpiResStream<true, false, false>, pg8::StaticOrder, true, true, true>(ring, g, S, E, F.wave); }
    GRID_BAR();
    { pg8::Gemm g{(const bf16*)(ws + WS_XR1), (const bf16*)(ws + WS_WF1), M, 2 * FF, D, D}; pg8::StaticOrder S; S.init(M, 2 * FF, F.G, bid);
      pg8::EpiGated<true> E{(bf16*)(ws + WS_H), FF, 0, (const float*)(ws + WS_PART1)};
      GEMM(pg8::EpiGated<true>, pg8::StaticOrder)(ring, g, S, E, F.wave); }
    GRID_BAR();
    { pg8::Gemm g{(const bf16*)(ws + WS_H), (const bf16*)(ws + WS_WF2), M, D, FF, FF}; pg8::StaticOrder S; S.init(M, D, F.G, bid);
      pg8::EpiResStream<true, true, true> E{ws + WS_XR1, (bf16*)(ws + WS_X2B), ws + WS_XR2, (float*)(ws + WS_PART2), 1.f};
      pg8::gemm_phase<pg8::EpiResStream<true, true, true>, pg8::StaticOrder, true, true>(ring, g, S, E, F.wave); }
    GRID_BAR();
    { pg8::Gemm g{(const bf16*)(ws + WS_XR2), (const bf16*)(ws + WS_WKVQ), M, 2 * D, D / 2, D / 2}; pg8::StaticOrder S; S.init(M, 2 * D, F.G, bid);
      pg8::EpiK2Q2 E{(bf16*)(ws + WS_KVQ2), (const float*)(ws + WS_PART2), INP(I_KV_GKN), INP(I_B_GQN), 1.f / 64};
      pg8::gemm_phase<pg8::EpiK2Q2, pg8::StaticOrder, true, true, true>(ring, g, S, E, F.wave); }
    { pg8::Gemm g{(const bf16*)(ws + WS_XR2), (const bf16*)(ws + WS_WKVQ + (size_t)2 * D * D), M, D, D / 2, D / 2}; pg8::StaticOrder S; S.init(M, D, F.G, bid);
      pg8::EpiRowScale16 E{(bf16*)(ws + WS_KVQ2), 3 * D, D, (const float*)(ws + WS_PART2), 1.f / 64};
      pg8::gemm_phase<pg8::EpiRowScale16, pg8::StaticOrder, true, true, true>(ring, g, S, E, F.wave); }
    GRID_BAR();
    bool fastB;
    { float bq = 0.f, bk = 0.f, bb = 0.f; const int l_ = lane_id_(); bq = fabsf(INP(I_B_GQN)[l_]); bk = fabsf(INP(I_KV_GKN)[l_]);
      for (int i = l_; i < NH * 257; i += 64) bb = fmaxf(bb, fabsf(INP(I_B_RELB)[i]));
      bq = wave_maxf(bq); bk = wave_maxf(bk); bb = wave_maxf(bb); fastB = __builtin_amdgcn_readfirstlane((int)(11.78f * bq * bk + 1.4427f * bb <= 40.f)) != 0; }
    att::attn_init<64, 3072, 3072, 2>(ring, F.wave);
    att::bf16x8 qfB[4]; bool qldB = false;
    int last_h = -1;
    for (int p = F.vcu; p < BATCH * NH * 8; p += F.G) {
        const int bh = p >> 3, cb = ((p & 7) + (p >> 8)) & 7, b = bh >> 4, h = bh & 15;
        const bool ldb = h != last_h; last_h = h;
        const int pn = p + F.G; const bool hn = pn < BATCH * NH * 8; const int bhn = pn >> 3, cbn = ((pn & 7) + (pn >> 8)) & 7;
        const int c0 = 4 * cb, cc = c0 + (F.wave >> 1);
        const bf16* base = (const bf16*)(ws + WS_KVQ2) + (size_t)b * SEQ * 3072 + h * 64;
#define P13_UNIT(NM) att::attn_unit<64, true, 3072, 3072, 3072, D, true, NM, 2>(ring, base + 2048, base, base + 1024, (bf16*)(ws + WS_O2 + (size_t)b * SEQ * D + h * 64), \
                                 256 * cb, c0 - 8 < 0 ? 0 : c0 - 8, c0 + 3, cc - 8 < 0 ? 0 : cc - 8, cc, cc, INP(I_B_RELB) + h * 257, nullptr, nullptr, F.wave, ldb, qfB, qldB, hn, \
                                 (const bf16*)(ws + WS_KVQ2) + (size_t)(bhn >> 4) * SEQ * 3072 + (bhn & 15) * 64 + 2048 + (size_t)(256 * cbn) * 3072)
        if (fastB) P13_UNIT(true); else P13_UNIT(false);
        qldB = hn;
    }
    GRID_BAR();
    { pg8::Gemm g{(const bf16*)(ws + WS_O2), (const bf16*)(ws + WS_WBO), M, D, D / 2, D / 2}; pg8::StaticOrder S; S.init(M, D, F.G, bid);
      pg8::EpiResStream<false, false, true> E{ws + WS_X2B, (bf16*)(ws + WS_XR3), nullptr, nullptr, 1.f / 2048};
      pg8::gemm_phase<pg8::EpiResStream<false, false, true>, pg8::StaticOrder, true, true, true>(ring, g, S, E, F.wave); }
    GRID_BAR();
    route_phase(F);
    GRID_BAR();
    slot_phase(F, ws);
    GRID_BAR();
#define MOE_LOAD(hf_) unsigned char* w2 = WSP; \
          const int nPA = __builtin_amdgcn_readfirstlane(((const GAS int*)(w2 + WS_META))[0]), nPB = __builtin_amdgcn_readfirstlane(((const GAS int*)(w2 + WS_META))[1]); (void)nPB; \
          const int xB = __builtin_amdgcn_readfirstlane(((const GAS int*)(w2 + WS_META))[18]); (void)xB; \
          const int p0 = (hf_) ? nPA : 0; int pbk[7]; \
          _Pragma("unroll") for (int k = 0; k < 7; ++k) pbk[k] = __builtin_amdgcn_readfirstlane(((const GAS int*)(w2 + WS_META))[2 + (hf_) * 8 + 1 + k]) - p0;
    constexpr size_t HMB_OFF = (size_t)MAXP_HALF * 256 * EFF;
    { MOE_LOAD(0)
      pg8::Gemm g{(const bf16*)(w2 + WS_XG), (const bf16*)(w2 + WS_WM1), nPA * 256, 2 * EFF, D / 2, D / 2};
      pg8::MoeOrder S; S.init(nPA, 2 * EFF / 256, F.G, bid);
#pragma unroll
      for (int k = 0; k < 7; ++k) S.pb[k] = pbk[k];
      pg8::EpiGatedF8 E{w2 + WS_HM, EFF, 2 * EFF / 256};
      pg8::gemm_phase<pg8::EpiGatedF8, pg8::MoeOrder, true, true, true>(ring, g, S, E, F.wave); }
    { MOE_LOAD(1)
      pg8::Gemm g{(const bf16*)(w2 + WS_XG + (size_t)p0 * 256 * D), (const bf16*)(w2 + WS_WM1), xB * 256, 2 * EFF, D / 2, D / 2};
      pg8::MoeOrder S; S.init(xB, 2 * EFF / 256, F.G, bid); S.rot = (nPA * (2 * EFF / 256)) % F.G;
#pragma unroll
      for (int k = 0; k < 7; ++k) S.pb[k] = pbk[k];
      pg8::EpiGatedF8 E{w2 + WS_HM + HMB_OFF, EFF, 2 * EFF / 256};
      pg8::gemm_phase<pg8::EpiGatedF8, pg8::MoeOrder, true, true, true>(ring, g, S, E, F.wave); }
    GRID_BAR();
    { MOE_LOAD(0)
      pg8::Gemm g{(const bf16*)(w2 + WS_HM), (const bf16*)(w2 + WS_WM2), 256 * 256, D, EFF / 2, EFF / 2};
      pg8::MoeOrder S; S.init(256, D / 256, F.G, bid);
#pragma unroll
      for (int k = 0; k < 7; ++k) S.pb[k] = pbk[k];
      pg8::EpiMoeDown<true> E{nullptr, (bf16*)(w2 + WS_XR3), (const int*)(w2 + WS_SLOTTOK), (const float*)(w2 + WS_SLOTGATE), 0, D, 1.f / 64};
      pg8::gemm_phase<pg8::EpiMoeDown<true>, pg8::MoeOrder, true, true, true>(ring, g, S, E, F.wave); }
    GRID_BAR();
    { MOE_LOAD(0)
      pg8::Gemm g{(const bf16*)(w2 + WS_HM), (const bf16*)(w2 + WS_WM2), nPA * 256, D, EFF / 2, EFF / 2};
      pg8::LeftOrder S; S.M.init(nPA, D / 256, F.G, bid); S.nLeft = 4 * (nPA - 256); S.c0 = 0; S.pbase = 256;
#pragma unroll
      for (int k = 0; k < 7; ++k) S.M.pb[k] = pbk[k];
      pg8::EpiMoeDown<true> E{nullptr, (bf16*)(w2 + WS_XR3), (const int*)(w2 + WS_SLOTTOK), (const float*)(w2 + WS_SLOTGATE), 0, D, 1.f / 64};
      pg8::gemm_phase<pg8::EpiMoeDown<true>, pg8::LeftOrder, true, true, true>(ring, g, S, E, F.wave); }
    { MOE_LOAD(1)
      pg8::Gemm g{(const bf16*)(w2 + WS_HM + HMB_OFF), (const bf16*)(w2 + WS_WM2), xB * 256, D, EFF / 2, EFF / 2};
      pg8::LeftOrder S; S.M.init(xB, D / 256, F.G, bid); S.nLeft = 4 * xB; S.c0 = 4 * (nPA - 256); S.pbase = 0;
#pragma unroll
      for (int k = 0; k < 7; ++k) S.M.pb[k] = pbk[k];
      pg8::EpiMoeDown<false> E{OUTP, (bf16*)(w2 + WS_XR3), (const int*)(w2 + WS_SLOTTOK), (const float*)(w2 + WS_SLOTGATE), p0 * 256, D, 1.f / 64};
      pg8::gemm_phase<pg8::EpiMoeDown<false>, pg8::LeftOrder, true, true, true>(ring, g, S, E, F.wave); }
    { MOE_LOAD(1)
      pg8::Gemm g{(const bf16*)(w2 + WS_XG + (size_t)(p0 + xB) * 256 * D), (const bf16*)(w2 + WS_WM1), (nPB - xB) * 256, 2 * EFF, D / 2, D / 2};
      pg8::MoeOrder S; S.init(nPB - xB, 2 * EFF / 256, F.G, bid); S.nBusy = 4 * (nPA - 256) + 4 * xB; S.SK = 4;
#pragma unroll
      for (int k = 0; k < 7; ++k) S.pb[k] = pbk[k] - xB;
      pg8::EpiGatedF8 E{w2 + WS_HM + HMB_OFF + (size_t)xB * 256 * EFF, EFF, 2 * EFF / 256};
      pg8::gemm_phase<pg8::EpiGatedF8, pg8::MoeOrder, true, true, true>(ring, g, S, E, F.wave); }
    GRID_BAR();
    { MOE_LOAD(1)
      pg8::Gemm g{(const bf16*)(w2 + WS_HM + HMB_OFF + (size_t)xB * 256 * EFF), (const bf16*)(w2 + WS_WM2), (nPB - xB) * 256, D, EFF / 2, EFF / 2};
      pg8::MoeOrder S; S.init(nPB - xB, D / 256, F.G, bid);
#pragma unroll
      for (int k = 0; k < 7; ++k) S.pb[k] = pbk[k] - xB;
      pg8::EpiMoeDown<false> E{OUTP, (bf16*)(w2 + WS_XR3), (const int*)(w2 + WS_SLOTTOK), (const float*)(w2 + WS_SLOTGATE), (p0 + xB) * 256, D, 1.f / 64};
      pg8::gemm_phase<pg8::EpiMoeDown<false>, pg8::MoeOrder, true, true, true>(ring, g, S, E, F.wave); }
#undef MOE_LOAD
#undef GRID_BAR
#undef bid
#undef GEMM
}

extern "C" void kernel_launch(void* const* d_in, const int* in_sizes, int n_in, void* d_out, int out_size, void* d_ws, size_t ws_size, hipStream_t stream) {
    static int grid = 0;
    if (grid == 0) {
        if (n_in != 27 || in_sizes[0] != M * D || out_size != M * D || ws_size < WS_END) { fprintf(stderr, "kernel_launch: unexpected shapes (n_in %d, in0 %d, out %d, ws %zu < %zu); nothing launched\n", n_in, n_in > 0 ? in_sizes[0] : -1, out_size, ws_size, (size_t)WS_END); grid = -1; return; }
        int dev = 0, cus = 0, per_cu = 0;
        if (hipGetDevice(&dev) != hipSuccess || hipDeviceGetAttribute(&cus, hipDeviceAttributeMultiprocessorCount, dev) != hipSuccess) { grid = -1; return; }
        if (hipFuncSetAttribute((const void*)yoco_fwd, hipFuncAttributeMaxDynamicSharedMemorySize, LDS_BYTES) != hipSuccess) { fprintf(stderr, "kernel_launch: hipFuncSetAttribute failed\n"); grid = -1; return; }
        if (hipOccupancyMaxActiveBlocksPerMultiprocessor(&per_cu, (const void*)yoco_fwd, NWAVES * 64, LDS_BYTES) != hipSuccess || per_cu < 1) { fprintf(stderr, "kernel_launch: occupancy query says %d\n", per_cu); }
        (void)hipGetLastError();
        grid = cus;
    }
    if (grid < 0) return;
    if (hipMemsetAsync((char*)d_ws + WS_CTL, 0, CTL_ZERO_BYTES, stream) != hipSuccess) return;
    Args a{};
    for (int i = 0; i < 27; ++i) a.in[i] = (const float*)d_in[i];
    a.out = (float*)d_out; a.ws = (unsigned char*)d_ws;
    hipLaunchKernelGGL(yoco_fwd, dim3(grid), dim3(NWAVES * 64), LDS_BYTES, stream, a);
}
```

```cpp
#include <hip/hip_runtime.h>
#include <cstdio>
#include <cstdint>
__device__ __forceinline__ int lane_id_() { unsigned m_ = ~0u; asm volatile("" : "+s"(m_)); return (int)__builtin_amdgcn_mbcnt_hi(m_, __builtin_amdgcn_mbcnt_lo(m_, 0u)); }
template <int X> __device__ __forceinline__ float swz_xor(float v) { return __builtin_bit_cast(float, __builtin_amdgcn_ds_swizzle(__builtin_bit_cast(int, v), (X << 10) | 0x1f)); }
__device__ __forceinline__ void halves32(float v, float& r_lo, float& r_hi) { unsigned a_ = __builtin_bit_cast(unsigned, v), b_ = a_;
    asm volatile("s_nop 1\n\tv_permlane32_swap_b32 %0, %1\n\ts_nop 1" : "+v"(a_), "+v"(b_)); r_lo = __builtin_bit_cast(float, a_); r_hi = __builtin_bit_cast(float, b_); }
__device__ __forceinline__ float xor32_partner(float v, int upper_half) { float lo, hi; halves32(v, lo, hi); return upper_half ? lo : hi; }
__device__ __forceinline__ float xor32_sum(float v) { float lo, hi; halves32(v, lo, hi); return lo + hi; }
__device__ __forceinline__ float xor32_max(float v) { float lo, hi; halves32(v, lo, hi); return fmaxf(lo, hi); }
namespace pg8 {
#define PG8_LAS __attribute__((address_space(3)))
typedef unsigned short bf16_t;
typedef short bf16x8 __attribute__((ext_vector_type(8)));
typedef float f32x4 __attribute__((ext_vector_type(4)));
typedef unsigned u32x4 __attribute__((ext_vector_type(4)));
constexpr int BM = 256, BK = 64, HALF = 128, HTB = HALF * BK * 2  , STAGE_BYTES = 8 * HTB, NXCD = 8, WGM = 8;

__host__ __device__ __forceinline__ int lds_byte(int r, int c) { const int st = (r >> 4) * 2 + (c >> 5), rr = r & 15, cc = c & 31, ob = rr * 64 + cc * 2; return st * 1024 + (ob ^ (((ob >> 9) & 1) << 5)); }
__host__ __device__ __forceinline__ void stage_rc(int b, int& R, int& C) { const int st = b / 1024, sb = b % 1024, swz = sb ^ (((sb >> 9) & 1) << 5); R = (st >> 1) * 16 + swz / 64; C = (st & 1) * 32 + (swz % 64) / 2; }
__host__ __device__ __forceinline__ int perm32(int rho) { const int n = rho >> 4, i = rho & 15; return 8 * (i >> 2) + 4 * n + (i & 3); }

struct Unit { int pm, pn; };
struct Gemm { const bf16_t* A; const bf16_t* Bt; int M, N, K, lda; };

struct StaticOrder {
    int nM, nN, nwg, G, c;
    __host__ __device__ void init(int M, int N, int G_, int c_) { nM = M / BM; nN = N / BM; nwg = nM * nN; G = G_; c = c_; }
    __host__ __device__ bool next(int i, Unit& u) const {
        const int L = i * G + c; if (L >= nwg) return false;
        int wgid = L; { const int q = nwg / NXCD, r = nwg % NXCD, xcd = wgid % NXCD, off = wgid / NXCD; wgid = (xcd < r ? xcd * (q + 1) : r * (q + 1) + (xcd - r) * q) + off; }
        const int nig = WGM * nN, gid = wgid / nig, fm = gid * WGM, gsz = (nM - fm) < WGM ? (nM - fm) : WGM;
        u.pm = fm + ((wgid % nig) % gsz); u.pn = (wgid % nig) / gsz; return true;
    }
    __device__ __forceinline__ void a_ready(const Unit&) const {}
    __device__ __forceinline__ void done(const Unit&) const {}
};
__device__ __forceinline__ unsigned cvt_pk_bf16(float lo, float hi) { unsigned r; asm volatile("v_cvt_pk_bf16_f32 %0, %1, %2" : "=v"(r) : "v"(lo), "v"(hi)); return r; }
__device__ __forceinline__ float silu_f(float x) { const float e = __builtin_amdgcn_exp2f(x * -1.4426950408889634f); return x * __builtin_amdgcn_rcpf(1.f + e); }

__device__ __forceinline__ float sum4(const f32x4& a) { return (a[0] + a[1]) + (a[2] + a[3]); }
__device__ __forceinline__ float part_sum8(const float* p) { return sum4(*(const f32x4*)p) + sum4(*(const f32x4*)(p + 4)); }
__device__ __forceinline__ float part_sum16(const float* p) { return (sum4(*(const f32x4*)p) + sum4(*(const f32x4*)(p + 4))) + (sum4(*(const f32x4*)(p + 8)) + sum4(*(const f32x4*)(p + 12))); }
__device__ __forceinline__ float fq_sum(float v) { v += swz_xor<16>(v); return xor32_sum(v); }
__device__ __forceinline__ float sq8(const f32x4& a, const f32x4& b) { return ((a[0] * a[0] + a[1] * a[1]) + (a[2] * a[2] + a[3] * a[3])) + ((b[0] * b[0] + b[1] * b[1]) + (b[2] * b[2] + b[3] * b[3])); }
__device__ __forceinline__ u32x4 pack8(const f32x4& a, const f32x4& b) { u32x4 w; w.x = cvt_pk_bf16(a[0], a[1]); w.y = cvt_pk_bf16(a[2], a[3]); w.z = cvt_pk_bf16(b[0], b[1]); w.w = cvt_pk_bf16(b[2], b[3]); return w; }
constexpr float EPS_ = 1e-6f;
__device__ __forceinline__ unsigned pk_fp8x4(float a, float b, float c, float d) { int w = 0; w = __builtin_amdgcn_cvt_pk_fp8_f32(a, b, w, false); w = __builtin_amdgcn_cvt_pk_fp8_f32(c, d, w, true); return (unsigned)w; }

struct EpiQA {
    static constexpr bool PERM = true, AFTER_DRAIN = false;
    bf16_t* O; float* part; float wscale;
    __device__ __forceinline__ void operator()(const f32x4 (&acc)[2][2][4][2], const Unit& u, int wr, int wc, int fr, int fq) const {
        { int t_ = lane_id_(); asm volatile("" : "+v"(t_)); fr = t_ & 15; fq = (t_ >> 4) & 3; }
        const int row0 = u.pm * BM + wr * 64 + fr, col0 = u.pn * BM + wc * 32 + 8 * fq;
#pragma unroll
        for (int ai = 0; ai < 2; ++ai)
#pragma unroll
            for (int m = 0; m < 4; ++m) { const int row = row0 + ai * HALF + m * 16; bf16_t* rowp = O + (size_t)row * 768 + col0;
                const f32x4 a0 = acc[ai][0][m][0] * wscale, a1 = acc[ai][0][m][1] * wscale, b0 = acc[ai][1][m][0] * wscale, b1 = acc[ai][1][m][1] * wscale;
                *(u32x4*)(rowp) = pack8(a0, a1); *(u32x4*)(rowp + HALF) = pack8(b0, b1);
                const float s0 = sq8(a0, a1), s1 = sq8(b0, b1);
                float* pr = part + (size_t)row * 16;
                if (u.pn == 0) { const float t = fq_sum(s0 + s1); if (fq == 0) pr[wc] = t; }
                else if (u.pn == 1) { const float t0 = fq_sum(s0), t1 = fq_sum(s1); if (fq == 0) { pr[4 + wc] = t0; pr[8 + wc] = t1; } }
                else { const float t = fq_sum(s0); if (fq == 0) pr[12 + wc] = t; } }
    }
};

struct EpiRowScaleBf16 {
    static constexpr bool PERM = true, AFTER_DRAIN = false;
    bf16_t* O; int ldc; const float* part; float inv_n;
    __device__ __forceinline__ void operator()(const f32x4 (&acc)[2][2][4][2], const Unit& u, int wr, int wc, int fr, int fq) const {
        { int t_ = lane_id_(); asm volatile("" : "+v"(t_)); fr = t_ & 15; fq = (t_ >> 4) & 3; }
        const int row0 = u.pm * BM + wr * 64 + fr, col0 = u.pn * BM + wc * 32 + 8 * fq;
#pragma unroll
        for (int ai = 0; ai < 2; ++ai)
#pragma unroll
            for (int m = 0; m < 4; ++m) { const int row = row0 + ai * HALF + m * 16; bf16_t* rowp = O + (size_t)row * ldc + col0;
                const float rs = __builtin_amdgcn_rsqf(part_sum8(part + (size_t)row * 16) * inv_n + EPS_);
                *(u32x4*)(rowp) = pack8(acc[ai][0][m][0] * rs, acc[ai][0][m][1] * rs); *(u32x4*)(rowp + HALF) = pack8(acc[ai][1][m][0] * rs, acc[ai][1][m][1] * rs); }
    }
};

struct EpiKVup {
    static constexpr bool PERM = true, AFTER_DRAIN = false;
    bf16_t* Kd; bf16_t* Vd; const float* part; const bf16_t* QA; const float* g_kn; const float* rope;
    __device__ __forceinline__ void operator()(const f32x4 (&acc)[2][2][4][2], const Unit& u, int wr, int wc, int fr, int fq) const {
        { int t_ = lane_id_(); asm volatile("" : "+v"(t_)); fr = t_ & 15; fq = (t_ >> 4) & 3; }
        const int row0 = u.pm * BM + wr * 64 + fr;
        if (u.pn >= 4) {
            const int col0 = (u.pn - 4) * BM + wc * 32 + 8 * fq;
#pragma unroll
            for (int ai = 0; ai < 2; ++ai)
#pragma unroll
                for (int m = 0; m < 4; ++m) { const int row = row0 + ai * HALF + m * 16; bf16_t* rowp = Vd + (size_t)row * 1024 + col0;
                    const float rs = __builtin_amdgcn_rsqf(part_sum8(part + (size_t)row * 16 + 8) * (1.f / 256) + EPS_);
                    *(u32x4*)(rowp) = pack8(acc[ai][0][m][0] * rs, acc[ai][0][m][1] * rs); *(u32x4*)(rowp + HALF) = pack8(acc[ai][1][m][0] * rs, acc[ai][1][m][1] * rs); }
            return;
        }
        const int head = 4 * u.pn + wc;
        f32x4 gA0 = *(const f32x4*)(g_kn + 8 * fq), gA1 = *(const f32x4*)(g_kn + 8 * fq + 4), gB0 = *(const f32x4*)(g_kn + 32 + 8 * fq), gB1 = *(const f32x4*)(g_kn + 32 + 8 * fq + 4);
        const f32x4 gR1 = *(const f32x4*)(g_kn + 64 + 4 * fq), gR2 = *(const f32x4*)(g_kn + 80 + 4 * fq);
#pragma unroll
        for (int ai = 0; ai < 2; ++ai)
#pragma unroll
            for (int m = 0; m < 4; ++m) { const int row = row0 + ai * HALF + m * 16;
                const float rs = __builtin_amdgcn_rsqf(part_sum8(part + (size_t)row * 16 + 8) * (1.f / 256) + EPS_);
                f32x4 a0 = acc[ai][0][m][0] * rs, a1 = acc[ai][0][m][1] * rs, b0 = acc[ai][1][m][0] * rs, b1 = acc[ai][1][m][1] * rs;
                const unsigned long long p1 = *(const unsigned long long*)(QA + (size_t)row * 768 + 640 + 4 * fq), p2 = *(const unsigned long long*)(QA + (size_t)row * 768 + 656 + 4 * fq);
                f32x4 x1, x2;
                x1[0] = __builtin_bit_cast(float, (unsigned)(p1 << 16)); x1[1] = __builtin_bit_cast(float, (unsigned)p1 & 0xffff0000u);
                x1[2] = __builtin_bit_cast(float, (unsigned)(p1 >> 32) << 16); x1[3] = __builtin_bit_cast(float, (unsigned)(p1 >> 32) & 0xffff0000u);
                x2[0] = __builtin_bit_cast(float, (unsigned)(p2 << 16)); x2[1] = __builtin_bit_cast(float, (unsigned)p2 & 0xffff0000u);
                x2[2] = __builtin_bit_cast(float, (unsigned)(p2 >> 32) << 16); x2[3] = __builtin_bit_cast(float, (unsigned)(p2 >> 32) & 0xffff0000u);
                const float ss = fq_sum(sq8(a0, a1) + sq8(b0, b1) + sq8(x1, x2));
                const float sh = __builtin_amdgcn_rsqf(ss * (1.f / 96) + EPS_);
                bf16_t* kp = Kd + (size_t)row * 1536 + head * 96;
                *(u32x4*)(kp + 8 * fq) = pack8(a0 * gA0 * sh, a1 * gA1 * sh); *(u32x4*)(kp + 32 + 8 * fq) = pack8(b0 * gB0 * sh, b1 * gB1 * sh);
                const f32x4* rp = (const f32x4*)(rope + ((size_t)(row & 2047) * 16 + 4 * fq) * 2);
                const f32x4 c01 = rp[0], c23 = rp[1];
                const f32x4 y1 = x1 * gR1 * sh, y2 = x2 * gR2 * sh;
                f32x4 o1, o2;
                o1[0] = y1[0] * c01[0] - y2[0] * c01[1]; o2[0] = y2[0] * c01[0] + y1[0] * c01[1];
                o1[1] = y1[1] * c01[2] - y2[1] * c01[3]; o2[1] = y2[1] * c01[2] + y1[1] * c01[3];
                o1[2] = y1[2] * c23[0] - y2[2] * c23[1]; o2[2] = y2[2] * c23[0] + y1[2] * c23[1];
                o1[3] = y1[3] * c23[2] - y2[3] * c23[3]; o2[3] = y2[3] * c23[2] + y1[3] * c23[3];
                unsigned long long w1 = (unsigned long long)cvt_pk_bf16(o1[0], o1[1]) | ((unsigned long long)cvt_pk_bf16(o1[2], o1[3]) << 32);
                unsigned long long w2 = (unsigned long long)cvt_pk_bf16(o2[0], o2[1]) | ((unsigned long long)cvt_pk_bf16(o2[2], o2[3]) << 32);
                *(unsigned long long*)(kp + 64 + 4 * fq) = w1; *(unsigned long long*)(kp + 80 + 4 * fq) = w2; }
    }
};

struct EpiK2Q2 {
    static constexpr bool PERM = true, AFTER_DRAIN = false;
    bf16_t* O; const float* pss; const float* gk; const float* gq; float wscale;
    __device__ __forceinline__ void operator()(const f32x4 (&acc)[2][2][4][2], const Unit& u, int wr, int wc, int fr, int fq) const {
        { int t_ = lane_id_(); asm volatile("" : "+v"(t_)); fr = t_ & 15; fq = (t_ >> 4) & 3; }
        const int row0 = u.pm * BM + wr * 64 + fr, isq = u.pn >> 2, tl = u.pn & 3;
        const float* g = isq ? gq : gk; const float post = isq ? 0.125f * 1.4426950408889634f : 1.f;
        const f32x4 gA0 = *(const f32x4*)(g + 8 * fq) * post, gA1 = *(const f32x4*)(g + 8 * fq + 4) * post, gB0 = *(const f32x4*)(g + 32 + 8 * fq) * post, gB1 = *(const f32x4*)(g + 32 + 8 * fq + 4) * post;
        const int colh = isq * 2048 + (4 * tl + wc) * 64;
        unsigned zhi_ = 0u; asm volatile("" : "+v"(zhi_));
        const unsigned long long coff = ((unsigned long long)zhi_ << 32) | (unsigned)((colh + 8 * fq) * 2);
#pragma unroll
        for (int ai = 0; ai < 2; ++ai)
#pragma unroll
            for (int m = 0; m < 4; ++m) { const int row = row0 + ai * HALF + m * 16; unsigned char* rowp = (unsigned char*)O + (size_t)row * 6144 + coff;
                const float rs = __builtin_amdgcn_rsqf(part_sum16(pss + (size_t)row * 16) * (1.f / 1024) + EPS_) * wscale;
                const f32x4 a0 = acc[ai][0][m][0] * rs, a1 = acc[ai][0][m][1] * rs, b0 = acc[ai][1][m][0] * rs, b1 = acc[ai][1][m][1] * rs;
                const float ss = fq_sum(sq8(a0, a1) + sq8(b0, b1));
                const float sh = __builtin_amdgcn_rsqf(ss * (1.f / 64) + EPS_);
                *(u32x4*)(rowp) = pack8(a0 * gA0 * sh, a1 * gA1 * sh); *(u32x4*)(rowp + 64) = pack8(b0 * gB0 * sh, b1 * gB1 * sh); }
    }
};
struct EpiRowScale16 {
    static constexpr bool PERM = true, AFTER_DRAIN = false;
    bf16_t* O; int ldc; int coff; const float* pss; float wscale;
    __device__ __forceinline__ void operator()(const f32x4 (&acc)[2][2][4][2], const Unit& u, int wr, int wc, int fr, int fq) const {
        { int t_ = lane_id_(); asm volatile("" : "+v"(t_)); fr = t_ & 15; fq = (t_ >> 4) & 3; }
        const int row0 = u.pm * BM + wr * 64 + fr, col0 = coff + u.pn * BM + wc * 32 + 8 * fq;
#pragma unroll
        for (int ai = 0; ai < 2; ++ai)
#pragma unroll
            for (int m = 0; m < 4; ++m) { const int row = row0 + ai * HALF + m * 16; bf16_t* rowp = O + (size_t)row * ldc + col0;
                const float rs = __builtin_amdgcn_rsqf(part_sum16(pss + (size_t)row * 16) * (1.f / 1024) + EPS_) * wscale;
                *(u32x4*)(rowp) = pack8(acc[ai][0][m][0] * rs, acc[ai][0][m][1] * rs); *(u32x4*)(rowp + HALF) = pack8(acc[ai][1][m][0] * rs, acc[ai][1][m][1] * rs); }
    }
};

template <bool SSQ> struct EpiGated {
    static constexpr bool PERM = true, AFTER_DRAIN = false;
    bf16_t* Hd; int ldc; int ntile; const float* rs;
    __device__ __forceinline__ void operator()(const f32x4 (&acc)[2][2][4][2], const Unit& u, int wr, int wc, int fr, int fq) const {
        { int t_ = lane_id_(); asm volatile("" : "+v"(t_)); fr = t_ & 15; fq = (t_ >> 4) & 3; }
        const int pnl = ntile ? (u.pn % ntile) : u.pn;
        const int row0 = u.pm * BM + wr * 64 + fr, col0 = pnl * HALF + wc * 32 + 8 * fq;
#pragma unroll
        for (int ai = 0; ai < 2; ++ai)
#pragma unroll
            for (int m = 0; m < 4; ++m) { const int row = row0 + ai * HALF + m * 16; bf16_t* rowp = Hd + (size_t)row * ldc + col0;
                const float r = SSQ ? __builtin_amdgcn_rsqf(part_sum16(rs + (size_t)row * 16) * (1.f / 1024) + EPS_) : rs[row];
                const f32x4 g0 = acc[ai][0][m][0] * r, g1 = acc[ai][0][m][1] * r, u0 = acc[ai][1][m][0] * r, u1 = acc[ai][1][m][1] * r;
                u32x4 w;
                w.x = cvt_pk_bf16(silu_f(g0[0]) * u0[0], silu_f(g0[1]) * u0[1]); w.y = cvt_pk_bf16(silu_f(g0[2]) * u0[2], silu_f(g0[3]) * u0[3]);
                w.z = cvt_pk_bf16(silu_f(g1[0]) * u1[0], silu_f(g1[1]) * u1[1]); w.w = cvt_pk_bf16(silu_f(g1[2]) * u1[2], silu_f(g1[3]) * u1[3]);
                *(u32x4*)rowp = w; }
    }
};

template <bool RS = false, bool SC64 = true> struct EpiGatedF8T {
    static constexpr bool PERM = true, AFTER_DRAIN = false;
    unsigned char* Hd; int ldc; int ntile; const float* rs;
    static __device__ __forceinline__ float gate(float g, float u) {
        if constexpr (SC64) { const float e = __builtin_amdgcn_exp2f(g * (-1.4426950408889634f / 64.f)); return (g * u) * (__builtin_amdgcn_rcpf(1.f + e) * (1.f / 4096.f)); }
        else { const float e = __builtin_amdgcn_exp2f(g * -1.4426950408889634f); return (g * u) * __builtin_amdgcn_rcpf(1.f + e); } }
    __device__ __forceinline__ void operator()(const f32x4 (&acc)[2][2][4][2], const Unit& u, int wr, int wc, int fr, int fq) const {
        { int t_ = lane_id_(); asm volatile("" : "+v"(t_)); fr = t_ & 15; fq = (t_ >> 4) & 3; }
        const int pnl = ntile ? (u.pn % ntile) : u.pn;
        const int row0 = u.pm * BM + wr * 64 + fr, col0 = pnl * HALF + wc * 32 + 8 * fq;
#pragma unroll
        for (int ai = 0; ai < 2; ++ai)
#pragma unroll
            for (int m = 0; m < 4; ++m) { const int row = row0 + ai * HALF + m * 16; unsigned char* rowp = Hd + (size_t)row * ldc + col0;
                f32x4 g0 = acc[ai][0][m][0], g1 = acc[ai][0][m][1], u0 = acc[ai][1][m][0], u1 = acc[ai][1][m][1];
                if constexpr (RS) { const float r = __builtin_amdgcn_rsqf(part_sum16(rs + (size_t)row * 16) * (1.f / 1024) + EPS_); g0 = g0 * r; g1 = g1 * r; u0 = u0 * r; u1 = u1 * r; }
                unsigned long long w = (unsigned long long)pk_fp8x4(gate(g0[0], u0[0]), gate(g0[1], u0[1]), gate(g0[2], u0[2]), gate(g0[3], u0[3]))
                                     | ((unsigned long long)pk_fp8x4(gate(g1[0], u1[0]), gate(g1[1], u1[1]), gate(g1[2], u1[2]), gate(g1[3], u1[3])) << 32);
                *(unsigned long long*)rowp = w; }
    }
};
typedef EpiGatedF8T<false, true> EpiGatedF8;

template <bool SSQ, bool XF8, bool RES16> struct EpiResStream {
    static constexpr bool PERM = true, AFTER_DRAIN = false;
    const void* res; bf16_t* XB; unsigned char* X8; float* ssq; float ascale;
    __device__ __forceinline__ void operator()(const f32x4 (&acc)[2][2][4][2], const Unit& u, int wr, int wc, int fr, int fq) const {
        { int t_ = lane_id_(); asm volatile("" : "+v"(t_)); fr = t_ & 15; fq = (t_ >> 4) & 3; }
        const int row0 = u.pm * BM + wr * 64 + fr, col0 = u.pn * BM + wc * 32 + 8 * fq;
        f32x4 rw[4][2][2];
#define ERS_ROW(it) (row0 + ((it) >> 2) * HALF + ((it) & 3) * 16)
#define ERS_LOAD(it) do { const size_t ro_ = (size_t)ERS_ROW(it) * 1024 + col0; _Pragma("unroll") for (int bj = 0; bj < 2; ++bj) { \
            if constexpr (RES16) rw[(it) & 3][bj][0] = __builtin_bit_cast(f32x4, *(const u32x4*)((const bf16_t*)res + ro_ + bj * HALF)); \
            else { _Pragma("unroll") for (int n = 0; n < 2; ++n) rw[(it) & 3][bj][n] = *(const f32x4*)((const float*)res + ro_ + bj * HALF + n * 4); } } } while (0)
        ERS_LOAD(0); ERS_LOAD(1); ERS_LOAD(2); ERS_LOAD(3);
#pragma unroll
        for (int it = 0; it < 8; ++it) { const int ai = it >> 2, m = it & 3; const int row = ERS_ROW(it); const size_t ro = (size_t)row * 1024 + col0;
                f32x4 r[2][2];
#pragma unroll
                for (int bj = 0; bj < 2; ++bj) {
                    if constexpr (RES16) { const u32x4 w = __builtin_bit_cast(u32x4, rw[it & 3][bj][0]);
                        r[bj][0] = (f32x4){__builtin_bit_cast(float, w.x << 16), __builtin_bit_cast(float, w.x & 0xffff0000u), __builtin_bit_cast(float, w.y << 16), __builtin_bit_cast(float, w.y & 0xffff0000u)};
                        r[bj][1] = (f32x4){__builtin_bit_cast(float, w.z << 16), __builtin_bit_cast(float, w.z & 0xffff0000u), __builtin_bit_cast(float, w.w << 16), __builtin_bit_cast(float, w.w & 0xffff0000u)}; }
                    else { r[bj][0] = rw[it & 3][bj][0]; r[bj][1] = rw[it & 3][bj][1]; }
                    r[bj][0] = r[bj][0] + acc[ai][bj][m][0] * ascale; r[bj][1] = r[bj][1] + acc[ai][bj][m][1] * ascale; }
                if (it + 4 < 8) ERS_LOAD(it + 4);
                *(u32x4*)(XB + ro) = pack8(r[0][0], r[0][1]); *(u32x4*)(XB + ro + HALF) = pack8(r[1][0], r[1][1]);
                if constexpr (XF8) { unsigned char* x8 = X8 + ro;
                    *(unsigned long long*)(x8) = (unsigned long long)pk_fp8x4(r[0][0][0], r[0][0][1], r[0][0][2], r[0][0][3]) | ((unsigned long long)pk_fp8x4(r[0][1][0], r[0][1][1], r[0][1][2], r[0][1][3]) << 32);
                    *(unsigned long long*)(x8 + HALF) = (unsigned long long)pk_fp8x4(r[1][0][0], r[1][0][1], r[1][0][2], r[1][0][3]) | ((unsigned long long)pk_fp8x4(r[1][1][0], r[1][1][1], r[1][1][2], r[1][1][3]) << 32); }
                if (SSQ) { const float t = fq_sum(sq8(r[0][0], r[0][1]) + sq8(r[1][0], r[1][1])); if (fq == 0) ssq[(size_t)row * 16 + u.pn * 4 + wc] = t; } }
#undef ERS_LOAD
#undef ERS_ROW
    }
};

template <bool FIRST> struct EpiMoeDown {
    static constexpr bool PERM = false, AFTER_DRAIN = false;
    float* out; bf16_t* xb; const int* slot_tok; const float* slot_gate; int slot_base; int ldc; float wscale;
    __device__ __forceinline__ void operator()(const f32x4 (&acc)[2][2][4][2], const Unit& u, int wr, int wc, int fr, int fq) const {
        { int t_ = lane_id_(); asm volatile("" : "+v"(t_)); fr = t_ & 15; fq = (t_ >> 4) & 3; }
        const int pnl = u.pn & 3;
        const int row0 = slot_base + u.pm * BM + wr * 64 + fr, col0 = pnl * BM + wc * 32 + 4 * fq;
        int tk[8]; float gt[8];
#pragma unroll
        for (int it = 0; it < 8; ++it) { const int slot = row0 + (it >> 2) * HALF + (it & 3) * 16; tk[it] = slot_tok[slot]; gt[it] = slot_gate[slot] * wscale; }
        unsigned rlo[4][2][2], rhi[4][2][2];
#define EMD_LOAD(it) do { if (tk[it] >= 0) { _Pragma("unroll") for (int bj = 0; bj < 2; ++bj) _Pragma("unroll") for (int n = 0; n < 2; ++n) { \
            const unsigned long long q_ = *(const unsigned long long*)(xb + (size_t)tk[it] * ldc + col0 + bj * HALF + n * 16); \
            rlo[(it) & 3][bj][n] = (unsigned)q_; rhi[(it) & 3][bj][n] = (unsigned)(q_ >> 32); } } } while (0)
        EMD_LOAD(0); EMD_LOAD(1); EMD_LOAD(2); EMD_LOAD(3);
#pragma unroll
        for (int it = 0; it < 8; ++it) { const int ai = it >> 2, m = it & 3;
            if (tk[it] >= 0) { const size_t ro = (size_t)tk[it] * ldc + col0;
#pragma unroll
                for (int bj = 0; bj < 2; ++bj)
#pragma unroll
                    for (int n = 0; n < 2; ++n) { const unsigned lo = rlo[it & 3][bj][n], hi = rhi[it & 3][bj][n];
                        f32x4 r = (f32x4){__builtin_bit_cast(float, lo << 16), __builtin_bit_cast(float, lo & 0xffff0000u), __builtin_bit_cast(float, hi << 16), __builtin_bit_cast(float, hi & 0xffff0000u)};
                        r = r + acc[ai][bj][m][n] * gt[it];
                        if constexpr (FIRST) *(unsigned long long*)(xb + ro + bj * HALF + n * 16) = (unsigned long long)cvt_pk_bf16(r[0], r[1]) | ((unsigned long long)cvt_pk_bf16(r[2], r[3]) << 32);
                        else *(f32x4*)(out + ro + bj * HALF + n * 16) = r; } }
            if (it + 4 < 8) EMD_LOAD(it + 4); }
#undef EMD_LOAD
    }
};

struct MoeOrder {
    int nM, nN, nwg, G, c; int pb[7];
    int rot;
    int nBusy, SK;
    __device__ void init(int nPanels, int nN_, int G_, int c_) { nM = nPanels; nN = nN_; nwg = nM * nN; G = G_; c = c_; nBusy = 0; SK = 0; rot = 0; }
    __device__ __forceinline__ int expert_of(int pm) const { int e = 0;
#pragma unroll
        for (int k = 0; k < 7; ++k) e += (pm >= pb[k]) ? 1 : 0;
        return e; }
    __device__ bool next(int i, Unit& u) const {
        int L;
        if (nBusy == 0) { int ce = c - rot; if (ce < 0) ce += G; L = i * G + ce; }
        else if (c >= nBusy) L = (i < SK) ? i * (G - nBusy) + (c - nBusy) : SK * (G - nBusy) + (i - SK) * G + c;
        else L = SK * (G - nBusy) + i * G + c;
        if (L >= nwg) return false;
        int wgid = L; { const int q = nwg / NXCD, r = nwg % NXCD, xcd = wgid % NXCD, off = wgid / NXCD; wgid = (xcd < r ? xcd * (q + 1) : r * (q + 1) + (xcd - r) * q) + off; }
        const int nig = WGM * nN, gid = wgid / nig, fm = gid * WGM, gsz = (nM - fm) < WGM ? (nM - fm) : WGM;
        u.pm = fm + ((wgid % nig) % gsz); const int pnl = (wgid % nig) / gsz;
        u.pn = expert_of(u.pm) * nN + pnl; return true;
    }
    __device__ __forceinline__ void a_ready(const Unit&) const {}
    __device__ __forceinline__ void done(const Unit&) const {}
};
struct LeftOrder {
    MoeOrder M; int nLeft, c0, pbase;
    __device__ bool next(int i, Unit& u) const { const int j = M.c - c0; if (i != 0 || j < 0 || j >= nLeft) return false; u.pm = pbase + (j >> 2); u.pn = M.expert_of(u.pm) * 4 + (j & 3); return true; }
    __device__ __forceinline__ void a_ready(const Unit&) const {}
    __device__ __forceinline__ void done(const Unit&) const {}
};
template <class Epi, class Sched, bool ALIGN_EPI = false, bool SP2 = false, bool F8 = false>
__device__ __forceinline__ void gemm_phase(PG8_LAS unsigned char* lds, const Gemm g, const Sched& S, const Epi& E, const int wave_idx) {
    int tid_ = wave_idx * 64 + lane_id_(); asm volatile("" : "+v"(tid_));
    const int tid = tid_, wid = __builtin_amdgcn_readfirstlane(tid >> 6), lane = tid & 63, wr = wid >> 2, wc = wid & 3, fr = lane & 15, fq = lane >> 4;
    const int K = g.K, nt = K / BK;
    unsigned voffA0, voffB0;
    { int R, C; stage_rc(tid * 16, R, C); const int Rb = Epi::PERM ? ((R & ~31) + perm32(R & 31)) : R;
      voffA0 = (unsigned)(R * g.lda + C) * 2u; voffB0 = (unsigned)(Rb * K + C) * 2u; }
    const size_t voffAR = (size_t)64 * g.lda * 2, voffBR = (size_t)64 * K * 2;
    const size_t kstep = (size_t)(BK * 2);
    const size_t hstepA = (size_t)HALF * g.lda * 2, hstepB = (size_t)HALF * K * 2;
    const size_t tstepA = 2 * hstepA, tstepB = 2 * hstepB;
    const unsigned lds0_ = (unsigned)(__UINTPTR_TYPE__)lds;
    const unsigned ldsw = (unsigned)wid * 1024u;
    const int aoff = lds_byte(wr * 64 + fr, fq * 8), boff = lds_byte(wc * 32 + fr, fq * 8);
#define PG8_SA(b, h) (((b) * 2 + (h)) * HTB)
#define PG8_SB(b, h) ((4 + (b) * 2 + (h)) * HTB)
#define PG8_STAGE(bufoff, gbase, voff) do { _Pragma("unroll") for (int _i = 0; _i < 2; ++_i) { unsigned keep_; const char* sb_ = (const char*)(gbase) + (size_t)_i * voff##R; \
        asm volatile("s_mov_b32 %0, m0\n\ts_mov_b32 m0, %3\n\ts_nop 0\n\tglobal_load_lds_dwordx4 %1, %2\n\ts_mov_b32 m0, %0" \
            : "=&s"(keep_) : "v"(voff##0), "s"(sb_), "s"(lds0_ + (unsigned)((bufoff) + _i * 8192) + ldsw) : "memory"); } } while (0)
#define PG8_LDA(dst, b, h) do { _Pragma("unroll") for (int m = 0; m < 4; ++m) _Pragma("unroll") for (int k = 0; k < 2; ++k) dst[m][k] = *(const PG8_LAS bf16x8*)(lds + PG8_SA(b, h) + aoff + m * 2048 + k * 1024); } while (0)
#define PG8_LDB(dst, b, h) do { _Pragma("unroll") for (int n = 0; n < 2; ++n) _Pragma("unroll") for (int k = 0; k < 2; ++k) dst[n][k] = *(const PG8_LAS bf16x8*)(lds + PG8_SB(b, h) + boff + n * 2048 + k * 1024); } while (0)
#define PG8_MMA(ai, bj, At, Bt) do { __builtin_amdgcn_s_setprio(1); _Pragma("unroll") for (int m = 0; m < 4; ++m) _Pragma("unroll") for (int n = 0; n < 2; ++n) { \
        if constexpr (F8) { typedef int v8i_ __attribute__((ext_vector_type(8))); typedef int v4i_ __attribute__((ext_vector_type(4))); \
            const v4i_ b0_ = __builtin_bit_cast(v4i_, Bt[n][0]), b1_ = __builtin_bit_cast(v4i_, Bt[n][1]), a0_ = __builtin_bit_cast(v4i_, At[m][0]), a1_ = __builtin_bit_cast(v4i_, At[m][1]); \
            const v8i_ bb_ = __builtin_shufflevector(b0_, b1_, 0, 1, 2, 3, 4, 5, 6, 7), aa_ = __builtin_shufflevector(a0_, a1_, 0, 1, 2, 3, 4, 5, 6, 7); \
            acc[ai][bj][m][n] = __builtin_amdgcn_mfma_scale_f32_16x16x128_f8f6f4(bb_, aa_, acc[ai][bj][m][n], 0, 0, 0, 0, 0, 0); } \
        else { _Pragma("unroll") for (int k = 0; k < 2; ++k) acc[ai][bj][m][n] = __builtin_amdgcn_mfma_f32_16x16x32_bf16(Bt[n][k], At[m][k], acc[ai][bj][m][n], 0, 0, 0); } } \
        __builtin_amdgcn_s_setprio(0); } while (0)
#define PG8_WAIT_V(n) asm volatile("s_waitcnt vmcnt(" #n ")" ::: "memory")
#define PG8_WAIT_L(n) asm volatile("s_waitcnt lgkmcnt(" #n ")" ::: "memory")
#define PG8_BAR __builtin_amdgcn_s_barrier()
#define PG8_SCHED __builtin_amdgcn_sched_barrier(0)
    Unit cur, nxt; int ui = 0;
    if (!S.next(0, cur)) return;
    f32x4 acc[2][2][4][2];
#pragma unroll
    for (int a = 0; a < 2; ++a)
#pragma unroll
        for (int b = 0; b < 2; ++b)
#pragma unroll
            for (int m = 0; m < 4; ++m)
#pragma unroll
                for (int n = 0; n < 2; ++n) acc[a][b][m][n] = (f32x4){0.f, 0.f, 0.f, 0.f};
    bf16x8 At[4][2], B0[2][2], B1[2][2];
    const char* cA = (const char*)g.A + (size_t)cur.pm * tstepA; const char* cB = (const char*)g.Bt + (size_t)cur.pn * tstepB;
    S.a_ready(cur);
    if constexpr (SP2) {
        PG8_STAGE(PG8_SB(0, 0), cB, voffB); PG8_STAGE(PG8_SB(0, 1), cB + hstepB, voffB); PG8_STAGE(PG8_SA(0, 0), cA, voffA); PG8_STAGE(PG8_SA(0, 1), cA + hstepA, voffA);
        if (wr == 1) PG8_BAR;
        PG8_WAIT_V(2); PG8_BAR;
        PG8_STAGE(PG8_SB(1, 0), cB + kstep, voffB); PG8_STAGE(PG8_SA(1, 0), cA + kstep, voffA); PG8_STAGE(PG8_SB(1, 1), cB + hstepB + kstep, voffB);
        PG8_WAIT_V(6); PG8_BAR;
    } else {
        PG8_STAGE(PG8_SB(0, 0), cB, voffB); PG8_STAGE(PG8_SA(0, 0), cA, voffA); PG8_STAGE(PG8_SB(0, 1), cB + hstepB, voffB); PG8_STAGE(PG8_SA(0, 1), cA + hstepA, voffA);
        if (wr == 1) PG8_BAR;
        PG8_WAIT_V(4); PG8_BAR;
        PG8_STAGE(PG8_SB(1, 0), cB + kstep, voffB); PG8_STAGE(PG8_SA(1, 0), cA + kstep, voffA); PG8_STAGE(PG8_SB(1, 1), cB + hstepB + kstep, voffB);
        PG8_WAIT_V(6); PG8_BAR;
    }
    for (;;) {
        const bool has_next = S.next(ui + 1, nxt);
        const char* nA = has_next ? (const char*)g.A + (size_t)nxt.pm * tstepA : cA; const char* nB = has_next ? (const char*)g.Bt + (size_t)nxt.pn * tstepB : cB;
#pragma unroll 1
        for (int t = 0; t < nt; t += 2) {
            const bool last = (t == nt - 2);
            const char* a1 = cA + (size_t)(t + 1) * kstep;
            const char* a2 = last ? nA : cA + (size_t)(t + 2) * kstep; const char* b2 = last ? nB : cB + (size_t)(t + 2) * kstep;
            const char* a3 = a2 + kstep; const char* b3 = b2 + kstep;
            if (last && has_next) S.a_ready(nxt);
            if constexpr (SP2) {
            PG8_LDB(B0, 0, 0); PG8_LDB(B1, 0, 1); PG8_SCHED; PG8_LDA(At, 0, 0); PG8_STAGE(PG8_SA(1, 1), a1 + hstepA, voffA);
            PG8_WAIT_V(8); PG8_WAIT_L(0); PG8_BAR; PG8_MMA(0, 0, At, B0); PG8_MMA(0, 1, At, B1); PG8_BAR; PG8_SCHED;
            PG8_LDA(At, 0, 1); PG8_STAGE(PG8_SB(0, 0), b2, voffB); PG8_STAGE(PG8_SB(0, 1), b2 + hstepB, voffB); PG8_STAGE(PG8_SA(0, 0), a2, voffA);
            PG8_WAIT_V(8); PG8_WAIT_L(0); PG8_BAR; PG8_MMA(1, 0, At, B0); PG8_MMA(1, 1, At, B1); PG8_BAR; PG8_SCHED;
            PG8_LDB(B0, 1, 0); PG8_LDB(B1, 1, 1); PG8_SCHED; PG8_LDA(At, 1, 0); PG8_STAGE(PG8_SA(0, 1), a2 + hstepA, voffA);
            PG8_WAIT_V(8); PG8_WAIT_L(0); PG8_BAR; PG8_MMA(0, 0, At, B0); PG8_MMA(0, 1, At, B1); PG8_BAR; PG8_SCHED;
            PG8_LDA(At, 1, 1); PG8_STAGE(PG8_SB(1, 0), b3, voffB); PG8_STAGE(PG8_SB(1, 1), b3 + hstepB, voffB); PG8_STAGE(PG8_SA(1, 0), a3, voffA);
            PG8_WAIT_V(8); PG8_WAIT_L(0); PG8_BAR; PG8_MMA(1, 0, At, B0); PG8_MMA(1, 1, At, B1); PG8_BAR; PG8_SCHED;
            } else {
            PG8_LDB(B0, 0, 0); PG8_SCHED; PG8_LDA(At, 0, 0); PG8_STAGE(PG8_SA(1, 1), a1 + hstepA, voffA);
            PG8_WAIT_L(8); PG8_BAR; PG8_WAIT_L(0); PG8_MMA(0, 0, At, B0); PG8_BAR; PG8_SCHED;
            PG8_LDB(B1, 0, 1); PG8_STAGE(PG8_SB(0, 0), b2, voffB);
            PG8_BAR; PG8_WAIT_L(0); PG8_MMA(0, 1, At, B1); PG8_BAR;
            PG8_LDA(At, 0, 1); PG8_STAGE(PG8_SA(0, 0), a2, voffA);
            PG8_BAR; PG8_WAIT_L(0); PG8_MMA(1, 0, At, B0); PG8_BAR; PG8_SCHED;
            PG8_STAGE(PG8_SB(0, 1), b2 + hstepB, voffB);
            PG8_WAIT_V(6); PG8_BAR; PG8_MMA(1, 1, At, B1); PG8_BAR;
            PG8_LDB(B0, 1, 0); PG8_SCHED; PG8_LDA(At, 1, 0); PG8_STAGE(PG8_SA(0, 1), a2 + hstepA, voffA);
            PG8_WAIT_L(8); PG8_BAR; PG8_WAIT_L(0); PG8_MMA(0, 0, At, B0); PG8_BAR; PG8_SCHED;
            PG8_LDB(B1, 1, 1); PG8_STAGE(PG8_SB(1, 0), b3, voffB);
            PG8_BAR; PG8_WAIT_L(0); PG8_MMA(0, 1, At, B1); PG8_BAR;
            PG8_LDA(At, 1, 1); PG8_STAGE(PG8_SA(1, 0), a3, voffA);
            PG8_BAR; PG8_WAIT_L(0); PG8_MMA(1, 0, At, B0); PG8_BAR; PG8_SCHED;
            PG8_STAGE(PG8_SB(1, 1), b3 + hstepB, voffB);
            PG8_WAIT_V(6); PG8_BAR; PG8_MMA(1, 1, At, B1); PG8_BAR;
            }
        }
        if constexpr (ALIGN_EPI) { if (wr == 0) PG8_BAR; }
        if constexpr (!Epi::AFTER_DRAIN) { E(acc, cur, wr, wc, fr, fq); S.done(cur); }
        if (!has_next) break;
#pragma unroll
        for (int a = 0; a < 2; ++a)
#pragma unroll
            for (int b = 0; b < 2; ++b)
#pragma unroll
                for (int m = 0; m < 4; ++m)
#pragma unroll
                    for (int n = 0; n < 2; ++n) acc[a][b][m][n] = (f32x4){0.f, 0.f, 0.f, 0.f};
        cur = nxt; cA = nA; cB = nB; ++ui;
        if constexpr (ALIGN_EPI) { if (wr == 1) PG8_BAR; }
    }
    PG8_WAIT_V(0);
    if constexpr (!ALIGN_EPI) { if (wr == 0) PG8_BAR; }
    PG8_BAR;
    if constexpr (Epi::AFTER_DRAIN) { E.fused(acc, cur, wr, wc, fr, fq, lds, wid, lane); S.done(cur); }
#undef PG8_SA
#undef PG8_SB
#undef PG8_STAGE
#undef PG8_LDA
#undef PG8_LDB
#undef PG8_MMA
#undef PG8_WAIT_V
#undef PG8_WAIT_L
#undef PG8_BAR
#undef PG8_SCHED
}
}
namespace att {
#define ATT_LAS __attribute__((address_space(3)))
typedef unsigned short bf16;
typedef short bf16x8 __attribute__((ext_vector_type(8)));
typedef short s16x4 __attribute__((ext_vector_type(4)));
typedef float f32x16 __attribute__((ext_vector_type(16)));
typedef float f32x4_t __attribute__((ext_vector_type(4)));
typedef unsigned u32x4 __attribute__((ext_vector_type(4)));
typedef unsigned u32x2 __attribute__((ext_vector_type(2)));
typedef float f32x2_t __attribute__((ext_vector_type(2))); typedef __bf16 bf16x2_t __attribute__((ext_vector_type(2)));
__device__ __forceinline__ unsigned cvtpk(float lo, float hi) { f32x2_t v = {lo, hi}; bf16x2_t b = __builtin_convertvector(v, bf16x2_t); return __builtin_bit_cast(unsigned, b); }
__device__ __forceinline__ s16x4 vtr(const ATT_LAS unsigned char* p) { return __builtin_bit_cast(s16x4, __builtin_amdgcn_ds_read_tr16_b64_v4i16((ATT_LAS s16x4*)p)); }
constexpr int VSTR = 192;
template <int DQK> struct Geo { static constexpr int KSTR = DQK * 2 + 16, KBUF = 64 * KSTR, VBUF = 64 * VSTR, CPR = DQK / 8, NKC = 64 * CPR, KIT = (NKC + 511) / 512; };
template <int DQK> constexpr int lds_bytes() { return 3 * Geo<DQK>::KBUF + 3 * Geo<DQK>::VBUF + 2048 + 8192; }

__device__ __forceinline__ float xhalf_sum(float m) { return xor32_sum(m); }
__device__ __forceinline__ float max3f(float a, float b, float c) { float r; asm("v_max3_f32 %0, %1, %2, %3" : "=v"(r) : "v"(a), "v"(b), "v"(c)); return r; }
__device__ __forceinline__ float max2f(float a, float b) { float r; asm("v_max_f32_e32 %0, %1, %2" : "=v"(r) : "v"(a), "v"(b)); return r; }
__device__ __forceinline__ float rowmax32(const f32x16& p0, const f32x16& p1) {
    float a = max2f(p0[0], p1[0]), b = max2f(p0[1], p1[1]), c = max2f(p0[2], p1[2]), d = max2f(p0[3], p1[3]);
#pragma unroll
    for (int r = 4; r < 16; r += 4) { a = max3f(a, p0[r], p1[r]); b = max3f(b, p0[r + 1], p1[r + 1]); c = max3f(c, p0[r + 2], p1[r + 2]); d = max3f(d, p0[r + 3], p1[r + 3]); }
    const float m = max2f(max2f(a, b), max2f(c, d));
    float lo_, hi_; halves32(m, lo_, hi_);
    return max2f(lo_, hi_);
}

template <int DQK, int kpitch, int vpitch, int NS>
__device__ __forceinline__ void attn_init(ATT_LAS unsigned char* lds, const int wave_idx) {
    typedef Geo<DQK> G;
    const int lane = lane_id_(), wid = wave_idx;
    constexpr int KCPL = G::KSTR / 16, KNP = (64 * KCPL + 63) / 64, VCPL = VSTR / 16, VNP = 64 * VCPL / 64, KPP = (KNP + 7) / 8, VPP = (VNP + 7) / 8;
    ATT_LAS unsigned* dmaL = (ATT_LAS unsigned*)(lds + NS * G::KBUF + NS * G::VBUF + 2048) + wid * 256 + lane;
#pragma unroll
    for (int pp = 0; pp < KPP; ++pp) { const int pc = wid + 8 * pp, c = pc * 64 + lane, row = (c / KCPL) & 63, ch = c % KCPL; dmaL[64 * pp] = (unsigned)(row * kpitch + (ch < G::CPR ? ch : 0) * 8) * 2u; }
#pragma unroll
    for (int pp = 0; pp < VPP; ++pp) { const int pc = wid + 8 * pp, c = pc * 64 + lane, row = (c / VCPL) & 63, ch = c % VCPL; dmaL[128 + 64 * pp] = (unsigned)(row * vpitch + (ch < 8 ? ch : 0) * 8) * 2u; }
}

template <int DQK, bool BAND, int qpitch, int kpitch, int vpitch, int opitch, bool OF8 = false, bool NOMAX = false, int NS = 2, int DBG = 0>
__device__ __forceinline__ void attn_unit(ATT_LAS unsigned char* lds, const bf16* Qb, const bf16* Kb, const bf16* Vb, bf16* Ob,
                                          int q0, int t_lo, int t_hi, int my_lo, int my_hi, int cc, const float* bias_g, const float* g_qn, const float* rope, const int wave_idx, const bool load_bias,
                                          bf16x8 (&qf)[DQK / 16], const bool q_loaded, const bool has_next, const bf16* Qn) {
    typedef Geo<DQK> G;
    int tid_ = wave_idx * 64 + lane_id_(); asm volatile("" : "+v"(tid_));
    const int tid = tid_, lane = tid & 63, r32 = lane & 31, hi = lane >> 5, wid = __builtin_amdgcn_readfirstlane(tid >> 6);
    ATT_LAS float* biasL = (ATT_LAS float*)(lds + NS * G::KBUF + NS * G::VBUF);
    constexpr int KCPL = G::KSTR / 16, KNP = (64 * KCPL + 63) / 64;
    constexpr int VCPL = VSTR / 16, VNP = 64 * VCPL / 64;
    constexpr int KPP = (KNP + 7) / 8, VPP = (VNP + 7) / 8;
    ATT_LAS unsigned* dmaL = (ATT_LAS unsigned*)(lds + NS * G::KBUF + NS * G::VBUF + 2048) + wid * 256 + lane;
    const unsigned ldsb = __builtin_amdgcn_readfirstlane((unsigned)(size_t)lds);
    const int kc = (KNP - 1 - wid) / 8 + 1, vc = (VNP - 1 - wid) / 8 + 1;
#define ATT_MOD3(x) (NS == 3 ? (x) - 3 * (((x) * 43) >> 7) : ((x) & 1))
#define ATT_DMA1(gptr, voff_, ldsaddr) do { unsigned keep_; asm volatile("s_mov_b32 %0, m0\n\ts_mov_b32 m0, %3\n\ts_nop 0\n\tglobal_load_lds_dwordx4 %1, %2\n\ts_mov_b32 m0, %0" \
            : "=&s"(keep_) : "v"(voff_), "s"(gptr), "s"(ldsaddr) : "memory"); } while (0)
#define ATT_DMA_K(t) do { const int t_ = (t); const char* kt_ = (const char*)(Kb + (size_t)t_ * 64 * kpitch); const unsigned d_ = ldsb + ATT_MOD3(t_) * G::KBUF + wid * 1024; \
        _Pragma("unroll") for (int pp = 0; pp < KPP; ++pp) { if (wid + 8 * pp < KNP) { const unsigned vo_ = dmaL[64 * pp]; ATT_DMA1(kt_, vo_, d_ + pp * 8192); } } } while (0)
#define ATT_DMA_V(t) do { const int t_ = (t); const char* vt_ = (const char*)(Vb + (size_t)t_ * 64 * vpitch); const unsigned d_ = ldsb + NS * G::KBUF + ATT_MOD3(t_) * G::VBUF + wid * 1024; \
        _Pragma("unroll") for (int pp = 0; pp < VPP; ++pp) { if (wid + 8 * pp < VNP) { const unsigned vo_ = dmaL[128 + 64 * pp]; ATT_DMA1(vt_, vo_, d_ + pp * 8192); } } } while (0)
#define ATT_WAITBAR(n) do { const int n_ = (n); \
        if (n_ == 0) asm volatile("s_waitcnt vmcnt(0) lgkmcnt(0)\n\ts_barrier" ::: "memory"); else if (n_ == 1) asm volatile("s_waitcnt vmcnt(1) lgkmcnt(0)\n\ts_barrier" ::: "memory"); \
        else if (n_ == 2) asm volatile("s_waitcnt vmcnt(2) lgkmcnt(0)\n\ts_barrier" ::: "memory"); else if (n_ == 3) asm volatile("s_waitcnt vmcnt(3) lgkmcnt(0)\n\ts_barrier" ::: "memory"); \
        else if (n_ == 4) asm volatile("s_waitcnt vmcnt(4) lgkmcnt(0)\n\ts_barrier" ::: "memory"); else if (n_ == 5) asm volatile("s_waitcnt vmcnt(5) lgkmcnt(0)\n\ts_barrier" ::: "memory"); \
        else asm volatile("s_waitcnt vmcnt(6) lgkmcnt(0)\n\ts_barrier" ::: "memory"); } while (0)
    ATT_DMA_K(t_lo); ATT_DMA_V(t_lo);
    if (t_lo + 1 <= t_hi) { ATT_DMA_K(t_lo + 1); if (NS == 3) ATT_DMA_V(t_lo + 1); }
    if (NS == 3) { if (t_lo + 2 <= t_hi) ATT_DMA_K(t_lo + 2); }
    if (BAND) { if (load_bias && tid < 257) biasL[tid] = bias_g[tid] * 1.4426950408889634f; }
    if (!q_loaded) { const bf16* qp = Qb + (size_t)(q0 + wid * 32 + r32) * qpitch + 8 * hi;
#pragma unroll
      for (int kk = 0; kk < DQK / 16; ++kk) { if constexpr (DBG & 8) qf[kk] = (bf16x8){(short)lane, 1, 2, 3, 4, 5, 6, 7}; else qf[kk] = *(const bf16x8*)(qp + 16 * kk); } }
    if constexpr (!BAND) {
        float qv[DQK / 16][8]; float ss = 0.f;
#pragma unroll
        for (int kk = 0; kk < DQK / 16; ++kk)
#pragma unroll
            for (int j = 0; j < 8; ++j) { qv[kk][j] = __builtin_bit_cast(float, (unsigned)(unsigned short)qf[kk][j] << 16); ss += qv[kk][j] * qv[kk][j]; }
        ss = xhalf_sum(ss);
        const float rs = __builtin_amdgcn_rsqf(ss * (1.f / DQK) + 1e-6f) * (0.10206207261596577f * 1.4426950408889634f);
#pragma unroll
        for (int kk = 0; kk < DQK / 16; ++kk) { const f32x4_t g0 = *(const f32x4_t*)(g_qn + 16 * kk + 8 * hi), g1 = *(const f32x4_t*)(g_qn + 16 * kk + 8 * hi + 4);
#pragma unroll
            for (int j = 0; j < 4; ++j) { qv[kk][j] *= rs * g0[j]; qv[kk][4 + j] *= rs * g1[j]; } }
        const f32x4_t* rp = (const f32x4_t*)(rope + ((size_t)(q0 + wid * 32 + r32) * 16 + 8 * hi) * 2);
#pragma unroll
        for (int j2 = 0; j2 < 4; ++j2) { const f32x4_t cs = rp[j2];
            { const float x1 = qv[4][2 * j2], x2 = qv[5][2 * j2]; qv[4][2 * j2] = x1 * cs[0] - x2 * cs[1]; qv[5][2 * j2] = x2 * cs[0] + x1 * cs[1]; }
            { const float x1 = qv[4][2 * j2 + 1], x2 = qv[5][2 * j2 + 1]; qv[4][2 * j2 + 1] = x1 * cs[2] - x2 * cs[3]; qv[5][2 * j2 + 1] = x2 * cs[2] + x1 * cs[3]; } }
#pragma unroll
        for (int kk = 0; kk < DQK / 16; ++kk) { u32x4 w; w.x = cvtpk(qv[kk][0], qv[kk][1]); w.y = cvtpk(qv[kk][2], qv[kk][3]); w.z = cvtpk(qv[kk][4], qv[kk][5]); w.w = cvtpk(qv[kk][6], qv[kk][7]);
            qf[kk] = __builtin_bit_cast(bf16x8, w); }
    }
    f32x16 o0, o1;
#pragma unroll
    for (int i = 0; i < 16; ++i) { o0[i] = 0.f; o1[i] = 0.f; }
    float mrun = -INFINITY, lsum = 0.f; float ls4[4] = {0.f, 0.f, 0.f, 0.f};
    const int koff = r32 * G::KSTR + hi * 16;
    const int voff = ((lane >> 5) * 4 + ((lane & 15) >> 2)) * VSTR + (((lane >> 4) & 1) * 16 + (lane & 3) * 4) * 2;
    const f32x16 zero16 = {0.f, 0.f, 0.f, 0.f, 0.f, 0.f, 0.f, 0.f, 0.f, 0.f, 0.f, 0.f, 0.f, 0.f, 0.f, 0.f};
#define ATT_QK(X0, X1, t) do { const ATT_LAS unsigned char* Kt = lds + ATT_MOD3(t) * G::KBUF + koff; \
        _Pragma("unroll") for (int kk = 0; kk < DQK / 16; ++kk) { \
            const bf16x8 a0 = *(const ATT_LAS bf16x8*)(Kt + kk * 32); const bf16x8 a1 = *(const ATT_LAS bf16x8*)(Kt + 32 * G::KSTR + kk * 32); \
            X0 = __builtin_amdgcn_mfma_f32_32x32x16_bf16(a0, qf[kk], kk ? X0 : zero16, 0, 0, 0); X1 = __builtin_amdgcn_mfma_f32_32x32x16_bf16(a1, qf[kk], kk ? X1 : zero16, 0, 0, 0); } } while (0)
#define ATT_FARSCALE() do { const float f_ = __builtin_amdgcn_exp2f(biasL[256]); _Pragma("unroll") for (int i = 0; i < 16; ++i) { o0[i] *= f_; o1[i] *= f_; } \
        ls4[0] *= f_; ls4[1] *= f_; ls4[2] *= f_; ls4[3] *= f_; } while (0)
#define ATT_SMPV(X0, X1, t) do { \
        float cadd = 0.f; \
        if (BAND && !(DBG & 2)) { const int delta = cc - (t); \
            if (delta >= 3) { if constexpr (!NOMAX) cadd = biasL[256]; } \
            else { const ATT_LAS float* bp = biasL + (64 * delta + (32 * (wid & 1) + r32) - 4 * hi + 128 - 63); \
                if (delta < 2) { _Pragma("unroll") for (int i = 0; i < 16; ++i) { const int kj = (i & 3) + 8 * (i >> 2); X0[i] += bp[63 - kj]; X1[i] += bp[31 - kj]; } } \
                else { const int relb = 64 * delta + (32 * (wid & 1) + r32) - 4 * hi + 128; \
                    _Pragma("unroll") for (int i = 0; i < 16; ++i) { const int kj = (i & 3) + 8 * (i >> 2); int i0 = relb - kj, i1 = relb - kj - 32; i0 = i0 > 256 ? 256 : i0; i1 = i1 > 256 ? 256 : i1; \
                        X0[i] += biasL[i0]; X1[i] += biasL[i1]; } } } } \
        if constexpr (NOMAX) { \
            _Pragma("unroll") for (int i = 0; i < 16; ++i) { X0[i] = __builtin_amdgcn_exp2f(X0[i]); X1[i] = __builtin_amdgcn_exp2f(X1[i]); ls4[i & 3] += X0[i] + X1[i]; } \
        } else { \
        const float mt = rowmax32(X0, X1) + cadd; \
        const float mnew = max2f(mrun, mt); \
        const float alpha = __builtin_amdgcn_exp2f(mrun - mnew); \
        const float msub = mnew - cadd; \
        mrun = mnew; \
        float psa[4] = {0.f, 0.f, 0.f, 0.f};   \
        _Pragma("unroll") for (int i = 0; i < 16; ++i) { X0[i] = __builtin_amdgcn_exp2f(X0[i] - msub); X1[i] = __builtin_amdgcn_exp2f(X1[i] - msub); psa[i & 3] += X0[i] + X1[i]; } \
        const float ps = (psa[0] + psa[1]) + (psa[2] + psa[3]); \
        lsum = lsum * alpha + ps; \
        _Pragma("unroll") for (int i = 0; i < 16; ++i) { o0[i] *= alpha; o1[i] *= alpha; } } \
        bf16x8 pf[2][2]; \
        _Pragma("unroll") for (int s = 0; s < 2; ++s) { u32x4 w0, w1; \
            w0.x = cvtpk(X0[8 * s + 0], X0[8 * s + 1]); w0.y = cvtpk(X0[8 * s + 2], X0[8 * s + 3]); w0.z = cvtpk(X0[8 * s + 4], X0[8 * s + 5]); w0.w = cvtpk(X0[8 * s + 6], X0[8 * s + 7]); \
            w1.x = cvtpk(X1[8 * s + 0], X1[8 * s + 1]); w1.y = cvtpk(X1[8 * s + 2], X1[8 * s + 3]); w1.z = cvtpk(X1[8 * s + 4], X1[8 * s + 5]); w1.w = cvtpk(X1[8 * s + 6], X1[8 * s + 7]); \
            pf[0][s] = __builtin_bit_cast(bf16x8, w0); pf[1][s] = __builtin_bit_cast(bf16x8, w1); } \
        const ATT_LAS unsigned char* Vt = lds + NS * G::KBUF + ATT_MOD3(t) * G::VBUF + voff; \
        _Pragma("unroll") for (int kb = 0; kb < 2; ++kb) _Pragma("unroll") for (int s = 0; s < 2; ++s) { \
            const ATT_LAS unsigned char* vp = Vt + (32 * kb + 16 * s) * VSTR; \
            const s16x4 l0 = vtr(vp), h0 = vtr(vp + 8 * VSTR), l1 = vtr(vp + 64), h1 = vtr(vp + 8 * VSTR + 64); \
            const bf16x8 a0 = (bf16x8){l0[0], l0[1], l0[2], l0[3], h0[0], h0[1], h0[2], h0[3]}; \
            const bf16x8 a1 = (bf16x8){l1[0], l1[1], l1[2], l1[3], h1[0], h1[1], h1[2], h1[3]}; \
            o0 = __builtin_amdgcn_mfma_f32_32x32x16_bf16(a0, pf[kb][s], o0, 0, 0, 0); o1 = __builtin_amdgcn_mfma_f32_32x32x16_bf16(a1, pf[kb][s], o1, 0, 0, 0); } \
        if constexpr (NOMAX && BAND) { if (cc - (t) == 3) ATT_FARSCALE(); } } while (0)
#define ATT_FUSED(C0, C1, N0, N1, t, tn) do { \
        bf16x8 kfa[DQK / 16], kfb[DQK / 16]; \
        { const ATT_LAS unsigned char* Kt = lds + ATT_MOD3(tn) * G::KBUF + koff; \
          _Pragma("unroll") for (int kk = 0; kk < DQK / 16; ++kk) { kfa[kk] = *(const ATT_LAS bf16x8*)(Kt + kk * 32); kfb[kk] = *(const ATT_LAS bf16x8*)(Kt + 32 * G::KSTR + kk * 32); } } \
        if constexpr (!NOMAX) __builtin_amdgcn_sched_barrier(0); \
        float cadd = 0.f; \
        if (BAND && !(DBG & 2)) { const int delta = cc - (t); \
            if (delta >= 3) { if constexpr (!NOMAX) cadd = biasL[256]; } \
            else { const ATT_LAS float* bp = biasL + (64 * delta + (32 * (wid & 1) + r32) - 4 * hi + 128 - 63); \
                if (delta < 2) { _Pragma("unroll") for (int i = 0; i < 16; ++i) { const int kj = (i & 3) + 8 * (i >> 2); C0[i] += bp[63 - kj]; C1[i] += bp[31 - kj]; } } \
                else { const int relb = 64 * delta + (32 * (wid & 1) + r32) - 4 * hi + 128; \
                    _Pragma("unroll") for (int i = 0; i < 16; ++i) { const int kj = (i & 3) + 8 * (i >> 2); int i0 = relb - kj, i1 = relb - kj - 32; i0 = i0 > 256 ? 256 : i0; i1 = i1 > 256 ? 256 : i1; \
                        C0[i] += biasL[i0]; C1[i] += biasL[i1]; } } } } \
        float alpha = 1.f, msub = 0.f; \
        if constexpr (!NOMAX) { \
        const float mt = rowmax32(C0, C1) + cadd; \
        const float mnew = max2f(mrun, mt); \
        alpha = __builtin_amdgcn_exp2f(mrun - mnew); \
        msub = mnew - cadd; \
        if (__builtin_amdgcn_ballot_w64(mnew > mrun)) { _Pragma("unroll") for (int i = 0; i < 16; ++i) { o0[i] *= alpha; o1[i] *= alpha; } } \
        mrun = mnew; } \
        if constexpr (!NOMAX || BAND) __builtin_amdgcn_sched_barrier(0); \
        _Pragma("unroll") for (int kk = 0; kk < DQK / 16; ++kk) { \
            N0 = __builtin_amdgcn_mfma_f32_32x32x16_bf16(kfa[kk], qf[kk], kk ? N0 : zero16, 0, 0, 0); N1 = __builtin_amdgcn_mfma_f32_32x32x16_bf16(kfb[kk], qf[kk], kk ? N1 : zero16, 0, 0, 0); } \
        s16x4 vl0[4], vh0[4], vl1[4], vh1[4]; \
        { const ATT_LAS unsigned char* Vt = lds + NS * G::KBUF + ATT_MOD3(t) * G::VBUF + voff; \
          _Pragma("unroll") for (int ks = 0; ks < 4; ++ks) { const ATT_LAS unsigned char* vp = Vt + 16 * ks * VSTR; vl0[ks] = vtr(vp); vh0[ks] = vtr(vp + 8 * VSTR); vl1[ks] = vtr(vp + 64); vh1[ks] = vtr(vp + 8 * VSTR + 64); } } \
        if constexpr (NOMAX) { \
            _Pragma("unroll") for (int i = 0; i < 16; ++i) { C0[i] = __builtin_amdgcn_exp2f(C0[i]); C1[i] = __builtin_amdgcn_exp2f(C1[i]); ls4[i & 3] += C0[i] + C1[i]; } \
        } else { \
        float psa[4] = {0.f, 0.f, 0.f, 0.f}; \
        _Pragma("unroll") for (int i = 0; i < 16; ++i) { C0[i] = __builtin_amdgcn_exp2f(C0[i] - msub); C1[i] = __builtin_amdgcn_exp2f(C1[i] - msub); psa[i & 3] += C0[i] + C1[i]; } \
        const float ps = (psa[0] + psa[1]) + (psa[2] + psa[3]); \
        lsum = lsum * alpha + ps; } \
        bf16x8 pf[4]; \
        _Pragma("unroll") for (int s = 0; s < 2; ++s) { u32x4 w0, w1; \
            w0.x = cvtpk(C0[8 * s + 0], C0[8 * s + 1]); w0.y = cvtpk(C0[8 * s + 2], C0[8 * s + 3]); w0.z = cvtpk(C0[8 * s + 4], C0[8 * s + 5]); w0.w = cvtpk(C0[8 * s + 6], C0[8 * s + 7]); \
            w1.x = cvtpk(C1[8 * s + 0], C1[8 * s + 1]); w1.y = cvtpk(C1[8 * s + 2], C1[8 * s + 3]); w1.z = cvtpk(C1[8 * s + 4], C1[8 * s + 5]); w1.w = cvtpk(C1[8 * s + 6], C1[8 * s + 7]); \
            pf[s] = __builtin_bit_cast(bf16x8, w0); pf[2 + s] = __builtin_bit_cast(bf16x8, w1); } \
        __builtin_amdgcn_sched_barrier(0); \
        _Pragma("unroll") for (int ks = 0; ks < 4; ++ks) { \
            const bf16x8 a0 = (bf16x8){vl0[ks][0], vl0[ks][1], vl0[ks][2], vl0[ks][3], vh0[ks][0], vh0[ks][1], vh0[ks][2], vh0[ks][3]}; \
            const bf16x8 a1 = (bf16x8){vl1[ks][0], vl1[ks][1], vl1[ks][2], vl1[ks][3], vh1[ks][0], vh1[ks][1], vh1[ks][2], vh1[ks][3]}; \
            o0 = __builtin_amdgcn_mfma_f32_32x32x16_bf16(a0, pf[ks], o0, 0, 0, 0); o1 = __builtin_amdgcn_mfma_f32_32x32x16_bf16(a1, pf[ks], o1, 0, 0, 0); } \
        if constexpr (NOMAX && BAND) { if (cc - (t) == 3) ATT_FARSCALE(); } } while (0)
#define ATT_STAGE(t) do { if ((t) + NS <= t_hi) ATT_DMA_K((t) + NS); if ((t) + NS - 1 <= t_hi) ATT_DMA_V((t) + NS - 1); } while (0)
#define ATT_STAGE_T(t) do { ATT_STAGE(t); \
        if ((t) == t_hi && has_next) { const bf16* qp_ = Qn + (size_t)(wid * 32 + r32) * qpitch + 8 * hi; _Pragma("unroll") for (int kk = 0; kk < DQK / 16; ++kk) qf[kk] = *(const bf16x8*)(qp_ + 16 * kk); } } while (0)
#define ATT_NFL(t) ((NS == 3 ? ((t) + 3 <= t_hi ? kc : 0) + ((t) + 2 <= t_hi ? vc : 0) : 0) + (((t) == t_hi && has_next) ? DQK / 16 : 0))
    f32x16 sa0, sa1, sb0, sb1;
    ATT_WAITBAR(0);
    if (my_lo == t_lo) ATT_QK(sa0, sa1, t_lo);
    ATT_WAITBAR(0);
    {
        int t = t_lo;
        for (; t < my_lo - 1; ++t) { ATT_STAGE(t); ATT_WAITBAR(ATT_NFL(t)); }
        if (my_lo > t_lo) { ATT_STAGE(t); ATT_QK(sa0, sa1, t + 1); ATT_WAITBAR(ATT_NFL(t)); ++t; }
        int nf = my_hi - my_lo;
        for (; nf >= 2; nf -= 2, t += 2) {
            ATT_STAGE(t); ATT_FUSED(sa0, sa1, sb0, sb1, t, t + 1); ATT_WAITBAR(ATT_NFL(t));
            ATT_STAGE(t + 1); ATT_FUSED(sb0, sb1, sa0, sa1, t + 1, t + 2); ATT_WAITBAR(ATT_NFL(t + 1));
        }
        if (nf == 1) {
            ATT_STAGE(t); ATT_FUSED(sa0, sa1, sb0, sb1, t, t + 1); ATT_WAITBAR(ATT_NFL(t)); ++t;
            ATT_STAGE_T(t); ATT_SMPV(sb0, sb1, t); ATT_WAITBAR(ATT_NFL(t)); ++t;
        } else {
            ATT_STAGE_T(t); ATT_SMPV(sa0, sa1, t); ATT_WAITBAR(ATT_NFL(t)); ++t;
        }
        for (; t <= t_hi; ++t) { ATT_STAGE_T(t); ATT_WAITBAR(ATT_NFL(t)); }
    }
    if constexpr (NOMAX) lsum = (ls4[0] + ls4[1]) + (ls4[2] + ls4[3]);
    const float ltot = xhalf_sum(lsum);
    const float inv = 1.f / ltot;
    if constexpr (DBG & 4) { if (ltot == 12345.678f) *(float*)Ob = o0[0] + o1[0]; } else
    if constexpr (OF8) {
        const float i64 = inv * 32.f;
        int w0[4], w1[4];
#pragma unroll
        for (int g4 = 0; g4 < 4; ++g4) { w0[g4] = 0; w1[g4] = 0;
            w0[g4] = __builtin_amdgcn_cvt_pk_fp8_f32(o0[4 * g4 + 0] * i64, o0[4 * g4 + 1] * i64, w0[g4], false); w0[g4] = __builtin_amdgcn_cvt_pk_fp8_f32(o0[4 * g4 + 2] * i64, o0[4 * g4 + 3] * i64, w0[g4], true);
            w1[g4] = __builtin_amdgcn_cvt_pk_fp8_f32(o1[4 * g4 + 0] * i64, o1[4 * g4 + 1] * i64, w1[g4], false); w1[g4] = __builtin_amdgcn_cvt_pk_fp8_f32(o1[4 * g4 + 2] * i64, o1[4 * g4 + 3] * i64, w1[g4], true); }
        asm volatile("s_nop 1\n\tv_permlane32_swap_b32 %0, %1\n\tv_permlane32_swap_b32 %2, %3\n\tv_permlane32_swap_b32 %4, %5\n\tv_permlane32_swap_b32 %6, %7\n\ts_nop 1"
                     : "+v"(w0[2]), "+v"(w0[0]), "+v"(w0[3]), "+v"(w0[1]), "+v"(w1[2]), "+v"(w1[0]), "+v"(w1[3]), "+v"(w1[1]));
        unsigned char* op = (unsigned char*)Ob + (size_t)(q0 + wid * 32 + r32) * opitch + (hi ? 0 : 16);
        *(u32x4*)op = (u32x4){(unsigned)w0[2], (unsigned)w0[0], (unsigned)w0[3], (unsigned)w0[1]};
        *(u32x4*)(op + 32) = (u32x4){(unsigned)w1[2], (unsigned)w1[0], (unsigned)w1[3], (unsigned)w1[1]};
    } else {
    bf16* op = Ob + (size_t)(q0 + wid * 32 + r32) * opitch + 4 * hi;
#pragma unroll
    for (int g4 = 0; g4 < 4; ++g4) {
        u32x2 w0, w1;
        w0.x = cvtpk(o0[4 * g4 + 0] * inv, o0[4 * g4 + 1] * inv); w0.y = cvtpk(o0[4 * g4 + 2] * inv, o0[4 * g4 + 3] * inv);
        w1.x = cvtpk(o1[4 * g4 + 0] * inv, o1[4 * g4 + 1] * inv); w1.y = cvtpk(o1[4 * g4 + 2] * inv, o1[4 * g4 + 3] * inv);
        *(u32x2*)(op + 8 * g4) = w0; *(u32x2*)(op + 32 + 8 * g4) = w1;
    }
    }
#undef ATT_DMA_K
#undef ATT_DMA_V
#undef ATT_QK
#undef ATT_SMPV
#undef ATT_STAGE
#undef ATT_STAGE_T
#undef ATT_FUSED
#undef ATT_MOD3
#undef ATT_DMA1
#undef ATT_WAITBAR
#undef ATT_NFL
#undef ATT_FARSCALE
}
}
constexpr int NWAVES = 8;
constexpr int D = 1024, BATCH = 32, SEQ = 2048, M = BATCH * SEQ;
constexpr int NH = 16, QLORA = 384, KVLORA = 256, ROPE_D = 32, NOPE = 64, QKD = 96;
constexpr int NA = 768;
constexpr int FF = 2816, EFF = 3584, NE = 8;
constexpr float EPS = 1e-6f, LOG2E = 1.4426950408889634f;
constexpr int MAXP_HALF = 264, MAXP = 528;
constexpr size_t MiB = 1u << 20;
constexpr size_t WS_CTL = 0, CTL_ZERO_BYTES = 1 * MiB;
constexpr size_t WS_ROPE = 1 * MiB;
constexpr size_t WS_CNT = WS_ROPE + 256 * 1024;
constexpr size_t WS_PANELE = WS_CNT + 16 * 1024;
constexpr size_t WS_META = WS_PANELE + 4096;
constexpr size_t WS_TOKE = 2 * MiB;
constexpr size_t WS_TOKG = WS_TOKE + (size_t)M * 4;
constexpr size_t WS_SLOTTOK = WS_TOKG + (size_t)M * 8;
constexpr size_t WS_SLOTGATE = WS_SLOTTOK + (size_t)MAXP * 256 * 4;
constexpr size_t WS_PARTQA = 976 * MiB, WS_PART1 = 980 * MiB, WS_PART2 = 984 * MiB;
constexpr size_t WS_TOKRSTD = 4 * MiB;
constexpr size_t WS_SLOTRSTD = WS_TOKRSTD + (size_t)M * 4;
static_assert(WS_SLOTGATE + (size_t)MAXP * 256 * 4 <= WS_TOKRSTD && WS_SLOTRSTD + (size_t)MAXP * 256 * 4 <= 8 * MiB, "small arrays");
constexpr size_t WS_W = 8 * MiB;
constexpr size_t WS_WA = WS_W, WS_WUQ = WS_WA + (size_t)NA * D * 2, WS_WUKV = WS_WUQ + (size_t)1536 * QLORA * 2, WS_WO = WS_WUKV + (size_t)2048 * KVLORA * 2;
constexpr size_t WS_WF1 = WS_WO + (size_t)D * D * 2, WS_WF2 = WS_WF1 + (size_t)2 * FF * D * 2, WS_WKVQ = WS_WF2 + (size_t)D * FF * 2, WS_WBO = WS_WKVQ + (size_t)3 * D * D * 2;
constexpr size_t WS_WM1 = WS_WBO + (size_t)D * D * 2, WS_WM2 = WS_WM1 + (size_t)NE * 2 * EFF * D * 2, WS_WEND = WS_WM2 + (size_t)NE * D * EFF * 2;
constexpr size_t ARENA = 208 * MiB;
static_assert(WS_WEND <= ARENA, "weights fit under the arena");
constexpr size_t WS_XN = ARENA;
constexpr size_t WS_QA = ARENA + 128 * MiB;
constexpr size_t WS_Q = ARENA + 224 * MiB;
constexpr size_t WS_K = ARENA + 416 * MiB;
constexpr size_t WS_V = ARENA + 608 * MiB;
constexpr size_t WS_O = ARENA;
static_assert(WS_V + (size_t)M * D * 2 <= 1024 * MiB, "MLA arena");
constexpr size_t WS_XR1 = ARENA + 128 * MiB;
constexpr size_t WS_H = ARENA + 256 * MiB;
constexpr size_t WS_XR2 = ARENA;
constexpr size_t WS_X2B = ARENA + 608 * MiB;
constexpr size_t WS_KVQ2 = ARENA + 128 * MiB;
constexpr size_t WS_O2 = ARENA + 512 * MiB;
constexpr size_t WS_XR3 = ARENA + 132 * MiB;
constexpr size_t WS_XG = ARENA;
constexpr size_t WS_HM = ARENA + 264 * MiB;
constexpr size_t WS_END = WS_HM + (size_t)MAXP_HALF * 256 * EFF * 2;
static_assert(WS_XG + (size_t)MAXP * 256 * D <= WS_XR3 && WS_XR3 + (size_t)M * D * 2 <= WS_HM && WS_END <= 1024 * MiB && WS_H + (size_t)M * FF * 2 <= WS_X2B && WS_X2B + (size_t)M * D * 2 <= 976 * MiB && WS_O2 + (size_t)M * D <= WS_X2B, "arena");
constexpr int CW_BAR = 4096;
constexpr int RING_OFF = 0, RING_BYTES = 131072;
constexpr int P0_SCR = 128 * 33 * 4;
constexpr int LDSCTL_OFF = 8 * P0_SCR, MISC_OFF = LDSCTL_OFF + 320;
static_assert(LDSCTL_OFF >= RING_BYTES, "control words above every phase's scratch");
constexpr int LDS_BYTES = 147456;
static_assert(MISC_OFF + 128 <= LDS_BYTES, "LDS map");
static_assert(att::lds_bytes<96>() <= RING_BYTES, "attention scratch fits the ring region");

#define GAS __attribute__((address_space(1)))
#define LAS __attribute__((address_space(3)))
typedef unsigned short bf16;
typedef unsigned v4u __attribute__((ext_vector_type(4)));
typedef unsigned v2u __attribute__((ext_vector_type(2)));
typedef float f32x4 __attribute__((ext_vector_type(4)));
typedef GAS unsigned gu32;
#define RLX_AGENT __ATOMIC_RELAXED, __HIP_MEMORY_SCOPE_AGENT
#define LDS_WAIT() asm volatile("s_waitcnt lgkmcnt(0)" ::: "memory")
__device__ __forceinline__ unsigned f2bf(float f) { unsigned u = __builtin_bit_cast(unsigned, f); return (u + 0x7fffu + ((u >> 16) & 1u)) >> 16; }
__device__ __forceinline__ unsigned pk2(float lo, float hi) { return f2bf(lo) | (f2bf(hi) << 16); }
__device__ __forceinline__ float bflo(unsigned u) { return __builtin_bit_cast(float, u << 16); }
__device__ __forceinline__ float bfhi(unsigned u) { return __builtin_bit_cast(float, u & 0xffff0000u); }
__device__ __forceinline__ float wave_sum(float v) {
    v += swz_xor<1>(v); v += swz_xor<2>(v); v += swz_xor<4>(v); v += swz_xor<8>(v); v += swz_xor<16>(v);
    return xor32_sum(v);
}
__device__ __forceinline__ float wave_maxf(float v) {
    v = fmaxf(v, swz_xor<1>(v)); v = fmaxf(v, swz_xor<2>(v)); v = fmaxf(v, swz_xor<4>(v)); v = fmaxf(v, swz_xor<8>(v)); v = fmaxf(v, swz_xor<16>(v));
    return xor32_max(v);
}

#define XB_TMO      128
#define XB_XCNT(j)  (256  + 64 * (j))
#define XB_XSUB(j)  (1280 + 64 * (j))
#define XB_XGEN(j)  (2304 + 64 * (j))
#define XB_TOP      3328
#define XB_TOPGEN   3392
#define XCD_BAR_WORDS 3456
#define XB_SPIN_CAP (1u << 18)

__device__ __forceinline__ unsigned xb_ld(unsigned* p)              { return __hip_atomic_load(p, __ATOMIC_RELAXED, __HIP_MEMORY_SCOPE_AGENT); }
__device__ __forceinline__ unsigned xb_add(unsigned* p, unsigned v) { return __hip_atomic_fetch_add(p, v, __ATOMIC_RELAXED, __HIP_MEMORY_SCOPE_AGENT); }
__device__ __forceinline__ unsigned xb_xcc_id() { return (unsigned)__builtin_amdgcn_s_getreg((3 << 11) | 20) & 0xFu; }
#define XB_SPIN(cond, bar) do { unsigned _sp = 0; while (cond) { __builtin_amdgcn_s_sleep(1); \
    if ((++_sp & 255u) == 0u) { if (xb_ld(&(bar)[XB_TMO])) break; if (_sp > XB_SPIN_CAP) { atomicAdd(&(bar)[XB_TMO], 1u); break; } } } } while (0)

struct XcdBarrier {
    int t0;
    unsigned* bar; unsigned x;
    volatile LAS unsigned* st;
};

__device__ __forceinline__ XcdBarrier xcd_barrier_post(unsigned* bar, volatile LAS unsigned* st, int t0) {
    XcdBarrier b; b.t0 = t0; b.bar = bar; b.x = xb_xcc_id(); b.st = st;
    if (b.t0) (void)xb_add(&bar[XB_XCNT(b.x)], 1u);
    return b;
}
__device__ __forceinline__ void xcd_barrier_complete(unsigned* bar, unsigned x, unsigned& nloc, unsigned& nx) {
    const unsigned G = gridDim.x * gridDim.y * gridDim.z;
    unsigned sum, cnt, mine, sp = 0u;
    for (;;) {
        sum = 0u; cnt = 0u; mine = 0u;
#pragma unroll
        for (unsigned j = 0; j < 16; ++j) { const unsigned c = xb_ld(&bar[XB_XCNT(j)]); sum += c; cnt += (c > 0u) ? 1u : 0u; mine = (j == x) ? c : mine; }
        if (sum == G) break;
        __builtin_amdgcn_s_sleep(1);
        if ((++sp & 255u) == 0u) { if (xb_ld(&bar[XB_TMO])) break; if (sp > XB_SPIN_CAP) { atomicAdd(&bar[XB_TMO], 1u); break; } }
    }
    nloc = mine > 0u ? mine : 1u; nx = cnt > 0u ? cnt : 1u;
}

__device__ __forceinline__ void xcd_barrier(const XcdBarrier& b) {
    asm volatile("s_waitcnt vmcnt(0)" ::: "memory");
    __syncthreads();
    if (b.t0) {
        unsigned* bar = b.bar;
        __builtin_amdgcn_s_waitcnt(0);
        unsigned nloc = b.st[0], nx = b.st[1];
        if (nloc == 0u) { xcd_barrier_complete(bar, b.x, nloc, nx); b.st[0] = nloc; b.st[1] = nx; }
        const unsigned old = xb_add(&bar[XB_XSUB(b.x)], 1u);
        const unsigned gen = old / nloc;
        if (old + 1u == (gen + 1u) * nloc) {
            __builtin_amdgcn_fence(__ATOMIC_RELEASE, "agent");
            asm volatile("s_waitcnt vmcnt(0)" ::: "memory");
            const unsigned og = xb_add(&bar[XB_TOP], 1u);
            const unsigned tg = og / nx;
            if (og + 1u == (tg + 1u) * nx) xb_add(&bar[XB_TOPGEN], 1u);
            else XB_SPIN(xb_ld(&bar[XB_TOPGEN]) == tg, bar);
            __builtin_amdgcn_fence(__ATOMIC_ACQUIRE, "agent");
            xb_add(&bar[XB_XGEN(b.x)], 1u);
            asm volatile("s_waitcnt vmcnt(0)" ::: "memory");
        } else {
            XB_SPIN(xb_ld(&bar[XB_XGEN(b.x)]) == gen, bar);
            __builtin_amdgcn_fence(__ATOMIC_ACQUIRE, "agent");
            asm volatile("s_waitcnt vmcnt(0)" ::: "memory");
        }
    }
    __syncthreads();
}

struct Args { const float* in[27]; float* out; unsigned char* ws; };
enum { I_X = 0, I_ATTN_NORM, I_FFN_NORM, I_A_WDQ, I_A_GCQ, I_A_WUQ, I_A_WDKV, I_A_GCKV, I_A_WUKV, I_A_GQN, I_A_GKN, I_A_WO, I_KV_NORM, I_KV_WK, I_KV_WV, I_KV_GKN,
       I_B_WQ, I_B_GQN, I_B_RELB, I_B_WO, I_FFN_W1, I_FFN_W3, I_FFN_W2, I_MOE_ROUTER, I_MOE_W1, I_MOE_W3, I_MOE_W2 };

struct Frame {
    LAS unsigned char* lds;
    int wave, vcu, G;
};
typedef const __attribute__((address_space(4))) Args* KArgs;
__device__ __forceinline__ KArgs kargs() { KArgs p = (KArgs)__builtin_amdgcn_kernarg_segment_ptr(); asm volatile("" : "+s"(p)); return p; }
#define INP(i) (kargs()->in[i])
#define OUTP (kargs()->out)
#define WSP (kargs()->ws)
__device__ __forceinline__ int fresh(int v) { asm volatile("" : "+v"(v)); return v; }

__device__ __forceinline__ void tr_item(const float* W, int ldw, int K, int k0, int nsrc0, const float* gain, bf16* WT, int drow0, LAS float* scr, int lane) {
    const int c4 = lane & 7, r = lane >> 3;
    const GAS float* src = (const GAS float*)W + (size_t)(k0 + r) * ldw + nsrc0 + 4 * c4;
    f32x4 v[16];
#pragma unroll
    for (int i = 0; i < 16; ++i) v[i] = *(const GAS f32x4*)(src + (size_t)(8 * i) * ldw);
    if (gain) {
#pragma unroll
        for (int i = 0; i < 16; ++i) v[i] = v[i] * gain[k0 + 8 * i + r];
    }
#pragma unroll
    for (int i = 0; i < 16; ++i) { LAS float* d = scr + (8 * i + r) * 33 + 4 * c4; d[0] = v[i].x; d[1] = v[i].y; d[2] = v[i].z; d[3] = v[i].w; }
    LDS_WAIT(); asm volatile("" ::: "memory");
    const int c16 = lane >> 2;
#pragma unroll
    for (int j = 0; j < 8; ++j) { const int n = (lane & 3) + 4 * j; const LAS float* sp = scr + (8 * c16) * 33 + n;
        v4u o; o.x = pk2(sp[0 * 33], sp[1 * 33]); o.y = pk2(sp[2 * 33], sp[3 * 33]); o.z = pk2(sp[4 * 33], sp[5 * 33]); o.w = pk2(sp[6 * 33], sp[7 * 33]);
        *(GAS v4u*)(WT + (size_t)(drow0 + n) * K + k0 + 8 * c16) = o; }
    LDS_WAIT(); asm volatile("" ::: "memory");
}
__device__ __forceinline__ void tr_plain(const float* W, int K, int N, const float* gain, bf16* WT, int drow_off, LAS float* scr, int item, int lane) {
    const int nblk = N / 32, kb = item / nblk, nb = item % nblk;
    tr_item(W, N, K, 128 * kb, 32 * nb, gain, WT, drow_off + 32 * nb, scr, lane);
}
__device__ __forceinline__ void tr_gated(const float* W, int K, int N, const float* gain, bf16* WT, int half, LAS float* scr, int item, int lane) {
    const int nblk = N / 32, kb = item / nblk, nb = item % nblk, n0 = 32 * nb;
    tr_item(W, N, K, 128 * kb, n0, gain, WT, (n0 >> 7) * 256 + half * 128 + (n0 & 127), scr, lane);
}
__device__ __forceinline__ unsigned pk_fp8x4(float a, float b, float c, float d) { int w = 0; w = __builtin_amdgcn_cvt_pk_fp8_f32(a, b, w, false); w = __builtin_amdgcn_cvt_pk_fp8_f32(c, d, w, true); return (unsigned)w; }
__device__ __forceinline__ void tr_item_f8(const float* W, int ldw, int K, int k0, int nsrc0, const float* gain, unsigned char* WT, int drow0, LAS float* scr, int lane) {
    const int c4 = lane & 7, r = lane >> 3;
    const GAS float* src = (const GAS float*)W + (size_t)(k0 + r) * ldw + nsrc0 + 4 * c4;
    f32x4 v[16];
#pragma unroll
    for (int i = 0; i < 16; ++i) v[i] = *(const GAS f32x4*)(src + (size_t)(8 * i) * ldw);
#pragma unroll
    for (int i = 0; i < 16; ++i) v[i] = v[i] * (gain ? gain[k0 + 8 * i + r] * 64.f : 64.f);
#pragma unroll
    for (int i = 0; i < 16; ++i) { LAS float* d = scr + (8 * i + r) * 33 + 4 * c4; d[0] = v[i].x; d[1] = v[i].y; d[2] = v[i].z; d[3] = v[i].w; }
    LDS_WAIT(); asm volatile("" ::: "memory");
    const int c8 = lane >> 3;
#pragma unroll
    for (int j = 0; j < 4; ++j) { const int n = (lane & 7) + 8 * j; const LAS float* sp = scr + (16 * c8) * 33 + n;
        v4u o; o.x = pk_fp8x4(sp[0 * 33], sp[1 * 33], sp[2 * 33], sp[3 * 33]); o.y = pk_fp8x4(sp[4 * 33], sp[5 * 33], sp[6 * 33], sp[7 * 33]);
        o.z = pk_fp8x4(sp[8 * 33], sp[9 * 33], sp[10 * 33], sp[11 * 33]); o.w = pk_fp8x4(sp[12 * 33], sp[13 * 33], sp[14 * 33], sp[15 * 33]);
        *(GAS v4u*)(WT + (size_t)(drow0 + n) * K + k0 + 16 * c8) = o; }
    LDS_WAIT(); asm volatile("" ::: "memory");
}
__device__ __forceinline__ float rms_row_to_bf16(const float* xrow, bf16* orow, int lane, f32x4 (&v)[4]) {
    const GAS f32x4* xr = (const GAS f32x4*)xrow + lane;
    float s = 0.f;
#pragma unroll
    for (int j = 0; j < 4; ++j) { v[j] = xr[64 * j]; s += (v[j].x * v[j].x + v[j].y * v[j].y) + (v[j].z * v[j].z + v[j].w * v[j].w); }
    const float rstd = 1.f / sqrtf(wave_sum(s) * (1.f / D) + EPS);
    GAS unsigned long long* o8 = (GAS unsigned long long*)orow + lane;
#pragma unroll
    for (int j = 0; j < 4; ++j) o8[64 * j] = (unsigned long long)pk2(v[j].x * rstd, v[j].y * rstd) | ((unsigned long long)pk2(v[j].z * rstd, v[j].w * rstd) << 32);
    return rstd;
}
__device__ __forceinline__ void norm_phase(const Frame& F, const float* x, bf16* xn) {
    const int tid = fresh(F.wave * 64 + lane_id_()), lane = tid & 63; (void)lane;
    const int gw = F.vcu * NWAVES + F.wave, NGW = F.G * NWAVES;
    for (int m = 2 * gw; m < M; m += 2 * NGW) {
        const GAS f32x4* xr = (const GAS f32x4*)(x + (size_t)m * D) + lane;
        f32x4 v[8]; float s0 = 0.f, s1 = 0.f;
#pragma unroll
        for (int j = 0; j < 8; ++j) v[j] = xr[64 * j];
#pragma unroll
        for (int j = 0; j < 4; ++j) { s0 += (v[j].x * v[j].x + v[j].y * v[j].y) + (v[j].z * v[j].z + v[j].w * v[j].w); s1 += (v[4 + j].x * v[4 + j].x + v[4 + j].y * v[4 + j].y) + (v[4 + j].z * v[4 + j].z + v[4 + j].w * v[4 + j].w); }
        const float r0 = 1.f / sqrtf(wave_sum(s0) * (1.f / D) + EPS), r1 = 1.f / sqrtf(wave_sum(s1) * (1.f / D) + EPS);
        GAS unsigned* o4 = (GAS unsigned*)((GAS unsigned char*)xn + (size_t)m * D) + lane;
#pragma unroll
        for (int j = 0; j < 8; ++j) { const float rr = j < 4 ? r0 : r1; o4[64 * j] = pk_fp8x4(v[j].x * rr, v[j].y * rr, v[j].z * rr, v[j].w * rr); }
    }
}

__device__ __forceinline__ void p0_prologue(const Frame& F) {
    const int tid = fresh(F.wave * 64 + lane_id_()), lane = tid & 63; (void)lane;
    LAS float* scr = (LAS float*)(F.lds + RING_OFF + F.wave * P0_SCR);
    unsigned char* ws = WSP;
    const int gw = F.vcu * NWAVES + F.wave, NGW = F.G * NWAVES;
    constexpr int I_DQ = 8 * 12, I_DKV = 8 * 9, I_UQ = 3 * 48, I_UKV = 2 * 64, I_SQ = 8 * 32, I_F13 = 8 * 88, I_F2 = 22 * 32, I_M13 = 8 * 112, I_M2 = 28 * 32;
    constexpr int NSMALL = I_DQ + I_DKV + I_UQ + I_UKV + I_SQ + 2 * I_F13 + I_F2 + 4 * I_SQ;
    constexpr int NITEMS = NSMALL + NE * (2 * I_M13 + I_M2);
    for (int it = gw; it < NITEMS; it += NGW) {
        int r = it;
        if (r < I_DQ)  { const int kb = r / 12, n0 = 32 * (r % 12); tr_item_f8(INP(I_A_WDQ), QLORA, D, 128 * kb, n0, INP(I_ATTN_NORM), ws + WS_WA, n0, scr, lane); continue; } r -= I_DQ;
        if (r < I_DKV) { const int kb = r / 9, n0 = 32 * (r % 9); tr_item_f8(INP(I_A_WDKV), KVLORA + ROPE_D, D, 128 * kb, n0, INP(I_ATTN_NORM), ws + WS_WA, QLORA + n0, scr, lane); continue; } r -= I_DKV;
        if (r < I_UQ)  { tr_plain(INP(I_A_WUQ), QLORA, NH * QKD, INP(I_A_GCQ), (bf16*)(ws + WS_WUQ), 0, scr, r, lane); continue; } r -= I_UQ;
        if (r < I_UKV) { const int kb = r / 64, n0 = 32 * (r % 64), head = n0 >> 7, within = n0 & 127;
            const int drow = within < 64 ? 256 * (head >> 2) + 128 * (within >> 5) + 32 * (head & 3) : 1024 + head * 64 + (within - 64);
            tr_item(INP(I_A_WUKV), NH * 128, KVLORA, 128 * kb, n0, INP(I_A_GCKV), (bf16*)(ws + WS_WUKV), drow, scr, lane); continue; } r -= I_UKV;
        if (r < I_SQ)  { const int kb = r / 32, n0 = 32 * (r % 32); tr_item_f8(INP(I_A_WO), D, D, 128 * kb, n0, nullptr, ws + WS_WO, n0, scr, lane); continue; } r -= I_SQ;
        if (r < I_F13) { tr_gated(INP(I_FFN_W1), D, FF, INP(I_FFN_NORM), (bf16*)(ws + WS_WF1), 0, scr, r, lane); continue; } r -= I_F13;
        if (r < I_F13) { tr_gated(INP(I_FFN_W3), D, FF, INP(I_FFN_NORM), (bf16*)(ws + WS_WF1), 1, scr, r, lane); continue; } r -= I_F13;
        if (r < I_F2)  { const int kb = r / 32, n0 = 32 * (r % 32); tr_item_f8(INP(I_FFN_W2), D, FF, 128 * kb, n0, nullptr, ws + WS_WF2, n0, scr, lane); continue; } r -= I_F2;
        if (r < I_SQ)  { const int kb = r / 32, n0 = 32 * (r % 32), head = n0 >> 6;
            tr_item_f8(INP(I_KV_WK), D, D, 128 * kb, n0, INP(I_KV_NORM), ws + WS_WKVQ, 256 * (head >> 2) + 128 * ((n0 >> 5) & 1) + 32 * (head & 3), scr, lane); continue; } r -= I_SQ;
        if (r < I_SQ)  { const int kb = r / 32, n0 = 32 * (r % 32); tr_item_f8(INP(I_KV_WV), D, D, 128 * kb, n0, INP(I_KV_NORM), ws + WS_WKVQ, 2 * D + n0, scr, lane); continue; } r -= I_SQ;
        if (r < I_SQ)  { const int kb = r / 32, n0 = 32 * (r % 32), head = n0 >> 6;
            tr_item_f8(INP(I_B_WQ), D, D, 128 * kb, n0, INP(I_ATTN_NORM) + D, ws + WS_WKVQ, D + 256 * (head >> 2) + 128 * ((n0 >> 5) & 1) + 32 * (head & 3), scr, lane); continue; } r -= I_SQ;
        if (r < I_SQ)  { const int kb = r / 32, n0 = 32 * (r % 32); tr_item_f8(INP(I_B_WO), D, D, 128 * kb, n0, nullptr, ws + WS_WBO, n0, scr, lane); continue; } r -= I_SQ;
        const int e = r / (2 * I_M13 + I_M2); r -= e * (2 * I_M13 + I_M2);
        if (r < I_M13) { const int kb = r / 112, n0 = 32 * (r % 112);
            tr_item_f8(INP(I_MOE_W1) + (size_t)e * D * EFF, EFF, D, 128 * kb, n0, INP(I_FFN_NORM) + D, ws + WS_WM1 + (size_t)e * 2 * EFF * D, (n0 >> 7) * 256 + (n0 & 127), scr, lane); continue; } r -= I_M13;
        if (r < I_M13) { const int kb = r / 112, n0 = 32 * (r % 112);
            tr_item_f8(INP(I_MOE_W3) + (size_t)e * D * EFF, EFF, D, 128 * kb, n0, INP(I_FFN_NORM) + D, ws + WS_WM1 + (size_t)e * 2 * EFF * D, (n0 >> 7) * 256 + 128 + (n0 & 127), scr, lane); continue; } r -= I_M13;
        { const int kb = r / 32, n0 = 32 * (r % 32); tr_item_f8(INP(I_MOE_W2) + (size_t)e * EFF * D, D, EFF, 128 * kb, n0, nullptr, ws + WS_WM2 + (size_t)e * D * EFF, n0, scr, lane); }
    }
    const int gt = F.vcu * (NWAVES * 64) + tid, NGT = F.G * NWAVES * 64;
    for (int c = gt; c < 96 * D / 16; c += NGT) *((GAS v4u*)(ws + WS_WA + (size_t)(QLORA + KVLORA + ROPE_D) * D) + c) = (v4u){0u, 0u, 0u, 0u};
    for (int c = gt; c < SEQ * 16; c += NGT) { const int pos = c >> 4, i = c & 15;
        const float inv = __builtin_amdgcn_exp2f(-(float)i * (13.287712379549449f / 16.f));
        const float rev = (float)pos * inv * 0.15915494309189535f; const float fr = rev - floorf(rev);
        ((GAS float*)(ws + WS_ROPE))[2 * c] = __builtin_amdgcn_cosf(fr); ((GAS float*)(ws + WS_ROPE))[2 * c + 1] = __builtin_amdgcn_sinf(fr); }
    norm_phase(F, INP(I_X), (bf16*)(ws + WS_XN));
}

__device__ __forceinline__ void route_phase(const Frame& F) {
    const int tid = fresh(F.wave * 64 + lane_id_()), lane = tid & 63;
    unsigned char* ws = WSP;
    LAS float* wrg = (LAS float*)(F.lds + RING_OFF);
    LAS int* cnt = (LAS int*)(F.lds + RING_OFF + 32768);
    const float* wr = INP(I_MOE_ROUTER); const float* g = INP(I_FFN_NORM) + D;
    { float wv[16], gv[16];
#pragma unroll
      for (int it = 0; it < 16; ++it) { const int idx = tid + it * NWAVES * 64; wv[it] = wr[idx]; gv[it] = g[idx >> 3]; }
#pragma unroll
      for (int it = 0; it < 16; ++it) { const int idx = tid + it * NWAVES * 64, k = idx >> 3, e = idx & 7, l = k >> 4, i = k & 15;
          wrg[((i * 2) + (e >> 2)) * 256 + 4 * l + (e & 3)] = wv[it] * gv[it]; } }
    __syncthreads();
    const int b5 = (lane >> 5) & 1, b4 = (lane >> 4) & 1, b3 = (lane >> 3) & 1;
    typedef float f32x2 __attribute__((ext_vector_type(2)));
    f32x2 wreg[16][4];
#pragma unroll
    for (int j = 0; j < 16; ++j) { const f32x4 w0 = *(const LAS f32x4*)(wrg + (j * 2) * 256 + 4 * lane), w1 = *(const LAS f32x4*)(wrg + (j * 2 + 1) * 256 + 4 * lane);
        wreg[j][0] = (f32x2){w0.x, w0.y}; wreg[j][1] = (f32x2){w0.z, w0.w}; wreg[j][2] = (f32x2){w1.x, w1.y}; wreg[j][3] = (f32x2){w1.z, w1.w}; }
    for (int c = F.vcu; c < M / 256; c += F.G) {
        if (tid < 16) cnt[tid] = 0;
        __syncthreads();
        v4u vn[2], vm[2];
        { const GAS v4u* xr = (const GAS v4u*)(ws + WS_XR3 + (size_t)(c * 256 + F.wave * 32) * D * 2) + 2 * lane; vn[0] = xr[0]; vn[1] = xr[1]; vm[0] = xr[D * 2 / 16]; vm[1] = xr[D * 2 / 16 + 1]; }
#pragma unroll 2
        for (int i = 0; i < 32; ++i) {
            const int m = c * 256 + F.wave * 32 + i;
            const v4u q0 = vn[0], q1 = vn[1];
            vn[0] = vm[0]; vn[1] = vm[1];
            if (i + 2 < 32) { const GAS v4u* xr = (const GAS v4u*)(ws + WS_XR3 + (size_t)(m + 2) * D * 2) + 2 * lane; vm[0] = xr[0]; vm[1] = xr[1]; }
            const unsigned qw[8] = {q0.x, q0.y, q0.z, q0.w, q1.x, q1.y, q1.z, q1.w};
            float xv[16]; float ssx = 0.f;
#pragma unroll
            for (int j = 0; j < 8; ++j) { xv[2 * j] = bflo(qw[j]); xv[2 * j + 1] = bfhi(qw[j]); }
#pragma unroll
            for (int j = 0; j < 16; j += 4) ssx += (xv[j] * xv[j] + xv[j + 1] * xv[j + 1]) + (xv[j + 2] * xv[j + 2] + xv[j + 3] * xv[j + 3]);
            float lg[8];
            { f32x2 l2[4] = {{0.f, 0.f}, {0.f, 0.f}, {0.f, 0.f}, {0.f, 0.f}};
#pragma unroll
              for (int j = 0; j < 16; ++j) { const f32x2 xx = {xv[j], xv[j]};
#pragma unroll
                  for (int q = 0; q < 4; ++q) l2[q] = l2[q] + xx * wreg[j][q]; }
#pragma unroll
              for (int q = 0; q < 4; ++q) { lg[2 * q] = l2[q].x; lg[2 * q + 1] = l2[q].y; } }
            float r4[4], r2[2], r1;
#pragma unroll
            for (int e = 0; e < 4; ++e) { const float mine = b5 ? lg[4 + e] : lg[e], other = b5 ? lg[e] : lg[4 + e]; r4[e] = mine + xor32_partner(other, b5); }
#pragma unroll
            for (int e = 0; e < 2; ++e) { const float mine = b4 ? r4[2 + e] : r4[e], other = b4 ? r4[e] : r4[2 + e]; r2[e] = mine + swz_xor<16>(other); }
            { const float mine = b3 ? r2[1] : r2[0], other = b3 ? r2[0] : r2[1]; r1 = mine + swz_xor<8>(other); }
            r1 += swz_xor<4>(r1); r1 += swz_xor<2>(r1); r1 += swz_xor<1>(r1);
            const float rstd = 1.f / sqrtf(wave_sum(ssx) * (1.f / D) + EPS);
#pragma unroll
            for (int e = 0; e < 8; ++e) lg[e] = __builtin_bit_cast(float, __builtin_amdgcn_readlane(__builtin_bit_cast(int, r1), 8 * e)) * rstd;
            int e1 = 0; float l1 = lg[0];
#pragma unroll
            for (int e = 1; e < 8; ++e) if (lg[e] > l1) { l1 = lg[e]; e1 = e; }
            int e2 = -1; float l2 = -INFINITY;
#pragma unroll
            for (int e = 0; e < 8; ++e) if (e != e1 && lg[e] > l2) { l2 = lg[e]; e2 = e; }
            const float g1 = 1.f / (1.f + __expf(l2 - l1)), g2 = 1.f - g1;
            const int elo = e1 < e2 ? e1 : e2, ehi = e1 < e2 ? e2 : e1;
            const float glo = e1 < e2 ? g1 : g2, ghi = e1 < e2 ? g2 : g1;
            if (lane == 0) { ((GAS float*)(ws + WS_TOKRSTD))[m] = rstd; ((GAS int*)(ws + WS_TOKE))[m] = elo | (ehi << 8); ((GAS float*)(ws + WS_TOKG))[2 * m] = glo; ((GAS float*)(ws + WS_TOKG))[2 * m + 1] = ghi;
                atomicAdd((int*)&cnt[elo], 1); atomicAdd((int*)&cnt[8 + ehi], 1); }
        }
        __syncthreads();
        if (tid < 16) ((GAS int*)(ws + WS_CNT))[c * 16 + tid] = cnt[tid];
        __syncthreads();
    }
}

__device__ __forceinline__ void slot_phase(const Frame& F, unsigned char* ws) {
    const int tid = fresh(F.wave * 64 + lane_id_()), lane = tid & 63; (void)lane;
    LAS int* call = (LAS int*)(F.lds + RING_OFF);
    LAS int* tot = call + 4096; LAS int* base = tot + 16; LAS int* pre = base + 16; LAS int* meta = pre + 16;
    LAS int* grp = meta + 16;
    LAS int* slot_of = grp + 512;
    for (int idx = tid; idx < 4096; idx += NWAVES * 64) call[idx] = ((const GAS int*)(ws + WS_CNT))[idx];
    __syncthreads();
    if (tid < 16) { int t = 0; for (int cc = 0; cc < 256; ++cc) t += call[cc * 16 + tid]; tot[tid] = t; }
    __syncthreads();
    if (tid == 0) { int off = 0; for (int g = 0; g < 16; ++g) { base[g] = off; off += (tot[g] + 255) & ~255; if (g == 7) meta[0] = off >> 8; } meta[1] = (off >> 8) - meta[0]; }
    __syncthreads();
    for (int c = F.vcu; c < M / 256; c += F.G) {
        if (tid < 16) { int p = 0; for (int cc = 0; cc < c; ++cc) p += call[cc * 16 + tid]; pre[tid] = p; }
        const int hf = tid >> 8, i = tid & 255, m = c * 256 + i;
        const int te = ((const GAS int*)(ws + WS_TOKE))[m];
        const int g = hf * 8 + (hf ? ((te >> 8) & 0xff) : (te & 0xff));
        grp[tid] = g;
        __syncthreads();
        int rank = 0;
        for (int j = 0; j < i; ++j) rank += (grp[hf * 256 + j] == g) ? 1 : 0;
        const int slot = base[g] + pre[g] + rank;
        ((GAS int*)(ws + WS_SLOTTOK))[slot] = m; ((GAS float*)(ws + WS_SLOTGATE))[slot] = ((const GAS float*)(ws + WS_TOKG))[2 * m + hf];
        slot_of[tid] = slot;
        __syncthreads();
        for (int i0 = F.wave; i0 < 256; i0 += 4 * NWAVES) {
            v4u x[4][2]; float rs[4];
#pragma unroll
            for (int k = 0; k < 4; ++k) { const int mm = c * 256 + i0 + 8 * k; const GAS v4u* src = (const GAS v4u*)(ws + WS_XR3 + (size_t)mm * D * 2);
                x[k][0] = src[2 * lane]; x[k][1] = src[2 * lane + 1]; rs[k] = ((const GAS float*)(ws + WS_TOKRSTD))[mm]; }
#pragma unroll
            for (int k = 0; k < 4; ++k) { const int i = i0 + 8 * k; const v4u x0 = x[k][0], x1 = x[k][1]; const float r = rs[k];
                const v4u o = (v4u){pk_fp8x4(bflo(x0.x) * r, bfhi(x0.x) * r, bflo(x0.y) * r, bfhi(x0.y) * r), pk_fp8x4(bflo(x0.z) * r, bfhi(x0.z) * r, bflo(x0.w) * r, bfhi(x0.w) * r),
                                    pk_fp8x4(bflo(x1.x) * r, bfhi(x1.x) * r, bflo(x1.y) * r, bfhi(x1.y) * r), pk_fp8x4(bflo(x1.z) * r, bfhi(x1.z) * r, bflo(x1.w) * r, bfhi(x1.w) * r)};
                ((GAS v4u*)(ws + WS_XG + (size_t)slot_of[i] * D))[lane] = o; ((GAS v4u*)(ws + WS_XG + (size_t)slot_of[256 + i] * D))[lane] = o; }
        }
        __syncthreads();
    }
    for (int g = F.vcu; g < 16; g += F.G) {
        const int s0 = base[g] + tot[g], s1 = base[g] + ((tot[g] + 255) & ~255);
        for (int s = s0 + F.wave; s < s1; s += NWAVES) { GAS v4u* dst = (GAS v4u*)(ws + WS_XG + (size_t)s * D);
            dst[lane] = (v4u){0u, 0u, 0u, 0u};
            if (lane == 0) { ((GAS int*)(ws + WS_SLOTTOK))[s] = -1; ((GAS float*)(ws + WS_SLOTGATE))[s] = 0.f; } }
    }
    if (F.vcu == 0) {
        if (tid < 16) { const int p0 = base[tid] >> 8, p1 = (base[tid] + ((tot[tid] + 255) & ~255)) >> 8; for (int p = p0; p < p1; ++p) ((GAS int*)(ws + WS_PANELE))[p] = tid & 7; }
        if (tid == 0) { ((GAS int*)(ws + WS_META))[0] = meta[0]; ((GAS int*)(ws + WS_META))[1] = meta[1]; }
        if (tid < 16) ((GAS int*)(ws + WS_META))[2 + tid] = base[tid] >> 8;
        if (tid == 0) { const int nPA = meta[0], nPB = meta[1]; int x = nPB > 256 ? nPB - 256 : 0;
            if (x > 0 && nPA > 256) { int LA = 0, HB = 7;
                for (int g = 0; g < 8; ++g) { const int q0 = base[g] >> 8, q1 = q0 + ((tot[g] + 255) >> 8); if (q0 <= 256 && 256 < q1) LA = g; }
                for (int g = 8; g < 16; ++g) { const int q0 = base[g] >> 8, q1 = q0 + ((tot[g] + 255) >> 8), P = nPA + x - 1; if (q0 <= P && P < q1) HB = g - 8; }
                if (LA < HB) x = 0; }
            ((GAS int*)(ws + WS_META))[18] = x; }
    }
    __syncthreads();
}

__global__ void __launch_bounds__(NWAVES * 64, 2) yoco_fwd(Args args) {
    extern __shared__ __attribute__((aligned(16))) unsigned char lds_raw[];
    Frame F;
    F.lds = (LAS unsigned char*)lds_raw;
    F.wave = __builtin_amdgcn_readfirstlane((int)threadIdx.x >> 6);
    F.G = gridDim.x; { const int bx = blockIdx.x; F.vcu = (F.G % 8 == 0) ? (bx % 8) * (F.G / 8) + bx / 8 : bx; }
    unsigned char* ws = WSP;
    volatile LAS unsigned* MISC = (volatile LAS unsigned*)(F.lds + MISC_OFF);
    for (int u = fresh((int)threadIdx.x); u < (LDS_BYTES - LDSCTL_OFF) / 4; u += NWAVES * 64) ((LAS unsigned*)(F.lds + LDSCTL_OFF))[u] = 0u;
    __syncthreads();
    (void)xcd_barrier_post((unsigned*)(ws + WS_CTL) + CW_BAR, MISC + 8, (F.wave == 0 && lane_id_() == 0) ? 1 : 0);
    LAS unsigned char* ring = F.lds + RING_OFF;
#define bid ((int)blockIdx.x)
#define GRID_BAR() do { XcdBarrier b_; b_.t0 = (F.wave == 0 && lane_id_() == 0) ? 1 : 0; b_.bar = (unsigned*)(WSP + WS_CTL) + CW_BAR; b_.x = xb_xcc_id(); b_.st = (volatile LAS unsigned*)(F.lds + MISC_OFF) + 8; xcd_barrier(b_); } while (0)
#define GEMM(EpiT, SchedT) pg8::gemm_phase<EpiT, SchedT, true, true>

    p0_prologue(F);
    GRID_BAR();
    { pg8::Gemm g{(const bf16*)(ws + WS_XN), (const bf16*)(ws + WS_WA), M, NA, D / 2, D / 2}; pg8::StaticOrder S; S.init(M, NA, F.G, bid);
      pg8::EpiQA E{(bf16*)(ws + WS_QA), (float*)(ws + WS_PARTQA), 1.f / 64};
      pg8::gemm_phase<pg8::EpiQA, pg8::StaticOrder, true, true, true>(ring, g, S, E, F.wave); }
    GRID_BAR();
    { pg8::Gemm g{(const bf16*)(ws + WS_QA), (const bf16*)(ws + WS_WUQ), M, NH * QKD, QLORA, NA}; pg8::StaticOrder S; S.init(M, NH * QKD, F.G, bid);
      pg8::EpiRowScaleBf16 E{(bf16*)(ws + WS_Q), NH * QKD, (const float*)(ws + WS_PARTQA), 1.f / QLORA};
      GEMM(pg8::EpiRowScaleBf16, pg8::StaticOrder)(ring, g, S, E, F.wave); }
    { pg8::Gemm g{(const bf16*)(ws + WS_QA) + QLORA, (const bf16*)(ws + WS_WUKV), M, NH * 128, KVLORA, NA}; pg8::StaticOrder S; S.init(M, NH * 128, F.G, bid);
      pg8::EpiKVup E{(bf16*)(ws + WS_K), (bf16*)(ws + WS_V), (const float*)(ws + WS_PARTQA), (const bf16*)(ws + WS_QA), INP(I_A_GKN), (const float*)(ws + WS_ROPE)};
      GEMM(pg8::EpiKVup, pg8::StaticOrder)(ring, g, S, E, F.wave); }
    GRID_BAR();
    bool fastA;
    { float bq = 0.f, bk = 0.f; const int l_ = lane_id_(); for (int i = l_; i < QKD; i += 64) { bq = fmaxf(bq, fabsf(INP(I_A_GQN)[i])); bk = fmaxf(bk, fabsf(INP(I_A_GKN)[i])); }
      bq = wave_maxf(bq); bk = wave_maxf(bk); fastA = __builtin_amdgcn_readfirstlane((int)(14.42f * bq * bk <= 40.f)) != 0; }
#define P5_UNIT(NM) att::attn_unit<96, false, 1536, 1536, D, D, true, NM, 2>(ring, (const bf16*)(ws + WS_Q) + (size_t)b * SEQ * 1536 + h * QKD, (const bf16*)(ws + WS_K) + (size_t)b * SEQ * 1536 + h * QKD, \
                                      (const bf16*)(ws + WS_V) + (size_t)b * SEQ * D + h * 64, (bf16*)(ws + WS_O + (size_t)b * SEQ * D + h * 64), \
                                      256 * qb, 0, 4 * qb + 3, 0, 4 * qb + (F.wave >> 1), 0, nullptr, INP(I_A_GQN), (const float*)(ws + WS_ROPE), F.wave, true, qfA, false, false, \
                                      (const bf16*)(ws + WS_Q) + (size_t)bn * SEQ * 1536 + hh * QKD + (size_t)(256 * qbn) * 1536)
    att::attn_init<96, 1536, D, 2>(ring, F.wave);
    att::bf16x8 qfA[6]; bool qldA = false;
    for (int p = F.vcu; p < BATCH * NH * 4; p += F.G) {
        const int bh = p >> 2, pid = p & 3, b = bh >> 4, h = bh & 15;
        for (int u2 = 0; u2 < 2; ++u2) {
            const int qb = u2 ? 7 - pid : pid;
            const int pn = u2 ? p + F.G : p; const bool hn = pn < BATCH * NH * 4;
            const int bhn = pn >> 2, pidn = pn & 3, bn = bhn >> 4, hh = bhn & 15, qbn = u2 ? pidn : 7 - pidn;
            if (fastA) P5_UNIT(true); else P5_UNIT(false);
        }
    }
    GRID_BAR();
    { pg8::Gemm g{(const bf16*)(ws + WS_O), (const bf16*)(ws + WS_WO), M, D, D / 2, D / 2}; pg8::StaticOrder S; S.init(M, D, F.G, bid);
      pg8::EpiResStream<true, false, false> E{INP(I_X), (bf16*)(ws + WS_XR1), nullptr, (float*)(ws + WS_PART1), 1.f / 2048};
      pg8::gemm_phase<pg8::EpiResStream<true, false, false>, pg8::StaticOrder, true, true, true>(ring, g, S, E, F.wave); }
    GRID_BAR();
    { pg8::Gemm g{(const bf16*)(ws + WS_XR1), (const bf16*)(ws + WS_WF1), M, 2 * FF, D, D}; pg8::StaticOrder S; S.init(M, 2 * FF, F.G, bid);
      pg8::EpiGatedF8T<true, false> E{ws + WS_H, FF, 0, (const float*)(ws + WS_PART1)};
      typedef pg8::EpiGatedF8T<true, false> EpiH8; GEMM(EpiH8, pg8::StaticOrder)(ring, g, S, E, F.wave); }
    GRID_BAR();
    { pg8::Gemm g{(const bf16*)(ws + WS_H), (const bf16*)(ws + WS_WF2), M, D, FF / 2, FF / 2}; pg8::StaticOrder S; S.init(M, D, F.G, bid);
      pg8::EpiResStream<true, true, true> E{ws + WS_XR1, (bf16*)(ws + WS_X2B), ws + WS_XR2, (float*)(ws + WS_PART2), 1.f / 64};
      pg8::gemm_phase<pg8::EpiResStream<true, true, true>, pg8::StaticOrder, true, true, true>(ring, g, S, E, F.wave); }
    GRID_BAR();
    { pg8::Gemm g{(const bf16*)(ws + WS_XR2), (const bf16*)(ws + WS_WKVQ), M, 2 * D, D / 2, D / 2}; pg8::StaticOrder S; S.init(M, 2 * D, F.G, bid);
      pg8::EpiK2Q2 E{(bf16*)(ws + WS_KVQ2), (const float*)(ws + WS_PART2), INP(I_KV_GKN), INP(I_B_GQN), 1.f / 64};
      pg8::gemm_phase<pg8::EpiK2Q2, pg8::StaticOrder, true, true, true>(ring, g, S, E, F.wave); }
    { pg8::Gemm g{(const bf16*)(ws + WS_XR2), (const bf16*)(ws + WS_WKVQ + (size_t)2 * D * D), M, D, D / 2, D / 2}; pg8::StaticOrder S; S.init(M, D, F.G, bid);
      pg8::EpiRowScale16 E{(bf16*)(ws + WS_KVQ2), 3 * D, D, (const float*)(ws + WS_PART2), 1.f / 64};
      pg8::gemm_phase<pg8::EpiRowScale16, pg8::StaticOrder, true, true, true>(ring, g, S, E, F.wave); }
    GRID_BAR();
    bool fastB;
    { float bq = 0.f, bk = 0.f, bb = 0.f; const int l_ = lane_id_(); bq = fabsf(INP(I_B_GQN)[l_]); bk = fabsf(INP(I_KV_GKN)[l_]);
      for (int i = l_; i < NH * 257; i += 64) bb = fmaxf(bb, fabsf(INP(I_B_RELB)[i]));
      bq = wave_maxf(bq); bk = wave_maxf(bk); bb = wave_maxf(bb); fastB = __builtin_amdgcn_readfirstlane((int)(11.78f * bq * bk + 1.4427f * bb <= 40.f)) != 0; }
    att::attn_init<64, 3072, 3072, 2>(ring, F.wave);
    att::bf16x8 qfB[4]; bool qldB = false;
    int last_h = -1;
    for (int p = F.vcu; p < BATCH * NH * 8; p += F.G) {
        const int bh = p >> 3, cb = ((p & 7) + (p >> 8)) & 7, b = bh >> 4, h = bh & 15;
        const bool ldb = h != last_h; last_h = h;
        const int pn = p + F.G; const bool hn = pn < BATCH * NH * 8; const int bhn = pn >> 3, cbn = ((pn & 7) + (pn >> 8)) & 7;
        const int c0 = 4 * cb, cc = c0 + (F.wave >> 1);
        const bf16* base = (const bf16*)(ws + WS_KVQ2) + (size_t)b * SEQ * 3072 + h * 64;
#define P13_UNIT(NM) att::attn_unit<64, true, 3072, 3072, 3072, D, true, NM, 2>(ring, base + 2048, base, base + 1024, (bf16*)(ws + WS_O2 + (size_t)b * SEQ * D + h * 64), \
                                 256 * cb, c0 - 8 < 0 ? 0 : c0 - 8, c0 + 3, cc - 8 < 0 ? 0 : cc - 8, cc, cc, INP(I_B_RELB) + h * 257, nullptr, nullptr, F.wave, ldb, qfB, qldB, hn, \
                                 (const bf16*)(ws + WS_KVQ2) + (size_t)(bhn >> 4) * SEQ * 3072 + (bhn & 15) * 64 + 2048 + (size_t)(256 * cbn) * 3072)
        if (fastB) P13_UNIT(true); else P13_UNIT(false);
        qldB = hn;
    }
    GRID_BAR();
    { pg8::Gemm g{(const bf16*)(ws + WS_O2), (const bf16*)(ws + WS_WBO), M, D, D / 2, D / 2}; pg8::StaticOrder S; S.init(M, D, F.G, bid);
      pg8::EpiResStream<false, false, true> E{ws + WS_X2B, (bf16*)(ws + WS_XR3), nullptr, nullptr, 1.f / 2048};
      pg8::gemm_phase<pg8::EpiResStream<false, false, true>, pg8::StaticOrder, true, true, true>(ring, g, S, E, F.wave); }
    GRID_BAR();
    route_phase(F);
    GRID_BAR();
    slot_phase(F, ws);
    GRID_BAR();
#define MOE_LOAD(hf_) unsigned char* w2 = WSP; \
          const int nPA = __builtin_amdgcn_readfirstlane(((const GAS int*)(w2 + WS_META))[0]), nPB = __builtin_amdgcn_readfirstlane(((const GAS int*)(w2 + WS_META))[1]); (void)nPB; \
          const int xB = __builtin_amdgcn_readfirstlane(((const GAS int*)(w2 + WS_META))[18]); (void)xB; \
          const int p0 = (hf_) ? nPA : 0; int pbk[7]; \
          _Pragma("unroll") for (int k = 0; k < 7; ++k) pbk[k] = __builtin_amdgcn_readfirstlane(((const GAS int*)(w2 + WS_META))[2 + (hf_) * 8 + 1 + k]) - p0;
    constexpr size_t HMB_OFF = (size_t)MAXP_HALF * 256 * EFF;
    { MOE_LOAD(0)
      pg8::Gemm g{(const bf16*)(w2 + WS_XG), (const bf16*)(w2 + WS_WM1), nPA * 256, 2 * EFF, D / 2, D / 2};
      pg8::MoeOrder S; S.init(nPA, 2 * EFF / 256, F.G, bid);
#pragma unroll
      for (int k = 0; k < 7; ++k) S.pb[k] = pbk[k];
      pg8::EpiGatedF8 E{w2 + WS_HM, EFF, 2 * EFF / 256};
      pg8::gemm_phase<pg8::EpiGatedF8, pg8::MoeOrder, true, true, true>(ring, g, S, E, F.wave); }
    { MOE_LOAD(1)
      pg8::Gemm g{(const bf16*)(w2 + WS_XG + (size_t)p0 * 256 * D), (const bf16*)(w2 + WS_WM1), xB * 256, 2 * EFF, D / 2, D / 2};
      pg8::MoeOrder S; S.init(xB, 2 * EFF / 256, F.G, bid); S.rot = (nPA * (2 * EFF / 256)) % F.G;
#pragma unroll
      for (int k = 0; k < 7; ++k) S.pb[k] = pbk[k];
      pg8::EpiGatedF8 E{w2 + WS_HM + HMB_OFF, EFF, 2 * EFF / 256};
      pg8::gemm_phase<pg8::EpiGatedF8, pg8::MoeOrder, true, true, true>(ring, g, S, E, F.wave); }
    GRID_BAR();
    { MOE_LOAD(0)
      pg8::Gemm g{(const bf16*)(w2 + WS_HM), (const bf16*)(w2 + WS_WM2), 256 * 256, D, EFF / 2, EFF / 2};
      pg8::MoeOrder S; S.init(256, D / 256, F.G, bid);
#pragma unroll
      for (int k = 0; k < 7; ++k) S.pb[k] = pbk[k];
      pg8::EpiMoeDown<true> E{nullptr, (bf16*)(w2 + WS_XR3), (const int*)(w2 + WS_SLOTTOK), (const float*)(w2 + WS_SLOTGATE), 0, D, 1.f / 64};
      pg8::gemm_phase<pg8::EpiMoeDown<true>, pg8::MoeOrder, true, true, true>(ring, g, S, E, F.wave); }
    GRID_BAR();
    { MOE_LOAD(0)
      pg8::Gemm g{(const bf16*)(w2 + WS_HM), (const bf16*)(w2 + WS_WM2), nPA * 256, D, EFF / 2, EFF / 2};
      pg8::LeftOrder S; S.M.init(nPA, D / 256, F.G, bid); S.nLeft = 4 * (nPA - 256); S.c0 = 0; S.pbase = 256;
#pragma unroll
      for (int k = 0; k < 7; ++k) S.M.pb[k] = pbk[k];
      pg8::EpiMoeDown<true> E{nullptr, (bf16*)(w2 + WS_XR3), (const int*)(w2 + WS_SLOTTOK), (const float*)(w2 + WS_SLOTGATE), 0, D, 1.f / 64};
      pg8::gemm_phase<pg8::EpiMoeDown<true>, pg8::LeftOrder, true, true, true>(ring, g, S, E, F.wave); }
    { MOE_LOAD(1)
      pg8::Gemm g{(const bf16*)(w2 + WS_HM + HMB_OFF), (const bf16*)(w2 + WS_WM2), xB * 256, D, EFF / 2, EFF / 2};
      pg8::LeftOrder S; S.M.init(xB, D / 256, F.G, bid); S.nLeft = 4 * xB; S.c0 = 4 * (nPA - 256); S.pbase = 0;
#pragma unroll
      for (int k = 0; k < 7; ++k) S.M.pb[k] = pbk[k];
      pg8::EpiMoeDown<false> E{OUTP, (bf16*)(w2 + WS_XR3), (const int*)(w2 + WS_SLOTTOK), (const float*)(w2 + WS_SLOTGATE), p0 * 256, D, 1.f / 64};
      pg8::gemm_phase<pg8::EpiMoeDown<false>, pg8::LeftOrder, true, true, true>(ring, g, S, E, F.wave); }
    { MOE_LOAD(1)
      pg8::Gemm g{(const bf16*)(w2 + WS_XG + (size_t)(p0 + xB) * 256 * D), (const bf16*)(w2 + WS_WM1), (nPB - xB) * 256, 2 * EFF, D / 2, D / 2};
      pg8::MoeOrder S; S.init(nPB - xB, 2 * EFF / 256, F.G, bid); S.nBusy = 4 * (nPA - 256) + 4 * xB; S.SK = 4;
#pragma unroll
      for (int k = 0; k < 7; ++k) S.pb[k] = pbk[k] - xB;
      pg8::EpiGatedF8 E{w2 + WS_HM + HMB_OFF + (size_t)xB * 256 * EFF, EFF, 2 * EFF / 256};
      pg8::gemm_phase<pg8::EpiGatedF8, pg8::MoeOrder, true, true, true>(ring, g, S, E, F.wave); }
    GRID_BAR();
    { MOE_LOAD(1)
      pg8::Gemm g{(const bf16*)(w2 + WS_HM + HMB_OFF + (size_t)xB * 256 * EFF), (const bf16*)(w2 + WS_WM2), (nPB - xB) * 256, D, EFF / 2, EFF / 2};
      pg8::MoeOrder S; S.init(nPB - xB, D / 256, F.G, bid);
#pragma unroll
      for (int k = 0; k < 7; ++k) S.pb[k] = pbk[k] - xB;
      pg8::EpiMoeDown<false> E{OUTP, (bf16*)(w2 + WS_XR3), (const int*)(w2 + WS_SLOTTOK), (const float*)(w2 + WS_SLOTGATE), (p0 + xB) * 256, D, 1.f / 64};
      pg8::gemm_phase<pg8::EpiMoeDown<false>, pg8::MoeOrder, true, true, true>(ring, g, S, E, F.wave); }
#undef MOE_LOAD
#undef GRID_BAR
#undef bid
#undef GEMM
}

extern "C" void kernel_launch(void* const* d_in, const int* in_sizes, int n_in, void* d_out, int out_size, void* d_ws, size_t ws_size, hipStream_t stream) {
    static int grid = 0;
    if (grid == 0) {
        if (n_in != 27 || in_sizes[0] != M * D || out_size != M * D || ws_size < WS_END) { fprintf(stderr, "kernel_launch: unexpected shapes (n_in %d, in0 %d, out %d, ws %zu < %zu); nothing launched\n", n_in, n_in > 0 ? in_sizes[0] : -1, out_size, ws_size, (size_t)WS_END); grid = -1; return; }
        int dev = 0, cus = 0, per_cu = 0;
        if (hipGetDevice(&dev) != hipSuccess || hipDeviceGetAttribute(&cus, hipDeviceAttributeMultiprocessorCount, dev) != hipSuccess) { grid = -1; return; }
        if (hipFuncSetAttribute((const void*)yoco_fwd, hipFuncAttributeMaxDynamicSharedMemorySize, LDS_BYTES) != hipSuccess) { fprintf(stderr, "kernel_launch: hipFuncSetAttribute failed\n"); grid = -1; return; }
        if (hipOccupancyMaxActiveBlocksPerMultiprocessor(&per_cu, (const void*)yoco_fwd, NWAVES * 64, LDS_BYTES) != hipSuccess || per_cu < 1) { fprintf(stderr, "kernel_launch: occupancy query says %d\n", per_cu); }
        (void)hipGetLastError();
        grid = cus;
    }
    if (grid < 0) return;
    if (hipMemsetAsync((char*)d_ws + WS_CTL, 0, CTL_ZERO_BYTES, stream) != hipSuccess) return;
    Args a{};
    for (int i = 0; i < 27; ++i) a.in[i] = (const float*)d_in[i];
    a.out = (float*)d_out; a.ws = (unsigned char*)d_ws;
    hipLaunchKernelGGL(yoco_fwd, dim3(grid), dim3(NWAVES * 64), LDS_BYTES, stream, a);
}
```

```cpp
#include <hip/hip_runtime.h>
#include <cstdio>
#include <cstdint>
__device__ __forceinline__ int lane_id_() { unsigned m_ = ~0u; asm volatile("" : "+s"(m_)); return (int)__builtin_amdgcn_mbcnt_hi(m_, __builtin_amdgcn_mbcnt_lo(m_, 0u)); }
template <int X> __device__ __forceinline__ float swz_xor(float v) { return __builtin_bit_cast(float, __builtin_amdgcn_ds_swizzle(__builtin_bit_cast(int, v), (X << 10) | 0x1f)); }
__device__ __forceinline__ void halves32(float v, float& r_lo, float& r_hi) { unsigned a_ = __builtin_bit_cast(unsigned, v), b_ = a_;
    asm volatile("s_nop 1\n\tv_permlane32_swap_b32 %0, %1\n\ts_nop 1" : "+v"(a_), "+v"(b_)); r_lo = __builtin_bit_cast(float, a_); r_hi = __builtin_bit_cast(float, b_); }
__device__ __forceinline__ float xor32_partner(float v, int upper_half) { float lo, hi; halves32(v, lo, hi); return upper_half ? lo : hi; }
__device__ __forceinline__ float xor32_sum(float v) { float lo, hi; halves32(v, lo, hi); return lo + hi; }
__device__ __forceinline__ float xor32_max(float v) { float lo, hi; halves32(v, lo, hi); return fmaxf(lo, hi); }
namespace pg8 {
#define PG8_LAS __attribute__((address_space(3)))
typedef unsigned short bf16_t;
typedef short bf16x8 __attribute__((ext_vector_type(8)));
typedef float f32x4 __attribute__((ext_vector_type(4)));
typedef unsigned u32x4 __attribute__((ext_vector_type(4)));
constexpr int BM = 256, BK = 64, HALF = 128, HTB = HALF * BK * 2  , STAGE_BYTES = 8 * HTB, NXCD = 8, WGM = 8;

__host__ __device__ __forceinline__ int lds_byte(int r, int c) { const int st = (r >> 4) * 2 + (c >> 5), rr = r & 15, cc = c & 31, ob = rr * 64 + cc * 2; return st * 1024 + (ob ^ (((ob >> 9) & 1) << 5)); }
__host__ __device__ __forceinline__ void stage_rc(int b, int& R, int& C) { const int st = b / 1024, sb = b % 1024, swz = sb ^ (((sb >> 9) & 1) << 5); R = (st >> 1) * 16 + swz / 64; C = (st & 1) * 32 + (swz % 64) / 2; }
__host__ __device__ __forceinline__ int perm32(int rho) { const int n = rho >> 4, i = rho & 15; return 8 * (i >> 2) + 4 * n + (i & 3); }

struct Unit { int pm, pn; };
struct Gemm { const bf16_t* A; const bf16_t* Bt; int M, N, K, lda; };

struct StaticOrder {
    int nM, nN, nwg, G, c;
    __host__ __device__ void init(int M, int N, int G_, int c_) { nM = M / BM; nN = N / BM; nwg = nM * nN; G = G_; c = c_; }
    __host__ __device__ bool next(int i, Unit& u) const {
        const int L = i * G + c; if (L >= nwg) return false;
        int wgid = L; { const int q = nwg / NXCD, r = nwg % NXCD, xcd = wgid % NXCD, off = wgid / NXCD; wgid = (xcd < r ? xcd * (q + 1) : r * (q + 1) + (xcd - r) * q) + off; }
        const int nig = WGM * nN, gid = wgid / nig, fm = gid * WGM, gsz = (nM - fm) < WGM ? (nM - fm) : WGM;
        u.pm = fm + ((wgid % nig) % gsz); u.pn = (wgid % nig) / gsz; return true;
    }
    __device__ __forceinline__ void a_ready(const Unit&) const {}
    __device__ __forceinline__ void done(const Unit&) const {}
};
__device__ __forceinline__ unsigned cvt_pk_bf16(float lo, float hi) { unsigned r; asm volatile("v_cvt_pk_bf16_f32 %0, %1, %2" : "=v"(r) : "v"(lo), "v"(hi)); return r; }
__device__ __forceinline__ float silu_f(float x) { const float e = __builtin_amdgcn_exp2f(x * -1.4426950408889634f); return x * __builtin_amdgcn_rcpf(1.f + e); }

__device__ __forceinline__ float sum4(const f32x4& a) { return (a[0] + a[1]) + (a[2] + a[3]); }
__device__ __forceinline__ float part_sum8(const float* p) { return sum4(*(const f32x4*)p) + sum4(*(const f32x4*)(p + 4)); }
__device__ __forceinline__ float part_sum16(const float* p) { return (sum4(*(const f32x4*)p) + sum4(*(const f32x4*)(p + 4))) + (sum4(*(const f32x4*)(p + 8)) + sum4(*(const f32x4*)(p + 12))); }
__device__ __forceinline__ float fq_sum(float v) { v += swz_xor<16>(v); return xor32_sum(v); }
__device__ __forceinline__ float sq8(const f32x4& a, const f32x4& b) { return ((a[0] * a[0] + a[1] * a[1]) + (a[2] * a[2] + a[3] * a[3])) + ((b[0] * b[0] + b[1] * b[1]) + (b[2] * b[2] + b[3] * b[3])); }
__device__ __forceinline__ u32x4 pack8(const f32x4& a, const f32x4& b) { u32x4 w; w.x = cvt_pk_bf16(a[0], a[1]); w.y = cvt_pk_bf16(a[2], a[3]); w.z = cvt_pk_bf16(b[0], b[1]); w.w = cvt_pk_bf16(b[2], b[3]); return w; }
constexpr float EPS_ = 1e-6f;
__device__ __forceinline__ unsigned pk_fp8x4(float a, float b, float c, float d) { int w = 0; w = __builtin_amdgcn_cvt_pk_fp8_f32(a, b, w, false); w = __builtin_amdgcn_cvt_pk_fp8_f32(c, d, w, true); return (unsigned)w; }

struct EpiQA {
    static constexpr bool PERM = true, AFTER_DRAIN = false;
    bf16_t* O; float* part; float wscale;
    __device__ __forceinline__ void operator()(const f32x4 (&acc)[2][2][4][2], const Unit& u, int wr, int wc, int fr, int fq) const {
        { int t_ = lane_id_(); asm volatile("" : "+v"(t_)); fr = t_ & 15; fq = (t_ >> 4) & 3; }
        const int row0 = u.pm * BM + wr * 64 + fr, col0 = u.pn * BM + wc * 32 + 8 * fq;
#pragma unroll
        for (int ai = 0; ai < 2; ++ai)
#pragma unroll
            for (int m = 0; m < 4; ++m) { const int row = row0 + ai * HALF + m * 16; bf16_t* rowp = O + (size_t)row * 768 + col0;
                const f32x4 a0 = acc[ai][0][m][0] * wscale, a1 = acc[ai][0][m][1] * wscale, b0 = acc[ai][1][m][0] * wscale, b1 = acc[ai][1][m][1] * wscale;
                *(u32x4*)(rowp) = pack8(a0, a1); *(u32x4*)(rowp + HALF) = pack8(b0, b1);
                const float s0 = sq8(a0, a1), s1 = sq8(b0, b1);
                float* pr = part + (size_t)row * 16;
                if (u.pn == 0) { const float t = fq_sum(s0 + s1); if (fq == 0) pr[wc] = t; }
                else if (u.pn == 1) { const float t0 = fq_sum(s0), t1 = fq_sum(s1); if (fq == 0) { pr[4 + wc] = t0; pr[8 + wc] = t1; } }
                else { const float t = fq_sum(s0); if (fq == 0) pr[12 + wc] = t; } }
    }
};

struct EpiRowScaleBf16 {
    static constexpr bool PERM = true, AFTER_DRAIN = false;
    bf16_t* O; int ldc; const float* part; float inv_n;
    __device__ __forceinline__ void operator()(const f32x4 (&acc)[2][2][4][2], const Unit& u, int wr, int wc, int fr, int fq) const {
        { int t_ = lane_id_(); asm volatile("" : "+v"(t_)); fr = t_ & 15; fq = (t_ >> 4) & 3; }
        const int row0 = u.pm * BM + wr * 64 + fr, col0 = u.pn * BM + wc * 32 + 8 * fq;
#pragma unroll
        for (int ai = 0; ai < 2; ++ai)
#pragma unroll
            for (int m = 0; m < 4; ++m) { const int row = row0 + ai * HALF + m * 16; bf16_t* rowp = O + (size_t)row * ldc + col0;
                const float rs = __builtin_amdgcn_rsqf(part_sum8(part + (size_t)row * 16) * inv_n + EPS_);
                *(u32x4*)(rowp) = pack8(acc[ai][0][m][0] * rs, acc[ai][0][m][1] * rs); *(u32x4*)(rowp + HALF) = pack8(acc[ai][1][m][0] * rs, acc[ai][1][m][1] * rs); }
    }
};

struct EpiKVup {
    static constexpr bool PERM = true, AFTER_DRAIN = false;
    bf16_t* Kd; bf16_t* Vd; const float* part; const bf16_t* QA; const float* g_kn; const float* rope;
    __device__ __forceinline__ void operator()(const f32x4 (&acc)[2][2][4][2], const Unit& u, int wr, int wc, int fr, int fq) const {
        { int t_ = lane_id_(); asm volatile("" : "+v"(t_)); fr = t_ & 15; fq = (t_ >> 4) & 3; }
        const int row0 = u.pm * BM + wr * 64 + fr;
        if (u.pn >= 4) {
            const int col0 = (u.pn - 4) * BM + wc * 32 + 8 * fq;
#pragma unroll
            for (int ai = 0; ai < 2; ++ai)
#pragma unroll
                for (int m = 0; m < 4; ++m) { const int row = row0 + ai * HALF + m * 16; bf16_t* rowp = Vd + (size_t)row * 1024 + col0;
                    const float rs = __builtin_amdgcn_rsqf(part_sum8(part + (size_t)row * 16 + 8) * (1.f / 256) + EPS_);
                    *(u32x4*)(rowp) = pack8(acc[ai][0][m][0] * rs, acc[ai][0][m][1] * rs); *(u32x4*)(rowp + HALF) = pack8(acc[ai][1][m][0] * rs, acc[ai][1][m][1] * rs); }
            return;
        }
        const int head = 4 * u.pn + wc;
        f32x4 gA0 = *(const f32x4*)(g_kn + 8 * fq), gA1 = *(const f32x4*)(g_kn + 8 * fq + 4), gB0 = *(const f32x4*)(g_kn + 32 + 8 * fq), gB1 = *(const f32x4*)(g_kn + 32 + 8 * fq + 4);
        const f32x4 gR1 = *(const f32x4*)(g_kn + 64 + 4 * fq), gR2 = *(const f32x4*)(g_kn + 80 + 4 * fq);
#pragma unroll
        for (int ai = 0; ai < 2; ++ai)
#pragma unroll
            for (int m = 0; m < 4; ++m) { const int row = row0 + ai * HALF + m * 16;
                const float rs = __builtin_amdgcn_rsqf(part_sum8(part + (size_t)row * 16 + 8) * (1.f / 256) + EPS_);
                f32x4 a0 = acc[ai][0][m][0] * rs, a1 = acc[ai][0][m][1] * rs, b0 = acc[ai][1][m][0] * rs, b1 = acc[ai][1][m][1] * rs;
                const unsigned long long p1 = *(const unsigned long long*)(QA + (size_t)row * 768 + 640 + 4 * fq), p2 = *(const unsigned long long*)(QA + (size_t)row * 768 + 656 + 4 * fq);
                f32x4 x1, x2;
                x1[0] = __builtin_bit_cast(float, (unsigned)(p1 << 16)); x1[1] = __builtin_bit_cast(float, (unsigned)p1 & 0xffff0000u);
                x1[2] = __builtin_bit_cast(float, (unsigned)(p1 >> 32) << 16); x1[3] = __builtin_bit_cast(float, (unsigned)(p1 >> 32) & 0xffff0000u);
                x2[0] = __builtin_bit_cast(float, (unsigned)(p2 << 16)); x2[1] = __builtin_bit_cast(float, (unsigned)p2 & 0xffff0000u);
                x2[2] = __builtin_bit_cast(float, (unsigned)(p2 >> 32) << 16); x2[3] = __builtin_bit_cast(float, (unsigned)(p2 >> 32) & 0xffff0000u);
                const float ss = fq_sum(sq8(a0, a1) + sq8(b0, b1) + sq8(x1, x2));
                const float sh = __builtin_amdgcn_rsqf(ss * (1.f / 96) + EPS_);
                bf16_t* kp = Kd + (size_t)row * 1536 + head * 96;
                *(u32x4*)(kp + 8 * fq) = pack8(a0 * gA0 * sh, a1 * gA1 * sh); *(u32x4*)(kp + 32 + 8 * fq) = pack8(b0 * gB0 * sh, b1 * gB1 * sh);
                const f32x4* rp = (const f32x4*)(rope + ((size_t)(row & 2047) * 16 + 4 * fq) * 2);
                const f32x4 c01 = rp[0], c23 = rp[1];
                const f32x4 y1 = x1 * gR1 * sh, y2 = x2 * gR2 * sh;
                f32x4 o1, o2;
                o1[0] = y1[0] * c01[0] - y2[0] * c01[1]; o2[0] = y2[0] * c01[0] + y1[0] * c01[1];
                o1[1] = y1[1] * c01[2] - y2[1] * c01[3]; o2[1] = y2[1] * c01[2] + y1[1] * c01[3];
                o1[2] = y1[2] * c23[0] - y2[2] * c23[1]; o2[2] = y2[2] * c23[0] + y1[2] * c23[1];
                o1[3] = y1[3] * c23[2] - y2[3] * c23[3]; o2[3] = y2[3] * c23[2] + y1[3] * c23[3];
                unsigned long long w1 = (unsigned long long)cvt_pk_bf16(o1[0], o1[1]) | ((unsigned long long)cvt_pk_bf16(o1[2], o1[3]) << 32);
                unsigned long long w2 = (unsigned long long)cvt_pk_bf16(o2[0], o2[1]) | ((unsigned long long)cvt_pk_bf16(o2[2], o2[3]) << 32);
                *(unsigned long long*)(kp + 64 + 4 * fq) = w1; *(unsigned long long*)(kp + 80 + 4 * fq) = w2; }
    }
};

struct EpiK2Q2 {
    static constexpr bool PERM = true, AFTER_DRAIN = false;
    bf16_t* O; const float* pss; const float* gk; const float* gq; float wscale;
    __device__ __forceinline__ void operator()(const f32x4 (&acc)[2][2][4][2], const Unit& u, int wr, int wc, int fr, int fq) const {
        { int t_ = lane_id_(); asm volatile("" : "+v"(t_)); fr = t_ & 15; fq = (t_ >> 4) & 3; }
        const int row0 = u.pm * BM + wr * 64 + fr, isq = u.pn >> 2, tl = u.pn & 3;
        const float* g = isq ? gq : gk; const float post = isq ? 0.125f * 1.4426950408889634f : 1.f;
        const f32x4 gA0 = *(const f32x4*)(g + 8 * fq) * post, gA1 = *(const f32x4*)(g + 8 * fq + 4) * post, gB0 = *(const f32x4*)(g + 32 + 8 * fq) * post, gB1 = *(const f32x4*)(g + 32 + 8 * fq + 4) * post;
        const int colh = isq * 2048 + (4 * tl + wc) * 64;
        unsigned zhi_ = 0u; asm volatile("" : "+v"(zhi_));
        const unsigned long long coff = ((unsigned long long)zhi_ << 32) | (unsigned)((colh + 8 * fq) * 2);
#pragma unroll
        for (int ai = 0; ai < 2; ++ai)
#pragma unroll
            for (int m = 0; m < 4; ++m) { const int row = row0 + ai * HALF + m * 16; unsigned char* rowp = (unsigned char*)O + (size_t)row * 6144 + coff;
                const float rs = __builtin_amdgcn_rsqf(part_sum16(pss + (size_t)row * 16) * (1.f / 1024) + EPS_) * wscale;
                const f32x4 a0 = acc[ai][0][m][0] * rs, a1 = acc[ai][0][m][1] * rs, b0 = acc[ai][1][m][0] * rs, b1 = acc[ai][1][m][1] * rs;
                const float ss = fq_sum(sq8(a0, a1) + sq8(b0, b1));
                const float sh = __builtin_amdgcn_rsqf(ss * (1.f / 64) + EPS_);
                *(u32x4*)(rowp) = pack8(a0 * gA0 * sh, a1 * gA1 * sh); *(u32x4*)(rowp + 64) = pack8(b0 * gB0 * sh, b1 * gB1 * sh); }
    }
};
struct EpiRowScale16 {
    static constexpr bool PERM = true, AFTER_DRAIN = false;
    bf16_t* O; int ldc; int coff; const float* pss; float wscale;
    __device__ __forceinline__ void operator()(const f32x4 (&acc)[2][2][4][2], const Unit& u, int wr, int wc, int fr, int fq) const {
        { int t_ = lane_id_(); asm volatile("" : "+v"(t_)); fr = t_ & 15; fq = (t_ >> 4) & 3; }
        const int row0 = u.pm * BM + wr * 64 + fr, col0 = coff + u.pn * BM + wc * 32 + 8 * fq;
#pragma unroll
        for (int ai = 0; ai < 2; ++ai)
#pragma unroll
            for (int m = 0; m < 4; ++m) { const int row = row0 + ai * HALF + m * 16; bf16_t* rowp = O + (size_t)row * ldc + col0;
                const float rs = __builtin_amdgcn_rsqf(part_sum16(pss + (size_t)row * 16) * (1.f / 1024) + EPS_) * wscale;
                *(u32x4*)(rowp) = pack8(acc[ai][0][m][0] * rs, acc[ai][0][m][1] * rs); *(u32x4*)(rowp + HALF) = pack8(acc[ai][1][m][0] * rs, acc[ai][1][m][1] * rs); }
    }
};

template <bool SSQ> struct EpiGated {
    static constexpr bool PERM = true, AFTER_DRAIN = false;
    bf16_t* Hd; int ldc; int ntile; const float* rs;
    __device__ __forceinline__ void operator()(const f32x4 (&acc)[2][2][4][2], const Unit& u, int wr, int wc, int fr, int fq) const {
        { int t_ = lane_id_(); asm volatile("" : "+v"(t_)); fr = t_ & 15; fq = (t_ >> 4) & 3; }
        const int pnl = ntile ? (u.pn % ntile) : u.pn;
        const int row0 = u.pm * BM + wr * 64 + fr, col0 = pnl * HALF + wc * 32 + 8 * fq;
#pragma unroll
        for (int ai = 0; ai < 2; ++ai)
#pragma unroll
            for (int m = 0; m < 4; ++m) { const int row = row0 + ai * HALF + m * 16; bf16_t* rowp = Hd + (size_t)row * ldc + col0;
                const float r = SSQ ? __builtin_amdgcn_rsqf(part_sum16(rs + (size_t)row * 16) * (1.f / 1024) + EPS_) : rs[row];
                const f32x4 g0 = acc[ai][0][m][0] * r, g1 = acc[ai][0][m][1] * r, u0 = acc[ai][1][m][0] * r, u1 = acc[ai][1][m][1] * r;
                u32x4 w;
                w.x = cvt_pk_bf16(silu_f(g0[0]) * u0[0], silu_f(g0[1]) * u0[1]); w.y = cvt_pk_bf16(silu_f(g0[2]) * u0[2], silu_f(g0[3]) * u0[3]);
                w.z = cvt_pk_bf16(silu_f(g1[0]) * u1[0], silu_f(g1[1]) * u1[1]); w.w = cvt_pk_bf16(silu_f(g1[2]) * u1[2], silu_f(g1[3]) * u1[3]);
                *(u32x4*)rowp = w; }
    }
};

template <bool RS = false, bool SC64 = true> struct EpiGatedF8T {
    static constexpr bool PERM = true, AFTER_DRAIN = false;
    unsigned char* Hd; int ldc; int ntile; const float* rs;
    static __device__ __forceinline__ float gate(float g, float u) {
        if constexpr (SC64) { const float e = __builtin_amdgcn_exp2f(g * (-1.4426950408889634f / 64.f)); return (g * u) * (__builtin_amdgcn_rcpf(1.f + e) * (1.f / 4096.f)); }
        else { const float e = __builtin_amdgcn_exp2f(g * -1.4426950408889634f); return (g * u) * __builtin_amdgcn_rcpf(1.f + e); } }
    __device__ __forceinline__ void operator()(const f32x4 (&acc)[2][2][4][2], const Unit& u, int wr, int wc, int fr, int fq) const {
        { int t_ = lane_id_(); asm volatile("" : "+v"(t_)); fr = t_ & 15; fq = (t_ >> 4) & 3; }
        const int pnl = ntile ? (u.pn % ntile) : u.pn;
        const int row0 = u.pm * BM + wr * 64 + fr, col0 = pnl * HALF + wc * 32 + 8 * fq;
#pragma unroll
        for (int ai = 0; ai < 2; ++ai)
#pragma unroll
            for (int m = 0; m < 4; ++m) { const int row = row0 + ai * HALF + m * 16; unsigned char* rowp = Hd + (size_t)row * ldc + col0;
                f32x4 g0 = acc[ai][0][m][0], g1 = acc[ai][0][m][1], u0 = acc[ai][1][m][0], u1 = acc[ai][1][m][1];
                if constexpr (RS) { const float r = __builtin_amdgcn_rsqf(part_sum16(rs + (size_t)row * 16) * (1.f / 1024) + EPS_); g0 = g0 * r; g1 = g1 * r; u0 = u0 * r; u1 = u1 * r; }
                unsigned long long w = (unsigned long long)pk_fp8x4(gate(g0[0], u0[0]), gate(g0[1], u0[1]), gate(g0[2], u0[2]), gate(g0[3], u0[3]))
                                     | ((unsigned long long)pk_fp8x4(gate(g1[0], u1[0]), gate(g1[1], u1[1]), gate(g1[2], u1[2]), gate(g1[3], u1[3])) << 32);
                *(unsigned long long*)rowp = w; }
    }
};
typedef EpiGatedF8T<false, true> EpiGatedF8;

template <bool SSQ, bool XF8, bool RES16> struct EpiResStream {
    static constexpr bool PERM = true, AFTER_DRAIN = false;
    const void* res; bf16_t* XB; unsigned char* X8; float* ssq; float ascale;
    __device__ __forceinline__ void operator()(const f32x4 (&acc)[2][2][4][2], const Unit& u, int wr, int wc, int fr, int fq) const {
        { int t_ = lane_id_(); asm volatile("" : "+v"(t_)); fr = t_ & 15; fq = (t_ >> 4) & 3; }
        const int row0 = u.pm * BM + wr * 64 + fr, col0 = u.pn * BM + wc * 32 + 8 * fq;
        f32x4 rw[4][2][2];
#define ERS_ROW(it) (row0 + ((it) >> 2) * HALF + ((it) & 3) * 16)
#define ERS_LOAD(it) do { const size_t ro_ = (size_t)ERS_ROW(it) * 1024 + col0; _Pragma("unroll") for (int bj = 0; bj < 2; ++bj) { \
            if constexpr (RES16) rw[(it) & 3][bj][0] = __builtin_bit_cast(f32x4, *(const u32x4*)((const bf16_t*)res + ro_ + bj * HALF)); \
            else { _Pragma("unroll") for (int n = 0; n < 2; ++n) rw[(it) & 3][bj][n] = *(const f32x4*)((const float*)res + ro_ + bj * HALF + n * 4); } } } while (0)
        ERS_LOAD(0); ERS_LOAD(1); ERS_LOAD(2); ERS_LOAD(3);
#pragma unroll
        for (int it = 0; it < 8; ++it) { const int ai = it >> 2, m = it & 3; const int row = ERS_ROW(it); const size_t ro = (size_t)row * 1024 + col0;
                f32x4 r[2][2];
#pragma unroll
                for (int bj = 0; bj < 2; ++bj) {
                    if constexpr (RES16) { const u32x4 w = __builtin_bit_cast(u32x4, rw[it & 3][bj][0]);
                        r[bj][0] = (f32x4){__builtin_bit_cast(float, w.x << 16), __builtin_bit_cast(float, w.x & 0xffff0000u), __builtin_bit_cast(float, w.y << 16), __builtin_bit_cast(float, w.y & 0xffff0000u)};
                        r[bj][1] = (f32x4){__builtin_bit_cast(float, w.z << 16), __builtin_bit_cast(float, w.z & 0xffff0000u), __builtin_bit_cast(float, w.w << 16), __builtin_bit_cast(float, w.w & 0xffff0000u)}; }
                    else { r[bj][0] = rw[it & 3][bj][0]; r[bj][1] = rw[it & 3][bj][1]; }
                    r[bj][0] = r[bj][0] + acc[ai][bj][m][0] * ascale; r[bj][1] = r[bj][1] + acc[ai][bj][m][1] * ascale; }
                if (it + 4 < 8) ERS_LOAD(it + 4);
                *(u32x4*)(XB + ro) = pack8(r[0][0], r[0][1]); *(u32x4*)(XB + ro + HALF) = pack8(r[1][0], r[1][1]);
                if constexpr (XF8) { unsigned char* x8 = X8 + ro;
                    *(unsigned long long*)(x8) = (unsigned long long)pk_fp8x4(r[0][0][0], r[0][0][1], r[0][0][2], r[0][0][3]) | ((unsigned long long)pk_fp8x4(r[0][1][0], r[0][1][1], r[0][1][2], r[0][1][3]) << 32);
                    *(unsigned long long*)(x8 + HALF) = (unsigned long long)pk_fp8x4(r[1][0][0], r[1][0][1], r[1][0][2], r[1][0][3]) | ((unsigned long long)pk_fp8x4(r[1][1][0], r[1][1][1], r[1][1][2], r[1][1][3]) << 32); }
                if (SSQ) { const float t = fq_sum(sq8(r[0][0], r[0][1]) + sq8(r[1][0], r[1][1])); if (fq == 0) ssq[(size_t)row * 16 + u.pn * 4 + wc] = t; } }
#undef ERS_LOAD
#undef ERS_ROW
    }
};

template <bool FIRST> struct EpiMoeDown {
    static constexpr bool PERM = true, AFTER_DRAIN = false;
    float* out; bf16_t* xb; const int* slot_tok; const float* slot_gate; int slot_base; int ldc; float wscale;
    __device__ __forceinline__ void operator()(const f32x4 (&acc)[2][2][4][2], const Unit& u, int wr, int wc, int fr, int fq) const {
        { int t_ = lane_id_(); asm volatile("" : "+v"(t_)); fr = t_ & 15; fq = (t_ >> 4) & 3; }
        const int pnl = u.pn & 3;
        const int row0 = slot_base + u.pm * BM + wr * 64 + fr, col0 = pnl * BM + wc * 32 + 8 * fq;
        int tk[8]; float gt[8];
#pragma unroll
        for (int it = 0; it < 8; ++it) { const int slot = row0 + (it >> 2) * HALF + (it & 3) * 16; tk[it] = slot_tok[slot]; gt[it] = slot_gate[slot] * wscale; }
        u32x4 rq[4][2];
#define EMD_LOAD(it) do { if (tk[it] >= 0) { _Pragma("unroll") for (int bj = 0; bj < 2; ++bj) rq[(it) & 3][bj] = *(const u32x4*)(xb + (size_t)tk[it] * ldc + col0 + bj * HALF); } } while (0)
        EMD_LOAD(0); EMD_LOAD(1); EMD_LOAD(2); EMD_LOAD(3);
#pragma unroll
        for (int it = 0; it < 8; ++it) { const int ai = it >> 2, m = it & 3;
            if (tk[it] >= 0) { const size_t ro = (size_t)tk[it] * ldc + col0;
#pragma unroll
                for (int bj = 0; bj < 2; ++bj) { const u32x4 w = rq[it & 3][bj];
                    f32x4 r0 = (f32x4){__builtin_bit_cast(float, w.x << 16), __builtin_bit_cast(float, w.x & 0xffff0000u), __builtin_bit_cast(float, w.y << 16), __builtin_bit_cast(float, w.y & 0xffff0000u)};
                    f32x4 r1 = (f32x4){__builtin_bit_cast(float, w.z << 16), __builtin_bit_cast(float, w.z & 0xffff0000u), __builtin_bit_cast(float, w.w << 16), __builtin_bit_cast(float, w.w & 0xffff0000u)};
                    r0 = r0 + acc[ai][bj][m][0] * gt[it]; r1 = r1 + acc[ai][bj][m][1] * gt[it];
                    if constexpr (FIRST) *(u32x4*)(xb + ro + bj * HALF) = pack8(r0, r1);
                    else { *(f32x4*)(out + ro + bj * HALF) = r0; *(f32x4*)(out + ro + bj * HALF + 4) = r1; } } }
            if (it + 4 < 8) EMD_LOAD(it + 4); }
#undef EMD_LOAD
    }
};

struct MoeOrder {
    int nM, nN, nwg, G, c; int pb[7];
    int rot;
    int nBusy, SK;
    __device__ void init(int nPanels, int nN_, int G_, int c_) { nM = nPanels; nN = nN_; nwg = nM * nN; G = G_; c = c_; nBusy = 0; SK = 0; rot = 0; }
    __device__ __forceinline__ int expert_of(int pm) const { int e = 0;
#pragma unroll
        for (int k = 0; k < 7; ++k) e += (pm >= pb[k]) ? 1 : 0;
        return e; }
    __device__ bool next(int i, Unit& u) const {
        int L;
        if (nBusy == 0) { int ce = c - rot; if (ce < 0) ce += G; L = i * G + ce; }
        else if (c >= nBusy) L = (i < SK) ? i * (G - nBusy) + (c - nBusy) : SK * (G - nBusy) + (i - SK) * G + c;
        else L = SK * (G - nBusy) + i * G + c;
        if (L >= nwg) return false;
        int wgid = L; { const int q = nwg / NXCD, r = nwg % NXCD, xcd = wgid % NXCD, off = wgid / NXCD; wgid = (xcd < r ? xcd * (q + 1) : r * (q + 1) + (xcd - r) * q) + off; }
        const int nig = WGM * nN, gid = wgid / nig, fm = gid * WGM, gsz = (nM - fm) < WGM ? (nM - fm) : WGM;
        u.pm = fm + ((wgid % nig) % gsz); const int pnl = (wgid % nig) / gsz;
        u.pn = expert_of(u.pm) * nN + pnl; return true;
    }
    __device__ __forceinline__ void a_ready(const Unit&) const {}
    __device__ __forceinline__ void done(const Unit&) const {}
};
struct LeftOrder {
    MoeOrder M; int nLeft, c0, pbase;
    __device__ bool next(int i, Unit& u) const { const int j = M.c - c0; if (i != 0 || j < 0 || j >= nLeft) return false; u.pm = pbase + (j >> 2); u.pn = M.expert_of(u.pm) * 4 + (j & 3); return true; }
    __device__ __forceinline__ void a_ready(const Unit&) const {}
    __device__ __forceinline__ void done(const Unit&) const {}
};
template <class Epi, class Sched, bool ALIGN_EPI = false, bool SP2 = false, bool F8 = false>
__device__ __forceinline__ void gemm_phase(PG8_LAS unsigned char* lds, const Gemm g, const Sched& S, const Epi& E, const int wave_idx) {
    int tid_ = wave_idx * 64 + lane_id_(); asm volatile("" : "+v"(tid_));
    const int tid = tid_, wid = __builtin_amdgcn_readfirstlane(tid >> 6), lane = tid & 63, wr = wid >> 2, wc = wid & 3, fr = lane & 15, fq = lane >> 4;
    const int K = g.K, nt = K / BK;
    unsigned voffA0, voffB0;
    { int R, C; stage_rc(tid * 16, R, C); const int Rb = Epi::PERM ? ((R & ~31) + perm32(R & 31)) : R;
      voffA0 = (unsigned)(R * g.lda + C) * 2u; voffB0 = (unsigned)(Rb * K + C) * 2u; }
    const size_t voffAR = (size_t)64 * g.lda * 2, voffBR = (size_t)64 * K * 2;
    const size_t kstep = (size_t)(BK * 2);
    const size_t hstepA = (size_t)HALF * g.lda * 2, hstepB = (size_t)HALF * K * 2;
    const size_t tstepA = 2 * hstepA, tstepB = 2 * hstepB;
    const unsigned lds0_ = (unsigned)(__UINTPTR_TYPE__)lds;
    const unsigned ldsw = (unsigned)wid * 1024u;
    const int aoff = lds_byte(wr * 64 + fr, fq * 8), boff = lds_byte(wc * 32 + fr, fq * 8);
#define PG8_SA(b, h) (((b) * 2 + (h)) * HTB)
#define PG8_SB(b, h) ((4 + (b) * 2 + (h)) * HTB)
#define PG8_STAGE(bufoff, gbase, voff) do { _Pragma("unroll") for (int _i = 0; _i < 2; ++_i) { unsigned keep_; const char* sb_ = (const char*)(gbase) + (size_t)_i * voff##R; \
        asm volatile("s_mov_b32 %0, m0\n\ts_mov_b32 m0, %3\n\ts_nop 0\n\tglobal_load_lds_dwordx4 %1, %2\n\ts_mov_b32 m0, %0" \
            : "=&s"(keep_) : "v"(voff##0), "s"(sb_), "s"(lds0_ + (unsigned)((bufoff) + _i * 8192) + ldsw) : "memory"); } } while (0)
#define PG8_LDA(dst, b, h) do { _Pragma("unroll") for (int m = 0; m < 4; ++m) _Pragma("unroll") for (int k = 0; k < 2; ++k) dst[m][k] = *(const PG8_LAS bf16x8*)(lds + PG8_SA(b, h) + aoff + m * 2048 + k * 1024); } while (0)
#define PG8_LDB(dst, b, h) do { _Pragma("unroll") for (int n = 0; n < 2; ++n) _Pragma("unroll") for (int k = 0; k < 2; ++k) dst[n][k] = *(const PG8_LAS bf16x8*)(lds + PG8_SB(b, h) + boff + n * 2048 + k * 1024); } while (0)
#define PG8_MMA(ai, bj, At, Bt) do { __builtin_amdgcn_s_setprio(1); _Pragma("unroll") for (int m = 0; m < 4; ++m) _Pragma("unroll") for (int n = 0; n < 2; ++n) { \
        if constexpr (F8) { typedef int v8i_ __attribute__((ext_vector_type(8))); typedef int v4i_ __attribute__((ext_vector_type(4))); \
            const v4i_ b0_ = __builtin_bit_cast(v4i_, Bt[n][0]), b1_ = __builtin_bit_cast(v4i_, Bt[n][1]), a0_ = __builtin_bit_cast(v4i_, At[m][0]), a1_ = __builtin_bit_cast(v4i_, At[m][1]); \
            const v8i_ bb_ = __builtin_shufflevector(b0_, b1_, 0, 1, 2, 3, 4, 5, 6, 7), aa_ = __builtin_shufflevector(a0_, a1_, 0, 1, 2, 3, 4, 5, 6, 7); \
            acc[ai][bj][m][n] = __builtin_amdgcn_mfma_scale_f32_16x16x128_f8f6f4(bb_, aa_, acc[ai][bj][m][n], 0, 0, 0, 0, 0, 0); } \
        else { _Pragma("unroll") for (int k = 0; k < 2; ++k) acc[ai][bj][m][n] = __builtin_amdgcn_mfma_f32_16x16x32_bf16(Bt[n][k], At[m][k], acc[ai][bj][m][n], 0, 0, 0); } } \
        __builtin_amdgcn_s_setprio(0); } while (0)
#define PG8_WAIT_V(n) asm volatile("s_waitcnt vmcnt(" #n ")" ::: "memory")
#define PG8_WAIT_L(n) asm volatile("s_waitcnt lgkmcnt(" #n ")" ::: "memory")
#define PG8_BAR __builtin_amdgcn_s_barrier()
#define PG8_SCHED __builtin_amdgcn_sched_barrier(0)
    Unit cur, nxt; int ui = 0;
    if (!S.next(0, cur)) return;
    f32x4 acc[2][2][4][2];
#pragma unroll
    for (int a = 0; a < 2; ++a)
#pragma unroll
        for (int b = 0; b < 2; ++b)
#pragma unroll
            for (int m = 0; m < 4; ++m)
#pragma unroll
                for (int n = 0; n < 2; ++n) acc[a][b][m][n] = (f32x4){0.f, 0.f, 0.f, 0.f};
    bf16x8 At[4][2], B0[2][2], B1[2][2];
    const char* cA = (const char*)g.A + (size_t)cur.pm * tstepA; const char* cB = (const char*)g.Bt + (size_t)cur.pn * tstepB;
    S.a_ready(cur);
    if constexpr (SP2) {
        PG8_STAGE(PG8_SB(0, 0), cB, voffB); PG8_STAGE(PG8_SB(0, 1), cB + hstepB, voffB); PG8_STAGE(PG8_SA(0, 0), cA, voffA); PG8_STAGE(PG8_SA(0, 1), cA + hstepA, voffA);
        if (wr == 1) PG8_BAR;
        PG8_WAIT_V(2); PG8_BAR;
        PG8_STAGE(PG8_SB(1, 0), cB + kstep, voffB); PG8_STAGE(PG8_SA(1, 0), cA + kstep, voffA); PG8_STAGE(PG8_SB(1, 1), cB + hstepB + kstep, voffB);
        PG8_WAIT_V(6); PG8_BAR;
    } else {
        PG8_STAGE(PG8_SB(0, 0), cB, voffB); PG8_STAGE(PG8_SA(0, 0), cA, voffA); PG8_STAGE(PG8_SB(0, 1), cB + hstepB, voffB); PG8_STAGE(PG8_SA(0, 1), cA + hstepA, voffA);
        if (wr == 1) PG8_BAR;
        PG8_WAIT_V(4); PG8_BAR;
        PG8_STAGE(PG8_SB(1, 0), cB + kstep, voffB); PG8_STAGE(PG8_SA(1, 0), cA + kstep, voffA); PG8_STAGE(PG8_SB(1, 1), cB + hstepB + kstep, voffB);
        PG8_WAIT_V(6); PG8_BAR;
    }
    for (;;) {
        const bool has_next = S.next(ui + 1, nxt);
        const char* nA = has_next ? (const char*)g.A + (size_t)nxt.pm * tstepA : cA; const char* nB = has_next ? (const char*)g.Bt + (size_t)nxt.pn * tstepB : cB;
#pragma unroll 1
        for (int t = 0; t < nt; t += 2) {
            const bool last = (t == nt - 2);
            const char* a1 = cA + (size_t)(t + 1) * kstep;
            const char* a2 = last ? nA : cA + (size_t)(t + 2) * kstep; const char* b2 = last ? nB : cB + (size_t)(t + 2) * kstep;
            const char* a3 = a2 + kstep; const char* b3 = b2 + kstep;
            if (last && has_next) S.a_ready(nxt);
            if constexpr (SP2) {
            PG8_LDB(B0, 0, 0); PG8_LDB(B1, 0, 1); PG8_SCHED; PG8_LDA(At, 0, 0); PG8_STAGE(PG8_SA(1, 1), a1 + hstepA, voffA);
            PG8_WAIT_V(8); PG8_WAIT_L(0); PG8_BAR; PG8_MMA(0, 0, At, B0); PG8_MMA(0, 1, At, B1); PG8_BAR; PG8_SCHED;
            PG8_LDA(At, 0, 1); PG8_STAGE(PG8_SB(0, 0), b2, voffB); PG8_STAGE(PG8_SB(0, 1), b2 + hstepB, voffB); PG8_STAGE(PG8_SA(0, 0), a2, voffA);
            PG8_WAIT_V(8); PG8_WAIT_L(0); PG8_BAR; PG8_MMA(1, 0, At, B0); PG8_MMA(1, 1, At, B1); PG8_BAR; PG8_SCHED;
            PG8_LDB(B0, 1, 0); PG8_LDB(B1, 1, 1); PG8_SCHED; PG8_LDA(At, 1, 0); PG8_STAGE(PG8_SA(0, 1), a2 + hstepA, voffA);
            PG8_WAIT_V(8); PG8_WAIT_L(0); PG8_BAR; PG8_MMA(0, 0, At, B0); PG8_MMA(0, 1, At, B1); PG8_BAR; PG8_SCHED;
            PG8_LDA(At, 1, 1); PG8_STAGE(PG8_SB(1, 0), b3, voffB); PG8_STAGE(PG8_SB(1, 1), b3 + hstepB, voffB); PG8_STAGE(PG8_SA(1, 0), a3, voffA);
            PG8_WAIT_V(8); PG8_WAIT_L(0); PG8_BAR; PG8_MMA(1, 0, At, B0); PG8_MMA(1, 1, At, B1); PG8_BAR; PG8_SCHED;
            } else {
            PG8_LDB(B0, 0, 0); PG8_SCHED; PG8_LDA(At, 0, 0); PG8_STAGE(PG8_SA(1, 1), a1 + hstepA, voffA);
            PG8_WAIT_L(8); PG8_BAR; PG8_WAIT_L(0); PG8_MMA(0, 0, At, B0); PG8_BAR; PG8_SCHED;
            PG8_LDB(B1, 0, 1); PG8_STAGE(PG8_SB(0, 0), b2, voffB);
            PG8_BAR; PG8_WAIT_L(0); PG8_MMA(0, 1, At, B1); PG8_BAR;
            PG8_LDA(At, 0, 1); PG8_STAGE(PG8_SA(0, 0), a2, voffA);
            PG8_BAR; PG8_WAIT_L(0); PG8_MMA(1, 0, At, B0); PG8_BAR; PG8_SCHED;
            PG8_STAGE(PG8_SB(0, 1), b2 + hstepB, voffB);
            PG8_WAIT_V(6); PG8_BAR; PG8_MMA(1, 1, At, B1); PG8_BAR;
            PG8_LDB(B0, 1, 0); PG8_SCHED; PG8_LDA(At, 1, 0); PG8_STAGE(PG8_SA(0, 1), a2 + hstepA, voffA);
            PG8_WAIT_L(8); PG8_BAR; PG8_WAIT_L(0); PG8_MMA(0, 0, At, B0); PG8_BAR; PG8_SCHED;
            PG8_LDB(B1, 1, 1); PG8_STAGE(PG8_SB(1, 0), b3, voffB);
            PG8_BAR; PG8_WAIT_L(0); PG8_MMA(0, 1, At, B1); PG8_BAR;
            PG8_LDA(At, 1, 1); PG8_STAGE(PG8_SA(1, 0), a3, voffA);
            PG8_BAR; PG8_WAIT_L(0); PG8_MMA(1, 0, At, B0); PG8_BAR; PG8_SCHED;
            PG8_STAGE(PG8_SB(1, 1), b3 + hstepB, voffB);
            PG8_WAIT_V(6); PG8_BAR; PG8_MMA(1, 1, At, B1); PG8_BAR;
            }
        }
        if constexpr (ALIGN_EPI) { if (wr == 0) PG8_BAR; }
        if constexpr (!Epi::AFTER_DRAIN) { E(acc, cur, wr, wc, fr, fq); S.done(cur); }
        if (!has_next) break;
#pragma unroll
        for (int a = 0; a < 2; ++a)
#pragma unroll
            for (int b = 0; b < 2; ++b)
#pragma unroll
                for (int m = 0; m < 4; ++m)
#pragma unroll
                    for (int n = 0; n < 2; ++n) acc[a][b][m][n] = (f32x4){0.f, 0.f, 0.f, 0.f};
        cur = nxt; cA = nA; cB = nB; ++ui;
        if constexpr (ALIGN_EPI) { if (wr == 1) PG8_BAR; }
    }
    PG8_WAIT_V(0);
    if constexpr (!ALIGN_EPI) { if (wr == 0) PG8_BAR; }
    PG8_BAR;
    if constexpr (Epi::AFTER_DRAIN) { E.fused(acc, cur, wr, wc, fr, fq, lds, wid, lane); S.done(cur); }
#undef PG8_SA
#undef PG8_SB
#undef PG8_STAGE
#undef PG8_LDA
#undef PG8_LDB
#undef PG8_MMA
#undef PG8_WAIT_V
#undef PG8_WAIT_L
#undef PG8_BAR
#undef PG8_SCHED
}
}
namespace att {
#define ATT_LAS __attribute__((address_space(3)))
typedef unsigned short bf16;
typedef short bf16x8 __attribute__((ext_vector_type(8)));
typedef short s16x4 __attribute__((ext_vector_type(4)));
typedef float f32x16 __attribute__((ext_vector_type(16)));
typedef float f32x4_t __attribute__((ext_vector_type(4)));
typedef unsigned u32x4 __attribute__((ext_vector_type(4)));
typedef unsigned u32x2 __attribute__((ext_vector_type(2)));
typedef float f32x2_t __attribute__((ext_vector_type(2))); typedef __bf16 bf16x2_t __attribute__((ext_vector_type(2)));
__device__ __forceinline__ unsigned cvtpk(float lo, float hi) { f32x2_t v = {lo, hi}; bf16x2_t b = __builtin_convertvector(v, bf16x2_t); return __builtin_bit_cast(unsigned, b); }
__device__ __forceinline__ s16x4 vtr(const ATT_LAS unsigned char* p) { return __builtin_bit_cast(s16x4, __builtin_amdgcn_ds_read_tr16_b64_v4i16((ATT_LAS s16x4*)p)); }
constexpr int VSTR = 192;
template <int DQK> struct Geo { static constexpr int KSTR = DQK * 2 + 16, KBUF = 64 * KSTR, VBUF = 64 * VSTR, CPR = DQK / 8, NKC = 64 * CPR, KIT = (NKC + 511) / 512; };
template <int DQK> constexpr int lds_bytes() { return 3 * Geo<DQK>::KBUF + 3 * Geo<DQK>::VBUF + 2048 + 8192; }

__device__ __forceinline__ float xhalf_sum(float m) { return xor32_sum(m); }
__device__ __forceinline__ float max3f(float a, float b, float c) { float r; asm("v_max3_f32 %0, %1, %2, %3" : "=v"(r) : "v"(a), "v"(b), "v"(c)); return r; }
__device__ __forceinline__ float max2f(float a, float b) { float r; asm("v_max_f32_e32 %0, %1, %2" : "=v"(r) : "v"(a), "v"(b)); return r; }
__device__ __forceinline__ float rowmax32(const f32x16& p0, const f32x16& p1) {
    float a = max2f(p0[0], p1[0]), b = max2f(p0[1], p1[1]), c = max2f(p0[2], p1[2]), d = max2f(p0[3], p1[3]);
#pragma unroll
    for (int r = 4; r < 16; r += 4) { a = max3f(a, p0[r], p1[r]); b = max3f(b, p0[r + 1], p1[r + 1]); c = max3f(c, p0[r + 2], p1[r + 2]); d = max3f(d, p0[r + 3], p1[r + 3]); }
    const float m = max2f(max2f(a, b), max2f(c, d));
    float lo_, hi_; halves32(m, lo_, hi_);
    return max2f(lo_, hi_);
}

template <int DQK, int kpitch, int vpitch, int NS>
__device__ __forceinline__ void attn_init(ATT_LAS unsigned char* lds, const int wave_idx) {
    typedef Geo<DQK> G;
    const int lane = lane_id_(), wid = wave_idx;
    constexpr int KCPL = G::KSTR / 16, KNP = (64 * KCPL + 63) / 64, VCPL = VSTR / 16, VNP = 64 * VCPL / 64, KPP = (KNP + 7) / 8, VPP = (VNP + 7) / 8;
    ATT_LAS unsigned* dmaL = (ATT_LAS unsigned*)(lds + NS * G::KBUF + NS * G::VBUF + 2048) + wid * 256 + lane;
#pragma unroll
    for (int pp = 0; pp < KPP; ++pp) { const int pc = wid + 8 * pp, c = pc * 64 + lane, row = (c / KCPL) & 63, ch = c % KCPL; dmaL[64 * pp] = (unsigned)(row * kpitch + (ch < G::CPR ? ch : 0) * 8) * 2u; }
#pragma unroll
    for (int pp = 0; pp < VPP; ++pp) { const int pc = wid + 8 * pp, c = pc * 64 + lane, row = (c / VCPL) & 63, ch = c % VCPL; dmaL[128 + 64 * pp] = (unsigned)(row * vpitch + (ch < 8 ? ch : 0) * 8) * 2u; }
}

template <int DQK, bool BAND, int qpitch, int kpitch, int vpitch, int opitch, bool OF8 = false, bool NOMAX = false, int NS = 2, int DBG = 0>
__device__ __forceinline__ void attn_unit(ATT_LAS unsigned char* lds, const bf16* Qb, const bf16* Kb, const bf16* Vb, bf16* Ob,
                                          int q0, int t_lo, int t_hi, int my_lo, int my_hi, int cc, const float* bias_g, const float* g_qn, const float* rope, const int wave_idx, const bool load_bias,
                                          bf16x8 (&qf)[DQK / 16], const bool q_loaded, const bool has_next, const bf16* Qn) {
    typedef Geo<DQK> G;
    int tid_ = wave_idx * 64 + lane_id_(); asm volatile("" : "+v"(tid_));
    const int tid = tid_, lane = tid & 63, r32 = lane & 31, hi = lane >> 5, wid = __builtin_amdgcn_readfirstlane(tid >> 6);
    ATT_LAS float* biasL = (ATT_LAS float*)(lds + NS * G::KBUF + NS * G::VBUF);
    constexpr int KCPL = G::KSTR / 16, KNP = (64 * KCPL + 63) / 64;
    constexpr int VCPL = VSTR / 16, VNP = 64 * VCPL / 64;
    constexpr int KPP = (KNP + 7) / 8, VPP = (VNP + 7) / 8;
    ATT_LAS unsigned* dmaL = (ATT_LAS unsigned*)(lds + NS * G::KBUF + NS * G::VBUF + 2048) + wid * 256 + lane;
    const unsigned ldsb = __builtin_amdgcn_readfirstlane((unsigned)(size_t)lds);
    const int kc = (KNP - 1 - wid) / 8 + 1, vc = (VNP - 1 - wid) / 8 + 1;
#define ATT_MOD3(x) (NS == 3 ? (x) - 3 * (((x) * 43) >> 7) : ((x) & 1))
#define ATT_DMA1(gptr, voff_, ldsaddr) do { unsigned keep_; asm volatile("s_mov_b32 %0, m0\n\ts_mov_b32 m0, %3\n\ts_nop 0\n\tglobal_load_lds_dwordx4 %1, %2\n\ts_mov_b32 m0, %0" \
            : "=&s"(keep_) : "v"(voff_), "s"(gptr), "s"(ldsaddr) : "memory"); } while (0)
#define ATT_DMA_K(t) do { const int t_ = (t); const char* kt_ = (const char*)(Kb + (size_t)t_ * 64 * kpitch); const unsigned d_ = ldsb + ATT_MOD3(t_) * G::KBUF + wid * 1024; \
        _Pragma("unroll") for (int pp = 0; pp < KPP; ++pp) { if (wid + 8 * pp < KNP) { const unsigned vo_ = dmaL[64 * pp]; ATT_DMA1(kt_, vo_, d_ + pp * 8192); } } } while (0)
#define ATT_DMA_V(t) do { const int t_ = (t); const char* vt_ = (const char*)(Vb + (size_t)t_ * 64 * vpitch); const unsigned d_ = ldsb + NS * G::KBUF + ATT_MOD3(t_) * G::VBUF + wid * 1024; \
        _Pragma("unroll") for (int pp = 0; pp < VPP; ++pp) { if (wid + 8 * pp < VNP) { const unsigned vo_ = dmaL[128 + 64 * pp]; ATT_DMA1(vt_, vo_, d_ + pp * 8192); } } } while (0)
#define ATT_WAITBAR(n) do { const int n_ = (n); \
        if (n_ == 0) asm volatile("s_waitcnt vmcnt(0) lgkmcnt(0)\n\ts_barrier" ::: "memory"); else if (n_ == 1) asm volatile("s_waitcnt vmcnt(1) lgkmcnt(0)\n\ts_barrier" ::: "memory"); \
        else if (n_ == 2) asm volatile("s_waitcnt vmcnt(2) lgkmcnt(0)\n\ts_barrier" ::: "memory"); else if (n_ == 3) asm volatile("s_waitcnt vmcnt(3) lgkmcnt(0)\n\ts_barrier" ::: "memory"); \
        else if (n_ == 4) asm volatile("s_waitcnt vmcnt(4) lgkmcnt(0)\n\ts_barrier" ::: "memory"); else if (n_ == 5) asm volatile("s_waitcnt vmcnt(5) lgkmcnt(0)\n\ts_barrier" ::: "memory"); \
        else asm volatile("s_waitcnt vmcnt(6) lgkmcnt(0)\n\ts_barrier" ::: "memory"); } while (0)
    ATT_DMA_K(t_lo); ATT_DMA_V(t_lo);
    if (t_lo + 1 <= t_hi) { ATT_DMA_K(t_lo + 1); if (NS == 3) ATT_DMA_V(t_lo + 1); }
    if (NS == 3) { if (t_lo + 2 <= t_hi) ATT_DMA_K(t_lo + 2); }
    if (BAND) { if (load_bias && tid < 257) biasL[tid] = bias_g[tid] * 1.4426950408889634f; }
    if (!q_loaded) { const bf16* qp = Qb + (size_t)(q0 + wid * 32 + r32) * qpitch + 8 * hi;
#pragma unroll
      for (int kk = 0; kk < DQK / 16; ++kk) { if constexpr (DBG & 8) qf[kk] = (bf16x8){(short)lane, 1, 2, 3, 4, 5, 6, 7}; else qf[kk] = *(const bf16x8*)(qp + 16 * kk); } }
    if constexpr (!BAND) {
        float qv[DQK / 16][8]; float ss = 0.f;
#pragma unroll
        for (int kk = 0; kk < DQK / 16; ++kk)
#pragma unroll
            for (int j = 0; j < 8; ++j) { qv[kk][j] = __builtin_bit_cast(float, (unsigned)(unsigned short)qf[kk][j] << 16); ss += qv[kk][j] * qv[kk][j]; }
        ss = xhalf_sum(ss);
        const float rs = __builtin_amdgcn_rsqf(ss * (1.f / DQK) + 1e-6f) * (0.10206207261596577f * 1.4426950408889634f);
#pragma unroll
        for (int kk = 0; kk < DQK / 16; ++kk) { const f32x4_t g0 = *(const f32x4_t*)(g_qn + 16 * kk + 8 * hi), g1 = *(const f32x4_t*)(g_qn + 16 * kk + 8 * hi + 4);
#pragma unroll
            for (int j = 0; j < 4; ++j) { qv[kk][j] *= rs * g0[j]; qv[kk][4 + j] *= rs * g1[j]; } }
        const f32x4_t* rp = (const f32x4_t*)(rope + ((size_t)(q0 + wid * 32 + r32) * 16 + 8 * hi) * 2);
#pragma unroll
        for (int j2 = 0; j2 < 4; ++j2) { const f32x4_t cs = rp[j2];
            { const float x1 = qv[4][2 * j2], x2 = qv[5][2 * j2]; qv[4][2 * j2] = x1 * cs[0] - x2 * cs[1]; qv[5][2 * j2] = x2 * cs[0] + x1 * cs[1]; }
            { const float x1 = qv[4][2 * j2 + 1], x2 = qv[5][2 * j2 + 1]; qv[4][2 * j2 + 1] = x1 * cs[2] - x2 * cs[3]; qv[5][2 * j2 + 1] = x2 * cs[2] + x1 * cs[3]; } }
#pragma unroll
        for (int kk = 0; kk < DQK / 16; ++kk) { u32x4 w; w.x = cvtpk(qv[kk][0], qv[kk][1]); w.y = cvtpk(qv[kk][2], qv[kk][3]); w.z = cvtpk(qv[kk][4], qv[kk][5]); w.w = cvtpk(qv[kk][6], qv[kk][7]);
            qf[kk] = __builtin_bit_cast(bf16x8, w); }
    }
    f32x16 o0, o1;
#pragma unroll
    for (int i = 0; i < 16; ++i) { o0[i] = 0.f; o1[i] = 0.f; }
    float mrun = -INFINITY, lsum = 0.f; float ls4[4] = {0.f, 0.f, 0.f, 0.f};
    const int koff = r32 * G::KSTR + hi * 16;
    const int voff = ((lane >> 5) * 4 + ((lane & 15) >> 2)) * VSTR + (((lane >> 4) & 1) * 16 + (lane & 3) * 4) * 2;
    const f32x16 zero16 = {0.f, 0.f, 0.f, 0.f, 0.f, 0.f, 0.f, 0.f, 0.f, 0.f, 0.f, 0.f, 0.f, 0.f, 0.f, 0.f};
#define ATT_QK(X0, X1, t) do { const ATT_LAS unsigned char* Kt = lds + ATT_MOD3(t) * G::KBUF + koff; \
        _Pragma("unroll") for (int kk = 0; kk < DQK / 16; ++kk) { \
            const bf16x8 a0 = *(const ATT_LAS bf16x8*)(Kt + kk * 32); const bf16x8 a1 = *(const ATT_LAS bf16x8*)(Kt + 32 * G::KSTR + kk * 32); \
            X0 = __builtin_amdgcn_mfma_f32_32x32x16_bf16(a0, qf[kk], kk ? X0 : zero16, 0, 0, 0); X1 = __builtin_amdgcn_mfma_f32_32x32x16_bf16(a1, qf[kk], kk ? X1 : zero16, 0, 0, 0); } } while (0)
#define ATT_FARSCALE() do { const float f_ = __builtin_amdgcn_exp2f(biasL[256]); _Pragma("unroll") for (int i = 0; i < 16; ++i) { o0[i] *= f_; o1[i] *= f_; } \
        ls4[0] *= f_; ls4[1] *= f_; ls4[2] *= f_; ls4[3] *= f_; } while (0)
#define ATT_SMPV(X0, X1, t) do { \
        float cadd = 0.f; \
        if (BAND && !(DBG & 2)) { const int delta = cc - (t); \
            if (delta >= 3) { if constexpr (!NOMAX) cadd = biasL[256]; } \
            else { const ATT_LAS float* bp = biasL + (64 * delta + (32 * (wid & 1) + r32) - 4 * hi + 128 - 63); \
                if (delta < 2) { _Pragma("unroll") for (int i = 0; i < 16; ++i) { const int kj = (i & 3) + 8 * (i >> 2); X0[i] += bp[63 - kj]; X1[i] += bp[31 - kj]; } } \
                else { const int relb = 64 * delta + (32 * (wid & 1) + r32) - 4 * hi + 128; \
                    _Pragma("unroll") for (int i = 0; i < 16; ++i) { const int kj = (i & 3) + 8 * (i >> 2); int i0 = relb - kj, i1 = relb - kj - 32; i0 = i0 > 256 ? 256 : i0; i1 = i1 > 256 ? 256 : i1; \
                        X0[i] += biasL[i0]; X1[i] += biasL[i1]; } } } } \
        if constexpr (NOMAX) { \
            _Pragma("unroll") for (int i = 0; i < 16; ++i) { X0[i] = __builtin_amdgcn_exp2f(X0[i]); X1[i] = __builtin_amdgcn_exp2f(X1[i]); ls4[i & 3] += X0[i] + X1[i]; } \
        } else { \
        const float mt = rowmax32(X0, X1) + cadd; \
        const float mnew = max2f(mrun, mt); \
        const float alpha = __builtin_amdgcn_exp2f(mrun - mnew); \
        const float msub = mnew - cadd; \
        mrun = mnew; \
        float psa[4] = {0.f, 0.f, 0.f, 0.f};   \
        _Pragma("unroll") for (int i = 0; i < 16; ++i) { X0[i] = __builtin_amdgcn_exp2f(X0[i] - msub); X1[i] = __builtin_amdgcn_exp2f(X1[i] - msub); psa[i & 3] += X0[i] + X1[i]; } \
        const float ps = (psa[0] + psa[1]) + (psa[2] + psa[3]); \
        lsum = lsum * alpha + ps; \
        _Pragma("unroll") for (int i = 0; i < 16; ++i) { o0[i] *= alpha; o1[i] *= alpha; } } \
        bf16x8 pf[2][2]; \
        _Pragma("unroll") for (int s = 0; s < 2; ++s) { u32x4 w0, w1; \
            w0.x = cvtpk(X0[8 * s + 0], X0[8 * s + 1]); w0.y = cvtpk(X0[8 * s + 2], X0[8 * s + 3]); w0.z = cvtpk(X0[8 * s + 4], X0[8 * s + 5]); w0.w = cvtpk(X0[8 * s + 6], X0[8 * s + 7]); \
            w1.x = cvtpk(X1[8 * s + 0], X1[8 * s + 1]); w1.y = cvtpk(X1[8 * s + 2], X1[8 * s + 3]); w1.z = cvtpk(X1[8 * s + 4], X1[8 * s + 5]); w1.w = cvtpk(X1[8 * s + 6], X1[8 * s + 7]); \
            pf[0][s] = __builtin_bit_cast(bf16x8, w0); pf[1][s] = __builtin_bit_cast(bf16x8, w1); } \
        const ATT_LAS unsigned char* Vt = lds + NS * G::KBUF + ATT_MOD3(t) * G::VBUF + voff; \
        _Pragma("unroll") for (int kb = 0; kb < 2; ++kb) _Pragma("unroll") for (int s = 0; s < 2; ++s) { \
            const ATT_LAS unsigned char* vp = Vt + (32 * kb + 16 * s) * VSTR; \
            const s16x4 l0 = vtr(vp), h0 = vtr(vp + 8 * VSTR), l1 = vtr(vp + 64), h1 = vtr(vp + 8 * VSTR + 64); \
            const bf16x8 a0 = (bf16x8){l0[0], l0[1], l0[2], l0[3], h0[0], h0[1], h0[2], h0[3]}; \
            const bf16x8 a1 = (bf16x8){l1[0], l1[1], l1[2], l1[3], h1[0], h1[1], h1[2], h1[3]}; \
            o0 = __builtin_amdgcn_mfma_f32_32x32x16_bf16(a0, pf[kb][s], o0, 0, 0, 0); o1 = __builtin_amdgcn_mfma_f32_32x32x16_bf16(a1, pf[kb][s], o1, 0, 0, 0); } \
        if constexpr (NOMAX && BAND) { if (cc - (t) == 3) ATT_FARSCALE(); } } while (0)
#define ATT_FUSED(C0, C1, N0, N1, t, tn) do { \
        bf16x8 kfa[DQK / 16], kfb[DQK / 16]; \
        { const ATT_LAS unsigned char* Kt = lds + ATT_MOD3(tn) * G::KBUF + koff; \
          _Pragma("unroll") for (int kk = 0; kk < DQK / 16; ++kk) { kfa[kk] = *(const ATT_LAS bf16x8*)(Kt + kk * 32); kfb[kk] = *(const ATT_LAS bf16x8*)(Kt + 32 * G::KSTR + kk * 32); } } \
        if constexpr (!NOMAX) __builtin_amdgcn_sched_barrier(0); \
        float cadd = 0.f; \
        if (BAND && !(DBG & 2)) { const int delta = cc - (t); \
            if (delta >= 3) { if constexpr (!NOMAX) cadd = biasL[256]; } \
            else { const ATT_LAS float* bp = biasL + (64 * delta + (32 * (wid & 1) + r32) - 4 * hi + 128 - 63); \
                if (delta < 2) { _Pragma("unroll") for (int i = 0; i < 16; ++i) { const int kj = (i & 3) + 8 * (i >> 2); C0[i] += bp[63 - kj]; C1[i] += bp[31 - kj]; } } \
                else { const int relb = 64 * delta + (32 * (wid & 1) + r32) - 4 * hi + 128; \
                    _Pragma("unroll") for (int i = 0; i < 16; ++i) { const int kj = (i & 3) + 8 * (i >> 2); int i0 = relb - kj, i1 = relb - kj - 32; i0 = i0 > 256 ? 256 : i0; i1 = i1 > 256 ? 256 : i1; \
                        C0[i] += biasL[i0]; C1[i] += biasL[i1]; } } } } \
        float alpha = 1.f, msub = 0.f; \
        if constexpr (!NOMAX) { \
        const float mt = rowmax32(C0, C1) + cadd; \
        const float mnew = max2f(mrun, mt); \
        alpha = __builtin_amdgcn_exp2f(mrun - mnew); \
        msub = mnew - cadd; \
        if (__builtin_amdgcn_ballot_w64(mnew > mrun)) { _Pragma("unroll") for (int i = 0; i < 16; ++i) { o0[i] *= alpha; o1[i] *= alpha; } } \
        mrun = mnew; } \
        if constexpr (!NOMAX || BAND) __builtin_amdgcn_sched_barrier(0); \
        _Pragma("unroll") for (int kk = 0; kk < DQK / 16; ++kk) { \
            N0 = __builtin_amdgcn_mfma_f32_32x32x16_bf16(kfa[kk], qf[kk], kk ? N0 : zero16, 0, 0, 0); N1 = __builtin_amdgcn_mfma_f32_32x32x16_bf16(kfb[kk], qf[kk], kk ? N1 : zero16, 0, 0, 0); } \
        s16x4 vl0[4], vh0[4], vl1[4], vh1[4]; \
        { const ATT_LAS unsigned char* Vt = lds + NS * G::KBUF + ATT_MOD3(t) * G::VBUF + voff; \
          _Pragma("unroll") for (int ks = 0; ks < 4; ++ks) { const ATT_LAS unsigned char* vp = Vt + 16 * ks * VSTR; vl0[ks] = vtr(vp); vh0[ks] = vtr(vp + 8 * VSTR); vl1[ks] = vtr(vp + 64); vh1[ks] = vtr(vp + 8 * VSTR + 64); } } \
        if constexpr (NOMAX) { \
            _Pragma("unroll") for (int i = 0; i < 16; ++i) { C0[i] = __builtin_amdgcn_exp2f(C0[i]); C1[i] = __builtin_amdgcn_exp2f(C1[i]); ls4[i & 3] += C0[i] + C1[i]; } \
        } else { \
        float psa[4] = {0.f, 0.f, 0.f, 0.f}; \
        _Pragma("unroll") for (int i = 0; i < 16; ++i) { C0[i] = __builtin_amdgcn_exp2f(C0[i] - msub); C1[i] = __builtin_amdgcn_exp2f(C1[i] - msub); psa[i & 3] += C0[i] + C1[i]; } \
        const float ps = (psa[0] + psa[1]) + (psa[2] + psa[3]); \
        lsum = lsum * alpha + ps; } \
        bf16x8 pf[4]; \
        _Pragma("unroll") for (int s = 0; s < 2; ++s) { u32x4 w0, w1; \
            w0.x = cvtpk(C0[8 * s + 0], C0[8 * s + 1]); w0.y = cvtpk(C0[8 * s + 2], C0[8 * s + 3]); w0.z = cvtpk(C0[8 * s + 4], C0[8 * s + 5]); w0.w = cvtpk(C0[8 * s + 6], C0[8 * s + 7]); \
            w1.x = cvtpk(C1[8 * s + 0], C1[8 * s + 1]); w1.y = cvtpk(C1[8 * s + 2], C1[8 * s + 3]); w1.z = cvtpk(C1[8 * s + 4], C1[8 * s + 5]); w1.w = cvtpk(C1[8 * s + 6], C1[8 * s + 7]); \
            pf[s] = __builtin_bit_cast(bf16x8, w0); pf[2 + s] = __builtin_bit_cast(bf16x8, w1); } \
        __builtin_amdgcn_sched_barrier(0); \
        _Pragma("unroll") for (int ks = 0; ks < 4; ++ks) { \
            const bf16x8 a0 = (bf16x8){vl0[ks][0], vl0[ks][1], vl0[ks][2], vl0[ks][3], vh0[ks][0], vh0[ks][1], vh0[ks][2], vh0[ks][3]}; \
            const bf16x8 a1 = (bf16x8){vl1[ks][0], vl1[ks][1], vl1[ks][2], vl1[ks][3], vh1[ks][0], vh1[ks][1], vh1[ks][2], vh1[ks][3]}; \
            o0 = __builtin_amdgcn_mfma_f32_32x32x16_bf16(a0, pf[ks], o0, 0, 0, 0); o1 = __builtin_amdgcn_mfma_f32_32x32x16_bf16(a1, pf[ks], o1, 0, 0, 0); } \
        if constexpr (NOMAX && BAND) { if (cc - (t) == 3) ATT_FARSCALE(); } } while (0)
#define ATT_STAGE(t) do { if ((t) + NS <= t_hi) ATT_DMA_K((t) + NS); if ((t) + NS - 1 <= t_hi) ATT_DMA_V((t) + NS - 1); } while (0)
#define ATT_STAGE_T(t) do { ATT_STAGE(t); \
        if ((t) == t_hi && has_next) { const bf16* qp_ = Qn + (size_t)(wid * 32 + r32) * qpitch + 8 * hi; _Pragma("unroll") for (int kk = 0; kk < DQK / 16; ++kk) qf[kk] = *(const bf16x8*)(qp_ + 16 * kk); } } while (0)
#define ATT_NFL(t) ((NS == 3 ? ((t) + 3 <= t_hi ? kc : 0) + ((t) + 2 <= t_hi ? vc : 0) : 0) + (((t) == t_hi && has_next) ? DQK / 16 : 0))
    f32x16 sa0, sa1, sb0, sb1;
    ATT_WAITBAR(0);
    if (my_lo == t_lo) ATT_QK(sa0, sa1, t_lo);
    ATT_WAITBAR(0);
    {
        int t = t_lo;
        for (; t < my_lo - 1; ++t) { ATT_STAGE(t); ATT_WAITBAR(ATT_NFL(t)); }
        if (my_lo > t_lo) { ATT_STAGE(t); ATT_QK(sa0, sa1, t + 1); ATT_WAITBAR(ATT_NFL(t)); ++t; }
        int nf = my_hi - my_lo;
        for (; nf >= 2; nf -= 2, t += 2) {
            ATT_STAGE(t); ATT_FUSED(sa0, sa1, sb0, sb1, t, t + 1); ATT_WAITBAR(ATT_NFL(t));
            ATT_STAGE(t + 1); ATT_FUSED(sb0, sb1, sa0, sa1, t + 1, t + 2); ATT_WAITBAR(ATT_NFL(t + 1));
        }
        if (nf == 1) {
            ATT_STAGE(t); ATT_FUSED(sa0, sa1, sb0, sb1, t, t + 1); ATT_WAITBAR(ATT_NFL(t)); ++t;
            ATT_STAGE_T(t); ATT_SMPV(sb0, sb1, t); ATT_WAITBAR(ATT_NFL(t)); ++t;
        } else {
            ATT_STAGE_T(t); ATT_SMPV(sa0, sa1, t); ATT_WAITBAR(ATT_NFL(t)); ++t;
        }
        for (; t <= t_hi; ++t) { ATT_STAGE_T(t); ATT_WAITBAR(ATT_NFL(t)); }
    }
    if constexpr (NOMAX) lsum = (ls4[0] + ls4[1]) + (ls4[2] + ls4[3]);
    const float ltot = xhalf_sum(lsum);
    const float inv = 1.f / ltot;
    if constexpr (DBG & 4) { if (ltot == 12345.678f) *(float*)Ob = o0[0] + o1[0]; } else
    if constexpr (OF8) {
        const float i64 = inv * 32.f;
        int w0[4], w1[4];
#pragma unroll
        for (int g4 = 0; g4 < 4; ++g4) { w0[g4] = 0; w1[g4] = 0;
            w0[g4] = __builtin_amdgcn_cvt_pk_fp8_f32(o0[4 * g4 + 0] * i64, o0[4 * g4 + 1] * i64, w0[g4], false); w0[g4] = __builtin_amdgcn_cvt_pk_fp8_f32(o0[4 * g4 + 2] * i64, o0[4 * g4 + 3] * i64, w0[g4], true);
            w1[g4] = __builtin_amdgcn_cvt_pk_fp8_f32(o1[4 * g4 + 0] * i64, o1[4 * g4 + 1] * i64, w1[g4], false); w1[g4] = __builtin_amdgcn_cvt_pk_fp8_f32(o1[4 * g4 + 2] * i64, o1[4 * g4 + 3] * i64, w1[g4], true); }
        asm volatile("s_nop 1\n\tv_permlane32_swap_b32 %0, %1\n\tv_permlane32_swap_b32 %2, %3\n\tv_permlane32_swap_b32 %4, %5\n\tv_permlane32_swap_b32 %6, %7\n\ts_nop 1"
                     : "+v"(w0[2]), "+v"(w0[0]), "+v"(w0[3]), "+v"(w0[1]), "+v"(w1[2]), "+v"(w1[0]), "+v"(w1[3]), "+v"(w1[1]));
        unsigned char* op = (unsigned char*)Ob + (size_t)(q0 + wid * 32 + r32) * opitch + (hi ? 0 : 16);
        *(u32x4*)op = (u32x4){(unsigned)w0[2], (unsigned)w0[0], (unsigned)w0[3], (unsigned)w0[1]};
        *(u32x4*)(op + 32) = (u32x4){(unsigned)w1[2], (unsigned)w1[0], (unsigned)w1[3], (unsigned)w1[1]};
    } else {
    bf16* op = Ob + (size_t)(q0 + wid * 32 + r32) * opitch + 4 * hi;
#pragma unroll
    for (int g4 = 0; g4 < 4; ++g4) {
        u32x2 w0, w1;
        w0.x = cvtpk(o0[4 * g4 + 0] * inv, o0[4 * g4 + 1] * inv); w0.y = cvtpk(o0[4 * g4 + 2] * inv, o0[4 * g4 + 3] * inv);
        w1.x = cvtpk(o1[4 * g4 + 0] * inv, o1[4 * g4 + 1] * inv); w1.y = cvtpk(o1[4 * g4 + 2] * inv, o1[4 * g4 + 3] * inv);
        *(u32x2*)(op + 8 * g4) = w0; *(u32x2*)(op + 32 + 8 * g4) = w1;
    }
    }
#undef ATT_DMA_K
#undef ATT_DMA_V
#undef ATT_QK
#undef ATT_SMPV
#undef ATT_STAGE
#undef ATT_STAGE_T
#undef ATT_FUSED
#undef ATT_MOD3
#undef ATT_DMA1
#undef ATT_WAITBAR
#undef ATT_NFL
#undef ATT_FARSCALE
}
}
constexpr int NWAVES = 8;
constexpr int D = 1024, BATCH = 32, SEQ = 2048, M = BATCH * SEQ;
constexpr int NH = 16, QLORA = 384, KVLORA = 256, ROPE_D = 32, NOPE = 64, QKD = 96;
constexpr int NA = 768;
constexpr int FF = 2816, EFF = 3584, NE = 8;
constexpr float EPS = 1e-6f, LOG2E = 1.4426950408889634f;
constexpr int MAXP_HALF = 264, MAXP = 528;
constexpr size_t MiB = 1u << 20;
constexpr size_t WS_CTL = 0, CTL_ZERO_BYTES = 1 * MiB;
constexpr size_t WS_ROPE = 1 * MiB;
constexpr size_t WS_CNT = WS_ROPE + 256 * 1024;
constexpr size_t WS_PANELE = WS_CNT + 16 * 1024;
constexpr size_t WS_META = WS_PANELE + 4096;
constexpr size_t WS_TOKE = 2 * MiB;
constexpr size_t WS_TOKG = WS_TOKE + (size_t)M * 4;
constexpr size_t WS_SLOTTOK = WS_TOKG + (size_t)M * 8;
constexpr size_t WS_SLOTGATE = WS_SLOTTOK + (size_t)MAXP * 256 * 4;
constexpr size_t WS_PARTQA = 976 * MiB, WS_PART1 = 980 * MiB, WS_PART2 = 984 * MiB;
constexpr size_t WS_TOKRSTD = 4 * MiB;
constexpr size_t WS_SLOTRSTD = WS_TOKRSTD + (size_t)M * 4;
static_assert(WS_SLOTGATE + (size_t)MAXP * 256 * 4 <= WS_TOKRSTD && WS_SLOTRSTD + (size_t)MAXP * 256 * 4 <= 8 * MiB, "small arrays");
constexpr size_t WS_W = 8 * MiB;
constexpr size_t WS_WA = WS_W, WS_WUQ = WS_WA + (size_t)NA * D * 2, WS_WUKV = WS_WUQ + (size_t)1536 * QLORA * 2, WS_WO = WS_WUKV + (size_t)2048 * KVLORA * 2;
constexpr size_t WS_WF1 = WS_WO + (size_t)D * D * 2, WS_WF2 = WS_WF1 + (size_t)2 * FF * D * 2, WS_WKVQ = WS_WF2 + (size_t)D * FF * 2, WS_WBO = WS_WKVQ + (size_t)3 * D * D * 2;
constexpr size_t WS_WM1 = WS_WBO + (size_t)D * D * 2, WS_WM2 = WS_WM1 + (size_t)NE * 2 * EFF * D * 2, WS_WEND = WS_WM2 + (size_t)NE * D * EFF * 2;
constexpr size_t ARENA = 208 * MiB;
static_assert(WS_WEND <= ARENA, "weights fit under the arena");
constexpr size_t WS_XN = ARENA;
constexpr size_t WS_QA = ARENA + 128 * MiB;
constexpr size_t WS_Q = ARENA + 224 * MiB;
constexpr size_t WS_K = ARENA + 416 * MiB;
constexpr size_t WS_V = ARENA + 608 * MiB;
constexpr size_t WS_O = ARENA;
static_assert(WS_V + (size_t)M * D * 2 <= 1024 * MiB, "MLA arena");
constexpr size_t WS_XR1 = ARENA + 128 * MiB;
constexpr size_t WS_H = ARENA + 256 * MiB;
constexpr size_t WS_XR2 = ARENA;
constexpr size_t WS_X2B = ARENA + 608 * MiB;
constexpr size_t WS_KVQ2 = ARENA + 128 * MiB;
constexpr size_t WS_O2 = ARENA + 512 * MiB;
constexpr size_t WS_XR3 = ARENA + 132 * MiB;
constexpr size_t WS_XG = ARENA;
constexpr size_t WS_HM = ARENA + 264 * MiB;
constexpr size_t WS_END = WS_HM + (size_t)MAXP_HALF * 256 * EFF * 2;
static_assert(WS_XG + (size_t)MAXP * 256 * D <= WS_XR3 && WS_XR3 + (size_t)M * D * 2 <= WS_HM && WS_END <= 1024 * MiB && WS_H + (size_t)M * FF * 2 <= WS_X2B && WS_X2B + (size_t)M * D * 2 <= 976 * MiB && WS_O2 + (size_t)M * D <= WS_X2B, "arena");
constexpr int CW_BAR = 4096;
constexpr int RING_OFF = 0, RING_BYTES = 131072;
constexpr int P0_SCR = 128 * 33 * 4;
constexpr int LDSCTL_OFF = 8 * P0_SCR, MISC_OFF = LDSCTL_OFF + 320;
static_assert(LDSCTL_OFF >= RING_BYTES, "control words above every phase's scratch");
constexpr int LDS_BYTES = 147456;
static_assert(MISC_OFF + 128 <= LDS_BYTES, "LDS map");
static_assert(att::lds_bytes<96>() <= RING_BYTES, "attention scratch fits the ring region");

#define GAS __attribute__((address_space(1)))
#define LAS __attribute__((address_space(3)))
typedef unsigned short bf16;
typedef unsigned v4u __attribute__((ext_vector_type(4)));
typedef unsigned v2u __attribute__((ext_vector_type(2)));
typedef float f32x4 __attribute__((ext_vector_type(4)));
typedef GAS unsigned gu32;
#define RLX_AGENT __ATOMIC_RELAXED, __HIP_MEMORY_SCOPE_AGENT
#define LDS_WAIT() asm volatile("s_waitcnt lgkmcnt(0)" ::: "memory")
__device__ __forceinline__ unsigned f2bf(float f) { unsigned u = __builtin_bit_cast(unsigned, f); return (u + 0x7fffu + ((u >> 16) & 1u)) >> 16; }
__device__ __forceinline__ unsigned pk2(float lo, float hi) { return f2bf(lo) | (f2bf(hi) << 16); }
__device__ __forceinline__ float bflo(unsigned u) { return __builtin_bit_cast(float, u << 16); }
__device__ __forceinline__ float bfhi(unsigned u) { return __builtin_bit_cast(float, u & 0xffff0000u); }
__device__ __forceinline__ float wave_sum(float v) {
    v += swz_xor<1>(v); v += swz_xor<2>(v); v += swz_xor<4>(v); v += swz_xor<8>(v); v += swz_xor<16>(v);
    return xor32_sum(v);
}
__device__ __forceinline__ float wave_maxf(float v) {
    v = fmaxf(v, swz_xor<1>(v)); v = fmaxf(v, swz_xor<2>(v)); v = fmaxf(v, swz_xor<4>(v)); v = fmaxf(v, swz_xor<8>(v)); v = fmaxf(v, swz_xor<16>(v));
    return xor32_max(v);
}

#define XB_TMO      128
#define XB_XCNT(j)  (256  + 64 * (j))
#define XB_XSUB(j)  (1280 + 64 * (j))
#define XB_XGEN(j)  (2304 + 64 * (j))
#define XB_TOP      3328
#define XB_TOPGEN   3392
#define XCD_BAR_WORDS 3456
#define XB_SPIN_CAP (1u << 18)

__device__ __forceinline__ unsigned xb_ld(unsigned* p)              { return __hip_atomic_load(p, __ATOMIC_RELAXED, __HIP_MEMORY_SCOPE_AGENT); }
__device__ __forceinline__ unsigned xb_add(unsigned* p, unsigned v) { return __hip_atomic_fetch_add(p, v, __ATOMIC_RELAXED, __HIP_MEMORY_SCOPE_AGENT); }
__device__ __forceinline__ unsigned xb_xcc_id() { return (unsigned)__builtin_amdgcn_s_getreg((3 << 11) | 20) & 0xFu; }
#define XB_SPIN(cond, bar) do { unsigned _sp = 0; while (cond) { __builtin_amdgcn_s_sleep(1); \
    if ((++_sp & 255u) == 0u) { if (xb_ld(&(bar)[XB_TMO])) break; if (_sp > XB_SPIN_CAP) { atomicAdd(&(bar)[XB_TMO], 1u); break; } } } } while (0)

struct XcdBarrier {
    int t0;
    unsigned* bar; unsigned x;
    volatile LAS unsigned* st;
};

__device__ __forceinline__ XcdBarrier xcd_barrier_post(unsigned* bar, volatile LAS unsigned* st, int t0) {
    XcdBarrier b; b.t0 = t0; b.bar = bar; b.x = xb_xcc_id(); b.st = st;
    if (b.t0) (void)xb_add(&bar[XB_XCNT(b.x)], 1u);
    return b;
}
__device__ __forceinline__ void xcd_barrier_complete(unsigned* bar, unsigned x, unsigned& nloc, unsigned& nx) {
    const unsigned G = gridDim.x * gridDim.y * gridDim.z;
    unsigned sum, cnt, mine, sp = 0u;
    for (;;) {
        sum = 0u; cnt = 0u; mine = 0u;
#pragma unroll
        for (unsigned j = 0; j < 16; ++j) { const unsigned c = xb_ld(&bar[XB_XCNT(j)]); sum += c; cnt += (c > 0u) ? 1u : 0u; mine = (j == x) ? c : mine; }
        if (sum == G) break;
        __builtin_amdgcn_s_sleep(1);
        if ((++sp & 255u) == 0u) { if (xb_ld(&bar[XB_TMO])) break; if (sp > XB_SPIN_CAP) { atomicAdd(&bar[XB_TMO], 1u); break; } }
    }
    nloc = mine > 0u ? mine : 1u; nx = cnt > 0u ? cnt : 1u;
}

__device__ __forceinline__ void xcd_barrier(const XcdBarrier& b) {
    asm volatile("s_waitcnt vmcnt(0)" ::: "memory");
    __syncthreads();
    if (b.t0) {
        unsigned* bar = b.bar;
        __builtin_amdgcn_s_waitcnt(0);
        unsigned nloc = b.st[0], nx = b.st[1];
        if (nloc == 0u) { xcd_barrier_complete(bar, b.x, nloc, nx); b.st[0] = nloc; b.st[1] = nx; }
        const unsigned old = xb_add(&bar[XB_XSUB(b.x)], 1u);
        const unsigned gen = old / nloc;
        if (old + 1u == (gen + 1u) * nloc) {
            __builtin_amdgcn_fence(__ATOMIC_RELEASE, "agent");
            asm volatile("s_waitcnt vmcnt(0)" ::: "memory");
            const unsigned og = xb_add(&bar[XB_TOP], 1u);
            const unsigned tg = og / nx;
            if (og + 1u == (tg + 1u) * nx) xb_add(&bar[XB_TOPGEN], 1u);
            else XB_SPIN(xb_ld(&bar[XB_TOPGEN]) == tg, bar);
            __builtin_amdgcn_fence(__ATOMIC_ACQUIRE, "agent");
            xb_add(&bar[XB_XGEN(b.x)], 1u);
            asm volatile("s_waitcnt vmcnt(0)" ::: "memory");
        } else {
            XB_SPIN(xb_ld(&bar[XB_XGEN(b.x)]) == gen, bar);
            __builtin_amdgcn_fence(__ATOMIC_ACQUIRE, "agent");
            asm volatile("s_waitcnt vmcnt(0)" ::: "memory");
        }
    }
    __syncthreads();
}

struct Args { const float* in[27]; float* out; unsigned char* ws; };
enum { I_X = 0, I_ATTN_NORM, I_FFN_NORM, I_A_WDQ, I_A_GCQ, I_A_WUQ, I_A_WDKV, I_A_GCKV, I_A_WUKV, I_A_GQN, I_A_GKN, I_A_WO, I_KV_NORM, I_KV_WK, I_KV_WV, I_KV_GKN,
       I_B_WQ, I_B_GQN, I_B_RELB, I_B_WO, I_FFN_W1, I_FFN_W3, I_FFN_W2, I_MOE_ROUTER, I_MOE_W1, I_MOE_W3, I_MOE_W2 };

struct Frame {
    LAS unsigned char* lds;
    int wave, vcu, G;
};
typedef const __attribute__((address_space(4))) Args* KArgs;
__device__ __forceinline__ KArgs kargs() { KArgs p = (KArgs)__builtin_amdgcn_kernarg_segment_ptr(); asm volatile("" : "+s"(p)); return p; }
#define INP(i) (kargs()->in[i])
#define OUTP (kargs()->out)
#define WSP (kargs()->ws)
__device__ __forceinline__ int fresh(int v) { asm volatile("" : "+v"(v)); return v; }

__device__ __forceinline__ void tr_item(const float* W, int ldw, int K, int k0, int nsrc0, const float* gain, bf16* WT, int drow0, LAS float* scr, int lane) {
    const int c4 = lane & 7, r = lane >> 3;
    const GAS float* src = (const GAS float*)W + (size_t)(k0 + r) * ldw + nsrc0 + 4 * c4;
    f32x4 v[16];
#pragma unroll
    for (int i = 0; i < 16; ++i) v[i] = *(const GAS f32x4*)(src + (size_t)(8 * i) * ldw);
    if (gain) {
#pragma unroll
        for (int i = 0; i < 16; ++i) v[i] = v[i] * gain[k0 + 8 * i + r];
    }
#pragma unroll
    for (int i = 0; i < 16; ++i) { LAS float* d = scr + (8 * i + r) * 33 + 4 * c4; d[0] = v[i].x; d[1] = v[i].y; d[2] = v[i].z; d[3] = v[i].w; }
    LDS_WAIT(); asm volatile("" ::: "memory");
    const int c16 = lane >> 2;
#pragma unroll
    for (int j = 0; j < 8; ++j) { const int n = (lane & 3) + 4 * j; const LAS float* sp = scr + (8 * c16) * 33 + n;
        v4u o; o.x = pk2(sp[0 * 33], sp[1 * 33]); o.y = pk2(sp[2 * 33], sp[3 * 33]); o.z = pk2(sp[4 * 33], sp[5 * 33]); o.w = pk2(sp[6 * 33], sp[7 * 33]);
        *(GAS v4u*)(WT + (size_t)(drow0 + n) * K + k0 + 8 * c16) = o; }
    LDS_WAIT(); asm volatile("" ::: "memory");
}
__device__ __forceinline__ void tr_plain(const float* W, int K, int N, const float* gain, bf16* WT, int drow_off, LAS float* scr, int item, int lane) {
    const int nblk = N / 32, kb = item / nblk, nb = item % nblk;
    tr_item(W, N, K, 128 * kb, 32 * nb, gain, WT, drow_off + 32 * nb, scr, lane);
}
__device__ __forceinline__ void tr_gated(const float* W, int K, int N, const float* gain, bf16* WT, int half, LAS float* scr, int item, int lane) {
    const int nblk = N / 32, kb = item / nblk, nb = item % nblk, n0 = 32 * nb;
    tr_item(W, N, K, 128 * kb, n0, gain, WT, (n0 >> 7) * 256 + half * 128 + (n0 & 127), scr, lane);
}
__device__ __forceinline__ unsigned pk_fp8x4(float a, float b, float c, float d) { int w = 0; w = __builtin_amdgcn_cvt_pk_fp8_f32(a, b, w, false); w = __builtin_amdgcn_cvt_pk_fp8_f32(c, d, w, true); return (unsigned)w; }
__device__ __forceinline__ void tr_item_f8(const float* W, int ldw, int K, int k0, int nsrc0, const float* gain, unsigned char* WT, int drow0, LAS float* scr, int lane) {
    const int c4 = lane & 7, r = lane >> 3;
    const GAS float* src = (const GAS float*)W + (size_t)(k0 + r) * ldw + nsrc0 + 4 * c4;
    f32x4 v[16];
#pragma unroll
    for (int i = 0; i < 16; ++i) v[i] = *(const GAS f32x4*)(src + (size_t)(8 * i) * ldw);
#pragma unroll
    for (int i = 0; i < 16; ++i) v[i] = v[i] * (gain ? gain[k0 + 8 * i + r] * 64.f : 64.f);
#pragma unroll
    for (int i = 0; i < 16; ++i) { LAS float* d = scr + (8 * i + r) * 33 + 4 * c4; d[0] = v[i].x; d[1] = v[i].y; d[2] = v[i].z; d[3] = v[i].w; }
    LDS_WAIT(); asm volatile("" ::: "memory");
    const int c8 = lane >> 3;
#pragma unroll
    for (int j = 0; j < 4; ++j) { const int n = (lane & 7) + 8 * j; const LAS float* sp = scr + (16 * c8) * 33 + n;
        v4u o; o.x = pk_fp8x4(sp[0 * 33], sp[1 * 33], sp[2 * 33], sp[3 * 33]); o.y = pk_fp8x4(sp[4 * 33], sp[5 * 33], sp[6 * 33], sp[7 * 33]);
        o.z = pk_fp8x4(sp[8 * 33], sp[9 * 33], sp[10 * 33], sp[11 * 33]); o.w = pk_fp8x4(sp[12 * 33], sp[13 * 33], sp[14 * 33], sp[15 * 33]);
        *(GAS v4u*)(WT + (size_t)(drow0 + n) * K + k0 + 16 * c8) = o; }
    LDS_WAIT(); asm volatile("" ::: "memory");
}
__device__ __forceinline__ float rms_row_to_bf16(const float* xrow, bf16* orow, int lane, f32x4 (&v)[4]) {
    const GAS f32x4* xr = (const GAS f32x4*)xrow + lane;
    float s = 0.f;
#pragma unroll
    for (int j = 0; j < 4; ++j) { v[j] = xr[64 * j]; s += (v[j].x * v[j].x + v[j].y * v[j].y) + (v[j].z * v[j].z + v[j].w * v[j].w); }
    const float rstd = 1.f / sqrtf(wave_sum(s) * (1.f / D) + EPS);
    GAS unsigned long long* o8 = (GAS unsigned long long*)orow + lane;
#pragma unroll
    for (int j = 0; j < 4; ++j) o8[64 * j] = (unsigned long long)pk2(v[j].x * rstd, v[j].y * rstd) | ((unsigned long long)pk2(v[j].z * rstd, v[j].w * rstd) << 32);
    return rstd;
}
__device__ __forceinline__ void norm_phase(const Frame& F, const float* x, bf16* xn) {
    const int tid = fresh(F.wave * 64 + lane_id_()), lane = tid & 63; (void)lane;
    const int gw = F.vcu * NWAVES + F.wave, NGW = F.G * NWAVES;
    for (int m = 2 * gw; m < M; m += 2 * NGW) {
        const GAS f32x4* xr = (const GAS f32x4*)(x + (size_t)m * D) + lane;
        f32x4 v[8]; float s0 = 0.f, s1 = 0.f;
#pragma unroll
        for (int j = 0; j < 8; ++j) v[j] = xr[64 * j];
#pragma unroll
        for (int j = 0; j < 4; ++j) { s0 += (v[j].x * v[j].x + v[j].y * v[j].y) + (v[j].z * v[j].z + v[j].w * v[j].w); s1 += (v[4 + j].x * v[4 + j].x + v[4 + j].y * v[4 + j].y) + (v[4 + j].z * v[4 + j].z + v[4 + j].w * v[4 + j].w); }
        const float r0 = 1.f / sqrtf(wave_sum(s0) * (1.f / D) + EPS), r1 = 1.f / sqrtf(wave_sum(s1) * (1.f / D) + EPS);
        GAS unsigned* o4 = (GAS unsigned*)((GAS unsigned char*)xn + (size_t)m * D) + lane;
#pragma unroll
        for (int j = 0; j < 8; ++j) { const float rr = j < 4 ? r0 : r1; o4[64 * j] = pk_fp8x4(v[j].x * rr, v[j].y * rr, v[j].z * rr, v[j].w * rr); }
    }
}

__device__ __forceinline__ void p0_prologue(const Frame& F) {
    const int tid = fresh(F.wave * 64 + lane_id_()), lane = tid & 63; (void)lane;
    LAS float* scr = (LAS float*)(F.lds + RING_OFF + F.wave * P0_SCR);
    unsigned char* ws = WSP;
    const int gw = F.vcu * NWAVES + F.wave, NGW = F.G * NWAVES;
    constexpr int I_DQ = 8 * 12, I_DKV = 8 * 9, I_UQ = 3 * 48, I_UKV = 2 * 64, I_SQ = 8 * 32, I_F13 = 8 * 88, I_F2 = 22 * 32, I_M13 = 8 * 112, I_M2 = 28 * 32;
    constexpr int NSMALL = I_DQ + I_DKV + I_UQ + I_UKV + I_SQ + 2 * I_F13 + I_F2 + 4 * I_SQ;
    constexpr int NITEMS = NSMALL + NE * (2 * I_M13 + I_M2);
    for (int it = gw; it < NITEMS; it += NGW) {
        int r = it;
        if (r < I_DQ)  { const int kb = r / 12, n0 = 32 * (r % 12); tr_item_f8(INP(I_A_WDQ), QLORA, D, 128 * kb, n0, INP(I_ATTN_NORM), ws + WS_WA, n0, scr, lane); continue; } r -= I_DQ;
        if (r < I_DKV) { const int kb = r / 9, n0 = 32 * (r % 9); tr_item_f8(INP(I_A_WDKV), KVLORA + ROPE_D, D, 128 * kb, n0, INP(I_ATTN_NORM), ws + WS_WA, QLORA + n0, scr, lane); continue; } r -= I_DKV;
        if (r < I_UQ)  { tr_plain(INP(I_A_WUQ), QLORA, NH * QKD, INP(I_A_GCQ), (bf16*)(ws + WS_WUQ), 0, scr, r, lane); continue; } r -= I_UQ;
        if (r < I_UKV) { const int kb = r / 64, n0 = 32 * (r % 64), head = n0 >> 7, within = n0 & 127;
            const int drow = within < 64 ? 256 * (head >> 2) + 128 * (within >> 5) + 32 * (head & 3) : 1024 + head * 64 + (within - 64);
            tr_item(INP(I_A_WUKV), NH * 128, KVLORA, 128 * kb, n0, INP(I_A_GCKV), (bf16*)(ws + WS_WUKV), drow, scr, lane); continue; } r -= I_UKV;
        if (r < I_SQ)  { const int kb = r / 32, n0 = 32 * (r % 32); tr_item_f8(INP(I_A_WO), D, D, 128 * kb, n0, nullptr, ws + WS_WO, n0, scr, lane); continue; } r -= I_SQ;
        if (r < I_F13) { tr_gated(INP(I_FFN_W1), D, FF, INP(I_FFN_NORM), (bf16*)(ws + WS_WF1), 0, scr, r, lane); continue; } r -= I_F13;
        if (r < I_F13) { tr_gated(INP(I_FFN_W3), D, FF, INP(I_FFN_NORM), (bf16*)(ws + WS_WF1), 1, scr, r, lane); continue; } r -= I_F13;
        if (r < I_F2)  { const int kb = r / 32, n0 = 32 * (r % 32); tr_item_f8(INP(I_FFN_W2), D, FF, 128 * kb, n0, nullptr, ws + WS_WF2, n0, scr, lane); continue; } r -= I_F2;
        if (r < I_SQ)  { const int kb = r / 32, n0 = 32 * (r % 32), head = n0 >> 6;
            tr_item_f8(INP(I_KV_WK), D, D, 128 * kb, n0, INP(I_KV_NORM), ws + WS_WKVQ, 256 * (head >> 2) + 128 * ((n0 >> 5) & 1) + 32 * (head & 3), scr, lane); continue; } r -= I_SQ;
        if (r < I_SQ)  { const int kb = r / 32, n0 = 32 * (r % 32); tr_item_f8(INP(I_KV_WV), D, D, 128 * kb, n0, INP(I_KV_NORM), ws + WS_WKVQ, 2 * D + n0, scr, lane); continue; } r -= I_SQ;
        if (r < I_SQ)  { const int kb = r / 32, n0 = 32 * (r % 32), head = n0 >> 6;
            tr_item_f8(INP(I_B_WQ), D, D, 128 * kb, n0, INP(I_ATTN_NORM) + D, ws + WS_WKVQ, D + 256 * (head >> 2) + 128 * ((n0 >> 5) & 1) + 32 * (head & 3), scr, lane); continue; } r -= I_SQ;
        if (r < I_SQ)  { const int kb = r / 32, n0 = 32 * (r % 32); tr_item_f8(INP(I_B_WO), D, D, 128 * kb, n0, nullptr, ws + WS_WBO, n0, scr, lane); continue; } r -= I_SQ;
        const int e = r / (2 * I_M13 + I_M2); r -= e * (2 * I_M13 + I_M2);
        if (r < I_M13) { const int kb = r / 112, n0 = 32 * (r % 112);
            tr_item_f8(INP(I_MOE_W1) + (size_t)e * D * EFF, EFF, D, 128 * kb, n0, INP(I_FFN_NORM) + D, ws + WS_WM1 + (size_t)e * 2 * EFF * D, (n0 >> 7) * 256 + (n0 & 127), scr, lane); continue; } r -= I_M13;
        if (r < I_M13) { const int kb = r / 112, n0 = 32 * (r % 112);
            tr_item_f8(INP(I_MOE_W3) + (size_t)e * D * EFF, EFF, D, 128 * kb, n0, INP(I_FFN_NORM) + D, ws + WS_WM1 + (size_t)e * 2 * EFF * D, (n0 >> 7) * 256 + 128 + (n0 & 127), scr, lane); continue; } r -= I_M13;
        { const int kb = r / 32, n0 = 32 * (r % 32); tr_item_f8(INP(I_MOE_W2) + (size_t)e * EFF * D, D, EFF, 128 * kb, n0, nullptr, ws + WS_WM2 + (size_t)e * D * EFF, n0, scr, lane); }
    }
    const int gt = F.vcu * (NWAVES * 64) + tid, NGT = F.G * NWAVES * 64;
    for (int c = gt; c < 96 * D / 16; c += NGT) *((GAS v4u*)(ws + WS_WA + (size_t)(QLORA + KVLORA + ROPE_D) * D) + c) = (v4u){0u, 0u, 0u, 0u};
    for (int c = gt; c < SEQ * 16; c += NGT) { const int pos = c >> 4, i = c & 15;
        const float inv = __builtin_amdgcn_exp2f(-(float)i * (13.287712379549449f / 16.f));
        const float rev = (float)pos * inv * 0.15915494309189535f; const float fr = rev - floorf(rev);
        ((GAS float*)(ws + WS_ROPE))[2 * c] = __builtin_amdgcn_cosf(fr); ((GAS float*)(ws + WS_ROPE))[2 * c + 1] = __builtin_amdgcn_sinf(fr); }
    norm_phase(F, INP(I_X), (bf16*)(ws + WS_XN));
}

__device__ __forceinline__ void route_phase(const Frame& F) {
    const int tid = fresh(F.wave * 64 + lane_id_()), lane = tid & 63;
    unsigned char* ws = WSP;
    LAS float* wrg = (LAS float*)(F.lds + RING_OFF);
    LAS int* cnt = (LAS int*)(F.lds + RING_OFF + 32768);
    const float* wr = INP(I_MOE_ROUTER); const float* g = INP(I_FFN_NORM) + D;
    { float wv[16], gv[16];
#pragma unroll
      for (int it = 0; it < 16; ++it) { const int idx = tid + it * NWAVES * 64; wv[it] = wr[idx]; gv[it] = g[idx >> 3]; }
#pragma unroll
      for (int it = 0; it < 16; ++it) { const int idx = tid + it * NWAVES * 64, k = idx >> 3, e = idx & 7, l = k >> 4, i = k & 15;
          wrg[((i * 2) + (e >> 2)) * 256 + 4 * l + (e & 3)] = wv[it] * gv[it]; } }
    __syncthreads();
    const int b5 = (lane >> 5) & 1, b4 = (lane >> 4) & 1, b3 = (lane >> 3) & 1;
    typedef float f32x2 __attribute__((ext_vector_type(2)));
    f32x2 wreg[16][4];
#pragma unroll
    for (int j = 0; j < 16; ++j) { const f32x4 w0 = *(const LAS f32x4*)(wrg + (j * 2) * 256 + 4 * lane), w1 = *(const LAS f32x4*)(wrg + (j * 2 + 1) * 256 + 4 * lane);
        wreg[j][0] = (f32x2){w0.x, w0.y}; wreg[j][1] = (f32x2){w0.z, w0.w}; wreg[j][2] = (f32x2){w1.x, w1.y}; wreg[j][3] = (f32x2){w1.z, w1.w}; }
    for (int c = F.vcu; c < M / 256; c += F.G) {
        if (tid < 16) cnt[tid] = 0;
        __syncthreads();
        v4u vn[2], vm[2];
        { const GAS v4u* xr = (const GAS v4u*)(ws + WS_XR3 + (size_t)(c * 256 + F.wave * 32) * D * 2) + 2 * lane; vn[0] = xr[0]; vn[1] = xr[1]; vm[0] = xr[D * 2 / 16]; vm[1] = xr[D * 2 / 16 + 1]; }
#pragma unroll 2
        for (int i = 0; i < 32; ++i) {
            const int m = c * 256 + F.wave * 32 + i;
            const v4u q0 = vn[0], q1 = vn[1];
            vn[0] = vm[0]; vn[1] = vm[1];
            if (i + 2 < 32) { const GAS v4u* xr = (const GAS v4u*)(ws + WS_XR3 + (size_t)(m + 2) * D * 2) + 2 * lane; vm[0] = xr[0]; vm[1] = xr[1]; }
            const unsigned qw[8] = {q0.x, q0.y, q0.z, q0.w, q1.x, q1.y, q1.z, q1.w};
            float xv[16]; float ssx = 0.f;
#pragma unroll
            for (int j = 0; j < 8; ++j) { xv[2 * j] = bflo(qw[j]); xv[2 * j + 1] = bfhi(qw[j]); }
#pragma unroll
            for (int j = 0; j < 16; j += 4) ssx += (xv[j] * xv[j] + xv[j + 1] * xv[j + 1]) + (xv[j + 2] * xv[j + 2] + xv[j + 3] * xv[j + 3]);
            float lg[8];
            { f32x2 l2[4] = {{0.f, 0.f}, {0.f, 0.f}, {0.f, 0.f}, {0.f, 0.f}};
#pragma unroll
              for (int j = 0; j < 16; ++j) { const f32x2 xx = {xv[j], xv[j]};
#pragma unroll
                  for (int q = 0; q < 4; ++q) l2[q] = l2[q] + xx * wreg[j][q]; }
#pragma unroll
              for (int q = 0; q < 4; ++q) { lg[2 * q] = l2[q].x; lg[2 * q + 1] = l2[q].y; } }
            float r4[4], r2[2], r1;
#pragma unroll
            for (int e = 0; e < 4; ++e) { const float mine = b5 ? lg[4 + e] : lg[e], other = b5 ? lg[e] : lg[4 + e]; r4[e] = mine + xor32_partner(other, b5); }
#pragma unroll
            for (int e = 0; e < 2; ++e) { const float mine = b4 ? r4[2 + e] : r4[e], other = b4 ? r4[e] : r4[2 + e]; r2[e] = mine + swz_xor<16>(other); }
            { const float mine = b3 ? r2[1] : r2[0], other = b3 ? r2[0] : r2[1]; r1 = mine + swz_xor<8>(other); }
            r1 += swz_xor<4>(r1); r1 += swz_xor<2>(r1); r1 += swz_xor<1>(r1);
            const float rstd = 1.f / sqrtf(wave_sum(ssx) * (1.f / D) + EPS);
#pragma unroll
            for (int e = 0; e < 8; ++e) lg[e] = __builtin_bit_cast(float, __builtin_amdgcn_readlane(__builtin_bit_cast(int, r1), 8 * e)) * rstd;
            int e1 = 0; float l1 = lg[0];
#pragma unroll
            for (int e = 1; e < 8; ++e) if (lg[e] > l1) { l1 = lg[e]; e1 = e; }
            int e2 = -1; float l2 = -INFINITY;
#pragma unroll
            for (int e = 0; e < 8; ++e) if (e != e1 && lg[e] > l2) { l2 = lg[e]; e2 = e; }
            const float g1 = 1.f / (1.f + __expf(l2 - l1)), g2 = 1.f - g1;
            const int elo = e1 < e2 ? e1 : e2, ehi = e1 < e2 ? e2 : e1;
            const float glo = e1 < e2 ? g1 : g2, ghi = e1 < e2 ? g2 : g1;
            if (lane == 0) { ((GAS float*)(ws + WS_TOKRSTD))[m] = rstd; ((GAS int*)(ws + WS_TOKE))[m] = elo | (ehi << 8); ((GAS float*)(ws + WS_TOKG))[2 * m] = glo; ((GAS float*)(ws + WS_TOKG))[2 * m + 1] = ghi;
                atomicAdd((int*)&cnt[elo], 1); atomicAdd((int*)&cnt[8 + ehi], 1); }
        }
        __syncthreads();
        if (tid < 16) ((GAS int*)(ws + WS_CNT))[c * 16 + tid] = cnt[tid];
        __syncthreads();
    }
}

__device__ __forceinline__ void slot_phase(const Frame& F, unsigned char* ws) {
    const int tid = fresh(F.wave * 64 + lane_id_()), lane = tid & 63; (void)lane;
    LAS int* call = (LAS int*)(F.lds + RING_OFF);
    LAS int* tot = call + 4096; LAS int* base = tot + 16; LAS int* pre = base + 16; LAS int* meta = pre + 16;
    LAS int* grp = meta + 16;
    LAS int* slot_of = grp + 512;
    for (int idx = tid; idx < 4096; idx += NWAVES * 64) call[idx] = ((const GAS int*)(ws + WS_CNT))[idx];
    __syncthreads();
    if (tid < 16) { int t = 0; for (int cc = 0; cc < 256; ++cc) t += call[cc * 16 + tid]; tot[tid] = t; }
    __syncthreads();
    if (tid == 0) { int off = 0; for (int g = 0; g < 16; ++g) { base[g] = off; off += (tot[g] + 255) & ~255; if (g == 7) meta[0] = off >> 8; } meta[1] = (off >> 8) - meta[0]; }
    __syncthreads();
    for (int c = F.vcu; c < M / 256; c += F.G) {
        if (tid < 16) { int p = 0; for (int cc = 0; cc < c; ++cc) p += call[cc * 16 + tid]; pre[tid] = p; }
        const int hf = tid >> 8, i = tid & 255, m = c * 256 + i;
        const int te = ((const GAS int*)(ws + WS_TOKE))[m];
        const int g = hf * 8 + (hf ? ((te >> 8) & 0xff) : (te & 0xff));
        grp[tid] = g;
        __syncthreads();
        int rank = 0;
        for (int j = 0; j < i; ++j) rank += (grp[hf * 256 + j] == g) ? 1 : 0;
        const int slot = base[g] + pre[g] + rank;
        ((GAS int*)(ws + WS_SLOTTOK))[slot] = m; ((GAS float*)(ws + WS_SLOTGATE))[slot] = ((const GAS float*)(ws + WS_TOKG))[2 * m + hf];
        slot_of[tid] = slot;
        __syncthreads();
        for (int i0 = F.wave; i0 < 256; i0 += 4 * NWAVES) {
            v4u x[4][2]; float rs[4];
#pragma unroll
            for (int k = 0; k < 4; ++k) { const int mm = c * 256 + i0 + 8 * k; const GAS v4u* src = (const GAS v4u*)(ws + WS_XR3 + (size_t)mm * D * 2);
                x[k][0] = src[2 * lane]; x[k][1] = src[2 * lane + 1]; rs[k] = ((const GAS float*)(ws + WS_TOKRSTD))[mm]; }
#pragma unroll
            for (int k = 0; k < 4; ++k) { const int i = i0 + 8 * k; const v4u x0 = x[k][0], x1 = x[k][1]; const float r = rs[k];
                const v4u o = (v4u){pk_fp8x4(bflo(x0.x) * r, bfhi(x0.x) * r, bflo(x0.y) * r, bfhi(x0.y) * r), pk_fp8x4(bflo(x0.z) * r, bfhi(x0.z) * r, bflo(x0.w) * r, bfhi(x0.w) * r),
                                    pk_fp8x4(bflo(x1.x) * r, bfhi(x1.x) * r, bflo(x1.y) * r, bfhi(x1.y) * r), pk_fp8x4(bflo(x1.z) * r, bfhi(x1.z) * r, bflo(x1.w) * r, bfhi(x1.w) * r)};
                ((GAS v4u*)(ws + WS_XG + (size_t)slot_of[i] * D))[lane] = o; ((GAS v4u*)(ws + WS_XG + (size_t)slot_of[256 + i] * D))[lane] = o; }
        }
        __syncthreads();
    }
    for (int g = F.vcu; g < 16; g += F.G) {
        const int s0 = base[g] + tot[g], s1 = base[g] + ((tot[g] + 255) & ~255);
        for (int s = s0 + F.wave; s < s1; s += NWAVES) { GAS v4u* dst = (GAS v4u*)(ws + WS_XG + (size_t)s * D);
            dst[lane] = (v4u){0u, 0u, 0u, 0u};
            if (lane == 0) { ((GAS int*)(ws + WS_SLOTTOK))[s] = -1; ((GAS float*)(ws + WS_SLOTGATE))[s] = 0.f; } }
    }
    if (F.vcu == 0) {
        if (tid < 16) { const int p0 = base[tid] >> 8, p1 = (base[tid] + ((tot[tid] + 255) & ~255)) >> 8; for (int p = p0; p < p1; ++p) ((GAS int*)(ws + WS_PANELE))[p] = tid & 7; }
        if (tid == 0) { ((GAS int*)(ws + WS_META))[0] = meta[0]; ((GAS int*)(ws + WS_META))[1] = meta[1]; }
        if (tid < 16) ((GAS int*)(ws + WS_META))[2 + tid] = base[tid] >> 8;
        if (tid == 0) { const int nPA = meta[0], nPB = meta[1]; int x = nPB > 256 ? nPB - 256 : 0;
            if (x > 0 && nPA > 256) { int LA = 0, HB = 7;
                for (int g = 0; g < 8; ++g) { const int q0 = base[g] >> 8, q1 = q0 + ((tot[g] + 255) >> 8); if (q0 <= 256 && 256 < q1) LA = g; }
                for (int g = 8; g < 16; ++g) { const int q0 = base[g] >> 8, q1 = q0 + ((tot[g] + 255) >> 8), P = nPA + x - 1; if (q0 <= P && P < q1) HB = g - 8; }
                if (LA < HB) x = 0; }
            ((GAS int*)(ws + WS_META))[18] = x; }
    }
    __syncthreads();
}

__global__ void __launch_bounds__(NWAVES * 64, 2) yoco_fwd(Args args) {
    extern __shared__ __attribute__((aligned(16))) unsigned char lds_raw[];
    Frame F;
    F.lds = (LAS unsigned char*)lds_raw;
    F.wave = __builtin_amdgcn_readfirstlane((int)threadIdx.x >> 6);
    F.G = gridDim.x; { const int bx = blockIdx.x; F.vcu = (F.G % 8 == 0) ? (bx % 8) * (F.G / 8) + bx / 8 : bx; }
    unsigned char* ws = WSP;
    volatile LAS unsigned* MISC = (volatile LAS unsigned*)(F.lds + MISC_OFF);
    for (int u = fresh((int)threadIdx.x); u < (LDS_BYTES - LDSCTL_OFF) / 4; u += NWAVES * 64) ((LAS unsigned*)(F.lds + LDSCTL_OFF))[u] = 0u;
    __syncthreads();
    (void)xcd_barrier_post((unsigned*)(ws + WS_CTL) + CW_BAR, MISC + 8, (F.wave == 0 && lane_id_() == 0) ? 1 : 0);
    LAS unsigned char* ring = F.lds + RING_OFF;
#define bid ((int)blockIdx.x)
#define GRID_BAR() do { XcdBarrier b_; b_.t0 = (F.wave == 0 && lane_id_() == 0) ? 1 : 0; b_.bar = (unsigned*)(WSP + WS_CTL) + CW_BAR; b_.x = xb_xcc_id(); b_.st = (volatile LAS unsigned*)(F.lds + MISC_OFF) + 8; xcd_barrier(b_); } while (0)
#define GEMM(EpiT, SchedT) pg8::gemm_phase<EpiT, SchedT, true, true>

    p0_prologue(F);
    GRID_BAR();
    { pg8::Gemm g{(const bf16*)(ws + WS_XN), (const bf16*)(ws + WS_WA), M, NA, D / 2, D / 2}; pg8::StaticOrder S; S.init(M, NA, F.G, bid);
      pg8::EpiQA E{(bf16*)(ws + WS_QA), (float*)(ws + WS_PARTQA), 1.f / 64};
      pg8::gemm_phase<pg8::EpiQA, pg8::StaticOrder, true, true, true>(ring, g, S, E, F.wave); }
    GRID_BAR();
    { pg8::Gemm g{(const bf16*)(ws + WS_QA), (const bf16*)(ws + WS_WUQ), M, NH * QKD, QLORA, NA}; pg8::StaticOrder S; S.init(M, NH * QKD, F.G, bid);
      pg8::EpiRowScaleBf16 E{(bf16*)(ws + WS_Q), NH * QKD, (const float*)(ws + WS_PARTQA), 1.f / QLORA};
      GEMM(pg8::EpiRowScaleBf16, pg8::StaticOrder)(ring, g, S, E, F.wave); }
    { pg8::Gemm g{(const bf16*)(ws + WS_QA) + QLORA, (const bf16*)(ws + WS_WUKV), M, NH * 128, KVLORA, NA}; pg8::StaticOrder S; S.init(M, NH * 128, F.G, bid);
      pg8::EpiKVup E{(bf16*)(ws + WS_K), (bf16*)(ws + WS_V), (const float*)(ws + WS_PARTQA), (const bf16*)(ws + WS_QA), INP(I_A_GKN), (const float*)(ws + WS_ROPE)};
      GEMM(pg8::EpiKVup, pg8::StaticOrder)(ring, g, S, E, F.wave); }
    GRID_BAR();
    bool fastA;
    { float bq = 0.f, bk = 0.f; const int l_ = lane_id_(); for (int i = l_; i < QKD; i += 64) { bq = fmaxf(bq, fabsf(INP(I_A_GQN)[i])); bk = fmaxf(bk, fabsf(INP(I_A_GKN)[i])); }
      bq = wave_maxf(bq); bk = wave_maxf(bk); fastA = __builtin_amdgcn_readfirstlane((int)(14.42f * bq * bk <= 40.f)) != 0; }
#define P5_UNIT(NM) att::attn_unit<96, false, 1536, 1536, D, D, true, NM, 2>(ring, (const bf16*)(ws + WS_Q) + (size_t)b * SEQ * 1536 + h * QKD, (const bf16*)(ws + WS_K) + (size_t)b * SEQ * 1536 + h * QKD, \
                                      (const bf16*)(ws + WS_V) + (size_t)b * SEQ * D + h * 64, (bf16*)(ws + WS_O + (size_t)b * SEQ * D + h * 64), \
                                      256 * qb, 0, 4 * qb + 3, 0, 4 * qb + (F.wave >> 1), 0, nullptr, INP(I_A_GQN), (const float*)(ws + WS_ROPE), F.wave, true, qfA, false, false, \
                                      (const bf16*)(ws + WS_Q) + (size_t)bn * SEQ * 1536 + hh * QKD + (size_t)(256 * qbn) * 1536)
    att::attn_init<96, 1536, D, 2>(ring, F.wave);
    att::bf16x8 qfA[6]; bool qldA = false;
    for (int p = F.vcu; p < BATCH * NH * 4; p += F.G) {
        const int bh = p >> 2, pid = p & 3, b = bh >> 4, h = bh & 15;
        for (int u2 = 0; u2 < 2; ++u2) {
            const int qb = u2 ? 7 - pid : pid;
            const int pn = u2 ? p + F.G : p; const bool hn = pn < BATCH * NH * 4;
            const int bhn = pn >> 2, pidn = pn & 3, bn = bhn >> 4, hh = bhn & 15, qbn = u2 ? pidn : 7 - pidn;
            if (fastA) P5_UNIT(true); else P5_UNIT(false);
        }
    }
    GRID_BAR();
    { pg8::Gemm g{(const bf16*)(ws + WS_O), (const bf16*)(ws + WS_WO), M, D, D / 2, D / 2}; pg8::StaticOrder S; S.init(M, D, F.G, bid);
      pg8::EpiResStream<true, false, false> E{INP(I_X), (bf16*)(ws + WS_XR1), nullptr, (float*)(ws + WS_PART1), 1.f / 2048};
      pg8::gemm_phase<pg8::EpiResStream<true, false, false>, pg8::StaticOrder, true, true, true>(ring, g, S, E, F.wave); }
    GRID_BAR();
    { pg8::Gemm g{(const bf16*)(ws + WS_XR1), (const bf16*)(ws + WS_WF1), M, 2 * FF, D, D}; pg8::StaticOrder S; S.init(M, 2 * FF, F.G, bid);
      pg8::EpiGatedF8T<true, false> E{ws + WS_H, FF, 0, (const float*)(ws + WS_PART1)};
      typedef pg8::EpiGatedF8T<true, false> EpiH8; GEMM(EpiH8, pg8::StaticOrder)(ring, g, S, E, F.wave); }
    GRID_BAR();
    { pg8::Gemm g{(const bf16*)(ws + WS_H), (const bf16*)(ws + WS_WF2), M, D, FF / 2, FF / 2}; pg8::StaticOrder S; S.init(M, D, F.G, bid);
      pg8::EpiResStream<true, true, true> E{ws + WS_XR1, (bf16*)(ws + WS_X2B), ws + WS_XR2, (float*)(ws + WS_PART2), 1.f / 64};
      pg8::gemm_phase<pg8::EpiResStream<true, true, true>, pg8::StaticOrder, true, true, true>(ring, g, S, E, F.wave); }
    GRID_BAR();
    { pg8::Gemm g{(const bf16*)(ws + WS_XR2), (const bf16*)(ws + WS_WKVQ), M, 2 * D, D / 2, D / 2}; pg8::StaticOrder S; S.init(M, 2 * D, F.G, bid);
      pg8::EpiK2Q2 E{(bf16*)(ws + WS_KVQ2), (const float*)(ws + WS_PART2), INP(I_KV_GKN), INP(I_B_GQN), 1.f / 64};
      pg8::gemm_phase<pg8::EpiK2Q2, pg8::StaticOrder, true, true, true>(ring, g, S, E, F.wave); }
    { pg8::Gemm g{(const bf16*)(ws + WS_XR2), (const bf16*)(ws + WS_WKVQ + (size_t)2 * D * D), M, D, D / 2, D / 2}; pg8::StaticOrder S; S.init(M, D, F.G, bid);
      pg8::EpiRowScale16 E{(bf16*)(ws + WS_KVQ2), 3 * D, D, (const float*)(ws + WS_PART2), 1.f / 64};
      pg8::gemm_phase<pg8::EpiRowScale16, pg8::StaticOrder, true, true, true>(ring, g, S, E, F.wave); }
    GRID_BAR();
    bool fastB;
    { float bq = 0.f, bk = 0.f, bb = 0.f; const int l_ = lane_id_(); bq = fabsf(INP(I_B_GQN)[l_]); bk = fabsf(INP(I_KV_GKN)[l_]);
      for (int i = l_; i < NH * 257; i += 64) bb = fmaxf(bb, fabsf(INP(I_B_RELB)[i]));
      bq = wave_maxf(bq); bk = wave_maxf(bk); bb = wave_maxf(bb); fastB = __builtin_amdgcn_readfirstlane((int)(11.78f * bq * bk + 1.4427f * bb <= 40.f)) != 0; }
    att::attn_init<64, 3072, 3072, 2>(ring, F.wave);
    att::bf16x8 qfB[4]; bool qldB = false;
    int last_h = -1;
    for (int p = F.vcu; p < BATCH * NH * 8; p += F.G) {
        const int bh = p >> 3, cb = ((p & 7) + (p >> 8)) & 7, b = bh >> 4, h = bh & 15;
        const bool ldb = h != last_h; last_h = h;
        const int pn = p + F.G; const bool hn = pn < BATCH * NH * 8; const int bhn = pn >> 3, cbn = ((pn & 7) + (pn >> 8)) & 7;
        const int c0 = 4 * cb, cc = c0 + (F.wave >> 1);
        const bf16* base = (const bf16*)(ws + WS_KVQ2) + (size_t)b * SEQ * 3072 + h * 64;
#define P13_UNIT(NM) att::attn_unit<64, true, 3072, 3072, 3072, D, true, NM, 2>(ring, base + 2048, base, base + 1024, (bf16*)(ws + WS_O2 + (size_t)b * SEQ * D + h * 64), \
                                 256 * cb, c0 - 8 < 0 ? 0 : c0 - 8, c0 + 3, cc - 8 < 0 ? 0 : cc - 8, cc, cc, INP(I_B_RELB) + h * 257, nullptr, nullptr, F.wave, ldb, qfB, qldB, hn, \
                                 (const bf16*)(ws + WS_KVQ2) + (size_t)(bhn >> 4) * SEQ * 3072 + (bhn & 15) * 64 + 2048 + (size_t)(256 * cbn) * 3072)
        if (fastB) P13_UNIT(true); else P13_UNIT(false);
        qldB = hn;
    }
    GRID_BAR();
    { pg8::Gemm g{(const bf16*)(ws + WS_O2), (const bf16*)(ws + WS_WBO), M, D, D / 2, D / 2}; pg8::StaticOrder S; S.init(M, D, F.G, bid);
      pg8::EpiResStream<false, false, true> E{ws + WS_X2B, (bf16*)(ws + WS_XR3), nullptr, nullptr, 1.f / 2048};
      pg8::gemm_phase<pg8::EpiResStream<false, false, true>, pg8::StaticOrder, true, true, true>(ring, g, S, E, F.wave); }
    GRID_BAR();
    route_phase(F);
    GRID_BAR();
    slot_phase(F, ws);
    GRID_BAR();
#define MOE_LOAD(hf_) unsigned char* w2 = WSP; \
          const int nPA = __builtin_amdgcn_readfirstlane(((const GAS int*)(w2 + WS_META))[0]), nPB = __builtin_amdgcn_readfirstlane(((const GAS int*)(w2 + WS_META))[1]); (void)nPB; \
          const int xB = __builtin_amdgcn_readfirstlane(((const GAS int*)(w2 + WS_META))[18]); (void)xB; \
          const int p0 = (hf_) ? nPA : 0; int pbk[7]; \
          _Pragma("unroll") for (int k = 0; k < 7; ++k) pbk[k] = __builtin_amdgcn_readfirstlane(((const GAS int*)(w2 + WS_META))[2 + (hf_) * 8 + 1 + k]) - p0;
    constexpr size_t HMB_OFF = (size_t)MAXP_HALF * 256 * EFF;
    { MOE_LOAD(0)
      pg8::Gemm g{(const bf16*)(w2 + WS_XG), (const bf16*)(w2 + WS_WM1), nPA * 256, 2 * EFF, D / 2, D / 2};
      pg8::MoeOrder S; S.init(nPA, 2 * EFF / 256, F.G, bid);
#pragma unroll
      for (int k = 0; k < 7; ++k) S.pb[k] = pbk[k];
      pg8::EpiGatedF8 E{w2 + WS_HM, EFF, 2 * EFF / 256};
      pg8::gemm_phase<pg8::EpiGatedF8, pg8::MoeOrder, true, true, true>(ring, g, S, E, F.wave); }
    { MOE_LOAD(1)
      pg8::Gemm g{(const bf16*)(w2 + WS_XG + (size_t)p0 * 256 * D), (const bf16*)(w2 + WS_WM1), xB * 256, 2 * EFF, D / 2, D / 2};
      pg8::MoeOrder S; S.init(xB, 2 * EFF / 256, F.G, bid); S.rot = (nPA * (2 * EFF / 256)) % F.G;
#pragma unroll
      for (int k = 0; k < 7; ++k) S.pb[k] = pbk[k];
      pg8::EpiGatedF8 E{w2 + WS_HM + HMB_OFF, EFF, 2 * EFF / 256};
      pg8::gemm_phase<pg8::EpiGatedF8, pg8::MoeOrder, true, true, true>(ring, g, S, E, F.wave); }
    GRID_BAR();
    { MOE_LOAD(0)
      pg8::Gemm g{(const bf16*)(w2 + WS_HM), (const bf16*)(w2 + WS_WM2), 256 * 256, D, EFF / 2, EFF / 2};
      pg8::MoeOrder S; S.init(256, D / 256, F.G, bid);
#pragma unroll
      for (int k = 0; k < 7; ++k) S.pb[k] = pbk[k];
      pg8::EpiMoeDown<true> E{nullptr, (bf16*)(w2 + WS_XR3), (const int*)(w2 + WS_SLOTTOK), (const float*)(w2 + WS_SLOTGATE), 0, D, 1.f / 64};
      pg8::gemm_phase<pg8::EpiMoeDown<true>, pg8::MoeOrder, true, true, true>(ring, g, S, E, F.wave); }
    GRID_BAR();
    { MOE_LOAD(0)
      pg8::Gemm g{(const bf16*)(w2 + WS_HM), (const bf16*)(w2 + WS_WM2), nPA * 256, D, EFF / 2, EFF / 2};
      pg8::LeftOrder S; S.M.init(nPA, D / 256, F.G, bid); S.nLeft = 4 * (nPA - 256); S.c0 = 0; S.pbase = 256;
#pragma unroll
      for (int k = 0; k < 7; ++k) S.M.pb[k] = pbk[k];
      pg8::EpiMoeDown<true> E{nullptr, (bf16*)(w2 + WS_XR3), (const int*)(w2 + WS_SLOTTOK), (const float*)(w2 + WS_SLOTGATE), 0, D, 1.f / 64};
      pg8::gemm_phase<pg8::EpiMoeDown<true>, pg8::LeftOrder, true, true, true>(ring, g, S, E, F.wave); }
    { MOE_LOAD(1)
      pg8::Gemm g{(const bf16*)(w2 + WS_HM + HMB_OFF), (const bf16*)(w2 + WS_WM2), xB * 256, D, EFF / 2, EFF / 2};
      pg8::LeftOrder S; S.M.init(xB, D / 256, F.G, bid); S.nLeft = 4 * xB; S.c0 = 4 * (nPA - 256); S.pbase = 0;
#pragma unroll
      for (int k = 0; k < 7; ++k) S.M.pb[k] = pbk[k];
      pg8::EpiMoeDown<false> E{OUTP, (bf16*)(w2 + WS_XR3), (const int*)(w2 + WS_SLOTTOK), (const float*)(w2 + WS_SLOTGATE), p0 * 256, D, 1.f / 64};
      pg8::gemm_phase<pg8::EpiMoeDown<false>, pg8::LeftOrder, true, true, true>(ring, g, S, E, F.wave); }
    { MOE_LOAD(1)
      pg8::Gemm g{(const bf16*)(w2 + WS_XG + (size_t)(p0 + xB) * 256 * D), (const bf16*)(w2 + WS_WM1), (nPB - xB) * 256, 2 * EFF, D / 2, D / 2};
      pg8::MoeOrder S; S.init(nPB - xB, 2 * EFF / 256, F.G, bid); S.nBusy = 4 * (nPA - 256) + 4 * xB; S.SK = 4;
#pragma unroll
      for (int k = 0; k < 7; ++k) S.pb[k] = pbk[k] - xB;
      pg8::EpiGatedF8 E{w2 + WS_HM + HMB_OFF + (size_t)xB * 256 * EFF, EFF, 2 * EFF / 256};
      pg8::gemm_phase<pg8::EpiGatedF8, pg8::MoeOrder, true, true, true>(ring, g, S, E, F.wave); }
    GRID_BAR();
    { MOE_LOAD(1)
      pg8::Gemm g{(const bf16*)(w2 + WS_HM + HMB_OFF + (size_t)xB * 256 * EFF), (const bf16*)(w2 + WS_WM2), (nPB - xB) * 256, D, EFF / 2, EFF / 2};
      pg8::MoeOrder S; S.init(nPB - xB, D / 256, F.G, bid);
#pragma unroll
      for (int k = 0; k < 7; ++k) S.pb[k] = pbk[k] - xB;
      pg8::EpiMoeDown<false> E{OUTP, (bf16*)(w2 + WS_XR3), (const int*)(w2 + WS_SLOTTOK), (const float*)(w2 + WS_SLOTGATE), (p0 + xB) * 256, D, 1.f / 64};
      pg8::gemm_phase<pg8::EpiMoeDown<false>, pg8::MoeOrder, true, true, true>(ring, g, S, E, F.wave); }
#undef MOE_LOAD
#undef GRID_BAR
#undef bid
#undef GEMM
}

extern "C" void kernel_launch(void* const* d_in, const int* in_sizes, int n_in, void* d_out, int out_size, void* d_ws, size_t ws_size, hipStream_t stream) {
    static int grid = 0;
    if (grid == 0) {
        if (n_in != 27 || in_sizes[0] != M * D || out_size != M * D || ws_size < WS_END) { fprintf(stderr, "kernel_launch: unexpected shapes (n_in %d, in0 %d, out %d, ws %zu < %zu); nothing launched\n", n_in, n_in > 0 ? in_sizes[0] : -1, out_size, ws_size, (size_t)WS_END); grid = -1; return; }
        int dev = 0, cus = 0, per_cu = 0;
        if (hipGetDevice(&dev) != hipSuccess || hipDeviceGetAttribute(&cus, hipDeviceAttributeMultiprocessorCount, dev) != hipSuccess) { grid = -1; return; }
        if (hipFuncSetAttribute((const void*)yoco_fwd, hipFuncAttributeMaxDynamicSharedMemorySize, LDS_BYTES) != hipSuccess) { fprintf(stderr, "kernel_launch: hipFuncSetAttribute failed\n"); grid = -1; return; }
        if (hipOccupancyMaxActiveBlocksPerMultiprocessor(&per_cu, (const void*)yoco_fwd, NWAVES * 64, LDS_BYTES) != hipSuccess || per_cu < 1) { fprintf(stderr, "kernel_launch: occupancy query says %d\n", per_cu); }
        (void)hipGetLastError();
        grid = cus;
    }
    if (grid < 0) return;
    if (hipMemsetAsync((char*)d_ws + WS_CTL, 0, CTL_ZERO_BYTES, stream) != hipSuccess) return;
    Args a{};
    for (int i = 0; i < 27; ++i) a.in[i] = (const float*)d_in[i];
    a.out = (float*)d_out; a.ws = (unsigned char*)d_ws;
    hipLaunchKernelGGL(yoco_fwd, dim3(grid), dim3(NWAVES * 64), LDS_BYTES, stream, a);
}
```

```cpp
#include <hip/hip_runtime.h>
#include <cstdio>
#include <cstdint>
__device__ __forceinline__ int lane_id_() { unsigned m_ = ~0u; asm volatile("" : "+s"(m_)); return (int)__builtin_amdgcn_mbcnt_hi(m_, __builtin_amdgcn_mbcnt_lo(m_, 0u)); }
template <int X> __device__ __forceinline__ float swz_xor(float v) { return __builtin_bit_cast(float, __builtin_amdgcn_ds_swizzle(__builtin_bit_cast(int, v), (X << 10) | 0x1f)); }
__device__ __forceinline__ void halves32(float v, float& r_lo, float& r_hi) { unsigned a_ = __builtin_bit_cast(unsigned, v), b_ = a_;
    asm volatile("s_nop 1\n\tv_permlane32_swap_b32 %0, %1\n\ts_nop 1" : "+v"(a_), "+v"(b_)); r_lo = __builtin_bit_cast(float, a_); r_hi = __builtin_bit_cast(float, b_); }
__device__ __forceinline__ float xor32_partner(float v, int upper_half) { float lo, hi; halves32(v, lo, hi); return upper_half ? lo : hi; }
__device__ __forceinline__ float xor32_sum(float v) { float lo, hi; halves32(v, lo, hi); return lo + hi; }
__device__ __forceinline__ float xor32_max(float v) { float lo, hi; halves32(v, lo, hi); return fmaxf(lo, hi); }
namespace pg8 {
#define PG8_LAS __attribute__((address_space(3)))
typedef unsigned short bf16_t;
typedef short bf16x8 __attribute__((ext_vector_type(8)));
typedef float f32x4 __attribute__((ext_vector_type(4)));
typedef unsigned u32x4 __attribute__((ext_vector_type(4)));
constexpr int BM = 256, BK = 64, HALF = 128, HTB = HALF * BK * 2  , STAGE_BYTES = 8 * HTB, NXCD = 8, WGM = 8;

__host__ __device__ __forceinline__ int lds_byte(int r, int c) { const int st = (r >> 4) * 2 + (c >> 5), rr = r & 15, cc = c & 31, ob = rr * 64 + cc * 2; return st * 1024 + (ob ^ (((ob >> 9) & 1) << 5)); }
__host__ __device__ __forceinline__ void stage_rc(int b, int& R, int& C) { const int st = b / 1024, sb = b % 1024, swz = sb ^ (((sb >> 9) & 1) << 5); R = (st >> 1) * 16 + swz / 64; C = (st & 1) * 32 + (swz % 64) / 2; }
__host__ __device__ __forceinline__ int perm32(int rho) { const int n = rho >> 4, i = rho & 15; return 8 * (i >> 2) + 4 * n + (i & 3); }

struct Unit { int pm, pn; };
struct Gemm { const bf16_t* A; const bf16_t* Bt; int M, N, K, lda; };

struct StaticOrder {
    int nM, nN, nwg, G, c;
    __host__ __device__ void init(int M, int N, int G_, int c_) { nM = M / BM; nN = N / BM; nwg = nM * nN; G = G_; c = c_; }
    __host__ __device__ bool next(int i, Unit& u) const {
        const int L = i * G + c; if (L >= nwg) return false;
        int wgid = L; { const int q = nwg / NXCD, r = nwg % NXCD, xcd = wgid % NXCD, off = wgid / NXCD; wgid = (xcd < r ? xcd * (q + 1) : r * (q + 1) + (xcd - r) * q) + off; }
        const int nig = WGM * nN, gid = wgid / nig, fm = gid * WGM, gsz = (nM - fm) < WGM ? (nM - fm) : WGM;
        u.pm = fm + ((wgid % nig) % gsz); u.pn = (wgid % nig) / gsz; return true;
    }
    __device__ __forceinline__ void a_ready(const Unit&) const {}
    __device__ __forceinline__ void done(const Unit&) const {}
};
__device__ __forceinline__ unsigned cvt_pk_bf16(float lo, float hi) { unsigned r; asm volatile("v_cvt_pk_bf16_f32 %0, %1, %2" : "=v"(r) : "v"(lo), "v"(hi)); return r; }
__device__ __forceinline__ float silu_f(float x) { const float e = __builtin_amdgcn_exp2f(x * -1.4426950408889634f); return x * __builtin_amdgcn_rcpf(1.f + e); }

__device__ __forceinline__ float sum4(const f32x4& a) { return (a[0] + a[1]) + (a[2] + a[3]); }
__device__ __forceinline__ float part_sum8(const float* p) { return sum4(*(const f32x4*)p) + sum4(*(const f32x4*)(p + 4)); }
__device__ __forceinline__ float part_sum16(const float* p) { return (sum4(*(const f32x4*)p) + sum4(*(const f32x4*)(p + 4))) + (sum4(*(const f32x4*)(p + 8)) + sum4(*(const f32x4*)(p + 12))); }
__device__ __forceinline__ float fq_sum(float v) { v += swz_xor<16>(v); return xor32_sum(v); }
__device__ __forceinline__ float sq8(const f32x4& a, const f32x4& b) { return ((a[0] * a[0] + a[1] * a[1]) + (a[2] * a[2] + a[3] * a[3])) + ((b[0] * b[0] + b[1] * b[1]) + (b[2] * b[2] + b[3] * b[3])); }
__device__ __forceinline__ u32x4 pack8(const f32x4& a, const f32x4& b) { u32x4 w; w.x = cvt_pk_bf16(a[0], a[1]); w.y = cvt_pk_bf16(a[2], a[3]); w.z = cvt_pk_bf16(b[0], b[1]); w.w = cvt_pk_bf16(b[2], b[3]); return w; }
constexpr float EPS_ = 1e-6f;
__device__ __forceinline__ unsigned pk_fp8x4(float a, float b, float c, float d) { int w = 0; w = __builtin_amdgcn_cvt_pk_fp8_f32(a, b, w, false); w = __builtin_amdgcn_cvt_pk_fp8_f32(c, d, w, true); return (unsigned)w; }

struct EpiQA {
    static constexpr bool PERM = true, AFTER_DRAIN = false;
    bf16_t* O; float* part; float wscale;
    __device__ __forceinline__ void operator()(const f32x4 (&acc)[2][2][4][2], const Unit& u, int wr, int wc, int fr, int fq) const {
        { int t_ = lane_id_(); asm volatile("" : "+v"(t_)); fr = t_ & 15; fq = (t_ >> 4) & 3; }
        const int row0 = u.pm * BM + wr * 64 + fr, col0 = u.pn * BM + wc * 32 + 8 * fq;
#pragma unroll
        for (int ai = 0; ai < 2; ++ai)
#pragma unroll
            for (int m = 0; m < 4; ++m) { const int row = row0 + ai * HALF + m * 16; bf16_t* rowp = O + (size_t)row * 768 + col0;
                const f32x4 a0 = acc[ai][0][m][0] * wscale, a1 = acc[ai][0][m][1] * wscale, b0 = acc[ai][1][m][0] * wscale, b1 = acc[ai][1][m][1] * wscale;
                *(u32x4*)(rowp) = pack8(a0, a1); *(u32x4*)(rowp + HALF) = pack8(b0, b1);
                const float s0 = sq8(a0, a1), s1 = sq8(b0, b1);
                float* pr = part + (size_t)row * 16;
                if (u.pn == 0) { const float t = fq_sum(s0 + s1); if (fq == 0) pr[wc] = t; }
                else if (u.pn == 1) { const float t0 = fq_sum(s0), t1 = fq_sum(s1); if (fq == 0) { pr[4 + wc] = t0; pr[8 + wc] = t1; } }
                else { const float t = fq_sum(s0); if (fq == 0) pr[12 + wc] = t; } }
    }
};

struct EpiRowScaleBf16 {
    static constexpr bool PERM = true, AFTER_DRAIN = false;
    bf16_t* O; int ldc; const float* part; float inv_n;
    __device__ __forceinline__ void operator()(const f32x4 (&acc)[2][2][4][2], const Unit& u, int wr, int wc, int fr, int fq) const {
        { int t_ = lane_id_(); asm volatile("" : "+v"(t_)); fr = t_ & 15; fq = (t_ >> 4) & 3; }
        const int row0 = u.pm * BM + wr * 64 + fr, col0 = u.pn * BM + wc * 32 + 8 * fq;
#pragma unroll
        for (int ai = 0; ai < 2; ++ai)
#pragma unroll
            for (int m = 0; m < 4; ++m) { const int row = row0 + ai * HALF + m * 16; bf16_t* rowp = O + (size_t)row * ldc + col0;
                const float rs = __builtin_amdgcn_rsqf(part_sum8(part + (size_t)row * 16) * inv_n + EPS_);
                *(u32x4*)(rowp) = pack8(acc[ai][0][m][0] * rs, acc[ai][0][m][1] * rs); *(u32x4*)(rowp + HALF) = pack8(acc[ai][1][m][0] * rs, acc[ai][1][m][1] * rs); }
    }
};

struct EpiKVup {
    static constexpr bool PERM = true, AFTER_DRAIN = false;
    bf16_t* Kd; bf16_t* Vd; const float* part; const bf16_t* QA; const float* g_kn; const float* rope;
    __device__ __forceinline__ void operator()(const f32x4 (&acc)[2][2][4][2], const Unit& u, int wr, int wc, int fr, int fq) const {
        { int t_ = lane_id_(); asm volatile("" : "+v"(t_)); fr = t_ & 15; fq = (t_ >> 4) & 3; }
        const int row0 = u.pm * BM + wr * 64 + fr;
        if (u.pn >= 4) {
            const int col0 = (u.pn - 4) * BM + wc * 32 + 8 * fq;
#pragma unroll
            for (int ai = 0; ai < 2; ++ai)
#pragma unroll
                for (int m = 0; m < 4; ++m) { const int row = row0 + ai * HALF + m * 16; bf16_t* rowp = Vd + (size_t)row * 1024 + col0;
                    const float rs = __builtin_amdgcn_rsqf(part_sum8(part + (size_t)row * 16 + 8) * (1.f / 256) + EPS_);
                    *(u32x4*)(rowp) = pack8(acc[ai][0][m][0] * rs, acc[ai][0][m][1] * rs); *(u32x4*)(rowp + HALF) = pack8(acc[ai][1][m][0] * rs, acc[ai][1][m][1] * rs); }
            return;
        }
        const int head = 4 * u.pn + wc;
        f32x4 gA0 = *(const f32x4*)(g_kn + 8 * fq), gA1 = *(const f32x4*)(g_kn + 8 * fq + 4), gB0 = *(const f32x4*)(g_kn + 32 + 8 * fq), gB1 = *(const f32x4*)(g_kn + 32 + 8 * fq + 4);
        const f32x4 gR1 = *(const f32x4*)(g_kn + 64 + 4 * fq), gR2 = *(const f32x4*)(g_kn + 80 + 4 * fq);
#pragma unroll
        for (int ai = 0; ai < 2; ++ai)
#pragma unroll
            for (int m = 0; m < 4; ++m) { const int row = row0 + ai * HALF + m * 16;
                const float rs = __builtin_amdgcn_rsqf(part_sum8(part + (size_t)row * 16 + 8) * (1.f / 256) + EPS_);
                f32x4 a0 = acc[ai][0][m][0] * rs, a1 = acc[ai][0][m][1] * rs, b0 = acc[ai][1][m][0] * rs, b1 = acc[ai][1][m][1] * rs;
                const unsigned long long p1 = *(const unsigned long long*)(QA + (size_t)row * 768 + 640 + 4 * fq), p2 = *(const unsigned long long*)(QA + (size_t)row * 768 + 656 + 4 * fq);
                f32x4 x1, x2;
                x1[0] = __builtin_bit_cast(float, (unsigned)(p1 << 16)); x1[1] = __builtin_bit_cast(float, (unsigned)p1 & 0xffff0000u);
                x1[2] = __builtin_bit_cast(float, (unsigned)(p1 >> 32) << 16); x1[3] = __builtin_bit_cast(float, (unsigned)(p1 >> 32) & 0xffff0000u);
                x2[0] = __builtin_bit_cast(float, (unsigned)(p2 << 16)); x2[1] = __builtin_bit_cast(float, (unsigned)p2 & 0xffff0000u);
                x2[2] = __builtin_bit_cast(float, (unsigned)(p2 >> 32) << 16); x2[3] = __builtin_bit_cast(float, (unsigned)(p2 >> 32) & 0xffff0000u);
                const float ss = fq_sum(sq8(a0, a1) + sq8(b0, b1) + sq8(x1, x2));
                const float sh = __builtin_amdgcn_rsqf(ss * (1.f / 96) + EPS_);
                bf16_t* kp = Kd + (size_t)row * 1536 + head * 96;
                *(u32x4*)(kp + 8 * fq) = pack8(a0 * gA0 * sh, a1 * gA1 * sh); *(u32x4*)(kp + 32 + 8 * fq) = pack8(b0 * gB0 * sh, b1 * gB1 * sh);
                const f32x4* rp = (const f32x4*)(rope + ((size_t)(row & 2047) * 16 + 4 * fq) * 2);
                const f32x4 c01 = rp[0], c23 = rp[1];
                const f32x4 y1 = x1 * gR1 * sh, y2 = x2 * gR2 * sh;
                f32x4 o1, o2;
                o1[0] = y1[0] * c01[0] - y2[0] * c01[1]; o2[0] = y2[0] * c01[0] + y1[0] * c01[1];
                o1[1] = y1[1] * c01[2] - y2[1] * c01[3]; o2[1] = y2[1] * c01[2] + y1[1] * c01[3];
                o1[2] = y1[2] * c23[0] - y2[2] * c23[1]; o2[2] = y2[2] * c23[0] + y1[2] * c23[1];
                o1[3] = y1[3] * c23[2] - y2[3] * c23[3]; o2[3] = y2[3] * c23[2] + y1[3] * c23[3];
                unsigned long long w1 = (unsigned long long)cvt_pk_bf16(o1[0], o1[1]) | ((unsigned long long)cvt_pk_bf16(o1[2], o1[3]) << 32);
                unsigned long long w2 = (unsigned long long)cvt_pk_bf16(o2[0], o2[1]) | ((unsigned long long)cvt_pk_bf16(o2[2], o2[3]) << 32);
                *(unsigned long long*)(kp + 64 + 4 * fq) = w1; *(unsigned long long*)(kp + 80 + 4 * fq) = w2; }
    }
};

struct EpiK2Q2 {
    static constexpr bool PERM = true, AFTER_DRAIN = false;
    bf16_t* O; const float* pss; const float* gk; const float* gq; float wscale;
    __device__ __forceinline__ void operator()(const f32x4 (&acc)[2][2][4][2], const Unit& u, int wr, int wc, int fr, int fq) const {
        { int t_ = lane_id_(); asm volatile("" : "+v"(t_)); fr = t_ & 15; fq = (t_ >> 4) & 3; }
        const int row0 = u.pm * BM + wr * 64 + fr, isq = u.pn >> 2, tl = u.pn & 3;
        const float* g = isq ? gq : gk; const float post = isq ? 0.125f * 1.4426950408889634f : 1.f;
        const f32x4 gA0 = *(const f32x4*)(g + 8 * fq) * post, gA1 = *(const f32x4*)(g + 8 * fq + 4) * post, gB0 = *(const f32x4*)(g + 32 + 8 * fq) * post, gB1 = *(const f32x4*)(g + 32 + 8 * fq + 4) * post;
        const int colh = isq * 2048 + (4 * tl + wc) * 64;
        unsigned zhi_ = 0u; asm volatile("" : "+v"(zhi_));
        const unsigned long long coff = ((unsigned long long)zhi_ << 32) | (unsigned)((colh + 8 * fq) * 2);
#pragma unroll
        for (int ai = 0; ai < 2; ++ai)
#pragma unroll
            for (int m = 0; m < 4; ++m) { const int row = row0 + ai * HALF + m * 16; unsigned char* rowp = (unsigned char*)O + (size_t)row * 6144 + coff;
                const float rs = __builtin_amdgcn_rsqf(part_sum16(pss + (size_t)row * 16) * (1.f / 1024) + EPS_) * wscale;
                const f32x4 a0 = acc[ai][0][m][0] * rs, a1 = acc[ai][0][m][1] * rs, b0 = acc[ai][1][m][0] * rs, b1 = acc[ai][1][m][1] * rs;
                const float ss = fq_sum(sq8(a0, a1) + sq8(b0, b1));
                const float sh = __builtin_amdgcn_rsqf(ss * (1.f / 64) + EPS_);
                *(u32x4*)(rowp) = pack8(a0 * gA0 * sh, a1 * gA1 * sh); *(u32x4*)(rowp + 64) = pack8(b0 * gB0 * sh, b1 * gB1 * sh); }
    }
};
struct EpiRowScale16 {
    static constexpr bool PERM = true, AFTER_DRAIN = false;
    bf16_t* O; int ldc; int coff; const float* pss; float wscale;
    __device__ __forceinline__ void operator()(const f32x4 (&acc)[2][2][4][2], const Unit& u, int wr, int wc, int fr, int fq) const {
        { int t_ = lane_id_(); asm volatile("" : "+v"(t_)); fr = t_ & 15; fq = (t_ >> 4) & 3; }
        const int row0 = u.pm * BM + wr * 64 + fr, col0 = coff + u.pn * BM + wc * 32 + 8 * fq;
#pragma unroll
        for (int ai = 0; ai < 2; ++ai)
#pragma unroll
            for (int m = 0; m < 4; ++m) { const int row = row0 + ai * HALF + m * 16; bf16_t* rowp = O + (size_t)row * ldc + col0;
                const float rs = __builtin_amdgcn_rsqf(part_sum16(pss + (size_t)row * 16) * (1.f / 1024) + EPS_) * wscale;
                *(u32x4*)(rowp) = pack8(acc[ai][0][m][0] * rs, acc[ai][0][m][1] * rs); *(u32x4*)(rowp + HALF) = pack8(acc[ai][1][m][0] * rs, acc[ai][1][m][1] * rs); }
    }
};

template <bool SSQ> struct EpiGated {
    static constexpr bool PERM = true, AFTER_DRAIN = false;
    bf16_t* Hd; int ldc; int ntile; const float* rs;
    __device__ __forceinline__ void operator()(const f32x4 (&acc)[2][2][4][2], const Unit& u, int wr, int wc, int fr, int fq) const {
        { int t_ = lane_id_(); asm volatile("" : "+v"(t_)); fr = t_ & 15; fq = (t_ >> 4) & 3; }
        const int pnl = ntile ? (u.pn % ntile) : u.pn;
        const int row0 = u.pm * BM + wr * 64 + fr, col0 = pnl * HALF + wc * 32 + 8 * fq;
#pragma unroll
        for (int ai = 0; ai < 2; ++ai)
#pragma unroll
            for (int m = 0; m < 4; ++m) { const int row = row0 + ai * HALF + m * 16; bf16_t* rowp = Hd + (size_t)row * ldc + col0;
                const float r = SSQ ? __builtin_amdgcn_rsqf(part_sum16(rs + (size_t)row * 16) * (1.f / 1024) + EPS_) : rs[row];
                const f32x4 g0 = acc[ai][0][m][0] * r, g1 = acc[ai][0][m][1] * r, u0 = acc[ai][1][m][0] * r, u1 = acc[ai][1][m][1] * r;
                u32x4 w;
                w.x = cvt_pk_bf16(silu_f(g0[0]) * u0[0], silu_f(g0[1]) * u0[1]); w.y = cvt_pk_bf16(silu_f(g0[2]) * u0[2], silu_f(g0[3]) * u0[3]);
                w.z = cvt_pk_bf16(silu_f(g1[0]) * u1[0], silu_f(g1[1]) * u1[1]); w.w = cvt_pk_bf16(silu_f(g1[2]) * u1[2], silu_f(g1[3]) * u1[3]);
                *(u32x4*)rowp = w; }
    }
};

template <bool RS = false, bool SC64 = true> struct EpiGatedF8T {
    static constexpr bool PERM = true, AFTER_DRAIN = false;
    unsigned char* Hd; int ldc; int ntile; const float* rs;
    static __device__ __forceinline__ float gate(float g, float u) {
        if constexpr (SC64) { const float e = __builtin_amdgcn_exp2f(g * (-1.4426950408889634f / 64.f)); return (g * u) * (__builtin_amdgcn_rcpf(1.f + e) * (1.f / 4096.f)); }
        else { const float e = __builtin_amdgcn_exp2f(g * -1.4426950408889634f); return (g * u) * __builtin_amdgcn_rcpf(1.f + e); } }
    __device__ __forceinline__ void operator()(const f32x4 (&acc)[2][2][4][2], const Unit& u, int wr, int wc, int fr, int fq) const {
        { int t_ = lane_id_(); asm volatile("" : "+v"(t_)); fr = t_ & 15; fq = (t_ >> 4) & 3; }
        const int pnl = ntile ? (u.pn % ntile) : u.pn;
        const int row0 = u.pm * BM + wr * 64 + fr, col0 = pnl * HALF + wc * 32 + 8 * fq;
#pragma unroll
        for (int ai = 0; ai < 2; ++ai)
#pragma unroll
            for (int m = 0; m < 4; ++m) { const int row = row0 + ai * HALF + m * 16; unsigned char* rowp = Hd + (size_t)row * ldc + col0;
                f32x4 g0 = acc[ai][0][m][0], g1 = acc[ai][0][m][1], u0 = acc[ai][1][m][0], u1 = acc[ai][1][m][1];
                if constexpr (RS) { const float r = __builtin_amdgcn_rsqf(part_sum16(rs + (size_t)row * 16) * (1.f / 1024) + EPS_); g0 = g0 * r; g1 = g1 * r; u0 = u0 * r; u1 = u1 * r; }
                unsigned long long w = (unsigned long long)pk_fp8x4(gate(g0[0], u0[0]), gate(g0[1], u0[1]), gate(g0[2], u0[2]), gate(g0[3], u0[3]))
                                     | ((unsigned long long)pk_fp8x4(gate(g1[0], u1[0]), gate(g1[1], u1[1]), gate(g1[2], u1[2]), gate(g1[3], u1[3])) << 32);
                *(unsigned long long*)rowp = w; }
    }
};
typedef EpiGatedF8T<false, true> EpiGatedF8;

template <bool SSQ, bool XF8, bool RES16> struct EpiResStream {
    static constexpr bool PERM = true, AFTER_DRAIN = false;
    const void* res; bf16_t* XB; unsigned char* X8; float* ssq; float ascale;
    __device__ __forceinline__ void operator()(const f32x4 (&acc)[2][2][4][2], const Unit& u, int wr, int wc, int fr, int fq) const {
        { int t_ = lane_id_(); asm volatile("" : "+v"(t_)); fr = t_ & 15; fq = (t_ >> 4) & 3; }
        const int row0 = u.pm * BM + wr * 64 + fr, col0 = u.pn * BM + wc * 32 + 8 * fq;
        f32x4 rw[4][2][2];
#define ERS_ROW(it) (row0 + ((it) >> 2) * HALF + ((it) & 3) * 16)
#define ERS_LOAD(it) do { const size_t ro_ = (size_t)ERS_ROW(it) * 1024 + col0; _Pragma("unroll") for (int bj = 0; bj < 2; ++bj) { \
            if constexpr (RES16) rw[(it) & 3][bj][0] = __builtin_bit_cast(f32x4, *(const u32x4*)((const bf16_t*)res + ro_ + bj * HALF)); \
            else { _Pragma("unroll") for (int n = 0; n < 2; ++n) rw[(it) & 3][bj][n] = *(const f32x4*)((const float*)res + ro_ + bj * HALF + n * 4); } } } while (0)
        ERS_LOAD(0); ERS_LOAD(1); ERS_LOAD(2); ERS_LOAD(3);
#pragma unroll
        for (int it = 0; it < 8; ++it) { const int ai = it >> 2, m = it & 3; const int row = ERS_ROW(it); const size_t ro = (size_t)row * 1024 + col0;
                f32x4 r[2][2];
#pragma unroll
                for (int bj = 0; bj < 2; ++bj) {
                    if constexpr (RES16) { const u32x4 w = __builtin_bit_cast(u32x4, rw[it & 3][bj][0]);
                        r[bj][0] = (f32x4){__builtin_bit_cast(float, w.x << 16), __builtin_bit_cast(float, w.x & 0xffff0000u), __builtin_bit_cast(float, w.y << 16), __builtin_bit_cast(float, w.y & 0xffff0000u)};
                        r[bj][1] = (f32x4){__builtin_bit_cast(float, w.z << 16), __builtin_bit_cast(float, w.z & 0xffff0000u), __builtin_bit_cast(float, w.w << 16), __builtin_bit_cast(float, w.w & 0xffff0000u)}; }
                    else { r[bj][0] = rw[it & 3][bj][0]; r[bj][1] = rw[it & 3][bj][1]; }
                    r[bj][0] = r[bj][0] + acc[ai][bj][m][0] * ascale; r[bj][1] = r[bj][1] + acc[ai][bj][m][1] * ascale; }
                if (it + 4 < 8) ERS_LOAD(it + 4);
                *(u32x4*)(XB + ro) = pack8(r[0][0], r[0][1]); *(u32x4*)(XB + ro + HALF) = pack8(r[1][0], r[1][1]);
                if constexpr (XF8) { unsigned char* x8 = X8 + ro;
                    *(unsigned long long*)(x8) = (unsigned long long)pk_fp8x4(r[0][0][0], r[0][0][1], r[0][0][2], r[0][0][3]) | ((unsigned long long)pk_fp8x4(r[0][1][0], r[0][1][1], r[0][1][2], r[0][1][3]) << 32);
                    *(unsigned long long*)(x8 + HALF) = (unsigned long long)pk_fp8x4(r[1][0][0], r[1][0][1], r[1][0][2], r[1][0][3]) | ((unsigned long long)pk_fp8x4(r[1][1][0], r[1][1][1], r[1][1][2], r[1][1][3]) << 32); }
                if (SSQ) { const float t = fq_sum(sq8(r[0][0], r[0][1]) + sq8(r[1][0], r[1][1])); if (fq == 0) ssq[(size_t)row * 16 + u.pn * 4 + wc] = t; } }
#undef ERS_LOAD
#undef ERS_ROW
    }
};

template <bool FIRST> struct EpiMoeDown {
    static constexpr bool PERM = true, AFTER_DRAIN = false;
    float* out; bf16_t* xb; const int* slot_tok; const float* slot_gate; int slot_base; int ldc; float wscale;
    __device__ __forceinline__ void operator()(const f32x4 (&acc)[2][2][4][2], const Unit& u, int wr, int wc, int fr, int fq) const {
        { int t_ = lane_id_(); asm volatile("" : "+v"(t_)); fr = t_ & 15; fq = (t_ >> 4) & 3; }
        const int pnl = u.pn & 3;
        const int row0 = slot_base + u.pm * BM + wr * 64 + fr, col0 = pnl * BM + wc * 32 + 8 * fq;
        int tk[8]; float gt[8];
#pragma unroll
        for (int it = 0; it < 8; ++it) { const int slot = row0 + (it >> 2) * HALF + (it & 3) * 16; tk[it] = slot_tok[slot]; gt[it] = slot_gate[slot] * wscale; }
        u32x4 rq[4][2];
#define EMD_LOAD(it) do { if (tk[it] >= 0) { _Pragma("unroll") for (int bj = 0; bj < 2; ++bj) rq[(it) & 3][bj] = *(const u32x4*)(xb + (size_t)tk[it] * ldc + col0 + bj * HALF); } } while (0)
        EMD_LOAD(0); EMD_LOAD(1); EMD_LOAD(2); EMD_LOAD(3);
#pragma unroll
        for (int it = 0; it < 8; ++it) { const int ai = it >> 2, m = it & 3;
            if (tk[it] >= 0) { const size_t ro = (size_t)tk[it] * ldc + col0;
#pragma unroll
                for (int bj = 0; bj < 2; ++bj) { const u32x4 w = rq[it & 3][bj];
                    f32x4 r0 = (f32x4){__builtin_bit_cast(float, w.x << 16), __builtin_bit_cast(float, w.x & 0xffff0000u), __builtin_bit_cast(float, w.y << 16), __builtin_bit_cast(float, w.y & 0xffff0000u)};
                    f32x4 r1 = (f32x4){__builtin_bit_cast(float, w.z << 16), __builtin_bit_cast(float, w.z & 0xffff0000u), __builtin_bit_cast(float, w.w << 16), __builtin_bit_cast(float, w.w & 0xffff0000u)};
                    r0 = r0 + acc[ai][bj][m][0] * gt[it]; r1 = r1 + acc[ai][bj][m][1] * gt[it];
                    if constexpr (FIRST) *(u32x4*)(xb + ro + bj * HALF) = pack8(r0, r1);
                    else { *(f32x4*)(out + ro + bj * HALF) = r0; *(f32x4*)(out + ro + bj * HALF + 4) = r1; } } }
            if (it + 4 < 8) EMD_LOAD(it + 4); }
#undef EMD_LOAD
    }
};

struct MoeOrder {
    int nM, nN, nwg, G, c; int pb[7];
    int rot;
    int nBusy, SK;
    __device__ void init(int nPanels, int nN_, int G_, int c_) { nM = nPanels; nN = nN_; nwg = nM * nN; G = G_; c = c_; nBusy = 0; SK = 0; rot = 0; }
    __device__ __forceinline__ int expert_of(int pm) const { int e = 0;
#pragma unroll
        for (int k = 0; k < 7; ++k) e += (pm >= pb[k]) ? 1 : 0;
        return e; }
    __device__ bool next(int i, Unit& u) const {
        int L;
        if (nBusy == 0) { int ce = c - rot; if (ce < 0) ce += G; L = i * G + ce; }
        else if (c >= nBusy) L = (i < SK) ? i * (G - nBusy) + (c - nBusy) : SK * (G - nBusy) + (i - SK) * G + c;
        else L = SK * (G - nBusy) + i * G + c;
        if (L >= nwg) return false;
        int wgid = L; { const int q = nwg / NXCD, r = nwg % NXCD, xcd = wgid % NXCD, off = wgid / NXCD; wgid = (xcd < r ? xcd * (q + 1) : r * (q + 1) + (xcd - r) * q) + off; }
        const int nig = WGM * nN, gid = wgid / nig, fm = gid * WGM, gsz = (nM - fm) < WGM ? (nM - fm) : WGM;
        u.pm = fm + ((wgid % nig) % gsz); const int pnl = (wgid % nig) / gsz;
        u.pn = expert_of(u.pm) * nN + pnl; return true;
    }
    __device__ __forceinline__ void a_ready(const Unit&) const {}
    __device__ __forceinline__ void done(const Unit&) const {}
};
struct LeftOrder {
    MoeOrder M; int nLeft, c0, pbase;
    __device__ bool next(int i, Unit& u) const { const int j = M.c - c0; if (i != 0 || j < 0 || j >= nLeft) return false; u.pm = pbase + (j >> 2); u.pn = M.expert_of(u.pm) * 4 + (j & 3); return true; }
    __device__ __forceinline__ void a_ready(const Unit&) const {}
    __device__ __forceinline__ void done(const Unit&) const {}
};
template <class Epi, class Sched, bool ALIGN_EPI = false, bool SP2 = false, bool F8 = false>
__device__ __forceinline__ void gemm_phase(PG8_LAS unsigned char* lds, const Gemm g, const Sched& S, const Epi& E, const int wave_idx) {
    int tid_ = wave_idx * 64 + lane_id_(); asm volatile("" : "+v"(tid_));
    const int tid = tid_, wid = __builtin_amdgcn_readfirstlane(tid >> 6), lane = tid & 63, wr = wid >> 2, wc = wid & 3, fr = lane & 15, fq = lane >> 4;
    const int K = g.K, nt = K / BK;
    unsigned voffA0, voffB0;
    { int R, C; stage_rc(tid * 16, R, C); const int Rb = Epi::PERM ? ((R & ~31) + perm32(R & 31)) : R;
      voffA0 = (unsigned)(R * g.lda + C) * 2u; voffB0 = (unsigned)(Rb * K + C) * 2u; }
    const size_t voffAR = (size_t)64 * g.lda * 2, voffBR = (size_t)64 * K * 2;
    const size_t kstep = (size_t)(BK * 2);
    const size_t hstepA = (size_t)HALF * g.lda * 2, hstepB = (size_t)HALF * K * 2;
    const size_t tstepA = 2 * hstepA, tstepB = 2 * hstepB;
    const unsigned lds0_ = (unsigned)(__UINTPTR_TYPE__)lds;
    const unsigned ldsw = (unsigned)wid * 1024u;
    const int aoff = lds_byte(wr * 64 + fr, fq * 8), boff = lds_byte(wc * 32 + fr, fq * 8);
#define PG8_SA(b, h) (((b) * 2 + (h)) * HTB)
#define PG8_SB(b, h) ((4 + (b) * 2 + (h)) * HTB)
#define PG8_STAGE(bufoff, gbase, voff) do { _Pragma("unroll") for (int _i = 0; _i < 2; ++_i) { unsigned keep_; const char* sb_ = (const char*)(gbase) + (size_t)_i * voff##R; \
        asm volatile("s_mov_b32 %0, m0\n\ts_mov_b32 m0, %3\n\ts_nop 0\n\tglobal_load_lds_dwordx4 %1, %2\n\ts_mov_b32 m0, %0" \
            : "=&s"(keep_) : "v"(voff##0), "s"(sb_), "s"(lds0_ + (unsigned)((bufoff) + _i * 8192) + ldsw) : "memory"); } } while (0)
#define PG8_LDA(dst, b, h) do { _Pragma("unroll") for (int m = 0; m < 4; ++m) _Pragma("unroll") for (int k = 0; k < 2; ++k) dst[m][k] = *(const PG8_LAS bf16x8*)(lds + PG8_SA(b, h) + aoff + m * 2048 + k * 1024); } while (0)
#define PG8_LDB(dst, b, h) do { _Pragma("unroll") for (int n = 0; n < 2; ++n) _Pragma("unroll") for (int k = 0; k < 2; ++k) dst[n][k] = *(const PG8_LAS bf16x8*)(lds + PG8_SB(b, h) + boff + n * 2048 + k * 1024); } while (0)
#define PG8_MMA(ai, bj, At, Bt) do { __builtin_amdgcn_s_setprio(1); _Pragma("unroll") for (int m = 0; m < 4; ++m) _Pragma("unroll") for (int n = 0; n < 2; ++n) { \
        if constexpr (F8) { typedef int v8i_ __attribute__((ext_vector_type(8))); typedef int v4i_ __attribute__((ext_vector_type(4))); \
            const v4i_ b0_ = __builtin_bit_cast(v4i_, Bt[n][0]), b1_ = __builtin_bit_cast(v4i_, Bt[n][1]), a0_ = __builtin_bit_cast(v4i_, At[m][0]), a1_ = __builtin_bit_cast(v4i_, At[m][1]); \
            const v8i_ bb_ = __builtin_shufflevector(b0_, b1_, 0, 1, 2, 3, 4, 5, 6, 7), aa_ = __builtin_shufflevector(a0_, a1_, 0, 1, 2, 3, 4, 5, 6, 7); \
            acc[ai][bj][m][n] = __builtin_amdgcn_mfma_scale_f32_16x16x128_f8f6f4(bb_, aa_, acc[ai][bj][m][n], 0, 0, 0, 0, 0, 0); } \
        else { _Pragma("unroll") for (int k = 0; k < 2; ++k) acc[ai][bj][m][n] = __builtin_amdgcn_mfma_f32_16x16x32_bf16(Bt[n][k], At[m][k], acc[ai][bj][m][n], 0, 0, 0); } } \
        __builtin_amdgcn_s_setprio(0); } while (0)
#define PG8_WAIT_V(n) asm volatile("s_waitcnt vmcnt(" #n ")" ::: "memory")
#define PG8_WAIT_L(n) asm volatile("s_waitcnt lgkmcnt(" #n ")" ::: "memory")
#define PG8_BAR __builtin_amdgcn_s_barrier()
#define PG8_SCHED __builtin_amdgcn_sched_barrier(0)
    Unit cur, nxt; int ui = 0;
    if (!S.next(0, cur)) return;
    f32x4 acc[2][2][4][2];
#pragma unroll
    for (int a = 0; a < 2; ++a)
#pragma unroll
        for (int b = 0; b < 2; ++b)
#pragma unroll
            for (int m = 0; m < 4; ++m)
#pragma unroll
                for (int n = 0; n < 2; ++n) acc[a][b][m][n] = (f32x4){0.f, 0.f, 0.f, 0.f};
    bf16x8 At[4][2], B0[2][2], B1[2][2];
    const char* cA = (const char*)g.A + (size_t)cur.pm * tstepA; const char* cB = (const char*)g.Bt + (size_t)cur.pn * tstepB;
    S.a_ready(cur);
    if constexpr (SP2) {
        PG8_STAGE(PG8_SB(0, 0), cB, voffB); PG8_STAGE(PG8_SB(0, 1), cB + hstepB, voffB); PG8_STAGE(PG8_SA(0, 0), cA, voffA); PG8_STAGE(PG8_SA(0, 1), cA + hstepA, voffA);
        if (wr == 1) PG8_BAR;
        PG8_WAIT_V(2); PG8_BAR;
        PG8_STAGE(PG8_SB(1, 0), cB + kstep, voffB); PG8_STAGE(PG8_SA(1, 0), cA + kstep, voffA); PG8_STAGE(PG8_SB(1, 1), cB + hstepB + kstep, voffB);
        PG8_WAIT_V(6); PG8_BAR;
    } else {
        PG8_STAGE(PG8_SB(0, 0), cB, voffB); PG8_STAGE(PG8_SA(0, 0), cA, voffA); PG8_STAGE(PG8_SB(0, 1), cB + hstepB, voffB); PG8_STAGE(PG8_SA(0, 1), cA + hstepA, voffA);
        if (wr == 1) PG8_BAR;
        PG8_WAIT_V(4); PG8_BAR;
        PG8_STAGE(PG8_SB(1, 0), cB + kstep, voffB); PG8_STAGE(PG8_SA(1, 0), cA + kstep, voffA); PG8_STAGE(PG8_SB(1, 1), cB + hstepB + kstep, voffB);
        PG8_WAIT_V(6); PG8_BAR;
    }
    for (;;) {
        const bool has_next = S.next(ui + 1, nxt);
        const char* nA = has_next ? (const char*)g.A + (size_t)nxt.pm * tstepA : cA; const char* nB = has_next ? (const char*)g.Bt + (size_t)nxt.pn * tstepB : cB;
#pragma unroll 1
        for (int t = 0; t < nt; t += 2) {
            const bool last = (t == nt - 2);
            const char* a1 = cA + (size_t)(t + 1) * kstep;
            const char* a2 = last ? nA : cA + (size_t)(t + 2) * kstep; const char* b2 = last ? nB : cB + (size_t)(t + 2) * kstep;
            const char* a3 = a2 + kstep; const char* b3 = b2 + kstep;
            if (last && has_next) S.a_ready(nxt);
            if constexpr (SP2) {
            PG8_LDB(B0, 0, 0); PG8_LDB(B1, 0, 1); PG8_SCHED; PG8_LDA(At, 0, 0); PG8_STAGE(PG8_SA(1, 1), a1 + hstepA, voffA);
            PG8_WAIT_V(8); PG8_WAIT_L(0); PG8_BAR; PG8_MMA(0, 0, At, B0); PG8_MMA(0, 1, At, B1); PG8_BAR; PG8_SCHED;
            PG8_LDA(At, 0, 1); PG8_STAGE(PG8_SB(0, 0), b2, voffB); PG8_STAGE(PG8_SB(0, 1), b2 + hstepB, voffB); PG8_STAGE(PG8_SA(0, 0), a2, voffA);
            PG8_WAIT_V(8); PG8_WAIT_L(0); PG8_BAR; PG8_MMA(1, 0, At, B0); PG8_MMA(1, 1, At, B1); PG8_BAR; PG8_SCHED;
            PG8_LDB(B0, 1, 0); PG8_LDB(B1, 1, 1); PG8_SCHED; PG8_LDA(At, 1, 0); PG8_STAGE(PG8_SA(0, 1), a2 + hstepA, voffA);
            PG8_WAIT_V(8); PG8_WAIT_L(0); PG8_BAR; PG8_MMA(0, 0, At, B0); PG8_MMA(0, 1, At, B1); PG8_BAR; PG8_SCHED;
            PG8_LDA(At, 1, 1); PG8_STAGE(PG8_SB(1, 0), b3, voffB); PG8_STAGE(PG8_SB(1, 1), b3 + hstepB, voffB); PG8_STAGE(PG8_SA(1, 0), a3, voffA);
            PG8_WAIT_V(8); PG8_WAIT_L(0); PG8_BAR; PG8_MMA(1, 0, At, B0); PG8_MMA(1, 1, At, B1); PG8_BAR; PG8_SCHED;
            } else {
            PG8_LDB(B0, 0, 0); PG8_SCHED; PG8_LDA(At, 0, 0); PG8_STAGE(PG8_SA(1, 1), a1 + hstepA, voffA);
            PG8_WAIT_L(8); PG8_BAR; PG8_WAIT_L(0); PG8_MMA(0, 0, At, B0); PG8_BAR; PG8_SCHED;
            PG8_LDB(B1, 0, 1); PG8_STAGE(PG8_SB(0, 0), b2, voffB);
            PG8_BAR; PG8_WAIT_L(0); PG8_MMA(0, 1, At, B1); PG8_BAR;
            PG8_LDA(At, 0, 1); PG8_STAGE(PG8_SA(0, 0), a2, voffA);
            PG8_BAR; PG8_WAIT_L(0); PG8_MMA(1, 0, At, B0); PG8_BAR; PG8_SCHED;
            PG8_STAGE(PG8_SB(0, 1), b2 + hstepB, voffB);
            PG8_WAIT_V(6); PG8_BAR; PG8_MMA(1, 1, At, B1); PG8_BAR;
            PG8_LDB(B0, 1, 0); PG8_SCHED; PG8_LDA(At, 1, 0); PG8_STAGE(PG8_SA(0, 1), a2 + hstepA, voffA);
            PG8_WAIT_L(8); PG8_BAR; PG8_WAIT_L(0); PG8_MMA(0, 0, At, B0); PG8_BAR; PG8_SCHED;
            PG8_LDB(B1, 1, 1); PG8_STAGE(PG8_SB(1, 0), b3, voffB);
            PG8_BAR; PG8_WAIT_L(0); PG8_MMA(0, 1, At, B1); PG8_BAR;
            PG8_LDA(At, 1, 1); PG8_STAGE(PG8_SA(1, 0), a3, voffA);
            PG8_BAR; PG8_WAIT_L(0); PG8_MMA(1, 0, At, B0); PG8_BAR; PG8_SCHED;
            PG8_STAGE(PG8_SB(1, 1), b3 + hstepB, voffB);
            PG8_WAIT_V(6); PG8_BAR; PG8_MMA(1, 1, At, B1); PG8_BAR;
            }
        }
        if constexpr (ALIGN_EPI) { if (wr == 0) PG8_BAR; }
        if constexpr (!Epi::AFTER_DRAIN) { E(acc, cur, wr, wc, fr, fq); S.done(cur); }
        if (!has_next) break;
#pragma unroll
        for (int a = 0; a < 2; ++a)
#pragma unroll
            for (int b = 0; b < 2; ++b)
#pragma unroll
                for (int m = 0; m < 4; ++m)
#pragma unroll
                    for (int n = 0; n < 2; ++n) acc[a][b][m][n] = (f32x4){0.f, 0.f, 0.f, 0.f};
        cur = nxt; cA = nA; cB = nB; ++ui;
        if constexpr (ALIGN_EPI) { if (wr == 1) PG8_BAR; }
    }
    PG8_WAIT_V(0);
    if constexpr (!ALIGN_EPI) { if (wr == 0) PG8_BAR; }
    PG8_BAR;
    if constexpr (Epi::AFTER_DRAIN) { E.fused(acc, cur, wr, wc, fr, fq, lds, wid, lane); S.done(cur); }
#undef PG8_SA
#undef PG8_SB
#undef PG8_STAGE
#undef PG8_LDA
#undef PG8_LDB
#undef PG8_MMA
#undef PG8_WAIT_V
#undef PG8_WAIT_L
#undef PG8_BAR
#undef PG8_SCHED
}
}
namespace att {
#define ATT_LAS __attribute__((address_space(3)))
typedef unsigned short bf16;
typedef short bf16x8 __attribute__((ext_vector_type(8)));
typedef short s16x4 __attribute__((ext_vector_type(4)));
typedef float f32x16 __attribute__((ext_vector_type(16)));
typedef float f32x4_t __attribute__((ext_vector_type(4)));
typedef unsigned u32x4 __attribute__((ext_vector_type(4)));
typedef unsigned u32x2 __attribute__((ext_vector_type(2)));
typedef float f32x2_t __attribute__((ext_vector_type(2))); typedef __bf16 bf16x2_t __attribute__((ext_vector_type(2)));
__device__ __forceinline__ unsigned cvtpk(float lo, float hi) { f32x2_t v = {lo, hi}; bf16x2_t b = __builtin_convertvector(v, bf16x2_t); return __builtin_bit_cast(unsigned, b); }
__device__ __forceinline__ s16x4 vtr(const ATT_LAS unsigned char* p) { return __builtin_bit_cast(s16x4, __builtin_amdgcn_ds_read_tr16_b64_v4i16((ATT_LAS s16x4*)p)); }
constexpr int VSTR = 192;
template <int DQK> struct Geo { static constexpr int KSTR = DQK * 2 + 16, KBUF = 64 * KSTR, VBUF = 64 * VSTR, CPR = DQK / 8, NKC = 64 * CPR, KIT = (NKC + 511) / 512; };
template <int DQK> constexpr int lds_bytes() { return 3 * Geo<DQK>::KBUF + 3 * Geo<DQK>::VBUF + 2048 + 8192; }

__device__ __forceinline__ float xhalf_sum(float m) { return xor32_sum(m); }
__device__ __forceinline__ float max3f(float a, float b, float c) { float r; asm("v_max3_f32 %0, %1, %2, %3" : "=v"(r) : "v"(a), "v"(b), "v"(c)); return r; }
__device__ __forceinline__ float max2f(float a, float b) { float r; asm("v_max_f32_e32 %0, %1, %2" : "=v"(r) : "v"(a), "v"(b)); return r; }
__device__ __forceinline__ float rowmax32(const f32x16& p0, const f32x16& p1) {
    float a = max2f(p0[0], p1[0]), b = max2f(p0[1], p1[1]), c = max2f(p0[2], p1[2]), d = max2f(p0[3], p1[3]);
#pragma unroll
    for (int r = 4; r < 16; r += 4) { a = max3f(a, p0[r], p1[r]); b = max3f(b, p0[r + 1], p1[r + 1]); c = max3f(c, p0[r + 2], p1[r + 2]); d = max3f(d, p0[r + 3], p1[r + 3]); }
    const float m = max2f(max2f(a, b), max2f(c, d));
    float lo_, hi_; halves32(m, lo_, hi_);
    return max2f(lo_, hi_);
}

template <int DQK, int kpitch, int vpitch, int NS>
__device__ __forceinline__ void attn_init(ATT_LAS unsigned char* lds, const int wave_idx) {
    typedef Geo<DQK> G;
    const int lane = lane_id_(), wid = wave_idx;
    constexpr int KCPL = G::KSTR / 16, KNP = (64 * KCPL + 63) / 64, VCPL = VSTR / 16, VNP = 64 * VCPL / 64, KPP = (KNP + 7) / 8, VPP = (VNP + 7) / 8;
    ATT_LAS unsigned* dmaL = (ATT_LAS unsigned*)(lds + NS * G::KBUF + NS * G::VBUF + 2048) + wid * 256 + lane;
#pragma unroll
    for (int pp = 0; pp < KPP; ++pp) { const int pc = wid + 8 * pp, c = pc * 64 + lane, row = (c / KCPL) & 63, ch = c % KCPL; dmaL[64 * pp] = (unsigned)(row * kpitch + (ch < G::CPR ? ch : 0) * 8) * 2u; }
#pragma unroll
    for (int pp = 0; pp < VPP; ++pp) { const int pc = wid + 8 * pp, c = pc * 64 + lane, row = (c / VCPL) & 63, ch = c % VCPL; dmaL[128 + 64 * pp] = (unsigned)(row * vpitch + (ch < 8 ? ch : 0) * 8) * 2u; }
}

template <int DQK, bool BAND, int qpitch, int kpitch, int vpitch, int opitch, bool OF8 = false, bool NOMAX = false, int NS = 2, int DBG = 0>
__device__ __forceinline__ void attn_unit(ATT_LAS unsigned char* lds, const bf16* Qb, const bf16* Kb, const bf16* Vb, bf16* Ob,
                                          int q0, int t_lo, int t_hi, int my_lo, int my_hi, int cc, const float* bias_g, const float* g_qn, const float* rope, const int wave_idx, const bool load_bias,
                                          bf16x8 (&qf)[DQK / 16], const bool q_loaded, const bool has_next, const bf16* Qn, const int t_max, const int kofs) {
    typedef Geo<DQK> G;
    int tid_ = wave_idx * 64 + lane_id_(); asm volatile("" : "+v"(tid_));
    const int tid = tid_, lane = tid & 63, r32 = lane & 31, hi = lane >> 5, wid = __builtin_amdgcn_readfirstlane(tid >> 6);
    ATT_LAS float* biasL = (ATT_LAS float*)(lds + NS * G::KBUF + NS * G::VBUF);
    constexpr int KCPL = G::KSTR / 16, KNP = (64 * KCPL + 63) / 64;
    constexpr int VCPL = VSTR / 16, VNP = 64 * VCPL / 64;
    constexpr int KPP = (KNP + 7) / 8, VPP = (VNP + 7) / 8;
    ATT_LAS unsigned* dmaL = (ATT_LAS unsigned*)(lds + NS * G::KBUF + NS * G::VBUF + 2048) + wid * 256 + lane;
    const unsigned ldsb = __builtin_amdgcn_readfirstlane((unsigned)(size_t)lds);
    const int kc = (KNP - 1 - wid) / 8 + 1, vc = (VNP - 1 - wid) / 8 + 1;
#define ATT_MOD3(x) (NS == 5 ? (x) - 5 * (((x) * 52) >> 8) : NS == 3 ? (x) - 3 * (((x) * 43) >> 7) : ((x) & 1))
#define ATT_DMA1(gptr, voff_, ldsaddr) do { unsigned keep_; asm volatile("s_mov_b32 %0, m0\n\ts_mov_b32 m0, %3\n\ts_nop 0\n\tglobal_load_lds_dwordx4 %1, %2\n\ts_mov_b32 m0, %0" \
            : "=&s"(keep_) : "v"(voff_), "s"(gptr), "s"(ldsaddr) : "memory"); } while (0)
#define ATT_DMA_K(t) do { const int t_ = (t); const char* kt_ = (const char*)(Kb + (size_t)t_ * 64 * kpitch); const unsigned d_ = ldsb + ATT_MOD3(t_) * G::KBUF + wid * 1024; \
        _Pragma("unroll") for (int pp = 0; pp < KPP; ++pp) { if (wid + 8 * pp < KNP) { const unsigned vo_ = dmaL[64 * pp]; ATT_DMA1(kt_, vo_, d_ + pp * 8192); } } } while (0)
#define ATT_DMA_V(t) do { const int t_ = (t); const char* vt_ = (const char*)(Vb + (size_t)t_ * 64 * vpitch); const unsigned d_ = ldsb + NS * G::KBUF + ATT_MOD3(t_) * G::VBUF + wid * 1024; \
        _Pragma("unroll") for (int pp = 0; pp < VPP; ++pp) { if (wid + 8 * pp < VNP) { const unsigned vo_ = dmaL[128 + 64 * pp]; ATT_DMA1(vt_, vo_, d_ + pp * 8192); } } } while (0)
#define ATT_WAITBAR(n) do { const int n_ = (n); \
        if (n_ == 0) asm volatile("s_waitcnt vmcnt(0) lgkmcnt(0)\n\ts_barrier" ::: "memory"); else if (n_ == 1) asm volatile("s_waitcnt vmcnt(1) lgkmcnt(0)\n\ts_barrier" ::: "memory"); \
        else if (n_ == 2) asm volatile("s_waitcnt vmcnt(2) lgkmcnt(0)\n\ts_barrier" ::: "memory"); else if (n_ == 3) asm volatile("s_waitcnt vmcnt(3) lgkmcnt(0)\n\ts_barrier" ::: "memory"); \
        else if (n_ == 4) asm volatile("s_waitcnt vmcnt(4) lgkmcnt(0)\n\ts_barrier" ::: "memory"); else if (n_ == 5) asm volatile("s_waitcnt vmcnt(5) lgkmcnt(0)\n\ts_barrier" ::: "memory"); \
        else asm volatile("s_waitcnt vmcnt(6) lgkmcnt(0)\n\ts_barrier" ::: "memory"); } while (0)
#pragma unroll
    for (int j = 0; j < NS; ++j) { if (t_lo + j >= 0 && t_lo + j <= t_max) ATT_DMA_K(t_lo + j); if (j < NS - 1) { if (t_lo + j >= 0 && t_lo + j <= t_max) ATT_DMA_V(t_lo + j); } }
    if (BAND) { if (load_bias && tid < 257) biasL[tid] = bias_g[tid] * 1.4426950408889634f; }
    if (!q_loaded) { const bf16* qp = Qb + (size_t)(q0 + wid * 32 + r32) * qpitch + 8 * hi;
#pragma unroll
      for (int kk = 0; kk < DQK / 16; ++kk) { if constexpr (DBG & 8) qf[kk] = (bf16x8){(short)lane, 1, 2, 3, 4, 5, 6, 7}; else qf[kk] = *(const bf16x8*)(qp + 16 * kk); } }
    if constexpr (!BAND) {
        float qv[DQK / 16][8]; float ss = 0.f;
#pragma unroll
        for (int kk = 0; kk < DQK / 16; ++kk)
#pragma unroll
            for (int j = 0; j < 8; ++j) { qv[kk][j] = __builtin_bit_cast(float, (unsigned)(unsigned short)qf[kk][j] << 16); ss += qv[kk][j] * qv[kk][j]; }
        ss = xhalf_sum(ss);
        const float rs = __builtin_amdgcn_rsqf(ss * (1.f / DQK) + 1e-6f) * (0.10206207261596577f * 1.4426950408889634f);
#pragma unroll
        for (int kk = 0; kk < DQK / 16; ++kk) { const f32x4_t g0 = *(const f32x4_t*)(g_qn + 16 * kk + 8 * hi), g1 = *(const f32x4_t*)(g_qn + 16 * kk + 8 * hi + 4);
#pragma unroll
            for (int j = 0; j < 4; ++j) { qv[kk][j] *= rs * g0[j]; qv[kk][4 + j] *= rs * g1[j]; } }
        const f32x4_t* rp = (const f32x4_t*)(rope + ((size_t)(q0 + wid * 32 + r32) * 16 + 8 * hi) * 2);
#pragma unroll
        for (int j2 = 0; j2 < 4; ++j2) { const f32x4_t cs = rp[j2];
            { const float x1 = qv[4][2 * j2], x2 = qv[5][2 * j2]; qv[4][2 * j2] = x1 * cs[0] - x2 * cs[1]; qv[5][2 * j2] = x2 * cs[0] + x1 * cs[1]; }
            { const float x1 = qv[4][2 * j2 + 1], x2 = qv[5][2 * j2 + 1]; qv[4][2 * j2 + 1] = x1 * cs[2] - x2 * cs[3]; qv[5][2 * j2 + 1] = x2 * cs[2] + x1 * cs[3]; } }
#pragma unroll
        for (int kk = 0; kk < DQK / 16; ++kk) { u32x4 w; w.x = cvtpk(qv[kk][0], qv[kk][1]); w.y = cvtpk(qv[kk][2], qv[kk][3]); w.z = cvtpk(qv[kk][4], qv[kk][5]); w.w = cvtpk(qv[kk][6], qv[kk][7]);
            qf[kk] = __builtin_bit_cast(bf16x8, w); }
    }
    f32x16 o0, o1;
#pragma unroll
    for (int i = 0; i < 16; ++i) { o0[i] = 0.f; o1[i] = 0.f; }
    float mrun = -INFINITY, lsum = 0.f; float ls4[4] = {0.f, 0.f, 0.f, 0.f};
    const int koff = r32 * G::KSTR + hi * 16;
    const int voff = ((lane >> 5) * 4 + ((lane & 15) >> 2)) * VSTR + (((lane >> 4) & 1) * 16 + (lane & 3) * 4) * 2;
    const f32x16 zero16 = {0.f, 0.f, 0.f, 0.f, 0.f, 0.f, 0.f, 0.f, 0.f, 0.f, 0.f, 0.f, 0.f, 0.f, 0.f, 0.f};
#define ATT_QK(X0, X1, t) do { const ATT_LAS unsigned char* Kt = lds + ATT_MOD3((t) + kofs) * G::KBUF + koff; \
        _Pragma("unroll") for (int kk = 0; kk < DQK / 16; ++kk) { \
            const bf16x8 a0 = *(const ATT_LAS bf16x8*)(Kt + kk * 32); const bf16x8 a1 = *(const ATT_LAS bf16x8*)(Kt + 32 * G::KSTR + kk * 32); \
            X0 = __builtin_amdgcn_mfma_f32_32x32x16_bf16(a0, qf[kk], kk ? X0 : zero16, 0, 0, 0); X1 = __builtin_amdgcn_mfma_f32_32x32x16_bf16(a1, qf[kk], kk ? X1 : zero16, 0, 0, 0); } } while (0)
#define ATT_FARSCALE() do { const float f_ = __builtin_amdgcn_exp2f(biasL[256]); _Pragma("unroll") for (int i = 0; i < 16; ++i) { o0[i] *= f_; o1[i] *= f_; } \
        ls4[0] *= f_; ls4[1] *= f_; ls4[2] *= f_; ls4[3] *= f_; } while (0)
#define ATT_SMPV(X0, X1, t) do { \
        float cadd = 0.f; \
        if (BAND && !(DBG & 2)) { const int delta = cc - ((t) + kofs); \
            if (delta >= 3) { if constexpr (!NOMAX) cadd = biasL[256]; } \
            else { const ATT_LAS float* bp = biasL + (64 * delta + (32 * (wid & 1) + r32) - 4 * hi + 128 - 63); \
                if (delta < 2) { _Pragma("unroll") for (int i = 0; i < 16; ++i) { const int kj = (i & 3) + 8 * (i >> 2); X0[i] += bp[63 - kj]; X1[i] += bp[31 - kj]; } } \
                else { const int relb = 64 * delta + (32 * (wid & 1) + r32) - 4 * hi + 128; \
                    _Pragma("unroll") for (int i = 0; i < 16; ++i) { const int kj = (i & 3) + 8 * (i >> 2); int i0 = relb - kj, i1 = relb - kj - 32; i0 = i0 > 256 ? 256 : i0; i1 = i1 > 256 ? 256 : i1; \
                        X0[i] += biasL[i0]; X1[i] += biasL[i1]; } } } } \
        if constexpr (NOMAX) { \
            _Pragma("unroll") for (int i = 0; i < 16; ++i) { X0[i] = __builtin_amdgcn_exp2f(X0[i]); X1[i] = __builtin_amdgcn_exp2f(X1[i]); ls4[i & 3] += X0[i] + X1[i]; } \
        } else { \
        const float mt = rowmax32(X0, X1) + cadd; \
        const float mnew = max2f(mrun, mt); \
        const float alpha = __builtin_amdgcn_exp2f(mrun - mnew); \
        const float msub = mnew - cadd; \
        mrun = mnew; \
        float psa[4] = {0.f, 0.f, 0.f, 0.f};   \
        _Pragma("unroll") for (int i = 0; i < 16; ++i) { X0[i] = __builtin_amdgcn_exp2f(X0[i] - msub); X1[i] = __builtin_amdgcn_exp2f(X1[i] - msub); psa[i & 3] += X0[i] + X1[i]; } \
        const float ps = (psa[0] + psa[1]) + (psa[2] + psa[3]); \
        lsum = lsum * alpha + ps; \
        _Pragma("unroll") for (int i = 0; i < 16; ++i) { o0[i] *= alpha; o1[i] *= alpha; } } \
        bf16x8 pf[2][2]; \
        _Pragma("unroll") for (int s = 0; s < 2; ++s) { u32x4 w0, w1; \
            w0.x = cvtpk(X0[8 * s + 0], X0[8 * s + 1]); w0.y = cvtpk(X0[8 * s + 2], X0[8 * s + 3]); w0.z = cvtpk(X0[8 * s + 4], X0[8 * s + 5]); w0.w = cvtpk(X0[8 * s + 6], X0[8 * s + 7]); \
            w1.x = cvtpk(X1[8 * s + 0], X1[8 * s + 1]); w1.y = cvtpk(X1[8 * s + 2], X1[8 * s + 3]); w1.z = cvtpk(X1[8 * s + 4], X1[8 * s + 5]); w1.w = cvtpk(X1[8 * s + 6], X1[8 * s + 7]); \
            pf[0][s] = __builtin_bit_cast(bf16x8, w0); pf[1][s] = __builtin_bit_cast(bf16x8, w1); } \
        const ATT_LAS unsigned char* Vt = lds + NS * G::KBUF + ATT_MOD3((t) + kofs) * G::VBUF + voff; \
        _Pragma("unroll") for (int kb = 0; kb < 2; ++kb) _Pragma("unroll") for (int s = 0; s < 2; ++s) { \
            const ATT_LAS unsigned char* vp = Vt + (32 * kb + 16 * s) * VSTR; \
            const s16x4 l0 = vtr(vp), h0 = vtr(vp + 8 * VSTR), l1 = vtr(vp + 64), h1 = vtr(vp + 8 * VSTR + 64); \
            const bf16x8 a0 = (bf16x8){l0[0], l0[1], l0[2], l0[3], h0[0], h0[1], h0[2], h0[3]}; \
            const bf16x8 a1 = (bf16x8){l1[0], l1[1], l1[2], l1[3], h1[0], h1[1], h1[2], h1[3]}; \
            o0 = __builtin_amdgcn_mfma_f32_32x32x16_bf16(a0, pf[kb][s], o0, 0, 0, 0); o1 = __builtin_amdgcn_mfma_f32_32x32x16_bf16(a1, pf[kb][s], o1, 0, 0, 0); } \
        if constexpr (NOMAX && BAND) { if (cc - ((t) + kofs) == 3) ATT_FARSCALE(); } } while (0)
#define ATT_FUSED(C0, C1, N0, N1, t, tn) do { \
        bf16x8 kfa[DQK / 16], kfb[DQK / 16]; \
        { const ATT_LAS unsigned char* Kt = lds + ATT_MOD3((tn) + kofs) * G::KBUF + koff; \
          _Pragma("unroll") for (int kk = 0; kk < DQK / 16; ++kk) { kfa[kk] = *(const ATT_LAS bf16x8*)(Kt + kk * 32); kfb[kk] = *(const ATT_LAS bf16x8*)(Kt + 32 * G::KSTR + kk * 32); } } \
        if constexpr (!NOMAX) __builtin_amdgcn_sched_barrier(0); \
        float cadd = 0.f; \
        if (BAND && !(DBG & 2)) { const int delta = cc - ((t) + kofs); \
            if (delta >= 3) { if constexpr (!NOMAX) cadd = biasL[256]; } \
            else { const ATT_LAS float* bp = biasL + (64 * delta + (32 * (wid & 1) + r32) - 4 * hi + 128 - 63); \
                if (delta < 2) { _Pragma("unroll") for (int i = 0; i < 16; ++i) { const int kj = (i & 3) + 8 * (i >> 2); C0[i] += bp[63 - kj]; C1[i] += bp[31 - kj]; } } \
                else { const int relb = 64 * delta + (32 * (wid & 1) + r32) - 4 * hi + 128; \
                    _Pragma("unroll") for (int i = 0; i < 16; ++i) { const int kj = (i & 3) + 8 * (i >> 2); int i0 = relb - kj, i1 = relb - kj - 32; i0 = i0 > 256 ? 256 : i0; i1 = i1 > 256 ? 256 : i1; \
                        C0[i] += biasL[i0]; C1[i] += biasL[i1]; } } } } \
        float alpha = 1.f, msub = 0.f; \
        if constexpr (!NOMAX) { \
        const float mt = rowmax32(C0, C1) + cadd; \
        const float mnew = max2f(mrun, mt); \
        alpha = __builtin_amdgcn_exp2f(mrun - mnew); \
        msub = mnew - cadd; \
        if (__builtin_amdgcn_ballot_w64(mnew > mrun)) { _Pragma("unroll") for (int i = 0; i < 16; ++i) { o0[i] *= alpha; o1[i] *= alpha; } } \
        mrun = mnew; } \
        if constexpr (!NOMAX || BAND) __builtin_amdgcn_sched_barrier(0); \
        _Pragma("unroll") for (int kk = 0; kk < DQK / 16; ++kk) { \
            N0 = __builtin_amdgcn_mfma_f32_32x32x16_bf16(kfa[kk], qf[kk], kk ? N0 : zero16, 0, 0, 0); N1 = __builtin_amdgcn_mfma_f32_32x32x16_bf16(kfb[kk], qf[kk], kk ? N1 : zero16, 0, 0, 0); } \
        s16x4 vl0[4], vh0[4], vl1[4], vh1[4]; \
        { const ATT_LAS unsigned char* Vt = lds + NS * G::KBUF + ATT_MOD3((t) + kofs) * G::VBUF + voff; \
          _Pragma("unroll") for (int ks = 0; ks < 4; ++ks) { const ATT_LAS unsigned char* vp = Vt + 16 * ks * VSTR; vl0[ks] = vtr(vp); vh0[ks] = vtr(vp + 8 * VSTR); vl1[ks] = vtr(vp + 64); vh1[ks] = vtr(vp + 8 * VSTR + 64); } } \
        if constexpr (NOMAX) { \
            _Pragma("unroll") for (int i = 0; i < 16; ++i) { C0[i] = __builtin_amdgcn_exp2f(C0[i]); C1[i] = __builtin_amdgcn_exp2f(C1[i]); ls4[i & 3] += C0[i] + C1[i]; } \
        } else { \
        float psa[4] = {0.f, 0.f, 0.f, 0.f}; \
        _Pragma("unroll") for (int i = 0; i < 16; ++i) { C0[i] = __builtin_amdgcn_exp2f(C0[i] - msub); C1[i] = __builtin_amdgcn_exp2f(C1[i] - msub); psa[i & 3] += C0[i] + C1[i]; } \
        const float ps = (psa[0] + psa[1]) + (psa[2] + psa[3]); \
        lsum = lsum * alpha + ps; } \
        bf16x8 pf[4]; \
        _Pragma("unroll") for (int s = 0; s < 2; ++s) { u32x4 w0, w1; \
            w0.x = cvtpk(C0[8 * s + 0], C0[8 * s + 1]); w0.y = cvtpk(C0[8 * s + 2], C0[8 * s + 3]); w0.z = cvtpk(C0[8 * s + 4], C0[8 * s + 5]); w0.w = cvtpk(C0[8 * s + 6], C0[8 * s + 7]); \
            w1.x = cvtpk(C1[8 * s + 0], C1[8 * s + 1]); w1.y = cvtpk(C1[8 * s + 2], C1[8 * s + 3]); w1.z = cvtpk(C1[8 * s + 4], C1[8 * s + 5]); w1.w = cvtpk(C1[8 * s + 6], C1[8 * s + 7]); \
            pf[s] = __builtin_bit_cast(bf16x8, w0); pf[2 + s] = __builtin_bit_cast(bf16x8, w1); } \
        __builtin_amdgcn_sched_barrier(0); \
        _Pragma("unroll") for (int ks = 0; ks < 4; ++ks) { \
            const bf16x8 a0 = (bf16x8){vl0[ks][0], vl0[ks][1], vl0[ks][2], vl0[ks][3], vh0[ks][0], vh0[ks][1], vh0[ks][2], vh0[ks][3]}; \
            const bf16x8 a1 = (bf16x8){vl1[ks][0], vl1[ks][1], vl1[ks][2], vl1[ks][3], vh1[ks][0], vh1[ks][1], vh1[ks][2], vh1[ks][3]}; \
            o0 = __builtin_amdgcn_mfma_f32_32x32x16_bf16(a0, pf[ks], o0, 0, 0, 0); o1 = __builtin_amdgcn_mfma_f32_32x32x16_bf16(a1, pf[ks], o1, 0, 0, 0); } \
        if constexpr (NOMAX && BAND) { if (cc - ((t) + kofs) == 3) ATT_FARSCALE(); } } while (0)
#define ATT_STAGE(t) do { if ((t) + NS <= t_max) ATT_DMA_K((t) + NS); if ((t) + NS - 1 <= t_max) ATT_DMA_V((t) + NS - 1); } while (0)
#define ATT_STAGE_T(t) do { ATT_STAGE(t); \
        if ((t) == t_hi && has_next) { const bf16* qp_ = Qn + (size_t)(wid * 32 + r32) * qpitch + 8 * hi; _Pragma("unroll") for (int kk = 0; kk < DQK / 16; ++kk) qf[kk] = *(const bf16x8*)(qp_ + 16 * kk); } } while (0)
#define ATT_NFL(t) ((NS == 3 ? ((t) + 3 <= t_max ? kc : 0) + ((t) + 2 <= t_max ? vc : 0) : 0) + (((t) == t_hi && has_next) ? DQK / 16 : 0))
    f32x16 sa0, sa1, sb0, sb1;
    ATT_WAITBAR(0);
    if (my_lo == t_lo) ATT_QK(sa0, sa1, t_lo);
    ATT_WAITBAR(0);
    {
        int t = t_lo;
        for (; t < my_lo - 1; ++t) { ATT_STAGE(t); ATT_WAITBAR(ATT_NFL(t)); }
        if (my_lo > t_lo) { ATT_STAGE(t); ATT_QK(sa0, sa1, t + 1); ATT_WAITBAR(ATT_NFL(t)); ++t; }
        int nf = my_hi - my_lo;
        for (; nf >= 2; nf -= 2, t += 2) {
            ATT_STAGE(t); ATT_FUSED(sa0, sa1, sb0, sb1, t, t + 1); ATT_WAITBAR(ATT_NFL(t));
            ATT_STAGE(t + 1); ATT_FUSED(sb0, sb1, sa0, sa1, t + 1, t + 2); ATT_WAITBAR(ATT_NFL(t + 1));
        }
        if (nf == 1) {
            ATT_STAGE(t); ATT_FUSED(sa0, sa1, sb0, sb1, t, t + 1); ATT_WAITBAR(ATT_NFL(t)); ++t;
            ATT_STAGE_T(t); ATT_SMPV(sb0, sb1, t); ATT_WAITBAR(ATT_NFL(t)); ++t;
        } else {
            ATT_STAGE_T(t); ATT_SMPV(sa0, sa1, t); ATT_WAITBAR(ATT_NFL(t)); ++t;
        }
        for (; t <= t_hi; ++t) { ATT_STAGE_T(t); ATT_WAITBAR(ATT_NFL(t)); }
    }
    if constexpr (NOMAX) lsum = (ls4[0] + ls4[1]) + (ls4[2] + ls4[3]);
    const float ltot = xhalf_sum(lsum);
    const float inv = 1.f / ltot;
    if constexpr (DBG & 4) { if (ltot == 12345.678f) *(float*)Ob = o0[0] + o1[0]; } else
    if constexpr (OF8) {
        const float i64 = inv * 32.f;
        int w0[4], w1[4];
#pragma unroll
        for (int g4 = 0; g4 < 4; ++g4) { w0[g4] = 0; w1[g4] = 0;
            w0[g4] = __builtin_amdgcn_cvt_pk_fp8_f32(o0[4 * g4 + 0] * i64, o0[4 * g4 + 1] * i64, w0[g4], false); w0[g4] = __builtin_amdgcn_cvt_pk_fp8_f32(o0[4 * g4 + 2] * i64, o0[4 * g4 + 3] * i64, w0[g4], true);
            w1[g4] = __builtin_amdgcn_cvt_pk_fp8_f32(o1[4 * g4 + 0] * i64, o1[4 * g4 + 1] * i64, w1[g4], false); w1[g4] = __builtin_amdgcn_cvt_pk_fp8_f32(o1[4 * g4 + 2] * i64, o1[4 * g4 + 3] * i64, w1[g4], true); }
        asm volatile("s_nop 1\n\tv_permlane32_swap_b32 %0, %1\n\tv_permlane32_swap_b32 %2, %3\n\tv_permlane32_swap_b32 %4, %5\n\tv_permlane32_swap_b32 %6, %7\n\ts_nop 1"
                     : "+v"(w0[2]), "+v"(w0[0]), "+v"(w0[3]), "+v"(w0[1]), "+v"(w1[2]), "+v"(w1[0]), "+v"(w1[3]), "+v"(w1[1]));
        unsigned char* op = (unsigned char*)Ob + (size_t)(q0 + wid * 32 + r32) * opitch + (hi ? 0 : 16);
        *(u32x4*)op = (u32x4){(unsigned)w0[2], (unsigned)w0[0], (unsigned)w0[3], (unsigned)w0[1]};
        *(u32x4*)(op + 32) = (u32x4){(unsigned)w1[2], (unsigned)w1[0], (unsigned)w1[3], (unsigned)w1[1]};
    } else {
    bf16* op = Ob + (size_t)(q0 + wid * 32 + r32) * opitch + 4 * hi;
#pragma unroll
    for (int g4 = 0; g4 < 4; ++g4) {
        u32x2 w0, w1;
        w0.x = cvtpk(o0[4 * g4 + 0] * inv, o0[4 * g4 + 1] * inv); w0.y = cvtpk(o0[4 * g4 + 2] * inv, o0[4 * g4 + 3] * inv);
        w1.x = cvtpk(o1[4 * g4 + 0] * inv, o1[4 * g4 + 1] * inv); w1.y = cvtpk(o1[4 * g4 + 2] * inv, o1[4 * g4 + 3] * inv);
        *(u32x2*)(op + 8 * g4) = w0; *(u32x2*)(op + 32 + 8 * g4) = w1;
    }
    }
#undef ATT_DMA_K
#undef ATT_DMA_V
#undef ATT_QK
#undef ATT_SMPV
#undef ATT_STAGE
#undef ATT_STAGE_T
#undef ATT_FUSED
#undef ATT_MOD3
#undef ATT_DMA1
#undef ATT_WAITBAR
#undef ATT_NFL
#undef ATT_FARSCALE
}
}
constexpr int NWAVES = 8;
constexpr int D = 1024, BATCH = 32, SEQ = 2048, M = BATCH * SEQ;
constexpr int NH = 16, QLORA = 384, KVLORA = 256, ROPE_D = 32, NOPE = 64, QKD = 96;
constexpr int NA = 768;
constexpr int FF = 2816, EFF = 3584, NE = 8;
constexpr float EPS = 1e-6f, LOG2E = 1.4426950408889634f;
constexpr int MAXP_HALF = 264, MAXP = 528;
constexpr size_t MiB = 1u << 20;
constexpr size_t WS_CTL = 0, CTL_ZERO_BYTES = 1 * MiB;
constexpr size_t WS_ROPE = 1 * MiB;
constexpr size_t WS_CNT = WS_ROPE + 256 * 1024;
constexpr size_t WS_PANELE = WS_CNT + 16 * 1024;
constexpr size_t WS_META = WS_PANELE + 4096;
constexpr size_t WS_TOKE = 2 * MiB;
constexpr size_t WS_TOKG = WS_TOKE + (size_t)M * 4;
constexpr size_t WS_SLOTTOK = WS_TOKG + (size_t)M * 8;
constexpr size_t WS_SLOTGATE = WS_SLOTTOK + (size_t)MAXP * 256 * 4;
constexpr size_t WS_PARTQA = 976 * MiB, WS_PART1 = 980 * MiB, WS_PART2 = 984 * MiB;
constexpr size_t WS_TOKRSTD = 4 * MiB;
constexpr size_t WS_SLOTRSTD = WS_TOKRSTD + (size_t)M * 4;
static_assert(WS_SLOTGATE + (size_t)MAXP * 256 * 4 <= WS_TOKRSTD && WS_SLOTRSTD + (size_t)MAXP * 256 * 4 <= 8 * MiB, "small arrays");
constexpr size_t WS_W = 8 * MiB;
constexpr size_t WS_WA = WS_W, WS_WUQ = WS_WA + (size_t)NA * D * 2, WS_WUKV = WS_WUQ + (size_t)1536 * QLORA * 2, WS_WO = WS_WUKV + (size_t)2048 * KVLORA * 2;
constexpr size_t WS_WF1 = WS_WO + (size_t)D * D * 2, WS_WF2 = WS_WF1 + (size_t)2 * FF * D * 2, WS_WKVQ = WS_WF2 + (size_t)D * FF * 2, WS_WBO = WS_WKVQ + (size_t)3 * D * D * 2;
constexpr size_t WS_WM1 = WS_WBO + (size_t)D * D * 2, WS_WM2 = WS_WM1 + (size_t)NE * 2 * EFF * D * 2, WS_WEND = WS_WM2 + (size_t)NE * D * EFF * 2;
constexpr size_t ARENA = 208 * MiB;
static_assert(WS_WEND <= ARENA, "weights fit under the arena");
constexpr size_t WS_XN = ARENA;
constexpr size_t WS_QA = ARENA + 128 * MiB;
constexpr size_t WS_Q = ARENA + 224 * MiB;
constexpr size_t WS_K = ARENA + 416 * MiB;
constexpr size_t WS_V = ARENA + 608 * MiB;
constexpr size_t WS_O = ARENA;
static_assert(WS_V + (size_t)M * D * 2 <= 1024 * MiB, "MLA arena");
constexpr size_t WS_XR1 = ARENA + 128 * MiB;
constexpr size_t WS_H = ARENA + 256 * MiB;
constexpr size_t WS_XR2 = ARENA;
constexpr size_t WS_X2B = ARENA + 608 * MiB;
constexpr size_t WS_KVQ2 = ARENA + 128 * MiB;
constexpr size_t WS_O2 = ARENA + 512 * MiB;
constexpr size_t WS_XR3 = ARENA + 132 * MiB;
constexpr size_t WS_XG = ARENA;
constexpr size_t WS_HM = ARENA + 264 * MiB;
constexpr size_t WS_END = WS_HM + (size_t)MAXP_HALF * 256 * EFF * 2;
static_assert(WS_XG + (size_t)MAXP * 256 * D <= WS_XR3 && WS_XR3 + (size_t)M * D * 2 <= WS_HM && WS_END <= 1024 * MiB && WS_H + (size_t)M * FF * 2 <= WS_X2B && WS_X2B + (size_t)M * D * 2 <= 976 * MiB && WS_O2 + (size_t)M * D <= WS_X2B, "arena");
constexpr int CW_BAR = 4096;
constexpr int RING_OFF = 0, RING_BYTES = 131072;
constexpr int P0_SCR = 128 * 33 * 4;
constexpr int LDSCTL_OFF = 8 * P0_SCR, MISC_OFF = LDSCTL_OFF + 320;
static_assert(LDSCTL_OFF >= RING_BYTES, "control words above every phase's scratch");
constexpr int LDS_BYTES = 147456;
static_assert(MISC_OFF + 128 <= LDS_BYTES, "LDS map");
static_assert(att::lds_bytes<96>() <= RING_BYTES, "attention scratch fits the ring region");

#define GAS __attribute__((address_space(1)))
#define LAS __attribute__((address_space(3)))
typedef unsigned short bf16;
typedef unsigned v4u __attribute__((ext_vector_type(4)));
typedef unsigned v2u __attribute__((ext_vector_type(2)));
typedef float f32x4 __attribute__((ext_vector_type(4)));
typedef GAS unsigned gu32;
#define RLX_AGENT __ATOMIC_RELAXED, __HIP_MEMORY_SCOPE_AGENT
#define LDS_WAIT() asm volatile("s_waitcnt lgkmcnt(0)" ::: "memory")
__device__ __forceinline__ unsigned f2bf(float f) { unsigned u = __builtin_bit_cast(unsigned, f); return (u + 0x7fffu + ((u >> 16) & 1u)) >> 16; }
__device__ __forceinline__ unsigned pk2(float lo, float hi) { return f2bf(lo) | (f2bf(hi) << 16); }
__device__ __forceinline__ float bflo(unsigned u) { return __builtin_bit_cast(float, u << 16); }
__device__ __forceinline__ float bfhi(unsigned u) { return __builtin_bit_cast(float, u & 0xffff0000u); }
__device__ __forceinline__ float wave_sum(float v) {
    v += swz_xor<1>(v); v += swz_xor<2>(v); v += swz_xor<4>(v); v += swz_xor<8>(v); v += swz_xor<16>(v);
    return xor32_sum(v);
}
__device__ __forceinline__ float wave_maxf(float v) {
    v = fmaxf(v, swz_xor<1>(v)); v = fmaxf(v, swz_xor<2>(v)); v = fmaxf(v, swz_xor<4>(v)); v = fmaxf(v, swz_xor<8>(v)); v = fmaxf(v, swz_xor<16>(v));
    return xor32_max(v);
}

#define XB_TMO      128
#define XB_XCNT(j)  (256  + 64 * (j))
#define XB_XSUB(j)  (1280 + 64 * (j))
#define XB_XGEN(j)  (2304 + 64 * (j))
#define XB_TOP      3328
#define XB_TOPGEN   3392
#define XCD_BAR_WORDS 3456
#define XB_SPIN_CAP (1u << 18)

__device__ __forceinline__ unsigned xb_ld(unsigned* p)              { return __hip_atomic_load(p, __ATOMIC_RELAXED, __HIP_MEMORY_SCOPE_AGENT); }
__device__ __forceinline__ unsigned xb_add(unsigned* p, unsigned v) { return __hip_atomic_fetch_add(p, v, __ATOMIC_RELAXED, __HIP_MEMORY_SCOPE_AGENT); }
__device__ __forceinline__ unsigned xb_xcc_id() { return (unsigned)__builtin_amdgcn_s_getreg((3 << 11) | 20) & 0xFu; }
#define XB_SPIN(cond, bar) do { unsigned _sp = 0; while (cond) { __builtin_amdgcn_s_sleep(1); \
    if ((++_sp & 255u) == 0u) { if (xb_ld(&(bar)[XB_TMO])) break; if (_sp > XB_SPIN_CAP) { atomicAdd(&(bar)[XB_TMO], 1u); break; } } } } while (0)

struct XcdBarrier {
    int t0;
    unsigned* bar; unsigned x;
    volatile LAS unsigned* st;
};

__device__ __forceinline__ XcdBarrier xcd_barrier_post(unsigned* bar, volatile LAS unsigned* st, int t0) {
    XcdBarrier b; b.t0 = t0; b.bar = bar; b.x = xb_xcc_id(); b.st = st;
    if (b.t0) (void)xb_add(&bar[XB_XCNT(b.x)], 1u);
    return b;
}
__device__ __forceinline__ void xcd_barrier_complete(unsigned* bar, unsigned x, unsigned& nloc, unsigned& nx) {
    const unsigned G = gridDim.x * gridDim.y * gridDim.z;
    unsigned sum, cnt, mine, sp = 0u;
    for (;;) {
        sum = 0u; cnt = 0u; mine = 0u;
#pragma unroll
        for (unsigned j = 0; j < 16; ++j) { const unsigned c = xb_ld(&bar[XB_XCNT(j)]); sum += c; cnt += (c > 0u) ? 1u : 0u; mine = (j == x) ? c : mine; }
        if (sum == G) break;
        __builtin_amdgcn_s_sleep(1);
        if ((++sp & 255u) == 0u) { if (xb_ld(&bar[XB_TMO])) break; if (sp > XB_SPIN_CAP) { atomicAdd(&bar[XB_TMO], 1u); break; } }
    }
    nloc = mine > 0u ? mine : 1u; nx = cnt > 0u ? cnt : 1u;
}

__device__ __forceinline__ void xcd_barrier(const XcdBarrier& b) {
    asm volatile("s_waitcnt vmcnt(0)" ::: "memory");
    __syncthreads();
    if (b.t0) {
        unsigned* bar = b.bar;
        __builtin_amdgcn_s_waitcnt(0);
        unsigned nloc = b.st[0], nx = b.st[1];
        if (nloc == 0u) { xcd_barrier_complete(bar, b.x, nloc, nx); b.st[0] = nloc; b.st[1] = nx; }
        const unsigned old = xb_add(&bar[XB_XSUB(b.x)], 1u);
        const unsigned gen = old / nloc;
        if (old + 1u == (gen + 1u) * nloc) {
            __builtin_amdgcn_fence(__ATOMIC_RELEASE, "agent");
            asm volatile("s_waitcnt vmcnt(0)" ::: "memory");
            const unsigned og = xb_add(&bar[XB_TOP], 1u);
            const unsigned tg = og / nx;
            if (og + 1u == (tg + 1u) * nx) xb_add(&bar[XB_TOPGEN], 1u);
            else XB_SPIN(xb_ld(&bar[XB_TOPGEN]) == tg, bar);
            __builtin_amdgcn_fence(__ATOMIC_ACQUIRE, "agent");
            xb_add(&bar[XB_XGEN(b.x)], 1u);
            asm volatile("s_waitcnt vmcnt(0)" ::: "memory");
        } else {
            XB_SPIN(xb_ld(&bar[XB_XGEN(b.x)]) == gen, bar);
            __builtin_amdgcn_fence(__ATOMIC_ACQUIRE, "agent");
            asm volatile("s_waitcnt vmcnt(0)" ::: "memory");
        }
    }
    __syncthreads();
}

struct Args { const float* in[27]; float* out; unsigned char* ws; };
enum { I_X = 0, I_ATTN_NORM, I_FFN_NORM, I_A_WDQ, I_A_GCQ, I_A_WUQ, I_A_WDKV, I_A_GCKV, I_A_WUKV, I_A_GQN, I_A_GKN, I_A_WO, I_KV_NORM, I_KV_WK, I_KV_WV, I_KV_GKN,
       I_B_WQ, I_B_GQN, I_B_RELB, I_B_WO, I_FFN_W1, I_FFN_W3, I_FFN_W2, I_MOE_ROUTER, I_MOE_W1, I_MOE_W3, I_MOE_W2 };

struct Frame {
    LAS unsigned char* lds;
    int wave, vcu, G;
};
typedef const __attribute__((address_space(4))) Args* KArgs;
__device__ __forceinline__ KArgs kargs() { KArgs p = (KArgs)__builtin_amdgcn_kernarg_segment_ptr(); asm volatile("" : "+s"(p)); return p; }
#define INP(i) (kargs()->in[i])
#define OUTP (kargs()->out)
#define WSP (kargs()->ws)
__device__ __forceinline__ int fresh(int v) { asm volatile("" : "+v"(v)); return v; }

__device__ __forceinline__ void tr_item(const float* W, int ldw, int K, int k0, int nsrc0, const float* gain, bf16* WT, int drow0, LAS float* scr, int lane) {
    const int c4 = lane & 7, r = lane >> 3;
    const GAS float* src = (const GAS float*)W + (size_t)(k0 + r) * ldw + nsrc0 + 4 * c4;
    f32x4 v[16];
#pragma unroll
    for (int i = 0; i < 16; ++i) v[i] = *(const GAS f32x4*)(src + (size_t)(8 * i) * ldw);
    if (gain) {
#pragma unroll
        for (int i = 0; i < 16; ++i) v[i] = v[i] * gain[k0 + 8 * i + r];
    }
#pragma unroll
    for (int i = 0; i < 16; ++i) { LAS float* d = scr + (8 * i + r) * 33 + 4 * c4; d[0] = v[i].x; d[1] = v[i].y; d[2] = v[i].z; d[3] = v[i].w; }
    LDS_WAIT(); asm volatile("" ::: "memory");
    const int c16 = lane >> 2;
#pragma unroll
    for (int j = 0; j < 8; ++j) { const int n = (lane & 3) + 4 * j; const LAS float* sp = scr + (8 * c16) * 33 + n;
        v4u o; o.x = pk2(sp[0 * 33], sp[1 * 33]); o.y = pk2(sp[2 * 33], sp[3 * 33]); o.z = pk2(sp[4 * 33], sp[5 * 33]); o.w = pk2(sp[6 * 33], sp[7 * 33]);
        *(GAS v4u*)(WT + (size_t)(drow0 + n) * K + k0 + 8 * c16) = o; }
    LDS_WAIT(); asm volatile("" ::: "memory");
}
__device__ __forceinline__ void tr_plain(const float* W, int K, int N, const float* gain, bf16* WT, int drow_off, LAS float* scr, int item, int lane) {
    const int nblk = N / 32, kb = item / nblk, nb = item % nblk;
    tr_item(W, N, K, 128 * kb, 32 * nb, gain, WT, drow_off + 32 * nb, scr, lane);
}
__device__ __forceinline__ void tr_gated(const float* W, int K, int N, const float* gain, bf16* WT, int half, LAS float* scr, int item, int lane) {
    const int nblk = N / 32, kb = item / nblk, nb = item % nblk, n0 = 32 * nb;
    tr_item(W, N, K, 128 * kb, n0, gain, WT, (n0 >> 7) * 256 + half * 128 + (n0 & 127), scr, lane);
}
__device__ __forceinline__ unsigned pk_fp8x4(float a, float b, float c, float d) { int w = 0; w = __builtin_amdgcn_cvt_pk_fp8_f32(a, b, w, false); w = __builtin_amdgcn_cvt_pk_fp8_f32(c, d, w, true); return (unsigned)w; }
__device__ __forceinline__ void tr_item_f8(const float* W, int ldw, int K, int k0, int nsrc0, const float* gain, unsigned char* WT, int drow0, LAS float* scr, int lane) {
    const int c4 = lane & 7, r = lane >> 3;
    const GAS float* src = (const GAS float*)W + (size_t)(k0 + r) * ldw + nsrc0 + 4 * c4;
    f32x4 v[16];
#pragma unroll
    for (int i = 0; i < 16; ++i) v[i] = *(const GAS f32x4*)(src + (size_t)(8 * i) * ldw);
#pragma unroll
    for (int i = 0; i < 16; ++i) v[i] = v[i] * (gain ? gain[k0 + 8 * i + r] * 64.f : 64.f);
#pragma unroll
    for (int i = 0; i < 16; ++i) { LAS float* d = scr + (8 * i + r) * 33 + 4 * c4; d[0] = v[i].x; d[1] = v[i].y; d[2] = v[i].z; d[3] = v[i].w; }
    LDS_WAIT(); asm volatile("" ::: "memory");
    const int c8 = lane >> 3;
#pragma unroll
    for (int j = 0; j < 4; ++j) { const int n = (lane & 7) + 8 * j; const LAS float* sp = scr + (16 * c8) * 33 + n;
        v4u o; o.x = pk_fp8x4(sp[0 * 33], sp[1 * 33], sp[2 * 33], sp[3 * 33]); o.y = pk_fp8x4(sp[4 * 33], sp[5 * 33], sp[6 * 33], sp[7 * 33]);
        o.z = pk_fp8x4(sp[8 * 33], sp[9 * 33], sp[10 * 33], sp[11 * 33]); o.w = pk_fp8x4(sp[12 * 33], sp[13 * 33], sp[14 * 33], sp[15 * 33]);
        *(GAS v4u*)(WT + (size_t)(drow0 + n) * K + k0 + 16 * c8) = o; }
    LDS_WAIT(); asm volatile("" ::: "memory");
}
__device__ __forceinline__ float rms_row_to_bf16(const float* xrow, bf16* orow, int lane, f32x4 (&v)[4]) {
    const GAS f32x4* xr = (const GAS f32x4*)xrow + lane;
    float s = 0.f;
#pragma unroll
    for (int j = 0; j < 4; ++j) { v[j] = xr[64 * j]; s += (v[j].x * v[j].x + v[j].y * v[j].y) + (v[j].z * v[j].z + v[j].w * v[j].w); }
    const float rstd = 1.f / sqrtf(wave_sum(s) * (1.f / D) + EPS);
    GAS unsigned long long* o8 = (GAS unsigned long long*)orow + lane;
#pragma unroll
    for (int j = 0; j < 4; ++j) o8[64 * j] = (unsigned long long)pk2(v[j].x * rstd, v[j].y * rstd) | ((unsigned long long)pk2(v[j].z * rstd, v[j].w * rstd) << 32);
    return rstd;
}
__device__ __forceinline__ void norm_phase(const Frame& F, const float* x, bf16* xn) {
    const int tid = fresh(F.wave * 64 + lane_id_()), lane = tid & 63; (void)lane;
    const int gw = F.vcu * NWAVES + F.wave, NGW = F.G * NWAVES;
    for (int m = 2 * gw; m < M; m += 2 * NGW) {
        const GAS f32x4* xr = (const GAS f32x4*)(x + (size_t)m * D) + lane;
        f32x4 v[8]; float s0 = 0.f, s1 = 0.f;
#pragma unroll
        for (int j = 0; j < 8; ++j) v[j] = xr[64 * j];
#pragma unroll
        for (int j = 0; j < 4; ++j) { s0 += (v[j].x * v[j].x + v[j].y * v[j].y) + (v[j].z * v[j].z + v[j].w * v[j].w); s1 += (v[4 + j].x * v[4 + j].x + v[4 + j].y * v[4 + j].y) + (v[4 + j].z * v[4 + j].z + v[4 + j].w * v[4 + j].w); }
        const float r0 = 1.f / sqrtf(wave_sum(s0) * (1.f / D) + EPS), r1 = 1.f / sqrtf(wave_sum(s1) * (1.f / D) + EPS);
        GAS unsigned* o4 = (GAS unsigned*)((GAS unsigned char*)xn + (size_t)m * D) + lane;
#pragma unroll
        for (int j = 0; j < 8; ++j) { const float rr = j < 4 ? r0 : r1; o4[64 * j] = pk_fp8x4(v[j].x * rr, v[j].y * rr, v[j].z * rr, v[j].w * rr); }
    }
}

__device__ __forceinline__ void p0_prologue(const Frame& F) {
    const int tid = fresh(F.wave * 64 + lane_id_()), lane = tid & 63; (void)lane;
    LAS float* scr = (LAS float*)(F.lds + RING_OFF + F.wave * P0_SCR);
    unsigned char* ws = WSP;
    const int gw = F.vcu * NWAVES + F.wave, NGW = F.G * NWAVES;
    constexpr int I_DQ = 8 * 12, I_DKV = 8 * 9, I_UQ = 3 * 48, I_UKV = 2 * 64, I_SQ = 8 * 32, I_F13 = 8 * 88, I_F2 = 22 * 32, I_M13 = 8 * 112, I_M2 = 28 * 32;
    constexpr int NSMALL = I_DQ + I_DKV + I_UQ + I_UKV + I_SQ + 2 * I_F13 + I_F2 + 4 * I_SQ;
    constexpr int NITEMS = NSMALL + NE * (2 * I_M13 + I_M2);
    for (int it = gw; it < NITEMS; it += NGW) {
        int r = it;
        if (r < I_DQ)  { const int kb = r / 12, n0 = 32 * (r % 12); tr_item_f8(INP(I_A_WDQ), QLORA, D, 128 * kb, n0, INP(I_ATTN_NORM), ws + WS_WA, n0, scr, lane); continue; } r -= I_DQ;
        if (r < I_DKV) { const int kb = r / 9, n0 = 32 * (r % 9); tr_item_f8(INP(I_A_WDKV), KVLORA + ROPE_D, D, 128 * kb, n0, INP(I_ATTN_NORM), ws + WS_WA, QLORA + n0, scr, lane); continue; } r -= I_DKV;
        if (r < I_UQ)  { tr_plain(INP(I_A_WUQ), QLORA, NH * QKD, INP(I_A_GCQ), (bf16*)(ws + WS_WUQ), 0, scr, r, lane); continue; } r -= I_UQ;
        if (r < I_UKV) { const int kb = r / 64, n0 = 32 * (r % 64), head = n0 >> 7, within = n0 & 127;
            const int drow = within < 64 ? 256 * (head >> 2) + 128 * (within >> 5) + 32 * (head & 3) : 1024 + head * 64 + (within - 64);
            tr_item(INP(I_A_WUKV), NH * 128, KVLORA, 128 * kb, n0, INP(I_A_GCKV), (bf16*)(ws + WS_WUKV), drow, scr, lane); continue; } r -= I_UKV;
        if (r < I_SQ)  { const int kb = r / 32, n0 = 32 * (r % 32); tr_item_f8(INP(I_A_WO), D, D, 128 * kb, n0, nullptr, ws + WS_WO, n0, scr, lane); continue; } r -= I_SQ;
        if (r < I_F13) { tr_gated(INP(I_FFN_W1), D, FF, INP(I_FFN_NORM), (bf16*)(ws + WS_WF1), 0, scr, r, lane); continue; } r -= I_F13;
        if (r < I_F13) { tr_gated(INP(I_FFN_W3), D, FF, INP(I_FFN_NORM), (bf16*)(ws + WS_WF1), 1, scr, r, lane); continue; } r -= I_F13;
        if (r < I_F2)  { const int kb = r / 32, n0 = 32 * (r % 32); tr_item_f8(INP(I_FFN_W2), D, FF, 128 * kb, n0, nullptr, ws + WS_WF2, n0, scr, lane); continue; } r -= I_F2;
        if (r < I_SQ)  { const int kb = r / 32, n0 = 32 * (r % 32), head = n0 >> 6;
            tr_item_f8(INP(I_KV_WK), D, D, 128 * kb, n0, INP(I_KV_NORM), ws + WS_WKVQ, 256 * (head >> 2) + 128 * ((n0 >> 5) & 1) + 32 * (head & 3), scr, lane); continue; } r -= I_SQ;
        if (r < I_SQ)  { const int kb = r / 32, n0 = 32 * (r % 32); tr_item_f8(INP(I_KV_WV), D, D, 128 * kb, n0, INP(I_KV_NORM), ws + WS_WKVQ, 2 * D + n0, scr, lane); continue; } r -= I_SQ;
        if (r < I_SQ)  { const int kb = r / 32, n0 = 32 * (r % 32), head = n0 >> 6;
            tr_item_f8(INP(I_B_WQ), D, D, 128 * kb, n0, INP(I_ATTN_NORM) + D, ws + WS_WKVQ, D + 256 * (head >> 2) + 128 * ((n0 >> 5) & 1) + 32 * (head & 3), scr, lane); continue; } r -= I_SQ;
        if (r < I_SQ)  { const int kb = r / 32, n0 = 32 * (r % 32); tr_item_f8(INP(I_B_WO), D, D, 128 * kb, n0, nullptr, ws + WS_WBO, n0, scr, lane); continue; } r -= I_SQ;
        const int e = r / (2 * I_M13 + I_M2); r -= e * (2 * I_M13 + I_M2);
        if (r < I_M13) { const int kb = r / 112, n0 = 32 * (r % 112);
            tr_item_f8(INP(I_MOE_W1) + (size_t)e * D * EFF, EFF, D, 128 * kb, n0, INP(I_FFN_NORM) + D, ws + WS_WM1 + (size_t)e * 2 * EFF * D, (n0 >> 7) * 256 + (n0 & 127), scr, lane); continue; } r -= I_M13;
        if (r < I_M13) { const int kb = r / 112, n0 = 32 * (r % 112);
            tr_item_f8(INP(I_MOE_W3) + (size_t)e * D * EFF, EFF, D, 128 * kb, n0, INP(I_FFN_NORM) + D, ws + WS_WM1 + (size_t)e * 2 * EFF * D, (n0 >> 7) * 256 + 128 + (n0 & 127), scr, lane); continue; } r -= I_M13;
        { const int kb = r / 32, n0 = 32 * (r % 32); tr_item_f8(INP(I_MOE_W2) + (size_t)e * EFF * D, D, EFF, 128 * kb, n0, nullptr, ws + WS_WM2 + (size_t)e * D * EFF, n0, scr, lane); }
    }
    const int gt = F.vcu * (NWAVES * 64) + tid, NGT = F.G * NWAVES * 64;
    for (int c = gt; c < 96 * D / 16; c += NGT) *((GAS v4u*)(ws + WS_WA + (size_t)(QLORA + KVLORA + ROPE_D) * D) + c) = (v4u){0u, 0u, 0u, 0u};
    for (int c = gt; c < SEQ * 16; c += NGT) { const int pos = c >> 4, i = c & 15;
        const float inv = __builtin_amdgcn_exp2f(-(float)i * (13.287712379549449f / 16.f));
        const float rev = (float)pos * inv * 0.15915494309189535f; const float fr = rev - floorf(rev);
        ((GAS float*)(ws + WS_ROPE))[2 * c] = __builtin_amdgcn_cosf(fr); ((GAS float*)(ws + WS_ROPE))[2 * c + 1] = __builtin_amdgcn_sinf(fr); }
    norm_phase(F, INP(I_X), (bf16*)(ws + WS_XN));
}

__device__ __forceinline__ void route_phase(const Frame& F) {
    const int tid = fresh(F.wave * 64 + lane_id_()), lane = tid & 63;
    unsigned char* ws = WSP;
    LAS float* wrg = (LAS float*)(F.lds + RING_OFF);
    LAS int* cnt = (LAS int*)(F.lds + RING_OFF + 32768);
    const float* wr = INP(I_MOE_ROUTER); const float* g = INP(I_FFN_NORM) + D;
    { float wv[16], gv[16];
#pragma unroll
      for (int it = 0; it < 16; ++it) { const int idx = tid + it * NWAVES * 64; wv[it] = wr[idx]; gv[it] = g[idx >> 3]; }
#pragma unroll
      for (int it = 0; it < 16; ++it) { const int idx = tid + it * NWAVES * 64, k = idx >> 3, e = idx & 7, l = k >> 4, i = k & 15;
          wrg[((i * 2) + (e >> 2)) * 256 + 4 * l + (e & 3)] = wv[it] * gv[it]; } }
    __syncthreads();
    const int b5 = (lane >> 5) & 1, b4 = (lane >> 4) & 1, b3 = (lane >> 3) & 1;
    typedef float f32x2 __attribute__((ext_vector_type(2)));
    f32x2 wreg[16][4];
#pragma unroll
    for (int j = 0; j < 16; ++j) { const f32x4 w0 = *(const LAS f32x4*)(wrg + (j * 2) * 256 + 4 * lane), w1 = *(const LAS f32x4*)(wrg + (j * 2 + 1) * 256 + 4 * lane);
        wreg[j][0] = (f32x2){w0.x, w0.y}; wreg[j][1] = (f32x2){w0.z, w0.w}; wreg[j][2] = (f32x2){w1.x, w1.y}; wreg[j][3] = (f32x2){w1.z, w1.w}; }
    for (int c = F.vcu; c < M / 256; c += F.G) {
        if (tid < 16) cnt[tid] = 0;
        __syncthreads();
        v4u vn[2], vm[2];
        { const GAS v4u* xr = (const GAS v4u*)(ws + WS_XR3 + (size_t)(c * 256 + F.wave * 32) * D * 2) + 2 * lane; vn[0] = xr[0]; vn[1] = xr[1]; vm[0] = xr[D * 2 / 16]; vm[1] = xr[D * 2 / 16 + 1]; }
#pragma unroll 2
        for (int i = 0; i < 32; ++i) {
            const int m = c * 256 + F.wave * 32 + i;
            const v4u q0 = vn[0], q1 = vn[1];
            vn[0] = vm[0]; vn[1] = vm[1];
            if (i + 2 < 32) { const GAS v4u* xr = (const GAS v4u*)(ws + WS_XR3 + (size_t)(m + 2) * D * 2) + 2 * lane; vm[0] = xr[0]; vm[1] = xr[1]; }
            const unsigned qw[8] = {q0.x, q0.y, q0.z, q0.w, q1.x, q1.y, q1.z, q1.w};
            float xv[16]; float ssx = 0.f;
#pragma unroll
            for (int j = 0; j < 8; ++j) { xv[2 * j] = bflo(qw[j]); xv[2 * j + 1] = bfhi(qw[j]); }
#pragma unroll
            for (int j = 0; j < 16; j += 4) ssx += (xv[j] * xv[j] + xv[j + 1] * xv[j + 1]) + (xv[j + 2] * xv[j + 2] + xv[j + 3] * xv[j + 3]);
            float lg[8];
            { f32x2 l2[4] = {{0.f, 0.f}, {0.f, 0.f}, {0.f, 0.f}, {0.f, 0.f}};
#pragma unroll
              for (int j = 0; j < 16; ++j) { const f32x2 xx = {xv[j], xv[j]};
#pragma unroll
                  for (int q = 0; q < 4; ++q) l2[q] = l2[q] + xx * wreg[j][q]; }
#pragma unroll
              for (int q = 0; q < 4; ++q) { lg[2 * q] = l2[q].x; lg[2 * q + 1] = l2[q].y; } }
            float r4[4], r2[2], r1;
#pragma unroll
            for (int e = 0; e < 4; ++e) { const float mine = b5 ? lg[4 + e] : lg[e], other = b5 ? lg[e] : lg[4 + e]; r4[e] = mine + xor32_partner(other, b5); }
#pragma unroll
            for (int e = 0; e < 2; ++e) { const float mine = b4 ? r4[2 + e] : r4[e], other = b4 ? r4[e] : r4[2 + e]; r2[e] = mine + swz_xor<16>(other); }
            { const float mine = b3 ? r2[1] : r2[0], other = b3 ? r2[0] : r2[1]; r1 = mine + swz_xor<8>(other); }
            r1 += swz_xor<4>(r1); r1 += swz_xor<2>(r1); r1 += swz_xor<1>(r1);
            const float rstd = 1.f / sqrtf(wave_sum(ssx) * (1.f / D) + EPS);
#pragma unroll
            for (int e = 0; e < 8; ++e) lg[e] = __builtin_bit_cast(float, __builtin_amdgcn_readlane(__builtin_bit_cast(int, r1), 8 * e)) * rstd;
            int e1 = 0; float l1 = lg[0];
#pragma unroll
            for (int e = 1; e < 8; ++e) if (lg[e] > l1) { l1 = lg[e]; e1 = e; }
            int e2 = -1; float l2 = -INFINITY;
#pragma unroll
            for (int e = 0; e < 8; ++e) if (e != e1 && lg[e] > l2) { l2 = lg[e]; e2 = e; }
            const float g1 = 1.f / (1.f + __expf(l2 - l1)), g2 = 1.f - g1;
            const int elo = e1 < e2 ? e1 : e2, ehi = e1 < e2 ? e2 : e1;
            const float glo = e1 < e2 ? g1 : g2, ghi = e1 < e2 ? g2 : g1;
            if (lane == 0) { ((GAS float*)(ws + WS_TOKRSTD))[m] = rstd; ((GAS int*)(ws + WS_TOKE))[m] = elo | (ehi << 8); ((GAS float*)(ws + WS_TOKG))[2 * m] = glo; ((GAS float*)(ws + WS_TOKG))[2 * m + 1] = ghi;
                atomicAdd((int*)&cnt[elo], 1); atomicAdd((int*)&cnt[8 + ehi], 1); }
        }
        __syncthreads();
        if (tid < 16) ((GAS int*)(ws + WS_CNT))[c * 16 + tid] = cnt[tid];
        __syncthreads();
    }
}

__device__ __forceinline__ void slot_phase(const Frame& F, unsigned char* ws) {
    const int tid = fresh(F.wave * 64 + lane_id_()), lane = tid & 63; (void)lane;
    LAS int* call = (LAS int*)(F.lds + RING_OFF);
    LAS int* tot = call + 4096; LAS int* base = tot + 16; LAS int* pre = base + 16; LAS int* meta = pre + 16;
    LAS int* grp = meta + 16;
    LAS int* slot_of = grp + 512;
    for (int idx = tid; idx < 4096; idx += NWAVES * 64) call[idx] = ((const GAS int*)(ws + WS_CNT))[idx];
    __syncthreads();
    if (tid < 16) { int t = 0; for (int cc = 0; cc < 256; ++cc) t += call[cc * 16 + tid]; tot[tid] = t; }
    __syncthreads();
    if (tid == 0) { int off = 0; for (int g = 0; g < 16; ++g) { base[g] = off; off += (tot[g] + 255) & ~255; if (g == 7) meta[0] = off >> 8; } meta[1] = (off >> 8) - meta[0]; }
    __syncthreads();
    for (int c = F.vcu; c < M / 256; c += F.G) {
        if (tid < 16) { int p = 0; for (int cc = 0; cc < c; ++cc) p += call[cc * 16 + tid]; pre[tid] = p; }
        const int hf = tid >> 8, i = tid & 255, m = c * 256 + i;
        const int te = ((const GAS int*)(ws + WS_TOKE))[m];
        const int g = hf * 8 + (hf ? ((te >> 8) & 0xff) : (te & 0xff));
        grp[tid] = g;
        __syncthreads();
        int rank = 0;
        for (int j = 0; j < i; ++j) rank += (grp[hf * 256 + j] == g) ? 1 : 0;
        const int slot = base[g] + pre[g] + rank;
        ((GAS int*)(ws + WS_SLOTTOK))[slot] = m; ((GAS float*)(ws + WS_SLOTGATE))[slot] = ((const GAS float*)(ws + WS_TOKG))[2 * m + hf];
        slot_of[tid] = slot;
        __syncthreads();
        for (int i0 = F.wave; i0 < 256; i0 += 4 * NWAVES) {
            v4u x[4][2]; float rs[4];
#pragma unroll
            for (int k = 0; k < 4; ++k) { const int mm = c * 256 + i0 + 8 * k; const GAS v4u* src = (const GAS v4u*)(ws + WS_XR3 + (size_t)mm * D * 2);
                x[k][0] = src[2 * lane]; x[k][1] = src[2 * lane + 1]; rs[k] = ((const GAS float*)(ws + WS_TOKRSTD))[mm]; }
#pragma unroll
            for (int k = 0; k < 4; ++k) { const int i = i0 + 8 * k; const v4u x0 = x[k][0], x1 = x[k][1]; const float r = rs[k];
                const v4u o = (v4u){pk_fp8x4(bflo(x0.x) * r, bfhi(x0.x) * r, bflo(x0.y) * r, bfhi(x0.y) * r), pk_fp8x4(bflo(x0.z) * r, bfhi(x0.z) * r, bflo(x0.w) * r, bfhi(x0.w) * r),
                                    pk_fp8x4(bflo(x1.x) * r, bfhi(x1.x) * r, bflo(x1.y) * r, bfhi(x1.y) * r), pk_fp8x4(bflo(x1.z) * r, bfhi(x1.z) * r, bflo(x1.w) * r, bfhi(x1.w) * r)};
                ((GAS v4u*)(ws + WS_XG + (size_t)slot_of[i] * D))[lane] = o; ((GAS v4u*)(ws + WS_XG + (size_t)slot_of[256 + i] * D))[lane] = o; }
        }
        __syncthreads();
    }
    for (int g = F.vcu; g < 16; g += F.G) {
        const int s0 = base[g] + tot[g], s1 = base[g] + ((tot[g] + 255) & ~255);
        for (int s = s0 + F.wave; s < s1; s += NWAVES) { GAS v4u* dst = (GAS v4u*)(ws + WS_XG + (size_t)s * D);
            dst[lane] = (v4u){0u, 0u, 0u, 0u};
            if (lane == 0) { ((GAS int*)(ws + WS_SLOTTOK))[s] = -1; ((GAS float*)(ws + WS_SLOTGATE))[s] = 0.f; } }
    }
    if (F.vcu == 0) {
        if (tid < 16) { const int p0 = base[tid] >> 8, p1 = (base[tid] + ((tot[tid] + 255) & ~255)) >> 8; for (int p = p0; p < p1; ++p) ((GAS int*)(ws + WS_PANELE))[p] = tid & 7; }
        if (tid == 0) { ((GAS int*)(ws + WS_META))[0] = meta[0]; ((GAS int*)(ws + WS_META))[1] = meta[1]; }
        if (tid < 16) ((GAS int*)(ws + WS_META))[2 + tid] = base[tid] >> 8;
        if (tid == 0) { const int nPA = meta[0], nPB = meta[1]; int x = nPB > 256 ? nPB - 256 : 0;
            if (x > 0 && nPA > 256) { int LA = 0, HB = 7;
                for (int g = 0; g < 8; ++g) { const int q0 = base[g] >> 8, q1 = q0 + ((tot[g] + 255) >> 8); if (q0 <= 256 && 256 < q1) LA = g; }
                for (int g = 8; g < 16; ++g) { const int q0 = base[g] >> 8, q1 = q0 + ((tot[g] + 255) >> 8), P = nPA + x - 1; if (q0 <= P && P < q1) HB = g - 8; }
                if (LA < HB) x = 0; }
            ((GAS int*)(ws + WS_META))[18] = x; }
    }
    __syncthreads();
}

__global__ void __launch_bounds__(NWAVES * 64, 2) yoco_fwd(Args args) {
    extern __shared__ __attribute__((aligned(16))) unsigned char lds_raw[];
    Frame F;
    F.lds = (LAS unsigned char*)lds_raw;
    F.wave = __builtin_amdgcn_readfirstlane((int)threadIdx.x >> 6);
    F.G = gridDim.x; { const int bx = blockIdx.x; F.vcu = (F.G % 8 == 0) ? (bx % 8) * (F.G / 8) + bx / 8 : bx; }
    unsigned char* ws = WSP;
    volatile LAS unsigned* MISC = (volatile LAS unsigned*)(F.lds + MISC_OFF);
    for (int u = fresh((int)threadIdx.x); u < (LDS_BYTES - LDSCTL_OFF) / 4; u += NWAVES * 64) ((LAS unsigned*)(F.lds + LDSCTL_OFF))[u] = 0u;
    __syncthreads();
    (void)xcd_barrier_post((unsigned*)(ws + WS_CTL) + CW_BAR, MISC + 8, (F.wave == 0 && lane_id_() == 0) ? 1 : 0);
    LAS unsigned char* ring = F.lds + RING_OFF;
#define bid ((int)blockIdx.x)
#define GRID_BAR() do { XcdBarrier b_; b_.t0 = (F.wave == 0 && lane_id_() == 0) ? 1 : 0; b_.bar = (unsigned*)(WSP + WS_CTL) + CW_BAR; b_.x = xb_xcc_id(); b_.st = (volatile LAS unsigned*)(F.lds + MISC_OFF) + 8; xcd_barrier(b_); } while (0)
#define GEMM(EpiT, SchedT) pg8::gemm_phase<EpiT, SchedT, true, true>

    p0_prologue(F);
    GRID_BAR();
    { pg8::Gemm g{(const bf16*)(ws + WS_XN), (const bf16*)(ws + WS_WA), M, NA, D / 2, D / 2}; pg8::StaticOrder S; S.init(M, NA, F.G, bid);
      pg8::EpiQA E{(bf16*)(ws + WS_QA), (float*)(ws + WS_PARTQA), 1.f / 64};
      pg8::gemm_phase<pg8::EpiQA, pg8::StaticOrder, true, true, true>(ring, g, S, E, F.wave); }
    GRID_BAR();
    { pg8::Gemm g{(const bf16*)(ws + WS_QA), (const bf16*)(ws + WS_WUQ), M, NH * QKD, QLORA, NA}; pg8::StaticOrder S; S.init(M, NH * QKD, F.G, bid);
      pg8::EpiRowScaleBf16 E{(bf16*)(ws + WS_Q), NH * QKD, (const float*)(ws + WS_PARTQA), 1.f / QLORA};
      GEMM(pg8::EpiRowScaleBf16, pg8::StaticOrder)(ring, g, S, E, F.wave); }
    { pg8::Gemm g{(const bf16*)(ws + WS_QA) + QLORA, (const bf16*)(ws + WS_WUKV), M, NH * 128, KVLORA, NA}; pg8::StaticOrder S; S.init(M, NH * 128, F.G, bid);
      pg8::EpiKVup E{(bf16*)(ws + WS_K), (bf16*)(ws + WS_V), (const float*)(ws + WS_PARTQA), (const bf16*)(ws + WS_QA), INP(I_A_GKN), (const float*)(ws + WS_ROPE)};
      GEMM(pg8::EpiKVup, pg8::StaticOrder)(ring, g, S, E, F.wave); }
    GRID_BAR();
    bool fastA;
    { float bq = 0.f, bk = 0.f; const int l_ = lane_id_(); for (int i = l_; i < QKD; i += 64) { bq = fmaxf(bq, fabsf(INP(I_A_GQN)[i])); bk = fmaxf(bk, fabsf(INP(I_A_GKN)[i])); }
      bq = wave_maxf(bq); bk = wave_maxf(bk); fastA = __builtin_amdgcn_readfirstlane((int)(14.42f * bq * bk <= 40.f)) != 0; }
#define P5_UNIT(NM) att::attn_unit<96, false, 1536, 1536, D, D, true, NM, 2>(ring, (const bf16*)(ws + WS_Q) + (size_t)b * SEQ * 1536 + h * QKD, (const bf16*)(ws + WS_K) + (size_t)b * SEQ * 1536 + h * QKD, \
                                      (const bf16*)(ws + WS_V) + (size_t)b * SEQ * D + h * 64, (bf16*)(ws + WS_O + (size_t)b * SEQ * D + h * 64), \
                                      256 * qb, 0, 4 * qb + 3, 0, 4 * qb + (F.wave >> 1), 0, nullptr, INP(I_A_GQN), (const float*)(ws + WS_ROPE), F.wave, true, qfA, false, false, \
                                      (const bf16*)(ws + WS_Q) + (size_t)bn * SEQ * 1536 + hh * QKD + (size_t)(256 * qbn) * 1536, 4 * qb + 3, 0)
    att::attn_init<96, 1536, D, 2>(ring, F.wave);
    att::bf16x8 qfA[6]; bool qldA = false;
    for (int p = F.vcu; p < BATCH * NH * 4; p += F.G) {
        const int bh = p >> 2, pid = p & 3, b = bh >> 4, h = bh & 15;
        for (int u2 = 0; u2 < 2; ++u2) {
            const int qb = u2 ? 7 - pid : pid;
            const int pn = u2 ? p + F.G : p; const bool hn = pn < BATCH * NH * 4;
            const int bhn = pn >> 2, pidn = pn & 3, bn = bhn >> 4, hh = bhn & 15, qbn = u2 ? pidn : 7 - pidn;
            if (fastA) P5_UNIT(true); else P5_UNIT(false);
        }
    }
    GRID_BAR();
    { pg8::Gemm g{(const bf16*)(ws + WS_O), (const bf16*)(ws + WS_WO), M, D, D / 2, D / 2}; pg8::StaticOrder S; S.init(M, D, F.G, bid);
      pg8::EpiResStream<true, false, false> E{INP(I_X), (bf16*)(ws + WS_XR1), nullptr, (float*)(ws + WS_PART1), 1.f / 2048};
      pg8::gemm_phase<pg8::EpiResStream<true, false, false>, pg8::StaticOrder, true, true, true>(ring, g, S, E, F.wave); }
    GRID_BAR();
    { pg8::Gemm g{(const bf16*)(ws + WS_XR1), (const bf16*)(ws + WS_WF1), M, 2 * FF, D, D}; pg8::StaticOrder S; S.init(M, 2 * FF, F.G, bid);
      pg8::EpiGatedF8T<true, false> E{ws + WS_H, FF, 0, (const float*)(ws + WS_PART1)};
      typedef pg8::EpiGatedF8T<true, false> EpiH8; GEMM(EpiH8, pg8::StaticOrder)(ring, g, S, E, F.wave); }
    GRID_BAR();
    { pg8::Gemm g{(const bf16*)(ws + WS_H), (const bf16*)(ws + WS_WF2), M, D, FF / 2, FF / 2}; pg8::StaticOrder S; S.init(M, D, F.G, bid);
      pg8::EpiResStream<true, true, true> E{ws + WS_XR1, (bf16*)(ws + WS_X2B), ws + WS_XR2, (float*)(ws + WS_PART2), 1.f / 64};
      pg8::gemm_phase<pg8::EpiResStream<true, true, true>, pg8::StaticOrder, true, true, true>(ring, g, S, E, F.wave); }
    GRID_BAR();
    { pg8::Gemm g{(const bf16*)(ws + WS_XR2), (const bf16*)(ws + WS_WKVQ), M, 2 * D, D / 2, D / 2}; pg8::StaticOrder S; S.init(M, 2 * D, F.G, bid);
      pg8::EpiK2Q2 E{(bf16*)(ws + WS_KVQ2), (const float*)(ws + WS_PART2), INP(I_KV_GKN), INP(I_B_GQN), 1.f / 64};
      pg8::gemm_phase<pg8::EpiK2Q2, pg8::StaticOrder, true, true, true>(ring, g, S, E, F.wave); }
    { pg8::Gemm g{(const bf16*)(ws + WS_XR2), (const bf16*)(ws + WS_WKVQ + (size_t)2 * D * D), M, D, D / 2, D / 2}; pg8::StaticOrder S; S.init(M, D, F.G, bid);
      pg8::EpiRowScale16 E{(bf16*)(ws + WS_KVQ2), 3 * D, D, (const float*)(ws + WS_PART2), 1.f / 64};
      pg8::gemm_phase<pg8::EpiRowScale16, pg8::StaticOrder, true, true, true>(ring, g, S, E, F.wave); }
    GRID_BAR();
    bool fastB;
    { float bq = 0.f, bk = 0.f, bb = 0.f; const int l_ = lane_id_(); bq = fabsf(INP(I_B_GQN)[l_]); bk = fabsf(INP(I_KV_GKN)[l_]);
      for (int i = l_; i < NH * 257; i += 64) bb = fmaxf(bb, fabsf(INP(I_B_RELB)[i]));
      bq = wave_maxf(bq); bk = wave_maxf(bk); bb = wave_maxf(bb); fastB = __builtin_amdgcn_readfirstlane((int)(11.78f * bq * bk + 1.4427f * bb <= 40.f)) != 0; }
    att::attn_init<64, 3072, 3072, 5>(ring, F.wave);
    static_assert(5 * (att::Geo<64>::KBUF + att::Geo<64>::VBUF) + 2048 + 8192 <= RING_BYTES, "band attention: five-slot rings fit the ring region");
    att::bf16x8 qfB[4]; bool qldB = false;
    int last_h = -1;
    for (int p = F.vcu; p < BATCH * NH * 8; p += F.G) {
        const int bh = p >> 3, cb = ((p & 7) + (p >> 8)) & 7, b = bh >> 4, h = bh & 15;
        const bool ldb = h != last_h; last_h = h;
        const int pn = p + F.G; const bool hn = pn < BATCH * NH * 8; const int bhn = pn >> 3, cbn = ((pn & 7) + (pn >> 8)) & 7;
        const int c0 = 4 * cb, cc = c0 + (F.wave >> 1);
        const bf16* base = (const bf16*)(ws + WS_KVQ2) + (size_t)b * SEQ * 3072 + h * 64;
#define P13_UNIT(NM) att::attn_unit<64, true, 3072, 3072, 3072, D, true, NM, 5>(ring, base + 2048, base, base + 1024, (bf16*)(ws + WS_O2 + (size_t)b * SEQ * D + h * 64), \
                                 256 * cb, c0 - 8 < -3 ? -3 : c0 - 8, c0, (cc - 8 < 0 ? 0 : cc - 8) - (F.wave >> 1), c0, cc, INP(I_B_RELB) + h * 257, nullptr, nullptr, F.wave, ldb, qfB, qldB, hn, \
                                 (const bf16*)(ws + WS_KVQ2) + (size_t)(bhn >> 4) * SEQ * 3072 + (bhn & 15) * 64 + 2048 + (size_t)(256 * cbn) * 3072, c0 + 3, F.wave >> 1)
        if (fastB) P13_UNIT(true); else P13_UNIT(false);
        qldB = hn;
    }
    GRID_BAR();
    { pg8::Gemm g{(const bf16*)(ws + WS_O2), (const bf16*)(ws + WS_WBO), M, D, D / 2, D / 2}; pg8::StaticOrder S; S.init(M, D, F.G, bid);
      pg8::EpiResStream<false, false, true> E{ws + WS_X2B, (bf16*)(ws + WS_XR3), nullptr, nullptr, 1.f / 2048};
      pg8::gemm_phase<pg8::EpiResStream<false, false, true>, pg8::StaticOrder, true, true, true>(ring, g, S, E, F.wave); }
    GRID_BAR();
    route_phase(F);
    GRID_BAR();
    slot_phase(F, ws);
    GRID_BAR();
#define MOE_LOAD(hf_) unsigned char* w2 = WSP; \
          const int nPA = __builtin_amdgcn_readfirstlane(((const GAS int*)(w2 + WS_META))[0]), nPB = __builtin_amdgcn_readfirstlane(((const GAS int*)(w2 + WS_META))[1]); (void)nPB; \
          const int xB = __builtin_amdgcn_readfirstlane(((const GAS int*)(w2 + WS_META))[18]); (void)xB; \
          const int p0 = (hf_) ? nPA : 0; int pbk[7]; \
          _Pragma("unroll") for (int k = 0; k < 7; ++k) pbk[k] = __builtin_amdgcn_readfirstlane(((const GAS int*)(w2 + WS_META))[2 + (hf_) * 8 + 1 + k]) - p0;
    constexpr size_t HMB_OFF = (size_t)MAXP_HALF * 256 * EFF;
    { MOE_LOAD(0)
      pg8::Gemm g{(const bf16*)(w2 + WS_XG), (const bf16*)(w2 + WS_WM1), nPA * 256, 2 * EFF, D / 2, D / 2};
      pg8::MoeOrder S; S.init(nPA, 2 * EFF / 256, F.G, bid);
#pragma unroll
      for (int k = 0; k < 7; ++k) S.pb[k] = pbk[k];
      pg8::EpiGatedF8 E{w2 + WS_HM, EFF, 2 * EFF / 256};
      pg8::gemm_phase<pg8::EpiGatedF8, pg8::MoeOrder, true, true, true>(ring, g, S, E, F.wave); }
    { MOE_LOAD(1)
      pg8::Gemm g{(const bf16*)(w2 + WS_XG + (size_t)p0 * 256 * D), (const bf16*)(w2 + WS_WM1), xB * 256, 2 * EFF, D / 2, D / 2};
      pg8::MoeOrder S; S.init(xB, 2 * EFF / 256, F.G, bid); S.rot = (nPA * (2 * EFF / 256)) % F.G;
#pragma unroll
      for (int k = 0; k < 7; ++k) S.pb[k] = pbk[k];
      pg8::EpiGatedF8 E{w2 + WS_HM + HMB_OFF, EFF, 2 * EFF / 256};
      pg8::gemm_phase<pg8::EpiGatedF8, pg8::MoeOrder, true, true, true>(ring, g, S, E, F.wave); }
    GRID_BAR();
    { MOE_LOAD(0)
      pg8::Gemm g{(const bf16*)(w2 + WS_HM), (const bf16*)(w2 + WS_WM2), 256 * 256, D, EFF / 2, EFF / 2};
      pg8::MoeOrder S; S.init(256, D / 256, F.G, bid);
#pragma unroll
      for (int k = 0; k < 7; ++k) S.pb[k] = pbk[k];
      pg8::EpiMoeDown<true> E{nullptr, (bf16*)(w2 + WS_XR3), (const int*)(w2 + WS_SLOTTOK), (const float*)(w2 + WS_SLOTGATE), 0, D, 1.f / 64};
      pg8::gemm_phase<pg8::EpiMoeDown<true>, pg8::MoeOrder, true, true, true>(ring, g, S, E, F.wave); }
    GRID_BAR();
    { MOE_LOAD(0)
      pg8::Gemm g{(const bf16*)(w2 + WS_HM), (const bf16*)(w2 + WS_WM2), nPA * 256, D, EFF / 2, EFF / 2};
      pg8::LeftOrder S; S.M.init(nPA, D / 256, F.G, bid); S.nLeft = 4 * (nPA - 256); S.c0 = 0; S.pbase = 256;
#pragma unroll
      for (int k = 0; k < 7; ++k) S.M.pb[k] = pbk[k];
      pg8::EpiMoeDown<true> E{nullptr, (bf16*)(w2 + WS_XR3), (const int*)(w2 + WS_SLOTTOK), (const float*)(w2 + WS_SLOTGATE), 0, D, 1.f / 64};
      pg8::gemm_phase<pg8::EpiMoeDown<true>, pg8::LeftOrder, true, true, true>(ring, g, S, E, F.wave); }
    { MOE_LOAD(1)
      pg8::Gemm g{(const bf16*)(w2 + WS_HM + HMB_OFF), (const bf16*)(w2 + WS_WM2), xB * 256, D, EFF / 2, EFF / 2};
      pg8::LeftOrder S; S.M.init(xB, D / 256, F.G, bid); S.nLeft = 4 * xB; S.c0 = 4 * (nPA - 256); S.pbase = 0;
#pragma unroll
      for (int k = 0; k < 7; ++k) S.M.pb[k] = pbk[k];
      pg8::EpiMoeDown<false> E{OUTP, (bf16*)(w2 + WS_XR3), (const int*)(w2 + WS_SLOTTOK), (const float*)(w2 + WS_SLOTGATE), p0 * 256, D, 1.f / 64};
      pg8::gemm_phase<pg8::EpiMoeDown<false>, pg8::LeftOrder, true, true, true>(ring, g, S, E, F.wave); }
    { MOE_LOAD(1)
      pg8::Gemm g{(const bf16*)(w2 + WS_XG + (size_t)(p0 + xB) * 256 * D), (const bf16*)(w2 + WS_WM1), (nPB - xB) * 256, 2 * EFF, D / 2, D / 2};
      pg8::MoeOrder S; S.init(nPB - xB, 2 * EFF / 256, F.G, bid); S.nBusy = 4 * (nPA - 256) + 4 * xB; S.SK = 4;
#pragma unroll
      for (int k = 0; k < 7; ++k) S.pb[k] = pbk[k] - xB;
      pg8::EpiGatedF8 E{w2 + WS_HM + HMB_OFF + (size_t)xB * 256 * EFF, EFF, 2 * EFF / 256};
      pg8::gemm_phase<pg8::EpiGatedF8, pg8::MoeOrder, true, true, true>(ring, g, S, E, F.wave); }
    GRID_BAR();
    { MOE_LOAD(1)
      pg8::Gemm g{(const bf16*)(w2 + WS_HM + HMB_OFF + (size_t)xB * 256 * EFF), (const bf16*)(w2 + WS_WM2), (nPB - xB) * 256, D, EFF / 2, EFF / 2};
      pg8::MoeOrder S; S.init(nPB - xB, D / 256, F.G, bid);
#pragma unroll
      for (int k = 0; k < 7; ++k) S.pb[k] = pbk[k] - xB;
      pg8::EpiMoeDown<false> E{OUTP, (bf16*)(w2 + WS_XR3), (const int*)(w2 + WS_SLOTTOK), (const float*)(w2 + WS_SLOTGATE), (p0 + xB) * 256, D, 1.f / 64};
      pg8::gemm_phase<pg8::EpiMoeDown<false>, pg8::MoeOrder, true, true, true>(ring, g, S, E, F.wave); }
#undef MOE_LOAD
#undef GRID_BAR
#undef bid
#undef GEMM
}

extern "C" void kernel_launch(void* const* d_in, const int* in_sizes, int n_in, void* d_out, int out_size, void* d_ws, size_t ws_size, hipStream_t stream) {
    static int grid = 0;
    if (grid == 0) {
        if (n_in != 27 || in_sizes[0] != M * D || out_size != M * D || ws_size < (size_t)988 * MiB) { fprintf(stderr, "kernel_launch: unexpected shapes (n_in %d, in0 %d, out %d, ws %zu < %zu); nothing launched\n", n_in, n_in > 0 ? in_sizes[0] : -1, out_size, ws_size, (size_t)WS_END); grid = -1; return; }
        int dev = 0, cus = 0, per_cu = 0;
        if (hipGetDevice(&dev) != hipSuccess || hipDeviceGetAttribute(&cus, hipDeviceAttributeMultiprocessorCount, dev) != hipSuccess) { grid = -1; return; }
        if (hipFuncSetAttribute((const void*)yoco_fwd, hipFuncAttributeMaxDynamicSharedMemorySize, LDS_BYTES) != hipSuccess) { fprintf(stderr, "kernel_launch: hipFuncSetAttribute failed\n"); grid = -1; return; }
        if (hipOccupancyMaxActiveBlocksPerMultiprocessor(&per_cu, (const void*)yoco_fwd, NWAVES * 64, LDS_BYTES) != hipSuccess || per_cu < 1) { fprintf(stderr, "kernel_launch: occupancy query says %d\n", per_cu); }
        (void)hipGetLastError();
        grid = cus;
    }
    if (grid < 0) return;
    if (hipMemsetAsync((char*)d_ws + WS_CTL, 0, CTL_ZERO_BYTES, stream) != hipSuccess) return;
    Args a{};
    for (int i = 0; i < 27; ++i) a.in[i] = (const float*)d_in[i];
    a.out = (float*)d_out; a.ws = (unsigned char*)d_ws;
    hipLaunchKernelGGL(yoco_fwd, dim3(grid), dim3(NWAVES * 64), LDS_BYTES, stream, a);
}
```
